# Optimizing an MI355X kernel written in HIP

```python
import jax, jax.numpy as jnp
from jax import lax
import numpy as np

D_MODEL = 2048
BATCH = 2
SEQ = 16384
DEPTH = 1

CHUNK = 64
RWKV_HEADS = 16
RWKV_HEAD_DIM = 64
RWKV_WIDTH = RWKV_HEADS * RWKV_HEAD_DIM
DECAY_RANK = 96
ICLR_RANK = 96
GATE_RANK = 256
GN_EPS = 64e-5
FOX_HEADS = 8
FOX_HEAD_DIM = 128
FOX_WIDTH = FOX_HEADS * FOX_HEAD_DIM
Q_BLOCK = 128
N_EXPERTS = 32
TOP_K = 4
D_FF = 2048
SWIGLU_LIMIT = 7.0
SWIGLU_ALPHA = 1.702
EXPERT_BLOCK = 512
NORM_EPS = 1e-6
RWKV_COLS = 3 * RWKV_WIDTH + DECAY_RANK + ICLR_RANK + GATE_RANK
FOX_COLS = 3 * FOX_WIDTH + FOX_HEADS + FOX_WIDTH
GATE_COLS = 2 * D_MODEL
IN_COLS = RWKV_COLS + FOX_COLS + GATE_COLS

kernel_name = "hybrid_rwkv7_fox_moe_adaln_block"


def _split(t, sizes):
    cuts = [int(v) for v in np.cumsum(sizes)[:-1]]
    return jnp.split(t, cuts, axis=-1)


def rms_norm(t, g, eps=NORM_EPS):
    tf = t.astype(jnp.float32)
    y = tf * lax.rsqrt(jnp.mean(tf * tf, axis=-1, keepdims=True) + eps)
    return (y * g.astype(jnp.float32)).astype(t.dtype)


def rwkv7_scan(r, w, k, v, a, b):
    bsz, _, nh, n = r.shape
    xs = tuple(jnp.moveaxis(t.astype(jnp.float32), 1, 0) for t in (r, w, k, v, a, b))

    def step(state, inp):
        r_t, w_t, k_t, v_t, a_t, b_t = inp
        sa = jnp.einsum('bhij,bhj->bhi', state, a_t)
        state = state * w_t[:, :, None, :] + sa[..., None] * b_t[:, :, None, :] + v_t[..., None] * k_t[:, :, None, :]
        return state, jnp.einsum('bhij,bhj->bhi', state, r_t)

    s0 = jnp.zeros((bsz, nh, n, n), jnp.float32)
    _, ys = lax.scan(step, s0, xs)
    return jnp.moveaxis(ys, 0, 1)


def rwkv7_mixer(p, mu, w_decay_up, decay_w0, w_iclr_up, iclr_a0, w_gate_up_rwkv,
                k_k, k_a, r_k, gn_g, gn_b):
    bsz, seq, _ = p.shape
    f32 = jnp.float32
    prev = jnp.pad(p, ((0, 0), (1, 0), (0, 0)))[:, :-1]
    p = p + mu * (prev - p)
    r, k, v, d_lo, a_lo, g_lo = _split(p, [RWKV_WIDTH] * 3 + [DECAY_RANK, ICLR_RANK, GATE_RANK])
    w_pre = (decay_w0 + jnp.tanh(d_lo) @ w_decay_up).astype(f32)
    decay = jnp.exp(-jnp.exp(-jax.nn.softplus(-w_pre) - 0.5))
    a = jax.nn.sigmoid(iclr_a0 + a_lo @ w_iclr_up)
    g = jax.nn.sigmoid(g_lo) @ w_gate_up_rwkv
    heads = lambda t: t.reshape(bsz, seq, RWKV_HEADS, RWKV_HEAD_DIM)
    kk = heads(k * k_k).astype(f32)
    kk = kk / jnp.maximum(jnp.linalg.norm(kk, axis=-1, keepdims=True), 1e-12)
    k = k * (1.0 + (a - 1.0) * k_a)
    r_h, k_h, v_h = heads(r), heads(k), heads(v)
    a_h = heads(a).astype(f32)
    y = rwkv7_scan(r_h, heads(decay), k_h, v_h, -kk, kk * a_h)
    mean = jnp.mean(y, axis=-1, keepdims=True)
    var = jnp.mean(jnp.square(y - mean), axis=-1, keepdims=True)
    y = ((y - mean) * lax.rsqrt(var + GN_EPS)).reshape(bsz, seq, RWKV_WIDTH)
    y = y * gn_g.astype(f32) + gn_b.astype(f32)
    bonus = jnp.sum(r_h.astype(f32) * k_h.astype(f32) * r_k.astype(f32), axis=-1, keepdims=True) * v_h.astype(f32)
    out = y + bonus.reshape(bsz, seq, RWKV_WIDTH)
    return out.astype(p.dtype) * g


def fox_mixer(p, b_f, q_norm, k_norm):
    bsz, seq, _ = p.shape
    q, k, v, f_pre, og = _split(p, [FOX_WIDTH] * 3 + [FOX_HEADS, FOX_WIDTH])
    heads = lambda t: t.reshape(bsz, seq, FOX_HEADS, FOX_HEAD_DIM).transpose(0, 2, 1, 3)
    q = rms_norm(heads(q), q_norm)
    k = rms_norm(heads(k), k_norm)
    v = heads(v)
    log_f = jax.nn.log_sigmoid((f_pre + b_f).astype(jnp.float32)).transpose(0, 2, 1)
    cum = jnp.cumsum(log_f, axis=-1)
    scale = FOX_HEAD_DIM ** -0.5
    kpos = jnp.arange(seq)

    def attend(i):
        start = i * Q_BLOCK
        qb = lax.dynamic_slice_in_dim(q, start, Q_BLOCK, axis=2)
        cb = lax.dynamic_slice_in_dim(cum, start, Q_BLOCK, axis=2)
        logits = jnp.einsum('bhqd,bhkd->bhqk', qb, k).astype(jnp.float32) * scale + cb[..., None] - cum[:, :, None, :]
        qpos = start + jnp.arange(Q_BLOCK)
        logits = jnp.where(kpos[None, :] <= qpos[:, None], logits, -jnp.inf)
        probs = jax.nn.softmax(logits, axis=-1)
        return jnp.einsum('bhqk,bhkd->bhqd', probs.astype(v.dtype), v)

    o = lax.map(attend, jnp.arange(seq // Q_BLOCK))
    o = o.transpose(1, 0, 3, 2, 4).reshape(bsz, seq, FOX_WIDTH)
    return o * jax.nn.sigmoid(og)


def moe_ffn(h, w_router, b_router, w_gu, b_gu, w_dn, b_dn):
    n_tok, d = h.shape
    logits = (h @ w_router + b_router).astype(jnp.float32)
    top_val, top_idx = lax.top_k(logits, TOP_K)
    weights = jax.nn.softmax(top_val, axis=-1)
    n_assign = n_tok * TOP_K
    flat_e = top_idx.reshape(n_assign)
    flat_tok = jnp.repeat(jnp.arange(n_tok, dtype=jnp.int32), TOP_K)
    flat_w = weights.reshape(n_assign)
    order = jnp.argsort(flat_e)
    s_e, s_tok, s_w = flat_e[order], flat_tok[order], flat_w[order]
    counts = jnp.bincount(flat_e, length=N_EXPERTS)
    padded = (counts + EXPERT_BLOCK - 1) // EXPERT_BLOCK * EXPERT_BLOCK
    pad_end = jnp.cumsum(padded)
    pad_start = pad_end - padded
    grp_start = jnp.cumsum(counts) - counts
    slot = pad_start[s_e] + jnp.arange(n_assign) - grp_start[s_e]
    n_blocks = -(-n_assign // EXPERT_BLOCK) + N_EXPERTS
    n_slots = n_blocks * EXPERT_BLOCK
    buf_tok = jnp.full((n_slots,), n_tok, jnp.int32).at[slot].set(s_tok)
    buf_w = jnp.zeros((n_slots,), jnp.float32).at[slot].set(s_w)
    blk_e = jnp.minimum(jnp.searchsorted(pad_end, jnp.arange(n_blocks) * EXPERT_BLOCK, side='right'), N_EXPERTS - 1)
    h_pad = jnp.concatenate([h, jnp.zeros((1, d), h.dtype)], axis=0)

    def expert_block(args):
        tok, e = args
        gu = h_pad[tok] @ w_gu[e] + b_gu[e]
        gate, lin = jnp.split(gu, 2, axis=-1)
        gate = jnp.minimum(gate, SWIGLU_LIMIT)
        lin = jnp.clip(lin, -SWIGLU_LIMIT, SWIGLU_LIMIT)
        act = gate * jax.nn.sigmoid(SWIGLU_ALPHA * gate) * (lin + 1.0)
        return act @ w_dn[e] + b_dn[e]

    y = lax.map(expert_block, (buf_tok.reshape(n_blocks, EXPERT_BLOCK), blk_e)).reshape(n_slots, d)
    y = y * buf_w[:, None].astype(y.dtype)
    return jax.ops.segment_sum(y, buf_tok, num_segments=n_tok + 1)[:n_tok]


def setup_inputs(seed: int = 0) -> dict:
    key = jax.random.key(seed)
    ks = jax.random.split(key, 32)
    f32 = jnp.float32
    D = D_MODEL

    def nrm(k, shape, scale=1.0):
        return jax.random.normal(k, shape, f32) * scale

    def unif(k, shape, lo, hi):
        return jax.random.uniform(k, shape, f32, lo, hi)

    return {
        'x': nrm(ks[0], (BATCH, SEQ, D)),
        'c': nrm(ks[1], (BATCH, D)),
        'w_ada': nrm(ks[2], (D, 6 * D), D ** -0.5),
        'b_ada': nrm(ks[3], (6 * D,), 0.01),
        'norm1_g': 1.0 + nrm(ks[4], (D,), 0.02),
        'w_in': nrm(ks[5], (D, IN_COLS), D ** -0.5),
        'rwkv_mu': unif(ks[6], (RWKV_COLS,), 0.0, 1.0),
        'w_decay_up': nrm(ks[7], (DECAY_RANK, RWKV_WIDTH), 0.5 * DECAY_RANK ** -0.5),
        'decay_w0': unif(ks[8], (RWKV_WIDTH,), -5.0, -1.0),
        'w_iclr_up': nrm(ks[9], (ICLR_RANK, RWKV_WIDTH), 0.5 * ICLR_RANK ** -0.5),
        'iclr_a0': nrm(ks[10], (RWKV_WIDTH,), 0.1),
        'w_gate_up_rwkv': nrm(ks[11], (GATE_RANK, RWKV_WIDTH), GATE_RANK ** -0.5),
        'rwkv_k_k': 0.85 + nrm(ks[12], (RWKV_WIDTH,), 0.02),
        'rwkv_k_a': 1.0 + nrm(ks[13], (RWKV_WIDTH,), 0.02),
        'rwkv_r_k': nrm(ks[14], (RWKV_HEADS, RWKV_HEAD_DIM), 0.1),
        'rwkv_gn_g': 1.0 + nrm(ks[15], (RWKV_WIDTH,), 0.02),
        'rwkv_gn_b': nrm(ks[16], (RWKV_WIDTH,), 0.01),
        'w_out_a': nrm(ks[17], (RWKV_WIDTH, D), RWKV_WIDTH ** -0.5),
        'fox_b_f': unif(ks[18], (FOX_HEADS,), 1.0, 5.0),
        'fox_q_norm': 1.0 + nrm(ks[19], (FOX_HEAD_DIM,), 0.02),
        'fox_k_norm': 1.0 + nrm(ks[20], (FOX_HEAD_DIM,), 0.02),
        'w_out_b': nrm(ks[21], (FOX_WIDTH, D), FOX_WIDTH ** -0.5),
        'w_out': nrm(ks[22], (D, D), D ** -0.5),
        'norm2_g': 1.0 + nrm(ks[23], (D,), 0.02),
        'w_router': nrm(ks[24], (D, N_EXPERTS), D ** -0.5),
        'b_router': nrm(ks[25], (N_EXPERTS,), 0.01),
        'w_expert_gu': nrm(ks[26], (N_EXPERTS, D, 2 * D_FF), D ** -0.5),
        'b_expert_gu': nrm(ks[27], (N_EXPERTS, 2 * D_FF), 0.01),
        'w_expert_down': nrm(ks[28], (N_EXPERTS, D_FF, D), D_FF ** -0.5),
        'b_expert_down': nrm(ks[29], (N_EXPERTS, D), 0.01),
        'norm_final_g': 1.0 + nrm(ks[30], (D,), 0.02),
    }


def reference(x, c, w_ada, b_ada, norm1_g, w_in, rwkv_mu, w_decay_up, decay_w0, w_iclr_up,
              iclr_a0, w_gate_up_rwkv, rwkv_k_k, rwkv_k_a, rwkv_r_k, rwkv_gn_g, rwkv_gn_b,
              w_out_a, fox_b_f, fox_q_norm, fox_k_norm, w_out_b, w_out, norm2_g, w_router,
              b_router, w_expert_gu, b_expert_gu, w_expert_down, b_expert_down, norm_final_g):
    mod = jax.nn.silu(c) @ w_ada + b_ada
    shift1, scale1, gate1, shift2, scale2, gate2 = (m[:, None, :] for m in jnp.split(mod, 6, axis=-1))
    for _ in range(DEPTH):
        h = rms_norm(x, norm1_g) * (1.0 + scale1) + shift1
        p_rwkv, p_fox, p_gate = _split(h @ w_in, [RWKV_COLS, FOX_COLS, GATE_COLS])
        y_a = rwkv7_mixer(p_rwkv, rwkv_mu, w_decay_up, decay_w0, w_iclr_up, iclr_a0,
                          w_gate_up_rwkv, rwkv_k_k, rwkv_k_a, rwkv_r_k, rwkv_gn_g, rwkv_gn_b) @ w_out_a
        y_b = fox_mixer(p_fox, fox_b_f, fox_q_norm, fox_k_norm) @ w_out_b
        gate_a, gate_b = jnp.split(jax.nn.sigmoid(p_gate), 2, axis=-1)
        x = x + gate1 * ((gate_a * y_a + gate_b * y_b) @ w_out)
        h = rms_norm(x, norm2_g) * (1.0 + scale2) + shift2
        y = moe_ffn(h.reshape(-1, D_MODEL), w_router, b_router, w_expert_gu, b_expert_gu,
                    w_expert_down, b_expert_down)
        x = x + gate2 * y.reshape(x.shape)
    return rms_norm(x, norm_final_g)
```

```cpp
#include <hip/hip_runtime.h>
#include <hip/hip_bf16.h>
#include <cstdio>
#include <cstdint>
constexpr int NWAVES = 8;
#ifndef MK_N_LAUNCHES
#define MK_N_LAUNCHES 0
#endif
constexpr int BATCH = 2, SEQ = 16384, DM = 2048, T = BATCH * SEQ;
constexpr int NP = 11776;
constexpr int PC_R = 0, PC_K = 1024, PC_V = 2048, PC_FQ = 3072, PC_FK = 4096, PC_FV = 5120, PC_OG = 6144, PC_GA = 7168, PC_GB = 9216, PC_GLO = 11264, PC_DLO = 11520, PC_ALO = 11616, PC_F = 11712, PC_END = 11720;
constexpr int RW = 1024, FW = 1024, NE = 32, DFF = 2048, TOPK = 4;
constexpr int NSLOT = T * TOPK + NE * 256;
constexpr float NORM_EPS = 1e-6f, GN_EPS = 64e-5f;

constexpr size_t MiB = 1u << 20;
constexpr size_t WS_CTL = 0, CTL_ZERO_BYTES = 1 * MiB;
constexpr size_t WS_MOD = 1 * MiB;
constexpr size_t WS_WRT = 1 * MiB + 128 * 1024;
constexpr size_t WS_TOKE = 2 * MiB, WS_TOKW = 2 * MiB + 512 * 1024, WS_TOKS = 3 * MiB, WS_SLOTW = 3 * MiB + 512 * 1024;
constexpr size_t WS_WGCNT = 4 * MiB + 512 * 1024, WS_TILEE = 4 * MiB + 768 * 1024;
constexpr size_t WS_LF = 5 * MiB, WS_CS = 6 * MiB;
constexpr size_t WS_BT1 = 7 * MiB, WS_BT2 = 8 * MiB, WS_WOA = 9 * MiB, WS_WOB = 13 * MiB, WS_WOUT = 17 * MiB, WS_WIN = 25 * MiB;
constexpr size_t WS_WGU = 72 * MiB, WS_WDN = 584 * MiB, WS_X1 = 840 * MiB, WS_H = 1096 * MiB;
constexpr size_t WS_P = 1226 * MiB, WS_R = 1962 * MiB, WS_K = 2026 * MiB, WS_V = 2090 * MiB, WS_FQ = 2154 * MiB, WS_FK = 2218 * MiB, WS_FV = 2282 * MiB;
constexpr size_t WS_LW = 2346 * MiB, WS_SG = 2362 * MiB, WS_LOGW = 2378 * MiB, WS_A = 2506 * MiB, WS_G = 2570 * MiB, WS_YRAW = 2634 * MiB, WS_YA = 2762 * MiB, WS_YB = 2826 * MiB, WS_MRG = 2890 * MiB;
constexpr size_t WS_HS = 1226 * MiB, WS_ACT = 1770 * MiB;
constexpr size_t WS_END = 3018 * MiB;
static_assert(WS_WIN + (size_t)NP * DM * 2 <= WS_WGU && WS_ACT + (size_t)NSLOT * DFF * 2 <= WS_END && WS_HS + (size_t)NSLOT * DM * 2 <= WS_ACT && WS_SLOTW + (size_t)NSLOT * 4 <= WS_WGCNT, "d_ws map");
constexpr int CW_TMO = 0, CW_BAR = 4096;

constexpr int RING_OFF = 0, RING_BYTES = 143360;
constexpr int LDSCTL_OFF = RING_BYTES, MISC_OFF = LDSCTL_OFF + 320;
constexpr int LDS_BYTES = 147456;

#define GAS __attribute__((address_space(1)))
#define LAS __attribute__((address_space(3)))
typedef unsigned short bf16;
typedef unsigned v4u __attribute__((ext_vector_type(4)));
typedef unsigned v2u __attribute__((ext_vector_type(2)));
typedef float f32x4 __attribute__((ext_vector_type(4)));
typedef short bf16x8 __attribute__((ext_vector_type(8)));
typedef GAS unsigned gu32;
#define RLX_AGENT __ATOMIC_RELAXED, __HIP_MEMORY_SCOPE_AGENT
#define LDS_WAIT() asm volatile("s_waitcnt lgkmcnt(0)" ::: "memory")
#define VM_WAIT() asm volatile("s_waitcnt vmcnt(0)" ::: "memory")
__device__ __forceinline__ unsigned f2bf(float f) { unsigned u = __builtin_bit_cast(unsigned, f); return (u + 0x7fffu + ((u >> 16) & 1u)) >> 16; }
__device__ __forceinline__ unsigned pk2(float lo, float hi) { return f2bf(lo) | (f2bf(hi) << 16); }
__device__ __forceinline__ float bflo(unsigned w) { return __uint_as_float(w << 16); }
__device__ __forceinline__ float bfhi(unsigned w) { return __uint_as_float(w & 0xffff0000u); }
__device__ __forceinline__ void unpack8(v4u w, float (&f)[8]) { f[0] = bflo(w.x); f[1] = bfhi(w.x); f[2] = bflo(w.y); f[3] = bfhi(w.y); f[4] = bflo(w.z); f[5] = bfhi(w.z); f[6] = bflo(w.w); f[7] = bfhi(w.w); }
__device__ __forceinline__ v4u pack8f(const float (&f)[8]) { v4u w; w.x = pk2(f[0], f[1]); w.y = pk2(f[2], f[3]); w.z = pk2(f[4], f[5]); w.w = pk2(f[6], f[7]); return w; }
__device__ __forceinline__ float sigmoidf_(float x) { return 1.f / (1.f + __expf(-x)); }
__device__ __forceinline__ float wave_sum(float v) {
#pragma unroll
    for (int o = 1; o < 64; o <<= 1) v += __shfl_xor(v, o);
    return v;
}
namespace pg8 {
#define PG8_LAS __attribute__((address_space(3)))
typedef unsigned short bf16_t;
typedef short bf16x8 __attribute__((ext_vector_type(8)));
typedef float f32x4 __attribute__((ext_vector_type(4)));
typedef unsigned u32x4 __attribute__((ext_vector_type(4)));
constexpr int BM = 256, BK = 64, HALF = 128, HTB = HALF * BK * 2  , STAGE_BYTES = 8 * HTB, NXCD = 8, WGM = 8;

__host__ __device__ __forceinline__ int lds_byte(int r, int c) { const int st = (r >> 4) * 2 + (c >> 5), rr = r & 15, cc = c & 31, ob = rr * 64 + cc * 2; return st * 1024 + (ob ^ (((ob >> 9) & 1) << 5)); }
__host__ __device__ __forceinline__ void stage_rc(int b, int& R, int& C) { const int st = b / 1024, sb = b % 1024, swz = sb ^ (((sb >> 9) & 1) << 5); R = (st >> 1) * 16 + swz / 64; C = (st & 1) * 32 + (swz % 64) / 2; }
__host__ __device__ __forceinline__ int perm32(int rho) { const int n = rho >> 4, i = rho & 15; return 8 * (i >> 2) + 4 * n + (i & 3); }

struct Unit { int pm, pn, e; };
struct Gemm { const bf16_t* A; const bf16_t* Bt; int M, N, K; };

struct StaticOrder {
    int nM, nN, nwg, G, c;
    __host__ __device__ void init(int M, int N, int G_, int c_) { nM = M / BM; nN = N / BM; nwg = nM * nN; G = G_; c = c_; }
    __host__ __device__ bool next(int i, Unit& u) const {
        const long L = (long)i * G + c; if (L >= nwg) return false;
        int wgid = (int)L; { const int q = nwg / NXCD, r = nwg % NXCD, xcd = wgid % NXCD, off = wgid / NXCD; wgid = (xcd < r ? xcd * (q + 1) : r * (q + 1) + (xcd - r) * q) + off; }
        const int nig = WGM * nN, gid = wgid / nig, fm = gid * WGM, gsz = (nM - fm) < WGM ? (nM - fm) : WGM;
        u.pm = fm + ((wgid % nig) % gsz); u.pn = (wgid % nig) / gsz; u.e = 0; return true;
    }
    __device__ __forceinline__ void a_ready(const Unit&) const {}
    __device__ __forceinline__ void done(const Unit&) const {}
};

__device__ __forceinline__ unsigned cvt_pk_bf16(float lo, float hi) { unsigned r; asm volatile("v_cvt_pk_bf16_f32 %0, %1, %2" : "=v"(r) : "v"(lo), "v"(hi)); return r; }
typedef float f32x2 __attribute__((ext_vector_type(2)));
__device__ __forceinline__ f32x2 gelu_pk(f32x2 v) {
    const f32x2 av = __builtin_elementwise_abs(v), d = av * 0.2316418882f + 1.0f;
    f32x2 t; t.x = __builtin_amdgcn_rcpf(d.x); t.y = __builtin_amdgcn_rcpf(d.y);
    f32x2 q = t * 0.5307027145f + (-0.7265760135f); q = q * t + 0.7107068705f; q = q * t + (-0.142248368f); q = q * t + 0.127414796f; q = q * t;
    const f32x2 s = (v * v) * (-0.72134752044f);
    f32x2 e; e.x = __builtin_amdgcn_exp2f(s.x); e.y = __builtin_amdgcn_exp2f(s.y);
    const f32x2 m = v * (q * e), r = v - m;
    f32x2 o; o.x = v.x < 0.f ? m.x : r.x; o.y = v.y < 0.f ? m.y : r.y; return o;
}

template <int ACT  > struct EpiBf16 {
    static constexpr bool PERM = true, AFTER_DRAIN = false; static_assert(ACT == 0 || ACT == 1, "EpiBf16: ACT is 0 (none) or 1 (gelu_pk)");
    bf16_t* O; int ldc; const float* bias; int split_cols; size_t split_stride; float scale0;
    __device__ __forceinline__ void operator()(const f32x4 (&acc)[2][2][4][2], const Unit& u, int wr, int wc, int fr, int fq) const {
        const int row0 = u.pm * BM + wr * 64 + fr; int colt = u.pn * BM; bf16_t* base = O;
        float sc = 1.f; if (split_cols) { const int t = colt / split_cols; base += (size_t)t * split_stride; colt -= t * split_cols; if (t == 0) sc = scale0; }
        const int col0 = colt + wc * 32 + 8 * fq, bcol0 = u.pn * BM + wc * 32 + 8 * fq;
        f32x4 bv[2][2];
#pragma unroll
        for (int bj = 0; bj < 2; ++bj)
#pragma unroll
            for (int n = 0; n < 2; ++n) bv[bj][n] = bias ? *(const f32x4*)(bias + bcol0 + bj * HALF + 4 * n) : (f32x4){0.f, 0.f, 0.f, 0.f};
#pragma unroll
        for (int ai = 0; ai < 2; ++ai)
#pragma unroll
            for (int m = 0; m < 4; ++m) { bf16_t* rowp = base + (size_t)(row0 + ai * HALF + m * 16) * ldc + col0;
#pragma unroll
                for (int bj = 0; bj < 2; ++bj) { f32x4 v0 = acc[ai][bj][m][0] + bv[bj][0], v1 = acc[ai][bj][m][1] + bv[bj][1];
                    if (ACT == 1) { f32x2 a = gelu_pk((f32x2){v0[0], v0[1]}), b = gelu_pk((f32x2){v0[2], v0[3]}), c = gelu_pk((f32x2){v1[0], v1[1]}), d = gelu_pk((f32x2){v1[2], v1[3]});
                        v0 = (f32x4){a.x, a.y, b.x, b.y}; v1 = (f32x4){c.x, c.y, d.x, d.y}; }
                    v0 = v0 * sc; v1 = v1 * sc; u32x4 w; w.x = cvt_pk_bf16(v0[0], v0[1]); w.y = cvt_pk_bf16(v0[2], v0[3]); w.z = cvt_pk_bf16(v1[0], v1[1]); w.w = cvt_pk_bf16(v1[2], v1[3]);
                    *(u32x4*)(rowp + bj * HALF) = w; } }
    }
};

template <class Epi, class Sched, bool ALIGN_EPI = false, bool SP2 = false>
__device__ __forceinline__ void gemm_phase(PG8_LAS unsigned char* lds, const Gemm g, const Sched& S, const Epi& E, const int tid) {
    const int wid = __builtin_amdgcn_readfirstlane(tid >> 6), lane = tid & 63, wr = wid >> 2, wc = wid & 3, fr = lane & 15, fq = lane >> 4;
    const int K = g.K, nt = K / BK;
    unsigned voffA[2], voffB[2];
#pragma unroll
    for (int i = 0; i < 2; ++i) { int R, C; stage_rc(tid * 16 + i * 8192, R, C); const int Rb = Epi::PERM ? ((R & ~31) + perm32(R & 31)) : R;
        voffA[i] = (unsigned)(R * K + C) * 2u; voffB[i] = (unsigned)(Rb * K + C) * 2u; }
    const size_t kstep = (size_t)(BK * 2);
    const size_t hstep = (size_t)HALF * K * 2;
    const size_t tstep = 2 * hstep;
    const unsigned ldsw = (unsigned)wid * 1024u;
    const int aoff = lds_byte(wr * 64 + fr, fq * 8), boff = lds_byte(wc * 32 + fr, fq * 8);
#define PG8_SA(b, h) (((b) * 2 + (h)) * HTB)
#define PG8_SB(b, h) ((4 + (b) * 2 + (h)) * HTB)
#define PG8_STAGE(bufoff, gbase, voff) do { _Pragma("unroll") for (int _i = 0; _i < 2; ++_i) \
        __builtin_amdgcn_global_load_lds((const unsigned*)((const char*)(gbase) + (voff)[_i]), (PG8_LAS unsigned*)(lds + (bufoff) + ldsw + _i * 8192), 16, 0, 0); } while (0)
#define PG8_LDA(dst, b, h) do { _Pragma("unroll") for (int m = 0; m < 4; ++m) _Pragma("unroll") for (int k = 0; k < 2; ++k) dst[m][k] = *(const PG8_LAS bf16x8*)(lds + PG8_SA(b, h) + aoff + m * 2048 + k * 1024); } while (0)
#define PG8_LDB(dst, b, h) do { _Pragma("unroll") for (int n = 0; n < 2; ++n) _Pragma("unroll") for (int k = 0; k < 2; ++k) dst[n][k] = *(const PG8_LAS bf16x8*)(lds + PG8_SB(b, h) + boff + n * 2048 + k * 1024); } while (0)
#define PG8_MMA(ai, bj, At, Bt) do { __builtin_amdgcn_s_setprio(1); _Pragma("unroll") for (int m = 0; m < 4; ++m) _Pragma("unroll") for (int n = 0; n < 2; ++n) _Pragma("unroll") for (int k = 0; k < 2; ++k) \
        acc[ai][bj][m][n] = __builtin_amdgcn_mfma_f32_16x16x32_bf16(Bt[n][k], At[m][k], acc[ai][bj][m][n], 0, 0, 0); __builtin_amdgcn_s_setprio(0); } while (0)
#define PG8_WAIT_V(n) asm volatile("s_waitcnt vmcnt(" #n ")" ::: "memory")
#define PG8_WAIT_L(n) asm volatile("s_waitcnt lgkmcnt(" #n ")" ::: "memory")
#define PG8_BAR __builtin_amdgcn_s_barrier()
#define PG8_SCHED __builtin_amdgcn_sched_barrier(0)
    Unit cur, nxt; int ui = 0;
    if (!S.next(0, cur)) return;
    f32x4 acc[2][2][4][2];
#pragma unroll
    for (int a = 0; a < 2; ++a)
#pragma unroll
        for (int b = 0; b < 2; ++b)
#pragma unroll
            for (int m = 0; m < 4; ++m)
#pragma unroll
                for (int n = 0; n < 2; ++n) acc[a][b][m][n] = (f32x4){0.f, 0.f, 0.f, 0.f};
    bf16x8 At[4][2], B0[2][2], B1[2][2];
    const char* cA = (const char*)g.A + (size_t)cur.pm * tstep; const size_t estep = (size_t)g.N * K * 2; const char* cB = (const char*)g.Bt + (size_t)cur.e * estep + (size_t)cur.pn * tstep;
    S.a_ready(cur);
    if constexpr (SP2) {
        PG8_STAGE(PG8_SB(0, 0), cB, voffB); PG8_STAGE(PG8_SB(0, 1), cB + hstep, voffB); PG8_STAGE(PG8_SA(0, 0), cA, voffA); PG8_STAGE(PG8_SA(0, 1), cA + hstep, voffA);
        if (wr == 1) PG8_BAR;
        PG8_WAIT_V(2); PG8_BAR;
        PG8_STAGE(PG8_SB(1, 0), cB + kstep, voffB); PG8_STAGE(PG8_SA(1, 0), cA + kstep, voffA); PG8_STAGE(PG8_SB(1, 1), cB + hstep + kstep, voffB);
        PG8_WAIT_V(6); PG8_BAR;
    } else {
        PG8_STAGE(PG8_SB(0, 0), cB, voffB); PG8_STAGE(PG8_SA(0, 0), cA, voffA); PG8_STAGE(PG8_SB(0, 1), cB + hstep, voffB); PG8_STAGE(PG8_SA(0, 1), cA + hstep, voffA);
        if (wr == 1) PG8_BAR;
        PG8_WAIT_V(4); PG8_BAR;
        PG8_STAGE(PG8_SB(1, 0), cB + kstep, voffB); PG8_STAGE(PG8_SA(1, 0), cA + kstep, voffA); PG8_STAGE(PG8_SB(1, 1), cB + hstep + kstep, voffB);
        PG8_WAIT_V(6); PG8_BAR;
    }
    for (;;) {
        const bool has_next = S.next(ui + 1, nxt);
        const char* nA = has_next ? (const char*)g.A + (size_t)nxt.pm * tstep : cA; const char* nB = has_next ? (const char*)g.Bt + (size_t)nxt.e * estep + (size_t)nxt.pn * tstep : cB;
        for (int t = 0; t < nt; t += 2) {
            const bool last = (t == nt - 2);
            const char* a1 = cA + (size_t)(t + 1) * kstep;
            const char* a2 = last ? nA : cA + (size_t)(t + 2) * kstep; const char* b2 = last ? nB : cB + (size_t)(t + 2) * kstep;
            const char* a3 = a2 + kstep; const char* b3 = b2 + kstep;
            if (last && has_next) S.a_ready(nxt);
            if constexpr (SP2) {
            PG8_LDB(B0, 0, 0); PG8_LDB(B1, 0, 1); PG8_SCHED; PG8_LDA(At, 0, 0); PG8_STAGE(PG8_SA(1, 1), a1 + hstep, voffA);
            PG8_WAIT_V(8); PG8_WAIT_L(0); PG8_BAR; PG8_MMA(0, 0, At, B0); PG8_MMA(0, 1, At, B1); PG8_BAR; PG8_SCHED;
            PG8_LDA(At, 0, 1); PG8_STAGE(PG8_SB(0, 0), b2, voffB); PG8_STAGE(PG8_SB(0, 1), b2 + hstep, voffB); PG8_STAGE(PG8_SA(0, 0), a2, voffA);
            PG8_WAIT_V(8); PG8_WAIT_L(0); PG8_BAR; PG8_MMA(1, 0, At, B0); PG8_MMA(1, 1, At, B1); PG8_BAR; PG8_SCHED;
            PG8_LDB(B0, 1, 0); PG8_LDB(B1, 1, 1); PG8_SCHED; PG8_LDA(At, 1, 0); PG8_STAGE(PG8_SA(0, 1), a2 + hstep, voffA);
            PG8_WAIT_V(8); PG8_WAIT_L(0); PG8_BAR; PG8_MMA(0, 0, At, B0); PG8_MMA(0, 1, At, B1); PG8_BAR; PG8_SCHED;
            PG8_LDA(At, 1, 1); PG8_STAGE(PG8_SB(1, 0), b3, voffB); PG8_STAGE(PG8_SB(1, 1), b3 + hstep, voffB); PG8_STAGE(PG8_SA(1, 0), a3, voffA);
            PG8_WAIT_V(8); PG8_WAIT_L(0); PG8_BAR; PG8_MMA(1, 0, At, B0); PG8_MMA(1, 1, At, B1); PG8_BAR; PG8_SCHED;
            } else {
            PG8_LDB(B0, 0, 0); PG8_SCHED; PG8_LDA(At, 0, 0); PG8_STAGE(PG8_SA(1, 1), a1 + hstep, voffA);
            PG8_WAIT_L(8); PG8_BAR; PG8_WAIT_L(0); PG8_MMA(0, 0, At, B0); PG8_BAR; PG8_SCHED;
            PG8_LDB(B1, 0, 1); PG8_STAGE(PG8_SB(0, 0), b2, voffB);
            PG8_BAR; PG8_WAIT_L(0); PG8_MMA(0, 1, At, B1); PG8_BAR;
            PG8_LDA(At, 0, 1); PG8_STAGE(PG8_SA(0, 0), a2, voffA);
            PG8_BAR; PG8_WAIT_L(0); PG8_MMA(1, 0, At, B0); PG8_BAR; PG8_SCHED;
            PG8_STAGE(PG8_SB(0, 1), b2 + hstep, voffB);
            PG8_WAIT_V(6); PG8_BAR; PG8_MMA(1, 1, At, B1); PG8_BAR;
            PG8_LDB(B0, 1, 0); PG8_SCHED; PG8_LDA(At, 1, 0); PG8_STAGE(PG8_SA(0, 1), a2 + hstep, voffA);
            PG8_WAIT_L(8); PG8_BAR; PG8_WAIT_L(0); PG8_MMA(0, 0, At, B0); PG8_BAR; PG8_SCHED;
            PG8_LDB(B1, 1, 1); PG8_STAGE(PG8_SB(1, 0), b3, voffB);
            PG8_BAR; PG8_WAIT_L(0); PG8_MMA(0, 1, At, B1); PG8_BAR;
            PG8_LDA(At, 1, 1); PG8_STAGE(PG8_SA(1, 0), a3, voffA);
            PG8_BAR; PG8_WAIT_L(0); PG8_MMA(1, 0, At, B0); PG8_BAR; PG8_SCHED;
            PG8_STAGE(PG8_SB(1, 1), b3 + hstep, voffB);
            PG8_WAIT_V(6); PG8_BAR; PG8_MMA(1, 1, At, B1); PG8_BAR;
            }
        }
        if constexpr (ALIGN_EPI) { if (wr == 0) PG8_BAR; }
        if constexpr (!Epi::AFTER_DRAIN) { E(acc, cur, wr, wc, fr, fq); S.done(cur); }
        if (!has_next) break;
#pragma unroll
        for (int a = 0; a < 2; ++a)
#pragma unroll
            for (int b = 0; b < 2; ++b)
#pragma unroll
                for (int m = 0; m < 4; ++m)
#pragma unroll
                    for (int n = 0; n < 2; ++n) acc[a][b][m][n] = (f32x4){0.f, 0.f, 0.f, 0.f};
        cur = nxt; cA = nA; cB = nB; ++ui;
        if constexpr (ALIGN_EPI) { if (wr == 1) PG8_BAR; }
    }
    PG8_WAIT_V(0);
    if constexpr (!ALIGN_EPI) { if (wr == 0) PG8_BAR; }
    PG8_BAR;
    if constexpr (Epi::AFTER_DRAIN) { E.fused(acc, cur, wr, wc, fr, fq, lds, wid, lane); S.done(cur); }
#undef PG8_SA
#undef PG8_SB
#undef PG8_STAGE
#undef PG8_LDA
#undef PG8_LDB
#undef PG8_MMA
#undef PG8_WAIT_V
#undef PG8_WAIT_L
#undef PG8_BAR
#undef PG8_SCHED
}
}
namespace pg8 {
__device__ __forceinline__ float ep_bflo(unsigned w) { return __uint_as_float(w << 16); }
__device__ __forceinline__ float ep_bfhi(unsigned w) { return __uint_as_float(w & 0xffff0000u); }
__device__ __forceinline__ float ep_sig(float x) { return __builtin_amdgcn_rcpf(1.f + __builtin_amdgcn_exp2f(-1.4426950408889634f * x)); }
__device__ __forceinline__ void ep_unpack8(u32x4 w, f32x4& a, f32x4& b) { a = (f32x4){ep_bflo(w.x), ep_bfhi(w.x), ep_bflo(w.y), ep_bfhi(w.y)}; b = (f32x4){ep_bflo(w.z), ep_bfhi(w.z), ep_bflo(w.w), ep_bfhi(w.w)}; }
__device__ __forceinline__ u32x4 ep_pack8(f32x4 a, f32x4 b) { u32x4 w; w.x = cvt_pk_bf16(a[0], a[1]); w.y = cvt_pk_bf16(a[2], a[3]); w.z = cvt_pk_bf16(b[0], b[1]); w.w = cvt_pk_bf16(b[2], b[3]); return w; }
__device__ __forceinline__ f32x4 ep_sig4(f32x4 v) { return (f32x4){ep_sig(v[0]), ep_sig(v[1]), ep_sig(v[2]), ep_sig(v[3])}; }
#define EPI_LOOP_BEGIN const int row0 = u.pm * BM + wr * 64 + fr, col0 = u.pn * BM + wc * 32 + 8 * fq; \
    _Pragma("unroll") for (int ai = 0; ai < 2; ++ai) _Pragma("unroll") for (int m = 0; m < 4; ++m) { const int row = row0 + ai * HALF + m * 16; \
    _Pragma("unroll") for (int bj = 0; bj < 2; ++bj) { const int col = col0 + bj * HALF; const f32x4 v0 = acc[ai][bj][m][0], v1 = acc[ai][bj][m][1];
#define EPI_LOOP_END } }

struct EpiLora1 {
    static constexpr bool PERM = true, AFTER_DRAIN = false;
    float* logw; bf16_t* a; const float* w0; const float* a0;
    __device__ __forceinline__ void operator()(const f32x4 (&acc)[2][2][4][2], const Unit& u, int wr, int wc, int fr, int fq) const {
        EPI_LOOP_BEGIN
            if (u.pn < 4) { const f32x4 b0 = *(const f32x4*)(w0 + col), b1 = *(const f32x4*)(w0 + col + 4);
                float* o = logw + (size_t)row * 1024 + col; *(f32x4*)o = ep_sig4(v0 + b0) * (-0.6065306597126334f); *(f32x4*)(o + 4) = ep_sig4(v1 + b1) * (-0.6065306597126334f); }
            else { const int c = col - 1024; const f32x4 b0 = *(const f32x4*)(a0 + c), b1 = *(const f32x4*)(a0 + c + 4);
                *(u32x4*)(a + (size_t)row * 1024 + c) = ep_pack8(ep_sig4(v0 + b0), ep_sig4(v1 + b1)); }
        EPI_LOOP_END
    }
};
template <int SECOND> struct EpiGateMerge {
    static constexpr bool PERM = true, AFTER_DRAIN = false;
    bf16_t* mrg; const bf16_t* P; int gcol;
    __device__ __forceinline__ void operator()(const f32x4 (&acc)[2][2][4][2], const Unit& u, int wr, int wc, int fr, int fq) const {
        EPI_LOOP_BEGIN
            f32x4 g0, g1; ep_unpack8(*(const u32x4*)(P + (size_t)row * 11776 + gcol + col), g0, g1);
            f32x4 r0 = ep_sig4(g0) * v0, r1 = ep_sig4(g1) * v1;
            bf16_t* o = mrg + (size_t)row * 2048 + col;
            if (SECOND) { f32x4 t0, t1; ep_unpack8(*(const u32x4*)o, t0, t1); r0 = r0 + t0; r1 = r1 + t1; }
            *(u32x4*)o = ep_pack8(r0, r1);
        EPI_LOOP_END
    }
};
struct EpiResid {
    static constexpr bool PERM = true, AFTER_DRAIN = false;
    const float* x; float* x1; const float* mod;
    __device__ __forceinline__ void operator()(const f32x4 (&acc)[2][2][4][2], const Unit& u, int wr, int wc, int fr, int fq) const {
        const float* gt = mod + (size_t)((u.pm * BM) / 16384) * 12288 + 4096;
        EPI_LOOP_BEGIN
            const f32x4 g0 = *(const f32x4*)(gt + col), g1 = *(const f32x4*)(gt + col + 4);
            const size_t off = (size_t)row * 2048 + col;
            *(f32x4*)(x1 + off) = *(const f32x4*)(x + off) + g0 * v0; *(f32x4*)(x1 + off + 4) = *(const f32x4*)(x + off + 4) + g1 * v1;
        EPI_LOOP_END
    }
};
struct EpiSwiglu {
    static constexpr bool PERM = true, AFTER_DRAIN = false;
    bf16_t* act; const float* bias;
    __device__ __forceinline__ void operator()(const f32x4 (&acc)[2][2][4][2], const Unit& u, int wr, int wc, int fr, int fq) const {
        const int row0 = u.pm * BM + wr * 64 + fr, gcol = u.pn * 128 + wc * 32 + 8 * fq;
        const float* bg = bias + (size_t)u.e * 4096 + gcol; const float* bl = bg + 2048;
        const f32x4 bg0 = *(const f32x4*)bg, bg1 = *(const f32x4*)(bg + 4), bl0 = *(const f32x4*)bl, bl1 = *(const f32x4*)(bl + 4);
#pragma unroll
        for (int ai = 0; ai < 2; ++ai)
#pragma unroll
            for (int m = 0; m < 4; ++m) { const int row = row0 + ai * HALF + m * 16;
                f32x4 g0 = acc[ai][0][m][0] + bg0, g1 = acc[ai][0][m][1] + bg1, l0 = acc[ai][1][m][0] + bl0, l1 = acc[ai][1][m][1] + bl1, r0, r1;
#pragma unroll
                for (int i = 0; i < 4; ++i) { const float a = fminf(g0[i], 7.f), b = fminf(g1[i], 7.f);
                    r0[i] = a * ep_sig(1.702f * a) * (fminf(fmaxf(l0[i], -7.f), 7.f) + 1.f); r1[i] = b * ep_sig(1.702f * b) * (fminf(fmaxf(l1[i], -7.f), 7.f) + 1.f); }
                *(u32x4*)(act + (size_t)row * 2048 + gcol) = ep_pack8(r0, r1); }
    }
};
struct EpiDown {
    static constexpr bool PERM = true, AFTER_DRAIN = false;
    bf16_t* ys; const float* bias; const float* slot_w;
    __device__ __forceinline__ void operator()(const f32x4 (&acc)[2][2][4][2], const Unit& u, int wr, int wc, int fr, int fq) const {
        const float* be = bias + (size_t)u.e * 2048;
        EPI_LOOP_BEGIN
            const float w = slot_w[row];
            const f32x4 b0 = *(const f32x4*)(be + col), b1 = *(const f32x4*)(be + col + 4);
            *(u32x4*)(ys + (size_t)row * 2048 + col) = ep_pack8((v0 + b0) * w, (v1 + b1) * w);
        EPI_LOOP_END
    }
};
struct MoeOrder : StaticOrder {
    const int* tile_e;
    __device__ bool next(int i, Unit& u) const { if (!StaticOrder::next(i, u)) return false; u.e = tile_e[u.pm]; return true; }
};
}
namespace fox {
enum { ORDER_NATURAL = 0, ORDER_REVERSED = 1, ORDER_PAIRED = 2, ORDER_XCD = 4 };
using TIN = __hip_bfloat16; using TOUT = __hip_bfloat16;
constexpr int B = 2, H = 8, HKV = 8, SQ = 16384, SKV = 16384, D = 128;
constexpr int PITCH = 1024;
constexpr int GPITCH = 11776;
constexpr int QOFF = 0;
constexpr int WINDOW = SKV;
constexpr float THR = 8.f;
constexpr int ORDER = ORDER_PAIRED;
constexpr bool WSKIP = false;
constexpr float SCALE = 0.08838834764831845f;
constexpr int NW = 8, QBLK = 32, KVBLK = 64, QB = NW * QBLK;
constexpr int SHM_V = KVBLK * D * 2, SHM_K = KVBLK * D * 2;
constexpr int LDS_CB = 2 * SHM_V + 2 * SHM_K + NW * 64 * 4;
constexpr int LDS_GATE = LDS_CB + 3 * 64 * 4 + 256;
constexpr int LDS_BYTES = LDS_GATE + NW * 8192;
static_assert(D == 128 && SQ % QB == 0 && SKV % KVBLK == 0 && H % HKV == 0 && QOFF >= 0 && QOFF + SQ <= SKV && WINDOW >= 1, "geometry");

using bf16 = __hip_bfloat16;
typedef short bf16x8 __attribute__((ext_vector_type(8)));
typedef short s16x4 __attribute__((ext_vector_type(4)));
typedef float f32x16 __attribute__((ext_vector_type(16)));
typedef float f32x4 __attribute__((ext_vector_type(4)));
typedef unsigned u32x4 __attribute__((ext_vector_type(4)));
template <class A, class Bt> struct same_t { static constexpr bool v = false; };
template <class A> struct same_t<A, A> { static constexpr bool v = true; };

#define KSWZ(row, colB) ((row) * 256 + ((colB) ^ (((row) & 7) << 4)))
#define SBAR() __builtin_amdgcn_sched_barrier(0)
__device__ __forceinline__ int v_st(int k, int c) { const int kk = (k & ~0xC) | ((k & 4) << 1) | ((k & 8) >> 1); return ((kk >> 3) * 4 + (c >> 5)) * 512 + ((kk & 7) * 32 + (c & 31)) * 2; }
__device__ __forceinline__ int v_rd_base(int lane) { return ((lane & 3) << 3) | (((lane >> 2) & 3) << 6) | (((lane >> 4) & 1) << 5) | (((lane >> 5) & 1) << 8); }
constexpr int v_rd_off(int d0, int ks, int half) { return d0 * 512 + ks * 4096 + half * 2048; }
__device__ __forceinline__ int crow(int r, int hi) { return (r & 3) + 8 * (r >> 2) + 4 * hi; }
__device__ __forceinline__ unsigned cvtpk(float lo, float hi) {
    unsigned r; asm volatile("v_cvt_pk_bf16_f32 %0, %1, %2" : "=v"(r) : "v"(lo), "v"(hi)); return r;
}
__device__ __forceinline__ bf16x8 pack8(f32x4 a, f32x4 b) {
    u32x4 w = {cvtpk(a[0], a[1]), cvtpk(a[2], a[3]), cvtpk(b[0], b[1]), cvtpk(b[2], b[3])};
    return *reinterpret_cast<bf16x8*>(&w);
}
template <class T> __device__ __forceinline__ bf16x8 load8(const T* p) {
    if constexpr (same_t<T, float>::v) { return pack8(*(const f32x4*)p, *(const f32x4*)(p + 4)); }
    else { return *reinterpret_cast<const bf16x8*>(p); }
}
__device__ __forceinline__ void mask_tile(f32x16& p0, f32x16& p1, int dq, unsigned W) {
    const float NEG = -__builtin_inff();
#pragma unroll
    for (int r = 0; r < 16; ++r) {
        const int c = (r & 3) + 8 * (r >> 2);
        if ((unsigned)(dq - c) >= W) p0[r] = NEG;
        if ((unsigned)(dq - c - 32) >= W) p1[r] = NEG;
    }
}
__device__ __forceinline__ void partialSM(f32x16& p0, f32x16& p1, float& m_reg, float& mn, float& alpha) {
    float pmax = p0[0]; for (int r = 1; r < 16; ++r) pmax = fmaxf(pmax, p0[r]); for (int r = 0; r < 16; ++r) pmax = fmaxf(pmax, p1[r]);
    { auto rr = __builtin_amdgcn_permlane32_swap(__float_as_uint(pmax), __float_as_uint(pmax), false, false);
      pmax = fmaxf(__uint_as_float(rr[0]), __uint_as_float(rr[1])); }
    constexpr float C2 = 1.4426950408889634f * SCALE;
    if (__builtin_expect(__all((pmax - m_reg) * SCALE <= THR), 1)) { mn = m_reg; alpha = 1.f; }
    else { mn = fmaxf(m_reg, pmax); alpha = __builtin_amdgcn_exp2f((m_reg - mn) * C2); m_reg = mn; }
    const float mnL = -mn * C2;
    for (int r = 0; r < 16; ++r) p0[r] = fmaf(p0[r], C2, mnL); for (int r = 0; r < 16; ++r) p1[r] = fmaf(p1[r], C2, mnL);
    for (int r = 0; r < 16; ++r) p0[r] = __builtin_amdgcn_exp2f(p0[r]);
}
__device__ __forceinline__ void finishSM(f32x16& p0, f32x16& p1, float alpha, float& l_reg, bf16x8& pa0, bf16x8& pa1, bf16x8& pa2, bf16x8& pa3) {
    for (int r = 0; r < 16; ++r) p1[r] = __builtin_amdgcn_exp2f(p1[r]);
    float ps = 0; for (int r = 0; r < 16; ++r) ps += p0[r]; for (int r = 0; r < 16; ++r) ps += p1[r];
    { auto rr = __builtin_amdgcn_permlane32_swap(__float_as_uint(ps), __float_as_uint(ps), false, false);
      ps = __uint_as_float(rr[0]) + __uint_as_float(rr[1]); }
    l_reg = l_reg * alpha + ps;
#define PK4(P, B_, OUT) do { unsigned a0 = cvtpk(P[B_+0], P[B_+1]), a1 = cvtpk(P[B_+2], P[B_+3]);                          \
        unsigned b0 = cvtpk(P[B_+4], P[B_+5]), b1 = cvtpk(P[B_+6], P[B_+7]);                                             \
        auto r0 = __builtin_amdgcn_permlane32_swap(a0, b0, false, false); auto r1 = __builtin_amdgcn_permlane32_swap(a1, b1, false, false); \
        u32x4 w = {r0[0], r1[0], r0[1], r1[1]}; OUT = *reinterpret_cast<bf16x8*>(&w); } while (0)
    PK4(p0, 0, pa0); PK4(p0, 8, pa1); PK4(p1, 0, pa2); PK4(p1, 8, pa3);
#undef PK4
}
template <int KB, bool SK>
__device__ __forceinline__ void qkt(f32x16& p0, f32x16& p1, const char* K_lds, int r32, int hi, const bf16x8* qr, bool act, int cbi) {
    if (SK && !act) { const float NEG = -__builtin_inff();
#pragma unroll
        for (int r = 0; r < 16; ++r) { p0[r] = NEG; p1[r] = NEG; } return; }
    { const float* cb_ = (const float*)(K_lds + 2 * SHM_K + NW * 64 * 4) + cbi * 64 + 4 * hi;
#pragma unroll
      for (int g_ = 0; g_ < 4; ++g_) { const f32x4 b0_ = *(const f32x4*)(cb_ + 8 * g_), b1_ = *(const f32x4*)(cb_ + 32 + 8 * g_);
#pragma unroll
          for (int i_ = 0; i_ < 4; ++i_) { p0[4 * g_ + i_] = b0_[i_]; p1[4 * g_ + i_] = b1_[i_]; } } }
    const char* kb[4];
#pragma unroll
    for (int dd = 0; dd < 4; ++dd) kb[dd] = K_lds + KB * SHM_K + KSWZ(r32, (dd * 16 + hi * 8) * 2);
#pragma unroll
    for (int d0 = 0; d0 < 8; ++d0) { const char* a = kb[d0 & 3] + (d0 >> 2) * 128;
        bf16x8 b0 = *reinterpret_cast<const bf16x8*>(a);
        bf16x8 b1 = *reinterpret_cast<const bf16x8*>(a + 32 * 256);
        p0 = __builtin_amdgcn_mfma_f32_32x32x16_bf16(b0, qr[d0], p0, 0, 0, 0);
        p1 = __builtin_amdgcn_mfma_f32_32x32x16_bf16(b1, qr[d0], p1, 0, 0, 0); }
}
template <int VB, bool SK>
__device__ __forceinline__ void pv_tile(f32x16* o, int vb0, bf16x8 pa0, bf16x8 pa1, bf16x8 pa2, bf16x8 pa3, bool act) {
    if (SK && !act) return;
#define TRRD(dst, off) asm volatile("ds_read_b64_tr_b16 %0, %1 offset:%2" : "=&v"(dst) : "v"(vb0), "i"(off) : "memory")
#define PV_D0(d0) do { s16x4 l0, l1, l2, l3, h0, h1, h2, h3; constexpr int b_ = VB * SHM_V + v_rd_off(d0, 0, 0);     \
        TRRD(l0, b_); TRRD(h0, b_ + 2048); TRRD(l1, b_ + 4096); TRRD(h1, b_ + 6144); TRRD(l2, b_ + 8192); TRRD(h2, b_ + 10240); TRRD(l3, b_ + 12288); TRRD(h3, b_ + 14336); \
        asm volatile("s_waitcnt lgkmcnt(0)" ::: "memory"); SBAR();                 \
        o[d0] = __builtin_amdgcn_mfma_f32_32x32x16_bf16(pa0, (bf16x8){l0[0], l0[1], l0[2], l0[3], h0[0], h0[1], h0[2], h0[3]}, o[d0], 0, 0, 0);   \
        o[d0] = __builtin_amdgcn_mfma_f32_32x32x16_bf16(pa1, (bf16x8){l1[0], l1[1], l1[2], l1[3], h1[0], h1[1], h1[2], h1[3]}, o[d0], 0, 0, 0);   \
        o[d0] = __builtin_amdgcn_mfma_f32_32x32x16_bf16(pa2, (bf16x8){l2[0], l2[1], l2[2], l2[3], h2[0], h2[1], h2[2], h2[3]}, o[d0], 0, 0, 0);   \
        o[d0] = __builtin_amdgcn_mfma_f32_32x32x16_bf16(pa3, (bf16x8){l3[0], l3[1], l3[2], l3[3], h3[0], h3[1], h3[2], h3[3]}, o[d0], 0, 0, 0); } while (0)
    PV_D0(0); PV_D0(1); PV_D0(2); PV_D0(3);
#undef PV_D0
#undef TRRD
}

template <class TIn, class TOut> struct BlockRef { const unsigned char* ws; int row0, bh, P0;
    __device__ __forceinline__ const TIn* Q() const { return (const TIn*)(ws + WS_FQ) + (size_t)row0 * PITCH + (bh % H) * D; }
    __device__ __forceinline__ const TIn* K() const { return (const TIn*)(ws + WS_FK) + (size_t)(bh / H) * SQ * PITCH + (bh % H) * D; }
    __device__ __forceinline__ const TIn* V() const { return (const TIn*)(ws + WS_FV) + (size_t)(bh / H) * SQ * PITCH + (bh % H) * D; }
    __device__ __forceinline__ TOut* O() const { return (TOut*)(ws + WS_YB) + (size_t)row0 * PITCH + (bh % H) * D; }
    __device__ __forceinline__ const float* C() const { return (const float*)(ws + WS_CS) + (size_t)bh * SQ; }
    __device__ __forceinline__ const TIn* G() const { return (const TIn*)(ws + WS_P) + (size_t)row0 * GPITCH + PC_OG + (bh % H) * D; }
};
template <class TIn> struct Seam {
    bf16x8 qr[8];
    bf16x8 st_v0, st_v1, st_k0, st_k1; int cbi; f32x4 sf0, sf1, sf2, sf3;
    f32x4 tq[16];
};
__device__ __forceinline__ int swa_jlo(int P0, int W) { const int lowk = P0 - W + 1; return lowk > 0 ? lowk / KVBLK : 0; }
#define ROW(p, k0, rr) ((p) + (size_t)((k0) + (rr)) * PITCH + sc)
#define VMW() asm volatile("s_waitcnt vmcnt(0)" ::: "memory")
#define VMWN(n) asm volatile("s_waitcnt vmcnt(%0)" :: "i"(n) : "memory")
#define NEXT3(x) ((x) == 2 ? 0 : (x) + 1)
#define SLOAD_H(Kp, Vp, Cp, k0, CI) do { S.st_v0 = load8<TIn>(ROW(Vp, k0, sr)); S.st_v1 = load8<TIn>(ROW(Vp, k0, 32 + sr));              \
                         S.st_k0 = load8<TIn>(ROW(Kp, k0, sr)); S.st_k1 = load8<TIn>(ROW(Kp, k0, 32 + sr));                 \
                         if (wid == 0) __builtin_amdgcn_global_load_lds((const unsigned*)((Cp) + (k0) + lane), (__attribute__((address_space(3))) unsigned*)(lds + LDS_CB + (CI) * 256), 4, 0, 0); } while (0)
#define SWRITE_HK(bf) do { *(bf16x8*)(K_lds + (bf) * SHM_K + kws) = S.st_k0; *(bf16x8*)(K_lds + (bf) * SHM_K + kws + 32 * 256) = S.st_k1; } while (0)
#define SWRITE_HV(bf) do { *(bf16x8*)(V_lds + (bf) * SHM_V + vst0) = S.st_v0; *(bf16x8*)(V_lds + (bf) * SHM_V + vst1) = S.st_v1; } while (0)
#define SWRITE_H(bf) do { SWRITE_HV(bf); SWRITE_HK(bf); } while (0)
#define SLOAD_F(p, k0) do { S.sf0 = *(const f32x4*)ROW(p, k0, sr); S.sf1 = *(const f32x4*)(ROW(p, k0, sr) + 4);                \
                            S.sf2 = *(const f32x4*)ROW(p, k0, 32 + sr); S.sf3 = *(const f32x4*)(ROW(p, k0, 32 + sr) + 4); } while (0)
#define SWRITE_KF(bf) do { *(bf16x8*)(K_lds + (bf) * SHM_K + kws) = pack8(S.sf0, S.sf1); *(bf16x8*)(K_lds + (bf) * SHM_K + kws + 32 * 256) = pack8(S.sf2, S.sf3); } while (0)
#define SWRITE_VF(bf) do { *(bf16x8*)(V_lds + (bf) * SHM_V + vst0) = pack8(S.sf0, S.sf1); *(bf16x8*)(V_lds + (bf) * SHM_V + vst1) = pack8(S.sf2, S.sf3); } while (0)
template <class TIn, class TOut>
__device__ __forceinline__ void causal_swa_prime(const BlockRef<TIn, TOut>& cur, int W, char* lds, Seam<TIn>& S, const int tid) {
    constexpr bool F32 = same_t<TIn, float>::v;
    const int wid = __builtin_amdgcn_readfirstlane(tid >> 6), lane = tid & 63, r32 = lane & 31, hi = lane >> 5;
    const int sr = tid >> 4, sc = (tid & 15) * 8, kws = KSWZ(sr, sc * 2); char* K_lds = lds + 2 * SHM_V;
    const int kb0 = swa_jlo(cur.P0, W) * KVBLK;
    for (int d0 = 0; d0 < 8; ++d0) S.qr[d0] = load8<TIn>(cur.Q() + (size_t)(wid * QBLK + r32) * PITCH + d0 * 16 + hi * 8);
    if constexpr (F32) { SLOAD_F((const float*)cur.K(), kb0); VMW(); SWRITE_KF(0); SBAR(); SLOAD_F((const float*)cur.V(), kb0); }
    else { S.cbi = 0; SLOAD_H(cur.K(), cur.V(), cur.C(), kb0, 0); VMW(); SWRITE_HK(0); }
    __syncthreads();
}
template <class TIn, class TOut>
__device__ __forceinline__ void causal_swa_block(const BlockRef<TIn, TOut>& cur, const BlockRef<TIn, TOut>& nxt, int skv, int W, char* lds, Seam<TIn>& S, const int tid) {
    constexpr bool F32 = same_t<TIn, float>::v;
    const int wid = __builtin_amdgcn_readfirstlane(tid >> 6), lane = tid & 63, r32 = lane & 31, hi = lane >> 5;
    const int j_lo = swa_jlo(cur.P0, W);
    int j_hi = (cur.P0 + QB - 1) / KVBLK + 1; if (j_hi > skv / KVBLK) j_hi = skv / KVBLK;
    const int NT = j_hi - j_lo;
    const int kbn = swa_jlo(nxt.P0, W) * KVBLK;
    const int qlo = cur.P0 + wid * QBLK, qm = qlo + r32 - 4 * hi;
    char* V_lds = lds; char* K_lds = lds + 2 * SHM_V;
    float* ws = (float*)(lds + 2 * SHM_V + 2 * SHM_K) + wid * 64; float* li_l = ws, * al_l = ws + 32;
    float m_reg = -1e30f, l_reg = 0; f32x16 o[4] = {};
    const int sr = tid >> 4, sc = (tid & 15) * 8, vst0 = v_st(sr, sc), vst1 = v_st(32 + sr, sc), kws = KSWZ(sr, sc * 2);
    const int vb0 = (int)(uintptr_t)V_lds + v_rd_base(lane);
    const TIn* Kh = cur.K(); const TIn* Vh = cur.V(); const float* Ch = cur.C(); int cb_t = S.cbi;
    {
        const TIn* gsrc = cur.G() + (size_t)(wid * QBLK + (lane >> 4)) * GPITCH + (lane & 15) * 8;
#pragma unroll
        for (int i_ = 0; i_ < 8; ++i_) __builtin_amdgcn_global_load_lds((const unsigned*)(gsrc + (size_t)(4 * i_) * GPITCH), (__attribute__((address_space(3))) unsigned*)(lds + LDS_GATE + wid * 8192 + i_ * 1024), 16, 0, 0); }
#define RESC(a) do { if (__any((a) < 1.f)) { if (hi == 0) al_l[r32] = (a); asm volatile("s_waitcnt lgkmcnt(0)" ::: "memory");              \
                     for (int d_ = 0; d_ < 4; ++d_) for (int r = 0; r < 16; ++r) o[d_][r] *= al_l[crow(r, hi)]; } } while (0)
#define KBASE(t) ((j_lo + (t)) * KVBLK)
#define ACT(t) (KBASE(t) <= qlo + QBLK - 1 && KBASE(t) + KVBLK - 1 >= qlo - W + 1)
#define MASKT(P0_, P1_, t) do { const int kb_ = KBASE(t); if ((!SK || ACT(t)) && (kb_ + KVBLK - 1 > qlo || kb_ <= qlo + QBLK - 1 - W)) mask_tile(P0_, P1_, qm - kb_, (unsigned)W); } while (0)
    constexpr int NQL = F32 ? 16 : 8;
    constexpr bool SK = WSKIP && !F32;
#define SEAM_K0() do { VMWN(NQL); if constexpr (F32) { SWRITE_KF(0); SBAR(); SLOAD_F((const float*)nxt.V(), kbn); } else { SWRITE_HK(0); } SBAR(); } while (0)
    f32x16 pA0, pA1, pB0, pB1; float mnA, mnB, alA, alB; bf16x8 pa0, pa1, pa2, pa3;
    if constexpr (F32) { VMW(); SWRITE_VF(0); SBAR(); } else { SWRITE_HV(0); SBAR(); }
    if (NT > 1) { if constexpr (F32) SLOAD_F((const float*)Kh, KBASE(1)); else SLOAD_H(Kh, Vh, Ch, KBASE(1), NEXT3(cb_t)); }
    SBAR(); qkt<0, SK>(pA0, pA1, K_lds, r32, hi, S.qr, ACT(0), cb_t);
    if constexpr (F32) { if (NT > 1) { VMW(); SWRITE_KF(1); SBAR(); SLOAD_F((const float*)Vh, KBASE(1)); } }
    MASKT(pA0, pA1, 0); partialSM(pA0, pA1, m_reg, mnA, alA);
    if (NT > 1) { VMW(); if constexpr (F32) { SWRITE_VF(1); SBAR(); if (NT > 2) SLOAD_F((const float*)Kh, KBASE(2)); } else SWRITE_H(1); }
    __syncthreads();
#define HALF_STEP(PX0, PX1, mnX, alX, PY0, PY1, alY, t, KB, VB, SB) do {                                                      \
        SBAR(); cb_t = NEXT3(cb_t); qkt<KB, SK>(PX0, PX1, K_lds, r32, hi, S.qr, ACT(t), cb_t);                                             \
        finishSM(PY0, PY1, alY, l_reg, pa0, pa1, pa2, pa3); SBAR();                                                           \
        if ((t) + 1 < NT) { if constexpr (F32) { VMW(); SWRITE_KF(SB); SBAR(); SLOAD_F((const float*)Vh, KBASE((t) + 1)); }  \
                            else { SLOAD_H(Kh, Vh, Ch, KBASE((t) + 1), NEXT3(cb_t)); } SBAR(); }                                               \
        pv_tile<VB, SK>(o, vb0, pa0, pa1, pa2, pa3, ACT((t) - 1)); MASKT(PX0, PX1, (t)); partialSM(PX0, PX1, m_reg, mnX, alX);                                        \
        __syncthreads();                                                                                                      \
        if ((t) + 1 < NT) { VMW(); if constexpr (F32) { SWRITE_VF(SB); SBAR(); if ((t) + 2 < NT) SLOAD_F((const float*)Kh, KBASE((t) + 2)); } \
                            else { SWRITE_H(SB); } }                                                                          \
        RESC(alX); __syncthreads(); } while (0)
    for (int t = 1; t + 1 < NT; t += 2) {
        HALF_STEP(pB0, pB1, mnB, alB, pA0, pA1, alA, t, 1, 0, 0);
        HALF_STEP(pA0, pA1, mnA, alA, pB0, pB1, alB, t + 1, 0, 1, 1);
    }
    const bool even = (NT & 1) == 0;
    if (even) { SBAR(); cb_t = NEXT3(cb_t); qkt<1, SK>(pB0, pB1, K_lds, r32, hi, S.qr, ACT(NT - 1), cb_t); SBAR(); }
#define QROW(e) (nxt.Q() + (size_t)(wid * QBLK + r32) * PITCH + ((e) >> 1) * 16 + hi * 8 + ((e) & 1) * 4)
    if constexpr (F32) { SLOAD_F((const float*)nxt.K(), kbn); SBAR();
#pragma unroll
        for (int e = 0; e < 8; ++e) S.tq[e] = *(const f32x4*)QROW(e); }
    else { SLOAD_H(nxt.K(), nxt.V(), nxt.C(), kbn, NEXT3(cb_t)); S.cbi = NEXT3(cb_t); SBAR();
#pragma unroll
        for (int d0 = 0; d0 < 8; ++d0) S.qr[d0] = load8<TIn>(nxt.Q() + (size_t)(wid * QBLK + r32) * PITCH + d0 * 16 + hi * 8); }
    SBAR();
    finishSM(pA0, pA1, alA, l_reg, pa0, pa1, pa2, pa3); SBAR();
    if constexpr (F32) {
#pragma unroll
        for (int e = 8; e < 16; ++e) S.tq[e] = *(const f32x4*)QROW(e); SBAR(); }
#undef QROW
    pv_tile<0, SK>(o, vb0, pa0, pa1, pa2, pa3, ACT(even ? NT - 2 : NT - 1));
    if (even) { MASKT(pB0, pB1, NT - 1); partialSM(pB0, pB1, m_reg, mnB, alB); __syncthreads(); RESC(alB);
        finishSM(pB0, pB1, alB, l_reg, pa0, pa1, pa2, pa3); SBAR(); pv_tile<1, SK>(o, vb0, pa0, pa1, pa2, pa3, ACT(NT - 1)); }
    SBAR(); SEAM_K0();
    if (hi == 0) li_l[r32] = l_reg; asm volatile("s_waitcnt lgkmcnt(0)" ::: "memory");
    float rli[16];
#pragma unroll
    for (int r = 0; r < 16; ++r) rli[r] = __builtin_amdgcn_rcpf(li_l[crow(r, hi)]);
    int hi_e = hi; asm volatile("" : "+v"(hi_e));
    TOut* Ow = cur.O() + (size_t)(wid * QBLK) * PITCH + (size_t)(4 * hi_e) * PITCH; const char* gl_ = lds + LDS_GATE + wid * 8192 + 4 * hi_e * 256;
#pragma unroll
    for (int r = 0; r < 16; ++r) { const int orow = (r & 3) + 8 * (r >> 2);
#pragma unroll
        for (int d0 = 0; d0 < 4; ++d0) { const float v = o[d0][r] * rli[r];
            if constexpr (same_t<TOut, float>::v) { Ow[(size_t)orow * PITCH + d0 * 32 + r32] = v; }
            else { const float vn = __shfl_xor(v, 1);
                   if ((r32 & 1) == 0) { const unsigned gw_ = *(const unsigned*)(gl_ + orow * 256 + (d0 * 32 + r32) * 2);
                       const float g0_ = __uint_as_float(gw_ << 16), g1_ = __uint_as_float(gw_ & 0xffff0000u);
                       const float s0_ = __builtin_amdgcn_rcpf(1.f + __builtin_amdgcn_exp2f(-1.4426950408889634f * g0_)), s1_ = __builtin_amdgcn_rcpf(1.f + __builtin_amdgcn_exp2f(-1.4426950408889634f * g1_));
                       *(unsigned*)(Ow + (size_t)orow * PITCH + d0 * 32 + r32) = cvtpk(v * s0_, vn * s1_); } } } }
    if constexpr (F32) {
#pragma unroll
        for (int d0 = 0; d0 < 8; ++d0) S.qr[d0] = pack8(S.tq[2 * d0], S.tq[2 * d0 + 1]); }
    __syncthreads();
#undef RESC
#undef KBASE
#undef ACT
#undef MASKT
#undef SEAM_K0
#undef HALF_STEP
}
#undef ROW
#undef VMW
#undef VMWN
#undef SLOAD_H
#undef SWRITE_HK
#undef SWRITE_HV
#undef SWRITE_H
#undef SLOAD_F
#undef SWRITE_KF
#undef SWRITE_VF

}
#define XB_TMO      128
#define XB_XCNT(j)  (256  + 64 * (j))
#define XB_XSUB(j)  (1280 + 64 * (j))
#define XB_XGEN(j)  (2304 + 64 * (j))
#define XB_TOP      3328
#define XB_TOPGEN   3392
#define XCD_BAR_WORDS 3456
#define XB_SPIN_CAP (1u << 18)

__device__ __forceinline__ unsigned xb_ld(unsigned* p)              { return __hip_atomic_load(p, __ATOMIC_RELAXED, __HIP_MEMORY_SCOPE_AGENT); }
__device__ __forceinline__ unsigned xb_add(unsigned* p, unsigned v) { return __hip_atomic_fetch_add(p, v, __ATOMIC_RELAXED, __HIP_MEMORY_SCOPE_AGENT); }
__device__ __forceinline__ unsigned xb_xcc_id() { return (unsigned)__builtin_amdgcn_s_getreg((3 << 11) | 20) & 0xFu; }
#define XB_SPIN(cond, bar) do { unsigned _sp = 0; while (cond) { __builtin_amdgcn_s_sleep(1); \
    if ((++_sp & 255u) == 0u) { if (xb_ld(&(bar)[XB_TMO])) break; if (_sp > XB_SPIN_CAP) { atomicAdd(&(bar)[XB_TMO], 1u); break; } } } } while (0)

struct XcdBarrier {
    unsigned* bar; unsigned x;
    volatile LAS unsigned* st;
};

__device__ __forceinline__ XcdBarrier xcd_barrier_post(unsigned* bar, volatile LAS unsigned* st, const int tid) {
    XcdBarrier b; b.bar = bar; b.x = xb_xcc_id(); b.st = st;
    if (tid == 0) (void)xb_add(&bar[XB_XCNT(b.x)], 1u);
    return b;
}
__device__ __forceinline__ void xcd_barrier_complete(unsigned* bar, unsigned x, unsigned& nloc, unsigned& nx) {
    const unsigned G = gridDim.x * gridDim.y * gridDim.z;
    unsigned sum, cnt, mine, sp = 0u;
    for (;;) {
        sum = 0u; cnt = 0u; mine = 0u;
#pragma unroll
        for (unsigned j = 0; j < 16; ++j) { const unsigned c = xb_ld(&bar[XB_XCNT(j)]); sum += c; cnt += (c > 0u) ? 1u : 0u; mine = (j == x) ? c : mine; }
        if (sum == G) break;
        __builtin_amdgcn_s_sleep(1);
        if ((++sp & 255u) == 0u) { if (xb_ld(&bar[XB_TMO])) break; if (sp > XB_SPIN_CAP) { atomicAdd(&bar[XB_TMO], 1u); break; } }
    }
    nloc = mine > 0u ? mine : 1u; nx = cnt > 0u ? cnt : 1u;
}

__device__ __forceinline__ void xcd_barrier(const XcdBarrier& b, const int tid) {
    asm volatile("s_waitcnt vmcnt(0)" ::: "memory");
    __syncthreads();
    if (tid == 0) {
        unsigned* bar = b.bar;
        __builtin_amdgcn_s_waitcnt(0);
        unsigned nloc = b.st[0], nx = b.st[1];
        if (nloc == 0u) { xcd_barrier_complete(bar, b.x, nloc, nx); b.st[0] = nloc; b.st[1] = nx; }
        const unsigned old = xb_add(&bar[XB_XSUB(b.x)], 1u);
        const unsigned gen = old / nloc;
        if (old + 1u == (gen + 1u) * nloc) {
            __builtin_amdgcn_fence(__ATOMIC_RELEASE, "agent");
            asm volatile("s_waitcnt vmcnt(0)" ::: "memory");
            const unsigned og = xb_add(&bar[XB_TOP], 1u);
            const unsigned tg = og / nx;
            if (og + 1u == (tg + 1u) * nx) xb_add(&bar[XB_TOPGEN], 1u);
            else XB_SPIN(xb_ld(&bar[XB_TOPGEN]) == tg, bar);
            __builtin_amdgcn_fence(__ATOMIC_ACQUIRE, "agent");
            xb_add(&bar[XB_XGEN(b.x)], 1u);
            asm volatile("s_waitcnt vmcnt(0)" ::: "memory");
        } else {
            XB_SPIN(xb_ld(&bar[XB_XGEN(b.x)]) == gen, bar);
            __builtin_amdgcn_fence(__ATOMIC_ACQUIRE, "agent");
            asm volatile("s_waitcnt vmcnt(0)" ::: "memory");
        }
    }
    __syncthreads();
}
enum InIdx { I_X = 0, I_C, I_WADA, I_BADA, I_N1G, I_WIN, I_MU, I_WDEC, I_W0, I_WICLR, I_A0, I_WGATE, I_KK, I_KA, I_RK, I_GNG, I_GNB, I_WOA, I_BF, I_QN, I_KN, I_WOB, I_WOUT, I_N2G, I_WR, I_BR, I_WGU, I_BGU, I_WDN, I_BDN, I_NFG, N_IN };
struct Args { const float* in[N_IN]; float* out; unsigned char* ws; int ph_lo, ph_hi; };
static_assert(sizeof(Args) == (N_IN + 2) * 8 + 8, "Args has no padding");
typedef const __attribute__((address_space(4))) Args* ArgsP;
struct Frame {
    LAS unsigned char* lds;
    volatile LAS unsigned* MISC;
    gu32* ctl;
    int tid, lane, wave, G, wg;
    unsigned char* ws;
    ArgsP ap;
};
#define WSP(T_, off) ((T_*)(F.ws + (off)))

__device__ __forceinline__ int win_orig_col(int c) {
    if (c < PC_FQ) return c;
    if (c < PC_OG) return 3520 + (c - PC_FQ);
    if (c < PC_GA) return 6600 + (c - PC_OG);
    if (c < PC_GLO) return 7624 + (c - PC_GA);
    if (c < PC_DLO) return 3264 + (c - PC_GLO);
    if (c < PC_ALO) return 3072 + (c - PC_DLO);
    if (c < PC_F) return 3168 + (c - PC_ALO);
    if (c < PC_END) return 6592 + (c - PC_F);
    return -1;
}
__device__ __forceinline__ void tr_item(const float* W, int ldw, int K, bf16* WT, int drow0, int scol0, int nvalid, int k0, LAS float* scr, int lane) {
    const int n = lane & 31;
#pragma unroll 8
    for (int i = 0; i < 32; ++i) { const int kk = 2 * i + (lane >> 5); scr[kk * 33 + n] = (n < nvalid) ? W[(size_t)(k0 + kk) * ldw + scol0 + n] : 0.f; }
    LDS_WAIT(); asm volatile("" ::: "memory");
    const int c = lane & 7;
#pragma unroll
    for (int j = 0; j < 4; ++j) { const int nn = (lane >> 3) + 8 * j; const LAS float* s = scr + (8 * c) * 33 + nn;
        v4u o; o.x = pk2(s[0 * 33], s[1 * 33]); o.y = pk2(s[2 * 33], s[3 * 33]); o.z = pk2(s[4 * 33], s[5 * 33]); o.w = pk2(s[6 * 33], s[7 * 33]);
        *(GAS v4u*)(WT + (size_t)(drow0 + nn) * K + k0 + 8 * c) = o; }
    LDS_WAIT(); asm volatile("" ::: "memory");
}
__device__ __forceinline__ void p0_prologue(Frame& F) {
    LAS float* scr = (LAS float*)(F.lds + RING_OFF + F.wave * 16384);
    const int gw = F.wg * NWAVES + F.wave, NGW = F.G * NWAVES, lane = F.lane;
    constexpr int I_IN = 32 * 368, I_OA = 16 * 64, I_OB = I_OA, I_OUT = 32 * 64, I_GU = NE * 32 * 128, I_DN = NE * 32 * 64;
    constexpr int NITEMS = I_IN + I_OA + I_OB + I_OUT + I_GU + I_DN;
    for (int it = gw; it < NITEMS; it += NGW) {
        int r = it;
        if (r < I_IN) { const int kb = r / 368, gp = r % 368, c0 = gp * 32, oc = win_orig_col(c0); int nv = 32; if (oc < 0) nv = 0; else if (c0 + 32 > PC_END) nv = PC_END - c0;
            tr_item(F.ap->in[I_WIN], 11720, 2048, WSP(bf16, WS_WIN), c0, oc < 0 ? 0 : oc, nv, kb * 64, scr, lane); continue; } r -= I_IN;
        if (r < I_OA) { tr_item(F.ap->in[I_WOA], 2048, 1024, WSP(bf16, WS_WOA), (r % 64) * 32, (r % 64) * 32, 32, (r / 64) * 64, scr, lane); continue; } r -= I_OA;
        if (r < I_OB) { tr_item(F.ap->in[I_WOB], 2048, 1024, WSP(bf16, WS_WOB), (r % 64) * 32, (r % 64) * 32, 32, (r / 64) * 64, scr, lane); continue; } r -= I_OB;
        if (r < I_OUT) { tr_item(F.ap->in[I_WOUT], 2048, 2048, WSP(bf16, WS_WOUT), (r % 64) * 32, (r % 64) * 32, 32, (r / 64) * 64, scr, lane); continue; } r -= I_OUT;
        if (r < I_GU) { const int e = r / (32 * 128), q = r % (32 * 128), kb = q / 128, gp = q % 128, d0 = gp * 32;
            const int pn = d0 >> 8, j = d0 & 255, sc = j < 128 ? 128 * pn + j : 2048 + 128 * pn + (j - 128);
            tr_item(F.ap->in[I_WGU] + (size_t)e * 2048 * 4096, 4096, 2048, WSP(bf16, WS_WGU) + (size_t)e * 4096 * 2048, d0, sc, 32, kb * 64, scr, lane); continue; } r -= I_GU;
        { const int e = r / (32 * 64), q = r % (32 * 64), kb = q / 64, gp = q % 64;
            tr_item(F.ap->in[I_WDN] + (size_t)e * 2048 * 2048, 2048, 2048, WSP(bf16, WS_WDN) + (size_t)e * 2048 * 2048, gp * 32, gp * 32, 32, kb * 64, scr, lane); }
    }
    const int gt = F.wg * (NWAVES * 64) + F.tid, NGT = F.G * NWAVES * 64;
    { bf16* b1 = WSP(bf16, WS_BT1); const float* wd = F.ap->in[I_WDEC]; const float* wi = F.ap->in[I_WICLR];
      for (int i = gt; i < 2048 * 256; i += NGT) { const int n = i >> 8, k = i & 255; float v = 0.f;
          if (n < 1024) { if (k < 96) v = wd[k * 1024 + n]; } else { if (k >= 128 && k < 224) v = wi[(k - 128) * 1024 + (n - 1024)]; }
          b1[i] = (bf16)f2bf(v); } }
    { bf16* b2 = WSP(bf16, WS_BT2); const float* wg = F.ap->in[I_WGATE];
      for (int i = gt; i < 1024 * 256; i += NGT) { const int n = i >> 8, k = i & 255; b2[i] = (bf16)f2bf(wg[k * 1024 + n]); } }
    { float* wrt = WSP(float, WS_WRT); const float* wr = F.ap->in[I_WR];
      for (int i = gt; i < 32 * 2048; i += NGT) { const int e = i >> 11, k = i & 2047; wrt[i] = wr[k * 32 + e]; } }
    { bf16* h = WSP(bf16, WS_H) + (size_t)T * DM; for (int i = gt; i < DM; i += NGT) h[i] = 0; }
    if (F.wg < 192) {
        const float* wa = F.ap->in[I_WADA]; const float* cc = F.ap->in[I_C]; const int n = F.wg * 64 + lane;
        float s0 = 0.f, s1 = 0.f;
        for (int k = F.wave * 256; k < F.wave * 256 + 256; ++k) { const float w = wa[(size_t)k * 12288 + n]; const float c0 = cc[k], c1 = cc[2048 + k];
            s0 += c0 * sigmoidf_(c0) * w; s1 += c1 * sigmoidf_(c1) * w; }
        LAS float* red = (LAS float*)(F.lds + RING_OFF + 131072 - 4096);
        __syncthreads();
        red[(F.wave * 2 + 0) * 64 + lane] = s0; red[(F.wave * 2 + 1) * 64 + lane] = s1;
        __syncthreads();
        if (F.wave < 2) { float s = 0.f;
#pragma unroll
            for (int w = 0; w < 8; ++w) s += red[(w * 2 + F.wave) * 64 + lane];
            WSP(float, WS_MOD)[F.wave * 12288 + n] = s + F.ap->in[I_BADA][n]; }
    }
}
__device__ __forceinline__ void norm_mod_rows(Frame& F, const float* x, const float* g, int shift_off, int scale_off, bf16* H) {
    const int gw = F.wg * NWAVES + F.wave, NGW = F.G * NWAVES, lane = F.lane; const float* mod = WSP(float, WS_MOD);
    for (int m = gw; m < T; m += NGW) {
        const f32x4* xr = (const f32x4*)(x + (size_t)m * DM) + lane; f32x4 v[8]; float ss = 0.f;
#pragma unroll
        for (int j = 0; j < 8; ++j) { v[j] = xr[64 * j]; ss += (v[j].x * v[j].x + v[j].y * v[j].y) + (v[j].z * v[j].z + v[j].w * v[j].w); }
        const float rs = rsqrtf(wave_sum(ss) * (1.f / DM) + NORM_EPS); const float* mb = mod + (size_t)(m / SEQ) * 12288;
#pragma unroll
        for (int j = 0; j < 8; ++j) { const int c = 4 * lane + 256 * j; const f32x4 gg = *(const f32x4*)(g + c), sc = *(const f32x4*)(mb + scale_off + c), sh = *(const f32x4*)(mb + shift_off + c);
            const f32x4 y = v[j] * rs * gg * (sc + 1.f) + sh; v2u o; o.x = pk2(y.x, y.y); o.y = pk2(y.z, y.w); *(v2u*)(H + (size_t)m * DM + c) = o; }
    }
}
__device__ __forceinline__ void p3_prep(Frame& F) {
    const int gw = F.wg * NWAVES + F.wave, NGW = F.G * NWAVES, lane = F.lane;
    const bf16* P = WSP(bf16, WS_P); const float* mu = F.ap->in[I_MU];
    bf16* Rb = WSP(bf16, WS_R); bf16* LW = WSP(bf16, WS_LW); bf16* SG = WSP(bf16, WS_SG);
    for (int t = gw; t < T; t += NGW) {
        const bf16* pc = P + (size_t)t * NP; const bool first = (t % SEQ) == 0; const bf16* pp = first ? pc : pc - NP;
#pragma unroll
        for (int s = 0; s < 6; ++s) { const int c = (s * 64 + lane) * 8; float a[8], b[8], o[8]; unpack8(*(const v4u*)(pc + c), a); unpack8(*(const v4u*)(pp + c), b);
            const f32x4 m0 = *(const f32x4*)(mu + c), m1 = *(const f32x4*)(mu + c + 4);
#pragma unroll
            for (int i = 0; i < 8; ++i) { const float pv = first ? 0.f : b[i]; const float mm = i < 4 ? m0[i] : m1[i - 4]; o[i] = a[i] + mm * (pv - a[i]); }
            *(v4u*)(Rb + (size_t)(c >> 10) * ((WS_K - WS_R) / 2) + (size_t)t * RW + (c & 1023)) = pack8f(o); }
        { int c, mi; if (lane < 32) { c = PC_GLO + 8 * lane; mi = 3264 + 8 * lane; } else if (lane < 44) { c = PC_DLO + 8 * (lane - 32); mi = 3072 + 8 * (lane - 32); } else { c = PC_ALO + 8 * (lane - 44); mi = 3168 + 8 * (lane - 44); }
          float o[8] = {0.f, 0.f, 0.f, 0.f, 0.f, 0.f, 0.f, 0.f};
          if (lane < 56) { float a[8], b[8]; unpack8(*(const v4u*)(pc + c), a); unpack8(*(const v4u*)(pp + c), b);
              const f32x4 m0 = *(const f32x4*)(mu + mi), m1 = *(const f32x4*)(mu + mi + 4);
#pragma unroll
              for (int i = 0; i < 8; ++i) { const float pv = first ? 0.f : b[i]; const float mm = i < 4 ? m0[i] : m1[i - 4]; const float v = a[i] + mm * (pv - a[i]);
                  o[i] = lane < 32 ? sigmoidf_(v) : (lane < 44 ? tanhf(v) : v); } }
          bf16* dst; if (lane < 32) dst = SG + (size_t)t * 256 + 8 * lane; else if (lane < 44) dst = LW + (size_t)t * 256 + 8 * (lane - 32); else if (lane < 56) dst = LW + (size_t)t * 256 + 128 + 8 * (lane - 44);
          else if (lane < 60) dst = LW + (size_t)t * 256 + 96 + 8 * (lane - 56); else dst = LW + (size_t)t * 256 + 224 + 8 * (lane - 60);
          *(v4u*)dst = pack8f(o); }
#pragma unroll
        for (int s = 0; s < 2; ++s) { const int ch = s * 64 + lane, d0 = (ch & 15) * 8;
#pragma unroll
            for (int qk = 0; qk < 2; ++qk) { float a[8]; unpack8(*(const v4u*)(pc + (qk ? PC_FK : PC_FQ) + ch * 8), a); float ss = 0.f;
#pragma unroll
                for (int i = 0; i < 8; ++i) ss += a[i] * a[i];
                ss += __shfl_xor(ss, 1); ss += __shfl_xor(ss, 2); ss += __shfl_xor(ss, 4); ss += __shfl_xor(ss, 8);
                const float rs = rsqrtf(ss * (1.f / 128.f) + NORM_EPS); const float* gn = F.ap->in[qk ? I_KN : I_QN] + d0;
                const f32x4 g0 = *(const f32x4*)gn, g1 = *(const f32x4*)(gn + 4);
#pragma unroll
                for (int i = 0; i < 8; ++i) a[i] = a[i] * rs * (i < 4 ? g0[i] : g1[i - 4]);
                *(v4u*)(WSP(bf16, qk ? WS_FK : WS_FQ) + (size_t)t * FW + ch * 8) = pack8f(a); }
            *(v4u*)(WSP(bf16, WS_FV) + (size_t)t * FW + ch * 8) = *(const v4u*)(pc + PC_FV + ch * 8); }
        if (lane < 8) { const float xv = bflo((unsigned)pc[PC_F + lane]) + F.ap->in[I_BF][lane];
            WSP(float, WS_LF)[(size_t)t * 8 + lane] = fminf(xv, 0.f) - log1pf(__expf(-fabsf(xv))); }
    }
}
__device__ __forceinline__ void p4_cumsum(Frame& F) {
    if (F.wg >= 16) return;
    const int b = F.wg >> 3, h = F.wg & 7; const float* lf = WSP(float, WS_LF) + (size_t)b * SEQ * 8 + h; float* cs = WSP(float, WS_CS) + (size_t)F.wg * SEQ;
    LAS float* part = (LAS float*)(F.lds + RING_OFF);
    const int t0 = F.tid * 32; float s = 0.f;
    for (int i = 0; i < 32; ++i) s += lf[(size_t)(t0 + i) * 8];
    part[F.tid] = s; __syncthreads();
    if (F.tid == 0) { float run = 0.f; for (int i = 0; i < 512; ++i) { const float v = part[i]; part[i] = run; run += v; } }
    __syncthreads();
    float run = part[F.tid];
    for (int i = 0; i < 32; ++i) { run += lf[(size_t)(t0 + i) * 8]; cs[t0 + i] = -run * 11.313708498984761f; }
    __syncthreads();
}
__device__ __forceinline__ void p5_scan_naive(Frame& F) {
    constexpr int CH = 64;
    LAS float* Wl = (LAS float*)(F.lds + RING_OFF); LAS float* Al = Wl + CH * 64; LAS float* Bl = Al + CH * 64; LAS float* Kl = Bl + CH * 64; LAS float* Rl = Kl + CH * 64; LAS float* Vl = Rl + CH * 64; LAS float* Yl = Vl + CH * 64;
    const int tid = F.tid, row = tid >> 3, q = tid & 7;
    for (int bh = F.wg; bh < 32; bh += F.G) {
        const int b = bh >> 4, h = bh & 15; const size_t base = (size_t)b * SEQ * RW + h * 64;
        const bf16* Rg = WSP(bf16, WS_R) + base; const bf16* Kg = WSP(bf16, WS_K) + base; const bf16* Vg = WSP(bf16, WS_V) + base; const bf16* Ag = WSP(bf16, WS_A) + base;
        const float* Lg = WSP(float, WS_LOGW) + base; float* Yg = WSP(float, WS_YRAW) + base;
        float kkw[8], kaw[8];
#pragma unroll
        for (int i = 0; i < 8; ++i) { kkw[i] = F.ap->in[I_KK][h * 64 + 8 * q + i]; kaw[i] = F.ap->in[I_KA][h * 64 + 8 * q + i]; }
        float S[8] = {0.f, 0.f, 0.f, 0.f, 0.f, 0.f, 0.f, 0.f};
        for (int t0 = 0; t0 < SEQ; t0 += CH) {
            { const size_t off = (size_t)(t0 + row) * RW + 8 * q; float r[8], k[8], v[8], a[8];
              unpack8(*(const v4u*)(Rg + off), r); unpack8(*(const v4u*)(Kg + off), k); unpack8(*(const v4u*)(Vg + off), v); unpack8(*(const v4u*)(Ag + off), a);
              const f32x4 l0 = *(const f32x4*)(Lg + off), l1 = *(const f32x4*)(Lg + off + 4);
              float kk[8], ss = 0.f;
#pragma unroll
              for (int i = 0; i < 8; ++i) { kk[i] = k[i] * kkw[i]; ss += kk[i] * kk[i]; }
              ss += __shfl_xor(ss, 1); ss += __shfl_xor(ss, 2); ss += __shfl_xor(ss, 4);
              const float inv = 1.f / fmaxf(sqrtf(ss), 1e-12f);
#pragma unroll
              for (int i = 0; i < 8; ++i) { const int o = row * 64 + 8 * q + i; kk[i] *= inv;
                  Wl[o] = __expf(i < 4 ? l0[i] : l1[i - 4]); Al[o] = -kk[i]; Bl[o] = kk[i] * a[i]; Kl[o] = k[i] * (1.f + (a[i] - 1.f) * kaw[i]); Rl[o] = r[i]; Vl[o] = v[i]; } }
            __syncthreads();
            for (int t = 0; t < CH; ++t) { const int o = t * 64 + 8 * q; float sa = 0.f;
                const f32x4 a0 = *(const LAS f32x4*)(Al + o), a1 = *(const LAS f32x4*)(Al + o + 4), w0 = *(const LAS f32x4*)(Wl + o), w1 = *(const LAS f32x4*)(Wl + o + 4);
                const f32x4 b0 = *(const LAS f32x4*)(Bl + o), b1 = *(const LAS f32x4*)(Bl + o + 4), k0 = *(const LAS f32x4*)(Kl + o), k1 = *(const LAS f32x4*)(Kl + o + 4);
                const f32x4 r0 = *(const LAS f32x4*)(Rl + o), r1 = *(const LAS f32x4*)(Rl + o + 4); const float vv = Vl[t * 64 + row];
#pragma unroll
                for (int i = 0; i < 8; ++i) sa += S[i] * (i < 4 ? a0[i] : a1[i - 4]);
                sa += __shfl_xor(sa, 1); sa += __shfl_xor(sa, 2); sa += __shfl_xor(sa, 4);
                float y = 0.f;
#pragma unroll
                for (int i = 0; i < 8; ++i) { S[i] = S[i] * (i < 4 ? w0[i] : w1[i - 4]) + sa * (i < 4 ? b0[i] : b1[i - 4]) + vv * (i < 4 ? k0[i] : k1[i - 4]); y += S[i] * (i < 4 ? r0[i] : r1[i - 4]); }
                y += __shfl_xor(y, 1); y += __shfl_xor(y, 2); y += __shfl_xor(y, 4);
                if (q == 0) Yl[t * 64 + row] = y; }
            __syncthreads();
            { const int tt = tid >> 3, c = (tid & 7) * 8; *(f32x4*)(Yg + (size_t)(t0 + tt) * RW + c) = *(const LAS f32x4*)(Yl + tt * 64 + c); *(f32x4*)(Yg + (size_t)(t0 + tt) * RW + c + 4) = *(const LAS f32x4*)(Yl + tt * 64 + c + 4); }
        }
        __syncthreads();
    }
}
__device__ __forceinline__ void p7_post(Frame& F) {
    const int gw = F.wg * NWAVES + F.wave, NGW = F.G * NWAVES, lane = F.lane, c0 = 16 * lane;
    for (int t = gw; t < T; t += NGW) { const size_t off = (size_t)t * RW + c0;
        float y[16], r[16], k[16], v[16], a[16], g[16];
#pragma unroll
        for (int j = 0; j < 4; ++j) { const f32x4 yy = *(const f32x4*)(WSP(float, WS_YRAW) + off + 4 * j); y[4 * j] = yy.x; y[4 * j + 1] = yy.y; y[4 * j + 2] = yy.z; y[4 * j + 3] = yy.w; }
#pragma unroll
        for (int j = 0; j < 2; ++j) { float tmp[8];
            unpack8(*(const v4u*)(WSP(bf16, WS_R) + off + 8 * j), tmp); for (int i = 0; i < 8; ++i) r[8 * j + i] = tmp[i];
            unpack8(*(const v4u*)(WSP(bf16, WS_K) + off + 8 * j), tmp); for (int i = 0; i < 8; ++i) k[8 * j + i] = tmp[i];
            unpack8(*(const v4u*)(WSP(bf16, WS_V) + off + 8 * j), tmp); for (int i = 0; i < 8; ++i) v[8 * j + i] = tmp[i];
            unpack8(*(const v4u*)(WSP(bf16, WS_A) + off + 8 * j), tmp); for (int i = 0; i < 8; ++i) a[8 * j + i] = tmp[i];
            unpack8(*(const v4u*)(WSP(bf16, WS_G) + off + 8 * j), tmp); for (int i = 0; i < 8; ++i) g[8 * j + i] = tmp[i]; }
        float s = 0.f, bs = 0.f;
#pragma unroll
        for (int i = 0; i < 16; ++i) { s += y[i]; const float kp = k[i] * (1.f + (a[i] - 1.f) * F.ap->in[I_KA][c0 + i]); bs += r[i] * kp * F.ap->in[I_RK][c0 + i]; }
        s += __shfl_xor(s, 1); s += __shfl_xor(s, 2); bs += __shfl_xor(bs, 1); bs += __shfl_xor(bs, 2);
        const float mean = s * (1.f / 64.f); float q = 0.f;
#pragma unroll
        for (int i = 0; i < 16; ++i) { const float d = y[i] - mean; q += d * d; }
        q += __shfl_xor(q, 1); q += __shfl_xor(q, 2);
        const float rstd = rsqrtf(q * (1.f / 64.f) + GN_EPS); float o[16];
#pragma unroll
        for (int i = 0; i < 16; ++i) o[i] = ((y[i] - mean) * rstd * F.ap->in[I_GNG][c0 + i] + F.ap->in[I_GNB][c0 + i] + bs * v[i]) * g[i];
#pragma unroll
        for (int j = 0; j < 2; ++j) { v4u w; w.x = pk2(o[8 * j], o[8 * j + 1]); w.y = pk2(o[8 * j + 2], o[8 * j + 3]); w.z = pk2(o[8 * j + 4], o[8 * j + 5]); w.w = pk2(o[8 * j + 6], o[8 * j + 7]); *(v4u*)(WSP(bf16, WS_YA) + off + 8 * j) = w; }
    }
}
__device__ __forceinline__ fox::BlockRef<fox::bf16, fox::bf16> fox_ref(int L_, int pass_, const unsigned char* ws) {
    constexpr int NQB = fox::SQ / fox::QB, NX = NQB / 2;
    const int bh = L_ / NX, x = L_ % NX, qb = pass_ ? (NQB - 1 - x) : x;
    fox::BlockRef<fox::bf16, fox::bf16> r; r.ws = ws; r.row0 = (bh / fox::H) * fox::SQ + qb * fox::QB; r.bh = bh; r.P0 = qb * fox::QB; return r;
}
__device__ __forceinline__ void p6_attention(Frame& F, char* lds) {
    constexpr int NQB = fox::SQ / fox::QB, NX = NQB / 2, TOTAL = NX * fox::B * fox::H;
    const int stride = F.G; int L = F.wg; if (L >= TOTAL) return;
    int pass = 0;
    fox::BlockRef<fox::bf16, fox::bf16> cur = fox_ref(L, 0, F.ws);
    fox::Seam<fox::bf16> S;
    fox::causal_swa_prime<fox::bf16, fox::bf16>(cur, fox::WINDOW, lds, S, F.tid);
    for (;;) {
        const bool more_pass = pass == 0, more_item = L + stride < TOTAL, last = !more_pass && !more_item;
        int passn = pass + 1, Ln = L;
        if (!more_pass) { passn = 0; Ln = more_item ? L + stride : L; }
        const fox::BlockRef<fox::bf16, fox::bf16> nxt = last ? cur : fox_ref(Ln, passn, F.ws);
        fox::causal_swa_block<fox::bf16, fox::bf16>(cur, nxt, fox::SKV, fox::WINDOW, lds, S, F.tid);
        if (last) break;
        cur = nxt; pass = passn; L = Ln;
    }
}
typedef float f32x4m __attribute__((ext_vector_type(4)));
__device__ __forceinline__ void p11_router(Frame& F) {
    constexpr int TPW = T / 256 / NWAVES;
    const int lane = F.lane, t0 = (F.wg * NWAVES + F.wave) * TPW;
    const float* x1 = WSP(float, WS_X1); const float* mod = WSP(float, WS_MOD) + (size_t)(t0 / SEQ) * 12288; const float* g2 = F.ap->in[I_N2G]; bf16* H = WSP(bf16, WS_H);
    LAS float* lg = (LAS float*)(F.lds + RING_OFF + F.wave * 4096);
    LAS int* cnt = (LAS int*)(F.lds + RING_OFF + 65536);
    if (F.tid < 32) cnt[F.tid] = 0;
    __syncthreads();
    for (int i = 0; i < TPW; ++i) { const int m = t0 + i;
        const f32x4* xr = (const f32x4*)(x1 + (size_t)m * DM) + lane; f32x4 v[8]; float ss = 0.f;
#pragma unroll
        for (int j = 0; j < 8; ++j) { v[j] = xr[64 * j]; ss += (v[j].x * v[j].x + v[j].y * v[j].y) + (v[j].z * v[j].z + v[j].w * v[j].w); }
        const float rs = rsqrtf(wave_sum(ss) * (1.f / DM) + NORM_EPS);
        if (lane == 0) lg[512 + i] = rs;
#pragma unroll
        for (int j = 0; j < 8; ++j) { const int c = 4 * lane + 256 * j; const f32x4 gg = *(const f32x4*)(g2 + c), sc = *(const f32x4*)(mod + 4 * 2048 + c), sh = *(const f32x4*)(mod + 3 * 2048 + c);
            const f32x4 y = v[j] * rs * gg * (sc + 1.f) + sh; v2u o; o.x = pk2(y.x, y.y); o.y = pk2(y.z, y.w); *(v2u*)(H + (size_t)m * DM + c) = o; }
    }
    LDS_WAIT();
    { const int i = lane & 15, q = lane >> 4; const float rs = lg[512 + i]; const float* xr = x1 + (size_t)(t0 + i) * DM + 4 * q; const float* wr = WSP(float, WS_WRT) + (size_t)i * DM + 4 * q;
      f32x4m acc0 = {0.f, 0.f, 0.f, 0.f}, acc1 = {0.f, 0.f, 0.f, 0.f};
#pragma unroll 4
      for (int Sx = 0; Sx < DM / 16; ++Sx) { const int k = 16 * Sx;
          const f32x4 xv = *(const f32x4*)(xr + k), gg = *(const f32x4*)(g2 + k + 4 * q), sc = *(const f32x4*)(mod + 4 * 2048 + k + 4 * q), sh = *(const f32x4*)(mod + 3 * 2048 + k + 4 * q);
          const f32x4 hv = xv * rs * gg * (sc + 1.f) + sh; const f32x4 w0 = *(const f32x4*)(wr + k), w1 = *(const f32x4*)(wr + 16 * DM + k);
#pragma unroll
          for (int jj = 0; jj < 4; ++jj) { acc0 = __builtin_amdgcn_mfma_f32_16x16x4f32(hv[jj], w0[jj], acc0, 0, 0, 0); acc1 = __builtin_amdgcn_mfma_f32_16x16x4f32(hv[jj], w1[jj], acc1, 0, 0, 0); } }
      const float b0 = F.ap->in[I_BR][i], b1 = F.ap->in[I_BR][16 + i];
#pragma unroll
      for (int r = 0; r < 4; ++r) { lg[(4 * q + r) * 32 + i] = acc0[r] + b0; lg[(4 * q + r) * 32 + 16 + i] = acc1[r] + b1; } }
    LDS_WAIT();
    if (lane < 16) { const int m = t0 + lane; float v[4]; int e[4]; unsigned used = 0u;
#pragma unroll
        for (int k = 0; k < 4; ++k) { float best = -3.0e38f; int bi = 0;
            for (int j = 0; j < 32; ++j) { const float x = lg[lane * 32 + j]; if (!((used >> j) & 1u) && x > best) { best = x; bi = j; } }
            used |= 1u << bi; v[k] = best; e[k] = bi; }
        const float e1 = __expf(v[1] - v[0]), e2 = __expf(v[2] - v[0]), e3 = __expf(v[3] - v[0]), inv = 1.f / (1.f + e1 + e2 + e3);
        *(f32x4*)(WSP(float, WS_TOKW) + (size_t)m * 4) = (f32x4){inv, e1 * inv, e2 * inv, e3 * inv};
        int* te = WSP(int, WS_TOKE) + (size_t)m * 4; te[0] = e[0]; te[1] = e[1]; te[2] = e[2]; te[3] = e[3];
#pragma unroll
        for (int k = 0; k < 4; ++k) __hip_atomic_fetch_add(cnt + e[k], 1, __ATOMIC_RELAXED, __HIP_MEMORY_SCOPE_WORKGROUP); }
    __syncthreads();
    if (F.tid < 32) WSP(int, WS_WGCNT)[F.wg * 32 + F.tid] = cnt[F.tid];
    __syncthreads();
}
__device__ __forceinline__ void p12_slots(Frame& F) {
    constexpr int TPG = T / 256;
    LAS int* cur = (LAS int*)(F.lds + RING_OFF); LAS int* tot = cur + 32; LAS int* pre = cur + 64; LAS int* off = cur + 96; LAS int* slotl = cur + 160;
    const int* wgcnt = WSP(int, WS_WGCNT);
    if (F.tid < 32) { int tt = 0, pp = 0; for (int w = 0; w < 256; ++w) { const int c = wgcnt[w * 32 + F.tid]; if (w < F.wg) pp += c; tt += c; } tot[F.tid] = tt; pre[F.tid] = pp; }
    __syncthreads();
    if (F.tid == 0) { int o = 0; for (int e = 0; e < 32; ++e) { off[e] = o; o += (tot[e] + 255) & ~255; } off[32] = o; }
    __syncthreads();
    if (F.tid < 32) cur[F.tid] = off[F.tid] + pre[F.tid];
    if (F.wg == 0) { int* te = WSP(int, WS_TILEE); const int nt = off[32] >> 8;
        for (int p = F.tid; p < nt; p += NWAVES * 64) { int e = 0; for (int j = 1; j < 32; ++j) if ((p << 8) >= off[j]) e = j; te[p] = e; }
        if (F.tid == 0) te[1024] = nt; }
    __syncthreads();
    { const int t = F.wg * TPG + (F.tid >> 2), k = F.tid & 3; const int e = WSP(int, WS_TOKE)[(size_t)t * 4 + k];
      const int s = __hip_atomic_fetch_add(cur + e, 1, __ATOMIC_RELAXED, __HIP_MEMORY_SCOPE_WORKGROUP);
      slotl[F.tid] = s; WSP(int, WS_TOKS)[(size_t)t * 4 + k] = s; WSP(float, WS_SLOTW)[s] = WSP(float, WS_TOKW)[(size_t)t * 4 + k]; }
    __syncthreads();
    const bf16* H = WSP(bf16, WS_H); bf16* HS = WSP(bf16, WS_HS);
    for (int i = 0; i < TPG / NWAVES; ++i) { const int tl = F.wave * (TPG / NWAVES) + i, t = F.wg * TPG + tl; v4u v[4];
#pragma unroll
        for (int j = 0; j < 4; ++j) v[j] = *(const v4u*)(H + (size_t)t * DM + 8 * (F.lane + 64 * j));
#pragma unroll
        for (int k = 0; k < 4; ++k) { const int s = slotl[tl * 4 + k];
#pragma unroll
            for (int j = 0; j < 4; ++j) *(v4u*)(HS + (size_t)s * DM + 8 * (F.lane + 64 * j)) = v[j]; } }
    __syncthreads();
}
__device__ __forceinline__ void p15_final(Frame& F) {
    const int gw = F.wg * NWAVES + F.wave, NGW = F.G * NWAVES, lane = F.lane;
    const float* x1 = WSP(float, WS_X1); const bf16* YS = WSP(bf16, WS_HS); const float* gf = F.ap->in[I_NFG];
    for (int m = gw; m < T; m += NGW) { const float* gt = WSP(float, WS_MOD) + (size_t)(m / SEQ) * 12288 + 5 * 2048;
        const int4 sl = *(const int4*)(WSP(int, WS_TOKS) + (size_t)m * 4); float v[4][8]; float ss = 0.f;
#pragma unroll
        for (int j = 0; j < 4; ++j) { const int c = 8 * (lane + 64 * j); float y[8] = {0.f, 0.f, 0.f, 0.f, 0.f, 0.f, 0.f, 0.f}, tmp[8];
            unpack8(*(const v4u*)(YS + (size_t)sl.x * DM + c), tmp); for (int i = 0; i < 8; ++i) y[i] += tmp[i];
            unpack8(*(const v4u*)(YS + (size_t)sl.y * DM + c), tmp); for (int i = 0; i < 8; ++i) y[i] += tmp[i];
            unpack8(*(const v4u*)(YS + (size_t)sl.z * DM + c), tmp); for (int i = 0; i < 8; ++i) y[i] += tmp[i];
            unpack8(*(const v4u*)(YS + (size_t)sl.w * DM + c), tmp); for (int i = 0; i < 8; ++i) y[i] += tmp[i];
            const f32x4 xa = *(const f32x4*)(x1 + (size_t)m * DM + c), xb = *(const f32x4*)(x1 + (size_t)m * DM + c + 4), ga = *(const f32x4*)(gt + c), gb = *(const f32x4*)(gt + c + 4);
#pragma unroll
            for (int i = 0; i < 8; ++i) { const float xv = (i < 4 ? xa[i] : xb[i - 4]) + (i < 4 ? ga[i] : gb[i - 4]) * y[i]; v[j][i] = xv; ss += xv * xv; } }
        const float rs = rsqrtf(wave_sum(ss) * (1.f / DM) + NORM_EPS);
#pragma unroll
        for (int j = 0; j < 4; ++j) { const int c = 8 * (lane + 64 * j); const f32x4 ga = *(const f32x4*)(gf + c), gb = *(const f32x4*)(gf + c + 4);
            *(f32x4*)(F.ap->out + (size_t)m * DM + c) = (f32x4){v[j][0] * rs * ga[0], v[j][1] * rs * ga[1], v[j][2] * rs * ga[2], v[j][3] * rs * ga[3]};
            *(f32x4*)(F.ap->out + (size_t)m * DM + c + 4) = (f32x4){v[j][4] * rs * gb[0], v[j][5] * rs * gb[1], v[j][6] * rs * gb[2], v[j][7] * rs * gb[3]}; }
    }
}

__device__ __forceinline__ bool fresh(Frame& F) {
    asm volatile("" : "+s"(F.ap)); int w = F.wave; asm volatile("" : "+s"(w)); const int l = __builtin_amdgcn_mbcnt_hi(~0u, __builtin_amdgcn_mbcnt_lo(~0u, 0u)); F.lane = l; F.tid = w * 64 + l; return true; }
constexpr int N_PHASES = 16;
__global__ void __launch_bounds__(NWAVES * 64, 2) mk_fwd(Args args) {
    extern __shared__ __attribute__((aligned(16))) unsigned char lds[];
    Frame F;
    F.lds = (LAS unsigned char*)lds; F.MISC = (volatile LAS unsigned*)(F.lds + MISC_OFF);
    F.tid = threadIdx.x; F.lane = F.tid & 63; F.wave = __builtin_amdgcn_readfirstlane(F.tid >> 6); F.G = gridDim.x; F.wg = blockIdx.x;
    F.ap = (ArgsP)__builtin_amdgcn_kernarg_segment_ptr(); F.ws = F.ap->ws; F.ctl = (gu32*)(F.ws + WS_CTL);
    for (int u = F.tid; u < (LDS_BYTES - LDSCTL_OFF) / 4; u += NWAVES * 64) ((LAS unsigned*)(F.lds + LDSCTL_OFF))[u] = 0u;
    __syncthreads();
    const int lo = F.ap->ph_lo, hi = F.ap->ph_hi;
    XcdBarrier bar; bar.bar = (unsigned*)(F.ctl + CW_BAR); bar.x = 0; bar.st = nullptr;
    if (hi - lo > 1) bar = xcd_barrier_post((unsigned*)(F.ctl + CW_BAR), F.MISC + 8, F.tid);
#ifndef PH_MASK
#define PH_MASK 0xffff
#endif
#define IN(k) (((PH_MASK >> (k)) & 1) && lo <= (k) && (k) < hi && fresh(F))
#define SEAM(k) do { if (IN(k) && IN((k) + 1)) xcd_barrier(bar, F.tid); } while (0)
    if (IN(0)) { p0_prologue(F); } SEAM(0);
    if (IN(1)) { norm_mod_rows(F, F.ap->in[I_X], F.ap->in[I_N1G], 0, 2048, WSP(bf16, WS_H)); } SEAM(1);
    if (IN(2)) { pg8::Gemm g{WSP(bf16, WS_H), WSP(bf16, WS_WIN), T, NP, DM}; pg8::StaticOrder S; S.init(T, NP, F.G, F.wg);
        pg8::EpiBf16<0> E{WSP(bf16, WS_P), NP, nullptr, 0, 0, 1.f}; pg8::gemm_phase<pg8::EpiBf16<0>, pg8::StaticOrder, true, true>(F.lds + RING_OFF, g, S, E, F.tid); } SEAM(2);
    if (IN(3)) { p3_prep(F); } SEAM(3);
    if (IN(4)) { p4_cumsum(F);
        { pg8::Gemm g{WSP(bf16, WS_LW), WSP(bf16, WS_BT1), T, 2048, 256}; pg8::StaticOrder S; S.init(T, 2048, F.G, F.wg);
          pg8::EpiLora1 E{WSP(float, WS_LOGW), WSP(bf16, WS_A), F.ap->in[I_W0], F.ap->in[I_A0]}; pg8::gemm_phase<pg8::EpiLora1, pg8::StaticOrder, true, true>(F.lds + RING_OFF, g, S, E, F.tid); }
        } SEAM(4);
    if (IN(5)) { p5_scan_naive(F); __syncthreads();
        { pg8::Gemm g{WSP(bf16, WS_SG), WSP(bf16, WS_BT2), T, 1024, 256}; pg8::StaticOrder S; S.init(T, 1024, F.G, F.wg);
          pg8::EpiBf16<0> E{WSP(bf16, WS_G), 1024, nullptr, 0, 0, 1.f}; pg8::gemm_phase<pg8::EpiBf16<0>, pg8::StaticOrder, true, true>(F.lds + RING_OFF, g, S, E, F.tid); } } SEAM(5);
    if (IN(6)) { p6_attention(F, (char*)lds + RING_OFF); } SEAM(6);
    if (IN(7)) { p7_post(F); } SEAM(7);
    if (IN(8)) { pg8::Gemm g{WSP(bf16, WS_YA), WSP(bf16, WS_WOA), T, DM, 1024}; pg8::StaticOrder S; S.init(T, DM, F.G, F.wg);
        pg8::EpiGateMerge<0> E{WSP(bf16, WS_MRG), WSP(bf16, WS_P), PC_GA}; pg8::gemm_phase<pg8::EpiGateMerge<0>, pg8::StaticOrder, true, true>(F.lds + RING_OFF, g, S, E, F.tid); } SEAM(8);
    if (IN(9)) { pg8::Gemm g{WSP(bf16, WS_YB), WSP(bf16, WS_WOB), T, DM, 1024}; pg8::StaticOrder S; S.init(T, DM, F.G, F.wg);
        pg8::EpiGateMerge<1> E{WSP(bf16, WS_MRG), WSP(bf16, WS_P), PC_GB}; pg8::gemm_phase<pg8::EpiGateMerge<1>, pg8::StaticOrder, true, true>(F.lds + RING_OFF, g, S, E, F.tid); } SEAM(9);
    if (IN(10)) { pg8::Gemm g{WSP(bf16, WS_MRG), WSP(bf16, WS_WOUT), T, DM, DM}; pg8::StaticOrder S; S.init(T, DM, F.G, F.wg);
        pg8::EpiResid E{F.ap->in[I_X], WSP(float, WS_X1), WSP(float, WS_MOD)}; pg8::gemm_phase<pg8::EpiResid, pg8::StaticOrder, true, true>(F.lds + RING_OFF, g, S, E, F.tid); } SEAM(10);
    if (IN(11)) { p11_router(F); } SEAM(11);
    if (IN(12)) { p12_slots(F); } SEAM(12);
    if (IN(13)) { const int nt = WSP(int, WS_TILEE)[1024]; pg8::Gemm g{WSP(bf16, WS_HS), WSP(bf16, WS_WGU), nt * 256, 4096, DM}; pg8::MoeOrder S; S.init(nt * 256, 4096, F.G, F.wg); S.tile_e = WSP(int, WS_TILEE);
        pg8::EpiSwiglu E{WSP(bf16, WS_ACT), F.ap->in[I_BGU]}; pg8::gemm_phase<pg8::EpiSwiglu, pg8::MoeOrder, true, true>(F.lds + RING_OFF, g, S, E, F.tid); } SEAM(13);
    if (IN(14)) { const int nt = WSP(int, WS_TILEE)[1024]; pg8::Gemm g{WSP(bf16, WS_ACT), WSP(bf16, WS_WDN), nt * 256, 2048, DFF}; pg8::MoeOrder S; S.init(nt * 256, 2048, F.G, F.wg); S.tile_e = WSP(int, WS_TILEE);
        pg8::EpiDown E{WSP(bf16, WS_HS), F.ap->in[I_BDN], WSP(float, WS_SLOTW)}; pg8::gemm_phase<pg8::EpiDown, pg8::MoeOrder, true, true>(F.lds + RING_OFF, g, S, E, F.tid); } SEAM(14);
    if (IN(15)) { p15_final(F); }
#undef IN
#undef SEAM
}

extern "C" void kernel_launch(void* const* d_in, const int* in_sizes, int n_in, void* d_out, int out_size, void* d_ws, size_t ws_size, hipStream_t stream) {
    static int grid = 0;
    if (grid == 0) {
        if (n_in != N_IN || in_sizes[0] != T * DM || out_size != T * DM || ws_size < WS_END) { fprintf(stderr, "kernel_launch: shape/workspace mismatch (n_in %d, in0 %d, out %d, ws %zu < %zu)\n", n_in, n_in > 0 ? in_sizes[0] : -1, out_size, ws_size, (size_t)WS_END); grid = -1; return; }
        if (hipFuncSetAttribute((const void*)mk_fwd, hipFuncAttributeMaxDynamicSharedMemorySize, LDS_BYTES) != hipSuccess) { fprintf(stderr, "kernel_launch: hipFuncSetAttribute failed\n"); grid = -1; return; }
        int per_cu = 0;
        if (hipOccupancyMaxActiveBlocksPerMultiprocessor(&per_cu, (const void*)mk_fwd, NWAVES * 64, LDS_BYTES) != hipSuccess || per_cu < 1) fprintf(stderr, "kernel_launch: note: occupancy query reports %d workgroups per CU\n", per_cu);
        (void)hipGetLastError();
        grid = 256;
    }
    if (grid < 0) return;
    (void)hipMemsetAsync((char*)d_ws + WS_CTL, 0, CTL_ZERO_BYTES, stream);
    Args a{};
    for (int i = 0; i < N_IN; ++i) a.in[i] = (const float*)d_in[i];
    a.out = (float*)d_out; a.ws = (unsigned char*)d_ws;
#if MK_N_LAUNCHES == 1
    a.ph_lo = 0; a.ph_hi = N_PHASES;
    hipLaunchKernelGGL(mk_fwd, dim3(grid), dim3(NWAVES * 64), LDS_BYTES, stream, a);
#else
    for (int p = 0; p < N_PHASES; ++p) { a.ph_lo = p; a.ph_hi = p + 1; hipLaunchKernelGGL(mk_fwd, dim3(grid), dim3(NWAVES * 64), LDS_BYTES, stream, a); }
#endif
}
```

```cpp
#include <hip/hip_runtime.h>
#include <hip/hip_bf16.h>
#include <cstdio>
#include <cstdint>
constexpr int NWAVES = 8;
#ifndef MK_N_LAUNCHES
#define MK_N_LAUNCHES 1
#endif
constexpr int BATCH = 2, SEQ = 16384, DM = 2048, T = BATCH * SEQ;
constexpr int NP = 11776;
constexpr int PC_R = 0, PC_K = 1024, PC_V = 2048, PC_FQ = 3072, PC_FK = 4096, PC_FV = 5120, PC_OG = 6144, PC_GA = 7168, PC_GB = 9216, PC_GLO = 11264, PC_DLO = 11520, PC_ALO = 11616, PC_F = 11712, PC_END = 11720;
constexpr int RW = 1024, FW = 1024, NE = 32, DFF = 2048, TOPK = 4;
constexpr int NSLOT = T * TOPK + NE * 256;
constexpr float NORM_EPS = 1e-6f, GN_EPS = 64e-5f;

constexpr size_t MiB = 1u << 20;
constexpr size_t WS_CTL = 0, CTL_ZERO_BYTES = 1 * MiB;
constexpr size_t WS_MOD = 1 * MiB;
constexpr size_t WS_WRT = 1 * MiB + 128 * 1024;
constexpr size_t WS_TOKE = 2 * MiB, WS_TOKW = 2 * MiB + 512 * 1024, WS_TOKS = 3 * MiB, WS_SLOTW = 3 * MiB + 512 * 1024;
constexpr size_t WS_WGCNT = 4 * MiB + 512 * 1024, WS_TILEE = 4 * MiB + 768 * 1024;
constexpr size_t WS_LF = 5 * MiB, WS_CS = 6 * MiB;
constexpr size_t WS_BT1 = 7 * MiB, WS_BT2 = 8 * MiB, WS_WOA = 9 * MiB, WS_WOB = 13 * MiB, WS_WOUT = 17 * MiB, WS_WIN = 25 * MiB;
constexpr size_t WS_WGU = 72 * MiB, WS_WDN = 584 * MiB, WS_X1 = 840 * MiB, WS_H = 1096 * MiB;
constexpr size_t WS_P = 1226 * MiB, WS_R = 1962 * MiB, WS_K = 2026 * MiB, WS_V = 2090 * MiB, WS_FQ = 2154 * MiB, WS_FK = 2218 * MiB, WS_FV = 2282 * MiB;
constexpr size_t WS_LW = 2346 * MiB, WS_SG = 2362 * MiB, WS_LOGW = 2378 * MiB, WS_A = 2506 * MiB, WS_G = 2570 * MiB, WS_YRAW = 2634 * MiB, WS_YA = 2762 * MiB, WS_YB = 2826 * MiB, WS_MRG = 2890 * MiB;
constexpr size_t WS_HS = 1226 * MiB, WS_ACT = 1770 * MiB;
constexpr size_t WS_END = 3018 * MiB;
static_assert(WS_WIN + (size_t)NP * DM * 2 <= WS_WGU && WS_ACT + (size_t)NSLOT * DFF * 2 <= WS_END && WS_HS + (size_t)NSLOT * DM * 2 <= WS_ACT && WS_SLOTW + (size_t)NSLOT * 4 <= WS_WGCNT, "d_ws map");
constexpr int CW_TMO = 0, CW_BAR = 4096;

constexpr int RING_OFF = 0, RING_BYTES = 143360;
constexpr int LDSCTL_OFF = RING_BYTES, MISC_OFF = LDSCTL_OFF + 320;
constexpr int LDS_BYTES = 147456;

#define GAS __attribute__((address_space(1)))
#define LAS __attribute__((address_space(3)))
typedef unsigned short bf16;
typedef unsigned v4u __attribute__((ext_vector_type(4)));
typedef unsigned v2u __attribute__((ext_vector_type(2)));
typedef float f32x4 __attribute__((ext_vector_type(4)));
typedef short bf16x8 __attribute__((ext_vector_type(8)));
typedef GAS unsigned gu32;
#define RLX_AGENT __ATOMIC_RELAXED, __HIP_MEMORY_SCOPE_AGENT
#define LDS_WAIT() asm volatile("s_waitcnt lgkmcnt(0)" ::: "memory")
#define VM_WAIT() asm volatile("s_waitcnt vmcnt(0)" ::: "memory")
__device__ __forceinline__ unsigned f2bf(float f) { unsigned u = __builtin_bit_cast(unsigned, f); return (u + 0x7fffu + ((u >> 16) & 1u)) >> 16; }
__device__ __forceinline__ unsigned pk2(float lo, float hi) { return f2bf(lo) | (f2bf(hi) << 16); }
__device__ __forceinline__ float bflo(unsigned w) { return __uint_as_float(w << 16); }
__device__ __forceinline__ float bfhi(unsigned w) { return __uint_as_float(w & 0xffff0000u); }
__device__ __forceinline__ void unpack8(v4u w, float (&f)[8]) { f[0] = bflo(w.x); f[1] = bfhi(w.x); f[2] = bflo(w.y); f[3] = bfhi(w.y); f[4] = bflo(w.z); f[5] = bfhi(w.z); f[6] = bflo(w.w); f[7] = bfhi(w.w); }
__device__ __forceinline__ v4u pack8f(const float (&f)[8]) { v4u w; w.x = pk2(f[0], f[1]); w.y = pk2(f[2], f[3]); w.z = pk2(f[4], f[5]); w.w = pk2(f[6], f[7]); return w; }
__device__ __forceinline__ float sigmoidf_(float x) { return 1.f / (1.f + __expf(-x)); }
__device__ __forceinline__ float wave_sum(float v) {
#pragma unroll
    for (int o = 1; o < 64; o <<= 1) v += __shfl_xor(v, o);
    return v;
}
namespace pg8 {
#define PG8_LAS __attribute__((address_space(3)))
typedef unsigned short bf16_t;
typedef short bf16x8 __attribute__((ext_vector_type(8)));
typedef float f32x4 __attribute__((ext_vector_type(4)));
typedef unsigned u32x4 __attribute__((ext_vector_type(4)));
constexpr int BM = 256, BK = 64, HALF = 128, HTB = HALF * BK * 2  , STAGE_BYTES = 8 * HTB, NXCD = 8, WGM = 8;

__host__ __device__ __forceinline__ int lds_byte(int r, int c) { const int st = (r >> 4) * 2 + (c >> 5), rr = r & 15, cc = c & 31, ob = rr * 64 + cc * 2; return st * 1024 + (ob ^ (((ob >> 9) & 1) << 5)); }
__host__ __device__ __forceinline__ void stage_rc(int b, int& R, int& C) { const int st = b / 1024, sb = b % 1024, swz = sb ^ (((sb >> 9) & 1) << 5); R = (st >> 1) * 16 + swz / 64; C = (st & 1) * 32 + (swz % 64) / 2; }
__host__ __device__ __forceinline__ int perm32(int rho) { const int n = rho >> 4, i = rho & 15; return 8 * (i >> 2) + 4 * n + (i & 3); }

struct Unit { int pm, pn, e; };
struct Gemm { const bf16_t* A; const bf16_t* Bt; int M, N, K; };

struct StaticOrder {
    int nM, nN, nwg, G, c;
    __host__ __device__ void init(int M, int N, int G_, int c_) { nM = M / BM; nN = N / BM; nwg = nM * nN; G = G_; c = c_; }
    __host__ __device__ bool next(int i, Unit& u) const {
        const long L = (long)i * G + c; if (L >= nwg) return false;
        int wgid = (int)L; { const int q = nwg / NXCD, r = nwg % NXCD, xcd = wgid % NXCD, off = wgid / NXCD; wgid = (xcd < r ? xcd * (q + 1) : r * (q + 1) + (xcd - r) * q) + off; }
        const int nig = WGM * nN, gid = wgid / nig, fm = gid * WGM, gsz = (nM - fm) < WGM ? (nM - fm) : WGM;
        u.pm = fm + ((wgid % nig) % gsz); u.pn = (wgid % nig) / gsz; u.e = 0; return true;
    }
    __device__ __forceinline__ void a_ready(const Unit&) const {}
    __device__ __forceinline__ void done(const Unit&) const {}
};

__device__ __forceinline__ unsigned cvt_pk_bf16(float lo, float hi) { unsigned r; asm volatile("v_cvt_pk_bf16_f32 %0, %1, %2" : "=v"(r) : "v"(lo), "v"(hi)); return r; }
typedef float f32x2 __attribute__((ext_vector_type(2)));
__device__ __forceinline__ f32x2 gelu_pk(f32x2 v) {
    const f32x2 av = __builtin_elementwise_abs(v), d = av * 0.2316418882f + 1.0f;
    f32x2 t; t.x = __builtin_amdgcn_rcpf(d.x); t.y = __builtin_amdgcn_rcpf(d.y);
    f32x2 q = t * 0.5307027145f + (-0.7265760135f); q = q * t + 0.7107068705f; q = q * t + (-0.142248368f); q = q * t + 0.127414796f; q = q * t;
    const f32x2 s = (v * v) * (-0.72134752044f);
    f32x2 e; e.x = __builtin_amdgcn_exp2f(s.x); e.y = __builtin_amdgcn_exp2f(s.y);
    const f32x2 m = v * (q * e), r = v - m;
    f32x2 o; o.x = v.x < 0.f ? m.x : r.x; o.y = v.y < 0.f ? m.y : r.y; return o;
}

template <int ACT  > struct EpiBf16 {
    static constexpr bool PERM = true, AFTER_DRAIN = false; static_assert(ACT == 0 || ACT == 1, "EpiBf16: ACT is 0 (none) or 1 (gelu_pk)");
    bf16_t* O; int ldc; const float* bias; int split_cols; size_t split_stride; float scale0;
    __device__ __forceinline__ void operator()(const f32x4 (&acc)[2][2][4][2], const Unit& u, int wr, int wc, int fr, int fq) const {
        const int row0 = u.pm * BM + wr * 64 + fr; int colt = u.pn * BM; bf16_t* base = O;
        float sc = 1.f; if (split_cols) { const int t = colt / split_cols; base += (size_t)t * split_stride; colt -= t * split_cols; if (t == 0) sc = scale0; }
        const int col0 = colt + wc * 32 + 8 * fq, bcol0 = u.pn * BM + wc * 32 + 8 * fq;
        f32x4 bv[2][2];
#pragma unroll
        for (int bj = 0; bj < 2; ++bj)
#pragma unroll
            for (int n = 0; n < 2; ++n) bv[bj][n] = bias ? *(const f32x4*)(bias + bcol0 + bj * HALF + 4 * n) : (f32x4){0.f, 0.f, 0.f, 0.f};
#pragma unroll
        for (int ai = 0; ai < 2; ++ai)
#pragma unroll
            for (int m = 0; m < 4; ++m) { bf16_t* rowp = base + (size_t)(row0 + ai * HALF + m * 16) * ldc + col0;
#pragma unroll
                for (int bj = 0; bj < 2; ++bj) { f32x4 v0 = acc[ai][bj][m][0] + bv[bj][0], v1 = acc[ai][bj][m][1] + bv[bj][1];
                    if (ACT == 1) { f32x2 a = gelu_pk((f32x2){v0[0], v0[1]}), b = gelu_pk((f32x2){v0[2], v0[3]}), c = gelu_pk((f32x2){v1[0], v1[1]}), d = gelu_pk((f32x2){v1[2], v1[3]});
                        v0 = (f32x4){a.x, a.y, b.x, b.y}; v1 = (f32x4){c.x, c.y, d.x, d.y}; }
                    v0 = v0 * sc; v1 = v1 * sc; u32x4 w; w.x = cvt_pk_bf16(v0[0], v0[1]); w.y = cvt_pk_bf16(v0[2], v0[3]); w.z = cvt_pk_bf16(v1[0], v1[1]); w.w = cvt_pk_bf16(v1[2], v1[3]);
                    *(u32x4*)(rowp + bj * HALF) = w; } }
    }
};

template <class Epi, class Sched, bool ALIGN_EPI = false, bool SP2 = false>
__device__ __forceinline__ void gemm_phase(PG8_LAS unsigned char* lds, const Gemm g, const Sched& S, const Epi& E, const int tid) {
    const int wid = __builtin_amdgcn_readfirstlane(tid >> 6), lane = tid & 63, wr = wid >> 2, wc = wid & 3, fr = lane & 15, fq = lane >> 4;
    const int K = g.K, nt = K / BK;
    unsigned voffA[2], voffB[2];
#pragma unroll
    for (int i = 0; i < 2; ++i) { int R, C; stage_rc(tid * 16 + i * 8192, R, C); const int Rb = Epi::PERM ? ((R & ~31) + perm32(R & 31)) : R;
        voffA[i] = (unsigned)(R * K + C) * 2u; voffB[i] = (unsigned)(Rb * K + C) * 2u; }
    const size_t kstep = (size_t)(BK * 2);
    const size_t hstep = (size_t)HALF * K * 2;
    const size_t tstep = 2 * hstep;
    const unsigned ldsw = (unsigned)wid * 1024u;
    const int aoff = lds_byte(wr * 64 + fr, fq * 8), boff = lds_byte(wc * 32 + fr, fq * 8);
#define PG8_SA(b, h) (((b) * 2 + (h)) * HTB)
#define PG8_SB(b, h) ((4 + (b) * 2 + (h)) * HTB)
#define PG8_STAGE(bufoff, gbase, voff) do { _Pragma("unroll") for (int _i = 0; _i < 2; ++_i) \
        __builtin_amdgcn_global_load_lds((const unsigned*)((const char*)(gbase) + (voff)[_i]), (PG8_LAS unsigned*)(lds + (bufoff) + ldsw + _i * 8192), 16, 0, 0); } while (0)
#define PG8_LDA(dst, b, h) do { _Pragma("unroll") for (int m = 0; m < 4; ++m) _Pragma("unroll") for (int k = 0; k < 2; ++k) dst[m][k] = *(const PG8_LAS bf16x8*)(lds + PG8_SA(b, h) + aoff + m * 2048 + k * 1024); } while (0)
#define PG8_LDB(dst, b, h) do { _Pragma("unroll") for (int n = 0; n < 2; ++n) _Pragma("unroll") for (int k = 0; k < 2; ++k) dst[n][k] = *(const PG8_LAS bf16x8*)(lds + PG8_SB(b, h) + boff + n * 2048 + k * 1024); } while (0)
#define PG8_MMA(ai, bj, At, Bt) do { __builtin_amdgcn_s_setprio(1); _Pragma("unroll") for (int m = 0; m < 4; ++m) _Pragma("unroll") for (int n = 0; n < 2; ++n) _Pragma("unroll") for (int k = 0; k < 2; ++k) \
        acc[ai][bj][m][n] = __builtin_amdgcn_mfma_f32_16x16x32_bf16(Bt[n][k], At[m][k], acc[ai][bj][m][n], 0, 0, 0); __builtin_amdgcn_s_setprio(0); } while (0)
#define PG8_WAIT_V(n) asm volatile("s_waitcnt vmcnt(" #n ")" ::: "memory")
#define PG8_WAIT_L(n) asm volatile("s_waitcnt lgkmcnt(" #n ")" ::: "memory")
#define PG8_BAR __builtin_amdgcn_s_barrier()
#define PG8_SCHED __builtin_amdgcn_sched_barrier(0)
    Unit cur, nxt; int ui = 0;
    if (!S.next(0, cur)) return;
    f32x4 acc[2][2][4][2];
#pragma unroll
    for (int a = 0; a < 2; ++a)
#pragma unroll
        for (int b = 0; b < 2; ++b)
#pragma unroll
            for (int m = 0; m < 4; ++m)
#pragma unroll
                for (int n = 0; n < 2; ++n) acc[a][b][m][n] = (f32x4){0.f, 0.f, 0.f, 0.f};
    bf16x8 At[4][2], B0[2][2], B1[2][2];
    const char* cA = (const char*)g.A + (size_t)cur.pm * tstep; const size_t estep = (size_t)g.N * K * 2; const char* cB = (const char*)g.Bt + (size_t)cur.e * estep + (size_t)cur.pn * tstep;
    S.a_ready(cur);
    if constexpr (SP2) {
        PG8_STAGE(PG8_SB(0, 0), cB, voffB); PG8_STAGE(PG8_SB(0, 1), cB + hstep, voffB); PG8_STAGE(PG8_SA(0, 0), cA, voffA); PG8_STAGE(PG8_SA(0, 1), cA + hstep, voffA);
        if (wr == 1) PG8_BAR;
        PG8_WAIT_V(2); PG8_BAR;
        PG8_STAGE(PG8_SB(1, 0), cB + kstep, voffB); PG8_STAGE(PG8_SA(1, 0), cA + kstep, voffA); PG8_STAGE(PG8_SB(1, 1), cB + hstep + kstep, voffB);
        PG8_WAIT_V(6); PG8_BAR;
    } else {
        PG8_STAGE(PG8_SB(0, 0), cB, voffB); PG8_STAGE(PG8_SA(0, 0), cA, voffA); PG8_STAGE(PG8_SB(0, 1), cB + hstep, voffB); PG8_STAGE(PG8_SA(0, 1), cA + hstep, voffA);
        if (wr == 1) PG8_BAR;
        PG8_WAIT_V(4); PG8_BAR;
        PG8_STAGE(PG8_SB(1, 0), cB + kstep, voffB); PG8_STAGE(PG8_SA(1, 0), cA + kstep, voffA); PG8_STAGE(PG8_SB(1, 1), cB + hstep + kstep, voffB);
        PG8_WAIT_V(6); PG8_BAR;
    }
    for (;;) {
        const bool has_next = S.next(ui + 1, nxt);
        const char* nA = has_next ? (const char*)g.A + (size_t)nxt.pm * tstep : cA; const char* nB = has_next ? (const char*)g.Bt + (size_t)nxt.e * estep + (size_t)nxt.pn * tstep : cB;
        for (int t = 0; t < nt; t += 2) {
            const bool last = (t == nt - 2);
            const char* a1 = cA + (size_t)(t + 1) * kstep;
            const char* a2 = last ? nA : cA + (size_t)(t + 2) * kstep; const char* b2 = last ? nB : cB + (size_t)(t + 2) * kstep;
            const char* a3 = a2 + kstep; const char* b3 = b2 + kstep;
            if (last && has_next) S.a_ready(nxt);
            if constexpr (SP2) {
            PG8_LDB(B0, 0, 0); PG8_LDB(B1, 0, 1); PG8_SCHED; PG8_LDA(At, 0, 0); PG8_STAGE(PG8_SA(1, 1), a1 + hstep, voffA);
            PG8_WAIT_V(8); PG8_WAIT_L(0); PG8_BAR; PG8_MMA(0, 0, At, B0); PG8_MMA(0, 1, At, B1); PG8_BAR; PG8_SCHED;
            PG8_LDA(At, 0, 1); PG8_STAGE(PG8_SB(0, 0), b2, voffB); PG8_STAGE(PG8_SB(0, 1), b2 + hstep, voffB); PG8_STAGE(PG8_SA(0, 0), a2, voffA);
            PG8_WAIT_V(8); PG8_WAIT_L(0); PG8_BAR; PG8_MMA(1, 0, At, B0); PG8_MMA(1, 1, At, B1); PG8_BAR; PG8_SCHED;
            PG8_LDB(B0, 1, 0); PG8_LDB(B1, 1, 1); PG8_SCHED; PG8_LDA(At, 1, 0); PG8_STAGE(PG8_SA(0, 1), a2 + hstep, voffA);
            PG8_WAIT_V(8); PG8_WAIT_L(0); PG8_BAR; PG8_MMA(0, 0, At, B0); PG8_MMA(0, 1, At, B1); PG8_BAR; PG8_SCHED;
            PG8_LDA(At, 1, 1); PG8_STAGE(PG8_SB(1, 0), b3, voffB); PG8_STAGE(PG8_SB(1, 1), b3 + hstep, voffB); PG8_STAGE(PG8_SA(1, 0), a3, voffA);
            PG8_WAIT_V(8); PG8_WAIT_L(0); PG8_BAR; PG8_MMA(1, 0, At, B0); PG8_MMA(1, 1, At, B1); PG8_BAR; PG8_SCHED;
            } else {
            PG8_LDB(B0, 0, 0); PG8_SCHED; PG8_LDA(At, 0, 0); PG8_STAGE(PG8_SA(1, 1), a1 + hstep, voffA);
            PG8_WAIT_L(8); PG8_BAR; PG8_WAIT_L(0); PG8_MMA(0, 0, At, B0); PG8_BAR; PG8_SCHED;
            PG8_LDB(B1, 0, 1); PG8_STAGE(PG8_SB(0, 0), b2, voffB);
            PG8_BAR; PG8_WAIT_L(0); PG8_MMA(0, 1, At, B1); PG8_BAR;
            PG8_LDA(At, 0, 1); PG8_STAGE(PG8_SA(0, 0), a2, voffA);
            PG8_BAR; PG8_WAIT_L(0); PG8_MMA(1, 0, At, B0); PG8_BAR; PG8_SCHED;
            PG8_STAGE(PG8_SB(0, 1), b2 + hstep, voffB);
            PG8_WAIT_V(6); PG8_BAR; PG8_MMA(1, 1, At, B1); PG8_BAR;
            PG8_LDB(B0, 1, 0); PG8_SCHED; PG8_LDA(At, 1, 0); PG8_STAGE(PG8_SA(0, 1), a2 + hstep, voffA);
            PG8_WAIT_L(8); PG8_BAR; PG8_WAIT_L(0); PG8_MMA(0, 0, At, B0); PG8_BAR; PG8_SCHED;
            PG8_LDB(B1, 1, 1); PG8_STAGE(PG8_SB(1, 0), b3, voffB);
            PG8_BAR; PG8_WAIT_L(0); PG8_MMA(0, 1, At, B1); PG8_BAR;
            PG8_LDA(At, 1, 1); PG8_STAGE(PG8_SA(1, 0), a3, voffA);
            PG8_BAR; PG8_WAIT_L(0); PG8_MMA(1, 0, At, B0); PG8_BAR; PG8_SCHED;
            PG8_STAGE(PG8_SB(1, 1), b3 + hstep, voffB);
            PG8_WAIT_V(6); PG8_BAR; PG8_MMA(1, 1, At, B1); PG8_BAR;
            }
        }
        if constexpr (ALIGN_EPI) { if (wr == 0) PG8_BAR; }
        if constexpr (!Epi::AFTER_DRAIN) { E(acc, cur, wr, wc, fr, fq); S.done(cur); }
        if (!has_next) break;
#pragma unroll
        for (int a = 0; a < 2; ++a)
#pragma unroll
            for (int b = 0; b < 2; ++b)
#pragma unroll
                for (int m = 0; m < 4; ++m)
#pragma unroll
                    for (int n = 0; n < 2; ++n) acc[a][b][m][n] = (f32x4){0.f, 0.f, 0.f, 0.f};
        cur = nxt; cA = nA; cB = nB; ++ui;
        if constexpr (ALIGN_EPI) { if (wr == 1) PG8_BAR; }
    }
    PG8_WAIT_V(0);
    if constexpr (!ALIGN_EPI) { if (wr == 0) PG8_BAR; }
    PG8_BAR;
    if constexpr (Epi::AFTER_DRAIN) { E.fused(acc, cur, wr, wc, fr, fq, lds, wid, lane); S.done(cur); }
#undef PG8_SA
#undef PG8_SB
#undef PG8_STAGE
#undef PG8_LDA
#undef PG8_LDB
#undef PG8_MMA
#undef PG8_WAIT_V
#undef PG8_WAIT_L
#undef PG8_BAR
#undef PG8_SCHED
}
}
namespace pg8 {
__device__ __forceinline__ float ep_bflo(unsigned w) { return __uint_as_float(w << 16); }
__device__ __forceinline__ float ep_bfhi(unsigned w) { return __uint_as_float(w & 0xffff0000u); }
__device__ __forceinline__ float ep_sig(float x) { return __builtin_amdgcn_rcpf(1.f + __builtin_amdgcn_exp2f(-1.4426950408889634f * x)); }
__device__ __forceinline__ void ep_unpack8(u32x4 w, f32x4& a, f32x4& b) { a = (f32x4){ep_bflo(w.x), ep_bfhi(w.x), ep_bflo(w.y), ep_bfhi(w.y)}; b = (f32x4){ep_bflo(w.z), ep_bfhi(w.z), ep_bflo(w.w), ep_bfhi(w.w)}; }
__device__ __forceinline__ u32x4 ep_pack8(f32x4 a, f32x4 b) { u32x4 w; w.x = cvt_pk_bf16(a[0], a[1]); w.y = cvt_pk_bf16(a[2], a[3]); w.z = cvt_pk_bf16(b[0], b[1]); w.w = cvt_pk_bf16(b[2], b[3]); return w; }
__device__ __forceinline__ f32x4 ep_sig4(f32x4 v) { return (f32x4){ep_sig(v[0]), ep_sig(v[1]), ep_sig(v[2]), ep_sig(v[3])}; }
#define EPI_LOOP_BEGIN const int row0 = u.pm * BM + wr * 64 + fr, col0 = u.pn * BM + wc * 32 + 8 * fq; \
    _Pragma("unroll") for (int ai = 0; ai < 2; ++ai) _Pragma("unroll") for (int m = 0; m < 4; ++m) { const int row = row0 + ai * HALF + m * 16; \
    _Pragma("unroll") for (int bj = 0; bj < 2; ++bj) { const int col = col0 + bj * HALF; const f32x4 v0 = acc[ai][bj][m][0], v1 = acc[ai][bj][m][1];
#define EPI_LOOP_END } }

struct EpiLora1 {
    static constexpr bool PERM = true, AFTER_DRAIN = false;
    float* logw; bf16_t* a; const float* w0; const float* a0;
    __device__ __forceinline__ void operator()(const f32x4 (&acc)[2][2][4][2], const Unit& u, int wr, int wc, int fr, int fq) const {
        EPI_LOOP_BEGIN
            if (u.pn < 4) { const f32x4 b0 = *(const f32x4*)(w0 + col), b1 = *(const f32x4*)(w0 + col + 4);
                float* o = logw + (size_t)row * 1024 + col; *(f32x4*)o = ep_sig4(v0 + b0) * (-0.6065306597126334f); *(f32x4*)(o + 4) = ep_sig4(v1 + b1) * (-0.6065306597126334f); }
            else { const int c = col - 1024; const f32x4 b0 = *(const f32x4*)(a0 + c), b1 = *(const f32x4*)(a0 + c + 4);
                *(u32x4*)(a + (size_t)row * 1024 + c) = ep_pack8(ep_sig4(v0 + b0), ep_sig4(v1 + b1)); }
        EPI_LOOP_END
    }
};
template <int SECOND> struct EpiGateMerge {
    static constexpr bool PERM = true, AFTER_DRAIN = false;
    bf16_t* mrg; const bf16_t* P; int gcol;
    __device__ __forceinline__ void operator()(const f32x4 (&acc)[2][2][4][2], const Unit& u, int wr, int wc, int fr, int fq) const {
        EPI_LOOP_BEGIN
            f32x4 g0, g1; ep_unpack8(*(const u32x4*)(P + (size_t)row * 11776 + gcol + col), g0, g1);
            f32x4 r0 = ep_sig4(g0) * v0, r1 = ep_sig4(g1) * v1;
            bf16_t* o = mrg + (size_t)row * 2048 + col;
            if (SECOND) { f32x4 t0, t1; ep_unpack8(*(const u32x4*)o, t0, t1); r0 = r0 + t0; r1 = r1 + t1; }
            *(u32x4*)o = ep_pack8(r0, r1);
        EPI_LOOP_END
    }
};
struct EpiResid {
    static constexpr bool PERM = true, AFTER_DRAIN = false;
    const float* x; float* x1; const float* mod;
    __device__ __forceinline__ void operator()(const f32x4 (&acc)[2][2][4][2], const Unit& u, int wr, int wc, int fr, int fq) const {
        const float* gt = mod + (size_t)((u.pm * BM) / 16384) * 12288 + 4096;
        EPI_LOOP_BEGIN
            const f32x4 g0 = *(const f32x4*)(gt + col), g1 = *(const f32x4*)(gt + col + 4);
            const size_t off = (size_t)row * 2048 + col;
            *(f32x4*)(x1 + off) = *(const f32x4*)(x + off) + g0 * v0; *(f32x4*)(x1 + off + 4) = *(const f32x4*)(x + off + 4) + g1 * v1;
        EPI_LOOP_END
    }
};
struct EpiSwiglu {
    static constexpr bool PERM = true, AFTER_DRAIN = false;
    bf16_t* act; const float* bias;
    __device__ __forceinline__ void operator()(const f32x4 (&acc)[2][2][4][2], const Unit& u, int wr, int wc, int fr, int fq) const {
        const int row0 = u.pm * BM + wr * 64 + fr, gcol = u.pn * 128 + wc * 32 + 8 * fq;
        const float* bg = bias + (size_t)u.e * 4096 + gcol; const float* bl = bg + 2048;
        const f32x4 bg0 = *(const f32x4*)bg, bg1 = *(const f32x4*)(bg + 4), bl0 = *(const f32x4*)bl, bl1 = *(const f32x4*)(bl + 4);
#pragma unroll
        for (int ai = 0; ai < 2; ++ai)
#pragma unroll
            for (int m = 0; m < 4; ++m) { const int row = row0 + ai * HALF + m * 16;
                f32x4 g0 = acc[ai][0][m][0] + bg0, g1 = acc[ai][0][m][1] + bg1, l0 = acc[ai][1][m][0] + bl0, l1 = acc[ai][1][m][1] + bl1, r0, r1;
#pragma unroll
                for (int i = 0; i < 4; ++i) { const float a = fminf(g0[i], 7.f), b = fminf(g1[i], 7.f);
                    r0[i] = a * ep_sig(1.702f * a) * (fminf(fmaxf(l0[i], -7.f), 7.f) + 1.f); r1[i] = b * ep_sig(1.702f * b) * (fminf(fmaxf(l1[i], -7.f), 7.f) + 1.f); }
                *(u32x4*)(act + (size_t)row * 2048 + gcol) = ep_pack8(r0, r1); }
    }
};
struct EpiDown {
    static constexpr bool PERM = true, AFTER_DRAIN = false;
    bf16_t* ys; const float* bias; const float* slot_w;
    __device__ __forceinline__ void operator()(const f32x4 (&acc)[2][2][4][2], const Unit& u, int wr, int wc, int fr, int fq) const {
        const float* be = bias + (size_t)u.e * 2048;
        EPI_LOOP_BEGIN
            const float w = slot_w[row];
            const f32x4 b0 = *(const f32x4*)(be + col), b1 = *(const f32x4*)(be + col + 4);
            *(u32x4*)(ys + (size_t)row * 2048 + col) = ep_pack8((v0 + b0) * w, (v1 + b1) * w);
        EPI_LOOP_END
    }
};
struct MoeOrder : StaticOrder {
    const int* tile_e;
    __device__ bool next(int i, Unit& u) const { if (!StaticOrder::next(i, u)) return false; u.e = tile_e[u.pm]; return true; }
};
}
namespace fox {
enum { ORDER_NATURAL = 0, ORDER_REVERSED = 1, ORDER_PAIRED = 2, ORDER_XCD = 4 };
using TIN = __hip_bfloat16; using TOUT = __hip_bfloat16;
constexpr int B = 2, H = 8, HKV = 8, SQ = 16384, SKV = 16384, D = 128;
constexpr int PITCH = 1024;
constexpr int GPITCH = 11776;
constexpr int QOFF = 0;
constexpr int WINDOW = SKV;
constexpr float THR = 8.f;
constexpr int ORDER = ORDER_PAIRED;
constexpr bool WSKIP = false;
constexpr float SCALE = 0.08838834764831845f;
constexpr int NW = 8, QBLK = 32, KVBLK = 64, QB = NW * QBLK;
constexpr int SHM_V = KVBLK * D * 2, SHM_K = KVBLK * D * 2;
constexpr int LDS_CB = 2 * SHM_V + 2 * SHM_K + NW * 64 * 4;
constexpr int LDS_GATE = LDS_CB + 3 * 64 * 4 + 256;
constexpr int LDS_BYTES = LDS_GATE + NW * 8192;
static_assert(D == 128 && SQ % QB == 0 && SKV % KVBLK == 0 && H % HKV == 0 && QOFF >= 0 && QOFF + SQ <= SKV && WINDOW >= 1, "geometry");

using bf16 = __hip_bfloat16;
typedef short bf16x8 __attribute__((ext_vector_type(8)));
typedef short s16x4 __attribute__((ext_vector_type(4)));
typedef float f32x16 __attribute__((ext_vector_type(16)));
typedef float f32x4 __attribute__((ext_vector_type(4)));
typedef unsigned u32x4 __attribute__((ext_vector_type(4)));
template <class A, class Bt> struct same_t { static constexpr bool v = false; };
template <class A> struct same_t<A, A> { static constexpr bool v = true; };

#define KSWZ(row, colB) ((row) * 256 + ((colB) ^ (((row) & 7) << 4)))
#define SBAR() __builtin_amdgcn_sched_barrier(0)
__device__ __forceinline__ int v_st(int k, int c) { const int kk = (k & ~0xC) | ((k & 4) << 1) | ((k & 8) >> 1); return ((kk >> 3) * 4 + (c >> 5)) * 512 + ((kk & 7) * 32 + (c & 31)) * 2; }
__device__ __forceinline__ int v_rd_base(int lane) { return ((lane & 3) << 3) | (((lane >> 2) & 3) << 6) | (((lane >> 4) & 1) << 5) | (((lane >> 5) & 1) << 8); }
constexpr int v_rd_off(int d0, int ks, int half) { return d0 * 512 + ks * 4096 + half * 2048; }
__device__ __forceinline__ int crow(int r, int hi) { return (r & 3) + 8 * (r >> 2) + 4 * hi; }
__device__ __forceinline__ unsigned cvtpk(float lo, float hi) {
    unsigned r; asm volatile("v_cvt_pk_bf16_f32 %0, %1, %2" : "=v"(r) : "v"(lo), "v"(hi)); return r;
}
__device__ __forceinline__ bf16x8 pack8(f32x4 a, f32x4 b) {
    u32x4 w = {cvtpk(a[0], a[1]), cvtpk(a[2], a[3]), cvtpk(b[0], b[1]), cvtpk(b[2], b[3])};
    return *reinterpret_cast<bf16x8*>(&w);
}
template <class T> __device__ __forceinline__ bf16x8 load8(const T* p) {
    if constexpr (same_t<T, float>::v) { return pack8(*(const f32x4*)p, *(const f32x4*)(p + 4)); }
    else { return *reinterpret_cast<const bf16x8*>(p); }
}
__device__ __forceinline__ void mask_tile(f32x16& p0, f32x16& p1, int dq, unsigned W) {
    const float NEG = -__builtin_inff();
#pragma unroll
    for (int r = 0; r < 16; ++r) {
        const int c = (r & 3) + 8 * (r >> 2);
        if ((unsigned)(dq - c) >= W) p0[r] = NEG;
        if ((unsigned)(dq - c - 32) >= W) p1[r] = NEG;
    }
}
__device__ __forceinline__ void partialSM(f32x16& p0, f32x16& p1, float& m_reg, float& mn, float& alpha) {
    float pmax = p0[0]; for (int r = 1; r < 16; ++r) pmax = fmaxf(pmax, p0[r]); for (int r = 0; r < 16; ++r) pmax = fmaxf(pmax, p1[r]);
    { auto rr = __builtin_amdgcn_permlane32_swap(__float_as_uint(pmax), __float_as_uint(pmax), false, false);
      pmax = fmaxf(__uint_as_float(rr[0]), __uint_as_float(rr[1])); }
    constexpr float C2 = 1.4426950408889634f * SCALE;
    if (__builtin_expect(__all((pmax - m_reg) * SCALE <= THR), 1)) { mn = m_reg; alpha = 1.f; }
    else { mn = fmaxf(m_reg, pmax); alpha = __builtin_amdgcn_exp2f((m_reg - mn) * C2); m_reg = mn; }
    const float mnL = -mn * C2;
    for (int r = 0; r < 16; ++r) p0[r] = fmaf(p0[r], C2, mnL); for (int r = 0; r < 16; ++r) p1[r] = fmaf(p1[r], C2, mnL);
    for (int r = 0; r < 16; ++r) p0[r] = __builtin_amdgcn_exp2f(p0[r]);
}
__device__ __forceinline__ void finishSM(f32x16& p0, f32x16& p1, float alpha, float& l_reg, bf16x8& pa0, bf16x8& pa1, bf16x8& pa2, bf16x8& pa3) {
    for (int r = 0; r < 16; ++r) p1[r] = __builtin_amdgcn_exp2f(p1[r]);
    float ps = 0; for (int r = 0; r < 16; ++r) ps += p0[r]; for (int r = 0; r < 16; ++r) ps += p1[r];
    { auto rr = __builtin_amdgcn_permlane32_swap(__float_as_uint(ps), __float_as_uint(ps), false, false);
      ps = __uint_as_float(rr[0]) + __uint_as_float(rr[1]); }
    l_reg = l_reg * alpha + ps;
#define PK4(P, B_, OUT) do { unsigned a0 = cvtpk(P[B_+0], P[B_+1]), a1 = cvtpk(P[B_+2], P[B_+3]);                          \
        unsigned b0 = cvtpk(P[B_+4], P[B_+5]), b1 = cvtpk(P[B_+6], P[B_+7]);                                             \
        auto r0 = __builtin_amdgcn_permlane32_swap(a0, b0, false, false); auto r1 = __builtin_amdgcn_permlane32_swap(a1, b1, false, false); \
        u32x4 w = {r0[0], r1[0], r0[1], r1[1]}; OUT = *reinterpret_cast<bf16x8*>(&w); } while (0)
    PK4(p0, 0, pa0); PK4(p0, 8, pa1); PK4(p1, 0, pa2); PK4(p1, 8, pa3);
#undef PK4
}
template <int KB, bool SK>
__device__ __forceinline__ void qkt(f32x16& p0, f32x16& p1, const char* K_lds, int r32, int hi, const bf16x8* qr, bool act, int cbi) {
    if (SK && !act) { const float NEG = -__builtin_inff();
#pragma unroll
        for (int r = 0; r < 16; ++r) { p0[r] = NEG; p1[r] = NEG; } return; }
    { const float* cb_ = (const float*)(K_lds + 2 * SHM_K + NW * 64 * 4) + cbi * 64 + 4 * hi;
#pragma unroll
      for (int g_ = 0; g_ < 4; ++g_) { const f32x4 b0_ = *(const f32x4*)(cb_ + 8 * g_), b1_ = *(const f32x4*)(cb_ + 32 + 8 * g_);
#pragma unroll
          for (int i_ = 0; i_ < 4; ++i_) { p0[4 * g_ + i_] = b0_[i_]; p1[4 * g_ + i_] = b1_[i_]; } } }
    const char* kb[4];
#pragma unroll
    for (int dd = 0; dd < 4; ++dd) kb[dd] = K_lds + KB * SHM_K + KSWZ(r32, (dd * 16 + hi * 8) * 2);
#pragma unroll
    for (int d0 = 0; d0 < 8; ++d0) { const char* a = kb[d0 & 3] + (d0 >> 2) * 128;
        bf16x8 b0 = *reinterpret_cast<const bf16x8*>(a);
        bf16x8 b1 = *reinterpret_cast<const bf16x8*>(a + 32 * 256);
        p0 = __builtin_amdgcn_mfma_f32_32x32x16_bf16(b0, qr[d0], p0, 0, 0, 0);
        p1 = __builtin_amdgcn_mfma_f32_32x32x16_bf16(b1, qr[d0], p1, 0, 0, 0); }
}
template <int VB, bool SK>
__device__ __forceinline__ void pv_tile(f32x16* o, int vb0, bf16x8 pa0, bf16x8 pa1, bf16x8 pa2, bf16x8 pa3, bool act) {
    if (SK && !act) return;
#define TRRD(dst, off) asm volatile("ds_read_b64_tr_b16 %0, %1 offset:%2" : "=&v"(dst) : "v"(vb0), "i"(off) : "memory")
#define PV_D0(d0) do { s16x4 l0, l1, l2, l3, h0, h1, h2, h3; constexpr int b_ = VB * SHM_V + v_rd_off(d0, 0, 0);     \
        TRRD(l0, b_); TRRD(h0, b_ + 2048); TRRD(l1, b_ + 4096); TRRD(h1, b_ + 6144); TRRD(l2, b_ + 8192); TRRD(h2, b_ + 10240); TRRD(l3, b_ + 12288); TRRD(h3, b_ + 14336); \
        asm volatile("s_waitcnt lgkmcnt(0)" ::: "memory"); SBAR();                 \
        o[d0] = __builtin_amdgcn_mfma_f32_32x32x16_bf16(pa0, (bf16x8){l0[0], l0[1], l0[2], l0[3], h0[0], h0[1], h0[2], h0[3]}, o[d0], 0, 0, 0);   \
        o[d0] = __builtin_amdgcn_mfma_f32_32x32x16_bf16(pa1, (bf16x8){l1[0], l1[1], l1[2], l1[3], h1[0], h1[1], h1[2], h1[3]}, o[d0], 0, 0, 0);   \
        o[d0] = __builtin_amdgcn_mfma_f32_32x32x16_bf16(pa2, (bf16x8){l2[0], l2[1], l2[2], l2[3], h2[0], h2[1], h2[2], h2[3]}, o[d0], 0, 0, 0);   \
        o[d0] = __builtin_amdgcn_mfma_f32_32x32x16_bf16(pa3, (bf16x8){l3[0], l3[1], l3[2], l3[3], h3[0], h3[1], h3[2], h3[3]}, o[d0], 0, 0, 0); } while (0)
    PV_D0(0); PV_D0(1); PV_D0(2); PV_D0(3);
#undef PV_D0
#undef TRRD
}

template <class TIn, class TOut> struct BlockRef { const unsigned char* ws; int row0, bh, P0;
    __device__ __forceinline__ const TIn* Q() const { return (const TIn*)(ws + WS_FQ) + (size_t)row0 * PITCH + (bh % H) * D; }
    __device__ __forceinline__ const TIn* K() const { return (const TIn*)(ws + WS_FK) + (size_t)(bh / H) * SQ * PITCH + (bh % H) * D; }
    __device__ __forceinline__ const TIn* V() const { return (const TIn*)(ws + WS_FV) + (size_t)(bh / H) * SQ * PITCH + (bh % H) * D; }
    __device__ __forceinline__ TOut* O() const { return (TOut*)(ws + WS_YB) + (size_t)row0 * PITCH + (bh % H) * D; }
    __device__ __forceinline__ const float* C() const { return (const float*)(ws + WS_CS) + (size_t)bh * SQ; }
    __device__ __forceinline__ const TIn* G() const { return (const TIn*)(ws + WS_P) + (size_t)row0 * GPITCH + PC_OG + (bh % H) * D; }
};
template <class TIn> struct Seam {
    bf16x8 qr[8];
    bf16x8 st_v0, st_v1, st_k0, st_k1; int cbi; f32x4 sf0, sf1, sf2, sf3;
    f32x4 tq[16];
};
__device__ __forceinline__ int swa_jlo(int P0, int W) { const int lowk = P0 - W + 1; return lowk > 0 ? lowk / KVBLK : 0; }
#define ROW(p, k0, rr) ((p) + (size_t)((k0) + (rr)) * PITCH + sc)
#define VMW() asm volatile("s_waitcnt vmcnt(0)" ::: "memory")
#define VMWN(n) asm volatile("s_waitcnt vmcnt(%0)" :: "i"(n) : "memory")
#define NEXT3(x) ((x) == 2 ? 0 : (x) + 1)
#define SLOAD_H(Kp, Vp, Cp, k0, CI) do { S.st_v0 = load8<TIn>(ROW(Vp, k0, sr)); S.st_v1 = load8<TIn>(ROW(Vp, k0, 32 + sr));              \
                         S.st_k0 = load8<TIn>(ROW(Kp, k0, sr)); S.st_k1 = load8<TIn>(ROW(Kp, k0, 32 + sr));                 \
                         if (wid == 0) __builtin_amdgcn_global_load_lds((const unsigned*)((Cp) + (k0) + lane), (__attribute__((address_space(3))) unsigned*)(lds + LDS_CB + (CI) * 256), 4, 0, 0); } while (0)
#define SWRITE_HK(bf) do { *(bf16x8*)(K_lds + (bf) * SHM_K + kws) = S.st_k0; *(bf16x8*)(K_lds + (bf) * SHM_K + kws + 32 * 256) = S.st_k1; } while (0)
#define SWRITE_HV(bf) do { *(bf16x8*)(V_lds + (bf) * SHM_V + vst0) = S.st_v0; *(bf16x8*)(V_lds + (bf) * SHM_V + vst1) = S.st_v1; } while (0)
#define SWRITE_H(bf) do { SWRITE_HV(bf); SWRITE_HK(bf); } while (0)
#define SLOAD_F(p, k0) do { S.sf0 = *(const f32x4*)ROW(p, k0, sr); S.sf1 = *(const f32x4*)(ROW(p, k0, sr) + 4);                \
                            S.sf2 = *(const f32x4*)ROW(p, k0, 32 + sr); S.sf3 = *(const f32x4*)(ROW(p, k0, 32 + sr) + 4); } while (0)
#define SWRITE_KF(bf) do { *(bf16x8*)(K_lds + (bf) * SHM_K + kws) = pack8(S.sf0, S.sf1); *(bf16x8*)(K_lds + (bf) * SHM_K + kws + 32 * 256) = pack8(S.sf2, S.sf3); } while (0)
#define SWRITE_VF(bf) do { *(bf16x8*)(V_lds + (bf) * SHM_V + vst0) = pack8(S.sf0, S.sf1); *(bf16x8*)(V_lds + (bf) * SHM_V + vst1) = pack8(S.sf2, S.sf3); } while (0)
template <class TIn, class TOut>
__device__ __forceinline__ void causal_swa_prime(const BlockRef<TIn, TOut>& cur, int W, char* lds, Seam<TIn>& S, const int tid) {
    constexpr bool F32 = same_t<TIn, float>::v;
    const int wid = __builtin_amdgcn_readfirstlane(tid >> 6), lane = tid & 63, r32 = lane & 31, hi = lane >> 5;
    const int sr = tid >> 4, sc = (tid & 15) * 8, kws = KSWZ(sr, sc * 2); char* K_lds = lds + 2 * SHM_V;
    const int kb0 = swa_jlo(cur.P0, W) * KVBLK;
    for (int d0 = 0; d0 < 8; ++d0) S.qr[d0] = load8<TIn>(cur.Q() + (size_t)(wid * QBLK + r32) * PITCH + d0 * 16 + hi * 8);
    if constexpr (F32) { SLOAD_F((const float*)cur.K(), kb0); VMW(); SWRITE_KF(0); SBAR(); SLOAD_F((const float*)cur.V(), kb0); }
    else { S.cbi = 0; SLOAD_H(cur.K(), cur.V(), cur.C(), kb0, 0); VMW(); SWRITE_HK(0); }
    __syncthreads();
}
template <class TIn, class TOut>
__device__ __forceinline__ void causal_swa_block(const BlockRef<TIn, TOut>& cur, const BlockRef<TIn, TOut>& nxt, int skv, int W, char* lds, Seam<TIn>& S, const int tid) {
    constexpr bool F32 = same_t<TIn, float>::v;
    const int wid = __builtin_amdgcn_readfirstlane(tid >> 6), lane = tid & 63, r32 = lane & 31, hi = lane >> 5;
    const int j_lo = swa_jlo(cur.P0, W);
    int j_hi = (cur.P0 + QB - 1) / KVBLK + 1; if (j_hi > skv / KVBLK) j_hi = skv / KVBLK;
    const int NT = j_hi - j_lo;
    const int kbn = swa_jlo(nxt.P0, W) * KVBLK;
    const int qlo = cur.P0 + wid * QBLK, qm = qlo + r32 - 4 * hi;
    char* V_lds = lds; char* K_lds = lds + 2 * SHM_V;
    float* ws = (float*)(lds + 2 * SHM_V + 2 * SHM_K) + wid * 64; float* li_l = ws, * al_l = ws + 32;
    float m_reg = -1e30f, l_reg = 0; f32x16 o[4] = {};
    const int sr = tid >> 4, sc = (tid & 15) * 8, vst0 = v_st(sr, sc), vst1 = v_st(32 + sr, sc), kws = KSWZ(sr, sc * 2);
    const int vb0 = (int)(uintptr_t)V_lds + v_rd_base(lane);
    const TIn* Kh = cur.K(); const TIn* Vh = cur.V(); const float* Ch = cur.C(); int cb_t = S.cbi;
    {
        const TIn* gsrc = cur.G() + (size_t)(wid * QBLK + (lane >> 4)) * GPITCH + (lane & 15) * 8;
#pragma unroll
        for (int i_ = 0; i_ < 8; ++i_) __builtin_amdgcn_global_load_lds((const unsigned*)(gsrc + (size_t)(4 * i_) * GPITCH), (__attribute__((address_space(3))) unsigned*)(lds + LDS_GATE + wid * 8192 + i_ * 1024), 16, 0, 0); }
#define RESC(a) do { if (__any((a) < 1.f)) { if (hi == 0) al_l[r32] = (a); asm volatile("s_waitcnt lgkmcnt(0)" ::: "memory");              \
                     for (int d_ = 0; d_ < 4; ++d_) for (int r = 0; r < 16; ++r) o[d_][r] *= al_l[crow(r, hi)]; } } while (0)
#define KBASE(t) ((j_lo + (t)) * KVBLK)
#define ACT(t) (KBASE(t) <= qlo + QBLK - 1 && KBASE(t) + KVBLK - 1 >= qlo - W + 1)
#define MASKT(P0_, P1_, t) do { const int kb_ = KBASE(t); if ((!SK || ACT(t)) && (kb_ + KVBLK - 1 > qlo || kb_ <= qlo + QBLK - 1 - W)) mask_tile(P0_, P1_, qm - kb_, (unsigned)W); } while (0)
    constexpr int NQL = F32 ? 16 : 8;
    constexpr bool SK = WSKIP && !F32;
#define SEAM_K0() do { VMWN(NQL); if constexpr (F32) { SWRITE_KF(0); SBAR(); SLOAD_F((const float*)nxt.V(), kbn); } else { SWRITE_HK(0); } SBAR(); } while (0)
    f32x16 pA0, pA1, pB0, pB1; float mnA, mnB, alA, alB; bf16x8 pa0, pa1, pa2, pa3;
    if constexpr (F32) { VMW(); SWRITE_VF(0); SBAR(); } else { SWRITE_HV(0); SBAR(); }
    if (NT > 1) { if constexpr (F32) SLOAD_F((const float*)Kh, KBASE(1)); else SLOAD_H(Kh, Vh, Ch, KBASE(1), NEXT3(cb_t)); }
    SBAR(); qkt<0, SK>(pA0, pA1, K_lds, r32, hi, S.qr, ACT(0), cb_t);
    if constexpr (F32) { if (NT > 1) { VMW(); SWRITE_KF(1); SBAR(); SLOAD_F((const float*)Vh, KBASE(1)); } }
    MASKT(pA0, pA1, 0); partialSM(pA0, pA1, m_reg, mnA, alA);
    if (NT > 1) { VMW(); if constexpr (F32) { SWRITE_VF(1); SBAR(); if (NT > 2) SLOAD_F((const float*)Kh, KBASE(2)); } else SWRITE_H(1); }
    __syncthreads();
#define HALF_STEP(PX0, PX1, mnX, alX, PY0, PY1, alY, t, KB, VB, SB) do {                                                      \
        SBAR(); cb_t = NEXT3(cb_t); qkt<KB, SK>(PX0, PX1, K_lds, r32, hi, S.qr, ACT(t), cb_t);                                             \
        finishSM(PY0, PY1, alY, l_reg, pa0, pa1, pa2, pa3); SBAR();                                                           \
        if ((t) + 1 < NT) { if constexpr (F32) { VMW(); SWRITE_KF(SB); SBAR(); SLOAD_F((const float*)Vh, KBASE((t) + 1)); }  \
                            else { SLOAD_H(Kh, Vh, Ch, KBASE((t) + 1), NEXT3(cb_t)); } SBAR(); }                                               \
        pv_tile<VB, SK>(o, vb0, pa0, pa1, pa2, pa3, ACT((t) - 1)); MASKT(PX0, PX1, (t)); partialSM(PX0, PX1, m_reg, mnX, alX);                                        \
        __syncthreads();                                                                                                      \
        if ((t) + 1 < NT) { VMW(); if constexpr (F32) { SWRITE_VF(SB); SBAR(); if ((t) + 2 < NT) SLOAD_F((const float*)Kh, KBASE((t) + 2)); } \
                            else { SWRITE_H(SB); } }                                                                          \
        RESC(alX); __syncthreads(); } while (0)
    for (int t = 1; t + 1 < NT; t += 2) {
        HALF_STEP(pB0, pB1, mnB, alB, pA0, pA1, alA, t, 1, 0, 0);
        HALF_STEP(pA0, pA1, mnA, alA, pB0, pB1, alB, t + 1, 0, 1, 1);
    }
    const bool even = (NT & 1) == 0;
    if (even) { SBAR(); cb_t = NEXT3(cb_t); qkt<1, SK>(pB0, pB1, K_lds, r32, hi, S.qr, ACT(NT - 1), cb_t); SBAR(); }
#define QROW(e) (nxt.Q() + (size_t)(wid * QBLK + r32) * PITCH + ((e) >> 1) * 16 + hi * 8 + ((e) & 1) * 4)
    if constexpr (F32) { SLOAD_F((const float*)nxt.K(), kbn); SBAR();
#pragma unroll
        for (int e = 0; e < 8; ++e) S.tq[e] = *(const f32x4*)QROW(e); }
    else { SLOAD_H(nxt.K(), nxt.V(), nxt.C(), kbn, NEXT3(cb_t)); S.cbi = NEXT3(cb_t); SBAR();
#pragma unroll
        for (int d0 = 0; d0 < 8; ++d0) S.qr[d0] = load8<TIn>(nxt.Q() + (size_t)(wid * QBLK + r32) * PITCH + d0 * 16 + hi * 8); }
    SBAR();
    finishSM(pA0, pA1, alA, l_reg, pa0, pa1, pa2, pa3); SBAR();
    if constexpr (F32) {
#pragma unroll
        for (int e = 8; e < 16; ++e) S.tq[e] = *(const f32x4*)QROW(e); SBAR(); }
#undef QROW
    pv_tile<0, SK>(o, vb0, pa0, pa1, pa2, pa3, ACT(even ? NT - 2 : NT - 1));
    if (even) { MASKT(pB0, pB1, NT - 1); partialSM(pB0, pB1, m_reg, mnB, alB); __syncthreads(); RESC(alB);
        finishSM(pB0, pB1, alB, l_reg, pa0, pa1, pa2, pa3); SBAR(); pv_tile<1, SK>(o, vb0, pa0, pa1, pa2, pa3, ACT(NT - 1)); }
    SBAR(); SEAM_K0();
    if (hi == 0) li_l[r32] = l_reg; asm volatile("s_waitcnt lgkmcnt(0)" ::: "memory");
    float rli[16];
#pragma unroll
    for (int r = 0; r < 16; ++r) rli[r] = __builtin_amdgcn_rcpf(li_l[crow(r, hi)]);
    int hi_e = hi; asm volatile("" : "+v"(hi_e));
    TOut* Ow = cur.O() + (size_t)(wid * QBLK) * PITCH + (size_t)(4 * hi_e) * PITCH; const char* gl_ = lds + LDS_GATE + wid * 8192 + 4 * hi_e * 256;
#pragma unroll
    for (int r = 0; r < 16; ++r) { const int orow = (r & 3) + 8 * (r >> 2);
#pragma unroll
        for (int d0 = 0; d0 < 4; ++d0) { const float v = o[d0][r] * rli[r];
            if constexpr (same_t<TOut, float>::v) { Ow[(size_t)orow * PITCH + d0 * 32 + r32] = v; }
            else { const float vn = __shfl_xor(v, 1);
                   if ((r32 & 1) == 0) { const unsigned gw_ = *(const unsigned*)(gl_ + orow * 256 + (d0 * 32 + r32) * 2);
                       const float g0_ = __uint_as_float(gw_ << 16), g1_ = __uint_as_float(gw_ & 0xffff0000u);
                       const float s0_ = __builtin_amdgcn_rcpf(1.f + __builtin_amdgcn_exp2f(-1.4426950408889634f * g0_)), s1_ = __builtin_amdgcn_rcpf(1.f + __builtin_amdgcn_exp2f(-1.4426950408889634f * g1_));
                       *(unsigned*)(Ow + (size_t)orow * PITCH + d0 * 32 + r32) = cvtpk(v * s0_, vn * s1_); } } } }
    if constexpr (F32) {
#pragma unroll
        for (int d0 = 0; d0 < 8; ++d0) S.qr[d0] = pack8(S.tq[2 * d0], S.tq[2 * d0 + 1]); }
    __syncthreads();
#undef RESC
#undef KBASE
#undef ACT
#undef MASKT
#undef SEAM_K0
#undef HALF_STEP
}
#undef ROW
#undef VMW
#undef VMWN
#undef SLOAD_H
#undef SWRITE_HK
#undef SWRITE_HV
#undef SWRITE_H
#undef SLOAD_F
#undef SWRITE_KF
#undef SWRITE_VF

}
#define XB_TMO      128
#define XB_XCNT(j)  (256  + 64 * (j))
#define XB_XSUB(j)  (1280 + 64 * (j))
#define XB_XGEN(j)  (2304 + 64 * (j))
#define XB_TOP      3328
#define XB_TOPGEN   3392
#define XCD_BAR_WORDS 3456
#define XB_SPIN_CAP (1u << 18)

__device__ __forceinline__ unsigned xb_ld(unsigned* p)              { return __hip_atomic_load(p, __ATOMIC_RELAXED, __HIP_MEMORY_SCOPE_AGENT); }
__device__ __forceinline__ unsigned xb_add(unsigned* p, unsigned v) { return __hip_atomic_fetch_add(p, v, __ATOMIC_RELAXED, __HIP_MEMORY_SCOPE_AGENT); }
__device__ __forceinline__ unsigned xb_xcc_id() { return (unsigned)__builtin_amdgcn_s_getreg((3 << 11) | 20) & 0xFu; }
#define XB_SPIN(cond, bar) do { unsigned _sp = 0; while (cond) { __builtin_amdgcn_s_sleep(1); \
    if ((++_sp & 255u) == 0u) { if (xb_ld(&(bar)[XB_TMO])) break; if (_sp > XB_SPIN_CAP) { atomicAdd(&(bar)[XB_TMO], 1u); break; } } } } while (0)

struct XcdBarrier {
    unsigned* bar; unsigned x;
    volatile LAS unsigned* st;
};

__device__ __forceinline__ XcdBarrier xcd_barrier_post(unsigned* bar, volatile LAS unsigned* st, const int tid) {
    XcdBarrier b; b.bar = bar; b.x = xb_xcc_id(); b.st = st;
    if (tid == 0) (void)xb_add(&bar[XB_XCNT(b.x)], 1u);
    return b;
}
__device__ __forceinline__ void xcd_barrier_complete(unsigned* bar, unsigned x, unsigned& nloc, unsigned& nx) {
    const unsigned G = gridDim.x * gridDim.y * gridDim.z;
    unsigned sum, cnt, mine, sp = 0u;
    for (;;) {
        sum = 0u; cnt = 0u; mine = 0u;
#pragma unroll
        for (unsigned j = 0; j < 16; ++j) { const unsigned c = xb_ld(&bar[XB_XCNT(j)]); sum += c; cnt += (c > 0u) ? 1u : 0u; mine = (j == x) ? c : mine; }
        if (sum == G) break;
        __builtin_amdgcn_s_sleep(1);
        if ((++sp & 255u) == 0u) { if (xb_ld(&bar[XB_TMO])) break; if (sp > XB_SPIN_CAP) { atomicAdd(&bar[XB_TMO], 1u); break; } }
    }
    nloc = mine > 0u ? mine : 1u; nx = cnt > 0u ? cnt : 1u;
}

__device__ __forceinline__ void xcd_barrier(const XcdBarrier& b, const int tid) {
    asm volatile("s_waitcnt vmcnt(0)" ::: "memory");
    __syncthreads();
    if (tid == 0) {
        unsigned* bar = b.bar;
        __builtin_amdgcn_s_waitcnt(0);
        unsigned nloc = b.st[0], nx = b.st[1];
        if (nloc == 0u) { xcd_barrier_complete(bar, b.x, nloc, nx); b.st[0] = nloc; b.st[1] = nx; }
        const unsigned old = xb_add(&bar[XB_XSUB(b.x)], 1u);
        const unsigned gen = old / nloc;
        if (old + 1u == (gen + 1u) * nloc) {
            __builtin_amdgcn_fence(__ATOMIC_RELEASE, "agent");
            asm volatile("s_waitcnt vmcnt(0)" ::: "memory");
            const unsigned og = xb_add(&bar[XB_TOP], 1u);
            const unsigned tg = og / nx;
            if (og + 1u == (tg + 1u) * nx) xb_add(&bar[XB_TOPGEN], 1u);
            else XB_SPIN(xb_ld(&bar[XB_TOPGEN]) == tg, bar);
            __builtin_amdgcn_fence(__ATOMIC_ACQUIRE, "agent");
            xb_add(&bar[XB_XGEN(b.x)], 1u);
            asm volatile("s_waitcnt vmcnt(0)" ::: "memory");
        } else {
            XB_SPIN(xb_ld(&bar[XB_XGEN(b.x)]) == gen, bar);
            __builtin_amdgcn_fence(__ATOMIC_ACQUIRE, "agent");
            asm volatile("s_waitcnt vmcnt(0)" ::: "memory");
        }
    }
    __syncthreads();
}
enum InIdx { I_X = 0, I_C, I_WADA, I_BADA, I_N1G, I_WIN, I_MU, I_WDEC, I_W0, I_WICLR, I_A0, I_WGATE, I_KK, I_KA, I_RK, I_GNG, I_GNB, I_WOA, I_BF, I_QN, I_KN, I_WOB, I_WOUT, I_N2G, I_WR, I_BR, I_WGU, I_BGU, I_WDN, I_BDN, I_NFG, N_IN };
struct Args { const float* in[N_IN]; float* out; unsigned char* ws; int ph_lo, ph_hi; };
static_assert(sizeof(Args) == (N_IN + 2) * 8 + 8, "Args has no padding");
typedef const __attribute__((address_space(4))) Args* ArgsP;
struct Frame {
    LAS unsigned char* lds;
    volatile LAS unsigned* MISC;
    gu32* ctl;
    int tid, lane, wave, G, wg;
    unsigned char* ws;
    ArgsP ap;
};
#define WSP(T_, off) ((T_*)(F.ws + (off)))

__device__ __forceinline__ int win_orig_col(int c) {
    if (c < PC_FQ) return c;
    if (c < PC_OG) return 3520 + (c - PC_FQ);
    if (c < PC_GA) return 6600 + (c - PC_OG);
    if (c < PC_GLO) return 7624 + (c - PC_GA);
    if (c < PC_DLO) return 3264 + (c - PC_GLO);
    if (c < PC_ALO) return 3072 + (c - PC_DLO);
    if (c < PC_F) return 3168 + (c - PC_ALO);
    if (c < PC_END) return 6592 + (c - PC_F);
    return -1;
}
__device__ __forceinline__ void tr_item(const float* W, int ldw, int K, bf16* WT, int drow0, int scol0, int nvalid, int k0, LAS float* scr, int lane) {
    const int n = lane & 31;
#pragma unroll 8
    for (int i = 0; i < 32; ++i) { const int kk = 2 * i + (lane >> 5); scr[kk * 33 + n] = (n < nvalid) ? W[(size_t)(k0 + kk) * ldw + scol0 + n] : 0.f; }
    LDS_WAIT(); asm volatile("" ::: "memory");
    const int c = lane & 7;
#pragma unroll
    for (int j = 0; j < 4; ++j) { const int nn = (lane >> 3) + 8 * j; const LAS float* s = scr + (8 * c) * 33 + nn;
        v4u o; o.x = pk2(s[0 * 33], s[1 * 33]); o.y = pk2(s[2 * 33], s[3 * 33]); o.z = pk2(s[4 * 33], s[5 * 33]); o.w = pk2(s[6 * 33], s[7 * 33]);
        *(GAS v4u*)(WT + (size_t)(drow0 + nn) * K + k0 + 8 * c) = o; }
    LDS_WAIT(); asm volatile("" ::: "memory");
}
__device__ __forceinline__ void p0_prologue(Frame& F) {
    LAS float* scr = (LAS float*)(F.lds + RING_OFF + F.wave * 16384);
    const int gw = F.wg * NWAVES + F.wave, NGW = F.G * NWAVES, lane = F.lane;
    constexpr int I_IN = 32 * 368, I_OA = 16 * 64, I_OB = I_OA, I_OUT = 32 * 64, I_GU = NE * 32 * 128, I_DN = NE * 32 * 64;
    constexpr int NITEMS = I_IN + I_OA + I_OB + I_OUT + I_GU + I_DN;
    for (int it = gw; it < NITEMS; it += NGW) {
        int r = it;
        if (r < I_IN) { const int kb = r / 368, gp = r % 368, c0 = gp * 32, oc = win_orig_col(c0); int nv = 32; if (oc < 0) nv = 0; else if (c0 + 32 > PC_END) nv = PC_END - c0;
            tr_item(F.ap->in[I_WIN], 11720, 2048, WSP(bf16, WS_WIN), c0, oc < 0 ? 0 : oc, nv, kb * 64, scr, lane); continue; } r -= I_IN;
        if (r < I_OA) { tr_item(F.ap->in[I_WOA], 2048, 1024, WSP(bf16, WS_WOA), (r % 64) * 32, (r % 64) * 32, 32, (r / 64) * 64, scr, lane); continue; } r -= I_OA;
        if (r < I_OB) { tr_item(F.ap->in[I_WOB], 2048, 1024, WSP(bf16, WS_WOB), (r % 64) * 32, (r % 64) * 32, 32, (r / 64) * 64, scr, lane); continue; } r -= I_OB;
        if (r < I_OUT) { tr_item(F.ap->in[I_WOUT], 2048, 2048, WSP(bf16, WS_WOUT), (r % 64) * 32, (r % 64) * 32, 32, (r / 64) * 64, scr, lane); continue; } r -= I_OUT;
        if (r < I_GU) { const int e = r / (32 * 128), q = r % (32 * 128), kb = q / 128, gp = q % 128, d0 = gp * 32;
            const int pn = d0 >> 8, j = d0 & 255, sc = j < 128 ? 128 * pn + j : 2048 + 128 * pn + (j - 128);
            tr_item(F.ap->in[I_WGU] + (size_t)e * 2048 * 4096, 4096, 2048, WSP(bf16, WS_WGU) + (size_t)e * 4096 * 2048, d0, sc, 32, kb * 64, scr, lane); continue; } r -= I_GU;
        { const int e = r / (32 * 64), q = r % (32 * 64), kb = q / 64, gp = q % 64;
            tr_item(F.ap->in[I_WDN] + (size_t)e * 2048 * 2048, 2048, 2048, WSP(bf16, WS_WDN) + (size_t)e * 2048 * 2048, gp * 32, gp * 32, 32, kb * 64, scr, lane); }
    }
    const int gt = F.wg * (NWAVES * 64) + F.tid, NGT = F.G * NWAVES * 64;
    { bf16* b1 = WSP(bf16, WS_BT1); const float* wd = F.ap->in[I_WDEC]; const float* wi = F.ap->in[I_WICLR];
      for (int i = gt; i < 2048 * 256; i += NGT) { const int n = i >> 8, k = i & 255; float v = 0.f;
          if (n < 1024) { if (k < 96) v = wd[k * 1024 + n]; } else { if (k >= 128 && k < 224) v = wi[(k - 128) * 1024 + (n - 1024)]; }
          b1[i] = (bf16)f2bf(v); } }
    { bf16* b2 = WSP(bf16, WS_BT2); const float* wg = F.ap->in[I_WGATE];
      for (int i = gt; i < 1024 * 256; i += NGT) { const int n = i >> 8, k = i & 255; b2[i] = (bf16)f2bf(wg[k * 1024 + n]); } }
    { float* wrt = WSP(float, WS_WRT); const float* wr = F.ap->in[I_WR];
      for (int i = gt; i < 32 * 2048; i += NGT) { const int e = i >> 11, k = i & 2047; wrt[i] = wr[k * 32 + e]; } }
    { bf16* h = WSP(bf16, WS_H) + (size_t)T * DM; for (int i = gt; i < DM; i += NGT) h[i] = 0; }
    if (F.wg < 192) {
        const float* wa = F.ap->in[I_WADA]; const float* cc = F.ap->in[I_C]; const int n = F.wg * 64 + lane;
        float s0 = 0.f, s1 = 0.f;
        for (int k = F.wave * 256; k < F.wave * 256 + 256; ++k) { const float w = wa[(size_t)k * 12288 + n]; const float c0 = cc[k], c1 = cc[2048 + k];
            s0 += c0 * sigmoidf_(c0) * w; s1 += c1 * sigmoidf_(c1) * w; }
        LAS float* red = (LAS float*)(F.lds + RING_OFF + 131072 - 4096);
        __syncthreads();
        red[(F.wave * 2 + 0) * 64 + lane] = s0; red[(F.wave * 2 + 1) * 64 + lane] = s1;
        __syncthreads();
        if (F.wave < 2) { float s = 0.f;
#pragma unroll
            for (int w = 0; w < 8; ++w) s += red[(w * 2 + F.wave) * 64 + lane];
            WSP(float, WS_MOD)[F.wave * 12288 + n] = s + F.ap->in[I_BADA][n]; }
    }
}
__device__ __forceinline__ void norm_mod_rows(Frame& F, const float* x, const float* g, int shift_off, int scale_off, bf16* H) {
    const int gw = F.wg * NWAVES + F.wave, NGW = F.G * NWAVES, lane = F.lane; const float* mod = WSP(float, WS_MOD);
    for (int m = gw; m < T; m += NGW) {
        const f32x4* xr = (const f32x4*)(x + (size_t)m * DM) + lane; f32x4 v[8]; float ss = 0.f;
#pragma unroll
        for (int j = 0; j < 8; ++j) { v[j] = xr[64 * j]; ss += (v[j].x * v[j].x + v[j].y * v[j].y) + (v[j].z * v[j].z + v[j].w * v[j].w); }
        const float rs = rsqrtf(wave_sum(ss) * (1.f / DM) + NORM_EPS); const float* mb = mod + (size_t)(m / SEQ) * 12288;
#pragma unroll
        for (int j = 0; j < 8; ++j) { const int c = 4 * lane + 256 * j; const f32x4 gg = *(const f32x4*)(g + c), sc = *(const f32x4*)(mb + scale_off + c), sh = *(const f32x4*)(mb + shift_off + c);
            const f32x4 y = v[j] * rs * gg * (sc + 1.f) + sh; v2u o; o.x = pk2(y.x, y.y); o.y = pk2(y.z, y.w); *(v2u*)(H + (size_t)m * DM + c) = o; }
    }
}
__device__ __forceinline__ void p3_prep(Frame& F) {
    const int gw = F.wg * NWAVES + F.wave, NGW = F.G * NWAVES, lane = F.lane;
    const bf16* P = WSP(bf16, WS_P); const float* mu = F.ap->in[I_MU];
    bf16* Rb = WSP(bf16, WS_R); bf16* LW = WSP(bf16, WS_LW); bf16* SG = WSP(bf16, WS_SG);
    for (int t = gw; t < T; t += NGW) {
        const bf16* pc = P + (size_t)t * NP; const bool first = (t % SEQ) == 0; const bf16* pp = first ? pc : pc - NP;
#pragma unroll
        for (int s = 0; s < 6; ++s) { const int c = (s * 64 + lane) * 8; float a[8], b[8], o[8]; unpack8(*(const v4u*)(pc + c), a); unpack8(*(const v4u*)(pp + c), b);
            const f32x4 m0 = *(const f32x4*)(mu + c), m1 = *(const f32x4*)(mu + c + 4);
#pragma unroll
            for (int i = 0; i < 8; ++i) { const float pv = first ? 0.f : b[i]; const float mm = i < 4 ? m0[i] : m1[i - 4]; o[i] = a[i] + mm * (pv - a[i]); }
            *(v4u*)(Rb + (size_t)(c >> 10) * ((WS_K - WS_R) / 2) + (size_t)t * RW + (c & 1023)) = pack8f(o); }
        { int c, mi; if (lane < 32) { c = PC_GLO + 8 * lane; mi = 3264 + 8 * lane; } else if (lane < 44) { c = PC_DLO + 8 * (lane - 32); mi = 3072 + 8 * (lane - 32); } else { c = PC_ALO + 8 * (lane - 44); mi = 3168 + 8 * (lane - 44); }
          float o[8] = {0.f, 0.f, 0.f, 0.f, 0.f, 0.f, 0.f, 0.f};
          if (lane < 56) { float a[8], b[8]; unpack8(*(const v4u*)(pc + c), a); unpack8(*(const v4u*)(pp + c), b);
              const f32x4 m0 = *(const f32x4*)(mu + mi), m1 = *(const f32x4*)(mu + mi + 4);
#pragma unroll
              for (int i = 0; i < 8; ++i) { const float pv = first ? 0.f : b[i]; const float mm = i < 4 ? m0[i] : m1[i - 4]; const float v = a[i] + mm * (pv - a[i]);
                  o[i] = lane < 32 ? sigmoidf_(v) : (lane < 44 ? tanhf(v) : v); } }
          bf16* dst; if (lane < 32) dst = SG + (size_t)t * 256 + 8 * lane; else if (lane < 44) dst = LW + (size_t)t * 256 + 8 * (lane - 32); else if (lane < 56) dst = LW + (size_t)t * 256 + 128 + 8 * (lane - 44);
          else if (lane < 60) dst = LW + (size_t)t * 256 + 96 + 8 * (lane - 56); else dst = LW + (size_t)t * 256 + 224 + 8 * (lane - 60);
          *(v4u*)dst = pack8f(o); }
#pragma unroll
        for (int s = 0; s < 2; ++s) { const int ch = s * 64 + lane, d0 = (ch & 15) * 8;
#pragma unroll
            for (int qk = 0; qk < 2; ++qk) { float a[8]; unpack8(*(const v4u*)(pc + (qk ? PC_FK : PC_FQ) + ch * 8), a); float ss = 0.f;
#pragma unroll
                for (int i = 0; i < 8; ++i) ss += a[i] * a[i];
                ss += __shfl_xor(ss, 1); ss += __shfl_xor(ss, 2); ss += __shfl_xor(ss, 4); ss += __shfl_xor(ss, 8);
                const float rs = rsqrtf(ss * (1.f / 128.f) + NORM_EPS); const float* gn = F.ap->in[qk ? I_KN : I_QN] + d0;
                const f32x4 g0 = *(const f32x4*)gn, g1 = *(const f32x4*)(gn + 4);
#pragma unroll
                for (int i = 0; i < 8; ++i) a[i] = a[i] * rs * (i < 4 ? g0[i] : g1[i - 4]);
                *(v4u*)(WSP(bf16, qk ? WS_FK : WS_FQ) + (size_t)t * FW + ch * 8) = pack8f(a); }
            *(v4u*)(WSP(bf16, WS_FV) + (size_t)t * FW + ch * 8) = *(const v4u*)(pc + PC_FV + ch * 8); }
        if (lane < 8) { const float xv = bflo((unsigned)pc[PC_F + lane]) + F.ap->in[I_BF][lane];
            WSP(float, WS_LF)[(size_t)t * 8 + lane] = fminf(xv, 0.f) - log1pf(__expf(-fabsf(xv))); }
    }
}
__device__ __forceinline__ void p4_cumsum(Frame& F) {
    if (F.wg >= 16) return;
    const int b = F.wg >> 3, h = F.wg & 7; const float* lf = WSP(float, WS_LF) + (size_t)b * SEQ * 8 + h; float* cs = WSP(float, WS_CS) + (size_t)F.wg * SEQ;
    LAS float* part = (LAS float*)(F.lds + RING_OFF);
    const int t0 = F.tid * 32; float s = 0.f;
    for (int i = 0; i < 32; ++i) s += lf[(size_t)(t0 + i) * 8];
    part[F.tid] = s; __syncthreads();
    if (F.tid == 0) { float run = 0.f; for (int i = 0; i < 512; ++i) { const float v = part[i]; part[i] = run; run += v; } }
    __syncthreads();
    float run = part[F.tid];
    for (int i = 0; i < 32; ++i) { run += lf[(size_t)(t0 + i) * 8]; cs[t0 + i] = -run * 11.313708498984761f; }
    __syncthreads();
}
__device__ __forceinline__ void p5_scan_naive(Frame& F) {
    constexpr int CH = 64;
    LAS float* Wl = (LAS float*)(F.lds + RING_OFF); LAS float* Al = Wl + CH * 64; LAS float* Bl = Al + CH * 64; LAS float* Kl = Bl + CH * 64; LAS float* Rl = Kl + CH * 64; LAS float* Vl = Rl + CH * 64; LAS float* Yl = Vl + CH * 64;
    const int tid = F.tid, row = tid >> 3, q = tid & 7;
    for (int bh = F.wg; bh < 32; bh += F.G) {
        const int b = bh >> 4, h = bh & 15; const size_t base = (size_t)b * SEQ * RW + h * 64;
        const bf16* Rg = WSP(bf16, WS_R) + base; const bf16* Kg = WSP(bf16, WS_K) + base; const bf16* Vg = WSP(bf16, WS_V) + base; const bf16* Ag = WSP(bf16, WS_A) + base;
        const float* Lg = WSP(float, WS_LOGW) + base; float* Yg = WSP(float, WS_YRAW) + base;
        float kkw[8], kaw[8];
#pragma unroll
        for (int i = 0; i < 8; ++i) { kkw[i] = F.ap->in[I_KK][h * 64 + 8 * q + i]; kaw[i] = F.ap->in[I_KA][h * 64 + 8 * q + i]; }
        float S[8] = {0.f, 0.f, 0.f, 0.f, 0.f, 0.f, 0.f, 0.f};
        for (int t0 = 0; t0 < SEQ; t0 += CH) {
            { const size_t off = (size_t)(t0 + row) * RW + 8 * q; float r[8], k[8], v[8], a[8];
              unpack8(*(const v4u*)(Rg + off), r); unpack8(*(const v4u*)(Kg + off), k); unpack8(*(const v4u*)(Vg + off), v); unpack8(*(const v4u*)(Ag + off), a);
              const f32x4 l0 = *(const f32x4*)(Lg + off), l1 = *(const f32x4*)(Lg + off + 4);
              float kk[8], ss = 0.f;
#pragma unroll
              for (int i = 0; i < 8; ++i) { kk[i] = k[i] * kkw[i]; ss += kk[i] * kk[i]; }
              ss += __shfl_xor(ss, 1); ss += __shfl_xor(ss, 2); ss += __shfl_xor(ss, 4);
              const float inv = 1.f / fmaxf(sqrtf(ss), 1e-12f);
#pragma unroll
              for (int i = 0; i < 8; ++i) { const int o = row * 64 + 8 * q + i; kk[i] *= inv;
                  Wl[o] = __expf(i < 4 ? l0[i] : l1[i - 4]); Al[o] = -kk[i]; Bl[o] = kk[i] * a[i]; Kl[o] = k[i] * (1.f + (a[i] - 1.f) * kaw[i]); Rl[o] = r[i]; Vl[o] = v[i]; } }
            __syncthreads();
            for (int t = 0; t < CH; ++t) { const int o = t * 64 + 8 * q; float sa = 0.f;
                const f32x4 a0 = *(const LAS f32x4*)(Al + o), a1 = *(const LAS f32x4*)(Al + o + 4), w0 = *(const LAS f32x4*)(Wl + o), w1 = *(const LAS f32x4*)(Wl + o + 4);
                const f32x4 b0 = *(const LAS f32x4*)(Bl + o), b1 = *(const LAS f32x4*)(Bl + o + 4), k0 = *(const LAS f32x4*)(Kl + o), k1 = *(const LAS f32x4*)(Kl + o + 4);
                const f32x4 r0 = *(const LAS f32x4*)(Rl + o), r1 = *(const LAS f32x4*)(Rl + o + 4); const float vv = Vl[t * 64 + row];
#pragma unroll
                for (int i = 0; i < 8; ++i) sa += S[i] * (i < 4 ? a0[i] : a1[i - 4]);
                sa += __shfl_xor(sa, 1); sa += __shfl_xor(sa, 2); sa += __shfl_xor(sa, 4);
                float y = 0.f;
#pragma unroll
                for (int i = 0; i < 8; ++i) { S[i] = S[i] * (i < 4 ? w0[i] : w1[i - 4]) + sa * (i < 4 ? b0[i] : b1[i - 4]) + vv * (i < 4 ? k0[i] : k1[i - 4]); y += S[i] * (i < 4 ? r0[i] : r1[i - 4]); }
                y += __shfl_xor(y, 1); y += __shfl_xor(y, 2); y += __shfl_xor(y, 4);
                if (q == 0) Yl[t * 64 + row] = y; }
            __syncthreads();
            { const int tt = tid >> 3, c = (tid & 7) * 8; *(f32x4*)(Yg + (size_t)(t0 + tt) * RW + c) = *(const LAS f32x4*)(Yl + tt * 64 + c); *(f32x4*)(Yg + (size_t)(t0 + tt) * RW + c + 4) = *(const LAS f32x4*)(Yl + tt * 64 + c + 4); }
        }
        __syncthreads();
    }
}
__device__ __forceinline__ void p7_post(Frame& F) {
    const int gw = F.wg * NWAVES + F.wave, NGW = F.G * NWAVES, lane = F.lane, c0 = 16 * lane;
    for (int t = gw; t < T; t += NGW) { const size_t off = (size_t)t * RW + c0;
        float y[16], r[16], k[16], v[16], a[16], g[16];
#pragma unroll
        for (int j = 0; j < 4; ++j) { const f32x4 yy = *(const f32x4*)(WSP(float, WS_YRAW) + off + 4 * j); y[4 * j] = yy.x; y[4 * j + 1] = yy.y; y[4 * j + 2] = yy.z; y[4 * j + 3] = yy.w; }
#pragma unroll
        for (int j = 0; j < 2; ++j) { float tmp[8];
            unpack8(*(const v4u*)(WSP(bf16, WS_R) + off + 8 * j), tmp); for (int i = 0; i < 8; ++i) r[8 * j + i] = tmp[i];
            unpack8(*(const v4u*)(WSP(bf16, WS_K) + off + 8 * j), tmp); for (int i = 0; i < 8; ++i) k[8 * j + i] = tmp[i];
            unpack8(*(const v4u*)(WSP(bf16, WS_V) + off + 8 * j), tmp); for (int i = 0; i < 8; ++i) v[8 * j + i] = tmp[i];
            unpack8(*(const v4u*)(WSP(bf16, WS_A) + off + 8 * j), tmp); for (int i = 0; i < 8; ++i) a[8 * j + i] = tmp[i];
            unpack8(*(const v4u*)(WSP(bf16, WS_G) + off + 8 * j), tmp); for (int i = 0; i < 8; ++i) g[8 * j + i] = tmp[i]; }
        float s = 0.f, bs = 0.f;
#pragma unroll
        for (int i = 0; i < 16; ++i) { s += y[i]; const float kp = k[i] * (1.f + (a[i] - 1.f) * F.ap->in[I_KA][c0 + i]); bs += r[i] * kp * F.ap->in[I_RK][c0 + i]; }
        s += __shfl_xor(s, 1); s += __shfl_xor(s, 2); bs += __shfl_xor(bs, 1); bs += __shfl_xor(bs, 2);
        const float mean = s * (1.f / 64.f); float q = 0.f;
#pragma unroll
        for (int i = 0; i < 16; ++i) { const float d = y[i] - mean; q += d * d; }
        q += __shfl_xor(q, 1); q += __shfl_xor(q, 2);
        const float rstd = rsqrtf(q * (1.f / 64.f) + GN_EPS); float o[16];
#pragma unroll
        for (int i = 0; i < 16; ++i) o[i] = ((y[i] - mean) * rstd * F.ap->in[I_GNG][c0 + i] + F.ap->in[I_GNB][c0 + i] + bs * v[i]) * g[i];
#pragma unroll
        for (int j = 0; j < 2; ++j) { v4u w; w.x = pk2(o[8 * j], o[8 * j + 1]); w.y = pk2(o[8 * j + 2], o[8 * j + 3]); w.z = pk2(o[8 * j + 4], o[8 * j + 5]); w.w = pk2(o[8 * j + 6], o[8 * j + 7]); *(v4u*)(WSP(bf16, WS_YA) + off + 8 * j) = w; }
    }
}
__device__ __forceinline__ fox::BlockRef<fox::bf16, fox::bf16> fox_ref(int L_, int pass_, const unsigned char* ws) {
    constexpr int NQB = fox::SQ / fox::QB, NX = NQB / 2;
    const int bh = L_ / NX, x = L_ % NX, qb = pass_ ? (NQB - 1 - x) : x;
    fox::BlockRef<fox::bf16, fox::bf16> r; r.ws = ws; r.row0 = (bh / fox::H) * fox::SQ + qb * fox::QB; r.bh = bh; r.P0 = qb * fox::QB; return r;
}
__device__ __forceinline__ void p6_attention(Frame& F, char* lds) {
    constexpr int NQB = fox::SQ / fox::QB, NX = NQB / 2, TOTAL = NX * fox::B * fox::H;
    const int stride = F.G; int L = F.wg; if (L >= TOTAL) return;
    int pass = 0;
    fox::BlockRef<fox::bf16, fox::bf16> cur = fox_ref(L, 0, F.ws);
    fox::Seam<fox::bf16> S;
    fox::causal_swa_prime<fox::bf16, fox::bf16>(cur, fox::WINDOW, lds, S, F.tid);
    for (;;) {
        const bool more_pass = pass == 0, more_item = L + stride < TOTAL, last = !more_pass && !more_item;
        int passn = pass + 1, Ln = L;
        if (!more_pass) { passn = 0; Ln = more_item ? L + stride : L; }
        const fox::BlockRef<fox::bf16, fox::bf16> nxt = last ? cur : fox_ref(Ln, passn, F.ws);
        fox::causal_swa_block<fox::bf16, fox::bf16>(cur, nxt, fox::SKV, fox::WINDOW, lds, S, F.tid);
        if (last) break;
        cur = nxt; pass = passn; L = Ln;
    }
}
typedef float f32x4m __attribute__((ext_vector_type(4)));
__device__ __forceinline__ void p11_router(Frame& F) {
    constexpr int TPW = T / 256 / NWAVES;
    const int lane = F.lane, t0 = (F.wg * NWAVES + F.wave) * TPW;
    const float* x1 = WSP(float, WS_X1); const float* mod = WSP(float, WS_MOD) + (size_t)(t0 / SEQ) * 12288; const float* g2 = F.ap->in[I_N2G]; bf16* H = WSP(bf16, WS_H);
    LAS float* lg = (LAS float*)(F.lds + RING_OFF + F.wave * 4096);
    LAS int* cnt = (LAS int*)(F.lds + RING_OFF + 65536);
    if (F.tid < 32) cnt[F.tid] = 0;
    __syncthreads();
    for (int i = 0; i < TPW; ++i) { const int m = t0 + i;
        const f32x4* xr = (const f32x4*)(x1 + (size_t)m * DM) + lane; f32x4 v[8]; float ss = 0.f;
#pragma unroll
        for (int j = 0; j < 8; ++j) { v[j] = xr[64 * j]; ss += (v[j].x * v[j].x + v[j].y * v[j].y) + (v[j].z * v[j].z + v[j].w * v[j].w); }
        const float rs = rsqrtf(wave_sum(ss) * (1.f / DM) + NORM_EPS);
        if (lane == 0) lg[512 + i] = rs;
#pragma unroll
        for (int j = 0; j < 8; ++j) { const int c = 4 * lane + 256 * j; const f32x4 gg = *(const f32x4*)(g2 + c), sc = *(const f32x4*)(mod + 4 * 2048 + c), sh = *(const f32x4*)(mod + 3 * 2048 + c);
            const f32x4 y = v[j] * rs * gg * (sc + 1.f) + sh; v2u o; o.x = pk2(y.x, y.y); o.y = pk2(y.z, y.w); *(v2u*)(H + (size_t)m * DM + c) = o; }
    }
    LDS_WAIT();
    { const int i = lane & 15, q = lane >> 4; const float rs = lg[512 + i]; const float* xr = x1 + (size_t)(t0 + i) * DM + 4 * q; const float* wr = WSP(float, WS_WRT) + (size_t)i * DM + 4 * q;
      f32x4m acc0 = {0.f, 0.f, 0.f, 0.f}, acc1 = {0.f, 0.f, 0.f, 0.f};
#pragma unroll 4
      for (int Sx = 0; Sx < DM / 16; ++Sx) { const int k = 16 * Sx;
          const f32x4 xv = *(const f32x4*)(xr + k), gg = *(const f32x4*)(g2 + k + 4 * q), sc = *(const f32x4*)(mod + 4 * 2048 + k + 4 * q), sh = *(const f32x4*)(mod + 3 * 2048 + k + 4 * q);
          const f32x4 hv = xv * rs * gg * (sc + 1.f) + sh; const f32x4 w0 = *(const f32x4*)(wr + k), w1 = *(const f32x4*)(wr + 16 * DM + k);
#pragma unroll
          for (int jj = 0; jj < 4; ++jj) { acc0 = __builtin_amdgcn_mfma_f32_16x16x4f32(hv[jj], w0[jj], acc0, 0, 0, 0); acc1 = __builtin_amdgcn_mfma_f32_16x16x4f32(hv[jj], w1[jj], acc1, 0, 0, 0); } }
      const float b0 = F.ap->in[I_BR][i], b1 = F.ap->in[I_BR][16 + i];
#pragma unroll
      for (int r = 0; r < 4; ++r) { lg[(4 * q + r) * 32 + i] = acc0[r] + b0; lg[(4 * q + r) * 32 + 16 + i] = acc1[r] + b1; } }
    LDS_WAIT();
    if (lane < 16) { const int m = t0 + lane; float v[4]; int e[4]; unsigned used = 0u;
#pragma unroll
        for (int k = 0; k < 4; ++k) { float best = -3.0e38f; int bi = 0;
            for (int j = 0; j < 32; ++j) { const float x = lg[lane * 32 + j]; if (!((used >> j) & 1u) && x > best) { best = x; bi = j; } }
            used |= 1u << bi; v[k] = best; e[k] = bi; }
        const float e1 = __expf(v[1] - v[0]), e2 = __expf(v[2] - v[0]), e3 = __expf(v[3] - v[0]), inv = 1.f / (1.f + e1 + e2 + e3);
        *(f32x4*)(WSP(float, WS_TOKW) + (size_t)m * 4) = (f32x4){inv, e1 * inv, e2 * inv, e3 * inv};
        int* te = WSP(int, WS_TOKE) + (size_t)m * 4; te[0] = e[0]; te[1] = e[1]; te[2] = e[2]; te[3] = e[3];
#pragma unroll
        for (int k = 0; k < 4; ++k) __hip_atomic_fetch_add(cnt + e[k], 1, __ATOMIC_RELAXED, __HIP_MEMORY_SCOPE_WORKGROUP); }
    __syncthreads();
    if (F.tid < 32) WSP(int, WS_WGCNT)[F.wg * 32 + F.tid] = cnt[F.tid];
    __syncthreads();
}
__device__ __forceinline__ void p12_slots(Frame& F) {
    constexpr int TPG = T / 256;
    LAS int* cur = (LAS int*)(F.lds + RING_OFF); LAS int* tot = cur + 32; LAS int* pre = cur + 64; LAS int* off = cur + 96; LAS int* slotl = cur + 160;
    const int* wgcnt = WSP(int, WS_WGCNT);
    if (F.tid < 32) { int tt = 0, pp = 0; for (int w = 0; w < 256; ++w) { const int c = wgcnt[w * 32 + F.tid]; if (w < F.wg) pp += c; tt += c; } tot[F.tid] = tt; pre[F.tid] = pp; }
    __syncthreads();
    if (F.tid == 0) { int o = 0; for (int e = 0; e < 32; ++e) { off[e] = o; o += (tot[e] + 255) & ~255; } off[32] = o; }
    __syncthreads();
    if (F.tid < 32) cur[F.tid] = off[F.tid] + pre[F.tid];
    if (F.wg == 0) { int* te = WSP(int, WS_TILEE); const int nt = off[32] >> 8;
        for (int p = F.tid; p < nt; p += NWAVES * 64) { int e = 0; for (int j = 1; j < 32; ++j) if ((p << 8) >= off[j]) e = j; te[p] = e; }
        if (F.tid == 0) te[1024] = nt; }
    __syncthreads();
    { const int t = F.wg * TPG + (F.tid >> 2), k = F.tid & 3; const int e = WSP(int, WS_TOKE)[(size_t)t * 4 + k];
      const int s = __hip_atomic_fetch_add(cur + e, 1, __ATOMIC_RELAXED, __HIP_MEMORY_SCOPE_WORKGROUP);
      slotl[F.tid] = s; WSP(int, WS_TOKS)[(size_t)t * 4 + k] = s; WSP(float, WS_SLOTW)[s] = WSP(float, WS_TOKW)[(size_t)t * 4 + k]; }
    __syncthreads();
    const bf16* H = WSP(bf16, WS_H); bf16* HS = WSP(bf16, WS_HS);
    for (int i = 0; i < TPG / NWAVES; ++i) { const int tl = F.wave * (TPG / NWAVES) + i, t = F.wg * TPG + tl; v4u v[4];
#pragma unroll
        for (int j = 0; j < 4; ++j) v[j] = *(const v4u*)(H + (size_t)t * DM + 8 * (F.lane + 64 * j));
#pragma unroll
        for (int k = 0; k < 4; ++k) { const int s = slotl[tl * 4 + k];
#pragma unroll
            for (int j = 0; j < 4; ++j) *(v4u*)(HS + (size_t)s * DM + 8 * (F.lane + 64 * j)) = v[j]; } }
    __syncthreads();
}
__device__ __forceinline__ void p15_final(Frame& F) {
    const int gw = F.wg * NWAVES + F.wave, NGW = F.G * NWAVES, lane = F.lane;
    const float* x1 = WSP(float, WS_X1); const bf16* YS = WSP(bf16, WS_HS); const float* gf = F.ap->in[I_NFG];
    for (int m = gw; m < T; m += NGW) { const float* gt = WSP(float, WS_MOD) + (size_t)(m / SEQ) * 12288 + 5 * 2048;
        const int4 sl = *(const int4*)(WSP(int, WS_TOKS) + (size_t)m * 4); float v[4][8]; float ss = 0.f;
#pragma unroll
        for (int j = 0; j < 4; ++j) { const int c = 8 * (lane + 64 * j); float y[8] = {0.f, 0.f, 0.f, 0.f, 0.f, 0.f, 0.f, 0.f}, tmp[8];
            unpack8(*(const v4u*)(YS + (size_t)sl.x * DM + c), tmp); for (int i = 0; i < 8; ++i) y[i] += tmp[i];
            unpack8(*(const v4u*)(YS + (size_t)sl.y * DM + c), tmp); for (int i = 0; i < 8; ++i) y[i] += tmp[i];
            unpack8(*(const v4u*)(YS + (size_t)sl.z * DM + c), tmp); for (int i = 0; i < 8; ++i) y[i] += tmp[i];
            unpack8(*(const v4u*)(YS + (size_t)sl.w * DM + c), tmp); for (int i = 0; i < 8; ++i) y[i] += tmp[i];
            const f32x4 xa = *(const f32x4*)(x1 + (size_t)m * DM + c), xb = *(const f32x4*)(x1 + (size_t)m * DM + c + 4), ga = *(const f32x4*)(gt + c), gb = *(const f32x4*)(gt + c + 4);
#pragma unroll
            for (int i = 0; i < 8; ++i) { const float xv = (i < 4 ? xa[i] : xb[i - 4]) + (i < 4 ? ga[i] : gb[i - 4]) * y[i]; v[j][i] = xv; ss += xv * xv; } }
        const float rs = rsqrtf(wave_sum(ss) * (1.f / DM) + NORM_EPS);
#pragma unroll
        for (int j = 0; j < 4; ++j) { const int c = 8 * (lane + 64 * j); const f32x4 ga = *(const f32x4*)(gf + c), gb = *(const f32x4*)(gf + c + 4);
            *(f32x4*)(F.ap->out + (size_t)m * DM + c) = (f32x4){v[j][0] * rs * ga[0], v[j][1] * rs * ga[1], v[j][2] * rs * ga[2], v[j][3] * rs * ga[3]};
            *(f32x4*)(F.ap->out + (size_t)m * DM + c + 4) = (f32x4){v[j][4] * rs * gb[0], v[j][5] * rs * gb[1], v[j][6] * rs * gb[2], v[j][7] * rs * gb[3]}; }
    }
}

__device__ __forceinline__ bool fresh(Frame& F) {
    asm volatile("" : "+s"(F.ap)); int w = F.wave; asm volatile("" : "+s"(w)); const int l = __builtin_amdgcn_mbcnt_hi(~0u, __builtin_amdgcn_mbcnt_lo(~0u, 0u)); F.lane = l; F.tid = w * 64 + l; return true; }
constexpr int N_PHASES = 16;
__global__ void __launch_bounds__(NWAVES * 64, 2) mk_fwd(Args args) {
    extern __shared__ __attribute__((aligned(16))) unsigned char lds[];
    Frame F;
    F.lds = (LAS unsigned char*)lds; F.MISC = (volatile LAS unsigned*)(F.lds + MISC_OFF);
    F.tid = threadIdx.x; F.lane = F.tid & 63; F.wave = __builtin_amdgcn_readfirstlane(F.tid >> 6); F.G = gridDim.x; F.wg = blockIdx.x;
    F.ap = (ArgsP)__builtin_amdgcn_kernarg_segment_ptr(); F.ws = F.ap->ws; F.ctl = (gu32*)(F.ws + WS_CTL);
    for (int u = F.tid; u < (LDS_BYTES - LDSCTL_OFF) / 4; u += NWAVES * 64) ((LAS unsigned*)(F.lds + LDSCTL_OFF))[u] = 0u;
    __syncthreads();
    const int lo = F.ap->ph_lo, hi = F.ap->ph_hi;
    XcdBarrier bar; bar.bar = (unsigned*)(F.ctl + CW_BAR); bar.x = 0; bar.st = nullptr;
    if (hi - lo > 1) bar = xcd_barrier_post((unsigned*)(F.ctl + CW_BAR), F.MISC + 8, F.tid);
#ifndef PH_MASK
#define PH_MASK 0xffff
#endif
#define IN(k) (((PH_MASK >> (k)) & 1) && lo <= (k) && (k) < hi && fresh(F))
#define SEAM(k) do { if (IN(k) && IN((k) + 1)) xcd_barrier(bar, F.tid); } while (0)
    if (IN(0)) { p0_prologue(F); } SEAM(0);
    if (IN(1)) { norm_mod_rows(F, F.ap->in[I_X], F.ap->in[I_N1G], 0, 2048, WSP(bf16, WS_H)); } SEAM(1);
    if (IN(2)) { pg8::Gemm g{WSP(bf16, WS_H), WSP(bf16, WS_WIN), T, NP, DM}; pg8::StaticOrder S; S.init(T, NP, F.G, F.wg);
        pg8::EpiBf16<0> E{WSP(bf16, WS_P), NP, nullptr, 0, 0, 1.f}; pg8::gemm_phase<pg8::EpiBf16<0>, pg8::StaticOrder, true, true>(F.lds + RING_OFF, g, S, E, F.tid); } SEAM(2);
    if (IN(3)) { p3_prep(F); } SEAM(3);
    if (IN(4)) { p4_cumsum(F);
        { pg8::Gemm g{WSP(bf16, WS_LW), WSP(bf16, WS_BT1), T, 2048, 256}; pg8::StaticOrder S; S.init(T, 2048, F.G, F.wg);
          pg8::EpiLora1 E{WSP(float, WS_LOGW), WSP(bf16, WS_A), F.ap->in[I_W0], F.ap->in[I_A0]}; pg8::gemm_phase<pg8::EpiLora1, pg8::StaticOrder, true, true>(F.lds + RING_OFF, g, S, E, F.tid); }
        } SEAM(4);
    if (IN(5)) { p5_scan_naive(F); __syncthreads();
        { pg8::Gemm g{WSP(bf16, WS_SG), WSP(bf16, WS_BT2), T, 1024, 256}; pg8::StaticOrder S; S.init(T, 1024, F.G, F.wg);
          pg8::EpiBf16<0> E{WSP(bf16, WS_G), 1024, nullptr, 0, 0, 1.f}; pg8::gemm_phase<pg8::EpiBf16<0>, pg8::StaticOrder, true, true>(F.lds + RING_OFF, g, S, E, F.tid); } } SEAM(5);
    if (IN(6)) { p6_attention(F, (char*)lds + RING_OFF); } SEAM(6);
    if (IN(7)) { p7_post(F); } SEAM(7);
    if (IN(8)) { pg8::Gemm g{WSP(bf16, WS_YA), WSP(bf16, WS_WOA), T, DM, 1024}; pg8::StaticOrder S; S.init(T, DM, F.G, F.wg);
        pg8::EpiGateMerge<0> E{WSP(bf16, WS_MRG), WSP(bf16, WS_P), PC_GA}; pg8::gemm_phase<pg8::EpiGateMerge<0>, pg8::StaticOrder, true, true>(F.lds + RING_OFF, g, S, E, F.tid); } SEAM(8);
    if (IN(9)) { pg8::Gemm g{WSP(bf16, WS_YB), WSP(bf16, WS_WOB), T, DM, 1024}; pg8::StaticOrder S; S.init(T, DM, F.G, F.wg);
        pg8::EpiGateMerge<1> E{WSP(bf16, WS_MRG), WSP(bf16, WS_P), PC_GB}; pg8::gemm_phase<pg8::EpiGateMerge<1>, pg8::StaticOrder, true, true>(F.lds + RING_OFF, g, S, E, F.tid); } SEAM(9);
    if (IN(10)) { pg8::Gemm g{WSP(bf16, WS_MRG), WSP(bf16, WS_WOUT), T, DM, DM}; pg8::StaticOrder S; S.init(T, DM, F.G, F.wg);
        pg8::EpiResid E{F.ap->in[I_X], WSP(float, WS_X1), WSP(float, WS_MOD)}; pg8::gemm_phase<pg8::EpiResid, pg8::StaticOrder, true, true>(F.lds + RING_OFF, g, S, E, F.tid); } SEAM(10);
    if (IN(11)) { p11_router(F); } SEAM(11);
    if (IN(12)) { p12_slots(F); } SEAM(12);
    if (IN(13)) { const int nt = WSP(int, WS_TILEE)[1024]; pg8::Gemm g{WSP(bf16, WS_HS), WSP(bf16, WS_WGU), nt * 256, 4096, DM}; pg8::MoeOrder S; S.init(nt * 256, 4096, F.G, F.wg); S.tile_e = WSP(int, WS_TILEE);
        pg8::EpiSwiglu E{WSP(bf16, WS_ACT), F.ap->in[I_BGU]}; pg8::gemm_phase<pg8::EpiSwiglu, pg8::MoeOrder, true, true>(F.lds + RING_OFF, g, S, E, F.tid); } SEAM(13);
    if (IN(14)) { const int nt = WSP(int, WS_TILEE)[1024]; pg8::Gemm g{WSP(bf16, WS_ACT), WSP(bf16, WS_WDN), nt * 256, 2048, DFF}; pg8::MoeOrder S; S.init(nt * 256, 2048, F.G, F.wg); S.tile_e = WSP(int, WS_TILEE);
        pg8::EpiDown E{WSP(bf16, WS_HS), F.ap->in[I_BDN], WSP(float, WS_SLOTW)}; pg8::gemm_phase<pg8::EpiDown, pg8::MoeOrder, true, true>(F.lds + RING_OFF, g, S, E, F.tid); } SEAM(14);
    if (IN(15)) { p15_final(F); }
#undef IN
#undef SEAM
}

extern "C" void kernel_launch(void* const* d_in, const int* in_sizes, int n_in, void* d_out, int out_size, void* d_ws, size_t ws_size, hipStream_t stream) {
    static int grid = 0;
    if (grid == 0) {
        if (n_in != N_IN || in_sizes[0] != T * DM || out_size != T * DM || ws_size < WS_END) { fprintf(stderr, "kernel_launch: shape/workspace mismatch (n_in %d, in0 %d, out %d, ws %zu < %zu)\n", n_in, n_in > 0 ? in_sizes[0] : -1, out_size, ws_size, (size_t)WS_END); grid = -1; return; }
        if (hipFuncSetAttribute((const void*)mk_fwd, hipFuncAttributeMaxDynamicSharedMemorySize, LDS_BYTES) != hipSuccess) { fprintf(stderr, "kernel_launch: hipFuncSetAttribute failed\n"); grid = -1; return; }
        int per_cu = 0;
        if (hipOccupancyMaxActiveBlocksPerMultiprocessor(&per_cu, (const void*)mk_fwd, NWAVES * 64, LDS_BYTES) != hipSuccess || per_cu < 1) fprintf(stderr, "kernel_launch: note: occupancy query reports %d workgroups per CU\n", per_cu);
        (void)hipGetLastError();
        grid = 256;
    }
    if (grid < 0) return;
    (void)hipMemsetAsync((char*)d_ws + WS_CTL, 0, CTL_ZERO_BYTES, stream);
    Args a{};
    for (int i = 0; i < N_IN; ++i) a.in[i] = (const float*)d_in[i];
    a.out = (float*)d_out; a.ws = (unsigned char*)d_ws;
#if MK_N_LAUNCHES == 1
    a.ph_lo = 0; a.ph_hi = N_PHASES;
    hipLaunchKernelGGL(mk_fwd, dim3(grid), dim3(NWAVES * 64), LDS_BYTES, stream, a);
#else
    for (int p = 0; p < N_PHASES; ++p) { a.ph_lo = p; a.ph_hi = p + 1; hipLaunchKernelGGL(mk_fwd, dim3(grid), dim3(NWAVES * 64), LDS_BYTES, stream, a); }
#endif
}
```

```cpp
#include <hip/hip_runtime.h>
#include <hip/hip_bf16.h>
#include <cstdio>
#include <cstdint>
constexpr int NWAVES = 8;
#ifndef MK_N_LAUNCHES
#define MK_N_LAUNCHES 1
#endif
#ifndef RWKV_NAIVE
#define RWKV_NAIVE 0
#endif
constexpr int BATCH = 2, SEQ = 16384, DM = 2048, T = BATCH * SEQ;
constexpr int NP = 11776;
constexpr int PC_R = 0, PC_K = 1024, PC_V = 2048, PC_FQ = 3072, PC_FK = 4096, PC_FV = 5120, PC_OG = 6144, PC_GA = 7168, PC_GB = 9216, PC_GLO = 11264, PC_DLO = 11520, PC_ALO = 11616, PC_F = 11712, PC_END = 11720;
constexpr int RW = 1024, FW = 1024, NE = 32, DFF = 2048, TOPK = 4;
constexpr int NSLOT = T * TOPK + NE * 256;
constexpr float NORM_EPS = 1e-6f, GN_EPS = 64e-5f;

constexpr size_t MiB = 1u << 20;
constexpr size_t WS_CTL = 0, CTL_ZERO_BYTES = 1 * MiB;
constexpr size_t WS_MOD = 1 * MiB;
constexpr size_t WS_WRT = 1 * MiB + 128 * 1024;
constexpr size_t WS_TOKE = 2 * MiB, WS_TOKW = 2 * MiB + 512 * 1024, WS_TOKS = 3 * MiB, WS_SLOTW = 3 * MiB + 512 * 1024;
constexpr size_t WS_WGCNT = 4 * MiB + 512 * 1024, WS_TILEE = 4 * MiB + 768 * 1024;
constexpr size_t WS_LF = 5 * MiB, WS_CS = 6 * MiB;
constexpr size_t WS_BT1 = 7 * MiB, WS_BT2 = 8 * MiB, WS_WOA = 9 * MiB, WS_WOB = 13 * MiB, WS_WOUT = 17 * MiB, WS_WIN = 25 * MiB;
constexpr size_t WS_WGU = 72 * MiB, WS_WDN = 584 * MiB, WS_X1 = 840 * MiB, WS_H = 1096 * MiB;
constexpr size_t WS_P = 1226 * MiB, WS_R = 1962 * MiB, WS_K = 2026 * MiB, WS_V = 2090 * MiB, WS_FQ = 2154 * MiB, WS_FK = 2218 * MiB, WS_FV = 2282 * MiB;
constexpr size_t WS_LW = 2346 * MiB, WS_SG = 2362 * MiB, WS_LOGW = 2378 * MiB, WS_A = 2506 * MiB, WS_G = 2570 * MiB, WS_YRAW = 2634 * MiB, WS_YA = 2762 * MiB, WS_YB = 2826 * MiB, WS_MRG = 2890 * MiB;
constexpr size_t WS_HS = 1226 * MiB, WS_ACT = 1770 * MiB;
constexpr size_t WS_REC = 3018 * MiB;
constexpr size_t WS_END = 3274 * MiB;
static_assert(WS_WIN + (size_t)NP * DM * 2 <= WS_WGU && WS_ACT + (size_t)NSLOT * DFF * 2 <= WS_REC && WS_HS + (size_t)NSLOT * DM * 2 <= WS_ACT && WS_SLOTW + (size_t)NSLOT * 4 <= WS_WGCNT, "d_ws map");
constexpr int CW_TMO = 0, CW_BAR = 4096;

constexpr int RING_OFF = 0, RING_BYTES = 143360;
constexpr int LDSCTL_OFF = RING_BYTES, MISC_OFF = LDSCTL_OFF + 320;
constexpr int LDS_BYTES = 147456;

#define GAS __attribute__((address_space(1)))
#define LAS __attribute__((address_space(3)))
typedef unsigned short bf16;
typedef unsigned v4u __attribute__((ext_vector_type(4)));
typedef unsigned v2u __attribute__((ext_vector_type(2)));
typedef float f32x4 __attribute__((ext_vector_type(4)));
typedef short bf16x8 __attribute__((ext_vector_type(8)));
typedef GAS unsigned gu32;
#define RLX_AGENT __ATOMIC_RELAXED, __HIP_MEMORY_SCOPE_AGENT
#define LDS_WAIT() asm volatile("s_waitcnt lgkmcnt(0)" ::: "memory")
#define VM_WAIT() asm volatile("s_waitcnt vmcnt(0)" ::: "memory")
__device__ __forceinline__ unsigned f2bf(float f) { unsigned u = __builtin_bit_cast(unsigned, f); return (u + 0x7fffu + ((u >> 16) & 1u)) >> 16; }
__device__ __forceinline__ unsigned pk2(float lo, float hi) { return f2bf(lo) | (f2bf(hi) << 16); }
__device__ __forceinline__ float bflo(unsigned w) { return __uint_as_float(w << 16); }
__device__ __forceinline__ float bfhi(unsigned w) { return __uint_as_float(w & 0xffff0000u); }
__device__ __forceinline__ void unpack8(v4u w, float (&f)[8]) { f[0] = bflo(w.x); f[1] = bfhi(w.x); f[2] = bflo(w.y); f[3] = bfhi(w.y); f[4] = bflo(w.z); f[5] = bfhi(w.z); f[6] = bflo(w.w); f[7] = bfhi(w.w); }
__device__ __forceinline__ v4u pack8f(const float (&f)[8]) { v4u w; w.x = pk2(f[0], f[1]); w.y = pk2(f[2], f[3]); w.z = pk2(f[4], f[5]); w.w = pk2(f[6], f[7]); return w; }
__device__ __forceinline__ float sigmoidf_(float x) { return 1.f / (1.f + __expf(-x)); }
__device__ __forceinline__ float wave_sum(float v) {
#pragma unroll
    for (int o = 1; o < 64; o <<= 1) v += __shfl_xor(v, o);
    return v;
}
namespace pg8 {
#define PG8_LAS __attribute__((address_space(3)))
typedef unsigned short bf16_t;
typedef short bf16x8 __attribute__((ext_vector_type(8)));
typedef float f32x4 __attribute__((ext_vector_type(4)));
typedef unsigned u32x4 __attribute__((ext_vector_type(4)));
constexpr int BM = 256, BK = 64, HALF = 128, HTB = HALF * BK * 2  , STAGE_BYTES = 8 * HTB, NXCD = 8, WGM = 8;

__host__ __device__ __forceinline__ int lds_byte(int r, int c) { const int st = (r >> 4) * 2 + (c >> 5), rr = r & 15, cc = c & 31, ob = rr * 64 + cc * 2; return st * 1024 + (ob ^ (((ob >> 9) & 1) << 5)); }
__host__ __device__ __forceinline__ void stage_rc(int b, int& R, int& C) { const int st = b / 1024, sb = b % 1024, swz = sb ^ (((sb >> 9) & 1) << 5); R = (st >> 1) * 16 + swz / 64; C = (st & 1) * 32 + (swz % 64) / 2; }
__host__ __device__ __forceinline__ int perm32(int rho) { const int n = rho >> 4, i = rho & 15; return 8 * (i >> 2) + 4 * n + (i & 3); }

struct Unit { int pm, pn, e; };
struct Gemm { const bf16_t* A; const bf16_t* Bt; int M, N, K; };

struct StaticOrder {
    int nM, nN, nwg, G, c;
    __host__ __device__ void init(int M, int N, int G_, int c_) { nM = M / BM; nN = N / BM; nwg = nM * nN; G = G_; c = c_; }
    __host__ __device__ bool next(int i, Unit& u) const {
        const long L = (long)i * G + c; if (L >= nwg) return false;
        int wgid = (int)L; { const int q = nwg / NXCD, r = nwg % NXCD, xcd = wgid % NXCD, off = wgid / NXCD; wgid = (xcd < r ? xcd * (q + 1) : r * (q + 1) + (xcd - r) * q) + off; }
        const int nig = WGM * nN, gid = wgid / nig, fm = gid * WGM, gsz = (nM - fm) < WGM ? (nM - fm) : WGM;
        u.pm = fm + ((wgid % nig) % gsz); u.pn = (wgid % nig) / gsz; u.e = 0; return true;
    }
    __device__ __forceinline__ void a_ready(const Unit&) const {}
    __device__ __forceinline__ void done(const Unit&) const {}
};

__device__ __forceinline__ unsigned cvt_pk_bf16(float lo, float hi) { unsigned r; asm volatile("v_cvt_pk_bf16_f32 %0, %1, %2" : "=v"(r) : "v"(lo), "v"(hi)); return r; }
typedef float f32x2 __attribute__((ext_vector_type(2)));
__device__ __forceinline__ f32x2 gelu_pk(f32x2 v) {
    const f32x2 av = __builtin_elementwise_abs(v), d = av * 0.2316418882f + 1.0f;
    f32x2 t; t.x = __builtin_amdgcn_rcpf(d.x); t.y = __builtin_amdgcn_rcpf(d.y);
    f32x2 q = t * 0.5307027145f + (-0.7265760135f); q = q * t + 0.7107068705f; q = q * t + (-0.142248368f); q = q * t + 0.127414796f; q = q * t;
    const f32x2 s = (v * v) * (-0.72134752044f);
    f32x2 e; e.x = __builtin_amdgcn_exp2f(s.x); e.y = __builtin_amdgcn_exp2f(s.y);
    const f32x2 m = v * (q * e), r = v - m;
    f32x2 o; o.x = v.x < 0.f ? m.x : r.x; o.y = v.y < 0.f ? m.y : r.y; return o;
}

template <int ACT  > struct EpiBf16 {
    static constexpr bool PERM = true, AFTER_DRAIN = false; static_assert(ACT == 0 || ACT == 1, "EpiBf16: ACT is 0 (none) or 1 (gelu_pk)");
    bf16_t* O; int ldc; const float* bias; int split_cols; size_t split_stride; float scale0;
    __device__ __forceinline__ void operator()(const f32x4 (&acc)[2][2][4][2], const Unit& u, int wr, int wc, int fr, int fq) const {
        const int row0 = u.pm * BM + wr * 64 + fr; int colt = u.pn * BM; bf16_t* base = O;
        float sc = 1.f; if (split_cols) { const int t = colt / split_cols; base += (size_t)t * split_stride; colt -= t * split_cols; if (t == 0) sc = scale0; }
        const int col0 = colt + wc * 32 + 8 * fq, bcol0 = u.pn * BM + wc * 32 + 8 * fq;
        f32x4 bv[2][2];
#pragma unroll
        for (int bj = 0; bj < 2; ++bj)
#pragma unroll
            for (int n = 0; n < 2; ++n) bv[bj][n] = bias ? *(const f32x4*)(bias + bcol0 + bj * HALF + 4 * n) : (f32x4){0.f, 0.f, 0.f, 0.f};
#pragma unroll
        for (int ai = 0; ai < 2; ++ai)
#pragma unroll
            for (int m = 0; m < 4; ++m) { bf16_t* rowp = base + (size_t)(row0 + ai * HALF + m * 16) * ldc + col0;
#pragma unroll
                for (int bj = 0; bj < 2; ++bj) { f32x4 v0 = acc[ai][bj][m][0] + bv[bj][0], v1 = acc[ai][bj][m][1] + bv[bj][1];
                    if (ACT == 1) { f32x2 a = gelu_pk((f32x2){v0[0], v0[1]}), b = gelu_pk((f32x2){v0[2], v0[3]}), c = gelu_pk((f32x2){v1[0], v1[1]}), d = gelu_pk((f32x2){v1[2], v1[3]});
                        v0 = (f32x4){a.x, a.y, b.x, b.y}; v1 = (f32x4){c.x, c.y, d.x, d.y}; }
                    v0 = v0 * sc; v1 = v1 * sc; u32x4 w; w.x = cvt_pk_bf16(v0[0], v0[1]); w.y = cvt_pk_bf16(v0[2], v0[3]); w.z = cvt_pk_bf16(v1[0], v1[1]); w.w = cvt_pk_bf16(v1[2], v1[3]);
                    *(u32x4*)(rowp + bj * HALF) = w; } }
    }
};

template <class Epi, class Sched, bool ALIGN_EPI = false, bool SP2 = false>
__device__ __forceinline__ void gemm_phase(PG8_LAS unsigned char* lds, const Gemm g, const Sched& S, const Epi& E, const int tid) {
    const int wid = __builtin_amdgcn_readfirstlane(tid >> 6), lane = tid & 63, wr = wid >> 2, wc = wid & 3, fr = lane & 15, fq = lane >> 4;
    const int K = g.K, nt = K / BK;
    unsigned voffA[2], voffB[2];
#pragma unroll
    for (int i = 0; i < 2; ++i) { int R, C; stage_rc(tid * 16 + i * 8192, R, C); const int Rb = Epi::PERM ? ((R & ~31) + perm32(R & 31)) : R;
        voffA[i] = (unsigned)(R * K + C) * 2u; voffB[i] = (unsigned)(Rb * K + C) * 2u; }
    const size_t kstep = (size_t)(BK * 2);
    const size_t hstep = (size_t)HALF * K * 2;
    const size_t tstep = 2 * hstep;
    const unsigned ldsw = (unsigned)wid * 1024u;
    const int aoff = lds_byte(wr * 64 + fr, fq * 8), boff = lds_byte(wc * 32 + fr, fq * 8);
#define PG8_SA(b, h) (((b) * 2 + (h)) * HTB)
#define PG8_SB(b, h) ((4 + (b) * 2 + (h)) * HTB)
#define PG8_STAGE(bufoff, gbase, voff) do { _Pragma("unroll") for (int _i = 0; _i < 2; ++_i) \
        __builtin_amdgcn_global_load_lds((const unsigned*)((const char*)(gbase) + (voff)[_i]), (PG8_LAS unsigned*)(lds + (bufoff) + ldsw + _i * 8192), 16, 0, 0); } while (0)
#define PG8_LDA(dst, b, h) do { _Pragma("unroll") for (int m = 0; m < 4; ++m) _Pragma("unroll") for (int k = 0; k < 2; ++k) dst[m][k] = *(const PG8_LAS bf16x8*)(lds + PG8_SA(b, h) + aoff + m * 2048 + k * 1024); } while (0)
#define PG8_LDB(dst, b, h) do { _Pragma("unroll") for (int n = 0; n < 2; ++n) _Pragma("unroll") for (int k = 0; k < 2; ++k) dst[n][k] = *(const PG8_LAS bf16x8*)(lds + PG8_SB(b, h) + boff + n * 2048 + k * 1024); } while (0)
#define PG8_MMA(ai, bj, At, Bt) do { __builtin_amdgcn_s_setprio(1); _Pragma("unroll") for (int m = 0; m < 4; ++m) _Pragma("unroll") for (int n = 0; n < 2; ++n) _Pragma("unroll") for (int k = 0; k < 2; ++k) \
        acc[ai][bj][m][n] = __builtin_amdgcn_mfma_f32_16x16x32_bf16(Bt[n][k], At[m][k], acc[ai][bj][m][n], 0, 0, 0); __builtin_amdgcn_s_setprio(0); } while (0)
#define PG8_WAIT_V(n) asm volatile("s_waitcnt vmcnt(" #n ")" ::: "memory")
#define PG8_WAIT_L(n) asm volatile("s_waitcnt lgkmcnt(" #n ")" ::: "memory")
#define PG8_BAR __builtin_amdgcn_s_barrier()
#define PG8_SCHED __builtin_amdgcn_sched_barrier(0)
    Unit cur, nxt; int ui = 0;
    if (!S.next(0, cur)) return;
    f32x4 acc[2][2][4][2];
#pragma unroll
    for (int a = 0; a < 2; ++a)
#pragma unroll
        for (int b = 0; b < 2; ++b)
#pragma unroll
            for (int m = 0; m < 4; ++m)
#pragma unroll
                for (int n = 0; n < 2; ++n) acc[a][b][m][n] = (f32x4){0.f, 0.f, 0.f, 0.f};
    bf16x8 At[4][2], B0[2][2], B1[2][2];
    const char* cA = (const char*)g.A + (size_t)cur.pm * tstep; const size_t estep = (size_t)g.N * K * 2; const char* cB = (const char*)g.Bt + (size_t)cur.e * estep + (size_t)cur.pn * tstep;
    S.a_ready(cur);
    if constexpr (SP2) {
        PG8_STAGE(PG8_SB(0, 0), cB, voffB); PG8_STAGE(PG8_SB(0, 1), cB + hstep, voffB); PG8_STAGE(PG8_SA(0, 0), cA, voffA); PG8_STAGE(PG8_SA(0, 1), cA + hstep, voffA);
        if (wr == 1) PG8_BAR;
        PG8_WAIT_V(2); PG8_BAR;
        PG8_STAGE(PG8_SB(1, 0), cB + kstep, voffB); PG8_STAGE(PG8_SA(1, 0), cA + kstep, voffA); PG8_STAGE(PG8_SB(1, 1), cB + hstep + kstep, voffB);
        PG8_WAIT_V(6); PG8_BAR;
    } else {
        PG8_STAGE(PG8_SB(0, 0), cB, voffB); PG8_STAGE(PG8_SA(0, 0), cA, voffA); PG8_STAGE(PG8_SB(0, 1), cB + hstep, voffB); PG8_STAGE(PG8_SA(0, 1), cA + hstep, voffA);
        if (wr == 1) PG8_BAR;
        PG8_WAIT_V(4); PG8_BAR;
        PG8_STAGE(PG8_SB(1, 0), cB + kstep, voffB); PG8_STAGE(PG8_SA(1, 0), cA + kstep, voffA); PG8_STAGE(PG8_SB(1, 1), cB + hstep + kstep, voffB);
        PG8_WAIT_V(6); PG8_BAR;
    }
    for (;;) {
        const bool has_next = S.next(ui + 1, nxt);
        const char* nA = has_next ? (const char*)g.A + (size_t)nxt.pm * tstep : cA; const char* nB = has_next ? (const char*)g.Bt + (size_t)nxt.e * estep + (size_t)nxt.pn * tstep : cB;
        for (int t = 0; t < nt; t += 2) {
            const bool last = (t == nt - 2);
            const char* a1 = cA + (size_t)(t + 1) * kstep;
            const char* a2 = last ? nA : cA + (size_t)(t + 2) * kstep; const char* b2 = last ? nB : cB + (size_t)(t + 2) * kstep;
            const char* a3 = a2 + kstep; const char* b3 = b2 + kstep;
            if (last && has_next) S.a_ready(nxt);
            if constexpr (SP2) {
            PG8_LDB(B0, 0, 0); PG8_LDB(B1, 0, 1); PG8_SCHED; PG8_LDA(At, 0, 0); PG8_STAGE(PG8_SA(1, 1), a1 + hstep, voffA);
            PG8_WAIT_V(8); PG8_WAIT_L(0); PG8_BAR; PG8_MMA(0, 0, At, B0); PG8_MMA(0, 1, At, B1); PG8_BAR; PG8_SCHED;
            PG8_LDA(At, 0, 1); PG8_STAGE(PG8_SB(0, 0), b2, voffB); PG8_STAGE(PG8_SB(0, 1), b2 + hstep, voffB); PG8_STAGE(PG8_SA(0, 0), a2, voffA);
            PG8_WAIT_V(8); PG8_WAIT_L(0); PG8_BAR; PG8_MMA(1, 0, At, B0); PG8_MMA(1, 1, At, B1); PG8_BAR; PG8_SCHED;
            PG8_LDB(B0, 1, 0); PG8_LDB(B1, 1, 1); PG8_SCHED; PG8_LDA(At, 1, 0); PG8_STAGE(PG8_SA(0, 1), a2 + hstep, voffA);
            PG8_WAIT_V(8); PG8_WAIT_L(0); PG8_BAR; PG8_MMA(0, 0, At, B0); PG8_MMA(0, 1, At, B1); PG8_BAR; PG8_SCHED;
            PG8_LDA(At, 1, 1); PG8_STAGE(PG8_SB(1, 0), b3, voffB); PG8_STAGE(PG8_SB(1, 1), b3 + hstep, voffB); PG8_STAGE(PG8_SA(1, 0), a3, voffA);
            PG8_WAIT_V(8); PG8_WAIT_L(0); PG8_BAR; PG8_MMA(1, 0, At, B0); PG8_MMA(1, 1, At, B1); PG8_BAR; PG8_SCHED;
            } else {
            PG8_LDB(B0, 0, 0); PG8_SCHED; PG8_LDA(At, 0, 0); PG8_STAGE(PG8_SA(1, 1), a1 + hstep, voffA);
            PG8_WAIT_L(8); PG8_BAR; PG8_WAIT_L(0); PG8_MMA(0, 0, At, B0); PG8_BAR; PG8_SCHED;
            PG8_LDB(B1, 0, 1); PG8_STAGE(PG8_SB(0, 0), b2, voffB);
            PG8_BAR; PG8_WAIT_L(0); PG8_MMA(0, 1, At, B1); PG8_BAR;
            PG8_LDA(At, 0, 1); PG8_STAGE(PG8_SA(0, 0), a2, voffA);
            PG8_BAR; PG8_WAIT_L(0); PG8_MMA(1, 0, At, B0); PG8_BAR; PG8_SCHED;
            PG8_STAGE(PG8_SB(0, 1), b2 + hstep, voffB);
            PG8_WAIT_V(6); PG8_BAR; PG8_MMA(1, 1, At, B1); PG8_BAR;
            PG8_LDB(B0, 1, 0); PG8_SCHED; PG8_LDA(At, 1, 0); PG8_STAGE(PG8_SA(0, 1), a2 + hstep, voffA);
            PG8_WAIT_L(8); PG8_BAR; PG8_WAIT_L(0); PG8_MMA(0, 0, At, B0); PG8_BAR; PG8_SCHED;
            PG8_LDB(B1, 1, 1); PG8_STAGE(PG8_SB(1, 0), b3, voffB);
            PG8_BAR; PG8_WAIT_L(0); PG8_MMA(0, 1, At, B1); PG8_BAR;
            PG8_LDA(At, 1, 1); PG8_STAGE(PG8_SA(1, 0), a3, voffA);
            PG8_BAR; PG8_WAIT_L(0); PG8_MMA(1, 0, At, B0); PG8_BAR; PG8_SCHED;
            PG8_STAGE(PG8_SB(1, 1), b3 + hstep, voffB);
            PG8_WAIT_V(6); PG8_BAR; PG8_MMA(1, 1, At, B1); PG8_BAR;
            }
        }
        if constexpr (ALIGN_EPI) { if (wr == 0) PG8_BAR; }
        if constexpr (!Epi::AFTER_DRAIN) { E(acc, cur, wr, wc, fr, fq); S.done(cur); }
        if (!has_next) break;
#pragma unroll
        for (int a = 0; a < 2; ++a)
#pragma unroll
            for (int b = 0; b < 2; ++b)
#pragma unroll
                for (int m = 0; m < 4; ++m)
#pragma unroll
                    for (int n = 0; n < 2; ++n) acc[a][b][m][n] = (f32x4){0.f, 0.f, 0.f, 0.f};
        cur = nxt; cA = nA; cB = nB; ++ui;
        if constexpr (ALIGN_EPI) { if (wr == 1) PG8_BAR; }
    }
    PG8_WAIT_V(0);
    if constexpr (!ALIGN_EPI) { if (wr == 0) PG8_BAR; }
    PG8_BAR;
    if constexpr (Epi::AFTER_DRAIN) { E.fused(acc, cur, wr, wc, fr, fq, lds, wid, lane); S.done(cur); }
#undef PG8_SA
#undef PG8_SB
#undef PG8_STAGE
#undef PG8_LDA
#undef PG8_LDB
#undef PG8_MMA
#undef PG8_WAIT_V
#undef PG8_WAIT_L
#undef PG8_BAR
#undef PG8_SCHED
}
}
namespace pg8 {
__device__ __forceinline__ float ep_bflo(unsigned w) { return __uint_as_float(w << 16); }
__device__ __forceinline__ float ep_bfhi(unsigned w) { return __uint_as_float(w & 0xffff0000u); }
__device__ __forceinline__ float ep_sig(float x) { return __builtin_amdgcn_rcpf(1.f + __builtin_amdgcn_exp2f(-1.4426950408889634f * x)); }
__device__ __forceinline__ void ep_unpack8(u32x4 w, f32x4& a, f32x4& b) { a = (f32x4){ep_bflo(w.x), ep_bfhi(w.x), ep_bflo(w.y), ep_bfhi(w.y)}; b = (f32x4){ep_bflo(w.z), ep_bfhi(w.z), ep_bflo(w.w), ep_bfhi(w.w)}; }
__device__ __forceinline__ u32x4 ep_pack8(f32x4 a, f32x4 b) { u32x4 w; w.x = cvt_pk_bf16(a[0], a[1]); w.y = cvt_pk_bf16(a[2], a[3]); w.z = cvt_pk_bf16(b[0], b[1]); w.w = cvt_pk_bf16(b[2], b[3]); return w; }
__device__ __forceinline__ f32x4 ep_sig4(f32x4 v) { return (f32x4){ep_sig(v[0]), ep_sig(v[1]), ep_sig(v[2]), ep_sig(v[3])}; }
#define EPI_LOOP_BEGIN const int row0 = u.pm * BM + wr * 64 + fr, col0 = u.pn * BM + wc * 32 + 8 * fq; \
    _Pragma("unroll") for (int ai = 0; ai < 2; ++ai) _Pragma("unroll") for (int m = 0; m < 4; ++m) { const int row = row0 + ai * HALF + m * 16; \
    _Pragma("unroll") for (int bj = 0; bj < 2; ++bj) { const int col = col0 + bj * HALF; const f32x4 v0 = acc[ai][bj][m][0], v1 = acc[ai][bj][m][1];
#define EPI_LOOP_END } }

struct EpiLora1 {
    static constexpr bool PERM = true, AFTER_DRAIN = false;
    float* logw; bf16_t* a; const float* w0; const float* a0;
    __device__ __forceinline__ void operator()(const f32x4 (&acc)[2][2][4][2], const Unit& u, int wr, int wc, int fr, int fq) const {
        EPI_LOOP_BEGIN
            if (u.pn < 4) { const f32x4 b0 = *(const f32x4*)(w0 + col), b1 = *(const f32x4*)(w0 + col + 4);
                float* o = logw + (size_t)row * 1024 + col; *(f32x4*)o = ep_sig4(v0 + b0) * (-0.6065306597126334f); *(f32x4*)(o + 4) = ep_sig4(v1 + b1) * (-0.6065306597126334f); }
            else { const int c = col - 1024; const f32x4 b0 = *(const f32x4*)(a0 + c), b1 = *(const f32x4*)(a0 + c + 4);
                *(u32x4*)(a + (size_t)row * 1024 + c) = ep_pack8(ep_sig4(v0 + b0), ep_sig4(v1 + b1)); }
        EPI_LOOP_END
    }
};
template <int SECOND> struct EpiGateMerge {
    static constexpr bool PERM = true, AFTER_DRAIN = false;
    bf16_t* mrg; const bf16_t* P; int gcol;
    __device__ __forceinline__ void operator()(const f32x4 (&acc)[2][2][4][2], const Unit& u, int wr, int wc, int fr, int fq) const {
        EPI_LOOP_BEGIN
            f32x4 g0, g1; ep_unpack8(*(const u32x4*)(P + (size_t)row * 11776 + gcol + col), g0, g1);
            f32x4 r0 = ep_sig4(g0) * v0, r1 = ep_sig4(g1) * v1;
            bf16_t* o = mrg + (size_t)row * 2048 + col;
            if (SECOND) { f32x4 t0, t1; ep_unpack8(*(const u32x4*)o, t0, t1); r0 = r0 + t0; r1 = r1 + t1; }
            *(u32x4*)o = ep_pack8(r0, r1);
        EPI_LOOP_END
    }
};
struct EpiResid {
    static constexpr bool PERM = true, AFTER_DRAIN = false;
    const float* x; float* x1; const float* mod;
    __device__ __forceinline__ void operator()(const f32x4 (&acc)[2][2][4][2], const Unit& u, int wr, int wc, int fr, int fq) const {
        const float* gt = mod + (size_t)((u.pm * BM) / 16384) * 12288 + 4096;
        EPI_LOOP_BEGIN
            const f32x4 g0 = *(const f32x4*)(gt + col), g1 = *(const f32x4*)(gt + col + 4);
            const size_t off = (size_t)row * 2048 + col;
            *(f32x4*)(x1 + off) = *(const f32x4*)(x + off) + g0 * v0; *(f32x4*)(x1 + off + 4) = *(const f32x4*)(x + off + 4) + g1 * v1;
        EPI_LOOP_END
    }
};
struct EpiSwiglu {
    static constexpr bool PERM = true, AFTER_DRAIN = false;
    bf16_t* act; const float* bias;
    __device__ __forceinline__ void operator()(const f32x4 (&acc)[2][2][4][2], const Unit& u, int wr, int wc, int fr, int fq) const {
        const int row0 = u.pm * BM + wr * 64 + fr, gcol = u.pn * 128 + wc * 32 + 8 * fq;
        const float* bg = bias + (size_t)u.e * 4096 + gcol; const float* bl = bg + 2048;
        const f32x4 bg0 = *(const f32x4*)bg, bg1 = *(const f32x4*)(bg + 4), bl0 = *(const f32x4*)bl, bl1 = *(const f32x4*)(bl + 4);
#pragma unroll
        for (int ai = 0; ai < 2; ++ai)
#pragma unroll
            for (int m = 0; m < 4; ++m) { const int row = row0 + ai * HALF + m * 16;
                f32x4 g0 = acc[ai][0][m][0] + bg0, g1 = acc[ai][0][m][1] + bg1, l0 = acc[ai][1][m][0] + bl0, l1 = acc[ai][1][m][1] + bl1, r0, r1;
#pragma unroll
                for (int i = 0; i < 4; ++i) { const float a = fminf(g0[i], 7.f), b = fminf(g1[i], 7.f);
                    r0[i] = a * ep_sig(1.702f * a) * (fminf(fmaxf(l0[i], -7.f), 7.f) + 1.f); r1[i] = b * ep_sig(1.702f * b) * (fminf(fmaxf(l1[i], -7.f), 7.f) + 1.f); }
                *(u32x4*)(act + (size_t)row * 2048 + gcol) = ep_pack8(r0, r1); }
    }
};
struct EpiDown {
    static constexpr bool PERM = true, AFTER_DRAIN = false;
    bf16_t* ys; const float* bias; const float* slot_w;
    __device__ __forceinline__ void operator()(const f32x4 (&acc)[2][2][4][2], const Unit& u, int wr, int wc, int fr, int fq) const {
        const float* be = bias + (size_t)u.e * 2048;
        EPI_LOOP_BEGIN
            const float w = slot_w[row];
            const f32x4 b0 = *(const f32x4*)(be + col), b1 = *(const f32x4*)(be + col + 4);
            *(u32x4*)(ys + (size_t)row * 2048 + col) = ep_pack8((v0 + b0) * w, (v1 + b1) * w);
        EPI_LOOP_END
    }
};
struct MoeOrder : StaticOrder {
    const int* tile_e;
    __device__ bool next(int i, Unit& u) const { if (!StaticOrder::next(i, u)) return false; u.e = tile_e[u.pm]; return true; }
};
}
namespace fox {
enum { ORDER_NATURAL = 0, ORDER_REVERSED = 1, ORDER_PAIRED = 2, ORDER_XCD = 4 };
using TIN = __hip_bfloat16; using TOUT = __hip_bfloat16;
constexpr int B = 2, H = 8, HKV = 8, SQ = 16384, SKV = 16384, D = 128;
constexpr int PITCH = 1024;
constexpr int GPITCH = 11776;
constexpr int QOFF = 0;
constexpr int WINDOW = SKV;
constexpr float THR = 8.f;
constexpr int ORDER = ORDER_PAIRED;
constexpr bool WSKIP = false;
constexpr float SCALE = 0.08838834764831845f;
constexpr int NW = 8, QBLK = 32, KVBLK = 64, QB = NW * QBLK;
constexpr int SHM_V = KVBLK * D * 2, SHM_K = KVBLK * D * 2;
constexpr int LDS_CB = 2 * SHM_V + 2 * SHM_K + NW * 64 * 4;
constexpr int LDS_GATE = LDS_CB + 3 * 64 * 4 + 256;
constexpr int LDS_BYTES = LDS_GATE + NW * 8192;
static_assert(D == 128 && SQ % QB == 0 && SKV % KVBLK == 0 && H % HKV == 0 && QOFF >= 0 && QOFF + SQ <= SKV && WINDOW >= 1, "geometry");

using bf16 = __hip_bfloat16;
typedef short bf16x8 __attribute__((ext_vector_type(8)));
typedef short s16x4 __attribute__((ext_vector_type(4)));
typedef float f32x16 __attribute__((ext_vector_type(16)));
typedef float f32x4 __attribute__((ext_vector_type(4)));
typedef unsigned u32x4 __attribute__((ext_vector_type(4)));
template <class A, class Bt> struct same_t { static constexpr bool v = false; };
template <class A> struct same_t<A, A> { static constexpr bool v = true; };

#define KSWZ(row, colB) ((row) * 256 + ((colB) ^ (((row) & 7) << 4)))
#define SBAR() __builtin_amdgcn_sched_barrier(0)
__device__ __forceinline__ int v_st(int k, int c) { const int kk = (k & ~0xC) | ((k & 4) << 1) | ((k & 8) >> 1); return ((kk >> 3) * 4 + (c >> 5)) * 512 + ((kk & 7) * 32 + (c & 31)) * 2; }
__device__ __forceinline__ int v_rd_base(int lane) { return ((lane & 3) << 3) | (((lane >> 2) & 3) << 6) | (((lane >> 4) & 1) << 5) | (((lane >> 5) & 1) << 8); }
constexpr int v_rd_off(int d0, int ks, int half) { return d0 * 512 + ks * 4096 + half * 2048; }
__device__ __forceinline__ int crow(int r, int hi) { return (r & 3) + 8 * (r >> 2) + 4 * hi; }
__device__ __forceinline__ unsigned cvtpk(float lo, float hi) {
    unsigned r; asm volatile("v_cvt_pk_bf16_f32 %0, %1, %2" : "=v"(r) : "v"(lo), "v"(hi)); return r;
}
__device__ __forceinline__ bf16x8 pack8(f32x4 a, f32x4 b) {
    u32x4 w = {cvtpk(a[0], a[1]), cvtpk(a[2], a[3]), cvtpk(b[0], b[1]), cvtpk(b[2], b[3])};
    return *reinterpret_cast<bf16x8*>(&w);
}
template <class T> __device__ __forceinline__ bf16x8 load8(const T* p) {
    if constexpr (same_t<T, float>::v) { return pack8(*(const f32x4*)p, *(const f32x4*)(p + 4)); }
    else { return *reinterpret_cast<const bf16x8*>(p); }
}
__device__ __forceinline__ void mask_tile(f32x16& p0, f32x16& p1, int dq, unsigned W) {
    const float NEG = -__builtin_inff();
#pragma unroll
    for (int r = 0; r < 16; ++r) {
        const int c = (r & 3) + 8 * (r >> 2);
        if ((unsigned)(dq - c) >= W) p0[r] = NEG;
        if ((unsigned)(dq - c - 32) >= W) p1[r] = NEG;
    }
}
__device__ __forceinline__ void partialSM(f32x16& p0, f32x16& p1, float& m_reg, float& mn, float& alpha) {
    float pmax = p0[0]; for (int r = 1; r < 16; ++r) pmax = fmaxf(pmax, p0[r]); for (int r = 0; r < 16; ++r) pmax = fmaxf(pmax, p1[r]);
    { auto rr = __builtin_amdgcn_permlane32_swap(__float_as_uint(pmax), __float_as_uint(pmax), false, false);
      pmax = fmaxf(__uint_as_float(rr[0]), __uint_as_float(rr[1])); }
    constexpr float C2 = 1.4426950408889634f * SCALE;
    if (__builtin_expect(__all((pmax - m_reg) * SCALE <= THR), 1)) { mn = m_reg; alpha = 1.f; }
    else { mn = fmaxf(m_reg, pmax); alpha = __builtin_amdgcn_exp2f((m_reg - mn) * C2); m_reg = mn; }
    const float mnL = -mn * C2;
    for (int r = 0; r < 16; ++r) p0[r] = fmaf(p0[r], C2, mnL); for (int r = 0; r < 16; ++r) p1[r] = fmaf(p1[r], C2, mnL);
    for (int r = 0; r < 16; ++r) p0[r] = __builtin_amdgcn_exp2f(p0[r]);
}
__device__ __forceinline__ void finishSM(f32x16& p0, f32x16& p1, float alpha, float& l_reg, bf16x8& pa0, bf16x8& pa1, bf16x8& pa2, bf16x8& pa3) {
    for (int r = 0; r < 16; ++r) p1[r] = __builtin_amdgcn_exp2f(p1[r]);
    float ps = 0; for (int r = 0; r < 16; ++r) ps += p0[r]; for (int r = 0; r < 16; ++r) ps += p1[r];
    { auto rr = __builtin_amdgcn_permlane32_swap(__float_as_uint(ps), __float_as_uint(ps), false, false);
      ps = __uint_as_float(rr[0]) + __uint_as_float(rr[1]); }
    l_reg = l_reg * alpha + ps;
#define PK4(P, B_, OUT) do { unsigned a0 = cvtpk(P[B_+0], P[B_+1]), a1 = cvtpk(P[B_+2], P[B_+3]);                          \
        unsigned b0 = cvtpk(P[B_+4], P[B_+5]), b1 = cvtpk(P[B_+6], P[B_+7]);                                             \
        auto r0 = __builtin_amdgcn_permlane32_swap(a0, b0, false, false); auto r1 = __builtin_amdgcn_permlane32_swap(a1, b1, false, false); \
        u32x4 w = {r0[0], r1[0], r0[1], r1[1]}; OUT = *reinterpret_cast<bf16x8*>(&w); } while (0)
    PK4(p0, 0, pa0); PK4(p0, 8, pa1); PK4(p1, 0, pa2); PK4(p1, 8, pa3);
#undef PK4
}
template <int KB, bool SK>
__device__ __forceinline__ void qkt(f32x16& p0, f32x16& p1, const char* K_lds, int r32, int hi, const bf16x8* qr, bool act, int cbi) {
    if (SK && !act) { const float NEG = -__builtin_inff();
#pragma unroll
        for (int r = 0; r < 16; ++r) { p0[r] = NEG; p1[r] = NEG; } return; }
    { const float* cb_ = (const float*)(K_lds + 2 * SHM_K + NW * 64 * 4) + cbi * 64 + 4 * hi;
#pragma unroll
      for (int g_ = 0; g_ < 4; ++g_) { const f32x4 b0_ = *(const f32x4*)(cb_ + 8 * g_), b1_ = *(const f32x4*)(cb_ + 32 + 8 * g_);
#pragma unroll
          for (int i_ = 0; i_ < 4; ++i_) { p0[4 * g_ + i_] = b0_[i_]; p1[4 * g_ + i_] = b1_[i_]; } } }
    const char* kb[4];
#pragma unroll
    for (int dd = 0; dd < 4; ++dd) kb[dd] = K_lds + KB * SHM_K + KSWZ(r32, (dd * 16 + hi * 8) * 2);
#pragma unroll
    for (int d0 = 0; d0 < 8; ++d0) { const char* a = kb[d0 & 3] + (d0 >> 2) * 128;
        bf16x8 b0 = *reinterpret_cast<const bf16x8*>(a);
        bf16x8 b1 = *reinterpret_cast<const bf16x8*>(a + 32 * 256);
        p0 = __builtin_amdgcn_mfma_f32_32x32x16_bf16(b0, qr[d0], p0, 0, 0, 0);
        p1 = __builtin_amdgcn_mfma_f32_32x32x16_bf16(b1, qr[d0], p1, 0, 0, 0); }
}
template <int VB, bool SK>
__device__ __forceinline__ void pv_tile(f32x16* o, int vb0, bf16x8 pa0, bf16x8 pa1, bf16x8 pa2, bf16x8 pa3, bool act) {
    if (SK && !act) return;
#define TRRD(dst, off) asm volatile("ds_read_b64_tr_b16 %0, %1 offset:%2" : "=&v"(dst) : "v"(vb0), "i"(off) : "memory")
#define PV_D0(d0) do { s16x4 l0, l1, l2, l3, h0, h1, h2, h3; constexpr int b_ = VB * SHM_V + v_rd_off(d0, 0, 0);     \
        TRRD(l0, b_); TRRD(h0, b_ + 2048); TRRD(l1, b_ + 4096); TRRD(h1, b_ + 6144); TRRD(l2, b_ + 8192); TRRD(h2, b_ + 10240); TRRD(l3, b_ + 12288); TRRD(h3, b_ + 14336); \
        asm volatile("s_waitcnt lgkmcnt(0)" ::: "memory"); SBAR();                 \
        o[d0] = __builtin_amdgcn_mfma_f32_32x32x16_bf16(pa0, (bf16x8){l0[0], l0[1], l0[2], l0[3], h0[0], h0[1], h0[2], h0[3]}, o[d0], 0, 0, 0);   \
        o[d0] = __builtin_amdgcn_mfma_f32_32x32x16_bf16(pa1, (bf16x8){l1[0], l1[1], l1[2], l1[3], h1[0], h1[1], h1[2], h1[3]}, o[d0], 0, 0, 0);   \
        o[d0] = __builtin_amdgcn_mfma_f32_32x32x16_bf16(pa2, (bf16x8){l2[0], l2[1], l2[2], l2[3], h2[0], h2[1], h2[2], h2[3]}, o[d0], 0, 0, 0);   \
        o[d0] = __builtin_amdgcn_mfma_f32_32x32x16_bf16(pa3, (bf16x8){l3[0], l3[1], l3[2], l3[3], h3[0], h3[1], h3[2], h3[3]}, o[d0], 0, 0, 0); } while (0)
    PV_D0(0); PV_D0(1); PV_D0(2); PV_D0(3);
#undef PV_D0
#undef TRRD
}

template <class TIn, class TOut> struct BlockRef { const unsigned char* ws; int row0, bh, P0;
    __device__ __forceinline__ const TIn* Q() const { return (const TIn*)(ws + WS_FQ) + (size_t)row0 * PITCH + (bh % H) * D; }
    __device__ __forceinline__ const TIn* K() const { return (const TIn*)(ws + WS_FK) + (size_t)(bh / H) * SQ * PITCH + (bh % H) * D; }
    __device__ __forceinline__ const TIn* V() const { return (const TIn*)(ws + WS_FV) + (size_t)(bh / H) * SQ * PITCH + (bh % H) * D; }
    __device__ __forceinline__ TOut* O() const { return (TOut*)(ws + WS_YB) + (size_t)row0 * PITCH + (bh % H) * D; }
    __device__ __forceinline__ const float* C() const { return (const float*)(ws + WS_CS) + (size_t)bh * SQ; }
    __device__ __forceinline__ const TIn* G() const { return (const TIn*)(ws + WS_P) + (size_t)row0 * GPITCH + PC_OG + (bh % H) * D; }
};
template <class TIn> struct Seam {
    bf16x8 qr[8];
    bf16x8 st_v0, st_v1, st_k0, st_k1; int cbi; f32x4 sf0, sf1, sf2, sf3;
    f32x4 tq[16];
};
__device__ __forceinline__ int swa_jlo(int P0, int W) { const int lowk = P0 - W + 1; return lowk > 0 ? lowk / KVBLK : 0; }
#define ROW(p, k0, rr) ((p) + (size_t)((k0) + (rr)) * PITCH + sc)
#define VMW() asm volatile("s_waitcnt vmcnt(0)" ::: "memory")
#define VMWN(n) asm volatile("s_waitcnt vmcnt(%0)" :: "i"(n) : "memory")
#define NEXT3(x) ((x) == 2 ? 0 : (x) + 1)
#define SLOAD_H(Kp, Vp, Cp, k0, CI) do { S.st_v0 = load8<TIn>(ROW(Vp, k0, sr)); S.st_v1 = load8<TIn>(ROW(Vp, k0, 32 + sr));              \
                         S.st_k0 = load8<TIn>(ROW(Kp, k0, sr)); S.st_k1 = load8<TIn>(ROW(Kp, k0, 32 + sr));                 \
                         if (wid == 0) __builtin_amdgcn_global_load_lds((const unsigned*)((Cp) + (k0) + lane), (__attribute__((address_space(3))) unsigned*)(lds + LDS_CB + (CI) * 256), 4, 0, 0); } while (0)
#define SWRITE_HK(bf) do { *(bf16x8*)(K_lds + (bf) * SHM_K + kws) = S.st_k0; *(bf16x8*)(K_lds + (bf) * SHM_K + kws + 32 * 256) = S.st_k1; } while (0)
#define SWRITE_HV(bf) do { *(bf16x8*)(V_lds + (bf) * SHM_V + vst0) = S.st_v0; *(bf16x8*)(V_lds + (bf) * SHM_V + vst1) = S.st_v1; } while (0)
#define SWRITE_H(bf) do { SWRITE_HV(bf); SWRITE_HK(bf); } while (0)
#define SLOAD_F(p, k0) do { S.sf0 = *(const f32x4*)ROW(p, k0, sr); S.sf1 = *(const f32x4*)(ROW(p, k0, sr) + 4);                \
                            S.sf2 = *(const f32x4*)ROW(p, k0, 32 + sr); S.sf3 = *(const f32x4*)(ROW(p, k0, 32 + sr) + 4); } while (0)
#define SWRITE_KF(bf) do { *(bf16x8*)(K_lds + (bf) * SHM_K + kws) = pack8(S.sf0, S.sf1); *(bf16x8*)(K_lds + (bf) * SHM_K + kws + 32 * 256) = pack8(S.sf2, S.sf3); } while (0)
#define SWRITE_VF(bf) do { *(bf16x8*)(V_lds + (bf) * SHM_V + vst0) = pack8(S.sf0, S.sf1); *(bf16x8*)(V_lds + (bf) * SHM_V + vst1) = pack8(S.sf2, S.sf3); } while (0)
template <class TIn, class TOut>
__device__ __forceinline__ void causal_swa_prime(const BlockRef<TIn, TOut>& cur, int W, char* lds, Seam<TIn>& S, const int tid) {
    constexpr bool F32 = same_t<TIn, float>::v;
    const int wid = __builtin_amdgcn_readfirstlane(tid >> 6), lane = tid & 63, r32 = lane & 31, hi = lane >> 5;
    const int sr = tid >> 4, sc = (tid & 15) * 8, kws = KSWZ(sr, sc * 2); char* K_lds = lds + 2 * SHM_V;
    const int kb0 = swa_jlo(cur.P0, W) * KVBLK;
    for (int d0 = 0; d0 < 8; ++d0) S.qr[d0] = load8<TIn>(cur.Q() + (size_t)(wid * QBLK + r32) * PITCH + d0 * 16 + hi * 8);
    if constexpr (F32) { SLOAD_F((const float*)cur.K(), kb0); VMW(); SWRITE_KF(0); SBAR(); SLOAD_F((const float*)cur.V(), kb0); }
    else { S.cbi = 0; SLOAD_H(cur.K(), cur.V(), cur.C(), kb0, 0); VMW(); SWRITE_HK(0); }
    __syncthreads();
}
template <class TIn, class TOut>
__device__ __forceinline__ void causal_swa_block(const BlockRef<TIn, TOut>& cur, const BlockRef<TIn, TOut>& nxt, int skv, int W, char* lds, Seam<TIn>& S, const int tid) {
    constexpr bool F32 = same_t<TIn, float>::v;
    const int wid = __builtin_amdgcn_readfirstlane(tid >> 6), lane = tid & 63, r32 = lane & 31, hi = lane >> 5;
    const int j_lo = swa_jlo(cur.P0, W);
    int j_hi = (cur.P0 + QB - 1) / KVBLK + 1; if (j_hi > skv / KVBLK) j_hi = skv / KVBLK;
    const int NT = j_hi - j_lo;
    const int kbn = swa_jlo(nxt.P0, W) * KVBLK;
    const int qlo = cur.P0 + wid * QBLK, qm = qlo + r32 - 4 * hi;
    char* V_lds = lds; char* K_lds = lds + 2 * SHM_V;
    float* ws = (float*)(lds + 2 * SHM_V + 2 * SHM_K) + wid * 64; float* li_l = ws, * al_l = ws + 32;
    float m_reg = -1e30f, l_reg = 0; f32x16 o[4] = {};
    const int sr = tid >> 4, sc = (tid & 15) * 8, vst0 = v_st(sr, sc), vst1 = v_st(32 + sr, sc), kws = KSWZ(sr, sc * 2);
    const int vb0 = (int)(uintptr_t)V_lds + v_rd_base(lane);
    const TIn* Kh = cur.K(); const TIn* Vh = cur.V(); const float* Ch = cur.C(); int cb_t = S.cbi;
    {
        const TIn* gsrc = cur.G() + (size_t)(wid * QBLK + (lane >> 4)) * GPITCH + (lane & 15) * 8;
#pragma unroll
        for (int i_ = 0; i_ < 8; ++i_) __builtin_amdgcn_global_load_lds((const unsigned*)(gsrc + (size_t)(4 * i_) * GPITCH), (__attribute__((address_space(3))) unsigned*)(lds + LDS_GATE + wid * 8192 + i_ * 1024), 16, 0, 0); }
#define RESC(a) do { if (__any((a) < 1.f)) { if (hi == 0) al_l[r32] = (a); asm volatile("s_waitcnt lgkmcnt(0)" ::: "memory");              \
                     for (int d_ = 0; d_ < 4; ++d_) for (int r = 0; r < 16; ++r) o[d_][r] *= al_l[crow(r, hi)]; } } while (0)
#define KBASE(t) ((j_lo + (t)) * KVBLK)
#define ACT(t) (KBASE(t) <= qlo + QBLK - 1 && KBASE(t) + KVBLK - 1 >= qlo - W + 1)
#define MASKT(P0_, P1_, t) do { const int kb_ = KBASE(t); if ((!SK || ACT(t)) && (kb_ + KVBLK - 1 > qlo || kb_ <= qlo + QBLK - 1 - W)) mask_tile(P0_, P1_, qm - kb_, (unsigned)W); } while (0)
    constexpr int NQL = F32 ? 16 : 8;
    constexpr bool SK = WSKIP && !F32;
#define SEAM_K0() do { VMWN(NQL); if constexpr (F32) { SWRITE_KF(0); SBAR(); SLOAD_F((const float*)nxt.V(), kbn); } else { SWRITE_HK(0); } SBAR(); } while (0)
    f32x16 pA0, pA1, pB0, pB1; float mnA, mnB, alA, alB; bf16x8 pa0, pa1, pa2, pa3;
    if constexpr (F32) { VMW(); SWRITE_VF(0); SBAR(); } else { SWRITE_HV(0); SBAR(); }
    if (NT > 1) { if constexpr (F32) SLOAD_F((const float*)Kh, KBASE(1)); else SLOAD_H(Kh, Vh, Ch, KBASE(1), NEXT3(cb_t)); }
    SBAR(); qkt<0, SK>(pA0, pA1, K_lds, r32, hi, S.qr, ACT(0), cb_t);
    if constexpr (F32) { if (NT > 1) { VMW(); SWRITE_KF(1); SBAR(); SLOAD_F((const float*)Vh, KBASE(1)); } }
    MASKT(pA0, pA1, 0); partialSM(pA0, pA1, m_reg, mnA, alA);
    if (NT > 1) { VMW(); if constexpr (F32) { SWRITE_VF(1); SBAR(); if (NT > 2) SLOAD_F((const float*)Kh, KBASE(2)); } else SWRITE_H(1); }
    __syncthreads();
#define HALF_STEP(PX0, PX1, mnX, alX, PY0, PY1, alY, t, KB, VB, SB) do {                                                      \
        SBAR(); cb_t = NEXT3(cb_t); qkt<KB, SK>(PX0, PX1, K_lds, r32, hi, S.qr, ACT(t), cb_t);                                             \
        finishSM(PY0, PY1, alY, l_reg, pa0, pa1, pa2, pa3); SBAR();                                                           \
        if ((t) + 1 < NT) { if constexpr (F32) { VMW(); SWRITE_KF(SB); SBAR(); SLOAD_F((const float*)Vh, KBASE((t) + 1)); }  \
                            else { SLOAD_H(Kh, Vh, Ch, KBASE((t) + 1), NEXT3(cb_t)); } SBAR(); }                                               \
        pv_tile<VB, SK>(o, vb0, pa0, pa1, pa2, pa3, ACT((t) - 1)); MASKT(PX0, PX1, (t)); partialSM(PX0, PX1, m_reg, mnX, alX);                                        \
        __syncthreads();                                                                                                      \
        if ((t) + 1 < NT) { VMW(); if constexpr (F32) { SWRITE_VF(SB); SBAR(); if ((t) + 2 < NT) SLOAD_F((const float*)Kh, KBASE((t) + 2)); } \
                            else { SWRITE_H(SB); } }                                                                          \
        RESC(alX); __syncthreads(); } while (0)
    for (int t = 1; t + 1 < NT; t += 2) {
        HALF_STEP(pB0, pB1, mnB, alB, pA0, pA1, alA, t, 1, 0, 0);
        HALF_STEP(pA0, pA1, mnA, alA, pB0, pB1, alB, t + 1, 0, 1, 1);
    }
    const bool even = (NT & 1) == 0;
    if (even) { SBAR(); cb_t = NEXT3(cb_t); qkt<1, SK>(pB0, pB1, K_lds, r32, hi, S.qr, ACT(NT - 1), cb_t); SBAR(); }
#define QROW(e) (nxt.Q() + (size_t)(wid * QBLK + r32) * PITCH + ((e) >> 1) * 16 + hi * 8 + ((e) & 1) * 4)
    if constexpr (F32) { SLOAD_F((const float*)nxt.K(), kbn); SBAR();
#pragma unroll
        for (int e = 0; e < 8; ++e) S.tq[e] = *(const f32x4*)QROW(e); }
    else { SLOAD_H(nxt.K(), nxt.V(), nxt.C(), kbn, NEXT3(cb_t)); S.cbi = NEXT3(cb_t); SBAR();
#pragma unroll
        for (int d0 = 0; d0 < 8; ++d0) S.qr[d0] = load8<TIn>(nxt.Q() + (size_t)(wid * QBLK + r32) * PITCH + d0 * 16 + hi * 8); }
    SBAR();
    finishSM(pA0, pA1, alA, l_reg, pa0, pa1, pa2, pa3); SBAR();
    if constexpr (F32) {
#pragma unroll
        for (int e = 8; e < 16; ++e) S.tq[e] = *(const f32x4*)QROW(e); SBAR(); }
#undef QROW
    pv_tile<0, SK>(o, vb0, pa0, pa1, pa2, pa3, ACT(even ? NT - 2 : NT - 1));
    if (even) { MASKT(pB0, pB1, NT - 1); partialSM(pB0, pB1, m_reg, mnB, alB); __syncthreads(); RESC(alB);
        finishSM(pB0, pB1, alB, l_reg, pa0, pa1, pa2, pa3); SBAR(); pv_tile<1, SK>(o, vb0, pa0, pa1, pa2, pa3, ACT(NT - 1)); }
    SBAR(); SEAM_K0();
    if (hi == 0) li_l[r32] = l_reg; asm volatile("s_waitcnt lgkmcnt(0)" ::: "memory");
    float rli[16];
#pragma unroll
    for (int r = 0; r < 16; ++r) rli[r] = __builtin_amdgcn_rcpf(li_l[crow(r, hi)]);
    int hi_e = hi; asm volatile("" : "+v"(hi_e));
    TOut* Ow = cur.O() + (size_t)(wid * QBLK) * PITCH + (size_t)(4 * hi_e) * PITCH; const char* gl_ = lds + LDS_GATE + wid * 8192 + 4 * hi_e * 256;
#pragma unroll
    for (int r = 0; r < 16; ++r) { const int orow = (r & 3) + 8 * (r >> 2);
#pragma unroll
        for (int d0 = 0; d0 < 4; ++d0) { const float v = o[d0][r] * rli[r];
            if constexpr (same_t<TOut, float>::v) { Ow[(size_t)orow * PITCH + d0 * 32 + r32] = v; }
            else { const float vn = __shfl_xor(v, 1);
                   if ((r32 & 1) == 0) { const unsigned gw_ = *(const unsigned*)(gl_ + orow * 256 + (d0 * 32 + r32) * 2);
                       const float g0_ = __uint_as_float(gw_ << 16), g1_ = __uint_as_float(gw_ & 0xffff0000u);
                       const float s0_ = __builtin_amdgcn_rcpf(1.f + __builtin_amdgcn_exp2f(-1.4426950408889634f * g0_)), s1_ = __builtin_amdgcn_rcpf(1.f + __builtin_amdgcn_exp2f(-1.4426950408889634f * g1_));
                       *(unsigned*)(Ow + (size_t)orow * PITCH + d0 * 32 + r32) = cvtpk(v * s0_, vn * s1_); } } } }
    if constexpr (F32) {
#pragma unroll
        for (int d0 = 0; d0 < 8; ++d0) S.qr[d0] = pack8(S.tq[2 * d0], S.tq[2 * d0 + 1]); }
    __syncthreads();
#undef RESC
#undef KBASE
#undef ACT
#undef MASKT
#undef SEAM_K0
#undef HALF_STEP
}
#undef ROW
#undef VMW
#undef VMWN
#undef SLOAD_H
#undef SWRITE_HK
#undef SWRITE_HV
#undef SWRITE_H
#undef SLOAD_F
#undef SWRITE_KF
#undef SWRITE_VF

}
namespace rw {
typedef short bf16x8 __attribute__((ext_vector_type(8)));
typedef float f32x4 __attribute__((ext_vector_type(4)));
typedef unsigned u32x4 __attribute__((ext_vector_type(4)));
typedef unsigned u32x2 __attribute__((ext_vector_type(2)));
#define RW_LAS __attribute__((address_space(3)))
constexpr int PB = 144, PF = 272, MB = 64 * PB;
constexpr int O_R = 0, O_K = MB, O_A = 2 * MB, O_B = 3 * MB, O_BT = 4 * MB, O_KT = 5 * MB, O_VT = 6 * MB, O_AAK = 7 * MB, O_ARB = 8 * MB, O_ARK = 9 * MB;
constexpr int O_AAB = 10 * MB, O_GT = O_AAB + 64 * PF, O_GAM = O_GT + 64 * PF, O_TOT = O_GAM + 256, O_END = O_TOT + 2048;
constexpr int O_WT = O_K, O_UT = O_AAK;
static_assert(O_END <= 143360, "phase A LDS map");
constexpr int REC = 32768, REC_P = 0, REC_Q = 8192, REC_H = 16384, REC_Y = 24576;
__device__ __forceinline__ unsigned cvtpk(float lo, float hi) { unsigned r; asm volatile("v_cvt_pk_bf16_f32 %0, %1, %2" : "=v"(r) : "v"(lo), "v"(hi)); return r; }
__device__ __forceinline__ float blo(unsigned w) { return __uint_as_float(w << 16); }
__device__ __forceinline__ float bhi(unsigned w) { return __uint_as_float(w & 0xffff0000u); }
__device__ __forceinline__ bf16x8 frag(const RW_LAS unsigned char* base, int tile, int ks, int lane) { return *(const RW_LAS bf16x8*)(base + (16 * tile + (lane & 15)) * PB + (ks * 32 + 8 * (lane >> 4)) * 2); }
#define RW_MFMA(a, b, c) __builtin_amdgcn_mfma_f32_16x16x32_bf16(a, b, c, 0, 0, 0)
#define RW_SYNC() __syncthreads()
#define RW_BAR() do { asm volatile("" ::: "memory"); __builtin_amdgcn_s_barrier(); asm volatile("" ::: "memory"); } while (0)

__device__ __forceinline__ void phase_a_chunk(RW_LAS unsigned char* L, const unsigned short* Rg, const unsigned short* Kg, const unsigned short* Vg, const unsigned short* Ag, const float* Lg,
                                              const float* kkw_g, const float* kaw_g, unsigned char* rec, int tid) {
    const int lane = tid & 63, w = __builtin_amdgcn_readfirstlane(tid >> 6), g = lane >> 4, l15 = lane & 15;
    { const int tok = tid >> 3, part = tid & 7, c0 = 8 * part; const size_t off = (size_t)tok * 1024 + c0;
      const u32x4 rw_ = *(const u32x4*)(Rg + off), kw_ = *(const u32x4*)(Kg + off), vw_ = *(const u32x4*)(Vg + off), aw_ = *(const u32x4*)(Ag + off);
      const f32x4 l0 = *(const f32x4*)(Lg + off), l1 = *(const f32x4*)(Lg + off + 4);
      float lw[8] = {l0[0], l0[1], l0[2], l0[3], l1[0], l1[1], l1[2], l1[3]}, cum[8];
#pragma unroll
      for (int i = 0; i < 8; ++i) { float v = lw[i];
          float u = __shfl_up(v, 8); if (lane >= 8) v += u; u = __shfl_up(v, 16); if (lane >= 16) v += u; u = __shfl_up(v, 32); if (lane >= 32) v += u; cum[i] = v; }
      RW_LAS float* tot = (RW_LAS float*)(L + O_TOT);
      if (lane >= 56) {
#pragma unroll
          for (int i = 0; i < 8; ++i) tot[w * 64 + c0 + i] = cum[i]; }
      RW_SYNC();
#pragma unroll
      for (int ww = 0; ww < 7; ++ww) if (ww < w) { const f32x4 a0 = *(const RW_LAS f32x4*)(tot + ww * 64 + c0), a1 = *(const RW_LAS f32x4*)(tot + ww * 64 + c0 + 4);
#pragma unroll
          for (int i = 0; i < 4; ++i) { cum[i] += a0[i]; cum[4 + i] += a1[i]; } }
      float r[8] = {blo(rw_.x), bhi(rw_.x), blo(rw_.y), bhi(rw_.y), blo(rw_.z), bhi(rw_.z), blo(rw_.w), bhi(rw_.w)};
      float k[8] = {blo(kw_.x), bhi(kw_.x), blo(kw_.y), bhi(kw_.y), blo(kw_.z), bhi(kw_.z), blo(kw_.w), bhi(kw_.w)};
      float a[8] = {blo(aw_.x), bhi(aw_.x), blo(aw_.y), bhi(aw_.y), blo(aw_.z), bhi(aw_.z), blo(aw_.w), bhi(aw_.w)};
      const f32x4 kk0 = *(const f32x4*)(kkw_g + c0), kk1 = *(const f32x4*)(kkw_g + c0 + 4), ka0 = *(const f32x4*)(kaw_g + c0), ka1 = *(const f32x4*)(kaw_g + c0 + 4);
      float kk[8], ss = 0.f;
#pragma unroll
      for (int i = 0; i < 8; ++i) { kk[i] = k[i] * (i < 4 ? kk0[i] : kk1[i - 4]); ss += kk[i] * kk[i]; }
      ss += __shfl_xor(ss, 1); ss += __shfl_xor(ss, 2); ss += __shfl_xor(ss, 4);
      const float inv = 1.f / fmaxf(sqrtf(ss), 1e-12f);
      float Rt[8], Kt[8], At[8], Bt[8];
#pragma unroll
      for (int i = 0; i < 8; ++i) { const float eL = __expf(cum[i]), eLi = __expf(-cum[i]), eLx = __expf(cum[i] - lw[i]); const float kn = kk[i] * inv;
          Rt[i] = r[i] * eL; Kt[i] = k[i] * (1.f + (a[i] - 1.f) * (i < 4 ? ka0[i] : ka1[i - 4])) * eLi; At[i] = -kn * eLx; Bt[i] = kn * a[i] * eLi;
          if (tok == 63) ((RW_LAS float*)(L + O_GAM))[c0 + i] = eL; }
      u32x4 o;
      o.x = cvtpk(Rt[0], Rt[1]); o.y = cvtpk(Rt[2], Rt[3]); o.z = cvtpk(Rt[4], Rt[5]); o.w = cvtpk(Rt[6], Rt[7]); *(RW_LAS u32x4*)(L + O_R + tok * PB + c0 * 2) = o;
      o.x = cvtpk(Kt[0], Kt[1]); o.y = cvtpk(Kt[2], Kt[3]); o.z = cvtpk(Kt[4], Kt[5]); o.w = cvtpk(Kt[6], Kt[7]); *(RW_LAS u32x4*)(L + O_K + tok * PB + c0 * 2) = o;
      const u32x4 kq = o;
      o.x = cvtpk(At[0], At[1]); o.y = cvtpk(At[2], At[3]); o.z = cvtpk(At[4], At[5]); o.w = cvtpk(At[6], At[7]); *(RW_LAS u32x4*)(L + O_A + tok * PB + c0 * 2) = o;
      o.x = cvtpk(Bt[0], Bt[1]); o.y = cvtpk(Bt[2], Bt[3]); o.z = cvtpk(Bt[4], Bt[5]); o.w = cvtpk(Bt[6], Bt[7]); *(RW_LAS u32x4*)(L + O_B + tok * PB + c0 * 2) = o;
      const unsigned bq[4] = {o.x, o.y, o.z, o.w}, kq4[4] = {kq.x, kq.y, kq.z, kq.w}, vq[4] = {vw_.x, vw_.y, vw_.z, vw_.w};
#pragma unroll
      for (int i = 0; i < 8; ++i) { const int sh = (i & 1) * 16;
          *(RW_LAS unsigned short*)(L + O_BT + (c0 + i) * PB + tok * 2) = (unsigned short)(bq[i >> 1] >> sh);
          *(RW_LAS unsigned short*)(L + O_KT + (c0 + i) * PB + tok * 2) = (unsigned short)(kq4[i >> 1] >> sh);
          *(RW_LAS unsigned short*)(L + O_VT + (c0 + i) * PB + tok * 2) = (unsigned short)(vq[i >> 1] >> sh); }
    }
    RW_SYNC();
    const int t4 = w & 3, p2 = (w >> 2) * 2;
    { const bf16x8 b0 = frag(L + O_B, t4, 0, lane), b1 = frag(L + O_B, t4, 1, lane), k0 = frag(L + O_K, t4, 0, lane), k1 = frag(L + O_K, t4, 1, lane);
#pragma unroll
      for (int u = 0; u < 2; ++u) { const int nt = p2 + u, t = 16 * nt + l15, s0 = 16 * t4 + 4 * g;
          f32x4 ab = {0.f, 0.f, 0.f, 0.f}, ak = ab, rb = ab, rk = ab;
          if (t4 <= nt) { const bf16x8 a0 = frag(L + O_A, nt, 0, lane), a1 = frag(L + O_A, nt, 1, lane), r0 = frag(L + O_R, nt, 0, lane), r1 = frag(L + O_R, nt, 1, lane);
              ab = RW_MFMA(b0, a0, ab); ab = RW_MFMA(b1, a1, ab); ak = RW_MFMA(k0, a0, ak); ak = RW_MFMA(k1, a1, ak);
              rb = RW_MFMA(b0, r0, rb); rb = RW_MFMA(b1, r1, rb); rk = RW_MFMA(k0, r0, rk); rk = RW_MFMA(k1, r1, rk);
#pragma unroll
              for (int r = 0; r < 4; ++r) { const int s = s0 + r; if (!(s < t)) { ab[r] = 0.f; ak[r] = 0.f; } if (!(s <= t)) { rb[r] = 0.f; rk[r] = 0.f; } } }
          *(RW_LAS f32x4*)(L + O_AAB + t * PF + s0 * 4) = ab;
          u32x2 o; o.x = cvtpk(ak[0], ak[1]); o.y = cvtpk(ak[2], ak[3]); *(RW_LAS u32x2*)(L + O_AAK + t * PB + s0 * 2) = o;
          o.x = cvtpk(rb[0], rb[1]); o.y = cvtpk(rb[2], rb[3]); *(RW_LAS u32x2*)(L + O_ARB + t * PB + s0 * 2) = o;
          o.x = cvtpk(rk[0], rk[1]); o.y = cvtpk(rk[2], rk[3]); *(RW_LAS u32x2*)(L + O_ARK + t * PB + s0 * 2) = o; } }
    RW_SYNC();
    { const bf16x8 a0 = frag(L + O_AAK, t4, 0, lane), a1 = frag(L + O_AAK, t4, 1, lane);
#pragma unroll
      for (int u = 0; u < 2; ++u) { const int nt = p2 + u; f32x4 acc = {0.f, 0.f, 0.f, 0.f};
          acc = RW_MFMA(a0, frag(L + O_VT, nt, 0, lane), acc); acc = RW_MFMA(a1, frag(L + O_VT, nt, 1, lane), acc);
          *(RW_LAS f32x4*)(L + O_GT + (16 * nt + l15) * PF + (16 * t4 + 4 * g) * 4) = acc; } }
    RW_SYNC();
    if (tid < 128) { const int c = tid;
        const RW_LAS unsigned char* rhs = c < 64 ? (L + O_A + c * 2) : (L + O_GT + (c - 64) * PF);
        RW_LAS unsigned char* dst = c < 64 ? (L + O_WT + c * PB) : (L + O_UT + (c - 64) * PB);
        for (int b = 0; b < 4; ++b) { float z[16];
#pragma unroll
            for (int r = 0; r < 16; ++r) z[r] = c < 64 ? blo((unsigned)*(const RW_LAS unsigned short*)(rhs + (16 * b + r) * PB)) : *(const RW_LAS float*)(rhs + (16 * b + r) * 4);
            const RW_LAS unsigned char* arow = L + O_AAB + 16 * b * PF;
            for (int s4 = 0; s4 < 4 * b; ++s4) { const u32x2 xw = *(const RW_LAS u32x2*)(dst + s4 * 8); const float x0 = blo(xw.x), x1 = bhi(xw.x), x2 = blo(xw.y), x3 = bhi(xw.y);
#pragma unroll
                for (int r = 0; r < 16; ++r) { const f32x4 av = *(const RW_LAS f32x4*)(arow + r * PF + s4 * 16); z[r] += (av[0] * x0 + av[1] * x1) + (av[2] * x2 + av[3] * x3); } }
#pragma unroll
            for (int r = 1; r < 16; ++r) {
#pragma unroll
                for (int q4 = 0; q4 < (r + 3) / 4; ++q4) { const f32x4 av = *(const RW_LAS f32x4*)(arow + r * PF + (4 * b + q4) * 16);
                    if (4 * q4 + 0 < r) z[r] += av[0] * z[4 * q4 + 0]; if (4 * q4 + 1 < r) z[r] += av[1] * z[4 * q4 + 1]; if (4 * q4 + 2 < r) z[r] += av[2] * z[4 * q4 + 2]; if (4 * q4 + 3 < r) z[r] += av[3] * z[4 * q4 + 3]; } }
            u32x4 o; o.x = cvtpk(z[0], z[1]); o.y = cvtpk(z[2], z[3]); o.z = cvtpk(z[4], z[5]); o.w = cvtpk(z[6], z[7]); *(RW_LAS u32x4*)(dst + 32 * b) = o;
            o.x = cvtpk(z[8], z[9]); o.y = cvtpk(z[10], z[11]); o.z = cvtpk(z[12], z[13]); o.w = cvtpk(z[14], z[15]); *(RW_LAS u32x4*)(dst + 32 * b + 16) = o;
            asm volatile("s_waitcnt lgkmcnt(0)" ::: "memory"); } }
    RW_SYNC();
    {
      const bf16x8 rb0 = frag(L + O_ARB, t4, 0, lane), rb1 = frag(L + O_ARB, t4, 1, lane), bt0 = frag(L + O_BT, t4, 0, lane), bt1 = frag(L + O_BT, t4, 1, lane);
      const int col = 16 * t4 + l15; const float gam = ((const RW_LAS float*)(L + O_GAM))[col];
      unsigned qw[4], pw[4];
#pragma unroll
      for (int u = 0; u < 2; ++u) { const int mt = p2 + u, j0 = 16 * mt + 4 * g; const bf16x8 w0 = frag(L + O_WT, mt, 0, lane), w1 = frag(L + O_WT, mt, 1, lane);
          f32x4 q = {0.f, 0.f, 0.f, 0.f}, p = q; q = RW_MFMA(w0, rb0, q); q = RW_MFMA(w1, rb1, q); p = RW_MFMA(w0, bt0, p); p = RW_MFMA(w1, bt1, p);
          const u32x2 rr = *(const RW_LAS u32x2*)(L + O_R + col * PB + j0 * 2);
          q[0] += blo(rr.x); q[1] += bhi(rr.x); q[2] += blo(rr.y); q[3] += bhi(rr.y);
#pragma unroll
          for (int r = 0; r < 4; ++r) p[r] = (p[r] + ((j0 + r) == col ? 1.f : 0.f)) * gam;
          qw[2 * u] = cvtpk(q[0], q[1]); qw[2 * u + 1] = cvtpk(q[2], q[3]); pw[2 * u] = cvtpk(p[0], p[1]); pw[2 * u + 1] = cvtpk(p[2], p[3]); }
      const int fo = ((t4 * 2 + (p2 >> 1)) * 64 + lane) * 16;
      *(u32x4*)(rec + REC_Q + fo) = (u32x4){qw[0], qw[1], qw[2], qw[3]}; *(u32x4*)(rec + REC_P + fo) = (u32x4){pw[0], pw[1], pw[2], pw[3]}; }
    {
      const bf16x8 rb0 = frag(L + O_ARB, t4, 0, lane), rb1 = frag(L + O_ARB, t4, 1, lane), rk0 = frag(L + O_ARK, t4, 0, lane), rk1 = frag(L + O_ARK, t4, 1, lane);
      const bf16x8 ut0 = frag(L + O_UT, t4, 0, lane), ut1 = frag(L + O_UT, t4, 1, lane), vt0 = frag(L + O_VT, t4, 0, lane), vt1 = frag(L + O_VT, t4, 1, lane);
      const int col = 16 * t4 + l15;
#pragma unroll
      for (int u = 0; u < 2; ++u) { const int mt = p2 + u, m0 = 16 * mt + 4 * g;
          f32x4 y = {0.f, 0.f, 0.f, 0.f}, hm = y;
          y = RW_MFMA(frag(L + O_UT, mt, 0, lane), rb0, y); y = RW_MFMA(frag(L + O_UT, mt, 1, lane), rb1, y); y = RW_MFMA(frag(L + O_VT, mt, 0, lane), rk0, y); y = RW_MFMA(frag(L + O_VT, mt, 1, lane), rk1, y);
          hm = RW_MFMA(frag(L + O_BT, mt, 0, lane), ut0, hm); hm = RW_MFMA(frag(L + O_BT, mt, 1, lane), ut1, hm); hm = RW_MFMA(frag(L + O_KT, mt, 0, lane), vt0, hm); hm = RW_MFMA(frag(L + O_KT, mt, 1, lane), vt1, hm);
          const f32x4 gm = *(const RW_LAS f32x4*)(L + O_GAM + m0 * 4);
          u32x2 o; o.x = cvtpk(y[0], y[1]); o.y = cvtpk(y[2], y[3]); *(u32x2*)(rec + REC_Y + (col * 64 + m0) * 2) = o;
          o.x = cvtpk(hm[0] * gm[0], hm[1] * gm[1]); o.y = cvtpk(hm[2] * gm[2], hm[3] * gm[3]); *(u32x2*)(rec + REC_H + (col * 64 + m0) * 2) = o; } }
    RW_SYNC();
}

__device__ __forceinline__ void phase_b_head(RW_LAS unsigned char* L, const unsigned char* recs, float* Yg, int tid) {
    constexpr int NCH = 256, NSLOT = 4;
    const int lane = tid & 63, w = __builtin_amdgcn_readfirstlane(tid >> 6), g = lane >> 4, l15 = lane & 15;
    if (w >= 4) {
        const int lw = w - 4; const unsigned char* src = recs + lw * 8192 + lane * 16;
#define RW_ISSUE(c_) do { _Pragma("unroll") for (int k_ = 0; k_ < 8; ++k_) __builtin_amdgcn_global_load_lds((const unsigned*)(src + (size_t)(c_) * REC + k_ * 1024), (RW_LAS unsigned*)(L + ((c_) & 3) * REC + lw * 8192 + k_ * 1024), 16, 0, 0); } while (0)
        RW_ISSUE(0); RW_ISSUE(1); RW_ISSUE(2);
        asm volatile("s_waitcnt vmcnt(16)" ::: "memory");
        RW_BAR();
        for (int c = 0; c < NCH; ++c) {
            if (c + 3 < NCH) { RW_ISSUE(c + 3); asm volatile("s_waitcnt vmcnt(16)" ::: "memory"); }
            else asm volatile("s_waitcnt vmcnt(0)" ::: "memory");
            RW_BAR();
        }
#undef RW_ISSUE
    } else {
        f32x4 sacc[4];
#pragma unroll
        for (int m = 0; m < 4; ++m) sacc[m] = (f32x4){0.f, 0.f, 0.f, 0.f};
        RW_BAR();
        for (int c = 0; c < NCH; ++c) { const RW_LAS unsigned char* sl = L + (c & 3) * REC;
            bf16x8 bf[2];
#pragma unroll
            for (int s = 0; s < 2; ++s) { u32x4 v; v.x = cvtpk(sacc[2 * s][0], sacc[2 * s][1]); v.y = cvtpk(sacc[2 * s][2], sacc[2 * s][3]); v.z = cvtpk(sacc[2 * s + 1][0], sacc[2 * s + 1][1]); v.w = cvtpk(sacc[2 * s + 1][2], sacc[2 * s + 1][3]); bf[s] = __builtin_bit_cast(bf16x8, v); }
            f32x4 sn[4];
#pragma unroll
            for (int m = 0; m < 4; ++m) { const u32x2 hw = *(const RW_LAS u32x2*)(sl + REC_H + ((16 * w + l15) * 64 + 16 * m + 4 * g) * 2);
                f32x4 acc = {blo(hw.x), bhi(hw.x), blo(hw.y), bhi(hw.y)};
                acc = RW_MFMA(*(const RW_LAS bf16x8*)(sl + REC_P + ((m * 2 + 0) * 64 + lane) * 16), bf[0], acc);
                acc = RW_MFMA(*(const RW_LAS bf16x8*)(sl + REC_P + ((m * 2 + 1) * 64 + lane) * 16), bf[1], acc); sn[m] = acc; }
#pragma unroll
            for (int n = 0; n < 4; ++n) { const u32x2 yw = *(const RW_LAS u32x2*)(sl + REC_Y + ((16 * n + l15) * 64 + 16 * w + 4 * g) * 2);
                f32x4 acc = {blo(yw.x), bhi(yw.x), blo(yw.y), bhi(yw.y)};
                acc = RW_MFMA(bf[0], *(const RW_LAS bf16x8*)(sl + REC_Q + ((n * 2 + 0) * 64 + lane) * 16), acc);
                acc = RW_MFMA(bf[1], *(const RW_LAS bf16x8*)(sl + REC_Q + ((n * 2 + 1) * 64 + lane) * 16), acc);
                *(f32x4*)(Yg + (size_t)(c * 64 + 16 * n + l15) * 1024 + 16 * w + 4 * g) = acc; }
#pragma unroll
            for (int m = 0; m < 4; ++m) sacc[m] = sn[m];
            asm volatile("s_waitcnt lgkmcnt(0)" ::: "memory");
            RW_BAR();
        }
    }
}
}
#define XB_TMO      128
#define XB_XCNT(j)  (256  + 64 * (j))
#define XB_XSUB(j)  (1280 + 64 * (j))
#define XB_XGEN(j)  (2304 + 64 * (j))
#define XB_TOP      3328
#define XB_TOPGEN   3392
#define XCD_BAR_WORDS 3456
#define XB_SPIN_CAP (1u << 18)

__device__ __forceinline__ unsigned xb_ld(unsigned* p)              { return __hip_atomic_load(p, __ATOMIC_RELAXED, __HIP_MEMORY_SCOPE_AGENT); }
__device__ __forceinline__ unsigned xb_add(unsigned* p, unsigned v) { return __hip_atomic_fetch_add(p, v, __ATOMIC_RELAXED, __HIP_MEMORY_SCOPE_AGENT); }
__device__ __forceinline__ unsigned xb_xcc_id() { return (unsigned)__builtin_amdgcn_s_getreg((3 << 11) | 20) & 0xFu; }
#define XB_SPIN(cond, bar) do { unsigned _sp = 0; while (cond) { __builtin_amdgcn_s_sleep(1); \
    if ((++_sp & 255u) == 0u) { if (xb_ld(&(bar)[XB_TMO])) break; if (_sp > XB_SPIN_CAP) { atomicAdd(&(bar)[XB_TMO], 1u); break; } } } } while (0)

struct XcdBarrier {
    unsigned* bar; unsigned x;
    volatile LAS unsigned* st;
};

__device__ __forceinline__ XcdBarrier xcd_barrier_post(unsigned* bar, volatile LAS unsigned* st, const int tid) {
    XcdBarrier b; b.bar = bar; b.x = xb_xcc_id(); b.st = st;
    if (tid == 0) (void)xb_add(&bar[XB_XCNT(b.x)], 1u);
    return b;
}
__device__ __forceinline__ void xcd_barrier_complete(unsigned* bar, unsigned x, unsigned& nloc, unsigned& nx) {
    const unsigned G = gridDim.x * gridDim.y * gridDim.z;
    unsigned sum, cnt, mine, sp = 0u;
    for (;;) {
        sum = 0u; cnt = 0u; mine = 0u;
#pragma unroll
        for (unsigned j = 0; j < 16; ++j) { const unsigned c = xb_ld(&bar[XB_XCNT(j)]); sum += c; cnt += (c > 0u) ? 1u : 0u; mine = (j == x) ? c : mine; }
        if (sum == G) break;
        __builtin_amdgcn_s_sleep(1);
        if ((++sp & 255u) == 0u) { if (xb_ld(&bar[XB_TMO])) break; if (sp > XB_SPIN_CAP) { atomicAdd(&bar[XB_TMO], 1u); break; } }
    }
    nloc = mine > 0u ? mine : 1u; nx = cnt > 0u ? cnt : 1u;
}

__device__ __forceinline__ void xcd_barrier(const XcdBarrier& b, const int tid) {
    asm volatile("s_waitcnt vmcnt(0)" ::: "memory");
    __syncthreads();
    if (tid == 0) {
        unsigned* bar = b.bar;
        __builtin_amdgcn_s_waitcnt(0);
        unsigned nloc = b.st[0], nx = b.st[1];
        if (nloc == 0u) { xcd_barrier_complete(bar, b.x, nloc, nx); b.st[0] = nloc; b.st[1] = nx; }
        const unsigned old = xb_add(&bar[XB_XSUB(b.x)], 1u);
        const unsigned gen = old / nloc;
        if (old + 1u == (gen + 1u) * nloc) {
            __builtin_amdgcn_fence(__ATOMIC_RELEASE, "agent");
            asm volatile("s_waitcnt vmcnt(0)" ::: "memory");
            const unsigned og = xb_add(&bar[XB_TOP], 1u);
            const unsigned tg = og / nx;
            if (og + 1u == (tg + 1u) * nx) xb_add(&bar[XB_TOPGEN], 1u);
            else XB_SPIN(xb_ld(&bar[XB_TOPGEN]) == tg, bar);
            __builtin_amdgcn_fence(__ATOMIC_ACQUIRE, "agent");
            xb_add(&bar[XB_XGEN(b.x)], 1u);
            asm volatile("s_waitcnt vmcnt(0)" ::: "memory");
        } else {
            XB_SPIN(xb_ld(&bar[XB_XGEN(b.x)]) == gen, bar);
            __builtin_amdgcn_fence(__ATOMIC_ACQUIRE, "agent");
            asm volatile("s_waitcnt vmcnt(0)" ::: "memory");
        }
    }
    __syncthreads();
}
enum InIdx { I_X = 0, I_C, I_WADA, I_BADA, I_N1G, I_WIN, I_MU, I_WDEC, I_W0, I_WICLR, I_A0, I_WGATE, I_KK, I_KA, I_RK, I_GNG, I_GNB, I_WOA, I_BF, I_QN, I_KN, I_WOB, I_WOUT, I_N2G, I_WR, I_BR, I_WGU, I_BGU, I_WDN, I_BDN, I_NFG, N_IN };
struct Args { const float* in[N_IN]; float* out; unsigned char* ws; int ph_lo, ph_hi; };
static_assert(sizeof(Args) == (N_IN + 2) * 8 + 8, "Args has no padding");
typedef const __attribute__((address_space(4))) Args* ArgsP;
struct Frame {
    LAS unsigned char* lds;
    volatile LAS unsigned* MISC;
    gu32* ctl;
    int tid, lane, wave, G, wg;
    unsigned char* ws;
    ArgsP ap;
};
#define WSP(T_, off) ((T_*)(F.ws + (off)))

__device__ __forceinline__ int win_orig_col(int c) {
    if (c < PC_FQ) return c;
    if (c < PC_OG) return 3520 + (c - PC_FQ);
    if (c < PC_GA) return 6600 + (c - PC_OG);
    if (c < PC_GLO) return 7624 + (c - PC_GA);
    if (c < PC_DLO) return 3264 + (c - PC_GLO);
    if (c < PC_ALO) return 3072 + (c - PC_DLO);
    if (c < PC_F) return 3168 + (c - PC_ALO);
    if (c < PC_END) return 6592 + (c - PC_F);
    return -1;
}
__device__ __forceinline__ void tr_item(const float* W, int ldw, int K, bf16* WT, int drow0, int scol0, int nvalid, int k0, LAS float* scr, int lane) {
    const int n = lane & 31;
#pragma unroll 8
    for (int i = 0; i < 32; ++i) { const int kk = 2 * i + (lane >> 5); scr[kk * 33 + n] = (n < nvalid) ? W[(size_t)(k0 + kk) * ldw + scol0 + n] : 0.f; }
    LDS_WAIT(); asm volatile("" ::: "memory");
    const int c = lane & 7;
#pragma unroll
    for (int j = 0; j < 4; ++j) { const int nn = (lane >> 3) + 8 * j; const LAS float* s = scr + (8 * c) * 33 + nn;
        v4u o; o.x = pk2(s[0 * 33], s[1 * 33]); o.y = pk2(s[2 * 33], s[3 * 33]); o.z = pk2(s[4 * 33], s[5 * 33]); o.w = pk2(s[6 * 33], s[7 * 33]);
        *(GAS v4u*)(WT + (size_t)(drow0 + nn) * K + k0 + 8 * c) = o; }
    LDS_WAIT(); asm volatile("" ::: "memory");
}
__device__ __forceinline__ void p0_prologue(Frame& F) {
    LAS float* scr = (LAS float*)(F.lds + RING_OFF + F.wave * 16384);
    const int gw = F.wg * NWAVES + F.wave, NGW = F.G * NWAVES, lane = F.lane;
    constexpr int I_IN = 32 * 368, I_OA = 16 * 64, I_OB = I_OA, I_OUT = 32 * 64, I_GU = NE * 32 * 128, I_DN = NE * 32 * 64;
    constexpr int NITEMS = I_IN + I_OA + I_OB + I_OUT + I_GU + I_DN;
    for (int it = gw; it < NITEMS; it += NGW) {
        int r = it;
        if (r < I_IN) { const int kb = r / 368, gp = r % 368, c0 = gp * 32, oc = win_orig_col(c0); int nv = 32; if (oc < 0) nv = 0; else if (c0 + 32 > PC_END) nv = PC_END - c0;
            tr_item(F.ap->in[I_WIN], 11720, 2048, WSP(bf16, WS_WIN), c0, oc < 0 ? 0 : oc, nv, kb * 64, scr, lane); continue; } r -= I_IN;
        if (r < I_OA) { tr_item(F.ap->in[I_WOA], 2048, 1024, WSP(bf16, WS_WOA), (r % 64) * 32, (r % 64) * 32, 32, (r / 64) * 64, scr, lane); continue; } r -= I_OA;
        if (r < I_OB) { tr_item(F.ap->in[I_WOB], 2048, 1024, WSP(bf16, WS_WOB), (r % 64) * 32, (r % 64) * 32, 32, (r / 64) * 64, scr, lane); continue; } r -= I_OB;
        if (r < I_OUT) { tr_item(F.ap->in[I_WOUT], 2048, 2048, WSP(bf16, WS_WOUT), (r % 64) * 32, (r % 64) * 32, 32, (r / 64) * 64, scr, lane); continue; } r -= I_OUT;
        if (r < I_GU) { const int e = r / (32 * 128), q = r % (32 * 128), kb = q / 128, gp = q % 128, d0 = gp * 32;
            const int pn = d0 >> 8, j = d0 & 255, sc = j < 128 ? 128 * pn + j : 2048 + 128 * pn + (j - 128);
            tr_item(F.ap->in[I_WGU] + (size_t)e * 2048 * 4096, 4096, 2048, WSP(bf16, WS_WGU) + (size_t)e * 4096 * 2048, d0, sc, 32, kb * 64, scr, lane); continue; } r -= I_GU;
        { const int e = r / (32 * 64), q = r % (32 * 64), kb = q / 64, gp = q % 64;
            tr_item(F.ap->in[I_WDN] + (size_t)e * 2048 * 2048, 2048, 2048, WSP(bf16, WS_WDN) + (size_t)e * 2048 * 2048, gp * 32, gp * 32, 32, kb * 64, scr, lane); }
    }
    const int gt = F.wg * (NWAVES * 64) + F.tid, NGT = F.G * NWAVES * 64;
    { bf16* b1 = WSP(bf16, WS_BT1); const float* wd = F.ap->in[I_WDEC]; const float* wi = F.ap->in[I_WICLR];
      for (int i = gt; i < 2048 * 256; i += NGT) { const int n = i >> 8, k = i & 255; float v = 0.f;
          if (n < 1024) { if (k < 96) v = wd[k * 1024 + n]; } else { if (k >= 128 && k < 224) v = wi[(k - 128) * 1024 + (n - 1024)]; }
          b1[i] = (bf16)f2bf(v); } }
    { bf16* b2 = WSP(bf16, WS_BT2); const float* wg = F.ap->in[I_WGATE];
      for (int i = gt; i < 1024 * 256; i += NGT) { const int n = i >> 8, k = i & 255; b2[i] = (bf16)f2bf(wg[k * 1024 + n]); } }
    { float* wrt = WSP(float, WS_WRT); const float* wr = F.ap->in[I_WR];
      for (int i = gt; i < 32 * 2048; i += NGT) { const int e = i >> 11, k = i & 2047; wrt[i] = wr[k * 32 + e]; } }
    { bf16* h = WSP(bf16, WS_H) + (size_t)T * DM; for (int i = gt; i < DM; i += NGT) h[i] = 0; }
    if (F.wg < 192) {
        const float* wa = F.ap->in[I_WADA]; const float* cc = F.ap->in[I_C]; const int n = F.wg * 64 + lane;
        float s0 = 0.f, s1 = 0.f;
        for (int k = F.wave * 256; k < F.wave * 256 + 256; ++k) { const float w = wa[(size_t)k * 12288 + n]; const float c0 = cc[k], c1 = cc[2048 + k];
            s0 += c0 * sigmoidf_(c0) * w; s1 += c1 * sigmoidf_(c1) * w; }
        LAS float* red = (LAS float*)(F.lds + RING_OFF + 131072 - 4096);
        __syncthreads();
        red[(F.wave * 2 + 0) * 64 + lane] = s0; red[(F.wave * 2 + 1) * 64 + lane] = s1;
        __syncthreads();
        if (F.wave < 2) { float s = 0.f;
#pragma unroll
            for (int w = 0; w < 8; ++w) s += red[(w * 2 + F.wave) * 64 + lane];
            WSP(float, WS_MOD)[F.wave * 12288 + n] = s + F.ap->in[I_BADA][n]; }
    }
}
__device__ __forceinline__ void norm_mod_rows(Frame& F, const float* x, const float* g, int shift_off, int scale_off, bf16* H) {
    const int gw = F.wg * NWAVES + F.wave, NGW = F.G * NWAVES, lane = F.lane; const float* mod = WSP(float, WS_MOD);
    for (int m = gw; m < T; m += NGW) {
        const f32x4* xr = (const f32x4*)(x + (size_t)m * DM) + lane; f32x4 v[8]; float ss = 0.f;
#pragma unroll
        for (int j = 0; j < 8; ++j) { v[j] = xr[64 * j]; ss += (v[j].x * v[j].x + v[j].y * v[j].y) + (v[j].z * v[j].z + v[j].w * v[j].w); }
        const float rs = rsqrtf(wave_sum(ss) * (1.f / DM) + NORM_EPS); const float* mb = mod + (size_t)(m / SEQ) * 12288;
#pragma unroll
        for (int j = 0; j < 8; ++j) { const int c = 4 * lane + 256 * j; const f32x4 gg = *(const f32x4*)(g + c), sc = *(const f32x4*)(mb + scale_off + c), sh = *(const f32x4*)(mb + shift_off + c);
            const f32x4 y = v[j] * rs * gg * (sc + 1.f) + sh; v2u o; o.x = pk2(y.x, y.y); o.y = pk2(y.z, y.w); *(v2u*)(H + (size_t)m * DM + c) = o; }
    }
}
__device__ __forceinline__ void p3_prep(Frame& F) {
    const int gw = F.wg * NWAVES + F.wave, NGW = F.G * NWAVES, lane = F.lane;
    const bf16* P = WSP(bf16, WS_P); const float* mu = F.ap->in[I_MU];
    bf16* Rb = WSP(bf16, WS_R); bf16* LW = WSP(bf16, WS_LW); bf16* SG = WSP(bf16, WS_SG);
    for (int t = gw; t < T; t += NGW) {
        const bf16* pc = P + (size_t)t * NP; const bool first = (t % SEQ) == 0; const bf16* pp = first ? pc : pc - NP;
#pragma unroll
        for (int s = 0; s < 6; ++s) { const int c = (s * 64 + lane) * 8; float a[8], b[8], o[8]; unpack8(*(const v4u*)(pc + c), a); unpack8(*(const v4u*)(pp + c), b);
            const f32x4 m0 = *(const f32x4*)(mu + c), m1 = *(const f32x4*)(mu + c + 4);
#pragma unroll
            for (int i = 0; i < 8; ++i) { const float pv = first ? 0.f : b[i]; const float mm = i < 4 ? m0[i] : m1[i - 4]; o[i] = a[i] + mm * (pv - a[i]); }
            *(v4u*)(Rb + (size_t)(c >> 10) * ((WS_K - WS_R) / 2) + (size_t)t * RW + (c & 1023)) = pack8f(o); }
        { int c, mi; if (lane < 32) { c = PC_GLO + 8 * lane; mi = 3264 + 8 * lane; } else if (lane < 44) { c = PC_DLO + 8 * (lane - 32); mi = 3072 + 8 * (lane - 32); } else { c = PC_ALO + 8 * (lane - 44); mi = 3168 + 8 * (lane - 44); }
          float o[8] = {0.f, 0.f, 0.f, 0.f, 0.f, 0.f, 0.f, 0.f};
          if (lane < 56) { float a[8], b[8]; unpack8(*(const v4u*)(pc + c), a); unpack8(*(const v4u*)(pp + c), b);
              const f32x4 m0 = *(const f32x4*)(mu + mi), m1 = *(const f32x4*)(mu + mi + 4);
#pragma unroll
              for (int i = 0; i < 8; ++i) { const float pv = first ? 0.f : b[i]; const float mm = i < 4 ? m0[i] : m1[i - 4]; const float v = a[i] + mm * (pv - a[i]);
                  o[i] = lane < 32 ? sigmoidf_(v) : (lane < 44 ? tanhf(v) : v); } }
          bf16* dst; if (lane < 32) dst = SG + (size_t)t * 256 + 8 * lane; else if (lane < 44) dst = LW + (size_t)t * 256 + 8 * (lane - 32); else if (lane < 56) dst = LW + (size_t)t * 256 + 128 + 8 * (lane - 44);
          else if (lane < 60) dst = LW + (size_t)t * 256 + 96 + 8 * (lane - 56); else dst = LW + (size_t)t * 256 + 224 + 8 * (lane - 60);
          *(v4u*)dst = pack8f(o); }
#pragma unroll
        for (int s = 0; s < 2; ++s) { const int ch = s * 64 + lane, d0 = (ch & 15) * 8;
#pragma unroll
            for (int qk = 0; qk < 2; ++qk) { float a[8]; unpack8(*(const v4u*)(pc + (qk ? PC_FK : PC_FQ) + ch * 8), a); float ss = 0.f;
#pragma unroll
                for (int i = 0; i < 8; ++i) ss += a[i] * a[i];
                ss += __shfl_xor(ss, 1); ss += __shfl_xor(ss, 2); ss += __shfl_xor(ss, 4); ss += __shfl_xor(ss, 8);
                const float rs = rsqrtf(ss * (1.f / 128.f) + NORM_EPS); const float* gn = F.ap->in[qk ? I_KN : I_QN] + d0;
                const f32x4 g0 = *(const f32x4*)gn, g1 = *(const f32x4*)(gn + 4);
#pragma unroll
                for (int i = 0; i < 8; ++i) a[i] = a[i] * rs * (i < 4 ? g0[i] : g1[i - 4]);
                *(v4u*)(WSP(bf16, qk ? WS_FK : WS_FQ) + (size_t)t * FW + ch * 8) = pack8f(a); }
            *(v4u*)(WSP(bf16, WS_FV) + (size_t)t * FW + ch * 8) = *(const v4u*)(pc + PC_FV + ch * 8); }
        if (lane < 8) { const float xv = bflo((unsigned)pc[PC_F + lane]) + F.ap->in[I_BF][lane];
            WSP(float, WS_LF)[(size_t)t * 8 + lane] = fminf(xv, 0.f) - log1pf(__expf(-fabsf(xv))); }
    }
}
__device__ __forceinline__ void p4_cumsum(Frame& F) {
    if (F.wg >= 16) return;
    const int b = F.wg >> 3, h = F.wg & 7; const float* lf = WSP(float, WS_LF) + (size_t)b * SEQ * 8 + h; float* cs = WSP(float, WS_CS) + (size_t)F.wg * SEQ;
    LAS float* part = (LAS float*)(F.lds + RING_OFF);
    const int t0 = F.tid * 32; float s = 0.f;
    for (int i = 0; i < 32; ++i) s += lf[(size_t)(t0 + i) * 8];
    part[F.tid] = s; __syncthreads();
    if (F.tid == 0) { float run = 0.f; for (int i = 0; i < 512; ++i) { const float v = part[i]; part[i] = run; run += v; } }
    __syncthreads();
    float run = part[F.tid];
    for (int i = 0; i < 32; ++i) { run += lf[(size_t)(t0 + i) * 8]; cs[t0 + i] = -run * 11.313708498984761f; }
    __syncthreads();
}
__device__ __forceinline__ void p5_scan_naive(Frame& F) {
    constexpr int CH = 64;
    LAS float* Wl = (LAS float*)(F.lds + RING_OFF); LAS float* Al = Wl + CH * 64; LAS float* Bl = Al + CH * 64; LAS float* Kl = Bl + CH * 64; LAS float* Rl = Kl + CH * 64; LAS float* Vl = Rl + CH * 64; LAS float* Yl = Vl + CH * 64;
    const int tid = F.tid, row = tid >> 3, q = tid & 7;
    for (int bh = F.wg; bh < 32; bh += F.G) {
        const int b = bh >> 4, h = bh & 15; const size_t base = (size_t)b * SEQ * RW + h * 64;
        const bf16* Rg = WSP(bf16, WS_R) + base; const bf16* Kg = WSP(bf16, WS_K) + base; const bf16* Vg = WSP(bf16, WS_V) + base; const bf16* Ag = WSP(bf16, WS_A) + base;
        const float* Lg = WSP(float, WS_LOGW) + base; float* Yg = WSP(float, WS_YRAW) + base;
        float kkw[8], kaw[8];
#pragma unroll
        for (int i = 0; i < 8; ++i) { kkw[i] = F.ap->in[I_KK][h * 64 + 8 * q + i]; kaw[i] = F.ap->in[I_KA][h * 64 + 8 * q + i]; }
        float S[8] = {0.f, 0.f, 0.f, 0.f, 0.f, 0.f, 0.f, 0.f};
        for (int t0 = 0; t0 < SEQ; t0 += CH) {
            { const size_t off = (size_t)(t0 + row) * RW + 8 * q; float r[8], k[8], v[8], a[8];
              unpack8(*(const v4u*)(Rg + off), r); unpack8(*(const v4u*)(Kg + off), k); unpack8(*(const v4u*)(Vg + off), v); unpack8(*(const v4u*)(Ag + off), a);
              const f32x4 l0 = *(const f32x4*)(Lg + off), l1 = *(const f32x4*)(Lg + off + 4);
              float kk[8], ss = 0.f;
#pragma unroll
              for (int i = 0; i < 8; ++i) { kk[i] = k[i] * kkw[i]; ss += kk[i] * kk[i]; }
              ss += __shfl_xor(ss, 1); ss += __shfl_xor(ss, 2); ss += __shfl_xor(ss, 4);
              const float inv = 1.f / fmaxf(sqrtf(ss), 1e-12f);
#pragma unroll
              for (int i = 0; i < 8; ++i) { const int o = row * 64 + 8 * q + i; kk[i] *= inv;
                  Wl[o] = __expf(i < 4 ? l0[i] : l1[i - 4]); Al[o] = -kk[i]; Bl[o] = kk[i] * a[i]; Kl[o] = k[i] * (1.f + (a[i] - 1.f) * kaw[i]); Rl[o] = r[i]; Vl[o] = v[i]; } }
            __syncthreads();
            for (int t = 0; t < CH; ++t) { const int o = t * 64 + 8 * q; float sa = 0.f;
                const f32x4 a0 = *(const LAS f32x4*)(Al + o), a1 = *(const LAS f32x4*)(Al + o + 4), w0 = *(const LAS f32x4*)(Wl + o), w1 = *(const LAS f32x4*)(Wl + o + 4);
                const f32x4 b0 = *(const LAS f32x4*)(Bl + o), b1 = *(const LAS f32x4*)(Bl + o + 4), k0 = *(const LAS f32x4*)(Kl + o), k1 = *(const LAS f32x4*)(Kl + o + 4);
                const f32x4 r0 = *(const LAS f32x4*)(Rl + o), r1 = *(const LAS f32x4*)(Rl + o + 4); const float vv = Vl[t * 64 + row];
#pragma unroll
                for (int i = 0; i < 8; ++i) sa += S[i] * (i < 4 ? a0[i] : a1[i - 4]);
                sa += __shfl_xor(sa, 1); sa += __shfl_xor(sa, 2); sa += __shfl_xor(sa, 4);
                float y = 0.f;
#pragma unroll
                for (int i = 0; i < 8; ++i) { S[i] = S[i] * (i < 4 ? w0[i] : w1[i - 4]) + sa * (i < 4 ? b0[i] : b1[i - 4]) + vv * (i < 4 ? k0[i] : k1[i - 4]); y += S[i] * (i < 4 ? r0[i] : r1[i - 4]); }
                y += __shfl_xor(y, 1); y += __shfl_xor(y, 2); y += __shfl_xor(y, 4);
                if (q == 0) Yl[t * 64 + row] = y; }
            __syncthreads();
            { const int tt = tid >> 3, c = (tid & 7) * 8; *(f32x4*)(Yg + (size_t)(t0 + tt) * RW + c) = *(const LAS f32x4*)(Yl + tt * 64 + c); *(f32x4*)(Yg + (size_t)(t0 + tt) * RW + c + 4) = *(const LAS f32x4*)(Yl + tt * 64 + c + 4); }
        }
        __syncthreads();
    }
}
__device__ __forceinline__ void p7_post(Frame& F) {
    const int gw = F.wg * NWAVES + F.wave, NGW = F.G * NWAVES, lane = F.lane, c0 = 16 * lane;
    for (int t = gw; t < T; t += NGW) { const size_t off = (size_t)t * RW + c0;
        float y[16], r[16], k[16], v[16], a[16], g[16];
#pragma unroll
        for (int j = 0; j < 4; ++j) { const f32x4 yy = *(const f32x4*)(WSP(float, WS_YRAW) + off + 4 * j); y[4 * j] = yy.x; y[4 * j + 1] = yy.y; y[4 * j + 2] = yy.z; y[4 * j + 3] = yy.w; }
#pragma unroll
        for (int j = 0; j < 2; ++j) { float tmp[8];
            unpack8(*(const v4u*)(WSP(bf16, WS_R) + off + 8 * j), tmp); for (int i = 0; i < 8; ++i) r[8 * j + i] = tmp[i];
            unpack8(*(const v4u*)(WSP(bf16, WS_K) + off + 8 * j), tmp); for (int i = 0; i < 8; ++i) k[8 * j + i] = tmp[i];
            unpack8(*(const v4u*)(WSP(bf16, WS_V) + off + 8 * j), tmp); for (int i = 0; i < 8; ++i) v[8 * j + i] = tmp[i];
            unpack8(*(const v4u*)(WSP(bf16, WS_A) + off + 8 * j), tmp); for (int i = 0; i < 8; ++i) a[8 * j + i] = tmp[i];
            unpack8(*(const v4u*)(WSP(bf16, WS_G) + off + 8 * j), tmp); for (int i = 0; i < 8; ++i) g[8 * j + i] = tmp[i]; }
        float s = 0.f, bs = 0.f;
#pragma unroll
        for (int i = 0; i < 16; ++i) { s += y[i]; const float kp = k[i] * (1.f + (a[i] - 1.f) * F.ap->in[I_KA][c0 + i]); bs += r[i] * kp * F.ap->in[I_RK][c0 + i]; }
        s += __shfl_xor(s, 1); s += __shfl_xor(s, 2); bs += __shfl_xor(bs, 1); bs += __shfl_xor(bs, 2);
        const float mean = s * (1.f / 64.f); float q = 0.f;
#pragma unroll
        for (int i = 0; i < 16; ++i) { const float d = y[i] - mean; q += d * d; }
        q += __shfl_xor(q, 1); q += __shfl_xor(q, 2);
        const float rstd = rsqrtf(q * (1.f / 64.f) + GN_EPS); float o[16];
#pragma unroll
        for (int i = 0; i < 16; ++i) o[i] = ((y[i] - mean) * rstd * F.ap->in[I_GNG][c0 + i] + F.ap->in[I_GNB][c0 + i] + bs * v[i]) * g[i];
#pragma unroll
        for (int j = 0; j < 2; ++j) { v4u w; w.x = pk2(o[8 * j], o[8 * j + 1]); w.y = pk2(o[8 * j + 2], o[8 * j + 3]); w.z = pk2(o[8 * j + 4], o[8 * j + 5]); w.w = pk2(o[8 * j + 6], o[8 * j + 7]); *(v4u*)(WSP(bf16, WS_YA) + off + 8 * j) = w; }
    }
}
__device__ __forceinline__ fox::BlockRef<fox::bf16, fox::bf16> fox_ref(int L_, int pass_, const unsigned char* ws) {
    constexpr int NQB = fox::SQ / fox::QB, NX = NQB / 2;
    const int bh = L_ / NX, x = L_ % NX, qb = pass_ ? (NQB - 1 - x) : x;
    fox::BlockRef<fox::bf16, fox::bf16> r; r.ws = ws; r.row0 = (bh / fox::H) * fox::SQ + qb * fox::QB; r.bh = bh; r.P0 = qb * fox::QB; return r;
}
__device__ __forceinline__ void p6_attention(Frame& F, char* lds) {
    constexpr int NQB = fox::SQ / fox::QB, NX = NQB / 2, TOTAL = NX * fox::B * fox::H;
    const int stride = F.G; int L = F.wg; if (L >= TOTAL) return;
    int pass = 0;
    fox::BlockRef<fox::bf16, fox::bf16> cur = fox_ref(L, 0, F.ws);
    fox::Seam<fox::bf16> S;
    fox::causal_swa_prime<fox::bf16, fox::bf16>(cur, fox::WINDOW, lds, S, F.tid);
    for (;;) {
        const bool more_pass = pass == 0, more_item = L + stride < TOTAL, last = !more_pass && !more_item;
        int passn = pass + 1, Ln = L;
        if (!more_pass) { passn = 0; Ln = more_item ? L + stride : L; }
        const fox::BlockRef<fox::bf16, fox::bf16> nxt = last ? cur : fox_ref(Ln, passn, F.ws);
        fox::causal_swa_block<fox::bf16, fox::bf16>(cur, nxt, fox::SKV, fox::WINDOW, lds, S, F.tid);
        if (last) break;
        cur = nxt; pass = passn; L = Ln;
    }
}
typedef float f32x4m __attribute__((ext_vector_type(4)));
__device__ __forceinline__ void p11_router(Frame& F) {
    constexpr int TPW = T / 256 / NWAVES;
    const int lane = F.lane, t0 = (F.wg * NWAVES + F.wave) * TPW;
    const float* x1 = WSP(float, WS_X1); const float* mod = WSP(float, WS_MOD) + (size_t)(t0 / SEQ) * 12288; const float* g2 = F.ap->in[I_N2G]; bf16* H = WSP(bf16, WS_H);
    LAS float* lg = (LAS float*)(F.lds + RING_OFF + F.wave * 4096);
    LAS int* cnt = (LAS int*)(F.lds + RING_OFF + 65536);
    if (F.tid < 32) cnt[F.tid] = 0;
    __syncthreads();
    for (int i = 0; i < TPW; ++i) { const int m = t0 + i;
        const f32x4* xr = (const f32x4*)(x1 + (size_t)m * DM) + lane; f32x4 v[8]; float ss = 0.f;
#pragma unroll
        for (int j = 0; j < 8; ++j) { v[j] = xr[64 * j]; ss += (v[j].x * v[j].x + v[j].y * v[j].y) + (v[j].z * v[j].z + v[j].w * v[j].w); }
        const float rs = rsqrtf(wave_sum(ss) * (1.f / DM) + NORM_EPS);
        if (lane == 0) lg[512 + i] = rs;
#pragma unroll
        for (int j = 0; j < 8; ++j) { const int c = 4 * lane + 256 * j; const f32x4 gg = *(const f32x4*)(g2 + c), sc = *(const f32x4*)(mod + 4 * 2048 + c), sh = *(const f32x4*)(mod + 3 * 2048 + c);
            const f32x4 y = v[j] * rs * gg * (sc + 1.f) + sh; v2u o; o.x = pk2(y.x, y.y); o.y = pk2(y.z, y.w); *(v2u*)(H + (size_t)m * DM + c) = o; }
    }
    LDS_WAIT();
    { const int i = lane & 15, q = lane >> 4; const float rs = lg[512 + i]; const float* xr = x1 + (size_t)(t0 + i) * DM + 4 * q; const float* wr = WSP(float, WS_WRT) + (size_t)i * DM + 4 * q;
      f32x4m acc0 = {0.f, 0.f, 0.f, 0.f}, acc1 = {0.f, 0.f, 0.f, 0.f};
#pragma unroll 4
      for (int Sx = 0; Sx < DM / 16; ++Sx) { const int k = 16 * Sx;
          const f32x4 xv = *(const f32x4*)(xr + k), gg = *(const f32x4*)(g2 + k + 4 * q), sc = *(const f32x4*)(mod + 4 * 2048 + k + 4 * q), sh = *(const f32x4*)(mod + 3 * 2048 + k + 4 * q);
          const f32x4 hv = xv * rs * gg * (sc + 1.f) + sh; const f32x4 w0 = *(const f32x4*)(wr + k), w1 = *(const f32x4*)(wr + 16 * DM + k);
#pragma unroll
          for (int jj = 0; jj < 4; ++jj) { acc0 = __builtin_amdgcn_mfma_f32_16x16x4f32(hv[jj], w0[jj], acc0, 0, 0, 0); acc1 = __builtin_amdgcn_mfma_f32_16x16x4f32(hv[jj], w1[jj], acc1, 0, 0, 0); } }
      const float b0 = F.ap->in[I_BR][i], b1 = F.ap->in[I_BR][16 + i];
#pragma unroll
      for (int r = 0; r < 4; ++r) { lg[(4 * q + r) * 32 + i] = acc0[r] + b0; lg[(4 * q + r) * 32 + 16 + i] = acc1[r] + b1; } }
    LDS_WAIT();
    if (lane < 16) { const int m = t0 + lane; float v[4]; int e[4]; unsigned used = 0u;
#pragma unroll
        for (int k = 0; k < 4; ++k) { float best = -3.0e38f; int bi = 0;
            for (int j = 0; j < 32; ++j) { const float x = lg[lane * 32 + j]; if (!((used >> j) & 1u) && x > best) { best = x; bi = j; } }
            used |= 1u << bi; v[k] = best; e[k] = bi; }
        const float e1 = __expf(v[1] - v[0]), e2 = __expf(v[2] - v[0]), e3 = __expf(v[3] - v[0]), inv = 1.f / (1.f + e1 + e2 + e3);
        *(f32x4*)(WSP(float, WS_TOKW) + (size_t)m * 4) = (f32x4){inv, e1 * inv, e2 * inv, e3 * inv};
        int* te = WSP(int, WS_TOKE) + (size_t)m * 4; te[0] = e[0]; te[1] = e[1]; te[2] = e[2]; te[3] = e[3];
#pragma unroll
        for (int k = 0; k < 4; ++k) __hip_atomic_fetch_add(cnt + e[k], 1, __ATOMIC_RELAXED, __HIP_MEMORY_SCOPE_WORKGROUP); }
    __syncthreads();
    if (F.tid < 32) WSP(int, WS_WGCNT)[F.wg * 32 + F.tid] = cnt[F.tid];
    __syncthreads();
}
__device__ __forceinline__ void p12_slots(Frame& F) {
    constexpr int TPG = T / 256;
    LAS int* cur = (LAS int*)(F.lds + RING_OFF); LAS int* tot = cur + 32; LAS int* pre = cur + 64; LAS int* off = cur + 96; LAS int* slotl = cur + 160;
    const int* wgcnt = WSP(int, WS_WGCNT);
    if (F.tid < 32) { int tt = 0, pp = 0; for (int w = 0; w < 256; ++w) { const int c = wgcnt[w * 32 + F.tid]; if (w < F.wg) pp += c; tt += c; } tot[F.tid] = tt; pre[F.tid] = pp; }
    __syncthreads();
    if (F.tid == 0) { int o = 0; for (int e = 0; e < 32; ++e) { off[e] = o; o += (tot[e] + 255) & ~255; } off[32] = o; }
    __syncthreads();
    if (F.tid < 32) cur[F.tid] = off[F.tid] + pre[F.tid];
    if (F.wg == 0) { int* te = WSP(int, WS_TILEE); const int nt = off[32] >> 8;
        for (int p = F.tid; p < nt; p += NWAVES * 64) { int e = 0; for (int j = 1; j < 32; ++j) if ((p << 8) >= off[j]) e = j; te[p] = e; }
        if (F.tid == 0) te[1024] = nt; }
    __syncthreads();
    { const int t = F.wg * TPG + (F.tid >> 2), k = F.tid & 3; const int e = WSP(int, WS_TOKE)[(size_t)t * 4 + k];
      const int s = __hip_atomic_fetch_add(cur + e, 1, __ATOMIC_RELAXED, __HIP_MEMORY_SCOPE_WORKGROUP);
      slotl[F.tid] = s; WSP(int, WS_TOKS)[(size_t)t * 4 + k] = s; WSP(float, WS_SLOTW)[s] = WSP(float, WS_TOKW)[(size_t)t * 4 + k]; }
    __syncthreads();
    const bf16* H = WSP(bf16, WS_H); bf16* HS = WSP(bf16, WS_HS);
    for (int i = 0; i < TPG / NWAVES; ++i) { const int tl = F.wave * (TPG / NWAVES) + i, t = F.wg * TPG + tl; v4u v[4];
#pragma unroll
        for (int j = 0; j < 4; ++j) v[j] = *(const v4u*)(H + (size_t)t * DM + 8 * (F.lane + 64 * j));
#pragma unroll
        for (int k = 0; k < 4; ++k) { const int s = slotl[tl * 4 + k];
#pragma unroll
            for (int j = 0; j < 4; ++j) *(v4u*)(HS + (size_t)s * DM + 8 * (F.lane + 64 * j)) = v[j]; } }
    __syncthreads();
}
__device__ __forceinline__ void p15_final(Frame& F) {
    const int gw = F.wg * NWAVES + F.wave, NGW = F.G * NWAVES, lane = F.lane;
    const float* x1 = WSP(float, WS_X1); const bf16* YS = WSP(bf16, WS_HS); const float* gf = F.ap->in[I_NFG];
    for (int m = gw; m < T; m += NGW) { const float* gt = WSP(float, WS_MOD) + (size_t)(m / SEQ) * 12288 + 5 * 2048;
        const int4 sl = *(const int4*)(WSP(int, WS_TOKS) + (size_t)m * 4); float v[4][8]; float ss = 0.f;
#pragma unroll
        for (int j = 0; j < 4; ++j) { const int c = 8 * (lane + 64 * j); float y[8] = {0.f, 0.f, 0.f, 0.f, 0.f, 0.f, 0.f, 0.f}, tmp[8];
            unpack8(*(const v4u*)(YS + (size_t)sl.x * DM + c), tmp); for (int i = 0; i < 8; ++i) y[i] += tmp[i];
            unpack8(*(const v4u*)(YS + (size_t)sl.y * DM + c), tmp); for (int i = 0; i < 8; ++i) y[i] += tmp[i];
            unpack8(*(const v4u*)(YS + (size_t)sl.z * DM + c), tmp); for (int i = 0; i < 8; ++i) y[i] += tmp[i];
            unpack8(*(const v4u*)(YS + (size_t)sl.w * DM + c), tmp); for (int i = 0; i < 8; ++i) y[i] += tmp[i];
            const f32x4 xa = *(const f32x4*)(x1 + (size_t)m * DM + c), xb = *(const f32x4*)(x1 + (size_t)m * DM + c + 4), ga = *(const f32x4*)(gt + c), gb = *(const f32x4*)(gt + c + 4);
#pragma unroll
            for (int i = 0; i < 8; ++i) { const float xv = (i < 4 ? xa[i] : xb[i - 4]) + (i < 4 ? ga[i] : gb[i - 4]) * y[i]; v[j][i] = xv; ss += xv * xv; } }
        const float rs = rsqrtf(wave_sum(ss) * (1.f / DM) + NORM_EPS);
#pragma unroll
        for (int j = 0; j < 4; ++j) { const int c = 8 * (lane + 64 * j); const f32x4 ga = *(const f32x4*)(gf + c), gb = *(const f32x4*)(gf + c + 4);
            *(f32x4*)(F.ap->out + (size_t)m * DM + c) = (f32x4){v[j][0] * rs * ga[0], v[j][1] * rs * ga[1], v[j][2] * rs * ga[2], v[j][3] * rs * ga[3]};
            *(f32x4*)(F.ap->out + (size_t)m * DM + c + 4) = (f32x4){v[j][4] * rs * gb[0], v[j][5] * rs * gb[1], v[j][6] * rs * gb[2], v[j][7] * rs * gb[3]}; }
    }
}

__device__ __forceinline__ bool fresh(Frame& F) {
    asm volatile("" : "+s"(F.ap)); int w = F.wave; asm volatile("" : "+s"(w)); const int l = __builtin_amdgcn_mbcnt_hi(~0u, __builtin_amdgcn_mbcnt_lo(~0u, 0u)); F.lane = l; F.tid = w * 64 + l; return true; }
constexpr int N_PHASES = 18;
__global__ void __launch_bounds__(NWAVES * 64, 2) mk_fwd(Args args) {
    extern __shared__ __attribute__((aligned(16))) unsigned char lds[];
    Frame F;
    F.lds = (LAS unsigned char*)lds; F.MISC = (volatile LAS unsigned*)(F.lds + MISC_OFF);
    F.tid = threadIdx.x; F.lane = F.tid & 63; F.wave = __builtin_amdgcn_readfirstlane(F.tid >> 6); F.G = gridDim.x; F.wg = blockIdx.x;
    F.ap = (ArgsP)__builtin_amdgcn_kernarg_segment_ptr(); F.ws = F.ap->ws; F.ctl = (gu32*)(F.ws + WS_CTL);
    for (int u = F.tid; u < (LDS_BYTES - LDSCTL_OFF) / 4; u += NWAVES * 64) ((LAS unsigned*)(F.lds + LDSCTL_OFF))[u] = 0u;
    __syncthreads();
    const int lo = F.ap->ph_lo, hi = F.ap->ph_hi;
    XcdBarrier bar; bar.bar = (unsigned*)(F.ctl + CW_BAR); bar.x = 0; bar.st = nullptr;
    if (hi - lo > 1) bar = xcd_barrier_post((unsigned*)(F.ctl + CW_BAR), F.MISC + 8, F.tid);
#ifndef PH_MASK
#define PH_MASK 0x3ffff
#endif
#define IN(k) (((PH_MASK >> (k)) & 1) && lo <= (k) && (k) < hi && fresh(F))
#define SEAM(k) do { if (IN(k) && IN((k) + 1)) xcd_barrier(bar, F.tid); } while (0)
    if (IN(0)) { p0_prologue(F); } SEAM(0);
    if (IN(1)) { norm_mod_rows(F, F.ap->in[I_X], F.ap->in[I_N1G], 0, 2048, WSP(bf16, WS_H)); } SEAM(1);
    if (IN(2)) { pg8::Gemm g{WSP(bf16, WS_H), WSP(bf16, WS_WIN), T, NP, DM}; pg8::StaticOrder S; S.init(T, NP, F.G, F.wg);
        pg8::EpiBf16<0> E{WSP(bf16, WS_P), NP, nullptr, 0, 0, 1.f}; pg8::gemm_phase<pg8::EpiBf16<0>, pg8::StaticOrder, true, true>(F.lds + RING_OFF, g, S, E, F.tid); } SEAM(2);
    if (IN(3)) { p3_prep(F); } SEAM(3);
    if (IN(4)) { p4_cumsum(F);
        { pg8::Gemm g{WSP(bf16, WS_LW), WSP(bf16, WS_BT1), T, 2048, 256}; pg8::StaticOrder S; S.init(T, 2048, F.G, F.wg);
          pg8::EpiLora1 E{WSP(float, WS_LOGW), WSP(bf16, WS_A), F.ap->in[I_W0], F.ap->in[I_A0]}; pg8::gemm_phase<pg8::EpiLora1, pg8::StaticOrder, true, true>(F.lds + RING_OFF, g, S, E, F.tid); }
        } SEAM(4);
    if (IN(5)) {
        { pg8::Gemm g{WSP(bf16, WS_SG), WSP(bf16, WS_BT2), T, 1024, 256}; pg8::StaticOrder S; S.init(T, 1024, F.G, F.wg);
          pg8::EpiBf16<0> E{WSP(bf16, WS_G), 1024, nullptr, 0, 0, 1.f}; pg8::gemm_phase<pg8::EpiBf16<0>, pg8::StaticOrder, true, true>(F.lds + RING_OFF, g, S, E, F.tid); }
        } SEAM(5);
    if (IN(6)) {
#if RWKV_NAIVE
        p5_scan_naive(F);
#else
        for (int it = F.wg; it < 32 * 256; it += F.G) { const int bh = it >> 8, c = it & 255, b = bh >> 4, h = bh & 15; const size_t base = ((size_t)b * SEQ + (size_t)c * 64) * RW + h * 64;
            rw::phase_a_chunk(F.lds + RING_OFF, WSP(bf16, WS_R) + base, WSP(bf16, WS_K) + base, WSP(bf16, WS_V) + base, WSP(bf16, WS_A) + base, WSP(float, WS_LOGW) + base,
                              F.ap->in[I_KK] + h * 64, F.ap->in[I_KA] + h * 64, F.ws + WS_REC + (size_t)it * rw::REC, F.tid); }
#endif
        } SEAM(6);
    if (IN(7)) {
#if !RWKV_NAIVE
        for (int bh = F.wg; bh < 32; bh += F.G) { const int b = bh >> 4, h = bh & 15;
            rw::phase_b_head(F.lds + RING_OFF, F.ws + WS_REC + (size_t)bh * 256 * rw::REC, WSP(float, WS_YRAW) + (size_t)b * SEQ * RW + h * 64, F.tid); __syncthreads(); }
#endif
        } SEAM(7);
    if (IN(8)) { p6_attention(F, (char*)lds + RING_OFF); } SEAM(8);
    if (IN(9)) { p7_post(F); } SEAM(9);
    if (IN(10)) { pg8::Gemm g{WSP(bf16, WS_YA), WSP(bf16, WS_WOA), T, DM, 1024}; pg8::StaticOrder S; S.init(T, DM, F.G, F.wg);
        pg8::EpiGateMerge<0> E{WSP(bf16, WS_MRG), WSP(bf16, WS_P), PC_GA}; pg8::gemm_phase<pg8::EpiGateMerge<0>, pg8::StaticOrder, true, true>(F.lds + RING_OFF, g, S, E, F.tid); } SEAM(10);
    if (IN(11)) { pg8::Gemm g{WSP(bf16, WS_YB), WSP(bf16, WS_WOB), T, DM, 1024}; pg8::StaticOrder S; S.init(T, DM, F.G, F.wg);
        pg8::EpiGateMerge<1> E{WSP(bf16, WS_MRG), WSP(bf16, WS_P), PC_GB}; pg8::gemm_phase<pg8::EpiGateMerge<1>, pg8::StaticOrder, true, true>(F.lds + RING_OFF, g, S, E, F.tid); } SEAM(11);
    if (IN(12)) { pg8::Gemm g{WSP(bf16, WS_MRG), WSP(bf16, WS_WOUT), T, DM, DM}; pg8::StaticOrder S; S.init(T, DM, F.G, F.wg);
        pg8::EpiResid E{F.ap->in[I_X], WSP(float, WS_X1), WSP(float, WS_MOD)}; pg8::gemm_phase<pg8::EpiResid, pg8::StaticOrder, true, true>(F.lds + RING_OFF, g, S, E, F.tid); } SEAM(12);
    if (IN(13)) { p11_router(F); } SEAM(13);
    if (IN(14)) { p12_slots(F); } SEAM(14);
    if (IN(15)) { const int nt = WSP(int, WS_TILEE)[1024]; pg8::Gemm g{WSP(bf16, WS_HS), WSP(bf16, WS_WGU), nt * 256, 4096, DM}; pg8::MoeOrder S; S.init(nt * 256, 4096, F.G, F.wg); S.tile_e = WSP(int, WS_TILEE);
        pg8::EpiSwiglu E{WSP(bf16, WS_ACT), F.ap->in[I_BGU]}; pg8::gemm_phase<pg8::EpiSwiglu, pg8::MoeOrder, true, true>(F.lds + RING_OFF, g, S, E, F.tid); } SEAM(15);
    if (IN(16)) { const int nt = WSP(int, WS_TILEE)[1024]; pg8::Gemm g{WSP(bf16, WS_ACT), WSP(bf16, WS_WDN), nt * 256, 2048, DFF}; pg8::MoeOrder S; S.init(nt * 256, 2048, F.G, F.wg); S.tile_e = WSP(int, WS_TILEE);
        pg8::EpiDown E{WSP(bf16, WS_HS), F.ap->in[I_BDN], WSP(float, WS_SLOTW)}; pg8::gemm_phase<pg8::EpiDown, pg8::MoeOrder, true, true>(F.lds + RING_OFF, g, S, E, F.tid); } SEAM(16);
    if (IN(17)) { p15_final(F); }
#undef IN
#undef SEAM
}

extern "C" void kernel_launch(void* const* d_in, const int* in_sizes, int n_in, void* d_out, int out_size, void* d_ws, size_t ws_size, hipStream_t stream) {
    static int grid = 0;
    if (grid == 0) {
        if (n_in != N_IN || in_sizes[0] != T * DM || out_size != T * DM || ws_size < WS_END) { fprintf(stderr, "kernel_launch: shape/workspace mismatch (n_in %d, in0 %d, out %d, ws %zu < %zu)\n", n_in, n_in > 0 ? in_sizes[0] : -1, out_size, ws_size, (size_t)WS_END); grid = -1; return; }
        if (hipFuncSetAttribute((const void*)mk_fwd, hipFuncAttributeMaxDynamicSharedMemorySize, LDS_BYTES) != hipSuccess) { fprintf(stderr, "kernel_launch: hipFuncSetAttribute failed\n"); grid = -1; return; }
        int per_cu = 0;
        if (hipOccupancyMaxActiveBlocksPerMultiprocessor(&per_cu, (const void*)mk_fwd, NWAVES * 64, LDS_BYTES) != hipSuccess || per_cu < 1) fprintf(stderr, "kernel_launch: note: occupancy query reports %d workgroups per CU\n", per_cu);
        (void)hipGetLastError();
        grid = 256;
    }
    if (grid < 0) return;
    (void)hipMemsetAsync((char*)d_ws + WS_CTL, 0, CTL_ZERO_BYTES, stream);
    Args a{};
    for (int i = 0; i < N_IN; ++i) a.in[i] = (const float*)d_in[i];
    a.out = (float*)d_out; a.ws = (unsigned char*)d_ws;
#if MK_N_LAUNCHES == 1
    a.ph_lo = 0; a.ph_hi = N_PHASES;
    hipLaunchKernelGGL(mk_fwd, dim3(grid), dim3(NWAVES * 64), LDS_BYTES, stream, a);
#else
    for (int p = 0; p < N_PHASES; ++p) { a.ph_lo = p; a.ph_hi = p + 1; hipLaunchKernelGGL(mk_fwd, dim3(grid), dim3(NWAVES * 64), LDS_BYTES, stream, a); }
#endif
}
```

```cpp
#include <hip/hip_runtime.h>
#include <hip/hip_bf16.h>
#include <cstdio>
#include <cstdint>
constexpr int NWAVES = 8;
#ifndef MK_N_LAUNCHES
#define MK_N_LAUNCHES 1
#endif
#ifndef RWKV_NAIVE
#define RWKV_NAIVE 0
#endif
constexpr int BATCH = 2, SEQ = 16384, DM = 2048, T = BATCH * SEQ;
constexpr int NP = 11776;
constexpr int PC_R = 0, PC_K = 1024, PC_V = 2048, PC_FQ = 3072, PC_FK = 4096, PC_FV = 5120, PC_OG = 6144, PC_GA = 7168, PC_GB = 9216, PC_GLO = 11264, PC_DLO = 11520, PC_ALO = 11616, PC_F = 11712, PC_END = 11720;
constexpr int RW = 1024, FW = 1024, NE = 32, DFF = 2048, TOPK = 4;
constexpr int NSLOT = T * TOPK + NE * 256;
constexpr float NORM_EPS = 1e-6f, GN_EPS = 64e-5f;

constexpr size_t MiB = 1u << 20;
constexpr size_t WS_CTL = 0, CTL_ZERO_BYTES = 1 * MiB;
constexpr size_t WS_MOD = 1 * MiB;
constexpr size_t WS_WRT = 1 * MiB + 128 * 1024;
constexpr size_t WS_TOKE = 2 * MiB, WS_TOKW = 2 * MiB + 512 * 1024, WS_TOKS = 3 * MiB, WS_SLOTW = 3 * MiB + 512 * 1024;
constexpr size_t WS_WGCNT = 4 * MiB + 512 * 1024, WS_TILEE = 4 * MiB + 768 * 1024;
constexpr size_t WS_LF = 5 * MiB, WS_CS = 6 * MiB;
constexpr size_t WS_BT1 = 7 * MiB, WS_BT2 = 8 * MiB, WS_WOA = 9 * MiB, WS_WOB = 13 * MiB, WS_WOUT = 17 * MiB, WS_WIN = 25 * MiB;
constexpr size_t WS_WGU = 72 * MiB, WS_WDN = 584 * MiB, WS_X1 = 840 * MiB, WS_H = 1096 * MiB;
constexpr size_t WS_P = 1226 * MiB, WS_R = 1962 * MiB, WS_K = 2026 * MiB, WS_V = 2090 * MiB, WS_FQ = 2154 * MiB, WS_FK = 2218 * MiB, WS_FV = 2282 * MiB;
constexpr size_t WS_LW = 2346 * MiB, WS_SG = 2362 * MiB, WS_LOGW = 2378 * MiB, WS_A = 2506 * MiB, WS_G = 2570 * MiB, WS_YRAW = 2634 * MiB, WS_YA = 2762 * MiB, WS_YB = 2826 * MiB, WS_MRG = 2890 * MiB;
constexpr size_t WS_HS = 1226 * MiB, WS_ACT = 1770 * MiB;
constexpr size_t WS_REC = 3018 * MiB;
constexpr size_t WS_END = 3274 * MiB;
static_assert(WS_WIN + (size_t)NP * DM * 2 <= WS_WGU && WS_ACT + (size_t)NSLOT * DFF * 2 <= WS_REC && WS_HS + (size_t)NSLOT * DM * 2 <= WS_ACT && WS_SLOTW + (size_t)NSLOT * 4 <= WS_WGCNT, "d_ws map");
constexpr int CW_TMO = 0, CW_BAR = 4096;

constexpr int RING_OFF = 0, RING_BYTES = 143360;
constexpr int LDSCTL_OFF = RING_BYTES, MISC_OFF = LDSCTL_OFF + 320;
constexpr int LDS_BYTES = 147456;

#define GAS __attribute__((address_space(1)))
#define LAS __attribute__((address_space(3)))
typedef unsigned short bf16;
typedef unsigned v4u __attribute__((ext_vector_type(4)));
typedef unsigned v2u __attribute__((ext_vector_type(2)));
typedef float f32x4 __attribute__((ext_vector_type(4)));
typedef short bf16x8 __attribute__((ext_vector_type(8)));
typedef GAS unsigned gu32;
#define RLX_AGENT __ATOMIC_RELAXED, __HIP_MEMORY_SCOPE_AGENT
#define LDS_WAIT() asm volatile("s_waitcnt lgkmcnt(0)" ::: "memory")
#define VM_WAIT() asm volatile("s_waitcnt vmcnt(0)" ::: "memory")
__device__ __forceinline__ unsigned f2bf(float f) { unsigned u = __builtin_bit_cast(unsigned, f); return (u + 0x7fffu + ((u >> 16) & 1u)) >> 16; }
__device__ __forceinline__ unsigned pk2(float lo, float hi) { return f2bf(lo) | (f2bf(hi) << 16); }
__device__ __forceinline__ float bflo(unsigned w) { return __uint_as_float(w << 16); }
__device__ __forceinline__ float bfhi(unsigned w) { return __uint_as_float(w & 0xffff0000u); }
__device__ __forceinline__ void unpack8(v4u w, float (&f)[8]) { f[0] = bflo(w.x); f[1] = bfhi(w.x); f[2] = bflo(w.y); f[3] = bfhi(w.y); f[4] = bflo(w.z); f[5] = bfhi(w.z); f[6] = bflo(w.w); f[7] = bfhi(w.w); }
__device__ __forceinline__ v4u pack8f(const float (&f)[8]) { v4u w; w.x = pk2(f[0], f[1]); w.y = pk2(f[2], f[3]); w.z = pk2(f[4], f[5]); w.w = pk2(f[6], f[7]); return w; }
__device__ __forceinline__ float sigmoidf_(float x) { return 1.f / (1.f + __expf(-x)); }
__device__ __forceinline__ float wave_sum(float v) {
#pragma unroll
    for (int o = 1; o < 64; o <<= 1) v += __shfl_xor(v, o);
    return v;
}
namespace pg8 {
#define PG8_LAS __attribute__((address_space(3)))
typedef unsigned short bf16_t;
typedef short bf16x8 __attribute__((ext_vector_type(8)));
typedef float f32x4 __attribute__((ext_vector_type(4)));
typedef unsigned u32x4 __attribute__((ext_vector_type(4)));
constexpr int BM = 256, BK = 64, HALF = 128, HTB = HALF * BK * 2  , STAGE_BYTES = 8 * HTB, NXCD = 8, WGM = 8;

__host__ __device__ __forceinline__ int lds_byte(int r, int c) { const int st = (r >> 4) * 2 + (c >> 5), rr = r & 15, cc = c & 31, ob = rr * 64 + cc * 2; return st * 1024 + (ob ^ (((ob >> 9) & 1) << 5)); }
__host__ __device__ __forceinline__ void stage_rc(int b, int& R, int& C) { const int st = b / 1024, sb = b % 1024, swz = sb ^ (((sb >> 9) & 1) << 5); R = (st >> 1) * 16 + swz / 64; C = (st & 1) * 32 + (swz % 64) / 2; }
__host__ __device__ __forceinline__ int perm32(int rho) { const int n = rho >> 4, i = rho & 15; return 8 * (i >> 2) + 4 * n + (i & 3); }

struct Unit { int pm, pn, e; };
struct Gemm { const bf16_t* A; const bf16_t* Bt; int M, N, K; };

struct StaticOrder {
    int nM, nN, nwg, G, c;
    __host__ __device__ void init(int M, int N, int G_, int c_) { nM = M / BM; nN = N / BM; nwg = nM * nN; G = G_; c = c_; }
    __host__ __device__ bool next(int i, Unit& u) const {
        const long L = (long)i * G + c; if (L >= nwg) return false;
        int wgid = (int)L; { const int q = nwg / NXCD, r = nwg % NXCD, xcd = wgid % NXCD, off = wgid / NXCD; wgid = (xcd < r ? xcd * (q + 1) : r * (q + 1) + (xcd - r) * q) + off; }
        const int nig = WGM * nN, gid = wgid / nig, fm = gid * WGM, gsz = (nM - fm) < WGM ? (nM - fm) : WGM;
        u.pm = fm + ((wgid % nig) % gsz); u.pn = (wgid % nig) / gsz; u.e = 0; return true;
    }
    __device__ __forceinline__ void a_ready(const Unit&) const {}
    __device__ __forceinline__ void done(const Unit&) const {}
};

__device__ __forceinline__ unsigned cvt_pk_bf16(float lo, float hi) { unsigned r; asm volatile("v_cvt_pk_bf16_f32 %0, %1, %2" : "=v"(r) : "v"(lo), "v"(hi)); return r; }
typedef float f32x2 __attribute__((ext_vector_type(2)));
__device__ __forceinline__ f32x2 gelu_pk(f32x2 v) {
    const f32x2 av = __builtin_elementwise_abs(v), d = av * 0.2316418882f + 1.0f;
    f32x2 t; t.x = __builtin_amdgcn_rcpf(d.x); t.y = __builtin_amdgcn_rcpf(d.y);
    f32x2 q = t * 0.5307027145f + (-0.7265760135f); q = q * t + 0.7107068705f; q = q * t + (-0.142248368f); q = q * t + 0.127414796f; q = q * t;
    const f32x2 s = (v * v) * (-0.72134752044f);
    f32x2 e; e.x = __builtin_amdgcn_exp2f(s.x); e.y = __builtin_amdgcn_exp2f(s.y);
    const f32x2 m = v * (q * e), r = v - m;
    f32x2 o; o.x = v.x < 0.f ? m.x : r.x; o.y = v.y < 0.f ? m.y : r.y; return o;
}

template <int ACT  > struct EpiBf16 {
    static constexpr bool PERM = true, AFTER_DRAIN = false; static_assert(ACT == 0 || ACT == 1, "EpiBf16: ACT is 0 (none) or 1 (gelu_pk)");
    bf16_t* O; int ldc; const float* bias; int split_cols; size_t split_stride; float scale0;
    __device__ __forceinline__ void operator()(const f32x4 (&acc)[2][2][4][2], const Unit& u, int wr, int wc, int fr, int fq) const {
        const int row0 = u.pm * BM + wr * 64 + fr; int colt = u.pn * BM; bf16_t* base = O;
        float sc = 1.f; if (split_cols) { const int t = colt / split_cols; base += (size_t)t * split_stride; colt -= t * split_cols; if (t == 0) sc = scale0; }
        const int col0 = colt + wc * 32 + 8 * fq, bcol0 = u.pn * BM + wc * 32 + 8 * fq;
        f32x4 bv[2][2];
#pragma unroll
        for (int bj = 0; bj < 2; ++bj)
#pragma unroll
            for (int n = 0; n < 2; ++n) bv[bj][n] = bias ? *(const f32x4*)(bias + bcol0 + bj * HALF + 4 * n) : (f32x4){0.f, 0.f, 0.f, 0.f};
#pragma unroll
        for (int ai = 0; ai < 2; ++ai)
#pragma unroll
            for (int m = 0; m < 4; ++m) { bf16_t* rowp = base + (size_t)(row0 + ai * HALF + m * 16) * ldc + col0;
#pragma unroll
                for (int bj = 0; bj < 2; ++bj) { f32x4 v0 = acc[ai][bj][m][0] + bv[bj][0], v1 = acc[ai][bj][m][1] + bv[bj][1];
                    if (ACT == 1) { f32x2 a = gelu_pk((f32x2){v0[0], v0[1]}), b = gelu_pk((f32x2){v0[2], v0[3]}), c = gelu_pk((f32x2){v1[0], v1[1]}), d = gelu_pk((f32x2){v1[2], v1[3]});
                        v0 = (f32x4){a.x, a.y, b.x, b.y}; v1 = (f32x4){c.x, c.y, d.x, d.y}; }
                    v0 = v0 * sc; v1 = v1 * sc; u32x4 w; w.x = cvt_pk_bf16(v0[0], v0[1]); w.y = cvt_pk_bf16(v0[2], v0[3]); w.z = cvt_pk_bf16(v1[0], v1[1]); w.w = cvt_pk_bf16(v1[2], v1[3]);
                    *(u32x4*)(rowp + bj * HALF) = w; } }
    }
};

template <class Epi, class Sched, bool ALIGN_EPI = false, bool SP2 = false>
__device__ __forceinline__ void gemm_phase(PG8_LAS unsigned char* lds, const Gemm g, const Sched& S, const Epi& E, const int tid) {
    const int wid = __builtin_amdgcn_readfirstlane(tid >> 6), lane = tid & 63, wr = wid >> 2, wc = wid & 3, fr = lane & 15, fq = lane >> 4;
    const int K = g.K, nt = K / BK;
    unsigned voffA[2], voffB[2];
#pragma unroll
    for (int i = 0; i < 2; ++i) { int R, C; stage_rc(tid * 16 + i * 8192, R, C); const int Rb = Epi::PERM ? ((R & ~31) + perm32(R & 31)) : R;
        voffA[i] = (unsigned)(R * K + C) * 2u; voffB[i] = (unsigned)(Rb * K + C) * 2u; }
    const size_t kstep = (size_t)(BK * 2);
    const size_t hstep = (size_t)HALF * K * 2;
    const size_t tstep = 2 * hstep;
    const unsigned ldsw = (unsigned)wid * 1024u;
    const int aoff = lds_byte(wr * 64 + fr, fq * 8), boff = lds_byte(wc * 32 + fr, fq * 8);
#define PG8_SA(b, h) (((b) * 2 + (h)) * HTB)
#define PG8_SB(b, h) ((4 + (b) * 2 + (h)) * HTB)
#define PG8_STAGE(bufoff, gbase, voff) do { _Pragma("unroll") for (int _i = 0; _i < 2; ++_i) \
        __builtin_amdgcn_global_load_lds((const unsigned*)((const char*)(gbase) + (voff)[_i]), (PG8_LAS unsigned*)(lds + (bufoff) + ldsw + _i * 8192), 16, 0, 0); } while (0)
#define PG8_LDA(dst, b, h) do { _Pragma("unroll") for (int m = 0; m < 4; ++m) _Pragma("unroll") for (int k = 0; k < 2; ++k) dst[m][k] = *(const PG8_LAS bf16x8*)(lds + PG8_SA(b, h) + aoff + m * 2048 + k * 1024); } while (0)
#define PG8_LDB(dst, b, h) do { _Pragma("unroll") for (int n = 0; n < 2; ++n) _Pragma("unroll") for (int k = 0; k < 2; ++k) dst[n][k] = *(const PG8_LAS bf16x8*)(lds + PG8_SB(b, h) + boff + n * 2048 + k * 1024); } while (0)
#define PG8_MMA(ai, bj, At, Bt) do { __builtin_amdgcn_s_setprio(1); _Pragma("unroll") for (int m = 0; m < 4; ++m) _Pragma("unroll") for (int n = 0; n < 2; ++n) _Pragma("unroll") for (int k = 0; k < 2; ++k) \
        acc[ai][bj][m][n] = __builtin_amdgcn_mfma_f32_16x16x32_bf16(Bt[n][k], At[m][k], acc[ai][bj][m][n], 0, 0, 0); __builtin_amdgcn_s_setprio(0); } while (0)
#define PG8_WAIT_V(n) asm volatile("s_waitcnt vmcnt(" #n ")" ::: "memory")
#define PG8_WAIT_L(n) asm volatile("s_waitcnt lgkmcnt(" #n ")" ::: "memory")
#define PG8_BAR __builtin_amdgcn_s_barrier()
#define PG8_SCHED __builtin_amdgcn_sched_barrier(0)
    Unit cur, nxt; int ui = 0;
    if (!S.next(0, cur)) return;
    f32x4 acc[2][2][4][2];
#pragma unroll
    for (int a = 0; a < 2; ++a)
#pragma unroll
        for (int b = 0; b < 2; ++b)
#pragma unroll
            for (int m = 0; m < 4; ++m)
#pragma unroll
                for (int n = 0; n < 2; ++n) acc[a][b][m][n] = (f32x4){0.f, 0.f, 0.f, 0.f};
    bf16x8 At[4][2], B0[2][2], B1[2][2];
    const char* cA = (const char*)g.A + (size_t)cur.pm * tstep; const size_t estep = (size_t)g.N * K * 2; const char* cB = (const char*)g.Bt + (size_t)cur.e * estep + (size_t)cur.pn * tstep;
    S.a_ready(cur);
    if constexpr (SP2) {
        PG8_STAGE(PG8_SB(0, 0), cB, voffB); PG8_STAGE(PG8_SB(0, 1), cB + hstep, voffB); PG8_STAGE(PG8_SA(0, 0), cA, voffA); PG8_STAGE(PG8_SA(0, 1), cA + hstep, voffA);
        if (wr == 1) PG8_BAR;
        PG8_WAIT_V(2); PG8_BAR;
        PG8_STAGE(PG8_SB(1, 0), cB + kstep, voffB); PG8_STAGE(PG8_SA(1, 0), cA + kstep, voffA); PG8_STAGE(PG8_SB(1, 1), cB + hstep + kstep, voffB);
        PG8_WAIT_V(6); PG8_BAR;
    } else {
        PG8_STAGE(PG8_SB(0, 0), cB, voffB); PG8_STAGE(PG8_SA(0, 0), cA, voffA); PG8_STAGE(PG8_SB(0, 1), cB + hstep, voffB); PG8_STAGE(PG8_SA(0, 1), cA + hstep, voffA);
        if (wr == 1) PG8_BAR;
        PG8_WAIT_V(4); PG8_BAR;
        PG8_STAGE(PG8_SB(1, 0), cB + kstep, voffB); PG8_STAGE(PG8_SA(1, 0), cA + kstep, voffA); PG8_STAGE(PG8_SB(1, 1), cB + hstep + kstep, voffB);
        PG8_WAIT_V(6); PG8_BAR;
    }
    for (;;) {
        const bool has_next = S.next(ui + 1, nxt);
        const char* nA = has_next ? (const char*)g.A + (size_t)nxt.pm * tstep : cA; const char* nB = has_next ? (const char*)g.Bt + (size_t)nxt.e * estep + (size_t)nxt.pn * tstep : cB;
        for (int t = 0; t < nt; t += 2) {
            const bool last = (t == nt - 2);
            const char* a1 = cA + (size_t)(t + 1) * kstep;
            const char* a2 = last ? nA : cA + (size_t)(t + 2) * kstep; const char* b2 = last ? nB : cB + (size_t)(t + 2) * kstep;
            const char* a3 = a2 + kstep; const char* b3 = b2 + kstep;
            if (last && has_next) S.a_ready(nxt);
            if constexpr (SP2) {
            PG8_LDB(B0, 0, 0); PG8_LDB(B1, 0, 1); PG8_SCHED; PG8_LDA(At, 0, 0); PG8_STAGE(PG8_SA(1, 1), a1 + hstep, voffA);
            PG8_WAIT_V(8); PG8_WAIT_L(0); PG8_BAR; PG8_MMA(0, 0, At, B0); PG8_MMA(0, 1, At, B1); PG8_BAR; PG8_SCHED;
            PG8_LDA(At, 0, 1); PG8_STAGE(PG8_SB(0, 0), b2, voffB); PG8_STAGE(PG8_SB(0, 1), b2 + hstep, voffB); PG8_STAGE(PG8_SA(0, 0), a2, voffA);
            PG8_WAIT_V(8); PG8_WAIT_L(0); PG8_BAR; PG8_MMA(1, 0, At, B0); PG8_MMA(1, 1, At, B1); PG8_BAR; PG8_SCHED;
            PG8_LDB(B0, 1, 0); PG8_LDB(B1, 1, 1); PG8_SCHED; PG8_LDA(At, 1, 0); PG8_STAGE(PG8_SA(0, 1), a2 + hstep, voffA);
            PG8_WAIT_V(8); PG8_WAIT_L(0); PG8_BAR; PG8_MMA(0, 0, At, B0); PG8_MMA(0, 1, At, B1); PG8_BAR; PG8_SCHED;
            PG8_LDA(At, 1, 1); PG8_STAGE(PG8_SB(1, 0), b3, voffB); PG8_STAGE(PG8_SB(1, 1), b3 + hstep, voffB); PG8_STAGE(PG8_SA(1, 0), a3, voffA);
            PG8_WAIT_V(8); PG8_WAIT_L(0); PG8_BAR; PG8_MMA(1, 0, At, B0); PG8_MMA(1, 1, At, B1); PG8_BAR; PG8_SCHED;
            } else {
            PG8_LDB(B0, 0, 0); PG8_SCHED; PG8_LDA(At, 0, 0); PG8_STAGE(PG8_SA(1, 1), a1 + hstep, voffA);
            PG8_WAIT_L(8); PG8_BAR; PG8_WAIT_L(0); PG8_MMA(0, 0, At, B0); PG8_BAR; PG8_SCHED;
            PG8_LDB(B1, 0, 1); PG8_STAGE(PG8_SB(0, 0), b2, voffB);
            PG8_BAR; PG8_WAIT_L(0); PG8_MMA(0, 1, At, B1); PG8_BAR;
            PG8_LDA(At, 0, 1); PG8_STAGE(PG8_SA(0, 0), a2, voffA);
            PG8_BAR; PG8_WAIT_L(0); PG8_MMA(1, 0, At, B0); PG8_BAR; PG8_SCHED;
            PG8_STAGE(PG8_SB(0, 1), b2 + hstep, voffB);
            PG8_WAIT_V(6); PG8_BAR; PG8_MMA(1, 1, At, B1); PG8_BAR;
            PG8_LDB(B0, 1, 0); PG8_SCHED; PG8_LDA(At, 1, 0); PG8_STAGE(PG8_SA(0, 1), a2 + hstep, voffA);
            PG8_WAIT_L(8); PG8_BAR; PG8_WAIT_L(0); PG8_MMA(0, 0, At, B0); PG8_BAR; PG8_SCHED;
            PG8_LDB(B1, 1, 1); PG8_STAGE(PG8_SB(1, 0), b3, voffB);
            PG8_BAR; PG8_WAIT_L(0); PG8_MMA(0, 1, At, B1); PG8_BAR;
            PG8_LDA(At, 1, 1); PG8_STAGE(PG8_SA(1, 0), a3, voffA);
            PG8_BAR; PG8_WAIT_L(0); PG8_MMA(1, 0, At, B0); PG8_BAR; PG8_SCHED;
            PG8_STAGE(PG8_SB(1, 1), b3 + hstep, voffB);
            PG8_WAIT_V(6); PG8_BAR; PG8_MMA(1, 1, At, B1); PG8_BAR;
            }
        }
        if constexpr (ALIGN_EPI) { if (wr == 0) PG8_BAR; }
        if constexpr (!Epi::AFTER_DRAIN) { E(acc, cur, wr, wc, fr, fq); S.done(cur); }
        if (!has_next) break;
#pragma unroll
        for (int a = 0; a < 2; ++a)
#pragma unroll
            for (int b = 0; b < 2; ++b)
#pragma unroll
                for (int m = 0; m < 4; ++m)
#pragma unroll
                    for (int n = 0; n < 2; ++n) acc[a][b][m][n] = (f32x4){0.f, 0.f, 0.f, 0.f};
        cur = nxt; cA = nA; cB = nB; ++ui;
        if constexpr (ALIGN_EPI) { if (wr == 1) PG8_BAR; }
    }
    PG8_WAIT_V(0);
    if constexpr (!ALIGN_EPI) { if (wr == 0) PG8_BAR; }
    PG8_BAR;
    if constexpr (Epi::AFTER_DRAIN) { E.fused(acc, cur, wr, wc, fr, fq, lds, wid, lane); S.done(cur); }
#undef PG8_SA
#undef PG8_SB
#undef PG8_STAGE
#undef PG8_LDA
#undef PG8_LDB
#undef PG8_MMA
#undef PG8_WAIT_V
#undef PG8_WAIT_L
#undef PG8_BAR
#undef PG8_SCHED
}
}
namespace pg8 {
__device__ __forceinline__ float ep_bflo(unsigned w) { return __uint_as_float(w << 16); }
__device__ __forceinline__ float ep_bfhi(unsigned w) { return __uint_as_float(w & 0xffff0000u); }
__device__ __forceinline__ float ep_sig(float x) { return __builtin_amdgcn_rcpf(1.f + __builtin_amdgcn_exp2f(-1.4426950408889634f * x)); }
__device__ __forceinline__ void ep_unpack8(u32x4 w, f32x4& a, f32x4& b) { a = (f32x4){ep_bflo(w.x), ep_bfhi(w.x), ep_bflo(w.y), ep_bfhi(w.y)}; b = (f32x4){ep_bflo(w.z), ep_bfhi(w.z), ep_bflo(w.w), ep_bfhi(w.w)}; }
__device__ __forceinline__ u32x4 ep_pack8(f32x4 a, f32x4 b) { u32x4 w; w.x = cvt_pk_bf16(a[0], a[1]); w.y = cvt_pk_bf16(a[2], a[3]); w.z = cvt_pk_bf16(b[0], b[1]); w.w = cvt_pk_bf16(b[2], b[3]); return w; }
__device__ __forceinline__ f32x4 ep_sig4(f32x4 v) { return (f32x4){ep_sig(v[0]), ep_sig(v[1]), ep_sig(v[2]), ep_sig(v[3])}; }
#define EPI_LOOP_BEGIN const int row0 = u.pm * BM + wr * 64 + fr, col0 = u.pn * BM + wc * 32 + 8 * fq; \
    _Pragma("unroll") for (int ai = 0; ai < 2; ++ai) _Pragma("unroll") for (int m = 0; m < 4; ++m) { const int row = row0 + ai * HALF + m * 16; \
    _Pragma("unroll") for (int bj = 0; bj < 2; ++bj) { const int col = col0 + bj * HALF; const f32x4 v0 = acc[ai][bj][m][0], v1 = acc[ai][bj][m][1];
#define EPI_LOOP_END } }

struct EpiLora1 {
    static constexpr bool PERM = true, AFTER_DRAIN = false;
    float* logw; bf16_t* a; const float* w0; const float* a0;
    __device__ __forceinline__ void operator()(const f32x4 (&acc)[2][2][4][2], const Unit& u, int wr, int wc, int fr, int fq) const {
        EPI_LOOP_BEGIN
            if (u.pn < 4) { const f32x4 b0 = *(const f32x4*)(w0 + col), b1 = *(const f32x4*)(w0 + col + 4);
                float* o = logw + (size_t)row * 1024 + col; *(f32x4*)o = ep_sig4(v0 + b0) * (-0.6065306597126334f); *(f32x4*)(o + 4) = ep_sig4(v1 + b1) * (-0.6065306597126334f); }
            else { const int c = col - 1024; const f32x4 b0 = *(const f32x4*)(a0 + c), b1 = *(const f32x4*)(a0 + c + 4);
                *(u32x4*)(a + (size_t)row * 1024 + c) = ep_pack8(ep_sig4(v0 + b0), ep_sig4(v1 + b1)); }
        EPI_LOOP_END
    }
};
template <int SECOND> struct EpiGateMerge {
    static constexpr bool PERM = true, AFTER_DRAIN = false;
    bf16_t* mrg; const bf16_t* P; int gcol;
    __device__ __forceinline__ void operator()(const f32x4 (&acc)[2][2][4][2], const Unit& u, int wr, int wc, int fr, int fq) const {
        EPI_LOOP_BEGIN
            f32x4 g0, g1; ep_unpack8(*(const u32x4*)(P + (size_t)row * 11776 + gcol + col), g0, g1);
            f32x4 r0 = ep_sig4(g0) * v0, r1 = ep_sig4(g1) * v1;
            bf16_t* o = mrg + (size_t)row * 2048 + col;
            if (SECOND) { f32x4 t0, t1; ep_unpack8(*(const u32x4*)o, t0, t1); r0 = r0 + t0; r1 = r1 + t1; }
            *(u32x4*)o = ep_pack8(r0, r1);
        EPI_LOOP_END
    }
};
struct EpiResid {
    static constexpr bool PERM = true, AFTER_DRAIN = false;
    const float* x; float* x1; const float* mod;
    __device__ __forceinline__ void operator()(const f32x4 (&acc)[2][2][4][2], const Unit& u, int wr, int wc, int fr, int fq) const {
        const float* gt = mod + (size_t)((u.pm * BM) / 16384) * 12288 + 4096;
        EPI_LOOP_BEGIN
            const f32x4 g0 = *(const f32x4*)(gt + col), g1 = *(const f32x4*)(gt + col + 4);
            const size_t off = (size_t)row * 2048 + col;
            *(f32x4*)(x1 + off) = *(const f32x4*)(x + off) + g0 * v0; *(f32x4*)(x1 + off + 4) = *(const f32x4*)(x + off + 4) + g1 * v1;
        EPI_LOOP_END
    }
};
struct EpiSwiglu {
    static constexpr bool PERM = true, AFTER_DRAIN = false;
    bf16_t* act; const float* bias;
    __device__ __forceinline__ void operator()(const f32x4 (&acc)[2][2][4][2], const Unit& u, int wr, int wc, int fr, int fq) const {
        const int row0 = u.pm * BM + wr * 64 + fr, gcol = u.pn * 128 + wc * 32 + 8 * fq;
        const float* bg = bias + (size_t)u.e * 4096 + gcol; const float* bl = bg + 2048;
        const f32x4 bg0 = *(const f32x4*)bg, bg1 = *(const f32x4*)(bg + 4), bl0 = *(const f32x4*)bl, bl1 = *(const f32x4*)(bl + 4);
#pragma unroll
        for (int ai = 0; ai < 2; ++ai)
#pragma unroll
            for (int m = 0; m < 4; ++m) { const int row = row0 + ai * HALF + m * 16;
                f32x4 g0 = acc[ai][0][m][0] + bg0, g1 = acc[ai][0][m][1] + bg1, l0 = acc[ai][1][m][0] + bl0, l1 = acc[ai][1][m][1] + bl1, r0, r1;
#pragma unroll
                for (int i = 0; i < 4; ++i) { const float a = fminf(g0[i], 7.f), b = fminf(g1[i], 7.f);
                    r0[i] = a * ep_sig(1.702f * a) * (fminf(fmaxf(l0[i], -7.f), 7.f) + 1.f); r1[i] = b * ep_sig(1.702f * b) * (fminf(fmaxf(l1[i], -7.f), 7.f) + 1.f); }
                *(u32x4*)(act + (size_t)row * 2048 + gcol) = ep_pack8(r0, r1); }
    }
};
struct EpiDown {
    static constexpr bool PERM = true, AFTER_DRAIN = false;
    bf16_t* ys; const float* bias; const float* slot_w;
    __device__ __forceinline__ void operator()(const f32x4 (&acc)[2][2][4][2], const Unit& u, int wr, int wc, int fr, int fq) const {
        const float* be = bias + (size_t)u.e * 2048;
        EPI_LOOP_BEGIN
            const float w = slot_w[row];
            const f32x4 b0 = *(const f32x4*)(be + col), b1 = *(const f32x4*)(be + col + 4);
            *(u32x4*)(ys + (size_t)row * 2048 + col) = ep_pack8((v0 + b0) * w, (v1 + b1) * w);
        EPI_LOOP_END
    }
};
struct MoeOrder : StaticOrder {
    const int* tile_e;
    __device__ bool next(int i, Unit& u) const { if (!StaticOrder::next(i, u)) return false; u.e = tile_e[u.pm]; return true; }
};
}
namespace fox {
enum { ORDER_NATURAL = 0, ORDER_REVERSED = 1, ORDER_PAIRED = 2, ORDER_XCD = 4 };
using TIN = __hip_bfloat16; using TOUT = __hip_bfloat16;
constexpr int B = 2, H = 8, HKV = 8, SQ = 16384, SKV = 16384, D = 128;
constexpr int PITCH = 1024;
constexpr int GPITCH = 11776;
constexpr int QOFF = 0;
constexpr int WINDOW = SKV;
constexpr float THR = 8.f;
constexpr int ORDER = ORDER_PAIRED;
constexpr bool WSKIP = false;
constexpr float SCALE = 0.08838834764831845f;
constexpr int NW = 8, QBLK = 32, KVBLK = 64, QB = NW * QBLK;
constexpr int SHM_V = KVBLK * D * 2, SHM_K = KVBLK * D * 2;
constexpr int LDS_CB = 2 * SHM_V + 2 * SHM_K + NW * 64 * 4;
constexpr int LDS_GATE = LDS_CB + 3 * 64 * 4 + 256;
constexpr int LDS_BYTES = LDS_GATE + NW * 8192;
static_assert(D == 128 && SQ % QB == 0 && SKV % KVBLK == 0 && H % HKV == 0 && QOFF >= 0 && QOFF + SQ <= SKV && WINDOW >= 1, "geometry");

using bf16 = __hip_bfloat16;
typedef short bf16x8 __attribute__((ext_vector_type(8)));
typedef short s16x4 __attribute__((ext_vector_type(4)));
typedef float f32x16 __attribute__((ext_vector_type(16)));
typedef float f32x4 __attribute__((ext_vector_type(4)));
typedef unsigned u32x4 __attribute__((ext_vector_type(4)));
template <class A, class Bt> struct same_t { static constexpr bool v = false; };
template <class A> struct same_t<A, A> { static constexpr bool v = true; };

#define KSWZ(row, colB) ((row) * 256 + ((colB) ^ (((row) & 7) << 4)))
#define SBAR() __builtin_amdgcn_sched_barrier(0)
__device__ __forceinline__ int v_st(int k, int c) { const int kk = (k & ~0xC) | ((k & 4) << 1) | ((k & 8) >> 1); return ((kk >> 3) * 4 + (c >> 5)) * 512 + ((kk & 7) * 32 + (c & 31)) * 2; }
__device__ __forceinline__ int v_rd_base(int lane) { return ((lane & 3) << 3) | (((lane >> 2) & 3) << 6) | (((lane >> 4) & 1) << 5) | (((lane >> 5) & 1) << 8); }
constexpr int v_rd_off(int d0, int ks, int half) { return d0 * 512 + ks * 4096 + half * 2048; }
__device__ __forceinline__ int crow(int r, int hi) { return (r & 3) + 8 * (r >> 2) + 4 * hi; }
__device__ __forceinline__ unsigned cvtpk(float lo, float hi) {
    unsigned r; asm volatile("v_cvt_pk_bf16_f32 %0, %1, %2" : "=v"(r) : "v"(lo), "v"(hi)); return r;
}
__device__ __forceinline__ bf16x8 pack8(f32x4 a, f32x4 b) {
    u32x4 w = {cvtpk(a[0], a[1]), cvtpk(a[2], a[3]), cvtpk(b[0], b[1]), cvtpk(b[2], b[3])};
    return *reinterpret_cast<bf16x8*>(&w);
}
template <class T> __device__ __forceinline__ bf16x8 load8(const T* p) {
    if constexpr (same_t<T, float>::v) { return pack8(*(const f32x4*)p, *(const f32x4*)(p + 4)); }
    else { return *reinterpret_cast<const bf16x8*>(p); }
}
__device__ __forceinline__ void mask_tile(f32x16& p0, f32x16& p1, int dq, unsigned W) {
    const float NEG = -__builtin_inff();
#pragma unroll
    for (int r = 0; r < 16; ++r) {
        const int c = (r & 3) + 8 * (r >> 2);
        if ((unsigned)(dq - c) >= W) p0[r] = NEG;
        if ((unsigned)(dq - c - 32) >= W) p1[r] = NEG;
    }
}
__device__ __forceinline__ void partialSM(f32x16& p0, f32x16& p1, float& m_reg, float& mn, float& alpha) {
    float pmax = p0[0]; for (int r = 1; r < 16; ++r) pmax = fmaxf(pmax, p0[r]); for (int r = 0; r < 16; ++r) pmax = fmaxf(pmax, p1[r]);
    { auto rr = __builtin_amdgcn_permlane32_swap(__float_as_uint(pmax), __float_as_uint(pmax), false, false);
      pmax = fmaxf(__uint_as_float(rr[0]), __uint_as_float(rr[1])); }
    constexpr float C2 = 1.4426950408889634f * SCALE;
    if (__builtin_expect(__all((pmax - m_reg) * SCALE <= THR), 1)) { mn = m_reg; alpha = 1.f; }
    else { mn = fmaxf(m_reg, pmax); alpha = __builtin_amdgcn_exp2f((m_reg - mn) * C2); m_reg = mn; }
    const float mnL = -mn * C2;
    for (int r = 0; r < 16; ++r) p0[r] = fmaf(p0[r], C2, mnL); for (int r = 0; r < 16; ++r) p1[r] = fmaf(p1[r], C2, mnL);
    for (int r = 0; r < 16; ++r) p0[r] = __builtin_amdgcn_exp2f(p0[r]);
}
__device__ __forceinline__ void finishSM(f32x16& p0, f32x16& p1, float alpha, float& l_reg, bf16x8& pa0, bf16x8& pa1, bf16x8& pa2, bf16x8& pa3) {
    for (int r = 0; r < 16; ++r) p1[r] = __builtin_amdgcn_exp2f(p1[r]);
    float ps = 0; for (int r = 0; r < 16; ++r) ps += p0[r]; for (int r = 0; r < 16; ++r) ps += p1[r];
    { auto rr = __builtin_amdgcn_permlane32_swap(__float_as_uint(ps), __float_as_uint(ps), false, false);
      ps = __uint_as_float(rr[0]) + __uint_as_float(rr[1]); }
    l_reg = l_reg * alpha + ps;
#define PK4(P, B_, OUT) do { unsigned a0 = cvtpk(P[B_+0], P[B_+1]), a1 = cvtpk(P[B_+2], P[B_+3]);                          \
        unsigned b0 = cvtpk(P[B_+4], P[B_+5]), b1 = cvtpk(P[B_+6], P[B_+7]);                                             \
        auto r0 = __builtin_amdgcn_permlane32_swap(a0, b0, false, false); auto r1 = __builtin_amdgcn_permlane32_swap(a1, b1, false, false); \
        u32x4 w = {r0[0], r1[0], r0[1], r1[1]}; OUT = *reinterpret_cast<bf16x8*>(&w); } while (0)
    PK4(p0, 0, pa0); PK4(p0, 8, pa1); PK4(p1, 0, pa2); PK4(p1, 8, pa3);
#undef PK4
}
template <int KB, bool SK>
__device__ __forceinline__ void qkt(f32x16& p0, f32x16& p1, const char* K_lds, int r32, int hi, const bf16x8* qr, bool act, int cbi) {
    if (SK && !act) { const float NEG = -__builtin_inff();
#pragma unroll
        for (int r = 0; r < 16; ++r) { p0[r] = NEG; p1[r] = NEG; } return; }
    { const float* cb_ = (const float*)(K_lds + 2 * SHM_K + NW * 64 * 4) + cbi * 64 + 4 * hi;
#pragma unroll
      for (int g_ = 0; g_ < 4; ++g_) { const f32x4 b0_ = *(const f32x4*)(cb_ + 8 * g_), b1_ = *(const f32x4*)(cb_ + 32 + 8 * g_);
#pragma unroll
          for (int i_ = 0; i_ < 4; ++i_) { p0[4 * g_ + i_] = b0_[i_]; p1[4 * g_ + i_] = b1_[i_]; } } }
    const char* kb[4];
#pragma unroll
    for (int dd = 0; dd < 4; ++dd) kb[dd] = K_lds + KB * SHM_K + KSWZ(r32, (dd * 16 + hi * 8) * 2);
#pragma unroll
    for (int d0 = 0; d0 < 8; ++d0) { const char* a = kb[d0 & 3] + (d0 >> 2) * 128;
        bf16x8 b0 = *reinterpret_cast<const bf16x8*>(a);
        bf16x8 b1 = *reinterpret_cast<const bf16x8*>(a + 32 * 256);
        p0 = __builtin_amdgcn_mfma_f32_32x32x16_bf16(b0, qr[d0], p0, 0, 0, 0);
        p1 = __builtin_amdgcn_mfma_f32_32x32x16_bf16(b1, qr[d0], p1, 0, 0, 0); }
}
template <int VB, bool SK>
__device__ __forceinline__ void pv_tile(f32x16* o, int vb0, bf16x8 pa0, bf16x8 pa1, bf16x8 pa2, bf16x8 pa3, bool act) {
    if (SK && !act) return;
#define TRRD(dst, off) asm volatile("ds_read_b64_tr_b16 %0, %1 offset:%2" : "=&v"(dst) : "v"(vb0), "i"(off) : "memory")
#define PV_D0(d0) do { s16x4 l0, l1, l2, l3, h0, h1, h2, h3; constexpr int b_ = VB * SHM_V + v_rd_off(d0, 0, 0);     \
        TRRD(l0, b_); TRRD(h0, b_ + 2048); TRRD(l1, b_ + 4096); TRRD(h1, b_ + 6144); TRRD(l2, b_ + 8192); TRRD(h2, b_ + 10240); TRRD(l3, b_ + 12288); TRRD(h3, b_ + 14336); \
        asm volatile("s_waitcnt lgkmcnt(0)" ::: "memory"); SBAR();                 \
        o[d0] = __builtin_amdgcn_mfma_f32_32x32x16_bf16(pa0, (bf16x8){l0[0], l0[1], l0[2], l0[3], h0[0], h0[1], h0[2], h0[3]}, o[d0], 0, 0, 0);   \
        o[d0] = __builtin_amdgcn_mfma_f32_32x32x16_bf16(pa1, (bf16x8){l1[0], l1[1], l1[2], l1[3], h1[0], h1[1], h1[2], h1[3]}, o[d0], 0, 0, 0);   \
        o[d0] = __builtin_amdgcn_mfma_f32_32x32x16_bf16(pa2, (bf16x8){l2[0], l2[1], l2[2], l2[3], h2[0], h2[1], h2[2], h2[3]}, o[d0], 0, 0, 0);   \
        o[d0] = __builtin_amdgcn_mfma_f32_32x32x16_bf16(pa3, (bf16x8){l3[0], l3[1], l3[2], l3[3], h3[0], h3[1], h3[2], h3[3]}, o[d0], 0, 0, 0); } while (0)
    PV_D0(0); PV_D0(1); PV_D0(2); PV_D0(3);
#undef PV_D0
#undef TRRD
}

template <class TIn, class TOut> struct BlockRef { const unsigned char* ws; int row0, bh, P0;
    __device__ __forceinline__ const TIn* Q() const { return (const TIn*)(ws + WS_FQ) + (size_t)row0 * PITCH + (bh % H) * D; }
    __device__ __forceinline__ const TIn* K() const { return (const TIn*)(ws + WS_FK) + (size_t)(bh / H) * SQ * PITCH + (bh % H) * D; }
    __device__ __forceinline__ const TIn* V() const { return (const TIn*)(ws + WS_FV) + (size_t)(bh / H) * SQ * PITCH + (bh % H) * D; }
    __device__ __forceinline__ TOut* O() const { return (TOut*)(ws + WS_YB) + (size_t)row0 * PITCH + (bh % H) * D; }
    __device__ __forceinline__ const float* C() const { return (const float*)(ws + WS_CS) + (size_t)bh * SQ; }
    __device__ __forceinline__ const TIn* G() const { return (const TIn*)(ws + WS_P) + (size_t)row0 * GPITCH + PC_OG + (bh % H) * D; }
};
template <class TIn> struct Seam {
    bf16x8 qr[8];
    bf16x8 st_v0, st_v1, st_k0, st_k1; int cbi; f32x4 sf0, sf1, sf2, sf3;
    f32x4 tq[16];
};
__device__ __forceinline__ int swa_jlo(int P0, int W) { const int lowk = P0 - W + 1; return lowk > 0 ? lowk / KVBLK : 0; }
#define ROW(p, k0, rr) ((p) + (size_t)((k0) + (rr)) * PITCH + sc)
#define VMW() asm volatile("s_waitcnt vmcnt(0)" ::: "memory")
#define VMWN(n) asm volatile("s_waitcnt vmcnt(%0)" :: "i"(n) : "memory")
#define NEXT3(x) ((x) == 2 ? 0 : (x) + 1)
#define SLOAD_H(Kp, Vp, Cp, k0, CI) do { S.st_v0 = load8<TIn>(ROW(Vp, k0, sr)); S.st_v1 = load8<TIn>(ROW(Vp, k0, 32 + sr));              \
                         S.st_k0 = load8<TIn>(ROW(Kp, k0, sr)); S.st_k1 = load8<TIn>(ROW(Kp, k0, 32 + sr));                 \
                         if (wid == 0) __builtin_amdgcn_global_load_lds((const unsigned*)((Cp) + (k0) + lane), (__attribute__((address_space(3))) unsigned*)(lds + LDS_CB + (CI) * 256), 4, 0, 0); } while (0)
#define SWRITE_HK(bf) do { *(bf16x8*)(K_lds + (bf) * SHM_K + kws) = S.st_k0; *(bf16x8*)(K_lds + (bf) * SHM_K + kws + 32 * 256) = S.st_k1; } while (0)
#define SWRITE_HV(bf) do { *(bf16x8*)(V_lds + (bf) * SHM_V + vst0) = S.st_v0; *(bf16x8*)(V_lds + (bf) * SHM_V + vst1) = S.st_v1; } while (0)
#define SWRITE_H(bf) do { SWRITE_HV(bf); SWRITE_HK(bf); } while (0)
#define SLOAD_F(p, k0) do { S.sf0 = *(const f32x4*)ROW(p, k0, sr); S.sf1 = *(const f32x4*)(ROW(p, k0, sr) + 4);                \
                            S.sf2 = *(const f32x4*)ROW(p, k0, 32 + sr); S.sf3 = *(const f32x4*)(ROW(p, k0, 32 + sr) + 4); } while (0)
#define SWRITE_KF(bf) do { *(bf16x8*)(K_lds + (bf) * SHM_K + kws) = pack8(S.sf0, S.sf1); *(bf16x8*)(K_lds + (bf) * SHM_K + kws + 32 * 256) = pack8(S.sf2, S.sf3); } while (0)
#define SWRITE_VF(bf) do { *(bf16x8*)(V_lds + (bf) * SHM_V + vst0) = pack8(S.sf0, S.sf1); *(bf16x8*)(V_lds + (bf) * SHM_V + vst1) = pack8(S.sf2, S.sf3); } while (0)
template <class TIn, class TOut>
__device__ __forceinline__ void causal_swa_prime(const BlockRef<TIn, TOut>& cur, int W, char* lds, Seam<TIn>& S, const int tid) {
    constexpr bool F32 = same_t<TIn, float>::v;
    const int wid = __builtin_amdgcn_readfirstlane(tid >> 6), lane = tid & 63, r32 = lane & 31, hi = lane >> 5;
    const int sr = tid >> 4, sc = (tid & 15) * 8, kws = KSWZ(sr, sc * 2); char* K_lds = lds + 2 * SHM_V;
    const int kb0 = swa_jlo(cur.P0, W) * KVBLK;
    for (int d0 = 0; d0 < 8; ++d0) S.qr[d0] = load8<TIn>(cur.Q() + (size_t)(wid * QBLK + r32) * PITCH + d0 * 16 + hi * 8);
    if constexpr (F32) { SLOAD_F((const float*)cur.K(), kb0); VMW(); SWRITE_KF(0); SBAR(); SLOAD_F((const float*)cur.V(), kb0); }
    else { S.cbi = 0; SLOAD_H(cur.K(), cur.V(), cur.C(), kb0, 0); VMW(); SWRITE_HK(0); }
    __syncthreads();
}
template <class TIn, class TOut>
__device__ __forceinline__ void causal_swa_block(const BlockRef<TIn, TOut>& cur, const BlockRef<TIn, TOut>& nxt, int skv, int W, char* lds, Seam<TIn>& S, const int tid) {
    constexpr bool F32 = same_t<TIn, float>::v;
    const int wid = __builtin_amdgcn_readfirstlane(tid >> 6), lane = tid & 63, r32 = lane & 31, hi = lane >> 5;
    const int j_lo = swa_jlo(cur.P0, W);
    int j_hi = (cur.P0 + QB - 1) / KVBLK + 1; if (j_hi > skv / KVBLK) j_hi = skv / KVBLK;
    const int NT = j_hi - j_lo;
    const int kbn = swa_jlo(nxt.P0, W) * KVBLK;
    const int qlo = cur.P0 + wid * QBLK, qm = qlo + r32 - 4 * hi;
    char* V_lds = lds; char* K_lds = lds + 2 * SHM_V;
    float* ws = (float*)(lds + 2 * SHM_V + 2 * SHM_K) + wid * 64; float* li_l = ws, * al_l = ws + 32;
    float m_reg = -1e30f, l_reg = 0; f32x16 o[4] = {};
    const int sr = tid >> 4, sc = (tid & 15) * 8, vst0 = v_st(sr, sc), vst1 = v_st(32 + sr, sc), kws = KSWZ(sr, sc * 2);
    const int vb0 = (int)(uintptr_t)V_lds + v_rd_base(lane);
    const TIn* Kh = cur.K(); const TIn* Vh = cur.V(); const float* Ch = cur.C(); int cb_t = S.cbi;
    {
        const TIn* gsrc = cur.G() + (size_t)(wid * QBLK + (lane >> 4)) * GPITCH + (lane & 15) * 8;
#pragma unroll
        for (int i_ = 0; i_ < 8; ++i_) __builtin_amdgcn_global_load_lds((const unsigned*)(gsrc + (size_t)(4 * i_) * GPITCH), (__attribute__((address_space(3))) unsigned*)(lds + LDS_GATE + wid * 8192 + i_ * 1024), 16, 0, 0); }
#define RESC(a) do { if (__any((a) < 1.f)) { if (hi == 0) al_l[r32] = (a); asm volatile("s_waitcnt lgkmcnt(0)" ::: "memory");              \
                     for (int d_ = 0; d_ < 4; ++d_) for (int r = 0; r < 16; ++r) o[d_][r] *= al_l[crow(r, hi)]; } } while (0)
#define KBASE(t) ((j_lo + (t)) * KVBLK)
#define ACT(t) (KBASE(t) <= qlo + QBLK - 1 && KBASE(t) + KVBLK - 1 >= qlo - W + 1)
#define MASKT(P0_, P1_, t) do { const int kb_ = KBASE(t); if ((!SK || ACT(t)) && (kb_ + KVBLK - 1 > qlo || kb_ <= qlo + QBLK - 1 - W)) mask_tile(P0_, P1_, qm - kb_, (unsigned)W); } while (0)
    constexpr int NQL = F32 ? 16 : 8;
    constexpr bool SK = WSKIP && !F32;
#define SEAM_K0() do { VMWN(NQL); if constexpr (F32) { SWRITE_KF(0); SBAR(); SLOAD_F((const float*)nxt.V(), kbn); } else { SWRITE_HK(0); } SBAR(); } while (0)
    f32x16 pA0, pA1, pB0, pB1; float mnA, mnB, alA, alB; bf16x8 pa0, pa1, pa2, pa3;
    if constexpr (F32) { VMW(); SWRITE_VF(0); SBAR(); } else { SWRITE_HV(0); SBAR(); }
    if (NT > 1) { if constexpr (F32) SLOAD_F((const float*)Kh, KBASE(1)); else SLOAD_H(Kh, Vh, Ch, KBASE(1), NEXT3(cb_t)); }
    SBAR(); qkt<0, SK>(pA0, pA1, K_lds, r32, hi, S.qr, ACT(0), cb_t);
    if constexpr (F32) { if (NT > 1) { VMW(); SWRITE_KF(1); SBAR(); SLOAD_F((const float*)Vh, KBASE(1)); } }
    MASKT(pA0, pA1, 0); partialSM(pA0, pA1, m_reg, mnA, alA);
    if (NT > 1) { VMW(); if constexpr (F32) { SWRITE_VF(1); SBAR(); if (NT > 2) SLOAD_F((const float*)Kh, KBASE(2)); } else SWRITE_H(1); }
    __syncthreads();
#define HALF_STEP(PX0, PX1, mnX, alX, PY0, PY1, alY, t, KB, VB, SB) do {                                                      \
        SBAR(); cb_t = NEXT3(cb_t); qkt<KB, SK>(PX0, PX1, K_lds, r32, hi, S.qr, ACT(t), cb_t);                                             \
        finishSM(PY0, PY1, alY, l_reg, pa0, pa1, pa2, pa3); SBAR();                                                           \
        if ((t) + 1 < NT) { if constexpr (F32) { VMW(); SWRITE_KF(SB); SBAR(); SLOAD_F((const float*)Vh, KBASE((t) + 1)); }  \
                            else { SLOAD_H(Kh, Vh, Ch, KBASE((t) + 1), NEXT3(cb_t)); } SBAR(); }                                               \
        pv_tile<VB, SK>(o, vb0, pa0, pa1, pa2, pa3, ACT((t) - 1)); MASKT(PX0, PX1, (t)); partialSM(PX0, PX1, m_reg, mnX, alX);                                        \
        __syncthreads();                                                                                                      \
        if ((t) + 1 < NT) { VMW(); if constexpr (F32) { SWRITE_VF(SB); SBAR(); if ((t) + 2 < NT) SLOAD_F((const float*)Kh, KBASE((t) + 2)); } \
                            else { SWRITE_H(SB); } }                                                                          \
        RESC(alX); __syncthreads(); } while (0)
    for (int t = 1; t + 1 < NT; t += 2) {
        HALF_STEP(pB0, pB1, mnB, alB, pA0, pA1, alA, t, 1, 0, 0);
        HALF_STEP(pA0, pA1, mnA, alA, pB0, pB1, alB, t + 1, 0, 1, 1);
    }
    const bool even = (NT & 1) == 0;
    if (even) { SBAR(); cb_t = NEXT3(cb_t); qkt<1, SK>(pB0, pB1, K_lds, r32, hi, S.qr, ACT(NT - 1), cb_t); SBAR(); }
#define QROW(e) (nxt.Q() + (size_t)(wid * QBLK + r32) * PITCH + ((e) >> 1) * 16 + hi * 8 + ((e) & 1) * 4)
    if constexpr (F32) { SLOAD_F((const float*)nxt.K(), kbn); SBAR();
#pragma unroll
        for (int e = 0; e < 8; ++e) S.tq[e] = *(const f32x4*)QROW(e); }
    else { SLOAD_H(nxt.K(), nxt.V(), nxt.C(), kbn, NEXT3(cb_t)); S.cbi = NEXT3(cb_t); SBAR();
#pragma unroll
        for (int d0 = 0; d0 < 8; ++d0) S.qr[d0] = load8<TIn>(nxt.Q() + (size_t)(wid * QBLK + r32) * PITCH + d0 * 16 + hi * 8); }
    SBAR();
    finishSM(pA0, pA1, alA, l_reg, pa0, pa1, pa2, pa3); SBAR();
    if constexpr (F32) {
#pragma unroll
        for (int e = 8; e < 16; ++e) S.tq[e] = *(const f32x4*)QROW(e); SBAR(); }
#undef QROW
    pv_tile<0, SK>(o, vb0, pa0, pa1, pa2, pa3, ACT(even ? NT - 2 : NT - 1));
    if (even) { MASKT(pB0, pB1, NT - 1); partialSM(pB0, pB1, m_reg, mnB, alB); __syncthreads(); RESC(alB);
        finishSM(pB0, pB1, alB, l_reg, pa0, pa1, pa2, pa3); SBAR(); pv_tile<1, SK>(o, vb0, pa0, pa1, pa2, pa3, ACT(NT - 1)); }
    SBAR(); SEAM_K0();
    if (hi == 0) li_l[r32] = l_reg; asm volatile("s_waitcnt lgkmcnt(0)" ::: "memory");
    float rli[16];
#pragma unroll
    for (int r = 0; r < 16; ++r) rli[r] = __builtin_amdgcn_rcpf(li_l[crow(r, hi)]);
    int hi_e = hi; asm volatile("" : "+v"(hi_e));
    TOut* Ow = cur.O() + (size_t)(wid * QBLK) * PITCH + (size_t)(4 * hi_e) * PITCH; const char* gl_ = lds + LDS_GATE + wid * 8192 + 4 * hi_e * 256;
#pragma unroll
    for (int r = 0; r < 16; ++r) { const int orow = (r & 3) + 8 * (r >> 2);
#pragma unroll
        for (int d0 = 0; d0 < 4; ++d0) { const float v = o[d0][r] * rli[r];
            if constexpr (same_t<TOut, float>::v) { Ow[(size_t)orow * PITCH + d0 * 32 + r32] = v; }
            else { const float vn = __shfl_xor(v, 1);
                   if ((r32 & 1) == 0) { const unsigned gw_ = *(const unsigned*)(gl_ + orow * 256 + (d0 * 32 + r32) * 2);
                       const float g0_ = __uint_as_float(gw_ << 16), g1_ = __uint_as_float(gw_ & 0xffff0000u);
                       const float s0_ = __builtin_amdgcn_rcpf(1.f + __builtin_amdgcn_exp2f(-1.4426950408889634f * g0_)), s1_ = __builtin_amdgcn_rcpf(1.f + __builtin_amdgcn_exp2f(-1.4426950408889634f * g1_));
                       *(unsigned*)(Ow + (size_t)orow * PITCH + d0 * 32 + r32) = cvtpk(v * s0_, vn * s1_); } } } }
    if constexpr (F32) {
#pragma unroll
        for (int d0 = 0; d0 < 8; ++d0) S.qr[d0] = pack8(S.tq[2 * d0], S.tq[2 * d0 + 1]); }
    __syncthreads();
#undef RESC
#undef KBASE
#undef ACT
#undef MASKT
#undef SEAM_K0
#undef HALF_STEP
}
#undef ROW
#undef VMW
#undef VMWN
#undef SLOAD_H
#undef SWRITE_HK
#undef SWRITE_HV
#undef SWRITE_H
#undef SLOAD_F
#undef SWRITE_KF
#undef SWRITE_VF

}
#ifndef RW_SOLVE_OLD
#define RW_SOLVE_OLD 0
#endif
namespace rw {
typedef short bf16x8 __attribute__((ext_vector_type(8)));
typedef float f32x4 __attribute__((ext_vector_type(4)));
typedef unsigned u32x4 __attribute__((ext_vector_type(4)));
typedef unsigned u32x2 __attribute__((ext_vector_type(2)));
#define RW_LAS __attribute__((address_space(3)))
constexpr int PB = 144, PF = 272, MB = 64 * PB;
constexpr int O_R = 0, O_K = MB, O_A = 2 * MB, O_B = 3 * MB, O_BT = 4 * MB, O_KT = 5 * MB, O_VT = 6 * MB, O_AAK = 7 * MB, O_ARB = 8 * MB, O_ARK = 9 * MB;
constexpr int O_AAB = 10 * MB, O_GT = O_AAB + 64 * PF, O_GAM = O_GT + 64 * PF, O_TOT = O_GAM + 256, O_END = O_TOT + 2048;
constexpr int O_AABB = O_END, O_TB = O_AABB + MB, O_END2 = O_TB + 4 * 768;
constexpr int O_WT = O_K, O_UT = O_AAK;
static_assert(O_END2 <= 143360, "phase A LDS map");
constexpr int REC = 32768, REC_P = 0, REC_Q = 8192, REC_H = 16384, REC_Y = 24576;
typedef float f32x2_t __attribute__((ext_vector_type(2))); typedef __bf16 bf16x2_t __attribute__((ext_vector_type(2)));
__device__ __forceinline__ unsigned cvtpk(float lo, float hi) { f32x2_t v = {lo, hi}; bf16x2_t b = __builtin_convertvector(v, bf16x2_t); return __builtin_bit_cast(unsigned, b); }
__device__ __forceinline__ float blo(unsigned w) { return __uint_as_float(w << 16); }
__device__ __forceinline__ float bhi(unsigned w) { return __uint_as_float(w & 0xffff0000u); }
__device__ __forceinline__ bf16x8 frag(const RW_LAS unsigned char* base, int tile, int ks, int lane) { return *(const RW_LAS bf16x8*)(base + (16 * tile + (lane & 15)) * PB + (ks * 32 + 8 * (lane >> 4)) * 2); }
#define RW_MFMA(a, b, c) __builtin_amdgcn_mfma_f32_16x16x32_bf16(a, b, c, 0, 0, 0)
#define RW_SYNC() __syncthreads()
#define RW_BAR() do { asm volatile("" ::: "memory"); __builtin_amdgcn_s_barrier(); asm volatile("" ::: "memory"); } while (0)

struct ChunkIn { u32x4 r, k, v, a; f32x4 l0, l1; };
__device__ __forceinline__ void load_chunk(ChunkIn& c, const unsigned char* ws, int it, int tid) {
    const int bh = it >> 8, ch = it & 255, b = bh >> 4, h = bh & 15, tok = tid >> 3, part = tid & 7;
    const size_t off = ((size_t)b * SEQ + (size_t)ch * 64 + tok) * 1024 + h * 64 + 8 * part;
    c.r = *(const u32x4*)((const unsigned short*)(ws + WS_R) + off); c.k = *(const u32x4*)((const unsigned short*)(ws + WS_K) + off); c.v = *(const u32x4*)((const unsigned short*)(ws + WS_V) + off);
    c.a = *(const u32x4*)((const unsigned short*)(ws + WS_A) + off); c.l0 = *(const f32x4*)((const float*)(ws + WS_LOGW) + off); c.l1 = *(const f32x4*)((const float*)(ws + WS_LOGW) + off + 4);
}
__device__ __forceinline__ void phase_a(RW_LAS unsigned char* L, unsigned char* ws, const float* kk_all, const float* ka_all, int wg, int G, int tid) {
    const int lane = tid & 63, w = __builtin_amdgcn_readfirstlane(tid >> 6), g = lane >> 4, l15 = lane & 15;
    ChunkIn cin; if (wg < 8192) load_chunk(cin, ws, wg, tid);
  for (int it = wg; it < 8192; it += G) {
    unsigned char* rec = ws + WS_REC + (size_t)it * REC; const float* kkw_g = kk_all + ((it >> 8) & 15) * 64; const float* kaw_g = ka_all + ((it >> 8) & 15) * 64;
    { const int tok = tid >> 3, part = tid & 7, c0 = 8 * part;
      const u32x4 rw_ = cin.r, kw_ = cin.k, vw_ = cin.v, aw_ = cin.a; const f32x4 l0 = cin.l0, l1 = cin.l1;
      float lw[8] = {l0[0], l0[1], l0[2], l0[3], l1[0], l1[1], l1[2], l1[3]}, cum[8];
#pragma unroll
      for (int i = 0; i < 8; ++i) { float v = lw[i];
          float u = __shfl_up(v, 8); if (lane >= 8) v += u; u = __shfl_up(v, 16); if (lane >= 16) v += u; u = __shfl_up(v, 32); if (lane >= 32) v += u; cum[i] = v; }
      RW_LAS float* tot = (RW_LAS float*)(L + O_TOT);
      if (lane >= 56) {
#pragma unroll
          for (int i = 0; i < 8; ++i) tot[w * 64 + c0 + i] = cum[i]; }
      RW_SYNC();
#pragma unroll
      for (int ww = 0; ww < 7; ++ww) if (ww < w) { const f32x4 a0 = *(const RW_LAS f32x4*)(tot + ww * 64 + c0), a1 = *(const RW_LAS f32x4*)(tot + ww * 64 + c0 + 4);
#pragma unroll
          for (int i = 0; i < 4; ++i) { cum[i] += a0[i]; cum[4 + i] += a1[i]; } }
      float r[8] = {blo(rw_.x), bhi(rw_.x), blo(rw_.y), bhi(rw_.y), blo(rw_.z), bhi(rw_.z), blo(rw_.w), bhi(rw_.w)};
      float k[8] = {blo(kw_.x), bhi(kw_.x), blo(kw_.y), bhi(kw_.y), blo(kw_.z), bhi(kw_.z), blo(kw_.w), bhi(kw_.w)};
      float a[8] = {blo(aw_.x), bhi(aw_.x), blo(aw_.y), bhi(aw_.y), blo(aw_.z), bhi(aw_.z), blo(aw_.w), bhi(aw_.w)};
      const f32x4 kk0 = *(const f32x4*)(kkw_g + c0), kk1 = *(const f32x4*)(kkw_g + c0 + 4), ka0 = *(const f32x4*)(kaw_g + c0), ka1 = *(const f32x4*)(kaw_g + c0 + 4);
      float kk[8], ss = 0.f;
#pragma unroll
      for (int i = 0; i < 8; ++i) { kk[i] = k[i] * (i < 4 ? kk0[i] : kk1[i - 4]); ss += kk[i] * kk[i]; }
      ss += __shfl_xor(ss, 1); ss += __shfl_xor(ss, 2); ss += __shfl_xor(ss, 4);
      const float inv = 1.f / fmaxf(sqrtf(ss), 1e-12f);
      float Rt[8], Kt[8], At[8], Bt[8];
#pragma unroll
      for (int i = 0; i < 8; ++i) { const float eL = __expf(cum[i]), eLi = __expf(-cum[i]), eLx = __expf(cum[i] - lw[i]); const float kn = kk[i] * inv;
          Rt[i] = r[i] * eL; Kt[i] = k[i] * (1.f + (a[i] - 1.f) * (i < 4 ? ka0[i] : ka1[i - 4])) * eLi; At[i] = -kn * eLx; Bt[i] = kn * a[i] * eLi;
          if (tok == 63) ((RW_LAS float*)(L + O_GAM))[c0 + i] = eL; }
      u32x4 o;
      o.x = cvtpk(Rt[0], Rt[1]); o.y = cvtpk(Rt[2], Rt[3]); o.z = cvtpk(Rt[4], Rt[5]); o.w = cvtpk(Rt[6], Rt[7]); *(RW_LAS u32x4*)(L + O_R + tok * PB + c0 * 2) = o;
      o.x = cvtpk(Kt[0], Kt[1]); o.y = cvtpk(Kt[2], Kt[3]); o.z = cvtpk(Kt[4], Kt[5]); o.w = cvtpk(Kt[6], Kt[7]); *(RW_LAS u32x4*)(L + O_K + tok * PB + c0 * 2) = o;
      const u32x4 kq = o;
      o.x = cvtpk(At[0], At[1]); o.y = cvtpk(At[2], At[3]); o.z = cvtpk(At[4], At[5]); o.w = cvtpk(At[6], At[7]); *(RW_LAS u32x4*)(L + O_A + tok * PB + c0 * 2) = o;
      o.x = cvtpk(Bt[0], Bt[1]); o.y = cvtpk(Bt[2], Bt[3]); o.z = cvtpk(Bt[4], Bt[5]); o.w = cvtpk(Bt[6], Bt[7]); *(RW_LAS u32x4*)(L + O_B + tok * PB + c0 * 2) = o;
      const unsigned bq[4] = {o.x, o.y, o.z, o.w}, kq4[4] = {kq.x, kq.y, kq.z, kq.w}, vq[4] = {vw_.x, vw_.y, vw_.z, vw_.w};
#pragma unroll
      for (int i = 0; i < 8; ++i) { const int sh = (i & 1) * 16;
          *(RW_LAS unsigned short*)(L + O_BT + (c0 + i) * PB + tok * 2) = (unsigned short)(bq[i >> 1] >> sh);
          *(RW_LAS unsigned short*)(L + O_KT + (c0 + i) * PB + tok * 2) = (unsigned short)(kq4[i >> 1] >> sh);
          *(RW_LAS unsigned short*)(L + O_VT + (c0 + i) * PB + tok * 2) = (unsigned short)(vq[i >> 1] >> sh); }
    }
    if (it + G < 8192) load_chunk(cin, ws, it + G, tid);
    RW_SYNC();
    const int t4 = w & 3, p2 = (w >> 2) * 2;
    { const bf16x8 b0 = frag(L + O_B, t4, 0, lane), b1 = frag(L + O_B, t4, 1, lane), k0 = frag(L + O_K, t4, 0, lane), k1 = frag(L + O_K, t4, 1, lane);
#pragma unroll
      for (int u = 0; u < 2; ++u) { const int nt = p2 + u, t = 16 * nt + l15, s0 = 16 * t4 + 4 * g;
          f32x4 ab = {0.f, 0.f, 0.f, 0.f}, ak = ab, rb = ab, rk = ab;
          if (t4 <= nt) { const bf16x8 a0 = frag(L + O_A, nt, 0, lane), a1 = frag(L + O_A, nt, 1, lane), r0 = frag(L + O_R, nt, 0, lane), r1 = frag(L + O_R, nt, 1, lane);
              ab = RW_MFMA(b0, a0, ab); ab = RW_MFMA(b1, a1, ab); ak = RW_MFMA(k0, a0, ak); ak = RW_MFMA(k1, a1, ak);
              rb = RW_MFMA(b0, r0, rb); rb = RW_MFMA(b1, r1, rb); rk = RW_MFMA(k0, r0, rk); rk = RW_MFMA(k1, r1, rk);
#pragma unroll
              for (int r = 0; r < 4; ++r) { const int s = s0 + r; if (!(s < t)) { ab[r] = 0.f; ak[r] = 0.f; } if (!(s <= t)) { rb[r] = 0.f; rk[r] = 0.f; } } }
          *(RW_LAS f32x4*)(L + O_AAB + t * PF + s0 * 4) = ab;
          u32x2 o; o.x = cvtpk(ab[0], ab[1]); o.y = cvtpk(ab[2], ab[3]); *(RW_LAS u32x2*)(L + O_AABB + t * PB + s0 * 2) = o;
          o.x = cvtpk(ak[0], ak[1]); o.y = cvtpk(ak[2], ak[3]); *(RW_LAS u32x2*)(L + O_AAK + t * PB + s0 * 2) = o;
          o.x = cvtpk(rb[0], rb[1]); o.y = cvtpk(rb[2], rb[3]); *(RW_LAS u32x2*)(L + O_ARB + t * PB + s0 * 2) = o;
          o.x = cvtpk(rk[0], rk[1]); o.y = cvtpk(rk[2], rk[3]); *(RW_LAS u32x2*)(L + O_ARK + t * PB + s0 * 2) = o; } }
    RW_SYNC();
    { const bf16x8 a0 = frag(L + O_AAK, t4, 0, lane), a1 = frag(L + O_AAK, t4, 1, lane);
#pragma unroll
      for (int u = 0; u < 2; ++u) { const int nt = p2 + u; f32x4 acc = {0.f, 0.f, 0.f, 0.f};
          acc = RW_MFMA(a0, frag(L + O_VT, nt, 0, lane), acc); acc = RW_MFMA(a1, frag(L + O_VT, nt, 1, lane), acc);
          *(RW_LAS f32x4*)(L + O_GT + (16 * nt + l15) * PF + (16 * t4 + 4 * g) * 4) = acc; } }
    if (w < 4 && lane < 16) {
        float x[16]; const RW_LAS unsigned char* ab = L + O_AAB + 16 * w * PF + 16 * w * 4;
#pragma unroll
        for (int r = 0; r < 16; ++r) { float a0 = (r == lane) ? 1.f : 0.f, a1 = 0.f;
#pragma unroll
            for (int q4 = 0; q4 < (r + 3) / 4; ++q4) { const f32x4 av = *(const RW_LAS f32x4*)(ab + r * PF + q4 * 16);
                if (4 * q4 + 0 < r) a0 += av[0] * x[4 * q4 + 0]; if (4 * q4 + 1 < r) a1 += av[1] * x[4 * q4 + 1]; if (4 * q4 + 2 < r) a0 += av[2] * x[4 * q4 + 2]; if (4 * q4 + 3 < r) a1 += av[3] * x[4 * q4 + 3]; }
            x[r] = a0 + a1; *(RW_LAS unsigned short*)(L + O_TB + w * 768 + r * 48 + lane * 2) = (unsigned short)(cvtpk(x[r], 0.f) & 0xffffu); } }
    RW_SYNC();
#if RW_SOLVE_OLD
    if (tid < 128) { const int c = tid;
        const RW_LAS unsigned char* rhs = c < 64 ? (L + O_A + c * 2) : (L + O_GT + (c - 64) * PF);
        RW_LAS unsigned char* dst = c < 64 ? (L + O_WT + c * PB) : (L + O_UT + (c - 64) * PB);
        for (int b = 0; b < 4; ++b) { float z[16];
#pragma unroll
            for (int r = 0; r < 16; ++r) z[r] = c < 64 ? blo((unsigned)*(const RW_LAS unsigned short*)(rhs + (16 * b + r) * PB)) : *(const RW_LAS float*)(rhs + (16 * b + r) * 4);
            const RW_LAS unsigned char* arow = L + O_AAB + 16 * b * PF;
            for (int s4 = 0; s4 < 4 * b; ++s4) { const u32x2 xw = *(const RW_LAS u32x2*)(dst + s4 * 8); const float x0 = blo(xw.x), x1 = bhi(xw.x), x2 = blo(xw.y), x3 = bhi(xw.y);
#pragma unroll
                for (int r = 0; r < 16; ++r) { const f32x4 av = *(const RW_LAS f32x4*)(arow + r * PF + s4 * 16); z[r] += (av[0] * x0 + av[1] * x1) + (av[2] * x2 + av[3] * x3); } }
#pragma unroll
            for (int r = 1; r < 16; ++r) {
#pragma unroll
                for (int q4 = 0; q4 < (r + 3) / 4; ++q4) { const f32x4 av = *(const RW_LAS f32x4*)(arow + r * PF + (4 * b + q4) * 16);
                    if (4 * q4 + 0 < r) z[r] += av[0] * z[4 * q4 + 0]; if (4 * q4 + 1 < r) z[r] += av[1] * z[4 * q4 + 1]; if (4 * q4 + 2 < r) z[r] += av[2] * z[4 * q4 + 2]; if (4 * q4 + 3 < r) z[r] += av[3] * z[4 * q4 + 3]; } }
            u32x4 o; o.x = cvtpk(z[0], z[1]); o.y = cvtpk(z[2], z[3]); o.z = cvtpk(z[4], z[5]); o.w = cvtpk(z[6], z[7]); *(RW_LAS u32x4*)(dst + 32 * b) = o;
            o.x = cvtpk(z[8], z[9]); o.y = cvtpk(z[10], z[11]); o.z = cvtpk(z[12], z[13]); o.w = cvtpk(z[14], z[15]); *(RW_LAS u32x4*)(dst + 32 * b + 16) = o;
            asm volatile("s_waitcnt lgkmcnt(0)" ::: "memory"); } }
    RW_SYNC();
#else
    { RW_LAS unsigned char* xt = (w < 4 ? L + O_WT : L + O_UT) + (w & 3) * 16 * PB;
      { const u32x4 z4 = {0u, 0u, 0u, 0u}; *(RW_LAS u32x4*)(xt + l15 * PB + g * 16) = z4; *(RW_LAS u32x4*)(xt + l15 * PB + 64 + g * 16) = z4; }
      asm volatile("s_waitcnt lgkmcnt(0)" ::: "memory");
#pragma unroll
      for (int b = 0; b < 4; ++b) { f32x4 z;
          if (w < 4) { const RW_LAS unsigned char* ap = L + O_A + (16 * b + 4 * g) * PB + (16 * w + l15) * 2;
              z = (f32x4){blo((unsigned)*(const RW_LAS unsigned short*)(ap)), blo((unsigned)*(const RW_LAS unsigned short*)(ap + PB)), blo((unsigned)*(const RW_LAS unsigned short*)(ap + 2 * PB)), blo((unsigned)*(const RW_LAS unsigned short*)(ap + 3 * PB))}; }
          else z = *(const RW_LAS f32x4*)(L + O_GT + (16 * (w - 4) + l15) * PF + (16 * b + 4 * g) * 4);
          if (b > 0) { z = RW_MFMA(frag(L + O_AABB, b, 0, lane), *(const RW_LAS bf16x8*)(xt + l15 * PB + (8 * g) * 2), z);
                       if (b > 2) z = RW_MFMA(frag(L + O_AABB, b, 1, lane), *(const RW_LAS bf16x8*)(xt + l15 * PB + (32 + 8 * g) * 2), z); }
          const u32x2 tw = *(const RW_LAS u32x2*)(L + O_TB + b * 768 + l15 * 48 + (4 * g) * 2);
          const u32x4 tf = {tw.x, tw.y, 0u, 0u}, zf = {cvtpk(z[0], z[1]), cvtpk(z[2], z[3]), 0u, 0u};
          f32x4 xb = {0.f, 0.f, 0.f, 0.f}; xb = RW_MFMA(__builtin_bit_cast(bf16x8, tf), __builtin_bit_cast(bf16x8, zf), xb);
          u32x2 o; o.x = cvtpk(xb[0], xb[1]); o.y = cvtpk(xb[2], xb[3]); *(RW_LAS u32x2*)(xt + l15 * PB + (16 * b + 4 * g) * 2) = o;
          asm volatile("s_waitcnt lgkmcnt(0)" ::: "memory"); } }
    RW_SYNC();
#endif
    {
      const bf16x8 rb0 = frag(L + O_ARB, t4, 0, lane), rb1 = frag(L + O_ARB, t4, 1, lane), bt0 = frag(L + O_BT, t4, 0, lane), bt1 = frag(L + O_BT, t4, 1, lane);
      const int col = 16 * t4 + l15; const float gam = ((const RW_LAS float*)(L + O_GAM))[col];
      unsigned qw[4], pw[4];
#pragma unroll
      for (int u = 0; u < 2; ++u) { const int mt = p2 + u, j0 = 16 * mt + 4 * g; const bf16x8 w0 = frag(L + O_WT, mt, 0, lane), w1 = frag(L + O_WT, mt, 1, lane);
          f32x4 q = {0.f, 0.f, 0.f, 0.f}, p = q; q = RW_MFMA(w0, rb0, q); q = RW_MFMA(w1, rb1, q); p = RW_MFMA(w0, bt0, p); p = RW_MFMA(w1, bt1, p);
          const u32x2 rr = *(const RW_LAS u32x2*)(L + O_R + col * PB + j0 * 2);
          q[0] += blo(rr.x); q[1] += bhi(rr.x); q[2] += blo(rr.y); q[3] += bhi(rr.y);
#pragma unroll
          for (int r = 0; r < 4; ++r) p[r] = (p[r] + ((j0 + r) == col ? 1.f : 0.f)) * gam;
          qw[2 * u] = cvtpk(q[0], q[1]); qw[2 * u + 1] = cvtpk(q[2], q[3]); pw[2 * u] = cvtpk(p[0], p[1]); pw[2 * u + 1] = cvtpk(p[2], p[3]); }
      const int fo = ((t4 * 2 + (p2 >> 1)) * 64 + lane) * 16;
      *(u32x4*)(rec + REC_Q + fo) = (u32x4){qw[0], qw[1], qw[2], qw[3]}; *(u32x4*)(rec + REC_P + fo) = (u32x4){pw[0], pw[1], pw[2], pw[3]}; }
    {
      const bf16x8 rb0 = frag(L + O_ARB, t4, 0, lane), rb1 = frag(L + O_ARB, t4, 1, lane), rk0 = frag(L + O_ARK, t4, 0, lane), rk1 = frag(L + O_ARK, t4, 1, lane);
      const bf16x8 ut0 = frag(L + O_UT, t4, 0, lane), ut1 = frag(L + O_UT, t4, 1, lane), vt0 = frag(L + O_VT, t4, 0, lane), vt1 = frag(L + O_VT, t4, 1, lane);
      const int col = 16 * t4 + l15;
#pragma unroll
      for (int u = 0; u < 2; ++u) { const int mt = p2 + u, m0 = 16 * mt + 4 * g;
          f32x4 y = {0.f, 0.f, 0.f, 0.f}, hm = y;
          y = RW_MFMA(frag(L + O_UT, mt, 0, lane), rb0, y); y = RW_MFMA(frag(L + O_UT, mt, 1, lane), rb1, y); y = RW_MFMA(frag(L + O_VT, mt, 0, lane), rk0, y); y = RW_MFMA(frag(L + O_VT, mt, 1, lane), rk1, y);
          hm = RW_MFMA(frag(L + O_BT, mt, 0, lane), ut0, hm); hm = RW_MFMA(frag(L + O_BT, mt, 1, lane), ut1, hm); hm = RW_MFMA(frag(L + O_KT, mt, 0, lane), vt0, hm); hm = RW_MFMA(frag(L + O_KT, mt, 1, lane), vt1, hm);
          const f32x4 gm = *(const RW_LAS f32x4*)(L + O_GAM + m0 * 4);
          u32x2 o; o.x = cvtpk(y[0], y[1]); o.y = cvtpk(y[2], y[3]); *(u32x2*)(rec + REC_Y + (col * 64 + m0) * 2) = o;
          o.x = cvtpk(hm[0] * gm[0], hm[1] * gm[1]); o.y = cvtpk(hm[2] * gm[2], hm[3] * gm[3]); *(u32x2*)(rec + REC_H + (col * 64 + m0) * 2) = o; } }
    RW_SYNC();
  }
}

__device__ __forceinline__ void phase_b_head(RW_LAS unsigned char* L, const unsigned char* recs, float* Yg, int tid) {
    constexpr int NCH = 256, NSLOT = 4;
    const int lane = tid & 63, w = __builtin_amdgcn_readfirstlane(tid >> 6), g = lane >> 4, l15 = lane & 15;
    if (w >= 4) {
        const int lw = w - 4; const unsigned char* src = recs + lw * 8192 + lane * 16;
#define RW_ISSUE(c_) do { _Pragma("unroll") for (int k_ = 0; k_ < 8; ++k_) __builtin_amdgcn_global_load_lds((const unsigned*)(src + (size_t)(c_) * REC + k_ * 1024), (RW_LAS unsigned*)(L + ((c_) & 3) * REC + lw * 8192 + k_ * 1024), 16, 0, 0); } while (0)
        RW_ISSUE(0); RW_ISSUE(1); RW_ISSUE(2);
        asm volatile("s_waitcnt vmcnt(16)" ::: "memory");
        RW_BAR();
        for (int c = 0; c < NCH; ++c) {
            if (c + 3 < NCH) { RW_ISSUE(c + 3); asm volatile("s_waitcnt vmcnt(16)" ::: "memory"); }
            else asm volatile("s_waitcnt vmcnt(0)" ::: "memory");
            RW_BAR();
        }
#undef RW_ISSUE
    } else {
        f32x4 sacc[4];
#pragma unroll
        for (int m = 0; m < 4; ++m) sacc[m] = (f32x4){0.f, 0.f, 0.f, 0.f};
        RW_BAR();
        for (int c = 0; c < NCH; ++c) { const RW_LAS unsigned char* sl = L + (c & 3) * REC;
            bf16x8 bf[2];
#pragma unroll
            for (int s = 0; s < 2; ++s) { u32x4 v; v.x = cvtpk(sacc[2 * s][0], sacc[2 * s][1]); v.y = cvtpk(sacc[2 * s][2], sacc[2 * s][3]); v.z = cvtpk(sacc[2 * s + 1][0], sacc[2 * s + 1][1]); v.w = cvtpk(sacc[2 * s + 1][2], sacc[2 * s + 1][3]); bf[s] = __builtin_bit_cast(bf16x8, v); }
            f32x4 sn[4];
#pragma unroll
            for (int m = 0; m < 4; ++m) { const u32x2 hw = *(const RW_LAS u32x2*)(sl + REC_H + ((16 * w + l15) * 64 + 16 * m + 4 * g) * 2);
                f32x4 acc = {blo(hw.x), bhi(hw.x), blo(hw.y), bhi(hw.y)};
                acc = RW_MFMA(*(const RW_LAS bf16x8*)(sl + REC_P + ((m * 2 + 0) * 64 + lane) * 16), bf[0], acc);
                acc = RW_MFMA(*(const RW_LAS bf16x8*)(sl + REC_P + ((m * 2 + 1) * 64 + lane) * 16), bf[1], acc); sn[m] = acc; }
#pragma unroll
            for (int n = 0; n < 4; ++n) { const u32x2 yw = *(const RW_LAS u32x2*)(sl + REC_Y + ((16 * n + l15) * 64 + 16 * w + 4 * g) * 2);
                f32x4 acc = {blo(yw.x), bhi(yw.x), blo(yw.y), bhi(yw.y)};
                acc = RW_MFMA(bf[0], *(const RW_LAS bf16x8*)(sl + REC_Q + ((n * 2 + 0) * 64 + lane) * 16), acc);
                acc = RW_MFMA(bf[1], *(const RW_LAS bf16x8*)(sl + REC_Q + ((n * 2 + 1) * 64 + lane) * 16), acc);
                *(f32x4*)(Yg + (size_t)(c * 64 + 16 * n + l15) * 1024 + 16 * w + 4 * g) = acc; }
#pragma unroll
            for (int m = 0; m < 4; ++m) sacc[m] = sn[m];
            asm volatile("s_waitcnt lgkmcnt(0)" ::: "memory");
            RW_BAR();
        }
    }
}
}
#define XB_TMO      128
#define XB_XCNT(j)  (256  + 64 * (j))
#define XB_XSUB(j)  (1280 + 64 * (j))
#define XB_XGEN(j)  (2304 + 64 * (j))
#define XB_TOP      3328
#define XB_TOPGEN   3392
#define XCD_BAR_WORDS 3456
#define XB_SPIN_CAP (1u << 18)

__device__ __forceinline__ unsigned xb_ld(unsigned* p)              { return __hip_atomic_load(p, __ATOMIC_RELAXED, __HIP_MEMORY_SCOPE_AGENT); }
__device__ __forceinline__ unsigned xb_add(unsigned* p, unsigned v) { return __hip_atomic_fetch_add(p, v, __ATOMIC_RELAXED, __HIP_MEMORY_SCOPE_AGENT); }
__device__ __forceinline__ unsigned xb_xcc_id() { return (unsigned)__builtin_amdgcn_s_getreg((3 << 11) | 20) & 0xFu; }
#define XB_SPIN(cond, bar) do { unsigned _sp = 0; while (cond) { __builtin_amdgcn_s_sleep(1); \
    if ((++_sp & 255u) == 0u) { if (xb_ld(&(bar)[XB_TMO])) break; if (_sp > XB_SPIN_CAP) { atomicAdd(&(bar)[XB_TMO], 1u); break; } } } } while (0)

struct XcdBarrier {
    unsigned* bar; unsigned x;
    volatile LAS unsigned* st;
};

__device__ __forceinline__ XcdBarrier xcd_barrier_post(unsigned* bar, volatile LAS unsigned* st, const int tid) {
    XcdBarrier b; b.bar = bar; b.x = xb_xcc_id(); b.st = st;
    if (tid == 0) (void)xb_add(&bar[XB_XCNT(b.x)], 1u);
    return b;
}
__device__ __forceinline__ void xcd_barrier_complete(unsigned* bar, unsigned x, unsigned& nloc, unsigned& nx) {
    const unsigned G = gridDim.x * gridDim.y * gridDim.z;
    unsigned sum, cnt, mine, sp = 0u;
    for (;;) {
        sum = 0u; cnt = 0u; mine = 0u;
#pragma unroll
        for (unsigned j = 0; j < 16; ++j) { const unsigned c = xb_ld(&bar[XB_XCNT(j)]); sum += c; cnt += (c > 0u) ? 1u : 0u; mine = (j == x) ? c : mine; }
        if (sum == G) break;
        __builtin_amdgcn_s_sleep(1);
        if ((++sp & 255u) == 0u) { if (xb_ld(&bar[XB_TMO])) break; if (sp > XB_SPIN_CAP) { atomicAdd(&bar[XB_TMO], 1u); break; } }
    }
    nloc = mine > 0u ? mine : 1u; nx = cnt > 0u ? cnt : 1u;
}

__device__ __forceinline__ void xcd_barrier(const XcdBarrier& b, const int tid) {
    asm volatile("s_waitcnt vmcnt(0)" ::: "memory");
    __syncthreads();
    if (tid == 0) {
        unsigned* bar = b.bar;
        __builtin_amdgcn_s_waitcnt(0);
        unsigned nloc = b.st[0], nx = b.st[1];
        if (nloc == 0u) { xcd_barrier_complete(bar, b.x, nloc, nx); b.st[0] = nloc; b.st[1] = nx; }
        const unsigned old = xb_add(&bar[XB_XSUB(b.x)], 1u);
        const unsigned gen = old / nloc;
        if (old + 1u == (gen + 1u) * nloc) {
            __builtin_amdgcn_fence(__ATOMIC_RELEASE, "agent");
            asm volatile("s_waitcnt vmcnt(0)" ::: "memory");
            const unsigned og = xb_add(&bar[XB_TOP], 1u);
            const unsigned tg = og / nx;
            if (og + 1u == (tg + 1u) * nx) xb_add(&bar[XB_TOPGEN], 1u);
            else XB_SPIN(xb_ld(&bar[XB_TOPGEN]) == tg, bar);
            __builtin_amdgcn_fence(__ATOMIC_ACQUIRE, "agent");
            xb_add(&bar[XB_XGEN(b.x)], 1u);
            asm volatile("s_waitcnt vmcnt(0)" ::: "memory");
        } else {
            XB_SPIN(xb_ld(&bar[XB_XGEN(b.x)]) == gen, bar);
            __builtin_amdgcn_fence(__ATOMIC_ACQUIRE, "agent");
            asm volatile("s_waitcnt vmcnt(0)" ::: "memory");
        }
    }
    __syncthreads();
}
enum InIdx { I_X = 0, I_C, I_WADA, I_BADA, I_N1G, I_WIN, I_MU, I_WDEC, I_W0, I_WICLR, I_A0, I_WGATE, I_KK, I_KA, I_RK, I_GNG, I_GNB, I_WOA, I_BF, I_QN, I_KN, I_WOB, I_WOUT, I_N2G, I_WR, I_BR, I_WGU, I_BGU, I_WDN, I_BDN, I_NFG, N_IN };
struct Args { const float* in[N_IN]; float* out; unsigned char* ws; int ph_lo, ph_hi; };
static_assert(sizeof(Args) == (N_IN + 2) * 8 + 8, "Args has no padding");
typedef const __attribute__((address_space(4))) Args* ArgsP;
struct Frame {
    LAS unsigned char* lds;
    volatile LAS unsigned* MISC;
    gu32* ctl;
    int tid, lane, wave, G, wg;
    unsigned char* ws;
    ArgsP ap;
};
#define WSP(T_, off) ((T_*)(F.ws + (off)))

__device__ __forceinline__ int win_orig_col(int c) {
    if (c < PC_FQ) return c;
    if (c < PC_OG) return 3520 + (c - PC_FQ);
    if (c < PC_GA) return 6600 + (c - PC_OG);
    if (c < PC_GLO) return 7624 + (c - PC_GA);
    if (c < PC_DLO) return 3264 + (c - PC_GLO);
    if (c < PC_ALO) return 3072 + (c - PC_DLO);
    if (c < PC_F) return 3168 + (c - PC_ALO);
    if (c < PC_END) return 6592 + (c - PC_F);
    return -1;
}
__device__ __forceinline__ void tr_item(const float* W, int ldw, int K, bf16* WT, int drow0, int scol0, int nvalid, int k0, LAS float* scr, int lane) {
    const int n = lane & 31;
#pragma unroll 8
    for (int i = 0; i < 32; ++i) { const int kk = 2 * i + (lane >> 5); scr[kk * 33 + n] = (n < nvalid) ? W[(size_t)(k0 + kk) * ldw + scol0 + n] : 0.f; }
    LDS_WAIT(); asm volatile("" ::: "memory");
    const int c = lane & 7;
#pragma unroll
    for (int j = 0; j < 4; ++j) { const int nn = (lane >> 3) + 8 * j; const LAS float* s = scr + (8 * c) * 33 + nn;
        v4u o; o.x = pk2(s[0 * 33], s[1 * 33]); o.y = pk2(s[2 * 33], s[3 * 33]); o.z = pk2(s[4 * 33], s[5 * 33]); o.w = pk2(s[6 * 33], s[7 * 33]);
        *(GAS v4u*)(WT + (size_t)(drow0 + nn) * K + k0 + 8 * c) = o; }
    LDS_WAIT(); asm volatile("" ::: "memory");
}
__device__ __forceinline__ void p0_prologue(Frame& F) {
    LAS float* scr = (LAS float*)(F.lds + RING_OFF + F.wave * 16384);
    const int gw = F.wg * NWAVES + F.wave, NGW = F.G * NWAVES, lane = F.lane;
    constexpr int I_IN = 32 * 368, I_OA = 16 * 64, I_OB = I_OA, I_OUT = 32 * 64, I_GU = NE * 32 * 128, I_DN = NE * 32 * 64;
    constexpr int NITEMS = I_IN + I_OA + I_OB + I_OUT + I_GU + I_DN;
    for (int it = gw; it < NITEMS; it += NGW) {
        int r = it;
        if (r < I_IN) { const int kb = r / 368, gp = r % 368, c0 = gp * 32, oc = win_orig_col(c0); int nv = 32; if (oc < 0) nv = 0; else if (c0 + 32 > PC_END) nv = PC_END - c0;
            tr_item(F.ap->in[I_WIN], 11720, 2048, WSP(bf16, WS_WIN), c0, oc < 0 ? 0 : oc, nv, kb * 64, scr, lane); continue; } r -= I_IN;
        if (r < I_OA) { tr_item(F.ap->in[I_WOA], 2048, 1024, WSP(bf16, WS_WOA), (r % 64) * 32, (r % 64) * 32, 32, (r / 64) * 64, scr, lane); continue; } r -= I_OA;
        if (r < I_OB) { tr_item(F.ap->in[I_WOB], 2048, 1024, WSP(bf16, WS_WOB), (r % 64) * 32, (r % 64) * 32, 32, (r / 64) * 64, scr, lane); continue; } r -= I_OB;
        if (r < I_OUT) { tr_item(F.ap->in[I_WOUT], 2048, 2048, WSP(bf16, WS_WOUT), (r % 64) * 32, (r % 64) * 32, 32, (r / 64) * 64, scr, lane); continue; } r -= I_OUT;
        if (r < I_GU) { const int e = r / (32 * 128), q = r % (32 * 128), kb = q / 128, gp = q % 128, d0 = gp * 32;
            const int pn = d0 >> 8, j = d0 & 255, sc = j < 128 ? 128 * pn + j : 2048 + 128 * pn + (j - 128);
            tr_item(F.ap->in[I_WGU] + (size_t)e * 2048 * 4096, 4096, 2048, WSP(bf16, WS_WGU) + (size_t)e * 4096 * 2048, d0, sc, 32, kb * 64, scr, lane); continue; } r -= I_GU;
        { const int e = r / (32 * 64), q = r % (32 * 64), kb = q / 64, gp = q % 64;
            tr_item(F.ap->in[I_WDN] + (size_t)e * 2048 * 2048, 2048, 2048, WSP(bf16, WS_WDN) + (size_t)e * 2048 * 2048, gp * 32, gp * 32, 32, kb * 64, scr, lane); }
    }
    const int gt = F.wg * (NWAVES * 64) + F.tid, NGT = F.G * NWAVES * 64;
    { bf16* b1 = WSP(bf16, WS_BT1); const float* wd = F.ap->in[I_WDEC]; const float* wi = F.ap->in[I_WICLR];
      for (int i = gt; i < 2048 * 256; i += NGT) { const int n = i >> 8, k = i & 255; float v = 0.f;
          if (n < 1024) { if (k < 96) v = wd[k * 1024 + n]; } else { if (k >= 128 && k < 224) v = wi[(k - 128) * 1024 + (n - 1024)]; }
          b1[i] = (bf16)f2bf(v); } }
    { bf16* b2 = WSP(bf16, WS_BT2); const float* wg = F.ap->in[I_WGATE];
      for (int i = gt; i < 1024 * 256; i += NGT) { const int n = i >> 8, k = i & 255; b2[i] = (bf16)f2bf(wg[k * 1024 + n]); } }
    { float* wrt = WSP(float, WS_WRT); const float* wr = F.ap->in[I_WR];
      for (int i = gt; i < 32 * 2048; i += NGT) { const int e = i >> 11, k = i & 2047; wrt[i] = wr[k * 32 + e]; } }
    { bf16* h = WSP(bf16, WS_H) + (size_t)T * DM; for (int i = gt; i < DM; i += NGT) h[i] = 0; }
    if (F.wg < 192) {
        const float* wa = F.ap->in[I_WADA]; const float* cc = F.ap->in[I_C]; const int n = F.wg * 64 + lane;
        float s0 = 0.f, s1 = 0.f;
        for (int k = F.wave * 256; k < F.wave * 256 + 256; ++k) { const float w = wa[(size_t)k * 12288 + n]; const float c0 = cc[k], c1 = cc[2048 + k];
            s0 += c0 * sigmoidf_(c0) * w; s1 += c1 * sigmoidf_(c1) * w; }
        LAS float* red = (LAS float*)(F.lds + RING_OFF + 131072 - 4096);
        __syncthreads();
        red[(F.wave * 2 + 0) * 64 + lane] = s0; red[(F.wave * 2 + 1) * 64 + lane] = s1;
        __syncthreads();
        if (F.wave < 2) { float s = 0.f;
#pragma unroll
            for (int w = 0; w < 8; ++w) s += red[(w * 2 + F.wave) * 64 + lane];
            WSP(float, WS_MOD)[F.wave * 12288 + n] = s + F.ap->in[I_BADA][n]; }
    }
}
__device__ __forceinline__ void norm_mod_rows(Frame& F, const float* x, const float* g, int shift_off, int scale_off, bf16* H) {
    const int gw = F.wg * NWAVES + F.wave, NGW = F.G * NWAVES, lane = F.lane; const float* mod = WSP(float, WS_MOD);
    for (int m = gw; m < T; m += NGW) {
        const f32x4* xr = (const f32x4*)(x + (size_t)m * DM) + lane; f32x4 v[8]; float ss = 0.f;
#pragma unroll
        for (int j = 0; j < 8; ++j) { v[j] = xr[64 * j]; ss += (v[j].x * v[j].x + v[j].y * v[j].y) + (v[j].z * v[j].z + v[j].w * v[j].w); }
        const float rs = rsqrtf(wave_sum(ss) * (1.f / DM) + NORM_EPS); const float* mb = mod + (size_t)(m / SEQ) * 12288;
#pragma unroll
        for (int j = 0; j < 8; ++j) { const int c = 4 * lane + 256 * j; const f32x4 gg = *(const f32x4*)(g + c), sc = *(const f32x4*)(mb + scale_off + c), sh = *(const f32x4*)(mb + shift_off + c);
            const f32x4 y = v[j] * rs * gg * (sc + 1.f) + sh; v2u o; o.x = pk2(y.x, y.y); o.y = pk2(y.z, y.w); *(v2u*)(H + (size_t)m * DM + c) = o; }
    }
}
__device__ __forceinline__ void p3_prep(Frame& F) {
    const int gw = F.wg * NWAVES + F.wave, NGW = F.G * NWAVES, lane = F.lane;
    const bf16* P = WSP(bf16, WS_P); const float* mu = F.ap->in[I_MU];
    bf16* Rb = WSP(bf16, WS_R); bf16* LW = WSP(bf16, WS_LW); bf16* SG = WSP(bf16, WS_SG);
    for (int t = gw; t < T; t += NGW) {
        const bf16* pc = P + (size_t)t * NP; const bool first = (t % SEQ) == 0; const bf16* pp = first ? pc : pc - NP;
#pragma unroll
        for (int s = 0; s < 6; ++s) { const int c = (s * 64 + lane) * 8; float a[8], b[8], o[8]; unpack8(*(const v4u*)(pc + c), a); unpack8(*(const v4u*)(pp + c), b);
            const f32x4 m0 = *(const f32x4*)(mu + c), m1 = *(const f32x4*)(mu + c + 4);
#pragma unroll
            for (int i = 0; i < 8; ++i) { const float pv = first ? 0.f : b[i]; const float mm = i < 4 ? m0[i] : m1[i - 4]; o[i] = a[i] + mm * (pv - a[i]); }
            *(v4u*)(Rb + (size_t)(c >> 10) * ((WS_K - WS_R) / 2) + (size_t)t * RW + (c & 1023)) = pack8f(o); }
        { int c, mi; if (lane < 32) { c = PC_GLO + 8 * lane; mi = 3264 + 8 * lane; } else if (lane < 44) { c = PC_DLO + 8 * (lane - 32); mi = 3072 + 8 * (lane - 32); } else { c = PC_ALO + 8 * (lane - 44); mi = 3168 + 8 * (lane - 44); }
          float o[8] = {0.f, 0.f, 0.f, 0.f, 0.f, 0.f, 0.f, 0.f};
          if (lane < 56) { float a[8], b[8]; unpack8(*(const v4u*)(pc + c), a); unpack8(*(const v4u*)(pp + c), b);
              const f32x4 m0 = *(const f32x4*)(mu + mi), m1 = *(const f32x4*)(mu + mi + 4);
#pragma unroll
              for (int i = 0; i < 8; ++i) { const float pv = first ? 0.f : b[i]; const float mm = i < 4 ? m0[i] : m1[i - 4]; const float v = a[i] + mm * (pv - a[i]);
                  o[i] = lane < 32 ? sigmoidf_(v) : (lane < 44 ? tanhf(v) : v); } }
          bf16* dst; if (lane < 32) dst = SG + (size_t)t * 256 + 8 * lane; else if (lane < 44) dst = LW + (size_t)t * 256 + 8 * (lane - 32); else if (lane < 56) dst = LW + (size_t)t * 256 + 128 + 8 * (lane - 44);
          else if (lane < 60) dst = LW + (size_t)t * 256 + 96 + 8 * (lane - 56); else dst = LW + (size_t)t * 256 + 224 + 8 * (lane - 60);
          *(v4u*)dst = pack8f(o); }
#pragma unroll
        for (int s = 0; s < 2; ++s) { const int ch = s * 64 + lane, d0 = (ch & 15) * 8;
#pragma unroll
            for (int qk = 0; qk < 2; ++qk) { float a[8]; unpack8(*(const v4u*)(pc + (qk ? PC_FK : PC_FQ) + ch * 8), a); float ss = 0.f;
#pragma unroll
                for (int i = 0; i < 8; ++i) ss += a[i] * a[i];
                ss += __shfl_xor(ss, 1); ss += __shfl_xor(ss, 2); ss += __shfl_xor(ss, 4); ss += __shfl_xor(ss, 8);
                const float rs = rsqrtf(ss * (1.f / 128.f) + NORM_EPS); const float* gn = F.ap->in[qk ? I_KN : I_QN] + d0;
                const f32x4 g0 = *(const f32x4*)gn, g1 = *(const f32x4*)(gn + 4);
#pragma unroll
                for (int i = 0; i < 8; ++i) a[i] = a[i] * rs * (i < 4 ? g0[i] : g1[i - 4]);
                *(v4u*)(WSP(bf16, qk ? WS_FK : WS_FQ) + (size_t)t * FW + ch * 8) = pack8f(a); }
            *(v4u*)(WSP(bf16, WS_FV) + (size_t)t * FW + ch * 8) = *(const v4u*)(pc + PC_FV + ch * 8); }
        if (lane < 8) { const float xv = bflo((unsigned)pc[PC_F + lane]) + F.ap->in[I_BF][lane];
            WSP(float, WS_LF)[(size_t)t * 8 + lane] = fminf(xv, 0.f) - log1pf(__expf(-fabsf(xv))); }
    }
}
__device__ __forceinline__ void p4_cumsum(Frame& F) {
    if (F.wg >= 16) return;
    const int b = F.wg >> 3, h = F.wg & 7; const float* lf = WSP(float, WS_LF) + (size_t)b * SEQ * 8 + h; float* cs = WSP(float, WS_CS) + (size_t)F.wg * SEQ;
    LAS float* part = (LAS float*)(F.lds + RING_OFF);
    const int t0 = F.tid * 32; float s = 0.f;
    for (int i = 0; i < 32; ++i) s += lf[(size_t)(t0 + i) * 8];
    part[F.tid] = s; __syncthreads();
    if (F.tid == 0) { float run = 0.f; for (int i = 0; i < 512; ++i) { const float v = part[i]; part[i] = run; run += v; } }
    __syncthreads();
    float run = part[F.tid];
    for (int i = 0; i < 32; ++i) { run += lf[(size_t)(t0 + i) * 8]; cs[t0 + i] = -run * 11.313708498984761f; }
    __syncthreads();
}
__device__ __forceinline__ void p5_scan_naive(Frame& F) {
    constexpr int CH = 64;
    LAS float* Wl = (LAS float*)(F.lds + RING_OFF); LAS float* Al = Wl + CH * 64; LAS float* Bl = Al + CH * 64; LAS float* Kl = Bl + CH * 64; LAS float* Rl = Kl + CH * 64; LAS float* Vl = Rl + CH * 64; LAS float* Yl = Vl + CH * 64;
    const int tid = F.tid, row = tid >> 3, q = tid & 7;
    for (int bh = F.wg; bh < 32; bh += F.G) {
        const int b = bh >> 4, h = bh & 15; const size_t base = (size_t)b * SEQ * RW + h * 64;
        const bf16* Rg = WSP(bf16, WS_R) + base; const bf16* Kg = WSP(bf16, WS_K) + base; const bf16* Vg = WSP(bf16, WS_V) + base; const bf16* Ag = WSP(bf16, WS_A) + base;
        const float* Lg = WSP(float, WS_LOGW) + base; float* Yg = WSP(float, WS_YRAW) + base;
        float kkw[8], kaw[8];
#pragma unroll
        for (int i = 0; i < 8; ++i) { kkw[i] = F.ap->in[I_KK][h * 64 + 8 * q + i]; kaw[i] = F.ap->in[I_KA][h * 64 + 8 * q + i]; }
        float S[8] = {0.f, 0.f, 0.f, 0.f, 0.f, 0.f, 0.f, 0.f};
        for (int t0 = 0; t0 < SEQ; t0 += CH) {
            { const size_t off = (size_t)(t0 + row) * RW + 8 * q; float r[8], k[8], v[8], a[8];
              unpack8(*(const v4u*)(Rg + off), r); unpack8(*(const v4u*)(Kg + off), k); unpack8(*(const v4u*)(Vg + off), v); unpack8(*(const v4u*)(Ag + off), a);
              const f32x4 l0 = *(const f32x4*)(Lg + off), l1 = *(const f32x4*)(Lg + off + 4);
              float kk[8], ss = 0.f;
#pragma unroll
              for (int i = 0; i < 8; ++i) { kk[i] = k[i] * kkw[i]; ss += kk[i] * kk[i]; }
              ss += __shfl_xor(ss, 1); ss += __shfl_xor(ss, 2); ss += __shfl_xor(ss, 4);
              const float inv = 1.f / fmaxf(sqrtf(ss), 1e-12f);
#pragma unroll
              for (int i = 0; i < 8; ++i) { const int o = row * 64 + 8 * q + i; kk[i] *= inv;
                  Wl[o] = __expf(i < 4 ? l0[i] : l1[i - 4]); Al[o] = -kk[i]; Bl[o] = kk[i] * a[i]; Kl[o] = k[i] * (1.f + (a[i] - 1.f) * kaw[i]); Rl[o] = r[i]; Vl[o] = v[i]; } }
            __syncthreads();
            for (int t = 0; t < CH; ++t) { const int o = t * 64 + 8 * q; float sa = 0.f;
                const f32x4 a0 = *(const LAS f32x4*)(Al + o), a1 = *(const LAS f32x4*)(Al + o + 4), w0 = *(const LAS f32x4*)(Wl + o), w1 = *(const LAS f32x4*)(Wl + o + 4);
                const f32x4 b0 = *(const LAS f32x4*)(Bl + o), b1 = *(const LAS f32x4*)(Bl + o + 4), k0 = *(const LAS f32x4*)(Kl + o), k1 = *(const LAS f32x4*)(Kl + o + 4);
                const f32x4 r0 = *(const LAS f32x4*)(Rl + o), r1 = *(const LAS f32x4*)(Rl + o + 4); const float vv = Vl[t * 64 + row];
#pragma unroll
                for (int i = 0; i < 8; ++i) sa += S[i] * (i < 4 ? a0[i] : a1[i - 4]);
                sa += __shfl_xor(sa, 1); sa += __shfl_xor(sa, 2); sa += __shfl_xor(sa, 4);
                float y = 0.f;
#pragma unroll
                for (int i = 0; i < 8; ++i) { S[i] = S[i] * (i < 4 ? w0[i] : w1[i - 4]) + sa * (i < 4 ? b0[i] : b1[i - 4]) + vv * (i < 4 ? k0[i] : k1[i - 4]); y += S[i] * (i < 4 ? r0[i] : r1[i - 4]); }
                y += __shfl_xor(y, 1); y += __shfl_xor(y, 2); y += __shfl_xor(y, 4);
                if (q == 0) Yl[t * 64 + row] = y; }
            __syncthreads();
            { const int tt = tid >> 3, c = (tid & 7) * 8; *(f32x4*)(Yg + (size_t)(t0 + tt) * RW + c) = *(const LAS f32x4*)(Yl + tt * 64 + c); *(f32x4*)(Yg + (size_t)(t0 + tt) * RW + c + 4) = *(const LAS f32x4*)(Yl + tt * 64 + c + 4); }
        }
        __syncthreads();
    }
}
__device__ __forceinline__ void p7_post(Frame& F) {
    const int gw = F.wg * NWAVES + F.wave, NGW = F.G * NWAVES, lane = F.lane, c0 = 16 * lane;
    for (int t = gw; t < T; t += NGW) { const size_t off = (size_t)t * RW + c0;
        float y[16], r[16], k[16], v[16], a[16], g[16];
#pragma unroll
        for (int j = 0; j < 4; ++j) { const f32x4 yy = *(const f32x4*)(WSP(float, WS_YRAW) + off + 4 * j); y[4 * j] = yy.x; y[4 * j + 1] = yy.y; y[4 * j + 2] = yy.z; y[4 * j + 3] = yy.w; }
#pragma unroll
        for (int j = 0; j < 2; ++j) { float tmp[8];
            unpack8(*(const v4u*)(WSP(bf16, WS_R) + off + 8 * j), tmp); for (int i = 0; i < 8; ++i) r[8 * j + i] = tmp[i];
            unpack8(*(const v4u*)(WSP(bf16, WS_K) + off + 8 * j), tmp); for (int i = 0; i < 8; ++i) k[8 * j + i] = tmp[i];
            unpack8(*(const v4u*)(WSP(bf16, WS_V) + off + 8 * j), tmp); for (int i = 0; i < 8; ++i) v[8 * j + i] = tmp[i];
            unpack8(*(const v4u*)(WSP(bf16, WS_A) + off + 8 * j), tmp); for (int i = 0; i < 8; ++i) a[8 * j + i] = tmp[i];
            unpack8(*(const v4u*)(WSP(bf16, WS_G) + off + 8 * j), tmp); for (int i = 0; i < 8; ++i) g[8 * j + i] = tmp[i]; }
        float s = 0.f, bs = 0.f;
#pragma unroll
        for (int i = 0; i < 16; ++i) { s += y[i]; const float kp = k[i] * (1.f + (a[i] - 1.f) * F.ap->in[I_KA][c0 + i]); bs += r[i] * kp * F.ap->in[I_RK][c0 + i]; }
        s += __shfl_xor(s, 1); s += __shfl_xor(s, 2); bs += __shfl_xor(bs, 1); bs += __shfl_xor(bs, 2);
        const float mean = s * (1.f / 64.f); float q = 0.f;
#pragma unroll
        for (int i = 0; i < 16; ++i) { const float d = y[i] - mean; q += d * d; }
        q += __shfl_xor(q, 1); q += __shfl_xor(q, 2);
        const float rstd = rsqrtf(q * (1.f / 64.f) + GN_EPS); float o[16];
#pragma unroll
        for (int i = 0; i < 16; ++i) o[i] = ((y[i] - mean) * rstd * F.ap->in[I_GNG][c0 + i] + F.ap->in[I_GNB][c0 + i] + bs * v[i]) * g[i];
#pragma unroll
        for (int j = 0; j < 2; ++j) { v4u w; w.x = pk2(o[8 * j], o[8 * j + 1]); w.y = pk2(o[8 * j + 2], o[8 * j + 3]); w.z = pk2(o[8 * j + 4], o[8 * j + 5]); w.w = pk2(o[8 * j + 6], o[8 * j + 7]); *(v4u*)(WSP(bf16, WS_YA) + off + 8 * j) = w; }
    }
}
__device__ __forceinline__ fox::BlockRef<fox::bf16, fox::bf16> fox_ref(int L_, int pass_, const unsigned char* ws) {
    constexpr int NQB = fox::SQ / fox::QB, NX = NQB / 2;
    const int bh = L_ / NX, x = L_ % NX, qb = pass_ ? (NQB - 1 - x) : x;
    fox::BlockRef<fox::bf16, fox::bf16> r; r.ws = ws; r.row0 = (bh / fox::H) * fox::SQ + qb * fox::QB; r.bh = bh; r.P0 = qb * fox::QB; return r;
}
__device__ __forceinline__ void p6_attention(Frame& F, char* lds) {
    constexpr int NQB = fox::SQ / fox::QB, NX = NQB / 2, TOTAL = NX * fox::B * fox::H;
    const int stride = F.G; int L = F.wg; if (L >= TOTAL) return;
    int pass = 0;
    fox::BlockRef<fox::bf16, fox::bf16> cur = fox_ref(L, 0, F.ws);
    fox::Seam<fox::bf16> S;
    fox::causal_swa_prime<fox::bf16, fox::bf16>(cur, fox::WINDOW, lds, S, F.tid);
    for (;;) {
        const bool more_pass = pass == 0, more_item = L + stride < TOTAL, last = !more_pass && !more_item;
        int passn = pass + 1, Ln = L;
        if (!more_pass) { passn = 0; Ln = more_item ? L + stride : L; }
        const fox::BlockRef<fox::bf16, fox::bf16> nxt = last ? cur : fox_ref(Ln, passn, F.ws);
        fox::causal_swa_block<fox::bf16, fox::bf16>(cur, nxt, fox::SKV, fox::WINDOW, lds, S, F.tid);
        if (last) break;
        cur = nxt; pass = passn; L = Ln;
    }
}
typedef float f32x4m __attribute__((ext_vector_type(4)));
__device__ __forceinline__ void p11_router(Frame& F) {
    constexpr int TPW = T / 256 / NWAVES;
    const int lane = F.lane, t0 = (F.wg * NWAVES + F.wave) * TPW;
    const float* x1 = WSP(float, WS_X1); const float* mod = WSP(float, WS_MOD) + (size_t)(t0 / SEQ) * 12288; const float* g2 = F.ap->in[I_N2G]; bf16* H = WSP(bf16, WS_H);
    LAS float* lg = (LAS float*)(F.lds + RING_OFF + F.wave * 4096);
    LAS int* cnt = (LAS int*)(F.lds + RING_OFF + 65536);
    if (F.tid < 32) cnt[F.tid] = 0;
    __syncthreads();
    for (int i = 0; i < TPW; ++i) { const int m = t0 + i;
        const f32x4* xr = (const f32x4*)(x1 + (size_t)m * DM) + lane; f32x4 v[8]; float ss = 0.f;
#pragma unroll
        for (int j = 0; j < 8; ++j) { v[j] = xr[64 * j]; ss += (v[j].x * v[j].x + v[j].y * v[j].y) + (v[j].z * v[j].z + v[j].w * v[j].w); }
        const float rs = rsqrtf(wave_sum(ss) * (1.f / DM) + NORM_EPS);
        if (lane == 0) lg[512 + i] = rs;
#pragma unroll
        for (int j = 0; j < 8; ++j) { const int c = 4 * lane + 256 * j; const f32x4 gg = *(const f32x4*)(g2 + c), sc = *(const f32x4*)(mod + 4 * 2048 + c), sh = *(const f32x4*)(mod + 3 * 2048 + c);
            const f32x4 y = v[j] * rs * gg * (sc + 1.f) + sh; v2u o; o.x = pk2(y.x, y.y); o.y = pk2(y.z, y.w); *(v2u*)(H + (size_t)m * DM + c) = o; }
    }
    LDS_WAIT();
    { const int i = lane & 15, q = lane >> 4; const float rs = lg[512 + i]; const float* xr = x1 + (size_t)(t0 + i) * DM + 4 * q; const float* wr = WSP(float, WS_WRT) + (size_t)i * DM + 4 * q;
      f32x4m acc0 = {0.f, 0.f, 0.f, 0.f}, acc1 = {0.f, 0.f, 0.f, 0.f};
#pragma unroll 4
      for (int Sx = 0; Sx < DM / 16; ++Sx) { const int k = 16 * Sx;
          const f32x4 xv = *(const f32x4*)(xr + k), gg = *(const f32x4*)(g2 + k + 4 * q), sc = *(const f32x4*)(mod + 4 * 2048 + k + 4 * q), sh = *(const f32x4*)(mod + 3 * 2048 + k + 4 * q);
          const f32x4 hv = xv * rs * gg * (sc + 1.f) + sh; const f32x4 w0 = *(const f32x4*)(wr + k), w1 = *(const f32x4*)(wr + 16 * DM + k);
#pragma unroll
          for (int jj = 0; jj < 4; ++jj) { acc0 = __builtin_amdgcn_mfma_f32_16x16x4f32(hv[jj], w0[jj], acc0, 0, 0, 0); acc1 = __builtin_amdgcn_mfma_f32_16x16x4f32(hv[jj], w1[jj], acc1, 0, 0, 0); } }
      const float b0 = F.ap->in[I_BR][i], b1 = F.ap->in[I_BR][16 + i];
#pragma unroll
      for (int r = 0; r < 4; ++r) { lg[(4 * q + r) * 32 + i] = acc0[r] + b0; lg[(4 * q + r) * 32 + 16 + i] = acc1[r] + b1; } }
    LDS_WAIT();
    if (lane < 16) { const int m = t0 + lane; float v[4]; int e[4]; unsigned used = 0u;
#pragma unroll
        for (int k = 0; k < 4; ++k) { float best = -3.0e38f; int bi = 0;
            for (int j = 0; j < 32; ++j) { const float x = lg[lane * 32 + j]; if (!((used >> j) & 1u) && x > best) { best = x; bi = j; } }
            used |= 1u << bi; v[k] = best; e[k] = bi; }
        const float e1 = __expf(v[1] - v[0]), e2 = __expf(v[2] - v[0]), e3 = __expf(v[3] - v[0]), inv = 1.f / (1.f + e1 + e2 + e3);
        *(f32x4*)(WSP(float, WS_TOKW) + (size_t)m * 4) = (f32x4){inv, e1 * inv, e2 * inv, e3 * inv};
        int* te = WSP(int, WS_TOKE) + (size_t)m * 4; te[0] = e[0]; te[1] = e[1]; te[2] = e[2]; te[3] = e[3];
#pragma unroll
        for (int k = 0; k < 4; ++k) __hip_atomic_fetch_add(cnt + e[k], 1, __ATOMIC_RELAXED, __HIP_MEMORY_SCOPE_WORKGROUP); }
    __syncthreads();
    if (F.tid < 32) WSP(int, WS_WGCNT)[F.wg * 32 + F.tid] = cnt[F.tid];
    __syncthreads();
}
__device__ __forceinline__ void p12_slots(Frame& F) {
    constexpr int TPG = T / 256;
    LAS int* cur = (LAS int*)(F.lds + RING_OFF); LAS int* tot = cur + 32; LAS int* pre = cur + 64; LAS int* off = cur + 96; LAS int* slotl = cur + 160;
    const int* wgcnt = WSP(int, WS_WGCNT);
    if (F.tid < 32) { int tt = 0, pp = 0; for (int w = 0; w < 256; ++w) { const int c = wgcnt[w * 32 + F.tid]; if (w < F.wg) pp += c; tt += c; } tot[F.tid] = tt; pre[F.tid] = pp; }
    __syncthreads();
    if (F.tid == 0) { int o = 0; for (int e = 0; e < 32; ++e) { off[e] = o; o += (tot[e] + 255) & ~255; } off[32] = o; }
    __syncthreads();
    if (F.tid < 32) cur[F.tid] = off[F.tid] + pre[F.tid];
    if (F.wg == 0) { int* te = WSP(int, WS_TILEE); const int nt = off[32] >> 8;
        for (int p = F.tid; p < nt; p += NWAVES * 64) { int e = 0; for (int j = 1; j < 32; ++j) if ((p << 8) >= off[j]) e = j; te[p] = e; }
        if (F.tid == 0) te[1024] = nt; }
    __syncthreads();
    { const int t = F.wg * TPG + (F.tid >> 2), k = F.tid & 3; const int e = WSP(int, WS_TOKE)[(size_t)t * 4 + k];
      const int s = __hip_atomic_fetch_add(cur + e, 1, __ATOMIC_RELAXED, __HIP_MEMORY_SCOPE_WORKGROUP);
      slotl[F.tid] = s; WSP(int, WS_TOKS)[(size_t)t * 4 + k] = s; WSP(float, WS_SLOTW)[s] = WSP(float, WS_TOKW)[(size_t)t * 4 + k]; }
    __syncthreads();
    const bf16* H = WSP(bf16, WS_H); bf16* HS = WSP(bf16, WS_HS);
    for (int i = 0; i < TPG / NWAVES; ++i) { const int tl = F.wave * (TPG / NWAVES) + i, t = F.wg * TPG + tl; v4u v[4];
#pragma unroll
        for (int j = 0; j < 4; ++j) v[j] = *(const v4u*)(H + (size_t)t * DM + 8 * (F.lane + 64 * j));
#pragma unroll
        for (int k = 0; k < 4; ++k) { const int s = slotl[tl * 4 + k];
#pragma unroll
            for (int j = 0; j < 4; ++j) *(v4u*)(HS + (size_t)s * DM + 8 * (F.lane + 64 * j)) = v[j]; } }
    __syncthreads();
}
__device__ __forceinline__ void p15_final(Frame& F) {
    const int gw = F.wg * NWAVES + F.wave, NGW = F.G * NWAVES, lane = F.lane;
    const float* x1 = WSP(float, WS_X1); const bf16* YS = WSP(bf16, WS_HS); const float* gf = F.ap->in[I_NFG];
    for (int m = gw; m < T; m += NGW) { const float* gt = WSP(float, WS_MOD) + (size_t)(m / SEQ) * 12288 + 5 * 2048;
        const int4 sl = *(const int4*)(WSP(int, WS_TOKS) + (size_t)m * 4); float v[4][8]; float ss = 0.f;
#pragma unroll
        for (int j = 0; j < 4; ++j) { const int c = 8 * (lane + 64 * j); float y[8] = {0.f, 0.f, 0.f, 0.f, 0.f, 0.f, 0.f, 0.f}, tmp[8];
            unpack8(*(const v4u*)(YS + (size_t)sl.x * DM + c), tmp); for (int i = 0; i < 8; ++i) y[i] += tmp[i];
            unpack8(*(const v4u*)(YS + (size_t)sl.y * DM + c), tmp); for (int i = 0; i < 8; ++i) y[i] += tmp[i];
            unpack8(*(const v4u*)(YS + (size_t)sl.z * DM + c), tmp); for (int i = 0; i < 8; ++i) y[i] += tmp[i];
            unpack8(*(const v4u*)(YS + (size_t)sl.w * DM + c), tmp); for (int i = 0; i < 8; ++i) y[i] += tmp[i];
            const f32x4 xa = *(const f32x4*)(x1 + (size_t)m * DM + c), xb = *(const f32x4*)(x1 + (size_t)m * DM + c + 4), ga = *(const f32x4*)(gt + c), gb = *(const f32x4*)(gt + c + 4);
#pragma unroll
            for (int i = 0; i < 8; ++i) { const float xv = (i < 4 ? xa[i] : xb[i - 4]) + (i < 4 ? ga[i] : gb[i - 4]) * y[i]; v[j][i] = xv; ss += xv * xv; } }
        const float rs = rsqrtf(wave_sum(ss) * (1.f / DM) + NORM_EPS);
#pragma unroll
        for (int j = 0; j < 4; ++j) { const int c = 8 * (lane + 64 * j); const f32x4 ga = *(const f32x4*)(gf + c), gb = *(const f32x4*)(gf + c + 4);
            *(f32x4*)(F.ap->out + (size_t)m * DM + c) = (f32x4){v[j][0] * rs * ga[0], v[j][1] * rs * ga[1], v[j][2] * rs * ga[2], v[j][3] * rs * ga[3]};
            *(f32x4*)(F.ap->out + (size_t)m * DM + c + 4) = (f32x4){v[j][4] * rs * gb[0], v[j][5] * rs * gb[1], v[j][6] * rs * gb[2], v[j][7] * rs * gb[3]}; }
    }
}

__device__ __forceinline__ bool fresh(Frame& F) {
    asm volatile("" : "+s"(F.ap)); int w = F.wave; asm volatile("" : "+s"(w)); const int l = __builtin_amdgcn_mbcnt_hi(~0u, __builtin_amdgcn_mbcnt_lo(~0u, 0u)); F.lane = l; F.tid = w * 64 + l; return true; }
constexpr int N_PHASES = 18;
__global__ void __launch_bounds__(NWAVES * 64, 2) mk_fwd(Args args) {
    extern __shared__ __attribute__((aligned(16))) unsigned char lds[];
    Frame F;
    F.lds = (LAS unsigned char*)lds; F.MISC = (volatile LAS unsigned*)(F.lds + MISC_OFF);
    F.tid = threadIdx.x; F.lane = F.tid & 63; F.wave = __builtin_amdgcn_readfirstlane(F.tid >> 6); F.G = gridDim.x; F.wg = blockIdx.x;
    F.ap = (ArgsP)__builtin_amdgcn_kernarg_segment_ptr(); F.ws = F.ap->ws; F.ctl = (gu32*)(F.ws + WS_CTL);
    for (int u = F.tid; u < (LDS_BYTES - LDSCTL_OFF) / 4; u += NWAVES * 64) ((LAS unsigned*)(F.lds + LDSCTL_OFF))[u] = 0u;
    __syncthreads();
    const int lo = F.ap->ph_lo, hi = F.ap->ph_hi;
    XcdBarrier bar; bar.bar = (unsigned*)(F.ctl + CW_BAR); bar.x = 0; bar.st = nullptr;
    if (hi - lo > 1) bar = xcd_barrier_post((unsigned*)(F.ctl + CW_BAR), F.MISC + 8, F.tid);
#ifndef PH_MASK
#define PH_MASK 0x3ffff
#endif
#define IN(k) (((PH_MASK >> (k)) & 1) && lo <= (k) && (k) < hi && fresh(F))
#ifndef PROBE_DUP
#define PROBE_DUP 0
#endif
#define REP(k) for (int rep_ = 0; rep_ < 1 + ((PROBE_DUP >> (k)) & 1); ++rep_)
#define SEAM(k) do { if (IN(k) && IN((k) + 1)) xcd_barrier(bar, F.tid); } while (0)
    if (IN(0)) REP(0) { p0_prologue(F); } SEAM(0);
    if (IN(1)) REP(1) { norm_mod_rows(F, F.ap->in[I_X], F.ap->in[I_N1G], 0, 2048, WSP(bf16, WS_H)); } SEAM(1);
    if (IN(2)) REP(2) { pg8::Gemm g{WSP(bf16, WS_H), WSP(bf16, WS_WIN), T, NP, DM}; pg8::StaticOrder S; S.init(T, NP, F.G, F.wg);
        pg8::EpiBf16<0> E{WSP(bf16, WS_P), NP, nullptr, 0, 0, 1.f}; pg8::gemm_phase<pg8::EpiBf16<0>, pg8::StaticOrder, true, true>(F.lds + RING_OFF, g, S, E, F.tid); } SEAM(2);
    if (IN(3)) REP(3) { p3_prep(F); } SEAM(3);
    if (IN(4)) REP(4) { p4_cumsum(F);
        { pg8::Gemm g{WSP(bf16, WS_LW), WSP(bf16, WS_BT1), T, 2048, 256}; pg8::StaticOrder S; S.init(T, 2048, F.G, F.wg);
          pg8::EpiLora1 E{WSP(float, WS_LOGW), WSP(bf16, WS_A), F.ap->in[I_W0], F.ap->in[I_A0]}; pg8::gemm_phase<pg8::EpiLora1, pg8::StaticOrder, true, true>(F.lds + RING_OFF, g, S, E, F.tid); }
        } SEAM(4);
    if (IN(5)) REP(5) {
        { pg8::Gemm g{WSP(bf16, WS_SG), WSP(bf16, WS_BT2), T, 1024, 256}; pg8::StaticOrder S; S.init(T, 1024, F.G, F.wg);
          pg8::EpiBf16<0> E{WSP(bf16, WS_G), 1024, nullptr, 0, 0, 1.f}; pg8::gemm_phase<pg8::EpiBf16<0>, pg8::StaticOrder, true, true>(F.lds + RING_OFF, g, S, E, F.tid); }
        } SEAM(5);
    if (IN(6)) REP(6) {
#if RWKV_NAIVE
        p5_scan_naive(F);
#else
        rw::phase_a(F.lds + RING_OFF, F.ws, F.ap->in[I_KK], F.ap->in[I_KA], F.wg, F.G, F.tid);
#endif
        } SEAM(6);
    if (IN(7)) REP(7) {
#if !RWKV_NAIVE
        for (int bh = F.wg; bh < 32; bh += F.G) { const int b = bh >> 4, h = bh & 15;
            rw::phase_b_head(F.lds + RING_OFF, F.ws + WS_REC + (size_t)bh * 256 * rw::REC, WSP(float, WS_YRAW) + (size_t)b * SEQ * RW + h * 64, F.tid); __syncthreads(); }
#endif
        } SEAM(7);
    if (IN(8)) REP(8) { p6_attention(F, (char*)lds + RING_OFF); } SEAM(8);
    if (IN(9)) REP(9) { p7_post(F); } SEAM(9);
    if (IN(10)) REP(10) { pg8::Gemm g{WSP(bf16, WS_YA), WSP(bf16, WS_WOA), T, DM, 1024}; pg8::StaticOrder S; S.init(T, DM, F.G, F.wg);
        pg8::EpiGateMerge<0> E{WSP(bf16, WS_MRG), WSP(bf16, WS_P), PC_GA}; pg8::gemm_phase<pg8::EpiGateMerge<0>, pg8::StaticOrder, true, true>(F.lds + RING_OFF, g, S, E, F.tid); } SEAM(10);
    if (IN(11)) REP(11) { pg8::Gemm g{WSP(bf16, WS_YB), WSP(bf16, WS_WOB), T, DM, 1024}; pg8::StaticOrder S; S.init(T, DM, F.G, F.wg);
        pg8::EpiGateMerge<1> E{WSP(bf16, WS_MRG), WSP(bf16, WS_P), PC_GB}; pg8::gemm_phase<pg8::EpiGateMerge<1>, pg8::StaticOrder, true, true>(F.lds + RING_OFF, g, S, E, F.tid); } SEAM(11);
    if (IN(12)) REP(12) { pg8::Gemm g{WSP(bf16, WS_MRG), WSP(bf16, WS_WOUT), T, DM, DM}; pg8::StaticOrder S; S.init(T, DM, F.G, F.wg);
        pg8::EpiResid E{F.ap->in[I_X], WSP(float, WS_X1), WSP(float, WS_MOD)}; pg8::gemm_phase<pg8::EpiResid, pg8::StaticOrder, true, true>(F.lds + RING_OFF, g, S, E, F.tid); } SEAM(12);
    if (IN(13)) REP(13) { p11_router(F); } SEAM(13);
    if (IN(14)) REP(14) { p12_slots(F); } SEAM(14);
    if (IN(15)) REP(15) { const int nt = WSP(int, WS_TILEE)[1024]; pg8::Gemm g{WSP(bf16, WS_HS), WSP(bf16, WS_WGU), nt * 256, 4096, DM}; pg8::MoeOrder S; S.init(nt * 256, 4096, F.G, F.wg); S.tile_e = WSP(int, WS_TILEE);
        pg8::EpiSwiglu E{WSP(bf16, WS_ACT), F.ap->in[I_BGU]}; pg8::gemm_phase<pg8::EpiSwiglu, pg8::MoeOrder, true, true>(F.lds + RING_OFF, g, S, E, F.tid); } SEAM(15);
    if (IN(16)) REP(16) { const int nt = WSP(int, WS_TILEE)[1024]; pg8::Gemm g{WSP(bf16, WS_ACT), WSP(bf16, WS_WDN), nt * 256, 2048, DFF}; pg8::MoeOrder S; S.init(nt * 256, 2048, F.G, F.wg); S.tile_e = WSP(int, WS_TILEE);
        pg8::EpiDown E{WSP(bf16, WS_HS), F.ap->in[I_BDN], WSP(float, WS_SLOTW)}; pg8::gemm_phase<pg8::EpiDown, pg8::MoeOrder, true, true>(F.lds + RING_OFF, g, S, E, F.tid); } SEAM(16);
    if (IN(17)) REP(17) { p15_final(F); }
#undef IN
#undef SEAM
}

extern "C" void kernel_launch(void* const* d_in, const int* in_sizes, int n_in, void* d_out, int out_size, void* d_ws, size_t ws_size, hipStream_t stream) {
    static int grid = 0;
    if (grid == 0) {
        if (n_in != N_IN || in_sizes[0] != T * DM || out_size != T * DM || ws_size < WS_END) { fprintf(stderr, "kernel_launch: shape/workspace mismatch (n_in %d, in0 %d, out %d, ws %zu < %zu)\n", n_in, n_in > 0 ? in_sizes[0] : -1, out_size, ws_size, (size_t)WS_END); grid = -1; return; }
        if (hipFuncSetAttribute((const void*)mk_fwd, hipFuncAttributeMaxDynamicSharedMemorySize, LDS_BYTES) != hipSuccess) { fprintf(stderr, "kernel_launch: hipFuncSetAttribute failed\n"); grid = -1; return; }
        int per_cu = 0;
        if (hipOccupancyMaxActiveBlocksPerMultiprocessor(&per_cu, (const void*)mk_fwd, NWAVES * 64, LDS_BYTES) != hipSuccess || per_cu < 1) fprintf(stderr, "kernel_launch: note: occupancy query reports %d workgroups per CU\n", per_cu);
        (void)hipGetLastError();
        grid = 256;
    }
    if (grid < 0) return;
    (void)hipMemsetAsync((char*)d_ws + WS_CTL, 0, CTL_ZERO_BYTES, stream);
    Args a{};
    for (int i = 0; i < N_IN; ++i) a.in[i] = (const float*)d_in[i];
    a.out = (float*)d_out; a.ws = (unsigned char*)d_ws;
#if MK_N_LAUNCHES == 1
    a.ph_lo = 0; a.ph_hi = N_PHASES;
    hipLaunchKernelGGL(mk_fwd, dim3(grid), dim3(NWAVES * 64), LDS_BYTES, stream, a);
#else
    for (int p = 0; p < N_PHASES; ++p) { a.ph_lo = p; a.ph_hi = p + 1; hipLaunchKernelGGL(mk_fwd, dim3(grid), dim3(NWAVES * 64), LDS_BYTES, stream, a); }
#endif
}
```

```cpp
#include <hip/hip_runtime.h>
#include <hip/hip_bf16.h>
#include <cstdio>
#include <cstdint>
constexpr int NWAVES = 8;
#ifndef MK_N_LAUNCHES
#define MK_N_LAUNCHES 1
#endif
#ifndef RWKV_NAIVE
#define RWKV_NAIVE 0
#endif
constexpr int BATCH = 2, SEQ = 16384, DM = 2048, T = BATCH * SEQ;
constexpr int NP = 11776;
constexpr int PC_R = 0, PC_K = 1024, PC_V = 2048, PC_FQ = 3072, PC_FK = 4096, PC_FV = 5120, PC_OG = 6144, PC_GA = 7168, PC_GB = 9216, PC_GLO = 11264, PC_DLO = 11520, PC_ALO = 11616, PC_F = 11712, PC_END = 11720;
constexpr int RW = 1024, FW = 1024, NE = 32, DFF = 2048, TOPK = 4;
constexpr int NSLOT = T * TOPK + NE * 256;
constexpr float NORM_EPS = 1e-6f, GN_EPS = 64e-5f;
constexpr float FP8_SW = 64.f, FP8_SA1 = 2.f, FP8_SA2 = 4.f;

constexpr size_t MiB = 1u << 20;
constexpr size_t WS_CTL = 0, CTL_ZERO_BYTES = 1 * MiB;
constexpr size_t WS_MOD = 1 * MiB;
constexpr size_t WS_WRT = 1 * MiB + 128 * 1024;
constexpr size_t WS_TOKE = 2 * MiB, WS_TOKW = 2 * MiB + 512 * 1024, WS_TOKS = 3 * MiB, WS_SLOTW = 3 * MiB + 512 * 1024;
constexpr size_t WS_WGCNT = 4 * MiB + 512 * 1024, WS_TILEE = 4 * MiB + 768 * 1024;
constexpr size_t WS_LF = 5 * MiB, WS_CS = 6 * MiB;
constexpr size_t WS_BT1 = 7 * MiB, WS_BT2 = 8 * MiB, WS_WOA = 9 * MiB, WS_WOB = 13 * MiB, WS_WOUT = 17 * MiB, WS_WIN = 25 * MiB;
constexpr size_t WS_WGU = 72 * MiB, WS_WDN = 584 * MiB, WS_X1 = 840 * MiB, WS_H = 1096 * MiB;
constexpr size_t WS_P = 1226 * MiB, WS_R = 1962 * MiB, WS_K = 2026 * MiB, WS_V = 2090 * MiB, WS_FQ = 2154 * MiB, WS_FK = 2218 * MiB, WS_FV = 2282 * MiB;
constexpr size_t WS_LW = 2346 * MiB, WS_SG = 2362 * MiB, WS_LOGW = 2378 * MiB, WS_A = 2506 * MiB, WS_G = 2570 * MiB, WS_YRAW = 2634 * MiB, WS_YA = 2762 * MiB, WS_YB = 2826 * MiB, WS_MRG = 2890 * MiB;
constexpr size_t WS_HS = 1226 * MiB, WS_ACT = 1500 * MiB, WS_YS = 1774 * MiB;
constexpr size_t WS_REC = 3018 * MiB;
constexpr size_t WS_END = 3274 * MiB;
static_assert(WS_WIN + (size_t)NP * DM * 2 <= WS_WGU && WS_YS + (size_t)NSLOT * DM * 2 <= WS_REC && WS_HS + (size_t)NSLOT * DM <= WS_ACT && WS_ACT + (size_t)NSLOT * DFF <= WS_YS && WS_SLOTW + (size_t)NSLOT * 4 <= WS_WGCNT, "d_ws map");
constexpr int CW_TMO = 0, CW_BAR = 4096;

constexpr int RING_OFF = 0, RING_BYTES = 143360;
constexpr int LDSCTL_OFF = RING_BYTES, MISC_OFF = LDSCTL_OFF + 320;
constexpr int LDS_BYTES = 147456;

#define GAS __attribute__((address_space(1)))
#define LAS __attribute__((address_space(3)))
typedef unsigned short bf16;
typedef unsigned v4u __attribute__((ext_vector_type(4)));
typedef unsigned v2u __attribute__((ext_vector_type(2)));
typedef float f32x4 __attribute__((ext_vector_type(4)));
typedef short bf16x8 __attribute__((ext_vector_type(8)));
typedef GAS unsigned gu32;
#define RLX_AGENT __ATOMIC_RELAXED, __HIP_MEMORY_SCOPE_AGENT
#define LDS_WAIT() asm volatile("s_waitcnt lgkmcnt(0)" ::: "memory")
#define VM_WAIT() asm volatile("s_waitcnt vmcnt(0)" ::: "memory")
__device__ __forceinline__ unsigned f2bf(float f) { unsigned u = __builtin_bit_cast(unsigned, f); return (u + 0x7fffu + ((u >> 16) & 1u)) >> 16; }
__device__ __forceinline__ unsigned pk2(float lo, float hi) { return f2bf(lo) | (f2bf(hi) << 16); }
__device__ __forceinline__ float bflo(unsigned w) { return __uint_as_float(w << 16); }
__device__ __forceinline__ float bfhi(unsigned w) { return __uint_as_float(w & 0xffff0000u); }
__device__ __forceinline__ void unpack8(v4u w, float (&f)[8]) { f[0] = bflo(w.x); f[1] = bfhi(w.x); f[2] = bflo(w.y); f[3] = bfhi(w.y); f[4] = bflo(w.z); f[5] = bfhi(w.z); f[6] = bflo(w.w); f[7] = bfhi(w.w); }
__device__ __forceinline__ v4u pack8f(const float (&f)[8]) { v4u w; w.x = pk2(f[0], f[1]); w.y = pk2(f[2], f[3]); w.z = pk2(f[4], f[5]); w.w = pk2(f[6], f[7]); return w; }
__device__ __forceinline__ float sigmoidf_(float x) { return 1.f / (1.f + __expf(-x)); }
__device__ __forceinline__ float wave_sum(float v) {
#pragma unroll
    for (int o = 1; o < 64; o <<= 1) v += __shfl_xor(v, o);
    return v;
}
namespace pg8 {
#define PG8_LAS __attribute__((address_space(3)))
typedef unsigned short bf16_t;
typedef short bf16x8 __attribute__((ext_vector_type(8)));
typedef float f32x4 __attribute__((ext_vector_type(4)));
typedef unsigned u32x4 __attribute__((ext_vector_type(4)));
constexpr int BM = 256, BK = 64, HALF = 128, HTB = HALF * BK * 2  , STAGE_BYTES = 8 * HTB, NXCD = 8, WGM = 8;

__host__ __device__ __forceinline__ int lds_byte(int r, int c) { const int st = (r >> 4) * 2 + (c >> 5), rr = r & 15, cc = c & 31, ob = rr * 64 + cc * 2; return st * 1024 + (ob ^ (((ob >> 9) & 1) << 5)); }
__host__ __device__ __forceinline__ void stage_rc(int b, int& R, int& C) { const int st = b / 1024, sb = b % 1024, swz = sb ^ (((sb >> 9) & 1) << 5); R = (st >> 1) * 16 + swz / 64; C = (st & 1) * 32 + (swz % 64) / 2; }
__host__ __device__ __forceinline__ int perm32(int rho) { const int n = rho >> 4, i = rho & 15; return 8 * (i >> 2) + 4 * n + (i & 3); }

struct Unit { int pm, pn, e; };
struct Gemm { const bf16_t* A; const bf16_t* Bt; int M, N, K; };

struct StaticOrder {
    int nM, nN, nwg, G, c;
    __host__ __device__ void init(int M, int N, int G_, int c_) { nM = M / BM; nN = N / BM; nwg = nM * nN; G = G_; c = c_; }
    __host__ __device__ bool next(int i, Unit& u) const {
        const long L = (long)i * G + c; if (L >= nwg) return false;
        int wgid = (int)L; { const int q = nwg / NXCD, r = nwg % NXCD, xcd = wgid % NXCD, off = wgid / NXCD; wgid = (xcd < r ? xcd * (q + 1) : r * (q + 1) + (xcd - r) * q) + off; }
        const int nig = WGM * nN, gid = wgid / nig, fm = gid * WGM, gsz = (nM - fm) < WGM ? (nM - fm) : WGM;
        u.pm = fm + ((wgid % nig) % gsz); u.pn = (wgid % nig) / gsz; u.e = 0; return true;
    }
    __device__ __forceinline__ void a_ready(const Unit&) const {}
    __device__ __forceinline__ void done(const Unit&) const {}
};

__device__ __forceinline__ unsigned cvt_pk_bf16(float lo, float hi) { unsigned r; asm volatile("v_cvt_pk_bf16_f32 %0, %1, %2" : "=v"(r) : "v"(lo), "v"(hi)); return r; }
typedef float f32x2 __attribute__((ext_vector_type(2)));
__device__ __forceinline__ f32x2 gelu_pk(f32x2 v) {
    const f32x2 av = __builtin_elementwise_abs(v), d = av * 0.2316418882f + 1.0f;
    f32x2 t; t.x = __builtin_amdgcn_rcpf(d.x); t.y = __builtin_amdgcn_rcpf(d.y);
    f32x2 q = t * 0.5307027145f + (-0.7265760135f); q = q * t + 0.7107068705f; q = q * t + (-0.142248368f); q = q * t + 0.127414796f; q = q * t;
    const f32x2 s = (v * v) * (-0.72134752044f);
    f32x2 e; e.x = __builtin_amdgcn_exp2f(s.x); e.y = __builtin_amdgcn_exp2f(s.y);
    const f32x2 m = v * (q * e), r = v - m;
    f32x2 o; o.x = v.x < 0.f ? m.x : r.x; o.y = v.y < 0.f ? m.y : r.y; return o;
}

template <int ACT  > struct EpiBf16 {
    static constexpr bool PERM = true, AFTER_DRAIN = false; static_assert(ACT == 0 || ACT == 1, "EpiBf16: ACT is 0 (none) or 1 (gelu_pk)");
    bf16_t* O; int ldc; const float* bias; int split_cols; size_t split_stride; float scale0;
    __device__ __forceinline__ void operator()(const f32x4 (&acc)[2][2][4][2], const Unit& u, int wr, int wc, int fr, int fq) const {
        const int row0 = u.pm * BM + wr * 64 + fr; int colt = u.pn * BM; bf16_t* base = O;
        float sc = 1.f; if (split_cols) { const int t = colt / split_cols; base += (size_t)t * split_stride; colt -= t * split_cols; if (t == 0) sc = scale0; }
        const int col0 = colt + wc * 32 + 8 * fq, bcol0 = u.pn * BM + wc * 32 + 8 * fq;
        f32x4 bv[2][2];
#pragma unroll
        for (int bj = 0; bj < 2; ++bj)
#pragma unroll
            for (int n = 0; n < 2; ++n) bv[bj][n] = bias ? *(const f32x4*)(bias + bcol0 + bj * HALF + 4 * n) : (f32x4){0.f, 0.f, 0.f, 0.f};
#pragma unroll
        for (int ai = 0; ai < 2; ++ai)
#pragma unroll
            for (int m = 0; m < 4; ++m) { bf16_t* rowp = base + (size_t)(row0 + ai * HALF + m * 16) * ldc + col0;
#pragma unroll
                for (int bj = 0; bj < 2; ++bj) { f32x4 v0 = acc[ai][bj][m][0] + bv[bj][0], v1 = acc[ai][bj][m][1] + bv[bj][1];
                    if (ACT == 1) { f32x2 a = gelu_pk((f32x2){v0[0], v0[1]}), b = gelu_pk((f32x2){v0[2], v0[3]}), c = gelu_pk((f32x2){v1[0], v1[1]}), d = gelu_pk((f32x2){v1[2], v1[3]});
                        v0 = (f32x4){a.x, a.y, b.x, b.y}; v1 = (f32x4){c.x, c.y, d.x, d.y}; }
                    v0 = v0 * sc; v1 = v1 * sc; u32x4 w; w.x = cvt_pk_bf16(v0[0], v0[1]); w.y = cvt_pk_bf16(v0[2], v0[3]); w.z = cvt_pk_bf16(v1[0], v1[1]); w.w = cvt_pk_bf16(v1[2], v1[3]);
                    *(u32x4*)(rowp + bj * HALF) = w; } }
    }
};

typedef int v4i_t __attribute__((ext_vector_type(4))); typedef int v8i_t __attribute__((ext_vector_type(8)));
template <class Epi, class Sched, bool ALIGN_EPI = false, bool SP2 = false, bool FP8 = false>
__device__ __forceinline__ void gemm_phase(PG8_LAS unsigned char* lds, const Gemm g, const Sched& S, const Epi& E, const int tid) {
    const int wid = __builtin_amdgcn_readfirstlane(tid >> 6), lane = tid & 63, wr = wid >> 2, wc = wid & 3, fr = lane & 15, fq = lane >> 4;
    const int K = g.K, nt = K / BK;
    unsigned voffA[2], voffB[2];
#pragma unroll
    for (int i = 0; i < 2; ++i) { int R, C; stage_rc(tid * 16 + i * 8192, R, C); const int Rb = Epi::PERM ? ((R & ~31) + perm32(R & 31)) : R;
        voffA[i] = (unsigned)(R * K + C) * 2u; voffB[i] = (unsigned)(Rb * K + C) * 2u; }
    const size_t kstep = (size_t)(BK * 2);
    const size_t hstep = (size_t)HALF * K * 2;
    const size_t tstep = 2 * hstep;
    const unsigned ldsw = (unsigned)wid * 1024u;
    const int aoff = lds_byte(wr * 64 + fr, fq * 8), boff = lds_byte(wc * 32 + fr, fq * 8);
#define PG8_SA(b, h) (((b) * 2 + (h)) * HTB)
#define PG8_SB(b, h) ((4 + (b) * 2 + (h)) * HTB)
#define PG8_STAGE(bufoff, gbase, voff) do { _Pragma("unroll") for (int _i = 0; _i < 2; ++_i) \
        __builtin_amdgcn_global_load_lds((const unsigned*)((const char*)(gbase) + (voff)[_i]), (PG8_LAS unsigned*)(lds + (bufoff) + ldsw + _i * 8192), 16, 0, 0); } while (0)
#define PG8_CAT(x0, x1) __builtin_shufflevector(__builtin_bit_cast(v4i_t, x0), __builtin_bit_cast(v4i_t, x1), 0, 1, 2, 3, 4, 5, 6, 7)
#define PG8_LDA(dst, b, h) do { _Pragma("unroll") for (int m = 0; m < 4; ++m) { if constexpr (FP8) dst##8[m] = PG8_CAT(*(const PG8_LAS bf16x8*)(lds + PG8_SA(b, h) + aoff + m * 2048), *(const PG8_LAS bf16x8*)(lds + PG8_SA(b, h) + aoff + m * 2048 + 1024)); \
        else { _Pragma("unroll") for (int k = 0; k < 2; ++k) dst[m][k] = *(const PG8_LAS bf16x8*)(lds + PG8_SA(b, h) + aoff + m * 2048 + k * 1024); } } } while (0)
#define PG8_LDB(dst, b, h) do { _Pragma("unroll") for (int n = 0; n < 2; ++n) { if constexpr (FP8) dst##8[n] = PG8_CAT(*(const PG8_LAS bf16x8*)(lds + PG8_SB(b, h) + boff + n * 2048), *(const PG8_LAS bf16x8*)(lds + PG8_SB(b, h) + boff + n * 2048 + 1024)); \
        else { _Pragma("unroll") for (int k = 0; k < 2; ++k) dst[n][k] = *(const PG8_LAS bf16x8*)(lds + PG8_SB(b, h) + boff + n * 2048 + k * 1024); } } } while (0)
#define PG8_MMA16(ai, bj, At, Bt) do { __builtin_amdgcn_s_setprio(1); _Pragma("unroll") for (int m = 0; m < 4; ++m) _Pragma("unroll") for (int n = 0; n < 2; ++n) _Pragma("unroll") for (int k = 0; k < 2; ++k) \
        acc[ai][bj][m][n] = __builtin_amdgcn_mfma_f32_16x16x32_bf16(Bt[n][k], At[m][k], acc[ai][bj][m][n], 0, 0, 0); __builtin_amdgcn_s_setprio(0); } while (0)
#define PG8_MMA8(ai, bj, At, Bt) do { __builtin_amdgcn_s_setprio(1); _Pragma("unroll") for (int m = 0; m < 4; ++m) _Pragma("unroll") for (int n = 0; n < 2; ++n) \
        asm volatile("v_mfma_scale_f32_16x16x128_f8f6f4 %0, %1, %2, %0, %3, %3 op_sel_hi:[0,0,0]" : "+v"(acc[ai][bj][m][n]) : "v"(Bt##8[n]), "v"(At##8[m]), "v"(one_scale)); __builtin_amdgcn_s_setprio(0); } while (0)
#define PG8_MMA(ai, bj, At, Bt) do { if constexpr (FP8) PG8_MMA8(ai, bj, At, Bt); else PG8_MMA16(ai, bj, At, Bt); } while (0)
#define PG8_WAIT_V(n) asm volatile("s_waitcnt vmcnt(" #n ")" ::: "memory")
#define PG8_WAIT_L(n) asm volatile("s_waitcnt lgkmcnt(" #n ")" ::: "memory")
#define PG8_BAR __builtin_amdgcn_s_barrier()
#define PG8_SCHED __builtin_amdgcn_sched_barrier(0)
    Unit cur, nxt; int ui = 0;
    if (!S.next(0, cur)) return;
    f32x4 acc[2][2][4][2];
#pragma unroll
    for (int a = 0; a < 2; ++a)
#pragma unroll
        for (int b = 0; b < 2; ++b)
#pragma unroll
            for (int m = 0; m < 4; ++m)
#pragma unroll
                for (int n = 0; n < 2; ++n) acc[a][b][m][n] = (f32x4){0.f, 0.f, 0.f, 0.f};
    bf16x8 At[4][2], B0[2][2], B1[2][2]; v8i_t At8[4], B08[2], B18[2];
    int one_scale = 0x7f7f7f7f; asm volatile("" : "+v"(one_scale));
    const char* cA = (const char*)g.A + (size_t)cur.pm * tstep; const size_t estep = (size_t)g.N * K * 2; const char* cB = (const char*)g.Bt + (size_t)cur.e * estep + (size_t)cur.pn * tstep;
    S.a_ready(cur);
    if constexpr (SP2) {
        PG8_STAGE(PG8_SB(0, 0), cB, voffB); PG8_STAGE(PG8_SB(0, 1), cB + hstep, voffB); PG8_STAGE(PG8_SA(0, 0), cA, voffA); PG8_STAGE(PG8_SA(0, 1), cA + hstep, voffA);
        if (wr == 1) PG8_BAR;
        PG8_WAIT_V(2); PG8_BAR;
        PG8_STAGE(PG8_SB(1, 0), cB + kstep, voffB); PG8_STAGE(PG8_SA(1, 0), cA + kstep, voffA); PG8_STAGE(PG8_SB(1, 1), cB + hstep + kstep, voffB);
        PG8_WAIT_V(6); PG8_BAR;
    } else {
        PG8_STAGE(PG8_SB(0, 0), cB, voffB); PG8_STAGE(PG8_SA(0, 0), cA, voffA); PG8_STAGE(PG8_SB(0, 1), cB + hstep, voffB); PG8_STAGE(PG8_SA(0, 1), cA + hstep, voffA);
        if (wr == 1) PG8_BAR;
        PG8_WAIT_V(4); PG8_BAR;
        PG8_STAGE(PG8_SB(1, 0), cB + kstep, voffB); PG8_STAGE(PG8_SA(1, 0), cA + kstep, voffA); PG8_STAGE(PG8_SB(1, 1), cB + hstep + kstep, voffB);
        PG8_WAIT_V(6); PG8_BAR;
    }
    for (;;) {
        const bool has_next = S.next(ui + 1, nxt);
        const char* nA = has_next ? (const char*)g.A + (size_t)nxt.pm * tstep : cA; const char* nB = has_next ? (const char*)g.Bt + (size_t)nxt.e * estep + (size_t)nxt.pn * tstep : cB;
        for (int t = 0; t < nt; t += 2) {
            const bool last = (t == nt - 2);
            const char* a1 = cA + (size_t)(t + 1) * kstep;
            const char* a2 = last ? nA : cA + (size_t)(t + 2) * kstep; const char* b2 = last ? nB : cB + (size_t)(t + 2) * kstep;
            const char* a3 = a2 + kstep; const char* b3 = b2 + kstep;
            if (last && has_next) S.a_ready(nxt);
            if constexpr (SP2) {
            PG8_LDB(B0, 0, 0); PG8_LDB(B1, 0, 1); PG8_SCHED; PG8_LDA(At, 0, 0); PG8_STAGE(PG8_SA(1, 1), a1 + hstep, voffA);
            PG8_WAIT_V(8); PG8_WAIT_L(0); PG8_BAR; PG8_MMA(0, 0, At, B0); PG8_MMA(0, 1, At, B1); PG8_BAR; PG8_SCHED;
            PG8_LDA(At, 0, 1); PG8_STAGE(PG8_SB(0, 0), b2, voffB); PG8_STAGE(PG8_SB(0, 1), b2 + hstep, voffB); PG8_STAGE(PG8_SA(0, 0), a2, voffA);
            PG8_WAIT_V(8); PG8_WAIT_L(0); PG8_BAR; PG8_MMA(1, 0, At, B0); PG8_MMA(1, 1, At, B1); PG8_BAR; PG8_SCHED;
            PG8_LDB(B0, 1, 0); PG8_LDB(B1, 1, 1); PG8_SCHED; PG8_LDA(At, 1, 0); PG8_STAGE(PG8_SA(0, 1), a2 + hstep, voffA);
            PG8_WAIT_V(8); PG8_WAIT_L(0); PG8_BAR; PG8_MMA(0, 0, At, B0); PG8_MMA(0, 1, At, B1); PG8_BAR; PG8_SCHED;
            PG8_LDA(At, 1, 1); PG8_STAGE(PG8_SB(1, 0), b3, voffB); PG8_STAGE(PG8_SB(1, 1), b3 + hstep, voffB); PG8_STAGE(PG8_SA(1, 0), a3, voffA);
            PG8_WAIT_V(8); PG8_WAIT_L(0); PG8_BAR; PG8_MMA(1, 0, At, B0); PG8_MMA(1, 1, At, B1); PG8_BAR; PG8_SCHED;
            } else {
            PG8_LDB(B0, 0, 0); PG8_SCHED; PG8_LDA(At, 0, 0); PG8_STAGE(PG8_SA(1, 1), a1 + hstep, voffA);
            PG8_WAIT_L(8); PG8_BAR; PG8_WAIT_L(0); PG8_MMA(0, 0, At, B0); PG8_BAR; PG8_SCHED;
            PG8_LDB(B1, 0, 1); PG8_STAGE(PG8_SB(0, 0), b2, voffB);
            PG8_BAR; PG8_WAIT_L(0); PG8_MMA(0, 1, At, B1); PG8_BAR;
            PG8_LDA(At, 0, 1); PG8_STAGE(PG8_SA(0, 0), a2, voffA);
            PG8_BAR; PG8_WAIT_L(0); PG8_MMA(1, 0, At, B0); PG8_BAR; PG8_SCHED;
            PG8_STAGE(PG8_SB(0, 1), b2 + hstep, voffB);
            PG8_WAIT_V(6); PG8_BAR; PG8_MMA(1, 1, At, B1); PG8_BAR;
            PG8_LDB(B0, 1, 0); PG8_SCHED; PG8_LDA(At, 1, 0); PG8_STAGE(PG8_SA(0, 1), a2 + hstep, voffA);
            PG8_WAIT_L(8); PG8_BAR; PG8_WAIT_L(0); PG8_MMA(0, 0, At, B0); PG8_BAR; PG8_SCHED;
            PG8_LDB(B1, 1, 1); PG8_STAGE(PG8_SB(1, 0), b3, voffB);
            PG8_BAR; PG8_WAIT_L(0); PG8_MMA(0, 1, At, B1); PG8_BAR;
            PG8_LDA(At, 1, 1); PG8_STAGE(PG8_SA(1, 0), a3, voffA);
            PG8_BAR; PG8_WAIT_L(0); PG8_MMA(1, 0, At, B0); PG8_BAR; PG8_SCHED;
            PG8_STAGE(PG8_SB(1, 1), b3 + hstep, voffB);
            PG8_WAIT_V(6); PG8_BAR; PG8_MMA(1, 1, At, B1); PG8_BAR;
            }
        }
        if constexpr (ALIGN_EPI) { if (wr == 0) PG8_BAR; }
        if constexpr (FP8) asm volatile("s_nop 15\n\ts_nop 15" ::: "memory");
        if constexpr (!Epi::AFTER_DRAIN) { E(acc, cur, wr, wc, fr, fq); S.done(cur); }
        if (!has_next) break;
#pragma unroll
        for (int a = 0; a < 2; ++a)
#pragma unroll
            for (int b = 0; b < 2; ++b)
#pragma unroll
                for (int m = 0; m < 4; ++m)
#pragma unroll
                    for (int n = 0; n < 2; ++n) acc[a][b][m][n] = (f32x4){0.f, 0.f, 0.f, 0.f};
        cur = nxt; cA = nA; cB = nB; ++ui;
        if constexpr (ALIGN_EPI) { if (wr == 1) PG8_BAR; }
    }
    PG8_WAIT_V(0);
    if constexpr (!ALIGN_EPI) { if (wr == 0) PG8_BAR; }
    PG8_BAR;
    if constexpr (Epi::AFTER_DRAIN) { E.fused(acc, cur, wr, wc, fr, fq, lds, wid, lane); S.done(cur); }
#undef PG8_SA
#undef PG8_SB
#undef PG8_STAGE
#undef PG8_LDA
#undef PG8_LDB
#undef PG8_MMA
#undef PG8_MMA8
#undef PG8_MMA16
#undef PG8_CAT
#undef PG8_WAIT_V
#undef PG8_WAIT_L
#undef PG8_BAR
#undef PG8_SCHED
}
}
namespace pg8 {
__device__ __forceinline__ float ep_bflo(unsigned w) { return __uint_as_float(w << 16); }
__device__ __forceinline__ float ep_bfhi(unsigned w) { return __uint_as_float(w & 0xffff0000u); }
__device__ __forceinline__ float ep_sig(float x) { return __builtin_amdgcn_rcpf(1.f + __builtin_amdgcn_exp2f(-1.4426950408889634f * x)); }
__device__ __forceinline__ void ep_unpack8(u32x4 w, f32x4& a, f32x4& b) { a = (f32x4){ep_bflo(w.x), ep_bfhi(w.x), ep_bflo(w.y), ep_bfhi(w.y)}; b = (f32x4){ep_bflo(w.z), ep_bfhi(w.z), ep_bflo(w.w), ep_bfhi(w.w)}; }
__device__ __forceinline__ u32x4 ep_pack8(f32x4 a, f32x4 b) { u32x4 w; w.x = cvt_pk_bf16(a[0], a[1]); w.y = cvt_pk_bf16(a[2], a[3]); w.z = cvt_pk_bf16(b[0], b[1]); w.w = cvt_pk_bf16(b[2], b[3]); return w; }
__device__ __forceinline__ f32x4 ep_sig4(f32x4 v) { return (f32x4){ep_sig(v[0]), ep_sig(v[1]), ep_sig(v[2]), ep_sig(v[3])}; }
#define EPI_LOOP_BEGIN const int row0 = u.pm * BM + wr * 64 + fr, col0 = u.pn * BM + wc * 32 + 8 * fq; \
    _Pragma("unroll") for (int ai = 0; ai < 2; ++ai) _Pragma("unroll") for (int m = 0; m < 4; ++m) { const int row = row0 + ai * HALF + m * 16; \
    _Pragma("unroll") for (int bj = 0; bj < 2; ++bj) { const int col = col0 + bj * HALF; const f32x4 v0 = acc[ai][bj][m][0], v1 = acc[ai][bj][m][1];
#define EPI_LOOP_END } }

struct EpiLora1 {
    static constexpr bool PERM = true, AFTER_DRAIN = false;
    float* logw; bf16_t* a; const float* w0; const float* a0;
    __device__ __forceinline__ void operator()(const f32x4 (&acc)[2][2][4][2], const Unit& u, int wr, int wc, int fr, int fq) const {
        EPI_LOOP_BEGIN
            if (u.pn < 4) { const f32x4 b0 = *(const f32x4*)(w0 + col), b1 = *(const f32x4*)(w0 + col + 4);
                float* o = logw + (size_t)row * 1024 + col; *(f32x4*)o = ep_sig4(v0 + b0) * (-0.6065306597126334f); *(f32x4*)(o + 4) = ep_sig4(v1 + b1) * (-0.6065306597126334f); }
            else { const int c = col - 1024; const f32x4 b0 = *(const f32x4*)(a0 + c), b1 = *(const f32x4*)(a0 + c + 4);
                *(u32x4*)(a + (size_t)row * 1024 + c) = ep_pack8(ep_sig4(v0 + b0), ep_sig4(v1 + b1)); }
        EPI_LOOP_END
    }
};
template <int SECOND> struct EpiGateMerge {
    static constexpr bool PERM = true, AFTER_DRAIN = false;
    bf16_t* mrg; const bf16_t* P; int gcol;
    __device__ __forceinline__ void operator()(const f32x4 (&acc)[2][2][4][2], const Unit& u, int wr, int wc, int fr, int fq) const {
        EPI_LOOP_BEGIN
            f32x4 g0, g1; ep_unpack8(*(const u32x4*)(P + (size_t)row * 11776 + gcol + col), g0, g1);
            f32x4 r0 = ep_sig4(g0) * v0, r1 = ep_sig4(g1) * v1;
            bf16_t* o = mrg + (size_t)row * 2048 + col;
            if (SECOND) { f32x4 t0, t1; ep_unpack8(*(const u32x4*)o, t0, t1); r0 = r0 + t0; r1 = r1 + t1; }
            *(u32x4*)o = ep_pack8(r0, r1);
        EPI_LOOP_END
    }
};
struct EpiResid {
    static constexpr bool PERM = true, AFTER_DRAIN = false;
    const float* x; float* x1; const float* mod;
    __device__ __forceinline__ void operator()(const f32x4 (&acc)[2][2][4][2], const Unit& u, int wr, int wc, int fr, int fq) const {
        const float* gt = mod + (size_t)((u.pm * BM) / 16384) * 12288 + 4096;
        EPI_LOOP_BEGIN
            const f32x4 g0 = *(const f32x4*)(gt + col), g1 = *(const f32x4*)(gt + col + 4);
            const size_t off = (size_t)row * 2048 + col;
            *(f32x4*)(x1 + off) = *(const f32x4*)(x + off) + g0 * v0; *(f32x4*)(x1 + off + 4) = *(const f32x4*)(x + off + 4) + g1 * v1;
        EPI_LOOP_END
    }
};
struct EpiSwiglu {
    static constexpr bool PERM = true, AFTER_DRAIN = false;
    unsigned char* act; const float* bias;
    __device__ __forceinline__ void operator()(const f32x4 (&acc)[2][2][4][2], const Unit& u, int wr, int wc, int fr, int fq) const {
        const int row0 = u.pm * BM + wr * 64 + fr, gcol = u.pn * 128 + wc * 32 + 8 * fq;
        const float* bg = bias + (size_t)u.e * 4096 + gcol; const float* bl = bg + 2048;
        const f32x4 bg0 = *(const f32x4*)bg, bg1 = *(const f32x4*)(bg + 4), bl0 = *(const f32x4*)bl, bl1 = *(const f32x4*)(bl + 4);
#pragma unroll
        for (int ai = 0; ai < 2; ++ai)
#pragma unroll
            for (int m = 0; m < 4; ++m) { const int row = row0 + ai * HALF + m * 16;
                f32x4 g0 = acc[ai][0][m][0] * (1.f / 128.f) + bg0, g1 = acc[ai][0][m][1] * (1.f / 128.f) + bg1, l0 = acc[ai][1][m][0] * (1.f / 128.f) + bl0, l1 = acc[ai][1][m][1] * (1.f / 128.f) + bl1, r0, r1;
#pragma unroll
                for (int i = 0; i < 4; ++i) { const float a = fminf(g0[i], 7.f), b = fminf(g1[i], 7.f);
                    r0[i] = a * ep_sig(1.702f * a) * (fminf(fmaxf(l0[i], -7.f), 7.f) + 1.f); r1[i] = b * ep_sig(1.702f * b) * (fminf(fmaxf(l1[i], -7.f), 7.f) + 1.f); }
                r0 = r0 * 4.f; r1 = r1 * 4.f; typedef unsigned u32x2e __attribute__((ext_vector_type(2))); u32x2e o;
                { int w = __builtin_amdgcn_cvt_pk_fp8_f32(r0[0], r0[1], 0, false); w = __builtin_amdgcn_cvt_pk_fp8_f32(r0[2], r0[3], w, true); o.x = (unsigned)w; }
                { int w = __builtin_amdgcn_cvt_pk_fp8_f32(r1[0], r1[1], 0, false); w = __builtin_amdgcn_cvt_pk_fp8_f32(r1[2], r1[3], w, true); o.y = (unsigned)w; }
                *(u32x2e*)(act + (size_t)row * 2048 + gcol) = o; }
    }
};
struct EpiDown {
    static constexpr bool PERM = true, AFTER_DRAIN = false;
    bf16_t* ys; const float* bias; const float* slot_w;
    __device__ __forceinline__ void operator()(const f32x4 (&acc)[2][2][4][2], const Unit& u, int wr, int wc, int fr, int fq) const {
        const float* be = bias + (size_t)u.e * 2048;
        EPI_LOOP_BEGIN
            const float w = slot_w[row];
            const f32x4 b0 = *(const f32x4*)(be + col), b1 = *(const f32x4*)(be + col + 4);
            *(u32x4*)(ys + (size_t)row * 2048 + col) = ep_pack8((v0 * (1.f / 256.f) + b0) * w, (v1 * (1.f / 256.f) + b1) * w);
        EPI_LOOP_END
    }
};
struct MoeOrder : StaticOrder {
    const int* tile_e;
    __device__ bool next(int i, Unit& u) const { if (!StaticOrder::next(i, u)) return false; u.e = tile_e[u.pm]; return true; }
};
}
namespace fox {
enum { ORDER_NATURAL = 0, ORDER_REVERSED = 1, ORDER_PAIRED = 2, ORDER_XCD = 4 };
using TIN = __hip_bfloat16; using TOUT = __hip_bfloat16;
constexpr int B = 2, H = 8, HKV = 8, SQ = 16384, SKV = 16384, D = 128;
constexpr int PITCH = 1024;
constexpr int GPITCH = 11776;
constexpr int QOFF = 0;
constexpr int WINDOW = SKV;
constexpr float THR = 8.f;
constexpr int ORDER = ORDER_PAIRED;
constexpr bool WSKIP = false;
constexpr float SCALE = 0.08838834764831845f;
constexpr int NW = 8, QBLK = 32, KVBLK = 64, QB = NW * QBLK;
constexpr int SHM_V = KVBLK * D * 2, SHM_K = KVBLK * D * 2;
constexpr int LDS_CB = 2 * SHM_V + 2 * SHM_K + NW * 64 * 4;
constexpr int LDS_GATE = LDS_CB + 3 * 64 * 4 + 256;
constexpr int LDS_BYTES = LDS_GATE + NW * 8192;
static_assert(D == 128 && SQ % QB == 0 && SKV % KVBLK == 0 && H % HKV == 0 && QOFF >= 0 && QOFF + SQ <= SKV && WINDOW >= 1, "geometry");

using bf16 = __hip_bfloat16;
typedef short bf16x8 __attribute__((ext_vector_type(8)));
typedef short s16x4 __attribute__((ext_vector_type(4)));
typedef float f32x16 __attribute__((ext_vector_type(16)));
typedef float f32x4 __attribute__((ext_vector_type(4)));
typedef unsigned u32x4 __attribute__((ext_vector_type(4)));
template <class A, class Bt> struct same_t { static constexpr bool v = false; };
template <class A> struct same_t<A, A> { static constexpr bool v = true; };

#define KSWZ(row, colB) ((row) * 256 + ((colB) ^ (((row) & 7) << 4)))
#define SBAR() __builtin_amdgcn_sched_barrier(0)
__device__ __forceinline__ int v_st(int k, int c) { const int kk = (k & ~0xC) | ((k & 4) << 1) | ((k & 8) >> 1); return ((kk >> 3) * 4 + (c >> 5)) * 512 + ((kk & 7) * 32 + (c & 31)) * 2; }
__device__ __forceinline__ int v_rd_base(int lane) { return ((lane & 3) << 3) | (((lane >> 2) & 3) << 6) | (((lane >> 4) & 1) << 5) | (((lane >> 5) & 1) << 8); }
constexpr int v_rd_off(int d0, int ks, int half) { return d0 * 512 + ks * 4096 + half * 2048; }
__device__ __forceinline__ int crow(int r, int hi) { return (r & 3) + 8 * (r >> 2) + 4 * hi; }
__device__ __forceinline__ unsigned cvtpk(float lo, float hi) {
    unsigned r; asm volatile("v_cvt_pk_bf16_f32 %0, %1, %2" : "=v"(r) : "v"(lo), "v"(hi)); return r;
}
__device__ __forceinline__ bf16x8 pack8(f32x4 a, f32x4 b) {
    u32x4 w = {cvtpk(a[0], a[1]), cvtpk(a[2], a[3]), cvtpk(b[0], b[1]), cvtpk(b[2], b[3])};
    return *reinterpret_cast<bf16x8*>(&w);
}
template <class T> __device__ __forceinline__ bf16x8 load8(const T* p) {
    if constexpr (same_t<T, float>::v) { return pack8(*(const f32x4*)p, *(const f32x4*)(p + 4)); }
    else { return *reinterpret_cast<const bf16x8*>(p); }
}
__device__ __forceinline__ void mask_tile(f32x16& p0, f32x16& p1, int dq, unsigned W) {
    const float NEG = -__builtin_inff();
#pragma unroll
    for (int r = 0; r < 16; ++r) {
        const int c = (r & 3) + 8 * (r >> 2);
        if ((unsigned)(dq - c) >= W) p0[r] = NEG;
        if ((unsigned)(dq - c - 32) >= W) p1[r] = NEG;
    }
}
__device__ __forceinline__ void partialSM(f32x16& p0, f32x16& p1, float& m_reg, float& mn, float& alpha) {
    float pmax = p0[0]; for (int r = 1; r < 16; ++r) pmax = fmaxf(pmax, p0[r]); for (int r = 0; r < 16; ++r) pmax = fmaxf(pmax, p1[r]);
    { auto rr = __builtin_amdgcn_permlane32_swap(__float_as_uint(pmax), __float_as_uint(pmax), false, false);
      pmax = fmaxf(__uint_as_float(rr[0]), __uint_as_float(rr[1])); }
    constexpr float C2 = 1.4426950408889634f * SCALE;
    if (__builtin_expect(__all((pmax - m_reg) * SCALE <= THR), 1)) { mn = m_reg; alpha = 1.f; }
    else { mn = fmaxf(m_reg, pmax); alpha = __builtin_amdgcn_exp2f((m_reg - mn) * C2); m_reg = mn; }
    const float mnL = -mn * C2;
    for (int r = 0; r < 16; ++r) p0[r] = fmaf(p0[r], C2, mnL); for (int r = 0; r < 16; ++r) p1[r] = fmaf(p1[r], C2, mnL);
    for (int r = 0; r < 16; ++r) p0[r] = __builtin_amdgcn_exp2f(p0[r]);
}
__device__ __forceinline__ void finishSM(f32x16& p0, f32x16& p1, float alpha, float& l_reg, bf16x8& pa0, bf16x8& pa1, bf16x8& pa2, bf16x8& pa3) {
    for (int r = 0; r < 16; ++r) p1[r] = __builtin_amdgcn_exp2f(p1[r]);
    float ps = 0; for (int r = 0; r < 16; ++r) ps += p0[r]; for (int r = 0; r < 16; ++r) ps += p1[r];
    { auto rr = __builtin_amdgcn_permlane32_swap(__float_as_uint(ps), __float_as_uint(ps), false, false);
      ps = __uint_as_float(rr[0]) + __uint_as_float(rr[1]); }
    l_reg = l_reg * alpha + ps;
#define PK4(P, B_, OUT) do { unsigned a0 = cvtpk(P[B_+0], P[B_+1]), a1 = cvtpk(P[B_+2], P[B_+3]);                          \
        unsigned b0 = cvtpk(P[B_+4], P[B_+5]), b1 = cvtpk(P[B_+6], P[B_+7]);                                             \
        auto r0 = __builtin_amdgcn_permlane32_swap(a0, b0, false, false); auto r1 = __builtin_amdgcn_permlane32_swap(a1, b1, false, false); \
        u32x4 w = {r0[0], r1[0], r0[1], r1[1]}; OUT = *reinterpret_cast<bf16x8*>(&w); } while (0)
    PK4(p0, 0, pa0); PK4(p0, 8, pa1); PK4(p1, 0, pa2); PK4(p1, 8, pa3);
#undef PK4
}
template <int KB, bool SK>
__device__ __forceinline__ void qkt(f32x16& p0, f32x16& p1, const char* K_lds, int r32, int hi, const bf16x8* qr, bool act, int cbi) {
    if (SK && !act) { const float NEG = -__builtin_inff();
#pragma unroll
        for (int r = 0; r < 16; ++r) { p0[r] = NEG; p1[r] = NEG; } return; }
    { const float* cb_ = (const float*)(K_lds + 2 * SHM_K + NW * 64 * 4) + cbi * 64 + 4 * hi;
#pragma unroll
      for (int g_ = 0; g_ < 4; ++g_) { const f32x4 b0_ = *(const f32x4*)(cb_ + 8 * g_), b1_ = *(const f32x4*)(cb_ + 32 + 8 * g_);
#pragma unroll
          for (int i_ = 0; i_ < 4; ++i_) { p0[4 * g_ + i_] = b0_[i_]; p1[4 * g_ + i_] = b1_[i_]; } } }
    const char* kb[4];
#pragma unroll
    for (int dd = 0; dd < 4; ++dd) kb[dd] = K_lds + KB * SHM_K + KSWZ(r32, (dd * 16 + hi * 8) * 2);
#pragma unroll
    for (int d0 = 0; d0 < 8; ++d0) { const char* a = kb[d0 & 3] + (d0 >> 2) * 128;
        bf16x8 b0 = *reinterpret_cast<const bf16x8*>(a);
        bf16x8 b1 = *reinterpret_cast<const bf16x8*>(a + 32 * 256);
        p0 = __builtin_amdgcn_mfma_f32_32x32x16_bf16(b0, qr[d0], p0, 0, 0, 0);
        p1 = __builtin_amdgcn_mfma_f32_32x32x16_bf16(b1, qr[d0], p1, 0, 0, 0); }
}
template <int VB, bool SK>
__device__ __forceinline__ void pv_tile(f32x16* o, int vb0, bf16x8 pa0, bf16x8 pa1, bf16x8 pa2, bf16x8 pa3, bool act) {
    if (SK && !act) return;
#define TRRD(dst, off) asm volatile("ds_read_b64_tr_b16 %0, %1 offset:%2" : "=&v"(dst) : "v"(vb0), "i"(off) : "memory")
#define PV_D0(d0) do { s16x4 l0, l1, l2, l3, h0, h1, h2, h3; constexpr int b_ = VB * SHM_V + v_rd_off(d0, 0, 0);     \
        TRRD(l0, b_); TRRD(h0, b_ + 2048); TRRD(l1, b_ + 4096); TRRD(h1, b_ + 6144); TRRD(l2, b_ + 8192); TRRD(h2, b_ + 10240); TRRD(l3, b_ + 12288); TRRD(h3, b_ + 14336); \
        asm volatile("s_waitcnt lgkmcnt(0)" ::: "memory"); SBAR();                 \
        o[d0] = __builtin_amdgcn_mfma_f32_32x32x16_bf16(pa0, (bf16x8){l0[0], l0[1], l0[2], l0[3], h0[0], h0[1], h0[2], h0[3]}, o[d0], 0, 0, 0);   \
        o[d0] = __builtin_amdgcn_mfma_f32_32x32x16_bf16(pa1, (bf16x8){l1[0], l1[1], l1[2], l1[3], h1[0], h1[1], h1[2], h1[3]}, o[d0], 0, 0, 0);   \
        o[d0] = __builtin_amdgcn_mfma_f32_32x32x16_bf16(pa2, (bf16x8){l2[0], l2[1], l2[2], l2[3], h2[0], h2[1], h2[2], h2[3]}, o[d0], 0, 0, 0);   \
        o[d0] = __builtin_amdgcn_mfma_f32_32x32x16_bf16(pa3, (bf16x8){l3[0], l3[1], l3[2], l3[3], h3[0], h3[1], h3[2], h3[3]}, o[d0], 0, 0, 0); } while (0)
    PV_D0(0); PV_D0(1); PV_D0(2); PV_D0(3);
#undef PV_D0
#undef TRRD
}

template <class TIn, class TOut> struct BlockRef { const unsigned char* ws; int row0, bh, P0;
    __device__ __forceinline__ const TIn* Q() const { return (const TIn*)(ws + WS_FQ) + (size_t)row0 * PITCH + (bh % H) * D; }
    __device__ __forceinline__ const TIn* K() const { return (const TIn*)(ws + WS_FK) + (size_t)(bh / H) * SQ * PITCH + (bh % H) * D; }
    __device__ __forceinline__ const TIn* V() const { return (const TIn*)(ws + WS_FV) + (size_t)(bh / H) * SQ * PITCH + (bh % H) * D; }
    __device__ __forceinline__ TOut* O() const { return (TOut*)(ws + WS_YB) + (size_t)row0 * PITCH + (bh % H) * D; }
    __device__ __forceinline__ const float* C() const { return (const float*)(ws + WS_CS) + (size_t)bh * SQ; }
    __device__ __forceinline__ const TIn* G() const { return (const TIn*)(ws + WS_P) + (size_t)row0 * GPITCH + PC_OG + (bh % H) * D; }
};
template <class TIn> struct Seam {
    bf16x8 qr[8];
    bf16x8 st_v0, st_v1, st_k0, st_k1; int cbi; f32x4 sf0, sf1, sf2, sf3;
    f32x4 tq[16];
};
__device__ __forceinline__ int swa_jlo(int P0, int W) { const int lowk = P0 - W + 1; return lowk > 0 ? lowk / KVBLK : 0; }
#define ROW(p, k0, rr) ((p) + (size_t)((k0) + (rr)) * PITCH + sc)
#define VMW() asm volatile("s_waitcnt vmcnt(0)" ::: "memory")
#define VMWN(n) asm volatile("s_waitcnt vmcnt(%0)" :: "i"(n) : "memory")
#define NEXT3(x) ((x) == 2 ? 0 : (x) + 1)
#define SLOAD_H(Kp, Vp, Cp, k0, CI) do { S.st_v0 = load8<TIn>(ROW(Vp, k0, sr)); S.st_v1 = load8<TIn>(ROW(Vp, k0, 32 + sr));              \
                         S.st_k0 = load8<TIn>(ROW(Kp, k0, sr)); S.st_k1 = load8<TIn>(ROW(Kp, k0, 32 + sr));                 \
                         if (wid == 0) __builtin_amdgcn_global_load_lds((const unsigned*)((Cp) + (k0) + lane), (__attribute__((address_space(3))) unsigned*)(lds + LDS_CB + (CI) * 256), 4, 0, 0); } while (0)
#define SWRITE_HK(bf) do { *(bf16x8*)(K_lds + (bf) * SHM_K + kws) = S.st_k0; *(bf16x8*)(K_lds + (bf) * SHM_K + kws + 32 * 256) = S.st_k1; } while (0)
#define SWRITE_HV(bf) do { *(bf16x8*)(V_lds + (bf) * SHM_V + vst0) = S.st_v0; *(bf16x8*)(V_lds + (bf) * SHM_V + vst1) = S.st_v1; } while (0)
#define SWRITE_H(bf) do { SWRITE_HV(bf); SWRITE_HK(bf); } while (0)
#define SLOAD_F(p, k0) do { S.sf0 = *(const f32x4*)ROW(p, k0, sr); S.sf1 = *(const f32x4*)(ROW(p, k0, sr) + 4);                \
                            S.sf2 = *(const f32x4*)ROW(p, k0, 32 + sr); S.sf3 = *(const f32x4*)(ROW(p, k0, 32 + sr) + 4); } while (0)
#define SWRITE_KF(bf) do { *(bf16x8*)(K_lds + (bf) * SHM_K + kws) = pack8(S.sf0, S.sf1); *(bf16x8*)(K_lds + (bf) * SHM_K + kws + 32 * 256) = pack8(S.sf2, S.sf3); } while (0)
#define SWRITE_VF(bf) do { *(bf16x8*)(V_lds + (bf) * SHM_V + vst0) = pack8(S.sf0, S.sf1); *(bf16x8*)(V_lds + (bf) * SHM_V + vst1) = pack8(S.sf2, S.sf3); } while (0)
template <class TIn, class TOut>
__device__ __forceinline__ void causal_swa_prime(const BlockRef<TIn, TOut>& cur, int W, char* lds, Seam<TIn>& S, const int tid) {
    constexpr bool F32 = same_t<TIn, float>::v;
    const int wid = __builtin_amdgcn_readfirstlane(tid >> 6), lane = tid & 63, r32 = lane & 31, hi = lane >> 5;
    const int sr = tid >> 4, sc = (tid & 15) * 8, kws = KSWZ(sr, sc * 2); char* K_lds = lds + 2 * SHM_V;
    const int kb0 = swa_jlo(cur.P0, W) * KVBLK;
    for (int d0 = 0; d0 < 8; ++d0) S.qr[d0] = load8<TIn>(cur.Q() + (size_t)(wid * QBLK + r32) * PITCH + d0 * 16 + hi * 8);
    if constexpr (F32) { SLOAD_F((const float*)cur.K(), kb0); VMW(); SWRITE_KF(0); SBAR(); SLOAD_F((const float*)cur.V(), kb0); }
    else { S.cbi = 0; SLOAD_H(cur.K(), cur.V(), cur.C(), kb0, 0); VMW(); SWRITE_HK(0); }
    __syncthreads();
}
template <class TIn, class TOut>
__device__ __forceinline__ void causal_swa_block(const BlockRef<TIn, TOut>& cur, const BlockRef<TIn, TOut>& nxt, int skv, int W, char* lds, Seam<TIn>& S, const int tid) {
    constexpr bool F32 = same_t<TIn, float>::v;
    const int wid = __builtin_amdgcn_readfirstlane(tid >> 6), lane = tid & 63, r32 = lane & 31, hi = lane >> 5;
    const int j_lo = swa_jlo(cur.P0, W);
    int j_hi = (cur.P0 + QB - 1) / KVBLK + 1; if (j_hi > skv / KVBLK) j_hi = skv / KVBLK;
    const int NT = j_hi - j_lo;
    const int kbn = swa_jlo(nxt.P0, W) * KVBLK;
    const int qlo = cur.P0 + wid * QBLK, qm = qlo + r32 - 4 * hi;
    char* V_lds = lds; char* K_lds = lds + 2 * SHM_V;
    float* ws = (float*)(lds + 2 * SHM_V + 2 * SHM_K) + wid * 64; float* li_l = ws, * al_l = ws + 32;
    float m_reg = -1e30f, l_reg = 0; f32x16 o[4] = {};
    const int sr = tid >> 4, sc = (tid & 15) * 8, vst0 = v_st(sr, sc), vst1 = v_st(32 + sr, sc), kws = KSWZ(sr, sc * 2);
    const int vb0 = (int)(uintptr_t)V_lds + v_rd_base(lane);
    const TIn* Kh = cur.K(); const TIn* Vh = cur.V(); const float* Ch = cur.C(); int cb_t = S.cbi;
    {
        const TIn* gsrc = cur.G() + (size_t)(wid * QBLK + (lane >> 4)) * GPITCH + (lane & 15) * 8;
#pragma unroll
        for (int i_ = 0; i_ < 8; ++i_) __builtin_amdgcn_global_load_lds((const unsigned*)(gsrc + (size_t)(4 * i_) * GPITCH), (__attribute__((address_space(3))) unsigned*)(lds + LDS_GATE + wid * 8192 + i_ * 1024), 16, 0, 0); }
#define RESC(a) do { if (__any((a) < 1.f)) { if (hi == 0) al_l[r32] = (a); asm volatile("s_waitcnt lgkmcnt(0)" ::: "memory");              \
                     for (int d_ = 0; d_ < 4; ++d_) for (int r = 0; r < 16; ++r) o[d_][r] *= al_l[crow(r, hi)]; } } while (0)
#define KBASE(t) ((j_lo + (t)) * KVBLK)
#define ACT(t) (KBASE(t) <= qlo + QBLK - 1 && KBASE(t) + KVBLK - 1 >= qlo - W + 1)
#define MASKT(P0_, P1_, t) do { const int kb_ = KBASE(t); if ((!SK || ACT(t)) && (kb_ + KVBLK - 1 > qlo || kb_ <= qlo + QBLK - 1 - W)) mask_tile(P0_, P1_, qm - kb_, (unsigned)W); } while (0)
    constexpr int NQL = F32 ? 16 : 8;
    constexpr bool SK = WSKIP && !F32;
#define SEAM_K0() do { VMWN(NQL); if constexpr (F32) { SWRITE_KF(0); SBAR(); SLOAD_F((const float*)nxt.V(), kbn); } else { SWRITE_HK(0); } SBAR(); } while (0)
    f32x16 pA0, pA1, pB0, pB1; float mnA, mnB, alA, alB; bf16x8 pa0, pa1, pa2, pa3;
    if constexpr (F32) { VMW(); SWRITE_VF(0); SBAR(); } else { SWRITE_HV(0); SBAR(); }
    if (NT > 1) { if constexpr (F32) SLOAD_F((const float*)Kh, KBASE(1)); else SLOAD_H(Kh, Vh, Ch, KBASE(1), NEXT3(cb_t)); }
    SBAR(); qkt<0, SK>(pA0, pA1, K_lds, r32, hi, S.qr, ACT(0), cb_t);
    if constexpr (F32) { if (NT > 1) { VMW(); SWRITE_KF(1); SBAR(); SLOAD_F((const float*)Vh, KBASE(1)); } }
    MASKT(pA0, pA1, 0); partialSM(pA0, pA1, m_reg, mnA, alA);
    if (NT > 1) { VMW(); if constexpr (F32) { SWRITE_VF(1); SBAR(); if (NT > 2) SLOAD_F((const float*)Kh, KBASE(2)); } else SWRITE_H(1); }
    __syncthreads();
#define HALF_STEP(PX0, PX1, mnX, alX, PY0, PY1, alY, t, KB, VB, SB) do {                                                      \
        SBAR(); cb_t = NEXT3(cb_t); qkt<KB, SK>(PX0, PX1, K_lds, r32, hi, S.qr, ACT(t), cb_t);                                             \
        finishSM(PY0, PY1, alY, l_reg, pa0, pa1, pa2, pa3); SBAR();                                                           \
        if ((t) + 1 < NT) { if constexpr (F32) { VMW(); SWRITE_KF(SB); SBAR(); SLOAD_F((const float*)Vh, KBASE((t) + 1)); }  \
                            else { SLOAD_H(Kh, Vh, Ch, KBASE((t) + 1), NEXT3(cb_t)); } SBAR(); }                                               \
        pv_tile<VB, SK>(o, vb0, pa0, pa1, pa2, pa3, ACT((t) - 1)); MASKT(PX0, PX1, (t)); partialSM(PX0, PX1, m_reg, mnX, alX);                                        \
        __syncthreads();                                                                                                      \
        if ((t) + 1 < NT) { VMW(); if constexpr (F32) { SWRITE_VF(SB); SBAR(); if ((t) + 2 < NT) SLOAD_F((const float*)Kh, KBASE((t) + 2)); } \
                            else { SWRITE_H(SB); } }                                                                          \
        RESC(alX); __syncthreads(); } while (0)
    for (int t = 1; t + 1 < NT; t += 2) {
        HALF_STEP(pB0, pB1, mnB, alB, pA0, pA1, alA, t, 1, 0, 0);
        HALF_STEP(pA0, pA1, mnA, alA, pB0, pB1, alB, t + 1, 0, 1, 1);
    }
    const bool even = (NT & 1) == 0;
    if (even) { SBAR(); cb_t = NEXT3(cb_t); qkt<1, SK>(pB0, pB1, K_lds, r32, hi, S.qr, ACT(NT - 1), cb_t); SBAR(); }
#define QROW(e) (nxt.Q() + (size_t)(wid * QBLK + r32) * PITCH + ((e) >> 1) * 16 + hi * 8 + ((e) & 1) * 4)
    if constexpr (F32) { SLOAD_F((const float*)nxt.K(), kbn); SBAR();
#pragma unroll
        for (int e = 0; e < 8; ++e) S.tq[e] = *(const f32x4*)QROW(e); }
    else { SLOAD_H(nxt.K(), nxt.V(), nxt.C(), kbn, NEXT3(cb_t)); S.cbi = NEXT3(cb_t); SBAR();
#pragma unroll
        for (int d0 = 0; d0 < 8; ++d0) S.qr[d0] = load8<TIn>(nxt.Q() + (size_t)(wid * QBLK + r32) * PITCH + d0 * 16 + hi * 8); }
    SBAR();
    finishSM(pA0, pA1, alA, l_reg, pa0, pa1, pa2, pa3); SBAR();
    if constexpr (F32) {
#pragma unroll
        for (int e = 8; e < 16; ++e) S.tq[e] = *(const f32x4*)QROW(e); SBAR(); }
#undef QROW
    pv_tile<0, SK>(o, vb0, pa0, pa1, pa2, pa3, ACT(even ? NT - 2 : NT - 1));
    if (even) { MASKT(pB0, pB1, NT - 1); partialSM(pB0, pB1, m_reg, mnB, alB); __syncthreads(); RESC(alB);
        finishSM(pB0, pB1, alB, l_reg, pa0, pa1, pa2, pa3); SBAR(); pv_tile<1, SK>(o, vb0, pa0, pa1, pa2, pa3, ACT(NT - 1)); }
    SBAR(); SEAM_K0();
    if (hi == 0) li_l[r32] = l_reg; asm volatile("s_waitcnt lgkmcnt(0)" ::: "memory");
    float rli[16];
#pragma unroll
    for (int r = 0; r < 16; ++r) rli[r] = __builtin_amdgcn_rcpf(li_l[crow(r, hi)]);
    int hi_e = hi; asm volatile("" : "+v"(hi_e));
    TOut* Ow = cur.O() + (size_t)(wid * QBLK) * PITCH + (size_t)(4 * hi_e) * PITCH; const char* gl_ = lds + LDS_GATE + wid * 8192 + 4 * hi_e * 256;
#pragma unroll
    for (int r = 0; r < 16; ++r) { const int orow = (r & 3) + 8 * (r >> 2);
#pragma unroll
        for (int d0 = 0; d0 < 4; ++d0) { const float v = o[d0][r] * rli[r];
            if constexpr (same_t<TOut, float>::v) { Ow[(size_t)orow * PITCH + d0 * 32 + r32] = v; }
            else { const float vn = __shfl_xor(v, 1);
                   if ((r32 & 1) == 0) { const unsigned gw_ = *(const unsigned*)(gl_ + orow * 256 + (d0 * 32 + r32) * 2);
                       const float g0_ = __uint_as_float(gw_ << 16), g1_ = __uint_as_float(gw_ & 0xffff0000u);
                       const float s0_ = __builtin_amdgcn_rcpf(1.f + __builtin_amdgcn_exp2f(-1.4426950408889634f * g0_)), s1_ = __builtin_amdgcn_rcpf(1.f + __builtin_amdgcn_exp2f(-1.4426950408889634f * g1_));
                       *(unsigned*)(Ow + (size_t)orow * PITCH + d0 * 32 + r32) = cvtpk(v * s0_, vn * s1_); } } } }
    if constexpr (F32) {
#pragma unroll
        for (int d0 = 0; d0 < 8; ++d0) S.qr[d0] = pack8(S.tq[2 * d0], S.tq[2 * d0 + 1]); }
    __syncthreads();
#undef RESC
#undef KBASE
#undef ACT
#undef MASKT
#undef SEAM_K0
#undef HALF_STEP
}
#undef ROW
#undef VMW
#undef VMWN
#undef SLOAD_H
#undef SWRITE_HK
#undef SWRITE_HV
#undef SWRITE_H
#undef SLOAD_F
#undef SWRITE_KF
#undef SWRITE_VF

}
#ifndef RW_SOLVE_OLD
#define RW_SOLVE_OLD 0
#endif
namespace rw {
typedef short bf16x8 __attribute__((ext_vector_type(8)));
typedef float f32x4 __attribute__((ext_vector_type(4)));
typedef unsigned u32x4 __attribute__((ext_vector_type(4)));
typedef unsigned u32x2 __attribute__((ext_vector_type(2)));
#define RW_LAS __attribute__((address_space(3)))
constexpr int PB = 144, PF = 272, MB = 64 * PB;
constexpr int O_R = 0, O_K = MB, O_A = 2 * MB, O_B = 3 * MB, O_BT = 4 * MB, O_KT = 5 * MB, O_VT = 6 * MB, O_AAK = 7 * MB, O_ARB = 8 * MB, O_ARK = 9 * MB;
constexpr int O_AAB = 10 * MB, O_GT = O_AAB + 64 * PF, O_GAM = O_GT + 64 * PF, O_TOT = O_GAM + 256, O_END = O_TOT + 2048;
constexpr int O_AABB = O_END, O_TB = O_AABB + MB, O_END2 = O_TB + 4 * 768;
constexpr int O_WT = O_K, O_UT = O_AAK;
static_assert(O_END2 <= 143360, "phase A LDS map");
constexpr int REC = 32768, REC_P = 0, REC_Q = 8192, REC_H = 16384, REC_Y = 24576;
typedef float f32x2_t __attribute__((ext_vector_type(2))); typedef __bf16 bf16x2_t __attribute__((ext_vector_type(2)));
__device__ __forceinline__ unsigned cvtpk(float lo, float hi) { f32x2_t v = {lo, hi}; bf16x2_t b = __builtin_convertvector(v, bf16x2_t); return __builtin_bit_cast(unsigned, b); }
__device__ __forceinline__ float blo(unsigned w) { return __uint_as_float(w << 16); }
__device__ __forceinline__ float bhi(unsigned w) { return __uint_as_float(w & 0xffff0000u); }
__device__ __forceinline__ bf16x8 frag(const RW_LAS unsigned char* base, int tile, int ks, int lane) { return *(const RW_LAS bf16x8*)(base + (16 * tile + (lane & 15)) * PB + (ks * 32 + 8 * (lane >> 4)) * 2); }
#define RW_MFMA(a, b, c) __builtin_amdgcn_mfma_f32_16x16x32_bf16(a, b, c, 0, 0, 0)
#define RW_SYNC() __syncthreads()
#define RW_BAR() do { asm volatile("" ::: "memory"); __builtin_amdgcn_s_barrier(); asm volatile("" ::: "memory"); } while (0)

struct ChunkIn { u32x4 r, k, v, a; f32x4 l0, l1; };
__device__ __forceinline__ void load_chunk(ChunkIn& c, const unsigned char* ws, int it, int tid) {
    const int bh = it >> 8, ch = it & 255, b = bh >> 4, h = bh & 15, tok = tid >> 3, part = tid & 7;
    const size_t off = ((size_t)b * SEQ + (size_t)ch * 64 + tok) * 1024 + h * 64 + 8 * part;
    c.r = *(const u32x4*)((const unsigned short*)(ws + WS_R) + off); c.k = *(const u32x4*)((const unsigned short*)(ws + WS_K) + off); c.v = *(const u32x4*)((const unsigned short*)(ws + WS_V) + off);
    c.a = *(const u32x4*)((const unsigned short*)(ws + WS_A) + off); c.l0 = *(const f32x4*)((const float*)(ws + WS_LOGW) + off); c.l1 = *(const f32x4*)((const float*)(ws + WS_LOGW) + off + 4);
}
__device__ __forceinline__ void phase_a(RW_LAS unsigned char* L, unsigned char* ws, const float* kk_all, const float* ka_all, int wg, int G, int tid) {
    const int lane = tid & 63, w = __builtin_amdgcn_readfirstlane(tid >> 6), g = lane >> 4, l15 = lane & 15;
    ChunkIn cin; if (wg < 8192) load_chunk(cin, ws, wg, tid);
  for (int it = wg; it < 8192; it += G) {
    unsigned char* rec = ws + WS_REC + (size_t)it * REC; const float* kkw_g = kk_all + ((it >> 8) & 15) * 64; const float* kaw_g = ka_all + ((it >> 8) & 15) * 64;
    { const int tok = tid >> 3, part = tid & 7, c0 = 8 * part;
      const u32x4 rw_ = cin.r, kw_ = cin.k, vw_ = cin.v, aw_ = cin.a; const f32x4 l0 = cin.l0, l1 = cin.l1;
      float lw[8] = {l0[0], l0[1], l0[2], l0[3], l1[0], l1[1], l1[2], l1[3]}, cum[8];
#pragma unroll
      for (int i = 0; i < 8; ++i) { float v = lw[i];
          float u = __shfl_up(v, 8); if (lane >= 8) v += u; u = __shfl_up(v, 16); if (lane >= 16) v += u; u = __shfl_up(v, 32); if (lane >= 32) v += u; cum[i] = v; }
      RW_LAS float* tot = (RW_LAS float*)(L + O_TOT);
      if (lane >= 56) {
#pragma unroll
          for (int i = 0; i < 8; ++i) tot[w * 64 + c0 + i] = cum[i]; }
      RW_SYNC();
#pragma unroll
      for (int ww = 0; ww < 7; ++ww) if (ww < w) { const f32x4 a0 = *(const RW_LAS f32x4*)(tot + ww * 64 + c0), a1 = *(const RW_LAS f32x4*)(tot + ww * 64 + c0 + 4);
#pragma unroll
          for (int i = 0; i < 4; ++i) { cum[i] += a0[i]; cum[4 + i] += a1[i]; } }
      float r[8] = {blo(rw_.x), bhi(rw_.x), blo(rw_.y), bhi(rw_.y), blo(rw_.z), bhi(rw_.z), blo(rw_.w), bhi(rw_.w)};
      float k[8] = {blo(kw_.x), bhi(kw_.x), blo(kw_.y), bhi(kw_.y), blo(kw_.z), bhi(kw_.z), blo(kw_.w), bhi(kw_.w)};
      float a[8] = {blo(aw_.x), bhi(aw_.x), blo(aw_.y), bhi(aw_.y), blo(aw_.z), bhi(aw_.z), blo(aw_.w), bhi(aw_.w)};
      const f32x4 kk0 = *(const f32x4*)(kkw_g + c0), kk1 = *(const f32x4*)(kkw_g + c0 + 4), ka0 = *(const f32x4*)(kaw_g + c0), ka1 = *(const f32x4*)(kaw_g + c0 + 4);
      float kk[8], ss = 0.f;
#pragma unroll
      for (int i = 0; i < 8; ++i) { kk[i] = k[i] * (i < 4 ? kk0[i] : kk1[i - 4]); ss += kk[i] * kk[i]; }
      ss += __shfl_xor(ss, 1); ss += __shfl_xor(ss, 2); ss += __shfl_xor(ss, 4);
      const float inv = 1.f / fmaxf(sqrtf(ss), 1e-12f);
      float Rt[8], Kt[8], At[8], Bt[8];
#pragma unroll
      for (int i = 0; i < 8; ++i) { const float eL = __expf(cum[i]), eLi = __expf(-cum[i]), eLx = __expf(cum[i] - lw[i]); const float kn = kk[i] * inv;
          Rt[i] = r[i] * eL; Kt[i] = k[i] * (1.f + (a[i] - 1.f) * (i < 4 ? ka0[i] : ka1[i - 4])) * eLi; At[i] = -kn * eLx; Bt[i] = kn * a[i] * eLi;
          if (tok == 63) ((RW_LAS float*)(L + O_GAM))[c0 + i] = eL; }
      u32x4 o;
      o.x = cvtpk(Rt[0], Rt[1]); o.y = cvtpk(Rt[2], Rt[3]); o.z = cvtpk(Rt[4], Rt[5]); o.w = cvtpk(Rt[6], Rt[7]); *(RW_LAS u32x4*)(L + O_R + tok * PB + c0 * 2) = o;
      o.x = cvtpk(Kt[0], Kt[1]); o.y = cvtpk(Kt[2], Kt[3]); o.z = cvtpk(Kt[4], Kt[5]); o.w = cvtpk(Kt[6], Kt[7]); *(RW_LAS u32x4*)(L + O_K + tok * PB + c0 * 2) = o;
      const u32x4 kq = o;
      o.x = cvtpk(At[0], At[1]); o.y = cvtpk(At[2], At[3]); o.z = cvtpk(At[4], At[5]); o.w = cvtpk(At[6], At[7]); *(RW_LAS u32x4*)(L + O_A + tok * PB + c0 * 2) = o;
      o.x = cvtpk(Bt[0], Bt[1]); o.y = cvtpk(Bt[2], Bt[3]); o.z = cvtpk(Bt[4], Bt[5]); o.w = cvtpk(Bt[6], Bt[7]); *(RW_LAS u32x4*)(L + O_B + tok * PB + c0 * 2) = o;
      const unsigned bq[4] = {o.x, o.y, o.z, o.w}, kq4[4] = {kq.x, kq.y, kq.z, kq.w}, vq[4] = {vw_.x, vw_.y, vw_.z, vw_.w};
#pragma unroll
      for (int i = 0; i < 8; ++i) { const int sh = (i & 1) * 16;
          *(RW_LAS unsigned short*)(L + O_BT + (c0 + i) * PB + tok * 2) = (unsigned short)(bq[i >> 1] >> sh);
          *(RW_LAS unsigned short*)(L + O_KT + (c0 + i) * PB + tok * 2) = (unsigned short)(kq4[i >> 1] >> sh);
          *(RW_LAS unsigned short*)(L + O_VT + (c0 + i) * PB + tok * 2) = (unsigned short)(vq[i >> 1] >> sh); }
    }
    if (it + G < 8192) load_chunk(cin, ws, it + G, tid);
    RW_SYNC();
    const int t4 = w & 3, p2 = (w >> 2) * 2;
    { const bf16x8 b0 = frag(L + O_B, t4, 0, lane), b1 = frag(L + O_B, t4, 1, lane), k0 = frag(L + O_K, t4, 0, lane), k1 = frag(L + O_K, t4, 1, lane);
#pragma unroll
      for (int u = 0; u < 2; ++u) { const int nt = p2 + u, t = 16 * nt + l15, s0 = 16 * t4 + 4 * g;
          f32x4 ab = {0.f, 0.f, 0.f, 0.f}, ak = ab, rb = ab, rk = ab;
          if (t4 <= nt) { const bf16x8 a0 = frag(L + O_A, nt, 0, lane), a1 = frag(L + O_A, nt, 1, lane), r0 = frag(L + O_R, nt, 0, lane), r1 = frag(L + O_R, nt, 1, lane);
              ab = RW_MFMA(b0, a0, ab); ab = RW_MFMA(b1, a1, ab); ak = RW_MFMA(k0, a0, ak); ak = RW_MFMA(k1, a1, ak);
              rb = RW_MFMA(b0, r0, rb); rb = RW_MFMA(b1, r1, rb); rk = RW_MFMA(k0, r0, rk); rk = RW_MFMA(k1, r1, rk);
#pragma unroll
              for (int r = 0; r < 4; ++r) { const int s = s0 + r; if (!(s < t)) { ab[r] = 0.f; ak[r] = 0.f; } if (!(s <= t)) { rb[r] = 0.f; rk[r] = 0.f; } } }
          *(RW_LAS f32x4*)(L + O_AAB + t * PF + s0 * 4) = ab;
          u32x2 o; o.x = cvtpk(ab[0], ab[1]); o.y = cvtpk(ab[2], ab[3]); *(RW_LAS u32x2*)(L + O_AABB + t * PB + s0 * 2) = o;
          o.x = cvtpk(ak[0], ak[1]); o.y = cvtpk(ak[2], ak[3]); *(RW_LAS u32x2*)(L + O_AAK + t * PB + s0 * 2) = o;
          o.x = cvtpk(rb[0], rb[1]); o.y = cvtpk(rb[2], rb[3]); *(RW_LAS u32x2*)(L + O_ARB + t * PB + s0 * 2) = o;
          o.x = cvtpk(rk[0], rk[1]); o.y = cvtpk(rk[2], rk[3]); *(RW_LAS u32x2*)(L + O_ARK + t * PB + s0 * 2) = o; } }
    RW_SYNC();
    { const bf16x8 a0 = frag(L + O_AAK, t4, 0, lane), a1 = frag(L + O_AAK, t4, 1, lane);
#pragma unroll
      for (int u = 0; u < 2; ++u) { const int nt = p2 + u; f32x4 acc = {0.f, 0.f, 0.f, 0.f};
          acc = RW_MFMA(a0, frag(L + O_VT, nt, 0, lane), acc); acc = RW_MFMA(a1, frag(L + O_VT, nt, 1, lane), acc);
          *(RW_LAS f32x4*)(L + O_GT + (16 * nt + l15) * PF + (16 * t4 + 4 * g) * 4) = acc; } }
    if (w < 4 && lane < 16) {
        float x[16]; const RW_LAS unsigned char* ab = L + O_AAB + 16 * w * PF + 16 * w * 4;
#pragma unroll
        for (int r = 0; r < 16; ++r) { float a0 = (r == lane) ? 1.f : 0.f, a1 = 0.f;
#pragma unroll
            for (int q4 = 0; q4 < (r + 3) / 4; ++q4) { const f32x4 av = *(const RW_LAS f32x4*)(ab + r * PF + q4 * 16);
                if (4 * q4 + 0 < r) a0 += av[0] * x[4 * q4 + 0]; if (4 * q4 + 1 < r) a1 += av[1] * x[4 * q4 + 1]; if (4 * q4 + 2 < r) a0 += av[2] * x[4 * q4 + 2]; if (4 * q4 + 3 < r) a1 += av[3] * x[4 * q4 + 3]; }
            x[r] = a0 + a1; *(RW_LAS unsigned short*)(L + O_TB + w * 768 + r * 48 + lane * 2) = (unsigned short)(cvtpk(x[r], 0.f) & 0xffffu); } }
    RW_SYNC();
#if RW_SOLVE_OLD
    if (tid < 128) { const int c = tid;
        const RW_LAS unsigned char* rhs = c < 64 ? (L + O_A + c * 2) : (L + O_GT + (c - 64) * PF);
        RW_LAS unsigned char* dst = c < 64 ? (L + O_WT + c * PB) : (L + O_UT + (c - 64) * PB);
        for (int b = 0; b < 4; ++b) { float z[16];
#pragma unroll
            for (int r = 0; r < 16; ++r) z[r] = c < 64 ? blo((unsigned)*(const RW_LAS unsigned short*)(rhs + (16 * b + r) * PB)) : *(const RW_LAS float*)(rhs + (16 * b + r) * 4);
            const RW_LAS unsigned char* arow = L + O_AAB + 16 * b * PF;
            for (int s4 = 0; s4 < 4 * b; ++s4) { const u32x2 xw = *(const RW_LAS u32x2*)(dst + s4 * 8); const float x0 = blo(xw.x), x1 = bhi(xw.x), x2 = blo(xw.y), x3 = bhi(xw.y);
#pragma unroll
                for (int r = 0; r < 16; ++r) { const f32x4 av = *(const RW_LAS f32x4*)(arow + r * PF + s4 * 16); z[r] += (av[0] * x0 + av[1] * x1) + (av[2] * x2 + av[3] * x3); } }
#pragma unroll
            for (int r = 1; r < 16; ++r) {
#pragma unroll
                for (int q4 = 0; q4 < (r + 3) / 4; ++q4) { const f32x4 av = *(const RW_LAS f32x4*)(arow + r * PF + (4 * b + q4) * 16);
                    if (4 * q4 + 0 < r) z[r] += av[0] * z[4 * q4 + 0]; if (4 * q4 + 1 < r) z[r] += av[1] * z[4 * q4 + 1]; if (4 * q4 + 2 < r) z[r] += av[2] * z[4 * q4 + 2]; if (4 * q4 + 3 < r) z[r] += av[3] * z[4 * q4 + 3]; } }
            u32x4 o; o.x = cvtpk(z[0], z[1]); o.y = cvtpk(z[2], z[3]); o.z = cvtpk(z[4], z[5]); o.w = cvtpk(z[6], z[7]); *(RW_LAS u32x4*)(dst + 32 * b) = o;
            o.x = cvtpk(z[8], z[9]); o.y = cvtpk(z[10], z[11]); o.z = cvtpk(z[12], z[13]); o.w = cvtpk(z[14], z[15]); *(RW_LAS u32x4*)(dst + 32 * b + 16) = o;
            asm volatile("s_waitcnt lgkmcnt(0)" ::: "memory"); } }
    RW_SYNC();
#else
    { RW_LAS unsigned char* xt = (w < 4 ? L + O_WT : L + O_UT) + (w & 3) * 16 * PB;
      { const u32x4 z4 = {0u, 0u, 0u, 0u}; *(RW_LAS u32x4*)(xt + l15 * PB + g * 16) = z4; *(RW_LAS u32x4*)(xt + l15 * PB + 64 + g * 16) = z4; }
      asm volatile("s_waitcnt lgkmcnt(0)" ::: "memory");
#pragma unroll
      for (int b = 0; b < 4; ++b) { f32x4 z;
          if (w < 4) { const RW_LAS unsigned char* ap = L + O_A + (16 * b + 4 * g) * PB + (16 * w + l15) * 2;
              z = (f32x4){blo((unsigned)*(const RW_LAS unsigned short*)(ap)), blo((unsigned)*(const RW_LAS unsigned short*)(ap + PB)), blo((unsigned)*(const RW_LAS unsigned short*)(ap + 2 * PB)), blo((unsigned)*(const RW_LAS unsigned short*)(ap + 3 * PB))}; }
          else z = *(const RW_LAS f32x4*)(L + O_GT + (16 * (w - 4) + l15) * PF + (16 * b + 4 * g) * 4);
          if (b > 0) { z = RW_MFMA(frag(L + O_AABB, b, 0, lane), *(const RW_LAS bf16x8*)(xt + l15 * PB + (8 * g) * 2), z);
                       if (b > 2) z = RW_MFMA(frag(L + O_AABB, b, 1, lane), *(const RW_LAS bf16x8*)(xt + l15 * PB + (32 + 8 * g) * 2), z); }
          const u32x2 tw = *(const RW_LAS u32x2*)(L + O_TB + b * 768 + l15 * 48 + (4 * g) * 2);
          const u32x4 tf = {tw.x, tw.y, 0u, 0u}, zf = {cvtpk(z[0], z[1]), cvtpk(z[2], z[3]), 0u, 0u};
          f32x4 xb = {0.f, 0.f, 0.f, 0.f}; xb = RW_MFMA(__builtin_bit_cast(bf16x8, tf), __builtin_bit_cast(bf16x8, zf), xb);
          u32x2 o; o.x = cvtpk(xb[0], xb[1]); o.y = cvtpk(xb[2], xb[3]); *(RW_LAS u32x2*)(xt + l15 * PB + (16 * b + 4 * g) * 2) = o;
          asm volatile("s_waitcnt lgkmcnt(0)" ::: "memory"); } }
    RW_SYNC();
#endif
    {
      const bf16x8 rb0 = frag(L + O_ARB, t4, 0, lane), rb1 = frag(L + O_ARB, t4, 1, lane), bt0 = frag(L + O_BT, t4, 0, lane), bt1 = frag(L + O_BT, t4, 1, lane);
      const int col = 16 * t4 + l15; const float gam = ((const RW_LAS float*)(L + O_GAM))[col];
      unsigned qw[4], pw[4];
#pragma unroll
      for (int u = 0; u < 2; ++u) { const int mt = p2 + u, j0 = 16 * mt + 4 * g; const bf16x8 w0 = frag(L + O_WT, mt, 0, lane), w1 = frag(L + O_WT, mt, 1, lane);
          f32x4 q = {0.f, 0.f, 0.f, 0.f}, p = q; q = RW_MFMA(w0, rb0, q); q = RW_MFMA(w1, rb1, q); p = RW_MFMA(w0, bt0, p); p = RW_MFMA(w1, bt1, p);
          const u32x2 rr = *(const RW_LAS u32x2*)(L + O_R + col * PB + j0 * 2);
          q[0] += blo(rr.x); q[1] += bhi(rr.x); q[2] += blo(rr.y); q[3] += bhi(rr.y);
#pragma unroll
          for (int r = 0; r < 4; ++r) p[r] = (p[r] + ((j0 + r) == col ? 1.f : 0.f)) * gam;
          qw[2 * u] = cvtpk(q[0], q[1]); qw[2 * u + 1] = cvtpk(q[2], q[3]); pw[2 * u] = cvtpk(p[0], p[1]); pw[2 * u + 1] = cvtpk(p[2], p[3]); }
      const int fo = ((t4 * 2 + (p2 >> 1)) * 64 + lane) * 16;
      *(u32x4*)(rec + REC_Q + fo) = (u32x4){qw[0], qw[1], qw[2], qw[3]}; *(u32x4*)(rec + REC_P + fo) = (u32x4){pw[0], pw[1], pw[2], pw[3]}; }
    {
      const bf16x8 rb0 = frag(L + O_ARB, t4, 0, lane), rb1 = frag(L + O_ARB, t4, 1, lane), rk0 = frag(L + O_ARK, t4, 0, lane), rk1 = frag(L + O_ARK, t4, 1, lane);
      const bf16x8 ut0 = frag(L + O_UT, t4, 0, lane), ut1 = frag(L + O_UT, t4, 1, lane), vt0 = frag(L + O_VT, t4, 0, lane), vt1 = frag(L + O_VT, t4, 1, lane);
      const int col = 16 * t4 + l15;
#pragma unroll
      for (int u = 0; u < 2; ++u) { const int mt = p2 + u, m0 = 16 * mt + 4 * g;
          f32x4 y = {0.f, 0.f, 0.f, 0.f}, hm = y;
          y = RW_MFMA(frag(L + O_UT, mt, 0, lane), rb0, y); y = RW_MFMA(frag(L + O_UT, mt, 1, lane), rb1, y); y = RW_MFMA(frag(L + O_VT, mt, 0, lane), rk0, y); y = RW_MFMA(frag(L + O_VT, mt, 1, lane), rk1, y);
          hm = RW_MFMA(frag(L + O_BT, mt, 0, lane), ut0, hm); hm = RW_MFMA(frag(L + O_BT, mt, 1, lane), ut1, hm); hm = RW_MFMA(frag(L + O_KT, mt, 0, lane), vt0, hm); hm = RW_MFMA(frag(L + O_KT, mt, 1, lane), vt1, hm);
          const f32x4 gm = *(const RW_LAS f32x4*)(L + O_GAM + m0 * 4);
          u32x2 o; o.x = cvtpk(y[0], y[1]); o.y = cvtpk(y[2], y[3]); *(u32x2*)(rec + REC_Y + (col * 64 + m0) * 2) = o;
          o.x = cvtpk(hm[0] * gm[0], hm[1] * gm[1]); o.y = cvtpk(hm[2] * gm[2], hm[3] * gm[3]); *(u32x2*)(rec + REC_H + (col * 64 + m0) * 2) = o; } }
    RW_SYNC();
  }
}

__device__ __forceinline__ void phase_b_head(RW_LAS unsigned char* L, const unsigned char* recs, float* Yg, int tid) {
    constexpr int NCH = 256, NSLOT = 4;
    const int lane = tid & 63, w = __builtin_amdgcn_readfirstlane(tid >> 6), g = lane >> 4, l15 = lane & 15;
    if (w >= 4) {
        const int lw = w - 4; const unsigned char* src = recs + lw * 8192 + lane * 16;
#define RW_ISSUE(c_) do { _Pragma("unroll") for (int k_ = 0; k_ < 8; ++k_) __builtin_amdgcn_global_load_lds((const unsigned*)(src + (size_t)(c_) * REC + k_ * 1024), (RW_LAS unsigned*)(L + ((c_) & 3) * REC + lw * 8192 + k_ * 1024), 16, 0, 0); } while (0)
        RW_ISSUE(0); RW_ISSUE(1); RW_ISSUE(2);
        asm volatile("s_waitcnt vmcnt(16)" ::: "memory");
        RW_BAR();
        for (int c = 0; c < NCH; ++c) {
            if (c + 3 < NCH) { RW_ISSUE(c + 3); asm volatile("s_waitcnt vmcnt(16)" ::: "memory"); }
            else asm volatile("s_waitcnt vmcnt(0)" ::: "memory");
            RW_BAR();
        }
#undef RW_ISSUE
    } else {
        f32x4 sacc[4];
#pragma unroll
        for (int m = 0; m < 4; ++m) sacc[m] = (f32x4){0.f, 0.f, 0.f, 0.f};
        RW_BAR();
        for (int c = 0; c < NCH; ++c) { const RW_LAS unsigned char* sl = L + (c & 3) * REC;
            bf16x8 bf[2];
#pragma unroll
            for (int s = 0; s < 2; ++s) { u32x4 v; v.x = cvtpk(sacc[2 * s][0], sacc[2 * s][1]); v.y = cvtpk(sacc[2 * s][2], sacc[2 * s][3]); v.z = cvtpk(sacc[2 * s + 1][0], sacc[2 * s + 1][1]); v.w = cvtpk(sacc[2 * s + 1][2], sacc[2 * s + 1][3]); bf[s] = __builtin_bit_cast(bf16x8, v); }
            f32x4 sn[4];
#pragma unroll
            for (int m = 0; m < 4; ++m) { const u32x2 hw = *(const RW_LAS u32x2*)(sl + REC_H + ((16 * w + l15) * 64 + 16 * m + 4 * g) * 2);
                f32x4 acc = {blo(hw.x), bhi(hw.x), blo(hw.y), bhi(hw.y)};
                acc = RW_MFMA(*(const RW_LAS bf16x8*)(sl + REC_P + ((m * 2 + 0) * 64 + lane) * 16), bf[0], acc);
                acc = RW_MFMA(*(const RW_LAS bf16x8*)(sl + REC_P + ((m * 2 + 1) * 64 + lane) * 16), bf[1], acc); sn[m] = acc; }
#pragma unroll
            for (int n = 0; n < 4; ++n) { const u32x2 yw = *(const RW_LAS u32x2*)(sl + REC_Y + ((16 * n + l15) * 64 + 16 * w + 4 * g) * 2);
                f32x4 acc = {blo(yw.x), bhi(yw.x), blo(yw.y), bhi(yw.y)};
                acc = RW_MFMA(bf[0], *(const RW_LAS bf16x8*)(sl + REC_Q + ((n * 2 + 0) * 64 + lane) * 16), acc);
                acc = RW_MFMA(bf[1], *(const RW_LAS bf16x8*)(sl + REC_Q + ((n * 2 + 1) * 64 + lane) * 16), acc);
                *(f32x4*)(Yg + (size_t)(c * 64 + 16 * n + l15) * 1024 + 16 * w + 4 * g) = acc; }
#pragma unroll
            for (int m = 0; m < 4; ++m) sacc[m] = sn[m];
            asm volatile("s_waitcnt lgkmcnt(0)" ::: "memory");
            RW_BAR();
        }
    }
}
}
#define XB_TMO      128
#define XB_XCNT(j)  (256  + 64 * (j))
#define XB_XSUB(j)  (1280 + 64 * (j))
#define XB_XGEN(j)  (2304 + 64 * (j))
#define XB_TOP      3328
#define XB_TOPGEN   3392
#define XCD_BAR_WORDS 3456
#define XB_SPIN_CAP (1u << 18)

__device__ __forceinline__ unsigned xb_ld(unsigned* p)              { return __hip_atomic_load(p, __ATOMIC_RELAXED, __HIP_MEMORY_SCOPE_AGENT); }
__device__ __forceinline__ unsigned xb_add(unsigned* p, unsigned v) { return __hip_atomic_fetch_add(p, v, __ATOMIC_RELAXED, __HIP_MEMORY_SCOPE_AGENT); }
__device__ __forceinline__ unsigned xb_xcc_id() { return (unsigned)__builtin_amdgcn_s_getreg((3 << 11) | 20) & 0xFu; }
#define XB_SPIN(cond, bar) do { unsigned _sp = 0; while (cond) { __builtin_amdgcn_s_sleep(1); \
    if ((++_sp & 255u) == 0u) { if (xb_ld(&(bar)[XB_TMO])) break; if (_sp > XB_SPIN_CAP) { atomicAdd(&(bar)[XB_TMO], 1u); break; } } } } while (0)

struct XcdBarrier {
    unsigned* bar; unsigned x;
    volatile LAS unsigned* st;
};

__device__ __forceinline__ XcdBarrier xcd_barrier_post(unsigned* bar, volatile LAS unsigned* st, const int tid) {
    XcdBarrier b; b.bar = bar; b.x = xb_xcc_id(); b.st = st;
    if (tid == 0) (void)xb_add(&bar[XB_XCNT(b.x)], 1u);
    return b;
}
__device__ __forceinline__ void xcd_barrier_complete(unsigned* bar, unsigned x, unsigned& nloc, unsigned& nx) {
    const unsigned G = gridDim.x * gridDim.y * gridDim.z;
    unsigned sum, cnt, mine, sp = 0u;
    for (;;) {
        sum = 0u; cnt = 0u; mine = 0u;
#pragma unroll
        for (unsigned j = 0; j < 16; ++j) { const unsigned c = xb_ld(&bar[XB_XCNT(j)]); sum += c; cnt += (c > 0u) ? 1u : 0u; mine = (j == x) ? c : mine; }
        if (sum == G) break;
        __builtin_amdgcn_s_sleep(1);
        if ((++sp & 255u) == 0u) { if (xb_ld(&bar[XB_TMO])) break; if (sp > XB_SPIN_CAP) { atomicAdd(&bar[XB_TMO], 1u); break; } }
    }
    nloc = mine > 0u ? mine : 1u; nx = cnt > 0u ? cnt : 1u;
}

__device__ __forceinline__ void xcd_barrier(const XcdBarrier& b, const int tid) {
    asm volatile("s_waitcnt vmcnt(0)" ::: "memory");
    __syncthreads();
    if (tid == 0) {
        unsigned* bar = b.bar;
        __builtin_amdgcn_s_waitcnt(0);
        unsigned nloc = b.st[0], nx = b.st[1];
        if (nloc == 0u) { xcd_barrier_complete(bar, b.x, nloc, nx); b.st[0] = nloc; b.st[1] = nx; }
        const unsigned old = xb_add(&bar[XB_XSUB(b.x)], 1u);
        const unsigned gen = old / nloc;
        if (old + 1u == (gen + 1u) * nloc) {
            __builtin_amdgcn_fence(__ATOMIC_RELEASE, "agent");
            asm volatile("s_waitcnt vmcnt(0)" ::: "memory");
            const unsigned og = xb_add(&bar[XB_TOP], 1u);
            const unsigned tg = og / nx;
            if (og + 1u == (tg + 1u) * nx) xb_add(&bar[XB_TOPGEN], 1u);
            else XB_SPIN(xb_ld(&bar[XB_TOPGEN]) == tg, bar);
            __builtin_amdgcn_fence(__ATOMIC_ACQUIRE, "agent");
            xb_add(&bar[XB_XGEN(b.x)], 1u);
            asm volatile("s_waitcnt vmcnt(0)" ::: "memory");
        } else {
            XB_SPIN(xb_ld(&bar[XB_XGEN(b.x)]) == gen, bar);
            __builtin_amdgcn_fence(__ATOMIC_ACQUIRE, "agent");
            asm volatile("s_waitcnt vmcnt(0)" ::: "memory");
        }
    }
    __syncthreads();
}
enum InIdx { I_X = 0, I_C, I_WADA, I_BADA, I_N1G, I_WIN, I_MU, I_WDEC, I_W0, I_WICLR, I_A0, I_WGATE, I_KK, I_KA, I_RK, I_GNG, I_GNB, I_WOA, I_BF, I_QN, I_KN, I_WOB, I_WOUT, I_N2G, I_WR, I_BR, I_WGU, I_BGU, I_WDN, I_BDN, I_NFG, N_IN };
struct Args { const float* in[N_IN]; float* out; unsigned char* ws; int ph_lo, ph_hi; };
static_assert(sizeof(Args) == (N_IN + 2) * 8 + 8, "Args has no padding");
typedef const __attribute__((address_space(4))) Args* ArgsP;
struct Frame {
    LAS unsigned char* lds;
    volatile LAS unsigned* MISC;
    gu32* ctl;
    int tid, lane, wave, G, wg;
    unsigned char* ws;
    ArgsP ap;
};
#define WSP(T_, off) ((T_*)(F.ws + (off)))

__device__ __forceinline__ int win_orig_col(int c) {
    if (c < PC_FQ) return c;
    if (c < PC_OG) return 3520 + (c - PC_FQ);
    if (c < PC_GA) return 6600 + (c - PC_OG);
    if (c < PC_GLO) return 7624 + (c - PC_GA);
    if (c < PC_DLO) return 3264 + (c - PC_GLO);
    if (c < PC_ALO) return 3072 + (c - PC_DLO);
    if (c < PC_F) return 3168 + (c - PC_ALO);
    if (c < PC_END) return 6592 + (c - PC_F);
    return -1;
}
__device__ __forceinline__ void tr_item(const float* W, int ldw, int K, bf16* WT, int drow0, int scol0, int nvalid, int k0, LAS float* scr, int lane) {
    const int n = lane & 31;
#pragma unroll 8
    for (int i = 0; i < 32; ++i) { const int kk = 2 * i + (lane >> 5); scr[kk * 33 + n] = (n < nvalid) ? W[(size_t)(k0 + kk) * ldw + scol0 + n] : 0.f; }
    LDS_WAIT(); asm volatile("" ::: "memory");
    const int c = lane & 7;
#pragma unroll
    for (int j = 0; j < 4; ++j) { const int nn = (lane >> 3) + 8 * j; const LAS float* s = scr + (8 * c) * 33 + nn;
        v4u o; o.x = pk2(s[0 * 33], s[1 * 33]); o.y = pk2(s[2 * 33], s[3 * 33]); o.z = pk2(s[4 * 33], s[5 * 33]); o.w = pk2(s[6 * 33], s[7 * 33]);
        *(GAS v4u*)(WT + (size_t)(drow0 + nn) * K + k0 + 8 * c) = o; }
    LDS_WAIT(); asm volatile("" ::: "memory");
}
__device__ __forceinline__ unsigned pk4_fp8(float a, float b, float c, float d) { int w = __builtin_amdgcn_cvt_pk_fp8_f32(a, b, 0, false); w = __builtin_amdgcn_cvt_pk_fp8_f32(c, d, w, true); return (unsigned)w; }
__device__ __forceinline__ void tr_item8(const float* W, int ldw, int K, unsigned char* WT, int drow0, int scol0, int k0, float scale, LAS float* scr, int lane) {
    const int n = lane & 31;
#pragma unroll 8
    for (int i = 0; i < 32; ++i) { const int kk = 2 * i + (lane >> 5); scr[kk * 33 + n] = W[(size_t)(k0 + kk) * ldw + scol0 + n] * scale; }
    LDS_WAIT(); asm volatile("" ::: "memory");
    const int c = lane & 7;
#pragma unroll
    for (int j = 0; j < 4; ++j) { const int nn = (lane >> 3) + 8 * j; const LAS float* s = scr + (8 * c) * 33 + nn;
        v2u o; o.x = pk4_fp8(s[0 * 33], s[1 * 33], s[2 * 33], s[3 * 33]); o.y = pk4_fp8(s[4 * 33], s[5 * 33], s[6 * 33], s[7 * 33]);
        *(GAS v2u*)(WT + (size_t)(drow0 + nn) * K + k0 + 8 * c) = o; }
    LDS_WAIT(); asm volatile("" ::: "memory");
}
__device__ __forceinline__ void p0_prologue(Frame& F) {
    LAS float* scr = (LAS float*)(F.lds + RING_OFF + F.wave * 16384);
    const int gw = F.wg * NWAVES + F.wave, NGW = F.G * NWAVES, lane = F.lane;
    constexpr int I_IN = 32 * 368, I_OA = 16 * 64, I_OB = I_OA, I_OUT = 32 * 64, I_GU = NE * 32 * 128, I_DN = NE * 32 * 64;
    constexpr int NITEMS = I_IN + I_OA + I_OB + I_OUT + I_GU + I_DN;
    for (int it = gw; it < NITEMS; it += NGW) {
        int r = it;
        if (r < I_IN) { const int kb = r / 368, gp = r % 368, c0 = gp * 32, oc = win_orig_col(c0); int nv = 32; if (oc < 0) nv = 0; else if (c0 + 32 > PC_END) nv = PC_END - c0;
            tr_item(F.ap->in[I_WIN], 11720, 2048, WSP(bf16, WS_WIN), c0, oc < 0 ? 0 : oc, nv, kb * 64, scr, lane); continue; } r -= I_IN;
        if (r < I_OA) { tr_item(F.ap->in[I_WOA], 2048, 1024, WSP(bf16, WS_WOA), (r % 64) * 32, (r % 64) * 32, 32, (r / 64) * 64, scr, lane); continue; } r -= I_OA;
        if (r < I_OB) { tr_item(F.ap->in[I_WOB], 2048, 1024, WSP(bf16, WS_WOB), (r % 64) * 32, (r % 64) * 32, 32, (r / 64) * 64, scr, lane); continue; } r -= I_OB;
        if (r < I_OUT) { tr_item(F.ap->in[I_WOUT], 2048, 2048, WSP(bf16, WS_WOUT), (r % 64) * 32, (r % 64) * 32, 32, (r / 64) * 64, scr, lane); continue; } r -= I_OUT;
        if (r < I_GU) { const int e = r / (32 * 128), q = r % (32 * 128), kb = q / 128, gp = q % 128, d0 = gp * 32;
            const int pn = d0 >> 8, j = d0 & 255, sc = j < 128 ? 128 * pn + j : 2048 + 128 * pn + (j - 128);
            tr_item8(F.ap->in[I_WGU] + (size_t)e * 2048 * 4096, 4096, 2048, WSP(unsigned char, WS_WGU) + (size_t)e * 4096 * 2048, d0, sc, kb * 64, FP8_SW, scr, lane); continue; } r -= I_GU;
        { const int e = r / (32 * 64), q = r % (32 * 64), kb = q / 64, gp = q % 64;
            tr_item8(F.ap->in[I_WDN] + (size_t)e * 2048 * 2048, 2048, 2048, WSP(unsigned char, WS_WDN) + (size_t)e * 2048 * 2048, gp * 32, gp * 32, kb * 64, FP8_SW, scr, lane); }
    }
    const int gt = F.wg * (NWAVES * 64) + F.tid, NGT = F.G * NWAVES * 64;
    { bf16* b1 = WSP(bf16, WS_BT1); const float* wd = F.ap->in[I_WDEC]; const float* wi = F.ap->in[I_WICLR];
      for (int i = gt; i < 2048 * 256; i += NGT) { const int n = i >> 8, k = i & 255; float v = 0.f;
          if (n < 1024) { if (k < 96) v = wd[k * 1024 + n]; } else { if (k >= 128 && k < 224) v = wi[(k - 128) * 1024 + (n - 1024)]; }
          b1[i] = (bf16)f2bf(v); } }
    { bf16* b2 = WSP(bf16, WS_BT2); const float* wg = F.ap->in[I_WGATE];
      for (int i = gt; i < 1024 * 256; i += NGT) { const int n = i >> 8, k = i & 255; b2[i] = (bf16)f2bf(wg[k * 1024 + n]); } }
    { float* wrt = WSP(float, WS_WRT); const float* wr = F.ap->in[I_WR];
      for (int i = gt; i < 32 * 2048; i += NGT) { const int e = i >> 11, k = i & 2047; wrt[i] = wr[k * 32 + e]; } }
    { bf16* h = WSP(bf16, WS_H) + (size_t)T * DM; for (int i = gt; i < DM; i += NGT) h[i] = 0; }
    if (F.wg < 192) {
        const float* wa = F.ap->in[I_WADA]; const float* cc = F.ap->in[I_C]; const int n = F.wg * 64 + lane;
        float s0 = 0.f, s1 = 0.f;
        for (int k = F.wave * 256; k < F.wave * 256 + 256; ++k) { const float w = wa[(size_t)k * 12288 + n]; const float c0 = cc[k], c1 = cc[2048 + k];
            s0 += c0 * sigmoidf_(c0) * w; s1 += c1 * sigmoidf_(c1) * w; }
        LAS float* red = (LAS float*)(F.lds + RING_OFF + 131072 - 4096);
        __syncthreads();
        red[(F.wave * 2 + 0) * 64 + lane] = s0; red[(F.wave * 2 + 1) * 64 + lane] = s1;
        __syncthreads();
        if (F.wave < 2) { float s = 0.f;
#pragma unroll
            for (int w = 0; w < 8; ++w) s += red[(w * 2 + F.wave) * 64 + lane];
            WSP(float, WS_MOD)[F.wave * 12288 + n] = s + F.ap->in[I_BADA][n]; }
    }
}
__device__ __forceinline__ void norm_mod_rows(Frame& F, const float* x, const float* g, int shift_off, int scale_off, bf16* H) {
    const int gw = F.wg * NWAVES + F.wave, NGW = F.G * NWAVES, lane = F.lane; const float* mod = WSP(float, WS_MOD);
    for (int m = gw; m < T; m += NGW) {
        const f32x4* xr = (const f32x4*)(x + (size_t)m * DM) + lane; f32x4 v[8]; float ss = 0.f;
#pragma unroll
        for (int j = 0; j < 8; ++j) { v[j] = xr[64 * j]; ss += (v[j].x * v[j].x + v[j].y * v[j].y) + (v[j].z * v[j].z + v[j].w * v[j].w); }
        const float rs = rsqrtf(wave_sum(ss) * (1.f / DM) + NORM_EPS); const float* mb = mod + (size_t)(m / SEQ) * 12288;
#pragma unroll
        for (int j = 0; j < 8; ++j) { const int c = 4 * lane + 256 * j; const f32x4 gg = *(const f32x4*)(g + c), sc = *(const f32x4*)(mb + scale_off + c), sh = *(const f32x4*)(mb + shift_off + c);
            const f32x4 y = v[j] * rs * gg * (sc + 1.f) + sh; v2u o; o.x = pk2(y.x, y.y); o.y = pk2(y.z, y.w); *(v2u*)(H + (size_t)m * DM + c) = o; }
    }
}
__device__ __forceinline__ void p3_prep(Frame& F) {
    const int gw = F.wg * NWAVES + F.wave, NGW = F.G * NWAVES, lane = F.lane;
    const bf16* P = WSP(bf16, WS_P); const float* mu = F.ap->in[I_MU];
    bf16* Rb = WSP(bf16, WS_R); bf16* LW = WSP(bf16, WS_LW); bf16* SG = WSP(bf16, WS_SG);
    for (int t = gw; t < T; t += NGW) {
        const bf16* pc = P + (size_t)t * NP; const bool first = (t % SEQ) == 0; const bf16* pp = first ? pc : pc - NP;
#pragma unroll
        for (int s = 0; s < 6; ++s) { const int c = (s * 64 + lane) * 8; float a[8], b[8], o[8]; unpack8(*(const v4u*)(pc + c), a); unpack8(*(const v4u*)(pp + c), b);
            const f32x4 m0 = *(const f32x4*)(mu + c), m1 = *(const f32x4*)(mu + c + 4);
#pragma unroll
            for (int i = 0; i < 8; ++i) { const float pv = first ? 0.f : b[i]; const float mm = i < 4 ? m0[i] : m1[i - 4]; o[i] = a[i] + mm * (pv - a[i]); }
            *(v4u*)(Rb + (size_t)(c >> 10) * ((WS_K - WS_R) / 2) + (size_t)t * RW + (c & 1023)) = pack8f(o); }
        { int c, mi; if (lane < 32) { c = PC_GLO + 8 * lane; mi = 3264 + 8 * lane; } else if (lane < 44) { c = PC_DLO + 8 * (lane - 32); mi = 3072 + 8 * (lane - 32); } else { c = PC_ALO + 8 * (lane - 44); mi = 3168 + 8 * (lane - 44); }
          float o[8] = {0.f, 0.f, 0.f, 0.f, 0.f, 0.f, 0.f, 0.f};
          if (lane < 56) { float a[8], b[8]; unpack8(*(const v4u*)(pc + c), a); unpack8(*(const v4u*)(pp + c), b);
              const f32x4 m0 = *(const f32x4*)(mu + mi), m1 = *(const f32x4*)(mu + mi + 4);
#pragma unroll
              for (int i = 0; i < 8; ++i) { const float pv = first ? 0.f : b[i]; const float mm = i < 4 ? m0[i] : m1[i - 4]; const float v = a[i] + mm * (pv - a[i]);
                  o[i] = lane < 32 ? sigmoidf_(v) : (lane < 44 ? tanhf(v) : v); } }
          bf16* dst; if (lane < 32) dst = SG + (size_t)t * 256 + 8 * lane; else if (lane < 44) dst = LW + (size_t)t * 256 + 8 * (lane - 32); else if (lane < 56) dst = LW + (size_t)t * 256 + 128 + 8 * (lane - 44);
          else if (lane < 60) dst = LW + (size_t)t * 256 + 96 + 8 * (lane - 56); else dst = LW + (size_t)t * 256 + 224 + 8 * (lane - 60);
          *(v4u*)dst = pack8f(o); }
#pragma unroll
        for (int s = 0; s < 2; ++s) { const int ch = s * 64 + lane, d0 = (ch & 15) * 8;
#pragma unroll
            for (int qk = 0; qk < 2; ++qk) { float a[8]; unpack8(*(const v4u*)(pc + (qk ? PC_FK : PC_FQ) + ch * 8), a); float ss = 0.f;
#pragma unroll
                for (int i = 0; i < 8; ++i) ss += a[i] * a[i];
                ss += __shfl_xor(ss, 1); ss += __shfl_xor(ss, 2); ss += __shfl_xor(ss, 4); ss += __shfl_xor(ss, 8);
                const float rs = rsqrtf(ss * (1.f / 128.f) + NORM_EPS); const float* gn = F.ap->in[qk ? I_KN : I_QN] + d0;
                const f32x4 g0 = *(const f32x4*)gn, g1 = *(const f32x4*)(gn + 4);
#pragma unroll
                for (int i = 0; i < 8; ++i) a[i] = a[i] * rs * (i < 4 ? g0[i] : g1[i - 4]);
                *(v4u*)(WSP(bf16, qk ? WS_FK : WS_FQ) + (size_t)t * FW + ch * 8) = pack8f(a); }
            *(v4u*)(WSP(bf16, WS_FV) + (size_t)t * FW + ch * 8) = *(const v4u*)(pc + PC_FV + ch * 8); }
        if (lane < 8) { const float xv = bflo((unsigned)pc[PC_F + lane]) + F.ap->in[I_BF][lane];
            WSP(float, WS_LF)[(size_t)t * 8 + lane] = fminf(xv, 0.f) - log1pf(__expf(-fabsf(xv))); }
    }
}
__device__ __forceinline__ void p4_cumsum(Frame& F) {
    if (F.wg >= 16) return;
    const int b = F.wg >> 3, h = F.wg & 7; const float* lf = WSP(float, WS_LF) + (size_t)b * SEQ * 8 + h; float* cs = WSP(float, WS_CS) + (size_t)F.wg * SEQ;
    LAS float* part = (LAS float*)(F.lds + RING_OFF);
    const int t0 = F.tid * 32; float s = 0.f;
    for (int i = 0; i < 32; ++i) s += lf[(size_t)(t0 + i) * 8];
    part[F.tid] = s; __syncthreads();
    if (F.tid == 0) { float run = 0.f; for (int i = 0; i < 512; ++i) { const float v = part[i]; part[i] = run; run += v; } }
    __syncthreads();
    float run = part[F.tid];
    for (int i = 0; i < 32; ++i) { run += lf[(size_t)(t0 + i) * 8]; cs[t0 + i] = -run * 11.313708498984761f; }
    __syncthreads();
}
__device__ __forceinline__ void p5_scan_naive(Frame& F) {
    constexpr int CH = 64;
    LAS float* Wl = (LAS float*)(F.lds + RING_OFF); LAS float* Al = Wl + CH * 64; LAS float* Bl = Al + CH * 64; LAS float* Kl = Bl + CH * 64; LAS float* Rl = Kl + CH * 64; LAS float* Vl = Rl + CH * 64; LAS float* Yl = Vl + CH * 64;
    const int tid = F.tid, row = tid >> 3, q = tid & 7;
    for (int bh = F.wg; bh < 32; bh += F.G) {
        const int b = bh >> 4, h = bh & 15; const size_t base = (size_t)b * SEQ * RW + h * 64;
        const bf16* Rg = WSP(bf16, WS_R) + base; const bf16* Kg = WSP(bf16, WS_K) + base; const bf16* Vg = WSP(bf16, WS_V) + base; const bf16* Ag = WSP(bf16, WS_A) + base;
        const float* Lg = WSP(float, WS_LOGW) + base; float* Yg = WSP(float, WS_YRAW) + base;
        float kkw[8], kaw[8];
#pragma unroll
        for (int i = 0; i < 8; ++i) { kkw[i] = F.ap->in[I_KK][h * 64 + 8 * q + i]; kaw[i] = F.ap->in[I_KA][h * 64 + 8 * q + i]; }
        float S[8] = {0.f, 0.f, 0.f, 0.f, 0.f, 0.f, 0.f, 0.f};
        for (int t0 = 0; t0 < SEQ; t0 += CH) {
            { const size_t off = (size_t)(t0 + row) * RW + 8 * q; float r[8], k[8], v[8], a[8];
              unpack8(*(const v4u*)(Rg + off), r); unpack8(*(const v4u*)(Kg + off), k); unpack8(*(const v4u*)(Vg + off), v); unpack8(*(const v4u*)(Ag + off), a);
              const f32x4 l0 = *(const f32x4*)(Lg + off), l1 = *(const f32x4*)(Lg + off + 4);
              float kk[8], ss = 0.f;
#pragma unroll
              for (int i = 0; i < 8; ++i) { kk[i] = k[i] * kkw[i]; ss += kk[i] * kk[i]; }
              ss += __shfl_xor(ss, 1); ss += __shfl_xor(ss, 2); ss += __shfl_xor(ss, 4);
              const float inv = 1.f / fmaxf(sqrtf(ss), 1e-12f);
#pragma unroll
              for (int i = 0; i < 8; ++i) { const int o = row * 64 + 8 * q + i; kk[i] *= inv;
                  Wl[o] = __expf(i < 4 ? l0[i] : l1[i - 4]); Al[o] = -kk[i]; Bl[o] = kk[i] * a[i]; Kl[o] = k[i] * (1.f + (a[i] - 1.f) * kaw[i]); Rl[o] = r[i]; Vl[o] = v[i]; } }
            __syncthreads();
            for (int t = 0; t < CH; ++t) { const int o = t * 64 + 8 * q; float sa = 0.f;
                const f32x4 a0 = *(const LAS f32x4*)(Al + o), a1 = *(const LAS f32x4*)(Al + o + 4), w0 = *(const LAS f32x4*)(Wl + o), w1 = *(const LAS f32x4*)(Wl + o + 4);
                const f32x4 b0 = *(const LAS f32x4*)(Bl + o), b1 = *(const LAS f32x4*)(Bl + o + 4), k0 = *(const LAS f32x4*)(Kl + o), k1 = *(const LAS f32x4*)(Kl + o + 4);
                const f32x4 r0 = *(const LAS f32x4*)(Rl + o), r1 = *(const LAS f32x4*)(Rl + o + 4); const float vv = Vl[t * 64 + row];
#pragma unroll
                for (int i = 0; i < 8; ++i) sa += S[i] * (i < 4 ? a0[i] : a1[i - 4]);
                sa += __shfl_xor(sa, 1); sa += __shfl_xor(sa, 2); sa += __shfl_xor(sa, 4);
                float y = 0.f;
#pragma unroll
                for (int i = 0; i < 8; ++i) { S[i] = S[i] * (i < 4 ? w0[i] : w1[i - 4]) + sa * (i < 4 ? b0[i] : b1[i - 4]) + vv * (i < 4 ? k0[i] : k1[i - 4]); y += S[i] * (i < 4 ? r0[i] : r1[i - 4]); }
                y += __shfl_xor(y, 1); y += __shfl_xor(y, 2); y += __shfl_xor(y, 4);
                if (q == 0) Yl[t * 64 + row] = y; }
            __syncthreads();
            { const int tt = tid >> 3, c = (tid & 7) * 8; *(f32x4*)(Yg + (size_t)(t0 + tt) * RW + c) = *(const LAS f32x4*)(Yl + tt * 64 + c); *(f32x4*)(Yg + (size_t)(t0 + tt) * RW + c + 4) = *(const LAS f32x4*)(Yl + tt * 64 + c + 4); }
        }
        __syncthreads();
    }
}
__device__ __forceinline__ void p7_post(Frame& F) {
    const int gw = F.wg * NWAVES + F.wave, NGW = F.G * NWAVES, lane = F.lane, c0 = 16 * lane;
    for (int t = gw; t < T; t += NGW) { const size_t off = (size_t)t * RW + c0;
        float y[16], r[16], k[16], v[16], a[16], g[16];
#pragma unroll
        for (int j = 0; j < 4; ++j) { const f32x4 yy = *(const f32x4*)(WSP(float, WS_YRAW) + off + 4 * j); y[4 * j] = yy.x; y[4 * j + 1] = yy.y; y[4 * j + 2] = yy.z; y[4 * j + 3] = yy.w; }
#pragma unroll
        for (int j = 0; j < 2; ++j) { float tmp[8];
            unpack8(*(const v4u*)(WSP(bf16, WS_R) + off + 8 * j), tmp); for (int i = 0; i < 8; ++i) r[8 * j + i] = tmp[i];
            unpack8(*(const v4u*)(WSP(bf16, WS_K) + off + 8 * j), tmp); for (int i = 0; i < 8; ++i) k[8 * j + i] = tmp[i];
            unpack8(*(const v4u*)(WSP(bf16, WS_V) + off + 8 * j), tmp); for (int i = 0; i < 8; ++i) v[8 * j + i] = tmp[i];
            unpack8(*(const v4u*)(WSP(bf16, WS_A) + off + 8 * j), tmp); for (int i = 0; i < 8; ++i) a[8 * j + i] = tmp[i];
            unpack8(*(const v4u*)(WSP(bf16, WS_G) + off + 8 * j), tmp); for (int i = 0; i < 8; ++i) g[8 * j + i] = tmp[i]; }
        float s = 0.f, bs = 0.f;
#pragma unroll
        for (int i = 0; i < 16; ++i) { s += y[i]; const float kp = k[i] * (1.f + (a[i] - 1.f) * F.ap->in[I_KA][c0 + i]); bs += r[i] * kp * F.ap->in[I_RK][c0 + i]; }
        s += __shfl_xor(s, 1); s += __shfl_xor(s, 2); bs += __shfl_xor(bs, 1); bs += __shfl_xor(bs, 2);
        const float mean = s * (1.f / 64.f); float q = 0.f;
#pragma unroll
        for (int i = 0; i < 16; ++i) { const float d = y[i] - mean; q += d * d; }
        q += __shfl_xor(q, 1); q += __shfl_xor(q, 2);
        const float rstd = rsqrtf(q * (1.f / 64.f) + GN_EPS); float o[16];
#pragma unroll
        for (int i = 0; i < 16; ++i) o[i] = ((y[i] - mean) * rstd * F.ap->in[I_GNG][c0 + i] + F.ap->in[I_GNB][c0 + i] + bs * v[i]) * g[i];
#pragma unroll
        for (int j = 0; j < 2; ++j) { v4u w; w.x = pk2(o[8 * j], o[8 * j + 1]); w.y = pk2(o[8 * j + 2], o[8 * j + 3]); w.z = pk2(o[8 * j + 4], o[8 * j + 5]); w.w = pk2(o[8 * j + 6], o[8 * j + 7]); *(v4u*)(WSP(bf16, WS_YA) + off + 8 * j) = w; }
    }
}
__device__ __forceinline__ fox::BlockRef<fox::bf16, fox::bf16> fox_ref(int L_, int pass_, const unsigned char* ws) {
    constexpr int NQB = fox::SQ / fox::QB, NX = NQB / 2;
    const int bh = L_ / NX, x = L_ % NX, qb = pass_ ? (NQB - 1 - x) : x;
    fox::BlockRef<fox::bf16, fox::bf16> r; r.ws = ws; r.row0 = (bh / fox::H) * fox::SQ + qb * fox::QB; r.bh = bh; r.P0 = qb * fox::QB; return r;
}
__device__ __forceinline__ void p6_attention(Frame& F, char* lds) {
    constexpr int NQB = fox::SQ / fox::QB, NX = NQB / 2, TOTAL = NX * fox::B * fox::H;
    const int stride = F.G; int L = F.wg; if (L >= TOTAL) return;
    int pass = 0;
    fox::BlockRef<fox::bf16, fox::bf16> cur = fox_ref(L, 0, F.ws);
    fox::Seam<fox::bf16> S;
    fox::causal_swa_prime<fox::bf16, fox::bf16>(cur, fox::WINDOW, lds, S, F.tid);
    for (;;) {
        const bool more_pass = pass == 0, more_item = L + stride < TOTAL, last = !more_pass && !more_item;
        int passn = pass + 1, Ln = L;
        if (!more_pass) { passn = 0; Ln = more_item ? L + stride : L; }
        const fox::BlockRef<fox::bf16, fox::bf16> nxt = last ? cur : fox_ref(Ln, passn, F.ws);
        fox::causal_swa_block<fox::bf16, fox::bf16>(cur, nxt, fox::SKV, fox::WINDOW, lds, S, F.tid);
        if (last) break;
        cur = nxt; pass = passn; L = Ln;
    }
}
typedef float f32x4m __attribute__((ext_vector_type(4)));
__device__ __forceinline__ void p11_router(Frame& F) {
    constexpr int TPW = T / 256 / NWAVES;
    const int lane = F.lane, t0 = (F.wg * NWAVES + F.wave) * TPW;
    const float* x1 = WSP(float, WS_X1); const float* mod = WSP(float, WS_MOD) + (size_t)(t0 / SEQ) * 12288; const float* g2 = F.ap->in[I_N2G]; bf16* H = WSP(bf16, WS_H);
    LAS float* lg = (LAS float*)(F.lds + RING_OFF + F.wave * 4096);
    LAS int* cnt = (LAS int*)(F.lds + RING_OFF + 65536);
    if (F.tid < 32) cnt[F.tid] = 0;
    __syncthreads();
    for (int i = 0; i < TPW; ++i) { const int m = t0 + i;
        const f32x4* xr = (const f32x4*)(x1 + (size_t)m * DM) + lane; f32x4 v[8]; float ss = 0.f;
#pragma unroll
        for (int j = 0; j < 8; ++j) { v[j] = xr[64 * j]; ss += (v[j].x * v[j].x + v[j].y * v[j].y) + (v[j].z * v[j].z + v[j].w * v[j].w); }
        const float rs = rsqrtf(wave_sum(ss) * (1.f / DM) + NORM_EPS);
        if (lane == 0) lg[512 + i] = rs;
#pragma unroll
        for (int j = 0; j < 8; ++j) { const int c = 4 * lane + 256 * j; const f32x4 gg = *(const f32x4*)(g2 + c), sc = *(const f32x4*)(mod + 4 * 2048 + c), sh = *(const f32x4*)(mod + 3 * 2048 + c);
            const f32x4 y = v[j] * rs * gg * (sc + 1.f) + sh; v2u o; o.x = pk2(y.x, y.y); o.y = pk2(y.z, y.w); *(v2u*)(H + (size_t)m * DM + c) = o; }
    }
    LDS_WAIT();
    { const int i = lane & 15, q = lane >> 4; const float rs = lg[512 + i]; const float* xr = x1 + (size_t)(t0 + i) * DM + 4 * q; const float* wr = WSP(float, WS_WRT) + (size_t)i * DM + 4 * q;
      f32x4m acc0 = {0.f, 0.f, 0.f, 0.f}, acc1 = {0.f, 0.f, 0.f, 0.f};
#pragma unroll 4
      for (int Sx = 0; Sx < DM / 16; ++Sx) { const int k = 16 * Sx;
          const f32x4 xv = *(const f32x4*)(xr + k), gg = *(const f32x4*)(g2 + k + 4 * q), sc = *(const f32x4*)(mod + 4 * 2048 + k + 4 * q), sh = *(const f32x4*)(mod + 3 * 2048 + k + 4 * q);
          const f32x4 hv = xv * rs * gg * (sc + 1.f) + sh; const f32x4 w0 = *(const f32x4*)(wr + k), w1 = *(const f32x4*)(wr + 16 * DM + k);
#pragma unroll
          for (int jj = 0; jj < 4; ++jj) { acc0 = __builtin_amdgcn_mfma_f32_16x16x4f32(hv[jj], w0[jj], acc0, 0, 0, 0); acc1 = __builtin_amdgcn_mfma_f32_16x16x4f32(hv[jj], w1[jj], acc1, 0, 0, 0); } }
      const float b0 = F.ap->in[I_BR][i], b1 = F.ap->in[I_BR][16 + i];
#pragma unroll
      for (int r = 0; r < 4; ++r) { lg[(4 * q + r) * 32 + i] = acc0[r] + b0; lg[(4 * q + r) * 32 + 16 + i] = acc1[r] + b1; } }
    LDS_WAIT();
    if (lane < 16) { const int m = t0 + lane; float v[4]; int e[4]; unsigned used = 0u;
#pragma unroll
        for (int k = 0; k < 4; ++k) { float best = -3.0e38f; int bi = 0;
            for (int j = 0; j < 32; ++j) { const float x = lg[lane * 32 + j]; if (!((used >> j) & 1u) && x > best) { best = x; bi = j; } }
            used |= 1u << bi; v[k] = best; e[k] = bi; }
        const float e1 = __expf(v[1] - v[0]), e2 = __expf(v[2] - v[0]), e3 = __expf(v[3] - v[0]), inv = 1.f / (1.f + e1 + e2 + e3);
        *(f32x4*)(WSP(float, WS_TOKW) + (size_t)m * 4) = (f32x4){inv, e1 * inv, e2 * inv, e3 * inv};
        int* te = WSP(int, WS_TOKE) + (size_t)m * 4; te[0] = e[0]; te[1] = e[1]; te[2] = e[2]; te[3] = e[3];
#pragma unroll
        for (int k = 0; k < 4; ++k) __hip_atomic_fetch_add(cnt + e[k], 1, __ATOMIC_RELAXED, __HIP_MEMORY_SCOPE_WORKGROUP); }
    __syncthreads();
    if (F.tid < 32) WSP(int, WS_WGCNT)[F.wg * 32 + F.tid] = cnt[F.tid];
    __syncthreads();
}
__device__ __forceinline__ void p12_slots(Frame& F) {
    constexpr int TPG = T / 256;
    LAS int* cur = (LAS int*)(F.lds + RING_OFF); LAS int* tot = cur + 32; LAS int* pre = cur + 64; LAS int* off = cur + 96; LAS int* slotl = cur + 160;
    const int* wgcnt = WSP(int, WS_WGCNT);
    if (F.tid < 32) { int tt = 0, pp = 0; for (int w = 0; w < 256; ++w) { const int c = wgcnt[w * 32 + F.tid]; if (w < F.wg) pp += c; tt += c; } tot[F.tid] = tt; pre[F.tid] = pp; }
    __syncthreads();
    if (F.tid == 0) { int o = 0; for (int e = 0; e < 32; ++e) { off[e] = o; o += (tot[e] + 255) & ~255; } off[32] = o; }
    __syncthreads();
    if (F.tid < 32) cur[F.tid] = off[F.tid] + pre[F.tid];
    if (F.wg == 0) { int* te = WSP(int, WS_TILEE); const int nt = off[32] >> 8;
        for (int p = F.tid; p < nt; p += NWAVES * 64) { int e = 0; for (int j = 1; j < 32; ++j) if ((p << 8) >= off[j]) e = j; te[p] = e; }
        if (F.tid == 0) te[1024] = nt; }
    __syncthreads();
    { const int t = F.wg * TPG + (F.tid >> 2), k = F.tid & 3; const int e = WSP(int, WS_TOKE)[(size_t)t * 4 + k];
      const int s = __hip_atomic_fetch_add(cur + e, 1, __ATOMIC_RELAXED, __HIP_MEMORY_SCOPE_WORKGROUP);
      slotl[F.tid] = s; WSP(int, WS_TOKS)[(size_t)t * 4 + k] = s; WSP(float, WS_SLOTW)[s] = WSP(float, WS_TOKW)[(size_t)t * 4 + k]; }
    __syncthreads();
    const bf16* H = WSP(bf16, WS_H); unsigned char* HS = WSP(unsigned char, WS_HS);
    for (int i = 0; i < TPG / NWAVES; ++i) { const int tl = F.wave * (TPG / NWAVES) + i, t = F.wg * TPG + tl; v2u v[4];
#pragma unroll
        for (int j = 0; j < 4; ++j) { float f[8]; unpack8(*(const v4u*)(H + (size_t)t * DM + 8 * (F.lane + 64 * j)), f);
            v[j].x = pk4_fp8(f[0] * FP8_SA1, f[1] * FP8_SA1, f[2] * FP8_SA1, f[3] * FP8_SA1); v[j].y = pk4_fp8(f[4] * FP8_SA1, f[5] * FP8_SA1, f[6] * FP8_SA1, f[7] * FP8_SA1); }
#pragma unroll
        for (int k = 0; k < 4; ++k) { const int s = slotl[tl * 4 + k];
#pragma unroll
            for (int j = 0; j < 4; ++j) *(v2u*)(HS + (size_t)s * DM + 8 * (F.lane + 64 * j)) = v[j]; } }
    __syncthreads();
}
__device__ __forceinline__ void p15_final(Frame& F) {
    const int gw = F.wg * NWAVES + F.wave, NGW = F.G * NWAVES, lane = F.lane;
    const float* x1 = WSP(float, WS_X1); const bf16* YS = WSP(bf16, WS_YS); const float* gf = F.ap->in[I_NFG];
    for (int m = gw; m < T; m += NGW) { const float* gt = WSP(float, WS_MOD) + (size_t)(m / SEQ) * 12288 + 5 * 2048;
        const int4 sl = *(const int4*)(WSP(int, WS_TOKS) + (size_t)m * 4); float v[4][8]; float ss = 0.f;
#pragma unroll
        for (int j = 0; j < 4; ++j) { const int c = 8 * (lane + 64 * j); float y[8] = {0.f, 0.f, 0.f, 0.f, 0.f, 0.f, 0.f, 0.f}, tmp[8];
            unpack8(*(const v4u*)(YS + (size_t)sl.x * DM + c), tmp); for (int i = 0; i < 8; ++i) y[i] += tmp[i];
            unpack8(*(const v4u*)(YS + (size_t)sl.y * DM + c), tmp); for (int i = 0; i < 8; ++i) y[i] += tmp[i];
            unpack8(*(const v4u*)(YS + (size_t)sl.z * DM + c), tmp); for (int i = 0; i < 8; ++i) y[i] += tmp[i];
            unpack8(*(const v4u*)(YS + (size_t)sl.w * DM + c), tmp); for (int i = 0; i < 8; ++i) y[i] += tmp[i];
            const f32x4 xa = *(const f32x4*)(x1 + (size_t)m * DM + c), xb = *(const f32x4*)(x1 + (size_t)m * DM + c + 4), ga = *(const f32x4*)(gt + c), gb = *(const f32x4*)(gt + c + 4);
#pragma unroll
            for (int i = 0; i < 8; ++i) { const float xv = (i < 4 ? xa[i] : xb[i - 4]) + (i < 4 ? ga[i] : gb[i - 4]) * y[i]; v[j][i] = xv; ss += xv * xv; } }
        const float rs = rsqrtf(wave_sum(ss) * (1.f / DM) + NORM_EPS);
#pragma unroll
        for (int j = 0; j < 4; ++j) { const int c = 8 * (lane + 64 * j); const f32x4 ga = *(const f32x4*)(gf + c), gb = *(const f32x4*)(gf + c + 4);
            *(f32x4*)(F.ap->out + (size_t)m * DM + c) = (f32x4){v[j][0] * rs * ga[0], v[j][1] * rs * ga[1], v[j][2] * rs * ga[2], v[j][3] * rs * ga[3]};
            *(f32x4*)(F.ap->out + (size_t)m * DM + c + 4) = (f32x4){v[j][4] * rs * gb[0], v[j][5] * rs * gb[1], v[j][6] * rs * gb[2], v[j][7] * rs * gb[3]}; }
    }
}

__device__ __forceinline__ bool fresh(Frame& F) {
    asm volatile("" : "+s"(F.ap)); int w = F.wave; asm volatile("" : "+s"(w)); const int l = __builtin_amdgcn_mbcnt_hi(~0u, __builtin_amdgcn_mbcnt_lo(~0u, 0u)); F.lane = l; F.tid = w * 64 + l; return true; }
constexpr int N_PHASES = 18;
__global__ void __launch_bounds__(NWAVES * 64, 2) mk_fwd(Args args) {
    extern __shared__ __attribute__((aligned(16))) unsigned char lds[];
    Frame F;
    F.lds = (LAS unsigned char*)lds; F.MISC = (volatile LAS unsigned*)(F.lds + MISC_OFF);
    F.tid = threadIdx.x; F.lane = F.tid & 63; F.wave = __builtin_amdgcn_readfirstlane(F.tid >> 6); F.G = gridDim.x; F.wg = blockIdx.x;
    F.ap = (ArgsP)__builtin_amdgcn_kernarg_segment_ptr(); F.ws = F.ap->ws; F.ctl = (gu32*)(F.ws + WS_CTL);
    for (int u = F.tid; u < (LDS_BYTES - LDSCTL_OFF) / 4; u += NWAVES * 64) ((LAS unsigned*)(F.lds + LDSCTL_OFF))[u] = 0u;
    __syncthreads();
    const int lo = F.ap->ph_lo, hi = F.ap->ph_hi;
    XcdBarrier bar; bar.bar = (unsigned*)(F.ctl + CW_BAR); bar.x = 0; bar.st = nullptr;
    if (hi - lo > 1) bar = xcd_barrier_post((unsigned*)(F.ctl + CW_BAR), F.MISC + 8, F.tid);
#ifndef PH_MASK
#define PH_MASK 0x3ffff
#endif
#define IN(k) (((PH_MASK >> (k)) & 1) && lo <= (k) && (k) < hi && fresh(F))
#ifndef PROBE_DUP
#define PROBE_DUP 0
#endif
#define REP(k) for (int rep_ = 0; rep_ < 1 + ((PROBE_DUP >> (k)) & 1); ++rep_)
#define SEAM(k) do { if (IN(k) && IN((k) + 1)) xcd_barrier(bar, F.tid); } while (0)
    if (IN(0)) REP(0) { p0_prologue(F); } SEAM(0);
    if (IN(1)) REP(1) { norm_mod_rows(F, F.ap->in[I_X], F.ap->in[I_N1G], 0, 2048, WSP(bf16, WS_H)); } SEAM(1);
    if (IN(2)) REP(2) { pg8::Gemm g{WSP(bf16, WS_H), WSP(bf16, WS_WIN), T, NP, DM}; pg8::StaticOrder S; S.init(T, NP, F.G, F.wg);
        pg8::EpiBf16<0> E{WSP(bf16, WS_P), NP, nullptr, 0, 0, 1.f}; pg8::gemm_phase<pg8::EpiBf16<0>, pg8::StaticOrder, true, true>(F.lds + RING_OFF, g, S, E, F.tid); } SEAM(2);
    if (IN(3)) REP(3) { p3_prep(F); } SEAM(3);
    if (IN(4)) REP(4) { p4_cumsum(F);
        { pg8::Gemm g{WSP(bf16, WS_LW), WSP(bf16, WS_BT1), T, 2048, 256}; pg8::StaticOrder S; S.init(T, 2048, F.G, F.wg);
          pg8::EpiLora1 E{WSP(float, WS_LOGW), WSP(bf16, WS_A), F.ap->in[I_W0], F.ap->in[I_A0]}; pg8::gemm_phase<pg8::EpiLora1, pg8::StaticOrder, true, true>(F.lds + RING_OFF, g, S, E, F.tid); }
        } SEAM(4);
    if (IN(5)) REP(5) {
        { pg8::Gemm g{WSP(bf16, WS_SG), WSP(bf16, WS_BT2), T, 1024, 256}; pg8::StaticOrder S; S.init(T, 1024, F.G, F.wg);
          pg8::EpiBf16<0> E{WSP(bf16, WS_G), 1024, nullptr, 0, 0, 1.f}; pg8::gemm_phase<pg8::EpiBf16<0>, pg8::StaticOrder, true, true>(F.lds + RING_OFF, g, S, E, F.tid); }
        } SEAM(5);
    if (IN(6)) REP(6) {
#if RWKV_NAIVE
        p5_scan_naive(F);
#else
        rw::phase_a(F.lds + RING_OFF, F.ws, F.ap->in[I_KK], F.ap->in[I_KA], F.wg, F.G, F.tid);
#endif
        } SEAM(6);
    if (IN(7)) REP(7) {
#if !RWKV_NAIVE
        for (int bh = F.wg; bh < 32; bh += F.G) { const int b = bh >> 4, h = bh & 15;
            rw::phase_b_head(F.lds + RING_OFF, F.ws + WS_REC + (size_t)bh * 256 * rw::REC, WSP(float, WS_YRAW) + (size_t)b * SEQ * RW + h * 64, F.tid); __syncthreads(); }
#endif
        } SEAM(7);
    if (IN(8)) REP(8) { p6_attention(F, (char*)lds + RING_OFF); } SEAM(8);
    if (IN(9)) REP(9) { p7_post(F); } SEAM(9);
    if (IN(10)) REP(10) { pg8::Gemm g{WSP(bf16, WS_YA), WSP(bf16, WS_WOA), T, DM, 1024}; pg8::StaticOrder S; S.init(T, DM, F.G, F.wg);
        pg8::EpiGateMerge<0> E{WSP(bf16, WS_MRG), WSP(bf16, WS_P), PC_GA}; pg8::gemm_phase<pg8::EpiGateMerge<0>, pg8::StaticOrder, true, true>(F.lds + RING_OFF, g, S, E, F.tid); } SEAM(10);
    if (IN(11)) REP(11) { pg8::Gemm g{WSP(bf16, WS_YB), WSP(bf16, WS_WOB), T, DM, 1024}; pg8::StaticOrder S; S.init(T, DM, F.G, F.wg);
        pg8::EpiGateMerge<1> E{WSP(bf16, WS_MRG), WSP(bf16, WS_P), PC_GB}; pg8::gemm_phase<pg8::EpiGateMerge<1>, pg8::StaticOrder, true, true>(F.lds + RING_OFF, g, S, E, F.tid); } SEAM(11);
    if (IN(12)) REP(12) { pg8::Gemm g{WSP(bf16, WS_MRG), WSP(bf16, WS_WOUT), T, DM, DM}; pg8::StaticOrder S; S.init(T, DM, F.G, F.wg);
        pg8::EpiResid E{F.ap->in[I_X], WSP(float, WS_X1), WSP(float, WS_MOD)}; pg8::gemm_phase<pg8::EpiResid, pg8::StaticOrder, true, true>(F.lds + RING_OFF, g, S, E, F.tid); } SEAM(12);
    if (IN(13)) REP(13) { p11_router(F); } SEAM(13);
    if (IN(14)) REP(14) { p12_slots(F); } SEAM(14);
    if (IN(15)) REP(15) { const int nt = WSP(int, WS_TILEE)[1024]; pg8::Gemm g{WSP(bf16, WS_HS), WSP(bf16, WS_WGU), nt * 256, 4096, DM / 2}; pg8::MoeOrder S; S.init(nt * 256, 4096, F.G, F.wg); S.tile_e = WSP(int, WS_TILEE);
        pg8::EpiSwiglu E{WSP(unsigned char, WS_ACT), F.ap->in[I_BGU]}; pg8::gemm_phase<pg8::EpiSwiglu, pg8::MoeOrder, true, true, true>(F.lds + RING_OFF, g, S, E, F.tid); } SEAM(15);
    if (IN(16)) REP(16) { const int nt = WSP(int, WS_TILEE)[1024]; pg8::Gemm g{WSP(bf16, WS_ACT), WSP(bf16, WS_WDN), nt * 256, 2048, DFF / 2}; pg8::MoeOrder S; S.init(nt * 256, 2048, F.G, F.wg); S.tile_e = WSP(int, WS_TILEE);
        pg8::EpiDown E{WSP(bf16, WS_YS), F.ap->in[I_BDN], WSP(float, WS_SLOTW)}; pg8::gemm_phase<pg8::EpiDown, pg8::MoeOrder, true, true, true>(F.lds + RING_OFF, g, S, E, F.tid); } SEAM(16);
    if (IN(17)) REP(17) { p15_final(F); }
#undef IN
#undef SEAM
}

extern "C" void kernel_launch(void* const* d_in, const int* in_sizes, int n_in, void* d_out, int out_size, void* d_ws, size_t ws_size, hipStream_t stream) {
    static int grid = 0;
    if (grid == 0) {
        if (n_in != N_IN || in_sizes[0] != T * DM || out_size != T * DM || ws_size < WS_END) { fprintf(stderr, "kernel_launch: shape/workspace mismatch (n_in %d, in0 %d, out %d, ws %zu < %zu)\n", n_in, n_in > 0 ? in_sizes[0] : -1, out_size, ws_size, (size_t)WS_END); grid = -1; return; }
        if (hipFuncSetAttribute((const void*)mk_fwd, hipFuncAttributeMaxDynamicSharedMemorySize, LDS_BYTES) != hipSuccess) { fprintf(stderr, "kernel_launch: hipFuncSetAttribute failed\n"); grid = -1; return; }
        int per_cu = 0;
        if (hipOccupancyMaxActiveBlocksPerMultiprocessor(&per_cu, (const void*)mk_fwd, NWAVES * 64, LDS_BYTES) != hipSuccess || per_cu < 1) fprintf(stderr, "kernel_launch: note: occupancy query reports %d workgroups per CU\n", per_cu);
        (void)hipGetLastError();
        grid = 256;
    }
    if (grid < 0) return;
    (void)hipMemsetAsync((char*)d_ws + WS_CTL, 0, CTL_ZERO_BYTES, stream);
    Args a{};
    for (int i = 0; i < N_IN; ++i) a.in[i] = (const float*)d_in[i];
    a.out = (float*)d_out; a.ws = (unsigned char*)d_ws;
#if MK_N_LAUNCHES == 1
    a.ph_lo = 0; a.ph_hi = N_PHASES;
    hipLaunchKernelGGL(mk_fwd, dim3(grid), dim3(NWAVES * 64), LDS_BYTES, stream, a);
#else
    for (int p = 0; p < N_PHASES; ++p) { a.ph_lo = p; a.ph_hi = p + 1; hipLaunchKernelGGL(mk_fwd, dim3(grid), dim3(NWAVES * 64), LDS_BYTES, stream, a); }
#endif
}
```

```cpp
#include <hip/hip_runtime.h>
#include <hip/hip_bf16.h>
#include <cstdio>
#include <cstdint>
constexpr int NWAVES = 8;
#ifndef MK_N_LAUNCHES
#define MK_N_LAUNCHES 1
#endif
#ifndef RWKV_NAIVE
#define RWKV_NAIVE 0
#endif
constexpr int BATCH = 2, SEQ = 16384, DM = 2048, T = BATCH * SEQ;
constexpr int NP = 11776;
constexpr int PC_R = 0, PC_K = 1024, PC_V = 2048, PC_FQ = 3072, PC_FK = 4096, PC_FV = 5120, PC_OG = 6144, PC_GA = 7168, PC_GB = 9216, PC_GLO = 11264, PC_DLO = 11520, PC_ALO = 11616, PC_F = 11712, PC_END = 11720;
constexpr int RW = 1024, FW = 1024, NE = 32, DFF = 2048, TOPK = 4;
constexpr int NSLOT = T * TOPK + NE * 256;
constexpr float NORM_EPS = 1e-6f, GN_EPS = 64e-5f;
constexpr float FP8_SW = 64.f, FP8_SA1 = 2.f, FP8_SA2 = 4.f;

constexpr size_t MiB = 1u << 20;
constexpr size_t WS_CTL = 0, CTL_ZERO_BYTES = 1 * MiB;
constexpr size_t WS_MOD = 1 * MiB;
constexpr size_t WS_WRT = 1 * MiB + 128 * 1024;
constexpr size_t WS_TOKE = 2 * MiB, WS_TOKW = 2 * MiB + 512 * 1024, WS_TOKS = 3 * MiB, WS_SLOTW = 3 * MiB + 512 * 1024;
constexpr size_t WS_WGCNT = 4 * MiB + 512 * 1024, WS_TILEE = 4 * MiB + 768 * 1024;
constexpr size_t WS_LF = 5 * MiB, WS_CS = 6 * MiB;
constexpr size_t WS_BT1 = 7 * MiB, WS_BT2 = 8 * MiB, WS_WOA = 9 * MiB, WS_WOB = 13 * MiB, WS_WOUT = 17 * MiB, WS_WIN = 25 * MiB;
constexpr size_t WS_WGU = 72 * MiB, WS_WDN = 584 * MiB, WS_X1 = 840 * MiB, WS_H = 1096 * MiB;
constexpr size_t WS_P = 1226 * MiB, WS_R = 1962 * MiB, WS_K = 2026 * MiB, WS_V = 2090 * MiB, WS_FQ = 2154 * MiB, WS_FK = 2218 * MiB, WS_FV = 2282 * MiB;
constexpr size_t WS_LW = 2346 * MiB, WS_SG = 2362 * MiB, WS_LOGW = 2378 * MiB, WS_A = 2506 * MiB, WS_G = 2570 * MiB, WS_YRAW = 2634 * MiB, WS_YA = 2762 * MiB, WS_YB = 2826 * MiB, WS_MRG = 2890 * MiB;
constexpr size_t WS_HS = 1226 * MiB, WS_ACT = 1500 * MiB, WS_YS = 1774 * MiB;
constexpr size_t WS_REC = 3018 * MiB;
constexpr size_t WS_END = 3274 * MiB;
static_assert(WS_WIN + (size_t)NP * DM * 2 <= WS_WGU && WS_YS + (size_t)NSLOT * DM * 2 <= WS_REC && WS_HS + (size_t)NSLOT * DM <= WS_ACT && WS_ACT + (size_t)NSLOT * DFF <= WS_YS && WS_SLOTW + (size_t)NSLOT * 4 <= WS_WGCNT, "d_ws map");
constexpr int CW_TMO = 0, CW_ATTQ = 2048, CW_BAR = 4096;

constexpr int RING_OFF = 0, RING_BYTES = 143360;
constexpr int LDSCTL_OFF = RING_BYTES, MISC_OFF = LDSCTL_OFF + 320;
constexpr int LDS_BYTES = 147456;

#define GAS __attribute__((address_space(1)))
#define LAS __attribute__((address_space(3)))
typedef unsigned short bf16;
typedef unsigned v4u __attribute__((ext_vector_type(4)));
typedef unsigned v2u __attribute__((ext_vector_type(2)));
typedef float f32x4 __attribute__((ext_vector_type(4)));
typedef short bf16x8 __attribute__((ext_vector_type(8)));
typedef GAS unsigned gu32;
#define RLX_AGENT __ATOMIC_RELAXED, __HIP_MEMORY_SCOPE_AGENT
#define LDS_WAIT() asm volatile("s_waitcnt lgkmcnt(0)" ::: "memory")
#define VM_WAIT() asm volatile("s_waitcnt vmcnt(0)" ::: "memory")
__device__ __forceinline__ unsigned f2bf(float f) { unsigned u = __builtin_bit_cast(unsigned, f); return (u + 0x7fffu + ((u >> 16) & 1u)) >> 16; }
__device__ __forceinline__ unsigned pk2(float lo, float hi) { return f2bf(lo) | (f2bf(hi) << 16); }
__device__ __forceinline__ float bflo(unsigned w) { return __uint_as_float(w << 16); }
__device__ __forceinline__ float bfhi(unsigned w) { return __uint_as_float(w & 0xffff0000u); }
__device__ __forceinline__ void unpack8(v4u w, float (&f)[8]) { f[0] = bflo(w.x); f[1] = bfhi(w.x); f[2] = bflo(w.y); f[3] = bfhi(w.y); f[4] = bflo(w.z); f[5] = bfhi(w.z); f[6] = bflo(w.w); f[7] = bfhi(w.w); }
__device__ __forceinline__ v4u pack8f(const float (&f)[8]) { v4u w; w.x = pk2(f[0], f[1]); w.y = pk2(f[2], f[3]); w.z = pk2(f[4], f[5]); w.w = pk2(f[6], f[7]); return w; }
__device__ __forceinline__ float sigmoidf_(float x) { return 1.f / (1.f + __expf(-x)); }
__device__ __forceinline__ float wave_sum(float v) {
#pragma unroll
    for (int o = 1; o < 64; o <<= 1) v += __shfl_xor(v, o);
    return v;
}
namespace pg8 {
#define PG8_LAS __attribute__((address_space(3)))
typedef unsigned short bf16_t;
typedef short bf16x8 __attribute__((ext_vector_type(8)));
typedef float f32x4 __attribute__((ext_vector_type(4)));
typedef unsigned u32x4 __attribute__((ext_vector_type(4)));
constexpr int BM = 256, BK = 64, HALF = 128, HTB = HALF * BK * 2  , STAGE_BYTES = 8 * HTB, NXCD = 8, WGM = 8;

__host__ __device__ __forceinline__ int lds_byte(int r, int c) { const int st = (r >> 4) * 2 + (c >> 5), rr = r & 15, cc = c & 31, ob = rr * 64 + cc * 2; return st * 1024 + (ob ^ (((ob >> 9) & 1) << 5)); }
__host__ __device__ __forceinline__ void stage_rc(int b, int& R, int& C) { const int st = b / 1024, sb = b % 1024, swz = sb ^ (((sb >> 9) & 1) << 5); R = (st >> 1) * 16 + swz / 64; C = (st & 1) * 32 + (swz % 64) / 2; }
__host__ __device__ __forceinline__ int perm32(int rho) { const int n = rho >> 4, i = rho & 15; return 8 * (i >> 2) + 4 * n + (i & 3); }

struct Unit { int pm, pn, e; };
struct Gemm { const bf16_t* A; const bf16_t* Bt; int M, N, K; };

struct StaticOrder {
    int nM, nN, nwg, G, c;
    __host__ __device__ void init(int M, int N, int G_, int c_) { nM = M / BM; nN = N / BM; nwg = nM * nN; G = G_; c = c_; }
    __host__ __device__ bool next(int i, Unit& u) const {
        const long L = (long)i * G + c; if (L >= nwg) return false;
        int wgid = (int)L; { const int q = nwg / NXCD, r = nwg % NXCD, xcd = wgid % NXCD, off = wgid / NXCD; wgid = (xcd < r ? xcd * (q + 1) : r * (q + 1) + (xcd - r) * q) + off; }
        const int nig = WGM * nN, gid = wgid / nig, fm = gid * WGM, gsz = (nM - fm) < WGM ? (nM - fm) : WGM;
        u.pm = fm + ((wgid % nig) % gsz); u.pn = (wgid % nig) / gsz; u.e = 0; return true;
    }
    __device__ __forceinline__ void a_ready(const Unit&) const {}
    __device__ __forceinline__ void done(const Unit&) const {}
};

__device__ __forceinline__ unsigned cvt_pk_bf16(float lo, float hi) { unsigned r; asm volatile("v_cvt_pk_bf16_f32 %0, %1, %2" : "=v"(r) : "v"(lo), "v"(hi)); return r; }
typedef float f32x2 __attribute__((ext_vector_type(2)));
__device__ __forceinline__ f32x2 gelu_pk(f32x2 v) {
    const f32x2 av = __builtin_elementwise_abs(v), d = av * 0.2316418882f + 1.0f;
    f32x2 t; t.x = __builtin_amdgcn_rcpf(d.x); t.y = __builtin_amdgcn_rcpf(d.y);
    f32x2 q = t * 0.5307027145f + (-0.7265760135f); q = q * t + 0.7107068705f; q = q * t + (-0.142248368f); q = q * t + 0.127414796f; q = q * t;
    const f32x2 s = (v * v) * (-0.72134752044f);
    f32x2 e; e.x = __builtin_amdgcn_exp2f(s.x); e.y = __builtin_amdgcn_exp2f(s.y);
    const f32x2 m = v * (q * e), r = v - m;
    f32x2 o; o.x = v.x < 0.f ? m.x : r.x; o.y = v.y < 0.f ? m.y : r.y; return o;
}

template <int ACT  > struct EpiBf16 {
    static constexpr bool PERM = true, AFTER_DRAIN = false; static_assert(ACT == 0 || ACT == 1, "EpiBf16: ACT is 0 (none) or 1 (gelu_pk)");
    bf16_t* O; int ldc; const float* bias; int split_cols; size_t split_stride; float scale0;
    __device__ __forceinline__ void operator()(const f32x4 (&acc)[2][2][4][2], const Unit& u, int wr, int wc, int fr, int fq) const {
        const int row0 = u.pm * BM + wr * 64 + fr; int colt = u.pn * BM; bf16_t* base = O;
        float sc = 1.f; if (split_cols) { const int t = colt / split_cols; base += (size_t)t * split_stride; colt -= t * split_cols; if (t == 0) sc = scale0; }
        const int col0 = colt + wc * 32 + 8 * fq, bcol0 = u.pn * BM + wc * 32 + 8 * fq;
        f32x4 bv[2][2];
#pragma unroll
        for (int bj = 0; bj < 2; ++bj)
#pragma unroll
            for (int n = 0; n < 2; ++n) bv[bj][n] = bias ? *(const f32x4*)(bias + bcol0 + bj * HALF + 4 * n) : (f32x4){0.f, 0.f, 0.f, 0.f};
#pragma unroll
        for (int ai = 0; ai < 2; ++ai)
#pragma unroll
            for (int m = 0; m < 4; ++m) { bf16_t* rowp = base + (size_t)(row0 + ai * HALF + m * 16) * ldc + col0;
#pragma unroll
                for (int bj = 0; bj < 2; ++bj) { f32x4 v0 = acc[ai][bj][m][0] + bv[bj][0], v1 = acc[ai][bj][m][1] + bv[bj][1];
                    if (ACT == 1) { f32x2 a = gelu_pk((f32x2){v0[0], v0[1]}), b = gelu_pk((f32x2){v0[2], v0[3]}), c = gelu_pk((f32x2){v1[0], v1[1]}), d = gelu_pk((f32x2){v1[2], v1[3]});
                        v0 = (f32x4){a.x, a.y, b.x, b.y}; v1 = (f32x4){c.x, c.y, d.x, d.y}; }
                    v0 = v0 * sc; v1 = v1 * sc; u32x4 w; w.x = cvt_pk_bf16(v0[0], v0[1]); w.y = cvt_pk_bf16(v0[2], v0[3]); w.z = cvt_pk_bf16(v1[0], v1[1]); w.w = cvt_pk_bf16(v1[2], v1[3]);
                    *(u32x4*)(rowp + bj * HALF) = w; } }
    }
};

typedef int v4i_t __attribute__((ext_vector_type(4))); typedef int v8i_t __attribute__((ext_vector_type(8)));
template <class Epi, class Sched, bool ALIGN_EPI = false, bool SP2 = false, bool FP8 = false>
__device__ __forceinline__ void gemm_phase(PG8_LAS unsigned char* lds, const Gemm g, const Sched& S, const Epi& E, const int tid) {
    const int wid = __builtin_amdgcn_readfirstlane(tid >> 6), lane = tid & 63, wr = wid >> 2, wc = wid & 3, fr = lane & 15, fq = lane >> 4;
    const int K = g.K, nt = K / BK;
    unsigned voffA[2], voffB[2];
#pragma unroll
    for (int i = 0; i < 2; ++i) { int R, C; stage_rc(tid * 16 + i * 8192, R, C); const int Rb = Epi::PERM ? ((R & ~31) + perm32(R & 31)) : R;
        voffA[i] = (unsigned)(R * K + C) * 2u; voffB[i] = (unsigned)(Rb * K + C) * 2u; }
    const size_t kstep = (size_t)(BK * 2);
    const size_t hstep = (size_t)HALF * K * 2;
    const size_t tstep = 2 * hstep;
    const unsigned ldsw = (unsigned)wid * 1024u;
    const int aoff = lds_byte(wr * 64 + fr, fq * 8), boff = lds_byte(wc * 32 + fr, fq * 8);
#define PG8_SA(b, h) (((b) * 2 + (h)) * HTB)
#define PG8_SB(b, h) ((4 + (b) * 2 + (h)) * HTB)
#define PG8_STAGE(bufoff, gbase, voff) do { _Pragma("unroll") for (int _i = 0; _i < 2; ++_i) \
        __builtin_amdgcn_global_load_lds((const unsigned*)((const char*)(gbase) + (voff)[_i]), (PG8_LAS unsigned*)(lds + (bufoff) + ldsw + _i * 8192), 16, 0, 0); } while (0)
#define PG8_CAT(x0, x1) __builtin_shufflevector(__builtin_bit_cast(v4i_t, x0), __builtin_bit_cast(v4i_t, x1), 0, 1, 2, 3, 4, 5, 6, 7)
#define PG8_LDA(dst, b, h) do { _Pragma("unroll") for (int m = 0; m < 4; ++m) { if constexpr (FP8) dst##8[m] = PG8_CAT(*(const PG8_LAS bf16x8*)(lds + PG8_SA(b, h) + aoff + m * 2048), *(const PG8_LAS bf16x8*)(lds + PG8_SA(b, h) + aoff + m * 2048 + 1024)); \
        else { _Pragma("unroll") for (int k = 0; k < 2; ++k) dst[m][k] = *(const PG8_LAS bf16x8*)(lds + PG8_SA(b, h) + aoff + m * 2048 + k * 1024); } } } while (0)
#define PG8_LDB(dst, b, h) do { _Pragma("unroll") for (int n = 0; n < 2; ++n) { if constexpr (FP8) dst##8[n] = PG8_CAT(*(const PG8_LAS bf16x8*)(lds + PG8_SB(b, h) + boff + n * 2048), *(const PG8_LAS bf16x8*)(lds + PG8_SB(b, h) + boff + n * 2048 + 1024)); \
        else { _Pragma("unroll") for (int k = 0; k < 2; ++k) dst[n][k] = *(const PG8_LAS bf16x8*)(lds + PG8_SB(b, h) + boff + n * 2048 + k * 1024); } } } while (0)
#define PG8_MMA16(ai, bj, At, Bt) do { __builtin_amdgcn_s_setprio(1); _Pragma("unroll") for (int m = 0; m < 4; ++m) _Pragma("unroll") for (int n = 0; n < 2; ++n) _Pragma("unroll") for (int k = 0; k < 2; ++k) \
        acc[ai][bj][m][n] = __builtin_amdgcn_mfma_f32_16x16x32_bf16(Bt[n][k], At[m][k], acc[ai][bj][m][n], 0, 0, 0); __builtin_amdgcn_s_setprio(0); } while (0)
#define PG8_MMA8(ai, bj, At, Bt) do { __builtin_amdgcn_s_setprio(1); _Pragma("unroll") for (int m = 0; m < 4; ++m) _Pragma("unroll") for (int n = 0; n < 2; ++n) \
        asm volatile("v_mfma_scale_f32_16x16x128_f8f6f4 %0, %1, %2, %0, %3, %3 op_sel_hi:[0,0,0]" : "+v"(acc[ai][bj][m][n]) : "v"(Bt##8[n]), "v"(At##8[m]), "v"(one_scale)); __builtin_amdgcn_s_setprio(0); } while (0)
#define PG8_MMA(ai, bj, At, Bt) do { if constexpr (FP8) PG8_MMA8(ai, bj, At, Bt); else PG8_MMA16(ai, bj, At, Bt); } while (0)
#define PG8_WAIT_V(n) asm volatile("s_waitcnt vmcnt(" #n ")" ::: "memory")
#define PG8_WAIT_L(n) asm volatile("s_waitcnt lgkmcnt(" #n ")" ::: "memory")
#define PG8_BAR __builtin_amdgcn_s_barrier()
#define PG8_SCHED __builtin_amdgcn_sched_barrier(0)
    Unit cur, nxt; int ui = 0;
    if (!S.next(0, cur)) return;
    f32x4 acc[2][2][4][2];
#pragma unroll
    for (int a = 0; a < 2; ++a)
#pragma unroll
        for (int b = 0; b < 2; ++b)
#pragma unroll
            for (int m = 0; m < 4; ++m)
#pragma unroll
                for (int n = 0; n < 2; ++n) acc[a][b][m][n] = (f32x4){0.f, 0.f, 0.f, 0.f};
    bf16x8 At[4][2], B0[2][2], B1[2][2]; v8i_t At8[4], B08[2], B18[2];
    int one_scale = 0x7f7f7f7f; asm volatile("" : "+v"(one_scale));
    const char* cA = (const char*)g.A + (size_t)cur.pm * tstep; const size_t estep = (size_t)g.N * K * 2; const char* cB = (const char*)g.Bt + (size_t)cur.e * estep + (size_t)cur.pn * tstep;
    S.a_ready(cur);
    if constexpr (SP2) {
        PG8_STAGE(PG8_SB(0, 0), cB, voffB); PG8_STAGE(PG8_SB(0, 1), cB + hstep, voffB); PG8_STAGE(PG8_SA(0, 0), cA, voffA); PG8_STAGE(PG8_SA(0, 1), cA + hstep, voffA);
        if (wr == 1) PG8_BAR;
        PG8_WAIT_V(2); PG8_BAR;
        PG8_STAGE(PG8_SB(1, 0), cB + kstep, voffB); PG8_STAGE(PG8_SA(1, 0), cA + kstep, voffA); PG8_STAGE(PG8_SB(1, 1), cB + hstep + kstep, voffB);
        PG8_WAIT_V(6); PG8_BAR;
    } else {
        PG8_STAGE(PG8_SB(0, 0), cB, voffB); PG8_STAGE(PG8_SA(0, 0), cA, voffA); PG8_STAGE(PG8_SB(0, 1), cB + hstep, voffB); PG8_STAGE(PG8_SA(0, 1), cA + hstep, voffA);
        if (wr == 1) PG8_BAR;
        PG8_WAIT_V(4); PG8_BAR;
        PG8_STAGE(PG8_SB(1, 0), cB + kstep, voffB); PG8_STAGE(PG8_SA(1, 0), cA + kstep, voffA); PG8_STAGE(PG8_SB(1, 1), cB + hstep + kstep, voffB);
        PG8_WAIT_V(6); PG8_BAR;
    }
    for (;;) {
        const bool has_next = S.next(ui + 1, nxt);
        const char* nA = has_next ? (const char*)g.A + (size_t)nxt.pm * tstep : cA; const char* nB = has_next ? (const char*)g.Bt + (size_t)nxt.e * estep + (size_t)nxt.pn * tstep : cB;
        for (int t = 0; t < nt; t += 2) {
            const bool last = (t == nt - 2);
            const char* a1 = cA + (size_t)(t + 1) * kstep;
            const char* a2 = last ? nA : cA + (size_t)(t + 2) * kstep; const char* b2 = last ? nB : cB + (size_t)(t + 2) * kstep;
            const char* a3 = a2 + kstep; const char* b3 = b2 + kstep;
            if (last && has_next) S.a_ready(nxt);
            if constexpr (SP2) {
            PG8_LDB(B0, 0, 0); PG8_LDB(B1, 0, 1); PG8_SCHED; PG8_LDA(At, 0, 0); PG8_STAGE(PG8_SA(1, 1), a1 + hstep, voffA);
            PG8_WAIT_V(8); PG8_WAIT_L(0); PG8_BAR; PG8_MMA(0, 0, At, B0); PG8_MMA(0, 1, At, B1); PG8_BAR; PG8_SCHED;
            PG8_LDA(At, 0, 1); PG8_STAGE(PG8_SB(0, 0), b2, voffB); PG8_STAGE(PG8_SB(0, 1), b2 + hstep, voffB); PG8_STAGE(PG8_SA(0, 0), a2, voffA);
            PG8_WAIT_V(8); PG8_WAIT_L(0); PG8_BAR; PG8_MMA(1, 0, At, B0); PG8_MMA(1, 1, At, B1); PG8_BAR; PG8_SCHED;
            PG8_LDB(B0, 1, 0); PG8_LDB(B1, 1, 1); PG8_SCHED; PG8_LDA(At, 1, 0); PG8_STAGE(PG8_SA(0, 1), a2 + hstep, voffA);
            PG8_WAIT_V(8); PG8_WAIT_L(0); PG8_BAR; PG8_MMA(0, 0, At, B0); PG8_MMA(0, 1, At, B1); PG8_BAR; PG8_SCHED;
            PG8_LDA(At, 1, 1); PG8_STAGE(PG8_SB(1, 0), b3, voffB); PG8_STAGE(PG8_SB(1, 1), b3 + hstep, voffB); PG8_STAGE(PG8_SA(1, 0), a3, voffA);
            PG8_WAIT_V(8); PG8_WAIT_L(0); PG8_BAR; PG8_MMA(1, 0, At, B0); PG8_MMA(1, 1, At, B1); PG8_BAR; PG8_SCHED;
            } else {
            PG8_LDB(B0, 0, 0); PG8_SCHED; PG8_LDA(At, 0, 0); PG8_STAGE(PG8_SA(1, 1), a1 + hstep, voffA);
            PG8_WAIT_L(8); PG8_BAR; PG8_WAIT_L(0); PG8_MMA(0, 0, At, B0); PG8_BAR; PG8_SCHED;
            PG8_LDB(B1, 0, 1); PG8_STAGE(PG8_SB(0, 0), b2, voffB);
            PG8_BAR; PG8_WAIT_L(0); PG8_MMA(0, 1, At, B1); PG8_BAR;
            PG8_LDA(At, 0, 1); PG8_STAGE(PG8_SA(0, 0), a2, voffA);
            PG8_BAR; PG8_WAIT_L(0); PG8_MMA(1, 0, At, B0); PG8_BAR; PG8_SCHED;
            PG8_STAGE(PG8_SB(0, 1), b2 + hstep, voffB);
            PG8_WAIT_V(6); PG8_BAR; PG8_MMA(1, 1, At, B1); PG8_BAR;
            PG8_LDB(B0, 1, 0); PG8_SCHED; PG8_LDA(At, 1, 0); PG8_STAGE(PG8_SA(0, 1), a2 + hstep, voffA);
            PG8_WAIT_L(8); PG8_BAR; PG8_WAIT_L(0); PG8_MMA(0, 0, At, B0); PG8_BAR; PG8_SCHED;
            PG8_LDB(B1, 1, 1); PG8_STAGE(PG8_SB(1, 0), b3, voffB);
            PG8_BAR; PG8_WAIT_L(0); PG8_MMA(0, 1, At, B1); PG8_BAR;
            PG8_LDA(At, 1, 1); PG8_STAGE(PG8_SA(1, 0), a3, voffA);
            PG8_BAR; PG8_WAIT_L(0); PG8_MMA(1, 0, At, B0); PG8_BAR; PG8_SCHED;
            PG8_STAGE(PG8_SB(1, 1), b3 + hstep, voffB);
            PG8_WAIT_V(6); PG8_BAR; PG8_MMA(1, 1, At, B1); PG8_BAR;
            }
        }
        if constexpr (ALIGN_EPI) { if (wr == 0) PG8_BAR; }
        if constexpr (FP8) asm volatile("s_nop 15\n\ts_nop 15" ::: "memory");
        if constexpr (!Epi::AFTER_DRAIN) { E(acc, cur, wr, wc, fr, fq); S.done(cur); }
        if (!has_next) break;
#pragma unroll
        for (int a = 0; a < 2; ++a)
#pragma unroll
            for (int b = 0; b < 2; ++b)
#pragma unroll
                for (int m = 0; m < 4; ++m)
#pragma unroll
                    for (int n = 0; n < 2; ++n) acc[a][b][m][n] = (f32x4){0.f, 0.f, 0.f, 0.f};
        cur = nxt; cA = nA; cB = nB; ++ui;
        if constexpr (ALIGN_EPI) { if (wr == 1) PG8_BAR; }
    }
    PG8_WAIT_V(0);
    if constexpr (!ALIGN_EPI) { if (wr == 0) PG8_BAR; }
    PG8_BAR;
    if constexpr (Epi::AFTER_DRAIN) { E.fused(acc, cur, wr, wc, fr, fq, lds, wid, lane); S.done(cur); }
#undef PG8_SA
#undef PG8_SB
#undef PG8_STAGE
#undef PG8_LDA
#undef PG8_LDB
#undef PG8_MMA
#undef PG8_MMA8
#undef PG8_MMA16
#undef PG8_CAT
#undef PG8_WAIT_V
#undef PG8_WAIT_L
#undef PG8_BAR
#undef PG8_SCHED
}
}
namespace pg8 {
__device__ __forceinline__ float ep_bflo(unsigned w) { return __uint_as_float(w << 16); }
__device__ __forceinline__ float ep_bfhi(unsigned w) { return __uint_as_float(w & 0xffff0000u); }
__device__ __forceinline__ float ep_sig(float x) { return __builtin_amdgcn_rcpf(1.f + __builtin_amdgcn_exp2f(-1.4426950408889634f * x)); }
__device__ __forceinline__ void ep_unpack8(u32x4 w, f32x4& a, f32x4& b) { a = (f32x4){ep_bflo(w.x), ep_bfhi(w.x), ep_bflo(w.y), ep_bfhi(w.y)}; b = (f32x4){ep_bflo(w.z), ep_bfhi(w.z), ep_bflo(w.w), ep_bfhi(w.w)}; }
__device__ __forceinline__ u32x4 ep_pack8(f32x4 a, f32x4 b) { u32x4 w; w.x = cvt_pk_bf16(a[0], a[1]); w.y = cvt_pk_bf16(a[2], a[3]); w.z = cvt_pk_bf16(b[0], b[1]); w.w = cvt_pk_bf16(b[2], b[3]); return w; }
__device__ __forceinline__ f32x4 ep_sig4(f32x4 v) { return (f32x4){ep_sig(v[0]), ep_sig(v[1]), ep_sig(v[2]), ep_sig(v[3])}; }
#define EPI_LOOP_BEGIN const int row0 = u.pm * BM + wr * 64 + fr, col0 = u.pn * BM + wc * 32 + 8 * fq; \
    _Pragma("unroll") for (int ai = 0; ai < 2; ++ai) _Pragma("unroll") for (int m = 0; m < 4; ++m) { const int row = row0 + ai * HALF + m * 16; \
    _Pragma("unroll") for (int bj = 0; bj < 2; ++bj) { const int col = col0 + bj * HALF; const f32x4 v0 = acc[ai][bj][m][0], v1 = acc[ai][bj][m][1];
#define EPI_LOOP_END } }

struct EpiLora1 {
    static constexpr bool PERM = true, AFTER_DRAIN = false;
    float* logw; bf16_t* a; const float* w0; const float* a0;
    __device__ __forceinline__ void operator()(const f32x4 (&acc)[2][2][4][2], const Unit& u, int wr, int wc, int fr, int fq) const {
        EPI_LOOP_BEGIN
            if (u.pn < 4) { const f32x4 b0 = *(const f32x4*)(w0 + col), b1 = *(const f32x4*)(w0 + col + 4);
                float* o = logw + (size_t)row * 1024 + col; *(f32x4*)o = ep_sig4(v0 + b0) * (-0.6065306597126334f); *(f32x4*)(o + 4) = ep_sig4(v1 + b1) * (-0.6065306597126334f); }
            else { const int c = col - 1024; const f32x4 b0 = *(const f32x4*)(a0 + c), b1 = *(const f32x4*)(a0 + c + 4);
                *(u32x4*)(a + (size_t)row * 1024 + c) = ep_pack8(ep_sig4(v0 + b0), ep_sig4(v1 + b1)); }
        EPI_LOOP_END
    }
};
template <int SECOND> struct EpiGateMerge {
    static constexpr bool PERM = true, AFTER_DRAIN = false;
    bf16_t* mrg; const bf16_t* P; int gcol;
    __device__ __forceinline__ void operator()(const f32x4 (&acc)[2][2][4][2], const Unit& u, int wr, int wc, int fr, int fq) const {
        EPI_LOOP_BEGIN
            f32x4 g0, g1; ep_unpack8(*(const u32x4*)(P + (size_t)row * 11776 + gcol + col), g0, g1);
            f32x4 r0 = ep_sig4(g0) * v0, r1 = ep_sig4(g1) * v1;
            bf16_t* o = mrg + (size_t)row * 2048 + col;
            if (SECOND) { f32x4 t0, t1; ep_unpack8(*(const u32x4*)o, t0, t1); r0 = r0 + t0; r1 = r1 + t1; }
            *(u32x4*)o = ep_pack8(r0, r1);
        EPI_LOOP_END
    }
};
struct EpiResid {
    static constexpr bool PERM = true, AFTER_DRAIN = false;
    const float* x; float* x1; const float* mod;
    __device__ __forceinline__ void operator()(const f32x4 (&acc)[2][2][4][2], const Unit& u, int wr, int wc, int fr, int fq) const {
        const float* gt = mod + (size_t)((u.pm * BM) / 16384) * 12288 + 4096;
        EPI_LOOP_BEGIN
            const f32x4 g0 = *(const f32x4*)(gt + col), g1 = *(const f32x4*)(gt + col + 4);
            const size_t off = (size_t)row * 2048 + col;
            *(f32x4*)(x1 + off) = *(const f32x4*)(x + off) + g0 * v0; *(f32x4*)(x1 + off + 4) = *(const f32x4*)(x + off + 4) + g1 * v1;
        EPI_LOOP_END
    }
};
struct EpiSwiglu {
    static constexpr bool PERM = true, AFTER_DRAIN = false;
    unsigned char* act; const float* bias;
    __device__ __forceinline__ void operator()(const f32x4 (&acc)[2][2][4][2], const Unit& u, int wr, int wc, int fr, int fq) const {
        const int row0 = u.pm * BM + wr * 64 + fr, gcol = u.pn * 128 + wc * 32 + 8 * fq;
        const float* bg = bias + (size_t)u.e * 4096 + gcol; const float* bl = bg + 2048;
        const f32x4 bg0 = *(const f32x4*)bg, bg1 = *(const f32x4*)(bg + 4), bl0 = *(const f32x4*)bl, bl1 = *(const f32x4*)(bl + 4);
#pragma unroll
        for (int ai = 0; ai < 2; ++ai)
#pragma unroll
            for (int m = 0; m < 4; ++m) { const int row = row0 + ai * HALF + m * 16;
                f32x4 g0 = acc[ai][0][m][0] * (1.f / 128.f) + bg0, g1 = acc[ai][0][m][1] * (1.f / 128.f) + bg1, l0 = acc[ai][1][m][0] * (1.f / 128.f) + bl0, l1 = acc[ai][1][m][1] * (1.f / 128.f) + bl1, r0, r1;
#pragma unroll
                for (int i = 0; i < 4; ++i) { const float a = fminf(g0[i], 7.f), b = fminf(g1[i], 7.f);
                    r0[i] = a * ep_sig(1.702f * a) * (fminf(fmaxf(l0[i], -7.f), 7.f) + 1.f); r1[i] = b * ep_sig(1.702f * b) * (fminf(fmaxf(l1[i], -7.f), 7.f) + 1.f); }
                r0 = r0 * 4.f; r1 = r1 * 4.f; typedef unsigned u32x2e __attribute__((ext_vector_type(2))); u32x2e o;
                { int w = __builtin_amdgcn_cvt_pk_fp8_f32(r0[0], r0[1], 0, false); w = __builtin_amdgcn_cvt_pk_fp8_f32(r0[2], r0[3], w, true); o.x = (unsigned)w; }
                { int w = __builtin_amdgcn_cvt_pk_fp8_f32(r1[0], r1[1], 0, false); w = __builtin_amdgcn_cvt_pk_fp8_f32(r1[2], r1[3], w, true); o.y = (unsigned)w; }
                *(u32x2e*)(act + (size_t)row * 2048 + gcol) = o; }
    }
};
struct EpiDown {
    static constexpr bool PERM = true, AFTER_DRAIN = false;
    bf16_t* ys; const float* bias; const float* slot_w;
    __device__ __forceinline__ void operator()(const f32x4 (&acc)[2][2][4][2], const Unit& u, int wr, int wc, int fr, int fq) const {
        const float* be = bias + (size_t)u.e * 2048;
        EPI_LOOP_BEGIN
            const float w = slot_w[row];
            const f32x4 b0 = *(const f32x4*)(be + col), b1 = *(const f32x4*)(be + col + 4);
            *(u32x4*)(ys + (size_t)row * 2048 + col) = ep_pack8((v0 * (1.f / 256.f) + b0) * w, (v1 * (1.f / 256.f) + b1) * w);
        EPI_LOOP_END
    }
};
struct MoeOrder : StaticOrder {
    const int* tile_e;
    __device__ bool next(int i, Unit& u) const { if (!StaticOrder::next(i, u)) return false; u.e = tile_e[u.pm]; return true; }
};
}
namespace fox {
enum { ORDER_NATURAL = 0, ORDER_REVERSED = 1, ORDER_PAIRED = 2, ORDER_XCD = 4 };
using TIN = __hip_bfloat16; using TOUT = __hip_bfloat16;
constexpr int B = 2, H = 8, HKV = 8, SQ = 16384, SKV = 16384, D = 128;
constexpr int PITCH = 1024;
constexpr int GPITCH = 11776;
constexpr int QOFF = 0;
constexpr int WINDOW = SKV;
constexpr float THR = 8.f;
constexpr int ORDER = ORDER_PAIRED;
constexpr bool WSKIP = false;
constexpr float SCALE = 0.08838834764831845f;
constexpr int NW = 8, QBLK = 32, KVBLK = 64, QB = NW * QBLK;
constexpr int SHM_V = KVBLK * D * 2, SHM_K = KVBLK * D * 2;
constexpr int LDS_CB = 2 * SHM_V + 2 * SHM_K + NW * 64 * 4;
constexpr int LDS_GATE = LDS_CB + 3 * 64 * 4 + 256;
constexpr int LDS_BYTES = LDS_GATE + NW * 8192;
static_assert(D == 128 && SQ % QB == 0 && SKV % KVBLK == 0 && H % HKV == 0 && QOFF >= 0 && QOFF + SQ <= SKV && WINDOW >= 1, "geometry");

using bf16 = __hip_bfloat16;
typedef short bf16x8 __attribute__((ext_vector_type(8)));
typedef short s16x4 __attribute__((ext_vector_type(4)));
typedef float f32x16 __attribute__((ext_vector_type(16)));
typedef float f32x4 __attribute__((ext_vector_type(4)));
typedef unsigned u32x4 __attribute__((ext_vector_type(4)));
template <class A, class Bt> struct same_t { static constexpr bool v = false; };
template <class A> struct same_t<A, A> { static constexpr bool v = true; };

#define KSWZ(row, colB) ((row) * 256 + ((colB) ^ (((row) & 7) << 4)))
#define SBAR() __builtin_amdgcn_sched_barrier(0)
__device__ __forceinline__ int v_st(int k, int c) { const int kk = (k & ~0xC) | ((k & 4) << 1) | ((k & 8) >> 1); return ((kk >> 3) * 4 + (c >> 5)) * 512 + ((kk & 7) * 32 + (c & 31)) * 2; }
__device__ __forceinline__ int v_rd_base(int lane) { return ((lane & 3) << 3) | (((lane >> 2) & 3) << 6) | (((lane >> 4) & 1) << 5) | (((lane >> 5) & 1) << 8); }
constexpr int v_rd_off(int d0, int ks, int half) { return d0 * 512 + ks * 4096 + half * 2048; }
__device__ __forceinline__ int crow(int r, int hi) { return (r & 3) + 8 * (r >> 2) + 4 * hi; }
__device__ __forceinline__ unsigned cvtpk(float lo, float hi) {
    unsigned r; asm volatile("v_cvt_pk_bf16_f32 %0, %1, %2" : "=v"(r) : "v"(lo), "v"(hi)); return r;
}
__device__ __forceinline__ bf16x8 pack8(f32x4 a, f32x4 b) {
    u32x4 w = {cvtpk(a[0], a[1]), cvtpk(a[2], a[3]), cvtpk(b[0], b[1]), cvtpk(b[2], b[3])};
    return *reinterpret_cast<bf16x8*>(&w);
}
template <class T> __device__ __forceinline__ bf16x8 load8(const T* p) {
    if constexpr (same_t<T, float>::v) { return pack8(*(const f32x4*)p, *(const f32x4*)(p + 4)); }
    else { return *reinterpret_cast<const bf16x8*>(p); }
}
__device__ __forceinline__ void mask_tile(f32x16& p0, f32x16& p1, int dq, unsigned W) {
    const float NEG = -__builtin_inff();
#pragma unroll
    for (int r = 0; r < 16; ++r) {
        const int c = (r & 3) + 8 * (r >> 2);
        if ((unsigned)(dq - c) >= W) p0[r] = NEG;
        if ((unsigned)(dq - c - 32) >= W) p1[r] = NEG;
    }
}
__device__ __forceinline__ void partialSM(f32x16& p0, f32x16& p1, float& m_reg, float& mn, float& alpha) {
    float pmax = p0[0]; for (int r = 1; r < 16; ++r) pmax = fmaxf(pmax, p0[r]); for (int r = 0; r < 16; ++r) pmax = fmaxf(pmax, p1[r]);
    { auto rr = __builtin_amdgcn_permlane32_swap(__float_as_uint(pmax), __float_as_uint(pmax), false, false);
      pmax = fmaxf(__uint_as_float(rr[0]), __uint_as_float(rr[1])); }
    constexpr float C2 = 1.4426950408889634f * SCALE;
    if (__builtin_expect(__all((pmax - m_reg) * SCALE <= THR), 1)) { mn = m_reg; alpha = 1.f; }
    else { mn = fmaxf(m_reg, pmax); alpha = __builtin_amdgcn_exp2f((m_reg - mn) * C2); m_reg = mn; }
    const float mnL = -mn * C2;
    for (int r = 0; r < 16; ++r) p0[r] = fmaf(p0[r], C2, mnL); for (int r = 0; r < 16; ++r) p1[r] = fmaf(p1[r], C2, mnL);
    for (int r = 0; r < 16; ++r) p0[r] = __builtin_amdgcn_exp2f(p0[r]);
}
__device__ __forceinline__ void finishSM(f32x16& p0, f32x16& p1, float alpha, float& l_reg, bf16x8& pa0, bf16x8& pa1, bf16x8& pa2, bf16x8& pa3) {
    for (int r = 0; r < 16; ++r) p1[r] = __builtin_amdgcn_exp2f(p1[r]);
    float ps = 0; for (int r = 0; r < 16; ++r) ps += p0[r]; for (int r = 0; r < 16; ++r) ps += p1[r];
    { auto rr = __builtin_amdgcn_permlane32_swap(__float_as_uint(ps), __float_as_uint(ps), false, false);
      ps = __uint_as_float(rr[0]) + __uint_as_float(rr[1]); }
    l_reg = l_reg * alpha + ps;
#define PK4(P, B_, OUT) do { unsigned a0 = cvtpk(P[B_+0], P[B_+1]), a1 = cvtpk(P[B_+2], P[B_+3]);                          \
        unsigned b0 = cvtpk(P[B_+4], P[B_+5]), b1 = cvtpk(P[B_+6], P[B_+7]);                                             \
        auto r0 = __builtin_amdgcn_permlane32_swap(a0, b0, false, false); auto r1 = __builtin_amdgcn_permlane32_swap(a1, b1, false, false); \
        u32x4 w = {r0[0], r1[0], r0[1], r1[1]}; OUT = *reinterpret_cast<bf16x8*>(&w); } while (0)
    PK4(p0, 0, pa0); PK4(p0, 8, pa1); PK4(p1, 0, pa2); PK4(p1, 8, pa3);
#undef PK4
}
template <int KB, bool SK>
__device__ __forceinline__ void qkt(f32x16& p0, f32x16& p1, const char* K_lds, int r32, int hi, const bf16x8* qr, bool act, int cbi) {
    if (SK && !act) { const float NEG = -__builtin_inff();
#pragma unroll
        for (int r = 0; r < 16; ++r) { p0[r] = NEG; p1[r] = NEG; } return; }
    { const float* cb_ = (const float*)(K_lds + 2 * SHM_K + NW * 64 * 4) + cbi * 64 + 4 * hi;
#pragma unroll
      for (int g_ = 0; g_ < 4; ++g_) { const f32x4 b0_ = *(const f32x4*)(cb_ + 8 * g_), b1_ = *(const f32x4*)(cb_ + 32 + 8 * g_);
#pragma unroll
          for (int i_ = 0; i_ < 4; ++i_) { p0[4 * g_ + i_] = b0_[i_]; p1[4 * g_ + i_] = b1_[i_]; } } }
    const char* kb[4];
#pragma unroll
    for (int dd = 0; dd < 4; ++dd) kb[dd] = K_lds + KB * SHM_K + KSWZ(r32, (dd * 16 + hi * 8) * 2);
#pragma unroll
    for (int d0 = 0; d0 < 8; ++d0) { const char* a = kb[d0 & 3] + (d0 >> 2) * 128;
        bf16x8 b0 = *reinterpret_cast<const bf16x8*>(a);
        bf16x8 b1 = *reinterpret_cast<const bf16x8*>(a + 32 * 256);
        p0 = __builtin_amdgcn_mfma_f32_32x32x16_bf16(b0, qr[d0], p0, 0, 0, 0);
        p1 = __builtin_amdgcn_mfma_f32_32x32x16_bf16(b1, qr[d0], p1, 0, 0, 0); }
}
template <int VB, bool SK>
__device__ __forceinline__ void pv_tile(f32x16* o, int vb0, bf16x8 pa0, bf16x8 pa1, bf16x8 pa2, bf16x8 pa3, bool act) {
    if (SK && !act) return;
#define TRRD(dst, off) asm volatile("ds_read_b64_tr_b16 %0, %1 offset:%2" : "=&v"(dst) : "v"(vb0), "i"(off) : "memory")
#define PV_D0(d0) do { s16x4 l0, l1, l2, l3, h0, h1, h2, h3; constexpr int b_ = VB * SHM_V + v_rd_off(d0, 0, 0);     \
        TRRD(l0, b_); TRRD(h0, b_ + 2048); TRRD(l1, b_ + 4096); TRRD(h1, b_ + 6144); TRRD(l2, b_ + 8192); TRRD(h2, b_ + 10240); TRRD(l3, b_ + 12288); TRRD(h3, b_ + 14336); \
        asm volatile("s_waitcnt lgkmcnt(0)" ::: "memory"); SBAR();                 \
        o[d0] = __builtin_amdgcn_mfma_f32_32x32x16_bf16(pa0, (bf16x8){l0[0], l0[1], l0[2], l0[3], h0[0], h0[1], h0[2], h0[3]}, o[d0], 0, 0, 0);   \
        o[d0] = __builtin_amdgcn_mfma_f32_32x32x16_bf16(pa1, (bf16x8){l1[0], l1[1], l1[2], l1[3], h1[0], h1[1], h1[2], h1[3]}, o[d0], 0, 0, 0);   \
        o[d0] = __builtin_amdgcn_mfma_f32_32x32x16_bf16(pa2, (bf16x8){l2[0], l2[1], l2[2], l2[3], h2[0], h2[1], h2[2], h2[3]}, o[d0], 0, 0, 0);   \
        o[d0] = __builtin_amdgcn_mfma_f32_32x32x16_bf16(pa3, (bf16x8){l3[0], l3[1], l3[2], l3[3], h3[0], h3[1], h3[2], h3[3]}, o[d0], 0, 0, 0); } while (0)
    PV_D0(0); PV_D0(1); PV_D0(2); PV_D0(3);
#undef PV_D0
#undef TRRD
}

template <class TIn, class TOut> struct BlockRef { const unsigned char* ws; int row0, bh, P0;
    __device__ __forceinline__ const TIn* Q() const { return (const TIn*)(ws + WS_FQ) + (size_t)row0 * PITCH + (bh % H) * D; }
    __device__ __forceinline__ const TIn* K() const { return (const TIn*)(ws + WS_FK) + (size_t)(bh / H) * SQ * PITCH + (bh % H) * D; }
    __device__ __forceinline__ const TIn* V() const { return (const TIn*)(ws + WS_FV) + (size_t)(bh / H) * SQ * PITCH + (bh % H) * D; }
    __device__ __forceinline__ TOut* O() const { return (TOut*)(ws + WS_YB) + (size_t)row0 * PITCH + (bh % H) * D; }
    __device__ __forceinline__ const float* C() const { return (const float*)(ws + WS_CS) + (size_t)bh * SQ; }
    __device__ __forceinline__ const TIn* G() const { return (const TIn*)(ws + WS_P) + (size_t)row0 * GPITCH + PC_OG + (bh % H) * D; }
};
template <class TIn> struct Seam {
    bf16x8 qr[8];
    bf16x8 st_v0, st_v1, st_k0, st_k1; int cbi; f32x4 sf0, sf1, sf2, sf3;
    f32x4 tq[16];
};
__device__ __forceinline__ int swa_jlo(int P0, int W) { const int lowk = P0 - W + 1; return lowk > 0 ? lowk / KVBLK : 0; }
#define ROW(p, k0, rr) ((p) + (size_t)((k0) + (rr)) * PITCH + sc)
#define VMW() asm volatile("s_waitcnt vmcnt(0)" ::: "memory")
#define VMWN(n) asm volatile("s_waitcnt vmcnt(%0)" :: "i"(n) : "memory")
#define NEXT3(x) ((x) == 2 ? 0 : (x) + 1)
#define SLOAD_H(Kp, Vp, Cp, k0, CI) do { S.st_v0 = load8<TIn>(ROW(Vp, k0, sr)); S.st_v1 = load8<TIn>(ROW(Vp, k0, 32 + sr));              \
                         S.st_k0 = load8<TIn>(ROW(Kp, k0, sr)); S.st_k1 = load8<TIn>(ROW(Kp, k0, 32 + sr));                 \
                         if (wid == 0) __builtin_amdgcn_global_load_lds((const unsigned*)((Cp) + (k0) + lane), (__attribute__((address_space(3))) unsigned*)(lds + LDS_CB + (CI) * 256), 4, 0, 0); } while (0)
#define SWRITE_HK(bf) do { *(bf16x8*)(K_lds + (bf) * SHM_K + kws) = S.st_k0; *(bf16x8*)(K_lds + (bf) * SHM_K + kws + 32 * 256) = S.st_k1; } while (0)
#define SWRITE_HV(bf) do { *(bf16x8*)(V_lds + (bf) * SHM_V + vst0) = S.st_v0; *(bf16x8*)(V_lds + (bf) * SHM_V + vst1) = S.st_v1; } while (0)
#define SWRITE_H(bf) do { SWRITE_HV(bf); SWRITE_HK(bf); } while (0)
#define SLOAD_F(p, k0) do { S.sf0 = *(const f32x4*)ROW(p, k0, sr); S.sf1 = *(const f32x4*)(ROW(p, k0, sr) + 4);                \
                            S.sf2 = *(const f32x4*)ROW(p, k0, 32 + sr); S.sf3 = *(const f32x4*)(ROW(p, k0, 32 + sr) + 4); } while (0)
#define SWRITE_KF(bf) do { *(bf16x8*)(K_lds + (bf) * SHM_K + kws) = pack8(S.sf0, S.sf1); *(bf16x8*)(K_lds + (bf) * SHM_K + kws + 32 * 256) = pack8(S.sf2, S.sf3); } while (0)
#define SWRITE_VF(bf) do { *(bf16x8*)(V_lds + (bf) * SHM_V + vst0) = pack8(S.sf0, S.sf1); *(bf16x8*)(V_lds + (bf) * SHM_V + vst1) = pack8(S.sf2, S.sf3); } while (0)
template <class TIn, class TOut>
__device__ __forceinline__ void causal_swa_prime(const BlockRef<TIn, TOut>& cur, int W, char* lds, Seam<TIn>& S, const int tid) {
    constexpr bool F32 = same_t<TIn, float>::v;
    const int wid = __builtin_amdgcn_readfirstlane(tid >> 6), lane = tid & 63, r32 = lane & 31, hi = lane >> 5;
    const int sr = tid >> 4, sc = (tid & 15) * 8, kws = KSWZ(sr, sc * 2); char* K_lds = lds + 2 * SHM_V;
    const int kb0 = swa_jlo(cur.P0, W) * KVBLK;
    for (int d0 = 0; d0 < 8; ++d0) S.qr[d0] = load8<TIn>(cur.Q() + (size_t)(wid * QBLK + r32) * PITCH + d0 * 16 + hi * 8);
    if constexpr (F32) { SLOAD_F((const float*)cur.K(), kb0); VMW(); SWRITE_KF(0); SBAR(); SLOAD_F((const float*)cur.V(), kb0); }
    else { S.cbi = 0; SLOAD_H(cur.K(), cur.V(), cur.C(), kb0, 0); VMW(); SWRITE_HK(0); }
    __syncthreads();
}
template <class TIn, class TOut>
__device__ __forceinline__ void causal_swa_block(const BlockRef<TIn, TOut>& cur, const BlockRef<TIn, TOut>& nxt, int skv, int W, char* lds, Seam<TIn>& S, const int tid) {
    constexpr bool F32 = same_t<TIn, float>::v;
    const int wid = __builtin_amdgcn_readfirstlane(tid >> 6), lane = tid & 63, r32 = lane & 31, hi = lane >> 5;
    const int j_lo = swa_jlo(cur.P0, W);
    int j_hi = (cur.P0 + QB - 1) / KVBLK + 1; if (j_hi > skv / KVBLK) j_hi = skv / KVBLK;
    const int NT = j_hi - j_lo;
    const int kbn = swa_jlo(nxt.P0, W) * KVBLK;
    const int qlo = cur.P0 + wid * QBLK, qm = qlo + r32 - 4 * hi;
    char* V_lds = lds; char* K_lds = lds + 2 * SHM_V;
    float* ws = (float*)(lds + 2 * SHM_V + 2 * SHM_K) + wid * 64; float* li_l = ws, * al_l = ws + 32;
    float m_reg = -1e30f, l_reg = 0; f32x16 o[4] = {};
    const int sr = tid >> 4, sc = (tid & 15) * 8, vst0 = v_st(sr, sc), vst1 = v_st(32 + sr, sc), kws = KSWZ(sr, sc * 2);
    const int vb0 = (int)(uintptr_t)V_lds + v_rd_base(lane);
    const TIn* Kh = cur.K(); const TIn* Vh = cur.V(); const float* Ch = cur.C(); int cb_t = S.cbi;
    {
        const TIn* gsrc = cur.G() + (size_t)(wid * QBLK + (lane >> 4)) * GPITCH + (lane & 15) * 8;
#pragma unroll
        for (int i_ = 0; i_ < 8; ++i_) __builtin_amdgcn_global_load_lds((const unsigned*)(gsrc + (size_t)(4 * i_) * GPITCH), (__attribute__((address_space(3))) unsigned*)(lds + LDS_GATE + wid * 8192 + i_ * 1024), 16, 0, 0); }
#define RESC(a) do { if (__any((a) < 1.f)) { if (hi == 0) al_l[r32] = (a); asm volatile("s_waitcnt lgkmcnt(0)" ::: "memory");              \
                     for (int d_ = 0; d_ < 4; ++d_) for (int r = 0; r < 16; ++r) o[d_][r] *= al_l[crow(r, hi)]; } } while (0)
#define KBASE(t) ((j_lo + (t)) * KVBLK)
#define ACT(t) (KBASE(t) <= qlo + QBLK - 1 && KBASE(t) + KVBLK - 1 >= qlo - W + 1)
#define MASKT(P0_, P1_, t) do { const int kb_ = KBASE(t); if ((!SK || ACT(t)) && (kb_ + KVBLK - 1 > qlo || kb_ <= qlo + QBLK - 1 - W)) mask_tile(P0_, P1_, qm - kb_, (unsigned)W); } while (0)
    constexpr int NQL = F32 ? 16 : 8;
    constexpr bool SK = WSKIP && !F32;
#define SEAM_K0() do { VMWN(NQL); if constexpr (F32) { SWRITE_KF(0); SBAR(); SLOAD_F((const float*)nxt.V(), kbn); } else { SWRITE_HK(0); } SBAR(); } while (0)
    f32x16 pA0, pA1, pB0, pB1; float mnA, mnB, alA, alB; bf16x8 pa0, pa1, pa2, pa3;
    if constexpr (F32) { VMW(); SWRITE_VF(0); SBAR(); } else { SWRITE_HV(0); SBAR(); }
    if (NT > 1) { if constexpr (F32) SLOAD_F((const float*)Kh, KBASE(1)); else SLOAD_H(Kh, Vh, Ch, KBASE(1), NEXT3(cb_t)); }
    SBAR(); qkt<0, SK>(pA0, pA1, K_lds, r32, hi, S.qr, ACT(0), cb_t);
    if constexpr (F32) { if (NT > 1) { VMW(); SWRITE_KF(1); SBAR(); SLOAD_F((const float*)Vh, KBASE(1)); } }
    MASKT(pA0, pA1, 0); partialSM(pA0, pA1, m_reg, mnA, alA);
    if (NT > 1) { VMW(); if constexpr (F32) { SWRITE_VF(1); SBAR(); if (NT > 2) SLOAD_F((const float*)Kh, KBASE(2)); } else SWRITE_H(1); }
    __syncthreads();
#define HALF_STEP(PX0, PX1, mnX, alX, PY0, PY1, alY, t, KB, VB, SB) do {                                                      \
        SBAR(); cb_t = NEXT3(cb_t); qkt<KB, SK>(PX0, PX1, K_lds, r32, hi, S.qr, ACT(t), cb_t);                                             \
        finishSM(PY0, PY1, alY, l_reg, pa0, pa1, pa2, pa3); SBAR();                                                           \
        if ((t) + 1 < NT) { if constexpr (F32) { VMW(); SWRITE_KF(SB); SBAR(); SLOAD_F((const float*)Vh, KBASE((t) + 1)); }  \
                            else { SLOAD_H(Kh, Vh, Ch, KBASE((t) + 1), NEXT3(cb_t)); } SBAR(); }                                               \
        pv_tile<VB, SK>(o, vb0, pa0, pa1, pa2, pa3, ACT((t) - 1)); MASKT(PX0, PX1, (t)); partialSM(PX0, PX1, m_reg, mnX, alX);                                        \
        __syncthreads();                                                                                                      \
        if ((t) + 1 < NT) { VMW(); if constexpr (F32) { SWRITE_VF(SB); SBAR(); if ((t) + 2 < NT) SLOAD_F((const float*)Kh, KBASE((t) + 2)); } \
                            else { SWRITE_H(SB); } }                                                                          \
        RESC(alX); __syncthreads(); } while (0)
    for (int t = 1; t + 1 < NT; t += 2) {
        HALF_STEP(pB0, pB1, mnB, alB, pA0, pA1, alA, t, 1, 0, 0);
        HALF_STEP(pA0, pA1, mnA, alA, pB0, pB1, alB, t + 1, 0, 1, 1);
    }
    const bool even = (NT & 1) == 0;
    if (even) { SBAR(); cb_t = NEXT3(cb_t); qkt<1, SK>(pB0, pB1, K_lds, r32, hi, S.qr, ACT(NT - 1), cb_t); SBAR(); }
#define QROW(e) (nxt.Q() + (size_t)(wid * QBLK + r32) * PITCH + ((e) >> 1) * 16 + hi * 8 + ((e) & 1) * 4)
    if constexpr (F32) { SLOAD_F((const float*)nxt.K(), kbn); SBAR();
#pragma unroll
        for (int e = 0; e < 8; ++e) S.tq[e] = *(const f32x4*)QROW(e); }
    else { SLOAD_H(nxt.K(), nxt.V(), nxt.C(), kbn, NEXT3(cb_t)); S.cbi = NEXT3(cb_t); SBAR();
#pragma unroll
        for (int d0 = 0; d0 < 8; ++d0) S.qr[d0] = load8<TIn>(nxt.Q() + (size_t)(wid * QBLK + r32) * PITCH + d0 * 16 + hi * 8); }
    SBAR();
    finishSM(pA0, pA1, alA, l_reg, pa0, pa1, pa2, pa3); SBAR();
    if constexpr (F32) {
#pragma unroll
        for (int e = 8; e < 16; ++e) S.tq[e] = *(const f32x4*)QROW(e); SBAR(); }
#undef QROW
    pv_tile<0, SK>(o, vb0, pa0, pa1, pa2, pa3, ACT(even ? NT - 2 : NT - 1));
    if (even) { MASKT(pB0, pB1, NT - 1); partialSM(pB0, pB1, m_reg, mnB, alB); __syncthreads(); RESC(alB);
        finishSM(pB0, pB1, alB, l_reg, pa0, pa1, pa2, pa3); SBAR(); pv_tile<1, SK>(o, vb0, pa0, pa1, pa2, pa3, ACT(NT - 1)); }
    SBAR(); SEAM_K0();
    if (hi == 0) li_l[r32] = l_reg; asm volatile("s_waitcnt lgkmcnt(0)" ::: "memory");
    float rli[16];
#pragma unroll
    for (int r = 0; r < 16; ++r) rli[r] = __builtin_amdgcn_rcpf(li_l[crow(r, hi)]);
    int hi_e = hi; asm volatile("" : "+v"(hi_e));
    TOut* Ow = cur.O() + (size_t)(wid * QBLK) * PITCH + (size_t)(4 * hi_e) * PITCH; const char* gl_ = lds + LDS_GATE + wid * 8192 + 4 * hi_e * 256;
#pragma unroll
    for (int r = 0; r < 16; ++r) { const int orow = (r & 3) + 8 * (r >> 2);
#pragma unroll
        for (int d0 = 0; d0 < 4; ++d0) { const float v = o[d0][r] * rli[r];
            if constexpr (same_t<TOut, float>::v) { Ow[(size_t)orow * PITCH + d0 * 32 + r32] = v; }
            else { const float vn = __shfl_xor(v, 1);
                   if ((r32 & 1) == 0) { const unsigned gw_ = *(const unsigned*)(gl_ + orow * 256 + (d0 * 32 + r32) * 2);
                       const float g0_ = __uint_as_float(gw_ << 16), g1_ = __uint_as_float(gw_ & 0xffff0000u);
                       const float s0_ = __builtin_amdgcn_rcpf(1.f + __builtin_amdgcn_exp2f(-1.4426950408889634f * g0_)), s1_ = __builtin_amdgcn_rcpf(1.f + __builtin_amdgcn_exp2f(-1.4426950408889634f * g1_));
                       *(unsigned*)(Ow + (size_t)orow * PITCH + d0 * 32 + r32) = cvtpk(v * s0_, vn * s1_); } } } }
    if constexpr (F32) {
#pragma unroll
        for (int d0 = 0; d0 < 8; ++d0) S.qr[d0] = pack8(S.tq[2 * d0], S.tq[2 * d0 + 1]); }
    __syncthreads();
#undef RESC
#undef KBASE
#undef ACT
#undef MASKT
#undef SEAM_K0
#undef HALF_STEP
}
#undef ROW
#undef VMW
#undef VMWN
#undef SLOAD_H
#undef SWRITE_HK
#undef SWRITE_HV
#undef SWRITE_H
#undef SLOAD_F
#undef SWRITE_KF
#undef SWRITE_VF

}
#ifndef RW_SOLVE_OLD
#define RW_SOLVE_OLD 0
#endif
namespace rw {
typedef short bf16x8 __attribute__((ext_vector_type(8)));
typedef float f32x4 __attribute__((ext_vector_type(4)));
typedef unsigned u32x4 __attribute__((ext_vector_type(4)));
typedef unsigned u32x2 __attribute__((ext_vector_type(2)));
#define RW_LAS __attribute__((address_space(3)))
constexpr int PB = 144, PF = 272, MB = 64 * PB;
constexpr int O_R = 0, O_K = MB, O_A = 2 * MB, O_B = 3 * MB, O_BT = 4 * MB, O_KT = 5 * MB, O_VT = 6 * MB, O_AAK = 7 * MB, O_ARB = 8 * MB, O_ARK = 9 * MB;
constexpr int O_AAB = 10 * MB, O_GT = O_AAB + 64 * PF, O_GAM = O_GT + 64 * PF, O_TOT = O_GAM + 256, O_END = O_TOT + 2048;
constexpr int O_AABB = O_END, O_TB = O_AABB + MB, O_END2 = O_TB + 4 * 768;
constexpr int O_WT = O_K, O_UT = O_AAK;
static_assert(O_END2 <= 143360, "phase A LDS map");
constexpr int REC = 32768, REC_P = 0, REC_Q = 8192, REC_H = 16384, REC_Y = 24576;
typedef float f32x2_t __attribute__((ext_vector_type(2))); typedef __bf16 bf16x2_t __attribute__((ext_vector_type(2)));
__device__ __forceinline__ unsigned cvtpk(float lo, float hi) { f32x2_t v = {lo, hi}; bf16x2_t b = __builtin_convertvector(v, bf16x2_t); return __builtin_bit_cast(unsigned, b); }
__device__ __forceinline__ float blo(unsigned w) { return __uint_as_float(w << 16); }
__device__ __forceinline__ float bhi(unsigned w) { return __uint_as_float(w & 0xffff0000u); }
__device__ __forceinline__ bf16x8 frag(const RW_LAS unsigned char* base, int tile, int ks, int lane) { return *(const RW_LAS bf16x8*)(base + (16 * tile + (lane & 15)) * PB + (ks * 32 + 8 * (lane >> 4)) * 2); }
#define RW_MFMA(a, b, c) __builtin_amdgcn_mfma_f32_16x16x32_bf16(a, b, c, 0, 0, 0)
#define RW_SYNC() __syncthreads()
#define RW_BAR() do { asm volatile("" ::: "memory"); __builtin_amdgcn_s_barrier(); asm volatile("" ::: "memory"); } while (0)

struct ChunkIn { u32x4 r, k, v, a; f32x4 l0, l1; };
__device__ __forceinline__ void load_chunk(ChunkIn& c, const unsigned char* ws, int it, int tid) {
    const int bh = it >> 8, ch = it & 255, b = bh >> 4, h = bh & 15, tok = tid >> 3, part = tid & 7;
    const size_t off = ((size_t)b * SEQ + (size_t)ch * 64 + tok) * 1024 + h * 64 + 8 * part;
    c.r = *(const u32x4*)((const unsigned short*)(ws + WS_R) + off); c.k = *(const u32x4*)((const unsigned short*)(ws + WS_K) + off); c.v = *(const u32x4*)((const unsigned short*)(ws + WS_V) + off);
    c.a = *(const u32x4*)((const unsigned short*)(ws + WS_A) + off); c.l0 = *(const f32x4*)((const float*)(ws + WS_LOGW) + off); c.l1 = *(const f32x4*)((const float*)(ws + WS_LOGW) + off + 4);
}
__device__ __forceinline__ void phase_a(RW_LAS unsigned char* L, unsigned char* ws, const float* kk_all, const float* ka_all, int wg, int G, int tid) {
    const int lane = tid & 63, w = __builtin_amdgcn_readfirstlane(tid >> 6), g = lane >> 4, l15 = lane & 15;
    ChunkIn cin; if (wg < 8192) load_chunk(cin, ws, wg, tid);
  for (int it = wg; it < 8192; it += G) {
    unsigned char* rec = ws + WS_REC + (size_t)it * REC; const float* kkw_g = kk_all + ((it >> 8) & 15) * 64; const float* kaw_g = ka_all + ((it >> 8) & 15) * 64;
    { const int tok = tid >> 3, part = tid & 7, c0 = 8 * part;
      const u32x4 rw_ = cin.r, kw_ = cin.k, vw_ = cin.v, aw_ = cin.a; const f32x4 l0 = cin.l0, l1 = cin.l1;
      float lw[8] = {l0[0], l0[1], l0[2], l0[3], l1[0], l1[1], l1[2], l1[3]}, cum[8];
#pragma unroll
      for (int i = 0; i < 8; ++i) { float v = lw[i];
          float u = __shfl_up(v, 8); if (lane >= 8) v += u; u = __shfl_up(v, 16); if (lane >= 16) v += u; u = __shfl_up(v, 32); if (lane >= 32) v += u; cum[i] = v; }
      RW_LAS float* tot = (RW_LAS float*)(L + O_TOT);
      if (lane >= 56) {
#pragma unroll
          for (int i = 0; i < 8; ++i) tot[w * 64 + c0 + i] = cum[i]; }
      RW_SYNC();
#pragma unroll
      for (int ww = 0; ww < 7; ++ww) if (ww < w) { const f32x4 a0 = *(const RW_LAS f32x4*)(tot + ww * 64 + c0), a1 = *(const RW_LAS f32x4*)(tot + ww * 64 + c0 + 4);
#pragma unroll
          for (int i = 0; i < 4; ++i) { cum[i] += a0[i]; cum[4 + i] += a1[i]; } }
      float r[8] = {blo(rw_.x), bhi(rw_.x), blo(rw_.y), bhi(rw_.y), blo(rw_.z), bhi(rw_.z), blo(rw_.w), bhi(rw_.w)};
      float k[8] = {blo(kw_.x), bhi(kw_.x), blo(kw_.y), bhi(kw_.y), blo(kw_.z), bhi(kw_.z), blo(kw_.w), bhi(kw_.w)};
      float a[8] = {blo(aw_.x), bhi(aw_.x), blo(aw_.y), bhi(aw_.y), blo(aw_.z), bhi(aw_.z), blo(aw_.w), bhi(aw_.w)};
      const f32x4 kk0 = *(const f32x4*)(kkw_g + c0), kk1 = *(const f32x4*)(kkw_g + c0 + 4), ka0 = *(const f32x4*)(kaw_g + c0), ka1 = *(const f32x4*)(kaw_g + c0 + 4);
      float kk[8], ss = 0.f;
#pragma unroll
      for (int i = 0; i < 8; ++i) { kk[i] = k[i] * (i < 4 ? kk0[i] : kk1[i - 4]); ss += kk[i] * kk[i]; }
      ss += __shfl_xor(ss, 1); ss += __shfl_xor(ss, 2); ss += __shfl_xor(ss, 4);
      const float inv = 1.f / fmaxf(sqrtf(ss), 1e-12f);
      float Rt[8], Kt[8], At[8], Bt[8];
#pragma unroll
      for (int i = 0; i < 8; ++i) { const float eL = __expf(cum[i]), eLi = __expf(-cum[i]), eLx = __expf(cum[i] - lw[i]); const float kn = kk[i] * inv;
          Rt[i] = r[i] * eL; Kt[i] = k[i] * (1.f + (a[i] - 1.f) * (i < 4 ? ka0[i] : ka1[i - 4])) * eLi; At[i] = -kn * eLx; Bt[i] = kn * a[i] * eLi;
          if (tok == 63) ((RW_LAS float*)(L + O_GAM))[c0 + i] = eL; }
      u32x4 o;
      o.x = cvtpk(Rt[0], Rt[1]); o.y = cvtpk(Rt[2], Rt[3]); o.z = cvtpk(Rt[4], Rt[5]); o.w = cvtpk(Rt[6], Rt[7]); *(RW_LAS u32x4*)(L + O_R + tok * PB + c0 * 2) = o;
      o.x = cvtpk(Kt[0], Kt[1]); o.y = cvtpk(Kt[2], Kt[3]); o.z = cvtpk(Kt[4], Kt[5]); o.w = cvtpk(Kt[6], Kt[7]); *(RW_LAS u32x4*)(L + O_K + tok * PB + c0 * 2) = o;
      const u32x4 kq = o;
      o.x = cvtpk(At[0], At[1]); o.y = cvtpk(At[2], At[3]); o.z = cvtpk(At[4], At[5]); o.w = cvtpk(At[6], At[7]); *(RW_LAS u32x4*)(L + O_A + tok * PB + c0 * 2) = o;
      o.x = cvtpk(Bt[0], Bt[1]); o.y = cvtpk(Bt[2], Bt[3]); o.z = cvtpk(Bt[4], Bt[5]); o.w = cvtpk(Bt[6], Bt[7]); *(RW_LAS u32x4*)(L + O_B + tok * PB + c0 * 2) = o;
      const unsigned bq[4] = {o.x, o.y, o.z, o.w}, kq4[4] = {kq.x, kq.y, kq.z, kq.w}, vq[4] = {vw_.x, vw_.y, vw_.z, vw_.w};
#pragma unroll
      for (int i = 0; i < 8; ++i) { const int sh = (i & 1) * 16;
          *(RW_LAS unsigned short*)(L + O_BT + (c0 + i) * PB + tok * 2) = (unsigned short)(bq[i >> 1] >> sh);
          *(RW_LAS unsigned short*)(L + O_KT + (c0 + i) * PB + tok * 2) = (unsigned short)(kq4[i >> 1] >> sh);
          *(RW_LAS unsigned short*)(L + O_VT + (c0 + i) * PB + tok * 2) = (unsigned short)(vq[i >> 1] >> sh); }
    }
    if (it + G < 8192) load_chunk(cin, ws, it + G, tid);
    RW_SYNC();
    const int t4 = w & 3, p2 = (w >> 2) * 2;
    { const bf16x8 b0 = frag(L + O_B, t4, 0, lane), b1 = frag(L + O_B, t4, 1, lane), k0 = frag(L + O_K, t4, 0, lane), k1 = frag(L + O_K, t4, 1, lane);
#pragma unroll
      for (int u = 0; u < 2; ++u) { const int nt = p2 + u, t = 16 * nt + l15, s0 = 16 * t4 + 4 * g;
          f32x4 ab = {0.f, 0.f, 0.f, 0.f}, ak = ab, rb = ab, rk = ab;
          if (t4 <= nt) { const bf16x8 a0 = frag(L + O_A, nt, 0, lane), a1 = frag(L + O_A, nt, 1, lane), r0 = frag(L + O_R, nt, 0, lane), r1 = frag(L + O_R, nt, 1, lane);
              ab = RW_MFMA(b0, a0, ab); ab = RW_MFMA(b1, a1, ab); ak = RW_MFMA(k0, a0, ak); ak = RW_MFMA(k1, a1, ak);
              rb = RW_MFMA(b0, r0, rb); rb = RW_MFMA(b1, r1, rb); rk = RW_MFMA(k0, r0, rk); rk = RW_MFMA(k1, r1, rk);
#pragma unroll
              for (int r = 0; r < 4; ++r) { const int s = s0 + r; if (!(s < t)) { ab[r] = 0.f; ak[r] = 0.f; } if (!(s <= t)) { rb[r] = 0.f; rk[r] = 0.f; } } }
          *(RW_LAS f32x4*)(L + O_AAB + t * PF + s0 * 4) = ab;
          u32x2 o; o.x = cvtpk(ab[0], ab[1]); o.y = cvtpk(ab[2], ab[3]); *(RW_LAS u32x2*)(L + O_AABB + t * PB + s0 * 2) = o;
          o.x = cvtpk(ak[0], ak[1]); o.y = cvtpk(ak[2], ak[3]); *(RW_LAS u32x2*)(L + O_AAK + t * PB + s0 * 2) = o;
          o.x = cvtpk(rb[0], rb[1]); o.y = cvtpk(rb[2], rb[3]); *(RW_LAS u32x2*)(L + O_ARB + t * PB + s0 * 2) = o;
          o.x = cvtpk(rk[0], rk[1]); o.y = cvtpk(rk[2], rk[3]); *(RW_LAS u32x2*)(L + O_ARK + t * PB + s0 * 2) = o; } }
    RW_SYNC();
    { const bf16x8 a0 = frag(L + O_AAK, t4, 0, lane), a1 = frag(L + O_AAK, t4, 1, lane);
#pragma unroll
      for (int u = 0; u < 2; ++u) { const int nt = p2 + u; f32x4 acc = {0.f, 0.f, 0.f, 0.f};
          acc = RW_MFMA(a0, frag(L + O_VT, nt, 0, lane), acc); acc = RW_MFMA(a1, frag(L + O_VT, nt, 1, lane), acc);
          *(RW_LAS f32x4*)(L + O_GT + (16 * nt + l15) * PF + (16 * t4 + 4 * g) * 4) = acc; } }
    if (w < 4 && lane < 16) {
        float x[16]; const RW_LAS unsigned char* ab = L + O_AAB + 16 * w * PF + 16 * w * 4;
#pragma unroll
        for (int r = 0; r < 16; ++r) { float a0 = (r == lane) ? 1.f : 0.f, a1 = 0.f;
#pragma unroll
            for (int q4 = 0; q4 < (r + 3) / 4; ++q4) { const f32x4 av = *(const RW_LAS f32x4*)(ab + r * PF + q4 * 16);
                if (4 * q4 + 0 < r) a0 += av[0] * x[4 * q4 + 0]; if (4 * q4 + 1 < r) a1 += av[1] * x[4 * q4 + 1]; if (4 * q4 + 2 < r) a0 += av[2] * x[4 * q4 + 2]; if (4 * q4 + 3 < r) a1 += av[3] * x[4 * q4 + 3]; }
            x[r] = a0 + a1; *(RW_LAS unsigned short*)(L + O_TB + w * 768 + r * 48 + lane * 2) = (unsigned short)(cvtpk(x[r], 0.f) & 0xffffu); } }
    RW_SYNC();
#if RW_SOLVE_OLD
    if (tid < 128) { const int c = tid;
        const RW_LAS unsigned char* rhs = c < 64 ? (L + O_A + c * 2) : (L + O_GT + (c - 64) * PF);
        RW_LAS unsigned char* dst = c < 64 ? (L + O_WT + c * PB) : (L + O_UT + (c - 64) * PB);
        for (int b = 0; b < 4; ++b) { float z[16];
#pragma unroll
            for (int r = 0; r < 16; ++r) z[r] = c < 64 ? blo((unsigned)*(const RW_LAS unsigned short*)(rhs + (16 * b + r) * PB)) : *(const RW_LAS float*)(rhs + (16 * b + r) * 4);
            const RW_LAS unsigned char* arow = L + O_AAB + 16 * b * PF;
            for (int s4 = 0; s4 < 4 * b; ++s4) { const u32x2 xw = *(const RW_LAS u32x2*)(dst + s4 * 8); const float x0 = blo(xw.x), x1 = bhi(xw.x), x2 = blo(xw.y), x3 = bhi(xw.y);
#pragma unroll
                for (int r = 0; r < 16; ++r) { const f32x4 av = *(const RW_LAS f32x4*)(arow + r * PF + s4 * 16); z[r] += (av[0] * x0 + av[1] * x1) + (av[2] * x2 + av[3] * x3); } }
#pragma unroll
            for (int r = 1; r < 16; ++r) {
#pragma unroll
                for (int q4 = 0; q4 < (r + 3) / 4; ++q4) { const f32x4 av = *(const RW_LAS f32x4*)(arow + r * PF + (4 * b + q4) * 16);
                    if (4 * q4 + 0 < r) z[r] += av[0] * z[4 * q4 + 0]; if (4 * q4 + 1 < r) z[r] += av[1] * z[4 * q4 + 1]; if (4 * q4 + 2 < r) z[r] += av[2] * z[4 * q4 + 2]; if (4 * q4 + 3 < r) z[r] += av[3] * z[4 * q4 + 3]; } }
            u32x4 o; o.x = cvtpk(z[0], z[1]); o.y = cvtpk(z[2], z[3]); o.z = cvtpk(z[4], z[5]); o.w = cvtpk(z[6], z[7]); *(RW_LAS u32x4*)(dst + 32 * b) = o;
            o.x = cvtpk(z[8], z[9]); o.y = cvtpk(z[10], z[11]); o.z = cvtpk(z[12], z[13]); o.w = cvtpk(z[14], z[15]); *(RW_LAS u32x4*)(dst + 32 * b + 16) = o;
            asm volatile("s_waitcnt lgkmcnt(0)" ::: "memory"); } }
    RW_SYNC();
#else
    { RW_LAS unsigned char* xt = (w < 4 ? L + O_WT : L + O_UT) + (w & 3) * 16 * PB;
      { const u32x4 z4 = {0u, 0u, 0u, 0u}; *(RW_LAS u32x4*)(xt + l15 * PB + g * 16) = z4; *(RW_LAS u32x4*)(xt + l15 * PB + 64 + g * 16) = z4; }
      asm volatile("s_waitcnt lgkmcnt(0)" ::: "memory");
#pragma unroll
      for (int b = 0; b < 4; ++b) { f32x4 z;
          if (w < 4) { const RW_LAS unsigned char* ap = L + O_A + (16 * b + 4 * g) * PB + (16 * w + l15) * 2;
              z = (f32x4){blo((unsigned)*(const RW_LAS unsigned short*)(ap)), blo((unsigned)*(const RW_LAS unsigned short*)(ap + PB)), blo((unsigned)*(const RW_LAS unsigned short*)(ap + 2 * PB)), blo((unsigned)*(const RW_LAS unsigned short*)(ap + 3 * PB))}; }
          else z = *(const RW_LAS f32x4*)(L + O_GT + (16 * (w - 4) + l15) * PF + (16 * b + 4 * g) * 4);
          if (b > 0) { z = RW_MFMA(frag(L + O_AABB, b, 0, lane), *(const RW_LAS bf16x8*)(xt + l15 * PB + (8 * g) * 2), z);
                       if (b > 2) z = RW_MFMA(frag(L + O_AABB, b, 1, lane), *(const RW_LAS bf16x8*)(xt + l15 * PB + (32 + 8 * g) * 2), z); }
          const u32x2 tw = *(const RW_LAS u32x2*)(L + O_TB + b * 768 + l15 * 48 + (4 * g) * 2);
          const u32x4 tf = {tw.x, tw.y, 0u, 0u}, zf = {cvtpk(z[0], z[1]), cvtpk(z[2], z[3]), 0u, 0u};
          f32x4 xb = {0.f, 0.f, 0.f, 0.f}; xb = RW_MFMA(__builtin_bit_cast(bf16x8, tf), __builtin_bit_cast(bf16x8, zf), xb);
          u32x2 o; o.x = cvtpk(xb[0], xb[1]); o.y = cvtpk(xb[2], xb[3]); *(RW_LAS u32x2*)(xt + l15 * PB + (16 * b + 4 * g) * 2) = o;
          asm volatile("s_waitcnt lgkmcnt(0)" ::: "memory"); } }
    RW_SYNC();
#endif
    {
      const bf16x8 rb0 = frag(L + O_ARB, t4, 0, lane), rb1 = frag(L + O_ARB, t4, 1, lane), bt0 = frag(L + O_BT, t4, 0, lane), bt1 = frag(L + O_BT, t4, 1, lane);
      const int col = 16 * t4 + l15; const float gam = ((const RW_LAS float*)(L + O_GAM))[col];
      unsigned qw[4], pw[4];
#pragma unroll
      for (int u = 0; u < 2; ++u) { const int mt = p2 + u, j0 = 16 * mt + 4 * g; const bf16x8 w0 = frag(L + O_WT, mt, 0, lane), w1 = frag(L + O_WT, mt, 1, lane);
          f32x4 q = {0.f, 0.f, 0.f, 0.f}, p = q; q = RW_MFMA(w0, rb0, q); q = RW_MFMA(w1, rb1, q); p = RW_MFMA(w0, bt0, p); p = RW_MFMA(w1, bt1, p);
          const u32x2 rr = *(const RW_LAS u32x2*)(L + O_R + col * PB + j0 * 2);
          q[0] += blo(rr.x); q[1] += bhi(rr.x); q[2] += blo(rr.y); q[3] += bhi(rr.y);
#pragma unroll
          for (int r = 0; r < 4; ++r) p[r] = (p[r] + ((j0 + r) == col ? 1.f : 0.f)) * gam;
          qw[2 * u] = cvtpk(q[0], q[1]); qw[2 * u + 1] = cvtpk(q[2], q[3]); pw[2 * u] = cvtpk(p[0], p[1]); pw[2 * u + 1] = cvtpk(p[2], p[3]); }
      const int fo = ((t4 * 2 + (p2 >> 1)) * 64 + lane) * 16;
      *(u32x4*)(rec + REC_Q + fo) = (u32x4){qw[0], qw[1], qw[2], qw[3]}; *(u32x4*)(rec + REC_P + fo) = (u32x4){pw[0], pw[1], pw[2], pw[3]}; }
    {
      const bf16x8 rb0 = frag(L + O_ARB, t4, 0, lane), rb1 = frag(L + O_ARB, t4, 1, lane), rk0 = frag(L + O_ARK, t4, 0, lane), rk1 = frag(L + O_ARK, t4, 1, lane);
      const bf16x8 ut0 = frag(L + O_UT, t4, 0, lane), ut1 = frag(L + O_UT, t4, 1, lane), vt0 = frag(L + O_VT, t4, 0, lane), vt1 = frag(L + O_VT, t4, 1, lane);
      const int col = 16 * t4 + l15;
#pragma unroll
      for (int u = 0; u < 2; ++u) { const int mt = p2 + u, m0 = 16 * mt + 4 * g;
          f32x4 y = {0.f, 0.f, 0.f, 0.f}, hm = y;
          y = RW_MFMA(frag(L + O_UT, mt, 0, lane), rb0, y); y = RW_MFMA(frag(L + O_UT, mt, 1, lane), rb1, y); y = RW_MFMA(frag(L + O_VT, mt, 0, lane), rk0, y); y = RW_MFMA(frag(L + O_VT, mt, 1, lane), rk1, y);
          hm = RW_MFMA(frag(L + O_BT, mt, 0, lane), ut0, hm); hm = RW_MFMA(frag(L + O_BT, mt, 1, lane), ut1, hm); hm = RW_MFMA(frag(L + O_KT, mt, 0, lane), vt0, hm); hm = RW_MFMA(frag(L + O_KT, mt, 1, lane), vt1, hm);
          const f32x4 gm = *(const RW_LAS f32x4*)(L + O_GAM + m0 * 4);
          u32x2 o; o.x = cvtpk(y[0], y[1]); o.y = cvtpk(y[2], y[3]); *(u32x2*)(rec + REC_Y + (col * 64 + m0) * 2) = o;
          o.x = cvtpk(hm[0] * gm[0], hm[1] * gm[1]); o.y = cvtpk(hm[2] * gm[2], hm[3] * gm[3]); *(u32x2*)(rec + REC_H + (col * 64 + m0) * 2) = o; } }
    RW_SYNC();
  }
}

__device__ __forceinline__ void phase_b_head(RW_LAS unsigned char* L, const unsigned char* recs, float* Yg, int tid) {
    constexpr int NCH = 256, NSLOT = 4;
    const int lane = tid & 63, w = __builtin_amdgcn_readfirstlane(tid >> 6), g = lane >> 4, l15 = lane & 15;
    if (w >= 4) {
        const int lw = w - 4; const unsigned char* src = recs + lw * 8192 + lane * 16;
#define RW_ISSUE(c_) do { _Pragma("unroll") for (int k_ = 0; k_ < 8; ++k_) __builtin_amdgcn_global_load_lds((const unsigned*)(src + (size_t)(c_) * REC + k_ * 1024), (RW_LAS unsigned*)(L + ((c_) & 3) * REC + lw * 8192 + k_ * 1024), 16, 0, 0); } while (0)
        RW_ISSUE(0); RW_ISSUE(1); RW_ISSUE(2);
        asm volatile("s_waitcnt vmcnt(16)" ::: "memory");
        RW_BAR();
        for (int c = 0; c < NCH; ++c) {
            if (c + 3 < NCH) { RW_ISSUE(c + 3); asm volatile("s_waitcnt vmcnt(16)" ::: "memory"); }
            else asm volatile("s_waitcnt vmcnt(0)" ::: "memory");
            RW_BAR();
        }
#undef RW_ISSUE
    } else {
        f32x4 sacc[4];
#pragma unroll
        for (int m = 0; m < 4; ++m) sacc[m] = (f32x4){0.f, 0.f, 0.f, 0.f};
        RW_BAR();
        for (int c = 0; c < NCH; ++c) { const RW_LAS unsigned char* sl = L + (c & 3) * REC;
            bf16x8 bf[2];
#pragma unroll
            for (int s = 0; s < 2; ++s) { u32x4 v; v.x = cvtpk(sacc[2 * s][0], sacc[2 * s][1]); v.y = cvtpk(sacc[2 * s][2], sacc[2 * s][3]); v.z = cvtpk(sacc[2 * s + 1][0], sacc[2 * s + 1][1]); v.w = cvtpk(sacc[2 * s + 1][2], sacc[2 * s + 1][3]); bf[s] = __builtin_bit_cast(bf16x8, v); }
            f32x4 sn[4];
#pragma unroll
            for (int m = 0; m < 4; ++m) { const u32x2 hw = *(const RW_LAS u32x2*)(sl + REC_H + ((16 * w + l15) * 64 + 16 * m + 4 * g) * 2);
                f32x4 acc = {blo(hw.x), bhi(hw.x), blo(hw.y), bhi(hw.y)};
                acc = RW_MFMA(*(const RW_LAS bf16x8*)(sl + REC_P + ((m * 2 + 0) * 64 + lane) * 16), bf[0], acc);
                acc = RW_MFMA(*(const RW_LAS bf16x8*)(sl + REC_P + ((m * 2 + 1) * 64 + lane) * 16), bf[1], acc); sn[m] = acc; }
#pragma unroll
            for (int n = 0; n < 4; ++n) { const u32x2 yw = *(const RW_LAS u32x2*)(sl + REC_Y + ((16 * n + l15) * 64 + 16 * w + 4 * g) * 2);
                f32x4 acc = {blo(yw.x), bhi(yw.x), blo(yw.y), bhi(yw.y)};
                acc = RW_MFMA(bf[0], *(const RW_LAS bf16x8*)(sl + REC_Q + ((n * 2 + 0) * 64 + lane) * 16), acc);
                acc = RW_MFMA(bf[1], *(const RW_LAS bf16x8*)(sl + REC_Q + ((n * 2 + 1) * 64 + lane) * 16), acc);
                *(f32x4*)(Yg + (size_t)(c * 64 + 16 * n + l15) * 1024 + 16 * w + 4 * g) = acc; }
#pragma unroll
            for (int m = 0; m < 4; ++m) sacc[m] = sn[m];
            asm volatile("s_waitcnt lgkmcnt(0)" ::: "memory");
            RW_BAR();
        }
    }
}
}
#define XB_TMO      128
#define XB_XCNT(j)  (256  + 64 * (j))
#define XB_XSUB(j)  (1280 + 64 * (j))
#define XB_XGEN(j)  (2304 + 64 * (j))
#define XB_TOP      3328
#define XB_TOPGEN   3392
#define XCD_BAR_WORDS 3456
#define XB_SPIN_CAP (1u << 18)

__device__ __forceinline__ unsigned xb_ld(unsigned* p)              { return __hip_atomic_load(p, __ATOMIC_RELAXED, __HIP_MEMORY_SCOPE_AGENT); }
__device__ __forceinline__ unsigned xb_add(unsigned* p, unsigned v) { return __hip_atomic_fetch_add(p, v, __ATOMIC_RELAXED, __HIP_MEMORY_SCOPE_AGENT); }
__device__ __forceinline__ unsigned xb_xcc_id() { return (unsigned)__builtin_amdgcn_s_getreg((3 << 11) | 20) & 0xFu; }
#define XB_SPIN(cond, bar) do { unsigned _sp = 0; while (cond) { __builtin_amdgcn_s_sleep(1); \
    if ((++_sp & 255u) == 0u) { if (xb_ld(&(bar)[XB_TMO])) break; if (_sp > XB_SPIN_CAP) { atomicAdd(&(bar)[XB_TMO], 1u); break; } } } } while (0)

struct XcdBarrier {
    unsigned* bar; unsigned x;
    volatile LAS unsigned* st;
};

__device__ __forceinline__ XcdBarrier xcd_barrier_post(unsigned* bar, volatile LAS unsigned* st, const int tid) {
    XcdBarrier b; b.bar = bar; b.x = xb_xcc_id(); b.st = st;
    if (tid == 0) (void)xb_add(&bar[XB_XCNT(b.x)], 1u);
    return b;
}
__device__ __forceinline__ void xcd_barrier_complete(unsigned* bar, unsigned x, unsigned& nloc, unsigned& nx) {
    const unsigned G = gridDim.x * gridDim.y * gridDim.z;
    unsigned sum, cnt, mine, sp = 0u;
    for (;;) {
        sum = 0u; cnt = 0u; mine = 0u;
#pragma unroll
        for (unsigned j = 0; j < 16; ++j) { const unsigned c = xb_ld(&bar[XB_XCNT(j)]); sum += c; cnt += (c > 0u) ? 1u : 0u; mine = (j == x) ? c : mine; }
        if (sum == G) break;
        __builtin_amdgcn_s_sleep(1);
        if ((++sp & 255u) == 0u) { if (xb_ld(&bar[XB_TMO])) break; if (sp > XB_SPIN_CAP) { atomicAdd(&bar[XB_TMO], 1u); break; } }
    }
    nloc = mine > 0u ? mine : 1u; nx = cnt > 0u ? cnt : 1u;
}

__device__ __forceinline__ void xcd_barrier(const XcdBarrier& b, const int tid) {
    asm volatile("s_waitcnt vmcnt(0)" ::: "memory");
    __syncthreads();
    if (tid == 0) {
        unsigned* bar = b.bar;
        __builtin_amdgcn_s_waitcnt(0);
        unsigned nloc = b.st[0], nx = b.st[1];
        if (nloc == 0u) { xcd_barrier_complete(bar, b.x, nloc, nx); b.st[0] = nloc; b.st[1] = nx; }
        const unsigned old = xb_add(&bar[XB_XSUB(b.x)], 1u);
        const unsigned gen = old / nloc;
        if (old + 1u == (gen + 1u) * nloc) {
            __builtin_amdgcn_fence(__ATOMIC_RELEASE, "agent");
            asm volatile("s_waitcnt vmcnt(0)" ::: "memory");
            const unsigned og = xb_add(&bar[XB_TOP], 1u);
            const unsigned tg = og / nx;
            if (og + 1u == (tg + 1u) * nx) xb_add(&bar[XB_TOPGEN], 1u);
            else XB_SPIN(xb_ld(&bar[XB_TOPGEN]) == tg, bar);
            __builtin_amdgcn_fence(__ATOMIC_ACQUIRE, "agent");
            xb_add(&bar[XB_XGEN(b.x)], 1u);
            asm volatile("s_waitcnt vmcnt(0)" ::: "memory");
        } else {
            XB_SPIN(xb_ld(&bar[XB_XGEN(b.x)]) == gen, bar);
            __builtin_amdgcn_fence(__ATOMIC_ACQUIRE, "agent");
            asm volatile("s_waitcnt vmcnt(0)" ::: "memory");
        }
    }
    __syncthreads();
}
enum InIdx { I_X = 0, I_C, I_WADA, I_BADA, I_N1G, I_WIN, I_MU, I_WDEC, I_W0, I_WICLR, I_A0, I_WGATE, I_KK, I_KA, I_RK, I_GNG, I_GNB, I_WOA, I_BF, I_QN, I_KN, I_WOB, I_WOUT, I_N2G, I_WR, I_BR, I_WGU, I_BGU, I_WDN, I_BDN, I_NFG, N_IN };
struct Args { const float* in[N_IN]; float* out; unsigned char* ws; int ph_lo, ph_hi; };
static_assert(sizeof(Args) == (N_IN + 2) * 8 + 8, "Args has no padding");
typedef const __attribute__((address_space(4))) Args* ArgsP;
struct Frame {
    LAS unsigned char* lds;
    volatile LAS unsigned* MISC;
    gu32* ctl;
    int tid, lane, wave, G, wg;
    unsigned char* ws;
    ArgsP ap;
};
#define WSP(T_, off) ((T_*)(F.ws + (off)))

__device__ __forceinline__ int win_orig_col(int c) {
    if (c < PC_FQ) return c;
    if (c < PC_OG) return 3520 + (c - PC_FQ);
    if (c < PC_GA) return 6600 + (c - PC_OG);
    if (c < PC_GLO) return 7624 + (c - PC_GA);
    if (c < PC_DLO) return 3264 + (c - PC_GLO);
    if (c < PC_ALO) return 3072 + (c - PC_DLO);
    if (c < PC_F) return 3168 + (c - PC_ALO);
    if (c < PC_END) return 6592 + (c - PC_F);
    return -1;
}
__device__ __forceinline__ void tr_item(const float* W, int ldw, int K, bf16* WT, int drow0, int scol0, int nvalid, int k0, LAS float* scr, int lane) {
    const int n = lane & 31;
#pragma unroll 8
    for (int i = 0; i < 32; ++i) { const int kk = 2 * i + (lane >> 5); scr[kk * 33 + n] = (n < nvalid) ? W[(size_t)(k0 + kk) * ldw + scol0 + n] : 0.f; }
    LDS_WAIT(); asm volatile("" ::: "memory");
    const int c = lane & 7;
#pragma unroll
    for (int j = 0; j < 4; ++j) { const int nn = (lane >> 3) + 8 * j; const LAS float* s = scr + (8 * c) * 33 + nn;
        v4u o; o.x = pk2(s[0 * 33], s[1 * 33]); o.y = pk2(s[2 * 33], s[3 * 33]); o.z = pk2(s[4 * 33], s[5 * 33]); o.w = pk2(s[6 * 33], s[7 * 33]);
        *(GAS v4u*)(WT + (size_t)(drow0 + nn) * K + k0 + 8 * c) = o; }
    LDS_WAIT(); asm volatile("" ::: "memory");
}
__device__ __forceinline__ unsigned pk4_fp8(float a, float b, float c, float d) { int w = __builtin_amdgcn_cvt_pk_fp8_f32(a, b, 0, false); w = __builtin_amdgcn_cvt_pk_fp8_f32(c, d, w, true); return (unsigned)w; }
__device__ __forceinline__ void tr_item8(const float* W, int ldw, int K, unsigned char* WT, int drow0, int scol0, int k0, float scale, LAS float* scr, int lane) {
    const int n = lane & 31;
#pragma unroll 8
    for (int i = 0; i < 32; ++i) { const int kk = 2 * i + (lane >> 5); scr[kk * 33 + n] = W[(size_t)(k0 + kk) * ldw + scol0 + n] * scale; }
    LDS_WAIT(); asm volatile("" ::: "memory");
    const int c = lane & 7;
#pragma unroll
    for (int j = 0; j < 4; ++j) { const int nn = (lane >> 3) + 8 * j; const LAS float* s = scr + (8 * c) * 33 + nn;
        v2u o; o.x = pk4_fp8(s[0 * 33], s[1 * 33], s[2 * 33], s[3 * 33]); o.y = pk4_fp8(s[4 * 33], s[5 * 33], s[6 * 33], s[7 * 33]);
        *(GAS v2u*)(WT + (size_t)(drow0 + nn) * K + k0 + 8 * c) = o; }
    LDS_WAIT(); asm volatile("" ::: "memory");
}
__device__ __forceinline__ void p0_prologue(Frame& F) {
    LAS float* scr = (LAS float*)(F.lds + RING_OFF + F.wave * 16384);
    const int gw = F.wg * NWAVES + F.wave, NGW = F.G * NWAVES, lane = F.lane;
    constexpr int I_IN = 32 * 368, I_OA = 16 * 64, I_OB = I_OA, I_OUT = 32 * 64, I_GU = NE * 32 * 128, I_DN = NE * 32 * 64;
    constexpr int NITEMS = I_IN + I_OA + I_OB + I_OUT + I_GU + I_DN;
    for (int it = gw; it < NITEMS; it += NGW) {
        int r = it;
        if (r < I_IN) { const int kb = r / 368, gp = r % 368, c0 = gp * 32, oc = win_orig_col(c0); int nv = 32; if (oc < 0) nv = 0; else if (c0 + 32 > PC_END) nv = PC_END - c0;
            tr_item(F.ap->in[I_WIN], 11720, 2048, WSP(bf16, WS_WIN), c0, oc < 0 ? 0 : oc, nv, kb * 64, scr, lane); continue; } r -= I_IN;
        if (r < I_OA) { tr_item(F.ap->in[I_WOA], 2048, 1024, WSP(bf16, WS_WOA), (r % 64) * 32, (r % 64) * 32, 32, (r / 64) * 64, scr, lane); continue; } r -= I_OA;
        if (r < I_OB) { tr_item(F.ap->in[I_WOB], 2048, 1024, WSP(bf16, WS_WOB), (r % 64) * 32, (r % 64) * 32, 32, (r / 64) * 64, scr, lane); continue; } r -= I_OB;
        if (r < I_OUT) { tr_item(F.ap->in[I_WOUT], 2048, 2048, WSP(bf16, WS_WOUT), (r % 64) * 32, (r % 64) * 32, 32, (r / 64) * 64, scr, lane); continue; } r -= I_OUT;
        if (r < I_GU) { const int e = r / (32 * 128), q = r % (32 * 128), kb = q / 128, gp = q % 128, d0 = gp * 32;
            const int pn = d0 >> 8, j = d0 & 255, sc = j < 128 ? 128 * pn + j : 2048 + 128 * pn + (j - 128);
            tr_item8(F.ap->in[I_WGU] + (size_t)e * 2048 * 4096, 4096, 2048, WSP(unsigned char, WS_WGU) + (size_t)e * 4096 * 2048, d0, sc, kb * 64, FP8_SW, scr, lane); continue; } r -= I_GU;
        { const int e = r / (32 * 64), q = r % (32 * 64), kb = q / 64, gp = q % 64;
            tr_item8(F.ap->in[I_WDN] + (size_t)e * 2048 * 2048, 2048, 2048, WSP(unsigned char, WS_WDN) + (size_t)e * 2048 * 2048, gp * 32, gp * 32, kb * 64, FP8_SW, scr, lane); }
    }
    const int gt = F.wg * (NWAVES * 64) + F.tid, NGT = F.G * NWAVES * 64;
    { bf16* b1 = WSP(bf16, WS_BT1); const float* wd = F.ap->in[I_WDEC]; const float* wi = F.ap->in[I_WICLR];
      for (int i = gt; i < 2048 * 256; i += NGT) { const int n = i >> 8, k = i & 255; float v = 0.f;
          if (n < 1024) { if (k < 96) v = wd[k * 1024 + n]; } else { if (k >= 128 && k < 224) v = wi[(k - 128) * 1024 + (n - 1024)]; }
          b1[i] = (bf16)f2bf(v); } }
    { bf16* b2 = WSP(bf16, WS_BT2); const float* wg = F.ap->in[I_WGATE];
      for (int i = gt; i < 1024 * 256; i += NGT) { const int n = i >> 8, k = i & 255; b2[i] = (bf16)f2bf(wg[k * 1024 + n]); } }
    { float* wrt = WSP(float, WS_WRT); const float* wr = F.ap->in[I_WR];
      for (int i = gt; i < 32 * 2048; i += NGT) { const int e = i >> 11, k = i & 2047; wrt[i] = wr[k * 32 + e]; } }
    { bf16* h = WSP(bf16, WS_H) + (size_t)T * DM; for (int i = gt; i < DM; i += NGT) h[i] = 0; }
    if (F.wg < 192) {
        const float* wa = F.ap->in[I_WADA]; const float* cc = F.ap->in[I_C]; const int n = F.wg * 64 + lane;
        float s0 = 0.f, s1 = 0.f;
        for (int k = F.wave * 256; k < F.wave * 256 + 256; ++k) { const float w = wa[(size_t)k * 12288 + n]; const float c0 = cc[k], c1 = cc[2048 + k];
            s0 += c0 * sigmoidf_(c0) * w; s1 += c1 * sigmoidf_(c1) * w; }
        LAS float* red = (LAS float*)(F.lds + RING_OFF + 131072 - 4096);
        __syncthreads();
        red[(F.wave * 2 + 0) * 64 + lane] = s0; red[(F.wave * 2 + 1) * 64 + lane] = s1;
        __syncthreads();
        if (F.wave < 2) { float s = 0.f;
#pragma unroll
            for (int w = 0; w < 8; ++w) s += red[(w * 2 + F.wave) * 64 + lane];
            WSP(float, WS_MOD)[F.wave * 12288 + n] = s + F.ap->in[I_BADA][n]; }
    }
}
__device__ __forceinline__ void norm_mod_rows(Frame& F, const float* x, const float* g, int shift_off, int scale_off, bf16* H) {
    const int gw = F.wg * NWAVES + F.wave, NGW = F.G * NWAVES, lane = F.lane; const float* mod = WSP(float, WS_MOD);
    for (int m = gw; m < T; m += NGW) {
        const f32x4* xr = (const f32x4*)(x + (size_t)m * DM) + lane; f32x4 v[8]; float ss = 0.f;
#pragma unroll
        for (int j = 0; j < 8; ++j) { v[j] = xr[64 * j]; ss += (v[j].x * v[j].x + v[j].y * v[j].y) + (v[j].z * v[j].z + v[j].w * v[j].w); }
        const float rs = rsqrtf(wave_sum(ss) * (1.f / DM) + NORM_EPS); const float* mb = mod + (size_t)(m / SEQ) * 12288;
#pragma unroll
        for (int j = 0; j < 8; ++j) { const int c = 4 * lane + 256 * j; const f32x4 gg = *(const f32x4*)(g + c), sc = *(const f32x4*)(mb + scale_off + c), sh = *(const f32x4*)(mb + shift_off + c);
            const f32x4 y = v[j] * rs * gg * (sc + 1.f) + sh; v2u o; o.x = pk2(y.x, y.y); o.y = pk2(y.z, y.w); *(v2u*)(H + (size_t)m * DM + c) = o; }
    }
}
__device__ __forceinline__ void p3_prep(Frame& F) {
    const int gw = F.wg * NWAVES + F.wave, NGW = F.G * NWAVES, lane = F.lane;
    const bf16* P = WSP(bf16, WS_P); const float* mu = F.ap->in[I_MU];
    bf16* Rb = WSP(bf16, WS_R); bf16* LW = WSP(bf16, WS_LW); bf16* SG = WSP(bf16, WS_SG);
    for (int t = gw; t < T; t += NGW) {
        const bf16* pc = P + (size_t)t * NP; const bool first = (t % SEQ) == 0; const bf16* pp = first ? pc : pc - NP;
#pragma unroll
        for (int s = 0; s < 6; ++s) { const int c = (s * 64 + lane) * 8; float a[8], b[8], o[8]; unpack8(*(const v4u*)(pc + c), a); unpack8(*(const v4u*)(pp + c), b);
            const f32x4 m0 = *(const f32x4*)(mu + c), m1 = *(const f32x4*)(mu + c + 4);
#pragma unroll
            for (int i = 0; i < 8; ++i) { const float pv = first ? 0.f : b[i]; const float mm = i < 4 ? m0[i] : m1[i - 4]; o[i] = a[i] + mm * (pv - a[i]); }
            *(v4u*)(Rb + (size_t)(c >> 10) * ((WS_K - WS_R) / 2) + (size_t)t * RW + (c & 1023)) = pack8f(o); }
        { int c, mi; if (lane < 32) { c = PC_GLO + 8 * lane; mi = 3264 + 8 * lane; } else if (lane < 44) { c = PC_DLO + 8 * (lane - 32); mi = 3072 + 8 * (lane - 32); } else { c = PC_ALO + 8 * (lane - 44); mi = 3168 + 8 * (lane - 44); }
          float o[8] = {0.f, 0.f, 0.f, 0.f, 0.f, 0.f, 0.f, 0.f};
          if (lane < 56) { float a[8], b[8]; unpack8(*(const v4u*)(pc + c), a); unpack8(*(const v4u*)(pp + c), b);
              const f32x4 m0 = *(const f32x4*)(mu + mi), m1 = *(const f32x4*)(mu + mi + 4);
#pragma unroll
              for (int i = 0; i < 8; ++i) { const float pv = first ? 0.f : b[i]; const float mm = i < 4 ? m0[i] : m1[i - 4]; const float v = a[i] + mm * (pv - a[i]);
                  o[i] = lane < 32 ? sigmoidf_(v) : (lane < 44 ? tanhf(v) : v); } }
          bf16* dst; if (lane < 32) dst = SG + (size_t)t * 256 + 8 * lane; else if (lane < 44) dst = LW + (size_t)t * 256 + 8 * (lane - 32); else if (lane < 56) dst = LW + (size_t)t * 256 + 128 + 8 * (lane - 44);
          else if (lane < 60) dst = LW + (size_t)t * 256 + 96 + 8 * (lane - 56); else dst = LW + (size_t)t * 256 + 224 + 8 * (lane - 60);
          *(v4u*)dst = pack8f(o); }
#pragma unroll
        for (int s = 0; s < 2; ++s) { const int ch = s * 64 + lane, d0 = (ch & 15) * 8;
#pragma unroll
            for (int qk = 0; qk < 2; ++qk) { float a[8]; unpack8(*(const v4u*)(pc + (qk ? PC_FK : PC_FQ) + ch * 8), a); float ss = 0.f;
#pragma unroll
                for (int i = 0; i < 8; ++i) ss += a[i] * a[i];
                ss += __shfl_xor(ss, 1); ss += __shfl_xor(ss, 2); ss += __shfl_xor(ss, 4); ss += __shfl_xor(ss, 8);
                const float rs = rsqrtf(ss * (1.f / 128.f) + NORM_EPS); const float* gn = F.ap->in[qk ? I_KN : I_QN] + d0;
                const f32x4 g0 = *(const f32x4*)gn, g1 = *(const f32x4*)(gn + 4);
#pragma unroll
                for (int i = 0; i < 8; ++i) a[i] = a[i] * rs * (i < 4 ? g0[i] : g1[i - 4]);
                *(v4u*)(WSP(bf16, qk ? WS_FK : WS_FQ) + (size_t)t * FW + ch * 8) = pack8f(a); }
            *(v4u*)(WSP(bf16, WS_FV) + (size_t)t * FW + ch * 8) = *(const v4u*)(pc + PC_FV + ch * 8); }
        if (lane < 8) { const float xv = bflo((unsigned)pc[PC_F + lane]) + F.ap->in[I_BF][lane];
            WSP(float, WS_LF)[(size_t)t * 8 + lane] = fminf(xv, 0.f) - log1pf(__expf(-fabsf(xv))); }
    }
}
__device__ __forceinline__ void p4_cumsum(Frame& F) {
    if (F.wg >= 16) return;
    const int b = F.wg >> 3, h = F.wg & 7; const float* lf = WSP(float, WS_LF) + (size_t)b * SEQ * 8 + h; float* cs = WSP(float, WS_CS) + (size_t)F.wg * SEQ;
    LAS float* part = (LAS float*)(F.lds + RING_OFF);
    const int t0 = F.tid * 32; float s = 0.f;
    for (int i = 0; i < 32; ++i) s += lf[(size_t)(t0 + i) * 8];
    part[F.tid] = s; __syncthreads();
    if (F.tid == 0) { float run = 0.f; for (int i = 0; i < 512; ++i) { const float v = part[i]; part[i] = run; run += v; } }
    __syncthreads();
    float run = part[F.tid];
    for (int i = 0; i < 32; ++i) { run += lf[(size_t)(t0 + i) * 8]; cs[t0 + i] = -run * 11.313708498984761f; }
    __syncthreads();
}
__device__ __forceinline__ void p5_scan_naive(Frame& F) {
    constexpr int CH = 64;
    LAS float* Wl = (LAS float*)(F.lds + RING_OFF); LAS float* Al = Wl + CH * 64; LAS float* Bl = Al + CH * 64; LAS float* Kl = Bl + CH * 64; LAS float* Rl = Kl + CH * 64; LAS float* Vl = Rl + CH * 64; LAS float* Yl = Vl + CH * 64;
    const int tid = F.tid, row = tid >> 3, q = tid & 7;
    for (int bh = F.wg; bh < 32; bh += F.G) {
        const int b = bh >> 4, h = bh & 15; const size_t base = (size_t)b * SEQ * RW + h * 64;
        const bf16* Rg = WSP(bf16, WS_R) + base; const bf16* Kg = WSP(bf16, WS_K) + base; const bf16* Vg = WSP(bf16, WS_V) + base; const bf16* Ag = WSP(bf16, WS_A) + base;
        const float* Lg = WSP(float, WS_LOGW) + base; float* Yg = WSP(float, WS_YRAW) + base;
        float kkw[8], kaw[8];
#pragma unroll
        for (int i = 0; i < 8; ++i) { kkw[i] = F.ap->in[I_KK][h * 64 + 8 * q + i]; kaw[i] = F.ap->in[I_KA][h * 64 + 8 * q + i]; }
        float S[8] = {0.f, 0.f, 0.f, 0.f, 0.f, 0.f, 0.f, 0.f};
        for (int t0 = 0; t0 < SEQ; t0 += CH) {
            { const size_t off = (size_t)(t0 + row) * RW + 8 * q; float r[8], k[8], v[8], a[8];
              unpack8(*(const v4u*)(Rg + off), r); unpack8(*(const v4u*)(Kg + off), k); unpack8(*(const v4u*)(Vg + off), v); unpack8(*(const v4u*)(Ag + off), a);
              const f32x4 l0 = *(const f32x4*)(Lg + off), l1 = *(const f32x4*)(Lg + off + 4);
              float kk[8], ss = 0.f;
#pragma unroll
              for (int i = 0; i < 8; ++i) { kk[i] = k[i] * kkw[i]; ss += kk[i] * kk[i]; }
              ss += __shfl_xor(ss, 1); ss += __shfl_xor(ss, 2); ss += __shfl_xor(ss, 4);
              const float inv = 1.f / fmaxf(sqrtf(ss), 1e-12f);
#pragma unroll
              for (int i = 0; i < 8; ++i) { const int o = row * 64 + 8 * q + i; kk[i] *= inv;
                  Wl[o] = __expf(i < 4 ? l0[i] : l1[i - 4]); Al[o] = -kk[i]; Bl[o] = kk[i] * a[i]; Kl[o] = k[i] * (1.f + (a[i] - 1.f) * kaw[i]); Rl[o] = r[i]; Vl[o] = v[i]; } }
            __syncthreads();
            for (int t = 0; t < CH; ++t) { const int o = t * 64 + 8 * q; float sa = 0.f;
                const f32x4 a0 = *(const LAS f32x4*)(Al + o), a1 = *(const LAS f32x4*)(Al + o + 4), w0 = *(const LAS f32x4*)(Wl + o), w1 = *(const LAS f32x4*)(Wl + o + 4);
                const f32x4 b0 = *(const LAS f32x4*)(Bl + o), b1 = *(const LAS f32x4*)(Bl + o + 4), k0 = *(const LAS f32x4*)(Kl + o), k1 = *(const LAS f32x4*)(Kl + o + 4);
                const f32x4 r0 = *(const LAS f32x4*)(Rl + o), r1 = *(const LAS f32x4*)(Rl + o + 4); const float vv = Vl[t * 64 + row];
#pragma unroll
                for (int i = 0; i < 8; ++i) sa += S[i] * (i < 4 ? a0[i] : a1[i - 4]);
                sa += __shfl_xor(sa, 1); sa += __shfl_xor(sa, 2); sa += __shfl_xor(sa, 4);
                float y = 0.f;
#pragma unroll
                for (int i = 0; i < 8; ++i) { S[i] = S[i] * (i < 4 ? w0[i] : w1[i - 4]) + sa * (i < 4 ? b0[i] : b1[i - 4]) + vv * (i < 4 ? k0[i] : k1[i - 4]); y += S[i] * (i < 4 ? r0[i] : r1[i - 4]); }
                y += __shfl_xor(y, 1); y += __shfl_xor(y, 2); y += __shfl_xor(y, 4);
                if (q == 0) Yl[t * 64 + row] = y; }
            __syncthreads();
            { const int tt = tid >> 3, c = (tid & 7) * 8; *(f32x4*)(Yg + (size_t)(t0 + tt) * RW + c) = *(const LAS f32x4*)(Yl + tt * 64 + c); *(f32x4*)(Yg + (size_t)(t0 + tt) * RW + c + 4) = *(const LAS f32x4*)(Yl + tt * 64 + c + 4); }
        }
        __syncthreads();
    }
}
__device__ __forceinline__ void p7_post(Frame& F) {
    const int gw = F.wg * NWAVES + F.wave, NGW = F.G * NWAVES, lane = F.lane, c0 = 16 * lane;
    for (int t = gw; t < T; t += NGW) { const size_t off = (size_t)t * RW + c0;
        float y[16], r[16], k[16], v[16], a[16], g[16];
#pragma unroll
        for (int j = 0; j < 4; ++j) { const f32x4 yy = *(const f32x4*)(WSP(float, WS_YRAW) + off + 4 * j); y[4 * j] = yy.x; y[4 * j + 1] = yy.y; y[4 * j + 2] = yy.z; y[4 * j + 3] = yy.w; }
#pragma unroll
        for (int j = 0; j < 2; ++j) { float tmp[8];
            unpack8(*(const v4u*)(WSP(bf16, WS_R) + off + 8 * j), tmp); for (int i = 0; i < 8; ++i) r[8 * j + i] = tmp[i];
            unpack8(*(const v4u*)(WSP(bf16, WS_K) + off + 8 * j), tmp); for (int i = 0; i < 8; ++i) k[8 * j + i] = tmp[i];
            unpack8(*(const v4u*)(WSP(bf16, WS_V) + off + 8 * j), tmp); for (int i = 0; i < 8; ++i) v[8 * j + i] = tmp[i];
            unpack8(*(const v4u*)(WSP(bf16, WS_A) + off + 8 * j), tmp); for (int i = 0; i < 8; ++i) a[8 * j + i] = tmp[i];
            unpack8(*(const v4u*)(WSP(bf16, WS_G) + off + 8 * j), tmp); for (int i = 0; i < 8; ++i) g[8 * j + i] = tmp[i]; }
        float s = 0.f, bs = 0.f;
#pragma unroll
        for (int i = 0; i < 16; ++i) { s += y[i]; const float kp = k[i] * (1.f + (a[i] - 1.f) * F.ap->in[I_KA][c0 + i]); bs += r[i] * kp * F.ap->in[I_RK][c0 + i]; }
        s += __shfl_xor(s, 1); s += __shfl_xor(s, 2); bs += __shfl_xor(bs, 1); bs += __shfl_xor(bs, 2);
        const float mean = s * (1.f / 64.f); float q = 0.f;
#pragma unroll
        for (int i = 0; i < 16; ++i) { const float d = y[i] - mean; q += d * d; }
        q += __shfl_xor(q, 1); q += __shfl_xor(q, 2);
        const float rstd = rsqrtf(q * (1.f / 64.f) + GN_EPS); float o[16];
#pragma unroll
        for (int i = 0; i < 16; ++i) o[i] = ((y[i] - mean) * rstd * F.ap->in[I_GNG][c0 + i] + F.ap->in[I_GNB][c0 + i] + bs * v[i]) * g[i];
#pragma unroll
        for (int j = 0; j < 2; ++j) { v4u w; w.x = pk2(o[8 * j], o[8 * j + 1]); w.y = pk2(o[8 * j + 2], o[8 * j + 3]); w.z = pk2(o[8 * j + 4], o[8 * j + 5]); w.w = pk2(o[8 * j + 6], o[8 * j + 7]); *(v4u*)(WSP(bf16, WS_YA) + off + 8 * j) = w; }
    }
}
__device__ __forceinline__ fox::BlockRef<fox::bf16, fox::bf16> fox_ref(int L_, const unsigned char* ws) {
    const int bh = L_ & 15, qb = 63 - (L_ >> 4);
    fox::BlockRef<fox::bf16, fox::bf16> r; r.ws = ws; r.row0 = (bh / fox::H) * fox::SQ + qb * fox::QB; r.bh = bh; r.P0 = qb * fox::QB; return r;
}
__device__ __forceinline__ int att_fetch(Frame& F) {
    if (F.tid == 0) F.MISC[4] = __hip_atomic_fetch_add(F.ctl + CW_ATTQ, 1u, RLX_AGENT);
    __syncthreads(); const int v = (int)F.MISC[4]; __syncthreads(); return v;
}
__device__ __forceinline__ void p6_attention(Frame& F, char* lds) {
    constexpr int TOTAL = (fox::SQ / fox::QB) * fox::B * fox::H;
    int L = att_fetch(F); if (L >= TOTAL) return;
    fox::BlockRef<fox::bf16, fox::bf16> cur = fox_ref(L, F.ws);
    fox::Seam<fox::bf16> S;
    fox::causal_swa_prime<fox::bf16, fox::bf16>(cur, fox::WINDOW, lds, S, F.tid);
    for (;;) {
        const int Ln = att_fetch(F); const bool last = Ln >= TOTAL;
        const fox::BlockRef<fox::bf16, fox::bf16> nxt = last ? cur : fox_ref(Ln, F.ws);
        fox::causal_swa_block<fox::bf16, fox::bf16>(cur, nxt, fox::SKV, fox::WINDOW, lds, S, F.tid);
        if (last) break;
        cur = nxt;
    }
}
typedef float f32x4m __attribute__((ext_vector_type(4)));
__device__ __forceinline__ void p11_router(Frame& F) {
    constexpr int TPW = T / 256 / NWAVES;
    const int lane = F.lane, t0 = (F.wg * NWAVES + F.wave) * TPW;
    const float* x1 = WSP(float, WS_X1); const float* mod = WSP(float, WS_MOD) + (size_t)(t0 / SEQ) * 12288; const float* g2 = F.ap->in[I_N2G]; bf16* H = WSP(bf16, WS_H);
    LAS float* lg = (LAS float*)(F.lds + RING_OFF + F.wave * 4096);
    LAS int* cnt = (LAS int*)(F.lds + RING_OFF + 65536);
    if (F.tid < 32) cnt[F.tid] = 0;
    __syncthreads();
    for (int i = 0; i < TPW; ++i) { const int m = t0 + i;
        const f32x4* xr = (const f32x4*)(x1 + (size_t)m * DM) + lane; f32x4 v[8]; float ss = 0.f;
#pragma unroll
        for (int j = 0; j < 8; ++j) { v[j] = xr[64 * j]; ss += (v[j].x * v[j].x + v[j].y * v[j].y) + (v[j].z * v[j].z + v[j].w * v[j].w); }
        const float rs = rsqrtf(wave_sum(ss) * (1.f / DM) + NORM_EPS);
        if (lane == 0) lg[512 + i] = rs;
#pragma unroll
        for (int j = 0; j < 8; ++j) { const int c = 4 * lane + 256 * j; const f32x4 gg = *(const f32x4*)(g2 + c), sc = *(const f32x4*)(mod + 4 * 2048 + c), sh = *(const f32x4*)(mod + 3 * 2048 + c);
            const f32x4 y = v[j] * rs * gg * (sc + 1.f) + sh; v2u o; o.x = pk2(y.x, y.y); o.y = pk2(y.z, y.w); *(v2u*)(H + (size_t)m * DM + c) = o; }
    }
    LDS_WAIT();
    { const int i = lane & 15, q = lane >> 4; const float rs = lg[512 + i]; const float* xr = x1 + (size_t)(t0 + i) * DM + 4 * q; const float* wr = WSP(float, WS_WRT) + (size_t)i * DM + 4 * q;
      f32x4m acc0 = {0.f, 0.f, 0.f, 0.f}, acc1 = {0.f, 0.f, 0.f, 0.f};
#pragma unroll 4
      for (int Sx = 0; Sx < DM / 16; ++Sx) { const int k = 16 * Sx;
          const f32x4 xv = *(const f32x4*)(xr + k), gg = *(const f32x4*)(g2 + k + 4 * q), sc = *(const f32x4*)(mod + 4 * 2048 + k + 4 * q), sh = *(const f32x4*)(mod + 3 * 2048 + k + 4 * q);
          const f32x4 hv = xv * rs * gg * (sc + 1.f) + sh; const f32x4 w0 = *(const f32x4*)(wr + k), w1 = *(const f32x4*)(wr + 16 * DM + k);
#pragma unroll
          for (int jj = 0; jj < 4; ++jj) { acc0 = __builtin_amdgcn_mfma_f32_16x16x4f32(hv[jj], w0[jj], acc0, 0, 0, 0); acc1 = __builtin_amdgcn_mfma_f32_16x16x4f32(hv[jj], w1[jj], acc1, 0, 0, 0); } }
      const float b0 = F.ap->in[I_BR][i], b1 = F.ap->in[I_BR][16 + i];
#pragma unroll
      for (int r = 0; r < 4; ++r) { lg[(4 * q + r) * 32 + i] = acc0[r] + b0; lg[(4 * q + r) * 32 + 16 + i] = acc1[r] + b1; } }
    LDS_WAIT();
    if (lane < 16) { const int m = t0 + lane; float v[4]; int e[4]; unsigned used = 0u;
#pragma unroll
        for (int k = 0; k < 4; ++k) { float best = -3.0e38f; int bi = 0;
            for (int j = 0; j < 32; ++j) { const float x = lg[lane * 32 + j]; if (!((used >> j) & 1u) && x > best) { best = x; bi = j; } }
            used |= 1u << bi; v[k] = best; e[k] = bi; }
        const float e1 = __expf(v[1] - v[0]), e2 = __expf(v[2] - v[0]), e3 = __expf(v[3] - v[0]), inv = 1.f / (1.f + e1 + e2 + e3);
        *(f32x4*)(WSP(float, WS_TOKW) + (size_t)m * 4) = (f32x4){inv, e1 * inv, e2 * inv, e3 * inv};
        int* te = WSP(int, WS_TOKE) + (size_t)m * 4; te[0] = e[0]; te[1] = e[1]; te[2] = e[2]; te[3] = e[3];
#pragma unroll
        for (int k = 0; k < 4; ++k) __hip_atomic_fetch_add(cnt + e[k], 1, __ATOMIC_RELAXED, __HIP_MEMORY_SCOPE_WORKGROUP); }
    __syncthreads();
    if (F.tid < 32) WSP(int, WS_WGCNT)[F.wg * 32 + F.tid] = cnt[F.tid];
    __syncthreads();
}
__device__ __forceinline__ void p12_slots(Frame& F) {
    constexpr int TPG = T / 256;
    LAS int* cur = (LAS int*)(F.lds + RING_OFF); LAS int* tot = cur + 32; LAS int* pre = cur + 64; LAS int* off = cur + 96; LAS int* slotl = cur + 160;
    const int* wgcnt = WSP(int, WS_WGCNT);
    if (F.tid < 32) { int tt = 0, pp = 0; for (int w = 0; w < 256; ++w) { const int c = wgcnt[w * 32 + F.tid]; if (w < F.wg) pp += c; tt += c; } tot[F.tid] = tt; pre[F.tid] = pp; }
    __syncthreads();
    if (F.tid == 0) { int o = 0; for (int e = 0; e < 32; ++e) { off[e] = o; o += (tot[e] + 255) & ~255; } off[32] = o; }
    __syncthreads();
    if (F.tid < 32) cur[F.tid] = off[F.tid] + pre[F.tid];
    if (F.wg == 0) { int* te = WSP(int, WS_TILEE); const int nt = off[32] >> 8;
        for (int p = F.tid; p < nt; p += NWAVES * 64) { int e = 0; for (int j = 1; j < 32; ++j) if ((p << 8) >= off[j]) e = j; te[p] = e; }
        if (F.tid == 0) te[1024] = nt; }
    __syncthreads();
    { const int t = F.wg * TPG + (F.tid >> 2), k = F.tid & 3; const int e = WSP(int, WS_TOKE)[(size_t)t * 4 + k];
      const int s = __hip_atomic_fetch_add(cur + e, 1, __ATOMIC_RELAXED, __HIP_MEMORY_SCOPE_WORKGROUP);
      slotl[F.tid] = s; WSP(int, WS_TOKS)[(size_t)t * 4 + k] = s; WSP(float, WS_SLOTW)[s] = WSP(float, WS_TOKW)[(size_t)t * 4 + k]; }
    __syncthreads();
    const bf16* H = WSP(bf16, WS_H); unsigned char* HS = WSP(unsigned char, WS_HS);
    for (int i = 0; i < TPG / NWAVES; ++i) { const int tl = F.wave * (TPG / NWAVES) + i, t = F.wg * TPG + tl; v2u v[4];
#pragma unroll
        for (int j = 0; j < 4; ++j) { float f[8]; unpack8(*(const v4u*)(H + (size_t)t * DM + 8 * (F.lane + 64 * j)), f);
            v[j].x = pk4_fp8(f[0] * FP8_SA1, f[1] * FP8_SA1, f[2] * FP8_SA1, f[3] * FP8_SA1); v[j].y = pk4_fp8(f[4] * FP8_SA1, f[5] * FP8_SA1, f[6] * FP8_SA1, f[7] * FP8_SA1); }
#pragma unroll
        for (int k = 0; k < 4; ++k) { const int s = slotl[tl * 4 + k];
#pragma unroll
            for (int j = 0; j < 4; ++j) *(v2u*)(HS + (size_t)s * DM + 8 * (F.lane + 64 * j)) = v[j]; } }
    __syncthreads();
}
__device__ __forceinline__ void p15_final(Frame& F) {
    const int gw = F.wg * NWAVES + F.wave, NGW = F.G * NWAVES, lane = F.lane;
    const float* x1 = WSP(float, WS_X1); const bf16* YS = WSP(bf16, WS_YS); const float* gf = F.ap->in[I_NFG];
    for (int m = gw; m < T; m += NGW) { const float* gt = WSP(float, WS_MOD) + (size_t)(m / SEQ) * 12288 + 5 * 2048;
        const int4 sl = *(const int4*)(WSP(int, WS_TOKS) + (size_t)m * 4); float v[4][8]; float ss = 0.f;
#pragma unroll
        for (int j = 0; j < 4; ++j) { const int c = 8 * (lane + 64 * j); float y[8] = {0.f, 0.f, 0.f, 0.f, 0.f, 0.f, 0.f, 0.f}, tmp[8];
            unpack8(*(const v4u*)(YS + (size_t)sl.x * DM + c), tmp); for (int i = 0; i < 8; ++i) y[i] += tmp[i];
            unpack8(*(const v4u*)(YS + (size_t)sl.y * DM + c), tmp); for (int i = 0; i < 8; ++i) y[i] += tmp[i];
            unpack8(*(const v4u*)(YS + (size_t)sl.z * DM + c), tmp); for (int i = 0; i < 8; ++i) y[i] += tmp[i];
            unpack8(*(const v4u*)(YS + (size_t)sl.w * DM + c), tmp); for (int i = 0; i < 8; ++i) y[i] += tmp[i];
            const f32x4 xa = *(const f32x4*)(x1 + (size_t)m * DM + c), xb = *(const f32x4*)(x1 + (size_t)m * DM + c + 4), ga = *(const f32x4*)(gt + c), gb = *(const f32x4*)(gt + c + 4);
#pragma unroll
            for (int i = 0; i < 8; ++i) { const float xv = (i < 4 ? xa[i] : xb[i - 4]) + (i < 4 ? ga[i] : gb[i - 4]) * y[i]; v[j][i] = xv; ss += xv * xv; } }
        const float rs = rsqrtf(wave_sum(ss) * (1.f / DM) + NORM_EPS);
#pragma unroll
        for (int j = 0; j < 4; ++j) { const int c = 8 * (lane + 64 * j); const f32x4 ga = *(const f32x4*)(gf + c), gb = *(const f32x4*)(gf + c + 4);
            *(f32x4*)(F.ap->out + (size_t)m * DM + c) = (f32x4){v[j][0] * rs * ga[0], v[j][1] * rs * ga[1], v[j][2] * rs * ga[2], v[j][3] * rs * ga[3]};
            *(f32x4*)(F.ap->out + (size_t)m * DM + c + 4) = (f32x4){v[j][4] * rs * gb[0], v[j][5] * rs * gb[1], v[j][6] * rs * gb[2], v[j][7] * rs * gb[3]}; }
    }
}

__device__ __forceinline__ bool fresh(Frame& F) {
    asm volatile("" : "+s"(F.ap)); int w = F.wave; asm volatile("" : "+s"(w)); const int l = __builtin_amdgcn_mbcnt_hi(~0u, __builtin_amdgcn_mbcnt_lo(~0u, 0u)); F.lane = l; F.tid = w * 64 + l; return true; }
constexpr int N_PHASES = 18;
__global__ void __launch_bounds__(NWAVES * 64, 2) mk_fwd(Args args) {
    extern __shared__ __attribute__((aligned(16))) unsigned char lds[];
    Frame F;
    F.lds = (LAS unsigned char*)lds; F.MISC = (volatile LAS unsigned*)(F.lds + MISC_OFF);
    F.tid = threadIdx.x; F.lane = F.tid & 63; F.wave = __builtin_amdgcn_readfirstlane(F.tid >> 6); F.G = gridDim.x; F.wg = blockIdx.x;
    F.ap = (ArgsP)__builtin_amdgcn_kernarg_segment_ptr(); F.ws = F.ap->ws; F.ctl = (gu32*)(F.ws + WS_CTL);
    for (int u = F.tid; u < (LDS_BYTES - LDSCTL_OFF) / 4; u += NWAVES * 64) ((LAS unsigned*)(F.lds + LDSCTL_OFF))[u] = 0u;
    __syncthreads();
    const int lo = F.ap->ph_lo, hi = F.ap->ph_hi;
    XcdBarrier bar; bar.bar = (unsigned*)(F.ctl + CW_BAR); bar.x = 0; bar.st = nullptr;
    if (hi - lo > 1) bar = xcd_barrier_post((unsigned*)(F.ctl + CW_BAR), F.MISC + 8, F.tid);
#ifndef PH_MASK
#define PH_MASK 0x3ffff
#endif
#define IN(k) (((PH_MASK >> (k)) & 1) && lo <= (k) && (k) < hi && fresh(F))
#ifndef PROBE_DUP
#define PROBE_DUP 0
#endif
#define REP(k) for (int rep_ = 0; rep_ < 1 + ((PROBE_DUP >> (k)) & 1); ++rep_)
#define SEAM(k) do { if (IN(k) && IN((k) + 1)) xcd_barrier(bar, F.tid); } while (0)
    if (IN(0)) REP(0) { p0_prologue(F); } SEAM(0);
    if (IN(1)) REP(1) { norm_mod_rows(F, F.ap->in[I_X], F.ap->in[I_N1G], 0, 2048, WSP(bf16, WS_H)); } SEAM(1);
    if (IN(2)) REP(2) { pg8::Gemm g{WSP(bf16, WS_H), WSP(bf16, WS_WIN), T, NP, DM}; pg8::StaticOrder S; S.init(T, NP, F.G, F.wg);
        pg8::EpiBf16<0> E{WSP(bf16, WS_P), NP, nullptr, 0, 0, 1.f}; pg8::gemm_phase<pg8::EpiBf16<0>, pg8::StaticOrder, true, true>(F.lds + RING_OFF, g, S, E, F.tid); } SEAM(2);
    if (IN(3)) REP(3) { p3_prep(F); } SEAM(3);
    if (IN(4)) REP(4) { p4_cumsum(F);
        { pg8::Gemm g{WSP(bf16, WS_LW), WSP(bf16, WS_BT1), T, 2048, 256}; pg8::StaticOrder S; S.init(T, 2048, F.G, F.wg);
          pg8::EpiLora1 E{WSP(float, WS_LOGW), WSP(bf16, WS_A), F.ap->in[I_W0], F.ap->in[I_A0]}; pg8::gemm_phase<pg8::EpiLora1, pg8::StaticOrder, true, true>(F.lds + RING_OFF, g, S, E, F.tid); }
        } SEAM(4);
    if (IN(5)) REP(5) {
        { pg8::Gemm g{WSP(bf16, WS_SG), WSP(bf16, WS_BT2), T, 1024, 256}; pg8::StaticOrder S; S.init(T, 1024, F.G, F.wg);
          pg8::EpiBf16<0> E{WSP(bf16, WS_G), 1024, nullptr, 0, 0, 1.f}; pg8::gemm_phase<pg8::EpiBf16<0>, pg8::StaticOrder, true, true>(F.lds + RING_OFF, g, S, E, F.tid); }
        } SEAM(5);
    if (IN(6)) REP(6) {
#if RWKV_NAIVE
        p5_scan_naive(F);
#else
        rw::phase_a(F.lds + RING_OFF, F.ws, F.ap->in[I_KK], F.ap->in[I_KA], F.wg, F.G, F.tid);
#endif
        } SEAM(6);
    if (IN(7)) REP(7) {
#if !RWKV_NAIVE
        for (int bh = F.wg; bh < 32; bh += F.G) { const int b = bh >> 4, h = bh & 15;
            rw::phase_b_head(F.lds + RING_OFF, F.ws + WS_REC + (size_t)bh * 256 * rw::REC, WSP(float, WS_YRAW) + (size_t)b * SEQ * RW + h * 64, F.tid); __syncthreads(); }
#endif
        p6_attention(F, (char*)lds + RING_OFF); } SEAM(7);
    if (IN(9)) REP(9) { p7_post(F); } SEAM(9);
    if (IN(10)) REP(10) { pg8::Gemm g{WSP(bf16, WS_YA), WSP(bf16, WS_WOA), T, DM, 1024}; pg8::StaticOrder S; S.init(T, DM, F.G, F.wg);
        pg8::EpiGateMerge<0> E{WSP(bf16, WS_MRG), WSP(bf16, WS_P), PC_GA}; pg8::gemm_phase<pg8::EpiGateMerge<0>, pg8::StaticOrder, true, true>(F.lds + RING_OFF, g, S, E, F.tid); } SEAM(10);
    if (IN(11)) REP(11) { pg8::Gemm g{WSP(bf16, WS_YB), WSP(bf16, WS_WOB), T, DM, 1024}; pg8::StaticOrder S; S.init(T, DM, F.G, F.wg);
        pg8::EpiGateMerge<1> E{WSP(bf16, WS_MRG), WSP(bf16, WS_P), PC_GB}; pg8::gemm_phase<pg8::EpiGateMerge<1>, pg8::StaticOrder, true, true>(F.lds + RING_OFF, g, S, E, F.tid); } SEAM(11);
    if (IN(12)) REP(12) { pg8::Gemm g{WSP(bf16, WS_MRG), WSP(bf16, WS_WOUT), T, DM, DM}; pg8::StaticOrder S; S.init(T, DM, F.G, F.wg);
        pg8::EpiResid E{F.ap->in[I_X], WSP(float, WS_X1), WSP(float, WS_MOD)}; pg8::gemm_phase<pg8::EpiResid, pg8::StaticOrder, true, true>(F.lds + RING_OFF, g, S, E, F.tid); } SEAM(12);
    if (IN(13)) REP(13) { p11_router(F); } SEAM(13);
    if (IN(14)) REP(14) { p12_slots(F); } SEAM(14);
    if (IN(15)) REP(15) { const int nt = WSP(int, WS_TILEE)[1024]; pg8::Gemm g{WSP(bf16, WS_HS), WSP(bf16, WS_WGU), nt * 256, 4096, DM / 2}; pg8::MoeOrder S; S.init(nt * 256, 4096, F.G, F.wg); S.tile_e = WSP(int, WS_TILEE);
        pg8::EpiSwiglu E{WSP(unsigned char, WS_ACT), F.ap->in[I_BGU]}; pg8::gemm_phase<pg8::EpiSwiglu, pg8::MoeOrder, true, true, true>(F.lds + RING_OFF, g, S, E, F.tid); } SEAM(15);
    if (IN(16)) REP(16) { const int nt = WSP(int, WS_TILEE)[1024]; pg8::Gemm g{WSP(bf16, WS_ACT), WSP(bf16, WS_WDN), nt * 256, 2048, DFF / 2}; pg8::MoeOrder S; S.init(nt * 256, 2048, F.G, F.wg); S.tile_e = WSP(int, WS_TILEE);
        pg8::EpiDown E{WSP(bf16, WS_YS), F.ap->in[I_BDN], WSP(float, WS_SLOTW)}; pg8::gemm_phase<pg8::EpiDown, pg8::MoeOrder, true, true, true>(F.lds + RING_OFF, g, S, E, F.tid); } SEAM(16);
    if (IN(17)) REP(17) { p15_final(F); }
#undef IN
#undef SEAM
}

extern "C" void kernel_launch(void* const* d_in, const int* in_sizes, int n_in, void* d_out, int out_size, void* d_ws, size_t ws_size, hipStream_t stream) {
    static int grid = 0;
    if (grid == 0) {
        if (n_in != N_IN || in_sizes[0] != T * DM || out_size != T * DM || ws_size < WS_END) { fprintf(stderr, "kernel_launch: shape/workspace mismatch (n_in %d, in0 %d, out %d, ws %zu < %zu)\n", n_in, n_in > 0 ? in_sizes[0] : -1, out_size, ws_size, (size_t)WS_END); grid = -1; return; }
        if (hipFuncSetAttribute((const void*)mk_fwd, hipFuncAttributeMaxDynamicSharedMemorySize, LDS_BYTES) != hipSuccess) { fprintf(stderr, "kernel_launch: hipFuncSetAttribute failed\n"); grid = -1; return; }
        int per_cu = 0;
        if (hipOccupancyMaxActiveBlocksPerMultiprocessor(&per_cu, (const void*)mk_fwd, NWAVES * 64, LDS_BYTES) != hipSuccess || per_cu < 1) fprintf(stderr, "kernel_launch: note: occupancy query reports %d workgroups per CU\n", per_cu);
        (void)hipGetLastError();
        grid = 256;
    }
    if (grid < 0) return;
    (void)hipMemsetAsync((char*)d_ws + WS_CTL, 0, CTL_ZERO_BYTES, stream);
    Args a{};
    for (int i = 0; i < N_IN; ++i) a.in[i] = (const float*)d_in[i];
    a.out = (float*)d_out; a.ws = (unsigned char*)d_ws;
#if MK_N_LAUNCHES == 1
    a.ph_lo = 0; a.ph_hi = N_PHASES;
    hipLaunchKernelGGL(mk_fwd, dim3(grid), dim3(NWAVES * 64), LDS_BYTES, stream, a);
#else
    for (int p = 0; p < N_PHASES; ++p) { a.ph_lo = p; a.ph_hi = p + 1; hipLaunchKernelGGL(mk_fwd, dim3(grid), dim3(NWAVES * 64), LDS_BYTES, stream, a); }
#endif
}
```

```cpp
#include <hip/hip_runtime.h>
#include <hip/hip_bf16.h>
#include <cstdio>
#include <cstdint>
constexpr int NWAVES = 8;
#ifndef MK_N_LAUNCHES
#define MK_N_LAUNCHES 1
#endif
#ifndef INPROJ_FP8
#define INPROJ_FP8 1
#endif
#ifndef RWKV_NAIVE
#define RWKV_NAIVE 0
#endif
constexpr int BATCH = 2, SEQ = 16384, DM = 2048, T = BATCH * SEQ;
constexpr int NP = 11776;
constexpr int PC_R = 0, PC_K = 1024, PC_V = 2048, PC_FQ = 3072, PC_FK = 4096, PC_FV = 5120, PC_OG = 6144, PC_GA = 7168, PC_GB = 9216, PC_GLO = 11264, PC_DLO = 11520, PC_ALO = 11616, PC_F = 11712, PC_END = 11720;
constexpr int RW = 1024, FW = 1024, NE = 32, DFF = 2048, TOPK = 4;
constexpr int NSLOT = T * TOPK + NE * 256;
constexpr float NORM_EPS = 1e-6f, GN_EPS = 64e-5f;
constexpr float FP8_SW = 64.f, FP8_SA1 = 2.f, FP8_SA2 = 4.f;

constexpr size_t MiB = 1u << 20;
constexpr size_t WS_CTL = 0, CTL_ZERO_BYTES = 1 * MiB;
constexpr size_t WS_MOD = 1 * MiB;
constexpr size_t WS_WRT = 1 * MiB + 128 * 1024;
constexpr size_t WS_TOKE = 2 * MiB, WS_TOKW = 2 * MiB + 512 * 1024, WS_TOKS = 3 * MiB, WS_SLOTW = 3 * MiB + 512 * 1024;
constexpr size_t WS_WGCNT = 4 * MiB + 512 * 1024, WS_TILEE = 4 * MiB + 768 * 1024;
constexpr size_t WS_LF = 5 * MiB, WS_CS = 6 * MiB;
constexpr size_t WS_BT1 = 7 * MiB, WS_BT2 = 8 * MiB, WS_WOA = 9 * MiB, WS_WOB = 13 * MiB, WS_WOUT = 17 * MiB, WS_WIN = 25 * MiB;
constexpr size_t WS_WGU = 72 * MiB, WS_WDN = 584 * MiB, WS_X1 = 840 * MiB, WS_H = 1096 * MiB;
constexpr size_t WS_P = 1226 * MiB, WS_R = 1962 * MiB, WS_K = 2026 * MiB, WS_V = 2090 * MiB, WS_FQ = 2154 * MiB, WS_FK = 2218 * MiB, WS_FV = 2282 * MiB;
constexpr size_t WS_LW = 2346 * MiB, WS_SG = 2362 * MiB, WS_LOGW = 2378 * MiB, WS_A = 2506 * MiB, WS_G = 2570 * MiB, WS_YRAW = 2634 * MiB, WS_YA = 2762 * MiB, WS_YB = 2826 * MiB, WS_MRG = 2890 * MiB;
constexpr size_t WS_HS = 1226 * MiB, WS_ACT = 1500 * MiB, WS_YS = 1774 * MiB;
constexpr size_t WS_REC = 3018 * MiB;
constexpr size_t WS_END = 3274 * MiB;
static_assert(WS_WIN + (size_t)NP * DM * 2 <= WS_WGU && WS_YS + (size_t)NSLOT * DM * 2 <= WS_REC && WS_HS + (size_t)NSLOT * DM <= WS_ACT && WS_ACT + (size_t)NSLOT * DFF <= WS_YS && WS_SLOTW + (size_t)NSLOT * 4 <= WS_WGCNT, "d_ws map");
constexpr int CW_TMO = 0, CW_ATTQ = 2048, CW_BAR = 4096;

constexpr int RING_OFF = 0, RING_BYTES = 143360;
constexpr int LDSCTL_OFF = RING_BYTES, MISC_OFF = LDSCTL_OFF + 320;
constexpr int LDS_BYTES = 147456;

#define GAS __attribute__((address_space(1)))
#define LAS __attribute__((address_space(3)))
typedef unsigned short bf16;
typedef unsigned v4u __attribute__((ext_vector_type(4)));
typedef unsigned v2u __attribute__((ext_vector_type(2)));
typedef float f32x4 __attribute__((ext_vector_type(4)));
typedef short bf16x8 __attribute__((ext_vector_type(8)));
typedef GAS unsigned gu32;
#define RLX_AGENT __ATOMIC_RELAXED, __HIP_MEMORY_SCOPE_AGENT
#define LDS_WAIT() asm volatile("s_waitcnt lgkmcnt(0)" ::: "memory")
#define VM_WAIT() asm volatile("s_waitcnt vmcnt(0)" ::: "memory")
__device__ __forceinline__ unsigned f2bf(float f) { unsigned u = __builtin_bit_cast(unsigned, f); return (u + 0x7fffu + ((u >> 16) & 1u)) >> 16; }
__device__ __forceinline__ unsigned pk2(float lo, float hi) { return f2bf(lo) | (f2bf(hi) << 16); }
__device__ __forceinline__ float bflo(unsigned w) { return __uint_as_float(w << 16); }
__device__ __forceinline__ float bfhi(unsigned w) { return __uint_as_float(w & 0xffff0000u); }
__device__ __forceinline__ void unpack8(v4u w, float (&f)[8]) { f[0] = bflo(w.x); f[1] = bfhi(w.x); f[2] = bflo(w.y); f[3] = bfhi(w.y); f[4] = bflo(w.z); f[5] = bfhi(w.z); f[6] = bflo(w.w); f[7] = bfhi(w.w); }
__device__ __forceinline__ v4u pack8f(const float (&f)[8]) { v4u w; w.x = pk2(f[0], f[1]); w.y = pk2(f[2], f[3]); w.z = pk2(f[4], f[5]); w.w = pk2(f[6], f[7]); return w; }
__device__ __forceinline__ float sigmoidf_(float x) { return 1.f / (1.f + __expf(-x)); }
__device__ __forceinline__ float wave_sum(float v) {
#pragma unroll
    for (int o = 1; o < 64; o <<= 1) v += __shfl_xor(v, o);
    return v;
}
namespace pg8 {
#define PG8_LAS __attribute__((address_space(3)))
typedef unsigned short bf16_t;
typedef short bf16x8 __attribute__((ext_vector_type(8)));
typedef float f32x4 __attribute__((ext_vector_type(4)));
typedef unsigned u32x4 __attribute__((ext_vector_type(4)));
constexpr int BM = 256, BK = 64, HALF = 128, HTB = HALF * BK * 2  , STAGE_BYTES = 8 * HTB, NXCD = 8, WGM = 8;

__host__ __device__ __forceinline__ int lds_byte(int r, int c) { const int st = (r >> 4) * 2 + (c >> 5), rr = r & 15, cc = c & 31, ob = rr * 64 + cc * 2; return st * 1024 + (ob ^ (((ob >> 9) & 1) << 5)); }
__host__ __device__ __forceinline__ void stage_rc(int b, int& R, int& C) { const int st = b / 1024, sb = b % 1024, swz = sb ^ (((sb >> 9) & 1) << 5); R = (st >> 1) * 16 + swz / 64; C = (st & 1) * 32 + (swz % 64) / 2; }
__host__ __device__ __forceinline__ int perm32(int rho) { const int n = rho >> 4, i = rho & 15; return 8 * (i >> 2) + 4 * n + (i & 3); }

struct Unit { int pm, pn, e; };
struct Gemm { const bf16_t* A; const bf16_t* Bt; int M, N, K; };

struct StaticOrder {
    int nM, nN, nwg, G, c;
    __host__ __device__ void init(int M, int N, int G_, int c_) { nM = M / BM; nN = N / BM; nwg = nM * nN; G = G_; c = c_; }
    __host__ __device__ bool next(int i, Unit& u) const {
        const long L = (long)i * G + c; if (L >= nwg) return false;
        int wgid = (int)L; { const int q = nwg / NXCD, r = nwg % NXCD, xcd = wgid % NXCD, off = wgid / NXCD; wgid = (xcd < r ? xcd * (q + 1) : r * (q + 1) + (xcd - r) * q) + off; }
        const int nig = WGM * nN, gid = wgid / nig, fm = gid * WGM, gsz = (nM - fm) < WGM ? (nM - fm) : WGM;
        u.pm = fm + ((wgid % nig) % gsz); u.pn = (wgid % nig) / gsz; u.e = 0; return true;
    }
    __device__ __forceinline__ void a_ready(const Unit&) const {}
    __device__ __forceinline__ void done(const Unit&) const {}
};

__device__ __forceinline__ unsigned cvt_pk_bf16(float lo, float hi) { unsigned r; asm volatile("v_cvt_pk_bf16_f32 %0, %1, %2" : "=v"(r) : "v"(lo), "v"(hi)); return r; }
typedef float f32x2 __attribute__((ext_vector_type(2)));
__device__ __forceinline__ f32x2 gelu_pk(f32x2 v) {
    const f32x2 av = __builtin_elementwise_abs(v), d = av * 0.2316418882f + 1.0f;
    f32x2 t; t.x = __builtin_amdgcn_rcpf(d.x); t.y = __builtin_amdgcn_rcpf(d.y);
    f32x2 q = t * 0.5307027145f + (-0.7265760135f); q = q * t + 0.7107068705f; q = q * t + (-0.142248368f); q = q * t + 0.127414796f; q = q * t;
    const f32x2 s = (v * v) * (-0.72134752044f);
    f32x2 e; e.x = __builtin_amdgcn_exp2f(s.x); e.y = __builtin_amdgcn_exp2f(s.y);
    const f32x2 m = v * (q * e), r = v - m;
    f32x2 o; o.x = v.x < 0.f ? m.x : r.x; o.y = v.y < 0.f ? m.y : r.y; return o;
}

template <int ACT  > struct EpiBf16 {
    static constexpr bool PERM = true, AFTER_DRAIN = false; static_assert(ACT == 0 || ACT == 1, "EpiBf16: ACT is 0 (none) or 1 (gelu_pk)");
    bf16_t* O; int ldc; const float* bias; int split_cols; size_t split_stride; float scale0;
    __device__ __forceinline__ void operator()(const f32x4 (&acc)[2][2][4][2], const Unit& u, int wr, int wc, int fr, int fq) const {
        const int row0 = u.pm * BM + wr * 64 + fr; int colt = u.pn * BM; bf16_t* base = O;
        float sc = 1.f; if (split_cols) { const int t = colt / split_cols; base += (size_t)t * split_stride; colt -= t * split_cols; if (t == 0) sc = scale0; }
        const int col0 = colt + wc * 32 + 8 * fq, bcol0 = u.pn * BM + wc * 32 + 8 * fq;
        f32x4 bv[2][2];
#pragma unroll
        for (int bj = 0; bj < 2; ++bj)
#pragma unroll
            for (int n = 0; n < 2; ++n) bv[bj][n] = bias ? *(const f32x4*)(bias + bcol0 + bj * HALF + 4 * n) : (f32x4){0.f, 0.f, 0.f, 0.f};
#pragma unroll
        for (int ai = 0; ai < 2; ++ai)
#pragma unroll
            for (int m = 0; m < 4; ++m) { bf16_t* rowp = base + (size_t)(row0 + ai * HALF + m * 16) * ldc + col0;
#pragma unroll
                for (int bj = 0; bj < 2; ++bj) { f32x4 v0 = acc[ai][bj][m][0] + bv[bj][0], v1 = acc[ai][bj][m][1] + bv[bj][1];
                    if (ACT == 1) { f32x2 a = gelu_pk((f32x2){v0[0], v0[1]}), b = gelu_pk((f32x2){v0[2], v0[3]}), c = gelu_pk((f32x2){v1[0], v1[1]}), d = gelu_pk((f32x2){v1[2], v1[3]});
                        v0 = (f32x4){a.x, a.y, b.x, b.y}; v1 = (f32x4){c.x, c.y, d.x, d.y}; }
                    v0 = v0 * sc; v1 = v1 * sc; u32x4 w; w.x = cvt_pk_bf16(v0[0], v0[1]); w.y = cvt_pk_bf16(v0[2], v0[3]); w.z = cvt_pk_bf16(v1[0], v1[1]); w.w = cvt_pk_bf16(v1[2], v1[3]);
                    *(u32x4*)(rowp + bj * HALF) = w; } }
    }
};

typedef int v4i_t __attribute__((ext_vector_type(4))); typedef int v8i_t __attribute__((ext_vector_type(8)));
template <class Epi, class Sched, bool ALIGN_EPI = false, bool SP2 = false, bool FP8 = false>
__device__ __forceinline__ void gemm_phase(PG8_LAS unsigned char* lds, const Gemm g, const Sched& S, const Epi& E, const int tid) {
    const int wid = __builtin_amdgcn_readfirstlane(tid >> 6), lane = tid & 63, wr = wid >> 2, wc = wid & 3, fr = lane & 15, fq = lane >> 4;
    const int K = g.K, nt = K / BK;
    unsigned voffA[2], voffB[2];
#pragma unroll
    for (int i = 0; i < 2; ++i) { int R, C; stage_rc(tid * 16 + i * 8192, R, C); const int Rb = Epi::PERM ? ((R & ~31) + perm32(R & 31)) : R;
        voffA[i] = (unsigned)(R * K + C) * 2u; voffB[i] = (unsigned)(Rb * K + C) * 2u; }
    const size_t kstep = (size_t)(BK * 2);
    const size_t hstep = (size_t)HALF * K * 2;
    const size_t tstep = 2 * hstep;
    const unsigned ldsw = (unsigned)wid * 1024u;
    const int aoff = lds_byte(wr * 64 + fr, fq * 8), boff = lds_byte(wc * 32 + fr, fq * 8);
#define PG8_SA(b, h) (((b) * 2 + (h)) * HTB)
#define PG8_SB(b, h) ((4 + (b) * 2 + (h)) * HTB)
#define PG8_STAGE(bufoff, gbase, voff) do { _Pragma("unroll") for (int _i = 0; _i < 2; ++_i) \
        __builtin_amdgcn_global_load_lds((const unsigned*)((const char*)(gbase) + (voff)[_i]), (PG8_LAS unsigned*)(lds + (bufoff) + ldsw + _i * 8192), 16, 0, 0); } while (0)
#define PG8_CAT(x0, x1) __builtin_shufflevector(__builtin_bit_cast(v4i_t, x0), __builtin_bit_cast(v4i_t, x1), 0, 1, 2, 3, 4, 5, 6, 7)
#define PG8_LDA(dst, b, h) do { _Pragma("unroll") for (int m = 0; m < 4; ++m) { if constexpr (FP8) dst##8[m] = PG8_CAT(*(const PG8_LAS bf16x8*)(lds + PG8_SA(b, h) + aoff + m * 2048), *(const PG8_LAS bf16x8*)(lds + PG8_SA(b, h) + aoff + m * 2048 + 1024)); \
        else { _Pragma("unroll") for (int k = 0; k < 2; ++k) dst[m][k] = *(const PG8_LAS bf16x8*)(lds + PG8_SA(b, h) + aoff + m * 2048 + k * 1024); } } } while (0)
#define PG8_LDB(dst, b, h) do { _Pragma("unroll") for (int n = 0; n < 2; ++n) { if constexpr (FP8) dst##8[n] = PG8_CAT(*(const PG8_LAS bf16x8*)(lds + PG8_SB(b, h) + boff + n * 2048), *(const PG8_LAS bf16x8*)(lds + PG8_SB(b, h) + boff + n * 2048 + 1024)); \
        else { _Pragma("unroll") for (int k = 0; k < 2; ++k) dst[n][k] = *(const PG8_LAS bf16x8*)(lds + PG8_SB(b, h) + boff + n * 2048 + k * 1024); } } } while (0)
#define PG8_MMA16(ai, bj, At, Bt) do { __builtin_amdgcn_s_setprio(1); _Pragma("unroll") for (int m = 0; m < 4; ++m) _Pragma("unroll") for (int n = 0; n < 2; ++n) _Pragma("unroll") for (int k = 0; k < 2; ++k) \
        acc[ai][bj][m][n] = __builtin_amdgcn_mfma_f32_16x16x32_bf16(Bt[n][k], At[m][k], acc[ai][bj][m][n], 0, 0, 0); __builtin_amdgcn_s_setprio(0); } while (0)
#define PG8_MMA8(ai, bj, At, Bt) do { __builtin_amdgcn_s_setprio(1); _Pragma("unroll") for (int m = 0; m < 4; ++m) _Pragma("unroll") for (int n = 0; n < 2; ++n) \
        asm volatile("v_mfma_scale_f32_16x16x128_f8f6f4 %0, %1, %2, %0, %3, %3 op_sel_hi:[0,0,0]" : "+v"(acc[ai][bj][m][n]) : "v"(Bt##8[n]), "v"(At##8[m]), "v"(one_scale)); __builtin_amdgcn_s_setprio(0); } while (0)
#define PG8_MMA(ai, bj, At, Bt) do { if constexpr (FP8) PG8_MMA8(ai, bj, At, Bt); else PG8_MMA16(ai, bj, At, Bt); } while (0)
#define PG8_WAIT_V(n) asm volatile("s_waitcnt vmcnt(" #n ")" ::: "memory")
#define PG8_WAIT_L(n) asm volatile("s_waitcnt lgkmcnt(" #n ")" ::: "memory")
#define PG8_BAR __builtin_amdgcn_s_barrier()
#define PG8_SCHED __builtin_amdgcn_sched_barrier(0)
    Unit cur, nxt; int ui = 0;
    if (!S.next(0, cur)) return;
    f32x4 acc[2][2][4][2];
#pragma unroll
    for (int a = 0; a < 2; ++a)
#pragma unroll
        for (int b = 0; b < 2; ++b)
#pragma unroll
            for (int m = 0; m < 4; ++m)
#pragma unroll
                for (int n = 0; n < 2; ++n) acc[a][b][m][n] = (f32x4){0.f, 0.f, 0.f, 0.f};
    bf16x8 At[4][2], B0[2][2], B1[2][2]; v8i_t At8[4], B08[2], B18[2];
    int one_scale = 0x7f7f7f7f; asm volatile("" : "+v"(one_scale));
    const char* cA = (const char*)g.A + (size_t)cur.pm * tstep; const size_t estep = (size_t)g.N * K * 2; const char* cB = (const char*)g.Bt + (size_t)cur.e * estep + (size_t)cur.pn * tstep;
    S.a_ready(cur);
    if constexpr (SP2) {
        PG8_STAGE(PG8_SB(0, 0), cB, voffB); PG8_STAGE(PG8_SB(0, 1), cB + hstep, voffB); PG8_STAGE(PG8_SA(0, 0), cA, voffA); PG8_STAGE(PG8_SA(0, 1), cA + hstep, voffA);
        if (wr == 1) PG8_BAR;
        PG8_WAIT_V(2); PG8_BAR;
        PG8_STAGE(PG8_SB(1, 0), cB + kstep, voffB); PG8_STAGE(PG8_SA(1, 0), cA + kstep, voffA); PG8_STAGE(PG8_SB(1, 1), cB + hstep + kstep, voffB);
        PG8_WAIT_V(6); PG8_BAR;
    } else {
        PG8_STAGE(PG8_SB(0, 0), cB, voffB); PG8_STAGE(PG8_SA(0, 0), cA, voffA); PG8_STAGE(PG8_SB(0, 1), cB + hstep, voffB); PG8_STAGE(PG8_SA(0, 1), cA + hstep, voffA);
        if (wr == 1) PG8_BAR;
        PG8_WAIT_V(4); PG8_BAR;
        PG8_STAGE(PG8_SB(1, 0), cB + kstep, voffB); PG8_STAGE(PG8_SA(1, 0), cA + kstep, voffA); PG8_STAGE(PG8_SB(1, 1), cB + hstep + kstep, voffB);
        PG8_WAIT_V(6); PG8_BAR;
    }
    for (;;) {
        const bool has_next = S.next(ui + 1, nxt);
        const char* nA = has_next ? (const char*)g.A + (size_t)nxt.pm * tstep : cA; const char* nB = has_next ? (const char*)g.Bt + (size_t)nxt.e * estep + (size_t)nxt.pn * tstep : cB;
        for (int t = 0; t < nt; t += 2) {
            const bool last = (t == nt - 2);
            const char* a1 = cA + (size_t)(t + 1) * kstep;
            const char* a2 = last ? nA : cA + (size_t)(t + 2) * kstep; const char* b2 = last ? nB : cB + (size_t)(t + 2) * kstep;
            const char* a3 = a2 + kstep; const char* b3 = b2 + kstep;
            if (last && has_next) S.a_ready(nxt);
            if constexpr (SP2) {
            PG8_LDB(B0, 0, 0); PG8_LDB(B1, 0, 1); PG8_SCHED; PG8_LDA(At, 0, 0); PG8_STAGE(PG8_SA(1, 1), a1 + hstep, voffA);
            PG8_WAIT_V(8); PG8_WAIT_L(0); PG8_BAR; PG8_MMA(0, 0, At, B0); PG8_MMA(0, 1, At, B1); PG8_BAR; PG8_SCHED;
            PG8_LDA(At, 0, 1); PG8_STAGE(PG8_SB(0, 0), b2, voffB); PG8_STAGE(PG8_SB(0, 1), b2 + hstep, voffB); PG8_STAGE(PG8_SA(0, 0), a2, voffA);
            PG8_WAIT_V(8); PG8_WAIT_L(0); PG8_BAR; PG8_MMA(1, 0, At, B0); PG8_MMA(1, 1, At, B1); PG8_BAR; PG8_SCHED;
            PG8_LDB(B0, 1, 0); PG8_LDB(B1, 1, 1); PG8_SCHED; PG8_LDA(At, 1, 0); PG8_STAGE(PG8_SA(0, 1), a2 + hstep, voffA);
            PG8_WAIT_V(8); PG8_WAIT_L(0); PG8_BAR; PG8_MMA(0, 0, At, B0); PG8_MMA(0, 1, At, B1); PG8_BAR; PG8_SCHED;
            PG8_LDA(At, 1, 1); PG8_STAGE(PG8_SB(1, 0), b3, voffB); PG8_STAGE(PG8_SB(1, 1), b3 + hstep, voffB); PG8_STAGE(PG8_SA(1, 0), a3, voffA);
            PG8_WAIT_V(8); PG8_WAIT_L(0); PG8_BAR; PG8_MMA(1, 0, At, B0); PG8_MMA(1, 1, At, B1); PG8_BAR; PG8_SCHED;
            } else {
            PG8_LDB(B0, 0, 0); PG8_SCHED; PG8_LDA(At, 0, 0); PG8_STAGE(PG8_SA(1, 1), a1 + hstep, voffA);
            PG8_WAIT_L(8); PG8_BAR; PG8_WAIT_L(0); PG8_MMA(0, 0, At, B0); PG8_BAR; PG8_SCHED;
            PG8_LDB(B1, 0, 1); PG8_STAGE(PG8_SB(0, 0), b2, voffB);
            PG8_BAR; PG8_WAIT_L(0); PG8_MMA(0, 1, At, B1); PG8_BAR;
            PG8_LDA(At, 0, 1); PG8_STAGE(PG8_SA(0, 0), a2, voffA);
            PG8_BAR; PG8_WAIT_L(0); PG8_MMA(1, 0, At, B0); PG8_BAR; PG8_SCHED;
            PG8_STAGE(PG8_SB(0, 1), b2 + hstep, voffB);
            PG8_WAIT_V(6); PG8_BAR; PG8_MMA(1, 1, At, B1); PG8_BAR;
            PG8_LDB(B0, 1, 0); PG8_SCHED; PG8_LDA(At, 1, 0); PG8_STAGE(PG8_SA(0, 1), a2 + hstep, voffA);
            PG8_WAIT_L(8); PG8_BAR; PG8_WAIT_L(0); PG8_MMA(0, 0, At, B0); PG8_BAR; PG8_SCHED;
            PG8_LDB(B1, 1, 1); PG8_STAGE(PG8_SB(1, 0), b3, voffB);
            PG8_BAR; PG8_WAIT_L(0); PG8_MMA(0, 1, At, B1); PG8_BAR;
            PG8_LDA(At, 1, 1); PG8_STAGE(PG8_SA(1, 0), a3, voffA);
            PG8_BAR; PG8_WAIT_L(0); PG8_MMA(1, 0, At, B0); PG8_BAR; PG8_SCHED;
            PG8_STAGE(PG8_SB(1, 1), b3 + hstep, voffB);
            PG8_WAIT_V(6); PG8_BAR; PG8_MMA(1, 1, At, B1); PG8_BAR;
            }
        }
        if constexpr (ALIGN_EPI) { if (wr == 0) PG8_BAR; }
        if constexpr (FP8) asm volatile("s_nop 15\n\ts_nop 15" ::: "memory");
        if constexpr (!Epi::AFTER_DRAIN) { E(acc, cur, wr, wc, fr, fq); S.done(cur); }
        if (!has_next) break;
#pragma unroll
        for (int a = 0; a < 2; ++a)
#pragma unroll
            for (int b = 0; b < 2; ++b)
#pragma unroll
                for (int m = 0; m < 4; ++m)
#pragma unroll
                    for (int n = 0; n < 2; ++n) acc[a][b][m][n] = (f32x4){0.f, 0.f, 0.f, 0.f};
        cur = nxt; cA = nA; cB = nB; ++ui;
        if constexpr (ALIGN_EPI) { if (wr == 1) PG8_BAR; }
    }
    PG8_WAIT_V(0);
    if constexpr (!ALIGN_EPI) { if (wr == 0) PG8_BAR; }
    PG8_BAR;
    if constexpr (Epi::AFTER_DRAIN) { E.fused(acc, cur, wr, wc, fr, fq, lds, wid, lane); S.done(cur); }
#undef PG8_SA
#undef PG8_SB
#undef PG8_STAGE
#undef PG8_LDA
#undef PG8_LDB
#undef PG8_MMA
#undef PG8_MMA8
#undef PG8_MMA16
#undef PG8_CAT
#undef PG8_WAIT_V
#undef PG8_WAIT_L
#undef PG8_BAR
#undef PG8_SCHED
}
}
namespace pg8 {
__device__ __forceinline__ float ep_bflo(unsigned w) { return __uint_as_float(w << 16); }
__device__ __forceinline__ float ep_bfhi(unsigned w) { return __uint_as_float(w & 0xffff0000u); }
__device__ __forceinline__ float ep_sig(float x) { return __builtin_amdgcn_rcpf(1.f + __builtin_amdgcn_exp2f(-1.4426950408889634f * x)); }
__device__ __forceinline__ void ep_unpack8(u32x4 w, f32x4& a, f32x4& b) { a = (f32x4){ep_bflo(w.x), ep_bfhi(w.x), ep_bflo(w.y), ep_bfhi(w.y)}; b = (f32x4){ep_bflo(w.z), ep_bfhi(w.z), ep_bflo(w.w), ep_bfhi(w.w)}; }
__device__ __forceinline__ u32x4 ep_pack8(f32x4 a, f32x4 b) { u32x4 w; w.x = cvt_pk_bf16(a[0], a[1]); w.y = cvt_pk_bf16(a[2], a[3]); w.z = cvt_pk_bf16(b[0], b[1]); w.w = cvt_pk_bf16(b[2], b[3]); return w; }
__device__ __forceinline__ f32x4 ep_sig4(f32x4 v) { return (f32x4){ep_sig(v[0]), ep_sig(v[1]), ep_sig(v[2]), ep_sig(v[3])}; }
#define EPI_LOOP_BEGIN const int row0 = u.pm * BM + wr * 64 + fr, col0 = u.pn * BM + wc * 32 + 8 * fq; \
    _Pragma("unroll") for (int ai = 0; ai < 2; ++ai) _Pragma("unroll") for (int m = 0; m < 4; ++m) { const int row = row0 + ai * HALF + m * 16; \
    _Pragma("unroll") for (int bj = 0; bj < 2; ++bj) { const int col = col0 + bj * HALF; const f32x4 v0 = acc[ai][bj][m][0], v1 = acc[ai][bj][m][1];
#define EPI_LOOP_END } }

struct EpiBf16S {
    static constexpr bool PERM = true, AFTER_DRAIN = false;
    bf16_t* O; int ldc; float s;
    __device__ __forceinline__ void operator()(const f32x4 (&acc)[2][2][4][2], const Unit& u, int wr, int wc, int fr, int fq) const {
        EPI_LOOP_BEGIN
            *(u32x4*)(O + (size_t)row * ldc + col) = ep_pack8(v0 * s, v1 * s);
        EPI_LOOP_END
    }
};
struct EpiLora1 {
    static constexpr bool PERM = true, AFTER_DRAIN = false;
    float* logw; bf16_t* a; const float* w0; const float* a0;
    __device__ __forceinline__ void operator()(const f32x4 (&acc)[2][2][4][2], const Unit& u, int wr, int wc, int fr, int fq) const {
        EPI_LOOP_BEGIN
            if (u.pn < 4) { const f32x4 b0 = *(const f32x4*)(w0 + col), b1 = *(const f32x4*)(w0 + col + 4);
                float* o = logw + (size_t)row * 1024 + col; *(f32x4*)o = ep_sig4(v0 + b0) * (-0.6065306597126334f); *(f32x4*)(o + 4) = ep_sig4(v1 + b1) * (-0.6065306597126334f); }
            else { const int c = col - 1024; const f32x4 b0 = *(const f32x4*)(a0 + c), b1 = *(const f32x4*)(a0 + c + 4);
                *(u32x4*)(a + (size_t)row * 1024 + c) = ep_pack8(ep_sig4(v0 + b0), ep_sig4(v1 + b1)); }
        EPI_LOOP_END
    }
};
template <int SECOND> struct EpiGateMerge {
    static constexpr bool PERM = true, AFTER_DRAIN = false;
    bf16_t* mrg; const bf16_t* P; int gcol;
    __device__ __forceinline__ void operator()(const f32x4 (&acc)[2][2][4][2], const Unit& u, int wr, int wc, int fr, int fq) const {
        EPI_LOOP_BEGIN
            f32x4 g0, g1; ep_unpack8(*(const u32x4*)(P + (size_t)row * 11776 + gcol + col), g0, g1);
            f32x4 r0 = ep_sig4(g0) * v0, r1 = ep_sig4(g1) * v1;
            bf16_t* o = mrg + (size_t)row * 2048 + col;
            if (SECOND) { f32x4 t0, t1; ep_unpack8(*(const u32x4*)o, t0, t1); r0 = r0 + t0; r1 = r1 + t1; }
            *(u32x4*)o = ep_pack8(r0, r1);
        EPI_LOOP_END
    }
};
struct EpiResid {
    static constexpr bool PERM = true, AFTER_DRAIN = false;
    const float* x; float* x1; const float* mod;
    __device__ __forceinline__ void operator()(const f32x4 (&acc)[2][2][4][2], const Unit& u, int wr, int wc, int fr, int fq) const {
        const float* gt = mod + (size_t)((u.pm * BM) / 16384) * 12288 + 4096;
        EPI_LOOP_BEGIN
            const f32x4 g0 = *(const f32x4*)(gt + col), g1 = *(const f32x4*)(gt + col + 4);
            const size_t off = (size_t)row * 2048 + col;
            *(f32x4*)(x1 + off) = *(const f32x4*)(x + off) + g0 * v0; *(f32x4*)(x1 + off + 4) = *(const f32x4*)(x + off + 4) + g1 * v1;
        EPI_LOOP_END
    }
};
struct EpiSwiglu {
    static constexpr bool PERM = true, AFTER_DRAIN = false;
    unsigned char* act; const float* bias;
    __device__ __forceinline__ void operator()(const f32x4 (&acc)[2][2][4][2], const Unit& u, int wr, int wc, int fr, int fq) const {
        const int row0 = u.pm * BM + wr * 64 + fr, gcol = u.pn * 128 + wc * 32 + 8 * fq;
        const float* bg = bias + (size_t)u.e * 4096 + gcol; const float* bl = bg + 2048;
        const f32x4 bg0 = *(const f32x4*)bg, bg1 = *(const f32x4*)(bg + 4), bl0 = *(const f32x4*)bl, bl1 = *(const f32x4*)(bl + 4);
#pragma unroll
        for (int ai = 0; ai < 2; ++ai)
#pragma unroll
            for (int m = 0; m < 4; ++m) { const int row = row0 + ai * HALF + m * 16;
                f32x4 g0 = acc[ai][0][m][0] * (1.f / 128.f) + bg0, g1 = acc[ai][0][m][1] * (1.f / 128.f) + bg1, l0 = acc[ai][1][m][0] * (1.f / 128.f) + bl0, l1 = acc[ai][1][m][1] * (1.f / 128.f) + bl1, r0, r1;
#pragma unroll
                for (int i = 0; i < 4; ++i) { const float a = fminf(g0[i], 7.f), b = fminf(g1[i], 7.f);
                    r0[i] = a * ep_sig(1.702f * a) * (fminf(fmaxf(l0[i], -7.f), 7.f) + 1.f); r1[i] = b * ep_sig(1.702f * b) * (fminf(fmaxf(l1[i], -7.f), 7.f) + 1.f); }
                r0 = r0 * 4.f; r1 = r1 * 4.f; typedef unsigned u32x2e __attribute__((ext_vector_type(2))); u32x2e o;
                { int w = __builtin_amdgcn_cvt_pk_fp8_f32(r0[0], r0[1], 0, false); w = __builtin_amdgcn_cvt_pk_fp8_f32(r0[2], r0[3], w, true); o.x = (unsigned)w; }
                { int w = __builtin_amdgcn_cvt_pk_fp8_f32(r1[0], r1[1], 0, false); w = __builtin_amdgcn_cvt_pk_fp8_f32(r1[2], r1[3], w, true); o.y = (unsigned)w; }
                *(u32x2e*)(act + (size_t)row * 2048 + gcol) = o; }
    }
};
struct EpiDown {
    static constexpr bool PERM = true, AFTER_DRAIN = false;
    bf16_t* ys; const float* bias; const float* slot_w;
    __device__ __forceinline__ void operator()(const f32x4 (&acc)[2][2][4][2], const Unit& u, int wr, int wc, int fr, int fq) const {
        const float* be = bias + (size_t)u.e * 2048;
        EPI_LOOP_BEGIN
            const float w = slot_w[row];
            const f32x4 b0 = *(const f32x4*)(be + col), b1 = *(const f32x4*)(be + col + 4);
            *(u32x4*)(ys + (size_t)row * 2048 + col) = ep_pack8((v0 * (1.f / 256.f) + b0) * w, (v1 * (1.f / 256.f) + b1) * w);
        EPI_LOOP_END
    }
};
struct MoeOrder : StaticOrder {
    const int* tile_e;
    __device__ bool next(int i, Unit& u) const { if (!StaticOrder::next(i, u)) return false; u.e = tile_e[u.pm]; return true; }
};
}
namespace fox {
enum { ORDER_NATURAL = 0, ORDER_REVERSED = 1, ORDER_PAIRED = 2, ORDER_XCD = 4 };
using TIN = __hip_bfloat16; using TOUT = __hip_bfloat16;
constexpr int B = 2, H = 8, HKV = 8, SQ = 16384, SKV = 16384, D = 128;
constexpr int PITCH = 1024;
constexpr int GPITCH = 11776;
constexpr int QOFF = 0;
constexpr int WINDOW = SKV;
constexpr float THR = 8.f;
constexpr int ORDER = ORDER_PAIRED;
constexpr bool WSKIP = false;
constexpr float SCALE = 0.08838834764831845f;
constexpr int NW = 8, QBLK = 32, KVBLK = 64, QB = NW * QBLK;
constexpr int SHM_V = KVBLK * D * 2, SHM_K = KVBLK * D * 2;
constexpr int LDS_CB = 2 * SHM_V + 2 * SHM_K + NW * 64 * 4;
constexpr int LDS_GATE = LDS_CB + 3 * 64 * 4 + 256;
constexpr int LDS_BYTES = LDS_GATE + NW * 8192;
static_assert(D == 128 && SQ % QB == 0 && SKV % KVBLK == 0 && H % HKV == 0 && QOFF >= 0 && QOFF + SQ <= SKV && WINDOW >= 1, "geometry");

using bf16 = __hip_bfloat16;
typedef short bf16x8 __attribute__((ext_vector_type(8)));
typedef short s16x4 __attribute__((ext_vector_type(4)));
typedef float f32x16 __attribute__((ext_vector_type(16)));
typedef float f32x4 __attribute__((ext_vector_type(4)));
typedef unsigned u32x4 __attribute__((ext_vector_type(4)));
template <class A, class Bt> struct same_t { static constexpr bool v = false; };
template <class A> struct same_t<A, A> { static constexpr bool v = true; };

#define KSWZ(row, colB) ((row) * 256 + ((colB) ^ (((row) & 7) << 4)))
#define SBAR() __builtin_amdgcn_sched_barrier(0)
__device__ __forceinline__ int v_st(int k, int c) { const int kk = (k & ~0xC) | ((k & 4) << 1) | ((k & 8) >> 1); return ((kk >> 3) * 4 + (c >> 5)) * 512 + ((kk & 7) * 32 + (c & 31)) * 2; }
__device__ __forceinline__ int v_rd_base(int lane) { return ((lane & 3) << 3) | (((lane >> 2) & 3) << 6) | (((lane >> 4) & 1) << 5) | (((lane >> 5) & 1) << 8); }
constexpr int v_rd_off(int d0, int ks, int half) { return d0 * 512 + ks * 4096 + half * 2048; }
__device__ __forceinline__ int crow(int r, int hi) { return (r & 3) + 8 * (r >> 2) + 4 * hi; }
__device__ __forceinline__ unsigned cvtpk(float lo, float hi) {
    unsigned r; asm volatile("v_cvt_pk_bf16_f32 %0, %1, %2" : "=v"(r) : "v"(lo), "v"(hi)); return r;
}
__device__ __forceinline__ bf16x8 pack8(f32x4 a, f32x4 b) {
    u32x4 w = {cvtpk(a[0], a[1]), cvtpk(a[2], a[3]), cvtpk(b[0], b[1]), cvtpk(b[2], b[3])};
    return *reinterpret_cast<bf16x8*>(&w);
}
template <class T> __device__ __forceinline__ bf16x8 load8(const T* p) {
    if constexpr (same_t<T, float>::v) { return pack8(*(const f32x4*)p, *(const f32x4*)(p + 4)); }
    else { return *reinterpret_cast<const bf16x8*>(p); }
}
__device__ __forceinline__ void mask_tile(f32x16& p0, f32x16& p1, int dq, unsigned W) {
    const float NEG = -__builtin_inff();
#pragma unroll
    for (int r = 0; r < 16; ++r) {
        const int c = (r & 3) + 8 * (r >> 2);
        if ((unsigned)(dq - c) >= W) p0[r] = NEG;
        if ((unsigned)(dq - c - 32) >= W) p1[r] = NEG;
    }
}
__device__ __forceinline__ void partialSM(f32x16& p0, f32x16& p1, float& m_reg, float& mn, float& alpha) {
    float pmax = p0[0]; for (int r = 1; r < 16; ++r) pmax = fmaxf(pmax, p0[r]); for (int r = 0; r < 16; ++r) pmax = fmaxf(pmax, p1[r]);
    { auto rr = __builtin_amdgcn_permlane32_swap(__float_as_uint(pmax), __float_as_uint(pmax), false, false);
      pmax = fmaxf(__uint_as_float(rr[0]), __uint_as_float(rr[1])); }
    constexpr float C2 = 1.4426950408889634f * SCALE;
    if (__builtin_expect(__all((pmax - m_reg) * SCALE <= THR), 1)) { mn = m_reg; alpha = 1.f; }
    else { mn = fmaxf(m_reg, pmax); alpha = __builtin_amdgcn_exp2f((m_reg - mn) * C2); m_reg = mn; }
    const float mnL = -mn * C2;
    for (int r = 0; r < 16; ++r) p0[r] = fmaf(p0[r], C2, mnL); for (int r = 0; r < 16; ++r) p1[r] = fmaf(p1[r], C2, mnL);
    for (int r = 0; r < 16; ++r) p0[r] = __builtin_amdgcn_exp2f(p0[r]);
}
__device__ __forceinline__ void finishSM(f32x16& p0, f32x16& p1, float alpha, float& l_reg, bf16x8& pa0, bf16x8& pa1, bf16x8& pa2, bf16x8& pa3) {
    for (int r = 0; r < 16; ++r) p1[r] = __builtin_amdgcn_exp2f(p1[r]);
    float ps = 0; for (int r = 0; r < 16; ++r) ps += p0[r]; for (int r = 0; r < 16; ++r) ps += p1[r];
    { auto rr = __builtin_amdgcn_permlane32_swap(__float_as_uint(ps), __float_as_uint(ps), false, false);
      ps = __uint_as_float(rr[0]) + __uint_as_float(rr[1]); }
    l_reg = l_reg * alpha + ps;
#define PK4(P, B_, OUT) do { unsigned a0 = cvtpk(P[B_+0], P[B_+1]), a1 = cvtpk(P[B_+2], P[B_+3]);                          \
        unsigned b0 = cvtpk(P[B_+4], P[B_+5]), b1 = cvtpk(P[B_+6], P[B_+7]);                                             \
        auto r0 = __builtin_amdgcn_permlane32_swap(a0, b0, false, false); auto r1 = __builtin_amdgcn_permlane32_swap(a1, b1, false, false); \
        u32x4 w = {r0[0], r1[0], r0[1], r1[1]}; OUT = *reinterpret_cast<bf16x8*>(&w); } while (0)
    PK4(p0, 0, pa0); PK4(p0, 8, pa1); PK4(p1, 0, pa2); PK4(p1, 8, pa3);
#undef PK4
}
template <int KB, bool SK>
__device__ __forceinline__ void qkt(f32x16& p0, f32x16& p1, const char* K_lds, int r32, int hi, const bf16x8* qr, bool act, int cbi) {
    if (SK && !act) { const float NEG = -__builtin_inff();
#pragma unroll
        for (int r = 0; r < 16; ++r) { p0[r] = NEG; p1[r] = NEG; } return; }
    { const float* cb_ = (const float*)(K_lds + 2 * SHM_K + NW * 64 * 4) + cbi * 64 + 4 * hi;
#pragma unroll
      for (int g_ = 0; g_ < 4; ++g_) { const f32x4 b0_ = *(const f32x4*)(cb_ + 8 * g_), b1_ = *(const f32x4*)(cb_ + 32 + 8 * g_);
#pragma unroll
          for (int i_ = 0; i_ < 4; ++i_) { p0[4 * g_ + i_] = b0_[i_]; p1[4 * g_ + i_] = b1_[i_]; } } }
    const char* kb[4];
#pragma unroll
    for (int dd = 0; dd < 4; ++dd) kb[dd] = K_lds + KB * SHM_K + KSWZ(r32, (dd * 16 + hi * 8) * 2);
#pragma unroll
    for (int d0 = 0; d0 < 8; ++d0) { const char* a = kb[d0 & 3] + (d0 >> 2) * 128;
        bf16x8 b0 = *reinterpret_cast<const bf16x8*>(a);
        bf16x8 b1 = *reinterpret_cast<const bf16x8*>(a + 32 * 256);
        p0 = __builtin_amdgcn_mfma_f32_32x32x16_bf16(b0, qr[d0], p0, 0, 0, 0);
        p1 = __builtin_amdgcn_mfma_f32_32x32x16_bf16(b1, qr[d0], p1, 0, 0, 0); }
}
template <int VB, bool SK>
__device__ __forceinline__ void pv_tile(f32x16* o, int vb0, bf16x8 pa0, bf16x8 pa1, bf16x8 pa2, bf16x8 pa3, bool act) {
    if (SK && !act) return;
#define TRRD(dst, off) asm volatile("ds_read_b64_tr_b16 %0, %1 offset:%2" : "=&v"(dst) : "v"(vb0), "i"(off) : "memory")
#define PV_D0(d0) do { s16x4 l0, l1, l2, l3, h0, h1, h2, h3; constexpr int b_ = VB * SHM_V + v_rd_off(d0, 0, 0);     \
        TRRD(l0, b_); TRRD(h0, b_ + 2048); TRRD(l1, b_ + 4096); TRRD(h1, b_ + 6144); TRRD(l2, b_ + 8192); TRRD(h2, b_ + 10240); TRRD(l3, b_ + 12288); TRRD(h3, b_ + 14336); \
        asm volatile("s_waitcnt lgkmcnt(0)" ::: "memory"); SBAR();                 \
        o[d0] = __builtin_amdgcn_mfma_f32_32x32x16_bf16(pa0, (bf16x8){l0[0], l0[1], l0[2], l0[3], h0[0], h0[1], h0[2], h0[3]}, o[d0], 0, 0, 0);   \
        o[d0] = __builtin_amdgcn_mfma_f32_32x32x16_bf16(pa1, (bf16x8){l1[0], l1[1], l1[2], l1[3], h1[0], h1[1], h1[2], h1[3]}, o[d0], 0, 0, 0);   \
        o[d0] = __builtin_amdgcn_mfma_f32_32x32x16_bf16(pa2, (bf16x8){l2[0], l2[1], l2[2], l2[3], h2[0], h2[1], h2[2], h2[3]}, o[d0], 0, 0, 0);   \
        o[d0] = __builtin_amdgcn_mfma_f32_32x32x16_bf16(pa3, (bf16x8){l3[0], l3[1], l3[2], l3[3], h3[0], h3[1], h3[2], h3[3]}, o[d0], 0, 0, 0); } while (0)
    PV_D0(0); PV_D0(1); PV_D0(2); PV_D0(3);
#undef PV_D0
#undef TRRD
}

template <class TIn, class TOut> struct BlockRef { const unsigned char* ws; int row0, bh, P0;
    __device__ __forceinline__ const TIn* Q() const { return (const TIn*)(ws + WS_FQ) + (size_t)row0 * PITCH + (bh % H) * D; }
    __device__ __forceinline__ const TIn* K() const { return (const TIn*)(ws + WS_FK) + (size_t)(bh / H) * SQ * PITCH + (bh % H) * D; }
    __device__ __forceinline__ const TIn* V() const { return (const TIn*)(ws + WS_FV) + (size_t)(bh / H) * SQ * PITCH + (bh % H) * D; }
    __device__ __forceinline__ TOut* O() const { return (TOut*)(ws + WS_YB) + (size_t)row0 * PITCH + (bh % H) * D; }
    __device__ __forceinline__ const float* C() const { return (const float*)(ws + WS_CS) + (size_t)bh * SQ; }
    __device__ __forceinline__ const TIn* G() const { return (const TIn*)(ws + WS_P) + (size_t)row0 * GPITCH + PC_OG + (bh % H) * D; }
};
template <class TIn> struct Seam {
    bf16x8 qr[8];
    bf16x8 st_v0, st_v1, st_k0, st_k1; int cbi; f32x4 sf0, sf1, sf2, sf3;
    f32x4 tq[16];
};
__device__ __forceinline__ int swa_jlo(int P0, int W) { const int lowk = P0 - W + 1; return lowk > 0 ? lowk / KVBLK : 0; }
#define ROW(p, k0, rr) ((p) + (size_t)((k0) + (rr)) * PITCH + sc)
#define VMW() asm volatile("s_waitcnt vmcnt(0)" ::: "memory")
#define VMWN(n) asm volatile("s_waitcnt vmcnt(%0)" :: "i"(n) : "memory")
#define NEXT3(x) ((x) == 2 ? 0 : (x) + 1)
#define SLOAD_H(Kp, Vp, Cp, k0, CI) do { S.st_v0 = load8<TIn>(ROW(Vp, k0, sr)); S.st_v1 = load8<TIn>(ROW(Vp, k0, 32 + sr));              \
                         S.st_k0 = load8<TIn>(ROW(Kp, k0, sr)); S.st_k1 = load8<TIn>(ROW(Kp, k0, 32 + sr));                 \
                         if (wid == 0) __builtin_amdgcn_global_load_lds((const unsigned*)((Cp) + (k0) + lane), (__attribute__((address_space(3))) unsigned*)(lds + LDS_CB + (CI) * 256), 4, 0, 0); } while (0)
#define SWRITE_HK(bf) do { *(bf16x8*)(K_lds + (bf) * SHM_K + kws) = S.st_k0; *(bf16x8*)(K_lds + (bf) * SHM_K + kws + 32 * 256) = S.st_k1; } while (0)
#define SWRITE_HV(bf) do { *(bf16x8*)(V_lds + (bf) * SHM_V + vst0) = S.st_v0; *(bf16x8*)(V_lds + (bf) * SHM_V + vst1) = S.st_v1; } while (0)
#define SWRITE_H(bf) do { SWRITE_HV(bf); SWRITE_HK(bf); } while (0)
#define SLOAD_F(p, k0) do { S.sf0 = *(const f32x4*)ROW(p, k0, sr); S.sf1 = *(const f32x4*)(ROW(p, k0, sr) + 4);                \
                            S.sf2 = *(const f32x4*)ROW(p, k0, 32 + sr); S.sf3 = *(const f32x4*)(ROW(p, k0, 32 + sr) + 4); } while (0)
#define SWRITE_KF(bf) do { *(bf16x8*)(K_lds + (bf) * SHM_K + kws) = pack8(S.sf0, S.sf1); *(bf16x8*)(K_lds + (bf) * SHM_K + kws + 32 * 256) = pack8(S.sf2, S.sf3); } while (0)
#define SWRITE_VF(bf) do { *(bf16x8*)(V_lds + (bf) * SHM_V + vst0) = pack8(S.sf0, S.sf1); *(bf16x8*)(V_lds + (bf) * SHM_V + vst1) = pack8(S.sf2, S.sf3); } while (0)
template <class TIn, class TOut>
__device__ __forceinline__ void causal_swa_prime(const BlockRef<TIn, TOut>& cur, int W, char* lds, Seam<TIn>& S, const int tid) {
    constexpr bool F32 = same_t<TIn, float>::v;
    const int wid = __builtin_amdgcn_readfirstlane(tid >> 6), lane = tid & 63, r32 = lane & 31, hi = lane >> 5;
    const int sr = tid >> 4, sc = (tid & 15) * 8, kws = KSWZ(sr, sc * 2); char* K_lds = lds + 2 * SHM_V;
    const int kb0 = swa_jlo(cur.P0, W) * KVBLK;
    for (int d0 = 0; d0 < 8; ++d0) S.qr[d0] = load8<TIn>(cur.Q() + (size_t)(wid * QBLK + r32) * PITCH + d0 * 16 + hi * 8);
    if constexpr (F32) { SLOAD_F((const float*)cur.K(), kb0); VMW(); SWRITE_KF(0); SBAR(); SLOAD_F((const float*)cur.V(), kb0); }
    else { S.cbi = 0; SLOAD_H(cur.K(), cur.V(), cur.C(), kb0, 0); VMW(); SWRITE_HK(0); }
    __syncthreads();
}
template <class TIn, class TOut>
__device__ __forceinline__ void causal_swa_block(const BlockRef<TIn, TOut>& cur, const BlockRef<TIn, TOut>& nxt, int skv, int W, char* lds, Seam<TIn>& S, const int tid) {
    constexpr bool F32 = same_t<TIn, float>::v;
    const int wid = __builtin_amdgcn_readfirstlane(tid >> 6), lane = tid & 63, r32 = lane & 31, hi = lane >> 5;
    const int j_lo = swa_jlo(cur.P0, W);
    int j_hi = (cur.P0 + QB - 1) / KVBLK + 1; if (j_hi > skv / KVBLK) j_hi = skv / KVBLK;
    const int NT = j_hi - j_lo;
    const int kbn = swa_jlo(nxt.P0, W) * KVBLK;
    const int qlo = cur.P0 + wid * QBLK, qm = qlo + r32 - 4 * hi;
    char* V_lds = lds; char* K_lds = lds + 2 * SHM_V;
    float* ws = (float*)(lds + 2 * SHM_V + 2 * SHM_K) + wid * 64; float* li_l = ws, * al_l = ws + 32;
    float m_reg = -1e30f, l_reg = 0; f32x16 o[4] = {};
    const int sr = tid >> 4, sc = (tid & 15) * 8, vst0 = v_st(sr, sc), vst1 = v_st(32 + sr, sc), kws = KSWZ(sr, sc * 2);
    const int vb0 = (int)(uintptr_t)V_lds + v_rd_base(lane);
    const TIn* Kh = cur.K(); const TIn* Vh = cur.V(); const float* Ch = cur.C(); int cb_t = S.cbi;
    {
        const TIn* gsrc = cur.G() + (size_t)(wid * QBLK + (lane >> 4)) * GPITCH + (lane & 15) * 8;
#pragma unroll
        for (int i_ = 0; i_ < 8; ++i_) __builtin_amdgcn_global_load_lds((const unsigned*)(gsrc + (size_t)(4 * i_) * GPITCH), (__attribute__((address_space(3))) unsigned*)(lds + LDS_GATE + wid * 8192 + i_ * 1024), 16, 0, 0); }
#define RESC(a) do { if (__any((a) < 1.f)) { if (hi == 0) al_l[r32] = (a); asm volatile("s_waitcnt lgkmcnt(0)" ::: "memory");              \
                     for (int d_ = 0; d_ < 4; ++d_) for (int r = 0; r < 16; ++r) o[d_][r] *= al_l[crow(r, hi)]; } } while (0)
#define KBASE(t) ((j_lo + (t)) * KVBLK)
#define ACT(t) (KBASE(t) <= qlo + QBLK - 1 && KBASE(t) + KVBLK - 1 >= qlo - W + 1)
#define MASKT(P0_, P1_, t) do { const int kb_ = KBASE(t); if ((!SK || ACT(t)) && (kb_ + KVBLK - 1 > qlo || kb_ <= qlo + QBLK - 1 - W)) mask_tile(P0_, P1_, qm - kb_, (unsigned)W); } while (0)
    constexpr int NQL = F32 ? 16 : 8;
    constexpr bool SK = WSKIP && !F32;
#define SEAM_K0() do { VMWN(NQL); if constexpr (F32) { SWRITE_KF(0); SBAR(); SLOAD_F((const float*)nxt.V(), kbn); } else { SWRITE_HK(0); } SBAR(); } while (0)
    f32x16 pA0, pA1, pB0, pB1; float mnA, mnB, alA, alB; bf16x8 pa0, pa1, pa2, pa3;
    if constexpr (F32) { VMW(); SWRITE_VF(0); SBAR(); } else { SWRITE_HV(0); SBAR(); }
    if (NT > 1) { if constexpr (F32) SLOAD_F((const float*)Kh, KBASE(1)); else SLOAD_H(Kh, Vh, Ch, KBASE(1), NEXT3(cb_t)); }
    SBAR(); qkt<0, SK>(pA0, pA1, K_lds, r32, hi, S.qr, ACT(0), cb_t);
    if constexpr (F32) { if (NT > 1) { VMW(); SWRITE_KF(1); SBAR(); SLOAD_F((const float*)Vh, KBASE(1)); } }
    MASKT(pA0, pA1, 0); partialSM(pA0, pA1, m_reg, mnA, alA);
    if (NT > 1) { VMW(); if constexpr (F32) { SWRITE_VF(1); SBAR(); if (NT > 2) SLOAD_F((const float*)Kh, KBASE(2)); } else SWRITE_H(1); }
    __syncthreads();
#define HALF_STEP(PX0, PX1, mnX, alX, PY0, PY1, alY, t, KB, VB, SB) do {                                                      \
        SBAR(); cb_t = NEXT3(cb_t); qkt<KB, SK>(PX0, PX1, K_lds, r32, hi, S.qr, ACT(t), cb_t);                                             \
        finishSM(PY0, PY1, alY, l_reg, pa0, pa1, pa2, pa3); SBAR();                                                           \
        if ((t) + 1 < NT) { if constexpr (F32) { VMW(); SWRITE_KF(SB); SBAR(); SLOAD_F((const float*)Vh, KBASE((t) + 1)); }  \
                            else { SLOAD_H(Kh, Vh, Ch, KBASE((t) + 1), NEXT3(cb_t)); } SBAR(); }                                               \
        pv_tile<VB, SK>(o, vb0, pa0, pa1, pa2, pa3, ACT((t) - 1)); MASKT(PX0, PX1, (t)); partialSM(PX0, PX1, m_reg, mnX, alX);                                        \
        __syncthreads();                                                                                                      \
        if ((t) + 1 < NT) { VMW(); if constexpr (F32) { SWRITE_VF(SB); SBAR(); if ((t) + 2 < NT) SLOAD_F((const float*)Kh, KBASE((t) + 2)); } \
                            else { SWRITE_H(SB); } }                                                                          \
        RESC(alX); __syncthreads(); } while (0)
    for (int t = 1; t + 1 < NT; t += 2) {
        HALF_STEP(pB0, pB1, mnB, alB, pA0, pA1, alA, t, 1, 0, 0);
        HALF_STEP(pA0, pA1, mnA, alA, pB0, pB1, alB, t + 1, 0, 1, 1);
    }
    const bool even = (NT & 1) == 0;
    if (even) { SBAR(); cb_t = NEXT3(cb_t); qkt<1, SK>(pB0, pB1, K_lds, r32, hi, S.qr, ACT(NT - 1), cb_t); SBAR(); }
#define QROW(e) (nxt.Q() + (size_t)(wid * QBLK + r32) * PITCH + ((e) >> 1) * 16 + hi * 8 + ((e) & 1) * 4)
    if constexpr (F32) { SLOAD_F((const float*)nxt.K(), kbn); SBAR();
#pragma unroll
        for (int e = 0; e < 8; ++e) S.tq[e] = *(const f32x4*)QROW(e); }
    else { SLOAD_H(nxt.K(), nxt.V(), nxt.C(), kbn, NEXT3(cb_t)); S.cbi = NEXT3(cb_t); SBAR();
#pragma unroll
        for (int d0 = 0; d0 < 8; ++d0) S.qr[d0] = load8<TIn>(nxt.Q() + (size_t)(wid * QBLK + r32) * PITCH + d0 * 16 + hi * 8); }
    SBAR();
    finishSM(pA0, pA1, alA, l_reg, pa0, pa1, pa2, pa3); SBAR();
    if constexpr (F32) {
#pragma unroll
        for (int e = 8; e < 16; ++e) S.tq[e] = *(const f32x4*)QROW(e); SBAR(); }
#undef QROW
    pv_tile<0, SK>(o, vb0, pa0, pa1, pa2, pa3, ACT(even ? NT - 2 : NT - 1));
    if (even) { MASKT(pB0, pB1, NT - 1); partialSM(pB0, pB1, m_reg, mnB, alB); __syncthreads(); RESC(alB);
        finishSM(pB0, pB1, alB, l_reg, pa0, pa1, pa2, pa3); SBAR(); pv_tile<1, SK>(o, vb0, pa0, pa1, pa2, pa3, ACT(NT - 1)); }
    SBAR(); SEAM_K0();
    if (hi == 0) li_l[r32] = l_reg; asm volatile("s_waitcnt lgkmcnt(0)" ::: "memory");
    float rli[16];
#pragma unroll
    for (int r = 0; r < 16; ++r) rli[r] = __builtin_amdgcn_rcpf(li_l[crow(r, hi)]);
    int hi_e = hi; asm volatile("" : "+v"(hi_e));
    TOut* Ow = cur.O() + (size_t)(wid * QBLK) * PITCH + (size_t)(4 * hi_e) * PITCH; const char* gl_ = lds + LDS_GATE + wid * 8192 + 4 * hi_e * 256;
#pragma unroll
    for (int r = 0; r < 16; ++r) { const int orow = (r & 3) + 8 * (r >> 2);
#pragma unroll
        for (int d0 = 0; d0 < 4; ++d0) { const float v = o[d0][r] * rli[r];
            if constexpr (same_t<TOut, float>::v) { Ow[(size_t)orow * PITCH + d0 * 32 + r32] = v; }
            else { const float vn = __shfl_xor(v, 1);
                   if ((r32 & 1) == 0) { const unsigned gw_ = *(const unsigned*)(gl_ + orow * 256 + (d0 * 32 + r32) * 2);
                       const float g0_ = __uint_as_float(gw_ << 16), g1_ = __uint_as_float(gw_ & 0xffff0000u);
                       const float s0_ = __builtin_amdgcn_rcpf(1.f + __builtin_amdgcn_exp2f(-1.4426950408889634f * g0_)), s1_ = __builtin_amdgcn_rcpf(1.f + __builtin_amdgcn_exp2f(-1.4426950408889634f * g1_));
                       *(unsigned*)(Ow + (size_t)orow * PITCH + d0 * 32 + r32) = cvtpk(v * s0_, vn * s1_); } } } }
    if constexpr (F32) {
#pragma unroll
        for (int d0 = 0; d0 < 8; ++d0) S.qr[d0] = pack8(S.tq[2 * d0], S.tq[2 * d0 + 1]); }
    __syncthreads();
#undef RESC
#undef KBASE
#undef ACT
#undef MASKT
#undef SEAM_K0
#undef HALF_STEP
}
#undef ROW
#undef VMW
#undef VMWN
#undef SLOAD_H
#undef SWRITE_HK
#undef SWRITE_HV
#undef SWRITE_H
#undef SLOAD_F
#undef SWRITE_KF
#undef SWRITE_VF

}
#ifndef RW_SOLVE_OLD
#define RW_SOLVE_OLD 0
#endif
namespace rw {
typedef short bf16x8 __attribute__((ext_vector_type(8)));
typedef float f32x4 __attribute__((ext_vector_type(4)));
typedef unsigned u32x4 __attribute__((ext_vector_type(4)));
typedef unsigned u32x2 __attribute__((ext_vector_type(2)));
#define RW_LAS __attribute__((address_space(3)))
constexpr int PB = 144, PF = 272, MB = 64 * PB;
constexpr int O_R = 0, O_K = MB, O_A = 2 * MB, O_B = 3 * MB, O_BT = 4 * MB, O_KT = 5 * MB, O_VT = 6 * MB, O_AAK = 7 * MB, O_ARB = 8 * MB, O_ARK = 9 * MB;
constexpr int O_AAB = 10 * MB, O_GT = O_AAB + 64 * PF, O_GAM = O_GT + 64 * PF, O_TOT = O_GAM + 256, O_END = O_TOT + 2048;
constexpr int O_AABB = O_END, O_TB = O_AABB + MB, O_END2 = O_TB + 4 * 768;
constexpr int O_WT = O_K, O_UT = O_AAK;
static_assert(O_END2 <= 143360, "phase A LDS map");
constexpr int REC = 32768, REC_P = 0, REC_Q = 8192, REC_H = 16384, REC_Y = 24576;
typedef float f32x2_t __attribute__((ext_vector_type(2))); typedef __bf16 bf16x2_t __attribute__((ext_vector_type(2)));
__device__ __forceinline__ unsigned cvtpk(float lo, float hi) { f32x2_t v = {lo, hi}; bf16x2_t b = __builtin_convertvector(v, bf16x2_t); return __builtin_bit_cast(unsigned, b); }
__device__ __forceinline__ float blo(unsigned w) { return __uint_as_float(w << 16); }
__device__ __forceinline__ float bhi(unsigned w) { return __uint_as_float(w & 0xffff0000u); }
__device__ __forceinline__ bf16x8 frag(const RW_LAS unsigned char* base, int tile, int ks, int lane) { return *(const RW_LAS bf16x8*)(base + (16 * tile + (lane & 15)) * PB + (ks * 32 + 8 * (lane >> 4)) * 2); }
#define RW_MFMA(a, b, c) __builtin_amdgcn_mfma_f32_16x16x32_bf16(a, b, c, 0, 0, 0)
#define RW_SYNC() __syncthreads()
#define RW_BAR() do { asm volatile("" ::: "memory"); __builtin_amdgcn_s_barrier(); asm volatile("" ::: "memory"); } while (0)

struct ChunkIn { u32x4 r, k, v, a; f32x4 l0, l1; };
__device__ __forceinline__ void load_chunk(ChunkIn& c, const unsigned char* ws, int it, int tid) {
    const int bh = it >> 8, ch = it & 255, b = bh >> 4, h = bh & 15, tok = tid >> 3, part = tid & 7;
    const size_t off = ((size_t)b * SEQ + (size_t)ch * 64 + tok) * 1024 + h * 64 + 8 * part;
    c.r = *(const u32x4*)((const unsigned short*)(ws + WS_R) + off); c.k = *(const u32x4*)((const unsigned short*)(ws + WS_K) + off); c.v = *(const u32x4*)((const unsigned short*)(ws + WS_V) + off);
    c.a = *(const u32x4*)((const unsigned short*)(ws + WS_A) + off); c.l0 = *(const f32x4*)((const float*)(ws + WS_LOGW) + off); c.l1 = *(const f32x4*)((const float*)(ws + WS_LOGW) + off + 4);
}
__device__ __forceinline__ void phase_a(RW_LAS unsigned char* L, unsigned char* ws, const float* kk_all, const float* ka_all, int wg, int G, int tid) {
    const int lane = tid & 63, w = __builtin_amdgcn_readfirstlane(tid >> 6), g = lane >> 4, l15 = lane & 15;
    ChunkIn cin; if (wg < 8192) load_chunk(cin, ws, wg, tid);
  for (int it = wg; it < 8192; it += G) {
    unsigned char* rec = ws + WS_REC + (size_t)it * REC; const float* kkw_g = kk_all + ((it >> 8) & 15) * 64; const float* kaw_g = ka_all + ((it >> 8) & 15) * 64;
    { const int tok = tid >> 3, part = tid & 7, c0 = 8 * part;
      const u32x4 rw_ = cin.r, kw_ = cin.k, vw_ = cin.v, aw_ = cin.a; const f32x4 l0 = cin.l0, l1 = cin.l1;
      float lw[8] = {l0[0], l0[1], l0[2], l0[3], l1[0], l1[1], l1[2], l1[3]}, cum[8];
#pragma unroll
      for (int i = 0; i < 8; ++i) { float v = lw[i];
          float u = __shfl_up(v, 8); if (lane >= 8) v += u; u = __shfl_up(v, 16); if (lane >= 16) v += u; u = __shfl_up(v, 32); if (lane >= 32) v += u; cum[i] = v; }
      RW_LAS float* tot = (RW_LAS float*)(L + O_TOT);
      if (lane >= 56) {
#pragma unroll
          for (int i = 0; i < 8; ++i) tot[w * 64 + c0 + i] = cum[i]; }
      RW_SYNC();
#pragma unroll
      for (int ww = 0; ww < 7; ++ww) if (ww < w) { const f32x4 a0 = *(const RW_LAS f32x4*)(tot + ww * 64 + c0), a1 = *(const RW_LAS f32x4*)(tot + ww * 64 + c0 + 4);
#pragma unroll
          for (int i = 0; i < 4; ++i) { cum[i] += a0[i]; cum[4 + i] += a1[i]; } }
      float r[8] = {blo(rw_.x), bhi(rw_.x), blo(rw_.y), bhi(rw_.y), blo(rw_.z), bhi(rw_.z), blo(rw_.w), bhi(rw_.w)};
      float k[8] = {blo(kw_.x), bhi(kw_.x), blo(kw_.y), bhi(kw_.y), blo(kw_.z), bhi(kw_.z), blo(kw_.w), bhi(kw_.w)};
      float a[8] = {blo(aw_.x), bhi(aw_.x), blo(aw_.y), bhi(aw_.y), blo(aw_.z), bhi(aw_.z), blo(aw_.w), bhi(aw_.w)};
      const f32x4 kk0 = *(const f32x4*)(kkw_g + c0), kk1 = *(const f32x4*)(kkw_g + c0 + 4), ka0 = *(const f32x4*)(kaw_g + c0), ka1 = *(const f32x4*)(kaw_g + c0 + 4);
      float kk[8], ss = 0.f;
#pragma unroll
      for (int i = 0; i < 8; ++i) { kk[i] = k[i] * (i < 4 ? kk0[i] : kk1[i - 4]); ss += kk[i] * kk[i]; }
      ss += __shfl_xor(ss, 1); ss += __shfl_xor(ss, 2); ss += __shfl_xor(ss, 4);
      const float inv = 1.f / fmaxf(sqrtf(ss), 1e-12f);
      float Rt[8], Kt[8], At[8], Bt[8];
#pragma unroll
      for (int i = 0; i < 8; ++i) { const float eL = __expf(cum[i]), eLi = __expf(-cum[i]), eLx = __expf(cum[i] - lw[i]); const float kn = kk[i] * inv;
          Rt[i] = r[i] * eL; Kt[i] = k[i] * (1.f + (a[i] - 1.f) * (i < 4 ? ka0[i] : ka1[i - 4])) * eLi; At[i] = -kn * eLx; Bt[i] = kn * a[i] * eLi;
          if (tok == 63) ((RW_LAS float*)(L + O_GAM))[c0 + i] = eL; }
      u32x4 o;
      o.x = cvtpk(Rt[0], Rt[1]); o.y = cvtpk(Rt[2], Rt[3]); o.z = cvtpk(Rt[4], Rt[5]); o.w = cvtpk(Rt[6], Rt[7]); *(RW_LAS u32x4*)(L + O_R + tok * PB + c0 * 2) = o;
      o.x = cvtpk(Kt[0], Kt[1]); o.y = cvtpk(Kt[2], Kt[3]); o.z = cvtpk(Kt[4], Kt[5]); o.w = cvtpk(Kt[6], Kt[7]); *(RW_LAS u32x4*)(L + O_K + tok * PB + c0 * 2) = o;
      const u32x4 kq = o;
      o.x = cvtpk(At[0], At[1]); o.y = cvtpk(At[2], At[3]); o.z = cvtpk(At[4], At[5]); o.w = cvtpk(At[6], At[7]); *(RW_LAS u32x4*)(L + O_A + tok * PB + c0 * 2) = o;
      o.x = cvtpk(Bt[0], Bt[1]); o.y = cvtpk(Bt[2], Bt[3]); o.z = cvtpk(Bt[4], Bt[5]); o.w = cvtpk(Bt[6], Bt[7]); *(RW_LAS u32x4*)(L + O_B + tok * PB + c0 * 2) = o;
      const unsigned bq[4] = {o.x, o.y, o.z, o.w}, kq4[4] = {kq.x, kq.y, kq.z, kq.w}, vq[4] = {vw_.x, vw_.y, vw_.z, vw_.w};
#pragma unroll
      for (int i = 0; i < 8; ++i) { const int sh = (i & 1) * 16;
          *(RW_LAS unsigned short*)(L + O_BT + (c0 + i) * PB + tok * 2) = (unsigned short)(bq[i >> 1] >> sh);
          *(RW_LAS unsigned short*)(L + O_KT + (c0 + i) * PB + tok * 2) = (unsigned short)(kq4[i >> 1] >> sh);
          *(RW_LAS unsigned short*)(L + O_VT + (c0 + i) * PB + tok * 2) = (unsigned short)(vq[i >> 1] >> sh); }
    }
    if (it + G < 8192) load_chunk(cin, ws, it + G, tid);
    RW_SYNC();
    const int t4 = w & 3, p2 = (w >> 2) * 2;
    { const bf16x8 b0 = frag(L + O_B, t4, 0, lane), b1 = frag(L + O_B, t4, 1, lane), k0 = frag(L + O_K, t4, 0, lane), k1 = frag(L + O_K, t4, 1, lane);
#pragma unroll
      for (int u = 0; u < 2; ++u) { const int nt = p2 + u, t = 16 * nt + l15, s0 = 16 * t4 + 4 * g;
          f32x4 ab = {0.f, 0.f, 0.f, 0.f}, ak = ab, rb = ab, rk = ab;
          if (t4 <= nt) { const bf16x8 a0 = frag(L + O_A, nt, 0, lane), a1 = frag(L + O_A, nt, 1, lane), r0 = frag(L + O_R, nt, 0, lane), r1 = frag(L + O_R, nt, 1, lane);
              ab = RW_MFMA(b0, a0, ab); ab = RW_MFMA(b1, a1, ab); ak = RW_MFMA(k0, a0, ak); ak = RW_MFMA(k1, a1, ak);
              rb = RW_MFMA(b0, r0, rb); rb = RW_MFMA(b1, r1, rb); rk = RW_MFMA(k0, r0, rk); rk = RW_MFMA(k1, r1, rk);
#pragma unroll
              for (int r = 0; r < 4; ++r) { const int s = s0 + r; if (!(s < t)) { ab[r] = 0.f; ak[r] = 0.f; } if (!(s <= t)) { rb[r] = 0.f; rk[r] = 0.f; } } }
          *(RW_LAS f32x4*)(L + O_AAB + t * PF + s0 * 4) = ab;
          u32x2 o; o.x = cvtpk(ab[0], ab[1]); o.y = cvtpk(ab[2], ab[3]); *(RW_LAS u32x2*)(L + O_AABB + t * PB + s0 * 2) = o;
          o.x = cvtpk(ak[0], ak[1]); o.y = cvtpk(ak[2], ak[3]); *(RW_LAS u32x2*)(L + O_AAK + t * PB + s0 * 2) = o;
          o.x = cvtpk(rb[0], rb[1]); o.y = cvtpk(rb[2], rb[3]); *(RW_LAS u32x2*)(L + O_ARB + t * PB + s0 * 2) = o;
          o.x = cvtpk(rk[0], rk[1]); o.y = cvtpk(rk[2], rk[3]); *(RW_LAS u32x2*)(L + O_ARK + t * PB + s0 * 2) = o; } }
    RW_SYNC();
    { const bf16x8 a0 = frag(L + O_AAK, t4, 0, lane), a1 = frag(L + O_AAK, t4, 1, lane);
#pragma unroll
      for (int u = 0; u < 2; ++u) { const int nt = p2 + u; f32x4 acc = {0.f, 0.f, 0.f, 0.f};
          acc = RW_MFMA(a0, frag(L + O_VT, nt, 0, lane), acc); acc = RW_MFMA(a1, frag(L + O_VT, nt, 1, lane), acc);
          *(RW_LAS f32x4*)(L + O_GT + (16 * nt + l15) * PF + (16 * t4 + 4 * g) * 4) = acc; } }
    if (w < 4 && lane < 16) {
        float x[16]; const RW_LAS unsigned char* ab = L + O_AAB + 16 * w * PF + 16 * w * 4;
#pragma unroll
        for (int r = 0; r < 16; ++r) { float a0 = (r == lane) ? 1.f : 0.f, a1 = 0.f;
#pragma unroll
            for (int q4 = 0; q4 < (r + 3) / 4; ++q4) { const f32x4 av = *(const RW_LAS f32x4*)(ab + r * PF + q4 * 16);
                if (4 * q4 + 0 < r) a0 += av[0] * x[4 * q4 + 0]; if (4 * q4 + 1 < r) a1 += av[1] * x[4 * q4 + 1]; if (4 * q4 + 2 < r) a0 += av[2] * x[4 * q4 + 2]; if (4 * q4 + 3 < r) a1 += av[3] * x[4 * q4 + 3]; }
            x[r] = a0 + a1; *(RW_LAS unsigned short*)(L + O_TB + w * 768 + r * 48 + lane * 2) = (unsigned short)(cvtpk(x[r], 0.f) & 0xffffu); } }
    RW_SYNC();
#if RW_SOLVE_OLD
    if (tid < 128) { const int c = tid;
        const RW_LAS unsigned char* rhs = c < 64 ? (L + O_A + c * 2) : (L + O_GT + (c - 64) * PF);
        RW_LAS unsigned char* dst = c < 64 ? (L + O_WT + c * PB) : (L + O_UT + (c - 64) * PB);
        for (int b = 0; b < 4; ++b) { float z[16];
#pragma unroll
            for (int r = 0; r < 16; ++r) z[r] = c < 64 ? blo((unsigned)*(const RW_LAS unsigned short*)(rhs + (16 * b + r) * PB)) : *(const RW_LAS float*)(rhs + (16 * b + r) * 4);
            const RW_LAS unsigned char* arow = L + O_AAB + 16 * b * PF;
            for (int s4 = 0; s4 < 4 * b; ++s4) { const u32x2 xw = *(const RW_LAS u32x2*)(dst + s4 * 8); const float x0 = blo(xw.x), x1 = bhi(xw.x), x2 = blo(xw.y), x3 = bhi(xw.y);
#pragma unroll
                for (int r = 0; r < 16; ++r) { const f32x4 av = *(const RW_LAS f32x4*)(arow + r * PF + s4 * 16); z[r] += (av[0] * x0 + av[1] * x1) + (av[2] * x2 + av[3] * x3); } }
#pragma unroll
            for (int r = 1; r < 16; ++r) {
#pragma unroll
                for (int q4 = 0; q4 < (r + 3) / 4; ++q4) { const f32x4 av = *(const RW_LAS f32x4*)(arow + r * PF + (4 * b + q4) * 16);
                    if (4 * q4 + 0 < r) z[r] += av[0] * z[4 * q4 + 0]; if (4 * q4 + 1 < r) z[r] += av[1] * z[4 * q4 + 1]; if (4 * q4 + 2 < r) z[r] += av[2] * z[4 * q4 + 2]; if (4 * q4 + 3 < r) z[r] += av[3] * z[4 * q4 + 3]; } }
            u32x4 o; o.x = cvtpk(z[0], z[1]); o.y = cvtpk(z[2], z[3]); o.z = cvtpk(z[4], z[5]); o.w = cvtpk(z[6], z[7]); *(RW_LAS u32x4*)(dst + 32 * b) = o;
            o.x = cvtpk(z[8], z[9]); o.y = cvtpk(z[10], z[11]); o.z = cvtpk(z[12], z[13]); o.w = cvtpk(z[14], z[15]); *(RW_LAS u32x4*)(dst + 32 * b + 16) = o;
            asm volatile("s_waitcnt lgkmcnt(0)" ::: "memory"); } }
    RW_SYNC();
#else
    { RW_LAS unsigned char* xt = (w < 4 ? L + O_WT : L + O_UT) + (w & 3) * 16 * PB;
      { const u32x4 z4 = {0u, 0u, 0u, 0u}; *(RW_LAS u32x4*)(xt + l15 * PB + g * 16) = z4; *(RW_LAS u32x4*)(xt + l15 * PB + 64 + g * 16) = z4; }
      asm volatile("s_waitcnt lgkmcnt(0)" ::: "memory");
#pragma unroll
      for (int b = 0; b < 4; ++b) { f32x4 z;
          if (w < 4) { const RW_LAS unsigned char* ap = L + O_A + (16 * b + 4 * g) * PB + (16 * w + l15) * 2;
              z = (f32x4){blo((unsigned)*(const RW_LAS unsigned short*)(ap)), blo((unsigned)*(const RW_LAS unsigned short*)(ap + PB)), blo((unsigned)*(const RW_LAS unsigned short*)(ap + 2 * PB)), blo((unsigned)*(const RW_LAS unsigned short*)(ap + 3 * PB))}; }
          else z = *(const RW_LAS f32x4*)(L + O_GT + (16 * (w - 4) + l15) * PF + (16 * b + 4 * g) * 4);
          if (b > 0) { z = RW_MFMA(frag(L + O_AABB, b, 0, lane), *(const RW_LAS bf16x8*)(xt + l15 * PB + (8 * g) * 2), z);
                       if (b > 2) z = RW_MFMA(frag(L + O_AABB, b, 1, lane), *(const RW_LAS bf16x8*)(xt + l15 * PB + (32 + 8 * g) * 2), z); }
          const u32x2 tw = *(const RW_LAS u32x2*)(L + O_TB + b * 768 + l15 * 48 + (4 * g) * 2);
          const u32x4 tf = {tw.x, tw.y, 0u, 0u}, zf = {cvtpk(z[0], z[1]), cvtpk(z[2], z[3]), 0u, 0u};
          f32x4 xb = {0.f, 0.f, 0.f, 0.f}; xb = RW_MFMA(__builtin_bit_cast(bf16x8, tf), __builtin_bit_cast(bf16x8, zf), xb);
          u32x2 o; o.x = cvtpk(xb[0], xb[1]); o.y = cvtpk(xb[2], xb[3]); *(RW_LAS u32x2*)(xt + l15 * PB + (16 * b + 4 * g) * 2) = o;
          asm volatile("s_waitcnt lgkmcnt(0)" ::: "memory"); } }
    RW_SYNC();
#endif
    {
      const bf16x8 rb0 = frag(L + O_ARB, t4, 0, lane), rb1 = frag(L + O_ARB, t4, 1, lane), bt0 = frag(L + O_BT, t4, 0, lane), bt1 = frag(L + O_BT, t4, 1, lane);
      const int col = 16 * t4 + l15; const float gam = ((const RW_LAS float*)(L + O_GAM))[col];
      unsigned qw[4], pw[4];
#pragma unroll
      for (int u = 0; u < 2; ++u) { const int mt = p2 + u, j0 = 16 * mt + 4 * g; const bf16x8 w0 = frag(L + O_WT, mt, 0, lane), w1 = frag(L + O_WT, mt, 1, lane);
          f32x4 q = {0.f, 0.f, 0.f, 0.f}, p = q; q = RW_MFMA(w0, rb0, q); q = RW_MFMA(w1, rb1, q); p = RW_MFMA(w0, bt0, p); p = RW_MFMA(w1, bt1, p);
          const u32x2 rr = *(const RW_LAS u32x2*)(L + O_R + col * PB + j0 * 2);
          q[0] += blo(rr.x); q[1] += bhi(rr.x); q[2] += blo(rr.y); q[3] += bhi(rr.y);
#pragma unroll
          for (int r = 0; r < 4; ++r) p[r] = (p[r] + ((j0 + r) == col ? 1.f : 0.f)) * gam;
          qw[2 * u] = cvtpk(q[0], q[1]); qw[2 * u + 1] = cvtpk(q[2], q[3]); pw[2 * u] = cvtpk(p[0], p[1]); pw[2 * u + 1] = cvtpk(p[2], p[3]); }
      const int fo = ((t4 * 2 + (p2 >> 1)) * 64 + lane) * 16;
      *(u32x4*)(rec + REC_Q + fo) = (u32x4){qw[0], qw[1], qw[2], qw[3]}; *(u32x4*)(rec + REC_P + fo) = (u32x4){pw[0], pw[1], pw[2], pw[3]}; }
    {
      const bf16x8 rb0 = frag(L + O_ARB, t4, 0, lane), rb1 = frag(L + O_ARB, t4, 1, lane), rk0 = frag(L + O_ARK, t4, 0, lane), rk1 = frag(L + O_ARK, t4, 1, lane);
      const bf16x8 ut0 = frag(L + O_UT, t4, 0, lane), ut1 = frag(L + O_UT, t4, 1, lane), vt0 = frag(L + O_VT, t4, 0, lane), vt1 = frag(L + O_VT, t4, 1, lane);
      const int col = 16 * t4 + l15;
#pragma unroll
      for (int u = 0; u < 2; ++u) { const int mt = p2 + u, m0 = 16 * mt + 4 * g;
          f32x4 y = {0.f, 0.f, 0.f, 0.f}, hm = y;
          y = RW_MFMA(frag(L + O_UT, mt, 0, lane), rb0, y); y = RW_MFMA(frag(L + O_UT, mt, 1, lane), rb1, y); y = RW_MFMA(frag(L + O_VT, mt, 0, lane), rk0, y); y = RW_MFMA(frag(L + O_VT, mt, 1, lane), rk1, y);
          hm = RW_MFMA(frag(L + O_BT, mt, 0, lane), ut0, hm); hm = RW_MFMA(frag(L + O_BT, mt, 1, lane), ut1, hm); hm = RW_MFMA(frag(L + O_KT, mt, 0, lane), vt0, hm); hm = RW_MFMA(frag(L + O_KT, mt, 1, lane), vt1, hm);
          const f32x4 gm = *(const RW_LAS f32x4*)(L + O_GAM + m0 * 4);
          u32x2 o; o.x = cvtpk(y[0], y[1]); o.y = cvtpk(y[2], y[3]); *(u32x2*)(rec + REC_Y + (col * 64 + m0) * 2) = o;
          o.x = cvtpk(hm[0] * gm[0], hm[1] * gm[1]); o.y = cvtpk(hm[2] * gm[2], hm[3] * gm[3]); *(u32x2*)(rec + REC_H + (col * 64 + m0) * 2) = o; } }
    RW_SYNC();
  }
}

__device__ __forceinline__ void phase_b_head(RW_LAS unsigned char* L, const unsigned char* recs, float* Yg, int tid) {
    constexpr int NCH = 256, NSLOT = 4;
    const int lane = tid & 63, w = __builtin_amdgcn_readfirstlane(tid >> 6), g = lane >> 4, l15 = lane & 15;
    if (w >= 4) {
        const int lw = w - 4; const unsigned char* src = recs + lw * 8192 + lane * 16;
#define RW_ISSUE(c_) do { _Pragma("unroll") for (int k_ = 0; k_ < 8; ++k_) __builtin_amdgcn_global_load_lds((const unsigned*)(src + (size_t)(c_) * REC + k_ * 1024), (RW_LAS unsigned*)(L + ((c_) & 3) * REC + lw * 8192 + k_ * 1024), 16, 0, 0); } while (0)
        RW_ISSUE(0); RW_ISSUE(1); RW_ISSUE(2);
        asm volatile("s_waitcnt vmcnt(16)" ::: "memory");
        RW_BAR();
        for (int c = 0; c < NCH; ++c) {
            if (c + 3 < NCH) { RW_ISSUE(c + 3); asm volatile("s_waitcnt vmcnt(16)" ::: "memory"); }
            else asm volatile("s_waitcnt vmcnt(0)" ::: "memory");
            RW_BAR();
        }
#undef RW_ISSUE
    } else {
        f32x4 sacc[4];
#pragma unroll
        for (int m = 0; m < 4; ++m) sacc[m] = (f32x4){0.f, 0.f, 0.f, 0.f};
        RW_BAR();
        for (int c = 0; c < NCH; ++c) { const RW_LAS unsigned char* sl = L + (c & 3) * REC;
            bf16x8 bf[2];
#pragma unroll
            for (int s = 0; s < 2; ++s) { u32x4 v; v.x = cvtpk(sacc[2 * s][0], sacc[2 * s][1]); v.y = cvtpk(sacc[2 * s][2], sacc[2 * s][3]); v.z = cvtpk(sacc[2 * s + 1][0], sacc[2 * s + 1][1]); v.w = cvtpk(sacc[2 * s + 1][2], sacc[2 * s + 1][3]); bf[s] = __builtin_bit_cast(bf16x8, v); }
            f32x4 sn[4];
#pragma unroll
            for (int m = 0; m < 4; ++m) { const u32x2 hw = *(const RW_LAS u32x2*)(sl + REC_H + ((16 * w + l15) * 64 + 16 * m + 4 * g) * 2);
                f32x4 acc = {blo(hw.x), bhi(hw.x), blo(hw.y), bhi(hw.y)};
                acc = RW_MFMA(*(const RW_LAS bf16x8*)(sl + REC_P + ((m * 2 + 0) * 64 + lane) * 16), bf[0], acc);
                acc = RW_MFMA(*(const RW_LAS bf16x8*)(sl + REC_P + ((m * 2 + 1) * 64 + lane) * 16), bf[1], acc); sn[m] = acc; }
#pragma unroll
            for (int n = 0; n < 4; ++n) { const u32x2 yw = *(const RW_LAS u32x2*)(sl + REC_Y + ((16 * n + l15) * 64 + 16 * w + 4 * g) * 2);
                f32x4 acc = {blo(yw.x), bhi(yw.x), blo(yw.y), bhi(yw.y)};
                acc = RW_MFMA(bf[0], *(const RW_LAS bf16x8*)(sl + REC_Q + ((n * 2 + 0) * 64 + lane) * 16), acc);
                acc = RW_MFMA(bf[1], *(const RW_LAS bf16x8*)(sl + REC_Q + ((n * 2 + 1) * 64 + lane) * 16), acc);
                *(f32x4*)(Yg + (size_t)(c * 64 + 16 * n + l15) * 1024 + 16 * w + 4 * g) = acc; }
#pragma unroll
            for (int m = 0; m < 4; ++m) sacc[m] = sn[m];
            asm volatile("s_waitcnt lgkmcnt(0)" ::: "memory");
            RW_BAR();
        }
    }
}
}
#define XB_TMO      128
#define XB_XCNT(j)  (256  + 64 * (j))
#define XB_XSUB(j)  (1280 + 64 * (j))
#define XB_XGEN(j)  (2304 + 64 * (j))
#define XB_TOP      3328
#define XB_TOPGEN   3392
#define XCD_BAR_WORDS 3456
#define XB_SPIN_CAP (1u << 18)

__device__ __forceinline__ unsigned xb_ld(unsigned* p)              { return __hip_atomic_load(p, __ATOMIC_RELAXED, __HIP_MEMORY_SCOPE_AGENT); }
__device__ __forceinline__ unsigned xb_add(unsigned* p, unsigned v) { return __hip_atomic_fetch_add(p, v, __ATOMIC_RELAXED, __HIP_MEMORY_SCOPE_AGENT); }
__device__ __forceinline__ unsigned xb_xcc_id() { return (unsigned)__builtin_amdgcn_s_getreg((3 << 11) | 20) & 0xFu; }
#define XB_SPIN(cond, bar) do { unsigned _sp = 0; while (cond) { __builtin_amdgcn_s_sleep(1); \
    if ((++_sp & 255u) == 0u) { if (xb_ld(&(bar)[XB_TMO])) break; if (_sp > XB_SPIN_CAP) { atomicAdd(&(bar)[XB_TMO], 1u); break; } } } } while (0)

struct XcdBarrier {
    unsigned* bar; unsigned x;
    volatile LAS unsigned* st;
};

__device__ __forceinline__ XcdBarrier xcd_barrier_post(unsigned* bar, volatile LAS unsigned* st, const int tid) {
    XcdBarrier b; b.bar = bar; b.x = xb_xcc_id(); b.st = st;
    if (tid == 0) (void)xb_add(&bar[XB_XCNT(b.x)], 1u);
    return b;
}
__device__ __forceinline__ void xcd_barrier_complete(unsigned* bar, unsigned x, unsigned& nloc, unsigned& nx) {
    const unsigned G = gridDim.x * gridDim.y * gridDim.z;
    unsigned sum, cnt, mine, sp = 0u;
    for (;;) {
        sum = 0u; cnt = 0u; mine = 0u;
#pragma unroll
        for (unsigned j = 0; j < 16; ++j) { const unsigned c = xb_ld(&bar[XB_XCNT(j)]); sum += c; cnt += (c > 0u) ? 1u : 0u; mine = (j == x) ? c : mine; }
        if (sum == G) break;
        __builtin_amdgcn_s_sleep(1);
        if ((++sp & 255u) == 0u) { if (xb_ld(&bar[XB_TMO])) break; if (sp > XB_SPIN_CAP) { atomicAdd(&bar[XB_TMO], 1u); break; } }
    }
    nloc = mine > 0u ? mine : 1u; nx = cnt > 0u ? cnt : 1u;
}

__device__ __forceinline__ void xcd_barrier(const XcdBarrier& b, const int tid) {
    asm volatile("s_waitcnt vmcnt(0)" ::: "memory");
    __syncthreads();
    if (tid == 0) {
        unsigned* bar = b.bar;
        __builtin_amdgcn_s_waitcnt(0);
        unsigned nloc = b.st[0], nx = b.st[1];
        if (nloc == 0u) { xcd_barrier_complete(bar, b.x, nloc, nx); b.st[0] = nloc; b.st[1] = nx; }
        const unsigned old = xb_add(&bar[XB_XSUB(b.x)], 1u);
        const unsigned gen = old / nloc;
        if (old + 1u == (gen + 1u) * nloc) {
            __builtin_amdgcn_fence(__ATOMIC_RELEASE, "agent");
            asm volatile("s_waitcnt vmcnt(0)" ::: "memory");
            const unsigned og = xb_add(&bar[XB_TOP], 1u);
            const unsigned tg = og / nx;
            if (og + 1u == (tg + 1u) * nx) xb_add(&bar[XB_TOPGEN], 1u);
            else XB_SPIN(xb_ld(&bar[XB_TOPGEN]) == tg, bar);
            __builtin_amdgcn_fence(__ATOMIC_ACQUIRE, "agent");
            xb_add(&bar[XB_XGEN(b.x)], 1u);
            asm volatile("s_waitcnt vmcnt(0)" ::: "memory");
        } else {
            XB_SPIN(xb_ld(&bar[XB_XGEN(b.x)]) == gen, bar);
            __builtin_amdgcn_fence(__ATOMIC_ACQUIRE, "agent");
            asm volatile("s_waitcnt vmcnt(0)" ::: "memory");
        }
    }
    __syncthreads();
}
enum InIdx { I_X = 0, I_C, I_WADA, I_BADA, I_N1G, I_WIN, I_MU, I_WDEC, I_W0, I_WICLR, I_A0, I_WGATE, I_KK, I_KA, I_RK, I_GNG, I_GNB, I_WOA, I_BF, I_QN, I_KN, I_WOB, I_WOUT, I_N2G, I_WR, I_BR, I_WGU, I_BGU, I_WDN, I_BDN, I_NFG, N_IN };
struct Args { const float* in[N_IN]; float* out; unsigned char* ws; int ph_lo, ph_hi; };
static_assert(sizeof(Args) == (N_IN + 2) * 8 + 8, "Args has no padding");
typedef const __attribute__((address_space(4))) Args* ArgsP;
struct Frame {
    LAS unsigned char* lds;
    volatile LAS unsigned* MISC;
    gu32* ctl;
    int tid, lane, wave, G, wg;
    unsigned char* ws;
    ArgsP ap;
};
#define WSP(T_, off) ((T_*)(F.ws + (off)))

__device__ __forceinline__ int win_orig_col(int c) {
    if (c < PC_FQ) return c;
    if (c < PC_OG) return 3520 + (c - PC_FQ);
    if (c < PC_GA) return 6600 + (c - PC_OG);
    if (c < PC_GLO) return 7624 + (c - PC_GA);
    if (c < PC_DLO) return 3264 + (c - PC_GLO);
    if (c < PC_ALO) return 3072 + (c - PC_DLO);
    if (c < PC_F) return 3168 + (c - PC_ALO);
    if (c < PC_END) return 6592 + (c - PC_F);
    return -1;
}
__device__ __forceinline__ void tr_item(const float* W, int ldw, int K, bf16* WT, int drow0, int scol0, int nvalid, int k0, LAS float* scr, int lane) {
    const int n = lane & 31;
#pragma unroll 8
    for (int i = 0; i < 32; ++i) { const int kk = 2 * i + (lane >> 5); scr[kk * 33 + n] = (n < nvalid) ? W[(size_t)(k0 + kk) * ldw + scol0 + n] : 0.f; }
    LDS_WAIT(); asm volatile("" ::: "memory");
    const int c = lane & 7;
#pragma unroll
    for (int j = 0; j < 4; ++j) { const int nn = (lane >> 3) + 8 * j; const LAS float* s = scr + (8 * c) * 33 + nn;
        v4u o; o.x = pk2(s[0 * 33], s[1 * 33]); o.y = pk2(s[2 * 33], s[3 * 33]); o.z = pk2(s[4 * 33], s[5 * 33]); o.w = pk2(s[6 * 33], s[7 * 33]);
        *(GAS v4u*)(WT + (size_t)(drow0 + nn) * K + k0 + 8 * c) = o; }
    LDS_WAIT(); asm volatile("" ::: "memory");
}
__device__ __forceinline__ unsigned pk4_fp8(float a, float b, float c, float d) { int w = __builtin_amdgcn_cvt_pk_fp8_f32(a, b, 0, false); w = __builtin_amdgcn_cvt_pk_fp8_f32(c, d, w, true); return (unsigned)w; }
__device__ __forceinline__ void tr_item8(const float* W, int ldw, int K, unsigned char* WT, int drow0, int scol0, int nvalid, int k0, float scale, LAS float* scr, int lane) {
    const int n = lane & 31;
#pragma unroll 8
    for (int i = 0; i < 32; ++i) { const int kk = 2 * i + (lane >> 5); scr[kk * 33 + n] = (n < nvalid) ? W[(size_t)(k0 + kk) * ldw + scol0 + n] * scale : 0.f; }
    LDS_WAIT(); asm volatile("" ::: "memory");
    const int c = lane & 7;
#pragma unroll
    for (int j = 0; j < 4; ++j) { const int nn = (lane >> 3) + 8 * j; const LAS float* s = scr + (8 * c) * 33 + nn;
        v2u o; o.x = pk4_fp8(s[0 * 33], s[1 * 33], s[2 * 33], s[3 * 33]); o.y = pk4_fp8(s[4 * 33], s[5 * 33], s[6 * 33], s[7 * 33]);
        *(GAS v2u*)(WT + (size_t)(drow0 + nn) * K + k0 + 8 * c) = o; }
    LDS_WAIT(); asm volatile("" ::: "memory");
}
struct ConvItem { const float* src; unsigned char* dst; int ldw; };
__device__ __forceinline__ ConvItem conv_item(Frame& F, int it) {
    constexpr int I_GU = NE * 32 * 128; ConvItem c;
    if (it < I_GU) { const int e = it / (32 * 128), q = it % (32 * 128), kb = q / 128, gp = q % 128, d0 = gp * 32, pn = d0 >> 8, j = d0 & 255, sc = j < 128 ? 128 * pn + j : 2048 + 128 * pn + (j - 128);
        c.src = F.ap->in[I_WGU] + (size_t)e * 2048 * 4096 + (size_t)(kb * 64) * 4096 + sc; c.dst = WSP(unsigned char, WS_WGU) + (size_t)e * 4096 * 2048 + (size_t)d0 * 2048 + kb * 64; c.ldw = 4096; }
    else { const int r = it - I_GU, e = r / (32 * 64), q = r % (32 * 64), kb = q / 64, gp = q % 64;
        c.src = F.ap->in[I_WDN] + (size_t)e * 2048 * 2048 + (size_t)(kb * 64) * 2048 + gp * 32; c.dst = WSP(unsigned char, WS_WDN) + (size_t)e * 2048 * 2048 + (size_t)(gp * 32) * 2048 + kb * 64; c.ldw = 2048; }
    return c;
}
__device__ __forceinline__ void convert_experts(Frame& F, int rank, int nranks) {
    constexpr int NIT = NE * 32 * 128 + NE * 32 * 64;
    LAS float* scr = (LAS float*)(F.lds + RING_OFF + F.wave * 16384);
    const int lane = F.lane, gw = rank * NWAVES + F.wave, NGW = nranks * NWAVES, c4 = lane & 7, r8 = lane >> 3;
    f32x4 cur[8], n1[8], n2[8]; ConvItem ci, c1, c2;
#define CONV_LOAD(dst, cc, it_) do { cc = conv_item(F, it_); _Pragma("unroll") for (int j = 0; j < 8; ++j) dst[j] = __builtin_nontemporal_load((const f32x4*)(cc.src + (size_t)(r8 + 8 * j) * cc.ldw + 4 * c4)); } while (0)
    if (gw < NIT) CONV_LOAD(cur, ci, gw);
    if (gw + NGW < NIT) CONV_LOAD(n1, c1, gw + NGW);
    for (int it = gw; it < NIT; it += NGW) {
        if (it + 2 * NGW < NIT) CONV_LOAD(n2, c2, it + 2 * NGW);
#pragma unroll
        for (int j = 0; j < 8; ++j) { LAS float* s = scr + (r8 + 8 * j) * 33 + 4 * c4; s[0] = cur[j].x * FP8_SW; s[1] = cur[j].y * FP8_SW; s[2] = cur[j].z * FP8_SW; s[3] = cur[j].w * FP8_SW; }
        LDS_WAIT(); asm volatile("" ::: "memory");
#pragma unroll
        for (int j = 0; j < 4; ++j) { const int nn = r8 + 8 * j; const LAS float* s = scr + (8 * c4) * 33 + nn;
            v2u o; o.x = pk4_fp8(s[0 * 33], s[1 * 33], s[2 * 33], s[3 * 33]); o.y = pk4_fp8(s[4 * 33], s[5 * 33], s[6 * 33], s[7 * 33]);
            __builtin_nontemporal_store(o, (v2u*)(ci.dst + (size_t)nn * 2048 + 8 * c4)); }
        LDS_WAIT(); asm volatile("" ::: "memory");
        ci = c1; c1 = c2;
#pragma unroll
        for (int j = 0; j < 8; ++j) { cur[j] = n1[j]; n1[j] = n2[j]; }
    }
#undef CONV_LOAD
}
__device__ __forceinline__ void p0_prologue(Frame& F) {
    LAS float* scr = (LAS float*)(F.lds + RING_OFF + F.wave * 16384);
    const int gw = F.wg * NWAVES + F.wave, NGW = F.G * NWAVES, lane = F.lane;
    constexpr int I_IN = 32 * 368, I_OA = 16 * 64, I_OB = I_OA, I_OUT = 32 * 64;
    constexpr int NITEMS = I_IN + I_OA + I_OB + I_OUT;
    for (int it = gw; it < NITEMS; it += NGW) {
        int r = it;
        if (r < I_IN) { const int kb = r / 368, gp = r % 368, c0 = gp * 32, oc = win_orig_col(c0); int nv = 32; if (oc < 0) nv = 0; else if (c0 + 32 > PC_END) nv = PC_END - c0;
#if INPROJ_FP8
            tr_item8(F.ap->in[I_WIN], 11720, 2048, WSP(unsigned char, WS_WIN), c0, oc < 0 ? 0 : oc, nv, kb * 64, FP8_SW, scr, lane); continue; } r -= I_IN;
#else
            tr_item(F.ap->in[I_WIN], 11720, 2048, WSP(bf16, WS_WIN), c0, oc < 0 ? 0 : oc, nv, kb * 64, scr, lane); continue; } r -= I_IN;
#endif
        if (r < I_OA) { tr_item(F.ap->in[I_WOA], 2048, 1024, WSP(bf16, WS_WOA), (r % 64) * 32, (r % 64) * 32, 32, (r / 64) * 64, scr, lane); continue; } r -= I_OA;
        if (r < I_OB) { tr_item(F.ap->in[I_WOB], 2048, 1024, WSP(bf16, WS_WOB), (r % 64) * 32, (r % 64) * 32, 32, (r / 64) * 64, scr, lane); continue; } r -= I_OB;
        { tr_item(F.ap->in[I_WOUT], 2048, 2048, WSP(bf16, WS_WOUT), (r % 64) * 32, (r % 64) * 32, 32, (r / 64) * 64, scr, lane); }
    }
    const int gt = F.wg * (NWAVES * 64) + F.tid, NGT = F.G * NWAVES * 64;
    { bf16* b1 = WSP(bf16, WS_BT1); const float* wd = F.ap->in[I_WDEC]; const float* wi = F.ap->in[I_WICLR];
      for (int i = gt; i < 2048 * 256; i += NGT) { const int n = i >> 8, k = i & 255; float v = 0.f;
          if (n < 1024) { if (k < 96) v = wd[k * 1024 + n]; } else { if (k >= 128 && k < 224) v = wi[(k - 128) * 1024 + (n - 1024)]; }
          b1[i] = (bf16)f2bf(v); } }
    { bf16* b2 = WSP(bf16, WS_BT2); const float* wg = F.ap->in[I_WGATE];
      for (int i = gt; i < 1024 * 256; i += NGT) { const int n = i >> 8, k = i & 255; b2[i] = (bf16)f2bf(wg[k * 1024 + n]); } }
    { float* wrt = WSP(float, WS_WRT); const float* wr = F.ap->in[I_WR];
      for (int i = gt; i < 32 * 2048; i += NGT) { const int e = i >> 11, k = i & 2047; wrt[i] = wr[k * 32 + e]; } }
    { bf16* h = WSP(bf16, WS_H) + (size_t)T * DM; for (int i = gt; i < DM; i += NGT) h[i] = 0; }
    if (F.wg < 192) {
        const float* wa = F.ap->in[I_WADA]; const float* cc = F.ap->in[I_C]; const int n = F.wg * 64 + lane;
        float s0 = 0.f, s1 = 0.f;
        for (int k = F.wave * 256; k < F.wave * 256 + 256; ++k) { const float w = wa[(size_t)k * 12288 + n]; const float c0 = cc[k], c1 = cc[2048 + k];
            s0 += c0 * sigmoidf_(c0) * w; s1 += c1 * sigmoidf_(c1) * w; }
        LAS float* red = (LAS float*)(F.lds + RING_OFF + 131072 - 4096);
        __syncthreads();
        red[(F.wave * 2 + 0) * 64 + lane] = s0; red[(F.wave * 2 + 1) * 64 + lane] = s1;
        __syncthreads();
        if (F.wave < 2) { float s = 0.f;
#pragma unroll
            for (int w = 0; w < 8; ++w) s += red[(w * 2 + F.wave) * 64 + lane];
            WSP(float, WS_MOD)[F.wave * 12288 + n] = s + F.ap->in[I_BADA][n]; }
    }
}
template <bool OUT8> __device__ __forceinline__ void norm_mod_rows(Frame& F, const float* x, const float* g, int shift_off, int scale_off, bf16* H) {
    const int gw = F.wg * NWAVES + F.wave, NGW = F.G * NWAVES, lane = F.lane; const float* mod = WSP(float, WS_MOD);
    for (int m = gw; m < T; m += NGW) {
        const f32x4* xr = (const f32x4*)(x + (size_t)m * DM) + lane; f32x4 v[8]; float ss = 0.f;
#pragma unroll
        for (int j = 0; j < 8; ++j) { v[j] = xr[64 * j]; ss += (v[j].x * v[j].x + v[j].y * v[j].y) + (v[j].z * v[j].z + v[j].w * v[j].w); }
        const float rs = rsqrtf(wave_sum(ss) * (1.f / DM) + NORM_EPS); const float* mb = mod + (size_t)(m / SEQ) * 12288;
#pragma unroll
        for (int j = 0; j < 8; ++j) { const int c = 4 * lane + 256 * j; const f32x4 gg = *(const f32x4*)(g + c), sc = *(const f32x4*)(mb + scale_off + c), sh = *(const f32x4*)(mb + shift_off + c);
            const f32x4 y = v[j] * rs * gg * (sc + 1.f) + sh;
            if constexpr (OUT8) *(unsigned*)((unsigned char*)H + (size_t)m * DM + c) = pk4_fp8(y.x * FP8_SA1, y.y * FP8_SA1, y.z * FP8_SA1, y.w * FP8_SA1);
            else { v2u o; o.x = pk2(y.x, y.y); o.y = pk2(y.z, y.w); *(v2u*)(H + (size_t)m * DM + c) = o; } }
    }
}
__device__ __forceinline__ void p3_prep(Frame& F) {
    const int gw = F.wg * NWAVES + F.wave, NGW = F.G * NWAVES, lane = F.lane;
    const bf16* P = WSP(bf16, WS_P); const float* mu = F.ap->in[I_MU];
    bf16* Rb = WSP(bf16, WS_R); bf16* LW = WSP(bf16, WS_LW); bf16* SG = WSP(bf16, WS_SG);
    for (int t = gw; t < T; t += NGW) {
        const bf16* pc = P + (size_t)t * NP; const bool first = (t % SEQ) == 0; const bf16* pp = first ? pc : pc - NP;
#pragma unroll
        for (int s = 0; s < 6; ++s) { const int c = (s * 64 + lane) * 8; float a[8], b[8], o[8]; unpack8(*(const v4u*)(pc + c), a); unpack8(*(const v4u*)(pp + c), b);
            const f32x4 m0 = *(const f32x4*)(mu + c), m1 = *(const f32x4*)(mu + c + 4);
#pragma unroll
            for (int i = 0; i < 8; ++i) { const float pv = first ? 0.f : b[i]; const float mm = i < 4 ? m0[i] : m1[i - 4]; o[i] = a[i] + mm * (pv - a[i]); }
            *(v4u*)(Rb + (size_t)(c >> 10) * ((WS_K - WS_R) / 2) + (size_t)t * RW + (c & 1023)) = pack8f(o); }
        { int c, mi; if (lane < 32) { c = PC_GLO + 8 * lane; mi = 3264 + 8 * lane; } else if (lane < 44) { c = PC_DLO + 8 * (lane - 32); mi = 3072 + 8 * (lane - 32); } else { c = PC_ALO + 8 * (lane - 44); mi = 3168 + 8 * (lane - 44); }
          float o[8] = {0.f, 0.f, 0.f, 0.f, 0.f, 0.f, 0.f, 0.f};
          if (lane < 56) { float a[8], b[8]; unpack8(*(const v4u*)(pc + c), a); unpack8(*(const v4u*)(pp + c), b);
              const f32x4 m0 = *(const f32x4*)(mu + mi), m1 = *(const f32x4*)(mu + mi + 4);
#pragma unroll
              for (int i = 0; i < 8; ++i) { const float pv = first ? 0.f : b[i]; const float mm = i < 4 ? m0[i] : m1[i - 4]; const float v = a[i] + mm * (pv - a[i]);
                  o[i] = lane < 32 ? sigmoidf_(v) : (lane < 44 ? tanhf(v) : v); } }
          bf16* dst; if (lane < 32) dst = SG + (size_t)t * 256 + 8 * lane; else if (lane < 44) dst = LW + (size_t)t * 256 + 8 * (lane - 32); else if (lane < 56) dst = LW + (size_t)t * 256 + 128 + 8 * (lane - 44);
          else if (lane < 60) dst = LW + (size_t)t * 256 + 96 + 8 * (lane - 56); else dst = LW + (size_t)t * 256 + 224 + 8 * (lane - 60);
          *(v4u*)dst = pack8f(o); }
#pragma unroll
        for (int s = 0; s < 2; ++s) { const int ch = s * 64 + lane, d0 = (ch & 15) * 8;
#pragma unroll
            for (int qk = 0; qk < 2; ++qk) { float a[8]; unpack8(*(const v4u*)(pc + (qk ? PC_FK : PC_FQ) + ch * 8), a); float ss = 0.f;
#pragma unroll
                for (int i = 0; i < 8; ++i) ss += a[i] * a[i];
                ss += __shfl_xor(ss, 1); ss += __shfl_xor(ss, 2); ss += __shfl_xor(ss, 4); ss += __shfl_xor(ss, 8);
                const float rs = rsqrtf(ss * (1.f / 128.f) + NORM_EPS); const float* gn = F.ap->in[qk ? I_KN : I_QN] + d0;
                const f32x4 g0 = *(const f32x4*)gn, g1 = *(const f32x4*)(gn + 4);
#pragma unroll
                for (int i = 0; i < 8; ++i) a[i] = a[i] * rs * (i < 4 ? g0[i] : g1[i - 4]);
                *(v4u*)(WSP(bf16, qk ? WS_FK : WS_FQ) + (size_t)t * FW + ch * 8) = pack8f(a); }
            *(v4u*)(WSP(bf16, WS_FV) + (size_t)t * FW + ch * 8) = *(const v4u*)(pc + PC_FV + ch * 8); }
        if (lane < 8) { const float xv = bflo((unsigned)pc[PC_F + lane]) + F.ap->in[I_BF][lane];
            WSP(float, WS_LF)[(size_t)t * 8 + lane] = fminf(xv, 0.f) - log1pf(__expf(-fabsf(xv))); }
    }
}
__device__ __forceinline__ void p4_cumsum(Frame& F) {
    if (F.wg >= 16) return;
    const int b = F.wg >> 3, h = F.wg & 7; const float* lf = WSP(float, WS_LF) + (size_t)b * SEQ * 8 + h; float* cs = WSP(float, WS_CS) + (size_t)F.wg * SEQ;
    LAS float* part = (LAS float*)(F.lds + RING_OFF);
    const int t0 = F.tid * 32; float s = 0.f;
    for (int i = 0; i < 32; ++i) s += lf[(size_t)(t0 + i) * 8];
    part[F.tid] = s; __syncthreads();
    if (F.tid == 0) { float run = 0.f; for (int i = 0; i < 512; ++i) { const float v = part[i]; part[i] = run; run += v; } }
    __syncthreads();
    float run = part[F.tid];
    for (int i = 0; i < 32; ++i) { run += lf[(size_t)(t0 + i) * 8]; cs[t0 + i] = -run * 11.313708498984761f; }
    __syncthreads();
}
__device__ __forceinline__ void p5_scan_naive(Frame& F) {
    constexpr int CH = 64;
    LAS float* Wl = (LAS float*)(F.lds + RING_OFF); LAS float* Al = Wl + CH * 64; LAS float* Bl = Al + CH * 64; LAS float* Kl = Bl + CH * 64; LAS float* Rl = Kl + CH * 64; LAS float* Vl = Rl + CH * 64; LAS float* Yl = Vl + CH * 64;
    const int tid = F.tid, row = tid >> 3, q = tid & 7;
    for (int bh = F.wg; bh < 32; bh += F.G) {
        const int b = bh >> 4, h = bh & 15; const size_t base = (size_t)b * SEQ * RW + h * 64;
        const bf16* Rg = WSP(bf16, WS_R) + base; const bf16* Kg = WSP(bf16, WS_K) + base; const bf16* Vg = WSP(bf16, WS_V) + base; const bf16* Ag = WSP(bf16, WS_A) + base;
        const float* Lg = WSP(float, WS_LOGW) + base; float* Yg = WSP(float, WS_YRAW) + base;
        float kkw[8], kaw[8];
#pragma unroll
        for (int i = 0; i < 8; ++i) { kkw[i] = F.ap->in[I_KK][h * 64 + 8 * q + i]; kaw[i] = F.ap->in[I_KA][h * 64 + 8 * q + i]; }
        float S[8] = {0.f, 0.f, 0.f, 0.f, 0.f, 0.f, 0.f, 0.f};
        for (int t0 = 0; t0 < SEQ; t0 += CH) {
            { const size_t off = (size_t)(t0 + row) * RW + 8 * q; float r[8], k[8], v[8], a[8];
              unpack8(*(const v4u*)(Rg + off), r); unpack8(*(const v4u*)(Kg + off), k); unpack8(*(const v4u*)(Vg + off), v); unpack8(*(const v4u*)(Ag + off), a);
              const f32x4 l0 = *(const f32x4*)(Lg + off), l1 = *(const f32x4*)(Lg + off + 4);
              float kk[8], ss = 0.f;
#pragma unroll
              for (int i = 0; i < 8; ++i) { kk[i] = k[i] * kkw[i]; ss += kk[i] * kk[i]; }
              ss += __shfl_xor(ss, 1); ss += __shfl_xor(ss, 2); ss += __shfl_xor(ss, 4);
              const float inv = 1.f / fmaxf(sqrtf(ss), 1e-12f);
#pragma unroll
              for (int i = 0; i < 8; ++i) { const int o = row * 64 + 8 * q + i; kk[i] *= inv;
                  Wl[o] = __expf(i < 4 ? l0[i] : l1[i - 4]); Al[o] = -kk[i]; Bl[o] = kk[i] * a[i]; Kl[o] = k[i] * (1.f + (a[i] - 1.f) * kaw[i]); Rl[o] = r[i]; Vl[o] = v[i]; } }
            __syncthreads();
            for (int t = 0; t < CH; ++t) { const int o = t * 64 + 8 * q; float sa = 0.f;
                const f32x4 a0 = *(const LAS f32x4*)(Al + o), a1 = *(const LAS f32x4*)(Al + o + 4), w0 = *(const LAS f32x4*)(Wl + o), w1 = *(const LAS f32x4*)(Wl + o + 4);
                const f32x4 b0 = *(const LAS f32x4*)(Bl + o), b1 = *(const LAS f32x4*)(Bl + o + 4), k0 = *(const LAS f32x4*)(Kl + o), k1 = *(const LAS f32x4*)(Kl + o + 4);
                const f32x4 r0 = *(const LAS f32x4*)(Rl + o), r1 = *(const LAS f32x4*)(Rl + o + 4); const float vv = Vl[t * 64 + row];
#pragma unroll
                for (int i = 0; i < 8; ++i) sa += S[i] * (i < 4 ? a0[i] : a1[i - 4]);
                sa += __shfl_xor(sa, 1); sa += __shfl_xor(sa, 2); sa += __shfl_xor(sa, 4);
                float y = 0.f;
#pragma unroll
                for (int i = 0; i < 8; ++i) { S[i] = S[i] * (i < 4 ? w0[i] : w1[i - 4]) + sa * (i < 4 ? b0[i] : b1[i - 4]) + vv * (i < 4 ? k0[i] : k1[i - 4]); y += S[i] * (i < 4 ? r0[i] : r1[i - 4]); }
                y += __shfl_xor(y, 1); y += __shfl_xor(y, 2); y += __shfl_xor(y, 4);
                if (q == 0) Yl[t * 64 + row] = y; }
            __syncthreads();
            { const int tt = tid >> 3, c = (tid & 7) * 8; *(f32x4*)(Yg + (size_t)(t0 + tt) * RW + c) = *(const LAS f32x4*)(Yl + tt * 64 + c); *(f32x4*)(Yg + (size_t)(t0 + tt) * RW + c + 4) = *(const LAS f32x4*)(Yl + tt * 64 + c + 4); }
        }
        __syncthreads();
    }
}
__device__ __forceinline__ void p7_post(Frame& F) {
    const int gw = F.wg * NWAVES + F.wave, NGW = F.G * NWAVES, lane = F.lane, c0 = 16 * lane;
    for (int t = gw; t < T; t += NGW) { const size_t off = (size_t)t * RW + c0;
        float y[16], r[16], k[16], v[16], a[16], g[16];
#pragma unroll
        for (int j = 0; j < 4; ++j) { const f32x4 yy = *(const f32x4*)(WSP(float, WS_YRAW) + off + 4 * j); y[4 * j] = yy.x; y[4 * j + 1] = yy.y; y[4 * j + 2] = yy.z; y[4 * j + 3] = yy.w; }
#pragma unroll
        for (int j = 0; j < 2; ++j) { float tmp[8];
            unpack8(*(const v4u*)(WSP(bf16, WS_R) + off + 8 * j), tmp); for (int i = 0; i < 8; ++i) r[8 * j + i] = tmp[i];
            unpack8(*(const v4u*)(WSP(bf16, WS_K) + off + 8 * j), tmp); for (int i = 0; i < 8; ++i) k[8 * j + i] = tmp[i];
            unpack8(*(const v4u*)(WSP(bf16, WS_V) + off + 8 * j), tmp); for (int i = 0; i < 8; ++i) v[8 * j + i] = tmp[i];
            unpack8(*(const v4u*)(WSP(bf16, WS_A) + off + 8 * j), tmp); for (int i = 0; i < 8; ++i) a[8 * j + i] = tmp[i];
            unpack8(*(const v4u*)(WSP(bf16, WS_G) + off + 8 * j), tmp); for (int i = 0; i < 8; ++i) g[8 * j + i] = tmp[i]; }
        float s = 0.f, bs = 0.f;
#pragma unroll
        for (int i = 0; i < 16; ++i) { s += y[i]; const float kp = k[i] * (1.f + (a[i] - 1.f) * F.ap->in[I_KA][c0 + i]); bs += r[i] * kp * F.ap->in[I_RK][c0 + i]; }
        s += __shfl_xor(s, 1); s += __shfl_xor(s, 2); bs += __shfl_xor(bs, 1); bs += __shfl_xor(bs, 2);
        const float mean = s * (1.f / 64.f); float q = 0.f;
#pragma unroll
        for (int i = 0; i < 16; ++i) { const float d = y[i] - mean; q += d * d; }
        q += __shfl_xor(q, 1); q += __shfl_xor(q, 2);
        const float rstd = rsqrtf(q * (1.f / 64.f) + GN_EPS); float o[16];
#pragma unroll
        for (int i = 0; i < 16; ++i) o[i] = ((y[i] - mean) * rstd * F.ap->in[I_GNG][c0 + i] + F.ap->in[I_GNB][c0 + i] + bs * v[i]) * g[i];
#pragma unroll
        for (int j = 0; j < 2; ++j) { v4u w; w.x = pk2(o[8 * j], o[8 * j + 1]); w.y = pk2(o[8 * j + 2], o[8 * j + 3]); w.z = pk2(o[8 * j + 4], o[8 * j + 5]); w.w = pk2(o[8 * j + 6], o[8 * j + 7]); *(v4u*)(WSP(bf16, WS_YA) + off + 8 * j) = w; }
    }
}
__device__ __forceinline__ fox::BlockRef<fox::bf16, fox::bf16> fox_ref(int L_, const unsigned char* ws) {
    const int bh = L_ & 15, qb = 63 - (L_ >> 4);
    fox::BlockRef<fox::bf16, fox::bf16> r; r.ws = ws; r.row0 = (bh / fox::H) * fox::SQ + qb * fox::QB; r.bh = bh; r.P0 = qb * fox::QB; return r;
}
__device__ __forceinline__ int att_fetch(Frame& F) {
    if (F.tid == 0) F.MISC[4] = __hip_atomic_fetch_add(F.ctl + CW_ATTQ, 1u, RLX_AGENT);
    __syncthreads(); const int v = (int)F.MISC[4]; __syncthreads(); return v;
}
__device__ __forceinline__ void p6_attention(Frame& F, char* lds) {
    constexpr int TOTAL = (fox::SQ / fox::QB) * fox::B * fox::H;
    int L = att_fetch(F); if (L >= TOTAL) return;
    fox::BlockRef<fox::bf16, fox::bf16> cur = fox_ref(L, F.ws);
    fox::Seam<fox::bf16> S;
    fox::causal_swa_prime<fox::bf16, fox::bf16>(cur, fox::WINDOW, lds, S, F.tid);
    for (;;) {
        const int Ln = att_fetch(F); const bool last = Ln >= TOTAL;
        const fox::BlockRef<fox::bf16, fox::bf16> nxt = last ? cur : fox_ref(Ln, F.ws);
        fox::causal_swa_block<fox::bf16, fox::bf16>(cur, nxt, fox::SKV, fox::WINDOW, lds, S, F.tid);
        if (last) break;
        cur = nxt;
    }
}
typedef float f32x4m __attribute__((ext_vector_type(4)));
__device__ __forceinline__ void p11_router(Frame& F) {
    constexpr int TPW = T / 256 / NWAVES;
    const int lane = F.lane, t0 = (F.wg * NWAVES + F.wave) * TPW;
    const float* x1 = WSP(float, WS_X1); const float* mod = WSP(float, WS_MOD) + (size_t)(t0 / SEQ) * 12288; const float* g2 = F.ap->in[I_N2G]; bf16* H = WSP(bf16, WS_H);
    LAS float* lg = (LAS float*)(F.lds + RING_OFF + F.wave * 4096);
    LAS int* cnt = (LAS int*)(F.lds + RING_OFF + 65536);
    if (F.tid < 32) cnt[F.tid] = 0;
    __syncthreads();
    for (int i = 0; i < TPW; ++i) { const int m = t0 + i;
        const f32x4* xr = (const f32x4*)(x1 + (size_t)m * DM) + lane; f32x4 v[8]; float ss = 0.f;
#pragma unroll
        for (int j = 0; j < 8; ++j) { v[j] = xr[64 * j]; ss += (v[j].x * v[j].x + v[j].y * v[j].y) + (v[j].z * v[j].z + v[j].w * v[j].w); }
        const float rs = rsqrtf(wave_sum(ss) * (1.f / DM) + NORM_EPS);
        if (lane == 0) lg[512 + i] = rs;
#pragma unroll
        for (int j = 0; j < 8; ++j) { const int c = 4 * lane + 256 * j; const f32x4 gg = *(const f32x4*)(g2 + c), sc = *(const f32x4*)(mod + 4 * 2048 + c), sh = *(const f32x4*)(mod + 3 * 2048 + c);
            const f32x4 y = v[j] * rs * gg * (sc + 1.f) + sh; v2u o; o.x = pk2(y.x, y.y); o.y = pk2(y.z, y.w); *(v2u*)(H + (size_t)m * DM + c) = o; }
    }
    LDS_WAIT();
    { const int i = lane & 15, q = lane >> 4; const float rs = lg[512 + i]; const float* xr = x1 + (size_t)(t0 + i) * DM + 4 * q; const float* wr = WSP(float, WS_WRT) + (size_t)i * DM + 4 * q;
      f32x4m acc0 = {0.f, 0.f, 0.f, 0.f}, acc1 = {0.f, 0.f, 0.f, 0.f};
#pragma unroll 4
      for (int Sx = 0; Sx < DM / 16; ++Sx) { const int k = 16 * Sx;
          const f32x4 xv = *(const f32x4*)(xr + k), gg = *(const f32x4*)(g2 + k + 4 * q), sc = *(const f32x4*)(mod + 4 * 2048 + k + 4 * q), sh = *(const f32x4*)(mod + 3 * 2048 + k + 4 * q);
          const f32x4 hv = xv * rs * gg * (sc + 1.f) + sh; const f32x4 w0 = *(const f32x4*)(wr + k), w1 = *(const f32x4*)(wr + 16 * DM + k);
#pragma unroll
          for (int jj = 0; jj < 4; ++jj) { acc0 = __builtin_amdgcn_mfma_f32_16x16x4f32(hv[jj], w0[jj], acc0, 0, 0, 0); acc1 = __builtin_amdgcn_mfma_f32_16x16x4f32(hv[jj], w1[jj], acc1, 0, 0, 0); } }
      const float b0 = F.ap->in[I_BR][i], b1 = F.ap->in[I_BR][16 + i];
#pragma unroll
      for (int r = 0; r < 4; ++r) { lg[(4 * q + r) * 32 + i] = acc0[r] + b0; lg[(4 * q + r) * 32 + 16 + i] = acc1[r] + b1; } }
    LDS_WAIT();
    if (lane < 16) { const int m = t0 + lane; float v[4]; int e[4]; unsigned used = 0u;
#pragma unroll
        for (int k = 0; k < 4; ++k) { float best = -3.0e38f; int bi = 0;
            for (int j = 0; j < 32; ++j) { const float x = lg[lane * 32 + j]; if (!((used >> j) & 1u) && x > best) { best = x; bi = j; } }
            used |= 1u << bi; v[k] = best; e[k] = bi; }
        const float e1 = __expf(v[1] - v[0]), e2 = __expf(v[2] - v[0]), e3 = __expf(v[3] - v[0]), inv = 1.f / (1.f + e1 + e2 + e3);
        *(f32x4*)(WSP(float, WS_TOKW) + (size_t)m * 4) = (f32x4){inv, e1 * inv, e2 * inv, e3 * inv};
        int* te = WSP(int, WS_TOKE) + (size_t)m * 4; te[0] = e[0]; te[1] = e[1]; te[2] = e[2]; te[3] = e[3];
#pragma unroll
        for (int k = 0; k < 4; ++k) __hip_atomic_fetch_add(cnt + e[k], 1, __ATOMIC_RELAXED, __HIP_MEMORY_SCOPE_WORKGROUP); }
    __syncthreads();
    if (F.tid < 32) WSP(int, WS_WGCNT)[F.wg * 32 + F.tid] = cnt[F.tid];
    __syncthreads();
}
__device__ __forceinline__ void p12_slots(Frame& F) {
    constexpr int TPG = T / 256;
    LAS int* cur = (LAS int*)(F.lds + RING_OFF); LAS int* tot = cur + 32; LAS int* pre = cur + 64; LAS int* off = cur + 96; LAS int* slotl = cur + 160;
    const int* wgcnt = WSP(int, WS_WGCNT);
    if (F.tid < 32) { int tt = 0, pp = 0; for (int w = 0; w < 256; ++w) { const int c = wgcnt[w * 32 + F.tid]; if (w < F.wg) pp += c; tt += c; } tot[F.tid] = tt; pre[F.tid] = pp; }
    __syncthreads();
    if (F.tid == 0) { int o = 0; for (int e = 0; e < 32; ++e) { off[e] = o; o += (tot[e] + 255) & ~255; } off[32] = o; }
    __syncthreads();
    if (F.tid < 32) cur[F.tid] = off[F.tid] + pre[F.tid];
    if (F.wg == 0) { int* te = WSP(int, WS_TILEE); const int nt = off[32] >> 8;
        for (int p = F.tid; p < nt; p += NWAVES * 64) { int e = 0; for (int j = 1; j < 32; ++j) if ((p << 8) >= off[j]) e = j; te[p] = e; }
        if (F.tid == 0) te[1024] = nt; }
    __syncthreads();
    { const int t = F.wg * TPG + (F.tid >> 2), k = F.tid & 3; const int e = WSP(int, WS_TOKE)[(size_t)t * 4 + k];
      const int s = __hip_atomic_fetch_add(cur + e, 1, __ATOMIC_RELAXED, __HIP_MEMORY_SCOPE_WORKGROUP);
      slotl[F.tid] = s; WSP(int, WS_TOKS)[(size_t)t * 4 + k] = s; WSP(float, WS_SLOTW)[s] = WSP(float, WS_TOKW)[(size_t)t * 4 + k]; }
    __syncthreads();
    const bf16* H = WSP(bf16, WS_H); unsigned char* HS = WSP(unsigned char, WS_HS);
    for (int i = 0; i < TPG / NWAVES; ++i) { const int tl = F.wave * (TPG / NWAVES) + i, t = F.wg * TPG + tl; v2u v[4];
#pragma unroll
        for (int j = 0; j < 4; ++j) { float f[8]; unpack8(*(const v4u*)(H + (size_t)t * DM + 8 * (F.lane + 64 * j)), f);
            v[j].x = pk4_fp8(f[0] * FP8_SA1, f[1] * FP8_SA1, f[2] * FP8_SA1, f[3] * FP8_SA1); v[j].y = pk4_fp8(f[4] * FP8_SA1, f[5] * FP8_SA1, f[6] * FP8_SA1, f[7] * FP8_SA1); }
#pragma unroll
        for (int k = 0; k < 4; ++k) { const int s = slotl[tl * 4 + k];
#pragma unroll
            for (int j = 0; j < 4; ++j) *(v2u*)(HS + (size_t)s * DM + 8 * (F.lane + 64 * j)) = v[j]; } }
    __syncthreads();
}
__device__ __forceinline__ void p15_final(Frame& F) {
    const int gw = F.wg * NWAVES + F.wave, NGW = F.G * NWAVES, lane = F.lane;
    const float* x1 = WSP(float, WS_X1); const bf16* YS = WSP(bf16, WS_YS); const float* gf = F.ap->in[I_NFG];
    for (int m = gw; m < T; m += NGW) { const float* gt = WSP(float, WS_MOD) + (size_t)(m / SEQ) * 12288 + 5 * 2048;
        const int4 sl = *(const int4*)(WSP(int, WS_TOKS) + (size_t)m * 4); float v[4][8]; float ss = 0.f;
#pragma unroll
        for (int j = 0; j < 4; ++j) { const int c = 8 * (lane + 64 * j); float y[8] = {0.f, 0.f, 0.f, 0.f, 0.f, 0.f, 0.f, 0.f}, tmp[8];
            unpack8(*(const v4u*)(YS + (size_t)sl.x * DM + c), tmp); for (int i = 0; i < 8; ++i) y[i] += tmp[i];
            unpack8(*(const v4u*)(YS + (size_t)sl.y * DM + c), tmp); for (int i = 0; i < 8; ++i) y[i] += tmp[i];
            unpack8(*(const v4u*)(YS + (size_t)sl.z * DM + c), tmp); for (int i = 0; i < 8; ++i) y[i] += tmp[i];
            unpack8(*(const v4u*)(YS + (size_t)sl.w * DM + c), tmp); for (int i = 0; i < 8; ++i) y[i] += tmp[i];
            const f32x4 xa = *(const f32x4*)(x1 + (size_t)m * DM + c), xb = *(const f32x4*)(x1 + (size_t)m * DM + c + 4), ga = *(const f32x4*)(gt + c), gb = *(const f32x4*)(gt + c + 4);
#pragma unroll
            for (int i = 0; i < 8; ++i) { const float xv = (i < 4 ? xa[i] : xb[i - 4]) + (i < 4 ? ga[i] : gb[i - 4]) * y[i]; v[j][i] = xv; ss += xv * xv; } }
        const float rs = rsqrtf(wave_sum(ss) * (1.f / DM) + NORM_EPS);
#pragma unroll
        for (int j = 0; j < 4; ++j) { const int c = 8 * (lane + 64 * j); const f32x4 ga = *(const f32x4*)(gf + c), gb = *(const f32x4*)(gf + c + 4);
            *(f32x4*)(F.ap->out + (size_t)m * DM + c) = (f32x4){v[j][0] * rs * ga[0], v[j][1] * rs * ga[1], v[j][2] * rs * ga[2], v[j][3] * rs * ga[3]};
            *(f32x4*)(F.ap->out + (size_t)m * DM + c + 4) = (f32x4){v[j][4] * rs * gb[0], v[j][5] * rs * gb[1], v[j][6] * rs * gb[2], v[j][7] * rs * gb[3]}; }
    }
}

__device__ __forceinline__ bool fresh(Frame& F) {
    asm volatile("" : "+s"(F.ap)); int w = F.wave; asm volatile("" : "+s"(w)); const int l = __builtin_amdgcn_mbcnt_hi(~0u, __builtin_amdgcn_mbcnt_lo(~0u, 0u)); F.lane = l; F.tid = w * 64 + l; return true; }
constexpr int N_PHASES = 18;
#ifndef N_CONV_WG
#define N_CONV_WG 48
#endif
__global__ void __launch_bounds__(NWAVES * 64, 2) mk_fwd(Args args) {
    extern __shared__ __attribute__((aligned(16))) unsigned char lds[];
    Frame F;
    F.lds = (LAS unsigned char*)lds; F.MISC = (volatile LAS unsigned*)(F.lds + MISC_OFF);
    F.tid = threadIdx.x; F.lane = F.tid & 63; F.wave = __builtin_amdgcn_readfirstlane(F.tid >> 6); F.G = gridDim.x; F.wg = blockIdx.x;
    F.ap = (ArgsP)__builtin_amdgcn_kernarg_segment_ptr(); F.ws = F.ap->ws; F.ctl = (gu32*)(F.ws + WS_CTL);
    for (int u = F.tid; u < (LDS_BYTES - LDSCTL_OFF) / 4; u += NWAVES * 64) ((LAS unsigned*)(F.lds + LDSCTL_OFF))[u] = 0u;
    __syncthreads();
    const int lo = F.ap->ph_lo, hi = F.ap->ph_hi;
    XcdBarrier bar; bar.bar = (unsigned*)(F.ctl + CW_BAR); bar.x = 0; bar.st = nullptr;
    if (hi - lo > 1) bar = xcd_barrier_post((unsigned*)(F.ctl + CW_BAR), F.MISC + 8, F.tid);
#ifndef PH_MASK
#define PH_MASK 0x3ffff
#endif
#define IN(k) (((PH_MASK >> (k)) & 1) && lo <= (k) && (k) < hi && fresh(F))
#ifndef PROBE_DUP
#define PROBE_DUP 0
#endif
#define REP(k) for (int rep_ = 0; rep_ < 1 + ((PROBE_DUP >> (k)) & 1); ++rep_)
#define SEAM(k) do { if (IN(k) && IN((k) + 1)) xcd_barrier(bar, F.tid); } while (0)
    if (IN(0)) REP(0) { p0_prologue(F); } SEAM(0);
    if (IN(1)) REP(1) { norm_mod_rows<INPROJ_FP8 != 0>(F, F.ap->in[I_X], F.ap->in[I_N1G], 0, 2048, WSP(bf16, WS_H)); } SEAM(1);
    if (IN(2)) REP(2) {
#if INPROJ_FP8
        pg8::Gemm g{WSP(bf16, WS_H), WSP(bf16, WS_WIN), T, NP, DM / 2}; pg8::StaticOrder S; S.init(T, NP, F.G, F.wg);
        pg8::EpiBf16S E{WSP(bf16, WS_P), NP, 1.f / (FP8_SA1 * FP8_SW)}; pg8::gemm_phase<pg8::EpiBf16S, pg8::StaticOrder, true, true, true>(F.lds + RING_OFF, g, S, E, F.tid);
#else
        pg8::Gemm g{WSP(bf16, WS_H), WSP(bf16, WS_WIN), T, NP, DM}; pg8::StaticOrder S; S.init(T, NP, F.G, F.wg);
        pg8::EpiBf16<0> E{WSP(bf16, WS_P), NP, nullptr, 0, 0, 1.f}; pg8::gemm_phase<pg8::EpiBf16<0>, pg8::StaticOrder, true, true>(F.lds + RING_OFF, g, S, E, F.tid);
#endif
        } SEAM(2);
    if (IN(3)) REP(3) { p3_prep(F); } SEAM(3);
    if (IN(4)) REP(4) { p4_cumsum(F);
        { pg8::Gemm g{WSP(bf16, WS_LW), WSP(bf16, WS_BT1), T, 2048, 256}; pg8::StaticOrder S; S.init(T, 2048, F.G, F.wg);
          pg8::EpiLora1 E{WSP(float, WS_LOGW), WSP(bf16, WS_A), F.ap->in[I_W0], F.ap->in[I_A0]}; pg8::gemm_phase<pg8::EpiLora1, pg8::StaticOrder, true, true>(F.lds + RING_OFF, g, S, E, F.tid); }
        } SEAM(4);
    if (IN(5)) REP(5) {
        { pg8::Gemm g{WSP(bf16, WS_SG), WSP(bf16, WS_BT2), T, 1024, 256}; pg8::StaticOrder S; S.init(T, 1024, F.G, F.wg);
          pg8::EpiBf16<0> E{WSP(bf16, WS_G), 1024, nullptr, 0, 0, 1.f}; pg8::gemm_phase<pg8::EpiBf16<0>, pg8::StaticOrder, true, true>(F.lds + RING_OFF, g, S, E, F.tid); }
        } SEAM(5);
    if (IN(6)) REP(6) {
#if RWKV_NAIVE
        p5_scan_naive(F);
#else
        rw::phase_a(F.lds + RING_OFF, F.ws, F.ap->in[I_KK], F.ap->in[I_KA], F.wg, F.G, F.tid);
#endif
        } SEAM(6);
    if (IN(7)) REP(7) {
#if !RWKV_NAIVE
        for (int bh = F.wg; bh < 32; bh += F.G) { const int b = bh >> 4, h = bh & 15;
            rw::phase_b_head(F.lds + RING_OFF, F.ws + WS_REC + (size_t)bh * 256 * rw::REC, WSP(float, WS_YRAW) + (size_t)b * SEQ * RW + h * 64, F.tid); __syncthreads(); }
#endif
        if (F.wg >= 32 && F.wg < 32 + N_CONV_WG) { convert_experts(F, F.wg - 32, N_CONV_WG); __syncthreads(); }
        p6_attention(F, (char*)lds + RING_OFF); } SEAM(7);
    if (IN(9)) REP(9) { p7_post(F); } SEAM(9);
    if (IN(10)) REP(10) { pg8::Gemm g{WSP(bf16, WS_YA), WSP(bf16, WS_WOA), T, DM, 1024}; pg8::StaticOrder S; S.init(T, DM, F.G, F.wg);
        pg8::EpiGateMerge<0> E{WSP(bf16, WS_MRG), WSP(bf16, WS_P), PC_GA}; pg8::gemm_phase<pg8::EpiGateMerge<0>, pg8::StaticOrder, true, true>(F.lds + RING_OFF, g, S, E, F.tid); } SEAM(10);
    if (IN(11)) REP(11) { pg8::Gemm g{WSP(bf16, WS_YB), WSP(bf16, WS_WOB), T, DM, 1024}; pg8::StaticOrder S; S.init(T, DM, F.G, F.wg);
        pg8::EpiGateMerge<1> E{WSP(bf16, WS_MRG), WSP(bf16, WS_P), PC_GB}; pg8::gemm_phase<pg8::EpiGateMerge<1>, pg8::StaticOrder, true, true>(F.lds + RING_OFF, g, S, E, F.tid); } SEAM(11);
    if (IN(12)) REP(12) { pg8::Gemm g{WSP(bf16, WS_MRG), WSP(bf16, WS_WOUT), T, DM, DM}; pg8::StaticOrder S; S.init(T, DM, F.G, F.wg);
        pg8::EpiResid E{F.ap->in[I_X], WSP(float, WS_X1), WSP(float, WS_MOD)}; pg8::gemm_phase<pg8::EpiResid, pg8::StaticOrder, true, true>(F.lds + RING_OFF, g, S, E, F.tid); } SEAM(12);
    if (IN(13)) REP(13) { p11_router(F); } SEAM(13);
    if (IN(14)) REP(14) { p12_slots(F); } SEAM(14);
    if (IN(15)) REP(15) { const int nt = WSP(int, WS_TILEE)[1024]; pg8::Gemm g{WSP(bf16, WS_HS), WSP(bf16, WS_WGU), nt * 256, 4096, DM / 2}; pg8::MoeOrder S; S.init(nt * 256, 4096, F.G, F.wg); S.tile_e = WSP(int, WS_TILEE);
        pg8::EpiSwiglu E{WSP(unsigned char, WS_ACT), F.ap->in[I_BGU]}; pg8::gemm_phase<pg8::EpiSwiglu, pg8::MoeOrder, true, true, true>(F.lds + RING_OFF, g, S, E, F.tid); } SEAM(15);
    if (IN(16)) REP(16) { const int nt = WSP(int, WS_TILEE)[1024]; pg8::Gemm g{WSP(bf16, WS_ACT), WSP(bf16, WS_WDN), nt * 256, 2048, DFF / 2}; pg8::MoeOrder S; S.init(nt * 256, 2048, F.G, F.wg); S.tile_e = WSP(int, WS_TILEE);
        pg8::EpiDown E{WSP(bf16, WS_YS), F.ap->in[I_BDN], WSP(float, WS_SLOTW)}; pg8::gemm_phase<pg8::EpiDown, pg8::MoeOrder, true, true, true>(F.lds + RING_OFF, g, S, E, F.tid); } SEAM(16);
    if (IN(17)) REP(17) { p15_final(F); }
#undef IN
#undef SEAM
}

extern "C" void kernel_launch(void* const* d_in, const int* in_sizes, int n_in, void* d_out, int out_size, void* d_ws, size_t ws_size, hipStream_t stream) {
    static int grid = 0;
    if (grid == 0) {
        if (n_in != N_IN || in_sizes[0] != T * DM || out_size != T * DM || ws_size < WS_END) { fprintf(stderr, "kernel_launch: shape/workspace mismatch (n_in %d, in0 %d, out %d, ws %zu < %zu)\n", n_in, n_in > 0 ? in_sizes[0] : -1, out_size, ws_size, (size_t)WS_END); grid = -1; return; }
        if (hipFuncSetAttribute((const void*)mk_fwd, hipFuncAttributeMaxDynamicSharedMemorySize, LDS_BYTES) != hipSuccess) { fprintf(stderr, "kernel_launch: hipFuncSetAttribute failed\n"); grid = -1; return; }
        int per_cu = 0;
        if (hipOccupancyMaxActiveBlocksPerMultiprocessor(&per_cu, (const void*)mk_fwd, NWAVES * 64, LDS_BYTES) != hipSuccess || per_cu < 1) fprintf(stderr, "kernel_launch: note: occupancy query reports %d workgroups per CU\n", per_cu);
        (void)hipGetLastError();
        grid = 256;
    }
    if (grid < 0) return;
    (void)hipMemsetAsync((char*)d_ws + WS_CTL, 0, CTL_ZERO_BYTES, stream);
    Args a{};
    for (int i = 0; i < N_IN; ++i) a.in[i] = (const float*)d_in[i];
    a.out = (float*)d_out; a.ws = (unsigned char*)d_ws;
#if MK_N_LAUNCHES == 1
    a.ph_lo = 0; a.ph_hi = N_PHASES;
    hipLaunchKernelGGL(mk_fwd, dim3(grid), dim3(NWAVES * 64), LDS_BYTES, stream, a);
#else
    for (int p = 0; p < N_PHASES; ++p) { a.ph_lo = p; a.ph_hi = p + 1; hipLaunchKernelGGL(mk_fwd, dim3(grid), dim3(NWAVES * 64), LDS_BYTES, stream, a); }
#endif
}
```

```cpp
#include <hip/hip_runtime.h>
#include <hip/hip_bf16.h>
#include <cstdio>
#include <cstdint>
constexpr int NWAVES = 8;
#ifndef MK_N_LAUNCHES
#define MK_N_LAUNCHES 1
#endif
#ifndef INPROJ_FP8
#define INPROJ_FP8 1
#endif
#ifndef RWKV_NAIVE
#define RWKV_NAIVE 0
#endif
constexpr int BATCH = 2, SEQ = 16384, DM = 2048, T = BATCH * SEQ;
constexpr int NP = 11776;
constexpr int PC_R = 0, PC_K = 1024, PC_V = 2048, PC_FQ = 3072, PC_FK = 4096, PC_FV = 5120, PC_OG = 6144, PC_GA = 7168, PC_GB = 9216, PC_GLO = 11264, PC_DLO = 11520, PC_ALO = 11616, PC_F = 11712, PC_END = 11720;
constexpr int RW = 1024, FW = 1024, NE = 32, DFF = 2048, TOPK = 4;
constexpr int NSLOT = T * TOPK + NE * 256;
constexpr float NORM_EPS = 1e-6f, GN_EPS = 64e-5f;
constexpr float FOX_HORIZON = 140.f;
constexpr float FP8_SW = 64.f, FP8_SA1 = 2.f, FP8_SA2 = 4.f;

constexpr size_t MiB = 1u << 20;
constexpr size_t WS_CTL = 0, CTL_ZERO_BYTES = 1 * MiB;
constexpr size_t WS_MOD = 1 * MiB;
constexpr size_t WS_WRT = 1 * MiB + 128 * 1024;
constexpr size_t WS_TOKE = 2 * MiB, WS_TOKW = 2 * MiB + 512 * 1024, WS_TOKS = 3 * MiB, WS_SLOTW = 3 * MiB + 512 * 1024;
constexpr size_t WS_WGCNT = 4 * MiB + 512 * 1024, WS_TILEE = 4 * MiB + 768 * 1024;
constexpr size_t WS_JLO = 4 * MiB + 800 * 1024;
constexpr size_t WS_LF = 5 * MiB, WS_CS = 6 * MiB;
constexpr size_t WS_BT1 = 7 * MiB, WS_BT2 = 8 * MiB, WS_WOA = 9 * MiB, WS_WOB = 13 * MiB, WS_WOUT = 17 * MiB, WS_WIN = 25 * MiB;
constexpr size_t WS_WGU = 72 * MiB, WS_WDN = 584 * MiB, WS_X1 = 840 * MiB, WS_H = 1096 * MiB;
constexpr size_t WS_P = 1226 * MiB, WS_R = 1962 * MiB, WS_K = 2026 * MiB, WS_V = 2090 * MiB, WS_FQ = 2154 * MiB, WS_FK = 2218 * MiB, WS_FV = 2282 * MiB;
constexpr size_t WS_LW = 2346 * MiB, WS_SG = 2362 * MiB, WS_LOGW = 2378 * MiB, WS_A = 2506 * MiB, WS_G = 2570 * MiB, WS_YRAW = 2634 * MiB, WS_YA = 2762 * MiB, WS_YB = 2826 * MiB, WS_MRG = 2890 * MiB;
constexpr size_t WS_HS = 1226 * MiB, WS_ACT = 1500 * MiB, WS_YS = 1774 * MiB;
constexpr size_t WS_REC = 3018 * MiB;
constexpr size_t WS_END = 3274 * MiB;
static_assert(WS_WIN + (size_t)NP * DM * 2 <= WS_WGU && WS_YS + (size_t)NSLOT * DM * 2 <= WS_REC && WS_HS + (size_t)NSLOT * DM <= WS_ACT && WS_ACT + (size_t)NSLOT * DFF <= WS_YS && WS_SLOTW + (size_t)NSLOT * 4 <= WS_WGCNT, "d_ws map");
constexpr int CW_TMO = 0, CW_ATTQ = 2048, CW_BAR = 4096;

constexpr int RING_OFF = 0, RING_BYTES = 143360;
constexpr int LDSCTL_OFF = RING_BYTES, MISC_OFF = LDSCTL_OFF + 320;
constexpr int LDS_BYTES = 147456;

#define GAS __attribute__((address_space(1)))
#define LAS __attribute__((address_space(3)))
typedef unsigned short bf16;
typedef unsigned v4u __attribute__((ext_vector_type(4)));
typedef unsigned v2u __attribute__((ext_vector_type(2)));
typedef float f32x4 __attribute__((ext_vector_type(4)));
typedef short bf16x8 __attribute__((ext_vector_type(8)));
typedef GAS unsigned gu32;
#define RLX_AGENT __ATOMIC_RELAXED, __HIP_MEMORY_SCOPE_AGENT
#define LDS_WAIT() asm volatile("s_waitcnt lgkmcnt(0)" ::: "memory")
#define VM_WAIT() asm volatile("s_waitcnt vmcnt(0)" ::: "memory")
__device__ __forceinline__ unsigned f2bf(float f) { unsigned u = __builtin_bit_cast(unsigned, f); return (u + 0x7fffu + ((u >> 16) & 1u)) >> 16; }
__device__ __forceinline__ unsigned pk2(float lo, float hi) { return f2bf(lo) | (f2bf(hi) << 16); }
__device__ __forceinline__ float bflo(unsigned w) { return __uint_as_float(w << 16); }
__device__ __forceinline__ float bfhi(unsigned w) { return __uint_as_float(w & 0xffff0000u); }
__device__ __forceinline__ void unpack8(v4u w, float (&f)[8]) { f[0] = bflo(w.x); f[1] = bfhi(w.x); f[2] = bflo(w.y); f[3] = bfhi(w.y); f[4] = bflo(w.z); f[5] = bfhi(w.z); f[6] = bflo(w.w); f[7] = bfhi(w.w); }
__device__ __forceinline__ v4u pack8f(const float (&f)[8]) { v4u w; w.x = pk2(f[0], f[1]); w.y = pk2(f[2], f[3]); w.z = pk2(f[4], f[5]); w.w = pk2(f[6], f[7]); return w; }
__device__ __forceinline__ float sigmoidf_(float x) { return 1.f / (1.f + __expf(-x)); }
__device__ __forceinline__ float wave_sum(float v) {
#pragma unroll
    for (int o = 1; o < 64; o <<= 1) v += __shfl_xor(v, o);
    return v;
}
namespace pg8 {
#define PG8_LAS __attribute__((address_space(3)))
typedef unsigned short bf16_t;
typedef short bf16x8 __attribute__((ext_vector_type(8)));
typedef float f32x4 __attribute__((ext_vector_type(4)));
typedef unsigned u32x4 __attribute__((ext_vector_type(4)));
constexpr int BM = 256, BK = 64, HALF = 128, HTB = HALF * BK * 2  , STAGE_BYTES = 8 * HTB, NXCD = 8, WGM = 8;

__host__ __device__ __forceinline__ int lds_byte(int r, int c) { const int st = (r >> 4) * 2 + (c >> 5), rr = r & 15, cc = c & 31, ob = rr * 64 + cc * 2; return st * 1024 + (ob ^ (((ob >> 9) & 1) << 5)); }
__host__ __device__ __forceinline__ void stage_rc(int b, int& R, int& C) { const int st = b / 1024, sb = b % 1024, swz = sb ^ (((sb >> 9) & 1) << 5); R = (st >> 1) * 16 + swz / 64; C = (st & 1) * 32 + (swz % 64) / 2; }
__host__ __device__ __forceinline__ int perm32(int rho) { const int n = rho >> 4, i = rho & 15; return 8 * (i >> 2) + 4 * n + (i & 3); }

struct Unit { int pm, pn, e; };
struct Gemm { const bf16_t* A; const bf16_t* Bt; int M, N, K; };

struct StaticOrder {
    int nM, nN, nwg, G, c;
    __host__ __device__ void init(int M, int N, int G_, int c_) { nM = M / BM; nN = N / BM; nwg = nM * nN; G = G_; c = c_; }
    __host__ __device__ bool next(int i, Unit& u) const {
        const long L = (long)i * G + c; if (L >= nwg) return false;
        int wgid = (int)L; { const int q = nwg / NXCD, r = nwg % NXCD, xcd = wgid % NXCD, off = wgid / NXCD; wgid = (xcd < r ? xcd * (q + 1) : r * (q + 1) + (xcd - r) * q) + off; }
        const int nig = WGM * nN, gid = wgid / nig, fm = gid * WGM, gsz = (nM - fm) < WGM ? (nM - fm) : WGM;
        u.pm = fm + ((wgid % nig) % gsz); u.pn = (wgid % nig) / gsz; u.e = 0; return true;
    }
    __device__ __forceinline__ void a_ready(const Unit&) const {}
    __device__ __forceinline__ void done(const Unit&) const {}
};

__device__ __forceinline__ unsigned cvt_pk_bf16(float lo, float hi) { unsigned r; asm volatile("v_cvt_pk_bf16_f32 %0, %1, %2" : "=v"(r) : "v"(lo), "v"(hi)); return r; }
typedef float f32x2 __attribute__((ext_vector_type(2)));
__device__ __forceinline__ f32x2 gelu_pk(f32x2 v) {
    const f32x2 av = __builtin_elementwise_abs(v), d = av * 0.2316418882f + 1.0f;
    f32x2 t; t.x = __builtin_amdgcn_rcpf(d.x); t.y = __builtin_amdgcn_rcpf(d.y);
    f32x2 q = t * 0.5307027145f + (-0.7265760135f); q = q * t + 0.7107068705f; q = q * t + (-0.142248368f); q = q * t + 0.127414796f; q = q * t;
    const f32x2 s = (v * v) * (-0.72134752044f);
    f32x2 e; e.x = __builtin_amdgcn_exp2f(s.x); e.y = __builtin_amdgcn_exp2f(s.y);
    const f32x2 m = v * (q * e), r = v - m;
    f32x2 o; o.x = v.x < 0.f ? m.x : r.x; o.y = v.y < 0.f ? m.y : r.y; return o;
}

template <int ACT  > struct EpiBf16 {
    static constexpr bool PERM = true, AFTER_DRAIN = false; static_assert(ACT == 0 || ACT == 1, "EpiBf16: ACT is 0 (none) or 1 (gelu_pk)");
    bf16_t* O; int ldc; const float* bias; int split_cols; size_t split_stride; float scale0;
    __device__ __forceinline__ void operator()(const f32x4 (&acc)[2][2][4][2], const Unit& u, int wr, int wc, int fr, int fq) const {
        const int row0 = u.pm * BM + wr * 64 + fr; int colt = u.pn * BM; bf16_t* base = O;
        float sc = 1.f; if (split_cols) { const int t = colt / split_cols; base += (size_t)t * split_stride; colt -= t * split_cols; if (t == 0) sc = scale0; }
        const int col0 = colt + wc * 32 + 8 * fq, bcol0 = u.pn * BM + wc * 32 + 8 * fq;
        f32x4 bv[2][2];
#pragma unroll
        for (int bj = 0; bj < 2; ++bj)
#pragma unroll
            for (int n = 0; n < 2; ++n) bv[bj][n] = bias ? *(const f32x4*)(bias + bcol0 + bj * HALF + 4 * n) : (f32x4){0.f, 0.f, 0.f, 0.f};
#pragma unroll
        for (int ai = 0; ai < 2; ++ai)
#pragma unroll
            for (int m = 0; m < 4; ++m) { bf16_t* rowp = base + (size_t)(row0 + ai * HALF + m * 16) * ldc + col0;
#pragma unroll
                for (int bj = 0; bj < 2; ++bj) { f32x4 v0 = acc[ai][bj][m][0] + bv[bj][0], v1 = acc[ai][bj][m][1] + bv[bj][1];
                    if (ACT == 1) { f32x2 a = gelu_pk((f32x2){v0[0], v0[1]}), b = gelu_pk((f32x2){v0[2], v0[3]}), c = gelu_pk((f32x2){v1[0], v1[1]}), d = gelu_pk((f32x2){v1[2], v1[3]});
                        v0 = (f32x4){a.x, a.y, b.x, b.y}; v1 = (f32x4){c.x, c.y, d.x, d.y}; }
                    v0 = v0 * sc; v1 = v1 * sc; u32x4 w; w.x = cvt_pk_bf16(v0[0], v0[1]); w.y = cvt_pk_bf16(v0[2], v0[3]); w.z = cvt_pk_bf16(v1[0], v1[1]); w.w = cvt_pk_bf16(v1[2], v1[3]);
                    *(u32x4*)(rowp + bj * HALF) = w; } }
    }
};

typedef int v4i_t __attribute__((ext_vector_type(4))); typedef int v8i_t __attribute__((ext_vector_type(8)));
template <class Epi, class Sched, bool ALIGN_EPI = false, bool SP2 = false, bool FP8 = false>
__device__ __forceinline__ void gemm_phase(PG8_LAS unsigned char* lds, const Gemm g, const Sched& S, const Epi& E, const int tid) {
    const int wid = __builtin_amdgcn_readfirstlane(tid >> 6), lane = tid & 63, wr = wid >> 2, wc = wid & 3, fr = lane & 15, fq = lane >> 4;
    const int K = g.K, nt = K / BK;
    unsigned voffA[2], voffB[2];
#pragma unroll
    for (int i = 0; i < 2; ++i) { int R, C; stage_rc(tid * 16 + i * 8192, R, C); const int Rb = Epi::PERM ? ((R & ~31) + perm32(R & 31)) : R;
        voffA[i] = (unsigned)(R * K + C) * 2u; voffB[i] = (unsigned)(Rb * K + C) * 2u; }
    const size_t kstep = (size_t)(BK * 2);
    const size_t hstep = (size_t)HALF * K * 2;
    const size_t tstep = 2 * hstep;
    const unsigned ldsw = (unsigned)wid * 1024u;
    const int aoff = lds_byte(wr * 64 + fr, fq * 8), boff = lds_byte(wc * 32 + fr, fq * 8);
#define PG8_SA(b, h) (((b) * 2 + (h)) * HTB)
#define PG8_SB(b, h) ((4 + (b) * 2 + (h)) * HTB)
#define PG8_STAGE(bufoff, gbase, voff) do { _Pragma("unroll") for (int _i = 0; _i < 2; ++_i) \
        __builtin_amdgcn_global_load_lds((const unsigned*)((const char*)(gbase) + (voff)[_i]), (PG8_LAS unsigned*)(lds + (bufoff) + ldsw + _i * 8192), 16, 0, 0); } while (0)
#define PG8_CAT(x0, x1) __builtin_shufflevector(__builtin_bit_cast(v4i_t, x0), __builtin_bit_cast(v4i_t, x1), 0, 1, 2, 3, 4, 5, 6, 7)
#define PG8_LDA(dst, b, h) do { _Pragma("unroll") for (int m = 0; m < 4; ++m) { if constexpr (FP8) dst##8[m] = PG8_CAT(*(const PG8_LAS bf16x8*)(lds + PG8_SA(b, h) + aoff + m * 2048), *(const PG8_LAS bf16x8*)(lds + PG8_SA(b, h) + aoff + m * 2048 + 1024)); \
        else { _Pragma("unroll") for (int k = 0; k < 2; ++k) dst[m][k] = *(const PG8_LAS bf16x8*)(lds + PG8_SA(b, h) + aoff + m * 2048 + k * 1024); } } } while (0)
#define PG8_LDB(dst, b, h) do { _Pragma("unroll") for (int n = 0; n < 2; ++n) { if constexpr (FP8) dst##8[n] = PG8_CAT(*(const PG8_LAS bf16x8*)(lds + PG8_SB(b, h) + boff + n * 2048), *(const PG8_LAS bf16x8*)(lds + PG8_SB(b, h) + boff + n * 2048 + 1024)); \
        else { _Pragma("unroll") for (int k = 0; k < 2; ++k) dst[n][k] = *(const PG8_LAS bf16x8*)(lds + PG8_SB(b, h) + boff + n * 2048 + k * 1024); } } } while (0)
#define PG8_MMA16(ai, bj, At, Bt) do { __builtin_amdgcn_s_setprio(1); _Pragma("unroll") for (int m = 0; m < 4; ++m) _Pragma("unroll") for (int n = 0; n < 2; ++n) _Pragma("unroll") for (int k = 0; k < 2; ++k) \
        acc[ai][bj][m][n] = __builtin_amdgcn_mfma_f32_16x16x32_bf16(Bt[n][k], At[m][k], acc[ai][bj][m][n], 0, 0, 0); __builtin_amdgcn_s_setprio(0); } while (0)
#define PG8_MMA8(ai, bj, At, Bt) do { __builtin_amdgcn_s_setprio(1); _Pragma("unroll") for (int m = 0; m < 4; ++m) _Pragma("unroll") for (int n = 0; n < 2; ++n) \
        asm volatile("v_mfma_scale_f32_16x16x128_f8f6f4 %0, %1, %2, %0, %3, %3 op_sel_hi:[0,0,0]" : "+v"(acc[ai][bj][m][n]) : "v"(Bt##8[n]), "v"(At##8[m]), "v"(one_scale)); __builtin_amdgcn_s_setprio(0); } while (0)
#define PG8_MMA(ai, bj, At, Bt) do { if constexpr (FP8) PG8_MMA8(ai, bj, At, Bt); else PG8_MMA16(ai, bj, At, Bt); } while (0)
#define PG8_WAIT_V(n) asm volatile("s_waitcnt vmcnt(" #n ")" ::: "memory")
#define PG8_WAIT_L(n) asm volatile("s_waitcnt lgkmcnt(" #n ")" ::: "memory")
#define PG8_BAR __builtin_amdgcn_s_barrier()
#define PG8_SCHED __builtin_amdgcn_sched_barrier(0)
    Unit cur, nxt; int ui = 0;
    if (!S.next(0, cur)) return;
    f32x4 acc[2][2][4][2];
#pragma unroll
    for (int a = 0; a < 2; ++a)
#pragma unroll
        for (int b = 0; b < 2; ++b)
#pragma unroll
            for (int m = 0; m < 4; ++m)
#pragma unroll
                for (int n = 0; n < 2; ++n) acc[a][b][m][n] = (f32x4){0.f, 0.f, 0.f, 0.f};
    bf16x8 At[4][2], B0[2][2], B1[2][2]; v8i_t At8[4], B08[2], B18[2];
    int one_scale = 0x7f7f7f7f; asm volatile("" : "+v"(one_scale));
    const char* cA = (const char*)g.A + (size_t)cur.pm * tstep; const size_t estep = (size_t)g.N * K * 2; const char* cB = (const char*)g.Bt + (size_t)cur.e * estep + (size_t)cur.pn * tstep;
    S.a_ready(cur);
    if constexpr (SP2) {
        PG8_STAGE(PG8_SB(0, 0), cB, voffB); PG8_STAGE(PG8_SB(0, 1), cB + hstep, voffB); PG8_STAGE(PG8_SA(0, 0), cA, voffA); PG8_STAGE(PG8_SA(0, 1), cA + hstep, voffA);
        if (wr == 1) PG8_BAR;
        PG8_WAIT_V(2); PG8_BAR;
        PG8_STAGE(PG8_SB(1, 0), cB + kstep, voffB); PG8_STAGE(PG8_SA(1, 0), cA + kstep, voffA); PG8_STAGE(PG8_SB(1, 1), cB + hstep + kstep, voffB);
        PG8_WAIT_V(6); PG8_BAR;
    } else {
        PG8_STAGE(PG8_SB(0, 0), cB, voffB); PG8_STAGE(PG8_SA(0, 0), cA, voffA); PG8_STAGE(PG8_SB(0, 1), cB + hstep, voffB); PG8_STAGE(PG8_SA(0, 1), cA + hstep, voffA);
        if (wr == 1) PG8_BAR;
        PG8_WAIT_V(4); PG8_BAR;
        PG8_STAGE(PG8_SB(1, 0), cB + kstep, voffB); PG8_STAGE(PG8_SA(1, 0), cA + kstep, voffA); PG8_STAGE(PG8_SB(1, 1), cB + hstep + kstep, voffB);
        PG8_WAIT_V(6); PG8_BAR;
    }
    for (;;) {
        const bool has_next = S.next(ui + 1, nxt);
        const char* nA = has_next ? (const char*)g.A + (size_t)nxt.pm * tstep : cA; const char* nB = has_next ? (const char*)g.Bt + (size_t)nxt.e * estep + (size_t)nxt.pn * tstep : cB;
        for (int t = 0; t < nt; t += 2) {
            const bool last = (t == nt - 2);
            const char* a1 = cA + (size_t)(t + 1) * kstep;
            const char* a2 = last ? nA : cA + (size_t)(t + 2) * kstep; const char* b2 = last ? nB : cB + (size_t)(t + 2) * kstep;
            const char* a3 = a2 + kstep; const char* b3 = b2 + kstep;
            if (last && has_next) S.a_ready(nxt);
            if constexpr (SP2) {
            PG8_LDB(B0, 0, 0); PG8_LDB(B1, 0, 1); PG8_SCHED; PG8_LDA(At, 0, 0); PG8_STAGE(PG8_SA(1, 1), a1 + hstep, voffA);
            PG8_WAIT_V(8); PG8_WAIT_L(0); PG8_BAR; PG8_MMA(0, 0, At, B0); PG8_MMA(0, 1, At, B1); PG8_BAR; PG8_SCHED;
            PG8_LDA(At, 0, 1); PG8_STAGE(PG8_SB(0, 0), b2, voffB); PG8_STAGE(PG8_SB(0, 1), b2 + hstep, voffB); PG8_STAGE(PG8_SA(0, 0), a2, voffA);
            PG8_WAIT_V(8); PG8_WAIT_L(0); PG8_BAR; PG8_MMA(1, 0, At, B0); PG8_MMA(1, 1, At, B1); PG8_BAR; PG8_SCHED;
            PG8_LDB(B0, 1, 0); PG8_LDB(B1, 1, 1); PG8_SCHED; PG8_LDA(At, 1, 0); PG8_STAGE(PG8_SA(0, 1), a2 + hstep, voffA);
            PG8_WAIT_V(8); PG8_WAIT_L(0); PG8_BAR; PG8_MMA(0, 0, At, B0); PG8_MMA(0, 1, At, B1); PG8_BAR; PG8_SCHED;
            PG8_LDA(At, 1, 1); PG8_STAGE(PG8_SB(1, 0), b3, voffB); PG8_STAGE(PG8_SB(1, 1), b3 + hstep, voffB); PG8_STAGE(PG8_SA(1, 0), a3, voffA);
            PG8_WAIT_V(8); PG8_WAIT_L(0); PG8_BAR; PG8_MMA(1, 0, At, B0); PG8_MMA(1, 1, At, B1); PG8_BAR; PG8_SCHED;
            } else {
            PG8_LDB(B0, 0, 0); PG8_SCHED; PG8_LDA(At, 0, 0); PG8_STAGE(PG8_SA(1, 1), a1 + hstep, voffA);
            PG8_WAIT_L(8); PG8_BAR; PG8_WAIT_L(0); PG8_MMA(0, 0, At, B0); PG8_BAR; PG8_SCHED;
            PG8_LDB(B1, 0, 1); PG8_STAGE(PG8_SB(0, 0), b2, voffB);
            PG8_BAR; PG8_WAIT_L(0); PG8_MMA(0, 1, At, B1); PG8_BAR;
            PG8_LDA(At, 0, 1); PG8_STAGE(PG8_SA(0, 0), a2, voffA);
            PG8_BAR; PG8_WAIT_L(0); PG8_MMA(1, 0, At, B0); PG8_BAR; PG8_SCHED;
            PG8_STAGE(PG8_SB(0, 1), b2 + hstep, voffB);
            PG8_WAIT_V(6); PG8_BAR; PG8_MMA(1, 1, At, B1); PG8_BAR;
            PG8_LDB(B0, 1, 0); PG8_SCHED; PG8_LDA(At, 1, 0); PG8_STAGE(PG8_SA(0, 1), a2 + hstep, voffA);
            PG8_WAIT_L(8); PG8_BAR; PG8_WAIT_L(0); PG8_MMA(0, 0, At, B0); PG8_BAR; PG8_SCHED;
            PG8_LDB(B1, 1, 1); PG8_STAGE(PG8_SB(1, 0), b3, voffB);
            PG8_BAR; PG8_WAIT_L(0); PG8_MMA(0, 1, At, B1); PG8_BAR;
            PG8_LDA(At, 1, 1); PG8_STAGE(PG8_SA(1, 0), a3, voffA);
            PG8_BAR; PG8_WAIT_L(0); PG8_MMA(1, 0, At, B0); PG8_BAR; PG8_SCHED;
            PG8_STAGE(PG8_SB(1, 1), b3 + hstep, voffB);
            PG8_WAIT_V(6); PG8_BAR; PG8_MMA(1, 1, At, B1); PG8_BAR;
            }
        }
        if constexpr (ALIGN_EPI) { if (wr == 0) PG8_BAR; }
        if constexpr (FP8) asm volatile("s_nop 15\n\ts_nop 15" ::: "memory");
        if constexpr (!Epi::AFTER_DRAIN) { E(acc, cur, wr, wc, fr, fq); S.done(cur); }
        if (!has_next) break;
#pragma unroll
        for (int a = 0; a < 2; ++a)
#pragma unroll
            for (int b = 0; b < 2; ++b)
#pragma unroll
                for (int m = 0; m < 4; ++m)
#pragma unroll
                    for (int n = 0; n < 2; ++n) acc[a][b][m][n] = (f32x4){0.f, 0.f, 0.f, 0.f};
        cur = nxt; cA = nA; cB = nB; ++ui;
        if constexpr (ALIGN_EPI) { if (wr == 1) PG8_BAR; }
    }
    PG8_WAIT_V(0);
    if constexpr (!ALIGN_EPI) { if (wr == 0) PG8_BAR; }
    PG8_BAR;
    if constexpr (Epi::AFTER_DRAIN) { E.fused(acc, cur, wr, wc, fr, fq, lds, wid, lane); S.done(cur); }
#undef PG8_SA
#undef PG8_SB
#undef PG8_STAGE
#undef PG8_LDA
#undef PG8_LDB
#undef PG8_MMA
#undef PG8_MMA8
#undef PG8_MMA16
#undef PG8_CAT
#undef PG8_WAIT_V
#undef PG8_WAIT_L
#undef PG8_BAR
#undef PG8_SCHED
}
}
namespace pg8 {
__device__ __forceinline__ float ep_bflo(unsigned w) { return __uint_as_float(w << 16); }
__device__ __forceinline__ float ep_bfhi(unsigned w) { return __uint_as_float(w & 0xffff0000u); }
__device__ __forceinline__ float ep_sig(float x) { return __builtin_amdgcn_rcpf(1.f + __builtin_amdgcn_exp2f(-1.4426950408889634f * x)); }
__device__ __forceinline__ void ep_unpack8(u32x4 w, f32x4& a, f32x4& b) { a = (f32x4){ep_bflo(w.x), ep_bfhi(w.x), ep_bflo(w.y), ep_bfhi(w.y)}; b = (f32x4){ep_bflo(w.z), ep_bfhi(w.z), ep_bflo(w.w), ep_bfhi(w.w)}; }
__device__ __forceinline__ u32x4 ep_pack8(f32x4 a, f32x4 b) { u32x4 w; w.x = cvt_pk_bf16(a[0], a[1]); w.y = cvt_pk_bf16(a[2], a[3]); w.z = cvt_pk_bf16(b[0], b[1]); w.w = cvt_pk_bf16(b[2], b[3]); return w; }
__device__ __forceinline__ f32x4 ep_sig4(f32x4 v) { return (f32x4){ep_sig(v[0]), ep_sig(v[1]), ep_sig(v[2]), ep_sig(v[3])}; }
#define EPI_LOOP_BEGIN const int row0 = u.pm * BM + wr * 64 + fr, col0 = u.pn * BM + wc * 32 + 8 * fq; \
    _Pragma("unroll") for (int ai = 0; ai < 2; ++ai) _Pragma("unroll") for (int m = 0; m < 4; ++m) { const int row = row0 + ai * HALF + m * 16; \
    _Pragma("unroll") for (int bj = 0; bj < 2; ++bj) { const int col = col0 + bj * HALF; const f32x4 v0 = acc[ai][bj][m][0], v1 = acc[ai][bj][m][1];
#define EPI_LOOP_END } }

struct EpiBf16S {
    static constexpr bool PERM = true, AFTER_DRAIN = false;
    bf16_t* O; int ldc; float s;
    __device__ __forceinline__ void operator()(const f32x4 (&acc)[2][2][4][2], const Unit& u, int wr, int wc, int fr, int fq) const {
        EPI_LOOP_BEGIN
            *(u32x4*)(O + (size_t)row * ldc + col) = ep_pack8(v0 * s, v1 * s);
        EPI_LOOP_END
    }
};
struct EpiLora1 {
    static constexpr bool PERM = true, AFTER_DRAIN = false;
    float* logw; bf16_t* a; const float* w0; const float* a0;
    __device__ __forceinline__ void operator()(const f32x4 (&acc)[2][2][4][2], const Unit& u, int wr, int wc, int fr, int fq) const {
        EPI_LOOP_BEGIN
            if (u.pn < 4) { const f32x4 b0 = *(const f32x4*)(w0 + col), b1 = *(const f32x4*)(w0 + col + 4);
                float* o = logw + (size_t)row * 1024 + col; *(f32x4*)o = ep_sig4(v0 + b0) * (-0.6065306597126334f); *(f32x4*)(o + 4) = ep_sig4(v1 + b1) * (-0.6065306597126334f); }
            else { const int c = col - 1024; const f32x4 b0 = *(const f32x4*)(a0 + c), b1 = *(const f32x4*)(a0 + c + 4);
                *(u32x4*)(a + (size_t)row * 1024 + c) = ep_pack8(ep_sig4(v0 + b0), ep_sig4(v1 + b1)); }
        EPI_LOOP_END
    }
};
template <int SECOND> struct EpiGateMerge {
    static constexpr bool PERM = true, AFTER_DRAIN = false;
    bf16_t* mrg; const bf16_t* P; int gcol;
    __device__ __forceinline__ void operator()(const f32x4 (&acc)[2][2][4][2], const Unit& u, int wr, int wc, int fr, int fq) const {
        EPI_LOOP_BEGIN
            f32x4 g0, g1; ep_unpack8(*(const u32x4*)(P + (size_t)row * 11776 + gcol + col), g0, g1);
            f32x4 r0 = ep_sig4(g0) * v0, r1 = ep_sig4(g1) * v1;
            bf16_t* o = mrg + (size_t)row * 2048 + col;
            if (SECOND) { f32x4 t0, t1; ep_unpack8(*(const u32x4*)o, t0, t1); r0 = r0 + t0; r1 = r1 + t1; }
            *(u32x4*)o = ep_pack8(r0, r1);
        EPI_LOOP_END
    }
};
struct EpiResid {
    static constexpr bool PERM = true, AFTER_DRAIN = false;
    const float* x; float* x1; const float* mod;
    __device__ __forceinline__ void operator()(const f32x4 (&acc)[2][2][4][2], const Unit& u, int wr, int wc, int fr, int fq) const {
        const float* gt = mod + (size_t)((u.pm * BM) / 16384) * 12288 + 4096;
        EPI_LOOP_BEGIN
            const f32x4 g0 = *(const f32x4*)(gt + col), g1 = *(const f32x4*)(gt + col + 4);
            const size_t off = (size_t)row * 2048 + col;
            *(f32x4*)(x1 + off) = *(const f32x4*)(x + off) + g0 * v0; *(f32x4*)(x1 + off + 4) = *(const f32x4*)(x + off + 4) + g1 * v1;
        EPI_LOOP_END
    }
};
struct EpiSwiglu {
    static constexpr bool PERM = true, AFTER_DRAIN = false;
    unsigned char* act; const float* bias;
    __device__ __forceinline__ void operator()(const f32x4 (&acc)[2][2][4][2], const Unit& u, int wr, int wc, int fr, int fq) const {
        const int row0 = u.pm * BM + wr * 64 + fr, gcol = u.pn * 128 + wc * 32 + 8 * fq;
        const float* bg = bias + (size_t)u.e * 4096 + gcol; const float* bl = bg + 2048;
        const f32x4 bg0 = *(const f32x4*)bg, bg1 = *(const f32x4*)(bg + 4), bl0 = *(const f32x4*)bl, bl1 = *(const f32x4*)(bl + 4);
#pragma unroll
        for (int ai = 0; ai < 2; ++ai)
#pragma unroll
            for (int m = 0; m < 4; ++m) { const int row = row0 + ai * HALF + m * 16;
                f32x4 g0 = acc[ai][0][m][0] * (1.f / 128.f) + bg0, g1 = acc[ai][0][m][1] * (1.f / 128.f) + bg1, l0 = acc[ai][1][m][0] * (1.f / 128.f) + bl0, l1 = acc[ai][1][m][1] * (1.f / 128.f) + bl1, r0, r1;
#pragma unroll
                for (int i = 0; i < 4; ++i) { const float a = fminf(g0[i], 7.f), b = fminf(g1[i], 7.f);
                    r0[i] = a * ep_sig(1.702f * a) * (fminf(fmaxf(l0[i], -7.f), 7.f) + 1.f); r1[i] = b * ep_sig(1.702f * b) * (fminf(fmaxf(l1[i], -7.f), 7.f) + 1.f); }
                r0 = r0 * 4.f; r1 = r1 * 4.f; typedef unsigned u32x2e __attribute__((ext_vector_type(2))); u32x2e o;
                { int w = __builtin_amdgcn_cvt_pk_fp8_f32(r0[0], r0[1], 0, false); w = __builtin_amdgcn_cvt_pk_fp8_f32(r0[2], r0[3], w, true); o.x = (unsigned)w; }
                { int w = __builtin_amdgcn_cvt_pk_fp8_f32(r1[0], r1[1], 0, false); w = __builtin_amdgcn_cvt_pk_fp8_f32(r1[2], r1[3], w, true); o.y = (unsigned)w; }
                *(u32x2e*)(act + (size_t)row * 2048 + gcol) = o; }
    }
};
struct EpiDown {
    static constexpr bool PERM = true, AFTER_DRAIN = false;
    bf16_t* ys; const float* bias; const float* slot_w;
    __device__ __forceinline__ void operator()(const f32x4 (&acc)[2][2][4][2], const Unit& u, int wr, int wc, int fr, int fq) const {
        const float* be = bias + (size_t)u.e * 2048;
        EPI_LOOP_BEGIN
            const float w = slot_w[row];
            const f32x4 b0 = *(const f32x4*)(be + col), b1 = *(const f32x4*)(be + col + 4);
            *(u32x4*)(ys + (size_t)row * 2048 + col) = ep_pack8((v0 * (1.f / 256.f) + b0) * w, (v1 * (1.f / 256.f) + b1) * w);
        EPI_LOOP_END
    }
};
struct MoeOrder : StaticOrder {
    const int* tile_e;
    __device__ bool next(int i, Unit& u) const { if (!StaticOrder::next(i, u)) return false; u.e = tile_e[u.pm]; return true; }
};
}
namespace fox {
enum { ORDER_NATURAL = 0, ORDER_REVERSED = 1, ORDER_PAIRED = 2, ORDER_XCD = 4 };
using TIN = __hip_bfloat16; using TOUT = __hip_bfloat16;
constexpr int B = 2, H = 8, HKV = 8, SQ = 16384, SKV = 16384, D = 128;
constexpr int PITCH = 1024;
constexpr int GPITCH = 11776;
constexpr int QOFF = 0;
constexpr int WINDOW = SKV;
constexpr float THR = 8.f;
constexpr int ORDER = ORDER_PAIRED;
constexpr bool WSKIP = false;
constexpr float SCALE = 0.08838834764831845f;
constexpr int NW = 8, QBLK = 32, KVBLK = 64, QB = NW * QBLK;
constexpr int SHM_V = KVBLK * D * 2, SHM_K = KVBLK * D * 2;
constexpr int LDS_CB = 2 * SHM_V + 2 * SHM_K + NW * 64 * 4;
constexpr int LDS_GATE = LDS_CB + 3 * 64 * 4 + 256;
constexpr int LDS_BYTES = LDS_GATE + NW * 8192;
static_assert(D == 128 && SQ % QB == 0 && SKV % KVBLK == 0 && H % HKV == 0 && QOFF >= 0 && QOFF + SQ <= SKV && WINDOW >= 1, "geometry");

using bf16 = __hip_bfloat16;
typedef short bf16x8 __attribute__((ext_vector_type(8)));
typedef short s16x4 __attribute__((ext_vector_type(4)));
typedef float f32x16 __attribute__((ext_vector_type(16)));
typedef float f32x4 __attribute__((ext_vector_type(4)));
typedef unsigned u32x4 __attribute__((ext_vector_type(4)));
template <class A, class Bt> struct same_t { static constexpr bool v = false; };
template <class A> struct same_t<A, A> { static constexpr bool v = true; };

#define KSWZ(row, colB) ((row) * 256 + ((colB) ^ (((row) & 7) << 4)))
#define SBAR() __builtin_amdgcn_sched_barrier(0)
__device__ __forceinline__ int v_st(int k, int c) { const int kk = (k & ~0xC) | ((k & 4) << 1) | ((k & 8) >> 1); return ((kk >> 3) * 4 + (c >> 5)) * 512 + ((kk & 7) * 32 + (c & 31)) * 2; }
__device__ __forceinline__ int v_rd_base(int lane) { return ((lane & 3) << 3) | (((lane >> 2) & 3) << 6) | (((lane >> 4) & 1) << 5) | (((lane >> 5) & 1) << 8); }
constexpr int v_rd_off(int d0, int ks, int half) { return d0 * 512 + ks * 4096 + half * 2048; }
__device__ __forceinline__ int crow(int r, int hi) { return (r & 3) + 8 * (r >> 2) + 4 * hi; }
__device__ __forceinline__ unsigned cvtpk(float lo, float hi) {
    unsigned r; asm volatile("v_cvt_pk_bf16_f32 %0, %1, %2" : "=v"(r) : "v"(lo), "v"(hi)); return r;
}
__device__ __forceinline__ bf16x8 pack8(f32x4 a, f32x4 b) {
    u32x4 w = {cvtpk(a[0], a[1]), cvtpk(a[2], a[3]), cvtpk(b[0], b[1]), cvtpk(b[2], b[3])};
    return *reinterpret_cast<bf16x8*>(&w);
}
template <class T> __device__ __forceinline__ bf16x8 load8(const T* p) {
    if constexpr (same_t<T, float>::v) { return pack8(*(const f32x4*)p, *(const f32x4*)(p + 4)); }
    else { return *reinterpret_cast<const bf16x8*>(p); }
}
__device__ __forceinline__ void mask_tile(f32x16& p0, f32x16& p1, int dq, unsigned W) {
    const float NEG = -__builtin_inff();
#pragma unroll
    for (int r = 0; r < 16; ++r) {
        const int c = (r & 3) + 8 * (r >> 2);
        if ((unsigned)(dq - c) >= W) p0[r] = NEG;
        if ((unsigned)(dq - c - 32) >= W) p1[r] = NEG;
    }
}
__device__ __forceinline__ void partialSM(f32x16& p0, f32x16& p1, float& m_reg, float& mn, float& alpha) {
    float pmax = p0[0]; for (int r = 1; r < 16; ++r) pmax = fmaxf(pmax, p0[r]); for (int r = 0; r < 16; ++r) pmax = fmaxf(pmax, p1[r]);
    { auto rr = __builtin_amdgcn_permlane32_swap(__float_as_uint(pmax), __float_as_uint(pmax), false, false);
      pmax = fmaxf(__uint_as_float(rr[0]), __uint_as_float(rr[1])); }
    constexpr float C2 = 1.4426950408889634f * SCALE;
    if (__builtin_expect(__all((pmax - m_reg) * SCALE <= THR), 1)) { mn = m_reg; alpha = 1.f; }
    else { mn = fmaxf(m_reg, pmax); alpha = __builtin_amdgcn_exp2f((m_reg - mn) * C2); m_reg = mn; }
    const float mnL = -mn * C2;
    for (int r = 0; r < 16; ++r) p0[r] = fmaf(p0[r], C2, mnL); for (int r = 0; r < 16; ++r) p1[r] = fmaf(p1[r], C2, mnL);
    for (int r = 0; r < 16; ++r) p0[r] = __builtin_amdgcn_exp2f(p0[r]);
}
__device__ __forceinline__ void finishSM(f32x16& p0, f32x16& p1, float alpha, float& l_reg, bf16x8& pa0, bf16x8& pa1, bf16x8& pa2, bf16x8& pa3) {
    for (int r = 0; r < 16; ++r) p1[r] = __builtin_amdgcn_exp2f(p1[r]);
    float ps = 0; for (int r = 0; r < 16; ++r) ps += p0[r]; for (int r = 0; r < 16; ++r) ps += p1[r];
    { auto rr = __builtin_amdgcn_permlane32_swap(__float_as_uint(ps), __float_as_uint(ps), false, false);
      ps = __uint_as_float(rr[0]) + __uint_as_float(rr[1]); }
    l_reg = l_reg * alpha + ps;
#define PK4(P, B_, OUT) do { unsigned a0 = cvtpk(P[B_+0], P[B_+1]), a1 = cvtpk(P[B_+2], P[B_+3]);                          \
        unsigned b0 = cvtpk(P[B_+4], P[B_+5]), b1 = cvtpk(P[B_+6], P[B_+7]);                                             \
        auto r0 = __builtin_amdgcn_permlane32_swap(a0, b0, false, false); auto r1 = __builtin_amdgcn_permlane32_swap(a1, b1, false, false); \
        u32x4 w = {r0[0], r1[0], r0[1], r1[1]}; OUT = *reinterpret_cast<bf16x8*>(&w); } while (0)
    PK4(p0, 0, pa0); PK4(p0, 8, pa1); PK4(p1, 0, pa2); PK4(p1, 8, pa3);
#undef PK4
}
template <int KB, bool SK>
__device__ __forceinline__ void qkt(f32x16& p0, f32x16& p1, const char* K_lds, int r32, int hi, const bf16x8* qr, bool act, int cbi) {
    if (SK && !act) { const float NEG = -__builtin_inff();
#pragma unroll
        for (int r = 0; r < 16; ++r) { p0[r] = NEG; p1[r] = NEG; } return; }
    { const float* cb_ = (const float*)(K_lds + 2 * SHM_K + NW * 64 * 4) + cbi * 64 + 4 * hi;
#pragma unroll
      for (int g_ = 0; g_ < 4; ++g_) { const f32x4 b0_ = *(const f32x4*)(cb_ + 8 * g_), b1_ = *(const f32x4*)(cb_ + 32 + 8 * g_);
#pragma unroll
          for (int i_ = 0; i_ < 4; ++i_) { p0[4 * g_ + i_] = b0_[i_]; p1[4 * g_ + i_] = b1_[i_]; } } }
    const char* kb[4];
#pragma unroll
    for (int dd = 0; dd < 4; ++dd) kb[dd] = K_lds + KB * SHM_K + KSWZ(r32, (dd * 16 + hi * 8) * 2);
#pragma unroll
    for (int d0 = 0; d0 < 8; ++d0) { const char* a = kb[d0 & 3] + (d0 >> 2) * 128;
        bf16x8 b0 = *reinterpret_cast<const bf16x8*>(a);
        bf16x8 b1 = *reinterpret_cast<const bf16x8*>(a + 32 * 256);
        p0 = __builtin_amdgcn_mfma_f32_32x32x16_bf16(b0, qr[d0], p0, 0, 0, 0);
        p1 = __builtin_amdgcn_mfma_f32_32x32x16_bf16(b1, qr[d0], p1, 0, 0, 0); }
}
template <int VB, bool SK>
__device__ __forceinline__ void pv_tile(f32x16* o, int vb0, bf16x8 pa0, bf16x8 pa1, bf16x8 pa2, bf16x8 pa3, bool act) {
    if (SK && !act) return;
#define TRRD(dst, off) asm volatile("ds_read_b64_tr_b16 %0, %1 offset:%2" : "=&v"(dst) : "v"(vb0), "i"(off) : "memory")
#define PV_D0(d0) do { s16x4 l0, l1, l2, l3, h0, h1, h2, h3; constexpr int b_ = VB * SHM_V + v_rd_off(d0, 0, 0);     \
        TRRD(l0, b_); TRRD(h0, b_ + 2048); TRRD(l1, b_ + 4096); TRRD(h1, b_ + 6144); TRRD(l2, b_ + 8192); TRRD(h2, b_ + 10240); TRRD(l3, b_ + 12288); TRRD(h3, b_ + 14336); \
        asm volatile("s_waitcnt lgkmcnt(0)" ::: "memory"); SBAR();                 \
        o[d0] = __builtin_amdgcn_mfma_f32_32x32x16_bf16(pa0, (bf16x8){l0[0], l0[1], l0[2], l0[3], h0[0], h0[1], h0[2], h0[3]}, o[d0], 0, 0, 0);   \
        o[d0] = __builtin_amdgcn_mfma_f32_32x32x16_bf16(pa1, (bf16x8){l1[0], l1[1], l1[2], l1[3], h1[0], h1[1], h1[2], h1[3]}, o[d0], 0, 0, 0);   \
        o[d0] = __builtin_amdgcn_mfma_f32_32x32x16_bf16(pa2, (bf16x8){l2[0], l2[1], l2[2], l2[3], h2[0], h2[1], h2[2], h2[3]}, o[d0], 0, 0, 0);   \
        o[d0] = __builtin_amdgcn_mfma_f32_32x32x16_bf16(pa3, (bf16x8){l3[0], l3[1], l3[2], l3[3], h3[0], h3[1], h3[2], h3[3]}, o[d0], 0, 0, 0); } while (0)
    PV_D0(0); PV_D0(1); PV_D0(2); PV_D0(3);
#undef PV_D0
#undef TRRD
}

template <class TIn, class TOut> struct BlockRef { const unsigned char* ws; int row0, bh, P0, jlo;
    __device__ __forceinline__ const TIn* Q() const { return (const TIn*)(ws + WS_FQ) + (size_t)row0 * PITCH + (bh % H) * D; }
    __device__ __forceinline__ const TIn* K() const { return (const TIn*)(ws + WS_FK) + (size_t)(bh / H) * SQ * PITCH + (bh % H) * D; }
    __device__ __forceinline__ const TIn* V() const { return (const TIn*)(ws + WS_FV) + (size_t)(bh / H) * SQ * PITCH + (bh % H) * D; }
    __device__ __forceinline__ TOut* O() const { return (TOut*)(ws + WS_YB) + (size_t)row0 * PITCH + (bh % H) * D; }
    __device__ __forceinline__ const float* C() const { return (const float*)(ws + WS_CS) + (size_t)bh * SQ; }
    __device__ __forceinline__ const TIn* G() const { return (const TIn*)(ws + WS_P) + (size_t)row0 * GPITCH + PC_OG + (bh % H) * D; }
};
template <class TIn> struct Seam {
    bf16x8 qr[8];
    bf16x8 st_v0, st_v1, st_k0, st_k1; int cbi; f32x4 sf0, sf1, sf2, sf3;
    f32x4 tq[16];
};
__device__ __forceinline__ int swa_jlo(int P0, int W) { const int lowk = P0 - W + 1; return lowk > 0 ? lowk / KVBLK : 0; }
#define ROW(p, k0, rr) ((p) + (size_t)((k0) + (rr)) * PITCH + sc)
#define VMW() asm volatile("s_waitcnt vmcnt(0)" ::: "memory")
#define VMWN(n) asm volatile("s_waitcnt vmcnt(%0)" :: "i"(n) : "memory")
#define NEXT3(x) ((x) == 2 ? 0 : (x) + 1)
#define SLOAD_H(Kp, Vp, Cp, k0, CI) do { S.st_v0 = load8<TIn>(ROW(Vp, k0, sr)); S.st_v1 = load8<TIn>(ROW(Vp, k0, 32 + sr));              \
                         S.st_k0 = load8<TIn>(ROW(Kp, k0, sr)); S.st_k1 = load8<TIn>(ROW(Kp, k0, 32 + sr));                 \
                         if (wid == 0) __builtin_amdgcn_global_load_lds((const unsigned*)((Cp) + (k0) + lane), (__attribute__((address_space(3))) unsigned*)(lds + LDS_CB + (CI) * 256), 4, 0, 0); } while (0)
#define SWRITE_HK(bf) do { *(bf16x8*)(K_lds + (bf) * SHM_K + kws) = S.st_k0; *(bf16x8*)(K_lds + (bf) * SHM_K + kws + 32 * 256) = S.st_k1; } while (0)
#define SWRITE_HV(bf) do { *(bf16x8*)(V_lds + (bf) * SHM_V + vst0) = S.st_v0; *(bf16x8*)(V_lds + (bf) * SHM_V + vst1) = S.st_v1; } while (0)
#define SWRITE_H(bf) do { SWRITE_HV(bf); SWRITE_HK(bf); } while (0)
#define SLOAD_F(p, k0) do { S.sf0 = *(const f32x4*)ROW(p, k0, sr); S.sf1 = *(const f32x4*)(ROW(p, k0, sr) + 4);                \
                            S.sf2 = *(const f32x4*)ROW(p, k0, 32 + sr); S.sf3 = *(const f32x4*)(ROW(p, k0, 32 + sr) + 4); } while (0)
#define SWRITE_KF(bf) do { *(bf16x8*)(K_lds + (bf) * SHM_K + kws) = pack8(S.sf0, S.sf1); *(bf16x8*)(K_lds + (bf) * SHM_K + kws + 32 * 256) = pack8(S.sf2, S.sf3); } while (0)
#define SWRITE_VF(bf) do { *(bf16x8*)(V_lds + (bf) * SHM_V + vst0) = pack8(S.sf0, S.sf1); *(bf16x8*)(V_lds + (bf) * SHM_V + vst1) = pack8(S.sf2, S.sf3); } while (0)
template <class TIn, class TOut>
__device__ __forceinline__ void causal_swa_prime(const BlockRef<TIn, TOut>& cur, int W, char* lds, Seam<TIn>& S, const int tid) {
    constexpr bool F32 = same_t<TIn, float>::v;
    const int wid = __builtin_amdgcn_readfirstlane(tid >> 6), lane = tid & 63, r32 = lane & 31, hi = lane >> 5;
    const int sr = tid >> 4, sc = (tid & 15) * 8, kws = KSWZ(sr, sc * 2); char* K_lds = lds + 2 * SHM_V;
    const int kb0 = cur.jlo * KVBLK;
    for (int d0 = 0; d0 < 8; ++d0) S.qr[d0] = load8<TIn>(cur.Q() + (size_t)(wid * QBLK + r32) * PITCH + d0 * 16 + hi * 8);
    if constexpr (F32) { SLOAD_F((const float*)cur.K(), kb0); VMW(); SWRITE_KF(0); SBAR(); SLOAD_F((const float*)cur.V(), kb0); }
    else { S.cbi = 0; SLOAD_H(cur.K(), cur.V(), cur.C(), kb0, 0); VMW(); SWRITE_HK(0); }
    __syncthreads();
}
template <class TIn, class TOut>
__device__ __forceinline__ void causal_swa_block(const BlockRef<TIn, TOut>& cur, const BlockRef<TIn, TOut>& nxt, int skv, int W, char* lds, Seam<TIn>& S, const int tid) {
    constexpr bool F32 = same_t<TIn, float>::v;
    const int wid = __builtin_amdgcn_readfirstlane(tid >> 6), lane = tid & 63, r32 = lane & 31, hi = lane >> 5;
    const int j_lo = cur.jlo;
    int j_hi = (cur.P0 + QB - 1) / KVBLK + 1; if (j_hi > skv / KVBLK) j_hi = skv / KVBLK;
    const int NT = j_hi - j_lo;
    const int kbn = nxt.jlo * KVBLK;
    const int qlo = cur.P0 + wid * QBLK, qm = qlo + r32 - 4 * hi;
    char* V_lds = lds; char* K_lds = lds + 2 * SHM_V;
    float* ws = (float*)(lds + 2 * SHM_V + 2 * SHM_K) + wid * 64; float* li_l = ws, * al_l = ws + 32;
    float m_reg = -1e30f, l_reg = 0; f32x16 o[4] = {};
    const int sr = tid >> 4, sc = (tid & 15) * 8, vst0 = v_st(sr, sc), vst1 = v_st(32 + sr, sc), kws = KSWZ(sr, sc * 2);
    const int vb0 = (int)(uintptr_t)V_lds + v_rd_base(lane);
    const TIn* Kh = cur.K(); const TIn* Vh = cur.V(); const float* Ch = cur.C(); int cb_t = S.cbi;
    {
        const TIn* gsrc = cur.G() + (size_t)(wid * QBLK + (lane >> 4)) * GPITCH + (lane & 15) * 8;
#pragma unroll
        for (int i_ = 0; i_ < 8; ++i_) __builtin_amdgcn_global_load_lds((const unsigned*)(gsrc + (size_t)(4 * i_) * GPITCH), (__attribute__((address_space(3))) unsigned*)(lds + LDS_GATE + wid * 8192 + i_ * 1024), 16, 0, 0); }
#define RESC(a) do { if (__any((a) < 1.f)) { if (hi == 0) al_l[r32] = (a); asm volatile("s_waitcnt lgkmcnt(0)" ::: "memory");              \
                     for (int d_ = 0; d_ < 4; ++d_) for (int r = 0; r < 16; ++r) o[d_][r] *= al_l[crow(r, hi)]; } } while (0)
#define KBASE(t) ((j_lo + (t)) * KVBLK)
#define ACT(t) (KBASE(t) <= qlo + QBLK - 1 && KBASE(t) + KVBLK - 1 >= qlo - W + 1)
#define MASKT(P0_, P1_, t) do { const int kb_ = KBASE(t); if ((!SK || ACT(t)) && (kb_ + KVBLK - 1 > qlo || kb_ <= qlo + QBLK - 1 - W)) mask_tile(P0_, P1_, qm - kb_, (unsigned)W); } while (0)
    constexpr int NQL = F32 ? 16 : 8;
    constexpr bool SK = WSKIP && !F32;
#define SEAM_K0() do { VMWN(NQL); if constexpr (F32) { SWRITE_KF(0); SBAR(); SLOAD_F((const float*)nxt.V(), kbn); } else { SWRITE_HK(0); } SBAR(); } while (0)
    f32x16 pA0, pA1, pB0, pB1; float mnA, mnB, alA, alB; bf16x8 pa0, pa1, pa2, pa3;
    if constexpr (F32) { VMW(); SWRITE_VF(0); SBAR(); } else { SWRITE_HV(0); SBAR(); }
    if (NT > 1) { if constexpr (F32) SLOAD_F((const float*)Kh, KBASE(1)); else SLOAD_H(Kh, Vh, Ch, KBASE(1), NEXT3(cb_t)); }
    SBAR(); qkt<0, SK>(pA0, pA1, K_lds, r32, hi, S.qr, ACT(0), cb_t);
    if constexpr (F32) { if (NT > 1) { VMW(); SWRITE_KF(1); SBAR(); SLOAD_F((const float*)Vh, KBASE(1)); } }
    MASKT(pA0, pA1, 0); partialSM(pA0, pA1, m_reg, mnA, alA);
    if (NT > 1) { VMW(); if constexpr (F32) { SWRITE_VF(1); SBAR(); if (NT > 2) SLOAD_F((const float*)Kh, KBASE(2)); } else SWRITE_H(1); }
    __syncthreads();
#define HALF_STEP(PX0, PX1, mnX, alX, PY0, PY1, alY, t, KB, VB, SB) do {                                                      \
        SBAR(); cb_t = NEXT3(cb_t); qkt<KB, SK>(PX0, PX1, K_lds, r32, hi, S.qr, ACT(t), cb_t);                                             \
        finishSM(PY0, PY1, alY, l_reg, pa0, pa1, pa2, pa3); SBAR();                                                           \
        if ((t) + 1 < NT) { if constexpr (F32) { VMW(); SWRITE_KF(SB); SBAR(); SLOAD_F((const float*)Vh, KBASE((t) + 1)); }  \
                            else { SLOAD_H(Kh, Vh, Ch, KBASE((t) + 1), NEXT3(cb_t)); } SBAR(); }                                               \
        pv_tile<VB, SK>(o, vb0, pa0, pa1, pa2, pa3, ACT((t) - 1)); MASKT(PX0, PX1, (t)); partialSM(PX0, PX1, m_reg, mnX, alX);                                        \
        __syncthreads();                                                                                                      \
        if ((t) + 1 < NT) { VMW(); if constexpr (F32) { SWRITE_VF(SB); SBAR(); if ((t) + 2 < NT) SLOAD_F((const float*)Kh, KBASE((t) + 2)); } \
                            else { SWRITE_H(SB); } }                                                                          \
        RESC(alX); __syncthreads(); } while (0)
    for (int t = 1; t + 1 < NT; t += 2) {
        HALF_STEP(pB0, pB1, mnB, alB, pA0, pA1, alA, t, 1, 0, 0);
        HALF_STEP(pA0, pA1, mnA, alA, pB0, pB1, alB, t + 1, 0, 1, 1);
    }
    const bool even = (NT & 1) == 0;
    if (even) { SBAR(); cb_t = NEXT3(cb_t); qkt<1, SK>(pB0, pB1, K_lds, r32, hi, S.qr, ACT(NT - 1), cb_t); SBAR(); }
#define QROW(e) (nxt.Q() + (size_t)(wid * QBLK + r32) * PITCH + ((e) >> 1) * 16 + hi * 8 + ((e) & 1) * 4)
    if constexpr (F32) { SLOAD_F((const float*)nxt.K(), kbn); SBAR();
#pragma unroll
        for (int e = 0; e < 8; ++e) S.tq[e] = *(const f32x4*)QROW(e); }
    else { SLOAD_H(nxt.K(), nxt.V(), nxt.C(), kbn, NEXT3(cb_t)); S.cbi = NEXT3(cb_t); SBAR();
#pragma unroll
        for (int d0 = 0; d0 < 8; ++d0) S.qr[d0] = load8<TIn>(nxt.Q() + (size_t)(wid * QBLK + r32) * PITCH + d0 * 16 + hi * 8); }
    SBAR();
    finishSM(pA0, pA1, alA, l_reg, pa0, pa1, pa2, pa3); SBAR();
    if constexpr (F32) {
#pragma unroll
        for (int e = 8; e < 16; ++e) S.tq[e] = *(const f32x4*)QROW(e); SBAR(); }
#undef QROW
    pv_tile<0, SK>(o, vb0, pa0, pa1, pa2, pa3, ACT(even ? NT - 2 : NT - 1));
    if (even) { MASKT(pB0, pB1, NT - 1); partialSM(pB0, pB1, m_reg, mnB, alB); __syncthreads(); RESC(alB);
        finishSM(pB0, pB1, alB, l_reg, pa0, pa1, pa2, pa3); SBAR(); pv_tile<1, SK>(o, vb0, pa0, pa1, pa2, pa3, ACT(NT - 1)); }
    SBAR(); SEAM_K0();
    if (hi == 0) li_l[r32] = l_reg; asm volatile("s_waitcnt lgkmcnt(0)" ::: "memory");
    float rli[16];
#pragma unroll
    for (int r = 0; r < 16; ++r) rli[r] = __builtin_amdgcn_rcpf(li_l[crow(r, hi)]);
    int hi_e = hi; asm volatile("" : "+v"(hi_e));
    TOut* Ow = cur.O() + (size_t)(wid * QBLK) * PITCH + (size_t)(4 * hi_e) * PITCH; const char* gl_ = lds + LDS_GATE + wid * 8192 + 4 * hi_e * 256;
#pragma unroll
    for (int r = 0; r < 16; ++r) { const int orow = (r & 3) + 8 * (r >> 2);
#pragma unroll
        for (int d0 = 0; d0 < 4; ++d0) { const float v = o[d0][r] * rli[r];
            if constexpr (same_t<TOut, float>::v) { Ow[(size_t)orow * PITCH + d0 * 32 + r32] = v; }
            else { const float vn = __shfl_xor(v, 1);
                   if ((r32 & 1) == 0) { const unsigned gw_ = *(const unsigned*)(gl_ + orow * 256 + (d0 * 32 + r32) * 2);
                       const float g0_ = __uint_as_float(gw_ << 16), g1_ = __uint_as_float(gw_ & 0xffff0000u);
                       const float s0_ = __builtin_amdgcn_rcpf(1.f + __builtin_amdgcn_exp2f(-1.4426950408889634f * g0_)), s1_ = __builtin_amdgcn_rcpf(1.f + __builtin_amdgcn_exp2f(-1.4426950408889634f * g1_));
                       *(unsigned*)(Ow + (size_t)orow * PITCH + d0 * 32 + r32) = cvtpk(v * s0_, vn * s1_); } } } }
    if constexpr (F32) {
#pragma unroll
        for (int d0 = 0; d0 < 8; ++d0) S.qr[d0] = pack8(S.tq[2 * d0], S.tq[2 * d0 + 1]); }
    __syncthreads();
#undef RESC
#undef KBASE
#undef ACT
#undef MASKT
#undef SEAM_K0
#undef HALF_STEP
}
#undef ROW
#undef VMW
#undef VMWN
#undef SLOAD_H
#undef SWRITE_HK
#undef SWRITE_HV
#undef SWRITE_H
#undef SLOAD_F
#undef SWRITE_KF
#undef SWRITE_VF

}
#ifndef RW_SOLVE_OLD
#define RW_SOLVE_OLD 0
#endif
namespace rw {
typedef short bf16x8 __attribute__((ext_vector_type(8)));
typedef float f32x4 __attribute__((ext_vector_type(4)));
typedef unsigned u32x4 __attribute__((ext_vector_type(4)));
typedef unsigned u32x2 __attribute__((ext_vector_type(2)));
#define RW_LAS __attribute__((address_space(3)))
constexpr int PB = 144, PF = 272, MB = 64 * PB;
constexpr int O_R = 0, O_K = MB, O_A = 2 * MB, O_B = 3 * MB, O_BT = 4 * MB, O_KT = 5 * MB, O_VT = 6 * MB, O_AAK = 7 * MB, O_ARB = 8 * MB, O_ARK = 9 * MB;
constexpr int O_AAB = 10 * MB, O_GT = O_AAB + 64 * PF, O_GAM = O_GT + 64 * PF, O_TOT = O_GAM + 256, O_END = O_TOT + 2048;
constexpr int O_AABB = O_END, O_TB = O_AABB + MB, O_END2 = O_TB + 4 * 768;
constexpr int O_WT = O_K, O_UT = O_AAK;
static_assert(O_END2 <= 143360, "phase A LDS map");
constexpr int REC = 32768, REC_P = 0, REC_Q = 8192, REC_H = 16384, REC_Y = 24576;
typedef float f32x2_t __attribute__((ext_vector_type(2))); typedef __bf16 bf16x2_t __attribute__((ext_vector_type(2)));
__device__ __forceinline__ unsigned cvtpk(float lo, float hi) { f32x2_t v = {lo, hi}; bf16x2_t b = __builtin_convertvector(v, bf16x2_t); return __builtin_bit_cast(unsigned, b); }
__device__ __forceinline__ float blo(unsigned w) { return __uint_as_float(w << 16); }
__device__ __forceinline__ float bhi(unsigned w) { return __uint_as_float(w & 0xffff0000u); }
__device__ __forceinline__ bf16x8 frag(const RW_LAS unsigned char* base, int tile, int ks, int lane) { return *(const RW_LAS bf16x8*)(base + (16 * tile + (lane & 15)) * PB + (ks * 32 + 8 * (lane >> 4)) * 2); }
#define RW_MFMA(a, b, c) __builtin_amdgcn_mfma_f32_16x16x32_bf16(a, b, c, 0, 0, 0)
#define RW_SYNC() __syncthreads()
#define RW_BAR() do { asm volatile("" ::: "memory"); __builtin_amdgcn_s_barrier(); asm volatile("" ::: "memory"); } while (0)

struct ChunkIn { u32x4 r, k, v, a; f32x4 l0, l1; };
__device__ __forceinline__ void load_chunk(ChunkIn& c, const unsigned char* ws, int it, int tid) {
    const int bh = it >> 8, ch = it & 255, b = bh >> 4, h = bh & 15, tok = tid >> 3, part = tid & 7;
    const size_t off = ((size_t)b * SEQ + (size_t)ch * 64 + tok) * 1024 + h * 64 + 8 * part;
    c.r = *(const u32x4*)((const unsigned short*)(ws + WS_R) + off); c.k = *(const u32x4*)((const unsigned short*)(ws + WS_K) + off); c.v = *(const u32x4*)((const unsigned short*)(ws + WS_V) + off);
    c.a = *(const u32x4*)((const unsigned short*)(ws + WS_A) + off); c.l0 = *(const f32x4*)((const float*)(ws + WS_LOGW) + off); c.l1 = *(const f32x4*)((const float*)(ws + WS_LOGW) + off + 4);
}
__device__ __forceinline__ void phase_a(RW_LAS unsigned char* L, unsigned char* ws, const float* kk_all, const float* ka_all, int wg, int G, int tid) {
    const int lane = tid & 63, w = __builtin_amdgcn_readfirstlane(tid >> 6), g = lane >> 4, l15 = lane & 15;
    ChunkIn cin; if (wg < 8192) load_chunk(cin, ws, wg, tid);
  for (int it = wg; it < 8192; it += G) {
    unsigned char* rec = ws + WS_REC + (size_t)it * REC; const float* kkw_g = kk_all + ((it >> 8) & 15) * 64; const float* kaw_g = ka_all + ((it >> 8) & 15) * 64;
    { const int tok = tid >> 3, part = tid & 7, c0 = 8 * part;
      const u32x4 rw_ = cin.r, kw_ = cin.k, vw_ = cin.v, aw_ = cin.a; const f32x4 l0 = cin.l0, l1 = cin.l1;
      float lw[8] = {l0[0], l0[1], l0[2], l0[3], l1[0], l1[1], l1[2], l1[3]}, cum[8];
#pragma unroll
      for (int i = 0; i < 8; ++i) { float v = lw[i];
          float u = __shfl_up(v, 8); if (lane >= 8) v += u; u = __shfl_up(v, 16); if (lane >= 16) v += u; u = __shfl_up(v, 32); if (lane >= 32) v += u; cum[i] = v; }
      RW_LAS float* tot = (RW_LAS float*)(L + O_TOT);
      if (lane >= 56) {
#pragma unroll
          for (int i = 0; i < 8; ++i) tot[w * 64 + c0 + i] = cum[i]; }
      RW_SYNC();
#pragma unroll
      for (int ww = 0; ww < 7; ++ww) if (ww < w) { const f32x4 a0 = *(const RW_LAS f32x4*)(tot + ww * 64 + c0), a1 = *(const RW_LAS f32x4*)(tot + ww * 64 + c0 + 4);
#pragma unroll
          for (int i = 0; i < 4; ++i) { cum[i] += a0[i]; cum[4 + i] += a1[i]; } }
      float r[8] = {blo(rw_.x), bhi(rw_.x), blo(rw_.y), bhi(rw_.y), blo(rw_.z), bhi(rw_.z), blo(rw_.w), bhi(rw_.w)};
      float k[8] = {blo(kw_.x), bhi(kw_.x), blo(kw_.y), bhi(kw_.y), blo(kw_.z), bhi(kw_.z), blo(kw_.w), bhi(kw_.w)};
      float a[8] = {blo(aw_.x), bhi(aw_.x), blo(aw_.y), bhi(aw_.y), blo(aw_.z), bhi(aw_.z), blo(aw_.w), bhi(aw_.w)};
      const f32x4 kk0 = *(const f32x4*)(kkw_g + c0), kk1 = *(const f32x4*)(kkw_g + c0 + 4), ka0 = *(const f32x4*)(kaw_g + c0), ka1 = *(const f32x4*)(kaw_g + c0 + 4);
      float kk[8], ss = 0.f;
#pragma unroll
      for (int i = 0; i < 8; ++i) { kk[i] = k[i] * (i < 4 ? kk0[i] : kk1[i - 4]); ss += kk[i] * kk[i]; }
      ss += __shfl_xor(ss, 1); ss += __shfl_xor(ss, 2); ss += __shfl_xor(ss, 4);
      const float inv = 1.f / fmaxf(sqrtf(ss), 1e-12f);
      float Rt[8], Kt[8], At[8], Bt[8];
#pragma unroll
      for (int i = 0; i < 8; ++i) { const float eL = __expf(cum[i]), eLi = __expf(-cum[i]), eLx = __expf(cum[i] - lw[i]); const float kn = kk[i] * inv;
          Rt[i] = r[i] * eL; Kt[i] = k[i] * (1.f + (a[i] - 1.f) * (i < 4 ? ka0[i] : ka1[i - 4])) * eLi; At[i] = -kn * eLx; Bt[i] = kn * a[i] * eLi;
          if (tok == 63) ((RW_LAS float*)(L + O_GAM))[c0 + i] = eL; }
      u32x4 o;
      o.x = cvtpk(Rt[0], Rt[1]); o.y = cvtpk(Rt[2], Rt[3]); o.z = cvtpk(Rt[4], Rt[5]); o.w = cvtpk(Rt[6], Rt[7]); *(RW_LAS u32x4*)(L + O_R + tok * PB + c0 * 2) = o;
      o.x = cvtpk(Kt[0], Kt[1]); o.y = cvtpk(Kt[2], Kt[3]); o.z = cvtpk(Kt[4], Kt[5]); o.w = cvtpk(Kt[6], Kt[7]); *(RW_LAS u32x4*)(L + O_K + tok * PB + c0 * 2) = o;
      const u32x4 kq = o;
      o.x = cvtpk(At[0], At[1]); o.y = cvtpk(At[2], At[3]); o.z = cvtpk(At[4], At[5]); o.w = cvtpk(At[6], At[7]); *(RW_LAS u32x4*)(L + O_A + tok * PB + c0 * 2) = o;
      o.x = cvtpk(Bt[0], Bt[1]); o.y = cvtpk(Bt[2], Bt[3]); o.z = cvtpk(Bt[4], Bt[5]); o.w = cvtpk(Bt[6], Bt[7]); *(RW_LAS u32x4*)(L + O_B + tok * PB + c0 * 2) = o;
      const unsigned bq[4] = {o.x, o.y, o.z, o.w}, kq4[4] = {kq.x, kq.y, kq.z, kq.w}, vq[4] = {vw_.x, vw_.y, vw_.z, vw_.w};
#pragma unroll
      for (int i = 0; i < 8; ++i) { const int sh = (i & 1) * 16;
          *(RW_LAS unsigned short*)(L + O_BT + (c0 + i) * PB + tok * 2) = (unsigned short)(bq[i >> 1] >> sh);
          *(RW_LAS unsigned short*)(L + O_KT + (c0 + i) * PB + tok * 2) = (unsigned short)(kq4[i >> 1] >> sh);
          *(RW_LAS unsigned short*)(L + O_VT + (c0 + i) * PB + tok * 2) = (unsigned short)(vq[i >> 1] >> sh); }
    }
    if (it + G < 8192) load_chunk(cin, ws, it + G, tid);
    RW_SYNC();
    const int t4 = w & 3, p2 = (w >> 2) * 2;
    { const bf16x8 b0 = frag(L + O_B, t4, 0, lane), b1 = frag(L + O_B, t4, 1, lane), k0 = frag(L + O_K, t4, 0, lane), k1 = frag(L + O_K, t4, 1, lane);
#pragma unroll
      for (int u = 0; u < 2; ++u) { const int nt = p2 + u, t = 16 * nt + l15, s0 = 16 * t4 + 4 * g;
          f32x4 ab = {0.f, 0.f, 0.f, 0.f}, ak = ab, rb = ab, rk = ab;
          if (t4 <= nt) { const bf16x8 a0 = frag(L + O_A, nt, 0, lane), a1 = frag(L + O_A, nt, 1, lane), r0 = frag(L + O_R, nt, 0, lane), r1 = frag(L + O_R, nt, 1, lane);
              ab = RW_MFMA(b0, a0, ab); ab = RW_MFMA(b1, a1, ab); ak = RW_MFMA(k0, a0, ak); ak = RW_MFMA(k1, a1, ak);
              rb = RW_MFMA(b0, r0, rb); rb = RW_MFMA(b1, r1, rb); rk = RW_MFMA(k0, r0, rk); rk = RW_MFMA(k1, r1, rk);
#pragma unroll
              for (int r = 0; r < 4; ++r) { const int s = s0 + r; if (!(s < t)) { ab[r] = 0.f; ak[r] = 0.f; } if (!(s <= t)) { rb[r] = 0.f; rk[r] = 0.f; } } }
          *(RW_LAS f32x4*)(L + O_AAB + t * PF + s0 * 4) = ab;
          u32x2 o; o.x = cvtpk(ab[0], ab[1]); o.y = cvtpk(ab[2], ab[3]); *(RW_LAS u32x2*)(L + O_AABB + t * PB + s0 * 2) = o;
          o.x = cvtpk(ak[0], ak[1]); o.y = cvtpk(ak[2], ak[3]); *(RW_LAS u32x2*)(L + O_AAK + t * PB + s0 * 2) = o;
          o.x = cvtpk(rb[0], rb[1]); o.y = cvtpk(rb[2], rb[3]); *(RW_LAS u32x2*)(L + O_ARB + t * PB + s0 * 2) = o;
          o.x = cvtpk(rk[0], rk[1]); o.y = cvtpk(rk[2], rk[3]); *(RW_LAS u32x2*)(L + O_ARK + t * PB + s0 * 2) = o; } }
    RW_SYNC();
    { const bf16x8 a0 = frag(L + O_AAK, t4, 0, lane), a1 = frag(L + O_AAK, t4, 1, lane);
#pragma unroll
      for (int u = 0; u < 2; ++u) { const int nt = p2 + u; f32x4 acc = {0.f, 0.f, 0.f, 0.f};
          acc = RW_MFMA(a0, frag(L + O_VT, nt, 0, lane), acc); acc = RW_MFMA(a1, frag(L + O_VT, nt, 1, lane), acc);
          *(RW_LAS f32x4*)(L + O_GT + (16 * nt + l15) * PF + (16 * t4 + 4 * g) * 4) = acc; } }
    if (w < 4 && lane < 16) {
        float x[16]; const RW_LAS unsigned char* ab = L + O_AAB + 16 * w * PF + 16 * w * 4;
#pragma unroll
        for (int r = 0; r < 16; ++r) { float a0 = (r == lane) ? 1.f : 0.f, a1 = 0.f;
#pragma unroll
            for (int q4 = 0; q4 < (r + 3) / 4; ++q4) { const f32x4 av = *(const RW_LAS f32x4*)(ab + r * PF + q4 * 16);
                if (4 * q4 + 0 < r) a0 += av[0] * x[4 * q4 + 0]; if (4 * q4 + 1 < r) a1 += av[1] * x[4 * q4 + 1]; if (4 * q4 + 2 < r) a0 += av[2] * x[4 * q4 + 2]; if (4 * q4 + 3 < r) a1 += av[3] * x[4 * q4 + 3]; }
            x[r] = a0 + a1; *(RW_LAS unsigned short*)(L + O_TB + w * 768 + r * 48 + lane * 2) = (unsigned short)(cvtpk(x[r], 0.f) & 0xffffu); } }
    RW_SYNC();
#if RW_SOLVE_OLD
    if (tid < 128) { const int c = tid;
        const RW_LAS unsigned char* rhs = c < 64 ? (L + O_A + c * 2) : (L + O_GT + (c - 64) * PF);
        RW_LAS unsigned char* dst = c < 64 ? (L + O_WT + c * PB) : (L + O_UT + (c - 64) * PB);
        for (int b = 0; b < 4; ++b) { float z[16];
#pragma unroll
            for (int r = 0; r < 16; ++r) z[r] = c < 64 ? blo((unsigned)*(const RW_LAS unsigned short*)(rhs + (16 * b + r) * PB)) : *(const RW_LAS float*)(rhs + (16 * b + r) * 4);
            const RW_LAS unsigned char* arow = L + O_AAB + 16 * b * PF;
            for (int s4 = 0; s4 < 4 * b; ++s4) { const u32x2 xw = *(const RW_LAS u32x2*)(dst + s4 * 8); const float x0 = blo(xw.x), x1 = bhi(xw.x), x2 = blo(xw.y), x3 = bhi(xw.y);
#pragma unroll
                for (int r = 0; r < 16; ++r) { const f32x4 av = *(const RW_LAS f32x4*)(arow + r * PF + s4 * 16); z[r] += (av[0] * x0 + av[1] * x1) + (av[2] * x2 + av[3] * x3); } }
#pragma unroll
            for (int r = 1; r < 16; ++r) {
#pragma unroll
                for (int q4 = 0; q4 < (r + 3) / 4; ++q4) { const f32x4 av = *(const RW_LAS f32x4*)(arow + r * PF + (4 * b + q4) * 16);
                    if (4 * q4 + 0 < r) z[r] += av[0] * z[4 * q4 + 0]; if (4 * q4 + 1 < r) z[r] += av[1] * z[4 * q4 + 1]; if (4 * q4 + 2 < r) z[r] += av[2] * z[4 * q4 + 2]; if (4 * q4 + 3 < r) z[r] += av[3] * z[4 * q4 + 3]; } }
            u32x4 o; o.x = cvtpk(z[0], z[1]); o.y = cvtpk(z[2], z[3]); o.z = cvtpk(z[4], z[5]); o.w = cvtpk(z[6], z[7]); *(RW_LAS u32x4*)(dst + 32 * b) = o;
            o.x = cvtpk(z[8], z[9]); o.y = cvtpk(z[10], z[11]); o.z = cvtpk(z[12], z[13]); o.w = cvtpk(z[14], z[15]); *(RW_LAS u32x4*)(dst + 32 * b + 16) = o;
            asm volatile("s_waitcnt lgkmcnt(0)" ::: "memory"); } }
    RW_SYNC();
#else
    { RW_LAS unsigned char* xt = (w < 4 ? L + O_WT : L + O_UT) + (w & 3) * 16 * PB;
      { const u32x4 z4 = {0u, 0u, 0u, 0u}; *(RW_LAS u32x4*)(xt + l15 * PB + g * 16) = z4; *(RW_LAS u32x4*)(xt + l15 * PB + 64 + g * 16) = z4; }
      asm volatile("s_waitcnt lgkmcnt(0)" ::: "memory");
#pragma unroll
      for (int b = 0; b < 4; ++b) { f32x4 z;
          if (w < 4) { const RW_LAS unsigned char* ap = L + O_A + (16 * b + 4 * g) * PB + (16 * w + l15) * 2;
              z = (f32x4){blo((unsigned)*(const RW_LAS unsigned short*)(ap)), blo((unsigned)*(const RW_LAS unsigned short*)(ap + PB)), blo((unsigned)*(const RW_LAS unsigned short*)(ap + 2 * PB)), blo((unsigned)*(const RW_LAS unsigned short*)(ap + 3 * PB))}; }
          else z = *(const RW_LAS f32x4*)(L + O_GT + (16 * (w - 4) + l15) * PF + (16 * b + 4 * g) * 4);
          if (b > 0) { z = RW_MFMA(frag(L + O_AABB, b, 0, lane), *(const RW_LAS bf16x8*)(xt + l15 * PB + (8 * g) * 2), z);
                       if (b > 2) z = RW_MFMA(frag(L + O_AABB, b, 1, lane), *(const RW_LAS bf16x8*)(xt + l15 * PB + (32 + 8 * g) * 2), z); }
          const u32x2 tw = *(const RW_LAS u32x2*)(L + O_TB + b * 768 + l15 * 48 + (4 * g) * 2);
          const u32x4 tf = {tw.x, tw.y, 0u, 0u}, zf = {cvtpk(z[0], z[1]), cvtpk(z[2], z[3]), 0u, 0u};
          f32x4 xb = {0.f, 0.f, 0.f, 0.f}; xb = RW_MFMA(__builtin_bit_cast(bf16x8, tf), __builtin_bit_cast(bf16x8, zf), xb);
          u32x2 o; o.x = cvtpk(xb[0], xb[1]); o.y = cvtpk(xb[2], xb[3]); *(RW_LAS u32x2*)(xt + l15 * PB + (16 * b + 4 * g) * 2) = o;
          asm volatile("s_waitcnt lgkmcnt(0)" ::: "memory"); } }
    RW_SYNC();
#endif
    {
      const bf16x8 rb0 = frag(L + O_ARB, t4, 0, lane), rb1 = frag(L + O_ARB, t4, 1, lane), bt0 = frag(L + O_BT, t4, 0, lane), bt1 = frag(L + O_BT, t4, 1, lane);
      const int col = 16 * t4 + l15; const float gam = ((const RW_LAS float*)(L + O_GAM))[col];
      unsigned qw[4], pw[4];
#pragma unroll
      for (int u = 0; u < 2; ++u) { const int mt = p2 + u, j0 = 16 * mt + 4 * g; const bf16x8 w0 = frag(L + O_WT, mt, 0, lane), w1 = frag(L + O_WT, mt, 1, lane);
          f32x4 q = {0.f, 0.f, 0.f, 0.f}, p = q; q = RW_MFMA(w0, rb0, q); q = RW_MFMA(w1, rb1, q); p = RW_MFMA(w0, bt0, p); p = RW_MFMA(w1, bt1, p);
          const u32x2 rr = *(const RW_LAS u32x2*)(L + O_R + col * PB + j0 * 2);
          q[0] += blo(rr.x); q[1] += bhi(rr.x); q[2] += blo(rr.y); q[3] += bhi(rr.y);
#pragma unroll
          for (int r = 0; r < 4; ++r) p[r] = (p[r] + ((j0 + r) == col ? 1.f : 0.f)) * gam;
          qw[2 * u] = cvtpk(q[0], q[1]); qw[2 * u + 1] = cvtpk(q[2], q[3]); pw[2 * u] = cvtpk(p[0], p[1]); pw[2 * u + 1] = cvtpk(p[2], p[3]); }
      const int fo = ((t4 * 2 + (p2 >> 1)) * 64 + lane) * 16;
      *(u32x4*)(rec + REC_Q + fo) = (u32x4){qw[0], qw[1], qw[2], qw[3]}; *(u32x4*)(rec + REC_P + fo) = (u32x4){pw[0], pw[1], pw[2], pw[3]}; }
    {
      const bf16x8 rb0 = frag(L + O_ARB, t4, 0, lane), rb1 = frag(L + O_ARB, t4, 1, lane), rk0 = frag(L + O_ARK, t4, 0, lane), rk1 = frag(L + O_ARK, t4, 1, lane);
      const bf16x8 ut0 = frag(L + O_UT, t4, 0, lane), ut1 = frag(L + O_UT, t4, 1, lane), vt0 = frag(L + O_VT, t4, 0, lane), vt1 = frag(L + O_VT, t4, 1, lane);
      const int col = 16 * t4 + l15;
#pragma unroll
      for (int u = 0; u < 2; ++u) { const int mt = p2 + u, m0 = 16 * mt + 4 * g;
          f32x4 y = {0.f, 0.f, 0.f, 0.f}, hm = y;
          y = RW_MFMA(frag(L + O_UT, mt, 0, lane), rb0, y); y = RW_MFMA(frag(L + O_UT, mt, 1, lane), rb1, y); y = RW_MFMA(frag(L + O_VT, mt, 0, lane), rk0, y); y = RW_MFMA(frag(L + O_VT, mt, 1, lane), rk1, y);
          hm = RW_MFMA(frag(L + O_BT, mt, 0, lane), ut0, hm); hm = RW_MFMA(frag(L + O_BT, mt, 1, lane), ut1, hm); hm = RW_MFMA(frag(L + O_KT, mt, 0, lane), vt0, hm); hm = RW_MFMA(frag(L + O_KT, mt, 1, lane), vt1, hm);
          const f32x4 gm = *(const RW_LAS f32x4*)(L + O_GAM + m0 * 4);
          u32x2 o; o.x = cvtpk(y[0], y[1]); o.y = cvtpk(y[2], y[3]); *(u32x2*)(rec + REC_Y + (col * 64 + m0) * 2) = o;
          o.x = cvtpk(hm[0] * gm[0], hm[1] * gm[1]); o.y = cvtpk(hm[2] * gm[2], hm[3] * gm[3]); *(u32x2*)(rec + REC_H + (col * 64 + m0) * 2) = o; } }
    RW_SYNC();
  }
}

__device__ __forceinline__ void phase_b_head(RW_LAS unsigned char* L, const unsigned char* recs, float* Yg, int tid) {
    constexpr int NCH = 256, NSLOT = 4;
    const int lane = tid & 63, w = __builtin_amdgcn_readfirstlane(tid >> 6), g = lane >> 4, l15 = lane & 15;
    if (w >= 4) {
        const int lw = w - 4; const unsigned char* src = recs + lw * 8192 + lane * 16;
#define RW_ISSUE(c_) do { _Pragma("unroll") for (int k_ = 0; k_ < 8; ++k_) __builtin_amdgcn_global_load_lds((const unsigned*)(src + (size_t)(c_) * REC + k_ * 1024), (RW_LAS unsigned*)(L + ((c_) & 3) * REC + lw * 8192 + k_ * 1024), 16, 0, 0); } while (0)
        RW_ISSUE(0); RW_ISSUE(1); RW_ISSUE(2);
        asm volatile("s_waitcnt vmcnt(16)" ::: "memory");
        RW_BAR();
        for (int c = 0; c < NCH; ++c) {
            if (c + 3 < NCH) { RW_ISSUE(c + 3); asm volatile("s_waitcnt vmcnt(16)" ::: "memory"); }
            else asm volatile("s_waitcnt vmcnt(0)" ::: "memory");
            RW_BAR();
        }
#undef RW_ISSUE
    } else {
        f32x4 sacc[4];
#pragma unroll
        for (int m = 0; m < 4; ++m) sacc[m] = (f32x4){0.f, 0.f, 0.f, 0.f};
        RW_BAR();
        for (int c = 0; c < NCH; ++c) { const RW_LAS unsigned char* sl = L + (c & 3) * REC;
            bf16x8 bf[2];
#pragma unroll
            for (int s = 0; s < 2; ++s) { u32x4 v; v.x = cvtpk(sacc[2 * s][0], sacc[2 * s][1]); v.y = cvtpk(sacc[2 * s][2], sacc[2 * s][3]); v.z = cvtpk(sacc[2 * s + 1][0], sacc[2 * s + 1][1]); v.w = cvtpk(sacc[2 * s + 1][2], sacc[2 * s + 1][3]); bf[s] = __builtin_bit_cast(bf16x8, v); }
            f32x4 sn[4];
#pragma unroll
            for (int m = 0; m < 4; ++m) { const u32x2 hw = *(const RW_LAS u32x2*)(sl + REC_H + ((16 * w + l15) * 64 + 16 * m + 4 * g) * 2);
                f32x4 acc = {blo(hw.x), bhi(hw.x), blo(hw.y), bhi(hw.y)};
                acc = RW_MFMA(*(const RW_LAS bf16x8*)(sl + REC_P + ((m * 2 + 0) * 64 + lane) * 16), bf[0], acc);
                acc = RW_MFMA(*(const RW_LAS bf16x8*)(sl + REC_P + ((m * 2 + 1) * 64 + lane) * 16), bf[1], acc); sn[m] = acc; }
#pragma unroll
            for (int n = 0; n < 4; ++n) { const u32x2 yw = *(const RW_LAS u32x2*)(sl + REC_Y + ((16 * n + l15) * 64 + 16 * w + 4 * g) * 2);
                f32x4 acc = {blo(yw.x), bhi(yw.x), blo(yw.y), bhi(yw.y)};
                acc = RW_MFMA(bf[0], *(const RW_LAS bf16x8*)(sl + REC_Q + ((n * 2 + 0) * 64 + lane) * 16), acc);
                acc = RW_MFMA(bf[1], *(const RW_LAS bf16x8*)(sl + REC_Q + ((n * 2 + 1) * 64 + lane) * 16), acc);
                *(f32x4*)(Yg + (size_t)(c * 64 + 16 * n + l15) * 1024 + 16 * w + 4 * g) = acc; }
#pragma unroll
            for (int m = 0; m < 4; ++m) sacc[m] = sn[m];
            asm volatile("s_waitcnt lgkmcnt(0)" ::: "memory");
            RW_BAR();
        }
    }
}
}
#define XB_TMO      128
#define XB_XCNT(j)  (256  + 64 * (j))
#define XB_XSUB(j)  (1280 + 64 * (j))
#define XB_XGEN(j)  (2304 + 64 * (j))
#define XB_TOP      3328
#define XB_TOPGEN   3392
#define XCD_BAR_WORDS 3456
#define XB_SPIN_CAP (1u << 18)

__device__ __forceinline__ unsigned xb_ld(unsigned* p)              { return __hip_atomic_load(p, __ATOMIC_RELAXED, __HIP_MEMORY_SCOPE_AGENT); }
__device__ __forceinline__ unsigned xb_add(unsigned* p, unsigned v) { return __hip_atomic_fetch_add(p, v, __ATOMIC_RELAXED, __HIP_MEMORY_SCOPE_AGENT); }
__device__ __forceinline__ unsigned xb_xcc_id() { return (unsigned)__builtin_amdgcn_s_getreg((3 << 11) | 20) & 0xFu; }
#define XB_SPIN(cond, bar) do { unsigned _sp = 0; while (cond) { __builtin_amdgcn_s_sleep(1); \
    if ((++_sp & 255u) == 0u) { if (xb_ld(&(bar)[XB_TMO])) break; if (_sp > XB_SPIN_CAP) { atomicAdd(&(bar)[XB_TMO], 1u); break; } } } } while (0)

struct XcdBarrier {
    unsigned* bar; unsigned x;
    volatile LAS unsigned* st;
};

__device__ __forceinline__ XcdBarrier xcd_barrier_post(unsigned* bar, volatile LAS unsigned* st, const int tid) {
    XcdBarrier b; b.bar = bar; b.x = xb_xcc_id(); b.st = st;
    if (tid == 0) (void)xb_add(&bar[XB_XCNT(b.x)], 1u);
    return b;
}
__device__ __forceinline__ void xcd_barrier_complete(unsigned* bar, unsigned x, unsigned& nloc, unsigned& nx) {
    const unsigned G = gridDim.x * gridDim.y * gridDim.z;
    unsigned sum, cnt, mine, sp = 0u;
    for (;;) {
        sum = 0u; cnt = 0u; mine = 0u;
#pragma unroll
        for (unsigned j = 0; j < 16; ++j) { const unsigned c = xb_ld(&bar[XB_XCNT(j)]); sum += c; cnt += (c > 0u) ? 1u : 0u; mine = (j == x) ? c : mine; }
        if (sum == G) break;
        __builtin_amdgcn_s_sleep(1);
        if ((++sp & 255u) == 0u) { if (xb_ld(&bar[XB_TMO])) break; if (sp > XB_SPIN_CAP) { atomicAdd(&bar[XB_TMO], 1u); break; } }
    }
    nloc = mine > 0u ? mine : 1u; nx = cnt > 0u ? cnt : 1u;
}

__device__ __forceinline__ void xcd_barrier(const XcdBarrier& b, const int tid) {
    asm volatile("s_waitcnt vmcnt(0)" ::: "memory");
    __syncthreads();
    if (tid == 0) {
        unsigned* bar = b.bar;
        __builtin_amdgcn_s_waitcnt(0);
        unsigned nloc = b.st[0], nx = b.st[1];
        if (nloc == 0u) { xcd_barrier_complete(bar, b.x, nloc, nx); b.st[0] = nloc; b.st[1] = nx; }
        const unsigned old = xb_add(&bar[XB_XSUB(b.x)], 1u);
        const unsigned gen = old / nloc;
        if (old + 1u == (gen + 1u) * nloc) {
            __builtin_amdgcn_fence(__ATOMIC_RELEASE, "agent");
            asm volatile("s_waitcnt vmcnt(0)" ::: "memory");
            const unsigned og = xb_add(&bar[XB_TOP], 1u);
            const unsigned tg = og / nx;
            if (og + 1u == (tg + 1u) * nx) xb_add(&bar[XB_TOPGEN], 1u);
            else XB_SPIN(xb_ld(&bar[XB_TOPGEN]) == tg, bar);
            __builtin_amdgcn_fence(__ATOMIC_ACQUIRE, "agent");
            xb_add(&bar[XB_XGEN(b.x)], 1u);
            asm volatile("s_waitcnt vmcnt(0)" ::: "memory");
        } else {
            XB_SPIN(xb_ld(&bar[XB_XGEN(b.x)]) == gen, bar);
            __builtin_amdgcn_fence(__ATOMIC_ACQUIRE, "agent");
            asm volatile("s_waitcnt vmcnt(0)" ::: "memory");
        }
    }
    __syncthreads();
}
enum InIdx { I_X = 0, I_C, I_WADA, I_BADA, I_N1G, I_WIN, I_MU, I_WDEC, I_W0, I_WICLR, I_A0, I_WGATE, I_KK, I_KA, I_RK, I_GNG, I_GNB, I_WOA, I_BF, I_QN, I_KN, I_WOB, I_WOUT, I_N2G, I_WR, I_BR, I_WGU, I_BGU, I_WDN, I_BDN, I_NFG, N_IN };
struct Args { const float* in[N_IN]; float* out; unsigned char* ws; int ph_lo, ph_hi; };
static_assert(sizeof(Args) == (N_IN + 2) * 8 + 8, "Args has no padding");
typedef const __attribute__((address_space(4))) Args* ArgsP;
struct Frame {
    LAS unsigned char* lds;
    volatile LAS unsigned* MISC;
    gu32* ctl;
    int tid, lane, wave, G, wg;
    unsigned char* ws;
    ArgsP ap;
};
#define WSP(T_, off) ((T_*)(F.ws + (off)))

__device__ __forceinline__ int win_orig_col(int c) {
    if (c < PC_FQ) return c;
    if (c < PC_OG) return 3520 + (c - PC_FQ);
    if (c < PC_GA) return 6600 + (c - PC_OG);
    if (c < PC_GLO) return 7624 + (c - PC_GA);
    if (c < PC_DLO) return 3264 + (c - PC_GLO);
    if (c < PC_ALO) return 3072 + (c - PC_DLO);
    if (c < PC_F) return 3168 + (c - PC_ALO);
    if (c < PC_END) return 6592 + (c - PC_F);
    return -1;
}
__device__ __forceinline__ void tr_item(const float* W, int ldw, int K, bf16* WT, int drow0, int scol0, int nvalid, int k0, LAS float* scr, int lane) {
    const int n = lane & 31;
#pragma unroll 8
    for (int i = 0; i < 32; ++i) { const int kk = 2 * i + (lane >> 5); scr[kk * 33 + n] = (n < nvalid) ? W[(size_t)(k0 + kk) * ldw + scol0 + n] : 0.f; }
    LDS_WAIT(); asm volatile("" ::: "memory");
    const int c = lane & 7;
#pragma unroll
    for (int j = 0; j < 4; ++j) { const int nn = (lane >> 3) + 8 * j; const LAS float* s = scr + (8 * c) * 33 + nn;
        v4u o; o.x = pk2(s[0 * 33], s[1 * 33]); o.y = pk2(s[2 * 33], s[3 * 33]); o.z = pk2(s[4 * 33], s[5 * 33]); o.w = pk2(s[6 * 33], s[7 * 33]);
        *(GAS v4u*)(WT + (size_t)(drow0 + nn) * K + k0 + 8 * c) = o; }
    LDS_WAIT(); asm volatile("" ::: "memory");
}
__device__ __forceinline__ unsigned pk4_fp8(float a, float b, float c, float d) { int w = __builtin_amdgcn_cvt_pk_fp8_f32(a, b, 0, false); w = __builtin_amdgcn_cvt_pk_fp8_f32(c, d, w, true); return (unsigned)w; }
__device__ __forceinline__ void tr_item8(const float* W, int ldw, int K, unsigned char* WT, int drow0, int scol0, int nvalid, int k0, float scale, LAS float* scr, int lane) {
    const int n = lane & 31;
#pragma unroll 8
    for (int i = 0; i < 32; ++i) { const int kk = 2 * i + (lane >> 5); scr[kk * 33 + n] = (n < nvalid) ? W[(size_t)(k0 + kk) * ldw + scol0 + n] * scale : 0.f; }
    LDS_WAIT(); asm volatile("" ::: "memory");
    const int c = lane & 7;
#pragma unroll
    for (int j = 0; j < 4; ++j) { const int nn = (lane >> 3) + 8 * j; const LAS float* s = scr + (8 * c) * 33 + nn;
        v2u o; o.x = pk4_fp8(s[0 * 33], s[1 * 33], s[2 * 33], s[3 * 33]); o.y = pk4_fp8(s[4 * 33], s[5 * 33], s[6 * 33], s[7 * 33]);
        *(GAS v2u*)(WT + (size_t)(drow0 + nn) * K + k0 + 8 * c) = o; }
    LDS_WAIT(); asm volatile("" ::: "memory");
}
struct ConvItem { const float* src; unsigned char* dst; int ldw; };
__device__ __forceinline__ ConvItem conv_item(Frame& F, int it) {
    constexpr int I_GU = NE * 32 * 128; ConvItem c;
    if (it < I_GU) { const int e = it / (32 * 128), q = it % (32 * 128), kb = q / 128, gp = q % 128, d0 = gp * 32, pn = d0 >> 8, j = d0 & 255, sc = j < 128 ? 128 * pn + j : 2048 + 128 * pn + (j - 128);
        c.src = F.ap->in[I_WGU] + (size_t)e * 2048 * 4096 + (size_t)(kb * 64) * 4096 + sc; c.dst = WSP(unsigned char, WS_WGU) + (size_t)e * 4096 * 2048 + (size_t)d0 * 2048 + kb * 64; c.ldw = 4096; }
    else { const int r = it - I_GU, e = r / (32 * 64), q = r % (32 * 64), kb = q / 64, gp = q % 64;
        c.src = F.ap->in[I_WDN] + (size_t)e * 2048 * 2048 + (size_t)(kb * 64) * 2048 + gp * 32; c.dst = WSP(unsigned char, WS_WDN) + (size_t)e * 2048 * 2048 + (size_t)(gp * 32) * 2048 + kb * 64; c.ldw = 2048; }
    return c;
}
__device__ __forceinline__ void convert_experts(Frame& F, int rank, int nranks) {
    constexpr int NIT = NE * 32 * 128 + NE * 32 * 64;
    LAS float* scr = (LAS float*)(F.lds + RING_OFF + F.wave * 16384);
    const int lane = F.lane, gw = rank * NWAVES + F.wave, NGW = nranks * NWAVES, c4 = lane & 7, r8 = lane >> 3;
    f32x4 cur[8], n1[8], n2[8]; ConvItem ci, c1, c2;
#define CONV_LOAD(dst, cc, it_) do { cc = conv_item(F, it_); _Pragma("unroll") for (int j = 0; j < 8; ++j) dst[j] = __builtin_nontemporal_load((const f32x4*)(cc.src + (size_t)(r8 + 8 * j) * cc.ldw + 4 * c4)); } while (0)
    if (gw < NIT) CONV_LOAD(cur, ci, gw);
    if (gw + NGW < NIT) CONV_LOAD(n1, c1, gw + NGW);
    for (int it = gw; it < NIT; it += NGW) {
        if (it + 2 * NGW < NIT) CONV_LOAD(n2, c2, it + 2 * NGW);
#pragma unroll
        for (int j = 0; j < 8; ++j) { LAS float* s = scr + (r8 + 8 * j) * 33 + 4 * c4; s[0] = cur[j].x * FP8_SW; s[1] = cur[j].y * FP8_SW; s[2] = cur[j].z * FP8_SW; s[3] = cur[j].w * FP8_SW; }
        LDS_WAIT(); asm volatile("" ::: "memory");
#pragma unroll
        for (int j = 0; j < 4; ++j) { const int nn = r8 + 8 * j; const LAS float* s = scr + (8 * c4) * 33 + nn;
            v2u o; o.x = pk4_fp8(s[0 * 33], s[1 * 33], s[2 * 33], s[3 * 33]); o.y = pk4_fp8(s[4 * 33], s[5 * 33], s[6 * 33], s[7 * 33]);
            __builtin_nontemporal_store(o, (v2u*)(ci.dst + (size_t)nn * 2048 + 8 * c4)); }
        LDS_WAIT(); asm volatile("" ::: "memory");
        ci = c1; c1 = c2;
#pragma unroll
        for (int j = 0; j < 8; ++j) { cur[j] = n1[j]; n1[j] = n2[j]; }
    }
#undef CONV_LOAD
}
__device__ __forceinline__ void p0_prologue(Frame& F) {
    LAS float* scr = (LAS float*)(F.lds + RING_OFF + F.wave * 16384);
    const int gw = F.wg * NWAVES + F.wave, NGW = F.G * NWAVES, lane = F.lane;
    constexpr int I_IN = 32 * 368, I_OA = 16 * 64, I_OB = I_OA, I_OUT = 32 * 64;
    constexpr int NITEMS = I_IN + I_OA + I_OB + I_OUT;
    for (int it = gw; it < NITEMS; it += NGW) {
        int r = it;
        if (r < I_IN) { const int kb = r / 368, gp = r % 368, c0 = gp * 32, oc = win_orig_col(c0); int nv = 32; if (oc < 0) nv = 0; else if (c0 + 32 > PC_END) nv = PC_END - c0;
#if INPROJ_FP8
            tr_item8(F.ap->in[I_WIN], 11720, 2048, WSP(unsigned char, WS_WIN), c0, oc < 0 ? 0 : oc, nv, kb * 64, FP8_SW, scr, lane); continue; } r -= I_IN;
#else
            tr_item(F.ap->in[I_WIN], 11720, 2048, WSP(bf16, WS_WIN), c0, oc < 0 ? 0 : oc, nv, kb * 64, scr, lane); continue; } r -= I_IN;
#endif
        if (r < I_OA) { tr_item(F.ap->in[I_WOA], 2048, 1024, WSP(bf16, WS_WOA), (r % 64) * 32, (r % 64) * 32, 32, (r / 64) * 64, scr, lane); continue; } r -= I_OA;
        if (r < I_OB) { tr_item(F.ap->in[I_WOB], 2048, 1024, WSP(bf16, WS_WOB), (r % 64) * 32, (r % 64) * 32, 32, (r / 64) * 64, scr, lane); continue; } r -= I_OB;
        { tr_item(F.ap->in[I_WOUT], 2048, 2048, WSP(bf16, WS_WOUT), (r % 64) * 32, (r % 64) * 32, 32, (r / 64) * 64, scr, lane); }
    }
    const int gt = F.wg * (NWAVES * 64) + F.tid, NGT = F.G * NWAVES * 64;
    { bf16* b1 = WSP(bf16, WS_BT1); const float* wd = F.ap->in[I_WDEC]; const float* wi = F.ap->in[I_WICLR];
      for (int i = gt; i < 2048 * 256; i += NGT) { const int n = i >> 8, k = i & 255; float v = 0.f;
          if (n < 1024) { if (k < 96) v = wd[k * 1024 + n]; } else { if (k >= 128 && k < 224) v = wi[(k - 128) * 1024 + (n - 1024)]; }
          b1[i] = (bf16)f2bf(v); } }
    { bf16* b2 = WSP(bf16, WS_BT2); const float* wg = F.ap->in[I_WGATE];
      for (int i = gt; i < 1024 * 256; i += NGT) { const int n = i >> 8, k = i & 255; b2[i] = (bf16)f2bf(wg[k * 1024 + n]); } }
    { float* wrt = WSP(float, WS_WRT); const float* wr = F.ap->in[I_WR];
      for (int i = gt; i < 32 * 2048; i += NGT) { const int e = i >> 11, k = i & 2047; wrt[i] = wr[k * 32 + e]; } }
    { bf16* h = WSP(bf16, WS_H) + (size_t)T * DM; for (int i = gt; i < DM; i += NGT) h[i] = 0; }
    if (F.wg < 192) {
        const float* wa = F.ap->in[I_WADA]; const float* cc = F.ap->in[I_C]; const int n = F.wg * 64 + lane;
        float s0 = 0.f, s1 = 0.f;
        for (int k = F.wave * 256; k < F.wave * 256 + 256; ++k) { const float w = wa[(size_t)k * 12288 + n]; const float c0 = cc[k], c1 = cc[2048 + k];
            s0 += c0 * sigmoidf_(c0) * w; s1 += c1 * sigmoidf_(c1) * w; }
        LAS float* red = (LAS float*)(F.lds + RING_OFF + 131072 - 4096);
        __syncthreads();
        red[(F.wave * 2 + 0) * 64 + lane] = s0; red[(F.wave * 2 + 1) * 64 + lane] = s1;
        __syncthreads();
        if (F.wave < 2) { float s = 0.f;
#pragma unroll
            for (int w = 0; w < 8; ++w) s += red[(w * 2 + F.wave) * 64 + lane];
            WSP(float, WS_MOD)[F.wave * 12288 + n] = s + F.ap->in[I_BADA][n]; }
    }
}
template <bool OUT8> __device__ __forceinline__ void norm_mod_rows(Frame& F, const float* x, const float* g, int shift_off, int scale_off, bf16* H) {
    const int gw = F.wg * NWAVES + F.wave, NGW = F.G * NWAVES, lane = F.lane; const float* mod = WSP(float, WS_MOD);
    for (int m = gw; m < T; m += NGW) {
        const f32x4* xr = (const f32x4*)(x + (size_t)m * DM) + lane; f32x4 v[8]; float ss = 0.f;
#pragma unroll
        for (int j = 0; j < 8; ++j) { v[j] = xr[64 * j]; ss += (v[j].x * v[j].x + v[j].y * v[j].y) + (v[j].z * v[j].z + v[j].w * v[j].w); }
        const float rs = rsqrtf(wave_sum(ss) * (1.f / DM) + NORM_EPS); const float* mb = mod + (size_t)(m / SEQ) * 12288;
#pragma unroll
        for (int j = 0; j < 8; ++j) { const int c = 4 * lane + 256 * j; const f32x4 gg = *(const f32x4*)(g + c), sc = *(const f32x4*)(mb + scale_off + c), sh = *(const f32x4*)(mb + shift_off + c);
            const f32x4 y = v[j] * rs * gg * (sc + 1.f) + sh;
            if constexpr (OUT8) *(unsigned*)((unsigned char*)H + (size_t)m * DM + c) = pk4_fp8(y.x * FP8_SA1, y.y * FP8_SA1, y.z * FP8_SA1, y.w * FP8_SA1);
            else { v2u o; o.x = pk2(y.x, y.y); o.y = pk2(y.z, y.w); *(v2u*)(H + (size_t)m * DM + c) = o; } }
    }
}
__device__ __forceinline__ void p3_prep(Frame& F) {
    const int gw = F.wg * NWAVES + F.wave, NGW = F.G * NWAVES, lane = F.lane;
    const bf16* P = WSP(bf16, WS_P); const float* mu = F.ap->in[I_MU];
    bf16* Rb = WSP(bf16, WS_R); bf16* LW = WSP(bf16, WS_LW); bf16* SG = WSP(bf16, WS_SG);
    for (int t = gw; t < T; t += NGW) {
        const bf16* pc = P + (size_t)t * NP; const bool first = (t % SEQ) == 0; const bf16* pp = first ? pc : pc - NP;
#pragma unroll
        for (int s = 0; s < 6; ++s) { const int c = (s * 64 + lane) * 8; float a[8], b[8], o[8]; unpack8(*(const v4u*)(pc + c), a); unpack8(*(const v4u*)(pp + c), b);
            const f32x4 m0 = *(const f32x4*)(mu + c), m1 = *(const f32x4*)(mu + c + 4);
#pragma unroll
            for (int i = 0; i < 8; ++i) { const float pv = first ? 0.f : b[i]; const float mm = i < 4 ? m0[i] : m1[i - 4]; o[i] = a[i] + mm * (pv - a[i]); }
            *(v4u*)(Rb + (size_t)(c >> 10) * ((WS_K - WS_R) / 2) + (size_t)t * RW + (c & 1023)) = pack8f(o); }
        { int c, mi; if (lane < 32) { c = PC_GLO + 8 * lane; mi = 3264 + 8 * lane; } else if (lane < 44) { c = PC_DLO + 8 * (lane - 32); mi = 3072 + 8 * (lane - 32); } else { c = PC_ALO + 8 * (lane - 44); mi = 3168 + 8 * (lane - 44); }
          float o[8] = {0.f, 0.f, 0.f, 0.f, 0.f, 0.f, 0.f, 0.f};
          if (lane < 56) { float a[8], b[8]; unpack8(*(const v4u*)(pc + c), a); unpack8(*(const v4u*)(pp + c), b);
              const f32x4 m0 = *(const f32x4*)(mu + mi), m1 = *(const f32x4*)(mu + mi + 4);
#pragma unroll
              for (int i = 0; i < 8; ++i) { const float pv = first ? 0.f : b[i]; const float mm = i < 4 ? m0[i] : m1[i - 4]; const float v = a[i] + mm * (pv - a[i]);
                  o[i] = lane < 32 ? sigmoidf_(v) : (lane < 44 ? tanhf(v) : v); } }
          bf16* dst; if (lane < 32) dst = SG + (size_t)t * 256 + 8 * lane; else if (lane < 44) dst = LW + (size_t)t * 256 + 8 * (lane - 32); else if (lane < 56) dst = LW + (size_t)t * 256 + 128 + 8 * (lane - 44);
          else if (lane < 60) dst = LW + (size_t)t * 256 + 96 + 8 * (lane - 56); else dst = LW + (size_t)t * 256 + 224 + 8 * (lane - 60);
          *(v4u*)dst = pack8f(o); }
#pragma unroll
        for (int s = 0; s < 2; ++s) { const int ch = s * 64 + lane, d0 = (ch & 15) * 8;
#pragma unroll
            for (int qk = 0; qk < 2; ++qk) { float a[8]; unpack8(*(const v4u*)(pc + (qk ? PC_FK : PC_FQ) + ch * 8), a); float ss = 0.f;
#pragma unroll
                for (int i = 0; i < 8; ++i) ss += a[i] * a[i];
                ss += __shfl_xor(ss, 1); ss += __shfl_xor(ss, 2); ss += __shfl_xor(ss, 4); ss += __shfl_xor(ss, 8);
                const float rs = rsqrtf(ss * (1.f / 128.f) + NORM_EPS); const float* gn = F.ap->in[qk ? I_KN : I_QN] + d0;
                const f32x4 g0 = *(const f32x4*)gn, g1 = *(const f32x4*)(gn + 4);
#pragma unroll
                for (int i = 0; i < 8; ++i) a[i] = a[i] * rs * (i < 4 ? g0[i] : g1[i - 4]);
                *(v4u*)(WSP(bf16, qk ? WS_FK : WS_FQ) + (size_t)t * FW + ch * 8) = pack8f(a); }
            *(v4u*)(WSP(bf16, WS_FV) + (size_t)t * FW + ch * 8) = *(const v4u*)(pc + PC_FV + ch * 8); }
        if (lane < 8) { const float xv = bflo((unsigned)pc[PC_F + lane]) + F.ap->in[I_BF][lane];
            WSP(float, WS_LF)[(size_t)t * 8 + lane] = fminf(xv, 0.f) - log1pf(__expf(-fabsf(xv))); }
    }
}
__device__ __forceinline__ void p4_cumsum(Frame& F) {
    if (F.wg >= 16) return;
    const int b = F.wg >> 3, h = F.wg & 7; const float* lf = WSP(float, WS_LF) + (size_t)b * SEQ * 8 + h; float* cs = WSP(float, WS_CS) + (size_t)F.wg * SEQ;
    LAS float* part = (LAS float*)(F.lds + RING_OFF); LAS float* tend = part + 512; LAS float* tstart = part + 768;
    const int t0 = F.tid * 32; float s = 0.f;
    for (int i = 0; i < 32; ++i) s += lf[(size_t)(t0 + i) * 8];
    part[F.tid] = s; __syncthreads();
    if (F.tid == 0) { float run = 0.f; for (int i = 0; i < 512; ++i) { const float v = part[i]; part[i] = run; run += v; } }
    __syncthreads();
    float run = part[F.tid];
    for (int i = 0; i < 32; ++i) { run += lf[(size_t)(t0 + i) * 8]; const float c = -run * 11.313708498984761f; cs[t0 + i] = c;
        if (i == 0 && (F.tid & 7) == 0) tstart[F.tid >> 3] = c; if (i == 31 && (F.tid & 1)) tend[F.tid >> 1] = c; }
    __syncthreads();
    if (F.tid < 64) { const int qb = F.tid; const float target = tstart[qb] - FOX_HORIZON * 11.313708498984761f; int lo = 0, hi = 4 * qb;
        while (lo < hi) { const int mid = (lo + hi) >> 1; if (tend[mid] >= target) hi = mid; else lo = mid + 1; }
        WSP(int, WS_JLO)[F.wg * 64 + qb] = lo; }
    __syncthreads();
}
__device__ __forceinline__ void p5_scan_naive(Frame& F) {
    constexpr int CH = 64;
    LAS float* Wl = (LAS float*)(F.lds + RING_OFF); LAS float* Al = Wl + CH * 64; LAS float* Bl = Al + CH * 64; LAS float* Kl = Bl + CH * 64; LAS float* Rl = Kl + CH * 64; LAS float* Vl = Rl + CH * 64; LAS float* Yl = Vl + CH * 64;
    const int tid = F.tid, row = tid >> 3, q = tid & 7;
    for (int bh = F.wg; bh < 32; bh += F.G) {
        const int b = bh >> 4, h = bh & 15; const size_t base = (size_t)b * SEQ * RW + h * 64;
        const bf16* Rg = WSP(bf16, WS_R) + base; const bf16* Kg = WSP(bf16, WS_K) + base; const bf16* Vg = WSP(bf16, WS_V) + base; const bf16* Ag = WSP(bf16, WS_A) + base;
        const float* Lg = WSP(float, WS_LOGW) + base; float* Yg = WSP(float, WS_YRAW) + base;
        float kkw[8], kaw[8];
#pragma unroll
        for (int i = 0; i < 8; ++i) { kkw[i] = F.ap->in[I_KK][h * 64 + 8 * q + i]; kaw[i] = F.ap->in[I_KA][h * 64 + 8 * q + i]; }
        float S[8] = {0.f, 0.f, 0.f, 0.f, 0.f, 0.f, 0.f, 0.f};
        for (int t0 = 0; t0 < SEQ; t0 += CH) {
            { const size_t off = (size_t)(t0 + row) * RW + 8 * q; float r[8], k[8], v[8], a[8];
              unpack8(*(const v4u*)(Rg + off), r); unpack8(*(const v4u*)(Kg + off), k); unpack8(*(const v4u*)(Vg + off), v); unpack8(*(const v4u*)(Ag + off), a);
              const f32x4 l0 = *(const f32x4*)(Lg + off), l1 = *(const f32x4*)(Lg + off + 4);
              float kk[8], ss = 0.f;
#pragma unroll
              for (int i = 0; i < 8; ++i) { kk[i] = k[i] * kkw[i]; ss += kk[i] * kk[i]; }
              ss += __shfl_xor(ss, 1); ss += __shfl_xor(ss, 2); ss += __shfl_xor(ss, 4);
              const float inv = 1.f / fmaxf(sqrtf(ss), 1e-12f);
#pragma unroll
              for (int i = 0; i < 8; ++i) { const int o = row * 64 + 8 * q + i; kk[i] *= inv;
                  Wl[o] = __expf(i < 4 ? l0[i] : l1[i - 4]); Al[o] = -kk[i]; Bl[o] = kk[i] * a[i]; Kl[o] = k[i] * (1.f + (a[i] - 1.f) * kaw[i]); Rl[o] = r[i]; Vl[o] = v[i]; } }
            __syncthreads();
            for (int t = 0; t < CH; ++t) { const int o = t * 64 + 8 * q; float sa = 0.f;
                const f32x4 a0 = *(const LAS f32x4*)(Al + o), a1 = *(const LAS f32x4*)(Al + o + 4), w0 = *(const LAS f32x4*)(Wl + o), w1 = *(const LAS f32x4*)(Wl + o + 4);
                const f32x4 b0 = *(const LAS f32x4*)(Bl + o), b1 = *(const LAS f32x4*)(Bl + o + 4), k0 = *(const LAS f32x4*)(Kl + o), k1 = *(const LAS f32x4*)(Kl + o + 4);
                const f32x4 r0 = *(const LAS f32x4*)(Rl + o), r1 = *(const LAS f32x4*)(Rl + o + 4); const float vv = Vl[t * 64 + row];
#pragma unroll
                for (int i = 0; i < 8; ++i) sa += S[i] * (i < 4 ? a0[i] : a1[i - 4]);
                sa += __shfl_xor(sa, 1); sa += __shfl_xor(sa, 2); sa += __shfl_xor(sa, 4);
                float y = 0.f;
#pragma unroll
                for (int i = 0; i < 8; ++i) { S[i] = S[i] * (i < 4 ? w0[i] : w1[i - 4]) + sa * (i < 4 ? b0[i] : b1[i - 4]) + vv * (i < 4 ? k0[i] : k1[i - 4]); y += S[i] * (i < 4 ? r0[i] : r1[i - 4]); }
                y += __shfl_xor(y, 1); y += __shfl_xor(y, 2); y += __shfl_xor(y, 4);
                if (q == 0) Yl[t * 64 + row] = y; }
            __syncthreads();
            { const int tt = tid >> 3, c = (tid & 7) * 8; *(f32x4*)(Yg + (size_t)(t0 + tt) * RW + c) = *(const LAS f32x4*)(Yl + tt * 64 + c); *(f32x4*)(Yg + (size_t)(t0 + tt) * RW + c + 4) = *(const LAS f32x4*)(Yl + tt * 64 + c + 4); }
        }
        __syncthreads();
    }
}
__device__ __forceinline__ void p7_post(Frame& F) {
    const int gw = F.wg * NWAVES + F.wave, NGW = F.G * NWAVES, lane = F.lane, c0 = 16 * lane;
    for (int t = gw; t < T; t += NGW) { const size_t off = (size_t)t * RW + c0;
        float y[16], r[16], k[16], v[16], a[16], g[16];
#pragma unroll
        for (int j = 0; j < 4; ++j) { const f32x4 yy = *(const f32x4*)(WSP(float, WS_YRAW) + off + 4 * j); y[4 * j] = yy.x; y[4 * j + 1] = yy.y; y[4 * j + 2] = yy.z; y[4 * j + 3] = yy.w; }
#pragma unroll
        for (int j = 0; j < 2; ++j) { float tmp[8];
            unpack8(*(const v4u*)(WSP(bf16, WS_R) + off + 8 * j), tmp); for (int i = 0; i < 8; ++i) r[8 * j + i] = tmp[i];
            unpack8(*(const v4u*)(WSP(bf16, WS_K) + off + 8 * j), tmp); for (int i = 0; i < 8; ++i) k[8 * j + i] = tmp[i];
            unpack8(*(const v4u*)(WSP(bf16, WS_V) + off + 8 * j), tmp); for (int i = 0; i < 8; ++i) v[8 * j + i] = tmp[i];
            unpack8(*(const v4u*)(WSP(bf16, WS_A) + off + 8 * j), tmp); for (int i = 0; i < 8; ++i) a[8 * j + i] = tmp[i];
            unpack8(*(const v4u*)(WSP(bf16, WS_G) + off + 8 * j), tmp); for (int i = 0; i < 8; ++i) g[8 * j + i] = tmp[i]; }
        float s = 0.f, bs = 0.f;
#pragma unroll
        for (int i = 0; i < 16; ++i) { s += y[i]; const float kp = k[i] * (1.f + (a[i] - 1.f) * F.ap->in[I_KA][c0 + i]); bs += r[i] * kp * F.ap->in[I_RK][c0 + i]; }
        s += __shfl_xor(s, 1); s += __shfl_xor(s, 2); bs += __shfl_xor(bs, 1); bs += __shfl_xor(bs, 2);
        const float mean = s * (1.f / 64.f); float q = 0.f;
#pragma unroll
        for (int i = 0; i < 16; ++i) { const float d = y[i] - mean; q += d * d; }
        q += __shfl_xor(q, 1); q += __shfl_xor(q, 2);
        const float rstd = rsqrtf(q * (1.f / 64.f) + GN_EPS); float o[16];
#pragma unroll
        for (int i = 0; i < 16; ++i) o[i] = ((y[i] - mean) * rstd * F.ap->in[I_GNG][c0 + i] + F.ap->in[I_GNB][c0 + i] + bs * v[i]) * g[i];
#pragma unroll
        for (int j = 0; j < 2; ++j) { v4u w; w.x = pk2(o[8 * j], o[8 * j + 1]); w.y = pk2(o[8 * j + 2], o[8 * j + 3]); w.z = pk2(o[8 * j + 4], o[8 * j + 5]); w.w = pk2(o[8 * j + 6], o[8 * j + 7]); *(v4u*)(WSP(bf16, WS_YA) + off + 8 * j) = w; }
    }
}
__device__ __forceinline__ fox::BlockRef<fox::bf16, fox::bf16> fox_ref(int L_, const unsigned char* ws) {
    const int bh = L_ & 15, qb = 63 - (L_ >> 4);
    fox::BlockRef<fox::bf16, fox::bf16> r; r.ws = ws; r.row0 = (bh / fox::H) * fox::SQ + qb * fox::QB; r.bh = bh; r.P0 = qb * fox::QB; r.jlo = ((const int*)(ws + WS_JLO))[bh * 64 + qb]; return r;
}
__device__ __forceinline__ int att_fetch(Frame& F) {
    if (F.tid == 0) F.MISC[4] = __hip_atomic_fetch_add(F.ctl + CW_ATTQ, 1u, RLX_AGENT);
    __syncthreads(); const int v = (int)F.MISC[4]; __syncthreads(); return v;
}
__device__ __forceinline__ void p6_attention(Frame& F, char* lds) {
    constexpr int TOTAL = (fox::SQ / fox::QB) * fox::B * fox::H;
    int L = att_fetch(F); if (L >= TOTAL) return;
    fox::BlockRef<fox::bf16, fox::bf16> cur = fox_ref(L, F.ws);
    fox::Seam<fox::bf16> S;
    fox::causal_swa_prime<fox::bf16, fox::bf16>(cur, fox::WINDOW, lds, S, F.tid);
    for (;;) {
        const int Ln = att_fetch(F); const bool last = Ln >= TOTAL;
        const fox::BlockRef<fox::bf16, fox::bf16> nxt = last ? cur : fox_ref(Ln, F.ws);
        fox::causal_swa_block<fox::bf16, fox::bf16>(cur, nxt, fox::SKV, fox::WINDOW, lds, S, F.tid);
        if (last) break;
        cur = nxt;
    }
}
typedef float f32x4m __attribute__((ext_vector_type(4)));
__device__ __forceinline__ void p11_router(Frame& F) {
    constexpr int TPW = T / 256 / NWAVES;
    const int lane = F.lane, t0 = (F.wg * NWAVES + F.wave) * TPW;
    const float* x1 = WSP(float, WS_X1); const float* mod = WSP(float, WS_MOD) + (size_t)(t0 / SEQ) * 12288; const float* g2 = F.ap->in[I_N2G]; bf16* H = WSP(bf16, WS_H);
    LAS float* lg = (LAS float*)(F.lds + RING_OFF + F.wave * 4096);
    LAS int* cnt = (LAS int*)(F.lds + RING_OFF + 65536);
    if (F.tid < 32) cnt[F.tid] = 0;
    __syncthreads();
    for (int i = 0; i < TPW; ++i) { const int m = t0 + i;
        const f32x4* xr = (const f32x4*)(x1 + (size_t)m * DM) + lane; f32x4 v[8]; float ss = 0.f;
#pragma unroll
        for (int j = 0; j < 8; ++j) { v[j] = xr[64 * j]; ss += (v[j].x * v[j].x + v[j].y * v[j].y) + (v[j].z * v[j].z + v[j].w * v[j].w); }
        const float rs = rsqrtf(wave_sum(ss) * (1.f / DM) + NORM_EPS);
        if (lane == 0) lg[512 + i] = rs;
#pragma unroll
        for (int j = 0; j < 8; ++j) { const int c = 4 * lane + 256 * j; const f32x4 gg = *(const f32x4*)(g2 + c), sc = *(const f32x4*)(mod + 4 * 2048 + c), sh = *(const f32x4*)(mod + 3 * 2048 + c);
            const f32x4 y = v[j] * rs * gg * (sc + 1.f) + sh; v2u o; o.x = pk2(y.x, y.y); o.y = pk2(y.z, y.w); *(v2u*)(H + (size_t)m * DM + c) = o; }
    }
    LDS_WAIT();
    { const int i = lane & 15, q = lane >> 4; const float rs = lg[512 + i]; const float* xr = x1 + (size_t)(t0 + i) * DM + 4 * q; const float* wr = WSP(float, WS_WRT) + (size_t)i * DM + 4 * q;
      f32x4m acc0 = {0.f, 0.f, 0.f, 0.f}, acc1 = {0.f, 0.f, 0.f, 0.f};
#pragma unroll 4
      for (int Sx = 0; Sx < DM / 16; ++Sx) { const int k = 16 * Sx;
          const f32x4 xv = *(const f32x4*)(xr + k), gg = *(const f32x4*)(g2 + k + 4 * q), sc = *(const f32x4*)(mod + 4 * 2048 + k + 4 * q), sh = *(const f32x4*)(mod + 3 * 2048 + k + 4 * q);
          const f32x4 hv = xv * rs * gg * (sc + 1.f) + sh; const f32x4 w0 = *(const f32x4*)(wr + k), w1 = *(const f32x4*)(wr + 16 * DM + k);
#pragma unroll
          for (int jj = 0; jj < 4; ++jj) { acc0 = __builtin_amdgcn_mfma_f32_16x16x4f32(hv[jj], w0[jj], acc0, 0, 0, 0); acc1 = __builtin_amdgcn_mfma_f32_16x16x4f32(hv[jj], w1[jj], acc1, 0, 0, 0); } }
      const float b0 = F.ap->in[I_BR][i], b1 = F.ap->in[I_BR][16 + i];
#pragma unroll
      for (int r = 0; r < 4; ++r) { lg[(4 * q + r) * 32 + i] = acc0[r] + b0; lg[(4 * q + r) * 32 + 16 + i] = acc1[r] + b1; } }
    LDS_WAIT();
    if (lane < 16) { const int m = t0 + lane; float v[4]; int e[4]; unsigned used = 0u;
#pragma unroll
        for (int k = 0; k < 4; ++k) { float best = -3.0e38f; int bi = 0;
            for (int j = 0; j < 32; ++j) { const float x = lg[lane * 32 + j]; if (!((used >> j) & 1u) && x > best) { best = x; bi = j; } }
            used |= 1u << bi; v[k] = best; e[k] = bi; }
        const float e1 = __expf(v[1] - v[0]), e2 = __expf(v[2] - v[0]), e3 = __expf(v[3] - v[0]), inv = 1.f / (1.f + e1 + e2 + e3);
        *(f32x4*)(WSP(float, WS_TOKW) + (size_t)m * 4) = (f32x4){inv, e1 * inv, e2 * inv, e3 * inv};
        int* te = WSP(int, WS_TOKE) + (size_t)m * 4; te[0] = e[0]; te[1] = e[1]; te[2] = e[2]; te[3] = e[3];
#pragma unroll
        for (int k = 0; k < 4; ++k) __hip_atomic_fetch_add(cnt + e[k], 1, __ATOMIC_RELAXED, __HIP_MEMORY_SCOPE_WORKGROUP); }
    __syncthreads();
    if (F.tid < 32) WSP(int, WS_WGCNT)[F.wg * 32 + F.tid] = cnt[F.tid];
    __syncthreads();
}
__device__ __forceinline__ void p12_slots(Frame& F) {
    constexpr int TPG = T / 256;
    LAS int* cur = (LAS int*)(F.lds + RING_OFF); LAS int* tot = cur + 32; LAS int* pre = cur + 64; LAS int* off = cur + 96; LAS int* slotl = cur + 160;
    const int* wgcnt = WSP(int, WS_WGCNT);
    if (F.tid < 32) { int tt = 0, pp = 0; for (int w = 0; w < 256; ++w) { const int c = wgcnt[w * 32 + F.tid]; if (w < F.wg) pp += c; tt += c; } tot[F.tid] = tt; pre[F.tid] = pp; }
    __syncthreads();
    if (F.tid == 0) { int o = 0; for (int e = 0; e < 32; ++e) { off[e] = o; o += (tot[e] + 255) & ~255; } off[32] = o; }
    __syncthreads();
    if (F.tid < 32) cur[F.tid] = off[F.tid] + pre[F.tid];
    if (F.wg == 0) { int* te = WSP(int, WS_TILEE); const int nt = off[32] >> 8;
        for (int p = F.tid; p < nt; p += NWAVES * 64) { int e = 0; for (int j = 1; j < 32; ++j) if ((p << 8) >= off[j]) e = j; te[p] = e; }
        if (F.tid == 0) te[1024] = nt; }
    __syncthreads();
    { const int t = F.wg * TPG + (F.tid >> 2), k = F.tid & 3; const int e = WSP(int, WS_TOKE)[(size_t)t * 4 + k];
      const int s = __hip_atomic_fetch_add(cur + e, 1, __ATOMIC_RELAXED, __HIP_MEMORY_SCOPE_WORKGROUP);
      slotl[F.tid] = s; WSP(int, WS_TOKS)[(size_t)t * 4 + k] = s; WSP(float, WS_SLOTW)[s] = WSP(float, WS_TOKW)[(size_t)t * 4 + k]; }
    __syncthreads();
    const bf16* H = WSP(bf16, WS_H); unsigned char* HS = WSP(unsigned char, WS_HS);
    for (int i = 0; i < TPG / NWAVES; ++i) { const int tl = F.wave * (TPG / NWAVES) + i, t = F.wg * TPG + tl; v2u v[4];
#pragma unroll
        for (int j = 0; j < 4; ++j) { float f[8]; unpack8(*(const v4u*)(H + (size_t)t * DM + 8 * (F.lane + 64 * j)), f);
            v[j].x = pk4_fp8(f[0] * FP8_SA1, f[1] * FP8_SA1, f[2] * FP8_SA1, f[3] * FP8_SA1); v[j].y = pk4_fp8(f[4] * FP8_SA1, f[5] * FP8_SA1, f[6] * FP8_SA1, f[7] * FP8_SA1); }
#pragma unroll
        for (int k = 0; k < 4; ++k) { const int s = slotl[tl * 4 + k];
#pragma unroll
            for (int j = 0; j < 4; ++j) *(v2u*)(HS + (size_t)s * DM + 8 * (F.lane + 64 * j)) = v[j]; } }
    __syncthreads();
}
__device__ __forceinline__ void p15_final(Frame& F) {
    const int gw = F.wg * NWAVES + F.wave, NGW = F.G * NWAVES, lane = F.lane;
    const float* x1 = WSP(float, WS_X1); const bf16* YS = WSP(bf16, WS_YS); const float* gf = F.ap->in[I_NFG];
    for (int m = gw; m < T; m += NGW) { const float* gt = WSP(float, WS_MOD) + (size_t)(m / SEQ) * 12288 + 5 * 2048;
        const int4 sl = *(const int4*)(WSP(int, WS_TOKS) + (size_t)m * 4); float v[4][8]; float ss = 0.f;
#pragma unroll
        for (int j = 0; j < 4; ++j) { const int c = 8 * (lane + 64 * j); float y[8] = {0.f, 0.f, 0.f, 0.f, 0.f, 0.f, 0.f, 0.f}, tmp[8];
            unpack8(*(const v4u*)(YS + (size_t)sl.x * DM + c), tmp); for (int i = 0; i < 8; ++i) y[i] += tmp[i];
            unpack8(*(const v4u*)(YS + (size_t)sl.y * DM + c), tmp); for (int i = 0; i < 8; ++i) y[i] += tmp[i];
            unpack8(*(const v4u*)(YS + (size_t)sl.z * DM + c), tmp); for (int i = 0; i < 8; ++i) y[i] += tmp[i];
            unpack8(*(const v4u*)(YS + (size_t)sl.w * DM + c), tmp); for (int i = 0; i < 8; ++i) y[i] += tmp[i];
            const f32x4 xa = *(const f32x4*)(x1 + (size_t)m * DM + c), xb = *(const f32x4*)(x1 + (size_t)m * DM + c + 4), ga = *(const f32x4*)(gt + c), gb = *(const f32x4*)(gt + c + 4);
#pragma unroll
            for (int i = 0; i < 8; ++i) { const float xv = (i < 4 ? xa[i] : xb[i - 4]) + (i < 4 ? ga[i] : gb[i - 4]) * y[i]; v[j][i] = xv; ss += xv * xv; } }
        const float rs = rsqrtf(wave_sum(ss) * (1.f / DM) + NORM_EPS);
#pragma unroll
        for (int j = 0; j < 4; ++j) { const int c = 8 * (lane + 64 * j); const f32x4 ga = *(const f32x4*)(gf + c), gb = *(const f32x4*)(gf + c + 4);
            *(f32x4*)(F.ap->out + (size_t)m * DM + c) = (f32x4){v[j][0] * rs * ga[0], v[j][1] * rs * ga[1], v[j][2] * rs * ga[2], v[j][3] * rs * ga[3]};
            *(f32x4*)(F.ap->out + (size_t)m * DM + c + 4) = (f32x4){v[j][4] * rs * gb[0], v[j][5] * rs * gb[1], v[j][6] * rs * gb[2], v[j][7] * rs * gb[3]}; }
    }
}

__device__ __forceinline__ bool fresh(Frame& F) {
    asm volatile("" : "+s"(F.ap)); int w = F.wave; asm volatile("" : "+s"(w)); const int l = __builtin_amdgcn_mbcnt_hi(~0u, __builtin_amdgcn_mbcnt_lo(~0u, 0u)); F.lane = l; F.tid = w * 64 + l; return true; }
constexpr int N_PHASES = 18;
#ifndef N_CONV_WG
#define N_CONV_WG 48
#endif
__global__ void __launch_bounds__(NWAVES * 64, 2) mk_fwd(Args args) {
    extern __shared__ __attribute__((aligned(16))) unsigned char lds[];
    Frame F;
    F.lds = (LAS unsigned char*)lds; F.MISC = (volatile LAS unsigned*)(F.lds + MISC_OFF);
    F.tid = threadIdx.x; F.lane = F.tid & 63; F.wave = __builtin_amdgcn_readfirstlane(F.tid >> 6); F.G = gridDim.x; F.wg = blockIdx.x;
    F.ap = (ArgsP)__builtin_amdgcn_kernarg_segment_ptr(); F.ws = F.ap->ws; F.ctl = (gu32*)(F.ws + WS_CTL);
    for (int u = F.tid; u < (LDS_BYTES - LDSCTL_OFF) / 4; u += NWAVES * 64) ((LAS unsigned*)(F.lds + LDSCTL_OFF))[u] = 0u;
    __syncthreads();
    const int lo = F.ap->ph_lo, hi = F.ap->ph_hi;
    XcdBarrier bar; bar.bar = (unsigned*)(F.ctl + CW_BAR); bar.x = 0; bar.st = nullptr;
    if (hi - lo > 1) bar = xcd_barrier_post((unsigned*)(F.ctl + CW_BAR), F.MISC + 8, F.tid);
#ifndef PH_MASK
#define PH_MASK 0x3ffff
#endif
#define IN(k) (((PH_MASK >> (k)) & 1) && lo <= (k) && (k) < hi && fresh(F))
#ifndef PROBE_DUP
#define PROBE_DUP 0
#endif
#define REP(k) for (int rep_ = 0; rep_ < 1 + ((PROBE_DUP >> (k)) & 1); ++rep_)
#define SEAM(k) do { if (IN(k) && IN((k) + 1)) xcd_barrier(bar, F.tid); } while (0)
    if (IN(0)) REP(0) { p0_prologue(F); } SEAM(0);
    if (IN(1)) REP(1) { norm_mod_rows<INPROJ_FP8 != 0>(F, F.ap->in[I_X], F.ap->in[I_N1G], 0, 2048, WSP(bf16, WS_H)); } SEAM(1);
    if (IN(2)) REP(2) {
#if INPROJ_FP8
        pg8::Gemm g{WSP(bf16, WS_H), WSP(bf16, WS_WIN), T, NP, DM / 2}; pg8::StaticOrder S; S.init(T, NP, F.G, F.wg);
        pg8::EpiBf16S E{WSP(bf16, WS_P), NP, 1.f / (FP8_SA1 * FP8_SW)}; pg8::gemm_phase<pg8::EpiBf16S, pg8::StaticOrder, true, true, true>(F.lds + RING_OFF, g, S, E, F.tid);
#else
        pg8::Gemm g{WSP(bf16, WS_H), WSP(bf16, WS_WIN), T, NP, DM}; pg8::StaticOrder S; S.init(T, NP, F.G, F.wg);
        pg8::EpiBf16<0> E{WSP(bf16, WS_P), NP, nullptr, 0, 0, 1.f}; pg8::gemm_phase<pg8::EpiBf16<0>, pg8::StaticOrder, true, true>(F.lds + RING_OFF, g, S, E, F.tid);
#endif
        } SEAM(2);
    if (IN(3)) REP(3) { p3_prep(F); } SEAM(3);
    if (IN(4)) REP(4) { p4_cumsum(F);
        { pg8::Gemm g{WSP(bf16, WS_LW), WSP(bf16, WS_BT1), T, 2048, 256}; pg8::StaticOrder S; S.init(T, 2048, F.G, F.wg);
          pg8::EpiLora1 E{WSP(float, WS_LOGW), WSP(bf16, WS_A), F.ap->in[I_W0], F.ap->in[I_A0]}; pg8::gemm_phase<pg8::EpiLora1, pg8::StaticOrder, true, true>(F.lds + RING_OFF, g, S, E, F.tid); }
        } SEAM(4);
    if (IN(5)) REP(5) {
        { pg8::Gemm g{WSP(bf16, WS_SG), WSP(bf16, WS_BT2), T, 1024, 256}; pg8::StaticOrder S; S.init(T, 1024, F.G, F.wg);
          pg8::EpiBf16<0> E{WSP(bf16, WS_G), 1024, nullptr, 0, 0, 1.f}; pg8::gemm_phase<pg8::EpiBf16<0>, pg8::StaticOrder, true, true>(F.lds + RING_OFF, g, S, E, F.tid); }
        } SEAM(5);
    if (IN(6)) REP(6) {
#if RWKV_NAIVE
        p5_scan_naive(F);
#else
        rw::phase_a(F.lds + RING_OFF, F.ws, F.ap->in[I_KK], F.ap->in[I_KA], F.wg, F.G, F.tid);
#endif
        } SEAM(6);
    if (IN(7)) REP(7) {
#if !RWKV_NAIVE
        for (int bh = F.wg; bh < 32; bh += F.G) { const int b = bh >> 4, h = bh & 15;
            rw::phase_b_head(F.lds + RING_OFF, F.ws + WS_REC + (size_t)bh * 256 * rw::REC, WSP(float, WS_YRAW) + (size_t)b * SEQ * RW + h * 64, F.tid); __syncthreads(); }
#endif
        if (F.wg >= 32 && F.wg < 32 + N_CONV_WG) { convert_experts(F, F.wg - 32, N_CONV_WG); __syncthreads(); }
        p6_attention(F, (char*)lds + RING_OFF); } SEAM(7);
    if (IN(9)) REP(9) { p7_post(F); } SEAM(9);
    if (IN(10)) REP(10) { pg8::Gemm g{WSP(bf16, WS_YA), WSP(bf16, WS_WOA), T, DM, 1024}; pg8::StaticOrder S; S.init(T, DM, F.G, F.wg);
        pg8::EpiGateMerge<0> E{WSP(bf16, WS_MRG), WSP(bf16, WS_P), PC_GA}; pg8::gemm_phase<pg8::EpiGateMerge<0>, pg8::StaticOrder, true, true>(F.lds + RING_OFF, g, S, E, F.tid); } SEAM(10);
    if (IN(11)) REP(11) { pg8::Gemm g{WSP(bf16, WS_YB), WSP(bf16, WS_WOB), T, DM, 1024}; pg8::StaticOrder S; S.init(T, DM, F.G, F.wg);
        pg8::EpiGateMerge<1> E{WSP(bf16, WS_MRG), WSP(bf16, WS_P), PC_GB}; pg8::gemm_phase<pg8::EpiGateMerge<1>, pg8::StaticOrder, true, true>(F.lds + RING_OFF, g, S, E, F.tid); } SEAM(11);
    if (IN(12)) REP(12) { pg8::Gemm g{WSP(bf16, WS_MRG), WSP(bf16, WS_WOUT), T, DM, DM}; pg8::StaticOrder S; S.init(T, DM, F.G, F.wg);
        pg8::EpiResid E{F.ap->in[I_X], WSP(float, WS_X1), WSP(float, WS_MOD)}; pg8::gemm_phase<pg8::EpiResid, pg8::StaticOrder, true, true>(F.lds + RING_OFF, g, S, E, F.tid); } SEAM(12);
    if (IN(13)) REP(13) { p11_router(F); } SEAM(13);
    if (IN(14)) REP(14) { p12_slots(F); } SEAM(14);
    if (IN(15)) REP(15) { const int nt = WSP(int, WS_TILEE)[1024]; pg8::Gemm g{WSP(bf16, WS_HS), WSP(bf16, WS_WGU), nt * 256, 4096, DM / 2}; pg8::MoeOrder S; S.init(nt * 256, 4096, F.G, F.wg); S.tile_e = WSP(int, WS_TILEE);
        pg8::EpiSwiglu E{WSP(unsigned char, WS_ACT), F.ap->in[I_BGU]}; pg8::gemm_phase<pg8::EpiSwiglu, pg8::MoeOrder, true, true, true>(F.lds + RING_OFF, g, S, E, F.tid); } SEAM(15);
    if (IN(16)) REP(16) { const int nt = WSP(int, WS_TILEE)[1024]; pg8::Gemm g{WSP(bf16, WS_ACT), WSP(bf16, WS_WDN), nt * 256, 2048, DFF / 2}; pg8::MoeOrder S; S.init(nt * 256, 2048, F.G, F.wg); S.tile_e = WSP(int, WS_TILEE);
        pg8::EpiDown E{WSP(bf16, WS_YS), F.ap->in[I_BDN], WSP(float, WS_SLOTW)}; pg8::gemm_phase<pg8::EpiDown, pg8::MoeOrder, true, true, true>(F.lds + RING_OFF, g, S, E, F.tid); } SEAM(16);
    if (IN(17)) REP(17) { p15_final(F); }
#undef IN
#undef SEAM
}

extern "C" void kernel_launch(void* const* d_in, const int* in_sizes, int n_in, void* d_out, int out_size, void* d_ws, size_t ws_size, hipStream_t stream) {
    static int grid = 0;
    if (grid == 0) {
        if (n_in != N_IN || in_sizes[0] != T * DM || out_size != T * DM || ws_size < WS_END) { fprintf(stderr, "kernel_launch: shape/workspace mismatch (n_in %d, in0 %d, out %d, ws %zu < %zu)\n", n_in, n_in > 0 ? in_sizes[0] : -1, out_size, ws_size, (size_t)WS_END); grid = -1; return; }
        if (hipFuncSetAttribute((const void*)mk_fwd, hipFuncAttributeMaxDynamicSharedMemorySize, LDS_BYTES) != hipSuccess) { fprintf(stderr, "kernel_launch: hipFuncSetAttribute failed\n"); grid = -1; return; }
        int per_cu = 0;
        if (hipOccupancyMaxActiveBlocksPerMultiprocessor(&per_cu, (const void*)mk_fwd, NWAVES * 64, LDS_BYTES) != hipSuccess || per_cu < 1) fprintf(stderr, "kernel_launch: note: occupancy query reports %d workgroups per CU\n", per_cu);
        (void)hipGetLastError();
        grid = 256;
    }
    if (grid < 0) return;
    (void)hipMemsetAsync((char*)d_ws + WS_CTL, 0, CTL_ZERO_BYTES, stream);
    Args a{};
    for (int i = 0; i < N_IN; ++i) a.in[i] = (const float*)d_in[i];
    a.out = (float*)d_out; a.ws = (unsigned char*)d_ws;
#if MK_N_LAUNCHES == 1
    a.ph_lo = 0; a.ph_hi = N_PHASES;
    hipLaunchKernelGGL(mk_fwd, dim3(grid), dim3(NWAVES * 64), LDS_BYTES, stream, a);
#else
    for (int p = 0; p < N_PHASES; ++p) { a.ph_lo = p; a.ph_hi = p + 1; hipLaunchKernelGGL(mk_fwd, dim3(grid), dim3(NWAVES * 64), LDS_BYTES, stream, a); }
#endif
}
```

```cpp
#include <hip/hip_runtime.h>
#include <hip/hip_bf16.h>
#include <cstdio>
#include <cstdint>
constexpr int NWAVES = 8;
#ifndef MK_N_LAUNCHES
#define MK_N_LAUNCHES 1
#endif
#ifndef INPROJ_FP8
#define INPROJ_FP8 2
#endif
#ifndef OUTPROJ_FP8
#define OUTPROJ_FP8 1
#endif
#ifndef RWKV_NAIVE
#define RWKV_NAIVE 0
#endif
constexpr int BATCH = 2, SEQ = 16384, DM = 2048, T = BATCH * SEQ;
constexpr int NP = 11776;
constexpr int PC_R = 0, PC_K = 1024, PC_V = 2048, PC_GLO = 3072, PC_DLO = 3328, PC_ALO = 3424, PC_F = 3520, PC_FEND = 3528, PC_SPLIT = 3584, PC_GA = 3584, PC_FQ = 5632, PC_FK = 6656, PC_FV = 7680, PC_OG = 8704, PC_GB = 9728;
constexpr int RW = 1024, FW = 1024, NE = 32, DFF = 2048, TOPK = 4;
constexpr int NSLOT = T * TOPK + NE * 256;
constexpr float NORM_EPS = 1e-6f, GN_EPS = 64e-5f;
constexpr float FOX_SKIP_BITS = 32.f;
constexpr float FP8_SY = 16.f;
constexpr float FP8_SM = 16.f;
constexpr float FP8_SW = 64.f, FP8_SA1 = 2.f, FP8_SA2 = 4.f;

constexpr size_t MiB = 1u << 20;
constexpr size_t WS_CTL = 0, CTL_ZERO_BYTES = 1 * MiB;
constexpr size_t WS_MOD = 1 * MiB;
constexpr size_t WS_WRT = 1 * MiB + 128 * 1024;
constexpr size_t WS_TOKE = 2 * MiB, WS_TOKW = 2 * MiB + 512 * 1024, WS_TOKS = 3 * MiB, WS_SLOTW = 3 * MiB + 512 * 1024;
constexpr size_t WS_WGCNT = 4 * MiB + 512 * 1024, WS_TILEE = 4 * MiB + 768 * 1024;
constexpr size_t WS_RS = 4 * MiB + 832 * 1024;
constexpr size_t WS_AORD = 4 * MiB + 808 * 1024;
constexpr size_t WS_JLO = 4 * MiB + 800 * 1024;
constexpr size_t WS_LF = 5 * MiB, WS_CS = 6 * MiB;
constexpr size_t WS_STOK = 5 * MiB;
constexpr size_t WS_BT1 = 7 * MiB, WS_BT2 = 8 * MiB, WS_WOA = 9 * MiB, WS_WOB = 13 * MiB, WS_WOUT = 17 * MiB, WS_WIN = 25 * MiB;
constexpr size_t WS_WGU = 72 * MiB, WS_WDN = 584 * MiB, WS_X1 = 840 * MiB, WS_H = 1096 * MiB;
constexpr size_t WS_P = 1226 * MiB, WS_R = 1962 * MiB, WS_K = 2026 * MiB, WS_V = 2090 * MiB, WS_FQ = 2154 * MiB, WS_FK = 2218 * MiB, WS_FV = 2282 * MiB;
constexpr size_t WS_LW = 2346 * MiB, WS_SG = 2362 * MiB, WS_LOGW = 2378 * MiB, WS_A = 2506 * MiB, WS_G = 2570 * MiB, WS_YRAW = 2634 * MiB, WS_YA = 2762 * MiB, WS_YB = 2826 * MiB, WS_MRG = 2890 * MiB;
constexpr size_t WS_HS = 1226 * MiB, WS_ACT = 1500 * MiB, WS_YS = 1774 * MiB;
constexpr size_t WS_WIN8 = 3274 * MiB, WS_H8 = 3298 * MiB;
constexpr size_t WS_REC = 3018 * MiB;
constexpr size_t WS_SSP = 3362 * MiB;
constexpr size_t WS_MRG8 = 3366 * MiB;
constexpr size_t WS_END = 3430 * MiB;
static_assert(WS_WIN + (size_t)NP * DM * 2 <= WS_WGU && WS_YS + (size_t)NSLOT * DM * 2 <= WS_REC && WS_HS + (size_t)NSLOT * DM <= WS_ACT && WS_ACT + (size_t)NSLOT * DFF <= WS_YS && WS_SLOTW + (size_t)NSLOT * 4 <= WS_WGCNT, "d_ws map");
constexpr int CW_TMO = 0, CW_ATTQ = 2048, CW_BAR = 4096;

constexpr int RING_OFF = 0, RING_BYTES = 143360;
constexpr int LDSCTL_OFF = RING_BYTES, MISC_OFF = LDSCTL_OFF + 320;
constexpr int EPI_STG_OFF = 147456, LDS_BYTES = 163840;

#define GAS __attribute__((address_space(1)))
#define LAS __attribute__((address_space(3)))
typedef unsigned short bf16;
typedef unsigned v4u __attribute__((ext_vector_type(4)));
typedef unsigned v2u __attribute__((ext_vector_type(2)));
typedef float f32x4 __attribute__((ext_vector_type(4)));
typedef short bf16x8 __attribute__((ext_vector_type(8)));
typedef GAS unsigned gu32;
#define RLX_AGENT __ATOMIC_RELAXED, __HIP_MEMORY_SCOPE_AGENT
#define LDS_WAIT() asm volatile("s_waitcnt lgkmcnt(0)" ::: "memory")
#define VM_WAIT() asm volatile("s_waitcnt vmcnt(0)" ::: "memory")
__device__ __forceinline__ unsigned f2bf(float f) { unsigned u = __builtin_bit_cast(unsigned, f); return (u + 0x7fffu + ((u >> 16) & 1u)) >> 16; }
__device__ __forceinline__ unsigned pk2(float lo, float hi) { return f2bf(lo) | (f2bf(hi) << 16); }
__device__ __forceinline__ float bflo(unsigned w) { return __uint_as_float(w << 16); }
__device__ __forceinline__ float bfhi(unsigned w) { return __uint_as_float(w & 0xffff0000u); }
__device__ __forceinline__ void unpack8(v4u w, float (&f)[8]) { f[0] = bflo(w.x); f[1] = bfhi(w.x); f[2] = bflo(w.y); f[3] = bfhi(w.y); f[4] = bflo(w.z); f[5] = bfhi(w.z); f[6] = bflo(w.w); f[7] = bfhi(w.w); }
__device__ __forceinline__ v4u pack8f(const float (&f)[8]) { v4u w; w.x = pk2(f[0], f[1]); w.y = pk2(f[2], f[3]); w.z = pk2(f[4], f[5]); w.w = pk2(f[6], f[7]); return w; }
__device__ __forceinline__ float sigmoidf_(float x) { return 1.f / (1.f + __expf(-x)); }
__device__ __forceinline__ float wave_sum(float v) {
#pragma unroll
    for (int o = 1; o < 64; o <<= 1) v += __shfl_xor(v, o);
    return v;
}
namespace pg8 {
#define PG8_LAS __attribute__((address_space(3)))
typedef unsigned short bf16_t;
typedef short bf16x8 __attribute__((ext_vector_type(8)));
typedef float f32x4 __attribute__((ext_vector_type(4)));
typedef unsigned u32x4 __attribute__((ext_vector_type(4)));
constexpr int BM = 256, BK = 64, HALF = 128, HTB = HALF * BK * 2  , STAGE_BYTES = 8 * HTB, NXCD = 8, WGM = 8;

__host__ __device__ __forceinline__ int lds_byte(int r, int c) { const int st = (r >> 4) * 2 + (c >> 5), rr = r & 15, cc = c & 31, ob = rr * 64 + cc * 2; return st * 1024 + (ob ^ (((ob >> 9) & 1) << 5)); }
__host__ __device__ __forceinline__ void stage_rc(int b, int& R, int& C) { const int st = b / 1024, sb = b % 1024, swz = sb ^ (((sb >> 9) & 1) << 5); R = (st >> 1) * 16 + swz / 64; C = (st & 1) * 32 + (swz % 64) / 2; }
__host__ __device__ __forceinline__ int perm32(int rho) { const int n = rho >> 4, i = rho & 15; return 8 * (i >> 2) + 4 * n + (i & 3); }

struct Unit { int pm, pn, e; };
struct Gemm { const bf16_t* A; const bf16_t* Bt; int M, N, K; const int* rowmap = nullptr; };

struct StaticOrder {
    int nM, nN, nwg, G, c;
    __host__ __device__ void init(int M, int N, int G_, int c_) { nM = M / BM; nN = N / BM; nwg = nM * nN; G = G_; c = c_; }
    __host__ __device__ bool next(int i, Unit& u) const {
        const long L = (long)i * G + c; if (L >= nwg) return false;
        int wgid = (int)L; { const int q = nwg / NXCD, r = nwg % NXCD, xcd = wgid % NXCD, off = wgid / NXCD; wgid = (xcd < r ? xcd * (q + 1) : r * (q + 1) + (xcd - r) * q) + off; }
        const int nig = WGM * nN, gid = wgid / nig, fm = gid * WGM, gsz = (nM - fm) < WGM ? (nM - fm) : WGM;
        u.pm = fm + ((wgid % nig) % gsz); u.pn = (wgid % nig) / gsz; u.e = 0; return true;
    }
    __device__ __forceinline__ void a_ready(const Unit&) const {}
    __device__ __forceinline__ void done(const Unit&) const {}
};

__device__ __forceinline__ unsigned cvt_pk_bf16(float lo, float hi) { unsigned r; asm volatile("v_cvt_pk_bf16_f32 %0, %1, %2" : "=v"(r) : "v"(lo), "v"(hi)); return r; }
typedef float f32x2 __attribute__((ext_vector_type(2)));
__device__ __forceinline__ f32x2 gelu_pk(f32x2 v) {
    const f32x2 av = __builtin_elementwise_abs(v), d = av * 0.2316418882f + 1.0f;
    f32x2 t; t.x = __builtin_amdgcn_rcpf(d.x); t.y = __builtin_amdgcn_rcpf(d.y);
    f32x2 q = t * 0.5307027145f + (-0.7265760135f); q = q * t + 0.7107068705f; q = q * t + (-0.142248368f); q = q * t + 0.127414796f; q = q * t;
    const f32x2 s = (v * v) * (-0.72134752044f);
    f32x2 e; e.x = __builtin_amdgcn_exp2f(s.x); e.y = __builtin_amdgcn_exp2f(s.y);
    const f32x2 m = v * (q * e), r = v - m;
    f32x2 o; o.x = v.x < 0.f ? m.x : r.x; o.y = v.y < 0.f ? m.y : r.y; return o;
}

template <int ACT  > struct EpiBf16 {
    static constexpr bool PERM = true, AFTER_DRAIN = false; static_assert(ACT == 0 || ACT == 1, "EpiBf16: ACT is 0 (none) or 1 (gelu_pk)");
    bf16_t* O; int ldc; const float* bias; int split_cols; size_t split_stride; float scale0;
    __device__ __forceinline__ void operator()(const f32x4 (&acc)[2][2][4][2], const Unit& u, int wr, int wc, int fr, int fq) const {
        const int row0 = u.pm * BM + wr * 64 + fr; int colt = u.pn * BM; bf16_t* base = O;
        float sc = 1.f; if (split_cols) { const int t = colt / split_cols; base += (size_t)t * split_stride; colt -= t * split_cols; if (t == 0) sc = scale0; }
        const int col0 = colt + wc * 32 + 8 * fq, bcol0 = u.pn * BM + wc * 32 + 8 * fq;
        f32x4 bv[2][2];
#pragma unroll
        for (int bj = 0; bj < 2; ++bj)
#pragma unroll
            for (int n = 0; n < 2; ++n) bv[bj][n] = bias ? *(const f32x4*)(bias + bcol0 + bj * HALF + 4 * n) : (f32x4){0.f, 0.f, 0.f, 0.f};
#pragma unroll
        for (int ai = 0; ai < 2; ++ai)
#pragma unroll
            for (int m = 0; m < 4; ++m) { bf16_t* rowp = base + (size_t)(row0 + ai * HALF + m * 16) * ldc + col0;
#pragma unroll
                for (int bj = 0; bj < 2; ++bj) { f32x4 v0 = acc[ai][bj][m][0] + bv[bj][0], v1 = acc[ai][bj][m][1] + bv[bj][1];
                    if (ACT == 1) { f32x2 a = gelu_pk((f32x2){v0[0], v0[1]}), b = gelu_pk((f32x2){v0[2], v0[3]}), c = gelu_pk((f32x2){v1[0], v1[1]}), d = gelu_pk((f32x2){v1[2], v1[3]});
                        v0 = (f32x4){a.x, a.y, b.x, b.y}; v1 = (f32x4){c.x, c.y, d.x, d.y}; }
                    v0 = v0 * sc; v1 = v1 * sc; u32x4 w; w.x = cvt_pk_bf16(v0[0], v0[1]); w.y = cvt_pk_bf16(v0[2], v0[3]); w.z = cvt_pk_bf16(v1[0], v1[1]); w.w = cvt_pk_bf16(v1[2], v1[3]);
                    *(u32x4*)(rowp + bj * HALF) = w; } }
    }
};

typedef int v4i_t __attribute__((ext_vector_type(4))); typedef int v8i_t __attribute__((ext_vector_type(8)));
template <class Epi, class Sched, bool ALIGN_EPI = false, bool SP2 = false, bool FP8 = false, bool GATHER = false>
__device__ __forceinline__ void gemm_phase(PG8_LAS unsigned char* lds, const Gemm g, const Sched& S, const Epi& E, const int tid) {
    const int wid = __builtin_amdgcn_readfirstlane(tid >> 6), lane = tid & 63, wr = wid >> 2, wc = wid & 3, fr = lane & 15, fq = lane >> 4;
    const int K = g.K, nt = K / BK;
    static_assert(!GATHER || SP2, "GATHER is written for the SP2 loop");
    unsigned voffA[2], voffB[2]; int gR[2]; unsigned gC[2];
#pragma unroll
    for (int i = 0; i < 2; ++i) { int R, C; stage_rc(tid * 16 + i * 8192, R, C); const int Rb = Epi::PERM ? ((R & ~31) + perm32(R & 31)) : R;
        voffA[i] = (unsigned)(R * K + C) * 2u; voffB[i] = (unsigned)(Rb * K + C) * 2u; gR[i] = R; gC[i] = (unsigned)C * 2u; }
    unsigned vC[2][2], vN[2][2]; int raw[2][2];
#define PG8_ROWS_ISSUE(u) do { _Pragma("unroll") for (int _h = 0; _h < 2; ++_h) _Pragma("unroll") for (int _i = 0; _i < 2; ++_i) raw[_h][_i] = g.rowmap[(u).pm * BM + _h * HALF + gR[_i]]; } while (0)
#define PG8_ROWS_MAKE(v) do { _Pragma("unroll") for (int _h = 0; _h < 2; ++_h) _Pragma("unroll") for (int _i = 0; _i < 2; ++_i) { asm volatile("" : "+v"(raw[_h][_i])); (v)[_h][_i] = (unsigned)raw[_h][_i] * (unsigned)(K * 2) + gC[_i]; } } while (0)
    const size_t kstep = (size_t)(BK * 2);
    const size_t hstep = (size_t)HALF * K * 2;
    const size_t tstep = 2 * hstep;
    const unsigned ldsw = (unsigned)wid * 1024u;
    const int aoff = lds_byte(wr * 64 + fr, fq * 8), boff = lds_byte(wc * 32 + fr, fq * 8);
#define PG8_SA(b, h) (((b) * 2 + (h)) * HTB)
#define PG8_SB(b, h) ((4 + (b) * 2 + (h)) * HTB)
#define PG8_STAGE(bufoff, gbase, voff) do { _Pragma("unroll") for (int _i = 0; _i < 2; ++_i) \
        __builtin_amdgcn_global_load_lds((const unsigned*)((const char*)(gbase) + (voff)[_i]), (PG8_LAS unsigned*)(lds + (bufoff) + ldsw + _i * 8192), 16, 0, 0); } while (0)
#define PG8_STAGE_A(bufoff, ptr, h, nx) do { if constexpr (GATHER) { _Pragma("unroll") for (int _i = 0; _i < 2; ++_i) { const unsigned _vo = (nx) ? vN[h][_i] : vC[h][_i]; \
        __builtin_amdgcn_global_load_lds((const unsigned*)((const char*)(ptr) + _vo), (PG8_LAS unsigned*)(lds + (bufoff) + ldsw + _i * 8192), 16, 0, 0); } } else PG8_STAGE(bufoff, (ptr) + (h) * hstep, voffA); } while (0)
#define PG8_CAT(x0, x1) __builtin_shufflevector(__builtin_bit_cast(v4i_t, x0), __builtin_bit_cast(v4i_t, x1), 0, 1, 2, 3, 4, 5, 6, 7)
#define PG8_LDA(dst, b, h) do { _Pragma("unroll") for (int m = 0; m < 4; ++m) { if constexpr (FP8) dst##8[m] = PG8_CAT(*(const PG8_LAS bf16x8*)(lds + PG8_SA(b, h) + aoff + m * 2048), *(const PG8_LAS bf16x8*)(lds + PG8_SA(b, h) + aoff + m * 2048 + 1024)); \
        else { _Pragma("unroll") for (int k = 0; k < 2; ++k) dst[m][k] = *(const PG8_LAS bf16x8*)(lds + PG8_SA(b, h) + aoff + m * 2048 + k * 1024); } } } while (0)
#define PG8_LDB(dst, b, h) do { _Pragma("unroll") for (int n = 0; n < 2; ++n) { if constexpr (FP8) dst##8[n] = PG8_CAT(*(const PG8_LAS bf16x8*)(lds + PG8_SB(b, h) + boff + n * 2048), *(const PG8_LAS bf16x8*)(lds + PG8_SB(b, h) + boff + n * 2048 + 1024)); \
        else { _Pragma("unroll") for (int k = 0; k < 2; ++k) dst[n][k] = *(const PG8_LAS bf16x8*)(lds + PG8_SB(b, h) + boff + n * 2048 + k * 1024); } } } while (0)
#define PG8_MMA16(ai, bj, At, Bt) do { __builtin_amdgcn_s_setprio(1); _Pragma("unroll") for (int m = 0; m < 4; ++m) _Pragma("unroll") for (int n = 0; n < 2; ++n) _Pragma("unroll") for (int k = 0; k < 2; ++k) \
        acc[ai][bj][m][n] = __builtin_amdgcn_mfma_f32_16x16x32_bf16(Bt[n][k], At[m][k], acc[ai][bj][m][n], 0, 0, 0); __builtin_amdgcn_s_setprio(0); } while (0)
#define PG8_MMA8(ai, bj, At, Bt) do { __builtin_amdgcn_s_setprio(1); _Pragma("unroll") for (int m = 0; m < 4; ++m) _Pragma("unroll") for (int n = 0; n < 2; ++n) \
        asm volatile("v_mfma_scale_f32_16x16x128_f8f6f4 %0, %1, %2, %0, %3, %3 op_sel_hi:[0,0,0]" : "+v"(acc[ai][bj][m][n]) : "v"(Bt##8[n]), "v"(At##8[m]), "v"(one_scale)); __builtin_amdgcn_s_setprio(0); } while (0)
#define PG8_MMA(ai, bj, At, Bt) do { if constexpr (FP8) PG8_MMA8(ai, bj, At, Bt); else PG8_MMA16(ai, bj, At, Bt); } while (0)
#define PG8_WAIT_V(n) asm volatile("s_waitcnt vmcnt(" #n ")" ::: "memory")
#define PG8_WAIT_L(n) asm volatile("s_waitcnt lgkmcnt(" #n ")" ::: "memory")
#define PG8_BAR __builtin_amdgcn_s_barrier()
#define PG8_SCHED __builtin_amdgcn_sched_barrier(0)
    Unit cur, nxt; int ui = 0;
    if (!S.next(0, cur)) return;
    f32x4 acc[2][2][4][2];
#pragma unroll
    for (int a = 0; a < 2; ++a)
#pragma unroll
        for (int b = 0; b < 2; ++b)
#pragma unroll
            for (int m = 0; m < 4; ++m)
#pragma unroll
                for (int n = 0; n < 2; ++n) acc[a][b][m][n] = (f32x4){0.f, 0.f, 0.f, 0.f};
    bf16x8 At[4][2], B0[2][2], B1[2][2]; v8i_t At8[4], B08[2], B18[2];
    int one_scale = 0x7f7f7f7f; asm volatile("" : "+v"(one_scale));
    const char* cA = (const char*)g.A + (GATHER ? (size_t)0 : (size_t)cur.pm * tstep); const size_t estep = (size_t)g.N * K * 2; const char* cB = (const char*)g.Bt + (size_t)cur.e * estep + (size_t)cur.pn * tstep;
    S.a_ready(cur);
    if constexpr (GATHER) { PG8_ROWS_ISSUE(cur); PG8_ROWS_MAKE(vC); }
    if constexpr (SP2) {
        PG8_STAGE(PG8_SB(0, 0), cB, voffB); PG8_STAGE(PG8_SB(0, 1), cB + hstep, voffB); PG8_STAGE_A(PG8_SA(0, 0), cA, 0, false); PG8_STAGE_A(PG8_SA(0, 1), cA, 1, false);
        if (wr == 1) PG8_BAR;
        PG8_WAIT_V(2); PG8_BAR;
        PG8_STAGE(PG8_SB(1, 0), cB + kstep, voffB); PG8_STAGE_A(PG8_SA(1, 0), cA + kstep, 0, false); PG8_STAGE(PG8_SB(1, 1), cB + hstep + kstep, voffB);
        PG8_WAIT_V(6); PG8_BAR;
    } else {
        PG8_STAGE(PG8_SB(0, 0), cB, voffB); PG8_STAGE(PG8_SA(0, 0), cA, voffA); PG8_STAGE(PG8_SB(0, 1), cB + hstep, voffB); PG8_STAGE(PG8_SA(0, 1), cA + hstep, voffA);
        if (wr == 1) PG8_BAR;
        PG8_WAIT_V(4); PG8_BAR;
        PG8_STAGE(PG8_SB(1, 0), cB + kstep, voffB); PG8_STAGE(PG8_SA(1, 0), cA + kstep, voffA); PG8_STAGE(PG8_SB(1, 1), cB + hstep + kstep, voffB);
        PG8_WAIT_V(6); PG8_BAR;
    }
    for (;;) {
        const bool has_next = S.next(ui + 1, nxt);
        if constexpr (GATHER) { if (has_next) PG8_ROWS_ISSUE(nxt); }
        const char* nA = (has_next && !GATHER) ? (const char*)g.A + (size_t)nxt.pm * tstep : cA; const char* nB = has_next ? (const char*)g.Bt + (size_t)nxt.e * estep + (size_t)nxt.pn * tstep : cB;
        for (int t = 0; t < nt; t += 2) {
            const bool last = (t == nt - 2);
            const char* a1 = cA + (size_t)(t + 1) * kstep;
            const char* a2 = last ? nA : cA + (size_t)(t + 2) * kstep; const char* b2 = last ? nB : cB + (size_t)(t + 2) * kstep;
            const char* a3 = a2 + kstep; const char* b3 = b2 + kstep;
            if (last && has_next) S.a_ready(nxt);
            const bool nx = last && has_next; (void)nx;
            if constexpr (SP2) {
            PG8_LDB(B0, 0, 0); PG8_LDB(B1, 0, 1); PG8_SCHED; PG8_LDA(At, 0, 0); PG8_STAGE_A(PG8_SA(1, 1), a1, 1, false);
            PG8_WAIT_V(8); PG8_WAIT_L(0); PG8_BAR; PG8_MMA(0, 0, At, B0); PG8_MMA(0, 1, At, B1); PG8_BAR; PG8_SCHED;
            PG8_LDA(At, 0, 1); PG8_STAGE(PG8_SB(0, 0), b2, voffB); PG8_STAGE(PG8_SB(0, 1), b2 + hstep, voffB); PG8_STAGE_A(PG8_SA(0, 0), a2, 0, nx);
            PG8_WAIT_V(8); PG8_WAIT_L(0); PG8_BAR; PG8_MMA(1, 0, At, B0); PG8_MMA(1, 1, At, B1); PG8_BAR; PG8_SCHED;
            PG8_LDB(B0, 1, 0); PG8_LDB(B1, 1, 1); PG8_SCHED; PG8_LDA(At, 1, 0); PG8_STAGE_A(PG8_SA(0, 1), a2, 1, nx);
            PG8_WAIT_V(8); PG8_WAIT_L(0); PG8_BAR; PG8_MMA(0, 0, At, B0); PG8_MMA(0, 1, At, B1); PG8_BAR; PG8_SCHED;
            PG8_LDA(At, 1, 1); PG8_STAGE(PG8_SB(1, 0), b3, voffB); PG8_STAGE(PG8_SB(1, 1), b3 + hstep, voffB); PG8_STAGE_A(PG8_SA(1, 0), a3, 0, nx);
            PG8_WAIT_V(8); PG8_WAIT_L(0); PG8_BAR; PG8_MMA(1, 0, At, B0); PG8_MMA(1, 1, At, B1); PG8_BAR; PG8_SCHED;
            if constexpr (GATHER) { if (t == 0 && has_next) PG8_ROWS_MAKE(vN); }
            } else {
            PG8_LDB(B0, 0, 0); PG8_SCHED; PG8_LDA(At, 0, 0); PG8_STAGE(PG8_SA(1, 1), a1 + hstep, voffA);
            PG8_WAIT_L(8); PG8_BAR; PG8_WAIT_L(0); PG8_MMA(0, 0, At, B0); PG8_BAR; PG8_SCHED;
            PG8_LDB(B1, 0, 1); PG8_STAGE(PG8_SB(0, 0), b2, voffB);
            PG8_BAR; PG8_WAIT_L(0); PG8_MMA(0, 1, At, B1); PG8_BAR;
            PG8_LDA(At, 0, 1); PG8_STAGE(PG8_SA(0, 0), a2, voffA);
            PG8_BAR; PG8_WAIT_L(0); PG8_MMA(1, 0, At, B0); PG8_BAR; PG8_SCHED;
            PG8_STAGE(PG8_SB(0, 1), b2 + hstep, voffB);
            PG8_WAIT_V(6); PG8_BAR; PG8_MMA(1, 1, At, B1); PG8_BAR;
            PG8_LDB(B0, 1, 0); PG8_SCHED; PG8_LDA(At, 1, 0); PG8_STAGE(PG8_SA(0, 1), a2 + hstep, voffA);
            PG8_WAIT_L(8); PG8_BAR; PG8_WAIT_L(0); PG8_MMA(0, 0, At, B0); PG8_BAR; PG8_SCHED;
            PG8_LDB(B1, 1, 1); PG8_STAGE(PG8_SB(1, 0), b3, voffB);
            PG8_BAR; PG8_WAIT_L(0); PG8_MMA(0, 1, At, B1); PG8_BAR;
            PG8_LDA(At, 1, 1); PG8_STAGE(PG8_SA(1, 0), a3, voffA);
            PG8_BAR; PG8_WAIT_L(0); PG8_MMA(1, 0, At, B0); PG8_BAR; PG8_SCHED;
            PG8_STAGE(PG8_SB(1, 1), b3 + hstep, voffB);
            PG8_WAIT_V(6); PG8_BAR; PG8_MMA(1, 1, At, B1); PG8_BAR;
            }
        }
        if constexpr (ALIGN_EPI) { if (wr == 0) PG8_BAR; }
        if constexpr (FP8) asm volatile("s_nop 15\n\ts_nop 15" ::: "memory");
        if constexpr (!Epi::AFTER_DRAIN) { E(acc, cur, wr, wc, fr, fq); S.done(cur); }
        if (!has_next) break;
#pragma unroll
        for (int a = 0; a < 2; ++a)
#pragma unroll
            for (int b = 0; b < 2; ++b)
#pragma unroll
                for (int m = 0; m < 4; ++m)
#pragma unroll
                    for (int n = 0; n < 2; ++n) acc[a][b][m][n] = (f32x4){0.f, 0.f, 0.f, 0.f};
        cur = nxt; cA = nA; cB = nB; ++ui;
        if constexpr (GATHER) {
#pragma unroll
            for (int _h = 0; _h < 2; ++_h)
#pragma unroll
                for (int _i = 0; _i < 2; ++_i) vC[_h][_i] = vN[_h][_i]; }
        if constexpr (ALIGN_EPI) { if (wr == 1) PG8_BAR; }
    }
    PG8_WAIT_V(0);
    if constexpr (!ALIGN_EPI) { if (wr == 0) PG8_BAR; }
    PG8_BAR;
    if constexpr (Epi::AFTER_DRAIN) { E.fused(acc, cur, wr, wc, fr, fq, lds, wid, lane); S.done(cur); }
#undef PG8_SA
#undef PG8_SB
#undef PG8_STAGE
#undef PG8_STAGE_A
#undef PG8_ROWS_ISSUE
#undef PG8_ROWS_MAKE
#undef PG8_LDA
#undef PG8_LDB
#undef PG8_MMA
#undef PG8_MMA8
#undef PG8_MMA16
#undef PG8_CAT
#undef PG8_WAIT_V
#undef PG8_WAIT_L
#undef PG8_BAR
#undef PG8_SCHED
}
}
namespace pg8 {
__device__ __forceinline__ float ep_bflo(unsigned w) { return __uint_as_float(w << 16); }
__device__ __forceinline__ float ep_bfhi(unsigned w) { return __uint_as_float(w & 0xffff0000u); }
__device__ __forceinline__ float ep_sig(float x) { return __builtin_amdgcn_rcpf(1.f + __builtin_amdgcn_exp2f(-1.4426950408889634f * x)); }
__device__ __forceinline__ void ep_unpack8(u32x4 w, f32x4& a, f32x4& b) { a = (f32x4){ep_bflo(w.x), ep_bfhi(w.x), ep_bflo(w.y), ep_bfhi(w.y)}; b = (f32x4){ep_bflo(w.z), ep_bfhi(w.z), ep_bflo(w.w), ep_bfhi(w.w)}; }
__device__ __forceinline__ u32x4 ep_pack8(f32x4 a, f32x4 b) { u32x4 w; w.x = cvt_pk_bf16(a[0], a[1]); w.y = cvt_pk_bf16(a[2], a[3]); w.z = cvt_pk_bf16(b[0], b[1]); w.w = cvt_pk_bf16(b[2], b[3]); return w; }
__device__ __forceinline__ f32x4 ep_sig4(f32x4 v) { return (f32x4){ep_sig(v[0]), ep_sig(v[1]), ep_sig(v[2]), ep_sig(v[3])}; }
#define EPI_LOOP_BEGIN const int row0 = u.pm * BM + wr * 64 + fr, col0 = u.pn * BM + wc * 32 + 8 * fq; \
    _Pragma("unroll") for (int ai = 0; ai < 2; ++ai) _Pragma("unroll") for (int m = 0; m < 4; ++m) { const int row = row0 + ai * HALF + m * 16; \
    _Pragma("unroll") for (int bj = 0; bj < 2; ++bj) { const int col = col0 + bj * HALF; const f32x4 v0 = acc[ai][bj][m][0], v1 = acc[ai][bj][m][1];
#define EPI_LOOP_END } }

struct EpiBf16S {
    static constexpr bool PERM = true, AFTER_DRAIN = false;
    bf16_t* O; int ldc; float s;
#ifdef PROBE_EXTRA_ST
    bf16_t* X;
#endif
    __device__ __forceinline__ void operator()(const f32x4 (&acc)[2][2][4][2], const Unit& u, int wr, int wc, int fr, int fq) const {
#ifdef PROBE_EXTRA_ST
        const int xw = wr * 4 + wc, xl = fq * 16 + fr;
#endif
        EPI_LOOP_BEGIN
            *(u32x4*)(O + (size_t)row * ldc + col) = ep_pack8(v0 * s, v1 * s);
#ifdef PROBE_EXTRA_ST
#if PROBE_EXTRA_ST == 1
            *(u32x4*)(X + (size_t)(row - u.pm * BM) * 256 + (col - u.pn * BM)) = ep_pack8(v0 * s, v1 * s);
#else
            *(u32x4*)(X + (size_t)xw * 8192 + (size_t)((ai * 4 + m) * 2 + bj) * 512 + xl * 8) = ep_pack8(v0 * s, v1 * s);
#endif
#endif
        EPI_LOOP_END
    }
};
struct EpiNull {
    static constexpr bool PERM = true, AFTER_DRAIN = false;
    bf16_t* O;
    __device__ __forceinline__ void operator()(const f32x4 (&acc)[2][2][4][2], const Unit& u, int wr, int wc, int fr, int fq) const {
        float s = 0.f;
        EPI_LOOP_BEGIN
            s += v0[0] + v1[3];
        EPI_LOOP_END
        if (s == 123456.789f) O[0] = 0;
    }
};
struct EpiTile {
    static constexpr bool PERM = true, AFTER_DRAIN = false;
    bf16_t* O; float s;
    __device__ __forceinline__ void operator()(const f32x4 (&acc)[2][2][4][2], const Unit& u, int wr, int wc, int fr, int fq) const {
        bf16_t* base = O + (size_t)(u.pm * 46 + u.pn) * 65536;
        EPI_LOOP_BEGIN
            { const u32x4 pk_ = ep_pack8(v0 * s, v1 * s);
#if PROBE_TILE_EPI == 2
              if (m == 0) *(u32x4*)(base + (size_t)(row - u.pm * BM) * 256 + (col - u.pn * BM)) = pk_; else asm volatile("" :: "v"(pk_));
#else
              *(u32x4*)(base + (size_t)(row - u.pm * BM) * 256 + (col - u.pn * BM)) = pk_;
#endif
            }
        EPI_LOOP_END
    }
};
struct EpiLora1 {
    static constexpr bool PERM = true, AFTER_DRAIN = false;
    float* logw; bf16_t* a; const float* w0; const float* a0;
    __device__ __forceinline__ void operator()(const f32x4 (&acc)[2][2][4][2], const Unit& u, int wr, int wc, int fr, int fq) const {
        EPI_LOOP_BEGIN
            if (u.pn < 4) { const f32x4 b0 = *(const f32x4*)(w0 + col), b1 = *(const f32x4*)(w0 + col + 4);
                float* o = logw + (size_t)row * 1024 + col; *(f32x4*)o = ep_sig4(v0 + b0) * (-0.6065306597126334f); *(f32x4*)(o + 4) = ep_sig4(v1 + b1) * (-0.6065306597126334f); }
            else { const int c = col - 1024; const f32x4 b0 = *(const f32x4*)(a0 + c), b1 = *(const f32x4*)(a0 + c + 4);
                *(u32x4*)(a + (size_t)row * 1024 + c) = ep_pack8(ep_sig4(v0 + b0), ep_sig4(v1 + b1)); }
        EPI_LOOP_END
    }
};
template <int SECOND> struct EpiGateMerge {
    static constexpr bool PERM = true, AFTER_DRAIN = false;
    bf16_t* mrg; const bf16_t* P; int gcol; unsigned char* mrg8;
    __device__ __forceinline__ void operator()(const f32x4 (&acc)[2][2][4][2], const Unit& u, int wr, int wc, int fr, int fq) const {
        const int row0 = u.pm * BM + wr * 64 + fr, col0 = u.pn * BM + wc * 32 + 8 * fq;
#pragma unroll
        for (int bj = 0; bj < 2; ++bj) { const int col = col0 + bj * HALF;
#pragma unroll
            for (int ai = 0; ai < 2; ++ai) { u32x4 gw[4], tw[4];
#pragma unroll
                for (int m = 0; m < 4; ++m) { const int row = row0 + ai * HALF + m * 16; gw[m] = *(const u32x4*)(P + (size_t)row * 11776 + gcol + col); if (SECOND) tw[m] = *(const u32x4*)(mrg + (size_t)row * 2048 + col); }
#pragma unroll
                for (int m = 0; m < 4; ++m) { const int row = row0 + ai * HALF + m * 16; f32x4 g0, g1; ep_unpack8(gw[m], g0, g1);
                    f32x4 r0 = ep_sig4(g0) * acc[ai][bj][m][0], r1 = ep_sig4(g1) * acc[ai][bj][m][1];
                    if (SECOND) { f32x4 t0, t1; ep_unpack8(tw[m], t0, t1); r0 = r0 + t0; r1 = r1 + t1; }
                    if (SECOND && OUTPROJ_FP8) { r0 = r0 * FP8_SM; r1 = r1 * FP8_SM; typedef unsigned u32x2e __attribute__((ext_vector_type(2))); u32x2e o;
                        { int q = __builtin_amdgcn_cvt_pk_fp8_f32(r0[0], r0[1], 0, false); q = __builtin_amdgcn_cvt_pk_fp8_f32(r0[2], r0[3], q, true); o.x = (unsigned)q; }
                        { int q = __builtin_amdgcn_cvt_pk_fp8_f32(r1[0], r1[1], 0, false); q = __builtin_amdgcn_cvt_pk_fp8_f32(r1[2], r1[3], q, true); o.y = (unsigned)q; }
                        *(u32x2e*)(mrg8 + (size_t)row * 2048 + col) = o; }
                    else *(u32x4*)(mrg + (size_t)row * 2048 + col) = ep_pack8(r0, r1); }
                asm volatile("" ::: "memory"); } }
    }
};
struct EpiResid {
    static constexpr bool PERM = true, AFTER_DRAIN = false;
    const float* x; float* x1; const float* mod; float* ssp; float s;
    __device__ __forceinline__ void operator()(const f32x4 (&acc)[2][2][4][2], const Unit& u, int wr, int wc, int fr, int fq) const {
        const float* gt = mod + (size_t)((u.pm * BM) / 16384) * 12288 + 4096;
        const int row0 = u.pm * BM + wr * 64 + fr, col0 = u.pn * BM + wc * 32 + 8 * fq;
        float ss[2][4] = {{0.f, 0.f, 0.f, 0.f}, {0.f, 0.f, 0.f, 0.f}};
#pragma unroll
        for (int bj = 0; bj < 2; ++bj) { const int col = col0 + bj * HALF; const f32x4 g0 = *(const f32x4*)(gt + col) * s, g1 = *(const f32x4*)(gt + col + 4) * s;
#pragma unroll
            for (int ai = 0; ai < 2; ++ai) { f32x4 xa[4], xb[4];
#pragma unroll
                for (int m = 0; m < 4; ++m) { const size_t off = (size_t)(row0 + ai * HALF + m * 16) * 2048 + col; xa[m] = *(const f32x4*)(x + off); xb[m] = *(const f32x4*)(x + off + 4); }
#pragma unroll
                for (int m = 0; m < 4; ++m) { const size_t off = (size_t)(row0 + ai * HALF + m * 16) * 2048 + col; const f32x4 ya = xa[m] + g0 * acc[ai][bj][m][0], yb = xb[m] + g1 * acc[ai][bj][m][1];
                    *(f32x4*)(x1 + off) = ya; *(f32x4*)(x1 + off + 4) = yb;
                    ss[ai][m] += ((ya[0] * ya[0] + ya[1] * ya[1]) + (ya[2] * ya[2] + ya[3] * ya[3])) + ((yb[0] * yb[0] + yb[1] * yb[1]) + (yb[2] * yb[2] + yb[3] * yb[3])); }
                asm volatile("" ::: "memory"); } }
        float* sp = ssp + (size_t)(u.pn * 4 + wc) * 32768;
#pragma unroll
        for (int ai = 0; ai < 2; ++ai)
#pragma unroll
            for (int m = 0; m < 4; ++m) { float s = ss[ai][m]; s += __shfl_xor(s, 16); s += __shfl_xor(s, 32); if (fq == 0) sp[row0 + ai * HALF + m * 16] = s; }
    }
};
struct EpiSwiglu {
    static constexpr bool PERM = true, AFTER_DRAIN = false;
    unsigned char* act; const float* bias; PG8_LAS unsigned char* stg;
    __device__ __forceinline__ void operator()(const f32x4 (&acc)[2][2][4][2], const Unit& u, int wr, int wc, int fr, int fq) const {
        const int gcol = u.pn * 128 + wc * 32 + 8 * fq, lane = fq * 16 + fr, wid = wr * 4 + wc;
        const float* bg = bias + (size_t)u.e * 4096 + gcol; const float* bl = bg + 2048;
        const f32x4 bg0 = *(const f32x4*)bg, bg1 = *(const f32x4*)(bg + 4), bl0 = *(const f32x4*)bl, bl1 = *(const f32x4*)(bl + 4);
        typedef unsigned u32x2e __attribute__((ext_vector_type(2)));
#pragma unroll
        for (int ai = 0; ai < 2; ++ai) {
#pragma unroll
            for (int m = 0; m < 4; ++m) { const int rl = wr * 64 + m * 16 + fr;
                f32x4 g0 = acc[ai][0][m][0] * (1.f / 128.f) + bg0, g1 = acc[ai][0][m][1] * (1.f / 128.f) + bg1, l0 = acc[ai][1][m][0] * (1.f / 128.f) + bl0, l1 = acc[ai][1][m][1] * (1.f / 128.f) + bl1, r0, r1;
#pragma unroll
                for (int i = 0; i < 4; ++i) { const float a = fminf(g0[i], 7.f), b = fminf(g1[i], 7.f);
                    r0[i] = a * ep_sig(1.702f * a) * (fminf(fmaxf(l0[i], -7.f), 7.f) + 1.f); r1[i] = b * ep_sig(1.702f * b) * (fminf(fmaxf(l1[i], -7.f), 7.f) + 1.f); }
                r0 = r0 * 4.f; r1 = r1 * 4.f; u32x2e o;
                { int w = __builtin_amdgcn_cvt_pk_fp8_f32(r0[0], r0[1], 0, false); w = __builtin_amdgcn_cvt_pk_fp8_f32(r0[2], r0[3], w, true); o.x = (unsigned)w; }
                { int w = __builtin_amdgcn_cvt_pk_fp8_f32(r1[0], r1[1], 0, false); w = __builtin_amdgcn_cvt_pk_fp8_f32(r1[2], r1[3], w, true); o.y = (unsigned)w; }
                *(PG8_LAS u32x2e*)(stg + rl * 128 + (((2 * wc + (fq >> 1)) ^ (rl & 7)) << 4) + 8 * (fq & 1)) = o; }
            asm volatile("s_waitcnt lgkmcnt(0)" ::: "memory"); __builtin_amdgcn_s_barrier();
#pragma unroll
            for (int j = 0; j < 2; ++j) { const int rl = wid * 16 + j * 8 + (lane >> 3), p = lane & 7;
                const u32x4 v = *(const PG8_LAS u32x4*)(stg + rl * 128 + ((p ^ (rl & 7)) << 4));
                *(u32x4*)(act + (size_t)(u.pm * BM + ai * HALF + rl) * 2048 + u.pn * 128 + 16 * p) = v; }
            asm volatile("s_waitcnt lgkmcnt(0)" ::: "memory"); __builtin_amdgcn_s_barrier(); }
    }
};
struct EpiDown {
    static constexpr bool PERM = true, AFTER_DRAIN = false;
    unsigned char* ys; const float* bias; const float* slot_w;
    __device__ __forceinline__ void operator()(const f32x4 (&acc)[2][2][4][2], const Unit& u, int wr, int wc, int fr, int fq) const {
        const float* be = bias + (size_t)u.e * 2048; const int row0 = u.pm * BM + wr * 64 + fr, col0 = u.pn * BM + wc * 64 + 16 * fq;
        float w[2][4]; f32x4 b[2][2];
#pragma unroll
        for (int ai = 0; ai < 2; ++ai)
#pragma unroll
            for (int m = 0; m < 4; ++m) w[ai][m] = slot_w[row0 + ai * HALF + m * 16] * FP8_SY;
#pragma unroll
        for (int bj = 0; bj < 2; ++bj) { b[bj][0] = *(const f32x4*)(be + col0 + 8 * bj); b[bj][1] = *(const f32x4*)(be + col0 + 8 * bj + 4); }
#pragma unroll
        for (int ai = 0; ai < 2; ++ai)
#pragma unroll
            for (int m = 0; m < 4; ++m) { const int row = row0 + ai * HALF + m * 16; u32x4 o; unsigned q[4];
#pragma unroll
                for (int bj = 0; bj < 2; ++bj)
#pragma unroll
                    for (int n = 0; n < 2; ++n) { const f32x4 r = (acc[ai][bj][m][n] * (1.f / 256.f) + b[bj][n]) * w[ai][m];
                        int p = __builtin_amdgcn_cvt_pk_fp8_f32(r[0], r[1], 0, false); p = __builtin_amdgcn_cvt_pk_fp8_f32(r[2], r[3], p, true); q[2 * bj + n] = (unsigned)p; }
                o.x = q[0]; o.y = q[1]; o.z = q[2]; o.w = q[3];
                *(u32x4*)(ys + (size_t)row * 2048 + col0) = o; }
    }
};
struct MoeOrder : StaticOrder {
    const int* tile_e;
    __device__ bool next(int i, Unit& u) const { if (!StaticOrder::next(i, u)) return false; u.e = tile_e[u.pm]; return true; }
};
}
namespace fox {
enum { ORDER_NATURAL = 0, ORDER_REVERSED = 1, ORDER_PAIRED = 2, ORDER_XCD = 4 };
using TIN = __hip_bfloat16; using TOUT = __hip_bfloat16;
constexpr int B = 2, H = 8, HKV = 8, SQ = 16384, SKV = 16384, D = 128;
constexpr int PITCH = 1024;
constexpr int GPITCH = 11776;
constexpr int QOFF = 0;
constexpr int WINDOW = SKV;
constexpr float THR = 8.f;
constexpr int ORDER = ORDER_PAIRED;
constexpr bool WSKIP = false;
constexpr float SCALE = 0.08838834764831845f;
constexpr int NW = 8, QBLK = 32, KVBLK = 64, QB = NW * QBLK;
constexpr int SHM_V = KVBLK * D * 2, SHM_K = KVBLK * D * 2;
constexpr int LDS_CB = 2 * SHM_V + 2 * SHM_K + NW * 64 * 4;
constexpr int LDS_GATE = LDS_CB + 3 * 64 * 4 + 256;
constexpr int LDS_BYTES = LDS_GATE + NW * 8192;
static_assert(D == 128 && SQ % QB == 0 && SKV % KVBLK == 0 && H % HKV == 0 && QOFF >= 0 && QOFF + SQ <= SKV && WINDOW >= 1, "geometry");

using bf16 = __hip_bfloat16;
typedef short bf16x8 __attribute__((ext_vector_type(8)));
typedef short s16x4 __attribute__((ext_vector_type(4)));
typedef float f32x16 __attribute__((ext_vector_type(16)));
typedef float f32x4 __attribute__((ext_vector_type(4)));
typedef unsigned u32x4 __attribute__((ext_vector_type(4)));
template <class A, class Bt> struct same_t { static constexpr bool v = false; };
template <class A> struct same_t<A, A> { static constexpr bool v = true; };

#define KSWZ(row, colB) ((row) * 256 + ((colB) ^ (((row) & 7) << 4)))
#define SBAR() __builtin_amdgcn_sched_barrier(0)
__device__ __forceinline__ int v_st(int k, int c) { const int kk = (k & ~0xC) | ((k & 4) << 1) | ((k & 8) >> 1); return ((kk >> 3) * 4 + (c >> 5)) * 512 + ((kk & 7) * 32 + (c & 31)) * 2; }
__device__ __forceinline__ int v_rd_base(int lane) { return ((lane & 3) << 3) | (((lane >> 2) & 3) << 6) | (((lane >> 4) & 1) << 5) | (((lane >> 5) & 1) << 8); }
constexpr int v_rd_off(int d0, int ks, int half) { return d0 * 512 + ks * 4096 + half * 2048; }
__device__ __forceinline__ int crow(int r, int hi) { return (r & 3) + 8 * (r >> 2) + 4 * hi; }
__device__ __forceinline__ unsigned cvtpk(float lo, float hi) {
    unsigned r; asm volatile("v_cvt_pk_bf16_f32 %0, %1, %2" : "=v"(r) : "v"(lo), "v"(hi)); return r;
}
__device__ __forceinline__ bf16x8 pack8(f32x4 a, f32x4 b) {
    u32x4 w = {cvtpk(a[0], a[1]), cvtpk(a[2], a[3]), cvtpk(b[0], b[1]), cvtpk(b[2], b[3])};
    return *reinterpret_cast<bf16x8*>(&w);
}
template <class T> __device__ __forceinline__ bf16x8 load8(const T* p) {
    if constexpr (same_t<T, float>::v) { return pack8(*(const f32x4*)p, *(const f32x4*)(p + 4)); }
    else { return *reinterpret_cast<const bf16x8*>(p); }
}
__device__ __forceinline__ void mask_tile(f32x16& p0, f32x16& p1, int dq, unsigned W) {
    const float NEG = -__builtin_inff();
#pragma unroll
    for (int r = 0; r < 16; ++r) {
        const int c = (r & 3) + 8 * (r >> 2);
        if ((unsigned)(dq - c) >= W) p0[r] = NEG;
        if ((unsigned)(dq - c - 32) >= W) p1[r] = NEG;
    }
}
__device__ __forceinline__ void partialSM(f32x16& p0, f32x16& p1, float& m_reg, float& mn, float& alpha) {
    float pmax = p0[0]; for (int r = 1; r < 16; ++r) pmax = fmaxf(pmax, p0[r]); for (int r = 0; r < 16; ++r) pmax = fmaxf(pmax, p1[r]);
    { auto rr = __builtin_amdgcn_permlane32_swap(__float_as_uint(pmax), __float_as_uint(pmax), false, false);
      pmax = fmaxf(__uint_as_float(rr[0]), __uint_as_float(rr[1])); }
    constexpr float C2 = 1.4426950408889634f * SCALE;
    if (__builtin_expect(__all((pmax - m_reg) * SCALE <= THR), 1)) { mn = m_reg; alpha = 1.f; }
    else { mn = fmaxf(m_reg, pmax); alpha = __builtin_amdgcn_exp2f((m_reg - mn) * C2); m_reg = mn; }
    const float mnL = -mn * C2;
    for (int r = 0; r < 16; ++r) p0[r] = fmaf(p0[r], C2, mnL); for (int r = 0; r < 16; ++r) p1[r] = fmaf(p1[r], C2, mnL);
    for (int r = 0; r < 16; ++r) p0[r] = __builtin_amdgcn_exp2f(p0[r]);
}
__device__ __forceinline__ void finishSM(f32x16& p0, f32x16& p1, float alpha, float& l_reg, bf16x8& pa0, bf16x8& pa1, bf16x8& pa2, bf16x8& pa3) {
    for (int r = 0; r < 16; ++r) p1[r] = __builtin_amdgcn_exp2f(p1[r]);
    float ps = 0; for (int r = 0; r < 16; ++r) ps += p0[r]; for (int r = 0; r < 16; ++r) ps += p1[r];
    { auto rr = __builtin_amdgcn_permlane32_swap(__float_as_uint(ps), __float_as_uint(ps), false, false);
      ps = __uint_as_float(rr[0]) + __uint_as_float(rr[1]); }
    l_reg = l_reg * alpha + ps;
#define PK4(P, B_, OUT) do { unsigned a0 = cvtpk(P[B_+0], P[B_+1]), a1 = cvtpk(P[B_+2], P[B_+3]);                          \
        unsigned b0 = cvtpk(P[B_+4], P[B_+5]), b1 = cvtpk(P[B_+6], P[B_+7]);                                             \
        auto r0 = __builtin_amdgcn_permlane32_swap(a0, b0, false, false); auto r1 = __builtin_amdgcn_permlane32_swap(a1, b1, false, false); \
        u32x4 w = {r0[0], r1[0], r0[1], r1[1]}; OUT = *reinterpret_cast<bf16x8*>(&w); } while (0)
    PK4(p0, 0, pa0); PK4(p0, 8, pa1); PK4(p1, 0, pa2); PK4(p1, 8, pa3);
#undef PK4
}
template <int KB, bool SK>
__device__ __forceinline__ void qkt(f32x16& p0, f32x16& p1, const char* K_lds, int r32, int hi, const bf16x8* qr, bool act, int cbi) {
    if (SK && !act) { const float NEG = -__builtin_inff();
#pragma unroll
        for (int r = 0; r < 16; ++r) { p0[r] = NEG; p1[r] = NEG; } return; }
    { const float* cb_ = (const float*)(K_lds + 2 * SHM_K + NW * 64 * 4) + cbi * 64 + 4 * hi;
#pragma unroll
      for (int g_ = 0; g_ < 4; ++g_) { const f32x4 b0_ = *(const f32x4*)(cb_ + 8 * g_), b1_ = *(const f32x4*)(cb_ + 32 + 8 * g_);
#pragma unroll
          for (int i_ = 0; i_ < 4; ++i_) { p0[4 * g_ + i_] = b0_[i_]; p1[4 * g_ + i_] = b1_[i_]; } } }
    const char* kb[4];
#pragma unroll
    for (int dd = 0; dd < 4; ++dd) kb[dd] = K_lds + KB * SHM_K + KSWZ(r32, (dd * 16 + hi * 8) * 2);
#pragma unroll
    for (int d0 = 0; d0 < 8; ++d0) { const char* a = kb[d0 & 3] + (d0 >> 2) * 128;
        bf16x8 b0 = *reinterpret_cast<const bf16x8*>(a);
        bf16x8 b1 = *reinterpret_cast<const bf16x8*>(a + 32 * 256);
        p0 = __builtin_amdgcn_mfma_f32_32x32x16_bf16(b0, qr[d0], p0, 0, 0, 0);
        p1 = __builtin_amdgcn_mfma_f32_32x32x16_bf16(b1, qr[d0], p1, 0, 0, 0); }
}
template <int VB, bool SK>
__device__ __forceinline__ void pv_tile(f32x16* o, int vb0, bf16x8 pa0, bf16x8 pa1, bf16x8 pa2, bf16x8 pa3, bool act) {
    if (SK && !act) return;
#define TRRD(dst, off) asm volatile("ds_read_b64_tr_b16 %0, %1 offset:%2" : "=&v"(dst) : "v"(vb0), "i"(off) : "memory")
#define PV_D0(d0) do { s16x4 l0, l1, l2, l3, h0, h1, h2, h3; constexpr int b_ = VB * SHM_V + v_rd_off(d0, 0, 0);     \
        TRRD(l0, b_); TRRD(h0, b_ + 2048); TRRD(l1, b_ + 4096); TRRD(h1, b_ + 6144); TRRD(l2, b_ + 8192); TRRD(h2, b_ + 10240); TRRD(l3, b_ + 12288); TRRD(h3, b_ + 14336); \
        asm volatile("s_waitcnt lgkmcnt(0)" ::: "memory"); SBAR();                 \
        o[d0] = __builtin_amdgcn_mfma_f32_32x32x16_bf16(pa0, (bf16x8){l0[0], l0[1], l0[2], l0[3], h0[0], h0[1], h0[2], h0[3]}, o[d0], 0, 0, 0);   \
        o[d0] = __builtin_amdgcn_mfma_f32_32x32x16_bf16(pa1, (bf16x8){l1[0], l1[1], l1[2], l1[3], h1[0], h1[1], h1[2], h1[3]}, o[d0], 0, 0, 0);   \
        o[d0] = __builtin_amdgcn_mfma_f32_32x32x16_bf16(pa2, (bf16x8){l2[0], l2[1], l2[2], l2[3], h2[0], h2[1], h2[2], h2[3]}, o[d0], 0, 0, 0);   \
        o[d0] = __builtin_amdgcn_mfma_f32_32x32x16_bf16(pa3, (bf16x8){l3[0], l3[1], l3[2], l3[3], h3[0], h3[1], h3[2], h3[3]}, o[d0], 0, 0, 0); } while (0)
    PV_D0(0); PV_D0(1); PV_D0(2); PV_D0(3);
#undef PV_D0
#undef TRRD
}

template <class TIn, class TOut> struct BlockRef { const unsigned char* ws; int row0, bh, P0, jlo;
    __device__ __forceinline__ const TIn* Q() const { return (const TIn*)(ws + WS_FQ) + (size_t)row0 * PITCH + (bh % H) * D; }
    __device__ __forceinline__ const TIn* K() const { return (const TIn*)(ws + WS_FK) + (size_t)(bh / H) * SQ * PITCH + (bh % H) * D; }
    __device__ __forceinline__ const TIn* V() const { return (const TIn*)(ws + WS_P) + (size_t)(bh / H) * SQ * GPITCH + PC_FV + (bh % H) * D; }
    __device__ __forceinline__ TOut* O() const { return (TOut*)(ws + WS_YB) + (size_t)row0 * PITCH + (bh % H) * D; }
    __device__ __forceinline__ const float* C() const { return (const float*)(ws + WS_CS) + (size_t)bh * SQ; }
    __device__ __forceinline__ const TIn* G() const { return (const TIn*)(ws + WS_P) + (size_t)row0 * GPITCH + PC_OG + (bh % H) * D; }
};
template <class TIn> struct Seam {
    bf16x8 qr[8];
    bf16x8 st_v0, st_v1, st_k0, st_k1; int cbi; f32x4 sf0, sf1, sf2, sf3;
    f32x4 tq[16];
};
__device__ __forceinline__ int swa_jlo(int P0, int W) { const int lowk = P0 - W + 1; return lowk > 0 ? lowk / KVBLK : 0; }
#define ROW(p, k0, rr) ((p) + (size_t)((k0) + (rr)) * PITCH + sc)
#define ROWV(p, k0, rr) ((p) + (size_t)((k0) + (rr)) * GPITCH + sc)
#define VMW() asm volatile("s_waitcnt vmcnt(0)" ::: "memory")
#define VMWN(n) asm volatile("s_waitcnt vmcnt(%0)" :: "i"(n) : "memory")
#define NEXT3(x) ((x) == 2 ? 0 : (x) + 1)
#define SLOAD_H(Kp, Vp, Cp, k0, CI) do { S.st_v0 = load8<TIn>(ROWV(Vp, k0, sr)); S.st_v1 = load8<TIn>(ROWV(Vp, k0, 32 + sr));              \
                         S.st_k0 = load8<TIn>(ROW(Kp, k0, sr)); S.st_k1 = load8<TIn>(ROW(Kp, k0, 32 + sr));                 \
                         if (wid == 0) __builtin_amdgcn_global_load_lds((const unsigned*)((Cp) + (k0) + lane), (__attribute__((address_space(3))) unsigned*)(lds + LDS_CB + (CI) * 256), 4, 0, 0); } while (0)
#define SWRITE_HK(bf) do { *(bf16x8*)(K_lds + (bf) * SHM_K + kws) = S.st_k0; *(bf16x8*)(K_lds + (bf) * SHM_K + kws + 32 * 256) = S.st_k1; } while (0)
#define SWRITE_HV(bf) do { *(bf16x8*)(V_lds + (bf) * SHM_V + vst0) = S.st_v0; *(bf16x8*)(V_lds + (bf) * SHM_V + vst1) = S.st_v1; } while (0)
#define SWRITE_H(bf) do { SWRITE_HV(bf); SWRITE_HK(bf); } while (0)
#define SLOAD_F(p, k0) do { S.sf0 = *(const f32x4*)ROW(p, k0, sr); S.sf1 = *(const f32x4*)(ROW(p, k0, sr) + 4);                \
                            S.sf2 = *(const f32x4*)ROW(p, k0, 32 + sr); S.sf3 = *(const f32x4*)(ROW(p, k0, 32 + sr) + 4); } while (0)
#define SWRITE_KF(bf) do { *(bf16x8*)(K_lds + (bf) * SHM_K + kws) = pack8(S.sf0, S.sf1); *(bf16x8*)(K_lds + (bf) * SHM_K + kws + 32 * 256) = pack8(S.sf2, S.sf3); } while (0)
#define SWRITE_VF(bf) do { *(bf16x8*)(V_lds + (bf) * SHM_V + vst0) = pack8(S.sf0, S.sf1); *(bf16x8*)(V_lds + (bf) * SHM_V + vst1) = pack8(S.sf2, S.sf3); } while (0)
template <class TIn, class TOut>
__device__ __forceinline__ void causal_swa_prime(const BlockRef<TIn, TOut>& cur, int W, char* lds, Seam<TIn>& S, const int tid) {
    constexpr bool F32 = same_t<TIn, float>::v;
    const int wid = __builtin_amdgcn_readfirstlane(tid >> 6), lane = tid & 63, r32 = lane & 31, hi = lane >> 5;
    const int sr = tid >> 4, sc = (tid & 15) * 8, kws = KSWZ(sr, sc * 2); char* K_lds = lds + 2 * SHM_V;
    const int kb0 = cur.jlo * KVBLK;
    for (int d0 = 0; d0 < 8; ++d0) S.qr[d0] = load8<TIn>(cur.Q() + (size_t)(wid * QBLK + r32) * PITCH + d0 * 16 + hi * 8);
    if constexpr (F32) { SLOAD_F((const float*)cur.K(), kb0); VMW(); SWRITE_KF(0); SBAR(); SLOAD_F((const float*)cur.V(), kb0); }
    else { S.cbi = 0; SLOAD_H(cur.K(), cur.V(), cur.C(), kb0, 0); VMW(); SWRITE_HK(0); }
    __syncthreads();
}
template <class TIn, class TOut>
__device__ __forceinline__ void causal_swa_block(const BlockRef<TIn, TOut>& cur, const BlockRef<TIn, TOut>& nxt, int skv, int W, char* lds, Seam<TIn>& S, const int tid) {
    constexpr bool F32 = same_t<TIn, float>::v;
    const int wid = __builtin_amdgcn_readfirstlane(tid >> 6), lane = tid & 63, r32 = lane & 31, hi = lane >> 5;
    const int j_lo = cur.jlo;
    int j_hi = (cur.P0 + QB - 1) / KVBLK + 1; if (j_hi > skv / KVBLK) j_hi = skv / KVBLK;
    const int NT = j_hi - j_lo;
    const int kbn = nxt.jlo * KVBLK;
    const int qlo = cur.P0 + wid * QBLK, qm = qlo + r32 - 4 * hi;
    char* V_lds = lds; char* K_lds = lds + 2 * SHM_V;
    float* ws = (float*)(lds + 2 * SHM_V + 2 * SHM_K) + wid * 64; float* li_l = ws, * al_l = ws + 32;
    float m_reg = -1e30f, l_reg = 0; f32x16 o[4] = {};
    const int sr = tid >> 4, sc = (tid & 15) * 8, vst0 = v_st(sr, sc), vst1 = v_st(32 + sr, sc), kws = KSWZ(sr, sc * 2);
    const int vb0 = (int)(uintptr_t)V_lds + v_rd_base(lane);
    const TIn* Kh = cur.K(); const TIn* Vh = cur.V(); const float* Ch = cur.C(); int cb_t = S.cbi;
    {
        const TIn* gsrc = cur.G() + (size_t)(wid * QBLK + (lane >> 4)) * GPITCH + (lane & 15) * 8;
#pragma unroll
        for (int i_ = 0; i_ < 8; ++i_) __builtin_amdgcn_global_load_lds((const unsigned*)(gsrc + (size_t)(4 * i_) * GPITCH), (__attribute__((address_space(3))) unsigned*)(lds + LDS_GATE + wid * 8192 + i_ * 1024), 16, 0, 0); }
#define RESC(a) do { if (__any((a) < 1.f)) { if (hi == 0) al_l[r32] = (a); asm volatile("s_waitcnt lgkmcnt(0)" ::: "memory");              \
                     for (int d_ = 0; d_ < 4; ++d_) for (int r = 0; r < 16; ++r) o[d_][r] *= al_l[crow(r, hi)]; } } while (0)
#define KBASE(t) ((j_lo + (t)) * KVBLK)
#define ACT(t) (KBASE(t) <= qlo + QBLK - 1 && KBASE(t) + KVBLK - 1 >= qlo - W + 1)
#define MASKT(P0_, P1_, t) do { const int kb_ = KBASE(t); if ((!SK || ACT(t)) && (kb_ + KVBLK - 1 > qlo || kb_ <= qlo + QBLK - 1 - W)) mask_tile(P0_, P1_, qm - kb_, (unsigned)W); } while (0)
    constexpr int NQL = F32 ? 16 : 8;
    constexpr bool SK = WSKIP && !F32;
#define SEAM_K0() do { VMWN(NQL); if constexpr (F32) { SWRITE_KF(0); SBAR(); SLOAD_F((const float*)nxt.V(), kbn); } else { SWRITE_HK(0); } SBAR(); } while (0)
    f32x16 pA0, pA1, pB0, pB1; float mnA, mnB, alA, alB; bf16x8 pa0, pa1, pa2, pa3;
    if constexpr (F32) { VMW(); SWRITE_VF(0); SBAR(); } else { SWRITE_HV(0); SBAR(); }
    if (NT > 1) { if constexpr (F32) SLOAD_F((const float*)Kh, KBASE(1)); else SLOAD_H(Kh, Vh, Ch, KBASE(1), NEXT3(cb_t)); }
    SBAR(); qkt<0, SK>(pA0, pA1, K_lds, r32, hi, S.qr, ACT(0), cb_t);
    if constexpr (F32) { if (NT > 1) { VMW(); SWRITE_KF(1); SBAR(); SLOAD_F((const float*)Vh, KBASE(1)); } }
    MASKT(pA0, pA1, 0); partialSM(pA0, pA1, m_reg, mnA, alA);
    if (NT > 1) { VMW(); if constexpr (F32) { SWRITE_VF(1); SBAR(); if (NT > 2) SLOAD_F((const float*)Kh, KBASE(2)); } else SWRITE_H(1); }
    __syncthreads();
#define HALF_STEP(PX0, PX1, mnX, alX, PY0, PY1, alY, t, KB, VB, SB) do {                                                      \
        SBAR(); cb_t = NEXT3(cb_t); qkt<KB, SK>(PX0, PX1, K_lds, r32, hi, S.qr, ACT(t), cb_t);                                             \
        finishSM(PY0, PY1, alY, l_reg, pa0, pa1, pa2, pa3); SBAR();                                                           \
        if ((t) + 1 < NT) { if constexpr (F32) { VMW(); SWRITE_KF(SB); SBAR(); SLOAD_F((const float*)Vh, KBASE((t) + 1)); }  \
                            else { SLOAD_H(Kh, Vh, Ch, KBASE((t) + 1), NEXT3(cb_t)); } SBAR(); }                                               \
        pv_tile<VB, SK>(o, vb0, pa0, pa1, pa2, pa3, ACT((t) - 1)); MASKT(PX0, PX1, (t)); partialSM(PX0, PX1, m_reg, mnX, alX);                                        \
        __syncthreads();                                                                                                      \
        if ((t) + 1 < NT) { VMW(); if constexpr (F32) { SWRITE_VF(SB); SBAR(); if ((t) + 2 < NT) SLOAD_F((const float*)Kh, KBASE((t) + 2)); } \
                            else { SWRITE_H(SB); } }                                                                          \
        RESC(alX); __syncthreads(); } while (0)
    for (int t = 1; t + 1 < NT; t += 2) {
        HALF_STEP(pB0, pB1, mnB, alB, pA0, pA1, alA, t, 1, 0, 0);
        HALF_STEP(pA0, pA1, mnA, alA, pB0, pB1, alB, t + 1, 0, 1, 1);
    }
    const bool even = (NT & 1) == 0;
    if (even) { SBAR(); cb_t = NEXT3(cb_t); qkt<1, SK>(pB0, pB1, K_lds, r32, hi, S.qr, ACT(NT - 1), cb_t); SBAR(); }
#define QROW(e) (nxt.Q() + (size_t)(wid * QBLK + r32) * PITCH + ((e) >> 1) * 16 + hi * 8 + ((e) & 1) * 4)
    if constexpr (F32) { SLOAD_F((const float*)nxt.K(), kbn); SBAR();
#pragma unroll
        for (int e = 0; e < 8; ++e) S.tq[e] = *(const f32x4*)QROW(e); }
    else { SLOAD_H(nxt.K(), nxt.V(), nxt.C(), kbn, NEXT3(cb_t)); S.cbi = NEXT3(cb_t); SBAR();
#pragma unroll
        for (int d0 = 0; d0 < 8; ++d0) S.qr[d0] = load8<TIn>(nxt.Q() + (size_t)(wid * QBLK + r32) * PITCH + d0 * 16 + hi * 8); }
    SBAR();
    finishSM(pA0, pA1, alA, l_reg, pa0, pa1, pa2, pa3); SBAR();
    if constexpr (F32) {
#pragma unroll
        for (int e = 8; e < 16; ++e) S.tq[e] = *(const f32x4*)QROW(e); SBAR(); }
#undef QROW
    pv_tile<0, SK>(o, vb0, pa0, pa1, pa2, pa3, ACT(even ? NT - 2 : NT - 1));
    if (even) { MASKT(pB0, pB1, NT - 1); partialSM(pB0, pB1, m_reg, mnB, alB); __syncthreads(); RESC(alB);
        finishSM(pB0, pB1, alB, l_reg, pa0, pa1, pa2, pa3); SBAR(); pv_tile<1, SK>(o, vb0, pa0, pa1, pa2, pa3, ACT(NT - 1)); }
    SBAR(); SEAM_K0();
    if (hi == 0) li_l[r32] = l_reg; asm volatile("s_waitcnt lgkmcnt(0)" ::: "memory");
    float rli[16];
#pragma unroll
    for (int r = 0; r < 16; ++r) rli[r] = __builtin_amdgcn_rcpf(li_l[crow(r, hi)]);
    int hi_e = hi; asm volatile("" : "+v"(hi_e));
    TOut* Ow = cur.O() + (size_t)(wid * QBLK) * PITCH + (size_t)(4 * hi_e) * PITCH; const char* gl_ = lds + LDS_GATE + wid * 8192 + 4 * hi_e * 256;
#pragma unroll
    for (int r = 0; r < 16; ++r) { const int orow = (r & 3) + 8 * (r >> 2);
#pragma unroll
        for (int d0 = 0; d0 < 4; ++d0) { const float v = o[d0][r] * rli[r];
            if constexpr (same_t<TOut, float>::v) { Ow[(size_t)orow * PITCH + d0 * 32 + r32] = v; }
            else { const float vn = __shfl_xor(v, 1);
                   if ((r32 & 1) == 0) { const unsigned gw_ = *(const unsigned*)(gl_ + orow * 256 + (d0 * 32 + r32) * 2);
                       const float g0_ = __uint_as_float(gw_ << 16), g1_ = __uint_as_float(gw_ & 0xffff0000u);
                       const float s0_ = __builtin_amdgcn_rcpf(1.f + __builtin_amdgcn_exp2f(-1.4426950408889634f * g0_)), s1_ = __builtin_amdgcn_rcpf(1.f + __builtin_amdgcn_exp2f(-1.4426950408889634f * g1_));
                       *(unsigned*)(Ow + (size_t)orow * PITCH + d0 * 32 + r32) = cvtpk(v * s0_, vn * s1_); } } } }
    if constexpr (F32) {
#pragma unroll
        for (int d0 = 0; d0 < 8; ++d0) S.qr[d0] = pack8(S.tq[2 * d0], S.tq[2 * d0 + 1]); }
    __syncthreads();
#undef RESC
#undef KBASE
#undef ACT
#undef MASKT
#undef SEAM_K0
#undef HALF_STEP
}
#undef ROW
#undef ROWV
#undef VMW
#undef VMWN
#undef SLOAD_H
#undef SWRITE_HK
#undef SWRITE_HV
#undef SWRITE_H
#undef SLOAD_F
#undef SWRITE_KF
#undef SWRITE_VF

}
#ifndef RW_SOLVE_OLD
#define RW_SOLVE_OLD 0
#endif
namespace rw {
typedef short bf16x8 __attribute__((ext_vector_type(8)));
typedef float f32x4 __attribute__((ext_vector_type(4)));
typedef unsigned u32x4 __attribute__((ext_vector_type(4)));
typedef unsigned u32x2 __attribute__((ext_vector_type(2)));
#define RW_LAS __attribute__((address_space(3)))
constexpr int PB = 144, PF = 272, MB = 64 * PB;
constexpr int O_R = 0, O_K = MB, O_A = 2 * MB, O_B = 3 * MB, O_BT = 4 * MB, O_KT = 5 * MB, O_VT = 6 * MB, O_AAK = 7 * MB, O_ARB = 8 * MB, O_ARK = 9 * MB;
constexpr int O_AAB = 10 * MB, O_GT = O_AAB + 64 * PF, O_GAM = O_GT + 64 * PF, O_TOT = O_GAM + 256, O_END = O_TOT + 2048;
constexpr int O_AABB = O_END, O_TB = O_AABB + MB, O_END2 = O_TB + 4 * 768;
constexpr int O_WT = O_K, O_UT = O_AAK;
static_assert(O_END2 <= 143360, "phase A LDS map");
constexpr int REC = 32768, REC_P = 0, REC_Q = 8192, REC_H = 16384, REC_Y = 24576;
typedef float f32x2_t __attribute__((ext_vector_type(2))); typedef __bf16 bf16x2_t __attribute__((ext_vector_type(2)));
__device__ __forceinline__ unsigned cvtpk(float lo, float hi) { f32x2_t v = {lo, hi}; bf16x2_t b = __builtin_convertvector(v, bf16x2_t); return __builtin_bit_cast(unsigned, b); }
__device__ __forceinline__ float blo(unsigned w) { return __uint_as_float(w << 16); }
__device__ __forceinline__ float bhi(unsigned w) { return __uint_as_float(w & 0xffff0000u); }
__device__ __forceinline__ bf16x8 frag(const RW_LAS unsigned char* base, int tile, int ks, int lane) { return *(const RW_LAS bf16x8*)(base + (16 * tile + (lane & 15)) * PB + (ks * 32 + 8 * (lane >> 4)) * 2); }
#define RW_MFMA(a, b, c) __builtin_amdgcn_mfma_f32_16x16x32_bf16(a, b, c, 0, 0, 0)
#define RW_SYNC() __syncthreads()
#define RW_BAR() do { asm volatile("" ::: "memory"); __builtin_amdgcn_s_barrier(); asm volatile("" ::: "memory"); } while (0)

struct ChunkIn { u32x4 r, k, v, a; f32x4 l0, l1; };
__device__ __forceinline__ void load_chunk(ChunkIn& c, const unsigned char* ws, int it, int tid) {
    const int bh = it >> 8, ch = it & 255, b = bh >> 4, h = bh & 15, tok = tid >> 3, part = tid & 7;
    const size_t off = ((size_t)b * SEQ + (size_t)ch * 64 + tok) * 1024 + h * 64 + 8 * part;
    c.r = *(const u32x4*)((const unsigned short*)(ws + WS_R) + off); c.k = *(const u32x4*)((const unsigned short*)(ws + WS_K) + off); c.v = *(const u32x4*)((const unsigned short*)(ws + WS_V) + off);
    c.a = *(const u32x4*)((const unsigned short*)(ws + WS_A) + off); c.l0 = *(const f32x4*)((const float*)(ws + WS_LOGW) + off); c.l1 = *(const f32x4*)((const float*)(ws + WS_LOGW) + off + 4);
}
template <int STOP = 0>
__device__ __forceinline__ void phase_a(RW_LAS unsigned char* L, unsigned char* ws, size_t rec_off, const float* kk_all, const float* ka_all, int wg, int G, int tid) {
    const int lane = tid & 63, w = __builtin_amdgcn_readfirstlane(tid >> 6), g = lane >> 4, l15 = lane & 15;
    ChunkIn cin; if (wg < 8192) load_chunk(cin, ws, wg, tid);
  for (int it = wg; it < 8192; it += G) {
    unsigned char* rec = ws + rec_off + (size_t)it * REC; const float* kkw_g = kk_all + ((it >> 8) & 15) * 64; const float* kaw_g = ka_all + ((it >> 8) & 15) * 64;
    { const int tok = tid >> 3, part = tid & 7, c0 = 8 * part;
      const u32x4 rw_ = cin.r, kw_ = cin.k, vw_ = cin.v, aw_ = cin.a; const f32x4 l0 = cin.l0, l1 = cin.l1;
      float lw[8] = {l0[0], l0[1], l0[2], l0[3], l1[0], l1[1], l1[2], l1[3]}, cum[8];
#pragma unroll
      for (int i = 0; i < 8; ++i) { float v = lw[i];
          float u = __shfl_up(v, 8); if (lane >= 8) v += u; u = __shfl_up(v, 16); if (lane >= 16) v += u; u = __shfl_up(v, 32); if (lane >= 32) v += u; cum[i] = v; }
      RW_LAS float* tot = (RW_LAS float*)(L + O_TOT);
      if (lane >= 56) {
#pragma unroll
          for (int i = 0; i < 8; ++i) tot[w * 64 + c0 + i] = cum[i]; }
      RW_SYNC();
#pragma unroll
      for (int ww = 0; ww < 7; ++ww) if (ww < w) { const f32x4 a0 = *(const RW_LAS f32x4*)(tot + ww * 64 + c0), a1 = *(const RW_LAS f32x4*)(tot + ww * 64 + c0 + 4);
#pragma unroll
          for (int i = 0; i < 4; ++i) { cum[i] += a0[i]; cum[4 + i] += a1[i]; } }
      float r[8] = {blo(rw_.x), bhi(rw_.x), blo(rw_.y), bhi(rw_.y), blo(rw_.z), bhi(rw_.z), blo(rw_.w), bhi(rw_.w)};
      float k[8] = {blo(kw_.x), bhi(kw_.x), blo(kw_.y), bhi(kw_.y), blo(kw_.z), bhi(kw_.z), blo(kw_.w), bhi(kw_.w)};
      float a[8] = {blo(aw_.x), bhi(aw_.x), blo(aw_.y), bhi(aw_.y), blo(aw_.z), bhi(aw_.z), blo(aw_.w), bhi(aw_.w)};
      const f32x4 kk0 = *(const f32x4*)(kkw_g + c0), kk1 = *(const f32x4*)(kkw_g + c0 + 4), ka0 = *(const f32x4*)(kaw_g + c0), ka1 = *(const f32x4*)(kaw_g + c0 + 4);
      float kk[8], ss = 0.f;
#pragma unroll
      for (int i = 0; i < 8; ++i) { kk[i] = k[i] * (i < 4 ? kk0[i] : kk1[i - 4]); ss += kk[i] * kk[i]; }
      ss += __shfl_xor(ss, 1); ss += __shfl_xor(ss, 2); ss += __shfl_xor(ss, 4);
      const float inv = 1.f / fmaxf(sqrtf(ss), 1e-12f);
      float Rt[8], Kt[8], At[8], Bt[8];
#pragma unroll
      for (int i = 0; i < 8; ++i) { const float eL = __expf(cum[i]), eLi = __expf(-cum[i]), eLx = __expf(cum[i] - lw[i]); const float kn = kk[i] * inv;
          Rt[i] = r[i] * eL; Kt[i] = k[i] * (1.f + (a[i] - 1.f) * (i < 4 ? ka0[i] : ka1[i - 4])) * eLi; At[i] = -kn * eLx; Bt[i] = kn * a[i] * eLi;
          if (tok == 63) ((RW_LAS float*)(L + O_GAM))[c0 + i] = eL; }
      u32x4 o;
      o.x = cvtpk(Rt[0], Rt[1]); o.y = cvtpk(Rt[2], Rt[3]); o.z = cvtpk(Rt[4], Rt[5]); o.w = cvtpk(Rt[6], Rt[7]); *(RW_LAS u32x4*)(L + O_R + tok * PB + c0 * 2) = o;
      o.x = cvtpk(Kt[0], Kt[1]); o.y = cvtpk(Kt[2], Kt[3]); o.z = cvtpk(Kt[4], Kt[5]); o.w = cvtpk(Kt[6], Kt[7]); *(RW_LAS u32x4*)(L + O_K + tok * PB + c0 * 2) = o;
      o.x = cvtpk(At[0], At[1]); o.y = cvtpk(At[2], At[3]); o.z = cvtpk(At[4], At[5]); o.w = cvtpk(At[6], At[7]); *(RW_LAS u32x4*)(L + O_A + tok * PB + c0 * 2) = o;
      o.x = cvtpk(Bt[0], Bt[1]); o.y = cvtpk(Bt[2], Bt[3]); o.z = cvtpk(Bt[4], Bt[5]); o.w = cvtpk(Bt[6], Bt[7]); *(RW_LAS u32x4*)(L + O_B + tok * PB + c0 * 2) = o;
      *(RW_LAS u32x4*)(L + O_GT + tok * PB + c0 * 2) = vw_;
    }
    if (it + G < 8192) load_chunk(cin, ws, it + G, tid);
    RW_SYNC();
    if (STOP == 1) continue;
    {
      const int ch = tid & 63, tg = tid >> 6;
#pragma unroll
      for (int mtx = 0; mtx < 3; ++mtx) { const RW_LAS unsigned char* src = L + (mtx == 0 ? O_B : mtx == 1 ? O_K : O_GT) + (8 * tg) * PB + ch * 2; unsigned v[8];
#pragma unroll
          for (int i = 0; i < 8; ++i) v[i] = *(const RW_LAS unsigned short*)(src + i * PB);
          u32x4 o; o.x = v[0] | (v[1] << 16); o.y = v[2] | (v[3] << 16); o.z = v[4] | (v[5] << 16); o.w = v[6] | (v[7] << 16);
          *(RW_LAS u32x4*)(L + (mtx == 0 ? O_BT : mtx == 1 ? O_KT : O_VT) + ch * PB + (8 * tg) * 2) = o; } }
    const int t4 = w & 3, p2 = (w >> 2) * 2;
    { const bf16x8 b0 = frag(L + O_B, t4, 0, lane), b1 = frag(L + O_B, t4, 1, lane), k0 = frag(L + O_K, t4, 0, lane), k1 = frag(L + O_K, t4, 1, lane);
#pragma unroll
      for (int u = 0; u < 2; ++u) { const int nt = p2 + u, t = 16 * nt + l15, s0 = 16 * t4 + 4 * g;
          f32x4 ab = {0.f, 0.f, 0.f, 0.f}, ak = ab, rb = ab, rk = ab;
          if (t4 <= nt) { const bf16x8 a0 = frag(L + O_A, nt, 0, lane), a1 = frag(L + O_A, nt, 1, lane), r0 = frag(L + O_R, nt, 0, lane), r1 = frag(L + O_R, nt, 1, lane);
              ab = RW_MFMA(b0, a0, ab); ab = RW_MFMA(b1, a1, ab); ak = RW_MFMA(k0, a0, ak); ak = RW_MFMA(k1, a1, ak);
              rb = RW_MFMA(b0, r0, rb); rb = RW_MFMA(b1, r1, rb); rk = RW_MFMA(k0, r0, rk); rk = RW_MFMA(k1, r1, rk);
#pragma unroll
              for (int r = 0; r < 4; ++r) { const int s = s0 + r; if (!(s < t)) { ab[r] = 0.f; ak[r] = 0.f; } if (!(s <= t)) { rb[r] = 0.f; rk[r] = 0.f; } } }
          *(RW_LAS f32x4*)(L + O_AAB + t * PF + s0 * 4) = ab;
          u32x2 o; o.x = cvtpk(ab[0], ab[1]); o.y = cvtpk(ab[2], ab[3]); *(RW_LAS u32x2*)(L + O_AABB + t * PB + s0 * 2) = o;
          o.x = cvtpk(ak[0], ak[1]); o.y = cvtpk(ak[2], ak[3]); *(RW_LAS u32x2*)(L + O_AAK + t * PB + s0 * 2) = o;
          o.x = cvtpk(rb[0], rb[1]); o.y = cvtpk(rb[2], rb[3]); *(RW_LAS u32x2*)(L + O_ARB + t * PB + s0 * 2) = o;
          o.x = cvtpk(rk[0], rk[1]); o.y = cvtpk(rk[2], rk[3]); *(RW_LAS u32x2*)(L + O_ARK + t * PB + s0 * 2) = o; } }
    RW_SYNC();
    if (STOP == 2) continue;
    { const bf16x8 a0 = frag(L + O_AAK, t4, 0, lane), a1 = frag(L + O_AAK, t4, 1, lane);
#pragma unroll
      for (int u = 0; u < 2; ++u) { const int nt = p2 + u; f32x4 acc = {0.f, 0.f, 0.f, 0.f};
          acc = RW_MFMA(a0, frag(L + O_VT, nt, 0, lane), acc); acc = RW_MFMA(a1, frag(L + O_VT, nt, 1, lane), acc);
          *(RW_LAS f32x4*)(L + O_GT + (16 * nt + l15) * PF + (16 * t4 + 4 * g) * 4) = acc; } }
    if (w < 4 && lane < 16) {
        float x[16]; const RW_LAS unsigned char* ab = L + O_AAB + 16 * w * PF + 16 * w * 4;
#pragma unroll
        for (int r = 0; r < 16; ++r) { float a0 = (r == lane) ? 1.f : 0.f, a1 = 0.f;
#pragma unroll
            for (int q4 = 0; q4 < (r + 3) / 4; ++q4) { const f32x4 av = *(const RW_LAS f32x4*)(ab + r * PF + q4 * 16);
                if (4 * q4 + 0 < r) a0 += av[0] * x[4 * q4 + 0]; if (4 * q4 + 1 < r) a1 += av[1] * x[4 * q4 + 1]; if (4 * q4 + 2 < r) a0 += av[2] * x[4 * q4 + 2]; if (4 * q4 + 3 < r) a1 += av[3] * x[4 * q4 + 3]; }
            x[r] = a0 + a1; *(RW_LAS unsigned short*)(L + O_TB + w * 768 + r * 48 + lane * 2) = (unsigned short)(cvtpk(x[r], 0.f) & 0xffffu); } }
    RW_SYNC();
    if (STOP == 3) continue;
#if RW_SOLVE_OLD
    if (tid < 128) { const int c = tid;
        const RW_LAS unsigned char* rhs = c < 64 ? (L + O_A + c * 2) : (L + O_GT + (c - 64) * PF);
        RW_LAS unsigned char* dst = c < 64 ? (L + O_WT + c * PB) : (L + O_UT + (c - 64) * PB);
        for (int b = 0; b < 4; ++b) { float z[16];
#pragma unroll
            for (int r = 0; r < 16; ++r) z[r] = c < 64 ? blo((unsigned)*(const RW_LAS unsigned short*)(rhs + (16 * b + r) * PB)) : *(const RW_LAS float*)(rhs + (16 * b + r) * 4);
            const RW_LAS unsigned char* arow = L + O_AAB + 16 * b * PF;
            for (int s4 = 0; s4 < 4 * b; ++s4) { const u32x2 xw = *(const RW_LAS u32x2*)(dst + s4 * 8); const float x0 = blo(xw.x), x1 = bhi(xw.x), x2 = blo(xw.y), x3 = bhi(xw.y);
#pragma unroll
                for (int r = 0; r < 16; ++r) { const f32x4 av = *(const RW_LAS f32x4*)(arow + r * PF + s4 * 16); z[r] += (av[0] * x0 + av[1] * x1) + (av[2] * x2 + av[3] * x3); } }
#pragma unroll
            for (int r = 1; r < 16; ++r) {
#pragma unroll
                for (int q4 = 0; q4 < (r + 3) / 4; ++q4) { const f32x4 av = *(const RW_LAS f32x4*)(arow + r * PF + (4 * b + q4) * 16);
                    if (4 * q4 + 0 < r) z[r] += av[0] * z[4 * q4 + 0]; if (4 * q4 + 1 < r) z[r] += av[1] * z[4 * q4 + 1]; if (4 * q4 + 2 < r) z[r] += av[2] * z[4 * q4 + 2]; if (4 * q4 + 3 < r) z[r] += av[3] * z[4 * q4 + 3]; } }
            u32x4 o; o.x = cvtpk(z[0], z[1]); o.y = cvtpk(z[2], z[3]); o.z = cvtpk(z[4], z[5]); o.w = cvtpk(z[6], z[7]); *(RW_LAS u32x4*)(dst + 32 * b) = o;
            o.x = cvtpk(z[8], z[9]); o.y = cvtpk(z[10], z[11]); o.z = cvtpk(z[12], z[13]); o.w = cvtpk(z[14], z[15]); *(RW_LAS u32x4*)(dst + 32 * b + 16) = o;
            asm volatile("s_waitcnt lgkmcnt(0)" ::: "memory"); } }
    RW_SYNC();
#else
    { RW_LAS unsigned char* xt = (w < 4 ? L + O_WT : L + O_UT) + (w & 3) * 16 * PB;
      { const u32x4 z4 = {0u, 0u, 0u, 0u}; *(RW_LAS u32x4*)(xt + l15 * PB + g * 16) = z4; *(RW_LAS u32x4*)(xt + l15 * PB + 64 + g * 16) = z4; }
      asm volatile("s_waitcnt lgkmcnt(0)" ::: "memory");
#pragma unroll
      for (int b = 0; b < 4; ++b) { f32x4 z;
          if (w < 4) { const RW_LAS unsigned char* ap = L + O_A + (16 * b + 4 * g) * PB + (16 * w + l15) * 2;
              z = (f32x4){blo((unsigned)*(const RW_LAS unsigned short*)(ap)), blo((unsigned)*(const RW_LAS unsigned short*)(ap + PB)), blo((unsigned)*(const RW_LAS unsigned short*)(ap + 2 * PB)), blo((unsigned)*(const RW_LAS unsigned short*)(ap + 3 * PB))}; }
          else z = *(const RW_LAS f32x4*)(L + O_GT + (16 * (w - 4) + l15) * PF + (16 * b + 4 * g) * 4);
          if (b > 0) { z = RW_MFMA(frag(L + O_AABB, b, 0, lane), *(const RW_LAS bf16x8*)(xt + l15 * PB + (8 * g) * 2), z);
                       if (b > 2) z = RW_MFMA(frag(L + O_AABB, b, 1, lane), *(const RW_LAS bf16x8*)(xt + l15 * PB + (32 + 8 * g) * 2), z); }
          const u32x2 tw = *(const RW_LAS u32x2*)(L + O_TB + b * 768 + l15 * 48 + (4 * g) * 2);
          const u32x4 tf = {tw.x, tw.y, 0u, 0u}, zf = {cvtpk(z[0], z[1]), cvtpk(z[2], z[3]), 0u, 0u};
          f32x4 xb = {0.f, 0.f, 0.f, 0.f}; xb = RW_MFMA(__builtin_bit_cast(bf16x8, tf), __builtin_bit_cast(bf16x8, zf), xb);
          u32x2 o; o.x = cvtpk(xb[0], xb[1]); o.y = cvtpk(xb[2], xb[3]); *(RW_LAS u32x2*)(xt + l15 * PB + (16 * b + 4 * g) * 2) = o;
          asm volatile("s_waitcnt lgkmcnt(0)" ::: "memory"); } }
    RW_SYNC();
#endif
    if (STOP == 4) continue;
    {
      const bf16x8 rb0 = frag(L + O_ARB, t4, 0, lane), rb1 = frag(L + O_ARB, t4, 1, lane), bt0 = frag(L + O_BT, t4, 0, lane), bt1 = frag(L + O_BT, t4, 1, lane);
      const int col = 16 * t4 + l15; const float gam = ((const RW_LAS float*)(L + O_GAM))[col];
      unsigned qw[4], pw[4];
#pragma unroll
      for (int u = 0; u < 2; ++u) { const int mt = p2 + u, j0 = 16 * mt + 4 * g; const bf16x8 w0 = frag(L + O_WT, mt, 0, lane), w1 = frag(L + O_WT, mt, 1, lane);
          f32x4 q = {0.f, 0.f, 0.f, 0.f}, p = q; q = RW_MFMA(w0, rb0, q); q = RW_MFMA(w1, rb1, q); p = RW_MFMA(w0, bt0, p); p = RW_MFMA(w1, bt1, p);
          const u32x2 rr = *(const RW_LAS u32x2*)(L + O_R + col * PB + j0 * 2);
          q[0] += blo(rr.x); q[1] += bhi(rr.x); q[2] += blo(rr.y); q[3] += bhi(rr.y);
#pragma unroll
          for (int r = 0; r < 4; ++r) p[r] = (p[r] + ((j0 + r) == col ? 1.f : 0.f)) * gam;
          qw[2 * u] = cvtpk(q[0], q[1]); qw[2 * u + 1] = cvtpk(q[2], q[3]); pw[2 * u] = cvtpk(p[0], p[1]); pw[2 * u + 1] = cvtpk(p[2], p[3]); }
      const int fo = ((t4 * 2 + (p2 >> 1)) * 64 + lane) * 16;
      *(u32x4*)(rec + REC_Q + fo) = (u32x4){qw[0], qw[1], qw[2], qw[3]}; *(u32x4*)(rec + REC_P + fo) = (u32x4){pw[0], pw[1], pw[2], pw[3]}; }
    {
      const bf16x8 rb0 = frag(L + O_ARB, t4, 0, lane), rb1 = frag(L + O_ARB, t4, 1, lane), rk0 = frag(L + O_ARK, t4, 0, lane), rk1 = frag(L + O_ARK, t4, 1, lane);
      const bf16x8 ut0 = frag(L + O_UT, t4, 0, lane), ut1 = frag(L + O_UT, t4, 1, lane), vt0 = frag(L + O_VT, t4, 0, lane), vt1 = frag(L + O_VT, t4, 1, lane);
      const int col = 16 * t4 + l15;
#pragma unroll
      for (int u = 0; u < 2; ++u) { const int mt = p2 + u, m0 = 16 * mt + 4 * g;
          f32x4 y = {0.f, 0.f, 0.f, 0.f}, hm = y;
          y = RW_MFMA(frag(L + O_UT, mt, 0, lane), rb0, y); y = RW_MFMA(frag(L + O_UT, mt, 1, lane), rb1, y); y = RW_MFMA(frag(L + O_VT, mt, 0, lane), rk0, y); y = RW_MFMA(frag(L + O_VT, mt, 1, lane), rk1, y);
          hm = RW_MFMA(frag(L + O_BT, mt, 0, lane), ut0, hm); hm = RW_MFMA(frag(L + O_BT, mt, 1, lane), ut1, hm); hm = RW_MFMA(frag(L + O_KT, mt, 0, lane), vt0, hm); hm = RW_MFMA(frag(L + O_KT, mt, 1, lane), vt1, hm);
          const f32x4 gm = *(const RW_LAS f32x4*)(L + O_GAM + m0 * 4);
          u32x2 o; o.x = cvtpk(y[0], y[1]); o.y = cvtpk(y[2], y[3]); *(u32x2*)(rec + REC_Y + (col * 64 + m0) * 2) = o;
          o.x = cvtpk(hm[0] * gm[0], hm[1] * gm[1]); o.y = cvtpk(hm[2] * gm[2], hm[3] * gm[3]); *(u32x2*)(rec + REC_H + (col * 64 + m0) * 2) = o; } }
    RW_SYNC();
  }
}

__device__ __forceinline__ void phase_b_head(RW_LAS unsigned char* L, const unsigned char* recs, unsigned short* Yg, int tid) {
    constexpr int NCH = 256, NSLOT = 4;
    const int lane = tid & 63, w = __builtin_amdgcn_readfirstlane(tid >> 6), g = lane >> 4, l15 = lane & 15;
    if (w >= 4) {
        const int lw = w - 4; const unsigned char* src = recs + lw * 8192 + lane * 16;
#define RW_ISSUE(c_) do { _Pragma("unroll") for (int k_ = 0; k_ < 8; ++k_) __builtin_amdgcn_global_load_lds((const unsigned*)(src + (size_t)(c_) * REC + k_ * 1024), (RW_LAS unsigned*)(L + ((c_) & 3) * REC + lw * 8192 + k_ * 1024), 16, 0, 0); } while (0)
        RW_ISSUE(0); RW_ISSUE(1); RW_ISSUE(2);
        asm volatile("s_waitcnt vmcnt(16)" ::: "memory");
        RW_BAR();
        for (int c = 0; c < NCH; ++c) {
            if (c + 3 < NCH) { RW_ISSUE(c + 3); asm volatile("s_waitcnt vmcnt(16)" ::: "memory"); }
            else asm volatile("s_waitcnt vmcnt(0)" ::: "memory");
            RW_BAR();
        }
#undef RW_ISSUE
    } else {
        f32x4 sacc[4];
#pragma unroll
        for (int m = 0; m < 4; ++m) sacc[m] = (f32x4){0.f, 0.f, 0.f, 0.f};
        RW_BAR();
        for (int c = 0; c < NCH; ++c) { const RW_LAS unsigned char* sl = L + (c & 3) * REC;
            bf16x8 bf[2];
#pragma unroll
            for (int s = 0; s < 2; ++s) { u32x4 v; v.x = cvtpk(sacc[2 * s][0], sacc[2 * s][1]); v.y = cvtpk(sacc[2 * s][2], sacc[2 * s][3]); v.z = cvtpk(sacc[2 * s + 1][0], sacc[2 * s + 1][1]); v.w = cvtpk(sacc[2 * s + 1][2], sacc[2 * s + 1][3]); bf[s] = __builtin_bit_cast(bf16x8, v); }
            f32x4 sn[4];
#pragma unroll
            for (int m = 0; m < 4; ++m) { const u32x2 hw = *(const RW_LAS u32x2*)(sl + REC_H + ((16 * w + l15) * 64 + 16 * m + 4 * g) * 2);
                f32x4 acc = {blo(hw.x), bhi(hw.x), blo(hw.y), bhi(hw.y)};
                acc = RW_MFMA(*(const RW_LAS bf16x8*)(sl + REC_P + ((m * 2 + 0) * 64 + lane) * 16), bf[0], acc);
                acc = RW_MFMA(*(const RW_LAS bf16x8*)(sl + REC_P + ((m * 2 + 1) * 64 + lane) * 16), bf[1], acc); sn[m] = acc; }
#pragma unroll
            for (int n = 0; n < 4; ++n) { const u32x2 yw = *(const RW_LAS u32x2*)(sl + REC_Y + ((16 * n + l15) * 64 + 16 * w + 4 * g) * 2);
                f32x4 acc = {blo(yw.x), bhi(yw.x), blo(yw.y), bhi(yw.y)};
                acc = RW_MFMA(bf[0], *(const RW_LAS bf16x8*)(sl + REC_Q + ((n * 2 + 0) * 64 + lane) * 16), acc);
                acc = RW_MFMA(bf[1], *(const RW_LAS bf16x8*)(sl + REC_Q + ((n * 2 + 1) * 64 + lane) * 16), acc);
                u32x2 yo; yo.x = cvtpk(acc[0], acc[1]); yo.y = cvtpk(acc[2], acc[3]); *(u32x2*)(Yg + (size_t)(c * 64 + 16 * n + l15) * 1024 + 16 * w + 4 * g) = yo; }
#pragma unroll
            for (int m = 0; m < 4; ++m) sacc[m] = sn[m];
            asm volatile("s_waitcnt lgkmcnt(0)" ::: "memory");
            RW_BAR();
        }
    }
}
}
#define XB_TMO      128
#define XB_XCNT(j)  (256  + 64 * (j))
#define XB_XSUB(j)  (1280 + 64 * (j))
#define XB_XGEN(j)  (2304 + 64 * (j))
#define XB_TOP      3328
#define XB_TOPGEN   3392
#define XCD_BAR_WORDS 3456
#define XB_SPIN_CAP (1u << 18)

__device__ __forceinline__ unsigned xb_ld(unsigned* p)              { return __hip_atomic_load(p, __ATOMIC_RELAXED, __HIP_MEMORY_SCOPE_AGENT); }
__device__ __forceinline__ unsigned xb_add(unsigned* p, unsigned v) { return __hip_atomic_fetch_add(p, v, __ATOMIC_RELAXED, __HIP_MEMORY_SCOPE_AGENT); }
__device__ __forceinline__ unsigned xb_xcc_id() { return (unsigned)__builtin_amdgcn_s_getreg((3 << 11) | 20) & 0xFu; }
#define XB_SPIN(cond, bar) do { unsigned _sp = 0; while (cond) { __builtin_amdgcn_s_sleep(1); \
    if ((++_sp & 255u) == 0u) { if (xb_ld(&(bar)[XB_TMO])) break; if (_sp > XB_SPIN_CAP) { atomicAdd(&(bar)[XB_TMO], 1u); break; } } } } while (0)

struct XcdBarrier {
    unsigned* bar; unsigned x;
    volatile LAS unsigned* st;
};

__device__ __forceinline__ XcdBarrier xcd_barrier_post(unsigned* bar, volatile LAS unsigned* st, const int tid) {
    XcdBarrier b; b.bar = bar; b.x = xb_xcc_id(); b.st = st;
    if (tid == 0) (void)xb_add(&bar[XB_XCNT(b.x)], 1u);
    return b;
}
__device__ __forceinline__ void xcd_barrier_complete(unsigned* bar, unsigned x, unsigned& nloc, unsigned& nx) {
    const unsigned G = gridDim.x * gridDim.y * gridDim.z;
    unsigned sum, cnt, mine, sp = 0u;
    for (;;) {
        sum = 0u; cnt = 0u; mine = 0u;
#pragma unroll
        for (unsigned j = 0; j < 16; ++j) { const unsigned c = xb_ld(&bar[XB_XCNT(j)]); sum += c; cnt += (c > 0u) ? 1u : 0u; mine = (j == x) ? c : mine; }
        if (sum == G) break;
        __builtin_amdgcn_s_sleep(1);
        if ((++sp & 255u) == 0u) { if (xb_ld(&bar[XB_TMO])) break; if (sp > XB_SPIN_CAP) { atomicAdd(&bar[XB_TMO], 1u); break; } }
    }
    nloc = mine > 0u ? mine : 1u; nx = cnt > 0u ? cnt : 1u;
}

__device__ __forceinline__ void xcd_barrier(const XcdBarrier& b, const int tid) {
    asm volatile("s_waitcnt vmcnt(0)" ::: "memory");
    __syncthreads();
    if (tid == 0) {
        unsigned* bar = b.bar;
        __builtin_amdgcn_s_waitcnt(0);
        unsigned nloc = b.st[0], nx = b.st[1];
        if (nloc == 0u) { xcd_barrier_complete(bar, b.x, nloc, nx); b.st[0] = nloc; b.st[1] = nx; }
        const unsigned old = xb_add(&bar[XB_XSUB(b.x)], 1u);
        const unsigned gen = old / nloc;
        if (old + 1u == (gen + 1u) * nloc) {
            __builtin_amdgcn_fence(__ATOMIC_RELEASE, "agent");
            asm volatile("s_waitcnt vmcnt(0)" ::: "memory");
            const unsigned og = xb_add(&bar[XB_TOP], 1u);
            const unsigned tg = og / nx;
            if (og + 1u == (tg + 1u) * nx) xb_add(&bar[XB_TOPGEN], 1u);
            else XB_SPIN(xb_ld(&bar[XB_TOPGEN]) == tg, bar);
            __builtin_amdgcn_fence(__ATOMIC_ACQUIRE, "agent");
            xb_add(&bar[XB_XGEN(b.x)], 1u);
            asm volatile("s_waitcnt vmcnt(0)" ::: "memory");
        } else {
            XB_SPIN(xb_ld(&bar[XB_XGEN(b.x)]) == gen, bar);
            __builtin_amdgcn_fence(__ATOMIC_ACQUIRE, "agent");
            asm volatile("s_waitcnt vmcnt(0)" ::: "memory");
        }
    }
    __syncthreads();
}
enum InIdx { I_X = 0, I_C, I_WADA, I_BADA, I_N1G, I_WIN, I_MU, I_WDEC, I_W0, I_WICLR, I_A0, I_WGATE, I_KK, I_KA, I_RK, I_GNG, I_GNB, I_WOA, I_BF, I_QN, I_KN, I_WOB, I_WOUT, I_N2G, I_WR, I_BR, I_WGU, I_BGU, I_WDN, I_BDN, I_NFG, N_IN };
struct Args { const float* in[N_IN]; float* out; unsigned char* ws; int ph_lo, ph_hi; };
static_assert(sizeof(Args) == (N_IN + 2) * 8 + 8, "Args has no padding");
typedef const __attribute__((address_space(4))) Args* ArgsP;
struct Frame {
    LAS unsigned char* lds;
    volatile LAS unsigned* MISC;
    gu32* ctl;
    int tid, lane, wave, G, wg;
    unsigned char* ws;
    ArgsP ap;
};
#define WSP(T_, off) ((T_*)(F.ws + (off)))

__device__ __forceinline__ int win_orig_col(int c) {
    if (c < PC_GLO) return c;
    if (c < PC_DLO) return 3264 + (c - PC_GLO);
    if (c < PC_ALO) return 3072 + (c - PC_DLO);
    if (c < PC_F) return 3168 + (c - PC_ALO);
    if (c < PC_FEND) return 6592 + (c - PC_F);
    if (c < PC_SPLIT) return -1;
    if (c < PC_FQ) return 7624 + (c - PC_GA);
    if (c < PC_OG) return 3520 + (c - PC_FQ);
    if (c < PC_GB) return 6600 + (c - PC_OG);
    return 9672 + (c - PC_GB);
}
__device__ __forceinline__ void tr_item(const float* W, int ldw, int K, bf16* WT, int drow0, int scol0, int nvalid, int k0, LAS float* scr, int lane) {
    const int n = lane & 31;
#pragma unroll 8
    for (int i = 0; i < 32; ++i) { const int kk = 2 * i + (lane >> 5); scr[kk * 33 + n] = (n < nvalid) ? W[(size_t)(k0 + kk) * ldw + scol0 + n] : 0.f; }
    LDS_WAIT(); asm volatile("" ::: "memory");
    const int c = lane & 7;
#pragma unroll
    for (int j = 0; j < 4; ++j) { const int nn = (lane >> 3) + 8 * j; const LAS float* s = scr + (8 * c) * 33 + nn;
        v4u o; o.x = pk2(s[0 * 33], s[1 * 33]); o.y = pk2(s[2 * 33], s[3 * 33]); o.z = pk2(s[4 * 33], s[5 * 33]); o.w = pk2(s[6 * 33], s[7 * 33]);
        *(GAS v4u*)(WT + (size_t)(drow0 + nn) * K + k0 + 8 * c) = o; }
    LDS_WAIT(); asm volatile("" ::: "memory");
}
__device__ __forceinline__ unsigned pk4_fp8(float a, float b, float c, float d) { int w = __builtin_amdgcn_cvt_pk_fp8_f32(a, b, 0, false); w = __builtin_amdgcn_cvt_pk_fp8_f32(c, d, w, true); return (unsigned)w; }
__device__ __forceinline__ void tr_item8(const float* W, int ldw, int K, unsigned char* WT, int drow0, int scol0, int nvalid, int k0, float scale, LAS float* scr, int lane) {
    const int n = lane & 31;
#pragma unroll 8
    for (int i = 0; i < 32; ++i) { const int kk = 2 * i + (lane >> 5); scr[kk * 33 + n] = (n < nvalid) ? W[(size_t)(k0 + kk) * ldw + scol0 + n] * scale : 0.f; }
    LDS_WAIT(); asm volatile("" ::: "memory");
    const int c = lane & 7;
#pragma unroll
    for (int j = 0; j < 4; ++j) { const int nn = (lane >> 3) + 8 * j; const LAS float* s = scr + (8 * c) * 33 + nn;
        v2u o; o.x = pk4_fp8(s[0 * 33], s[1 * 33], s[2 * 33], s[3 * 33]); o.y = pk4_fp8(s[4 * 33], s[5 * 33], s[6 * 33], s[7 * 33]);
        *(GAS v2u*)(WT + (size_t)(drow0 + nn) * K + k0 + 8 * c) = o; }
    LDS_WAIT(); asm volatile("" ::: "memory");
}
struct ConvItem { const float* src; unsigned char* dst; int ldw, dn; };
__device__ __forceinline__ ConvItem conv_item(Frame& F, int it) {
    constexpr int I_GU = NE * 32 * 128; ConvItem c;
    if (it < I_GU) { const int e = it / (32 * 128), q = it % (32 * 128), kb = q / 128, gp = q % 128, d0 = gp * 32, pn = d0 >> 8, j = d0 & 255, sc = j < 128 ? 128 * pn + j : 2048 + 128 * pn + (j - 128);
        c.src = F.ap->in[I_WGU] + (size_t)e * 2048 * 4096 + (size_t)(kb * 64) * 4096 + sc; c.dst = WSP(unsigned char, WS_WGU) + (size_t)e * 4096 * 2048 + (size_t)d0 * 2048 + kb * 64; c.ldw = 4096; c.dn = 0; }
    else { const int r = it - I_GU, e = r / (32 * 64), q = r % (32 * 64), kb = q / 64, gp = q % 64;
        const int d0 = gp * 32, trow = (d0 & ~255) + 32 * ((d0 >> 6) & 3) + 16 * ((d0 >> 5) & 1);
        c.src = F.ap->in[I_WDN] + (size_t)e * 2048 * 2048 + (size_t)(kb * 64) * 2048 + d0; c.dst = WSP(unsigned char, WS_WDN) + (size_t)e * 2048 * 2048 + (size_t)trow * 2048 + kb * 64; c.ldw = 2048; c.dn = 1; }
    return c;
}
__device__ __forceinline__ void convert_experts(Frame& F, int rank, int nranks) {
    constexpr int NIT = NE * 32 * 128 + NE * 32 * 64;
    LAS float* scr = (LAS float*)(F.lds + RING_OFF + F.wave * 16384);
    const int lane = F.lane, gw = rank * NWAVES + F.wave, NGW = nranks * NWAVES, c4 = lane & 7, r8 = lane >> 3;
    f32x4 cur[8], n1[8], n2[8]; ConvItem ci, c1, c2;
#define CONV_LOAD(dst, cc, it_) do { cc = conv_item(F, it_); _Pragma("unroll") for (int j = 0; j < 8; ++j) dst[j] = __builtin_nontemporal_load((const f32x4*)(cc.src + (size_t)(r8 + 8 * j) * cc.ldw + 4 * c4)); } while (0)
    if (gw < NIT) CONV_LOAD(cur, ci, gw);
    if (gw + NGW < NIT) CONV_LOAD(n1, c1, gw + NGW);
    for (int it = gw; it < NIT; it += NGW) {
        if (it + 2 * NGW < NIT) CONV_LOAD(n2, c2, it + 2 * NGW);
#pragma unroll
        for (int j = 0; j < 8; ++j) { LAS float* s = scr + (r8 + 8 * j) * 33 + 4 * c4; s[0] = cur[j].x * FP8_SW; s[1] = cur[j].y * FP8_SW; s[2] = cur[j].z * FP8_SW; s[3] = cur[j].w * FP8_SW; }
        LDS_WAIT(); asm volatile("" ::: "memory");
#pragma unroll
        for (int j = 0; j < 4; ++j) { const int nn = r8 + 8 * j; const LAS float* s = scr + (8 * c4) * 33 + nn;
            v2u o; o.x = pk4_fp8(s[0 * 33], s[1 * 33], s[2 * 33], s[3 * 33]); o.y = pk4_fp8(s[4 * 33], s[5 * 33], s[6 * 33], s[7 * 33]);
            const int drow = ci.dn ? 128 * (j & 1) + 8 * (j >> 1) + r8 : nn;
            __builtin_nontemporal_store(o, (v2u*)(ci.dst + (size_t)drow * 2048 + 8 * c4)); }
        LDS_WAIT(); asm volatile("" ::: "memory");
        ci = c1; c1 = c2;
#pragma unroll
        for (int j = 0; j < 8; ++j) { cur[j] = n1[j]; n1[j] = n2[j]; }
    }
#undef CONV_LOAD
}
__device__ __forceinline__ void p0_prologue(Frame& F) {
    LAS float* scr = (LAS float*)(F.lds + RING_OFF + F.wave * 16384);
    const int gw = F.wg * NWAVES + F.wave, NGW = F.G * NWAVES, lane = F.lane;
    constexpr int I_IN = 32 * 368, I_OA = 16 * 64, I_OB = I_OA, I_OUT = 32 * 64;
    constexpr int NITEMS = I_IN + I_OA + I_OB + I_OUT;
    for (int it = gw; it < NITEMS; it += NGW) {
        int r = it;
        if (r < I_IN) { const int kb = r / 368, gp = r % 368, c0 = gp * 32, oc = win_orig_col(c0); const int nv = oc < 0 ? 0 : (c0 == PC_F ? PC_FEND - PC_F : 32);
            const bool as8 = INPROJ_FP8 == 1 || (INPROJ_FP8 == 2 && c0 >= PC_SPLIT);
            if (as8) tr_item8(F.ap->in[I_WIN], 11720, 2048, WSP(unsigned char, WS_WIN8), c0, oc < 0 ? 0 : oc, nv, kb * 64, FP8_SW, scr, lane);
            else tr_item(F.ap->in[I_WIN], 11720, 2048, WSP(bf16, WS_WIN), c0, oc < 0 ? 0 : oc, nv, kb * 64, scr, lane);
            continue; } r -= I_IN;
        if (r < I_OA) { tr_item(F.ap->in[I_WOA], 2048, 1024, WSP(bf16, WS_WOA), (r % 64) * 32, (r % 64) * 32, 32, (r / 64) * 64, scr, lane); continue; } r -= I_OA;
        if (r < I_OB) { tr_item(F.ap->in[I_WOB], 2048, 1024, WSP(bf16, WS_WOB), (r % 64) * 32, (r % 64) * 32, 32, (r / 64) * 64, scr, lane); continue; } r -= I_OB;
#if OUTPROJ_FP8
        { tr_item8(F.ap->in[I_WOUT], 2048, 2048, WSP(unsigned char, WS_WOUT), (r % 64) * 32, (r % 64) * 32, 32, (r / 64) * 64, FP8_SW, scr, lane); }
#else
        { tr_item(F.ap->in[I_WOUT], 2048, 2048, WSP(bf16, WS_WOUT), (r % 64) * 32, (r % 64) * 32, 32, (r / 64) * 64, scr, lane); }
#endif
    }
    const int gt = F.wg * (NWAVES * 64) + F.tid, NGT = F.G * NWAVES * 64;
    { bf16* b1 = WSP(bf16, WS_BT1); const float* wd = F.ap->in[I_WDEC]; const float* wi = F.ap->in[I_WICLR];
      for (int i = gt; i < 2048 * 256; i += NGT) { const int n = i >> 8, k = i & 255; float v = 0.f;
          if (n < 1024) { if (k < 96) v = wd[k * 1024 + n]; } else { if (k >= 128 && k < 224) v = wi[(k - 128) * 1024 + (n - 1024)]; }
          b1[i] = (bf16)f2bf(v); } }
    { bf16* b2 = WSP(bf16, WS_BT2); const float* wg = F.ap->in[I_WGATE];
      for (int i = gt; i < 1024 * 256; i += NGT) { const int n = i >> 8, k = i & 255; b2[i] = (bf16)f2bf(wg[k * 1024 + n]); } }
    { float* wrt = WSP(float, WS_WRT); const float* wr = F.ap->in[I_WR];
      for (int i = gt; i < 32 * 2048; i += NGT) { const int e = i >> 11, k = i & 2047; wrt[i] = wr[k * 32 + e]; } }
    { bf16* h = WSP(bf16, WS_H) + (size_t)T * DM; for (int i = gt; i < DM; i += NGT) h[i] = 0; }
    if (F.wg < 192) {
        const float* wa = F.ap->in[I_WADA]; const float* cc = F.ap->in[I_C]; const int n = F.wg * 64 + lane;
        LAS float* sl = (LAS float*)(F.lds + RING_OFF + 131072 - 4096 - 16384);
        __syncthreads();
#pragma unroll
        for (int j = 0; j < 8; ++j) { const int i = F.tid + 512 * j; const float c = cc[i]; sl[i] = c * sigmoidf_(c); }
        __syncthreads();
        float s0 = 0.f, s1 = 0.f; const float* wp = wa + (size_t)(F.wave * 256) * 12288 + n; const LAS float* s0p = sl + F.wave * 256; const LAS float* s1p = sl + 2048 + F.wave * 256;
        for (int k = 0; k < 256; k += 16) { float w[16];
#pragma unroll
            for (int u = 0; u < 16; ++u) w[u] = wp[(size_t)(k + u) * 12288];
#pragma unroll
            for (int u = 0; u < 16; u += 4) { const f32x4 a = *(const LAS f32x4*)(s0p + k + u), c = *(const LAS f32x4*)(s1p + k + u);
                s0 += (a[0] * w[u] + a[1] * w[u + 1]) + (a[2] * w[u + 2] + a[3] * w[u + 3]); s1 += (c[0] * w[u] + c[1] * w[u + 1]) + (c[2] * w[u + 2] + c[3] * w[u + 3]); } }
        LAS float* red = (LAS float*)(F.lds + RING_OFF + 131072 - 4096);
        __syncthreads();
        red[(F.wave * 2 + 0) * 64 + lane] = s0; red[(F.wave * 2 + 1) * 64 + lane] = s1;
        __syncthreads();
        if (F.wave < 2) { float s = 0.f;
#pragma unroll
            for (int w = 0; w < 8; ++w) s += red[(w * 2 + F.wave) * 64 + lane];
            WSP(float, WS_MOD)[F.wave * 12288 + n] = s + F.ap->in[I_BADA][n]; }
    }
}
template <int OUT8> __device__ __forceinline__ void norm_mod_rows(Frame& F, const float* x, const float* g, int shift_off, int scale_off, bf16* H, unsigned char* H8) {
    const int gw = F.wg * NWAVES + F.wave, NGW = F.G * NWAVES, lane = F.lane; const float* mod = WSP(float, WS_MOD);
    for (int m = gw; m < T; m += NGW) {
        const f32x4* xr = (const f32x4*)(x + (size_t)m * DM) + lane; f32x4 v[8]; float ss = 0.f;
#pragma unroll
        for (int j = 0; j < 8; ++j) { v[j] = xr[64 * j]; ss += (v[j].x * v[j].x + v[j].y * v[j].y) + (v[j].z * v[j].z + v[j].w * v[j].w); }
        const float rs = rsqrtf(wave_sum(ss) * (1.f / DM) + NORM_EPS); const float* mb = mod + (size_t)(m / SEQ) * 12288;
#pragma unroll
        for (int j = 0; j < 8; ++j) { const int c = 4 * lane + 256 * j; const f32x4 gg = *(const f32x4*)(g + c), sc = *(const f32x4*)(mb + scale_off + c), sh = *(const f32x4*)(mb + shift_off + c);
            const f32x4 y = v[j] * rs * gg * (sc + 1.f) + sh;
            if constexpr (OUT8 != 0) *(unsigned*)(H8 + (size_t)m * DM + c) = pk4_fp8(y.x * FP8_SA1, y.y * FP8_SA1, y.z * FP8_SA1, y.w * FP8_SA1);
            if constexpr (OUT8 != 1) { v2u o; o.x = pk2(y.x, y.y); o.y = pk2(y.z, y.w); *(v2u*)(H + (size_t)m * DM + c) = o; } }
    }
}
struct PrepTok { v4u rkv[6]; v4u lo; v4u fq[2], fk[2]; unsigned fp; };
__device__ __forceinline__ void prep_load(PrepTok& k, const bf16* pc, int lane, int cl) {
#pragma unroll
    for (int s = 0; s < 6; ++s) k.rkv[s] = *(const v4u*)(pc + PC_R + (s * 64 + lane) * 8);
    k.lo = *(const v4u*)(pc + cl);
#pragma unroll
    for (int s = 0; s < 2; ++s) { k.fq[s] = *(const v4u*)(pc + PC_FQ + (s * 64 + lane) * 8); k.fk[s] = *(const v4u*)(pc + PC_FK + (s * 64 + lane) * 8); }
    k.fp = (unsigned)pc[PC_F + (lane & 7)];
}
__device__ __forceinline__ void p3_prep(Frame& F) {
    const int gw = F.wg * NWAVES + F.wave, lane = F.lane, t0 = gw * 16;
    const bf16* P = WSP(bf16, WS_P); const float* mu = F.ap->in[I_MU];
    bf16* Rb = WSP(bf16, WS_R); bf16* LW = WSP(bf16, WS_LW); bf16* SG = WSP(bf16, WS_SG);
    int cl, mi; if (lane < 32) { cl = PC_GLO + 8 * lane; mi = 3264 + 8 * lane; } else if (lane < 44) { cl = PC_DLO + 8 * (lane - 32); mi = 3072 + 8 * (lane - 32); } else if (lane < 56) { cl = PC_ALO + 8 * (lane - 44); mi = 3168 + 8 * (lane - 44); } else { cl = PC_ALO; mi = 3168; }
    f32x4 m0[6], m1[6];
#pragma unroll
    for (int s = 0; s < 6; ++s) { const int c = (s * 64 + lane) * 8; m0[s] = *(const f32x4*)(mu + c); m1[s] = *(const f32x4*)(mu + c + 4); }
    const f32x4 ml0 = *(const f32x4*)(mu + mi), ml1 = *(const f32x4*)(mu + mi + 4);
    f32x4 gq[2][2], gk[2][2];
#pragma unroll
    for (int s = 0; s < 2; ++s) { const int d0 = ((s * 64 + lane) & 15) * 8; gq[s][0] = *(const f32x4*)(F.ap->in[I_QN] + d0); gq[s][1] = *(const f32x4*)(F.ap->in[I_QN] + d0 + 4); gk[s][0] = *(const f32x4*)(F.ap->in[I_KN] + d0); gk[s][1] = *(const f32x4*)(F.ap->in[I_KN] + d0 + 4); }
    const float bfl = F.ap->in[I_BF][lane & 7];
    v4u prv[6], prvl; const v4u zz = {0u, 0u, 0u, 0u};
    if ((t0 % SEQ) == 0) {
#pragma unroll
        for (int s = 0; s < 6; ++s) prv[s] = zz; prvl = zz; }
    else { const bf16* pp = P + (size_t)(t0 - 1) * NP;
#pragma unroll
        for (int s = 0; s < 6; ++s) prv[s] = *(const v4u*)(pp + PC_R + (s * 64 + lane) * 8); prvl = *(const v4u*)(pp + cl); }
    PrepTok cur, nxt; prep_load(cur, P + (size_t)t0 * NP, lane, cl);
    for (int i = 0; i < 16; ++i) { const int t = t0 + i;
        if (i + 1 < 16) prep_load(nxt, P + (size_t)(t + 1) * NP, lane, cl);
#pragma unroll
        for (int s = 0; s < 6; ++s) { const int c = (s * 64 + lane) * 8; float a[8], b[8], o[8]; unpack8(cur.rkv[s], a); unpack8(prv[s], b);
#pragma unroll
            for (int j = 0; j < 8; ++j) { const float mm = j < 4 ? m0[s][j] : m1[s][j - 4]; o[j] = a[j] + mm * (b[j] - a[j]); }
            *(v4u*)(Rb + (size_t)(c >> 10) * ((WS_K - WS_R) / 2) + (size_t)t * RW + (c & 1023)) = pack8f(o); prv[s] = cur.rkv[s]; }
        { float o[8] = {0.f, 0.f, 0.f, 0.f, 0.f, 0.f, 0.f, 0.f};
          if (lane < 56) { float a[8], b[8]; unpack8(cur.lo, a); unpack8(prvl, b);
#pragma unroll
              for (int j = 0; j < 8; ++j) { const float mm = j < 4 ? ml0[j] : ml1[j - 4]; const float v = a[j] + mm * (b[j] - a[j]); o[j] = lane < 32 ? sigmoidf_(v) : (lane < 44 ? tanhf(v) : v); } }
          prvl = cur.lo;
          bf16* dst; if (lane < 32) dst = SG + (size_t)t * 256 + 8 * lane; else if (lane < 44) dst = LW + (size_t)t * 256 + 8 * (lane - 32); else if (lane < 56) dst = LW + (size_t)t * 256 + 128 + 8 * (lane - 44);
          else if (lane < 60) dst = LW + (size_t)t * 256 + 96 + 8 * (lane - 56); else dst = LW + (size_t)t * 256 + 224 + 8 * (lane - 60);
          *(v4u*)dst = pack8f(o); }
#pragma unroll
        for (int s = 0; s < 2; ++s) { const int ch = s * 64 + lane;
#pragma unroll
            for (int qk = 0; qk < 2; ++qk) { float a[8]; unpack8(qk ? cur.fk[s] : cur.fq[s], a); float ss = 0.f;
#pragma unroll
                for (int j = 0; j < 8; ++j) ss += a[j] * a[j];
                ss += __shfl_xor(ss, 1); ss += __shfl_xor(ss, 2); ss += __shfl_xor(ss, 4); ss += __shfl_xor(ss, 8);
                const float rs = rsqrtf(ss * (1.f / 128.f) + NORM_EPS); const f32x4 g0 = qk ? gk[s][0] : gq[s][0], g1 = qk ? gk[s][1] : gq[s][1];
#pragma unroll
                for (int j = 0; j < 8; ++j) a[j] = a[j] * rs * (j < 4 ? g0[j] : g1[j - 4]);
                *(v4u*)(WSP(bf16, qk ? WS_FK : WS_FQ) + (size_t)t * FW + ch * 8) = pack8f(a); } }
        if (lane < 8) { const float xv = bflo(cur.fp) + bfl;
            WSP(float, WS_LF)[(size_t)t * 8 + lane] = fminf(xv, 0.f) - log1pf(__expf(-fabsf(xv))); }
        cur = nxt;
    }
}
__device__ __forceinline__ void p4_cumsum(Frame& F) {
    if (F.wg >= 16) return;
    const int b = F.wg >> 3, h = F.wg & 7; const float* lf = WSP(float, WS_LF) + (size_t)b * SEQ * 8 + h; float* cs = WSP(float, WS_CS) + (size_t)F.wg * SEQ;
    LAS float* part = (LAS float*)(F.lds + RING_OFF); LAS float* tend = part + 512; LAS float* tstart = part + 768;
    const int t0 = F.tid * 32; float s = 0.f;
    for (int i = 0; i < 32; ++i) s += lf[(size_t)(t0 + i) * 8];
    part[F.tid] = s; __syncthreads();
    if (F.tid == 0) { float run = 0.f; for (int i = 0; i < 512; ++i) { const float v = part[i]; part[i] = run; run += v; } }
    __syncthreads();
    float run = part[F.tid];
    for (int i = 0; i < 32; ++i) { run += lf[(size_t)(t0 + i) * 8]; const float c = -run * 11.313708498984761f; cs[t0 + i] = c;
        if (i == 0 && (F.tid & 7) == 0) tstart[F.tid >> 3] = c; if (i == 31 && (F.tid & 1)) tend[F.tid >> 1] = c; }
    __syncthreads();
    if (F.tid < 64) { const float* qn = F.ap->in[I_QN]; const float* kn = F.ap->in[I_KN]; float mq = fmaxf(fabsf(qn[F.tid]), fabsf(qn[F.tid + 64])), mk = fmaxf(fabsf(kn[F.tid]), fabsf(kn[F.tid + 64]));
#pragma unroll
        for (int o = 1; o < 64; o <<= 1) { mq = fmaxf(mq, __shfl_xor(mq, o)); mk = fmaxf(mk, __shfl_xor(mk, o)); }
        const float horizon = 2.f * 1.01f * 11.313708498984761f * mq * mk + 9.704060527839234f + FOX_SKIP_BITS * 0.6931471805599453f;
        const int qb = F.tid; const float target = tstart[qb] - horizon * 11.313708498984761f; int lo = 0, hi = 4 * qb;
        while (lo < hi) { const int mid = (lo + hi) >> 1; if (tend[mid] >= target) hi = mid; else lo = mid + 1; }
        WSP(int, WS_JLO)[F.wg * 64 + qb] = lo; }
    __syncthreads();
}
__device__ __forceinline__ void p5_scan_naive(Frame& F) {
    constexpr int CH = 64;
    LAS float* Wl = (LAS float*)(F.lds + RING_OFF); LAS float* Al = Wl + CH * 64; LAS float* Bl = Al + CH * 64; LAS float* Kl = Bl + CH * 64; LAS float* Rl = Kl + CH * 64; LAS float* Vl = Rl + CH * 64; LAS float* Yl = Vl + CH * 64;
    const int tid = F.tid, row = tid >> 3, q = tid & 7;
    for (int bh = F.wg; bh < 32; bh += F.G) {
        const int b = bh >> 4, h = bh & 15; const size_t base = (size_t)b * SEQ * RW + h * 64;
        const bf16* Rg = WSP(bf16, WS_R) + base; const bf16* Kg = WSP(bf16, WS_K) + base; const bf16* Vg = WSP(bf16, WS_V) + base; const bf16* Ag = WSP(bf16, WS_A) + base;
        const float* Lg = WSP(float, WS_LOGW) + base; float* Yg = WSP(float, WS_YRAW) + base;
        float kkw[8], kaw[8];
#pragma unroll
        for (int i = 0; i < 8; ++i) { kkw[i] = F.ap->in[I_KK][h * 64 + 8 * q + i]; kaw[i] = F.ap->in[I_KA][h * 64 + 8 * q + i]; }
        float S[8] = {0.f, 0.f, 0.f, 0.f, 0.f, 0.f, 0.f, 0.f};
        for (int t0 = 0; t0 < SEQ; t0 += CH) {
            { const size_t off = (size_t)(t0 + row) * RW + 8 * q; float r[8], k[8], v[8], a[8];
              unpack8(*(const v4u*)(Rg + off), r); unpack8(*(const v4u*)(Kg + off), k); unpack8(*(const v4u*)(Vg + off), v); unpack8(*(const v4u*)(Ag + off), a);
              const f32x4 l0 = *(const f32x4*)(Lg + off), l1 = *(const f32x4*)(Lg + off + 4);
              float kk[8], ss = 0.f;
#pragma unroll
              for (int i = 0; i < 8; ++i) { kk[i] = k[i] * kkw[i]; ss += kk[i] * kk[i]; }
              ss += __shfl_xor(ss, 1); ss += __shfl_xor(ss, 2); ss += __shfl_xor(ss, 4);
              const float inv = 1.f / fmaxf(sqrtf(ss), 1e-12f);
#pragma unroll
              for (int i = 0; i < 8; ++i) { const int o = row * 64 + 8 * q + i; kk[i] *= inv;
                  Wl[o] = __expf(i < 4 ? l0[i] : l1[i - 4]); Al[o] = -kk[i]; Bl[o] = kk[i] * a[i]; Kl[o] = k[i] * (1.f + (a[i] - 1.f) * kaw[i]); Rl[o] = r[i]; Vl[o] = v[i]; } }
            __syncthreads();
            for (int t = 0; t < CH; ++t) { const int o = t * 64 + 8 * q; float sa = 0.f;
                const f32x4 a0 = *(const LAS f32x4*)(Al + o), a1 = *(const LAS f32x4*)(Al + o + 4), w0 = *(const LAS f32x4*)(Wl + o), w1 = *(const LAS f32x4*)(Wl + o + 4);
                const f32x4 b0 = *(const LAS f32x4*)(Bl + o), b1 = *(const LAS f32x4*)(Bl + o + 4), k0 = *(const LAS f32x4*)(Kl + o), k1 = *(const LAS f32x4*)(Kl + o + 4);
                const f32x4 r0 = *(const LAS f32x4*)(Rl + o), r1 = *(const LAS f32x4*)(Rl + o + 4); const float vv = Vl[t * 64 + row];
#pragma unroll
                for (int i = 0; i < 8; ++i) sa += S[i] * (i < 4 ? a0[i] : a1[i - 4]);
                sa += __shfl_xor(sa, 1); sa += __shfl_xor(sa, 2); sa += __shfl_xor(sa, 4);
                float y = 0.f;
#pragma unroll
                for (int i = 0; i < 8; ++i) { S[i] = S[i] * (i < 4 ? w0[i] : w1[i - 4]) + sa * (i < 4 ? b0[i] : b1[i - 4]) + vv * (i < 4 ? k0[i] : k1[i - 4]); y += S[i] * (i < 4 ? r0[i] : r1[i - 4]); }
                y += __shfl_xor(y, 1); y += __shfl_xor(y, 2); y += __shfl_xor(y, 4);
                if (q == 0) Yl[t * 64 + row] = y; }
            __syncthreads();
            { const int tt = tid >> 3, c = (tid & 7) * 8; *(f32x4*)(Yg + (size_t)(t0 + tt) * RW + c) = *(const LAS f32x4*)(Yl + tt * 64 + c); *(f32x4*)(Yg + (size_t)(t0 + tt) * RW + c + 4) = *(const LAS f32x4*)(Yl + tt * 64 + c + 4); }
        }
        __syncthreads();
    }
}
struct PostTok { v4u y[2], r[2], k[2], v[2], a[2], g[2]; };
__device__ __forceinline__ void post_load(PostTok& p, const unsigned char* ws, size_t off) {
#pragma unroll
    for (int j = 0; j < 2; ++j) { p.y[j] = *(const v4u*)((const bf16*)(ws + WS_YRAW) + off + 8 * j); p.r[j] = *(const v4u*)((const bf16*)(ws + WS_R) + off + 8 * j); p.k[j] = *(const v4u*)((const bf16*)(ws + WS_K) + off + 8 * j);
        p.v[j] = *(const v4u*)((const bf16*)(ws + WS_V) + off + 8 * j); p.a[j] = *(const v4u*)((const bf16*)(ws + WS_A) + off + 8 * j); p.g[j] = *(const v4u*)((const bf16*)(ws + WS_G) + off + 8 * j); }
}
__device__ __forceinline__ void p7_post(Frame& F) {
    const int gw = F.wg * NWAVES + F.wave, NGW = F.G * NWAVES, lane = F.lane, c0 = 16 * lane;
    float ka[16], rk[16], gng[16], gnb[16];
#pragma unroll
    for (int i = 0; i < 16; ++i) { ka[i] = F.ap->in[I_KA][c0 + i]; rk[i] = F.ap->in[I_RK][c0 + i]; gng[i] = F.ap->in[I_GNG][c0 + i]; gnb[i] = F.ap->in[I_GNB][c0 + i]; }
    PostTok cur, nxt; if (gw < T) post_load(cur, F.ws, (size_t)gw * RW + c0);
    for (int t = gw; t < T; t += NGW) { const size_t off = (size_t)t * RW + c0;
        if (t + NGW < T) post_load(nxt, F.ws, (size_t)(t + NGW) * RW + c0);
        float y[16], r[16], k[16], v[16], a[16], g[16];
#pragma unroll
        for (int j = 0; j < 2; ++j) { float tmp[8];
            unpack8(cur.y[j], tmp); for (int i = 0; i < 8; ++i) y[8 * j + i] = tmp[i];
            unpack8(cur.r[j], tmp); for (int i = 0; i < 8; ++i) r[8 * j + i] = tmp[i];
            unpack8(cur.k[j], tmp); for (int i = 0; i < 8; ++i) k[8 * j + i] = tmp[i];
            unpack8(cur.v[j], tmp); for (int i = 0; i < 8; ++i) v[8 * j + i] = tmp[i];
            unpack8(cur.a[j], tmp); for (int i = 0; i < 8; ++i) a[8 * j + i] = tmp[i];
            unpack8(cur.g[j], tmp); for (int i = 0; i < 8; ++i) g[8 * j + i] = tmp[i]; }
        float s = 0.f, bs = 0.f;
#pragma unroll
        for (int i = 0; i < 16; ++i) { s += y[i]; const float kp = k[i] * (1.f + (a[i] - 1.f) * ka[i]); bs += r[i] * kp * rk[i]; }
        s += __shfl_xor(s, 1); s += __shfl_xor(s, 2); bs += __shfl_xor(bs, 1); bs += __shfl_xor(bs, 2);
        const float mean = s * (1.f / 64.f); float q = 0.f;
#pragma unroll
        for (int i = 0; i < 16; ++i) { const float d = y[i] - mean; q += d * d; }
        q += __shfl_xor(q, 1); q += __shfl_xor(q, 2);
        const float rstd = rsqrtf(q * (1.f / 64.f) + GN_EPS); float o[16];
#pragma unroll
        for (int i = 0; i < 16; ++i) o[i] = ((y[i] - mean) * rstd * gng[i] + gnb[i] + bs * v[i]) * g[i];
#pragma unroll
        for (int j = 0; j < 2; ++j) { v4u w; w.x = pk2(o[8 * j], o[8 * j + 1]); w.y = pk2(o[8 * j + 2], o[8 * j + 3]); w.z = pk2(o[8 * j + 4], o[8 * j + 5]); w.w = pk2(o[8 * j + 6], o[8 * j + 7]); *(v4u*)(WSP(bf16, WS_YA) + off + 8 * j) = w; }
        cur = nxt;
    }
}
__device__ __forceinline__ fox::BlockRef<fox::bf16, fox::bf16> fox_ref(int L_, const unsigned char* ws) {
    const int it = ((const int*)(ws + WS_AORD))[L_], bh = it & 15, qb = it >> 4;
    fox::BlockRef<fox::bf16, fox::bf16> r; r.ws = ws; r.row0 = (bh / fox::H) * fox::SQ + qb * fox::QB; r.bh = bh; r.P0 = qb * fox::QB; r.jlo = ((const int*)(ws + WS_JLO))[bh * 64 + qb]; return r;
}
__device__ __forceinline__ void att_order(Frame& F) {
    LAS int* hist = (LAS int*)(F.lds + RING_OFF); LAS int* base = hist + 260;
    for (int i = F.tid; i < 260; i += NWAVES * 64) hist[i] = 0;
    __syncthreads();
    const int* jl = WSP(int, WS_JLO); int cost[2];
#pragma unroll
    for (int u = 0; u < 2; ++u) { const int it = F.tid + 512 * u, bh = it & 15, qb = it >> 4; cost[u] = 4 * (qb + 1) - jl[bh * 64 + qb]; __hip_atomic_fetch_add(hist + cost[u], 1, __ATOMIC_RELAXED, __HIP_MEMORY_SCOPE_WORKGROUP); }
    __syncthreads();
    if (F.tid == 0) { int run = 0; for (int c = 256; c >= 0; --c) { base[c] = run; run += hist[c]; } }
    __syncthreads();
#pragma unroll
    for (int u = 0; u < 2; ++u) { const int it = F.tid + 512 * u; const int pos = __hip_atomic_fetch_add(base + cost[u], 1, __ATOMIC_RELAXED, __HIP_MEMORY_SCOPE_WORKGROUP); WSP(int, WS_AORD)[pos] = it; }
    __syncthreads();
}
__device__ __forceinline__ int att_fetch(Frame& F, int qi = 0) {
    if (F.tid == 0) F.MISC[4] = __hip_atomic_fetch_add(F.ctl + CW_ATTQ + qi, 1u, RLX_AGENT);
    __syncthreads(); const int v = (int)F.MISC[4]; __syncthreads(); return v;
}
__device__ __forceinline__ void p6_attention(Frame& F, char* lds, int qi = 0) {
    constexpr int TOTAL = (fox::SQ / fox::QB) * fox::B * fox::H;
    int L = att_fetch(F, qi); if (L >= TOTAL) return;
    fox::BlockRef<fox::bf16, fox::bf16> cur = fox_ref(L, F.ws);
    fox::Seam<fox::bf16> S;
    fox::causal_swa_prime<fox::bf16, fox::bf16>(cur, fox::WINDOW, lds, S, F.tid);
    for (;;) {
        const int Ln = att_fetch(F, qi); const bool last = Ln >= TOTAL;
        const fox::BlockRef<fox::bf16, fox::bf16> nxt = last ? cur : fox_ref(Ln, F.ws);
        fox::causal_swa_block<fox::bf16, fox::bf16>(cur, nxt, fox::SKV, fox::WINDOW, lds, S, F.tid);
        if (last) break;
        cur = nxt;
    }
}
typedef float f32x4m __attribute__((ext_vector_type(4)));
__device__ __forceinline__ void p11_router(Frame& F) {
    constexpr int TPW = T / 256 / NWAVES, XP = 136;
    const int lane = F.lane, t0 = (F.wg * NWAVES + F.wave) * TPW;
    const float* x1 = WSP(float, WS_X1); const float* mod = WSP(float, WS_MOD) + (size_t)(t0 / SEQ) * 12288; const float* g2 = F.ap->in[I_N2G]; const float* wrt = WSP(float, WS_WRT);
    LAS float* xs = (LAS float*)(F.lds + RING_OFF + F.wave * (16 * XP * 4));
    LAS float* av = (LAS float*)(F.lds + RING_OFF + 69632); LAS float* sv = av + DM;
    LAS float* lg = (LAS float*)(F.lds + RING_OFF + 86016 + F.wave * 2304);
    LAS int* cnt = (LAS int*)(F.lds + RING_OFF + 104448);
    LAS float* cpart = (LAS float*)(F.lds + RING_OFF + 104704);
    if (F.tid < 32) cnt[F.tid] = 0;
    { const int c = 4 * F.tid; const f32x4 gg = *(const f32x4*)(g2 + c), sc = *(const f32x4*)(mod + 4 * 2048 + c), sh = *(const f32x4*)(mod + 3 * 2048 + c);
      *(LAS f32x4*)(av + c) = gg * (sc + 1.f); *(LAS f32x4*)(sv + c) = sh; }
    __syncthreads();
    { const int e = F.tid & 31, part = F.tid >> 5; float s = 0.f;
      for (int k = 128 * part; k < 128 * part + 128; k += 4) { const f32x4 w = *(const f32x4*)(wrt + (size_t)e * DM + k), h = *(const LAS f32x4*)(sv + k); s += (w[0] * h[0] + w[1] * h[1]) + (w[2] * h[2] + w[3] * h[3]); }
      cpart[part * 32 + e] = s; }
    __syncthreads();
    if (F.tid < 32) { float s = F.ap->in[I_BR][F.tid];
#pragma unroll
        for (int p = 0; p < 16; ++p) s += cpart[p * 32 + F.tid];
        cpart[512 + F.tid] = s; }
    __syncthreads();
    const int i = lane & 15, q = lane >> 4, hf = lane >> 5, l32 = lane & 31;
    { const float* sp = WSP(float, WS_SSP) + (size_t)(8 * q) * T + t0 + i; float s = 0.f;
#pragma unroll
      for (int p = 0; p < 8; ++p) s += sp[(size_t)p * T];
      s += __shfl_xor(s, 16); s += __shfl_xor(s, 32); if (q == 0) lg[512 + i] = rsqrtf(s * (1.f / DM) + NORM_EPS); }
    LDS_WAIT(); asm volatile("" ::: "memory");
    float rsj[8];
#pragma unroll
    for (int j = 0; j < 8; ++j) rsj[j] = lg[512 + 2 * j + hf];
    unsigned char* H2 = WSP(unsigned char, WS_HS) + (size_t)(t0 + hf) * DM + 4 * l32;
    f32x4m acc0 = {0.f, 0.f, 0.f, 0.f}, acc1 = {0.f, 0.f, 0.f, 0.f};
    const float* xrow = x1 + (size_t)(t0 + hf) * DM + 4 * l32; const float* wr = wrt + (size_t)i * DM + 4 * q;
    for (int k0 = 0; k0 < DM; k0 += 128) { f32x4 xv[8], w0[8], w1[8];
#pragma unroll
        for (int j = 0; j < 8; ++j) xv[j] = *(const f32x4*)(xrow + (size_t)(2 * j) * DM + k0);
#pragma unroll
        for (int u = 0; u < 8; ++u) { w0[u] = *(const f32x4*)(wr + k0 + 16 * u); w1[u] = *(const f32x4*)(wr + 16 * DM + k0 + 16 * u); }
        const f32x4 a4 = *(const LAS f32x4*)(av + k0 + 4 * l32), s4 = *(const LAS f32x4*)(sv + k0 + 4 * l32) * FP8_SA1;
#pragma unroll
        for (int j = 0; j < 8; ++j) { const f32x4 xa = xv[j] * a4, hh = xa * (rsj[j] * FP8_SA1) + s4; *(LAS f32x4*)(xs + (2 * j + hf) * XP + 4 * l32) = xa;
            *(unsigned*)(H2 + (size_t)(2 * j) * DM + k0) = pk4_fp8(hh[0], hh[1], hh[2], hh[3]); }
        LDS_WAIT(); asm volatile("" ::: "memory");
#pragma unroll
        for (int u = 0; u < 8; ++u) { const f32x4 hv = *(const LAS f32x4*)(xs + i * XP + 16 * u + 4 * q);
#pragma unroll
            for (int jj = 0; jj < 4; ++jj) { acc0 = __builtin_amdgcn_mfma_f32_16x16x4f32(hv[jj], w0[u][jj], acc0, 0, 0, 0); acc1 = __builtin_amdgcn_mfma_f32_16x16x4f32(hv[jj], w1[u][jj], acc1, 0, 0, 0); } }
        LDS_WAIT(); asm volatile("" ::: "memory"); }
    { const float c0 = cpart[512 + i], c1 = cpart[512 + 16 + i];
#pragma unroll
      for (int r = 0; r < 4; ++r) { const float rs = lg[512 + 4 * q + r]; lg[(4 * q + r) * 32 + i] = acc0[r] * rs + c0; lg[(4 * q + r) * 32 + 16 + i] = acc1[r] * rs + c1; } }
    LDS_WAIT(); asm volatile("" ::: "memory");
    if (lane < 16) { const int m = t0 + lane; float v[4]; int e[4]; unsigned used = 0u;
#pragma unroll
        for (int k = 0; k < 4; ++k) { float best = -3.0e38f; int bi = 0;
            for (int j = 0; j < 32; ++j) { const float x = lg[lane * 32 + j]; if (!((used >> j) & 1u) && x > best) { best = x; bi = j; } }
            used |= 1u << bi; v[k] = best; e[k] = bi; }
        const float e1 = __expf(v[1] - v[0]), e2 = __expf(v[2] - v[0]), e3 = __expf(v[3] - v[0]), inv = 1.f / (1.f + e1 + e2 + e3);
        *(f32x4*)(WSP(float, WS_TOKW) + (size_t)m * 4) = (f32x4){inv, e1 * inv, e2 * inv, e3 * inv};
        int* te = WSP(int, WS_TOKE) + (size_t)m * 4; te[0] = e[0]; te[1] = e[1]; te[2] = e[2]; te[3] = e[3];
#pragma unroll
        for (int k = 0; k < 4; ++k) __hip_atomic_fetch_add(cnt + e[k], 1, __ATOMIC_RELAXED, __HIP_MEMORY_SCOPE_WORKGROUP); }
    __syncthreads();
    if (F.tid < 32) WSP(int, WS_WGCNT)[F.wg * 32 + F.tid] = cnt[F.tid];
    __syncthreads();
}
__device__ __forceinline__ void p12_slots(Frame& F) {
    constexpr int TPG = T / 256;
    LAS int* cur = (LAS int*)(F.lds + RING_OFF); LAS int* tot = cur + 32; LAS int* pre = cur + 64; LAS int* off = cur + 96; LAS int* slotl = cur + 160;
    const int* wgcnt = WSP(int, WS_WGCNT);
    if (F.tid < 32) { int tt = 0, pp = 0; for (int w = 0; w < 256; ++w) { const int c = wgcnt[w * 32 + F.tid]; if (w < F.wg) pp += c; tt += c; } tot[F.tid] = tt; pre[F.tid] = pp; }
    __syncthreads();
    if (F.tid == 0) { int o = 0; for (int e = 0; e < 32; ++e) { off[e] = o; o += (tot[e] + 255) & ~255; } off[32] = o; }
    __syncthreads();
    if (F.tid < 32) cur[F.tid] = off[F.tid] + pre[F.tid];
    if (F.wg == 0) { int* te = WSP(int, WS_TILEE); const int nt = off[32] >> 8;
        for (int p = F.tid; p < nt; p += NWAVES * 64) { int e = 0; for (int j = 1; j < 32; ++j) if ((p << 8) >= off[j]) e = j; te[p] = e; }
        if (F.tid == 0) te[1024] = nt; }
    __syncthreads();
    { const int t = F.wg * TPG + (F.tid >> 2), k = F.tid & 3; const int e = WSP(int, WS_TOKE)[(size_t)t * 4 + k];
      const int s = __hip_atomic_fetch_add(cur + e, 1, __ATOMIC_RELAXED, __HIP_MEMORY_SCOPE_WORKGROUP);
      WSP(int, WS_TOKS)[(size_t)t * 4 + k] = s; WSP(int, WS_STOK)[s] = t; WSP(float, WS_SLOTW)[s] = WSP(float, WS_TOKW)[(size_t)t * 4 + k]; }
    if (F.wg < 32) { const int s = off[F.wg] + tot[F.wg] + F.tid; if (s < off[F.wg + 1]) WSP(int, WS_STOK)[s] = 0; }
    __syncthreads();
}
__device__ __forceinline__ void p15_final(Frame& F) {
    const int gw = F.wg * NWAVES + F.wave, NGW = F.G * NWAVES, lane = F.lane;
    const float* x1 = WSP(float, WS_X1); const unsigned char* YS = WSP(unsigned char, WS_YS); const float* gf = F.ap->in[I_NFG];
    typedef float f32x2f __attribute__((ext_vector_type(2)));
    for (int m = gw; m < T; m += NGW) { const float* gt = WSP(float, WS_MOD) + (size_t)(m / SEQ) * 12288 + 5 * 2048;
        const int4 sl = *(const int4*)(WSP(int, WS_TOKS) + (size_t)m * 4); float v[2][16]; float ss = 0.f;
#pragma unroll
        for (int j = 0; j < 2; ++j) { const int c = 16 * (lane + 64 * j);
            const v4u q0 = *(const v4u*)(YS + (size_t)sl.x * DM + c), q1 = *(const v4u*)(YS + (size_t)sl.y * DM + c), q2 = *(const v4u*)(YS + (size_t)sl.z * DM + c), q3 = *(const v4u*)(YS + (size_t)sl.w * DM + c);
#pragma unroll
            for (int w = 0; w < 4; ++w) { const f32x4 xa = *(const f32x4*)(x1 + (size_t)m * DM + c + 4 * w), ga = *(const f32x4*)(gt + c + 4 * w);
                const f32x2f a0 = __builtin_amdgcn_cvt_pk_f32_fp8((int)q0[w], false), a1 = __builtin_amdgcn_cvt_pk_f32_fp8((int)q0[w], true), b0 = __builtin_amdgcn_cvt_pk_f32_fp8((int)q1[w], false), b1 = __builtin_amdgcn_cvt_pk_f32_fp8((int)q1[w], true);
                const f32x2f c0 = __builtin_amdgcn_cvt_pk_f32_fp8((int)q2[w], false), c1 = __builtin_amdgcn_cvt_pk_f32_fp8((int)q2[w], true), d0 = __builtin_amdgcn_cvt_pk_f32_fp8((int)q3[w], false), d1 = __builtin_amdgcn_cvt_pk_f32_fp8((int)q3[w], true);
                const f32x2f s0 = (a0 + b0) + (c0 + d0), s1 = (a1 + b1) + (c1 + d1); const float y[4] = {s0.x, s0.y, s1.x, s1.y};
#pragma unroll
                for (int i = 0; i < 4; ++i) { const float xv = xa[i] + ga[i] * (y[i] * (1.f / FP8_SY)); v[j][4 * w + i] = xv; ss += xv * xv; } } }
        const float rs = rsqrtf(wave_sum(ss) * (1.f / DM) + NORM_EPS);
#pragma unroll
        for (int j = 0; j < 2; ++j) { const int c = 16 * (lane + 64 * j);
#pragma unroll
            for (int w = 0; w < 4; ++w) { const f32x4 ga = *(const f32x4*)(gf + c + 4 * w);
                *(f32x4*)(F.ap->out + (size_t)m * DM + c + 4 * w) = (f32x4){v[j][4 * w] * rs * ga[0], v[j][4 * w + 1] * rs * ga[1], v[j][4 * w + 2] * rs * ga[2], v[j][4 * w + 3] * rs * ga[3]}; } }
    }
}

__device__ __forceinline__ void stagger(Frame& F, int ticks_step) {
    const unsigned long long t0 = __builtin_amdgcn_s_memrealtime(), d = (unsigned long long)(((F.wg * 5) & 7) * ticks_step);
    while (__builtin_amdgcn_s_memrealtime() - t0 < d) __builtin_amdgcn_s_sleep(8);
}
__device__ __forceinline__ bool fresh(Frame& F) {
    asm volatile("" : "+s"(F.ap)); int w = F.wave; asm volatile("" : "+s"(w)); const int l = __builtin_amdgcn_mbcnt_hi(~0u, __builtin_amdgcn_mbcnt_lo(~0u, 0u)); F.lane = l; F.tid = w * 64 + l; return true; }
constexpr int N_PHASES = 18;
#ifndef STAGGER_TICKS
#define STAGGER_TICKS 400
#endif
#ifndef N_CONV_WG
#define N_CONV_WG 96
#endif
__global__ void __launch_bounds__(NWAVES * 64, 2) mk_fwd(Args args) {
    extern __shared__ __attribute__((aligned(16))) unsigned char lds[];
    Frame F;
    F.lds = (LAS unsigned char*)lds; F.MISC = (volatile LAS unsigned*)(F.lds + MISC_OFF);
    F.tid = threadIdx.x; F.lane = F.tid & 63; F.wave = __builtin_amdgcn_readfirstlane(F.tid >> 6); F.G = gridDim.x; F.wg = blockIdx.x;
    F.ap = (ArgsP)__builtin_amdgcn_kernarg_segment_ptr(); F.ws = F.ap->ws; F.ctl = (gu32*)(F.ws + WS_CTL);
    for (int u = F.tid; u < (LDS_BYTES - LDSCTL_OFF) / 4; u += NWAVES * 64) ((LAS unsigned*)(F.lds + LDSCTL_OFF))[u] = 0u;
    __syncthreads();
    const int lo = F.ap->ph_lo, hi = F.ap->ph_hi;
    XcdBarrier bar; bar.bar = (unsigned*)(F.ctl + CW_BAR); bar.x = 0; bar.st = nullptr;
    if (hi - lo > 1) bar = xcd_barrier_post((unsigned*)(F.ctl + CW_BAR), F.MISC + 8, F.tid);
#ifndef PH_MASK
#define PH_MASK 0x3ffff
#endif
#define IN(k) (((PH_MASK >> (k)) & 1) && lo <= (k) && (k) < hi && fresh(F))
#ifndef PROBE_DUP
#define PROBE_DUP 0
#endif
#ifndef PROBE_PHASEA
#define PROBE_PHASEA -1
#endif
#ifndef PROBE_TILE_EPI
#define PROBE_TILE_EPI 0
#endif
#ifndef PROBE_NULL_EPI
#define PROBE_NULL_EPI 0
#endif
#define REP(k) for (int rep_ = 0; rep_ < 1 + ((PROBE_DUP >> (k)) & 1); ++rep_)
#define SEAM_NB(k) do { } while (0)
#define SEAM(k) do { if (IN(k) && IN((k) + 1)) xcd_barrier(bar, F.tid); } while (0)
    if (IN(0)) REP(0) { p0_prologue(F); } SEAM(0);
    if (IN(1)) REP(1) { norm_mod_rows<INPROJ_FP8>(F, F.ap->in[I_X], F.ap->in[I_N1G], 0, 2048, WSP(bf16, WS_H), WSP(unsigned char, WS_H8)); } SEAM(1);
    if (IN(2)) REP(2) {
#if INPROJ_FP8 == 1
        pg8::Gemm g{WSP(bf16, WS_H8), WSP(bf16, WS_WIN8), T, NP, DM / 2}; pg8::StaticOrder S; S.init(T, NP, F.G, F.wg);
        pg8::EpiBf16S E{WSP(bf16, WS_P), NP, 1.f / (FP8_SA1 * FP8_SW)}; pg8::gemm_phase<pg8::EpiBf16S, pg8::StaticOrder, true, true, true>(F.lds + RING_OFF, g, S, E, F.tid);
#elif INPROJ_FP8 == 2
        pg8::Gemm g{WSP(bf16, WS_H8), (const pg8::bf16_t*)(F.ws + WS_WIN8 + (size_t)PC_SPLIT * DM), T, NP - PC_SPLIT, DM / 2}; pg8::StaticOrder S; S.init(T, NP - PC_SPLIT, F.G, F.wg);
#ifdef PROBE_EXTRA_ST
        pg8::EpiBf16S E{WSP(bf16, WS_P) + PC_SPLIT, NP, 1.f / (FP8_SA1 * FP8_SW), (pg8::bf16_t*)(F.ws + WS_END + (size_t)F.wg * 131072)};
#else
        pg8::EpiBf16S E{WSP(bf16, WS_P) + PC_SPLIT, NP, 1.f / (FP8_SA1 * FP8_SW)};
#endif
        pg8::gemm_phase<pg8::EpiBf16S, pg8::StaticOrder, true, true, true>(F.lds + RING_OFF, g, S, E, F.tid);
#else
        pg8::Gemm g{WSP(bf16, WS_H), WSP(bf16, WS_WIN), T, NP, DM}; pg8::StaticOrder S; S.init(T, NP, F.G, F.wg);
        pg8::EpiBf16<0> E{WSP(bf16, WS_P), NP, nullptr, 0, 0, 1.f}; pg8::gemm_phase<pg8::EpiBf16<0>, pg8::StaticOrder, true, true>(F.lds + RING_OFF, g, S, E, F.tid);
#endif
        } SEAM_NB(2);
#if INPROJ_FP8 == 2
    if (IN(2)) { (void)fresh(F); pg8::Gemm g{WSP(bf16, WS_H), WSP(bf16, WS_WIN), T, PC_SPLIT, DM}; pg8::StaticOrder S; S.init(T, PC_SPLIT, F.G, F.wg);
        pg8::EpiBf16<0> E{WSP(bf16, WS_P), NP, nullptr, 0, 0, 1.f}; pg8::gemm_phase<pg8::EpiBf16<0>, pg8::StaticOrder, true, true>(F.lds + RING_OFF, g, S, E, F.tid); }
#endif
    SEAM(2);
    if (IN(3)) REP(3) { p3_prep(F); } SEAM(3);
    if (IN(4)) REP(4) { p4_cumsum(F);
        { pg8::Gemm g{WSP(bf16, WS_LW), WSP(bf16, WS_BT1), T, 2048, 256}; pg8::StaticOrder S; S.init(T, 2048, F.G, F.wg);
          pg8::EpiLora1 E{WSP(float, WS_LOGW), WSP(bf16, WS_A), F.ap->in[I_W0], F.ap->in[I_A0]}; pg8::gemm_phase<pg8::EpiLora1, pg8::StaticOrder, true, true>(F.lds + RING_OFF, g, S, E, F.tid); }
        } SEAM(4);
    if (IN(5)) REP(5) { if (F.wg == 0) att_order(F);
        { pg8::Gemm g{WSP(bf16, WS_SG), WSP(bf16, WS_BT2), T, 1024, 256}; pg8::StaticOrder S; S.init(T, 1024, F.G, F.wg);
          pg8::EpiBf16<0> E{WSP(bf16, WS_G), 1024, nullptr, 0, 0, 1.f}; pg8::gemm_phase<pg8::EpiBf16<0>, pg8::StaticOrder, true, true>(F.lds + RING_OFF, g, S, E, F.tid); }
        } SEAM(5);
    if (IN(6)) REP(6) {
#if RWKV_NAIVE
        p5_scan_naive(F);
#else
        rw::phase_a<0>(F.lds + RING_OFF, F.ws, WS_REC, F.ap->in[I_KK], F.ap->in[I_KA], F.wg, F.G, F.tid);
#if PROBE_PHASEA >= 0
        __syncthreads(); rw::phase_a<PROBE_PHASEA>(F.lds + RING_OFF, F.ws, WS_END, F.ap->in[I_KK], F.ap->in[I_KA], F.wg, F.G, F.tid);
#endif
#endif
        } SEAM(6);
    if (IN(7)) REP(7) {
#if !RWKV_NAIVE
        for (int bh = F.wg; bh < 32; bh += F.G) { const int b = bh >> 4, h = bh & 15;
            rw::phase_b_head(F.lds + RING_OFF, F.ws + WS_REC + (size_t)bh * 256 * rw::REC, WSP(unsigned short, WS_YRAW) + (size_t)b * SEQ * RW + h * 64, F.tid); __syncthreads(); }
#endif
        if (F.wg >= 32 && F.wg < 32 + N_CONV_WG) { convert_experts(F, F.wg - 32, N_CONV_WG); __syncthreads(); }
        p6_attention(F, (char*)lds + RING_OFF, 0); } SEAM(7);
#ifdef PROBE_P7
    if (IN(8)) {
        for (int bh = F.wg; bh < 32; bh += F.G) { const int b = bh >> 4, h = bh & 15;
            rw::phase_b_head(F.lds + RING_OFF, F.ws + WS_REC + (size_t)bh * 256 * rw::REC, WSP(unsigned short, WS_YRAW) + (size_t)b * SEQ * RW + h * 64, F.tid); __syncthreads(); }
        if (F.wg >= 32 && F.wg < 32 + N_CONV_WG) { convert_experts(F, F.wg - 32, N_CONV_WG); __syncthreads(); }
        p6_attention(F, (char*)lds + RING_OFF, 1); } SEAM(8);
#endif
    if (IN(9)) REP(9) { p7_post(F); } SEAM(9);
    if (IN(10)) REP(10) { pg8::Gemm g{WSP(bf16, WS_YA), WSP(bf16, WS_WOA), T, DM, 1024}; pg8::StaticOrder S; S.init(T, DM, F.G, F.wg);
        pg8::EpiGateMerge<0> E{WSP(bf16, WS_MRG), WSP(bf16, WS_P), PC_GA, nullptr}; pg8::gemm_phase<pg8::EpiGateMerge<0>, pg8::StaticOrder, true, true>(F.lds + RING_OFF, g, S, E, F.tid); } SEAM(10);
    if (IN(11)) REP(11) { pg8::Gemm g{WSP(bf16, WS_YB), WSP(bf16, WS_WOB), T, DM, 1024}; pg8::StaticOrder S; S.init(T, DM, F.G, F.wg);
        pg8::EpiGateMerge<1> E{WSP(bf16, WS_MRG), WSP(bf16, WS_P), PC_GB, WSP(unsigned char, WS_MRG8)}; pg8::gemm_phase<pg8::EpiGateMerge<1>, pg8::StaticOrder, true, true>(F.lds + RING_OFF, g, S, E, F.tid); } SEAM(11);
#if OUTPROJ_FP8
    if (IN(12)) REP(12) { pg8::Gemm g{WSP(bf16, WS_MRG8), WSP(bf16, WS_WOUT), T, DM, DM / 2}; pg8::StaticOrder S; S.init(T, DM, F.G, F.wg);
        pg8::EpiResid E{F.ap->in[I_X], WSP(float, WS_X1), WSP(float, WS_MOD), WSP(float, WS_SSP), 1.f / (FP8_SM * FP8_SW)}; pg8::gemm_phase<pg8::EpiResid, pg8::StaticOrder, true, true, true>(F.lds + RING_OFF, g, S, E, F.tid); } SEAM(12);
#else
    if (IN(12)) REP(12) { pg8::Gemm g{WSP(bf16, WS_MRG), WSP(bf16, WS_WOUT), T, DM, DM}; pg8::StaticOrder S; S.init(T, DM, F.G, F.wg);
        pg8::EpiResid E{F.ap->in[I_X], WSP(float, WS_X1), WSP(float, WS_MOD), WSP(float, WS_SSP), 1.f}; pg8::gemm_phase<pg8::EpiResid, pg8::StaticOrder, true, true>(F.lds + RING_OFF, g, S, E, F.tid); } SEAM(12);
#endif
    if (IN(13)) REP(13) { p11_router(F); } SEAM(13);
    if (IN(14)) REP(14) { p12_slots(F); } SEAM(14);
    if (IN(15)) REP(15) { const int nt = WSP(int, WS_TILEE)[1024]; pg8::Gemm g{WSP(bf16, WS_HS), WSP(bf16, WS_WGU), nt * 256, 4096, DM / 2, WSP(int, WS_STOK)}; pg8::MoeOrder S; S.init(nt * 256, 4096, F.G, F.wg); S.tile_e = WSP(int, WS_TILEE);
        pg8::EpiSwiglu E{WSP(unsigned char, WS_ACT), F.ap->in[I_BGU], F.lds + EPI_STG_OFF}; pg8::gemm_phase<pg8::EpiSwiglu, pg8::MoeOrder, true, true, true, true>(F.lds + RING_OFF, g, S, E, F.tid); } SEAM(15);
    if (IN(16)) REP(16) { const int nt = WSP(int, WS_TILEE)[1024]; pg8::Gemm g{WSP(bf16, WS_ACT), WSP(bf16, WS_WDN), nt * 256, 2048, DFF / 2}; pg8::MoeOrder S; S.init(nt * 256, 2048, F.G, F.wg); S.tile_e = WSP(int, WS_TILEE);
        pg8::EpiDown E{WSP(unsigned char, WS_YS), F.ap->in[I_BDN], WSP(float, WS_SLOTW)}; pg8::gemm_phase<pg8::EpiDown, pg8::MoeOrder, true, true, true>(F.lds + RING_OFF, g, S, E, F.tid); } SEAM(16);
    if (IN(17)) REP(17) { p15_final(F); }
#undef IN
#undef SEAM
}

extern "C" void kernel_launch(void* const* d_in, const int* in_sizes, int n_in, void* d_out, int out_size, void* d_ws, size_t ws_size, hipStream_t stream) {
    static int grid = 0;
    if (grid == 0) {
        if (n_in != N_IN || in_sizes[0] != T * DM || out_size != T * DM || ws_size < WS_END) { fprintf(stderr, "kernel_launch: shape/workspace mismatch (n_in %d, in0 %d, out %d, ws %zu < %zu)\n", n_in, n_in > 0 ? in_sizes[0] : -1, out_size, ws_size, (size_t)WS_END); grid = -1; return; }
        if (hipFuncSetAttribute((const void*)mk_fwd, hipFuncAttributeMaxDynamicSharedMemorySize, LDS_BYTES) != hipSuccess) { fprintf(stderr, "kernel_launch: hipFuncSetAttribute failed\n"); grid = -1; return; }
        int per_cu = 0;
        if (hipOccupancyMaxActiveBlocksPerMultiprocessor(&per_cu, (const void*)mk_fwd, NWAVES * 64, LDS_BYTES) != hipSuccess || per_cu < 1) fprintf(stderr, "kernel_launch: note: occupancy query reports %d workgroups per CU\n", per_cu);
        (void)hipGetLastError();
        grid = 256;
    }
    if (grid < 0) return;
    (void)hipMemsetAsync((char*)d_ws + WS_CTL, 0, CTL_ZERO_BYTES, stream);
    Args a{};
    for (int i = 0; i < N_IN; ++i) a.in[i] = (const float*)d_in[i];
    a.out = (float*)d_out; a.ws = (unsigned char*)d_ws;
#if MK_N_LAUNCHES == 1
    a.ph_lo = 0; a.ph_hi = N_PHASES;
    hipLaunchKernelGGL(mk_fwd, dim3(grid), dim3(NWAVES * 64), LDS_BYTES, stream, a);
#else
    for (int p = 0; p < N_PHASES; ++p) { a.ph_lo = p; a.ph_hi = p + 1; hipLaunchKernelGGL(mk_fwd, dim3(grid), dim3(NWAVES * 64), LDS_BYTES, stream, a); }
#endif
}
```

```cpp
#include <hip/hip_runtime.h>
#include <hip/hip_bf16.h>
#include <cstdio>
#include <cstdint>
constexpr int NWAVES = 8;
#ifndef MK_N_LAUNCHES
#define MK_N_LAUNCHES 1
#endif
#ifndef INPROJ_FP8
#define INPROJ_FP8 2
#endif
#ifndef OUTPROJ_FP8
#define OUTPROJ_FP8 1
#endif
#ifndef RWKV_NAIVE
#define RWKV_NAIVE 0
#endif
constexpr int BATCH = 2, SEQ = 16384, DM = 2048, T = BATCH * SEQ;
constexpr int NP = 11776;
constexpr int PC_R = 0, PC_K = 1024, PC_V = 2048, PC_GLO = 3072, PC_DLO = 3328, PC_ALO = 3424, PC_F = 3520, PC_FEND = 3528, PC_SPLIT = 3584, PC_GA = 3584, PC_FQ = 5632, PC_FK = 6656, PC_FV = 7680, PC_OG = 8704, PC_GB = 9728;
constexpr int RW = 1024, FW = 1024, NE = 32, DFF = 2048, TOPK = 4;
constexpr int NSLOT = T * TOPK + NE * 256;
constexpr float NORM_EPS = 1e-6f, GN_EPS = 64e-5f;
constexpr float FOX_SKIP_BITS = 32.f;
constexpr float FP8_SY = 16.f;
constexpr float FP8_SM = 16.f;
constexpr float FP8_SW = 64.f, FP8_SA1 = 2.f, FP8_SA2 = 4.f;

constexpr size_t MiB = 1u << 20;
constexpr size_t WS_CTL = 0, CTL_ZERO_BYTES = 1 * MiB;
constexpr size_t WS_MOD = 1 * MiB;
constexpr size_t WS_WRT = 1 * MiB + 128 * 1024;
constexpr size_t WS_TOKE = 2 * MiB, WS_TOKW = 2 * MiB + 512 * 1024, WS_TOKS = 3 * MiB, WS_SLOTW = 3 * MiB + 512 * 1024;
constexpr size_t WS_WGCNT = 4 * MiB + 512 * 1024, WS_TILEE = 4 * MiB + 768 * 1024;
constexpr size_t WS_RS = 4 * MiB + 832 * 1024;
constexpr size_t WS_AORD = 4 * MiB + 808 * 1024;
constexpr size_t WS_JLO = 4 * MiB + 800 * 1024;
constexpr size_t WS_LF = 5 * MiB, WS_CS = 6 * MiB;
constexpr size_t WS_STOK = 5 * MiB;
constexpr size_t WS_BT1 = 7 * MiB, WS_BT2 = 8 * MiB, WS_WOA = 9 * MiB, WS_WOB = 13 * MiB, WS_WOUT = 17 * MiB, WS_WIN = 25 * MiB;
constexpr size_t WS_WGU = 72 * MiB, WS_WDN = 584 * MiB, WS_X1 = 840 * MiB, WS_H = 1096 * MiB;
constexpr size_t WS_P = 1226 * MiB, WS_R = 1962 * MiB, WS_K = 2026 * MiB, WS_V = 2090 * MiB, WS_FQ = 2154 * MiB, WS_FK = 2218 * MiB, WS_FV = 2282 * MiB;
constexpr size_t WS_LW = 2346 * MiB, WS_SG = 2362 * MiB, WS_LOGW = 2378 * MiB, WS_A = 2506 * MiB, WS_G = 2570 * MiB, WS_YRAW = 2634 * MiB, WS_YA = 2762 * MiB, WS_YB = 2826 * MiB, WS_MRG = 2890 * MiB;
constexpr size_t WS_HS = 1226 * MiB, WS_ACT = 1500 * MiB, WS_YS = 1774 * MiB;
constexpr size_t WS_WIN8 = 3274 * MiB, WS_H8 = 3298 * MiB;
constexpr size_t WS_REC = 3018 * MiB;
constexpr size_t WS_SSP = 3362 * MiB;
constexpr size_t WS_MRG8 = 3366 * MiB;
constexpr size_t WS_END = 3430 * MiB;
static_assert(WS_WIN + (size_t)NP * DM * 2 <= WS_WGU && WS_YS + (size_t)NSLOT * DM * 2 <= WS_REC && WS_HS + (size_t)NSLOT * DM <= WS_ACT && WS_ACT + (size_t)NSLOT * DFF <= WS_YS && WS_SLOTW + (size_t)NSLOT * 4 <= WS_WGCNT, "d_ws map");
constexpr int CW_TMO = 0, CW_ATTQ = 2048, CW_BAR = 4096;

constexpr int RING_OFF = 0, RING_BYTES = 143360;
constexpr int LDSCTL_OFF = RING_BYTES, MISC_OFF = LDSCTL_OFF + 320;
constexpr int LDS_BYTES = 147456;

#define GAS __attribute__((address_space(1)))
#define LAS __attribute__((address_space(3)))
typedef unsigned short bf16;
typedef unsigned v4u __attribute__((ext_vector_type(4)));
typedef unsigned v2u __attribute__((ext_vector_type(2)));
typedef float f32x4 __attribute__((ext_vector_type(4)));
typedef short bf16x8 __attribute__((ext_vector_type(8)));
typedef GAS unsigned gu32;
#define RLX_AGENT __ATOMIC_RELAXED, __HIP_MEMORY_SCOPE_AGENT
#define LDS_WAIT() asm volatile("s_waitcnt lgkmcnt(0)" ::: "memory")
#define VM_WAIT() asm volatile("s_waitcnt vmcnt(0)" ::: "memory")
__device__ __forceinline__ unsigned f2bf(float f) { unsigned u = __builtin_bit_cast(unsigned, f); return (u + 0x7fffu + ((u >> 16) & 1u)) >> 16; }
__device__ __forceinline__ unsigned pk2(float lo, float hi) { return f2bf(lo) | (f2bf(hi) << 16); }
__device__ __forceinline__ float bflo(unsigned w) { return __uint_as_float(w << 16); }
__device__ __forceinline__ float bfhi(unsigned w) { return __uint_as_float(w & 0xffff0000u); }
__device__ __forceinline__ void unpack8(v4u w, float (&f)[8]) { f[0] = bflo(w.x); f[1] = bfhi(w.x); f[2] = bflo(w.y); f[3] = bfhi(w.y); f[4] = bflo(w.z); f[5] = bfhi(w.z); f[6] = bflo(w.w); f[7] = bfhi(w.w); }
__device__ __forceinline__ v4u pack8f(const float (&f)[8]) { v4u w; w.x = pk2(f[0], f[1]); w.y = pk2(f[2], f[3]); w.z = pk2(f[4], f[5]); w.w = pk2(f[6], f[7]); return w; }
__device__ __forceinline__ float sigmoidf_(float x) { return 1.f / (1.f + __expf(-x)); }
__device__ __forceinline__ float wave_sum(float v) {
#pragma unroll
    for (int o = 1; o < 64; o <<= 1) v += __shfl_xor(v, o);
    return v;
}
namespace pg8 {
#define PG8_LAS __attribute__((address_space(3)))
typedef unsigned short bf16_t;
typedef short bf16x8 __attribute__((ext_vector_type(8)));
typedef float f32x4 __attribute__((ext_vector_type(4)));
typedef unsigned u32x4 __attribute__((ext_vector_type(4)));
constexpr int BM = 256, BK = 64, HALF = 128, HTB = HALF * BK * 2  , STAGE_BYTES = 8 * HTB, NXCD = 8, WGM = 8;

__host__ __device__ __forceinline__ int lds_byte(int r, int c) { const int st = (r >> 4) * 2 + (c >> 5), rr = r & 15, cc = c & 31, ob = rr * 64 + cc * 2; return st * 1024 + (ob ^ (((ob >> 9) & 1) << 5)); }
__host__ __device__ __forceinline__ void stage_rc(int b, int& R, int& C) { const int st = b / 1024, sb = b % 1024, swz = sb ^ (((sb >> 9) & 1) << 5); R = (st >> 1) * 16 + swz / 64; C = (st & 1) * 32 + (swz % 64) / 2; }
__host__ __device__ __forceinline__ int perm32(int rho) { const int n = rho >> 4, i = rho & 15; return 8 * (i >> 2) + 4 * n + (i & 3); }

struct Unit { int pm, pn, e; };
struct Gemm { const bf16_t* A; const bf16_t* Bt; int M, N, K; const int* rowmap = nullptr; };

struct StaticOrder {
    int nM, nN, nwg, G, c;
    __host__ __device__ void init(int M, int N, int G_, int c_) { nM = M / BM; nN = N / BM; nwg = nM * nN; G = G_; c = c_; }
    __host__ __device__ bool next(int i, Unit& u) const {
        const long L = (long)i * G + c; if (L >= nwg) return false;
        int wgid = (int)L; { const int q = nwg / NXCD, r = nwg % NXCD, xcd = wgid % NXCD, off = wgid / NXCD; wgid = (xcd < r ? xcd * (q + 1) : r * (q + 1) + (xcd - r) * q) + off; }
        const int nig = WGM * nN, gid = wgid / nig, fm = gid * WGM, gsz = (nM - fm) < WGM ? (nM - fm) : WGM;
        u.pm = fm + ((wgid % nig) % gsz); u.pn = (wgid % nig) / gsz; u.e = 0; return true;
    }
    __device__ __forceinline__ void a_ready(const Unit&) const {}
    __device__ __forceinline__ void done(const Unit&) const {}
};

__device__ __forceinline__ unsigned cvt_pk_bf16(float lo, float hi) { unsigned r; asm volatile("v_cvt_pk_bf16_f32 %0, %1, %2" : "=v"(r) : "v"(lo), "v"(hi)); return r; }
typedef float f32x2 __attribute__((ext_vector_type(2)));
__device__ __forceinline__ f32x2 gelu_pk(f32x2 v) {
    const f32x2 av = __builtin_elementwise_abs(v), d = av * 0.2316418882f + 1.0f;
    f32x2 t; t.x = __builtin_amdgcn_rcpf(d.x); t.y = __builtin_amdgcn_rcpf(d.y);
    f32x2 q = t * 0.5307027145f + (-0.7265760135f); q = q * t + 0.7107068705f; q = q * t + (-0.142248368f); q = q * t + 0.127414796f; q = q * t;
    const f32x2 s = (v * v) * (-0.72134752044f);
    f32x2 e; e.x = __builtin_amdgcn_exp2f(s.x); e.y = __builtin_amdgcn_exp2f(s.y);
    const f32x2 m = v * (q * e), r = v - m;
    f32x2 o; o.x = v.x < 0.f ? m.x : r.x; o.y = v.y < 0.f ? m.y : r.y; return o;
}

template <int ACT  > struct EpiBf16 {
    static constexpr bool PERM = true, AFTER_DRAIN = false; static_assert(ACT == 0 || ACT == 1, "EpiBf16: ACT is 0 (none) or 1 (gelu_pk)");
    bf16_t* O; int ldc; const float* bias; int split_cols; size_t split_stride; float scale0;
    __device__ __forceinline__ void operator()(const f32x4 (&acc)[2][2][4][2], const Unit& u, int wr, int wc, int fr, int fq) const {
        const int row0 = u.pm * BM + wr * 64 + fr; int colt = u.pn * BM; bf16_t* base = O;
        float sc = 1.f; if (split_cols) { const int t = colt / split_cols; base += (size_t)t * split_stride; colt -= t * split_cols; if (t == 0) sc = scale0; }
        const int col0 = colt + wc * 32 + 8 * fq, bcol0 = u.pn * BM + wc * 32 + 8 * fq;
        f32x4 bv[2][2];
#pragma unroll
        for (int bj = 0; bj < 2; ++bj)
#pragma unroll
            for (int n = 0; n < 2; ++n) bv[bj][n] = bias ? *(const f32x4*)(bias + bcol0 + bj * HALF + 4 * n) : (f32x4){0.f, 0.f, 0.f, 0.f};
#pragma unroll
        for (int ai = 0; ai < 2; ++ai)
#pragma unroll
            for (int m = 0; m < 4; ++m) { bf16_t* rowp = base + (size_t)(row0 + ai * HALF + m * 16) * ldc + col0;
#pragma unroll
                for (int bj = 0; bj < 2; ++bj) { f32x4 v0 = acc[ai][bj][m][0] + bv[bj][0], v1 = acc[ai][bj][m][1] + bv[bj][1];
                    if (ACT == 1) { f32x2 a = gelu_pk((f32x2){v0[0], v0[1]}), b = gelu_pk((f32x2){v0[2], v0[3]}), c = gelu_pk((f32x2){v1[0], v1[1]}), d = gelu_pk((f32x2){v1[2], v1[3]});
                        v0 = (f32x4){a.x, a.y, b.x, b.y}; v1 = (f32x4){c.x, c.y, d.x, d.y}; }
                    v0 = v0 * sc; v1 = v1 * sc; u32x4 w; w.x = cvt_pk_bf16(v0[0], v0[1]); w.y = cvt_pk_bf16(v0[2], v0[3]); w.z = cvt_pk_bf16(v1[0], v1[1]); w.w = cvt_pk_bf16(v1[2], v1[3]);
                    *(u32x4*)(rowp + bj * HALF) = w; } }
    }
};

typedef int v4i_t __attribute__((ext_vector_type(4))); typedef int v8i_t __attribute__((ext_vector_type(8)));
template <class Epi, class Sched, bool ALIGN_EPI = false, bool SP2 = false, bool FP8 = false, bool GATHER = false>
__device__ __forceinline__ void gemm_phase(PG8_LAS unsigned char* lds, const Gemm g, const Sched& S, const Epi& E, const int tid) {
    const int wid = __builtin_amdgcn_readfirstlane(tid >> 6), lane = tid & 63, wr = wid >> 2, wc = wid & 3, fr = lane & 15, fq = lane >> 4;
    const int K = g.K, nt = K / BK;
    static_assert(!GATHER || SP2, "GATHER is written for the SP2 loop");
    unsigned voffA[2], voffB[2]; int gR[2]; unsigned gC[2];
#pragma unroll
    for (int i = 0; i < 2; ++i) { int R, C; stage_rc(tid * 16 + i * 8192, R, C); const int Rb = Epi::PERM ? ((R & ~31) + perm32(R & 31)) : R;
        voffA[i] = (unsigned)(R * K + C) * 2u; voffB[i] = (unsigned)(Rb * K + C) * 2u; gR[i] = R; gC[i] = (unsigned)C * 2u; }
    unsigned vC[2][2], vN[2][2]; int raw[2][2];
#define PG8_ROWS_ISSUE(u) do { _Pragma("unroll") for (int _h = 0; _h < 2; ++_h) _Pragma("unroll") for (int _i = 0; _i < 2; ++_i) raw[_h][_i] = g.rowmap[(u).pm * BM + _h * HALF + gR[_i]]; } while (0)
#define PG8_ROWS_MAKE(v) do { _Pragma("unroll") for (int _h = 0; _h < 2; ++_h) _Pragma("unroll") for (int _i = 0; _i < 2; ++_i) { asm volatile("" : "+v"(raw[_h][_i])); (v)[_h][_i] = (unsigned)raw[_h][_i] * (unsigned)(K * 2) + gC[_i]; } } while (0)
    const size_t kstep = (size_t)(BK * 2);
    const size_t hstep = (size_t)HALF * K * 2;
    const size_t tstep = 2 * hstep;
    const unsigned ldsw = (unsigned)wid * 1024u;
    const int aoff = lds_byte(wr * 64 + fr, fq * 8), boff = lds_byte(wc * 32 + fr, fq * 8);
#define PG8_SA(b, h) (((b) * 2 + (h)) * HTB)
#define PG8_SB(b, h) ((4 + (b) * 2 + (h)) * HTB)
#define PG8_STAGE(bufoff, gbase, voff) do { _Pragma("unroll") for (int _i = 0; _i < 2; ++_i) \
        __builtin_amdgcn_global_load_lds((const unsigned*)((const char*)(gbase) + (voff)[_i]), (PG8_LAS unsigned*)(lds + (bufoff) + ldsw + _i * 8192), 16, 0, 0); } while (0)
#define PG8_STAGE_A(bufoff, ptr, h, nx) do { if constexpr (GATHER) { _Pragma("unroll") for (int _i = 0; _i < 2; ++_i) { const unsigned _vo = (nx) ? vN[h][_i] : vC[h][_i]; \
        __builtin_amdgcn_global_load_lds((const unsigned*)((const char*)(ptr) + _vo), (PG8_LAS unsigned*)(lds + (bufoff) + ldsw + _i * 8192), 16, 0, 0); } } else PG8_STAGE(bufoff, (ptr) + (h) * hstep, voffA); } while (0)
#define PG8_CAT(x0, x1) __builtin_shufflevector(__builtin_bit_cast(v4i_t, x0), __builtin_bit_cast(v4i_t, x1), 0, 1, 2, 3, 4, 5, 6, 7)
#define PG8_LDA(dst, b, h) do { _Pragma("unroll") for (int m = 0; m < 4; ++m) { if constexpr (FP8) dst##8[m] = PG8_CAT(*(const PG8_LAS bf16x8*)(lds + PG8_SA(b, h) + aoff + m * 2048), *(const PG8_LAS bf16x8*)(lds + PG8_SA(b, h) + aoff + m * 2048 + 1024)); \
        else { _Pragma("unroll") for (int k = 0; k < 2; ++k) dst[m][k] = *(const PG8_LAS bf16x8*)(lds + PG8_SA(b, h) + aoff + m * 2048 + k * 1024); } } } while (0)
#define PG8_LDB(dst, b, h) do { _Pragma("unroll") for (int n = 0; n < 2; ++n) { if constexpr (FP8) dst##8[n] = PG8_CAT(*(const PG8_LAS bf16x8*)(lds + PG8_SB(b, h) + boff + n * 2048), *(const PG8_LAS bf16x8*)(lds + PG8_SB(b, h) + boff + n * 2048 + 1024)); \
        else { _Pragma("unroll") for (int k = 0; k < 2; ++k) dst[n][k] = *(const PG8_LAS bf16x8*)(lds + PG8_SB(b, h) + boff + n * 2048 + k * 1024); } } } while (0)
#define PG8_MMA16(ai, bj, At, Bt) do { __builtin_amdgcn_s_setprio(1); _Pragma("unroll") for (int m = 0; m < 4; ++m) _Pragma("unroll") for (int n = 0; n < 2; ++n) _Pragma("unroll") for (int k = 0; k < 2; ++k) \
        acc[ai][bj][m][n] = __builtin_amdgcn_mfma_f32_16x16x32_bf16(Bt[n][k], At[m][k], acc[ai][bj][m][n], 0, 0, 0); __builtin_amdgcn_s_setprio(0); } while (0)
#define PG8_MMA8(ai, bj, At, Bt) do { __builtin_amdgcn_s_setprio(1); _Pragma("unroll") for (int m = 0; m < 4; ++m) _Pragma("unroll") for (int n = 0; n < 2; ++n) \
        asm volatile("v_mfma_scale_f32_16x16x128_f8f6f4 %0, %1, %2, %0, %3, %3 op_sel_hi:[0,0,0]" : "+v"(acc[ai][bj][m][n]) : "v"(Bt##8[n]), "v"(At##8[m]), "v"(one_scale)); __builtin_amdgcn_s_setprio(0); } while (0)
#define PG8_MMA(ai, bj, At, Bt) do { if constexpr (FP8) PG8_MMA8(ai, bj, At, Bt); else PG8_MMA16(ai, bj, At, Bt); } while (0)
#define PG8_WAIT_V(n) asm volatile("s_waitcnt vmcnt(" #n ")" ::: "memory")
#define PG8_WAIT_L(n) asm volatile("s_waitcnt lgkmcnt(" #n ")" ::: "memory")
#define PG8_BAR __builtin_amdgcn_s_barrier()
#define PG8_SCHED __builtin_amdgcn_sched_barrier(0)
    Unit cur, nxt; int ui = 0;
    if (!S.next(0, cur)) return;
    f32x4 acc[2][2][4][2];
#pragma unroll
    for (int a = 0; a < 2; ++a)
#pragma unroll
        for (int b = 0; b < 2; ++b)
#pragma unroll
            for (int m = 0; m < 4; ++m)
#pragma unroll
                for (int n = 0; n < 2; ++n) acc[a][b][m][n] = (f32x4){0.f, 0.f, 0.f, 0.f};
    bf16x8 At[4][2], B0[2][2], B1[2][2]; v8i_t At8[4], B08[2], B18[2];
    int one_scale = 0x7f7f7f7f; asm volatile("" : "+v"(one_scale));
    const char* cA = (const char*)g.A + (GATHER ? (size_t)0 : (size_t)cur.pm * tstep); const size_t estep = (size_t)g.N * K * 2; const char* cB = (const char*)g.Bt + (size_t)cur.e * estep + (size_t)cur.pn * tstep;
    S.a_ready(cur);
    if constexpr (GATHER) { PG8_ROWS_ISSUE(cur); PG8_ROWS_MAKE(vC); }
    if constexpr (SP2) {
        PG8_STAGE(PG8_SB(0, 0), cB, voffB); PG8_STAGE(PG8_SB(0, 1), cB + hstep, voffB); PG8_STAGE_A(PG8_SA(0, 0), cA, 0, false); PG8_STAGE_A(PG8_SA(0, 1), cA, 1, false);
        if (wr == 1) PG8_BAR;
        PG8_WAIT_V(2); PG8_BAR;
        PG8_STAGE(PG8_SB(1, 0), cB + kstep, voffB); PG8_STAGE_A(PG8_SA(1, 0), cA + kstep, 0, false); PG8_STAGE(PG8_SB(1, 1), cB + hstep + kstep, voffB);
        PG8_WAIT_V(6); PG8_BAR;
    } else {
        PG8_STAGE(PG8_SB(0, 0), cB, voffB); PG8_STAGE(PG8_SA(0, 0), cA, voffA); PG8_STAGE(PG8_SB(0, 1), cB + hstep, voffB); PG8_STAGE(PG8_SA(0, 1), cA + hstep, voffA);
        if (wr == 1) PG8_BAR;
        PG8_WAIT_V(4); PG8_BAR;
        PG8_STAGE(PG8_SB(1, 0), cB + kstep, voffB); PG8_STAGE(PG8_SA(1, 0), cA + kstep, voffA); PG8_STAGE(PG8_SB(1, 1), cB + hstep + kstep, voffB);
        PG8_WAIT_V(6); PG8_BAR;
    }
    for (;;) {
        const bool has_next = S.next(ui + 1, nxt);
        if constexpr (GATHER) { if (has_next) PG8_ROWS_ISSUE(nxt); }
        const char* nA = (has_next && !GATHER) ? (const char*)g.A + (size_t)nxt.pm * tstep : cA; const char* nB = has_next ? (const char*)g.Bt + (size_t)nxt.e * estep + (size_t)nxt.pn * tstep : cB;
        for (int t = 0; t < nt; t += 2) {
            const bool last = (t == nt - 2);
            const char* a1 = cA + (size_t)(t + 1) * kstep;
            const char* a2 = last ? nA : cA + (size_t)(t + 2) * kstep; const char* b2 = last ? nB : cB + (size_t)(t + 2) * kstep;
            const char* a3 = a2 + kstep; const char* b3 = b2 + kstep;
            if (last && has_next) S.a_ready(nxt);
            const bool nx = last && has_next; (void)nx;
            if constexpr (SP2) {
            PG8_LDB(B0, 0, 0); PG8_LDB(B1, 0, 1); PG8_SCHED; PG8_LDA(At, 0, 0); PG8_STAGE_A(PG8_SA(1, 1), a1, 1, false);
            PG8_WAIT_V(8); PG8_WAIT_L(0); PG8_BAR; PG8_MMA(0, 0, At, B0); PG8_MMA(0, 1, At, B1); PG8_BAR; PG8_SCHED;
            PG8_LDA(At, 0, 1); PG8_STAGE(PG8_SB(0, 0), b2, voffB); PG8_STAGE(PG8_SB(0, 1), b2 + hstep, voffB); PG8_STAGE_A(PG8_SA(0, 0), a2, 0, nx);
            PG8_WAIT_V(8); PG8_WAIT_L(0); PG8_BAR; PG8_MMA(1, 0, At, B0); PG8_MMA(1, 1, At, B1); PG8_BAR; PG8_SCHED;
            PG8_LDB(B0, 1, 0); PG8_LDB(B1, 1, 1); PG8_SCHED; PG8_LDA(At, 1, 0); PG8_STAGE_A(PG8_SA(0, 1), a2, 1, nx);
            PG8_WAIT_V(8); PG8_WAIT_L(0); PG8_BAR; PG8_MMA(0, 0, At, B0); PG8_MMA(0, 1, At, B1); PG8_BAR; PG8_SCHED;
            PG8_LDA(At, 1, 1); PG8_STAGE(PG8_SB(1, 0), b3, voffB); PG8_STAGE(PG8_SB(1, 1), b3 + hstep, voffB); PG8_STAGE_A(PG8_SA(1, 0), a3, 0, nx);
            PG8_WAIT_V(8); PG8_WAIT_L(0); PG8_BAR; PG8_MMA(1, 0, At, B0); PG8_MMA(1, 1, At, B1); PG8_BAR; PG8_SCHED;
            if constexpr (GATHER) { if (t == 0 && has_next) PG8_ROWS_MAKE(vN); }
            } else {
            PG8_LDB(B0, 0, 0); PG8_SCHED; PG8_LDA(At, 0, 0); PG8_STAGE(PG8_SA(1, 1), a1 + hstep, voffA);
            PG8_WAIT_L(8); PG8_BAR; PG8_WAIT_L(0); PG8_MMA(0, 0, At, B0); PG8_BAR; PG8_SCHED;
            PG8_LDB(B1, 0, 1); PG8_STAGE(PG8_SB(0, 0), b2, voffB);
            PG8_BAR; PG8_WAIT_L(0); PG8_MMA(0, 1, At, B1); PG8_BAR;
            PG8_LDA(At, 0, 1); PG8_STAGE(PG8_SA(0, 0), a2, voffA);
            PG8_BAR; PG8_WAIT_L(0); PG8_MMA(1, 0, At, B0); PG8_BAR; PG8_SCHED;
            PG8_STAGE(PG8_SB(0, 1), b2 + hstep, voffB);
            PG8_WAIT_V(6); PG8_BAR; PG8_MMA(1, 1, At, B1); PG8_BAR;
            PG8_LDB(B0, 1, 0); PG8_SCHED; PG8_LDA(At, 1, 0); PG8_STAGE(PG8_SA(0, 1), a2 + hstep, voffA);
            PG8_WAIT_L(8); PG8_BAR; PG8_WAIT_L(0); PG8_MMA(0, 0, At, B0); PG8_BAR; PG8_SCHED;
            PG8_LDB(B1, 1, 1); PG8_STAGE(PG8_SB(1, 0), b3, voffB);
            PG8_BAR; PG8_WAIT_L(0); PG8_MMA(0, 1, At, B1); PG8_BAR;
            PG8_LDA(At, 1, 1); PG8_STAGE(PG8_SA(1, 0), a3, voffA);
            PG8_BAR; PG8_WAIT_L(0); PG8_MMA(1, 0, At, B0); PG8_BAR; PG8_SCHED;
            PG8_STAGE(PG8_SB(1, 1), b3 + hstep, voffB);
            PG8_WAIT_V(6); PG8_BAR; PG8_MMA(1, 1, At, B1); PG8_BAR;
            }
        }
        if constexpr (ALIGN_EPI) { if (wr == 0) PG8_BAR; }
        if constexpr (FP8) asm volatile("s_nop 15\n\ts_nop 15" ::: "memory");
        if constexpr (!Epi::AFTER_DRAIN) { E(acc, cur, wr, wc, fr, fq); S.done(cur); }
        if (!has_next) break;
#pragma unroll
        for (int a = 0; a < 2; ++a)
#pragma unroll
            for (int b = 0; b < 2; ++b)
#pragma unroll
                for (int m = 0; m < 4; ++m)
#pragma unroll
                    for (int n = 0; n < 2; ++n) acc[a][b][m][n] = (f32x4){0.f, 0.f, 0.f, 0.f};
        cur = nxt; cA = nA; cB = nB; ++ui;
        if constexpr (GATHER) {
#pragma unroll
            for (int _h = 0; _h < 2; ++_h)
#pragma unroll
                for (int _i = 0; _i < 2; ++_i) vC[_h][_i] = vN[_h][_i]; }
        if constexpr (ALIGN_EPI) { if (wr == 1) PG8_BAR; }
    }
    PG8_WAIT_V(0);
    if constexpr (!ALIGN_EPI) { if (wr == 0) PG8_BAR; }
    PG8_BAR;
    if constexpr (Epi::AFTER_DRAIN) { E.fused(acc, cur, wr, wc, fr, fq, lds, wid, lane); S.done(cur); }
#undef PG8_SA
#undef PG8_SB
#undef PG8_STAGE
#undef PG8_STAGE_A
#undef PG8_ROWS_ISSUE
#undef PG8_ROWS_MAKE
#undef PG8_LDA
#undef PG8_LDB
#undef PG8_MMA
#undef PG8_MMA8
#undef PG8_MMA16
#undef PG8_CAT
#undef PG8_WAIT_V
#undef PG8_WAIT_L
#undef PG8_BAR
#undef PG8_SCHED
}
}
namespace pg8 {
__device__ __forceinline__ float ep_bflo(unsigned w) { return __uint_as_float(w << 16); }
__device__ __forceinline__ float ep_bfhi(unsigned w) { return __uint_as_float(w & 0xffff0000u); }
__device__ __forceinline__ float ep_sig(float x) { return __builtin_amdgcn_rcpf(1.f + __builtin_amdgcn_exp2f(-1.4426950408889634f * x)); }
__device__ __forceinline__ void ep_unpack8(u32x4 w, f32x4& a, f32x4& b) { a = (f32x4){ep_bflo(w.x), ep_bfhi(w.x), ep_bflo(w.y), ep_bfhi(w.y)}; b = (f32x4){ep_bflo(w.z), ep_bfhi(w.z), ep_bflo(w.w), ep_bfhi(w.w)}; }
__device__ __forceinline__ u32x4 ep_pack8(f32x4 a, f32x4 b) { u32x4 w; w.x = cvt_pk_bf16(a[0], a[1]); w.y = cvt_pk_bf16(a[2], a[3]); w.z = cvt_pk_bf16(b[0], b[1]); w.w = cvt_pk_bf16(b[2], b[3]); return w; }
__device__ __forceinline__ f32x4 ep_sig4(f32x4 v) { return (f32x4){ep_sig(v[0]), ep_sig(v[1]), ep_sig(v[2]), ep_sig(v[3])}; }
#define EPI_LOOP_BEGIN const int row0 = u.pm * BM + wr * 64 + fr, col0 = u.pn * BM + wc * 32 + 8 * fq; \
    _Pragma("unroll") for (int ai = 0; ai < 2; ++ai) _Pragma("unroll") for (int m = 0; m < 4; ++m) { const int row = row0 + ai * HALF + m * 16; \
    _Pragma("unroll") for (int bj = 0; bj < 2; ++bj) { const int col = col0 + bj * HALF; const f32x4 v0 = acc[ai][bj][m][0], v1 = acc[ai][bj][m][1];
#define EPI_LOOP_END } }

struct EpiBf16S {
    static constexpr bool PERM = true, AFTER_DRAIN = false;
    bf16_t* O; int ldc; float s;
#ifdef PROBE_EXTRA_ST
    bf16_t* X;
#endif
    __device__ __forceinline__ void operator()(const f32x4 (&acc)[2][2][4][2], const Unit& u, int wr, int wc, int fr, int fq) const {
#ifdef PROBE_EXTRA_ST
        const int xw = wr * 4 + wc, xl = fq * 16 + fr;
#endif
        EPI_LOOP_BEGIN
            *(u32x4*)(O + (size_t)row * ldc + col) = ep_pack8(v0 * s, v1 * s);
#ifdef PROBE_EXTRA_ST
#if PROBE_EXTRA_ST == 1
            *(u32x4*)(X + (size_t)(row - u.pm * BM) * 256 + (col - u.pn * BM)) = ep_pack8(v0 * s, v1 * s);
#else
            *(u32x4*)(X + (size_t)xw * 8192 + (size_t)((ai * 4 + m) * 2 + bj) * 512 + xl * 8) = ep_pack8(v0 * s, v1 * s);
#endif
#endif
        EPI_LOOP_END
    }
};
struct EpiNull {
    static constexpr bool PERM = true, AFTER_DRAIN = false;
    bf16_t* O;
    __device__ __forceinline__ void operator()(const f32x4 (&acc)[2][2][4][2], const Unit& u, int wr, int wc, int fr, int fq) const {
        float s = 0.f;
        EPI_LOOP_BEGIN
            s += v0[0] + v1[3];
        EPI_LOOP_END
        if (s == 123456.789f) O[0] = 0;
    }
};
struct EpiTile {
    static constexpr bool PERM = true, AFTER_DRAIN = false;
    bf16_t* O; float s;
    __device__ __forceinline__ void operator()(const f32x4 (&acc)[2][2][4][2], const Unit& u, int wr, int wc, int fr, int fq) const {
        bf16_t* base = O + (size_t)(u.pm * 46 + u.pn) * 65536;
        EPI_LOOP_BEGIN
            { const u32x4 pk_ = ep_pack8(v0 * s, v1 * s);
#if PROBE_TILE_EPI == 2
              if (m == 0) *(u32x4*)(base + (size_t)(row - u.pm * BM) * 256 + (col - u.pn * BM)) = pk_; else asm volatile("" :: "v"(pk_));
#else
              *(u32x4*)(base + (size_t)(row - u.pm * BM) * 256 + (col - u.pn * BM)) = pk_;
#endif
            }
        EPI_LOOP_END
    }
};
struct EpiLora1 {
    static constexpr bool PERM = true, AFTER_DRAIN = false;
    float* logw; bf16_t* a; const float* w0; const float* a0;
    __device__ __forceinline__ void operator()(const f32x4 (&acc)[2][2][4][2], const Unit& u, int wr, int wc, int fr, int fq) const {
        EPI_LOOP_BEGIN
            if (u.pn < 4) { const f32x4 b0 = *(const f32x4*)(w0 + col), b1 = *(const f32x4*)(w0 + col + 4);
                float* o = logw + (size_t)row * 1024 + col; *(f32x4*)o = ep_sig4(v0 + b0) * (-0.6065306597126334f); *(f32x4*)(o + 4) = ep_sig4(v1 + b1) * (-0.6065306597126334f); }
            else { const int c = col - 1024; const f32x4 b0 = *(const f32x4*)(a0 + c), b1 = *(const f32x4*)(a0 + c + 4);
                *(u32x4*)(a + (size_t)row * 1024 + c) = ep_pack8(ep_sig4(v0 + b0), ep_sig4(v1 + b1)); }
        EPI_LOOP_END
    }
};
template <int SECOND> struct EpiGateMerge {
    static constexpr bool PERM = true, AFTER_DRAIN = false;
    bf16_t* mrg; const bf16_t* P; int gcol; unsigned char* mrg8;
    __device__ __forceinline__ void operator()(const f32x4 (&acc)[2][2][4][2], const Unit& u, int wr, int wc, int fr, int fq) const {
        const int row0 = u.pm * BM + wr * 64 + fr, col0 = u.pn * BM + wc * 32 + 8 * fq;
#pragma unroll
        for (int bj = 0; bj < 2; ++bj) { const int col = col0 + bj * HALF;
#pragma unroll
            for (int ai = 0; ai < 2; ++ai) { u32x4 gw[4], tw[4];
#pragma unroll
                for (int m = 0; m < 4; ++m) { const int row = row0 + ai * HALF + m * 16; gw[m] = *(const u32x4*)(P + (size_t)row * 11776 + gcol + col); if (SECOND) tw[m] = *(const u32x4*)(mrg + (size_t)row * 2048 + col); }
#pragma unroll
                for (int m = 0; m < 4; ++m) { const int row = row0 + ai * HALF + m * 16; f32x4 g0, g1; ep_unpack8(gw[m], g0, g1);
                    f32x4 r0 = ep_sig4(g0) * acc[ai][bj][m][0], r1 = ep_sig4(g1) * acc[ai][bj][m][1];
                    if (SECOND) { f32x4 t0, t1; ep_unpack8(tw[m], t0, t1); r0 = r0 + t0; r1 = r1 + t1; }
                    if (SECOND && OUTPROJ_FP8) { r0 = r0 * FP8_SM; r1 = r1 * FP8_SM; typedef unsigned u32x2e __attribute__((ext_vector_type(2))); u32x2e o;
                        { int q = __builtin_amdgcn_cvt_pk_fp8_f32(r0[0], r0[1], 0, false); q = __builtin_amdgcn_cvt_pk_fp8_f32(r0[2], r0[3], q, true); o.x = (unsigned)q; }
                        { int q = __builtin_amdgcn_cvt_pk_fp8_f32(r1[0], r1[1], 0, false); q = __builtin_amdgcn_cvt_pk_fp8_f32(r1[2], r1[3], q, true); o.y = (unsigned)q; }
                        *(u32x2e*)(mrg8 + (size_t)row * 2048 + col) = o; }
                    else *(u32x4*)(mrg + (size_t)row * 2048 + col) = ep_pack8(r0, r1); }
                asm volatile("" ::: "memory"); } }
    }
};
struct EpiResid {
    static constexpr bool PERM = true, AFTER_DRAIN = false;
    const float* x; float* x1; const float* mod; float* ssp; float s;
    __device__ __forceinline__ void operator()(const f32x4 (&acc)[2][2][4][2], const Unit& u, int wr, int wc, int fr, int fq) const {
        const float* gt = mod + (size_t)((u.pm * BM) / 16384) * 12288 + 4096;
        const int row0 = u.pm * BM + wr * 64 + fr, col0 = u.pn * BM + wc * 32 + 8 * fq;
        float ss[2][4] = {{0.f, 0.f, 0.f, 0.f}, {0.f, 0.f, 0.f, 0.f}};
#pragma unroll
        for (int bj = 0; bj < 2; ++bj) { const int col = col0 + bj * HALF; const f32x4 g0 = *(const f32x4*)(gt + col) * s, g1 = *(const f32x4*)(gt + col + 4) * s;
#pragma unroll
            for (int ai = 0; ai < 2; ++ai) { f32x4 xa[4], xb[4];
#pragma unroll
                for (int m = 0; m < 4; ++m) { const size_t off = (size_t)(row0 + ai * HALF + m * 16) * 2048 + col; xa[m] = *(const f32x4*)(x + off); xb[m] = *(const f32x4*)(x + off + 4); }
#pragma unroll
                for (int m = 0; m < 4; ++m) { const size_t off = (size_t)(row0 + ai * HALF + m * 16) * 2048 + col; const f32x4 ya = xa[m] + g0 * acc[ai][bj][m][0], yb = xb[m] + g1 * acc[ai][bj][m][1];
                    *(f32x4*)(x1 + off) = ya; *(f32x4*)(x1 + off + 4) = yb;
                    ss[ai][m] += ((ya[0] * ya[0] + ya[1] * ya[1]) + (ya[2] * ya[2] + ya[3] * ya[3])) + ((yb[0] * yb[0] + yb[1] * yb[1]) + (yb[2] * yb[2] + yb[3] * yb[3])); }
                asm volatile("" ::: "memory"); } }
        float* sp = ssp + (size_t)(u.pn * 4 + wc) * 32768;
#pragma unroll
        for (int ai = 0; ai < 2; ++ai)
#pragma unroll
            for (int m = 0; m < 4; ++m) { float s = ss[ai][m]; s += __shfl_xor(s, 16); s += __shfl_xor(s, 32); if (fq == 0) sp[row0 + ai * HALF + m * 16] = s; }
    }
};
struct EpiSwiglu {
    static constexpr bool PERM = true, AFTER_DRAIN = false;
    unsigned char* act; const float* bias;
    __device__ __forceinline__ void operator()(const f32x4 (&acc)[2][2][4][2], const Unit& u, int wr, int wc, int fr, int fq) const {
        const int row0 = u.pm * BM + wr * 64 + fr, gcol = u.pn * 128 + wc * 32 + 8 * fq;
        const float* bg = bias + (size_t)u.e * 4096 + gcol; const float* bl = bg + 2048;
        const f32x4 bg0 = *(const f32x4*)bg, bg1 = *(const f32x4*)(bg + 4), bl0 = *(const f32x4*)bl, bl1 = *(const f32x4*)(bl + 4);
#pragma unroll
        for (int ai = 0; ai < 2; ++ai)
#pragma unroll
            for (int m = 0; m < 4; ++m) { const int row = row0 + ai * HALF + m * 16;
                f32x4 g0 = acc[ai][0][m][0] * (1.f / 128.f) + bg0, g1 = acc[ai][0][m][1] * (1.f / 128.f) + bg1, l0 = acc[ai][1][m][0] * (1.f / 128.f) + bl0, l1 = acc[ai][1][m][1] * (1.f / 128.f) + bl1, r0, r1;
#pragma unroll
                for (int i = 0; i < 4; ++i) { const float a = fminf(g0[i], 7.f), b = fminf(g1[i], 7.f);
                    r0[i] = a * ep_sig(1.702f * a) * (fminf(fmaxf(l0[i], -7.f), 7.f) + 1.f); r1[i] = b * ep_sig(1.702f * b) * (fminf(fmaxf(l1[i], -7.f), 7.f) + 1.f); }
                r0 = r0 * 4.f; r1 = r1 * 4.f; typedef unsigned u32x2e __attribute__((ext_vector_type(2))); u32x2e o;
                { int w = __builtin_amdgcn_cvt_pk_fp8_f32(r0[0], r0[1], 0, false); w = __builtin_amdgcn_cvt_pk_fp8_f32(r0[2], r0[3], w, true); o.x = (unsigned)w; }
                { int w = __builtin_amdgcn_cvt_pk_fp8_f32(r1[0], r1[1], 0, false); w = __builtin_amdgcn_cvt_pk_fp8_f32(r1[2], r1[3], w, true); o.y = (unsigned)w; }
                *(u32x2e*)(act + (size_t)row * 2048 + gcol) = o; }
    }
};
struct EpiDown {
    static constexpr bool PERM = true, AFTER_DRAIN = false;
    unsigned char* ys; const float* bias; const float* slot_w;
    __device__ __forceinline__ void operator()(const f32x4 (&acc)[2][2][4][2], const Unit& u, int wr, int wc, int fr, int fq) const {
        const float* be = bias + (size_t)u.e * 2048; const int row0 = u.pm * BM + wr * 64 + fr, col0 = u.pn * BM + wc * 64 + 16 * fq;
        float w[2][4]; f32x4 b[2][2];
#pragma unroll
        for (int ai = 0; ai < 2; ++ai)
#pragma unroll
            for (int m = 0; m < 4; ++m) w[ai][m] = slot_w[row0 + ai * HALF + m * 16] * FP8_SY;
#pragma unroll
        for (int bj = 0; bj < 2; ++bj) { b[bj][0] = *(const f32x4*)(be + col0 + 8 * bj); b[bj][1] = *(const f32x4*)(be + col0 + 8 * bj + 4); }
#pragma unroll
        for (int ai = 0; ai < 2; ++ai)
#pragma unroll
            for (int m = 0; m < 4; ++m) { const int row = row0 + ai * HALF + m * 16; u32x4 o; unsigned q[4];
#pragma unroll
                for (int bj = 0; bj < 2; ++bj)
#pragma unroll
                    for (int n = 0; n < 2; ++n) { const f32x4 r = (acc[ai][bj][m][n] * (1.f / 256.f) + b[bj][n]) * w[ai][m];
                        int p = __builtin_amdgcn_cvt_pk_fp8_f32(r[0], r[1], 0, false); p = __builtin_amdgcn_cvt_pk_fp8_f32(r[2], r[3], p, true); q[2 * bj + n] = (unsigned)p; }
                o.x = q[0]; o.y = q[1]; o.z = q[2]; o.w = q[3];
                *(u32x4*)(ys + (size_t)row * 2048 + col0) = o; }
    }
};
struct MoeOrder : StaticOrder {
    const int* tile_e;
    __device__ bool next(int i, Unit& u) const { if (!StaticOrder::next(i, u)) return false; u.e = tile_e[u.pm]; return true; }
};
}
namespace fox {
enum { ORDER_NATURAL = 0, ORDER_REVERSED = 1, ORDER_PAIRED = 2, ORDER_XCD = 4 };
using TIN = __hip_bfloat16; using TOUT = __hip_bfloat16;
constexpr int B = 2, H = 8, HKV = 8, SQ = 16384, SKV = 16384, D = 128;
constexpr int PITCH = 1024;
constexpr int GPITCH = 11776;
constexpr int QOFF = 0;
constexpr int WINDOW = SKV;
constexpr float THR = 8.f;
constexpr int ORDER = ORDER_PAIRED;
constexpr bool WSKIP = false;
constexpr float SCALE = 0.08838834764831845f;
constexpr int NW = 8, QBLK = 32, KVBLK = 64, QB = NW * QBLK;
constexpr int SHM_V = KVBLK * D * 2, SHM_K = KVBLK * D * 2;
constexpr int LDS_CB = 2 * SHM_V + 2 * SHM_K + NW * 64 * 4;
constexpr int LDS_GATE = LDS_CB + 3 * 64 * 4 + 256;
constexpr int LDS_BYTES = LDS_GATE + NW * 8192;
static_assert(D == 128 && SQ % QB == 0 && SKV % KVBLK == 0 && H % HKV == 0 && QOFF >= 0 && QOFF + SQ <= SKV && WINDOW >= 1, "geometry");

using bf16 = __hip_bfloat16;
typedef short bf16x8 __attribute__((ext_vector_type(8)));
typedef short s16x4 __attribute__((ext_vector_type(4)));
typedef float f32x16 __attribute__((ext_vector_type(16)));
typedef float f32x4 __attribute__((ext_vector_type(4)));
typedef unsigned u32x4 __attribute__((ext_vector_type(4)));
template <class A, class Bt> struct same_t { static constexpr bool v = false; };
template <class A> struct same_t<A, A> { static constexpr bool v = true; };

#define KSWZ(row, colB) ((row) * 256 + ((colB) ^ (((row) & 7) << 4)))
#define SBAR() __builtin_amdgcn_sched_barrier(0)
__device__ __forceinline__ int v_st(int k, int c) { const int kk = (k & ~0xC) | ((k & 4) << 1) | ((k & 8) >> 1); return ((kk >> 3) * 4 + (c >> 5)) * 512 + ((kk & 7) * 32 + (c & 31)) * 2; }
__device__ __forceinline__ int v_rd_base(int lane) { return ((lane & 3) << 3) | (((lane >> 2) & 3) << 6) | (((lane >> 4) & 1) << 5) | (((lane >> 5) & 1) << 8); }
constexpr int v_rd_off(int d0, int ks, int half) { return d0 * 512 + ks * 4096 + half * 2048; }
__device__ __forceinline__ int crow(int r, int hi) { return (r & 3) + 8 * (r >> 2) + 4 * hi; }
__device__ __forceinline__ unsigned cvtpk(float lo, float hi) {
    unsigned r; asm volatile("v_cvt_pk_bf16_f32 %0, %1, %2" : "=v"(r) : "v"(lo), "v"(hi)); return r;
}
__device__ __forceinline__ bf16x8 pack8(f32x4 a, f32x4 b) {
    u32x4 w = {cvtpk(a[0], a[1]), cvtpk(a[2], a[3]), cvtpk(b[0], b[1]), cvtpk(b[2], b[3])};
    return *reinterpret_cast<bf16x8*>(&w);
}
template <class T> __device__ __forceinline__ bf16x8 load8(const T* p) {
    if constexpr (same_t<T, float>::v) { return pack8(*(const f32x4*)p, *(const f32x4*)(p + 4)); }
    else { return *reinterpret_cast<const bf16x8*>(p); }
}
__device__ __forceinline__ void mask_tile(f32x16& p0, f32x16& p1, int dq, unsigned W) {
    const float NEG = -__builtin_inff();
#pragma unroll
    for (int r = 0; r < 16; ++r) {
        const int c = (r & 3) + 8 * (r >> 2);
        if ((unsigned)(dq - c) >= W) p0[r] = NEG;
        if ((unsigned)(dq - c - 32) >= W) p1[r] = NEG;
    }
}
__device__ __forceinline__ void partialSM(f32x16& p0, f32x16& p1, float& m_reg, float& mn, float& alpha) {
    float pmax = p0[0]; for (int r = 1; r < 16; ++r) pmax = fmaxf(pmax, p0[r]); for (int r = 0; r < 16; ++r) pmax = fmaxf(pmax, p1[r]);
    { auto rr = __builtin_amdgcn_permlane32_swap(__float_as_uint(pmax), __float_as_uint(pmax), false, false);
      pmax = fmaxf(__uint_as_float(rr[0]), __uint_as_float(rr[1])); }
    constexpr float C2 = 1.4426950408889634f * SCALE;
    if (__builtin_expect(__all((pmax - m_reg) * SCALE <= THR), 1)) { mn = m_reg; alpha = 1.f; }
    else { mn = fmaxf(m_reg, pmax); alpha = __builtin_amdgcn_exp2f((m_reg - mn) * C2); m_reg = mn; }
    const float mnL = -mn * C2;
    for (int r = 0; r < 16; ++r) p0[r] = fmaf(p0[r], C2, mnL); for (int r = 0; r < 16; ++r) p1[r] = fmaf(p1[r], C2, mnL);
    for (int r = 0; r < 16; ++r) p0[r] = __builtin_amdgcn_exp2f(p0[r]);
}
__device__ __forceinline__ void finishSM(f32x16& p0, f32x16& p1, float alpha, float& l_reg, bf16x8& pa0, bf16x8& pa1, bf16x8& pa2, bf16x8& pa3) {
    for (int r = 0; r < 16; ++r) p1[r] = __builtin_amdgcn_exp2f(p1[r]);
    float ps = 0; for (int r = 0; r < 16; ++r) ps += p0[r]; for (int r = 0; r < 16; ++r) ps += p1[r];
    { auto rr = __builtin_amdgcn_permlane32_swap(__float_as_uint(ps), __float_as_uint(ps), false, false);
      ps = __uint_as_float(rr[0]) + __uint_as_float(rr[1]); }
    l_reg = l_reg * alpha + ps;
#define PK4(P, B_, OUT) do { unsigned a0 = cvtpk(P[B_+0], P[B_+1]), a1 = cvtpk(P[B_+2], P[B_+3]);                          \
        unsigned b0 = cvtpk(P[B_+4], P[B_+5]), b1 = cvtpk(P[B_+6], P[B_+7]);                                             \
        auto r0 = __builtin_amdgcn_permlane32_swap(a0, b0, false, false); auto r1 = __builtin_amdgcn_permlane32_swap(a1, b1, false, false); \
        u32x4 w = {r0[0], r1[0], r0[1], r1[1]}; OUT = *reinterpret_cast<bf16x8*>(&w); } while (0)
    PK4(p0, 0, pa0); PK4(p0, 8, pa1); PK4(p1, 0, pa2); PK4(p1, 8, pa3);
#undef PK4
}
template <int KB, bool SK>
__device__ __forceinline__ void qkt(f32x16& p0, f32x16& p1, const char* K_lds, int r32, int hi, const bf16x8* qr, bool act, int cbi) {
    if (SK && !act) { const float NEG = -__builtin_inff();
#pragma unroll
        for (int r = 0; r < 16; ++r) { p0[r] = NEG; p1[r] = NEG; } return; }
    { const float* cb_ = (const float*)(K_lds + 2 * SHM_K + NW * 64 * 4) + cbi * 64 + 4 * hi;
#pragma unroll
      for (int g_ = 0; g_ < 4; ++g_) { const f32x4 b0_ = *(const f32x4*)(cb_ + 8 * g_), b1_ = *(const f32x4*)(cb_ + 32 + 8 * g_);
#pragma unroll
          for (int i_ = 0; i_ < 4; ++i_) { p0[4 * g_ + i_] = b0_[i_]; p1[4 * g_ + i_] = b1_[i_]; } } }
    const char* kb[4];
#pragma unroll
    for (int dd = 0; dd < 4; ++dd) kb[dd] = K_lds + KB * SHM_K + KSWZ(r32, (dd * 16 + hi * 8) * 2);
#pragma unroll
    for (int d0 = 0; d0 < 8; ++d0) { const char* a = kb[d0 & 3] + (d0 >> 2) * 128;
        bf16x8 b0 = *reinterpret_cast<const bf16x8*>(a);
        bf16x8 b1 = *reinterpret_cast<const bf16x8*>(a + 32 * 256);
        p0 = __builtin_amdgcn_mfma_f32_32x32x16_bf16(b0, qr[d0], p0, 0, 0, 0);
        p1 = __builtin_amdgcn_mfma_f32_32x32x16_bf16(b1, qr[d0], p1, 0, 0, 0); }
}
template <int VB, bool SK>
__device__ __forceinline__ void pv_tile(f32x16* o, int vb0, bf16x8 pa0, bf16x8 pa1, bf16x8 pa2, bf16x8 pa3, bool act) {
    if (SK && !act) return;
#define TRRD(dst, off) asm volatile("ds_read_b64_tr_b16 %0, %1 offset:%2" : "=&v"(dst) : "v"(vb0), "i"(off) : "memory")
#define PV_D0(d0) do { s16x4 l0, l1, l2, l3, h0, h1, h2, h3; constexpr int b_ = VB * SHM_V + v_rd_off(d0, 0, 0);     \
        TRRD(l0, b_); TRRD(h0, b_ + 2048); TRRD(l1, b_ + 4096); TRRD(h1, b_ + 6144); TRRD(l2, b_ + 8192); TRRD(h2, b_ + 10240); TRRD(l3, b_ + 12288); TRRD(h3, b_ + 14336); \
        asm volatile("s_waitcnt lgkmcnt(0)" ::: "memory"); SBAR();                 \
        o[d0] = __builtin_amdgcn_mfma_f32_32x32x16_bf16(pa0, (bf16x8){l0[0], l0[1], l0[2], l0[3], h0[0], h0[1], h0[2], h0[3]}, o[d0], 0, 0, 0);   \
        o[d0] = __builtin_amdgcn_mfma_f32_32x32x16_bf16(pa1, (bf16x8){l1[0], l1[1], l1[2], l1[3], h1[0], h1[1], h1[2], h1[3]}, o[d0], 0, 0, 0);   \
        o[d0] = __builtin_amdgcn_mfma_f32_32x32x16_bf16(pa2, (bf16x8){l2[0], l2[1], l2[2], l2[3], h2[0], h2[1], h2[2], h2[3]}, o[d0], 0, 0, 0);   \
        o[d0] = __builtin_amdgcn_mfma_f32_32x32x16_bf16(pa3, (bf16x8){l3[0], l3[1], l3[2], l3[3], h3[0], h3[1], h3[2], h3[3]}, o[d0], 0, 0, 0); } while (0)
    PV_D0(0); PV_D0(1); PV_D0(2); PV_D0(3);
#undef PV_D0
#undef TRRD
}

template <class TIn, class TOut> struct BlockRef { const unsigned char* ws; int row0, bh, P0, jlo;
    __device__ __forceinline__ const TIn* Q() const { return (const TIn*)(ws + WS_FQ) + (size_t)row0 * PITCH + (bh % H) * D; }
    __device__ __forceinline__ const TIn* K() const { return (const TIn*)(ws + WS_FK) + (size_t)(bh / H) * SQ * PITCH + (bh % H) * D; }
    __device__ __forceinline__ const TIn* V() const { return (const TIn*)(ws + WS_P) + (size_t)(bh / H) * SQ * GPITCH + PC_FV + (bh % H) * D; }
    __device__ __forceinline__ TOut* O() const { return (TOut*)(ws + WS_YB) + (size_t)row0 * PITCH + (bh % H) * D; }
    __device__ __forceinline__ const float* C() const { return (const float*)(ws + WS_CS) + (size_t)bh * SQ; }
    __device__ __forceinline__ const TIn* G() const { return (const TIn*)(ws + WS_P) + (size_t)row0 * GPITCH + PC_OG + (bh % H) * D; }
};
template <class TIn> struct Seam {
    bf16x8 qr[8];
    bf16x8 st_v0, st_v1, st_k0, st_k1; int cbi; f32x4 sf0, sf1, sf2, sf3;
    f32x4 tq[16];
};
__device__ __forceinline__ int swa_jlo(int P0, int W) { const int lowk = P0 - W + 1; return lowk > 0 ? lowk / KVBLK : 0; }
#define ROW(p, k0, rr) ((p) + (size_t)((k0) + (rr)) * PITCH + sc)
#define ROWV(p, k0, rr) ((p) + (size_t)((k0) + (rr)) * GPITCH + sc)
#define VMW() asm volatile("s_waitcnt vmcnt(0)" ::: "memory")
#define VMWN(n) asm volatile("s_waitcnt vmcnt(%0)" :: "i"(n) : "memory")
#define NEXT3(x) ((x) == 2 ? 0 : (x) + 1)
#define SLOAD_H(Kp, Vp, Cp, k0, CI) do { S.st_v0 = load8<TIn>(ROWV(Vp, k0, sr)); S.st_v1 = load8<TIn>(ROWV(Vp, k0, 32 + sr));              \
                         S.st_k0 = load8<TIn>(ROW(Kp, k0, sr)); S.st_k1 = load8<TIn>(ROW(Kp, k0, 32 + sr));                 \
                         if (wid == 0) __builtin_amdgcn_global_load_lds((const unsigned*)((Cp) + (k0) + lane), (__attribute__((address_space(3))) unsigned*)(lds + LDS_CB + (CI) * 256), 4, 0, 0); } while (0)
#define SWRITE_HK(bf) do { *(bf16x8*)(K_lds + (bf) * SHM_K + kws) = S.st_k0; *(bf16x8*)(K_lds + (bf) * SHM_K + kws + 32 * 256) = S.st_k1; } while (0)
#define SWRITE_HV(bf) do { *(bf16x8*)(V_lds + (bf) * SHM_V + vst0) = S.st_v0; *(bf16x8*)(V_lds + (bf) * SHM_V + vst1) = S.st_v1; } while (0)
#define SWRITE_H(bf) do { SWRITE_HV(bf); SWRITE_HK(bf); } while (0)
#define SLOAD_F(p, k0) do { S.sf0 = *(const f32x4*)ROW(p, k0, sr); S.sf1 = *(const f32x4*)(ROW(p, k0, sr) + 4);                \
                            S.sf2 = *(const f32x4*)ROW(p, k0, 32 + sr); S.sf3 = *(const f32x4*)(ROW(p, k0, 32 + sr) + 4); } while (0)
#define SWRITE_KF(bf) do { *(bf16x8*)(K_lds + (bf) * SHM_K + kws) = pack8(S.sf0, S.sf1); *(bf16x8*)(K_lds + (bf) * SHM_K + kws + 32 * 256) = pack8(S.sf2, S.sf3); } while (0)
#define SWRITE_VF(bf) do { *(bf16x8*)(V_lds + (bf) * SHM_V + vst0) = pack8(S.sf0, S.sf1); *(bf16x8*)(V_lds + (bf) * SHM_V + vst1) = pack8(S.sf2, S.sf3); } while (0)
template <class TIn, class TOut>
__device__ __forceinline__ void causal_swa_prime(const BlockRef<TIn, TOut>& cur, int W, char* lds, Seam<TIn>& S, const int tid) {
    constexpr bool F32 = same_t<TIn, float>::v;
    const int wid = __builtin_amdgcn_readfirstlane(tid >> 6), lane = tid & 63, r32 = lane & 31, hi = lane >> 5;
    const int sr = tid >> 4, sc = (tid & 15) * 8, kws = KSWZ(sr, sc * 2); char* K_lds = lds + 2 * SHM_V;
    const int kb0 = cur.jlo * KVBLK;
    for (int d0 = 0; d0 < 8; ++d0) S.qr[d0] = load8<TIn>(cur.Q() + (size_t)(wid * QBLK + r32) * PITCH + d0 * 16 + hi * 8);
    if constexpr (F32) { SLOAD_F((const float*)cur.K(), kb0); VMW(); SWRITE_KF(0); SBAR(); SLOAD_F((const float*)cur.V(), kb0); }
    else { S.cbi = 0; SLOAD_H(cur.K(), cur.V(), cur.C(), kb0, 0); VMW(); SWRITE_HK(0); }
    __syncthreads();
}
template <class TIn, class TOut>
__device__ __forceinline__ void causal_swa_block(const BlockRef<TIn, TOut>& cur, const BlockRef<TIn, TOut>& nxt, int skv, int W, char* lds, Seam<TIn>& S, const int tid) {
    constexpr bool F32 = same_t<TIn, float>::v;
    const int wid = __builtin_amdgcn_readfirstlane(tid >> 6), lane = tid & 63, r32 = lane & 31, hi = lane >> 5;
    const int j_lo = cur.jlo;
    int j_hi = (cur.P0 + QB - 1) / KVBLK + 1; if (j_hi > skv / KVBLK) j_hi = skv / KVBLK;
    const int NT = j_hi - j_lo;
    const int kbn = nxt.jlo * KVBLK;
    const int qlo = cur.P0 + wid * QBLK, qm = qlo + r32 - 4 * hi;
    char* V_lds = lds; char* K_lds = lds + 2 * SHM_V;
    float* ws = (float*)(lds + 2 * SHM_V + 2 * SHM_K) + wid * 64; float* li_l = ws, * al_l = ws + 32;
    float m_reg = -1e30f, l_reg = 0; f32x16 o[4] = {};
    const int sr = tid >> 4, sc = (tid & 15) * 8, vst0 = v_st(sr, sc), vst1 = v_st(32 + sr, sc), kws = KSWZ(sr, sc * 2);
    const int vb0 = (int)(uintptr_t)V_lds + v_rd_base(lane);
    const TIn* Kh = cur.K(); const TIn* Vh = cur.V(); const float* Ch = cur.C(); int cb_t = S.cbi;
    {
        const TIn* gsrc = cur.G() + (size_t)(wid * QBLK + (lane >> 4)) * GPITCH + (lane & 15) * 8;
#pragma unroll
        for (int i_ = 0; i_ < 8; ++i_) __builtin_amdgcn_global_load_lds((const unsigned*)(gsrc + (size_t)(4 * i_) * GPITCH), (__attribute__((address_space(3))) unsigned*)(lds + LDS_GATE + wid * 8192 + i_ * 1024), 16, 0, 0); }
#define RESC(a) do { if (__any((a) < 1.f)) { if (hi == 0) al_l[r32] = (a); asm volatile("s_waitcnt lgkmcnt(0)" ::: "memory");              \
                     for (int d_ = 0; d_ < 4; ++d_) for (int r = 0; r < 16; ++r) o[d_][r] *= al_l[crow(r, hi)]; } } while (0)
#define KBASE(t) ((j_lo + (t)) * KVBLK)
#define ACT(t) (KBASE(t) <= qlo + QBLK - 1 && KBASE(t) + KVBLK - 1 >= qlo - W + 1)
#define MASKT(P0_, P1_, t) do { const int kb_ = KBASE(t); if ((!SK || ACT(t)) && (kb_ + KVBLK - 1 > qlo || kb_ <= qlo + QBLK - 1 - W)) mask_tile(P0_, P1_, qm - kb_, (unsigned)W); } while (0)
    constexpr int NQL = F32 ? 16 : 8;
    constexpr bool SK = WSKIP && !F32;
#define SEAM_K0() do { VMWN(NQL); if constexpr (F32) { SWRITE_KF(0); SBAR(); SLOAD_F((const float*)nxt.V(), kbn); } else { SWRITE_HK(0); } SBAR(); } while (0)
    f32x16 pA0, pA1, pB0, pB1; float mnA, mnB, alA, alB; bf16x8 pa0, pa1, pa2, pa3;
    if constexpr (F32) { VMW(); SWRITE_VF(0); SBAR(); } else { SWRITE_HV(0); SBAR(); }
    if (NT > 1) { if constexpr (F32) SLOAD_F((const float*)Kh, KBASE(1)); else SLOAD_H(Kh, Vh, Ch, KBASE(1), NEXT3(cb_t)); }
    SBAR(); qkt<0, SK>(pA0, pA1, K_lds, r32, hi, S.qr, ACT(0), cb_t);
    if constexpr (F32) { if (NT > 1) { VMW(); SWRITE_KF(1); SBAR(); SLOAD_F((const float*)Vh, KBASE(1)); } }
    MASKT(pA0, pA1, 0); partialSM(pA0, pA1, m_reg, mnA, alA);
    if (NT > 1) { VMW(); if constexpr (F32) { SWRITE_VF(1); SBAR(); if (NT > 2) SLOAD_F((const float*)Kh, KBASE(2)); } else SWRITE_H(1); }
    __syncthreads();
#define HALF_STEP(PX0, PX1, mnX, alX, PY0, PY1, alY, t, KB, VB, SB) do {                                                      \
        SBAR(); cb_t = NEXT3(cb_t); qkt<KB, SK>(PX0, PX1, K_lds, r32, hi, S.qr, ACT(t), cb_t);                                             \
        finishSM(PY0, PY1, alY, l_reg, pa0, pa1, pa2, pa3); SBAR();                                                           \
        if ((t) + 1 < NT) { if constexpr (F32) { VMW(); SWRITE_KF(SB); SBAR(); SLOAD_F((const float*)Vh, KBASE((t) + 1)); }  \
                            else { SLOAD_H(Kh, Vh, Ch, KBASE((t) + 1), NEXT3(cb_t)); } SBAR(); }                                               \
        pv_tile<VB, SK>(o, vb0, pa0, pa1, pa2, pa3, ACT((t) - 1)); MASKT(PX0, PX1, (t)); partialSM(PX0, PX1, m_reg, mnX, alX);                                        \
        __syncthreads();                                                                                                      \
        if ((t) + 1 < NT) { VMW(); if constexpr (F32) { SWRITE_VF(SB); SBAR(); if ((t) + 2 < NT) SLOAD_F((const float*)Kh, KBASE((t) + 2)); } \
                            else { SWRITE_H(SB); } }                                                                          \
        RESC(alX); __syncthreads(); } while (0)
    for (int t = 1; t + 1 < NT; t += 2) {
        HALF_STEP(pB0, pB1, mnB, alB, pA0, pA1, alA, t, 1, 0, 0);
        HALF_STEP(pA0, pA1, mnA, alA, pB0, pB1, alB, t + 1, 0, 1, 1);
    }
    const bool even = (NT & 1) == 0;
    if (even) { SBAR(); cb_t = NEXT3(cb_t); qkt<1, SK>(pB0, pB1, K_lds, r32, hi, S.qr, ACT(NT - 1), cb_t); SBAR(); }
#define QROW(e) (nxt.Q() + (size_t)(wid * QBLK + r32) * PITCH + ((e) >> 1) * 16 + hi * 8 + ((e) & 1) * 4)
    if constexpr (F32) { SLOAD_F((const float*)nxt.K(), kbn); SBAR();
#pragma unroll
        for (int e = 0; e < 8; ++e) S.tq[e] = *(const f32x4*)QROW(e); }
    else { SLOAD_H(nxt.K(), nxt.V(), nxt.C(), kbn, NEXT3(cb_t)); S.cbi = NEXT3(cb_t); SBAR();
#pragma unroll
        for (int d0 = 0; d0 < 8; ++d0) S.qr[d0] = load8<TIn>(nxt.Q() + (size_t)(wid * QBLK + r32) * PITCH + d0 * 16 + hi * 8); }
    SBAR();
    finishSM(pA0, pA1, alA, l_reg, pa0, pa1, pa2, pa3); SBAR();
    if constexpr (F32) {
#pragma unroll
        for (int e = 8; e < 16; ++e) S.tq[e] = *(const f32x4*)QROW(e); SBAR(); }
#undef QROW
    pv_tile<0, SK>(o, vb0, pa0, pa1, pa2, pa3, ACT(even ? NT - 2 : NT - 1));
    if (even) { MASKT(pB0, pB1, NT - 1); partialSM(pB0, pB1, m_reg, mnB, alB); __syncthreads(); RESC(alB);
        finishSM(pB0, pB1, alB, l_reg, pa0, pa1, pa2, pa3); SBAR(); pv_tile<1, SK>(o, vb0, pa0, pa1, pa2, pa3, ACT(NT - 1)); }
    SBAR(); SEAM_K0();
    if (hi == 0) li_l[r32] = l_reg; asm volatile("s_waitcnt lgkmcnt(0)" ::: "memory");
    float rli[16];
#pragma unroll
    for (int r = 0; r < 16; ++r) rli[r] = __builtin_amdgcn_rcpf(li_l[crow(r, hi)]);
    int hi_e = hi; asm volatile("" : "+v"(hi_e));
    TOut* Ow = cur.O() + (size_t)(wid * QBLK) * PITCH + (size_t)(4 * hi_e) * PITCH; const char* gl_ = lds + LDS_GATE + wid * 8192 + 4 * hi_e * 256;
#pragma unroll
    for (int r = 0; r < 16; ++r) { const int orow = (r & 3) + 8 * (r >> 2);
#pragma unroll
        for (int d0 = 0; d0 < 4; ++d0) { const float v = o[d0][r] * rli[r];
            if constexpr (same_t<TOut, float>::v) { Ow[(size_t)orow * PITCH + d0 * 32 + r32] = v; }
            else { const float vn = __shfl_xor(v, 1);
                   if ((r32 & 1) == 0) { const unsigned gw_ = *(const unsigned*)(gl_ + orow * 256 + (d0 * 32 + r32) * 2);
                       const float g0_ = __uint_as_float(gw_ << 16), g1_ = __uint_as_float(gw_ & 0xffff0000u);
                       const float s0_ = __builtin_amdgcn_rcpf(1.f + __builtin_amdgcn_exp2f(-1.4426950408889634f * g0_)), s1_ = __builtin_amdgcn_rcpf(1.f + __builtin_amdgcn_exp2f(-1.4426950408889634f * g1_));
                       *(unsigned*)(Ow + (size_t)orow * PITCH + d0 * 32 + r32) = cvtpk(v * s0_, vn * s1_); } } } }
    if constexpr (F32) {
#pragma unroll
        for (int d0 = 0; d0 < 8; ++d0) S.qr[d0] = pack8(S.tq[2 * d0], S.tq[2 * d0 + 1]); }
    __syncthreads();
#undef RESC
#undef KBASE
#undef ACT
#undef MASKT
#undef SEAM_K0
#undef HALF_STEP
}
#undef ROW
#undef ROWV
#undef VMW
#undef VMWN
#undef SLOAD_H
#undef SWRITE_HK
#undef SWRITE_HV
#undef SWRITE_H
#undef SLOAD_F
#undef SWRITE_KF
#undef SWRITE_VF

}
#ifndef RW_SOLVE_OLD
#define RW_SOLVE_OLD 0
#endif
namespace rw {
typedef short bf16x8 __attribute__((ext_vector_type(8)));
typedef float f32x4 __attribute__((ext_vector_type(4)));
typedef unsigned u32x4 __attribute__((ext_vector_type(4)));
typedef unsigned u32x2 __attribute__((ext_vector_type(2)));
#define RW_LAS __attribute__((address_space(3)))
constexpr int PB = 144, PF = 272, MB = 64 * PB;
constexpr int O_R = 0, O_K = MB, O_A = 2 * MB, O_B = 3 * MB, O_BT = 4 * MB, O_KT = 5 * MB, O_VT = 6 * MB, O_AAK = 7 * MB, O_ARB = 8 * MB, O_ARK = 9 * MB;
constexpr int O_AAB = 10 * MB, O_GT = O_AAB + 64 * PF, O_GAM = O_GT + 64 * PF, O_TOT = O_GAM + 256, O_END = O_TOT + 2048;
constexpr int O_AABB = O_END, O_TB = O_AABB + MB, O_END2 = O_TB + 4 * 768;
constexpr int O_WT = O_K, O_UT = O_AAK;
static_assert(O_END2 <= 143360, "phase A LDS map");
constexpr int REC = 32768, REC_P = 0, REC_Q = 8192, REC_H = 16384, REC_Y = 24576;
typedef float f32x2_t __attribute__((ext_vector_type(2))); typedef __bf16 bf16x2_t __attribute__((ext_vector_type(2)));
__device__ __forceinline__ unsigned cvtpk(float lo, float hi) { f32x2_t v = {lo, hi}; bf16x2_t b = __builtin_convertvector(v, bf16x2_t); return __builtin_bit_cast(unsigned, b); }
__device__ __forceinline__ float blo(unsigned w) { return __uint_as_float(w << 16); }
__device__ __forceinline__ float bhi(unsigned w) { return __uint_as_float(w & 0xffff0000u); }
__device__ __forceinline__ bf16x8 frag(const RW_LAS unsigned char* base, int tile, int ks, int lane) { return *(const RW_LAS bf16x8*)(base + (16 * tile + (lane & 15)) * PB + (ks * 32 + 8 * (lane >> 4)) * 2); }
#define RW_MFMA(a, b, c) __builtin_amdgcn_mfma_f32_16x16x32_bf16(a, b, c, 0, 0, 0)
#define RW_SYNC() __syncthreads()
#define RW_BAR() do { asm volatile("" ::: "memory"); __builtin_amdgcn_s_barrier(); asm volatile("" ::: "memory"); } while (0)

struct ChunkIn { u32x4 r, k, v, a; f32x4 l0, l1; };
__device__ __forceinline__ void load_chunk(ChunkIn& c, const unsigned char* ws, int it, int tid) {
    const int bh = it >> 8, ch = it & 255, b = bh >> 4, h = bh & 15, tok = tid >> 3, part = tid & 7;
    const size_t off = ((size_t)b * SEQ + (size_t)ch * 64 + tok) * 1024 + h * 64 + 8 * part;
    c.r = *(const u32x4*)((const unsigned short*)(ws + WS_R) + off); c.k = *(const u32x4*)((const unsigned short*)(ws + WS_K) + off); c.v = *(const u32x4*)((const unsigned short*)(ws + WS_V) + off);
    c.a = *(const u32x4*)((const unsigned short*)(ws + WS_A) + off); c.l0 = *(const f32x4*)((const float*)(ws + WS_LOGW) + off); c.l1 = *(const f32x4*)((const float*)(ws + WS_LOGW) + off + 4);
}
template <int STOP = 0>
__device__ __forceinline__ void phase_a(RW_LAS unsigned char* L, unsigned char* ws, size_t rec_off, const float* kk_all, const float* ka_all, int wg, int G, int tid) {
    const int lane = tid & 63, w = __builtin_amdgcn_readfirstlane(tid >> 6), g = lane >> 4, l15 = lane & 15;
    ChunkIn cin; if (wg < 8192) load_chunk(cin, ws, wg, tid);
  for (int it = wg; it < 8192; it += G) {
    unsigned char* rec = ws + rec_off + (size_t)it * REC; const float* kkw_g = kk_all + ((it >> 8) & 15) * 64; const float* kaw_g = ka_all + ((it >> 8) & 15) * 64;
    { const int tok = tid >> 3, part = tid & 7, c0 = 8 * part;
      const u32x4 rw_ = cin.r, kw_ = cin.k, vw_ = cin.v, aw_ = cin.a; const f32x4 l0 = cin.l0, l1 = cin.l1;
      float lw[8] = {l0[0], l0[1], l0[2], l0[3], l1[0], l1[1], l1[2], l1[3]}, cum[8];
#pragma unroll
      for (int i = 0; i < 8; ++i) { float v = lw[i];
          float u = __shfl_up(v, 8); if (lane >= 8) v += u; u = __shfl_up(v, 16); if (lane >= 16) v += u; u = __shfl_up(v, 32); if (lane >= 32) v += u; cum[i] = v; }
      RW_LAS float* tot = (RW_LAS float*)(L + O_TOT);
      if (lane >= 56) {
#pragma unroll
          for (int i = 0; i < 8; ++i) tot[w * 64 + c0 + i] = cum[i]; }
      RW_SYNC();
#pragma unroll
      for (int ww = 0; ww < 7; ++ww) if (ww < w) { const f32x4 a0 = *(const RW_LAS f32x4*)(tot + ww * 64 + c0), a1 = *(const RW_LAS f32x4*)(tot + ww * 64 + c0 + 4);
#pragma unroll
          for (int i = 0; i < 4; ++i) { cum[i] += a0[i]; cum[4 + i] += a1[i]; } }
      float r[8] = {blo(rw_.x), bhi(rw_.x), blo(rw_.y), bhi(rw_.y), blo(rw_.z), bhi(rw_.z), blo(rw_.w), bhi(rw_.w)};
      float k[8] = {blo(kw_.x), bhi(kw_.x), blo(kw_.y), bhi(kw_.y), blo(kw_.z), bhi(kw_.z), blo(kw_.w), bhi(kw_.w)};
      float a[8] = {blo(aw_.x), bhi(aw_.x), blo(aw_.y), bhi(aw_.y), blo(aw_.z), bhi(aw_.z), blo(aw_.w), bhi(aw_.w)};
      const f32x4 kk0 = *(const f32x4*)(kkw_g + c0), kk1 = *(const f32x4*)(kkw_g + c0 + 4), ka0 = *(const f32x4*)(kaw_g + c0), ka1 = *(const f32x4*)(kaw_g + c0 + 4);
      float kk[8], ss = 0.f;
#pragma unroll
      for (int i = 0; i < 8; ++i) { kk[i] = k[i] * (i < 4 ? kk0[i] : kk1[i - 4]); ss += kk[i] * kk[i]; }
      ss += __shfl_xor(ss, 1); ss += __shfl_xor(ss, 2); ss += __shfl_xor(ss, 4);
      const float inv = 1.f / fmaxf(sqrtf(ss), 1e-12f);
      float Rt[8], Kt[8], At[8], Bt[8];
#pragma unroll
      for (int i = 0; i < 8; ++i) { const float eL = __expf(cum[i]), eLi = __expf(-cum[i]), eLx = __expf(cum[i] - lw[i]); const float kn = kk[i] * inv;
          Rt[i] = r[i] * eL; Kt[i] = k[i] * (1.f + (a[i] - 1.f) * (i < 4 ? ka0[i] : ka1[i - 4])) * eLi; At[i] = -kn * eLx; Bt[i] = kn * a[i] * eLi;
          if (tok == 63) ((RW_LAS float*)(L + O_GAM))[c0 + i] = eL; }
      u32x4 o;
      o.x = cvtpk(Rt[0], Rt[1]); o.y = cvtpk(Rt[2], Rt[3]); o.z = cvtpk(Rt[4], Rt[5]); o.w = cvtpk(Rt[6], Rt[7]); *(RW_LAS u32x4*)(L + O_R + tok * PB + c0 * 2) = o;
      o.x = cvtpk(Kt[0], Kt[1]); o.y = cvtpk(Kt[2], Kt[3]); o.z = cvtpk(Kt[4], Kt[5]); o.w = cvtpk(Kt[6], Kt[7]); *(RW_LAS u32x4*)(L + O_K + tok * PB + c0 * 2) = o;
      o.x = cvtpk(At[0], At[1]); o.y = cvtpk(At[2], At[3]); o.z = cvtpk(At[4], At[5]); o.w = cvtpk(At[6], At[7]); *(RW_LAS u32x4*)(L + O_A + tok * PB + c0 * 2) = o;
      o.x = cvtpk(Bt[0], Bt[1]); o.y = cvtpk(Bt[2], Bt[3]); o.z = cvtpk(Bt[4], Bt[5]); o.w = cvtpk(Bt[6], Bt[7]); *(RW_LAS u32x4*)(L + O_B + tok * PB + c0 * 2) = o;
      *(RW_LAS u32x4*)(L + O_GT + tok * PB + c0 * 2) = vw_;
    }
    if (it + G < 8192) load_chunk(cin, ws, it + G, tid);
    RW_SYNC();
    if (STOP == 1) continue;
    {
      const int ch = tid & 63, tg = tid >> 6;
#pragma unroll
      for (int mtx = 0; mtx < 3; ++mtx) { const RW_LAS unsigned char* src = L + (mtx == 0 ? O_B : mtx == 1 ? O_K : O_GT) + (8 * tg) * PB + ch * 2; unsigned v[8];
#pragma unroll
          for (int i = 0; i < 8; ++i) v[i] = *(const RW_LAS unsigned short*)(src + i * PB);
          u32x4 o; o.x = v[0] | (v[1] << 16); o.y = v[2] | (v[3] << 16); o.z = v[4] | (v[5] << 16); o.w = v[6] | (v[7] << 16);
          *(RW_LAS u32x4*)(L + (mtx == 0 ? O_BT : mtx == 1 ? O_KT : O_VT) + ch * PB + (8 * tg) * 2) = o; } }
    const int t4 = w & 3, p2 = (w >> 2) * 2;
    { const bf16x8 b0 = frag(L + O_B, t4, 0, lane), b1 = frag(L + O_B, t4, 1, lane), k0 = frag(L + O_K, t4, 0, lane), k1 = frag(L + O_K, t4, 1, lane);
#pragma unroll
      for (int u = 0; u < 2; ++u) { const int nt = p2 + u, t = 16 * nt + l15, s0 = 16 * t4 + 4 * g;
          f32x4 ab = {0.f, 0.f, 0.f, 0.f}, ak = ab, rb = ab, rk = ab;
          if (t4 <= nt) { const bf16x8 a0 = frag(L + O_A, nt, 0, lane), a1 = frag(L + O_A, nt, 1, lane), r0 = frag(L + O_R, nt, 0, lane), r1 = frag(L + O_R, nt, 1, lane);
              ab = RW_MFMA(b0, a0, ab); ab = RW_MFMA(b1, a1, ab); ak = RW_MFMA(k0, a0, ak); ak = RW_MFMA(k1, a1, ak);
              rb = RW_MFMA(b0, r0, rb); rb = RW_MFMA(b1, r1, rb); rk = RW_MFMA(k0, r0, rk); rk = RW_MFMA(k1, r1, rk);
#pragma unroll
              for (int r = 0; r < 4; ++r) { const int s = s0 + r; if (!(s < t)) { ab[r] = 0.f; ak[r] = 0.f; } if (!(s <= t)) { rb[r] = 0.f; rk[r] = 0.f; } } }
          *(RW_LAS f32x4*)(L + O_AAB + t * PF + s0 * 4) = ab;
          u32x2 o; o.x = cvtpk(ab[0], ab[1]); o.y = cvtpk(ab[2], ab[3]); *(RW_LAS u32x2*)(L + O_AABB + t * PB + s0 * 2) = o;
          o.x = cvtpk(ak[0], ak[1]); o.y = cvtpk(ak[2], ak[3]); *(RW_LAS u32x2*)(L + O_AAK + t * PB + s0 * 2) = o;
          o.x = cvtpk(rb[0], rb[1]); o.y = cvtpk(rb[2], rb[3]); *(RW_LAS u32x2*)(L + O_ARB + t * PB + s0 * 2) = o;
          o.x = cvtpk(rk[0], rk[1]); o.y = cvtpk(rk[2], rk[3]); *(RW_LAS u32x2*)(L + O_ARK + t * PB + s0 * 2) = o; } }
    RW_SYNC();
    if (STOP == 2) continue;
    { const bf16x8 a0 = frag(L + O_AAK, t4, 0, lane), a1 = frag(L + O_AAK, t4, 1, lane);
#pragma unroll
      for (int u = 0; u < 2; ++u) { const int nt = p2 + u; f32x4 acc = {0.f, 0.f, 0.f, 0.f};
          acc = RW_MFMA(a0, frag(L + O_VT, nt, 0, lane), acc); acc = RW_MFMA(a1, frag(L + O_VT, nt, 1, lane), acc);
          *(RW_LAS f32x4*)(L + O_GT + (16 * nt + l15) * PF + (16 * t4 + 4 * g) * 4) = acc; } }
    if (w < 4 && lane < 16) {
        float x[16]; const RW_LAS unsigned char* ab = L + O_AAB + 16 * w * PF + 16 * w * 4;
#pragma unroll
        for (int r = 0; r < 16; ++r) { float a0 = (r == lane) ? 1.f : 0.f, a1 = 0.f;
#pragma unroll
            for (int q4 = 0; q4 < (r + 3) / 4; ++q4) { const f32x4 av = *(const RW_LAS f32x4*)(ab + r * PF + q4 * 16);
                if (4 * q4 + 0 < r) a0 += av[0] * x[4 * q4 + 0]; if (4 * q4 + 1 < r) a1 += av[1] * x[4 * q4 + 1]; if (4 * q4 + 2 < r) a0 += av[2] * x[4 * q4 + 2]; if (4 * q4 + 3 < r) a1 += av[3] * x[4 * q4 + 3]; }
            x[r] = a0 + a1; *(RW_LAS unsigned short*)(L + O_TB + w * 768 + r * 48 + lane * 2) = (unsigned short)(cvtpk(x[r], 0.f) & 0xffffu); } }
    RW_SYNC();
    if (STOP == 3) continue;
#if RW_SOLVE_OLD
    if (tid < 128) { const int c = tid;
        const RW_LAS unsigned char* rhs = c < 64 ? (L + O_A + c * 2) : (L + O_GT + (c - 64) * PF);
        RW_LAS unsigned char* dst = c < 64 ? (L + O_WT + c * PB) : (L + O_UT + (c - 64) * PB);
        for (int b = 0; b < 4; ++b) { float z[16];
#pragma unroll
            for (int r = 0; r < 16; ++r) z[r] = c < 64 ? blo((unsigned)*(const RW_LAS unsigned short*)(rhs + (16 * b + r) * PB)) : *(const RW_LAS float*)(rhs + (16 * b + r) * 4);
            const RW_LAS unsigned char* arow = L + O_AAB + 16 * b * PF;
            for (int s4 = 0; s4 < 4 * b; ++s4) { const u32x2 xw = *(const RW_LAS u32x2*)(dst + s4 * 8); const float x0 = blo(xw.x), x1 = bhi(xw.x), x2 = blo(xw.y), x3 = bhi(xw.y);
#pragma unroll
                for (int r = 0; r < 16; ++r) { const f32x4 av = *(const RW_LAS f32x4*)(arow + r * PF + s4 * 16); z[r] += (av[0] * x0 + av[1] * x1) + (av[2] * x2 + av[3] * x3); } }
#pragma unroll
            for (int r = 1; r < 16; ++r) {
#pragma unroll
                for (int q4 = 0; q4 < (r + 3) / 4; ++q4) { const f32x4 av = *(const RW_LAS f32x4*)(arow + r * PF + (4 * b + q4) * 16);
                    if (4 * q4 + 0 < r) z[r] += av[0] * z[4 * q4 + 0]; if (4 * q4 + 1 < r) z[r] += av[1] * z[4 * q4 + 1]; if (4 * q4 + 2 < r) z[r] += av[2] * z[4 * q4 + 2]; if (4 * q4 + 3 < r) z[r] += av[3] * z[4 * q4 + 3]; } }
            u32x4 o; o.x = cvtpk(z[0], z[1]); o.y = cvtpk(z[2], z[3]); o.z = cvtpk(z[4], z[5]); o.w = cvtpk(z[6], z[7]); *(RW_LAS u32x4*)(dst + 32 * b) = o;
            o.x = cvtpk(z[8], z[9]); o.y = cvtpk(z[10], z[11]); o.z = cvtpk(z[12], z[13]); o.w = cvtpk(z[14], z[15]); *(RW_LAS u32x4*)(dst + 32 * b + 16) = o;
            asm volatile("s_waitcnt lgkmcnt(0)" ::: "memory"); } }
    RW_SYNC();
#else
    { RW_LAS unsigned char* xt = (w < 4 ? L + O_WT : L + O_UT) + (w & 3) * 16 * PB;
      { const u32x4 z4 = {0u, 0u, 0u, 0u}; *(RW_LAS u32x4*)(xt + l15 * PB + g * 16) = z4; *(RW_LAS u32x4*)(xt + l15 * PB + 64 + g * 16) = z4; }
      asm volatile("s_waitcnt lgkmcnt(0)" ::: "memory");
#pragma unroll
      for (int b = 0; b < 4; ++b) { f32x4 z;
          if (w < 4) { const RW_LAS unsigned char* ap = L + O_A + (16 * b + 4 * g) * PB + (16 * w + l15) * 2;
              z = (f32x4){blo((unsigned)*(const RW_LAS unsigned short*)(ap)), blo((unsigned)*(const RW_LAS unsigned short*)(ap + PB)), blo((unsigned)*(const RW_LAS unsigned short*)(ap + 2 * PB)), blo((unsigned)*(const RW_LAS unsigned short*)(ap + 3 * PB))}; }
          else z = *(const RW_LAS f32x4*)(L + O_GT + (16 * (w - 4) + l15) * PF + (16 * b + 4 * g) * 4);
          if (b > 0) { z = RW_MFMA(frag(L + O_AABB, b, 0, lane), *(const RW_LAS bf16x8*)(xt + l15 * PB + (8 * g) * 2), z);
                       if (b > 2) z = RW_MFMA(frag(L + O_AABB, b, 1, lane), *(const RW_LAS bf16x8*)(xt + l15 * PB + (32 + 8 * g) * 2), z); }
          const u32x2 tw = *(const RW_LAS u32x2*)(L + O_TB + b * 768 + l15 * 48 + (4 * g) * 2);
          const u32x4 tf = {tw.x, tw.y, 0u, 0u}, zf = {cvtpk(z[0], z[1]), cvtpk(z[2], z[3]), 0u, 0u};
          f32x4 xb = {0.f, 0.f, 0.f, 0.f}; xb = RW_MFMA(__builtin_bit_cast(bf16x8, tf), __builtin_bit_cast(bf16x8, zf), xb);
          u32x2 o; o.x = cvtpk(xb[0], xb[1]); o.y = cvtpk(xb[2], xb[3]); *(RW_LAS u32x2*)(xt + l15 * PB + (16 * b + 4 * g) * 2) = o;
          asm volatile("s_waitcnt lgkmcnt(0)" ::: "memory"); } }
    RW_SYNC();
#endif
    if (STOP == 4) continue;
    {
      const bf16x8 rb0 = frag(L + O_ARB, t4, 0, lane), rb1 = frag(L + O_ARB, t4, 1, lane), bt0 = frag(L + O_BT, t4, 0, lane), bt1 = frag(L + O_BT, t4, 1, lane);
      const int col = 16 * t4 + l15; const float gam = ((const RW_LAS float*)(L + O_GAM))[col];
      unsigned qw[4], pw[4];
#pragma unroll
      for (int u = 0; u < 2; ++u) { const int mt = p2 + u, j0 = 16 * mt + 4 * g; const bf16x8 w0 = frag(L + O_WT, mt, 0, lane), w1 = frag(L + O_WT, mt, 1, lane);
          f32x4 q = {0.f, 0.f, 0.f, 0.f}, p = q; q = RW_MFMA(w0, rb0, q); q = RW_MFMA(w1, rb1, q); p = RW_MFMA(w0, bt0, p); p = RW_MFMA(w1, bt1, p);
          const u32x2 rr = *(const RW_LAS u32x2*)(L + O_R + col * PB + j0 * 2);
          q[0] += blo(rr.x); q[1] += bhi(rr.x); q[2] += blo(rr.y); q[3] += bhi(rr.y);
#pragma unroll
          for (int r = 0; r < 4; ++r) p[r] = (p[r] + ((j0 + r) == col ? 1.f : 0.f)) * gam;
          qw[2 * u] = cvtpk(q[0], q[1]); qw[2 * u + 1] = cvtpk(q[2], q[3]); pw[2 * u] = cvtpk(p[0], p[1]); pw[2 * u + 1] = cvtpk(p[2], p[3]); }
      const int fo = ((t4 * 2 + (p2 >> 1)) * 64 + lane) * 16;
      *(u32x4*)(rec + REC_Q + fo) = (u32x4){qw[0], qw[1], qw[2], qw[3]}; *(u32x4*)(rec + REC_P + fo) = (u32x4){pw[0], pw[1], pw[2], pw[3]}; }
    {
      const bf16x8 rb0 = frag(L + O_ARB, t4, 0, lane), rb1 = frag(L + O_ARB, t4, 1, lane), rk0 = frag(L + O_ARK, t4, 0, lane), rk1 = frag(L + O_ARK, t4, 1, lane);
      const bf16x8 ut0 = frag(L + O_UT, t4, 0, lane), ut1 = frag(L + O_UT, t4, 1, lane), vt0 = frag(L + O_VT, t4, 0, lane), vt1 = frag(L + O_VT, t4, 1, lane);
      const int col = 16 * t4 + l15;
#pragma unroll
      for (int u = 0; u < 2; ++u) { const int mt = p2 + u, m0 = 16 * mt + 4 * g;
          f32x4 y = {0.f, 0.f, 0.f, 0.f}, hm = y;
          y = RW_MFMA(frag(L + O_UT, mt, 0, lane), rb0, y); y = RW_MFMA(frag(L + O_UT, mt, 1, lane), rb1, y); y = RW_MFMA(frag(L + O_VT, mt, 0, lane), rk0, y); y = RW_MFMA(frag(L + O_VT, mt, 1, lane), rk1, y);
          hm = RW_MFMA(frag(L + O_BT, mt, 0, lane), ut0, hm); hm = RW_MFMA(frag(L + O_BT, mt, 1, lane), ut1, hm); hm = RW_MFMA(frag(L + O_KT, mt, 0, lane), vt0, hm); hm = RW_MFMA(frag(L + O_KT, mt, 1, lane), vt1, hm);
          const f32x4 gm = *(const RW_LAS f32x4*)(L + O_GAM + m0 * 4);
          u32x2 o; o.x = cvtpk(y[0], y[1]); o.y = cvtpk(y[2], y[3]); *(u32x2*)(rec + REC_Y + (col * 64 + m0) * 2) = o;
          o.x = cvtpk(hm[0] * gm[0], hm[1] * gm[1]); o.y = cvtpk(hm[2] * gm[2], hm[3] * gm[3]); *(u32x2*)(rec + REC_H + (col * 64 + m0) * 2) = o; } }
    RW_SYNC();
  }
}

__device__ __forceinline__ void phase_b_head(RW_LAS unsigned char* L, const unsigned char* recs, unsigned short* Yg, int tid) {
    constexpr int NCH = 256, NSLOT = 4;
    const int lane = tid & 63, w = __builtin_amdgcn_readfirstlane(tid >> 6), g = lane >> 4, l15 = lane & 15;
    if (w >= 4) {
        const int lw = w - 4; const unsigned char* src = recs + lw * 8192 + lane * 16;
#define RW_ISSUE(c_) do { _Pragma("unroll") for (int k_ = 0; k_ < 8; ++k_) __builtin_amdgcn_global_load_lds((const unsigned*)(src + (size_t)(c_) * REC + k_ * 1024), (RW_LAS unsigned*)(L + ((c_) & 3) * REC + lw * 8192 + k_ * 1024), 16, 0, 0); } while (0)
        RW_ISSUE(0); RW_ISSUE(1); RW_ISSUE(2);
        asm volatile("s_waitcnt vmcnt(16)" ::: "memory");
        RW_BAR();
        for (int c = 0; c < NCH; ++c) {
            if (c + 3 < NCH) { RW_ISSUE(c + 3); asm volatile("s_waitcnt vmcnt(16)" ::: "memory"); }
            else asm volatile("s_waitcnt vmcnt(0)" ::: "memory");
            RW_BAR();
        }
#undef RW_ISSUE
    } else {
        f32x4 sacc[4];
#pragma unroll
        for (int m = 0; m < 4; ++m) sacc[m] = (f32x4){0.f, 0.f, 0.f, 0.f};
        RW_BAR();
        for (int c = 0; c < NCH; ++c) { const RW_LAS unsigned char* sl = L + (c & 3) * REC;
            bf16x8 bf[2];
#pragma unroll
            for (int s = 0; s < 2; ++s) { u32x4 v; v.x = cvtpk(sacc[2 * s][0], sacc[2 * s][1]); v.y = cvtpk(sacc[2 * s][2], sacc[2 * s][3]); v.z = cvtpk(sacc[2 * s + 1][0], sacc[2 * s + 1][1]); v.w = cvtpk(sacc[2 * s + 1][2], sacc[2 * s + 1][3]); bf[s] = __builtin_bit_cast(bf16x8, v); }
            f32x4 sn[4];
#pragma unroll
            for (int m = 0; m < 4; ++m) { const u32x2 hw = *(const RW_LAS u32x2*)(sl + REC_H + ((16 * w + l15) * 64 + 16 * m + 4 * g) * 2);
                f32x4 acc = {blo(hw.x), bhi(hw.x), blo(hw.y), bhi(hw.y)};
                acc = RW_MFMA(*(const RW_LAS bf16x8*)(sl + REC_P + ((m * 2 + 0) * 64 + lane) * 16), bf[0], acc);
                acc = RW_MFMA(*(const RW_LAS bf16x8*)(sl + REC_P + ((m * 2 + 1) * 64 + lane) * 16), bf[1], acc); sn[m] = acc; }
#pragma unroll
            for (int n = 0; n < 4; ++n) { const u32x2 yw = *(const RW_LAS u32x2*)(sl + REC_Y + ((16 * n + l15) * 64 + 16 * w + 4 * g) * 2);
                f32x4 acc = {blo(yw.x), bhi(yw.x), blo(yw.y), bhi(yw.y)};
                acc = RW_MFMA(bf[0], *(const RW_LAS bf16x8*)(sl + REC_Q + ((n * 2 + 0) * 64 + lane) * 16), acc);
                acc = RW_MFMA(bf[1], *(const RW_LAS bf16x8*)(sl + REC_Q + ((n * 2 + 1) * 64 + lane) * 16), acc);
                u32x2 yo; yo.x = cvtpk(acc[0], acc[1]); yo.y = cvtpk(acc[2], acc[3]); *(u32x2*)(Yg + (size_t)(c * 64 + 16 * n + l15) * 1024 + 16 * w + 4 * g) = yo; }
#pragma unroll
            for (int m = 0; m < 4; ++m) sacc[m] = sn[m];
            asm volatile("s_waitcnt lgkmcnt(0)" ::: "memory");
            RW_BAR();
        }
    }
}
}
#define XB_TMO      128
#define XB_XCNT(j)  (256  + 64 * (j))
#define XB_XSUB(j)  (1280 + 64 * (j))
#define XB_XGEN(j)  (2304 + 64 * (j))
#define XB_TOP      3328
#define XB_TOPGEN   3392
#define XCD_BAR_WORDS 3456
#define XB_SPIN_CAP (1u << 18)

__device__ __forceinline__ unsigned xb_ld(unsigned* p)              { return __hip_atomic_load(p, __ATOMIC_RELAXED, __HIP_MEMORY_SCOPE_AGENT); }
__device__ __forceinline__ unsigned xb_add(unsigned* p, unsigned v) { return __hip_atomic_fetch_add(p, v, __ATOMIC_RELAXED, __HIP_MEMORY_SCOPE_AGENT); }
__device__ __forceinline__ unsigned xb_xcc_id() { return (unsigned)__builtin_amdgcn_s_getreg((3 << 11) | 20) & 0xFu; }
#define XB_SPIN(cond, bar) do { unsigned _sp = 0; while (cond) { __builtin_amdgcn_s_sleep(1); \
    if ((++_sp & 255u) == 0u) { if (xb_ld(&(bar)[XB_TMO])) break; if (_sp > XB_SPIN_CAP) { atomicAdd(&(bar)[XB_TMO], 1u); break; } } } } while (0)

struct XcdBarrier {
    unsigned* bar; unsigned x;
    volatile LAS unsigned* st;
};

__device__ __forceinline__ XcdBarrier xcd_barrier_post(unsigned* bar, volatile LAS unsigned* st, const int tid) {
    XcdBarrier b; b.bar = bar; b.x = xb_xcc_id(); b.st = st;
    if (tid == 0) (void)xb_add(&bar[XB_XCNT(b.x)], 1u);
    return b;
}
__device__ __forceinline__ void xcd_barrier_complete(unsigned* bar, unsigned x, unsigned& nloc, unsigned& nx) {
    const unsigned G = gridDim.x * gridDim.y * gridDim.z;
    unsigned sum, cnt, mine, sp = 0u;
    for (;;) {
        sum = 0u; cnt = 0u; mine = 0u;
#pragma unroll
        for (unsigned j = 0; j < 16; ++j) { const unsigned c = xb_ld(&bar[XB_XCNT(j)]); sum += c; cnt += (c > 0u) ? 1u : 0u; mine = (j == x) ? c : mine; }
        if (sum == G) break;
        __builtin_amdgcn_s_sleep(1);
        if ((++sp & 255u) == 0u) { if (xb_ld(&bar[XB_TMO])) break; if (sp > XB_SPIN_CAP) { atomicAdd(&bar[XB_TMO], 1u); break; } }
    }
    nloc = mine > 0u ? mine : 1u; nx = cnt > 0u ? cnt : 1u;
}

__device__ __forceinline__ void xcd_barrier(const XcdBarrier& b, const int tid) {
    asm volatile("s_waitcnt vmcnt(0)" ::: "memory");
    __syncthreads();
    if (tid == 0) {
        unsigned* bar = b.bar;
        __builtin_amdgcn_s_waitcnt(0);
        unsigned nloc = b.st[0], nx = b.st[1];
        if (nloc == 0u) { xcd_barrier_complete(bar, b.x, nloc, nx); b.st[0] = nloc; b.st[1] = nx; }
        const unsigned old = xb_add(&bar[XB_XSUB(b.x)], 1u);
        const unsigned gen = old / nloc;
        if (old + 1u == (gen + 1u) * nloc) {
            __builtin_amdgcn_fence(__ATOMIC_RELEASE, "agent");
            asm volatile("s_waitcnt vmcnt(0)" ::: "memory");
            const unsigned og = xb_add(&bar[XB_TOP], 1u);
            const unsigned tg = og / nx;
            if (og + 1u == (tg + 1u) * nx) xb_add(&bar[XB_TOPGEN], 1u);
            else XB_SPIN(xb_ld(&bar[XB_TOPGEN]) == tg, bar);
            __builtin_amdgcn_fence(__ATOMIC_ACQUIRE, "agent");
            xb_add(&bar[XB_XGEN(b.x)], 1u);
            asm volatile("s_waitcnt vmcnt(0)" ::: "memory");
        } else {
            XB_SPIN(xb_ld(&bar[XB_XGEN(b.x)]) == gen, bar);
            __builtin_amdgcn_fence(__ATOMIC_ACQUIRE, "agent");
            asm volatile("s_waitcnt vmcnt(0)" ::: "memory");
        }
    }
    __syncthreads();
}
enum InIdx { I_X = 0, I_C, I_WADA, I_BADA, I_N1G, I_WIN, I_MU, I_WDEC, I_W0, I_WICLR, I_A0, I_WGATE, I_KK, I_KA, I_RK, I_GNG, I_GNB, I_WOA, I_BF, I_QN, I_KN, I_WOB, I_WOUT, I_N2G, I_WR, I_BR, I_WGU, I_BGU, I_WDN, I_BDN, I_NFG, N_IN };
struct Args { const float* in[N_IN]; float* out; unsigned char* ws; int ph_lo, ph_hi; };
static_assert(sizeof(Args) == (N_IN + 2) * 8 + 8, "Args has no padding");
typedef const __attribute__((address_space(4))) Args* ArgsP;
struct Frame {
    LAS unsigned char* lds;
    volatile LAS unsigned* MISC;
    gu32* ctl;
    int tid, lane, wave, G, wg;
    unsigned char* ws;
    ArgsP ap;
};
#define WSP(T_, off) ((T_*)(F.ws + (off)))

__device__ __forceinline__ int win_orig_col(int c) {
    if (c < PC_GLO) return c;
    if (c < PC_DLO) return 3264 + (c - PC_GLO);
    if (c < PC_ALO) return 3072 + (c - PC_DLO);
    if (c < PC_F) return 3168 + (c - PC_ALO);
    if (c < PC_FEND) return 6592 + (c - PC_F);
    if (c < PC_SPLIT) return -1;
    if (c < PC_FQ) return 7624 + (c - PC_GA);
    if (c < PC_OG) return 3520 + (c - PC_FQ);
    if (c < PC_GB) return 6600 + (c - PC_OG);
    return 9672 + (c - PC_GB);
}
__device__ __forceinline__ void tr_item(const float* W, int ldw, int K, bf16* WT, int drow0, int scol0, int nvalid, int k0, LAS float* scr, int lane) {
    const int n = lane & 31;
#pragma unroll 8
    for (int i = 0; i < 32; ++i) { const int kk = 2 * i + (lane >> 5); scr[kk * 33 + n] = (n < nvalid) ? W[(size_t)(k0 + kk) * ldw + scol0 + n] : 0.f; }
    LDS_WAIT(); asm volatile("" ::: "memory");
    const int c = lane & 7;
#pragma unroll
    for (int j = 0; j < 4; ++j) { const int nn = (lane >> 3) + 8 * j; const LAS float* s = scr + (8 * c) * 33 + nn;
        v4u o; o.x = pk2(s[0 * 33], s[1 * 33]); o.y = pk2(s[2 * 33], s[3 * 33]); o.z = pk2(s[4 * 33], s[5 * 33]); o.w = pk2(s[6 * 33], s[7 * 33]);
        *(GAS v4u*)(WT + (size_t)(drow0 + nn) * K + k0 + 8 * c) = o; }
    LDS_WAIT(); asm volatile("" ::: "memory");
}
__device__ __forceinline__ unsigned pk4_fp8(float a, float b, float c, float d) { int w = __builtin_amdgcn_cvt_pk_fp8_f32(a, b, 0, false); w = __builtin_amdgcn_cvt_pk_fp8_f32(c, d, w, true); return (unsigned)w; }
__device__ __forceinline__ void tr_item8(const float* W, int ldw, int K, unsigned char* WT, int drow0, int scol0, int nvalid, int k0, float scale, LAS float* scr, int lane) {
    const int n = lane & 31;
#pragma unroll 8
    for (int i = 0; i < 32; ++i) { const int kk = 2 * i + (lane >> 5); scr[kk * 33 + n] = (n < nvalid) ? W[(size_t)(k0 + kk) * ldw + scol0 + n] * scale : 0.f; }
    LDS_WAIT(); asm volatile("" ::: "memory");
    const int c = lane & 7;
#pragma unroll
    for (int j = 0; j < 4; ++j) { const int nn = (lane >> 3) + 8 * j; const LAS float* s = scr + (8 * c) * 33 + nn;
        v2u o; o.x = pk4_fp8(s[0 * 33], s[1 * 33], s[2 * 33], s[3 * 33]); o.y = pk4_fp8(s[4 * 33], s[5 * 33], s[6 * 33], s[7 * 33]);
        *(GAS v2u*)(WT + (size_t)(drow0 + nn) * K + k0 + 8 * c) = o; }
    LDS_WAIT(); asm volatile("" ::: "memory");
}
struct ConvItem { const float* src; unsigned char* dst; int ldw, dn; };
__device__ __forceinline__ ConvItem conv_item(Frame& F, int it) {
    constexpr int I_GU = NE * 32 * 128; ConvItem c;
    if (it < I_GU) { const int e = it / (32 * 128), q = it % (32 * 128), kb = q / 128, gp = q % 128, d0 = gp * 32, pn = d0 >> 8, j = d0 & 255, sc = j < 128 ? 128 * pn + j : 2048 + 128 * pn + (j - 128);
        c.src = F.ap->in[I_WGU] + (size_t)e * 2048 * 4096 + (size_t)(kb * 64) * 4096 + sc; c.dst = WSP(unsigned char, WS_WGU) + (size_t)e * 4096 * 2048 + (size_t)d0 * 2048 + kb * 64; c.ldw = 4096; c.dn = 0; }
    else { const int r = it - I_GU, e = r / (32 * 64), q = r % (32 * 64), kb = q / 64, gp = q % 64;
        const int d0 = gp * 32, trow = (d0 & ~255) + 32 * ((d0 >> 6) & 3) + 16 * ((d0 >> 5) & 1);
        c.src = F.ap->in[I_WDN] + (size_t)e * 2048 * 2048 + (size_t)(kb * 64) * 2048 + d0; c.dst = WSP(unsigned char, WS_WDN) + (size_t)e * 2048 * 2048 + (size_t)trow * 2048 + kb * 64; c.ldw = 2048; c.dn = 1; }
    return c;
}
__device__ __forceinline__ void convert_experts(Frame& F, int rank, int nranks) {
    constexpr int NIT = NE * 32 * 128 + NE * 32 * 64;
    LAS float* scr = (LAS float*)(F.lds + RING_OFF + F.wave * 16384);
    const int lane = F.lane, gw = rank * NWAVES + F.wave, NGW = nranks * NWAVES, c4 = lane & 7, r8 = lane >> 3;
    f32x4 cur[8], n1[8], n2[8]; ConvItem ci, c1, c2;
#define CONV_LOAD(dst, cc, it_) do { cc = conv_item(F, it_); _Pragma("unroll") for (int j = 0; j < 8; ++j) dst[j] = __builtin_nontemporal_load((const f32x4*)(cc.src + (size_t)(r8 + 8 * j) * cc.ldw + 4 * c4)); } while (0)
    if (gw < NIT) CONV_LOAD(cur, ci, gw);
    if (gw + NGW < NIT) CONV_LOAD(n1, c1, gw + NGW);
    for (int it = gw; it < NIT; it += NGW) {
        if (it + 2 * NGW < NIT) CONV_LOAD(n2, c2, it + 2 * NGW);
#pragma unroll
        for (int j = 0; j < 8; ++j) { LAS float* s = scr + (r8 + 8 * j) * 33 + 4 * c4; s[0] = cur[j].x * FP8_SW; s[1] = cur[j].y * FP8_SW; s[2] = cur[j].z * FP8_SW; s[3] = cur[j].w * FP8_SW; }
        LDS_WAIT(); asm volatile("" ::: "memory");
#pragma unroll
        for (int j = 0; j < 4; ++j) { const int nn = r8 + 8 * j; const LAS float* s = scr + (8 * c4) * 33 + nn;
            v2u o; o.x = pk4_fp8(s[0 * 33], s[1 * 33], s[2 * 33], s[3 * 33]); o.y = pk4_fp8(s[4 * 33], s[5 * 33], s[6 * 33], s[7 * 33]);
            const int drow = ci.dn ? 128 * (j & 1) + 8 * (j >> 1) + r8 : nn;
            __builtin_nontemporal_store(o, (v2u*)(ci.dst + (size_t)drow * 2048 + 8 * c4)); }
        LDS_WAIT(); asm volatile("" ::: "memory");
        ci = c1; c1 = c2;
#pragma unroll
        for (int j = 0; j < 8; ++j) { cur[j] = n1[j]; n1[j] = n2[j]; }
    }
#undef CONV_LOAD
}
__device__ __forceinline__ void p0_prologue(Frame& F) {
    LAS float* scr = (LAS float*)(F.lds + RING_OFF + F.wave * 16384);
    const int gw = F.wg * NWAVES + F.wave, NGW = F.G * NWAVES, lane = F.lane;
    constexpr int I_IN = 32 * 368, I_OA = 16 * 64, I_OB = I_OA, I_OUT = 32 * 64;
    constexpr int NITEMS = I_IN + I_OA + I_OB + I_OUT;
    for (int it = gw; it < NITEMS; it += NGW) {
        int r = it;
        if (r < I_IN) { const int kb = r / 368, gp = r % 368, c0 = gp * 32, oc = win_orig_col(c0); const int nv = oc < 0 ? 0 : (c0 == PC_F ? PC_FEND - PC_F : 32);
            const bool as8 = INPROJ_FP8 == 1 || (INPROJ_FP8 == 2 && c0 >= PC_SPLIT);
            if (as8) tr_item8(F.ap->in[I_WIN], 11720, 2048, WSP(unsigned char, WS_WIN8), c0, oc < 0 ? 0 : oc, nv, kb * 64, FP8_SW, scr, lane);
            else tr_item(F.ap->in[I_WIN], 11720, 2048, WSP(bf16, WS_WIN), c0, oc < 0 ? 0 : oc, nv, kb * 64, scr, lane);
            continue; } r -= I_IN;
        if (r < I_OA) { tr_item(F.ap->in[I_WOA], 2048, 1024, WSP(bf16, WS_WOA), (r % 64) * 32, (r % 64) * 32, 32, (r / 64) * 64, scr, lane); continue; } r -= I_OA;
        if (r < I_OB) { tr_item(F.ap->in[I_WOB], 2048, 1024, WSP(bf16, WS_WOB), (r % 64) * 32, (r % 64) * 32, 32, (r / 64) * 64, scr, lane); continue; } r -= I_OB;
#if OUTPROJ_FP8
        { tr_item8(F.ap->in[I_WOUT], 2048, 2048, WSP(unsigned char, WS_WOUT), (r % 64) * 32, (r % 64) * 32, 32, (r / 64) * 64, FP8_SW, scr, lane); }
#else
        { tr_item(F.ap->in[I_WOUT], 2048, 2048, WSP(bf16, WS_WOUT), (r % 64) * 32, (r % 64) * 32, 32, (r / 64) * 64, scr, lane); }
#endif
    }
    const int gt = F.wg * (NWAVES * 64) + F.tid, NGT = F.G * NWAVES * 64;
    { bf16* b1 = WSP(bf16, WS_BT1); const float* wd = F.ap->in[I_WDEC]; const float* wi = F.ap->in[I_WICLR];
      for (int i = gt; i < 2048 * 256; i += NGT) { const int n = i >> 8, k = i & 255; float v = 0.f;
          if (n < 1024) { if (k < 96) v = wd[k * 1024 + n]; } else { if (k >= 128 && k < 224) v = wi[(k - 128) * 1024 + (n - 1024)]; }
          b1[i] = (bf16)f2bf(v); } }
    { bf16* b2 = WSP(bf16, WS_BT2); const float* wg = F.ap->in[I_WGATE];
      for (int i = gt; i < 1024 * 256; i += NGT) { const int n = i >> 8, k = i & 255; b2[i] = (bf16)f2bf(wg[k * 1024 + n]); } }
    { float* wrt = WSP(float, WS_WRT); const float* wr = F.ap->in[I_WR];
      for (int i = gt; i < 32 * 2048; i += NGT) { const int e = i >> 11, k = i & 2047; wrt[i] = wr[k * 32 + e]; } }
    { bf16* h = WSP(bf16, WS_H) + (size_t)T * DM; for (int i = gt; i < DM; i += NGT) h[i] = 0; }
    if (F.wg < 192) {
        const float* wa = F.ap->in[I_WADA]; const float* cc = F.ap->in[I_C]; const int n = F.wg * 64 + lane;
        LAS float* sl = (LAS float*)(F.lds + RING_OFF + 131072 - 4096 - 16384);
        __syncthreads();
#pragma unroll
        for (int j = 0; j < 8; ++j) { const int i = F.tid + 512 * j; const float c = cc[i]; sl[i] = c * sigmoidf_(c); }
        __syncthreads();
        float s0 = 0.f, s1 = 0.f; const float* wp = wa + (size_t)(F.wave * 256) * 12288 + n; const LAS float* s0p = sl + F.wave * 256; const LAS float* s1p = sl + 2048 + F.wave * 256;
        for (int k = 0; k < 256; k += 16) { float w[16];
#pragma unroll
            for (int u = 0; u < 16; ++u) w[u] = wp[(size_t)(k + u) * 12288];
#pragma unroll
            for (int u = 0; u < 16; u += 4) { const f32x4 a = *(const LAS f32x4*)(s0p + k + u), c = *(const LAS f32x4*)(s1p + k + u);
                s0 += (a[0] * w[u] + a[1] * w[u + 1]) + (a[2] * w[u + 2] + a[3] * w[u + 3]); s1 += (c[0] * w[u] + c[1] * w[u + 1]) + (c[2] * w[u + 2] + c[3] * w[u + 3]); } }
        LAS float* red = (LAS float*)(F.lds + RING_OFF + 131072 - 4096);
        __syncthreads();
        red[(F.wave * 2 + 0) * 64 + lane] = s0; red[(F.wave * 2 + 1) * 64 + lane] = s1;
        __syncthreads();
        if (F.wave < 2) { float s = 0.f;
#pragma unroll
            for (int w = 0; w < 8; ++w) s += red[(w * 2 + F.wave) * 64 + lane];
            WSP(float, WS_MOD)[F.wave * 12288 + n] = s + F.ap->in[I_BADA][n]; }
    }
}
template <int OUT8> __device__ __forceinline__ void norm_mod_rows(Frame& F, const float* x, const float* g, int shift_off, int scale_off, bf16* H, unsigned char* H8) {
    const int gw = F.wg * NWAVES + F.wave, NGW = F.G * NWAVES, lane = F.lane; const float* mod = WSP(float, WS_MOD);
    for (int m = gw; m < T; m += NGW) {
        const f32x4* xr = (const f32x4*)(x + (size_t)m * DM) + lane; f32x4 v[8]; float ss = 0.f;
#pragma unroll
        for (int j = 0; j < 8; ++j) { v[j] = xr[64 * j]; ss += (v[j].x * v[j].x + v[j].y * v[j].y) + (v[j].z * v[j].z + v[j].w * v[j].w); }
        const float rs = rsqrtf(wave_sum(ss) * (1.f / DM) + NORM_EPS); const float* mb = mod + (size_t)(m / SEQ) * 12288;
#pragma unroll
        for (int j = 0; j < 8; ++j) { const int c = 4 * lane + 256 * j; const f32x4 gg = *(const f32x4*)(g + c), sc = *(const f32x4*)(mb + scale_off + c), sh = *(const f32x4*)(mb + shift_off + c);
            const f32x4 y = v[j] * rs * gg * (sc + 1.f) + sh;
            if constexpr (OUT8 != 0) *(unsigned*)(H8 + (size_t)m * DM + c) = pk4_fp8(y.x * FP8_SA1, y.y * FP8_SA1, y.z * FP8_SA1, y.w * FP8_SA1);
            if constexpr (OUT8 != 1) { v2u o; o.x = pk2(y.x, y.y); o.y = pk2(y.z, y.w); *(v2u*)(H + (size_t)m * DM + c) = o; } }
    }
}
struct PrepTok { v4u rkv[6]; v4u lo; v4u fq[2], fk[2]; unsigned fp; };
__device__ __forceinline__ void prep_load(PrepTok& k, const bf16* pc, int lane, int cl) {
#pragma unroll
    for (int s = 0; s < 6; ++s) k.rkv[s] = *(const v4u*)(pc + PC_R + (s * 64 + lane) * 8);
    k.lo = *(const v4u*)(pc + cl);
#pragma unroll
    for (int s = 0; s < 2; ++s) { k.fq[s] = *(const v4u*)(pc + PC_FQ + (s * 64 + lane) * 8); k.fk[s] = *(const v4u*)(pc + PC_FK + (s * 64 + lane) * 8); }
    k.fp = (unsigned)pc[PC_F + (lane & 7)];
}
__device__ __forceinline__ void p3_prep(Frame& F) {
    const int gw = F.wg * NWAVES + F.wave, lane = F.lane, t0 = gw * 16;
    const bf16* P = WSP(bf16, WS_P); const float* mu = F.ap->in[I_MU];
    bf16* Rb = WSP(bf16, WS_R); bf16* LW = WSP(bf16, WS_LW); bf16* SG = WSP(bf16, WS_SG);
    int cl, mi; if (lane < 32) { cl = PC_GLO + 8 * lane; mi = 3264 + 8 * lane; } else if (lane < 44) { cl = PC_DLO + 8 * (lane - 32); mi = 3072 + 8 * (lane - 32); } else if (lane < 56) { cl = PC_ALO + 8 * (lane - 44); mi = 3168 + 8 * (lane - 44); } else { cl = PC_ALO; mi = 3168; }
    f32x4 m0[6], m1[6];
#pragma unroll
    for (int s = 0; s < 6; ++s) { const int c = (s * 64 + lane) * 8; m0[s] = *(const f32x4*)(mu + c); m1[s] = *(const f32x4*)(mu + c + 4); }
    const f32x4 ml0 = *(const f32x4*)(mu + mi), ml1 = *(const f32x4*)(mu + mi + 4);
    f32x4 gq[2][2], gk[2][2];
#pragma unroll
    for (int s = 0; s < 2; ++s) { const int d0 = ((s * 64 + lane) & 15) * 8; gq[s][0] = *(const f32x4*)(F.ap->in[I_QN] + d0); gq[s][1] = *(const f32x4*)(F.ap->in[I_QN] + d0 + 4); gk[s][0] = *(const f32x4*)(F.ap->in[I_KN] + d0); gk[s][1] = *(const f32x4*)(F.ap->in[I_KN] + d0 + 4); }
    const float bfl = F.ap->in[I_BF][lane & 7];
    v4u prv[6], prvl; const v4u zz = {0u, 0u, 0u, 0u};
    if ((t0 % SEQ) == 0) {
#pragma unroll
        for (int s = 0; s < 6; ++s) prv[s] = zz; prvl = zz; }
    else { const bf16* pp = P + (size_t)(t0 - 1) * NP;
#pragma unroll
        for (int s = 0; s < 6; ++s) prv[s] = *(const v4u*)(pp + PC_R + (s * 64 + lane) * 8); prvl = *(const v4u*)(pp + cl); }
    PrepTok cur, nxt; prep_load(cur, P + (size_t)t0 * NP, lane, cl);
    for (int i = 0; i < 16; ++i) { const int t = t0 + i;
        if (i + 1 < 16) prep_load(nxt, P + (size_t)(t + 1) * NP, lane, cl);
#pragma unroll
        for (int s = 0; s < 6; ++s) { const int c = (s * 64 + lane) * 8; float a[8], b[8], o[8]; unpack8(cur.rkv[s], a); unpack8(prv[s], b);
#pragma unroll
            for (int j = 0; j < 8; ++j) { const float mm = j < 4 ? m0[s][j] : m1[s][j - 4]; o[j] = a[j] + mm * (b[j] - a[j]); }
            *(v4u*)(Rb + (size_t)(c >> 10) * ((WS_K - WS_R) / 2) + (size_t)t * RW + (c & 1023)) = pack8f(o); prv[s] = cur.rkv[s]; }
        { float o[8] = {0.f, 0.f, 0.f, 0.f, 0.f, 0.f, 0.f, 0.f};
          if (lane < 56) { float a[8], b[8]; unpack8(cur.lo, a); unpack8(prvl, b);
#pragma unroll
              for (int j = 0; j < 8; ++j) { const float mm = j < 4 ? ml0[j] : ml1[j - 4]; const float v = a[j] + mm * (b[j] - a[j]); o[j] = lane < 32 ? sigmoidf_(v) : (lane < 44 ? tanhf(v) : v); } }
          prvl = cur.lo;
          bf16* dst; if (lane < 32) dst = SG + (size_t)t * 256 + 8 * lane; else if (lane < 44) dst = LW + (size_t)t * 256 + 8 * (lane - 32); else if (lane < 56) dst = LW + (size_t)t * 256 + 128 + 8 * (lane - 44);
          else if (lane < 60) dst = LW + (size_t)t * 256 + 96 + 8 * (lane - 56); else dst = LW + (size_t)t * 256 + 224 + 8 * (lane - 60);
          *(v4u*)dst = pack8f(o); }
#pragma unroll
        for (int s = 0; s < 2; ++s) { const int ch = s * 64 + lane;
#pragma unroll
            for (int qk = 0; qk < 2; ++qk) { float a[8]; unpack8(qk ? cur.fk[s] : cur.fq[s], a); float ss = 0.f;
#pragma unroll
                for (int j = 0; j < 8; ++j) ss += a[j] * a[j];
                ss += __shfl_xor(ss, 1); ss += __shfl_xor(ss, 2); ss += __shfl_xor(ss, 4); ss += __shfl_xor(ss, 8);
                const float rs = rsqrtf(ss * (1.f / 128.f) + NORM_EPS); const f32x4 g0 = qk ? gk[s][0] : gq[s][0], g1 = qk ? gk[s][1] : gq[s][1];
#pragma unroll
                for (int j = 0; j < 8; ++j) a[j] = a[j] * rs * (j < 4 ? g0[j] : g1[j - 4]);
                *(v4u*)(WSP(bf16, qk ? WS_FK : WS_FQ) + (size_t)t * FW + ch * 8) = pack8f(a); } }
        if (lane < 8) { const float xv = bflo(cur.fp) + bfl;
            WSP(float, WS_LF)[(size_t)t * 8 + lane] = fminf(xv, 0.f) - log1pf(__expf(-fabsf(xv))); }
        cur = nxt;
    }
}
__device__ __forceinline__ void p4_cumsum(Frame& F) {
    if (F.wg >= 16) return;
    const int b = F.wg >> 3, h = F.wg & 7; const float* lf = WSP(float, WS_LF) + (size_t)b * SEQ * 8 + h; float* cs = WSP(float, WS_CS) + (size_t)F.wg * SEQ;
    LAS float* part = (LAS float*)(F.lds + RING_OFF); LAS float* tend = part + 512; LAS float* tstart = part + 768;
    const int t0 = F.tid * 32; float s = 0.f;
    for (int i = 0; i < 32; ++i) s += lf[(size_t)(t0 + i) * 8];
    part[F.tid] = s; __syncthreads();
    if (F.tid == 0) { float run = 0.f; for (int i = 0; i < 512; ++i) { const float v = part[i]; part[i] = run; run += v; } }
    __syncthreads();
    float run = part[F.tid];
    for (int i = 0; i < 32; ++i) { run += lf[(size_t)(t0 + i) * 8]; const float c = -run * 11.313708498984761f; cs[t0 + i] = c;
        if (i == 0 && (F.tid & 7) == 0) tstart[F.tid >> 3] = c; if (i == 31 && (F.tid & 1)) tend[F.tid >> 1] = c; }
    __syncthreads();
    if (F.tid < 64) { const float* qn = F.ap->in[I_QN]; const float* kn = F.ap->in[I_KN]; float mq = fmaxf(fabsf(qn[F.tid]), fabsf(qn[F.tid + 64])), mk = fmaxf(fabsf(kn[F.tid]), fabsf(kn[F.tid + 64]));
#pragma unroll
        for (int o = 1; o < 64; o <<= 1) { mq = fmaxf(mq, __shfl_xor(mq, o)); mk = fmaxf(mk, __shfl_xor(mk, o)); }
        const float horizon = 2.f * 1.01f * 11.313708498984761f * mq * mk + 9.704060527839234f + FOX_SKIP_BITS * 0.6931471805599453f;
        const int qb = F.tid; const float target = tstart[qb] - horizon * 11.313708498984761f; int lo = 0, hi = 4 * qb;
        while (lo < hi) { const int mid = (lo + hi) >> 1; if (tend[mid] >= target) hi = mid; else lo = mid + 1; }
        WSP(int, WS_JLO)[F.wg * 64 + qb] = lo; }
    __syncthreads();
}
__device__ __forceinline__ void p5_scan_naive(Frame& F) {
    constexpr int CH = 64;
    LAS float* Wl = (LAS float*)(F.lds + RING_OFF); LAS float* Al = Wl + CH * 64; LAS float* Bl = Al + CH * 64; LAS float* Kl = Bl + CH * 64; LAS float* Rl = Kl + CH * 64; LAS float* Vl = Rl + CH * 64; LAS float* Yl = Vl + CH * 64;
    const int tid = F.tid, row = tid >> 3, q = tid & 7;
    for (int bh = F.wg; bh < 32; bh += F.G) {
        const int b = bh >> 4, h = bh & 15; const size_t base = (size_t)b * SEQ * RW + h * 64;
        const bf16* Rg = WSP(bf16, WS_R) + base; const bf16* Kg = WSP(bf16, WS_K) + base; const bf16* Vg = WSP(bf16, WS_V) + base; const bf16* Ag = WSP(bf16, WS_A) + base;
        const float* Lg = WSP(float, WS_LOGW) + base; float* Yg = WSP(float, WS_YRAW) + base;
        float kkw[8], kaw[8];
#pragma unroll
        for (int i = 0; i < 8; ++i) { kkw[i] = F.ap->in[I_KK][h * 64 + 8 * q + i]; kaw[i] = F.ap->in[I_KA][h * 64 + 8 * q + i]; }
        float S[8] = {0.f, 0.f, 0.f, 0.f, 0.f, 0.f, 0.f, 0.f};
        for (int t0 = 0; t0 < SEQ; t0 += CH) {
            { const size_t off = (size_t)(t0 + row) * RW + 8 * q; float r[8], k[8], v[8], a[8];
              unpack8(*(const v4u*)(Rg + off), r); unpack8(*(const v4u*)(Kg + off), k); unpack8(*(const v4u*)(Vg + off), v); unpack8(*(const v4u*)(Ag + off), a);
              const f32x4 l0 = *(const f32x4*)(Lg + off), l1 = *(const f32x4*)(Lg + off + 4);
              float kk[8], ss = 0.f;
#pragma unroll
              for (int i = 0; i < 8; ++i) { kk[i] = k[i] * kkw[i]; ss += kk[i] * kk[i]; }
              ss += __shfl_xor(ss, 1); ss += __shfl_xor(ss, 2); ss += __shfl_xor(ss, 4);
              const float inv = 1.f / fmaxf(sqrtf(ss), 1e-12f);
#pragma unroll
              for (int i = 0; i < 8; ++i) { const int o = row * 64 + 8 * q + i; kk[i] *= inv;
                  Wl[o] = __expf(i < 4 ? l0[i] : l1[i - 4]); Al[o] = -kk[i]; Bl[o] = kk[i] * a[i]; Kl[o] = k[i] * (1.f + (a[i] - 1.f) * kaw[i]); Rl[o] = r[i]; Vl[o] = v[i]; } }
            __syncthreads();
            for (int t = 0; t < CH; ++t) { const int o = t * 64 + 8 * q; float sa = 0.f;
                const f32x4 a0 = *(const LAS f32x4*)(Al + o), a1 = *(const LAS f32x4*)(Al + o + 4), w0 = *(const LAS f32x4*)(Wl + o), w1 = *(const LAS f32x4*)(Wl + o + 4);
                const f32x4 b0 = *(const LAS f32x4*)(Bl + o), b1 = *(const LAS f32x4*)(Bl + o + 4), k0 = *(const LAS f32x4*)(Kl + o), k1 = *(const LAS f32x4*)(Kl + o + 4);
                const f32x4 r0 = *(const LAS f32x4*)(Rl + o), r1 = *(const LAS f32x4*)(Rl + o + 4); const float vv = Vl[t * 64 + row];
#pragma unroll
                for (int i = 0; i < 8; ++i) sa += S[i] * (i < 4 ? a0[i] : a1[i - 4]);
                sa += __shfl_xor(sa, 1); sa += __shfl_xor(sa, 2); sa += __shfl_xor(sa, 4);
                float y = 0.f;
#pragma unroll
                for (int i = 0; i < 8; ++i) { S[i] = S[i] * (i < 4 ? w0[i] : w1[i - 4]) + sa * (i < 4 ? b0[i] : b1[i - 4]) + vv * (i < 4 ? k0[i] : k1[i - 4]); y += S[i] * (i < 4 ? r0[i] : r1[i - 4]); }
                y += __shfl_xor(y, 1); y += __shfl_xor(y, 2); y += __shfl_xor(y, 4);
                if (q == 0) Yl[t * 64 + row] = y; }
            __syncthreads();
            { const int tt = tid >> 3, c = (tid & 7) * 8; *(f32x4*)(Yg + (size_t)(t0 + tt) * RW + c) = *(const LAS f32x4*)(Yl + tt * 64 + c); *(f32x4*)(Yg + (size_t)(t0 + tt) * RW + c + 4) = *(const LAS f32x4*)(Yl + tt * 64 + c + 4); }
        }
        __syncthreads();
    }
}
struct PostTok { v4u y[2], r[2], k[2], v[2], a[2], g[2]; };
__device__ __forceinline__ void post_load(PostTok& p, const unsigned char* ws, size_t off) {
#pragma unroll
    for (int j = 0; j < 2; ++j) { p.y[j] = *(const v4u*)((const bf16*)(ws + WS_YRAW) + off + 8 * j); p.r[j] = *(const v4u*)((const bf16*)(ws + WS_R) + off + 8 * j); p.k[j] = *(const v4u*)((const bf16*)(ws + WS_K) + off + 8 * j);
        p.v[j] = *(const v4u*)((const bf16*)(ws + WS_V) + off + 8 * j); p.a[j] = *(const v4u*)((const bf16*)(ws + WS_A) + off + 8 * j); p.g[j] = *(const v4u*)((const bf16*)(ws + WS_G) + off + 8 * j); }
}
__device__ __forceinline__ void p7_post(Frame& F) {
    const int gw = F.wg * NWAVES + F.wave, NGW = F.G * NWAVES, lane = F.lane, c0 = 16 * lane;
    float ka[16], rk[16], gng[16], gnb[16];
#pragma unroll
    for (int i = 0; i < 16; ++i) { ka[i] = F.ap->in[I_KA][c0 + i]; rk[i] = F.ap->in[I_RK][c0 + i]; gng[i] = F.ap->in[I_GNG][c0 + i]; gnb[i] = F.ap->in[I_GNB][c0 + i]; }
    PostTok cur, nxt; if (gw < T) post_load(cur, F.ws, (size_t)gw * RW + c0);
    for (int t = gw; t < T; t += NGW) { const size_t off = (size_t)t * RW + c0;
        if (t + NGW < T) post_load(nxt, F.ws, (size_t)(t + NGW) * RW + c0);
        float y[16], r[16], k[16], v[16], a[16], g[16];
#pragma unroll
        for (int j = 0; j < 2; ++j) { float tmp[8];
            unpack8(cur.y[j], tmp); for (int i = 0; i < 8; ++i) y[8 * j + i] = tmp[i];
            unpack8(cur.r[j], tmp); for (int i = 0; i < 8; ++i) r[8 * j + i] = tmp[i];
            unpack8(cur.k[j], tmp); for (int i = 0; i < 8; ++i) k[8 * j + i] = tmp[i];
            unpack8(cur.v[j], tmp); for (int i = 0; i < 8; ++i) v[8 * j + i] = tmp[i];
            unpack8(cur.a[j], tmp); for (int i = 0; i < 8; ++i) a[8 * j + i] = tmp[i];
            unpack8(cur.g[j], tmp); for (int i = 0; i < 8; ++i) g[8 * j + i] = tmp[i]; }
        float s = 0.f, bs = 0.f;
#pragma unroll
        for (int i = 0; i < 16; ++i) { s += y[i]; const float kp = k[i] * (1.f + (a[i] - 1.f) * ka[i]); bs += r[i] * kp * rk[i]; }
        s += __shfl_xor(s, 1); s += __shfl_xor(s, 2); bs += __shfl_xor(bs, 1); bs += __shfl_xor(bs, 2);
        const float mean = s * (1.f / 64.f); float q = 0.f;
#pragma unroll
        for (int i = 0; i < 16; ++i) { const float d = y[i] - mean; q += d * d; }
        q += __shfl_xor(q, 1); q += __shfl_xor(q, 2);
        const float rstd = rsqrtf(q * (1.f / 64.f) + GN_EPS); float o[16];
#pragma unroll
        for (int i = 0; i < 16; ++i) o[i] = ((y[i] - mean) * rstd * gng[i] + gnb[i] + bs * v[i]) * g[i];
#pragma unroll
        for (int j = 0; j < 2; ++j) { v4u w; w.x = pk2(o[8 * j], o[8 * j + 1]); w.y = pk2(o[8 * j + 2], o[8 * j + 3]); w.z = pk2(o[8 * j + 4], o[8 * j + 5]); w.w = pk2(o[8 * j + 6], o[8 * j + 7]); *(v4u*)(WSP(bf16, WS_YA) + off + 8 * j) = w; }
        cur = nxt;
    }
}
__device__ __forceinline__ fox::BlockRef<fox::bf16, fox::bf16> fox_ref(int L_, const unsigned char* ws) {
    const int it = ((const int*)(ws + WS_AORD))[L_], bh = it & 15, qb = it >> 4;
    fox::BlockRef<fox::bf16, fox::bf16> r; r.ws = ws; r.row0 = (bh / fox::H) * fox::SQ + qb * fox::QB; r.bh = bh; r.P0 = qb * fox::QB; r.jlo = ((const int*)(ws + WS_JLO))[bh * 64 + qb]; return r;
}
__device__ __forceinline__ void att_order(Frame& F) {
    LAS int* hist = (LAS int*)(F.lds + RING_OFF); LAS int* base = hist + 260;
    for (int i = F.tid; i < 260; i += NWAVES * 64) hist[i] = 0;
    __syncthreads();
    const int* jl = WSP(int, WS_JLO); int cost[2];
#pragma unroll
    for (int u = 0; u < 2; ++u) { const int it = F.tid + 512 * u, bh = it & 15, qb = it >> 4; cost[u] = 4 * (qb + 1) - jl[bh * 64 + qb]; __hip_atomic_fetch_add(hist + cost[u], 1, __ATOMIC_RELAXED, __HIP_MEMORY_SCOPE_WORKGROUP); }
    __syncthreads();
    if (F.tid == 0) { int run = 0; for (int c = 256; c >= 0; --c) { base[c] = run; run += hist[c]; } }
    __syncthreads();
#pragma unroll
    for (int u = 0; u < 2; ++u) { const int it = F.tid + 512 * u; const int pos = __hip_atomic_fetch_add(base + cost[u], 1, __ATOMIC_RELAXED, __HIP_MEMORY_SCOPE_WORKGROUP); WSP(int, WS_AORD)[pos] = it; }
    __syncthreads();
}
__device__ __forceinline__ int att_fetch(Frame& F, int qi = 0) {
    if (F.tid == 0) F.MISC[4] = __hip_atomic_fetch_add(F.ctl + CW_ATTQ + qi, 1u, RLX_AGENT);
    __syncthreads(); const int v = (int)F.MISC[4]; __syncthreads(); return v;
}
__device__ __forceinline__ void p6_attention(Frame& F, char* lds, int qi = 0) {
    constexpr int TOTAL = (fox::SQ / fox::QB) * fox::B * fox::H;
    int L = att_fetch(F, qi); if (L >= TOTAL) return;
    fox::BlockRef<fox::bf16, fox::bf16> cur = fox_ref(L, F.ws);
    fox::Seam<fox::bf16> S;
    fox::causal_swa_prime<fox::bf16, fox::bf16>(cur, fox::WINDOW, lds, S, F.tid);
    for (;;) {
        const int Ln = att_fetch(F, qi); const bool last = Ln >= TOTAL;
        const fox::BlockRef<fox::bf16, fox::bf16> nxt = last ? cur : fox_ref(Ln, F.ws);
        fox::causal_swa_block<fox::bf16, fox::bf16>(cur, nxt, fox::SKV, fox::WINDOW, lds, S, F.tid);
        if (last) break;
        cur = nxt;
    }
}
typedef float f32x4m __attribute__((ext_vector_type(4)));
__device__ __forceinline__ void p11_router(Frame& F) {
    constexpr int TPW = T / 256 / NWAVES, XP = 136;
    const int lane = F.lane, t0 = (F.wg * NWAVES + F.wave) * TPW;
    const float* x1 = WSP(float, WS_X1); const float* mod = WSP(float, WS_MOD) + (size_t)(t0 / SEQ) * 12288; const float* g2 = F.ap->in[I_N2G]; const float* wrt = WSP(float, WS_WRT);
    LAS float* xs = (LAS float*)(F.lds + RING_OFF + F.wave * (16 * XP * 4));
    LAS float* av = (LAS float*)(F.lds + RING_OFF + 69632); LAS float* sv = av + DM;
    LAS float* lg = (LAS float*)(F.lds + RING_OFF + 86016 + F.wave * 2304);
    LAS int* cnt = (LAS int*)(F.lds + RING_OFF + 104448);
    LAS float* cpart = (LAS float*)(F.lds + RING_OFF + 104704);
    if (F.tid < 32) cnt[F.tid] = 0;
    { const int c = 4 * F.tid; const f32x4 gg = *(const f32x4*)(g2 + c), sc = *(const f32x4*)(mod + 4 * 2048 + c), sh = *(const f32x4*)(mod + 3 * 2048 + c);
      *(LAS f32x4*)(av + c) = gg * (sc + 1.f); *(LAS f32x4*)(sv + c) = sh; }
    __syncthreads();
    { const int e = F.tid & 31, part = F.tid >> 5; float s = 0.f;
      for (int k = 128 * part; k < 128 * part + 128; k += 4) { const f32x4 w = *(const f32x4*)(wrt + (size_t)e * DM + k), h = *(const LAS f32x4*)(sv + k); s += (w[0] * h[0] + w[1] * h[1]) + (w[2] * h[2] + w[3] * h[3]); }
      cpart[part * 32 + e] = s; }
    __syncthreads();
    if (F.tid < 32) { float s = F.ap->in[I_BR][F.tid];
#pragma unroll
        for (int p = 0; p < 16; ++p) s += cpart[p * 32 + F.tid];
        cpart[512 + F.tid] = s; }
    __syncthreads();
    const int i = lane & 15, q = lane >> 4, hf = lane >> 5, l32 = lane & 31;
    { const float* sp = WSP(float, WS_SSP) + (size_t)(8 * q) * T + t0 + i; float s = 0.f;
#pragma unroll
      for (int p = 0; p < 8; ++p) s += sp[(size_t)p * T];
      s += __shfl_xor(s, 16); s += __shfl_xor(s, 32); if (q == 0) lg[512 + i] = rsqrtf(s * (1.f / DM) + NORM_EPS); }
    LDS_WAIT(); asm volatile("" ::: "memory");
    float rsj[8];
#pragma unroll
    for (int j = 0; j < 8; ++j) rsj[j] = lg[512 + 2 * j + hf];
    unsigned char* H2 = WSP(unsigned char, WS_HS) + (size_t)(t0 + hf) * DM + 4 * l32;
    f32x4m acc0 = {0.f, 0.f, 0.f, 0.f}, acc1 = {0.f, 0.f, 0.f, 0.f};
    const float* xrow = x1 + (size_t)(t0 + hf) * DM + 4 * l32; const float* wr = wrt + (size_t)i * DM + 4 * q;
    for (int k0 = 0; k0 < DM; k0 += 128) { f32x4 xv[8], w0[8], w1[8];
#pragma unroll
        for (int j = 0; j < 8; ++j) xv[j] = *(const f32x4*)(xrow + (size_t)(2 * j) * DM + k0);
#pragma unroll
        for (int u = 0; u < 8; ++u) { w0[u] = *(const f32x4*)(wr + k0 + 16 * u); w1[u] = *(const f32x4*)(wr + 16 * DM + k0 + 16 * u); }
        const f32x4 a4 = *(const LAS f32x4*)(av + k0 + 4 * l32), s4 = *(const LAS f32x4*)(sv + k0 + 4 * l32) * FP8_SA1;
#pragma unroll
        for (int j = 0; j < 8; ++j) { const f32x4 xa = xv[j] * a4, hh = xa * (rsj[j] * FP8_SA1) + s4; *(LAS f32x4*)(xs + (2 * j + hf) * XP + 4 * l32) = xa;
            *(unsigned*)(H2 + (size_t)(2 * j) * DM + k0) = pk4_fp8(hh[0], hh[1], hh[2], hh[3]); }
        LDS_WAIT(); asm volatile("" ::: "memory");
#pragma unroll
        for (int u = 0; u < 8; ++u) { const f32x4 hv = *(const LAS f32x4*)(xs + i * XP + 16 * u + 4 * q);
#pragma unroll
            for (int jj = 0; jj < 4; ++jj) { acc0 = __builtin_amdgcn_mfma_f32_16x16x4f32(hv[jj], w0[u][jj], acc0, 0, 0, 0); acc1 = __builtin_amdgcn_mfma_f32_16x16x4f32(hv[jj], w1[u][jj], acc1, 0, 0, 0); } }
        LDS_WAIT(); asm volatile("" ::: "memory"); }
    { const float c0 = cpart[512 + i], c1 = cpart[512 + 16 + i];
#pragma unroll
      for (int r = 0; r < 4; ++r) { const float rs = lg[512 + 4 * q + r]; lg[(4 * q + r) * 32 + i] = acc0[r] * rs + c0; lg[(4 * q + r) * 32 + 16 + i] = acc1[r] * rs + c1; } }
    LDS_WAIT(); asm volatile("" ::: "memory");
    if (lane < 16) { const int m = t0 + lane; float v[4]; int e[4]; unsigned used = 0u;
#pragma unroll
        for (int k = 0; k < 4; ++k) { float best = -3.0e38f; int bi = 0;
            for (int j = 0; j < 32; ++j) { const float x = lg[lane * 32 + j]; if (!((used >> j) & 1u) && x > best) { best = x; bi = j; } }
            used |= 1u << bi; v[k] = best; e[k] = bi; }
        const float e1 = __expf(v[1] - v[0]), e2 = __expf(v[2] - v[0]), e3 = __expf(v[3] - v[0]), inv = 1.f / (1.f + e1 + e2 + e3);
        *(f32x4*)(WSP(float, WS_TOKW) + (size_t)m * 4) = (f32x4){inv, e1 * inv, e2 * inv, e3 * inv};
        int* te = WSP(int, WS_TOKE) + (size_t)m * 4; te[0] = e[0]; te[1] = e[1]; te[2] = e[2]; te[3] = e[3];
#pragma unroll
        for (int k = 0; k < 4; ++k) __hip_atomic_fetch_add(cnt + e[k], 1, __ATOMIC_RELAXED, __HIP_MEMORY_SCOPE_WORKGROUP); }
    __syncthreads();
    if (F.tid < 32) WSP(int, WS_WGCNT)[F.wg * 32 + F.tid] = cnt[F.tid];
    __syncthreads();
}
__device__ __forceinline__ void p12_slots(Frame& F) {
    constexpr int TPG = T / 256;
    LAS int* cur = (LAS int*)(F.lds + RING_OFF); LAS int* tot = cur + 32; LAS int* pre = cur + 64; LAS int* off = cur + 96; LAS int* slotl = cur + 160;
    const int* wgcnt = WSP(int, WS_WGCNT);
    if (F.tid < 32) { int tt = 0, pp = 0; for (int w = 0; w < 256; ++w) { const int c = wgcnt[w * 32 + F.tid]; if (w < F.wg) pp += c; tt += c; } tot[F.tid] = tt; pre[F.tid] = pp; }
    __syncthreads();
    if (F.tid == 0) { int o = 0; for (int e = 0; e < 32; ++e) { off[e] = o; o += (tot[e] + 255) & ~255; } off[32] = o; }
    __syncthreads();
    if (F.tid < 32) cur[F.tid] = off[F.tid] + pre[F.tid];
    if (F.wg == 0) { int* te = WSP(int, WS_TILEE); const int nt = off[32] >> 8;
        for (int p = F.tid; p < nt; p += NWAVES * 64) { int e = 0; for (int j = 1; j < 32; ++j) if ((p << 8) >= off[j]) e = j; te[p] = e; }
        if (F.tid == 0) te[1024] = nt; }
    __syncthreads();
    { const int t = F.wg * TPG + (F.tid >> 2), k = F.tid & 3; const int e = WSP(int, WS_TOKE)[(size_t)t * 4 + k];
      const int s = __hip_atomic_fetch_add(cur + e, 1, __ATOMIC_RELAXED, __HIP_MEMORY_SCOPE_WORKGROUP);
      WSP(int, WS_TOKS)[(size_t)t * 4 + k] = s; WSP(int, WS_STOK)[s] = t; WSP(float, WS_SLOTW)[s] = WSP(float, WS_TOKW)[(size_t)t * 4 + k]; }
    if (F.wg < 32) { const int s = off[F.wg] + tot[F.wg] + F.tid; if (s < off[F.wg + 1]) WSP(int, WS_STOK)[s] = 0; }
    __syncthreads();
}
__device__ __forceinline__ void p15_final(Frame& F) {
    const int gw = F.wg * NWAVES + F.wave, NGW = F.G * NWAVES, lane = F.lane;
    const float* x1 = WSP(float, WS_X1); const unsigned char* YS = WSP(unsigned char, WS_YS); const float* gf = F.ap->in[I_NFG];
    typedef float f32x2f __attribute__((ext_vector_type(2)));
#ifdef PROBE_P17X
    for (int mm = gw; mm < 2 * T; mm += NGW) { const int m = mm & (T - 1); const float* gt = WSP(float, WS_MOD) + (size_t)(m / SEQ) * 12288 + 5 * 2048;
#else
    for (int m = gw; m < T; m += NGW) { const float* gt = WSP(float, WS_MOD) + (size_t)(m / SEQ) * 12288 + 5 * 2048;
#endif
        const int4 sl = *(const int4*)(WSP(int, WS_TOKS) + (size_t)m * 4); f32x4 v[8]; float ss = 0.f;
        const unsigned char* y0 = YS + (size_t)sl.x * DM + 4 * lane; const unsigned char* y1 = YS + (size_t)sl.y * DM + 4 * lane; const unsigned char* y2 = YS + (size_t)sl.z * DM + 4 * lane; const unsigned char* y3 = YS + (size_t)sl.w * DM + 4 * lane;
#pragma unroll
        for (int u = 0; u < 8; ++u) { const int c = 256 * u + 4 * lane;
            const int q0 = *(const int*)(y0 + 256 * u), q1 = *(const int*)(y1 + 256 * u), q2 = *(const int*)(y2 + 256 * u), q3 = *(const int*)(y3 + 256 * u);
            const f32x4 xa = *(const f32x4*)(x1 + (size_t)m * DM + c), ga = *(const f32x4*)(gt + c);
            const f32x2f s0 = (__builtin_amdgcn_cvt_pk_f32_fp8(q0, false) + __builtin_amdgcn_cvt_pk_f32_fp8(q1, false)) + (__builtin_amdgcn_cvt_pk_f32_fp8(q2, false) + __builtin_amdgcn_cvt_pk_f32_fp8(q3, false));
            const f32x2f s1 = (__builtin_amdgcn_cvt_pk_f32_fp8(q0, true) + __builtin_amdgcn_cvt_pk_f32_fp8(q1, true)) + (__builtin_amdgcn_cvt_pk_f32_fp8(q2, true) + __builtin_amdgcn_cvt_pk_f32_fp8(q3, true));
            const f32x4 y = (f32x4){s0.x, s0.y, s1.x, s1.y} * (1.f / FP8_SY), xv = xa + ga * y; v[u] = xv; ss += (xv[0] * xv[0] + xv[1] * xv[1]) + (xv[2] * xv[2] + xv[3] * xv[3]); }
        const float rs = rsqrtf(wave_sum(ss) * (1.f / DM) + NORM_EPS);
#pragma unroll
        for (int u = 0; u < 8; ++u) { const int c = 256 * u + 4 * lane; const f32x4 ga = *(const f32x4*)(gf + c); *(f32x4*)(F.ap->out + (size_t)m * DM + c) = v[u] * rs * ga; }
    }
}

__device__ __forceinline__ void stagger(Frame& F, int ticks_step) {
    const unsigned long long t0 = __builtin_amdgcn_s_memrealtime(), d = (unsigned long long)(((F.wg * 5) & 7) * ticks_step);
    while (__builtin_amdgcn_s_memrealtime() - t0 < d) __builtin_amdgcn_s_sleep(8);
}
__device__ __forceinline__ bool fresh(Frame& F) {
    asm volatile("" : "+s"(F.ap)); int w = F.wave; asm volatile("" : "+s"(w)); const int l = __builtin_amdgcn_mbcnt_hi(~0u, __builtin_amdgcn_mbcnt_lo(~0u, 0u)); F.lane = l; F.tid = w * 64 + l; return true; }
constexpr int N_PHASES = 18;
#ifndef STAGGER_TICKS
#define STAGGER_TICKS 400
#endif
#ifndef N_CONV_WG
#define N_CONV_WG 96
#endif
__global__ void __launch_bounds__(NWAVES * 64, 2) mk_fwd(Args args) {
    extern __shared__ __attribute__((aligned(16))) unsigned char lds[];
    Frame F;
    F.lds = (LAS unsigned char*)lds; F.MISC = (volatile LAS unsigned*)(F.lds + MISC_OFF);
    F.tid = threadIdx.x; F.lane = F.tid & 63; F.wave = __builtin_amdgcn_readfirstlane(F.tid >> 6); F.G = gridDim.x; F.wg = blockIdx.x;
    F.ap = (ArgsP)__builtin_amdgcn_kernarg_segment_ptr(); F.ws = F.ap->ws; F.ctl = (gu32*)(F.ws + WS_CTL);
    for (int u = F.tid; u < (LDS_BYTES - LDSCTL_OFF) / 4; u += NWAVES * 64) ((LAS unsigned*)(F.lds + LDSCTL_OFF))[u] = 0u;
    __syncthreads();
    const int lo = F.ap->ph_lo, hi = F.ap->ph_hi;
    XcdBarrier bar; bar.bar = (unsigned*)(F.ctl + CW_BAR); bar.x = 0; bar.st = nullptr;
    if (hi - lo > 1) bar = xcd_barrier_post((unsigned*)(F.ctl + CW_BAR), F.MISC + 8, F.tid);
#ifndef PH_MASK
#define PH_MASK 0x3ffff
#endif
#define IN(k) (((PH_MASK >> (k)) & 1) && lo <= (k) && (k) < hi && fresh(F))
#ifndef PROBE_DUP
#define PROBE_DUP 0
#endif
#ifndef PROBE_PHASEA
#define PROBE_PHASEA -1
#endif
#ifndef PROBE_TILE_EPI
#define PROBE_TILE_EPI 0
#endif
#ifndef PROBE_NULL_EPI
#define PROBE_NULL_EPI 0
#endif
#define REP(k) for (int rep_ = 0; rep_ < 1 + ((PROBE_DUP >> (k)) & 1); ++rep_)
#define SEAM_NB(k) do { } while (0)
#define SEAM(k) do { if (IN(k) && IN((k) + 1)) xcd_barrier(bar, F.tid); } while (0)
    if (IN(0)) REP(0) { p0_prologue(F); } SEAM(0);
    if (IN(1)) REP(1) { norm_mod_rows<INPROJ_FP8>(F, F.ap->in[I_X], F.ap->in[I_N1G], 0, 2048, WSP(bf16, WS_H), WSP(unsigned char, WS_H8)); } SEAM(1);
    if (IN(2)) REP(2) {
#if INPROJ_FP8 == 1
        pg8::Gemm g{WSP(bf16, WS_H8), WSP(bf16, WS_WIN8), T, NP, DM / 2}; pg8::StaticOrder S; S.init(T, NP, F.G, F.wg);
        pg8::EpiBf16S E{WSP(bf16, WS_P), NP, 1.f / (FP8_SA1 * FP8_SW)}; pg8::gemm_phase<pg8::EpiBf16S, pg8::StaticOrder, true, true, true>(F.lds + RING_OFF, g, S, E, F.tid);
#elif INPROJ_FP8 == 2
        pg8::Gemm g{WSP(bf16, WS_H8), (const pg8::bf16_t*)(F.ws + WS_WIN8 + (size_t)PC_SPLIT * DM), T, NP - PC_SPLIT, DM / 2}; pg8::StaticOrder S; S.init(T, NP - PC_SPLIT, F.G, F.wg);
#ifdef PROBE_EXTRA_ST
        pg8::EpiBf16S E{WSP(bf16, WS_P) + PC_SPLIT, NP, 1.f / (FP8_SA1 * FP8_SW), (pg8::bf16_t*)(F.ws + WS_END + (size_t)F.wg * 131072)};
#else
        pg8::EpiBf16S E{WSP(bf16, WS_P) + PC_SPLIT, NP, 1.f / (FP8_SA1 * FP8_SW)};
#endif
        pg8::gemm_phase<pg8::EpiBf16S, pg8::StaticOrder, true, true, true>(F.lds + RING_OFF, g, S, E, F.tid);
#else
        pg8::Gemm g{WSP(bf16, WS_H), WSP(bf16, WS_WIN), T, NP, DM}; pg8::StaticOrder S; S.init(T, NP, F.G, F.wg);
        pg8::EpiBf16<0> E{WSP(bf16, WS_P), NP, nullptr, 0, 0, 1.f}; pg8::gemm_phase<pg8::EpiBf16<0>, pg8::StaticOrder, true, true>(F.lds + RING_OFF, g, S, E, F.tid);
#endif
        } SEAM_NB(2);
#if INPROJ_FP8 == 2
    if (IN(2)) { (void)fresh(F); pg8::Gemm g{WSP(bf16, WS_H), WSP(bf16, WS_WIN), T, PC_SPLIT, DM}; pg8::StaticOrder S; S.init(T, PC_SPLIT, F.G, F.wg);
        pg8::EpiBf16<0> E{WSP(bf16, WS_P), NP, nullptr, 0, 0, 1.f}; pg8::gemm_phase<pg8::EpiBf16<0>, pg8::StaticOrder, true, true>(F.lds + RING_OFF, g, S, E, F.tid); }
#endif
    SEAM(2);
    if (IN(3)) REP(3) { p3_prep(F); } SEAM(3);
    if (IN(4)) REP(4) { p4_cumsum(F);
        { pg8::Gemm g{WSP(bf16, WS_LW), WSP(bf16, WS_BT1), T, 2048, 256}; pg8::StaticOrder S; S.init(T, 2048, F.G, F.wg);
          pg8::EpiLora1 E{WSP(float, WS_LOGW), WSP(bf16, WS_A), F.ap->in[I_W0], F.ap->in[I_A0]}; pg8::gemm_phase<pg8::EpiLora1, pg8::StaticOrder, true, true>(F.lds + RING_OFF, g, S, E, F.tid); }
        } SEAM(4);
    if (IN(5)) REP(5) { if (F.wg == 0) att_order(F);
        { pg8::Gemm g{WSP(bf16, WS_SG), WSP(bf16, WS_BT2), T, 1024, 256}; pg8::StaticOrder S; S.init(T, 1024, F.G, F.wg);
          pg8::EpiBf16<0> E{WSP(bf16, WS_G), 1024, nullptr, 0, 0, 1.f}; pg8::gemm_phase<pg8::EpiBf16<0>, pg8::StaticOrder, true, true>(F.lds + RING_OFF, g, S, E, F.tid); }
        } SEAM(5);
    if (IN(6)) REP(6) {
#if RWKV_NAIVE
        p5_scan_naive(F);
#else
        rw::phase_a<0>(F.lds + RING_OFF, F.ws, WS_REC, F.ap->in[I_KK], F.ap->in[I_KA], F.wg, F.G, F.tid);
#if PROBE_PHASEA >= 0
        __syncthreads(); rw::phase_a<PROBE_PHASEA>(F.lds + RING_OFF, F.ws, WS_END, F.ap->in[I_KK], F.ap->in[I_KA], F.wg, F.G, F.tid);
#endif
#endif
        } SEAM(6);
    if (IN(7)) REP(7) {
#if !RWKV_NAIVE
        for (int bh = F.wg; bh < 32; bh += F.G) { const int b = bh >> 4, h = bh & 15;
            rw::phase_b_head(F.lds + RING_OFF, F.ws + WS_REC + (size_t)bh * 256 * rw::REC, WSP(unsigned short, WS_YRAW) + (size_t)b * SEQ * RW + h * 64, F.tid); __syncthreads(); }
#endif
        if (F.wg >= 32 && F.wg < 32 + N_CONV_WG) { convert_experts(F, F.wg - 32, N_CONV_WG); __syncthreads(); }
        p6_attention(F, (char*)lds + RING_OFF, 0); } SEAM(7);
#ifdef PROBE_P7
    if (IN(8)) {
        for (int bh = F.wg; bh < 32; bh += F.G) { const int b = bh >> 4, h = bh & 15;
            rw::phase_b_head(F.lds + RING_OFF, F.ws + WS_REC + (size_t)bh * 256 * rw::REC, WSP(unsigned short, WS_YRAW) + (size_t)b * SEQ * RW + h * 64, F.tid); __syncthreads(); }
        if (F.wg >= 32 && F.wg < 32 + N_CONV_WG) { convert_experts(F, F.wg - 32, N_CONV_WG); __syncthreads(); }
        p6_attention(F, (char*)lds + RING_OFF, 1); } SEAM(8);
#endif
    if (IN(9)) REP(9) { p7_post(F); } SEAM(9);
    if (IN(10)) REP(10) { pg8::Gemm g{WSP(bf16, WS_YA), WSP(bf16, WS_WOA), T, DM, 1024}; pg8::StaticOrder S; S.init(T, DM, F.G, F.wg);
        pg8::EpiGateMerge<0> E{WSP(bf16, WS_MRG), WSP(bf16, WS_P), PC_GA, nullptr}; pg8::gemm_phase<pg8::EpiGateMerge<0>, pg8::StaticOrder, true, true>(F.lds + RING_OFF, g, S, E, F.tid); } SEAM(10);
    if (IN(11)) REP(11) { pg8::Gemm g{WSP(bf16, WS_YB), WSP(bf16, WS_WOB), T, DM, 1024}; pg8::StaticOrder S; S.init(T, DM, F.G, F.wg);
        pg8::EpiGateMerge<1> E{WSP(bf16, WS_MRG), WSP(bf16, WS_P), PC_GB, WSP(unsigned char, WS_MRG8)}; pg8::gemm_phase<pg8::EpiGateMerge<1>, pg8::StaticOrder, true, true>(F.lds + RING_OFF, g, S, E, F.tid); } SEAM(11);
#if OUTPROJ_FP8
    if (IN(12)) REP(12) { pg8::Gemm g{WSP(bf16, WS_MRG8), WSP(bf16, WS_WOUT), T, DM, DM / 2}; pg8::StaticOrder S; S.init(T, DM, F.G, F.wg);
        pg8::EpiResid E{F.ap->in[I_X], WSP(float, WS_X1), WSP(float, WS_MOD), WSP(float, WS_SSP), 1.f / (FP8_SM * FP8_SW)}; pg8::gemm_phase<pg8::EpiResid, pg8::StaticOrder, true, true, true>(F.lds + RING_OFF, g, S, E, F.tid); } SEAM(12);
#else
    if (IN(12)) REP(12) { pg8::Gemm g{WSP(bf16, WS_MRG), WSP(bf16, WS_WOUT), T, DM, DM}; pg8::StaticOrder S; S.init(T, DM, F.G, F.wg);
        pg8::EpiResid E{F.ap->in[I_X], WSP(float, WS_X1), WSP(float, WS_MOD), WSP(float, WS_SSP), 1.f}; pg8::gemm_phase<pg8::EpiResid, pg8::StaticOrder, true, true>(F.lds + RING_OFF, g, S, E, F.tid); } SEAM(12);
#endif
    if (IN(13)) REP(13) { p11_router(F); } SEAM(13);
    if (IN(14)) REP(14) { p12_slots(F); } SEAM(14);
    if (IN(15)) REP(15) { const int nt = WSP(int, WS_TILEE)[1024]; pg8::Gemm g{WSP(bf16, WS_HS), WSP(bf16, WS_WGU), nt * 256, 4096, DM / 2, WSP(int, WS_STOK)}; pg8::MoeOrder S; S.init(nt * 256, 4096, F.G, F.wg); S.tile_e = WSP(int, WS_TILEE);
        pg8::EpiSwiglu E{WSP(unsigned char, WS_ACT), F.ap->in[I_BGU]}; pg8::gemm_phase<pg8::EpiSwiglu, pg8::MoeOrder, true, true, true, true>(F.lds + RING_OFF, g, S, E, F.tid); } SEAM(15);
    if (IN(16)) REP(16) { const int nt = WSP(int, WS_TILEE)[1024]; pg8::Gemm g{WSP(bf16, WS_ACT), WSP(bf16, WS_WDN), nt * 256, 2048, DFF / 2}; pg8::MoeOrder S; S.init(nt * 256, 2048, F.G, F.wg); S.tile_e = WSP(int, WS_TILEE);
        pg8::EpiDown E{WSP(unsigned char, WS_YS), F.ap->in[I_BDN], WSP(float, WS_SLOTW)}; pg8::gemm_phase<pg8::EpiDown, pg8::MoeOrder, true, true, true>(F.lds + RING_OFF, g, S, E, F.tid); } SEAM(16);
    if (IN(17)) REP(17) { p15_final(F); }
#undef IN
#undef SEAM
}

extern "C" void kernel_launch(void* const* d_in, const int* in_sizes, int n_in, void* d_out, int out_size, void* d_ws, size_t ws_size, hipStream_t stream) {
    static int grid = 0;
    if (grid == 0) {
        if (n_in != N_IN || in_sizes[0] != T * DM || out_size != T * DM || ws_size < WS_END) { fprintf(stderr, "kernel_launch: shape/workspace mismatch (n_in %d, in0 %d, out %d, ws %zu < %zu)\n", n_in, n_in > 0 ? in_sizes[0] : -1, out_size, ws_size, (size_t)WS_END); grid = -1; return; }
        if (hipFuncSetAttribute((const void*)mk_fwd, hipFuncAttributeMaxDynamicSharedMemorySize, LDS_BYTES) != hipSuccess) { fprintf(stderr, "kernel_launch: hipFuncSetAttribute failed\n"); grid = -1; return; }
        int per_cu = 0;
        if (hipOccupancyMaxActiveBlocksPerMultiprocessor(&per_cu, (const void*)mk_fwd, NWAVES * 64, LDS_BYTES) != hipSuccess || per_cu < 1) fprintf(stderr, "kernel_launch: note: occupancy query reports %d workgroups per CU\n", per_cu);
        (void)hipGetLastError();
        grid = 256;
    }
    if (grid < 0) return;
    (void)hipMemsetAsync((char*)d_ws + WS_CTL, 0, CTL_ZERO_BYTES, stream);
    Args a{};
    for (int i = 0; i < N_IN; ++i) a.in[i] = (const float*)d_in[i];
    a.out = (float*)d_out; a.ws = (unsigned char*)d_ws;
#if MK_N_LAUNCHES == 1
    a.ph_lo = 0; a.ph_hi = N_PHASES;
    hipLaunchKernelGGL(mk_fwd, dim3(grid), dim3(NWAVES * 64), LDS_BYTES, stream, a);
#else
    for (int p = 0; p < N_PHASES; ++p) { a.ph_lo = p; a.ph_hi = p + 1; hipLaunchKernelGGL(mk_fwd, dim3(grid), dim3(NWAVES * 64), LDS_BYTES, stream, a); }
#endif
}
```

```cpp
#include <hip/hip_runtime.h>
#include <hip/hip_bf16.h>
#include <cstdio>
#include <cstdint>
constexpr int NWAVES = 8;
#ifndef MK_N_LAUNCHES
#define MK_N_LAUNCHES 1
#endif
#ifndef INPROJ_FP8
#define INPROJ_FP8 2
#endif
#ifndef OUTPROJ_FP8
#define OUTPROJ_FP8 1
#endif
#ifndef RWKV_NAIVE
#define RWKV_NAIVE 0
#endif
constexpr int BATCH = 2, SEQ = 16384, DM = 2048, T = BATCH * SEQ;
constexpr int NP = 11776;
constexpr int PC_R = 0, PC_K = 1024, PC_V = 2048, PC_GLO = 3072, PC_DLO = 3328, PC_ALO = 3424, PC_F = 3520, PC_FEND = 3528, PC_SPLIT = 3584, PC_GA = 3584, PC_FQ = 5632, PC_FK = 6656, PC_FV = 7680, PC_OG = 8704, PC_GB = 9728;
constexpr int RW = 1024, FW = 1024, NE = 32, DFF = 2048, TOPK = 4;
constexpr int NSLOT = T * TOPK + NE * 256;
constexpr float NORM_EPS = 1e-6f, GN_EPS = 64e-5f;
constexpr float FOX_SKIP_BITS = 32.f;
constexpr float FP8_SY = 16.f;
constexpr float FP8_SM = 16.f;
constexpr float FP8_SW = 64.f, FP8_SA1 = 2.f, FP8_SA2 = 4.f;

constexpr size_t MiB = 1u << 20;
constexpr size_t WS_CTL = 0, CTL_ZERO_BYTES = 1 * MiB;
constexpr size_t WS_MOD = 1 * MiB;
constexpr size_t WS_WRT = 1 * MiB + 128 * 1024;
constexpr size_t WS_TOKE = 2 * MiB, WS_TOKW = 2 * MiB + 512 * 1024, WS_TOKS = 3 * MiB, WS_SLOTW = 3 * MiB + 512 * 1024;
constexpr size_t WS_WGCNT = 4 * MiB + 512 * 1024, WS_TILEE = 4 * MiB + 768 * 1024;
constexpr size_t WS_RS = 4 * MiB + 832 * 1024;
constexpr size_t WS_AORD = 4 * MiB + 808 * 1024;
constexpr size_t WS_JLO = 4 * MiB + 800 * 1024;
constexpr size_t WS_LF = 5 * MiB, WS_CS = 6 * MiB;
constexpr size_t WS_STOK = 5 * MiB;
constexpr size_t WS_BT1 = 7 * MiB, WS_BT2 = 8 * MiB, WS_WOA = 9 * MiB, WS_WOB = 13 * MiB, WS_WOUT = 17 * MiB, WS_WIN = 25 * MiB;
constexpr size_t WS_WGU = 72 * MiB, WS_WDN = 584 * MiB, WS_X1 = 840 * MiB, WS_H = 1096 * MiB;
constexpr size_t WS_P = 1226 * MiB, WS_R = 1962 * MiB, WS_K = 2026 * MiB, WS_V = 2090 * MiB, WS_FQ = 2154 * MiB, WS_FK = 2218 * MiB, WS_FV = 2282 * MiB;
constexpr size_t WS_LW = 2346 * MiB, WS_SG = 2362 * MiB, WS_LOGW = 2378 * MiB, WS_A = 2506 * MiB, WS_G = 2570 * MiB, WS_YRAW = 2634 * MiB, WS_YA = 2762 * MiB, WS_YB = 2826 * MiB, WS_MRG = 2890 * MiB;
constexpr size_t WS_HS = 1226 * MiB, WS_ACT = 1500 * MiB, WS_YS = 1774 * MiB;
constexpr size_t WS_WIN8 = 3274 * MiB, WS_H8 = 3298 * MiB;
constexpr size_t WS_REC = 3018 * MiB;
constexpr size_t WS_SSP = 3362 * MiB;
constexpr size_t WS_MRG8 = 3366 * MiB;
constexpr size_t WS_END = 3430 * MiB;
static_assert(WS_WIN + (size_t)NP * DM * 2 <= WS_WGU && WS_YS + (size_t)NSLOT * DM * 2 <= WS_REC && WS_HS + (size_t)NSLOT * DM <= WS_ACT && WS_ACT + (size_t)NSLOT * DFF <= WS_YS && WS_SLOTW + (size_t)NSLOT * 4 <= WS_WGCNT, "d_ws map");
constexpr int CW_TMO = 0, CW_ATTQ = 2048, CW_BAR = 4096;

constexpr int RING_OFF = 0, RING_BYTES = 143360;
constexpr int LDSCTL_OFF = RING_BYTES, MISC_OFF = LDSCTL_OFF + 320;
constexpr int LDS_BYTES = 147456;

#define GAS __attribute__((address_space(1)))
#define LAS __attribute__((address_space(3)))
typedef unsigned short bf16;
typedef unsigned v4u __attribute__((ext_vector_type(4)));
typedef unsigned v2u __attribute__((ext_vector_type(2)));
typedef float f32x4 __attribute__((ext_vector_type(4)));
typedef short bf16x8 __attribute__((ext_vector_type(8)));
typedef GAS unsigned gu32;
#define RLX_AGENT __ATOMIC_RELAXED, __HIP_MEMORY_SCOPE_AGENT
#define LDS_WAIT() asm volatile("s_waitcnt lgkmcnt(0)" ::: "memory")
#define VM_WAIT() asm volatile("s_waitcnt vmcnt(0)" ::: "memory")
__device__ __forceinline__ unsigned f2bf(float f) { unsigned u = __builtin_bit_cast(unsigned, f); return (u + 0x7fffu + ((u >> 16) & 1u)) >> 16; }
__device__ __forceinline__ unsigned pk2(float lo, float hi) { return f2bf(lo) | (f2bf(hi) << 16); }
__device__ __forceinline__ float bflo(unsigned w) { return __uint_as_float(w << 16); }
__device__ __forceinline__ float bfhi(unsigned w) { return __uint_as_float(w & 0xffff0000u); }
__device__ __forceinline__ void unpack8(v4u w, float (&f)[8]) { f[0] = bflo(w.x); f[1] = bfhi(w.x); f[2] = bflo(w.y); f[3] = bfhi(w.y); f[4] = bflo(w.z); f[5] = bfhi(w.z); f[6] = bflo(w.w); f[7] = bfhi(w.w); }
__device__ __forceinline__ v4u pack8f(const float (&f)[8]) { v4u w; w.x = pk2(f[0], f[1]); w.y = pk2(f[2], f[3]); w.z = pk2(f[4], f[5]); w.w = pk2(f[6], f[7]); return w; }
__device__ __forceinline__ float sigmoidf_(float x) { return 1.f / (1.f + __expf(-x)); }
__device__ __forceinline__ float wave_sum(float v) {
#pragma unroll
    for (int o = 1; o < 64; o <<= 1) v += __shfl_xor(v, o);
    return v;
}
namespace pg8 {
#define PG8_LAS __attribute__((address_space(3)))
typedef unsigned short bf16_t;
typedef short bf16x8 __attribute__((ext_vector_type(8)));
typedef float f32x4 __attribute__((ext_vector_type(4)));
typedef unsigned u32x4 __attribute__((ext_vector_type(4)));
constexpr int BM = 256, BK = 64, HALF = 128, HTB = HALF * BK * 2  , STAGE_BYTES = 8 * HTB, NXCD = 8, WGM = 8;

__host__ __device__ __forceinline__ int lds_byte(int r, int c) { const int st = (r >> 4) * 2 + (c >> 5), rr = r & 15, cc = c & 31, ob = rr * 64 + cc * 2; return st * 1024 + (ob ^ (((ob >> 9) & 1) << 5)); }
__host__ __device__ __forceinline__ void stage_rc(int b, int& R, int& C) { const int st = b / 1024, sb = b % 1024, swz = sb ^ (((sb >> 9) & 1) << 5); R = (st >> 1) * 16 + swz / 64; C = (st & 1) * 32 + (swz % 64) / 2; }
__host__ __device__ __forceinline__ int perm32(int rho) { const int n = rho >> 4, i = rho & 15; return 8 * (i >> 2) + 4 * n + (i & 3); }

struct Unit { int pm, pn, e; };
struct Gemm { const bf16_t* A; const bf16_t* Bt; int M, N, K; const int* rowmap = nullptr; };

struct StaticOrder {
    int nM, nN, nwg, G, c;
    __host__ __device__ void init(int M, int N, int G_, int c_) { nM = M / BM; nN = N / BM; nwg = nM * nN; G = G_; c = c_; }
    __host__ __device__ bool next(int i, Unit& u) const {
        const long L = (long)i * G + c; if (L >= nwg) return false;
        int wgid = (int)L; { const int q = nwg / NXCD, r = nwg % NXCD, xcd = wgid % NXCD, off = wgid / NXCD; wgid = (xcd < r ? xcd * (q + 1) : r * (q + 1) + (xcd - r) * q) + off; }
        const int nig = WGM * nN, gid = wgid / nig, fm = gid * WGM, gsz = (nM - fm) < WGM ? (nM - fm) : WGM;
        u.pm = fm + ((wgid % nig) % gsz); u.pn = (wgid % nig) / gsz; u.e = 0; return true;
    }
    __device__ __forceinline__ void a_ready(const Unit&) const {}
    __device__ __forceinline__ void done(const Unit&) const {}
};

__device__ __forceinline__ unsigned cvt_pk_bf16(float lo, float hi) { unsigned r; asm volatile("v_cvt_pk_bf16_f32 %0, %1, %2" : "=v"(r) : "v"(lo), "v"(hi)); return r; }
typedef float f32x2 __attribute__((ext_vector_type(2)));
__device__ __forceinline__ f32x2 gelu_pk(f32x2 v) {
    const f32x2 av = __builtin_elementwise_abs(v), d = av * 0.2316418882f + 1.0f;
    f32x2 t; t.x = __builtin_amdgcn_rcpf(d.x); t.y = __builtin_amdgcn_rcpf(d.y);
    f32x2 q = t * 0.5307027145f + (-0.7265760135f); q = q * t + 0.7107068705f; q = q * t + (-0.142248368f); q = q * t + 0.127414796f; q = q * t;
    const f32x2 s = (v * v) * (-0.72134752044f);
    f32x2 e; e.x = __builtin_amdgcn_exp2f(s.x); e.y = __builtin_amdgcn_exp2f(s.y);
    const f32x2 m = v * (q * e), r = v - m;
    f32x2 o; o.x = v.x < 0.f ? m.x : r.x; o.y = v.y < 0.f ? m.y : r.y; return o;
}

template <int ACT  > struct EpiBf16 {
    static constexpr bool PERM = true, AFTER_DRAIN = false; static_assert(ACT == 0 || ACT == 1, "EpiBf16: ACT is 0 (none) or 1 (gelu_pk)");
    bf16_t* O; int ldc; const float* bias; int split_cols; size_t split_stride; float scale0;
    __device__ __forceinline__ void operator()(const f32x4 (&acc)[2][2][4][2], const Unit& u, int wr, int wc, int fr, int fq) const {
        const int row0 = u.pm * BM + wr * 64 + fr; int colt = u.pn * BM; bf16_t* base = O;
        float sc = 1.f; if (split_cols) { const int t = colt / split_cols; base += (size_t)t * split_stride; colt -= t * split_cols; if (t == 0) sc = scale0; }
        const int col0 = colt + wc * 32 + 8 * fq, bcol0 = u.pn * BM + wc * 32 + 8 * fq;
        f32x4 bv[2][2];
#pragma unroll
        for (int bj = 0; bj < 2; ++bj)
#pragma unroll
            for (int n = 0; n < 2; ++n) bv[bj][n] = bias ? *(const f32x4*)(bias + bcol0 + bj * HALF + 4 * n) : (f32x4){0.f, 0.f, 0.f, 0.f};
#pragma unroll
        for (int ai = 0; ai < 2; ++ai)
#pragma unroll
            for (int m = 0; m < 4; ++m) { bf16_t* rowp = base + (size_t)(row0 + ai * HALF + m * 16) * ldc + col0;
#pragma unroll
                for (int bj = 0; bj < 2; ++bj) { f32x4 v0 = acc[ai][bj][m][0] + bv[bj][0], v1 = acc[ai][bj][m][1] + bv[bj][1];
                    if (ACT == 1) { f32x2 a = gelu_pk((f32x2){v0[0], v0[1]}), b = gelu_pk((f32x2){v0[2], v0[3]}), c = gelu_pk((f32x2){v1[0], v1[1]}), d = gelu_pk((f32x2){v1[2], v1[3]});
                        v0 = (f32x4){a.x, a.y, b.x, b.y}; v1 = (f32x4){c.x, c.y, d.x, d.y}; }
                    v0 = v0 * sc; v1 = v1 * sc; u32x4 w; w.x = cvt_pk_bf16(v0[0], v0[1]); w.y = cvt_pk_bf16(v0[2], v0[3]); w.z = cvt_pk_bf16(v1[0], v1[1]); w.w = cvt_pk_bf16(v1[2], v1[3]);
                    *(u32x4*)(rowp + bj * HALF) = w; } }
    }
};

typedef int v4i_t __attribute__((ext_vector_type(4))); typedef int v8i_t __attribute__((ext_vector_type(8)));
template <class Epi, class Sched, bool ALIGN_EPI = false, bool SP2 = false, bool FP8 = false, bool GATHER = false>
__device__ __forceinline__ void gemm_phase(PG8_LAS unsigned char* lds, const Gemm g, const Sched& S, const Epi& E, const int tid) {
    const int wid = __builtin_amdgcn_readfirstlane(tid >> 6), lane = tid & 63, wr = wid >> 2, wc = wid & 3, fr = lane & 15, fq = lane >> 4;
    const int K = g.K, nt = K / BK;
    static_assert(!GATHER || SP2, "GATHER is written for the SP2 loop");
    unsigned voffA[2], voffB[2]; int gR[2]; unsigned gC[2];
#pragma unroll
    for (int i = 0; i < 2; ++i) { int R, C; stage_rc(tid * 16 + i * 8192, R, C); const int Rb = Epi::PERM ? ((R & ~31) + perm32(R & 31)) : R;
        voffA[i] = (unsigned)(R * K + C) * 2u; voffB[i] = (unsigned)(Rb * K + C) * 2u; gR[i] = R; gC[i] = (unsigned)C * 2u; }
    unsigned vC[2][2], vN[2][2]; int raw[2][2];
#define PG8_ROWS_ISSUE(u) do { _Pragma("unroll") for (int _h = 0; _h < 2; ++_h) _Pragma("unroll") for (int _i = 0; _i < 2; ++_i) raw[_h][_i] = g.rowmap[(u).pm * BM + _h * HALF + gR[_i]]; } while (0)
#define PG8_ROWS_MAKE(v) do { _Pragma("unroll") for (int _h = 0; _h < 2; ++_h) _Pragma("unroll") for (int _i = 0; _i < 2; ++_i) { asm volatile("" : "+v"(raw[_h][_i])); (v)[_h][_i] = (unsigned)raw[_h][_i] * (unsigned)(K * 2) + gC[_i]; } } while (0)
    const size_t kstep = (size_t)(BK * 2);
    const size_t hstep = (size_t)HALF * K * 2;
    const size_t tstep = 2 * hstep;
    const unsigned ldsw = (unsigned)wid * 1024u;
    const int aoff = lds_byte(wr * 64 + fr, fq * 8), boff = lds_byte(wc * 32 + fr, fq * 8);
#define PG8_SA(b, h) (((b) * 2 + (h)) * HTB)
#define PG8_SB(b, h) ((4 + (b) * 2 + (h)) * HTB)
#define PG8_STAGE(bufoff, gbase, voff) do { _Pragma("unroll") for (int _i = 0; _i < 2; ++_i) \
        __builtin_amdgcn_global_load_lds((const unsigned*)((const char*)(gbase) + (voff)[_i]), (PG8_LAS unsigned*)(lds + (bufoff) + ldsw + _i * 8192), 16, 0, 0); } while (0)
#define PG8_STAGE_A(bufoff, ptr, h, nx) do { if constexpr (GATHER) { _Pragma("unroll") for (int _i = 0; _i < 2; ++_i) { const unsigned _vo = (nx) ? vN[h][_i] : vC[h][_i]; \
        __builtin_amdgcn_global_load_lds((const unsigned*)((const char*)(ptr) + _vo), (PG8_LAS unsigned*)(lds + (bufoff) + ldsw + _i * 8192), 16, 0, 0); } } else PG8_STAGE(bufoff, (ptr) + (h) * hstep, voffA); } while (0)
#define PG8_CAT(x0, x1) __builtin_shufflevector(__builtin_bit_cast(v4i_t, x0), __builtin_bit_cast(v4i_t, x1), 0, 1, 2, 3, 4, 5, 6, 7)
#define PG8_LDA(dst, b, h) do { _Pragma("unroll") for (int m = 0; m < 4; ++m) { if constexpr (FP8) dst##8[m] = PG8_CAT(*(const PG8_LAS bf16x8*)(lds + PG8_SA(b, h) + aoff + m * 2048), *(const PG8_LAS bf16x8*)(lds + PG8_SA(b, h) + aoff + m * 2048 + 1024)); \
        else { _Pragma("unroll") for (int k = 0; k < 2; ++k) dst[m][k] = *(const PG8_LAS bf16x8*)(lds + PG8_SA(b, h) + aoff + m * 2048 + k * 1024); } } } while (0)
#define PG8_LDB(dst, b, h) do { _Pragma("unroll") for (int n = 0; n < 2; ++n) { if constexpr (FP8) dst##8[n] = PG8_CAT(*(const PG8_LAS bf16x8*)(lds + PG8_SB(b, h) + boff + n * 2048), *(const PG8_LAS bf16x8*)(lds + PG8_SB(b, h) + boff + n * 2048 + 1024)); \
        else { _Pragma("unroll") for (int k = 0; k < 2; ++k) dst[n][k] = *(const PG8_LAS bf16x8*)(lds + PG8_SB(b, h) + boff + n * 2048 + k * 1024); } } } while (0)
#define PG8_MMA16(ai, bj, At, Bt) do { __builtin_amdgcn_s_setprio(1); _Pragma("unroll") for (int m = 0; m < 4; ++m) _Pragma("unroll") for (int n = 0; n < 2; ++n) _Pragma("unroll") for (int k = 0; k < 2; ++k) \
        acc[ai][bj][m][n] = __builtin_amdgcn_mfma_f32_16x16x32_bf16(Bt[n][k], At[m][k], acc[ai][bj][m][n], 0, 0, 0); __builtin_amdgcn_s_setprio(0); } while (0)
#define PG8_MMA8(ai, bj, At, Bt) do { __builtin_amdgcn_s_setprio(1); _Pragma("unroll") for (int m = 0; m < 4; ++m) _Pragma("unroll") for (int n = 0; n < 2; ++n) \
        asm volatile("v_mfma_scale_f32_16x16x128_f8f6f4 %0, %1, %2, %0, %3, %3 op_sel_hi:[0,0,0]" : "+v"(acc[ai][bj][m][n]) : "v"(Bt##8[n]), "v"(At##8[m]), "v"(one_scale)); __builtin_amdgcn_s_setprio(0); } while (0)
#define PG8_MMA(ai, bj, At, Bt) do { if constexpr (FP8) PG8_MMA8(ai, bj, At, Bt); else PG8_MMA16(ai, bj, At, Bt); } while (0)
#define PG8_WAIT_V(n) asm volatile("s_waitcnt vmcnt(" #n ")" ::: "memory")
#define PG8_WAIT_L(n) asm volatile("s_waitcnt lgkmcnt(" #n ")" ::: "memory")
#define PG8_BAR __builtin_amdgcn_s_barrier()
#define PG8_SCHED __builtin_amdgcn_sched_barrier(0)
    Unit cur, nxt; int ui = 0;
    if (!S.next(0, cur)) return;
    f32x4 acc[2][2][4][2];
#pragma unroll
    for (int a = 0; a < 2; ++a)
#pragma unroll
        for (int b = 0; b < 2; ++b)
#pragma unroll
            for (int m = 0; m < 4; ++m)
#pragma unroll
                for (int n = 0; n < 2; ++n) acc[a][b][m][n] = (f32x4){0.f, 0.f, 0.f, 0.f};
    bf16x8 At[4][2], B0[2][2], B1[2][2]; v8i_t At8[4], B08[2], B18[2];
    int one_scale = 0x7f7f7f7f; asm volatile("" : "+v"(one_scale));
    const char* cA = (const char*)g.A + (GATHER ? (size_t)0 : (size_t)cur.pm * tstep); const size_t estep = (size_t)g.N * K * 2; const char* cB = (const char*)g.Bt + (size_t)cur.e * estep + (size_t)cur.pn * tstep;
    S.a_ready(cur);
    if constexpr (GATHER) { PG8_ROWS_ISSUE(cur); PG8_ROWS_MAKE(vC); }
    if constexpr (SP2) {
        PG8_STAGE(PG8_SB(0, 0), cB, voffB); PG8_STAGE(PG8_SB(0, 1), cB + hstep, voffB); PG8_STAGE_A(PG8_SA(0, 0), cA, 0, false); PG8_STAGE_A(PG8_SA(0, 1), cA, 1, false);
        if (wr == 1) PG8_BAR;
        PG8_WAIT_V(2); PG8_BAR;
        PG8_STAGE(PG8_SB(1, 0), cB + kstep, voffB); PG8_STAGE_A(PG8_SA(1, 0), cA + kstep, 0, false); PG8_STAGE(PG8_SB(1, 1), cB + hstep + kstep, voffB);
        PG8_WAIT_V(6); PG8_BAR;
    } else {
        PG8_STAGE(PG8_SB(0, 0), cB, voffB); PG8_STAGE(PG8_SA(0, 0), cA, voffA); PG8_STAGE(PG8_SB(0, 1), cB + hstep, voffB); PG8_STAGE(PG8_SA(0, 1), cA + hstep, voffA);
        if (wr == 1) PG8_BAR;
        PG8_WAIT_V(4); PG8_BAR;
        PG8_STAGE(PG8_SB(1, 0), cB + kstep, voffB); PG8_STAGE(PG8_SA(1, 0), cA + kstep, voffA); PG8_STAGE(PG8_SB(1, 1), cB + hstep + kstep, voffB);
        PG8_WAIT_V(6); PG8_BAR;
    }
    for (;;) {
        const bool has_next = S.next(ui + 1, nxt);
        if constexpr (GATHER) { if (has_next) PG8_ROWS_ISSUE(nxt); }
        const char* nA = (has_next && !GATHER) ? (const char*)g.A + (size_t)nxt.pm * tstep : cA; const char* nB = has_next ? (const char*)g.Bt + (size_t)nxt.e * estep + (size_t)nxt.pn * tstep : cB;
        for (int t = 0; t < nt; t += 2) {
            const bool last = (t == nt - 2);
            const char* a1 = cA + (size_t)(t + 1) * kstep;
            const char* a2 = last ? nA : cA + (size_t)(t + 2) * kstep; const char* b2 = last ? nB : cB + (size_t)(t + 2) * kstep;
            const char* a3 = a2 + kstep; const char* b3 = b2 + kstep;
            if (last && has_next) S.a_ready(nxt);
            const bool nx = last && has_next; (void)nx;
            if constexpr (SP2) {
            PG8_LDB(B0, 0, 0); PG8_LDB(B1, 0, 1); PG8_SCHED; PG8_LDA(At, 0, 0); PG8_STAGE_A(PG8_SA(1, 1), a1, 1, false);
            PG8_WAIT_V(8); PG8_WAIT_L(0); PG8_BAR; PG8_MMA(0, 0, At, B0); PG8_MMA(0, 1, At, B1); PG8_BAR; PG8_SCHED;
            PG8_LDA(At, 0, 1); PG8_STAGE(PG8_SB(0, 0), b2, voffB); PG8_STAGE(PG8_SB(0, 1), b2 + hstep, voffB); PG8_STAGE_A(PG8_SA(0, 0), a2, 0, nx);
            PG8_WAIT_V(8); PG8_WAIT_L(0); PG8_BAR; PG8_MMA(1, 0, At, B0); PG8_MMA(1, 1, At, B1); PG8_BAR; PG8_SCHED;
            PG8_LDB(B0, 1, 0); PG8_LDB(B1, 1, 1); PG8_SCHED; PG8_LDA(At, 1, 0); PG8_STAGE_A(PG8_SA(0, 1), a2, 1, nx);
            PG8_WAIT_V(8); PG8_WAIT_L(0); PG8_BAR; PG8_MMA(0, 0, At, B0); PG8_MMA(0, 1, At, B1); PG8_BAR; PG8_SCHED;
            PG8_LDA(At, 1, 1); PG8_STAGE(PG8_SB(1, 0), b3, voffB); PG8_STAGE(PG8_SB(1, 1), b3 + hstep, voffB); PG8_STAGE_A(PG8_SA(1, 0), a3, 0, nx);
            PG8_WAIT_V(8); PG8_WAIT_L(0); PG8_BAR; PG8_MMA(1, 0, At, B0); PG8_MMA(1, 1, At, B1); PG8_BAR; PG8_SCHED;
            if constexpr (GATHER) { if (t == 0 && has_next) PG8_ROWS_MAKE(vN); }
            } else {
            PG8_LDB(B0, 0, 0); PG8_SCHED; PG8_LDA(At, 0, 0); PG8_STAGE(PG8_SA(1, 1), a1 + hstep, voffA);
            PG8_WAIT_L(8); PG8_BAR; PG8_WAIT_L(0); PG8_MMA(0, 0, At, B0); PG8_BAR; PG8_SCHED;
            PG8_LDB(B1, 0, 1); PG8_STAGE(PG8_SB(0, 0), b2, voffB);
            PG8_BAR; PG8_WAIT_L(0); PG8_MMA(0, 1, At, B1); PG8_BAR;
            PG8_LDA(At, 0, 1); PG8_STAGE(PG8_SA(0, 0), a2, voffA);
            PG8_BAR; PG8_WAIT_L(0); PG8_MMA(1, 0, At, B0); PG8_BAR; PG8_SCHED;
            PG8_STAGE(PG8_SB(0, 1), b2 + hstep, voffB);
            PG8_WAIT_V(6); PG8_BAR; PG8_MMA(1, 1, At, B1); PG8_BAR;
            PG8_LDB(B0, 1, 0); PG8_SCHED; PG8_LDA(At, 1, 0); PG8_STAGE(PG8_SA(0, 1), a2 + hstep, voffA);
            PG8_WAIT_L(8); PG8_BAR; PG8_WAIT_L(0); PG8_MMA(0, 0, At, B0); PG8_BAR; PG8_SCHED;
            PG8_LDB(B1, 1, 1); PG8_STAGE(PG8_SB(1, 0), b3, voffB);
            PG8_BAR; PG8_WAIT_L(0); PG8_MMA(0, 1, At, B1); PG8_BAR;
            PG8_LDA(At, 1, 1); PG8_STAGE(PG8_SA(1, 0), a3, voffA);
            PG8_BAR; PG8_WAIT_L(0); PG8_MMA(1, 0, At, B0); PG8_BAR; PG8_SCHED;
            PG8_STAGE(PG8_SB(1, 1), b3 + hstep, voffB);
            PG8_WAIT_V(6); PG8_BAR; PG8_MMA(1, 1, At, B1); PG8_BAR;
            }
        }
        if constexpr (ALIGN_EPI) { if (wr == 0) PG8_BAR; }
        if constexpr (FP8) asm volatile("s_nop 15\n\ts_nop 15" ::: "memory");
        if constexpr (!Epi::AFTER_DRAIN) { E(acc, cur, wr, wc, fr, fq); S.done(cur); }
        if (!has_next) break;
#pragma unroll
        for (int a = 0; a < 2; ++a)
#pragma unroll
            for (int b = 0; b < 2; ++b)
#pragma unroll
                for (int m = 0; m < 4; ++m)
#pragma unroll
                    for (int n = 0; n < 2; ++n) acc[a][b][m][n] = (f32x4){0.f, 0.f, 0.f, 0.f};
        cur = nxt; cA = nA; cB = nB; ++ui;
        if constexpr (GATHER) {
#pragma unroll
            for (int _h = 0; _h < 2; ++_h)
#pragma unroll
                for (int _i = 0; _i < 2; ++_i) vC[_h][_i] = vN[_h][_i]; }
        if constexpr (ALIGN_EPI) { if (wr == 1) PG8_BAR; }
    }
    PG8_WAIT_V(0);
    if constexpr (!ALIGN_EPI) { if (wr == 0) PG8_BAR; }
    PG8_BAR;
    if constexpr (Epi::AFTER_DRAIN) { E.fused(acc, cur, wr, wc, fr, fq, lds, wid, lane); S.done(cur); }
#undef PG8_SA
#undef PG8_SB
#undef PG8_STAGE
#undef PG8_STAGE_A
#undef PG8_ROWS_ISSUE
#undef PG8_ROWS_MAKE
#undef PG8_LDA
#undef PG8_LDB
#undef PG8_MMA
#undef PG8_MMA8
#undef PG8_MMA16
#undef PG8_CAT
#undef PG8_WAIT_V
#undef PG8_WAIT_L
#undef PG8_BAR
#undef PG8_SCHED
}
}
namespace pg8 {
__device__ __forceinline__ float ep_bflo(unsigned w) { return __uint_as_float(w << 16); }
__device__ __forceinline__ float ep_bfhi(unsigned w) { return __uint_as_float(w & 0xffff0000u); }
__device__ __forceinline__ float ep_sig(float x) { return __builtin_amdgcn_rcpf(1.f + __builtin_amdgcn_exp2f(-1.4426950408889634f * x)); }
__device__ __forceinline__ void ep_unpack8(u32x4 w, f32x4& a, f32x4& b) { a = (f32x4){ep_bflo(w.x), ep_bfhi(w.x), ep_bflo(w.y), ep_bfhi(w.y)}; b = (f32x4){ep_bflo(w.z), ep_bfhi(w.z), ep_bflo(w.w), ep_bfhi(w.w)}; }
__device__ __forceinline__ u32x4 ep_pack8(f32x4 a, f32x4 b) { u32x4 w; w.x = cvt_pk_bf16(a[0], a[1]); w.y = cvt_pk_bf16(a[2], a[3]); w.z = cvt_pk_bf16(b[0], b[1]); w.w = cvt_pk_bf16(b[2], b[3]); return w; }
__device__ __forceinline__ f32x4 ep_sig4(f32x4 v) { return (f32x4){ep_sig(v[0]), ep_sig(v[1]), ep_sig(v[2]), ep_sig(v[3])}; }
#define EPI_LOOP_BEGIN const int row0 = u.pm * BM + wr * 64 + fr, col0 = u.pn * BM + wc * 32 + 8 * fq; \
    _Pragma("unroll") for (int ai = 0; ai < 2; ++ai) _Pragma("unroll") for (int m = 0; m < 4; ++m) { const int row = row0 + ai * HALF + m * 16; \
    _Pragma("unroll") for (int bj = 0; bj < 2; ++bj) { const int col = col0 + bj * HALF; const f32x4 v0 = acc[ai][bj][m][0], v1 = acc[ai][bj][m][1];
#define EPI_LOOP_END } }

struct EpiBf16S {
    static constexpr bool PERM = true, AFTER_DRAIN = false;
    bf16_t* O; int ldc; float s;
#ifdef PROBE_EXTRA_ST
    bf16_t* X;
#endif
    __device__ __forceinline__ void operator()(const f32x4 (&acc)[2][2][4][2], const Unit& u, int wr, int wc, int fr, int fq) const {
#ifdef PROBE_EXTRA_ST
        const int xw = wr * 4 + wc, xl = fq * 16 + fr;
#endif
        EPI_LOOP_BEGIN
            *(u32x4*)(O + (size_t)row * ldc + col) = ep_pack8(v0 * s, v1 * s);
#ifdef PROBE_EXTRA_ST
#if PROBE_EXTRA_ST == 1
            *(u32x4*)(X + (size_t)(row - u.pm * BM) * 256 + (col - u.pn * BM)) = ep_pack8(v0 * s, v1 * s);
#else
            *(u32x4*)(X + (size_t)xw * 8192 + (size_t)((ai * 4 + m) * 2 + bj) * 512 + xl * 8) = ep_pack8(v0 * s, v1 * s);
#endif
#endif
        EPI_LOOP_END
    }
};
struct EpiNull {
    static constexpr bool PERM = true, AFTER_DRAIN = false;
    bf16_t* O;
    __device__ __forceinline__ void operator()(const f32x4 (&acc)[2][2][4][2], const Unit& u, int wr, int wc, int fr, int fq) const {
        float s = 0.f;
        EPI_LOOP_BEGIN
            s += v0[0] + v1[3];
        EPI_LOOP_END
        if (s == 123456.789f) O[0] = 0;
    }
};
struct EpiTile {
    static constexpr bool PERM = true, AFTER_DRAIN = false;
    bf16_t* O; float s;
    __device__ __forceinline__ void operator()(const f32x4 (&acc)[2][2][4][2], const Unit& u, int wr, int wc, int fr, int fq) const {
        bf16_t* base = O + (size_t)(u.pm * 46 + u.pn) * 65536;
        EPI_LOOP_BEGIN
            { const u32x4 pk_ = ep_pack8(v0 * s, v1 * s);
#if PROBE_TILE_EPI == 2
              if (m == 0) *(u32x4*)(base + (size_t)(row - u.pm * BM) * 256 + (col - u.pn * BM)) = pk_; else asm volatile("" :: "v"(pk_));
#else
              *(u32x4*)(base + (size_t)(row - u.pm * BM) * 256 + (col - u.pn * BM)) = pk_;
#endif
            }
        EPI_LOOP_END
    }
};
struct EpiLora1 {
    static constexpr bool PERM = true, AFTER_DRAIN = false;
    float* logw; bf16_t* a; const float* w0; const float* a0;
    __device__ __forceinline__ void operator()(const f32x4 (&acc)[2][2][4][2], const Unit& u, int wr, int wc, int fr, int fq) const {
        EPI_LOOP_BEGIN
            if (u.pn < 4) { const f32x4 b0 = *(const f32x4*)(w0 + col), b1 = *(const f32x4*)(w0 + col + 4);
                float* o = logw + (size_t)row * 1024 + col; *(f32x4*)o = ep_sig4(v0 + b0) * (-0.6065306597126334f); *(f32x4*)(o + 4) = ep_sig4(v1 + b1) * (-0.6065306597126334f); }
            else { const int c = col - 1024; const f32x4 b0 = *(const f32x4*)(a0 + c), b1 = *(const f32x4*)(a0 + c + 4);
                *(u32x4*)(a + (size_t)row * 1024 + c) = ep_pack8(ep_sig4(v0 + b0), ep_sig4(v1 + b1)); }
        EPI_LOOP_END
    }
};
template <int SECOND> struct EpiGateMerge {
    static constexpr bool PERM = true, AFTER_DRAIN = false;
    bf16_t* mrg; const bf16_t* P; int gcol; unsigned char* mrg8;
    __device__ __forceinline__ void operator()(const f32x4 (&acc)[2][2][4][2], const Unit& u, int wr, int wc, int fr, int fq) const {
        const int row0 = u.pm * BM + wr * 64 + fr, col0 = u.pn * BM + wc * 32 + 8 * fq;
#pragma unroll
        for (int bj = 0; bj < 2; ++bj) { const int col = col0 + bj * HALF;
#pragma unroll
            for (int ai = 0; ai < 2; ++ai) { u32x4 gw[4], tw[4];
#pragma unroll
                for (int m = 0; m < 4; ++m) { const int row = row0 + ai * HALF + m * 16; gw[m] = *(const u32x4*)(P + (size_t)row * 11776 + gcol + col); if (SECOND) tw[m] = *(const u32x4*)(mrg + (size_t)row * 2048 + col); }
#pragma unroll
                for (int m = 0; m < 4; ++m) { const int row = row0 + ai * HALF + m * 16; f32x4 g0, g1; ep_unpack8(gw[m], g0, g1);
                    f32x4 r0 = ep_sig4(g0) * acc[ai][bj][m][0], r1 = ep_sig4(g1) * acc[ai][bj][m][1];
                    if (SECOND) { f32x4 t0, t1; ep_unpack8(tw[m], t0, t1); r0 = r0 + t0; r1 = r1 + t1; }
                    if (SECOND && OUTPROJ_FP8) { r0 = r0 * FP8_SM; r1 = r1 * FP8_SM; typedef unsigned u32x2e __attribute__((ext_vector_type(2))); u32x2e o;
                        { int q = __builtin_amdgcn_cvt_pk_fp8_f32(r0[0], r0[1], 0, false); q = __builtin_amdgcn_cvt_pk_fp8_f32(r0[2], r0[3], q, true); o.x = (unsigned)q; }
                        { int q = __builtin_amdgcn_cvt_pk_fp8_f32(r1[0], r1[1], 0, false); q = __builtin_amdgcn_cvt_pk_fp8_f32(r1[2], r1[3], q, true); o.y = (unsigned)q; }
                        *(u32x2e*)(mrg8 + (size_t)row * 2048 + col) = o; }
                    else *(u32x4*)(mrg + (size_t)row * 2048 + col) = ep_pack8(r0, r1); }
                asm volatile("" ::: "memory"); } }
    }
};
struct EpiResid {
    static constexpr bool PERM = true, AFTER_DRAIN = false;
    const float* x; float* x1; const float* mod; float* ssp; float s;
    __device__ __forceinline__ void operator()(const f32x4 (&acc)[2][2][4][2], const Unit& u, int wr, int wc, int fr, int fq) const {
        const float* gt = mod + (size_t)((u.pm * BM) / 16384) * 12288 + 4096;
        const int row0 = u.pm * BM + wr * 64 + fr, col0 = u.pn * BM + wc * 32 + 8 * fq;
        float ss[2][4] = {{0.f, 0.f, 0.f, 0.f}, {0.f, 0.f, 0.f, 0.f}};
#pragma unroll
        for (int bj = 0; bj < 2; ++bj) { const int col = col0 + bj * HALF; const f32x4 g0 = *(const f32x4*)(gt + col) * s, g1 = *(const f32x4*)(gt + col + 4) * s;
#pragma unroll
            for (int ai = 0; ai < 2; ++ai) { f32x4 xa[4], xb[4];
#pragma unroll
                for (int m = 0; m < 4; ++m) { const size_t off = (size_t)(row0 + ai * HALF + m * 16) * 2048 + col; xa[m] = *(const f32x4*)(x + off); xb[m] = *(const f32x4*)(x + off + 4); }
#pragma unroll
                for (int m = 0; m < 4; ++m) { const size_t off = (size_t)(row0 + ai * HALF + m * 16) * 2048 + col; const f32x4 ya = xa[m] + g0 * acc[ai][bj][m][0], yb = xb[m] + g1 * acc[ai][bj][m][1];
                    *(f32x4*)(x1 + off) = ya; *(f32x4*)(x1 + off + 4) = yb;
                    ss[ai][m] += ((ya[0] * ya[0] + ya[1] * ya[1]) + (ya[2] * ya[2] + ya[3] * ya[3])) + ((yb[0] * yb[0] + yb[1] * yb[1]) + (yb[2] * yb[2] + yb[3] * yb[3])); }
                asm volatile("" ::: "memory"); } }
        float* sp = ssp + (size_t)(u.pn * 4 + wc) * 32768;
#pragma unroll
        for (int ai = 0; ai < 2; ++ai)
#pragma unroll
            for (int m = 0; m < 4; ++m) { float s = ss[ai][m]; s += __shfl_xor(s, 16); s += __shfl_xor(s, 32); if (fq == 0) sp[row0 + ai * HALF + m * 16] = s; }
    }
};
struct EpiSwiglu {
    static constexpr bool PERM = true, AFTER_DRAIN = false;
    unsigned char* act; const float* bias;
    __device__ __forceinline__ void operator()(const f32x4 (&acc)[2][2][4][2], const Unit& u, int wr, int wc, int fr, int fq) const {
        const int row0 = u.pm * BM + wr * 64 + fr, gcol = u.pn * 128 + wc * 32 + 8 * fq;
        const float* bg = bias + (size_t)u.e * 4096 + gcol; const float* bl = bg + 2048;
        const f32x4 bg0 = *(const f32x4*)bg, bg1 = *(const f32x4*)(bg + 4), bl0 = *(const f32x4*)bl, bl1 = *(const f32x4*)(bl + 4);
#pragma unroll
        for (int ai = 0; ai < 2; ++ai)
#pragma unroll
            for (int m = 0; m < 4; ++m) { const int row = row0 + ai * HALF + m * 16;
                f32x4 g0 = acc[ai][0][m][0] * (1.f / 128.f) + bg0, g1 = acc[ai][0][m][1] * (1.f / 128.f) + bg1, l0 = acc[ai][1][m][0] * (1.f / 128.f) + bl0, l1 = acc[ai][1][m][1] * (1.f / 128.f) + bl1, r0, r1;
#pragma unroll
                for (int i = 0; i < 4; ++i) { const float a = fminf(g0[i], 7.f), b = fminf(g1[i], 7.f);
                    r0[i] = a * ep_sig(1.702f * a) * (fminf(fmaxf(l0[i], -7.f), 7.f) + 1.f); r1[i] = b * ep_sig(1.702f * b) * (fminf(fmaxf(l1[i], -7.f), 7.f) + 1.f); }
                r0 = r0 * 4.f; r1 = r1 * 4.f; typedef unsigned u32x2e __attribute__((ext_vector_type(2))); u32x2e o;
                { int w = __builtin_amdgcn_cvt_pk_fp8_f32(r0[0], r0[1], 0, false); w = __builtin_amdgcn_cvt_pk_fp8_f32(r0[2], r0[3], w, true); o.x = (unsigned)w; }
                { int w = __builtin_amdgcn_cvt_pk_fp8_f32(r1[0], r1[1], 0, false); w = __builtin_amdgcn_cvt_pk_fp8_f32(r1[2], r1[3], w, true); o.y = (unsigned)w; }
                *(u32x2e*)(act + (size_t)row * 2048 + gcol) = o; }
    }
};
struct EpiDown {
    static constexpr bool PERM = true, AFTER_DRAIN = false;
    unsigned char* ys; const float* bias; const float* slot_w;
    __device__ __forceinline__ void operator()(const f32x4 (&acc)[2][2][4][2], const Unit& u, int wr, int wc, int fr, int fq) const {
        const float* be = bias + (size_t)u.e * 2048; const int row0 = u.pm * BM + wr * 64 + fr, col0 = u.pn * BM + wc * 64 + 16 * fq;
        float w[2][4]; f32x4 b[2][2];
#pragma unroll
        for (int ai = 0; ai < 2; ++ai)
#pragma unroll
            for (int m = 0; m < 4; ++m) w[ai][m] = slot_w[row0 + ai * HALF + m * 16] * FP8_SY;
#pragma unroll
        for (int bj = 0; bj < 2; ++bj) { b[bj][0] = *(const f32x4*)(be + col0 + 8 * bj); b[bj][1] = *(const f32x4*)(be + col0 + 8 * bj + 4); }
#pragma unroll
        for (int ai = 0; ai < 2; ++ai)
#pragma unroll
            for (int m = 0; m < 4; ++m) { const int row = row0 + ai * HALF + m * 16; u32x4 o; unsigned q[4];
#pragma unroll
                for (int bj = 0; bj < 2; ++bj)
#pragma unroll
                    for (int n = 0; n < 2; ++n) { const f32x4 r = (acc[ai][bj][m][n] * (1.f / 256.f) + b[bj][n]) * w[ai][m];
                        int p = __builtin_amdgcn_cvt_pk_fp8_f32(r[0], r[1], 0, false); p = __builtin_amdgcn_cvt_pk_fp8_f32(r[2], r[3], p, true); q[2 * bj + n] = (unsigned)p; }
                o.x = q[0]; o.y = q[1]; o.z = q[2]; o.w = q[3];
                *(u32x4*)(ys + (size_t)row * 2048 + col0) = o; }
    }
};
struct MoeOrder : StaticOrder {
    const int* tile_e;
    __device__ bool next(int i, Unit& u) const { if (!StaticOrder::next(i, u)) return false; u.e = tile_e[u.pm]; return true; }
};
}
namespace fox {
enum { ORDER_NATURAL = 0, ORDER_REVERSED = 1, ORDER_PAIRED = 2, ORDER_XCD = 4 };
using TIN = __hip_bfloat16; using TOUT = __hip_bfloat16;
constexpr int B = 2, H = 8, HKV = 8, SQ = 16384, SKV = 16384, D = 128;
constexpr int PITCH = 1024;
constexpr int GPITCH = 11776;
constexpr int QOFF = 0;
constexpr int WINDOW = SKV;
constexpr float THR = 8.f;
constexpr int ORDER = ORDER_PAIRED;
constexpr bool WSKIP = false;
constexpr float SCALE = 0.08838834764831845f;
constexpr int NW = 8, QBLK = 32, KVBLK = 64, QB = NW * QBLK;
constexpr int SHM_V = KVBLK * D * 2, SHM_K = KVBLK * D * 2;
constexpr int LDS_CB = 2 * SHM_V + 2 * SHM_K + NW * 64 * 4;
constexpr int LDS_GATE = LDS_CB + 3 * 64 * 4 + 256;
constexpr int LDS_BYTES = LDS_GATE + NW * 8192;
static_assert(D == 128 && SQ % QB == 0 && SKV % KVBLK == 0 && H % HKV == 0 && QOFF >= 0 && QOFF + SQ <= SKV && WINDOW >= 1, "geometry");

using bf16 = __hip_bfloat16;
typedef short bf16x8 __attribute__((ext_vector_type(8)));
typedef short s16x4 __attribute__((ext_vector_type(4)));
typedef float f32x16 __attribute__((ext_vector_type(16)));
typedef float f32x4 __attribute__((ext_vector_type(4)));
typedef unsigned u32x4 __attribute__((ext_vector_type(4)));
template <class A, class Bt> struct same_t { static constexpr bool v = false; };
template <class A> struct same_t<A, A> { static constexpr bool v = true; };

#define KSWZ(row, colB) ((row) * 256 + ((colB) ^ (((row) & 7) << 4)))
#define SBAR() __builtin_amdgcn_sched_barrier(0)
__device__ __forceinline__ int v_st(int k, int c) { const int kk = (k & ~0xC) | ((k & 4) << 1) | ((k & 8) >> 1); return ((kk >> 3) * 4 + (c >> 5)) * 512 + ((kk & 7) * 32 + (c & 31)) * 2; }
__device__ __forceinline__ int v_rd_base(int lane) { return ((lane & 3) << 3) | (((lane >> 2) & 3) << 6) | (((lane >> 4) & 1) << 5) | (((lane >> 5) & 1) << 8); }
constexpr int v_rd_off(int d0, int ks, int half) { return d0 * 512 + ks * 4096 + half * 2048; }
__device__ __forceinline__ int crow(int r, int hi) { return (r & 3) + 8 * (r >> 2) + 4 * hi; }
__device__ __forceinline__ unsigned cvtpk(float lo, float hi) {
    unsigned r; asm volatile("v_cvt_pk_bf16_f32 %0, %1, %2" : "=v"(r) : "v"(lo), "v"(hi)); return r;
}
__device__ __forceinline__ bf16x8 pack8(f32x4 a, f32x4 b) {
    u32x4 w = {cvtpk(a[0], a[1]), cvtpk(a[2], a[3]), cvtpk(b[0], b[1]), cvtpk(b[2], b[3])};
    return *reinterpret_cast<bf16x8*>(&w);
}
template <class T> __device__ __forceinline__ bf16x8 load8(const T* p) {
    if constexpr (same_t<T, float>::v) { return pack8(*(const f32x4*)p, *(const f32x4*)(p + 4)); }
    else { return *reinterpret_cast<const bf16x8*>(p); }
}
__device__ __forceinline__ void mask_tile(f32x16& p0, f32x16& p1, int dq, unsigned W) {
    const float NEG = -__builtin_inff();
#pragma unroll
    for (int r = 0; r < 16; ++r) {
        const int c = (r & 3) + 8 * (r >> 2);
        if ((unsigned)(dq - c) >= W) p0[r] = NEG;
        if ((unsigned)(dq - c - 32) >= W) p1[r] = NEG;
    }
}
__device__ __forceinline__ void partialSM(f32x16& p0, f32x16& p1, float& m_reg, float& mn, float& alpha) {
    float pmax = p0[0]; for (int r = 1; r < 16; ++r) pmax = fmaxf(pmax, p0[r]); for (int r = 0; r < 16; ++r) pmax = fmaxf(pmax, p1[r]);
    { auto rr = __builtin_amdgcn_permlane32_swap(__float_as_uint(pmax), __float_as_uint(pmax), false, false);
      pmax = fmaxf(__uint_as_float(rr[0]), __uint_as_float(rr[1])); }
    constexpr float C2 = 1.4426950408889634f * SCALE;
    if (__builtin_expect(__all((pmax - m_reg) * SCALE <= THR), 1)) { mn = m_reg; alpha = 1.f; }
    else { mn = fmaxf(m_reg, pmax); alpha = __builtin_amdgcn_exp2f((m_reg - mn) * C2); m_reg = mn; }
    const float mnL = -mn * C2;
    for (int r = 0; r < 16; ++r) p0[r] = fmaf(p0[r], C2, mnL); for (int r = 0; r < 16; ++r) p1[r] = fmaf(p1[r], C2, mnL);
    for (int r = 0; r < 16; ++r) p0[r] = __builtin_amdgcn_exp2f(p0[r]);
}
__device__ __forceinline__ void finishSM(f32x16& p0, f32x16& p1, float alpha, float& l_reg, bf16x8& pa0, bf16x8& pa1, bf16x8& pa2, bf16x8& pa3) {
    for (int r = 0; r < 16; ++r) p1[r] = __builtin_amdgcn_exp2f(p1[r]);
    float ps = 0; for (int r = 0; r < 16; ++r) ps += p0[r]; for (int r = 0; r < 16; ++r) ps += p1[r];
    { auto rr = __builtin_amdgcn_permlane32_swap(__float_as_uint(ps), __float_as_uint(ps), false, false);
      ps = __uint_as_float(rr[0]) + __uint_as_float(rr[1]); }
    l_reg = l_reg * alpha + ps;
#define PK4(P, B_, OUT) do { unsigned a0 = cvtpk(P[B_+0], P[B_+1]), a1 = cvtpk(P[B_+2], P[B_+3]);                          \
        unsigned b0 = cvtpk(P[B_+4], P[B_+5]), b1 = cvtpk(P[B_+6], P[B_+7]);                                             \
        auto r0 = __builtin_amdgcn_permlane32_swap(a0, b0, false, false); auto r1 = __builtin_amdgcn_permlane32_swap(a1, b1, false, false); \
        u32x4 w = {r0[0], r1[0], r0[1], r1[1]}; OUT = *reinterpret_cast<bf16x8*>(&w); } while (0)
    PK4(p0, 0, pa0); PK4(p0, 8, pa1); PK4(p1, 0, pa2); PK4(p1, 8, pa3);
#undef PK4
}
template <int KB, bool SK>
__device__ __forceinline__ void qkt(f32x16& p0, f32x16& p1, const char* K_lds, int r32, int hi, const bf16x8* qr, bool act, int cbi) {
    if (SK && !act) { const float NEG = -__builtin_inff();
#pragma unroll
        for (int r = 0; r < 16; ++r) { p0[r] = NEG; p1[r] = NEG; } return; }
    { const float* cb_ = (const float*)(K_lds + 2 * SHM_K + NW * 64 * 4) + cbi * 64 + 4 * hi;
#pragma unroll
      for (int g_ = 0; g_ < 4; ++g_) { const f32x4 b0_ = *(const f32x4*)(cb_ + 8 * g_), b1_ = *(const f32x4*)(cb_ + 32 + 8 * g_);
#pragma unroll
          for (int i_ = 0; i_ < 4; ++i_) { p0[4 * g_ + i_] = b0_[i_]; p1[4 * g_ + i_] = b1_[i_]; } } }
    const char* kb[4];
#pragma unroll
    for (int dd = 0; dd < 4; ++dd) kb[dd] = K_lds + KB * SHM_K + KSWZ(r32, (dd * 16 + hi * 8) * 2);
#pragma unroll
    for (int d0 = 0; d0 < 8; ++d0) { const char* a = kb[d0 & 3] + (d0 >> 2) * 128;
        bf16x8 b0 = *reinterpret_cast<const bf16x8*>(a);
        bf16x8 b1 = *reinterpret_cast<const bf16x8*>(a + 32 * 256);
        p0 = __builtin_amdgcn_mfma_f32_32x32x16_bf16(b0, qr[d0], p0, 0, 0, 0);
        p1 = __builtin_amdgcn_mfma_f32_32x32x16_bf16(b1, qr[d0], p1, 0, 0, 0); }
}
template <int VB, bool SK>
__device__ __forceinline__ void pv_tile(f32x16* o, int vb0, bf16x8 pa0, bf16x8 pa1, bf16x8 pa2, bf16x8 pa3, bool act) {
    if (SK && !act) return;
#define TRRD(dst, off) asm volatile("ds_read_b64_tr_b16 %0, %1 offset:%2" : "=&v"(dst) : "v"(vb0), "i"(off) : "memory")
#define PV_D0(d0) do { s16x4 l0, l1, l2, l3, h0, h1, h2, h3; constexpr int b_ = VB * SHM_V + v_rd_off(d0, 0, 0);     \
        TRRD(l0, b_); TRRD(h0, b_ + 2048); TRRD(l1, b_ + 4096); TRRD(h1, b_ + 6144); TRRD(l2, b_ + 8192); TRRD(h2, b_ + 10240); TRRD(l3, b_ + 12288); TRRD(h3, b_ + 14336); \
        asm volatile("s_waitcnt lgkmcnt(0)" ::: "memory"); SBAR();                 \
        o[d0] = __builtin_amdgcn_mfma_f32_32x32x16_bf16(pa0, (bf16x8){l0[0], l0[1], l0[2], l0[3], h0[0], h0[1], h0[2], h0[3]}, o[d0], 0, 0, 0);   \
        o[d0] = __builtin_amdgcn_mfma_f32_32x32x16_bf16(pa1, (bf16x8){l1[0], l1[1], l1[2], l1[3], h1[0], h1[1], h1[2], h1[3]}, o[d0], 0, 0, 0);   \
        o[d0] = __builtin_amdgcn_mfma_f32_32x32x16_bf16(pa2, (bf16x8){l2[0], l2[1], l2[2], l2[3], h2[0], h2[1], h2[2], h2[3]}, o[d0], 0, 0, 0);   \
        o[d0] = __builtin_amdgcn_mfma_f32_32x32x16_bf16(pa3, (bf16x8){l3[0], l3[1], l3[2], l3[3], h3[0], h3[1], h3[2], h3[3]}, o[d0], 0, 0, 0); } while (0)
    PV_D0(0); PV_D0(1); PV_D0(2); PV_D0(3);
#undef PV_D0
#undef TRRD
}

template <class TIn, class TOut> struct BlockRef { const unsigned char* ws; int row0, bh, P0, jlo;
    __device__ __forceinline__ const TIn* Q() const { return (const TIn*)(ws + WS_FQ) + (size_t)row0 * PITCH + (bh % H) * D; }
    __device__ __forceinline__ const TIn* K() const { return (const TIn*)(ws + WS_FK) + (size_t)(bh / H) * SQ * PITCH + (bh % H) * D; }
    __device__ __forceinline__ const TIn* V() const { return (const TIn*)(ws + WS_P) + (size_t)(bh / H) * SQ * GPITCH + PC_FV + (bh % H) * D; }
    __device__ __forceinline__ TOut* O() const { return (TOut*)(ws + WS_YB) + (size_t)row0 * PITCH + (bh % H) * D; }
    __device__ __forceinline__ const float* C() const { return (const float*)(ws + WS_CS) + (size_t)bh * SQ; }
    __device__ __forceinline__ const TIn* G() const { return (const TIn*)(ws + WS_P) + (size_t)row0 * GPITCH + PC_OG + (bh % H) * D; }
};
template <class TIn> struct Seam {
    bf16x8 qr[8];
    bf16x8 st_v0, st_v1, st_k0, st_k1; int cbi; f32x4 sf0, sf1, sf2, sf3;
    f32x4 tq[16];
};
__device__ __forceinline__ int swa_jlo(int P0, int W) { const int lowk = P0 - W + 1; return lowk > 0 ? lowk / KVBLK : 0; }
#define ROW(p, k0, rr) ((p) + (size_t)((k0) + (rr)) * PITCH + sc)
#define ROWV(p, k0, rr) ((p) + (size_t)((k0) + (rr)) * GPITCH + sc)
#define VMW() asm volatile("s_waitcnt vmcnt(0)" ::: "memory")
#define VMWN(n) asm volatile("s_waitcnt vmcnt(%0)" :: "i"(n) : "memory")
#define NEXT3(x) ((x) == 2 ? 0 : (x) + 1)
#define SLOAD_H(Kp, Vp, Cp, k0, CI) do { S.st_v0 = load8<TIn>(ROWV(Vp, k0, sr)); S.st_v1 = load8<TIn>(ROWV(Vp, k0, 32 + sr));              \
                         S.st_k0 = load8<TIn>(ROW(Kp, k0, sr)); S.st_k1 = load8<TIn>(ROW(Kp, k0, 32 + sr));                 \
                         if (wid == 0) __builtin_amdgcn_global_load_lds((const unsigned*)((Cp) + (k0) + lane), (__attribute__((address_space(3))) unsigned*)(lds + LDS_CB + (CI) * 256), 4, 0, 0); } while (0)
#define SWRITE_HK(bf) do { *(bf16x8*)(K_lds + (bf) * SHM_K + kws) = S.st_k0; *(bf16x8*)(K_lds + (bf) * SHM_K + kws + 32 * 256) = S.st_k1; } while (0)
#define SWRITE_HV(bf) do { *(bf16x8*)(V_lds + (bf) * SHM_V + vst0) = S.st_v0; *(bf16x8*)(V_lds + (bf) * SHM_V + vst1) = S.st_v1; } while (0)
#define SWRITE_H(bf) do { SWRITE_HV(bf); SWRITE_HK(bf); } while (0)
#define SLOAD_F(p, k0) do { S.sf0 = *(const f32x4*)ROW(p, k0, sr); S.sf1 = *(const f32x4*)(ROW(p, k0, sr) + 4);                \
                            S.sf2 = *(const f32x4*)ROW(p, k0, 32 + sr); S.sf3 = *(const f32x4*)(ROW(p, k0, 32 + sr) + 4); } while (0)
#define SWRITE_KF(bf) do { *(bf16x8*)(K_lds + (bf) * SHM_K + kws) = pack8(S.sf0, S.sf1); *(bf16x8*)(K_lds + (bf) * SHM_K + kws + 32 * 256) = pack8(S.sf2, S.sf3); } while (0)
#define SWRITE_VF(bf) do { *(bf16x8*)(V_lds + (bf) * SHM_V + vst0) = pack8(S.sf0, S.sf1); *(bf16x8*)(V_lds + (bf) * SHM_V + vst1) = pack8(S.sf2, S.sf3); } while (0)
template <class TIn, class TOut>
__device__ __forceinline__ void causal_swa_prime(const BlockRef<TIn, TOut>& cur, int W, char* lds, Seam<TIn>& S, const int tid) {
    constexpr bool F32 = same_t<TIn, float>::v;
    const int wid = __builtin_amdgcn_readfirstlane(tid >> 6), lane = tid & 63, r32 = lane & 31, hi = lane >> 5;
    const int sr = tid >> 4, sc = (tid & 15) * 8, kws = KSWZ(sr, sc * 2); char* K_lds = lds + 2 * SHM_V;
    const int kb0 = cur.jlo * KVBLK;
    for (int d0 = 0; d0 < 8; ++d0) S.qr[d0] = load8<TIn>(cur.Q() + (size_t)(wid * QBLK + r32) * PITCH + d0 * 16 + hi * 8);
    if constexpr (F32) { SLOAD_F((const float*)cur.K(), kb0); VMW(); SWRITE_KF(0); SBAR(); SLOAD_F((const float*)cur.V(), kb0); }
    else { S.cbi = 0; SLOAD_H(cur.K(), cur.V(), cur.C(), kb0, 0); VMW(); SWRITE_HK(0); }
    __syncthreads();
}
template <class TIn, class TOut>
__device__ __forceinline__ void causal_swa_block(const BlockRef<TIn, TOut>& cur, const BlockRef<TIn, TOut>& nxt, int skv, int W, char* lds, Seam<TIn>& S, const int tid) {
    constexpr bool F32 = same_t<TIn, float>::v;
    const int wid = __builtin_amdgcn_readfirstlane(tid >> 6), lane = tid & 63, r32 = lane & 31, hi = lane >> 5;
    const int j_lo = cur.jlo;
    int j_hi = (cur.P0 + QB - 1) / KVBLK + 1; if (j_hi > skv / KVBLK) j_hi = skv / KVBLK;
    const int NT = j_hi - j_lo;
    const int kbn = nxt.jlo * KVBLK;
    const int qlo = cur.P0 + wid * QBLK, qm = qlo + r32 - 4 * hi;
    char* V_lds = lds; char* K_lds = lds + 2 * SHM_V;
    float* ws = (float*)(lds + 2 * SHM_V + 2 * SHM_K) + wid * 64; float* li_l = ws, * al_l = ws + 32;
    float m_reg = -1e30f, l_reg = 0; f32x16 o[4] = {};
    const int sr = tid >> 4, sc = (tid & 15) * 8, vst0 = v_st(sr, sc), vst1 = v_st(32 + sr, sc), kws = KSWZ(sr, sc * 2);
    const int vb0 = (int)(uintptr_t)V_lds + v_rd_base(lane);
    const TIn* Kh = cur.K(); const TIn* Vh = cur.V(); const float* Ch = cur.C(); int cb_t = S.cbi;
    {
        const TIn* gsrc = cur.G() + (size_t)(wid * QBLK + (lane >> 4)) * GPITCH + (lane & 15) * 8;
#pragma unroll
        for (int i_ = 0; i_ < 8; ++i_) __builtin_amdgcn_global_load_lds((const unsigned*)(gsrc + (size_t)(4 * i_) * GPITCH), (__attribute__((address_space(3))) unsigned*)(lds + LDS_GATE + wid * 8192 + i_ * 1024), 16, 0, 0); }
#define RESC(a) do { if (__any((a) < 1.f)) { if (hi == 0) al_l[r32] = (a); asm volatile("s_waitcnt lgkmcnt(0)" ::: "memory");              \
                     for (int d_ = 0; d_ < 4; ++d_) for (int r = 0; r < 16; ++r) o[d_][r] *= al_l[crow(r, hi)]; } } while (0)
#define KBASE(t) ((j_lo + (t)) * KVBLK)
#define ACT(t) (KBASE(t) <= qlo + QBLK - 1 && KBASE(t) + KVBLK - 1 >= qlo - W + 1)
#define MASKT(P0_, P1_, t) do { const int kb_ = KBASE(t); if ((!SK || ACT(t)) && (kb_ + KVBLK - 1 > qlo || kb_ <= qlo + QBLK - 1 - W)) mask_tile(P0_, P1_, qm - kb_, (unsigned)W); } while (0)
    constexpr int NQL = F32 ? 16 : 8;
    constexpr bool SK = WSKIP && !F32;
#define SEAM_K0() do { VMWN(NQL); if constexpr (F32) { SWRITE_KF(0); SBAR(); SLOAD_F((const float*)nxt.V(), kbn); } else { SWRITE_HK(0); } SBAR(); } while (0)
    f32x16 pA0, pA1, pB0, pB1; float mnA, mnB, alA, alB; bf16x8 pa0, pa1, pa2, pa3;
    if constexpr (F32) { VMW(); SWRITE_VF(0); SBAR(); } else { SWRITE_HV(0); SBAR(); }
    if (NT > 1) { if constexpr (F32) SLOAD_F((const float*)Kh, KBASE(1)); else SLOAD_H(Kh, Vh, Ch, KBASE(1), NEXT3(cb_t)); }
    SBAR(); qkt<0, SK>(pA0, pA1, K_lds, r32, hi, S.qr, ACT(0), cb_t);
    if constexpr (F32) { if (NT > 1) { VMW(); SWRITE_KF(1); SBAR(); SLOAD_F((const float*)Vh, KBASE(1)); } }
    MASKT(pA0, pA1, 0); partialSM(pA0, pA1, m_reg, mnA, alA);
    if (NT > 1) { VMW(); if constexpr (F32) { SWRITE_VF(1); SBAR(); if (NT > 2) SLOAD_F((const float*)Kh, KBASE(2)); } else SWRITE_H(1); }
    __syncthreads();
#define HALF_STEP(PX0, PX1, mnX, alX, PY0, PY1, alY, t, KB, VB, SB) do {                                                      \
        SBAR(); cb_t = NEXT3(cb_t); qkt<KB, SK>(PX0, PX1, K_lds, r32, hi, S.qr, ACT(t), cb_t);                                             \
        finishSM(PY0, PY1, alY, l_reg, pa0, pa1, pa2, pa3); SBAR();                                                           \
        if ((t) + 1 < NT) { if constexpr (F32) { VMW(); SWRITE_KF(SB); SBAR(); SLOAD_F((const float*)Vh, KBASE((t) + 1)); }  \
                            else { SLOAD_H(Kh, Vh, Ch, KBASE((t) + 1), NEXT3(cb_t)); } SBAR(); }                                               \
        pv_tile<VB, SK>(o, vb0, pa0, pa1, pa2, pa3, ACT((t) - 1)); MASKT(PX0, PX1, (t)); partialSM(PX0, PX1, m_reg, mnX, alX);                                        \
        __syncthreads();                                                                                                      \
        if ((t) + 1 < NT) { VMW(); if constexpr (F32) { SWRITE_VF(SB); SBAR(); if ((t) + 2 < NT) SLOAD_F((const float*)Kh, KBASE((t) + 2)); } \
                            else { SWRITE_H(SB); } }                                                                          \
        RESC(alX); __syncthreads(); } while (0)
    for (int t = 1; t + 1 < NT; t += 2) {
        HALF_STEP(pB0, pB1, mnB, alB, pA0, pA1, alA, t, 1, 0, 0);
        HALF_STEP(pA0, pA1, mnA, alA, pB0, pB1, alB, t + 1, 0, 1, 1);
    }
    const bool even = (NT & 1) == 0;
    if (even) { SBAR(); cb_t = NEXT3(cb_t); qkt<1, SK>(pB0, pB1, K_lds, r32, hi, S.qr, ACT(NT - 1), cb_t); SBAR(); }
#define QROW(e) (nxt.Q() + (size_t)(wid * QBLK + r32) * PITCH + ((e) >> 1) * 16 + hi * 8 + ((e) & 1) * 4)
    if constexpr (F32) { SLOAD_F((const float*)nxt.K(), kbn); SBAR();
#pragma unroll
        for (int e = 0; e < 8; ++e) S.tq[e] = *(const f32x4*)QROW(e); }
    else { SLOAD_H(nxt.K(), nxt.V(), nxt.C(), kbn, NEXT3(cb_t)); S.cbi = NEXT3(cb_t); SBAR();
#pragma unroll
        for (int d0 = 0; d0 < 8; ++d0) S.qr[d0] = load8<TIn>(nxt.Q() + (size_t)(wid * QBLK + r32) * PITCH + d0 * 16 + hi * 8); }
    SBAR();
    finishSM(pA0, pA1, alA, l_reg, pa0, pa1, pa2, pa3); SBAR();
    if constexpr (F32) {
#pragma unroll
        for (int e = 8; e < 16; ++e) S.tq[e] = *(const f32x4*)QROW(e); SBAR(); }
#undef QROW
    pv_tile<0, SK>(o, vb0, pa0, pa1, pa2, pa3, ACT(even ? NT - 2 : NT - 1));
    if (even) { MASKT(pB0, pB1, NT - 1); partialSM(pB0, pB1, m_reg, mnB, alB); __syncthreads(); RESC(alB);
        finishSM(pB0, pB1, alB, l_reg, pa0, pa1, pa2, pa3); SBAR(); pv_tile<1, SK>(o, vb0, pa0, pa1, pa2, pa3, ACT(NT - 1)); }
    SBAR(); SEAM_K0();
    if (hi == 0) li_l[r32] = l_reg; asm volatile("s_waitcnt lgkmcnt(0)" ::: "memory");
    float rli[16];
#pragma unroll
    for (int r = 0; r < 16; ++r) rli[r] = __builtin_amdgcn_rcpf(li_l[crow(r, hi)]);
    int hi_e = hi; asm volatile("" : "+v"(hi_e));
    TOut* Ow = cur.O() + (size_t)(wid * QBLK) * PITCH + (size_t)(4 * hi_e) * PITCH; const char* gl_ = lds + LDS_GATE + wid * 8192 + 4 * hi_e * 256;
#pragma unroll
    for (int r = 0; r < 16; ++r) { const int orow = (r & 3) + 8 * (r >> 2);
#pragma unroll
        for (int d0 = 0; d0 < 4; ++d0) { const float v = o[d0][r] * rli[r];
            if constexpr (same_t<TOut, float>::v) { Ow[(size_t)orow * PITCH + d0 * 32 + r32] = v; }
            else { const float vn = __shfl_xor(v, 1);
                   if ((r32 & 1) == 0) { const unsigned gw_ = *(const unsigned*)(gl_ + orow * 256 + (d0 * 32 + r32) * 2);
                       const float g0_ = __uint_as_float(gw_ << 16), g1_ = __uint_as_float(gw_ & 0xffff0000u);
                       const float s0_ = __builtin_amdgcn_rcpf(1.f + __builtin_amdgcn_exp2f(-1.4426950408889634f * g0_)), s1_ = __builtin_amdgcn_rcpf(1.f + __builtin_amdgcn_exp2f(-1.4426950408889634f * g1_));
                       *(unsigned*)(Ow + (size_t)orow * PITCH + d0 * 32 + r32) = cvtpk(v * s0_, vn * s1_); } } } }
    if constexpr (F32) {
#pragma unroll
        for (int d0 = 0; d0 < 8; ++d0) S.qr[d0] = pack8(S.tq[2 * d0], S.tq[2 * d0 + 1]); }
    __syncthreads();
#undef RESC
#undef KBASE
#undef ACT
#undef MASKT
#undef SEAM_K0
#undef HALF_STEP
}
#undef ROW
#undef ROWV
#undef VMW
#undef VMWN
#undef SLOAD_H
#undef SWRITE_HK
#undef SWRITE_HV
#undef SWRITE_H
#undef SLOAD_F
#undef SWRITE_KF
#undef SWRITE_VF

}
#ifndef RW_SOLVE_OLD
#define RW_SOLVE_OLD 0
#endif
namespace rw {
typedef short bf16x8 __attribute__((ext_vector_type(8)));
typedef float f32x4 __attribute__((ext_vector_type(4)));
typedef unsigned u32x4 __attribute__((ext_vector_type(4)));
typedef unsigned u32x2 __attribute__((ext_vector_type(2)));
#define RW_LAS __attribute__((address_space(3)))
constexpr int PB = 144, PF = 272, MB = 64 * PB;
constexpr int O_R = 0, O_K = MB, O_A = 2 * MB, O_B = 3 * MB, O_BT = 4 * MB, O_KT = 5 * MB, O_VT = 6 * MB, O_AAK = 7 * MB, O_ARB = 8 * MB, O_ARK = 9 * MB;
constexpr int O_AAB = 10 * MB, O_GT = O_AAB + 64 * PF, O_GAM = O_GT + 64 * PF, O_TOT = O_GAM + 256, O_END = O_TOT + 2048;
constexpr int O_AABB = O_END, O_TB = O_AABB + MB, O_END2 = O_TB + 4 * 768;
constexpr int O_WT = O_K, O_UT = O_AAK;
static_assert(O_END2 <= 143360, "phase A LDS map");
constexpr int REC = 32768, REC_P = 0, REC_Q = 8192, REC_H = 16384, REC_Y = 24576;
typedef float f32x2_t __attribute__((ext_vector_type(2))); typedef __bf16 bf16x2_t __attribute__((ext_vector_type(2)));
__device__ __forceinline__ unsigned cvtpk(float lo, float hi) { f32x2_t v = {lo, hi}; bf16x2_t b = __builtin_convertvector(v, bf16x2_t); return __builtin_bit_cast(unsigned, b); }
__device__ __forceinline__ float blo(unsigned w) { return __uint_as_float(w << 16); }
__device__ __forceinline__ float bhi(unsigned w) { return __uint_as_float(w & 0xffff0000u); }
__device__ __forceinline__ bf16x8 frag(const RW_LAS unsigned char* base, int tile, int ks, int lane) { return *(const RW_LAS bf16x8*)(base + (16 * tile + (lane & 15)) * PB + (ks * 32 + 8 * (lane >> 4)) * 2); }
#define RW_MFMA(a, b, c) __builtin_amdgcn_mfma_f32_16x16x32_bf16(a, b, c, 0, 0, 0)
#define RW_SYNC() __syncthreads()
#define RW_BAR() do { asm volatile("" ::: "memory"); __builtin_amdgcn_s_barrier(); asm volatile("" ::: "memory"); } while (0)

struct ChunkIn { u32x4 r, k, v, a; f32x4 l0, l1; };
__device__ __forceinline__ void load_chunk(ChunkIn& c, const unsigned char* ws, int it, int tid) {
    const int bh = it >> 8, ch = it & 255, b = bh >> 4, h = bh & 15, tok = tid >> 3, part = tid & 7;
    const size_t off = ((size_t)b * SEQ + (size_t)ch * 64 + tok) * 1024 + h * 64 + 8 * part;
    c.r = *(const u32x4*)((const unsigned short*)(ws + WS_R) + off); c.k = *(const u32x4*)((const unsigned short*)(ws + WS_K) + off); c.v = *(const u32x4*)((const unsigned short*)(ws + WS_V) + off);
    c.a = *(const u32x4*)((const unsigned short*)(ws + WS_A) + off); c.l0 = *(const f32x4*)((const float*)(ws + WS_LOGW) + off); c.l1 = *(const f32x4*)((const float*)(ws + WS_LOGW) + off + 4);
}
template <int STOP = 0>
__device__ __forceinline__ void phase_a(RW_LAS unsigned char* L, unsigned char* ws, size_t rec_off, const float* kk_all, const float* ka_all, int wg, int G, int tid) {
    const int lane = tid & 63, w = __builtin_amdgcn_readfirstlane(tid >> 6), g = lane >> 4, l15 = lane & 15;
    ChunkIn cin; if (wg < 8192) load_chunk(cin, ws, wg, tid);
  for (int it = wg; it < 8192; it += G) {
    unsigned char* rec = ws + rec_off + (size_t)it * REC; const float* kkw_g = kk_all + ((it >> 8) & 15) * 64; const float* kaw_g = ka_all + ((it >> 8) & 15) * 64;
    { const int tok = tid >> 3, part = tid & 7, c0 = 8 * part;
      const u32x4 rw_ = cin.r, kw_ = cin.k, vw_ = cin.v, aw_ = cin.a; const f32x4 l0 = cin.l0, l1 = cin.l1;
      float lw[8] = {l0[0], l0[1], l0[2], l0[3], l1[0], l1[1], l1[2], l1[3]}, cum[8];
#pragma unroll
      for (int i = 0; i < 8; ++i) { float v = lw[i];
          float u = __shfl_up(v, 8); if (lane >= 8) v += u; u = __shfl_up(v, 16); if (lane >= 16) v += u; u = __shfl_up(v, 32); if (lane >= 32) v += u; cum[i] = v; }
      RW_LAS float* tot = (RW_LAS float*)(L + O_TOT);
      if (lane >= 56) {
#pragma unroll
          for (int i = 0; i < 8; ++i) tot[w * 64 + c0 + i] = cum[i]; }
      RW_SYNC();
#pragma unroll
      for (int ww = 0; ww < 7; ++ww) if (ww < w) { const f32x4 a0 = *(const RW_LAS f32x4*)(tot + ww * 64 + c0), a1 = *(const RW_LAS f32x4*)(tot + ww * 64 + c0 + 4);
#pragma unroll
          for (int i = 0; i < 4; ++i) { cum[i] += a0[i]; cum[4 + i] += a1[i]; } }
      float r[8] = {blo(rw_.x), bhi(rw_.x), blo(rw_.y), bhi(rw_.y), blo(rw_.z), bhi(rw_.z), blo(rw_.w), bhi(rw_.w)};
      float k[8] = {blo(kw_.x), bhi(kw_.x), blo(kw_.y), bhi(kw_.y), blo(kw_.z), bhi(kw_.z), blo(kw_.w), bhi(kw_.w)};
      float a[8] = {blo(aw_.x), bhi(aw_.x), blo(aw_.y), bhi(aw_.y), blo(aw_.z), bhi(aw_.z), blo(aw_.w), bhi(aw_.w)};
      const f32x4 kk0 = *(const f32x4*)(kkw_g + c0), kk1 = *(const f32x4*)(kkw_g + c0 + 4), ka0 = *(const f32x4*)(kaw_g + c0), ka1 = *(const f32x4*)(kaw_g + c0 + 4);
      float kk[8], ss = 0.f;
#pragma unroll
      for (int i = 0; i < 8; ++i) { kk[i] = k[i] * (i < 4 ? kk0[i] : kk1[i - 4]); ss += kk[i] * kk[i]; }
      ss += __shfl_xor(ss, 1); ss += __shfl_xor(ss, 2); ss += __shfl_xor(ss, 4);
      const float inv = 1.f / fmaxf(sqrtf(ss), 1e-12f);
      float Rt[8], Kt[8], At[8], Bt[8];
#pragma unroll
      for (int i = 0; i < 8; ++i) { const float eL = __expf(cum[i]), eLi = __expf(-cum[i]), eLx = __expf(cum[i] - lw[i]); const float kn = kk[i] * inv;
          Rt[i] = r[i] * eL; Kt[i] = k[i] * (1.f + (a[i] - 1.f) * (i < 4 ? ka0[i] : ka1[i - 4])) * eLi; At[i] = -kn * eLx; Bt[i] = kn * a[i] * eLi;
          if (tok == 63) ((RW_LAS float*)(L + O_GAM))[c0 + i] = eL; }
      u32x4 o;
      o.x = cvtpk(Rt[0], Rt[1]); o.y = cvtpk(Rt[2], Rt[3]); o.z = cvtpk(Rt[4], Rt[5]); o.w = cvtpk(Rt[6], Rt[7]); *(RW_LAS u32x4*)(L + O_R + tok * PB + c0 * 2) = o;
      o.x = cvtpk(Kt[0], Kt[1]); o.y = cvtpk(Kt[2], Kt[3]); o.z = cvtpk(Kt[4], Kt[5]); o.w = cvtpk(Kt[6], Kt[7]); *(RW_LAS u32x4*)(L + O_K + tok * PB + c0 * 2) = o;
      o.x = cvtpk(At[0], At[1]); o.y = cvtpk(At[2], At[3]); o.z = cvtpk(At[4], At[5]); o.w = cvtpk(At[6], At[7]); *(RW_LAS u32x4*)(L + O_A + tok * PB + c0 * 2) = o;
      o.x = cvtpk(Bt[0], Bt[1]); o.y = cvtpk(Bt[2], Bt[3]); o.z = cvtpk(Bt[4], Bt[5]); o.w = cvtpk(Bt[6], Bt[7]); *(RW_LAS u32x4*)(L + O_B + tok * PB + c0 * 2) = o;
      *(RW_LAS u32x4*)(L + O_GT + tok * PB + c0 * 2) = vw_;
    }
    if (it + G < 8192) load_chunk(cin, ws, it + G, tid);
    RW_SYNC();
    if (STOP == 1) continue;
    {
      const int ch = tid & 63, tg = tid >> 6;
#pragma unroll
      for (int mtx = 0; mtx < 3; ++mtx) { const RW_LAS unsigned char* src = L + (mtx == 0 ? O_B : mtx == 1 ? O_K : O_GT) + (8 * tg) * PB + ch * 2; unsigned v[8];
#pragma unroll
          for (int i = 0; i < 8; ++i) v[i] = *(const RW_LAS unsigned short*)(src + i * PB);
          u32x4 o; o.x = v[0] | (v[1] << 16); o.y = v[2] | (v[3] << 16); o.z = v[4] | (v[5] << 16); o.w = v[6] | (v[7] << 16);
          *(RW_LAS u32x4*)(L + (mtx == 0 ? O_BT : mtx == 1 ? O_KT : O_VT) + ch * PB + (8 * tg) * 2) = o; } }
    const int t4 = w & 3, p2 = (w >> 2) * 2;
    { const bf16x8 b0 = frag(L + O_B, t4, 0, lane), b1 = frag(L + O_B, t4, 1, lane), k0 = frag(L + O_K, t4, 0, lane), k1 = frag(L + O_K, t4, 1, lane);
#pragma unroll
      for (int u = 0; u < 2; ++u) { const int nt = p2 + u, t = 16 * nt + l15, s0 = 16 * t4 + 4 * g;
          f32x4 ab = {0.f, 0.f, 0.f, 0.f}, ak = ab, rb = ab, rk = ab;
          if (t4 <= nt) { const bf16x8 a0 = frag(L + O_A, nt, 0, lane), a1 = frag(L + O_A, nt, 1, lane), r0 = frag(L + O_R, nt, 0, lane), r1 = frag(L + O_R, nt, 1, lane);
              ab = RW_MFMA(b0, a0, ab); ab = RW_MFMA(b1, a1, ab); ak = RW_MFMA(k0, a0, ak); ak = RW_MFMA(k1, a1, ak);
              rb = RW_MFMA(b0, r0, rb); rb = RW_MFMA(b1, r1, rb); rk = RW_MFMA(k0, r0, rk); rk = RW_MFMA(k1, r1, rk);
#pragma unroll
              for (int r = 0; r < 4; ++r) { const int s = s0 + r; if (!(s < t)) { ab[r] = 0.f; ak[r] = 0.f; } if (!(s <= t)) { rb[r] = 0.f; rk[r] = 0.f; } } }
          *(RW_LAS f32x4*)(L + O_AAB + t * PF + s0 * 4) = ab;
          u32x2 o; o.x = cvtpk(ab[0], ab[1]); o.y = cvtpk(ab[2], ab[3]); *(RW_LAS u32x2*)(L + O_AABB + t * PB + s0 * 2) = o;
          o.x = cvtpk(ak[0], ak[1]); o.y = cvtpk(ak[2], ak[3]); *(RW_LAS u32x2*)(L + O_AAK + t * PB + s0 * 2) = o;
          o.x = cvtpk(rb[0], rb[1]); o.y = cvtpk(rb[2], rb[3]); *(RW_LAS u32x2*)(L + O_ARB + t * PB + s0 * 2) = o;
          o.x = cvtpk(rk[0], rk[1]); o.y = cvtpk(rk[2], rk[3]); *(RW_LAS u32x2*)(L + O_ARK + t * PB + s0 * 2) = o; } }
    RW_SYNC();
    if (STOP == 2) continue;
    { const bf16x8 a0 = frag(L + O_AAK, t4, 0, lane), a1 = frag(L + O_AAK, t4, 1, lane);
#pragma unroll
      for (int u = 0; u < 2; ++u) { const int nt = p2 + u; f32x4 acc = {0.f, 0.f, 0.f, 0.f};
          acc = RW_MFMA(a0, frag(L + O_VT, nt, 0, lane), acc); acc = RW_MFMA(a1, frag(L + O_VT, nt, 1, lane), acc);
          *(RW_LAS f32x4*)(L + O_GT + (16 * nt + l15) * PF + (16 * t4 + 4 * g) * 4) = acc; } }
    if (w < 4 && lane < 16) {
        float x[16]; const RW_LAS unsigned char* ab = L + O_AAB + 16 * w * PF + 16 * w * 4;
#pragma unroll
        for (int r = 0; r < 16; ++r) { float a0 = (r == lane) ? 1.f : 0.f, a1 = 0.f;
#pragma unroll
            for (int q4 = 0; q4 < (r + 3) / 4; ++q4) { const f32x4 av = *(const RW_LAS f32x4*)(ab + r * PF + q4 * 16);
                if (4 * q4 + 0 < r) a0 += av[0] * x[4 * q4 + 0]; if (4 * q4 + 1 < r) a1 += av[1] * x[4 * q4 + 1]; if (4 * q4 + 2 < r) a0 += av[2] * x[4 * q4 + 2]; if (4 * q4 + 3 < r) a1 += av[3] * x[4 * q4 + 3]; }
            x[r] = a0 + a1; *(RW_LAS unsigned short*)(L + O_TB + w * 768 + r * 48 + lane * 2) = (unsigned short)(cvtpk(x[r], 0.f) & 0xffffu); } }
    RW_SYNC();
    if (STOP == 3) continue;
#if RW_SOLVE_OLD
    if (tid < 128) { const int c = tid;
        const RW_LAS unsigned char* rhs = c < 64 ? (L + O_A + c * 2) : (L + O_GT + (c - 64) * PF);
        RW_LAS unsigned char* dst = c < 64 ? (L + O_WT + c * PB) : (L + O_UT + (c - 64) * PB);
        for (int b = 0; b < 4; ++b) { float z[16];
#pragma unroll
            for (int r = 0; r < 16; ++r) z[r] = c < 64 ? blo((unsigned)*(const RW_LAS unsigned short*)(rhs + (16 * b + r) * PB)) : *(const RW_LAS float*)(rhs + (16 * b + r) * 4);
            const RW_LAS unsigned char* arow = L + O_AAB + 16 * b * PF;
            for (int s4 = 0; s4 < 4 * b; ++s4) { const u32x2 xw = *(const RW_LAS u32x2*)(dst + s4 * 8); const float x0 = blo(xw.x), x1 = bhi(xw.x), x2 = blo(xw.y), x3 = bhi(xw.y);
#pragma unroll
                for (int r = 0; r < 16; ++r) { const f32x4 av = *(const RW_LAS f32x4*)(arow + r * PF + s4 * 16); z[r] += (av[0] * x0 + av[1] * x1) + (av[2] * x2 + av[3] * x3); } }
#pragma unroll
            for (int r = 1; r < 16; ++r) {
#pragma unroll
                for (int q4 = 0; q4 < (r + 3) / 4; ++q4) { const f32x4 av = *(const RW_LAS f32x4*)(arow + r * PF + (4 * b + q4) * 16);
                    if (4 * q4 + 0 < r) z[r] += av[0] * z[4 * q4 + 0]; if (4 * q4 + 1 < r) z[r] += av[1] * z[4 * q4 + 1]; if (4 * q4 + 2 < r) z[r] += av[2] * z[4 * q4 + 2]; if (4 * q4 + 3 < r) z[r] += av[3] * z[4 * q4 + 3]; } }
            u32x4 o; o.x = cvtpk(z[0], z[1]); o.y = cvtpk(z[2], z[3]); o.z = cvtpk(z[4], z[5]); o.w = cvtpk(z[6], z[7]); *(RW_LAS u32x4*)(dst + 32 * b) = o;
            o.x = cvtpk(z[8], z[9]); o.y = cvtpk(z[10], z[11]); o.z = cvtpk(z[12], z[13]); o.w = cvtpk(z[14], z[15]); *(RW_LAS u32x4*)(dst + 32 * b + 16) = o;
            asm volatile("s_waitcnt lgkmcnt(0)" ::: "memory"); } }
    RW_SYNC();
#else
    { RW_LAS unsigned char* xt = (w < 4 ? L + O_WT : L + O_UT) + (w & 3) * 16 * PB;
      { const u32x4 z4 = {0u, 0u, 0u, 0u}; *(RW_LAS u32x4*)(xt + l15 * PB + g * 16) = z4; *(RW_LAS u32x4*)(xt + l15 * PB + 64 + g * 16) = z4; }
      asm volatile("s_waitcnt lgkmcnt(0)" ::: "memory");
#pragma unroll
      for (int b = 0; b < 4; ++b) { f32x4 z;
          if (w < 4) { const RW_LAS unsigned char* ap = L + O_A + (16 * b + 4 * g) * PB + (16 * w + l15) * 2;
              z = (f32x4){blo((unsigned)*(const RW_LAS unsigned short*)(ap)), blo((unsigned)*(const RW_LAS unsigned short*)(ap + PB)), blo((unsigned)*(const RW_LAS unsigned short*)(ap + 2 * PB)), blo((unsigned)*(const RW_LAS unsigned short*)(ap + 3 * PB))}; }
          else z = *(const RW_LAS f32x4*)(L + O_GT + (16 * (w - 4) + l15) * PF + (16 * b + 4 * g) * 4);
          if (b > 0) { z = RW_MFMA(frag(L + O_AABB, b, 0, lane), *(const RW_LAS bf16x8*)(xt + l15 * PB + (8 * g) * 2), z);
                       if (b > 2) z = RW_MFMA(frag(L + O_AABB, b, 1, lane), *(const RW_LAS bf16x8*)(xt + l15 * PB + (32 + 8 * g) * 2), z); }
          const u32x2 tw = *(const RW_LAS u32x2*)(L + O_TB + b * 768 + l15 * 48 + (4 * g) * 2);
          const u32x4 tf = {tw.x, tw.y, 0u, 0u}, zf = {cvtpk(z[0], z[1]), cvtpk(z[2], z[3]), 0u, 0u};
          f32x4 xb = {0.f, 0.f, 0.f, 0.f}; xb = RW_MFMA(__builtin_bit_cast(bf16x8, tf), __builtin_bit_cast(bf16x8, zf), xb);
          u32x2 o; o.x = cvtpk(xb[0], xb[1]); o.y = cvtpk(xb[2], xb[3]); *(RW_LAS u32x2*)(xt + l15 * PB + (16 * b + 4 * g) * 2) = o;
          asm volatile("s_waitcnt lgkmcnt(0)" ::: "memory"); } }
    RW_SYNC();
#endif
    if (STOP == 4) continue;
    {
      const bf16x8 rb0 = frag(L + O_ARB, t4, 0, lane), rb1 = frag(L + O_ARB, t4, 1, lane), bt0 = frag(L + O_BT, t4, 0, lane), bt1 = frag(L + O_BT, t4, 1, lane);
      const int col = 16 * t4 + l15; const float gam = ((const RW_LAS float*)(L + O_GAM))[col];
      unsigned qw[4], pw[4];
#pragma unroll
      for (int u = 0; u < 2; ++u) { const int mt = p2 + u, j0 = 16 * mt + 4 * g; const bf16x8 w0 = frag(L + O_WT, mt, 0, lane), w1 = frag(L + O_WT, mt, 1, lane);
          f32x4 q = {0.f, 0.f, 0.f, 0.f}, p = q; q = RW_MFMA(w0, rb0, q); q = RW_MFMA(w1, rb1, q); p = RW_MFMA(w0, bt0, p); p = RW_MFMA(w1, bt1, p);
          const u32x2 rr = *(const RW_LAS u32x2*)(L + O_R + col * PB + j0 * 2);
          q[0] += blo(rr.x); q[1] += bhi(rr.x); q[2] += blo(rr.y); q[3] += bhi(rr.y);
#pragma unroll
          for (int r = 0; r < 4; ++r) p[r] = (p[r] + ((j0 + r) == col ? 1.f : 0.f)) * gam;
          qw[2 * u] = cvtpk(q[0], q[1]); qw[2 * u + 1] = cvtpk(q[2], q[3]); pw[2 * u] = cvtpk(p[0], p[1]); pw[2 * u + 1] = cvtpk(p[2], p[3]); }
      const int fo = ((t4 * 2 + (p2 >> 1)) * 64 + lane) * 16;
      *(u32x4*)(rec + REC_Q + fo) = (u32x4){qw[0], qw[1], qw[2], qw[3]}; *(u32x4*)(rec + REC_P + fo) = (u32x4){pw[0], pw[1], pw[2], pw[3]}; }
    {
      const bf16x8 rb0 = frag(L + O_ARB, t4, 0, lane), rb1 = frag(L + O_ARB, t4, 1, lane), rk0 = frag(L + O_ARK, t4, 0, lane), rk1 = frag(L + O_ARK, t4, 1, lane);
      const bf16x8 ut0 = frag(L + O_UT, t4, 0, lane), ut1 = frag(L + O_UT, t4, 1, lane), vt0 = frag(L + O_VT, t4, 0, lane), vt1 = frag(L + O_VT, t4, 1, lane);
      const int col = 16 * t4 + l15;
#pragma unroll
      for (int u = 0; u < 2; ++u) { const int mt = p2 + u, m0 = 16 * mt + 4 * g;
          f32x4 y = {0.f, 0.f, 0.f, 0.f}, hm = y;
          y = RW_MFMA(frag(L + O_UT, mt, 0, lane), rb0, y); y = RW_MFMA(frag(L + O_UT, mt, 1, lane), rb1, y); y = RW_MFMA(frag(L + O_VT, mt, 0, lane), rk0, y); y = RW_MFMA(frag(L + O_VT, mt, 1, lane), rk1, y);
          hm = RW_MFMA(frag(L + O_BT, mt, 0, lane), ut0, hm); hm = RW_MFMA(frag(L + O_BT, mt, 1, lane), ut1, hm); hm = RW_MFMA(frag(L + O_KT, mt, 0, lane), vt0, hm); hm = RW_MFMA(frag(L + O_KT, mt, 1, lane), vt1, hm);
          const f32x4 gm = *(const RW_LAS f32x4*)(L + O_GAM + m0 * 4);
          u32x2 o; o.x = cvtpk(y[0], y[1]); o.y = cvtpk(y[2], y[3]); *(u32x2*)(rec + REC_Y + (col * 64 + m0) * 2) = o;
          o.x = cvtpk(hm[0] * gm[0], hm[1] * gm[1]); o.y = cvtpk(hm[2] * gm[2], hm[3] * gm[3]); *(u32x2*)(rec + REC_H + (col * 64 + m0) * 2) = o; } }
    RW_SYNC();
  }
}

__device__ __forceinline__ void phase_b_head(RW_LAS unsigned char* L, const unsigned char* recs, unsigned short* Yg, int tid) {
    constexpr int NCH = 256, NSLOT = 4;
    const int lane = tid & 63, w = __builtin_amdgcn_readfirstlane(tid >> 6), g = lane >> 4, l15 = lane & 15;
    if (w >= 4) {
        const int lw = w - 4; const unsigned char* src = recs + lw * 8192 + lane * 16;
#define RW_ISSUE(c_) do { _Pragma("unroll") for (int k_ = 0; k_ < 8; ++k_) __builtin_amdgcn_global_load_lds((const unsigned*)(src + (size_t)(c_) * REC + k_ * 1024), (RW_LAS unsigned*)(L + ((c_) & 3) * REC + lw * 8192 + k_ * 1024), 16, 0, 0); } while (0)
        RW_ISSUE(0); RW_ISSUE(1); RW_ISSUE(2);
        asm volatile("s_waitcnt vmcnt(16)" ::: "memory");
        RW_BAR();
        for (int c = 0; c < NCH; ++c) {
            if (c + 3 < NCH) { RW_ISSUE(c + 3); asm volatile("s_waitcnt vmcnt(16)" ::: "memory"); }
            else asm volatile("s_waitcnt vmcnt(0)" ::: "memory");
            RW_BAR();
        }
#undef RW_ISSUE
    } else {
        f32x4 sacc[4];
#pragma unroll
        for (int m = 0; m < 4; ++m) sacc[m] = (f32x4){0.f, 0.f, 0.f, 0.f};
        RW_BAR();
        for (int c = 0; c < NCH; ++c) { const RW_LAS unsigned char* sl = L + (c & 3) * REC;
            bf16x8 bf[2];
#pragma unroll
            for (int s = 0; s < 2; ++s) { u32x4 v; v.x = cvtpk(sacc[2 * s][0], sacc[2 * s][1]); v.y = cvtpk(sacc[2 * s][2], sacc[2 * s][3]); v.z = cvtpk(sacc[2 * s + 1][0], sacc[2 * s + 1][1]); v.w = cvtpk(sacc[2 * s + 1][2], sacc[2 * s + 1][3]); bf[s] = __builtin_bit_cast(bf16x8, v); }
            f32x4 sn[4];
#pragma unroll
            for (int m = 0; m < 4; ++m) { const u32x2 hw = *(const RW_LAS u32x2*)(sl + REC_H + ((16 * w + l15) * 64 + 16 * m + 4 * g) * 2);
                f32x4 acc = {blo(hw.x), bhi(hw.x), blo(hw.y), bhi(hw.y)};
                acc = RW_MFMA(*(const RW_LAS bf16x8*)(sl + REC_P + ((m * 2 + 0) * 64 + lane) * 16), bf[0], acc);
                acc = RW_MFMA(*(const RW_LAS bf16x8*)(sl + REC_P + ((m * 2 + 1) * 64 + lane) * 16), bf[1], acc); sn[m] = acc; }
#pragma unroll
            for (int n = 0; n < 4; ++n) { const u32x2 yw = *(const RW_LAS u32x2*)(sl + REC_Y + ((16 * n + l15) * 64 + 16 * w + 4 * g) * 2);
                f32x4 acc = {blo(yw.x), bhi(yw.x), blo(yw.y), bhi(yw.y)};
                acc = RW_MFMA(bf[0], *(const RW_LAS bf16x8*)(sl + REC_Q + ((n * 2 + 0) * 64 + lane) * 16), acc);
                acc = RW_MFMA(bf[1], *(const RW_LAS bf16x8*)(sl + REC_Q + ((n * 2 + 1) * 64 + lane) * 16), acc);
                u32x2 yo; yo.x = cvtpk(acc[0], acc[1]); yo.y = cvtpk(acc[2], acc[3]); *(u32x2*)(Yg + (size_t)(c * 64 + 16 * n + l15) * 1024 + 16 * w + 4 * g) = yo; }
#pragma unroll
            for (int m = 0; m < 4; ++m) sacc[m] = sn[m];
            asm volatile("s_waitcnt lgkmcnt(0)" ::: "memory");
            RW_BAR();
        }
    }
}
}
#define XB_TMO      128
#define XB_XCNT(j)  (256  + 64 * (j))
#define XB_XSUB(j)  (1280 + 64 * (j))
#define XB_XGEN(j)  (2304 + 64 * (j))
#define XB_TOP      3328
#define XB_TOPGEN   3392
#define XCD_BAR_WORDS 3456
#define XB_SPIN_CAP (1u << 18)

__device__ __forceinline__ unsigned xb_ld(unsigned* p)              { return __hip_atomic_load(p, __ATOMIC_RELAXED, __HIP_MEMORY_SCOPE_AGENT); }
__device__ __forceinline__ unsigned xb_add(unsigned* p, unsigned v) { return __hip_atomic_fetch_add(p, v, __ATOMIC_RELAXED, __HIP_MEMORY_SCOPE_AGENT); }
__device__ __forceinline__ unsigned xb_xcc_id() { return (unsigned)__builtin_amdgcn_s_getreg((3 << 11) | 20) & 0xFu; }
#define XB_SPIN(cond, bar) do { unsigned _sp = 0; while (cond) { __builtin_amdgcn_s_sleep(1); \
    if ((++_sp & 255u) == 0u) { if (xb_ld(&(bar)[XB_TMO])) break; if (_sp > XB_SPIN_CAP) { atomicAdd(&(bar)[XB_TMO], 1u); break; } } } } while (0)

struct XcdBarrier {
    unsigned* bar; unsigned x;
    volatile LAS unsigned* st;
};

__device__ __forceinline__ XcdBarrier xcd_barrier_post(unsigned* bar, volatile LAS unsigned* st, const int tid) {
    XcdBarrier b; b.bar = bar; b.x = xb_xcc_id(); b.st = st;
    if (tid == 0) (void)xb_add(&bar[XB_XCNT(b.x)], 1u);
    return b;
}
__device__ __forceinline__ void xcd_barrier_complete(unsigned* bar, unsigned x, unsigned& nloc, unsigned& nx) {
    const unsigned G = gridDim.x * gridDim.y * gridDim.z;
    unsigned sum, cnt, mine, sp = 0u;
    for (;;) {
        sum = 0u; cnt = 0u; mine = 0u;
#pragma unroll
        for (unsigned j = 0; j < 16; ++j) { const unsigned c = xb_ld(&bar[XB_XCNT(j)]); sum += c; cnt += (c > 0u) ? 1u : 0u; mine = (j == x) ? c : mine; }
        if (sum == G) break;
        __builtin_amdgcn_s_sleep(1);
        if ((++sp & 255u) == 0u) { if (xb_ld(&bar[XB_TMO])) break; if (sp > XB_SPIN_CAP) { atomicAdd(&bar[XB_TMO], 1u); break; } }
    }
    nloc = mine > 0u ? mine : 1u; nx = cnt > 0u ? cnt : 1u;
}

__device__ __forceinline__ void xcd_barrier(const XcdBarrier& b, const int tid) {
    asm volatile("s_waitcnt vmcnt(0)" ::: "memory");
    __syncthreads();
    if (tid == 0) {
        unsigned* bar = b.bar;
        __builtin_amdgcn_s_waitcnt(0);
        unsigned nloc = b.st[0], nx = b.st[1];
        if (nloc == 0u) { xcd_barrier_complete(bar, b.x, nloc, nx); b.st[0] = nloc; b.st[1] = nx; }
        const unsigned old = xb_add(&bar[XB_XSUB(b.x)], 1u);
        const unsigned gen = old / nloc;
        if (old + 1u == (gen + 1u) * nloc) {
            __builtin_amdgcn_fence(__ATOMIC_RELEASE, "agent");
            asm volatile("s_waitcnt vmcnt(0)" ::: "memory");
            const unsigned og = xb_add(&bar[XB_TOP], 1u);
            const unsigned tg = og / nx;
            if (og + 1u == (tg + 1u) * nx) xb_add(&bar[XB_TOPGEN], 1u);
            else XB_SPIN(xb_ld(&bar[XB_TOPGEN]) == tg, bar);
            __builtin_amdgcn_fence(__ATOMIC_ACQUIRE, "agent");
            xb_add(&bar[XB_XGEN(b.x)], 1u);
            asm volatile("s_waitcnt vmcnt(0)" ::: "memory");
        } else {
            XB_SPIN(xb_ld(&bar[XB_XGEN(b.x)]) == gen, bar);
            __builtin_amdgcn_fence(__ATOMIC_ACQUIRE, "agent");
            asm volatile("s_waitcnt vmcnt(0)" ::: "memory");
        }
    }
    __syncthreads();
}
enum InIdx { I_X = 0, I_C, I_WADA, I_BADA, I_N1G, I_WIN, I_MU, I_WDEC, I_W0, I_WICLR, I_A0, I_WGATE, I_KK, I_KA, I_RK, I_GNG, I_GNB, I_WOA, I_BF, I_QN, I_KN, I_WOB, I_WOUT, I_N2G, I_WR, I_BR, I_WGU, I_BGU, I_WDN, I_BDN, I_NFG, N_IN };
struct Args { const float* in[N_IN]; float* out; unsigned char* ws; int ph_lo, ph_hi; };
static_assert(sizeof(Args) == (N_IN + 2) * 8 + 8, "Args has no padding");
typedef const __attribute__((address_space(4))) Args* ArgsP;
struct Frame {
    LAS unsigned char* lds;
    volatile LAS unsigned* MISC;
    gu32* ctl;
    int tid, lane, wave, G, wg;
    unsigned char* ws;
    ArgsP ap;
};
#define WSP(T_, off) ((T_*)(F.ws + (off)))

__device__ __forceinline__ int win_orig_col(int c) {
    if (c < PC_GLO) return c;
    if (c < PC_DLO) return 3264 + (c - PC_GLO);
    if (c < PC_ALO) return 3072 + (c - PC_DLO);
    if (c < PC_F) return 3168 + (c - PC_ALO);
    if (c < PC_FEND) return 6592 + (c - PC_F);
    if (c < PC_SPLIT) return -1;
    if (c < PC_FQ) return 7624 + (c - PC_GA);
    if (c < PC_OG) return 3520 + (c - PC_FQ);
    if (c < PC_GB) return 6600 + (c - PC_OG);
    return 9672 + (c - PC_GB);
}
__device__ __forceinline__ void tr_item(const float* W, int ldw, int K, bf16* WT, int drow0, int scol0, int nvalid, int k0, LAS float* scr, int lane) {
    const int n = lane & 31;
#pragma unroll 8
    for (int i = 0; i < 32; ++i) { const int kk = 2 * i + (lane >> 5); scr[kk * 33 + n] = (n < nvalid) ? W[(size_t)(k0 + kk) * ldw + scol0 + n] : 0.f; }
    LDS_WAIT(); asm volatile("" ::: "memory");
    const int c = lane & 7;
#pragma unroll
    for (int j = 0; j < 4; ++j) { const int nn = (lane >> 3) + 8 * j; const LAS float* s = scr + (8 * c) * 33 + nn;
        v4u o; o.x = pk2(s[0 * 33], s[1 * 33]); o.y = pk2(s[2 * 33], s[3 * 33]); o.z = pk2(s[4 * 33], s[5 * 33]); o.w = pk2(s[6 * 33], s[7 * 33]);
        *(GAS v4u*)(WT + (size_t)(drow0 + nn) * K + k0 + 8 * c) = o; }
    LDS_WAIT(); asm volatile("" ::: "memory");
}
__device__ __forceinline__ unsigned pk4_fp8(float a, float b, float c, float d) { int w = __builtin_amdgcn_cvt_pk_fp8_f32(a, b, 0, false); w = __builtin_amdgcn_cvt_pk_fp8_f32(c, d, w, true); return (unsigned)w; }
__device__ __forceinline__ void tr_item8(const float* W, int ldw, int K, unsigned char* WT, int drow0, int scol0, int nvalid, int k0, float scale, LAS float* scr, int lane) {
    const int n = lane & 31;
#pragma unroll 8
    for (int i = 0; i < 32; ++i) { const int kk = 2 * i + (lane >> 5); scr[kk * 33 + n] = (n < nvalid) ? W[(size_t)(k0 + kk) * ldw + scol0 + n] * scale : 0.f; }
    LDS_WAIT(); asm volatile("" ::: "memory");
    const int c = lane & 7;
#pragma unroll
    for (int j = 0; j < 4; ++j) { const int nn = (lane >> 3) + 8 * j; const LAS float* s = scr + (8 * c) * 33 + nn;
        v2u o; o.x = pk4_fp8(s[0 * 33], s[1 * 33], s[2 * 33], s[3 * 33]); o.y = pk4_fp8(s[4 * 33], s[5 * 33], s[6 * 33], s[7 * 33]);
        *(GAS v2u*)(WT + (size_t)(drow0 + nn) * K + k0 + 8 * c) = o; }
    LDS_WAIT(); asm volatile("" ::: "memory");
}
struct ConvItem { const float* src; unsigned char* dst; int ldw, dn; };
__device__ __forceinline__ ConvItem conv_item(Frame& F, int it) {
    constexpr int I_GU = NE * 32 * 128; ConvItem c;
    if (it < I_GU) { const int e = it / (32 * 128), q = it % (32 * 128), kb = q / 128, gp = q % 128, d0 = gp * 32, pn = d0 >> 8, j = d0 & 255, sc = j < 128 ? 128 * pn + j : 2048 + 128 * pn + (j - 128);
        c.src = F.ap->in[I_WGU] + (size_t)e * 2048 * 4096 + (size_t)(kb * 64) * 4096 + sc; c.dst = WSP(unsigned char, WS_WGU) + (size_t)e * 4096 * 2048 + (size_t)d0 * 2048 + kb * 64; c.ldw = 4096; c.dn = 0; }
    else { const int r = it - I_GU, e = r / (32 * 64), q = r % (32 * 64), kb = q / 64, gp = q % 64;
        const int d0 = gp * 32, trow = (d0 & ~255) + 32 * ((d0 >> 6) & 3) + 16 * ((d0 >> 5) & 1);
        c.src = F.ap->in[I_WDN] + (size_t)e * 2048 * 2048 + (size_t)(kb * 64) * 2048 + d0; c.dst = WSP(unsigned char, WS_WDN) + (size_t)e * 2048 * 2048 + (size_t)trow * 2048 + kb * 64; c.ldw = 2048; c.dn = 1; }
    return c;
}
__device__ __forceinline__ void convert_experts(Frame& F, int rank, int nranks) {
    constexpr int NIT = NE * 32 * 128 + NE * 32 * 64;
    LAS float* scr = (LAS float*)(F.lds + RING_OFF + F.wave * 16384);
    const int lane = F.lane, gw = rank * NWAVES + F.wave, NGW = nranks * NWAVES, c4 = lane & 7, r8 = lane >> 3;
    f32x4 cur[8], n1[8], n2[8]; ConvItem ci, c1, c2;
#define CONV_LOAD(dst, cc, it_) do { cc = conv_item(F, it_); _Pragma("unroll") for (int j = 0; j < 8; ++j) dst[j] = __builtin_nontemporal_load((const f32x4*)(cc.src + (size_t)(r8 + 8 * j) * cc.ldw + 4 * c4)); } while (0)
    if (gw < NIT) CONV_LOAD(cur, ci, gw);
    if (gw + NGW < NIT) CONV_LOAD(n1, c1, gw + NGW);
    for (int it = gw; it < NIT; it += NGW) {
        if (it + 2 * NGW < NIT) CONV_LOAD(n2, c2, it + 2 * NGW);
#pragma unroll
        for (int j = 0; j < 8; ++j) { LAS float* s = scr + (r8 + 8 * j) * 33 + 4 * c4; s[0] = cur[j].x * FP8_SW; s[1] = cur[j].y * FP8_SW; s[2] = cur[j].z * FP8_SW; s[3] = cur[j].w * FP8_SW; }
        LDS_WAIT(); asm volatile("" ::: "memory");
#pragma unroll
        for (int j = 0; j < 4; ++j) { const int nn = r8 + 8 * j; const LAS float* s = scr + (8 * c4) * 33 + nn;
            v2u o; o.x = pk4_fp8(s[0 * 33], s[1 * 33], s[2 * 33], s[3 * 33]); o.y = pk4_fp8(s[4 * 33], s[5 * 33], s[6 * 33], s[7 * 33]);
            const int drow = ci.dn ? 128 * (j & 1) + 8 * (j >> 1) + r8 : nn;
            __builtin_nontemporal_store(o, (v2u*)(ci.dst + (size_t)drow * 2048 + 8 * c4)); }
        LDS_WAIT(); asm volatile("" ::: "memory");
        ci = c1; c1 = c2;
#pragma unroll
        for (int j = 0; j < 8; ++j) { cur[j] = n1[j]; n1[j] = n2[j]; }
    }
#undef CONV_LOAD
}
__device__ __forceinline__ void p0_prologue(Frame& F) {
    LAS float* scr = (LAS float*)(F.lds + RING_OFF + F.wave * 16384);
    const int gw = F.wg * NWAVES + F.wave, NGW = F.G * NWAVES, lane = F.lane;
    constexpr int I_IN = 32 * 368, I_OA = 16 * 64, I_OB = I_OA, I_OUT = 32 * 64;
    constexpr int NITEMS = I_IN + I_OA + I_OB + I_OUT;
    for (int it = gw; it < NITEMS; it += NGW) {
        int r = it;
        if (r < I_IN) { const int kb = r / 368, gp = r % 368, c0 = gp * 32, oc = win_orig_col(c0); const int nv = oc < 0 ? 0 : (c0 == PC_F ? PC_FEND - PC_F : 32);
            const bool as8 = INPROJ_FP8 == 1 || (INPROJ_FP8 == 2 && c0 >= PC_SPLIT);
            if (as8) tr_item8(F.ap->in[I_WIN], 11720, 2048, WSP(unsigned char, WS_WIN8), c0, oc < 0 ? 0 : oc, nv, kb * 64, FP8_SW, scr, lane);
            else tr_item(F.ap->in[I_WIN], 11720, 2048, WSP(bf16, WS_WIN), c0, oc < 0 ? 0 : oc, nv, kb * 64, scr, lane);
            continue; } r -= I_IN;
        if (r < I_OA) { tr_item(F.ap->in[I_WOA], 2048, 1024, WSP(bf16, WS_WOA), (r % 64) * 32, (r % 64) * 32, 32, (r / 64) * 64, scr, lane); continue; } r -= I_OA;
        if (r < I_OB) { tr_item(F.ap->in[I_WOB], 2048, 1024, WSP(bf16, WS_WOB), (r % 64) * 32, (r % 64) * 32, 32, (r / 64) * 64, scr, lane); continue; } r -= I_OB;
#if OUTPROJ_FP8
        { tr_item8(F.ap->in[I_WOUT], 2048, 2048, WSP(unsigned char, WS_WOUT), (r % 64) * 32, (r % 64) * 32, 32, (r / 64) * 64, FP8_SW, scr, lane); }
#else
        { tr_item(F.ap->in[I_WOUT], 2048, 2048, WSP(bf16, WS_WOUT), (r % 64) * 32, (r % 64) * 32, 32, (r / 64) * 64, scr, lane); }
#endif
    }
    const int gt = F.wg * (NWAVES * 64) + F.tid, NGT = F.G * NWAVES * 64;
    { bf16* b1 = WSP(bf16, WS_BT1); const float* wd = F.ap->in[I_WDEC]; const float* wi = F.ap->in[I_WICLR];
      for (int i = gt; i < 2048 * 256; i += NGT) { const int n = i >> 8, k = i & 255; float v = 0.f;
          if (n < 1024) { if (k < 96) v = wd[k * 1024 + n]; } else { if (k >= 128 && k < 224) v = wi[(k - 128) * 1024 + (n - 1024)]; }
          b1[i] = (bf16)f2bf(v); } }
    { bf16* b2 = WSP(bf16, WS_BT2); const float* wg = F.ap->in[I_WGATE];
      for (int i = gt; i < 1024 * 256; i += NGT) { const int n = i >> 8, k = i & 255; b2[i] = (bf16)f2bf(wg[k * 1024 + n]); } }
    { float* wrt = WSP(float, WS_WRT); const float* wr = F.ap->in[I_WR];
      for (int i = gt; i < 32 * 2048; i += NGT) { const int e = i >> 11, k = i & 2047; wrt[i] = wr[k * 32 + e]; } }
    { bf16* h = WSP(bf16, WS_H) + (size_t)T * DM; for (int i = gt; i < DM; i += NGT) h[i] = 0; }
    if (F.wg < 192) {
        const float* wa = F.ap->in[I_WADA]; const float* cc = F.ap->in[I_C]; const int n = F.wg * 64 + lane;
        LAS float* sl = (LAS float*)(F.lds + RING_OFF + 131072 - 4096 - 16384);
        __syncthreads();
#pragma unroll
        for (int j = 0; j < 8; ++j) { const int i = F.tid + 512 * j; const float c = cc[i]; sl[i] = c * sigmoidf_(c); }
        __syncthreads();
        float s0 = 0.f, s1 = 0.f; const float* wp = wa + (size_t)(F.wave * 256) * 12288 + n; const LAS float* s0p = sl + F.wave * 256; const LAS float* s1p = sl + 2048 + F.wave * 256;
        for (int k = 0; k < 256; k += 16) { float w[16];
#pragma unroll
            for (int u = 0; u < 16; ++u) w[u] = wp[(size_t)(k + u) * 12288];
#pragma unroll
            for (int u = 0; u < 16; u += 4) { const f32x4 a = *(const LAS f32x4*)(s0p + k + u), c = *(const LAS f32x4*)(s1p + k + u);
                s0 += (a[0] * w[u] + a[1] * w[u + 1]) + (a[2] * w[u + 2] + a[3] * w[u + 3]); s1 += (c[0] * w[u] + c[1] * w[u + 1]) + (c[2] * w[u + 2] + c[3] * w[u + 3]); } }
        LAS float* red = (LAS float*)(F.lds + RING_OFF + 131072 - 4096);
        __syncthreads();
        red[(F.wave * 2 + 0) * 64 + lane] = s0; red[(F.wave * 2 + 1) * 64 + lane] = s1;
        __syncthreads();
        if (F.wave < 2) { float s = 0.f;
#pragma unroll
            for (int w = 0; w < 8; ++w) s += red[(w * 2 + F.wave) * 64 + lane];
            WSP(float, WS_MOD)[F.wave * 12288 + n] = s + F.ap->in[I_BADA][n]; }
    }
}
template <int OUT8> __device__ __forceinline__ void norm_mod_rows(Frame& F, const float* x, const float* g, int shift_off, int scale_off, bf16* H, unsigned char* H8) {
    const int gw = F.wg * NWAVES + F.wave, NGW = F.G * NWAVES, lane = F.lane; const float* mod = WSP(float, WS_MOD);
    for (int m = gw; m < T; m += NGW) {
        const f32x4* xr = (const f32x4*)(x + (size_t)m * DM) + lane; f32x4 v[8]; float ss = 0.f;
#pragma unroll
        for (int j = 0; j < 8; ++j) { v[j] = xr[64 * j]; ss += (v[j].x * v[j].x + v[j].y * v[j].y) + (v[j].z * v[j].z + v[j].w * v[j].w); }
        const float rs = rsqrtf(wave_sum(ss) * (1.f / DM) + NORM_EPS); const float* mb = mod + (size_t)(m / SEQ) * 12288;
#pragma unroll
        for (int j = 0; j < 8; ++j) { const int c = 4 * lane + 256 * j; const f32x4 gg = *(const f32x4*)(g + c), sc = *(const f32x4*)(mb + scale_off + c), sh = *(const f32x4*)(mb + shift_off + c);
            const f32x4 y = v[j] * rs * gg * (sc + 1.f) + sh;
            if constexpr (OUT8 != 0) *(unsigned*)(H8 + (size_t)m * DM + c) = pk4_fp8(y.x * FP8_SA1, y.y * FP8_SA1, y.z * FP8_SA1, y.w * FP8_SA1);
            if constexpr (OUT8 != 1) { v2u o; o.x = pk2(y.x, y.y); o.y = pk2(y.z, y.w); *(v2u*)(H + (size_t)m * DM + c) = o; } }
    }
}
struct PrepTok { v4u rkv[6]; v4u lo; v4u fq[2], fk[2]; unsigned fp; };
__device__ __forceinline__ void prep_load(PrepTok& k, const bf16* pc, int lane, int cl) {
#pragma unroll
    for (int s = 0; s < 6; ++s) k.rkv[s] = *(const v4u*)(pc + PC_R + (s * 64 + lane) * 8);
    k.lo = *(const v4u*)(pc + cl);
#pragma unroll
    for (int s = 0; s < 2; ++s) { k.fq[s] = *(const v4u*)(pc + PC_FQ + (s * 64 + lane) * 8); k.fk[s] = *(const v4u*)(pc + PC_FK + (s * 64 + lane) * 8); }
    k.fp = (unsigned)pc[PC_F + (lane & 7)];
}
__device__ __forceinline__ void p3_prep(Frame& F) {
    const int gw = F.wg * NWAVES + F.wave, lane = F.lane, t0 = gw * 16;
    const bf16* P = WSP(bf16, WS_P); const float* mu = F.ap->in[I_MU];
    bf16* Rb = WSP(bf16, WS_R); bf16* LW = WSP(bf16, WS_LW); bf16* SG = WSP(bf16, WS_SG);
    int cl, mi; if (lane < 32) { cl = PC_GLO + 8 * lane; mi = 3264 + 8 * lane; } else if (lane < 44) { cl = PC_DLO + 8 * (lane - 32); mi = 3072 + 8 * (lane - 32); } else if (lane < 56) { cl = PC_ALO + 8 * (lane - 44); mi = 3168 + 8 * (lane - 44); } else { cl = PC_ALO; mi = 3168; }
    f32x4 m0[6], m1[6];
#pragma unroll
    for (int s = 0; s < 6; ++s) { const int c = (s * 64 + lane) * 8; m0[s] = *(const f32x4*)(mu + c); m1[s] = *(const f32x4*)(mu + c + 4); }
    const f32x4 ml0 = *(const f32x4*)(mu + mi), ml1 = *(const f32x4*)(mu + mi + 4);
    f32x4 gq[2][2], gk[2][2];
#pragma unroll
    for (int s = 0; s < 2; ++s) { const int d0 = ((s * 64 + lane) & 15) * 8; gq[s][0] = *(const f32x4*)(F.ap->in[I_QN] + d0); gq[s][1] = *(const f32x4*)(F.ap->in[I_QN] + d0 + 4); gk[s][0] = *(const f32x4*)(F.ap->in[I_KN] + d0); gk[s][1] = *(const f32x4*)(F.ap->in[I_KN] + d0 + 4); }
    const float bfl = F.ap->in[I_BF][lane & 7];
    v4u prv[6], prvl; const v4u zz = {0u, 0u, 0u, 0u};
    if ((t0 % SEQ) == 0) {
#pragma unroll
        for (int s = 0; s < 6; ++s) prv[s] = zz; prvl = zz; }
    else { const bf16* pp = P + (size_t)(t0 - 1) * NP;
#pragma unroll
        for (int s = 0; s < 6; ++s) prv[s] = *(const v4u*)(pp + PC_R + (s * 64 + lane) * 8); prvl = *(const v4u*)(pp + cl); }
    PrepTok cur, nxt; prep_load(cur, P + (size_t)t0 * NP, lane, cl);
    for (int i = 0; i < 16; ++i) { const int t = t0 + i;
        if (i + 1 < 16) prep_load(nxt, P + (size_t)(t + 1) * NP, lane, cl);
#pragma unroll
        for (int s = 0; s < 6; ++s) { const int c = (s * 64 + lane) * 8; float a[8], b[8], o[8]; unpack8(cur.rkv[s], a); unpack8(prv[s], b);
#pragma unroll
            for (int j = 0; j < 8; ++j) { const float mm = j < 4 ? m0[s][j] : m1[s][j - 4]; o[j] = a[j] + mm * (b[j] - a[j]); }
            *(v4u*)(Rb + (size_t)(c >> 10) * ((WS_K - WS_R) / 2) + (size_t)t * RW + (c & 1023)) = pack8f(o); prv[s] = cur.rkv[s]; }
        { float o[8] = {0.f, 0.f, 0.f, 0.f, 0.f, 0.f, 0.f, 0.f};
          if (lane < 56) { float a[8], b[8]; unpack8(cur.lo, a); unpack8(prvl, b);
#pragma unroll
              for (int j = 0; j < 8; ++j) { const float mm = j < 4 ? ml0[j] : ml1[j - 4]; const float v = a[j] + mm * (b[j] - a[j]); o[j] = lane < 32 ? sigmoidf_(v) : (lane < 44 ? tanhf(v) : v); } }
          prvl = cur.lo;
          bf16* dst; if (lane < 32) dst = SG + (size_t)t * 256 + 8 * lane; else if (lane < 44) dst = LW + (size_t)t * 256 + 8 * (lane - 32); else if (lane < 56) dst = LW + (size_t)t * 256 + 128 + 8 * (lane - 44);
          else if (lane < 60) dst = LW + (size_t)t * 256 + 96 + 8 * (lane - 56); else dst = LW + (size_t)t * 256 + 224 + 8 * (lane - 60);
          *(v4u*)dst = pack8f(o); }
#pragma unroll
        for (int s = 0; s < 2; ++s) { const int ch = s * 64 + lane;
#pragma unroll
            for (int qk = 0; qk < 2; ++qk) { float a[8]; unpack8(qk ? cur.fk[s] : cur.fq[s], a); float ss = 0.f;
#pragma unroll
                for (int j = 0; j < 8; ++j) ss += a[j] * a[j];
                ss += __shfl_xor(ss, 1); ss += __shfl_xor(ss, 2); ss += __shfl_xor(ss, 4); ss += __shfl_xor(ss, 8);
                const float rs = rsqrtf(ss * (1.f / 128.f) + NORM_EPS); const f32x4 g0 = qk ? gk[s][0] : gq[s][0], g1 = qk ? gk[s][1] : gq[s][1];
#pragma unroll
                for (int j = 0; j < 8; ++j) a[j] = a[j] * rs * (j < 4 ? g0[j] : g1[j - 4]);
                *(v4u*)(WSP(bf16, qk ? WS_FK : WS_FQ) + (size_t)t * FW + ch * 8) = pack8f(a); } }
        if (lane < 8) { const float xv = bflo(cur.fp) + bfl;
            WSP(float, WS_LF)[(size_t)t * 8 + lane] = fminf(xv, 0.f) - log1pf(__expf(-fabsf(xv))); }
        cur = nxt;
    }
}
__device__ __forceinline__ void p4_cumsum(Frame& F) {
    if (F.wg >= 16) return;
    const int b = F.wg >> 3, h = F.wg & 7; const float* lf = WSP(float, WS_LF) + (size_t)b * SEQ * 8 + h; float* cs = WSP(float, WS_CS) + (size_t)F.wg * SEQ;
    LAS float* part = (LAS float*)(F.lds + RING_OFF); LAS float* tend = part + 512; LAS float* tstart = part + 768;
    const int t0 = F.tid * 32; float s = 0.f;
    for (int i = 0; i < 32; ++i) s += lf[(size_t)(t0 + i) * 8];
    part[F.tid] = s; __syncthreads();
    if (F.tid == 0) { float run = 0.f; for (int i = 0; i < 512; ++i) { const float v = part[i]; part[i] = run; run += v; } }
    __syncthreads();
    float run = part[F.tid];
    for (int i = 0; i < 32; ++i) { run += lf[(size_t)(t0 + i) * 8]; const float c = -run * 11.313708498984761f; cs[t0 + i] = c;
        if (i == 0 && (F.tid & 7) == 0) tstart[F.tid >> 3] = c; if (i == 31 && (F.tid & 1)) tend[F.tid >> 1] = c; }
    __syncthreads();
    if (F.tid < 64) { const float* qn = F.ap->in[I_QN]; const float* kn = F.ap->in[I_KN]; float mq = fmaxf(fabsf(qn[F.tid]), fabsf(qn[F.tid + 64])), mk = fmaxf(fabsf(kn[F.tid]), fabsf(kn[F.tid + 64]));
#pragma unroll
        for (int o = 1; o < 64; o <<= 1) { mq = fmaxf(mq, __shfl_xor(mq, o)); mk = fmaxf(mk, __shfl_xor(mk, o)); }
        const float horizon = 2.f * 1.01f * 11.313708498984761f * mq * mk + 9.704060527839234f + FOX_SKIP_BITS * 0.6931471805599453f;
        const int qb = F.tid; const float target = tstart[qb] - horizon * 11.313708498984761f; int lo = 0, hi = 4 * qb;
        while (lo < hi) { const int mid = (lo + hi) >> 1; if (tend[mid] >= target) hi = mid; else lo = mid + 1; }
        WSP(int, WS_JLO)[F.wg * 64 + qb] = lo; }
    __syncthreads();
}
__device__ __forceinline__ void p5_scan_naive(Frame& F) {
    constexpr int CH = 64;
    LAS float* Wl = (LAS float*)(F.lds + RING_OFF); LAS float* Al = Wl + CH * 64; LAS float* Bl = Al + CH * 64; LAS float* Kl = Bl + CH * 64; LAS float* Rl = Kl + CH * 64; LAS float* Vl = Rl + CH * 64; LAS float* Yl = Vl + CH * 64;
    const int tid = F.tid, row = tid >> 3, q = tid & 7;
    for (int bh = F.wg; bh < 32; bh += F.G) {
        const int b = bh >> 4, h = bh & 15; const size_t base = (size_t)b * SEQ * RW + h * 64;
        const bf16* Rg = WSP(bf16, WS_R) + base; const bf16* Kg = WSP(bf16, WS_K) + base; const bf16* Vg = WSP(bf16, WS_V) + base; const bf16* Ag = WSP(bf16, WS_A) + base;
        const float* Lg = WSP(float, WS_LOGW) + base; float* Yg = WSP(float, WS_YRAW) + base;
        float kkw[8], kaw[8];
#pragma unroll
        for (int i = 0; i < 8; ++i) { kkw[i] = F.ap->in[I_KK][h * 64 + 8 * q + i]; kaw[i] = F.ap->in[I_KA][h * 64 + 8 * q + i]; }
        float S[8] = {0.f, 0.f, 0.f, 0.f, 0.f, 0.f, 0.f, 0.f};
        for (int t0 = 0; t0 < SEQ; t0 += CH) {
            { const size_t off = (size_t)(t0 + row) * RW + 8 * q; float r[8], k[8], v[8], a[8];
              unpack8(*(const v4u*)(Rg + off), r); unpack8(*(const v4u*)(Kg + off), k); unpack8(*(const v4u*)(Vg + off), v); unpack8(*(const v4u*)(Ag + off), a);
              const f32x4 l0 = *(const f32x4*)(Lg + off), l1 = *(const f32x4*)(Lg + off + 4);
              float kk[8], ss = 0.f;
#pragma unroll
              for (int i = 0; i < 8; ++i) { kk[i] = k[i] * kkw[i]; ss += kk[i] * kk[i]; }
              ss += __shfl_xor(ss, 1); ss += __shfl_xor(ss, 2); ss += __shfl_xor(ss, 4);
              const float inv = 1.f / fmaxf(sqrtf(ss), 1e-12f);
#pragma unroll
              for (int i = 0; i < 8; ++i) { const int o = row * 64 + 8 * q + i; kk[i] *= inv;
                  Wl[o] = __expf(i < 4 ? l0[i] : l1[i - 4]); Al[o] = -kk[i]; Bl[o] = kk[i] * a[i]; Kl[o] = k[i] * (1.f + (a[i] - 1.f) * kaw[i]); Rl[o] = r[i]; Vl[o] = v[i]; } }
            __syncthreads();
            for (int t = 0; t < CH; ++t) { const int o = t * 64 + 8 * q; float sa = 0.f;
                const f32x4 a0 = *(const LAS f32x4*)(Al + o), a1 = *(const LAS f32x4*)(Al + o + 4), w0 = *(const LAS f32x4*)(Wl + o), w1 = *(const LAS f32x4*)(Wl + o + 4);
                const f32x4 b0 = *(const LAS f32x4*)(Bl + o), b1 = *(const LAS f32x4*)(Bl + o + 4), k0 = *(const LAS f32x4*)(Kl + o), k1 = *(const LAS f32x4*)(Kl + o + 4);
                const f32x4 r0 = *(const LAS f32x4*)(Rl + o), r1 = *(const LAS f32x4*)(Rl + o + 4); const float vv = Vl[t * 64 + row];
#pragma unroll
                for (int i = 0; i < 8; ++i) sa += S[i] * (i < 4 ? a0[i] : a1[i - 4]);
                sa += __shfl_xor(sa, 1); sa += __shfl_xor(sa, 2); sa += __shfl_xor(sa, 4);
                float y = 0.f;
#pragma unroll
                for (int i = 0; i < 8; ++i) { S[i] = S[i] * (i < 4 ? w0[i] : w1[i - 4]) + sa * (i < 4 ? b0[i] : b1[i - 4]) + vv * (i < 4 ? k0[i] : k1[i - 4]); y += S[i] * (i < 4 ? r0[i] : r1[i - 4]); }
                y += __shfl_xor(y, 1); y += __shfl_xor(y, 2); y += __shfl_xor(y, 4);
                if (q == 0) Yl[t * 64 + row] = y; }
            __syncthreads();
            { const int tt = tid >> 3, c = (tid & 7) * 8; *(f32x4*)(Yg + (size_t)(t0 + tt) * RW + c) = *(const LAS f32x4*)(Yl + tt * 64 + c); *(f32x4*)(Yg + (size_t)(t0 + tt) * RW + c + 4) = *(const LAS f32x4*)(Yl + tt * 64 + c + 4); }
        }
        __syncthreads();
    }
}
struct PostTok { v4u y[2], r[2], k[2], v[2], a[2], g[2]; };
__device__ __forceinline__ void post_load(PostTok& p, const unsigned char* ws, size_t off) {
#pragma unroll
    for (int j = 0; j < 2; ++j) { p.y[j] = *(const v4u*)((const bf16*)(ws + WS_YRAW) + off + 512 * j); p.r[j] = *(const v4u*)((const bf16*)(ws + WS_R) + off + 512 * j); p.k[j] = *(const v4u*)((const bf16*)(ws + WS_K) + off + 512 * j);
        p.v[j] = *(const v4u*)((const bf16*)(ws + WS_V) + off + 512 * j); p.a[j] = *(const v4u*)((const bf16*)(ws + WS_A) + off + 512 * j); p.g[j] = *(const v4u*)((const bf16*)(ws + WS_G) + off + 512 * j); }
}
__device__ __forceinline__ void p7_post(Frame& F) {
    const int gw = F.wg * NWAVES + F.wave, NGW = F.G * NWAVES, lane = F.lane, c0 = 8 * lane;
    float ka[16], rk[16], gng[16], gnb[16];
#pragma unroll
    for (int i = 0; i < 16; ++i) { const int c = 512 * (i >> 3) + c0 + (i & 7); ka[i] = F.ap->in[I_KA][c]; rk[i] = F.ap->in[I_RK][c]; gng[i] = F.ap->in[I_GNG][c]; gnb[i] = F.ap->in[I_GNB][c]; }
    PostTok cur, nxt; if (gw < T) post_load(cur, F.ws, (size_t)gw * RW + c0);
    for (int t = gw; t < T; t += NGW) { const size_t off = (size_t)t * RW + c0;
        if (t + NGW < T) post_load(nxt, F.ws, (size_t)(t + NGW) * RW + c0);
        float y[16], r[16], k[16], v[16], a[16], g[16];
#pragma unroll
        for (int j = 0; j < 2; ++j) { float tmp[8];
            unpack8(cur.y[j], tmp); for (int i = 0; i < 8; ++i) y[8 * j + i] = tmp[i];
            unpack8(cur.r[j], tmp); for (int i = 0; i < 8; ++i) r[8 * j + i] = tmp[i];
            unpack8(cur.k[j], tmp); for (int i = 0; i < 8; ++i) k[8 * j + i] = tmp[i];
            unpack8(cur.v[j], tmp); for (int i = 0; i < 8; ++i) v[8 * j + i] = tmp[i];
            unpack8(cur.a[j], tmp); for (int i = 0; i < 8; ++i) a[8 * j + i] = tmp[i];
            unpack8(cur.g[j], tmp); for (int i = 0; i < 8; ++i) g[8 * j + i] = tmp[i]; }
        float o[16];
#pragma unroll
        for (int j = 0; j < 2; ++j) { float s = 0.f, bs = 0.f;
#pragma unroll
            for (int i = 8 * j; i < 8 * j + 8; ++i) { s += y[i]; const float kp = k[i] * (1.f + (a[i] - 1.f) * ka[i]); bs += r[i] * kp * rk[i]; }
            s += __shfl_xor(s, 1); s += __shfl_xor(s, 2); s += __shfl_xor(s, 4); bs += __shfl_xor(bs, 1); bs += __shfl_xor(bs, 2); bs += __shfl_xor(bs, 4);
            const float mean = s * (1.f / 64.f); float q = 0.f;
#pragma unroll
            for (int i = 8 * j; i < 8 * j + 8; ++i) { const float d = y[i] - mean; q += d * d; }
            q += __shfl_xor(q, 1); q += __shfl_xor(q, 2); q += __shfl_xor(q, 4);
            const float rstd = rsqrtf(q * (1.f / 64.f) + GN_EPS);
#pragma unroll
            for (int i = 8 * j; i < 8 * j + 8; ++i) o[i] = ((y[i] - mean) * rstd * gng[i] + gnb[i] + bs * v[i]) * g[i]; }
#if OUTA_FP8
#pragma unroll
        for (int j = 0; j < 2; ++j) { v2u w; w.x = pk4_fp8(o[8 * j] * FP8_SYA, o[8 * j + 1] * FP8_SYA, o[8 * j + 2] * FP8_SYA, o[8 * j + 3] * FP8_SYA); w.y = pk4_fp8(o[8 * j + 4] * FP8_SYA, o[8 * j + 5] * FP8_SYA, o[8 * j + 6] * FP8_SYA, o[8 * j + 7] * FP8_SYA);
            *(v2u*)(WSP(unsigned char, WS_YA) + off + 512 * j) = w; }
#else
#pragma unroll
        for (int j = 0; j < 2; ++j) { v4u w; w.x = pk2(o[8 * j], o[8 * j + 1]); w.y = pk2(o[8 * j + 2], o[8 * j + 3]); w.z = pk2(o[8 * j + 4], o[8 * j + 5]); w.w = pk2(o[8 * j + 6], o[8 * j + 7]); *(v4u*)(WSP(bf16, WS_YA) + off + 512 * j) = w; }
#endif
        cur = nxt;
    }
}
__device__ __forceinline__ fox::BlockRef<fox::bf16, fox::bf16> fox_ref(int L_, const unsigned char* ws) {
    const int it = ((const int*)(ws + WS_AORD))[L_], bh = it & 15, qb = it >> 4;
    fox::BlockRef<fox::bf16, fox::bf16> r; r.ws = ws; r.row0 = (bh / fox::H) * fox::SQ + qb * fox::QB; r.bh = bh; r.P0 = qb * fox::QB; r.jlo = ((const int*)(ws + WS_JLO))[bh * 64 + qb]; return r;
}
__device__ __forceinline__ void att_order(Frame& F) {
    LAS int* hist = (LAS int*)(F.lds + RING_OFF); LAS int* base = hist + 260;
    for (int i = F.tid; i < 260; i += NWAVES * 64) hist[i] = 0;
    __syncthreads();
    const int* jl = WSP(int, WS_JLO); int cost[2];
#pragma unroll
    for (int u = 0; u < 2; ++u) { const int it = F.tid + 512 * u, bh = it & 15, qb = it >> 4; cost[u] = 4 * (qb + 1) - jl[bh * 64 + qb]; __hip_atomic_fetch_add(hist + cost[u], 1, __ATOMIC_RELAXED, __HIP_MEMORY_SCOPE_WORKGROUP); }
    __syncthreads();
    if (F.tid == 0) { int run = 0; for (int c = 256; c >= 0; --c) { base[c] = run; run += hist[c]; } }
    __syncthreads();
#pragma unroll
    for (int u = 0; u < 2; ++u) { const int it = F.tid + 512 * u; const int pos = __hip_atomic_fetch_add(base + cost[u], 1, __ATOMIC_RELAXED, __HIP_MEMORY_SCOPE_WORKGROUP); WSP(int, WS_AORD)[pos] = it; }
    __syncthreads();
}
__device__ __forceinline__ int att_fetch(Frame& F, int qi = 0) {
    if (F.tid == 0) F.MISC[4] = __hip_atomic_fetch_add(F.ctl + CW_ATTQ + qi, 1u, RLX_AGENT);
    __syncthreads(); const int v = (int)F.MISC[4]; __syncthreads(); return v;
}
__device__ __forceinline__ void p6_attention(Frame& F, char* lds, int qi = 0) {
    constexpr int TOTAL = (fox::SQ / fox::QB) * fox::B * fox::H;
    int L = att_fetch(F, qi); if (L >= TOTAL) return;
    fox::BlockRef<fox::bf16, fox::bf16> cur = fox_ref(L, F.ws);
    fox::Seam<fox::bf16> S;
    fox::causal_swa_prime<fox::bf16, fox::bf16>(cur, fox::WINDOW, lds, S, F.tid);
    for (;;) {
        const int Ln = att_fetch(F, qi); const bool last = Ln >= TOTAL;
        const fox::BlockRef<fox::bf16, fox::bf16> nxt = last ? cur : fox_ref(Ln, F.ws);
        fox::causal_swa_block<fox::bf16, fox::bf16>(cur, nxt, fox::SKV, fox::WINDOW, lds, S, F.tid);
        if (last) break;
        cur = nxt;
    }
}
typedef float f32x4m __attribute__((ext_vector_type(4)));
__device__ __forceinline__ void p11_router(Frame& F) {
    constexpr int TPW = T / 256 / NWAVES, XP = 136;
    const int lane = F.lane, t0 = (F.wg * NWAVES + F.wave) * TPW;
    const float* x1 = WSP(float, WS_X1); const float* mod = WSP(float, WS_MOD) + (size_t)(t0 / SEQ) * 12288; const float* g2 = F.ap->in[I_N2G]; const float* wrt = WSP(float, WS_WRT);
    LAS float* xs = (LAS float*)(F.lds + RING_OFF + F.wave * (16 * XP * 4));
    LAS float* av = (LAS float*)(F.lds + RING_OFF + 69632); LAS float* sv = av + DM;
    LAS float* lg = (LAS float*)(F.lds + RING_OFF + 86016 + F.wave * 2304);
    LAS int* cnt = (LAS int*)(F.lds + RING_OFF + 104448);
    LAS float* cpart = (LAS float*)(F.lds + RING_OFF + 104704);
    if (F.tid < 32) cnt[F.tid] = 0;
    { const int c = 4 * F.tid; const f32x4 gg = *(const f32x4*)(g2 + c), sc = *(const f32x4*)(mod + 4 * 2048 + c), sh = *(const f32x4*)(mod + 3 * 2048 + c);
      *(LAS f32x4*)(av + c) = gg * (sc + 1.f); *(LAS f32x4*)(sv + c) = sh; }
    __syncthreads();
    { const int e = F.tid & 31, part = F.tid >> 5; float s = 0.f;
      for (int k = 128 * part; k < 128 * part + 128; k += 4) { const f32x4 w = *(const f32x4*)(wrt + (size_t)e * DM + k), h = *(const LAS f32x4*)(sv + k); s += (w[0] * h[0] + w[1] * h[1]) + (w[2] * h[2] + w[3] * h[3]); }
      cpart[part * 32 + e] = s; }
    __syncthreads();
    if (F.tid < 32) { float s = F.ap->in[I_BR][F.tid];
#pragma unroll
        for (int p = 0; p < 16; ++p) s += cpart[p * 32 + F.tid];
        cpart[512 + F.tid] = s; }
    __syncthreads();
    const int i = lane & 15, q = lane >> 4, hf = lane >> 5, l32 = lane & 31;
    { const float* sp = WSP(float, WS_SSP) + (size_t)(8 * q) * T + t0 + i; float s = 0.f;
#pragma unroll
      for (int p = 0; p < 8; ++p) s += sp[(size_t)p * T];
      s += __shfl_xor(s, 16); s += __shfl_xor(s, 32); if (q == 0) lg[512 + i] = rsqrtf(s * (1.f / DM) + NORM_EPS); }
    LDS_WAIT(); asm volatile("" ::: "memory");
    float rsj[8];
#pragma unroll
    for (int j = 0; j < 8; ++j) rsj[j] = lg[512 + 2 * j + hf];
    unsigned char* H2 = WSP(unsigned char, WS_HS) + (size_t)(t0 + hf) * DM + 4 * l32;
    f32x4m acc0 = {0.f, 0.f, 0.f, 0.f}, acc1 = {0.f, 0.f, 0.f, 0.f};
    const float* xrow = x1 + (size_t)(t0 + hf) * DM + 4 * l32; const float* wr = wrt + (size_t)i * DM + 4 * q;
    for (int k0 = 0; k0 < DM; k0 += 128) { f32x4 xv[8], w0[8], w1[8];
#pragma unroll
        for (int j = 0; j < 8; ++j) xv[j] = *(const f32x4*)(xrow + (size_t)(2 * j) * DM + k0);
#pragma unroll
        for (int u = 0; u < 8; ++u) { w0[u] = *(const f32x4*)(wr + k0 + 16 * u); w1[u] = *(const f32x4*)(wr + 16 * DM + k0 + 16 * u); }
        const f32x4 a4 = *(const LAS f32x4*)(av + k0 + 4 * l32), s4 = *(const LAS f32x4*)(sv + k0 + 4 * l32) * FP8_SA1;
#pragma unroll
        for (int j = 0; j < 8; ++j) { const f32x4 xa = xv[j] * a4, hh = xa * (rsj[j] * FP8_SA1) + s4; *(LAS f32x4*)(xs + (2 * j + hf) * XP + 4 * l32) = xa;
            *(unsigned*)(H2 + (size_t)(2 * j) * DM + k0) = pk4_fp8(hh[0], hh[1], hh[2], hh[3]); }
        LDS_WAIT(); asm volatile("" ::: "memory");
#pragma unroll
        for (int u = 0; u < 8; ++u) { const f32x4 hv = *(const LAS f32x4*)(xs + i * XP + 16 * u + 4 * q);
#pragma unroll
            for (int jj = 0; jj < 4; ++jj) { acc0 = __builtin_amdgcn_mfma_f32_16x16x4f32(hv[jj], w0[u][jj], acc0, 0, 0, 0); acc1 = __builtin_amdgcn_mfma_f32_16x16x4f32(hv[jj], w1[u][jj], acc1, 0, 0, 0); } }
        LDS_WAIT(); asm volatile("" ::: "memory"); }
    { const float c0 = cpart[512 + i], c1 = cpart[512 + 16 + i];
#pragma unroll
      for (int r = 0; r < 4; ++r) { const float rs = lg[512 + 4 * q + r]; lg[(4 * q + r) * 32 + i] = acc0[r] * rs + c0; lg[(4 * q + r) * 32 + 16 + i] = acc1[r] * rs + c1; } }
    LDS_WAIT(); asm volatile("" ::: "memory");
    if (lane < 16) { const int m = t0 + lane; float v[4]; int e[4]; unsigned used = 0u;
#pragma unroll
        for (int k = 0; k < 4; ++k) { float best = -3.0e38f; int bi = 0;
            for (int j = 0; j < 32; ++j) { const float x = lg[lane * 32 + j]; if (!((used >> j) & 1u) && x > best) { best = x; bi = j; } }
            used |= 1u << bi; v[k] = best; e[k] = bi; }
        const float e1 = __expf(v[1] - v[0]), e2 = __expf(v[2] - v[0]), e3 = __expf(v[3] - v[0]), inv = 1.f / (1.f + e1 + e2 + e3);
        *(f32x4*)(WSP(float, WS_TOKW) + (size_t)m * 4) = (f32x4){inv, e1 * inv, e2 * inv, e3 * inv};
        int* te = WSP(int, WS_TOKE) + (size_t)m * 4; te[0] = e[0]; te[1] = e[1]; te[2] = e[2]; te[3] = e[3];
#pragma unroll
        for (int k = 0; k < 4; ++k) __hip_atomic_fetch_add(cnt + e[k], 1, __ATOMIC_RELAXED, __HIP_MEMORY_SCOPE_WORKGROUP); }
    __syncthreads();
    if (F.tid < 32) WSP(int, WS_WGCNT)[F.wg * 32 + F.tid] = cnt[F.tid];
    __syncthreads();
}
__device__ __forceinline__ void p12_slots(Frame& F) {
    constexpr int TPG = T / 256;
    LAS int* cur = (LAS int*)(F.lds + RING_OFF); LAS int* tot = cur + 32; LAS int* pre = cur + 64; LAS int* off = cur + 96; LAS int* slotl = cur + 160;
    const int* wgcnt = WSP(int, WS_WGCNT);
    if (F.tid < 32) { int tt = 0, pp = 0; for (int w = 0; w < 256; ++w) { const int c = wgcnt[w * 32 + F.tid]; if (w < F.wg) pp += c; tt += c; } tot[F.tid] = tt; pre[F.tid] = pp; }
    __syncthreads();
    if (F.tid == 0) { int o = 0; for (int e = 0; e < 32; ++e) { off[e] = o; o += (tot[e] + 255) & ~255; } off[32] = o; }
    __syncthreads();
    if (F.tid < 32) cur[F.tid] = off[F.tid] + pre[F.tid];
    if (F.wg == 0) { int* te = WSP(int, WS_TILEE); const int nt = off[32] >> 8;
        for (int p = F.tid; p < nt; p += NWAVES * 64) { int e = 0; for (int j = 1; j < 32; ++j) if ((p << 8) >= off[j]) e = j; te[p] = e; }
        if (F.tid == 0) te[1024] = nt; }
    __syncthreads();
    { const int t = F.wg * TPG + (F.tid >> 2), k = F.tid & 3; const int e = WSP(int, WS_TOKE)[(size_t)t * 4 + k];
      const int s = __hip_atomic_fetch_add(cur + e, 1, __ATOMIC_RELAXED, __HIP_MEMORY_SCOPE_WORKGROUP);
      WSP(int, WS_TOKS)[(size_t)t * 4 + k] = s; WSP(int, WS_STOK)[s] = t; WSP(float, WS_SLOTW)[s] = WSP(float, WS_TOKW)[(size_t)t * 4 + k]; }
    if (F.wg < 32) { const int s = off[F.wg] + tot[F.wg] + F.tid; if (s < off[F.wg + 1]) WSP(int, WS_STOK)[s] = 0; }
    __syncthreads();
}
__device__ __forceinline__ void p15_final(Frame& F) {
    const int gw = F.wg * NWAVES + F.wave, NGW = F.G * NWAVES, lane = F.lane;
    const float* x1 = WSP(float, WS_X1); const unsigned char* YS = WSP(unsigned char, WS_YS); const float* gf = F.ap->in[I_NFG];
    typedef float f32x2f __attribute__((ext_vector_type(2)));
#ifdef PROBE_P17X
    for (int mm = gw; mm < 2 * T; mm += NGW) { const int m = mm & (T - 1); const float* gt = WSP(float, WS_MOD) + (size_t)(m / SEQ) * 12288 + 5 * 2048;
#else
    for (int m = gw; m < T; m += NGW) { const float* gt = WSP(float, WS_MOD) + (size_t)(m / SEQ) * 12288 + 5 * 2048;
#endif
        const int4 sl = *(const int4*)(WSP(int, WS_TOKS) + (size_t)m * 4); f32x4 v[8]; float ss = 0.f;
        const unsigned char* y0 = YS + (size_t)sl.x * DM + 4 * lane; const unsigned char* y1 = YS + (size_t)sl.y * DM + 4 * lane; const unsigned char* y2 = YS + (size_t)sl.z * DM + 4 * lane; const unsigned char* y3 = YS + (size_t)sl.w * DM + 4 * lane;
#pragma unroll
        for (int u = 0; u < 8; ++u) { const int c = 256 * u + 4 * lane;
            const int q0 = *(const int*)(y0 + 256 * u), q1 = *(const int*)(y1 + 256 * u), q2 = *(const int*)(y2 + 256 * u), q3 = *(const int*)(y3 + 256 * u);
            const f32x4 xa = *(const f32x4*)(x1 + (size_t)m * DM + c), ga = *(const f32x4*)(gt + c);
            const f32x2f s0 = (__builtin_amdgcn_cvt_pk_f32_fp8(q0, false) + __builtin_amdgcn_cvt_pk_f32_fp8(q1, false)) + (__builtin_amdgcn_cvt_pk_f32_fp8(q2, false) + __builtin_amdgcn_cvt_pk_f32_fp8(q3, false));
            const f32x2f s1 = (__builtin_amdgcn_cvt_pk_f32_fp8(q0, true) + __builtin_amdgcn_cvt_pk_f32_fp8(q1, true)) + (__builtin_amdgcn_cvt_pk_f32_fp8(q2, true) + __builtin_amdgcn_cvt_pk_f32_fp8(q3, true));
            const f32x4 y = (f32x4){s0.x, s0.y, s1.x, s1.y} * (1.f / FP8_SY), xv = xa + ga * y; v[u] = xv; ss += (xv[0] * xv[0] + xv[1] * xv[1]) + (xv[2] * xv[2] + xv[3] * xv[3]); }
        const float rs = rsqrtf(wave_sum(ss) * (1.f / DM) + NORM_EPS);
#pragma unroll
        for (int u = 0; u < 8; ++u) { const int c = 256 * u + 4 * lane; const f32x4 ga = *(const f32x4*)(gf + c); *(f32x4*)(F.ap->out + (size_t)m * DM + c) = v[u] * rs * ga; }
    }
}

__device__ __forceinline__ void stagger(Frame& F, int ticks_step) {
    const unsigned long long t0 = __builtin_amdgcn_s_memrealtime(), d = (unsigned long long)(((F.wg * 5) & 7) * ticks_step);
    while (__builtin_amdgcn_s_memrealtime() - t0 < d) __builtin_amdgcn_s_sleep(8);
}
__device__ __forceinline__ bool fresh(Frame& F) {
    asm volatile("" : "+s"(F.ap)); int w = F.wave; asm volatile("" : "+s"(w)); const int l = __builtin_amdgcn_mbcnt_hi(~0u, __builtin_amdgcn_mbcnt_lo(~0u, 0u)); F.lane = l; F.tid = w * 64 + l; return true; }
constexpr int N_PHASES = 18;
#ifndef STAGGER_TICKS
#define STAGGER_TICKS 400
#endif
#ifndef N_CONV_WG
#define N_CONV_WG 96
#endif
__global__ void __launch_bounds__(NWAVES * 64, 2) mk_fwd(Args args) {
    extern __shared__ __attribute__((aligned(16))) unsigned char lds[];
    Frame F;
    F.lds = (LAS unsigned char*)lds; F.MISC = (volatile LAS unsigned*)(F.lds + MISC_OFF);
    F.tid = threadIdx.x; F.lane = F.tid & 63; F.wave = __builtin_amdgcn_readfirstlane(F.tid >> 6); F.G = gridDim.x; F.wg = blockIdx.x;
    F.ap = (ArgsP)__builtin_amdgcn_kernarg_segment_ptr(); F.ws = F.ap->ws; F.ctl = (gu32*)(F.ws + WS_CTL);
    for (int u = F.tid; u < (LDS_BYTES - LDSCTL_OFF) / 4; u += NWAVES * 64) ((LAS unsigned*)(F.lds + LDSCTL_OFF))[u] = 0u;
    __syncthreads();
    const int lo = F.ap->ph_lo, hi = F.ap->ph_hi;
    XcdBarrier bar; bar.bar = (unsigned*)(F.ctl + CW_BAR); bar.x = 0; bar.st = nullptr;
    if (hi - lo > 1) bar = xcd_barrier_post((unsigned*)(F.ctl + CW_BAR), F.MISC + 8, F.tid);
#ifndef PH_MASK
#define PH_MASK 0x3ffff
#endif
#define IN(k) (((PH_MASK >> (k)) & 1) && lo <= (k) && (k) < hi && fresh(F))
#ifndef PROBE_DUP
#define PROBE_DUP 0
#endif
#ifndef PROBE_PHASEA
#define PROBE_PHASEA -1
#endif
#ifndef PROBE_TILE_EPI
#define PROBE_TILE_EPI 0
#endif
#ifndef PROBE_NULL_EPI
#define PROBE_NULL_EPI 0
#endif
#define REP(k) for (int rep_ = 0; rep_ < 1 + ((PROBE_DUP >> (k)) & 1); ++rep_)
#define SEAM_NB(k) do { } while (0)
#define SEAM(k) do { if (IN(k) && IN((k) + 1)) xcd_barrier(bar, F.tid); } while (0)
    if (IN(0)) REP(0) { p0_prologue(F); } SEAM(0);
    if (IN(1)) REP(1) { norm_mod_rows<INPROJ_FP8>(F, F.ap->in[I_X], F.ap->in[I_N1G], 0, 2048, WSP(bf16, WS_H), WSP(unsigned char, WS_H8)); } SEAM(1);
    if (IN(2)) REP(2) {
#if INPROJ_FP8 == 1
        pg8::Gemm g{WSP(bf16, WS_H8), WSP(bf16, WS_WIN8), T, NP, DM / 2}; pg8::StaticOrder S; S.init(T, NP, F.G, F.wg);
        pg8::EpiBf16S E{WSP(bf16, WS_P), NP, 1.f / (FP8_SA1 * FP8_SW)}; pg8::gemm_phase<pg8::EpiBf16S, pg8::StaticOrder, true, true, true>(F.lds + RING_OFF, g, S, E, F.tid);
#elif INPROJ_FP8 == 2
        pg8::Gemm g{WSP(bf16, WS_H8), (const pg8::bf16_t*)(F.ws + WS_WIN8 + (size_t)PC_SPLIT * DM), T, NP - PC_SPLIT, DM / 2}; pg8::StaticOrder S; S.init(T, NP - PC_SPLIT, F.G, F.wg);
#ifdef PROBE_EXTRA_ST
        pg8::EpiBf16S E{WSP(bf16, WS_P) + PC_SPLIT, NP, 1.f / (FP8_SA1 * FP8_SW), (pg8::bf16_t*)(F.ws + WS_END + (size_t)F.wg * 131072)};
#else
        pg8::EpiBf16S E{WSP(bf16, WS_P) + PC_SPLIT, NP, 1.f / (FP8_SA1 * FP8_SW)};
#endif
        pg8::gemm_phase<pg8::EpiBf16S, pg8::StaticOrder, true, true, true>(F.lds + RING_OFF, g, S, E, F.tid);
#else
        pg8::Gemm g{WSP(bf16, WS_H), WSP(bf16, WS_WIN), T, NP, DM}; pg8::StaticOrder S; S.init(T, NP, F.G, F.wg);
        pg8::EpiBf16<0> E{WSP(bf16, WS_P), NP, nullptr, 0, 0, 1.f}; pg8::gemm_phase<pg8::EpiBf16<0>, pg8::StaticOrder, true, true>(F.lds + RING_OFF, g, S, E, F.tid);
#endif
        } SEAM_NB(2);
#if INPROJ_FP8 == 2
    if (IN(2)) { (void)fresh(F); pg8::Gemm g{WSP(bf16, WS_H), WSP(bf16, WS_WIN), T, PC_SPLIT, DM}; pg8::StaticOrder S; S.init(T, PC_SPLIT, F.G, F.wg);
        pg8::EpiBf16<0> E{WSP(bf16, WS_P), NP, nullptr, 0, 0, 1.f}; pg8::gemm_phase<pg8::EpiBf16<0>, pg8::StaticOrder, true, true>(F.lds + RING_OFF, g, S, E, F.tid); }
#endif
    SEAM(2);
    if (IN(3)) REP(3) { p3_prep(F); } SEAM(3);
    if (IN(4)) REP(4) { p4_cumsum(F);
        { pg8::Gemm g{WSP(bf16, WS_LW), WSP(bf16, WS_BT1), T, 2048, 256}; pg8::StaticOrder S; S.init(T, 2048, F.G, F.wg);
          pg8::EpiLora1 E{WSP(float, WS_LOGW), WSP(bf16, WS_A), F.ap->in[I_W0], F.ap->in[I_A0]}; pg8::gemm_phase<pg8::EpiLora1, pg8::StaticOrder, true, true>(F.lds + RING_OFF, g, S, E, F.tid); }
        } SEAM(4);
    if (IN(5)) REP(5) { if (F.wg == 0) att_order(F);
        { pg8::Gemm g{WSP(bf16, WS_SG), WSP(bf16, WS_BT2), T, 1024, 256}; pg8::StaticOrder S; S.init(T, 1024, F.G, F.wg);
          pg8::EpiBf16<0> E{WSP(bf16, WS_G), 1024, nullptr, 0, 0, 1.f}; pg8::gemm_phase<pg8::EpiBf16<0>, pg8::StaticOrder, true, true>(F.lds + RING_OFF, g, S, E, F.tid); }
        } SEAM(5);
    if (IN(6)) REP(6) {
#if RWKV_NAIVE
        p5_scan_naive(F);
#else
        rw::phase_a<0>(F.lds + RING_OFF, F.ws, WS_REC, F.ap->in[I_KK], F.ap->in[I_KA], F.wg, F.G, F.tid);
#if PROBE_PHASEA >= 0
        __syncthreads(); rw::phase_a<PROBE_PHASEA>(F.lds + RING_OFF, F.ws, WS_END, F.ap->in[I_KK], F.ap->in[I_KA], F.wg, F.G, F.tid);
#endif
#endif
        } SEAM(6);
    if (IN(7)) REP(7) {
#if !RWKV_NAIVE
        for (int bh = F.wg; bh < 32; bh += F.G) { const int b = bh >> 4, h = bh & 15;
            rw::phase_b_head(F.lds + RING_OFF, F.ws + WS_REC + (size_t)bh * 256 * rw::REC, WSP(unsigned short, WS_YRAW) + (size_t)b * SEQ * RW + h * 64, F.tid); __syncthreads(); }
#endif
        if (F.wg >= 32 && F.wg < 32 + N_CONV_WG) { convert_experts(F, F.wg - 32, N_CONV_WG); __syncthreads(); }
        p6_attention(F, (char*)lds + RING_OFF, 0); } SEAM(7);
#ifdef PROBE_P7
    if (IN(8)) {
        for (int bh = F.wg; bh < 32; bh += F.G) { const int b = bh >> 4, h = bh & 15;
            rw::phase_b_head(F.lds + RING_OFF, F.ws + WS_REC + (size_t)bh * 256 * rw::REC, WSP(unsigned short, WS_YRAW) + (size_t)b * SEQ * RW + h * 64, F.tid); __syncthreads(); }
        if (F.wg >= 32 && F.wg < 32 + N_CONV_WG) { convert_experts(F, F.wg - 32, N_CONV_WG); __syncthreads(); }
        p6_attention(F, (char*)lds + RING_OFF, 1); } SEAM(8);
#endif
    if (IN(9)) REP(9) { p7_post(F); } SEAM(9);
    if (IN(10)) REP(10) { pg8::Gemm g{WSP(bf16, WS_YA), WSP(bf16, WS_WOA), T, DM, 1024}; pg8::StaticOrder S; S.init(T, DM, F.G, F.wg);
        pg8::EpiGateMerge<0> E{WSP(bf16, WS_MRG), WSP(bf16, WS_P), PC_GA, nullptr}; pg8::gemm_phase<pg8::EpiGateMerge<0>, pg8::StaticOrder, true, true>(F.lds + RING_OFF, g, S, E, F.tid); } SEAM(10);
    if (IN(11)) REP(11) { pg8::Gemm g{WSP(bf16, WS_YB), WSP(bf16, WS_WOB), T, DM, 1024}; pg8::StaticOrder S; S.init(T, DM, F.G, F.wg);
        pg8::EpiGateMerge<1> E{WSP(bf16, WS_MRG), WSP(bf16, WS_P), PC_GB, WSP(unsigned char, WS_MRG8)}; pg8::gemm_phase<pg8::EpiGateMerge<1>, pg8::StaticOrder, true, true>(F.lds + RING_OFF, g, S, E, F.tid); } SEAM(11);
#if OUTPROJ_FP8
    if (IN(12)) REP(12) { pg8::Gemm g{WSP(bf16, WS_MRG8), WSP(bf16, WS_WOUT), T, DM, DM / 2}; pg8::StaticOrder S; S.init(T, DM, F.G, F.wg);
        pg8::EpiResid E{F.ap->in[I_X], WSP(float, WS_X1), WSP(float, WS_MOD), WSP(float, WS_SSP), 1.f / (FP8_SM * FP8_SW)}; pg8::gemm_phase<pg8::EpiResid, pg8::StaticOrder, true, true, true>(F.lds + RING_OFF, g, S, E, F.tid); } SEAM(12);
#else
    if (IN(12)) REP(12) { pg8::Gemm g{WSP(bf16, WS_MRG), WSP(bf16, WS_WOUT), T, DM, DM}; pg8::StaticOrder S; S.init(T, DM, F.G, F.wg);
        pg8::EpiResid E{F.ap->in[I_X], WSP(float, WS_X1), WSP(float, WS_MOD), WSP(float, WS_SSP), 1.f}; pg8::gemm_phase<pg8::EpiResid, pg8::StaticOrder, true, true>(F.lds + RING_OFF, g, S, E, F.tid); } SEAM(12);
#endif
    if (IN(13)) REP(13) { p11_router(F); } SEAM(13);
    if (IN(14)) REP(14) { p12_slots(F); } SEAM(14);
    if (IN(15)) REP(15) { const int nt = WSP(int, WS_TILEE)[1024]; pg8::Gemm g{WSP(bf16, WS_HS), WSP(bf16, WS_WGU), nt * 256, 4096, DM / 2, WSP(int, WS_STOK)}; pg8::MoeOrder S; S.init(nt * 256, 4096, F.G, F.wg); S.tile_e = WSP(int, WS_TILEE);
        pg8::EpiSwiglu E{WSP(unsigned char, WS_ACT), F.ap->in[I_BGU]}; pg8::gemm_phase<pg8::EpiSwiglu, pg8::MoeOrder, true, true, true, true>(F.lds + RING_OFF, g, S, E, F.tid); } SEAM(15);
    if (IN(16)) REP(16) { const int nt = WSP(int, WS_TILEE)[1024]; pg8::Gemm g{WSP(bf16, WS_ACT), WSP(bf16, WS_WDN), nt * 256, 2048, DFF / 2}; pg8::MoeOrder S; S.init(nt * 256, 2048, F.G, F.wg); S.tile_e = WSP(int, WS_TILEE);
        pg8::EpiDown E{WSP(unsigned char, WS_YS), F.ap->in[I_BDN], WSP(float, WS_SLOTW)}; pg8::gemm_phase<pg8::EpiDown, pg8::MoeOrder, true, true, true>(F.lds + RING_OFF, g, S, E, F.tid); } SEAM(16);
    if (IN(17)) REP(17) { p15_final(F); }
#undef IN
#undef SEAM
}

extern "C" void kernel_launch(void* const* d_in, const int* in_sizes, int n_in, void* d_out, int out_size, void* d_ws, size_t ws_size, hipStream_t stream) {
    static int grid = 0;
    if (grid == 0) {
        if (n_in != N_IN || in_sizes[0] != T * DM || out_size != T * DM || ws_size < WS_END) { fprintf(stderr, "kernel_launch: shape/workspace mismatch (n_in %d, in0 %d, out %d, ws %zu < %zu)\n", n_in, n_in > 0 ? in_sizes[0] : -1, out_size, ws_size, (size_t)WS_END); grid = -1; return; }
        if (hipFuncSetAttribute((const void*)mk_fwd, hipFuncAttributeMaxDynamicSharedMemorySize, LDS_BYTES) != hipSuccess) { fprintf(stderr, "kernel_launch: hipFuncSetAttribute failed\n"); grid = -1; return; }
        int per_cu = 0;
        if (hipOccupancyMaxActiveBlocksPerMultiprocessor(&per_cu, (const void*)mk_fwd, NWAVES * 64, LDS_BYTES) != hipSuccess || per_cu < 1) fprintf(stderr, "kernel_launch: note: occupancy query reports %d workgroups per CU\n", per_cu);
        (void)hipGetLastError();
        grid = 256;
    }
    if (grid < 0) return;
    (void)hipMemsetAsync((char*)d_ws + WS_CTL, 0, CTL_ZERO_BYTES, stream);
    Args a{};
    for (int i = 0; i < N_IN; ++i) a.in[i] = (const float*)d_in[i];
    a.out = (float*)d_out; a.ws = (unsigned char*)d_ws;
#if MK_N_LAUNCHES == 1
    a.ph_lo = 0; a.ph_hi = N_PHASES;
    hipLaunchKernelGGL(mk_fwd, dim3(grid), dim3(NWAVES * 64), LDS_BYTES, stream, a);
#else
    for (int p = 0; p < N_PHASES; ++p) { a.ph_lo = p; a.ph_hi = p + 1; hipLaunchKernelGGL(mk_fwd, dim3(grid), dim3(NWAVES * 64), LDS_BYTES, stream, a); }
#endif
}
```

```cpp
#include <hip/hip_runtime.h>
#include <hip/hip_bf16.h>
#include <cstdio>
#include <cstdint>
constexpr int NWAVES = 8;
#ifndef MK_N_LAUNCHES
#define MK_N_LAUNCHES 1
#endif
#ifndef INPROJ_FP8
#define INPROJ_FP8 1
#endif
#ifndef OUTPROJ_FP8
#define OUTPROJ_FP8 1
#endif
#ifndef RWKV_NAIVE
#define RWKV_NAIVE 0
#endif
constexpr int BATCH = 2, SEQ = 16384, DM = 2048, T = BATCH * SEQ;
constexpr int NP = 11776;
constexpr int PC_R = 0, PC_K = 1024, PC_V = 2048, PC_GLO = 3072, PC_DLO = 3328, PC_ALO = 3424, PC_F = 3520, PC_FEND = 3528, PC_SPLIT = 3584, PC_GA = 3584, PC_FQ = 5632, PC_FK = 6656, PC_FV = 7680, PC_OG = 8704, PC_GB = 9728;
constexpr int RW = 1024, FW = 1024, NE = 32, DFF = 2048, TOPK = 4;
constexpr int NSLOT = T * TOPK + NE * 256;
constexpr float NORM_EPS = 1e-6f, GN_EPS = 64e-5f;
constexpr float FOX_SKIP_BITS = 32.f;
constexpr float FP8_SY = 16.f;
constexpr float FP8_SM = 16.f;
constexpr float FP8_SW = 64.f, FP8_SA1 = 2.f, FP8_SA2 = 4.f;

constexpr size_t MiB = 1u << 20;
constexpr size_t WS_CTL = 0, CTL_ZERO_BYTES = 1 * MiB;
constexpr size_t WS_MOD = 1 * MiB;
constexpr size_t WS_WRT = 1 * MiB + 128 * 1024;
constexpr size_t WS_TOKE = 2 * MiB, WS_TOKW = 2 * MiB + 512 * 1024, WS_TOKS = 3 * MiB, WS_SLOTW = 3 * MiB + 512 * 1024;
constexpr size_t WS_WGCNT = 4 * MiB + 512 * 1024, WS_TILEE = 4 * MiB + 768 * 1024;
constexpr size_t WS_RS = 4 * MiB + 832 * 1024;
constexpr size_t WS_AORD = 4 * MiB + 808 * 1024;
constexpr size_t WS_JLO = 4 * MiB + 800 * 1024;
constexpr size_t WS_LF = 5 * MiB, WS_CS = 6 * MiB;
constexpr size_t WS_STOK = 5 * MiB;
constexpr size_t WS_BT1 = 7 * MiB, WS_BT2 = 8 * MiB, WS_WOA = 9 * MiB, WS_WOB = 13 * MiB, WS_WOUT = 17 * MiB, WS_WIN = 25 * MiB;
constexpr size_t WS_WGU = 72 * MiB, WS_WDN = 584 * MiB, WS_X1 = 840 * MiB, WS_H = 1096 * MiB;
constexpr size_t WS_P = 1226 * MiB, WS_R = 1962 * MiB, WS_K = 2026 * MiB, WS_V = 2090 * MiB, WS_FQ = 2154 * MiB, WS_FK = 2218 * MiB, WS_FV = 2282 * MiB;
constexpr size_t WS_LW = 2346 * MiB, WS_SG = 2362 * MiB, WS_LOGW = 2378 * MiB, WS_A = 2506 * MiB, WS_G = 2570 * MiB, WS_YRAW = 2634 * MiB, WS_YA = 2762 * MiB, WS_YB = 2826 * MiB, WS_MRG = 2890 * MiB;
constexpr size_t WS_HS = 1226 * MiB, WS_ACT = 1500 * MiB, WS_YS = 1774 * MiB;
constexpr size_t WS_WIN8 = 3274 * MiB, WS_H8 = 3298 * MiB;
constexpr size_t WS_REC = 3018 * MiB;
constexpr size_t WS_SSP = 3362 * MiB;
constexpr size_t WS_MRG8 = 3366 * MiB;
constexpr size_t WS_END = 3430 * MiB;
static_assert(WS_WIN + (size_t)NP * DM * 2 <= WS_WGU && WS_YS + (size_t)NSLOT * DM * 2 <= WS_REC && WS_HS + (size_t)NSLOT * DM <= WS_ACT && WS_ACT + (size_t)NSLOT * DFF <= WS_YS && WS_SLOTW + (size_t)NSLOT * 4 <= WS_WGCNT, "d_ws map");
constexpr int CW_TMO = 0, CW_ATTQ = 2048, CW_BAR = 4096;

constexpr int RING_OFF = 0, RING_BYTES = 143360;
constexpr int LDSCTL_OFF = RING_BYTES, MISC_OFF = LDSCTL_OFF + 320;
constexpr int LDS_BYTES = 147456;

#define GAS __attribute__((address_space(1)))
#define LAS __attribute__((address_space(3)))
typedef unsigned short bf16;
typedef unsigned v4u __attribute__((ext_vector_type(4)));
typedef unsigned v2u __attribute__((ext_vector_type(2)));
typedef float f32x4 __attribute__((ext_vector_type(4)));
typedef short bf16x8 __attribute__((ext_vector_type(8)));
typedef GAS unsigned gu32;
#define RLX_AGENT __ATOMIC_RELAXED, __HIP_MEMORY_SCOPE_AGENT
#define LDS_WAIT() asm volatile("s_waitcnt lgkmcnt(0)" ::: "memory")
#define VM_WAIT() asm volatile("s_waitcnt vmcnt(0)" ::: "memory")
__device__ __forceinline__ unsigned f2bf(float f) { unsigned u = __builtin_bit_cast(unsigned, f); return (u + 0x7fffu + ((u >> 16) & 1u)) >> 16; }
__device__ __forceinline__ unsigned pk2(float lo, float hi) { return f2bf(lo) | (f2bf(hi) << 16); }
__device__ __forceinline__ float bflo(unsigned w) { return __uint_as_float(w << 16); }
__device__ __forceinline__ float bfhi(unsigned w) { return __uint_as_float(w & 0xffff0000u); }
__device__ __forceinline__ void unpack8(v4u w, float (&f)[8]) { f[0] = bflo(w.x); f[1] = bfhi(w.x); f[2] = bflo(w.y); f[3] = bfhi(w.y); f[4] = bflo(w.z); f[5] = bfhi(w.z); f[6] = bflo(w.w); f[7] = bfhi(w.w); }
__device__ __forceinline__ v4u pack8f(const float (&f)[8]) { v4u w; w.x = pk2(f[0], f[1]); w.y = pk2(f[2], f[3]); w.z = pk2(f[4], f[5]); w.w = pk2(f[6], f[7]); return w; }
__device__ __forceinline__ float sigmoidf_(float x) { return 1.f / (1.f + __expf(-x)); }
__device__ __forceinline__ float wave_sum(float v) {
#pragma unroll
    for (int o = 1; o < 64; o <<= 1) v += __shfl_xor(v, o);
    return v;
}
namespace pg8 {
#define PG8_LAS __attribute__((address_space(3)))
typedef unsigned short bf16_t;
typedef short bf16x8 __attribute__((ext_vector_type(8)));
typedef float f32x4 __attribute__((ext_vector_type(4)));
typedef unsigned u32x4 __attribute__((ext_vector_type(4)));
constexpr int BM = 256, BK = 64, HALF = 128, HTB = HALF * BK * 2  , STAGE_BYTES = 8 * HTB, NXCD = 8, WGM = 8;

__host__ __device__ __forceinline__ int lds_byte(int r, int c) { const int st = (r >> 4) * 2 + (c >> 5), rr = r & 15, cc = c & 31, ob = rr * 64 + cc * 2; return st * 1024 + (ob ^ (((ob >> 9) & 1) << 5)); }
__host__ __device__ __forceinline__ void stage_rc(int b, int& R, int& C) { const int st = b / 1024, sb = b % 1024, swz = sb ^ (((sb >> 9) & 1) << 5); R = (st >> 1) * 16 + swz / 64; C = (st & 1) * 32 + (swz % 64) / 2; }
__host__ __device__ __forceinline__ int perm32(int rho) { const int n = rho >> 4, i = rho & 15; return 8 * (i >> 2) + 4 * n + (i & 3); }

struct Unit { int pm, pn, e; };
struct Gemm { const bf16_t* A; const bf16_t* Bt; int M, N, K; const int* rowmap = nullptr; };

struct StaticOrder {
    int nM, nN, nwg, G, c;
    __host__ __device__ void init(int M, int N, int G_, int c_) { nM = M / BM; nN = N / BM; nwg = nM * nN; G = G_; c = c_; }
    __host__ __device__ bool next(int i, Unit& u) const {
        const long L = (long)i * G + c; if (L >= nwg) return false;
        int wgid = (int)L; { const int q = nwg / NXCD, r = nwg % NXCD, xcd = wgid % NXCD, off = wgid / NXCD; wgid = (xcd < r ? xcd * (q + 1) : r * (q + 1) + (xcd - r) * q) + off; }
        const int nig = WGM * nN, gid = wgid / nig, fm = gid * WGM, gsz = (nM - fm) < WGM ? (nM - fm) : WGM;
        u.pm = fm + ((wgid % nig) % gsz); u.pn = (wgid % nig) / gsz; u.e = 0; return true;
    }
    __device__ __forceinline__ void a_ready(const Unit&) const {}
    __device__ __forceinline__ void done(const Unit&) const {}
};

__device__ __forceinline__ unsigned cvt_pk_bf16(float lo, float hi) { unsigned r; asm volatile("v_cvt_pk_bf16_f32 %0, %1, %2" : "=v"(r) : "v"(lo), "v"(hi)); return r; }
typedef float f32x2 __attribute__((ext_vector_type(2)));
__device__ __forceinline__ f32x2 gelu_pk(f32x2 v) {
    const f32x2 av = __builtin_elementwise_abs(v), d = av * 0.2316418882f + 1.0f;
    f32x2 t; t.x = __builtin_amdgcn_rcpf(d.x); t.y = __builtin_amdgcn_rcpf(d.y);
    f32x2 q = t * 0.5307027145f + (-0.7265760135f); q = q * t + 0.7107068705f; q = q * t + (-0.142248368f); q = q * t + 0.127414796f; q = q * t;
    const f32x2 s = (v * v) * (-0.72134752044f);
    f32x2 e; e.x = __builtin_amdgcn_exp2f(s.x); e.y = __builtin_amdgcn_exp2f(s.y);
    const f32x2 m = v * (q * e), r = v - m;
    f32x2 o; o.x = v.x < 0.f ? m.x : r.x; o.y = v.y < 0.f ? m.y : r.y; return o;
}

template <int ACT  > struct EpiBf16 {
    static constexpr bool PERM = true, AFTER_DRAIN = false; static_assert(ACT == 0 || ACT == 1, "EpiBf16: ACT is 0 (none) or 1 (gelu_pk)");
    bf16_t* O; int ldc; const float* bias; int split_cols; size_t split_stride; float scale0;
    __device__ __forceinline__ void operator()(const f32x4 (&acc)[2][2][4][2], const Unit& u, int wr, int wc, int fr, int fq) const {
        const int row0 = u.pm * BM + wr * 64 + fr; int colt = u.pn * BM; bf16_t* base = O;
        float sc = 1.f; if (split_cols) { const int t = colt / split_cols; base += (size_t)t * split_stride; colt -= t * split_cols; if (t == 0) sc = scale0; }
        const int col0 = colt + wc * 32 + 8 * fq, bcol0 = u.pn * BM + wc * 32 + 8 * fq;
        f32x4 bv[2][2];
#pragma unroll
        for (int bj = 0; bj < 2; ++bj)
#pragma unroll
            for (int n = 0; n < 2; ++n) bv[bj][n] = bias ? *(const f32x4*)(bias + bcol0 + bj * HALF + 4 * n) : (f32x4){0.f, 0.f, 0.f, 0.f};
#pragma unroll
        for (int ai = 0; ai < 2; ++ai)
#pragma unroll
            for (int m = 0; m < 4; ++m) { bf16_t* rowp = base + (size_t)(row0 + ai * HALF + m * 16) * ldc + col0;
#pragma unroll
                for (int bj = 0; bj < 2; ++bj) { f32x4 v0 = acc[ai][bj][m][0] + bv[bj][0], v1 = acc[ai][bj][m][1] + bv[bj][1];
                    if (ACT == 1) { f32x2 a = gelu_pk((f32x2){v0[0], v0[1]}), b = gelu_pk((f32x2){v0[2], v0[3]}), c = gelu_pk((f32x2){v1[0], v1[1]}), d = gelu_pk((f32x2){v1[2], v1[3]});
                        v0 = (f32x4){a.x, a.y, b.x, b.y}; v1 = (f32x4){c.x, c.y, d.x, d.y}; }
                    v0 = v0 * sc; v1 = v1 * sc; u32x4 w; w.x = cvt_pk_bf16(v0[0], v0[1]); w.y = cvt_pk_bf16(v0[2], v0[3]); w.z = cvt_pk_bf16(v1[0], v1[1]); w.w = cvt_pk_bf16(v1[2], v1[3]);
                    *(u32x4*)(rowp + bj * HALF) = w; } }
    }
};

typedef int v4i_t __attribute__((ext_vector_type(4))); typedef int v8i_t __attribute__((ext_vector_type(8)));
template <class Epi, class Sched, bool ALIGN_EPI = false, bool SP2 = false, bool FP8 = false, bool GATHER = false>
__device__ __forceinline__ void gemm_phase(PG8_LAS unsigned char* lds, const Gemm g, const Sched& S, const Epi& E, const int tid) {
    const int wid = __builtin_amdgcn_readfirstlane(tid >> 6), lane = tid & 63, wr = wid >> 2, wc = wid & 3, fr = lane & 15, fq = lane >> 4;
    const int K = g.K, nt = K / BK;
    static_assert(!GATHER || SP2, "GATHER is written for the SP2 loop");
    unsigned voffA[2], voffB[2]; int gR[2]; unsigned gC[2];
#pragma unroll
    for (int i = 0; i < 2; ++i) { int R, C; stage_rc(tid * 16 + i * 8192, R, C); const int Rb = Epi::PERM ? ((R & ~31) + perm32(R & 31)) : R;
        voffA[i] = (unsigned)(R * K + C) * 2u; voffB[i] = (unsigned)(Rb * K + C) * 2u; gR[i] = R; gC[i] = (unsigned)C * 2u; }
    unsigned vC[2][2], vN[2][2]; int raw[2][2];
#define PG8_ROWS_ISSUE(u) do { _Pragma("unroll") for (int _h = 0; _h < 2; ++_h) _Pragma("unroll") for (int _i = 0; _i < 2; ++_i) raw[_h][_i] = g.rowmap[(u).pm * BM + _h * HALF + gR[_i]]; } while (0)
#define PG8_ROWS_MAKE(v) do { _Pragma("unroll") for (int _h = 0; _h < 2; ++_h) _Pragma("unroll") for (int _i = 0; _i < 2; ++_i) { asm volatile("" : "+v"(raw[_h][_i])); (v)[_h][_i] = (unsigned)raw[_h][_i] * (unsigned)(K * 2) + gC[_i]; } } while (0)
    const size_t kstep = (size_t)(BK * 2);
    const size_t hstep = (size_t)HALF * K * 2;
    const size_t tstep = 2 * hstep;
    const unsigned ldsw = (unsigned)wid * 1024u;
    const int aoff = lds_byte(wr * 64 + fr, fq * 8), boff = lds_byte(wc * 32 + fr, fq * 8);
#define PG8_SA(b, h) (((b) * 2 + (h)) * HTB)
#define PG8_SB(b, h) ((4 + (b) * 2 + (h)) * HTB)
#define PG8_STAGE(bufoff, gbase, voff) do { _Pragma("unroll") for (int _i = 0; _i < 2; ++_i) \
        __builtin_amdgcn_global_load_lds((const unsigned*)((const char*)(gbase) + (voff)[_i]), (PG8_LAS unsigned*)(lds + (bufoff) + ldsw + _i * 8192), 16, 0, 0); } while (0)
#define PG8_STAGE_A(bufoff, ptr, h, nx) do { if constexpr (GATHER) { _Pragma("unroll") for (int _i = 0; _i < 2; ++_i) { const unsigned _vo = (nx) ? vN[h][_i] : vC[h][_i]; \
        __builtin_amdgcn_global_load_lds((const unsigned*)((const char*)(ptr) + _vo), (PG8_LAS unsigned*)(lds + (bufoff) + ldsw + _i * 8192), 16, 0, 0); } } else PG8_STAGE(bufoff, (ptr) + (h) * hstep, voffA); } while (0)
#define PG8_CAT(x0, x1) __builtin_shufflevector(__builtin_bit_cast(v4i_t, x0), __builtin_bit_cast(v4i_t, x1), 0, 1, 2, 3, 4, 5, 6, 7)
#define PG8_LDA(dst, b, h) do { _Pragma("unroll") for (int m = 0; m < 4; ++m) { if constexpr (FP8) dst##8[m] = PG8_CAT(*(const PG8_LAS bf16x8*)(lds + PG8_SA(b, h) + aoff + m * 2048), *(const PG8_LAS bf16x8*)(lds + PG8_SA(b, h) + aoff + m * 2048 + 1024)); \
        else { _Pragma("unroll") for (int k = 0; k < 2; ++k) dst[m][k] = *(const PG8_LAS bf16x8*)(lds + PG8_SA(b, h) + aoff + m * 2048 + k * 1024); } } } while (0)
#define PG8_LDB(dst, b, h) do { _Pragma("unroll") for (int n = 0; n < 2; ++n) { if constexpr (FP8) dst##8[n] = PG8_CAT(*(const PG8_LAS bf16x8*)(lds + PG8_SB(b, h) + boff + n * 2048), *(const PG8_LAS bf16x8*)(lds + PG8_SB(b, h) + boff + n * 2048 + 1024)); \
        else { _Pragma("unroll") for (int k = 0; k < 2; ++k) dst[n][k] = *(const PG8_LAS bf16x8*)(lds + PG8_SB(b, h) + boff + n * 2048 + k * 1024); } } } while (0)
#define PG8_MMA16(ai, bj, At, Bt) do { __builtin_amdgcn_s_setprio(1); _Pragma("unroll") for (int m = 0; m < 4; ++m) _Pragma("unroll") for (int n = 0; n < 2; ++n) _Pragma("unroll") for (int k = 0; k < 2; ++k) \
        acc[ai][bj][m][n] = __builtin_amdgcn_mfma_f32_16x16x32_bf16(Bt[n][k], At[m][k], acc[ai][bj][m][n], 0, 0, 0); __builtin_amdgcn_s_setprio(0); } while (0)
#define PG8_MMA8(ai, bj, At, Bt) do { __builtin_amdgcn_s_setprio(1); _Pragma("unroll") for (int m = 0; m < 4; ++m) _Pragma("unroll") for (int n = 0; n < 2; ++n) \
        asm volatile("v_mfma_scale_f32_16x16x128_f8f6f4 %0, %1, %2, %0, %3, %3 op_sel_hi:[0,0,0]" : "+v"(acc[ai][bj][m][n]) : "v"(Bt##8[n]), "v"(At##8[m]), "v"(one_scale)); __builtin_amdgcn_s_setprio(0); } while (0)
#define PG8_MMA(ai, bj, At, Bt) do { if constexpr (FP8) PG8_MMA8(ai, bj, At, Bt); else PG8_MMA16(ai, bj, At, Bt); } while (0)
#define PG8_WAIT_V(n) asm volatile("s_waitcnt vmcnt(" #n ")" ::: "memory")
#define PG8_WAIT_L(n) asm volatile("s_waitcnt lgkmcnt(" #n ")" ::: "memory")
#define PG8_BAR __builtin_amdgcn_s_barrier()
#define PG8_SCHED __builtin_amdgcn_sched_barrier(0)
    Unit cur, nxt; int ui = 0;
    if (!S.next(0, cur)) return;
    f32x4 acc[2][2][4][2];
#pragma unroll
    for (int a = 0; a < 2; ++a)
#pragma unroll
        for (int b = 0; b < 2; ++b)
#pragma unroll
            for (int m = 0; m < 4; ++m)
#pragma unroll
                for (int n = 0; n < 2; ++n) acc[a][b][m][n] = (f32x4){0.f, 0.f, 0.f, 0.f};
    bf16x8 At[4][2], B0[2][2], B1[2][2]; v8i_t At8[4], B08[2], B18[2];
    int one_scale = 0x7f7f7f7f; asm volatile("" : "+v"(one_scale));
    const char* cA = (const char*)g.A + (GATHER ? (size_t)0 : (size_t)cur.pm * tstep); const size_t estep = (size_t)g.N * K * 2; const char* cB = (const char*)g.Bt + (size_t)cur.e * estep + (size_t)cur.pn * tstep;
    S.a_ready(cur);
    if constexpr (GATHER) { PG8_ROWS_ISSUE(cur); PG8_ROWS_MAKE(vC); }
    if constexpr (SP2) {
        PG8_STAGE(PG8_SB(0, 0), cB, voffB); PG8_STAGE(PG8_SB(0, 1), cB + hstep, voffB); PG8_STAGE_A(PG8_SA(0, 0), cA, 0, false); PG8_STAGE_A(PG8_SA(0, 1), cA, 1, false);
        if (wr == 1) PG8_BAR;
        PG8_WAIT_V(2); PG8_BAR;
        PG8_STAGE(PG8_SB(1, 0), cB + kstep, voffB); PG8_STAGE_A(PG8_SA(1, 0), cA + kstep, 0, false); PG8_STAGE(PG8_SB(1, 1), cB + hstep + kstep, voffB);
        PG8_WAIT_V(6); PG8_BAR;
    } else {
        PG8_STAGE(PG8_SB(0, 0), cB, voffB); PG8_STAGE(PG8_SA(0, 0), cA, voffA); PG8_STAGE(PG8_SB(0, 1), cB + hstep, voffB); PG8_STAGE(PG8_SA(0, 1), cA + hstep, voffA);
        if (wr == 1) PG8_BAR;
        PG8_WAIT_V(4); PG8_BAR;
        PG8_STAGE(PG8_SB(1, 0), cB + kstep, voffB); PG8_STAGE(PG8_SA(1, 0), cA + kstep, voffA); PG8_STAGE(PG8_SB(1, 1), cB + hstep + kstep, voffB);
        PG8_WAIT_V(6); PG8_BAR;
    }
    for (;;) {
        const bool has_next = S.next(ui + 1, nxt);
        if constexpr (GATHER) { if (has_next) PG8_ROWS_ISSUE(nxt); }
        const char* nA = (has_next && !GATHER) ? (const char*)g.A + (size_t)nxt.pm * tstep : cA; const char* nB = has_next ? (const char*)g.Bt + (size_t)nxt.e * estep + (size_t)nxt.pn * tstep : cB;
        for (int t = 0; t < nt; t += 2) {
            const bool last = (t == nt - 2);
            const char* a1 = cA + (size_t)(t + 1) * kstep;
            const char* a2 = last ? nA : cA + (size_t)(t + 2) * kstep; const char* b2 = last ? nB : cB + (size_t)(t + 2) * kstep;
            const char* a3 = a2 + kstep; const char* b3 = b2 + kstep;
            if (last && has_next) S.a_ready(nxt);
            const bool nx = last && has_next; (void)nx;
            if constexpr (SP2) {
            PG8_LDB(B0, 0, 0); PG8_LDB(B1, 0, 1); PG8_SCHED; PG8_LDA(At, 0, 0); PG8_STAGE_A(PG8_SA(1, 1), a1, 1, false);
            PG8_WAIT_V(8); PG8_WAIT_L(0); PG8_BAR; PG8_MMA(0, 0, At, B0); PG8_MMA(0, 1, At, B1); PG8_BAR; PG8_SCHED;
            PG8_LDA(At, 0, 1); PG8_STAGE(PG8_SB(0, 0), b2, voffB); PG8_STAGE(PG8_SB(0, 1), b2 + hstep, voffB); PG8_STAGE_A(PG8_SA(0, 0), a2, 0, nx);
            PG8_WAIT_V(8); PG8_WAIT_L(0); PG8_BAR; PG8_MMA(1, 0, At, B0); PG8_MMA(1, 1, At, B1); PG8_BAR; PG8_SCHED;
            PG8_LDB(B0, 1, 0); PG8_LDB(B1, 1, 1); PG8_SCHED; PG8_LDA(At, 1, 0); PG8_STAGE_A(PG8_SA(0, 1), a2, 1, nx);
            PG8_WAIT_V(8); PG8_WAIT_L(0); PG8_BAR; PG8_MMA(0, 0, At, B0); PG8_MMA(0, 1, At, B1); PG8_BAR; PG8_SCHED;
            PG8_LDA(At, 1, 1); PG8_STAGE(PG8_SB(1, 0), b3, voffB); PG8_STAGE(PG8_SB(1, 1), b3 + hstep, voffB); PG8_STAGE_A(PG8_SA(1, 0), a3, 0, nx);
            PG8_WAIT_V(8); PG8_WAIT_L(0); PG8_BAR; PG8_MMA(1, 0, At, B0); PG8_MMA(1, 1, At, B1); PG8_BAR; PG8_SCHED;
            if constexpr (GATHER) { if (t == 0 && has_next) PG8_ROWS_MAKE(vN); }
            } else {
            PG8_LDB(B0, 0, 0); PG8_SCHED; PG8_LDA(At, 0, 0); PG8_STAGE(PG8_SA(1, 1), a1 + hstep, voffA);
            PG8_WAIT_L(8); PG8_BAR; PG8_WAIT_L(0); PG8_MMA(0, 0, At, B0); PG8_BAR; PG8_SCHED;
            PG8_LDB(B1, 0, 1); PG8_STAGE(PG8_SB(0, 0), b2, voffB);
            PG8_BAR; PG8_WAIT_L(0); PG8_MMA(0, 1, At, B1); PG8_BAR;
            PG8_LDA(At, 0, 1); PG8_STAGE(PG8_SA(0, 0), a2, voffA);
            PG8_BAR; PG8_WAIT_L(0); PG8_MMA(1, 0, At, B0); PG8_BAR; PG8_SCHED;
            PG8_STAGE(PG8_SB(0, 1), b2 + hstep, voffB);
            PG8_WAIT_V(6); PG8_BAR; PG8_MMA(1, 1, At, B1); PG8_BAR;
            PG8_LDB(B0, 1, 0); PG8_SCHED; PG8_LDA(At, 1, 0); PG8_STAGE(PG8_SA(0, 1), a2 + hstep, voffA);
            PG8_WAIT_L(8); PG8_BAR; PG8_WAIT_L(0); PG8_MMA(0, 0, At, B0); PG8_BAR; PG8_SCHED;
            PG8_LDB(B1, 1, 1); PG8_STAGE(PG8_SB(1, 0), b3, voffB);
            PG8_BAR; PG8_WAIT_L(0); PG8_MMA(0, 1, At, B1); PG8_BAR;
            PG8_LDA(At, 1, 1); PG8_STAGE(PG8_SA(1, 0), a3, voffA);
            PG8_BAR; PG8_WAIT_L(0); PG8_MMA(1, 0, At, B0); PG8_BAR; PG8_SCHED;
            PG8_STAGE(PG8_SB(1, 1), b3 + hstep, voffB);
            PG8_WAIT_V(6); PG8_BAR; PG8_MMA(1, 1, At, B1); PG8_BAR;
            }
        }
        if constexpr (ALIGN_EPI) { if (wr == 0) PG8_BAR; }
        if constexpr (FP8) asm volatile("s_nop 15\n\ts_nop 15" ::: "memory");
        if constexpr (!Epi::AFTER_DRAIN) { E(acc, cur, wr, wc, fr, fq); S.done(cur); }
        if (!has_next) break;
#pragma unroll
        for (int a = 0; a < 2; ++a)
#pragma unroll
            for (int b = 0; b < 2; ++b)
#pragma unroll
                for (int m = 0; m < 4; ++m)
#pragma unroll
                    for (int n = 0; n < 2; ++n) acc[a][b][m][n] = (f32x4){0.f, 0.f, 0.f, 0.f};
        cur = nxt; cA = nA; cB = nB; ++ui;
        if constexpr (GATHER) {
#pragma unroll
            for (int _h = 0; _h < 2; ++_h)
#pragma unroll
                for (int _i = 0; _i < 2; ++_i) vC[_h][_i] = vN[_h][_i]; }
        if constexpr (ALIGN_EPI) { if (wr == 1) PG8_BAR; }
    }
    PG8_WAIT_V(0);
    if constexpr (!ALIGN_EPI) { if (wr == 0) PG8_BAR; }
    PG8_BAR;
    if constexpr (Epi::AFTER_DRAIN) { E.fused(acc, cur, wr, wc, fr, fq, lds, wid, lane); S.done(cur); }
#undef PG8_SA
#undef PG8_SB
#undef PG8_STAGE
#undef PG8_STAGE_A
#undef PG8_ROWS_ISSUE
#undef PG8_ROWS_MAKE
#undef PG8_LDA
#undef PG8_LDB
#undef PG8_MMA
#undef PG8_MMA8
#undef PG8_MMA16
#undef PG8_CAT
#undef PG8_WAIT_V
#undef PG8_WAIT_L
#undef PG8_BAR
#undef PG8_SCHED
}
}
namespace pg8 {
__device__ __forceinline__ float ep_bflo(unsigned w) { return __uint_as_float(w << 16); }
__device__ __forceinline__ float ep_bfhi(unsigned w) { return __uint_as_float(w & 0xffff0000u); }
__device__ __forceinline__ float ep_sig(float x) { return __builtin_amdgcn_rcpf(1.f + __builtin_amdgcn_exp2f(-1.4426950408889634f * x)); }
__device__ __forceinline__ void ep_unpack8(u32x4 w, f32x4& a, f32x4& b) { a = (f32x4){ep_bflo(w.x), ep_bfhi(w.x), ep_bflo(w.y), ep_bfhi(w.y)}; b = (f32x4){ep_bflo(w.z), ep_bfhi(w.z), ep_bflo(w.w), ep_bfhi(w.w)}; }
__device__ __forceinline__ u32x4 ep_pack8(f32x4 a, f32x4 b) { u32x4 w; w.x = cvt_pk_bf16(a[0], a[1]); w.y = cvt_pk_bf16(a[2], a[3]); w.z = cvt_pk_bf16(b[0], b[1]); w.w = cvt_pk_bf16(b[2], b[3]); return w; }
__device__ __forceinline__ f32x4 ep_sig4(f32x4 v) { return (f32x4){ep_sig(v[0]), ep_sig(v[1]), ep_sig(v[2]), ep_sig(v[3])}; }
#define EPI_LOOP_BEGIN const int row0 = u.pm * BM + wr * 64 + fr, col0 = u.pn * BM + wc * 32 + 8 * fq; \
    _Pragma("unroll") for (int ai = 0; ai < 2; ++ai) _Pragma("unroll") for (int m = 0; m < 4; ++m) { const int row = row0 + ai * HALF + m * 16; \
    _Pragma("unroll") for (int bj = 0; bj < 2; ++bj) { const int col = col0 + bj * HALF; const f32x4 v0 = acc[ai][bj][m][0], v1 = acc[ai][bj][m][1];
#define EPI_LOOP_END } }

struct EpiBf16S {
    static constexpr bool PERM = true, AFTER_DRAIN = false;
    bf16_t* O; int ldc; float s;
#ifdef PROBE_EXTRA_ST
    bf16_t* X;
#endif
    __device__ __forceinline__ void operator()(const f32x4 (&acc)[2][2][4][2], const Unit& u, int wr, int wc, int fr, int fq) const {
#ifdef PROBE_EXTRA_ST
        const int xw = wr * 4 + wc, xl = fq * 16 + fr;
#endif
        EPI_LOOP_BEGIN
            *(u32x4*)(O + (size_t)row * ldc + col) = ep_pack8(v0 * s, v1 * s);
#ifdef PROBE_EXTRA_ST
#if PROBE_EXTRA_ST == 1
            *(u32x4*)(X + (size_t)(row - u.pm * BM) * 256 + (col - u.pn * BM)) = ep_pack8(v0 * s, v1 * s);
#else
            *(u32x4*)(X + (size_t)xw * 8192 + (size_t)((ai * 4 + m) * 2 + bj) * 512 + xl * 8) = ep_pack8(v0 * s, v1 * s);
#endif
#endif
        EPI_LOOP_END
    }
};
struct EpiNull {
    static constexpr bool PERM = true, AFTER_DRAIN = false;
    bf16_t* O;
    __device__ __forceinline__ void operator()(const f32x4 (&acc)[2][2][4][2], const Unit& u, int wr, int wc, int fr, int fq) const {
        float s = 0.f;
        EPI_LOOP_BEGIN
            s += v0[0] + v1[3];
        EPI_LOOP_END
        if (s == 123456.789f) O[0] = 0;
    }
};
struct EpiTile {
    static constexpr bool PERM = true, AFTER_DRAIN = false;
    bf16_t* O; float s;
    __device__ __forceinline__ void operator()(const f32x4 (&acc)[2][2][4][2], const Unit& u, int wr, int wc, int fr, int fq) const {
        bf16_t* base = O + (size_t)(u.pm * 46 + u.pn) * 65536;
        EPI_LOOP_BEGIN
            { const u32x4 pk_ = ep_pack8(v0 * s, v1 * s);
#if PROBE_TILE_EPI == 2
              if (m == 0) *(u32x4*)(base + (size_t)(row - u.pm * BM) * 256 + (col - u.pn * BM)) = pk_; else asm volatile("" :: "v"(pk_));
#else
              *(u32x4*)(base + (size_t)(row - u.pm * BM) * 256 + (col - u.pn * BM)) = pk_;
#endif
            }
        EPI_LOOP_END
    }
};
struct EpiLora1 {
    static constexpr bool PERM = true, AFTER_DRAIN = false;
    float* logw; bf16_t* a; const float* w0; const float* a0;
    __device__ __forceinline__ void operator()(const f32x4 (&acc)[2][2][4][2], const Unit& u, int wr, int wc, int fr, int fq) const {
        EPI_LOOP_BEGIN
            if (u.pn < 4) { const f32x4 b0 = *(const f32x4*)(w0 + col), b1 = *(const f32x4*)(w0 + col + 4);
                float* o = logw + (size_t)row * 1024 + col; *(f32x4*)o = ep_sig4(v0 + b0) * (-0.6065306597126334f); *(f32x4*)(o + 4) = ep_sig4(v1 + b1) * (-0.6065306597126334f); }
            else { const int c = col - 1024; const f32x4 b0 = *(const f32x4*)(a0 + c), b1 = *(const f32x4*)(a0 + c + 4);
                *(u32x4*)(a + (size_t)row * 1024 + c) = ep_pack8(ep_sig4(v0 + b0), ep_sig4(v1 + b1)); }
        EPI_LOOP_END
    }
};
template <int SECOND> struct EpiGateMerge {
    static constexpr bool PERM = true, AFTER_DRAIN = false;
    bf16_t* mrg; const bf16_t* P; int gcol; unsigned char* mrg8;
    __device__ __forceinline__ void operator()(const f32x4 (&acc)[2][2][4][2], const Unit& u, int wr, int wc, int fr, int fq) const {
        const int row0 = u.pm * BM + wr * 64 + fr, col0 = u.pn * BM + wc * 32 + 8 * fq;
#pragma unroll
        for (int bj = 0; bj < 2; ++bj) { const int col = col0 + bj * HALF;
#pragma unroll
            for (int ai = 0; ai < 2; ++ai) { u32x4 gw[4], tw[4];
#pragma unroll
                for (int m = 0; m < 4; ++m) { const int row = row0 + ai * HALF + m * 16; gw[m] = *(const u32x4*)(P + (size_t)row * 11776 + gcol + col); if (SECOND) tw[m] = *(const u32x4*)(mrg + (size_t)row * 2048 + col); }
#pragma unroll
                for (int m = 0; m < 4; ++m) { const int row = row0 + ai * HALF + m * 16; f32x4 g0, g1; ep_unpack8(gw[m], g0, g1);
                    f32x4 r0 = ep_sig4(g0) * acc[ai][bj][m][0], r1 = ep_sig4(g1) * acc[ai][bj][m][1];
                    if (SECOND) { f32x4 t0, t1; ep_unpack8(tw[m], t0, t1); r0 = r0 + t0; r1 = r1 + t1; }
                    if (SECOND && OUTPROJ_FP8) { r0 = r0 * FP8_SM; r1 = r1 * FP8_SM; typedef unsigned u32x2e __attribute__((ext_vector_type(2))); u32x2e o;
                        { int q = __builtin_amdgcn_cvt_pk_fp8_f32(r0[0], r0[1], 0, false); q = __builtin_amdgcn_cvt_pk_fp8_f32(r0[2], r0[3], q, true); o.x = (unsigned)q; }
                        { int q = __builtin_amdgcn_cvt_pk_fp8_f32(r1[0], r1[1], 0, false); q = __builtin_amdgcn_cvt_pk_fp8_f32(r1[2], r1[3], q, true); o.y = (unsigned)q; }
                        *(u32x2e*)(mrg8 + (size_t)row * 2048 + col) = o; }
                    else *(u32x4*)(mrg + (size_t)row * 2048 + col) = ep_pack8(r0, r1); }
                asm volatile("" ::: "memory"); } }
    }
};
struct EpiResid {
    static constexpr bool PERM = true, AFTER_DRAIN = false;
    const float* x; float* x1; const float* mod; float* ssp; float s;
    __device__ __forceinline__ void operator()(const f32x4 (&acc)[2][2][4][2], const Unit& u, int wr, int wc, int fr, int fq) const {
        const float* gt = mod + (size_t)((u.pm * BM) / 16384) * 12288 + 4096;
        const int row0 = u.pm * BM + wr * 64 + fr, col0 = u.pn * BM + wc * 32 + 8 * fq;
        float ss[2][4] = {{0.f, 0.f, 0.f, 0.f}, {0.f, 0.f, 0.f, 0.f}};
#pragma unroll
        for (int bj = 0; bj < 2; ++bj) { const int col = col0 + bj * HALF; const f32x4 g0 = *(const f32x4*)(gt + col) * s, g1 = *(const f32x4*)(gt + col + 4) * s;
#pragma unroll
            for (int ai = 0; ai < 2; ++ai) { f32x4 xa[4], xb[4];
#pragma unroll
                for (int m = 0; m < 4; ++m) { const size_t off = (size_t)(row0 + ai * HALF + m * 16) * 2048 + col; xa[m] = *(const f32x4*)(x + off); xb[m] = *(const f32x4*)(x + off + 4); }
#pragma unroll
                for (int m = 0; m < 4; ++m) { const size_t off = (size_t)(row0 + ai * HALF + m * 16) * 2048 + col; const f32x4 ya = xa[m] + g0 * acc[ai][bj][m][0], yb = xb[m] + g1 * acc[ai][bj][m][1];
                    *(f32x4*)(x1 + off) = ya; *(f32x4*)(x1 + off + 4) = yb;
                    ss[ai][m] += ((ya[0] * ya[0] + ya[1] * ya[1]) + (ya[2] * ya[2] + ya[3] * ya[3])) + ((yb[0] * yb[0] + yb[1] * yb[1]) + (yb[2] * yb[2] + yb[3] * yb[3])); }
                asm volatile("" ::: "memory"); } }
        float* sp = ssp + (size_t)(u.pn * 4 + wc) * 32768;
#pragma unroll
        for (int ai = 0; ai < 2; ++ai)
#pragma unroll
            for (int m = 0; m < 4; ++m) { float s = ss[ai][m]; s += __shfl_xor(s, 16); s += __shfl_xor(s, 32); if (fq == 0) sp[row0 + ai * HALF + m * 16] = s; }
    }
};
struct EpiSwiglu {
    static constexpr bool PERM = true, AFTER_DRAIN = false;
    unsigned char* act; const float* bias;
    __device__ __forceinline__ void operator()(const f32x4 (&acc)[2][2][4][2], const Unit& u, int wr, int wc, int fr, int fq) const {
        const int row0 = u.pm * BM + wr * 64 + fr, gcol = u.pn * 128 + wc * 32 + 8 * fq;
        const float* bg = bias + (size_t)u.e * 4096 + gcol; const float* bl = bg + 2048;
        const f32x4 bg0 = *(const f32x4*)bg, bg1 = *(const f32x4*)(bg + 4), bl0 = *(const f32x4*)bl, bl1 = *(const f32x4*)(bl + 4);
#pragma unroll
        for (int ai = 0; ai < 2; ++ai)
#pragma unroll
            for (int m = 0; m < 4; ++m) { const int row = row0 + ai * HALF + m * 16;
                f32x4 g0 = acc[ai][0][m][0] * (1.f / 128.f) + bg0, g1 = acc[ai][0][m][1] * (1.f / 128.f) + bg1, l0 = acc[ai][1][m][0] * (1.f / 128.f) + bl0, l1 = acc[ai][1][m][1] * (1.f / 128.f) + bl1, r0, r1;
#pragma unroll
                for (int i = 0; i < 4; ++i) { const float a = fminf(g0[i], 7.f), b = fminf(g1[i], 7.f);
                    r0[i] = a * ep_sig(1.702f * a) * (fminf(fmaxf(l0[i], -7.f), 7.f) + 1.f); r1[i] = b * ep_sig(1.702f * b) * (fminf(fmaxf(l1[i], -7.f), 7.f) + 1.f); }
                r0 = r0 * 4.f; r1 = r1 * 4.f; typedef unsigned u32x2e __attribute__((ext_vector_type(2))); u32x2e o;
                { int w = __builtin_amdgcn_cvt_pk_fp8_f32(r0[0], r0[1], 0, false); w = __builtin_amdgcn_cvt_pk_fp8_f32(r0[2], r0[3], w, true); o.x = (unsigned)w; }
                { int w = __builtin_amdgcn_cvt_pk_fp8_f32(r1[0], r1[1], 0, false); w = __builtin_amdgcn_cvt_pk_fp8_f32(r1[2], r1[3], w, true); o.y = (unsigned)w; }
                *(u32x2e*)(act + (size_t)row * 2048 + gcol) = o; }
    }
};
struct EpiDown {
    static constexpr bool PERM = true, AFTER_DRAIN = false;
    unsigned char* ys; const float* bias; const float* slot_w;
    __device__ __forceinline__ void operator()(const f32x4 (&acc)[2][2][4][2], const Unit& u, int wr, int wc, int fr, int fq) const {
        const float* be = bias + (size_t)u.e * 2048; const int row0 = u.pm * BM + wr * 64 + fr, col0 = u.pn * BM + wc * 64 + 16 * fq;
        float w[2][4]; f32x4 b[2][2];
#pragma unroll
        for (int ai = 0; ai < 2; ++ai)
#pragma unroll
            for (int m = 0; m < 4; ++m) w[ai][m] = slot_w[row0 + ai * HALF + m * 16] * FP8_SY;
#pragma unroll
        for (int bj = 0; bj < 2; ++bj) { b[bj][0] = *(const f32x4*)(be + col0 + 8 * bj); b[bj][1] = *(const f32x4*)(be + col0 + 8 * bj + 4); }
#pragma unroll
        for (int ai = 0; ai < 2; ++ai)
#pragma unroll
            for (int m = 0; m < 4; ++m) { const int row = row0 + ai * HALF + m * 16; u32x4 o; unsigned q[4];
#pragma unroll
                for (int bj = 0; bj < 2; ++bj)
#pragma unroll
                    for (int n = 0; n < 2; ++n) { const f32x4 r = (acc[ai][bj][m][n] * (1.f / 256.f) + b[bj][n]) * w[ai][m];
                        int p = __builtin_amdgcn_cvt_pk_fp8_f32(r[0], r[1], 0, false); p = __builtin_amdgcn_cvt_pk_fp8_f32(r[2], r[3], p, true); q[2 * bj + n] = (unsigned)p; }
                o.x = q[0]; o.y = q[1]; o.z = q[2]; o.w = q[3];
                *(u32x4*)(ys + (size_t)row * 2048 + col0) = o; }
    }
};
struct MoeOrder : StaticOrder {
    const int* tile_e;
    __device__ bool next(int i, Unit& u) const { if (!StaticOrder::next(i, u)) return false; u.e = tile_e[u.pm]; return true; }
};
}
namespace fox {
enum { ORDER_NATURAL = 0, ORDER_REVERSED = 1, ORDER_PAIRED = 2, ORDER_XCD = 4 };
using TIN = __hip_bfloat16; using TOUT = __hip_bfloat16;
constexpr int B = 2, H = 8, HKV = 8, SQ = 16384, SKV = 16384, D = 128;
constexpr int PITCH = 1024;
constexpr int GPITCH = 11776;
constexpr int QOFF = 0;
constexpr int WINDOW = SKV;
constexpr float THR = 8.f;
constexpr int ORDER = ORDER_PAIRED;
constexpr bool WSKIP = false;
constexpr float SCALE = 0.08838834764831845f;
constexpr int NW = 8, QBLK = 32, KVBLK = 64, QB = NW * QBLK;
constexpr int SHM_V = KVBLK * D * 2, SHM_K = KVBLK * D * 2;
constexpr int LDS_CB = 2 * SHM_V + 2 * SHM_K + NW * 64 * 4;
constexpr int LDS_GATE = LDS_CB + 3 * 64 * 4 + 256;
constexpr int LDS_BYTES = LDS_GATE + NW * 8192;
static_assert(D == 128 && SQ % QB == 0 && SKV % KVBLK == 0 && H % HKV == 0 && QOFF >= 0 && QOFF + SQ <= SKV && WINDOW >= 1, "geometry");

using bf16 = __hip_bfloat16;
typedef short bf16x8 __attribute__((ext_vector_type(8)));
typedef short s16x4 __attribute__((ext_vector_type(4)));
typedef float f32x16 __attribute__((ext_vector_type(16)));
typedef float f32x4 __attribute__((ext_vector_type(4)));
typedef unsigned u32x4 __attribute__((ext_vector_type(4)));
template <class A, class Bt> struct same_t { static constexpr bool v = false; };
template <class A> struct same_t<A, A> { static constexpr bool v = true; };

#define KSWZ(row, colB) ((row) * 256 + ((colB) ^ (((row) & 7) << 4)))
#define SBAR() __builtin_amdgcn_sched_barrier(0)
__device__ __forceinline__ int v_st(int k, int c) { const int kk = (k & ~0xC) | ((k & 4) << 1) | ((k & 8) >> 1); return ((kk >> 3) * 4 + (c >> 5)) * 512 + ((kk & 7) * 32 + (c & 31)) * 2; }
__device__ __forceinline__ int v_rd_base(int lane) { return ((lane & 3) << 3) | (((lane >> 2) & 3) << 6) | (((lane >> 4) & 1) << 5) | (((lane >> 5) & 1) << 8); }
constexpr int v_rd_off(int d0, int ks, int half) { return d0 * 512 + ks * 4096 + half * 2048; }
__device__ __forceinline__ int crow(int r, int hi) { return (r & 3) + 8 * (r >> 2) + 4 * hi; }
__device__ __forceinline__ unsigned cvtpk(float lo, float hi) {
    unsigned r; asm volatile("v_cvt_pk_bf16_f32 %0, %1, %2" : "=v"(r) : "v"(lo), "v"(hi)); return r;
}
__device__ __forceinline__ bf16x8 pack8(f32x4 a, f32x4 b) {
    u32x4 w = {cvtpk(a[0], a[1]), cvtpk(a[2], a[3]), cvtpk(b[0], b[1]), cvtpk(b[2], b[3])};
    return *reinterpret_cast<bf16x8*>(&w);
}
template <class T> __device__ __forceinline__ bf16x8 load8(const T* p) {
    if constexpr (same_t<T, float>::v) { return pack8(*(const f32x4*)p, *(const f32x4*)(p + 4)); }
    else { return *reinterpret_cast<const bf16x8*>(p); }
}
__device__ __forceinline__ void mask_tile(f32x16& p0, f32x16& p1, int dq, unsigned W) {
    const float NEG = -__builtin_inff();
#pragma unroll
    for (int r = 0; r < 16; ++r) {
        const int c = (r & 3) + 8 * (r >> 2);
        if ((unsigned)(dq - c) >= W) p0[r] = NEG;
        if ((unsigned)(dq - c - 32) >= W) p1[r] = NEG;
    }
}
__device__ __forceinline__ void partialSM(f32x16& p0, f32x16& p1, float& m_reg, float& mn, float& alpha) {
    float pmax = p0[0]; for (int r = 1; r < 16; ++r) pmax = fmaxf(pmax, p0[r]); for (int r = 0; r < 16; ++r) pmax = fmaxf(pmax, p1[r]);
    { auto rr = __builtin_amdgcn_permlane32_swap(__float_as_uint(pmax), __float_as_uint(pmax), false, false);
      pmax = fmaxf(__uint_as_float(rr[0]), __uint_as_float(rr[1])); }
    constexpr float C2 = 1.4426950408889634f * SCALE;
    if (__builtin_expect(__all((pmax - m_reg) * SCALE <= THR), 1)) { mn = m_reg; alpha = 1.f; }
    else { mn = fmaxf(m_reg, pmax); alpha = __builtin_amdgcn_exp2f((m_reg - mn) * C2); m_reg = mn; }
    const float mnL = -mn * C2;
    for (int r = 0; r < 16; ++r) p0[r] = fmaf(p0[r], C2, mnL); for (int r = 0; r < 16; ++r) p1[r] = fmaf(p1[r], C2, mnL);
    for (int r = 0; r < 16; ++r) p0[r] = __builtin_amdgcn_exp2f(p0[r]);
}
__device__ __forceinline__ void finishSM(f32x16& p0, f32x16& p1, float alpha, float& l_reg, bf16x8& pa0, bf16x8& pa1, bf16x8& pa2, bf16x8& pa3) {
    for (int r = 0; r < 16; ++r) p1[r] = __builtin_amdgcn_exp2f(p1[r]);
    float ps = 0; for (int r = 0; r < 16; ++r) ps += p0[r]; for (int r = 0; r < 16; ++r) ps += p1[r];
    { auto rr = __builtin_amdgcn_permlane32_swap(__float_as_uint(ps), __float_as_uint(ps), false, false);
      ps = __uint_as_float(rr[0]) + __uint_as_float(rr[1]); }
    l_reg = l_reg * alpha + ps;
#define PK4(P, B_, OUT) do { unsigned a0 = cvtpk(P[B_+0], P[B_+1]), a1 = cvtpk(P[B_+2], P[B_+3]);                          \
        unsigned b0 = cvtpk(P[B_+4], P[B_+5]), b1 = cvtpk(P[B_+6], P[B_+7]);                                             \
        auto r0 = __builtin_amdgcn_permlane32_swap(a0, b0, false, false); auto r1 = __builtin_amdgcn_permlane32_swap(a1, b1, false, false); \
        u32x4 w = {r0[0], r1[0], r0[1], r1[1]}; OUT = *reinterpret_cast<bf16x8*>(&w); } while (0)
    PK4(p0, 0, pa0); PK4(p0, 8, pa1); PK4(p1, 0, pa2); PK4(p1, 8, pa3);
#undef PK4
}
template <int KB, bool SK>
__device__ __forceinline__ void qkt(f32x16& p0, f32x16& p1, const char* K_lds, int r32, int hi, const bf16x8* qr, bool act, int cbi) {
    if (SK && !act) { const float NEG = -__builtin_inff();
#pragma unroll
        for (int r = 0; r < 16; ++r) { p0[r] = NEG; p1[r] = NEG; } return; }
    { const float* cb_ = (const float*)(K_lds + 2 * SHM_K + NW * 64 * 4) + cbi * 64 + 4 * hi;
#pragma unroll
      for (int g_ = 0; g_ < 4; ++g_) { const f32x4 b0_ = *(const f32x4*)(cb_ + 8 * g_), b1_ = *(const f32x4*)(cb_ + 32 + 8 * g_);
#pragma unroll
          for (int i_ = 0; i_ < 4; ++i_) { p0[4 * g_ + i_] = b0_[i_]; p1[4 * g_ + i_] = b1_[i_]; } } }
    const char* kb[4];
#pragma unroll
    for (int dd = 0; dd < 4; ++dd) kb[dd] = K_lds + KB * SHM_K + KSWZ(r32, (dd * 16 + hi * 8) * 2);
#pragma unroll
    for (int d0 = 0; d0 < 8; ++d0) { const char* a = kb[d0 & 3] + (d0 >> 2) * 128;
        bf16x8 b0 = *reinterpret_cast<const bf16x8*>(a);
        bf16x8 b1 = *reinterpret_cast<const bf16x8*>(a + 32 * 256);
        p0 = __builtin_amdgcn_mfma_f32_32x32x16_bf16(b0, qr[d0], p0, 0, 0, 0);
        p1 = __builtin_amdgcn_mfma_f32_32x32x16_bf16(b1, qr[d0], p1, 0, 0, 0); }
}
template <int VB, bool SK>
__device__ __forceinline__ void pv_tile(f32x16* o, int vb0, bf16x8 pa0, bf16x8 pa1, bf16x8 pa2, bf16x8 pa3, bool act) {
    if (SK && !act) return;
#define TRRD(dst, off) asm volatile("ds_read_b64_tr_b16 %0, %1 offset:%2" : "=&v"(dst) : "v"(vb0), "i"(off) : "memory")
#define PV_D0(d0) do { s16x4 l0, l1, l2, l3, h0, h1, h2, h3; constexpr int b_ = VB * SHM_V + v_rd_off(d0, 0, 0);     \
        TRRD(l0, b_); TRRD(h0, b_ + 2048); TRRD(l1, b_ + 4096); TRRD(h1, b_ + 6144); TRRD(l2, b_ + 8192); TRRD(h2, b_ + 10240); TRRD(l3, b_ + 12288); TRRD(h3, b_ + 14336); \
        asm volatile("s_waitcnt lgkmcnt(0)" ::: "memory"); SBAR();                 \
        o[d0] = __builtin_amdgcn_mfma_f32_32x32x16_bf16(pa0, (bf16x8){l0[0], l0[1], l0[2], l0[3], h0[0], h0[1], h0[2], h0[3]}, o[d0], 0, 0, 0);   \
        o[d0] = __builtin_amdgcn_mfma_f32_32x32x16_bf16(pa1, (bf16x8){l1[0], l1[1], l1[2], l1[3], h1[0], h1[1], h1[2], h1[3]}, o[d0], 0, 0, 0);   \
        o[d0] = __builtin_amdgcn_mfma_f32_32x32x16_bf16(pa2, (bf16x8){l2[0], l2[1], l2[2], l2[3], h2[0], h2[1], h2[2], h2[3]}, o[d0], 0, 0, 0);   \
        o[d0] = __builtin_amdgcn_mfma_f32_32x32x16_bf16(pa3, (bf16x8){l3[0], l3[1], l3[2], l3[3], h3[0], h3[1], h3[2], h3[3]}, o[d0], 0, 0, 0); } while (0)
    PV_D0(0); PV_D0(1); PV_D0(2); PV_D0(3);
#undef PV_D0
#undef TRRD
}

template <class TIn, class TOut> struct BlockRef { const unsigned char* ws; int row0, bh, P0, jlo;
    __device__ __forceinline__ const TIn* Q() const { return (const TIn*)(ws + WS_FQ) + (size_t)row0 * PITCH + (bh % H) * D; }
    __device__ __forceinline__ const TIn* K() const { return (const TIn*)(ws + WS_FK) + (size_t)(bh / H) * SQ * PITCH + (bh % H) * D; }
    __device__ __forceinline__ const TIn* V() const { return (const TIn*)(ws + WS_P) + (size_t)(bh / H) * SQ * GPITCH + PC_FV + (bh % H) * D; }
    __device__ __forceinline__ TOut* O() const { return (TOut*)(ws + WS_YB) + (size_t)row0 * PITCH + (bh % H) * D; }
    __device__ __forceinline__ const float* C() const { return (const float*)(ws + WS_CS) + (size_t)bh * SQ; }
    __device__ __forceinline__ const TIn* G() const { return (const TIn*)(ws + WS_P) + (size_t)row0 * GPITCH + PC_OG + (bh % H) * D; }
};
template <class TIn> struct Seam {
    bf16x8 qr[8];
    bf16x8 st_v0, st_v1, st_k0, st_k1; int cbi; f32x4 sf0, sf1, sf2, sf3;
    f32x4 tq[16];
};
__device__ __forceinline__ int swa_jlo(int P0, int W) { const int lowk = P0 - W + 1; return lowk > 0 ? lowk / KVBLK : 0; }
#define ROW(p, k0, rr) ((p) + (size_t)((k0) + (rr)) * PITCH + sc)
#define ROWV(p, k0, rr) ((p) + (size_t)((k0) + (rr)) * GPITCH + sc)
#define VMW() asm volatile("s_waitcnt vmcnt(0)" ::: "memory")
#define VMWN(n) asm volatile("s_waitcnt vmcnt(%0)" :: "i"(n) : "memory")
#define NEXT3(x) ((x) == 2 ? 0 : (x) + 1)
#define SLOAD_H(Kp, Vp, Cp, k0, CI) do { S.st_v0 = load8<TIn>(ROWV(Vp, k0, sr)); S.st_v1 = load8<TIn>(ROWV(Vp, k0, 32 + sr));              \
                         S.st_k0 = load8<TIn>(ROW(Kp, k0, sr)); S.st_k1 = load8<TIn>(ROW(Kp, k0, 32 + sr));                 \
                         if (wid == 0) __builtin_amdgcn_global_load_lds((const unsigned*)((Cp) + (k0) + lane), (__attribute__((address_space(3))) unsigned*)(lds + LDS_CB + (CI) * 256), 4, 0, 0); } while (0)
#define SWRITE_HK(bf) do { *(bf16x8*)(K_lds + (bf) * SHM_K + kws) = S.st_k0; *(bf16x8*)(K_lds + (bf) * SHM_K + kws + 32 * 256) = S.st_k1; } while (0)
#define SWRITE_HV(bf) do { *(bf16x8*)(V_lds + (bf) * SHM_V + vst0) = S.st_v0; *(bf16x8*)(V_lds + (bf) * SHM_V + vst1) = S.st_v1; } while (0)
#define SWRITE_H(bf) do { SWRITE_HV(bf); SWRITE_HK(bf); } while (0)
#define SLOAD_F(p, k0) do { S.sf0 = *(const f32x4*)ROW(p, k0, sr); S.sf1 = *(const f32x4*)(ROW(p, k0, sr) + 4);                \
                            S.sf2 = *(const f32x4*)ROW(p, k0, 32 + sr); S.sf3 = *(const f32x4*)(ROW(p, k0, 32 + sr) + 4); } while (0)
#define SWRITE_KF(bf) do { *(bf16x8*)(K_lds + (bf) * SHM_K + kws) = pack8(S.sf0, S.sf1); *(bf16x8*)(K_lds + (bf) * SHM_K + kws + 32 * 256) = pack8(S.sf2, S.sf3); } while (0)
#define SWRITE_VF(bf) do { *(bf16x8*)(V_lds + (bf) * SHM_V + vst0) = pack8(S.sf0, S.sf1); *(bf16x8*)(V_lds + (bf) * SHM_V + vst1) = pack8(S.sf2, S.sf3); } while (0)
template <class TIn, class TOut>
__device__ __forceinline__ void causal_swa_prime(const BlockRef<TIn, TOut>& cur, int W, char* lds, Seam<TIn>& S, const int tid) {
    constexpr bool F32 = same_t<TIn, float>::v;
    const int wid = __builtin_amdgcn_readfirstlane(tid >> 6), lane = tid & 63, r32 = lane & 31, hi = lane >> 5;
    const int sr = tid >> 4, sc = (tid & 15) * 8, kws = KSWZ(sr, sc * 2); char* K_lds = lds + 2 * SHM_V;
    const int kb0 = cur.jlo * KVBLK;
    for (int d0 = 0; d0 < 8; ++d0) S.qr[d0] = load8<TIn>(cur.Q() + (size_t)(wid * QBLK + r32) * PITCH + d0 * 16 + hi * 8);
    if constexpr (F32) { SLOAD_F((const float*)cur.K(), kb0); VMW(); SWRITE_KF(0); SBAR(); SLOAD_F((const float*)cur.V(), kb0); }
    else { S.cbi = 0; SLOAD_H(cur.K(), cur.V(), cur.C(), kb0, 0); VMW(); SWRITE_HK(0); }
    __syncthreads();
}
template <class TIn, class TOut>
__device__ __forceinline__ void causal_swa_block(const BlockRef<TIn, TOut>& cur, const BlockRef<TIn, TOut>& nxt, int skv, int W, char* lds, Seam<TIn>& S, const int tid) {
    constexpr bool F32 = same_t<TIn, float>::v;
    const int wid = __builtin_amdgcn_readfirstlane(tid >> 6), lane = tid & 63, r32 = lane & 31, hi = lane >> 5;
    const int j_lo = cur.jlo;
    int j_hi = (cur.P0 + QB - 1) / KVBLK + 1; if (j_hi > skv / KVBLK) j_hi = skv / KVBLK;
    const int NT = j_hi - j_lo;
    const int kbn = nxt.jlo * KVBLK;
    const int qlo = cur.P0 + wid * QBLK, qm = qlo + r32 - 4 * hi;
    char* V_lds = lds; char* K_lds = lds + 2 * SHM_V;
    float* ws = (float*)(lds + 2 * SHM_V + 2 * SHM_K) + wid * 64; float* li_l = ws, * al_l = ws + 32;
    float m_reg = -1e30f, l_reg = 0; f32x16 o[4] = {};
    const int sr = tid >> 4, sc = (tid & 15) * 8, vst0 = v_st(sr, sc), vst1 = v_st(32 + sr, sc), kws = KSWZ(sr, sc * 2);
    const int vb0 = (int)(uintptr_t)V_lds + v_rd_base(lane);
    const TIn* Kh = cur.K(); const TIn* Vh = cur.V(); const float* Ch = cur.C(); int cb_t = S.cbi;
    {
        const TIn* gsrc = cur.G() + (size_t)(wid * QBLK + (lane >> 4)) * GPITCH + (lane & 15) * 8;
#pragma unroll
        for (int i_ = 0; i_ < 8; ++i_) __builtin_amdgcn_global_load_lds((const unsigned*)(gsrc + (size_t)(4 * i_) * GPITCH), (__attribute__((address_space(3))) unsigned*)(lds + LDS_GATE + wid * 8192 + i_ * 1024), 16, 0, 0); }
#define RESC(a) do { if (__any((a) < 1.f)) { if (hi == 0) al_l[r32] = (a); asm volatile("s_waitcnt lgkmcnt(0)" ::: "memory");              \
                     for (int d_ = 0; d_ < 4; ++d_) for (int r = 0; r < 16; ++r) o[d_][r] *= al_l[crow(r, hi)]; } } while (0)
#define KBASE(t) ((j_lo + (t)) * KVBLK)
#define ACT(t) (KBASE(t) <= qlo + QBLK - 1 && KBASE(t) + KVBLK - 1 >= qlo - W + 1)
#define MASKT(P0_, P1_, t) do { const int kb_ = KBASE(t); if ((!SK || ACT(t)) && (kb_ + KVBLK - 1 > qlo || kb_ <= qlo + QBLK - 1 - W)) mask_tile(P0_, P1_, qm - kb_, (unsigned)W); } while (0)
    constexpr int NQL = F32 ? 16 : 8;
    constexpr bool SK = WSKIP && !F32;
#define SEAM_K0() do { VMWN(NQL); if constexpr (F32) { SWRITE_KF(0); SBAR(); SLOAD_F((const float*)nxt.V(), kbn); } else { SWRITE_HK(0); } SBAR(); } while (0)
    f32x16 pA0, pA1, pB0, pB1; float mnA, mnB, alA, alB; bf16x8 pa0, pa1, pa2, pa3;
    if constexpr (F32) { VMW(); SWRITE_VF(0); SBAR(); } else { SWRITE_HV(0); SBAR(); }
    if (NT > 1) { if constexpr (F32) SLOAD_F((const float*)Kh, KBASE(1)); else SLOAD_H(Kh, Vh, Ch, KBASE(1), NEXT3(cb_t)); }
    SBAR(); qkt<0, SK>(pA0, pA1, K_lds, r32, hi, S.qr, ACT(0), cb_t);
    if constexpr (F32) { if (NT > 1) { VMW(); SWRITE_KF(1); SBAR(); SLOAD_F((const float*)Vh, KBASE(1)); } }
    MASKT(pA0, pA1, 0); partialSM(pA0, pA1, m_reg, mnA, alA);
    if (NT > 1) { VMW(); if constexpr (F32) { SWRITE_VF(1); SBAR(); if (NT > 2) SLOAD_F((const float*)Kh, KBASE(2)); } else SWRITE_H(1); }
    __syncthreads();
#define HALF_STEP(PX0, PX1, mnX, alX, PY0, PY1, alY, t, KB, VB, SB) do {                                                      \
        SBAR(); cb_t = NEXT3(cb_t); qkt<KB, SK>(PX0, PX1, K_lds, r32, hi, S.qr, ACT(t), cb_t);                                             \
        finishSM(PY0, PY1, alY, l_reg, pa0, pa1, pa2, pa3); SBAR();                                                           \
        if ((t) + 1 < NT) { if constexpr (F32) { VMW(); SWRITE_KF(SB); SBAR(); SLOAD_F((const float*)Vh, KBASE((t) + 1)); }  \
                            else { SLOAD_H(Kh, Vh, Ch, KBASE((t) + 1), NEXT3(cb_t)); } SBAR(); }                                               \
        pv_tile<VB, SK>(o, vb0, pa0, pa1, pa2, pa3, ACT((t) - 1)); MASKT(PX0, PX1, (t)); partialSM(PX0, PX1, m_reg, mnX, alX);                                        \
        __syncthreads();                                                                                                      \
        if ((t) + 1 < NT) { VMW(); if constexpr (F32) { SWRITE_VF(SB); SBAR(); if ((t) + 2 < NT) SLOAD_F((const float*)Kh, KBASE((t) + 2)); } \
                            else { SWRITE_H(SB); } }                                                                          \
        RESC(alX); __syncthreads(); } while (0)
    for (int t = 1; t + 1 < NT; t += 2) {
        HALF_STEP(pB0, pB1, mnB, alB, pA0, pA1, alA, t, 1, 0, 0);
        HALF_STEP(pA0, pA1, mnA, alA, pB0, pB1, alB, t + 1, 0, 1, 1);
    }
    const bool even = (NT & 1) == 0;
    if (even) { SBAR(); cb_t = NEXT3(cb_t); qkt<1, SK>(pB0, pB1, K_lds, r32, hi, S.qr, ACT(NT - 1), cb_t); SBAR(); }
#define QROW(e) (nxt.Q() + (size_t)(wid * QBLK + r32) * PITCH + ((e) >> 1) * 16 + hi * 8 + ((e) & 1) * 4)
    if constexpr (F32) { SLOAD_F((const float*)nxt.K(), kbn); SBAR();
#pragma unroll
        for (int e = 0; e < 8; ++e) S.tq[e] = *(const f32x4*)QROW(e); }
    else { SLOAD_H(nxt.K(), nxt.V(), nxt.C(), kbn, NEXT3(cb_t)); S.cbi = NEXT3(cb_t); SBAR();
#pragma unroll
        for (int d0 = 0; d0 < 8; ++d0) S.qr[d0] = load8<TIn>(nxt.Q() + (size_t)(wid * QBLK + r32) * PITCH + d0 * 16 + hi * 8); }
    SBAR();
    finishSM(pA0, pA1, alA, l_reg, pa0, pa1, pa2, pa3); SBAR();
    if constexpr (F32) {
#pragma unroll
        for (int e = 8; e < 16; ++e) S.tq[e] = *(const f32x4*)QROW(e); SBAR(); }
#undef QROW
    pv_tile<0, SK>(o, vb0, pa0, pa1, pa2, pa3, ACT(even ? NT - 2 : NT - 1));
    if (even) { MASKT(pB0, pB1, NT - 1); partialSM(pB0, pB1, m_reg, mnB, alB); __syncthreads(); RESC(alB);
        finishSM(pB0, pB1, alB, l_reg, pa0, pa1, pa2, pa3); SBAR(); pv_tile<1, SK>(o, vb0, pa0, pa1, pa2, pa3, ACT(NT - 1)); }
    SBAR(); SEAM_K0();
    if (hi == 0) li_l[r32] = l_reg; asm volatile("s_waitcnt lgkmcnt(0)" ::: "memory");
    float rli[16];
#pragma unroll
    for (int r = 0; r < 16; ++r) rli[r] = __builtin_amdgcn_rcpf(li_l[crow(r, hi)]);
    int hi_e = hi; asm volatile("" : "+v"(hi_e));
    TOut* Ow = cur.O() + (size_t)(wid * QBLK) * PITCH + (size_t)(4 * hi_e) * PITCH; const char* gl_ = lds + LDS_GATE + wid * 8192 + 4 * hi_e * 256;
#pragma unroll
    for (int r = 0; r < 16; ++r) { const int orow = (r & 3) + 8 * (r >> 2);
#pragma unroll
        for (int d0 = 0; d0 < 4; ++d0) { const float v = o[d0][r] * rli[r];
            if constexpr (same_t<TOut, float>::v) { Ow[(size_t)orow * PITCH + d0 * 32 + r32] = v; }
            else { const float vn = __shfl_xor(v, 1);
                   if ((r32 & 1) == 0) { const unsigned gw_ = *(const unsigned*)(gl_ + orow * 256 + (d0 * 32 + r32) * 2);
                       const float g0_ = __uint_as_float(gw_ << 16), g1_ = __uint_as_float(gw_ & 0xffff0000u);
                       const float s0_ = __builtin_amdgcn_rcpf(1.f + __builtin_amdgcn_exp2f(-1.4426950408889634f * g0_)), s1_ = __builtin_amdgcn_rcpf(1.f + __builtin_amdgcn_exp2f(-1.4426950408889634f * g1_));
                       *(unsigned*)(Ow + (size_t)orow * PITCH + d0 * 32 + r32) = cvtpk(v * s0_, vn * s1_); } } } }
    if constexpr (F32) {
#pragma unroll
        for (int d0 = 0; d0 < 8; ++d0) S.qr[d0] = pack8(S.tq[2 * d0], S.tq[2 * d0 + 1]); }
    __syncthreads();
#undef RESC
#undef KBASE
#undef ACT
#undef MASKT
#undef SEAM_K0
#undef HALF_STEP
}
#undef ROW
#undef ROWV
#undef VMW
#undef VMWN
#undef SLOAD_H
#undef SWRITE_HK
#undef SWRITE_HV
#undef SWRITE_H
#undef SLOAD_F
#undef SWRITE_KF
#undef SWRITE_VF

}
#ifndef RW_SOLVE_OLD
#define RW_SOLVE_OLD 0
#endif
namespace rw {
typedef short bf16x8 __attribute__((ext_vector_type(8)));
typedef float f32x4 __attribute__((ext_vector_type(4)));
typedef unsigned u32x4 __attribute__((ext_vector_type(4)));
typedef unsigned u32x2 __attribute__((ext_vector_type(2)));
#define RW_LAS __attribute__((address_space(3)))
constexpr int PB = 144, PF = 272, MB = 64 * PB;
constexpr int O_R = 0, O_K = MB, O_A = 2 * MB, O_B = 3 * MB, O_BT = 4 * MB, O_KT = 5 * MB, O_VT = 6 * MB, O_AAK = 7 * MB, O_ARB = 8 * MB, O_ARK = 9 * MB;
constexpr int O_AAB = 10 * MB, O_GT = O_AAB + 64 * PF, O_GAM = O_GT + 64 * PF, O_TOT = O_GAM + 256, O_END = O_TOT + 2048;
constexpr int O_AABB = O_END, O_TB = O_AABB + MB, O_END2 = O_TB + 4 * 768;
constexpr int O_WT = O_K, O_UT = O_AAK;
static_assert(O_END2 <= 143360, "phase A LDS map");
constexpr int REC = 32768, REC_P = 0, REC_Q = 8192, REC_H = 16384, REC_Y = 24576;
typedef float f32x2_t __attribute__((ext_vector_type(2))); typedef __bf16 bf16x2_t __attribute__((ext_vector_type(2)));
__device__ __forceinline__ unsigned cvtpk(float lo, float hi) { f32x2_t v = {lo, hi}; bf16x2_t b = __builtin_convertvector(v, bf16x2_t); return __builtin_bit_cast(unsigned, b); }
__device__ __forceinline__ float blo(unsigned w) { return __uint_as_float(w << 16); }
__device__ __forceinline__ float bhi(unsigned w) { return __uint_as_float(w & 0xffff0000u); }
__device__ __forceinline__ bf16x8 frag(const RW_LAS unsigned char* base, int tile, int ks, int lane) { return *(const RW_LAS bf16x8*)(base + (16 * tile + (lane & 15)) * PB + (ks * 32 + 8 * (lane >> 4)) * 2); }
#define RW_MFMA(a, b, c) __builtin_amdgcn_mfma_f32_16x16x32_bf16(a, b, c, 0, 0, 0)
#define RW_SYNC() __syncthreads()
#define RW_BAR() do { asm volatile("" ::: "memory"); __builtin_amdgcn_s_barrier(); asm volatile("" ::: "memory"); } while (0)

struct ChunkIn { u32x4 r, k, v, a; f32x4 l0, l1; };
__device__ __forceinline__ void load_chunk(ChunkIn& c, const unsigned char* ws, int it, int tid) {
    const int bh = it >> 8, ch = it & 255, b = bh >> 4, h = bh & 15, tok = tid >> 3, part = tid & 7;
    const size_t off = ((size_t)b * SEQ + (size_t)ch * 64 + tok) * 1024 + h * 64 + 8 * part;
    c.r = *(const u32x4*)((const unsigned short*)(ws + WS_R) + off); c.k = *(const u32x4*)((const unsigned short*)(ws + WS_K) + off); c.v = *(const u32x4*)((const unsigned short*)(ws + WS_V) + off);
    c.a = *(const u32x4*)((const unsigned short*)(ws + WS_A) + off); c.l0 = *(const f32x4*)((const float*)(ws + WS_LOGW) + off); c.l1 = *(const f32x4*)((const float*)(ws + WS_LOGW) + off + 4);
}
template <int STOP = 0>
__device__ __forceinline__ void phase_a(RW_LAS unsigned char* L, unsigned char* ws, size_t rec_off, const float* kk_all, const float* ka_all, int wg, int G, int tid) {
    const int lane = tid & 63, w = __builtin_amdgcn_readfirstlane(tid >> 6), g = lane >> 4, l15 = lane & 15;
    ChunkIn cin; if (wg < 8192) load_chunk(cin, ws, wg, tid);
  for (int it = wg; it < 8192; it += G) {
    unsigned char* rec = ws + rec_off + (size_t)it * REC; const float* kkw_g = kk_all + ((it >> 8) & 15) * 64; const float* kaw_g = ka_all + ((it >> 8) & 15) * 64;
    { const int tok = tid >> 3, part = tid & 7, c0 = 8 * part;
      const u32x4 rw_ = cin.r, kw_ = cin.k, vw_ = cin.v, aw_ = cin.a; const f32x4 l0 = cin.l0, l1 = cin.l1;
      float lw[8] = {l0[0], l0[1], l0[2], l0[3], l1[0], l1[1], l1[2], l1[3]}, cum[8];
#pragma unroll
      for (int i = 0; i < 8; ++i) { float v = lw[i];
          float u = __shfl_up(v, 8); if (lane >= 8) v += u; u = __shfl_up(v, 16); if (lane >= 16) v += u; u = __shfl_up(v, 32); if (lane >= 32) v += u; cum[i] = v; }
      RW_LAS float* tot = (RW_LAS float*)(L + O_TOT);
      if (lane >= 56) {
#pragma unroll
          for (int i = 0; i < 8; ++i) tot[w * 64 + c0 + i] = cum[i]; }
      RW_SYNC();
#pragma unroll
      for (int ww = 0; ww < 7; ++ww) if (ww < w) { const f32x4 a0 = *(const RW_LAS f32x4*)(tot + ww * 64 + c0), a1 = *(const RW_LAS f32x4*)(tot + ww * 64 + c0 + 4);
#pragma unroll
          for (int i = 0; i < 4; ++i) { cum[i] += a0[i]; cum[4 + i] += a1[i]; } }
      float r[8] = {blo(rw_.x), bhi(rw_.x), blo(rw_.y), bhi(rw_.y), blo(rw_.z), bhi(rw_.z), blo(rw_.w), bhi(rw_.w)};
      float k[8] = {blo(kw_.x), bhi(kw_.x), blo(kw_.y), bhi(kw_.y), blo(kw_.z), bhi(kw_.z), blo(kw_.w), bhi(kw_.w)};
      float a[8] = {blo(aw_.x), bhi(aw_.x), blo(aw_.y), bhi(aw_.y), blo(aw_.z), bhi(aw_.z), blo(aw_.w), bhi(aw_.w)};
      const f32x4 kk0 = *(const f32x4*)(kkw_g + c0), kk1 = *(const f32x4*)(kkw_g + c0 + 4), ka0 = *(const f32x4*)(kaw_g + c0), ka1 = *(const f32x4*)(kaw_g + c0 + 4);
      float kk[8], ss = 0.f;
#pragma unroll
      for (int i = 0; i < 8; ++i) { kk[i] = k[i] * (i < 4 ? kk0[i] : kk1[i - 4]); ss += kk[i] * kk[i]; }
      ss += __shfl_xor(ss, 1); ss += __shfl_xor(ss, 2); ss += __shfl_xor(ss, 4);
      const float inv = 1.f / fmaxf(sqrtf(ss), 1e-12f);
      float Rt[8], Kt[8], At[8], Bt[8];
#pragma unroll
      for (int i = 0; i < 8; ++i) { const float eL = __expf(cum[i]), eLi = __expf(-cum[i]), eLx = __expf(cum[i] - lw[i]); const float kn = kk[i] * inv;
          Rt[i] = r[i] * eL; Kt[i] = k[i] * (1.f + (a[i] - 1.f) * (i < 4 ? ka0[i] : ka1[i - 4])) * eLi; At[i] = -kn * eLx; Bt[i] = kn * a[i] * eLi;
          if (tok == 63) ((RW_LAS float*)(L + O_GAM))[c0 + i] = eL; }
      u32x4 o;
      o.x = cvtpk(Rt[0], Rt[1]); o.y = cvtpk(Rt[2], Rt[3]); o.z = cvtpk(Rt[4], Rt[5]); o.w = cvtpk(Rt[6], Rt[7]); *(RW_LAS u32x4*)(L + O_R + tok * PB + c0 * 2) = o;
      o.x = cvtpk(Kt[0], Kt[1]); o.y = cvtpk(Kt[2], Kt[3]); o.z = cvtpk(Kt[4], Kt[5]); o.w = cvtpk(Kt[6], Kt[7]); *(RW_LAS u32x4*)(L + O_K + tok * PB + c0 * 2) = o;
      o.x = cvtpk(At[0], At[1]); o.y = cvtpk(At[2], At[3]); o.z = cvtpk(At[4], At[5]); o.w = cvtpk(At[6], At[7]); *(RW_LAS u32x4*)(L + O_A + tok * PB + c0 * 2) = o;
      o.x = cvtpk(Bt[0], Bt[1]); o.y = cvtpk(Bt[2], Bt[3]); o.z = cvtpk(Bt[4], Bt[5]); o.w = cvtpk(Bt[6], Bt[7]); *(RW_LAS u32x4*)(L + O_B + tok * PB + c0 * 2) = o;
      *(RW_LAS u32x4*)(L + O_GT + tok * PB + c0 * 2) = vw_;
    }
    if (it + G < 8192) load_chunk(cin, ws, it + G, tid);
    RW_SYNC();
    if (STOP == 1) continue;
    {
      const int ch = tid & 63, tg = tid >> 6;
#pragma unroll
      for (int mtx = 0; mtx < 3; ++mtx) { const RW_LAS unsigned char* src = L + (mtx == 0 ? O_B : mtx == 1 ? O_K : O_GT) + (8 * tg) * PB + ch * 2; unsigned v[8];
#pragma unroll
          for (int i = 0; i < 8; ++i) v[i] = *(const RW_LAS unsigned short*)(src + i * PB);
          u32x4 o; o.x = v[0] | (v[1] << 16); o.y = v[2] | (v[3] << 16); o.z = v[4] | (v[5] << 16); o.w = v[6] | (v[7] << 16);
          *(RW_LAS u32x4*)(L + (mtx == 0 ? O_BT : mtx == 1 ? O_KT : O_VT) + ch * PB + (8 * tg) * 2) = o; } }
    const int t4 = w & 3, p2 = (w >> 2) * 2;
    { const bf16x8 b0 = frag(L + O_B, t4, 0, lane), b1 = frag(L + O_B, t4, 1, lane), k0 = frag(L + O_K, t4, 0, lane), k1 = frag(L + O_K, t4, 1, lane);
#pragma unroll
      for (int u = 0; u < 2; ++u) { const int nt = p2 + u, t = 16 * nt + l15, s0 = 16 * t4 + 4 * g;
          f32x4 ab = {0.f, 0.f, 0.f, 0.f}, ak = ab, rb = ab, rk = ab;
          if (t4 <= nt) { const bf16x8 a0 = frag(L + O_A, nt, 0, lane), a1 = frag(L + O_A, nt, 1, lane), r0 = frag(L + O_R, nt, 0, lane), r1 = frag(L + O_R, nt, 1, lane);
              ab = RW_MFMA(b0, a0, ab); ab = RW_MFMA(b1, a1, ab); ak = RW_MFMA(k0, a0, ak); ak = RW_MFMA(k1, a1, ak);
              rb = RW_MFMA(b0, r0, rb); rb = RW_MFMA(b1, r1, rb); rk = RW_MFMA(k0, r0, rk); rk = RW_MFMA(k1, r1, rk);
#pragma unroll
              for (int r = 0; r < 4; ++r) { const int s = s0 + r; if (!(s < t)) { ab[r] = 0.f; ak[r] = 0.f; } if (!(s <= t)) { rb[r] = 0.f; rk[r] = 0.f; } } }
          *(RW_LAS f32x4*)(L + O_AAB + t * PF + s0 * 4) = ab;
          u32x2 o; o.x = cvtpk(ab[0], ab[1]); o.y = cvtpk(ab[2], ab[3]); *(RW_LAS u32x2*)(L + O_AABB + t * PB + s0 * 2) = o;
          o.x = cvtpk(ak[0], ak[1]); o.y = cvtpk(ak[2], ak[3]); *(RW_LAS u32x2*)(L + O_AAK + t * PB + s0 * 2) = o;
          o.x = cvtpk(rb[0], rb[1]); o.y = cvtpk(rb[2], rb[3]); *(RW_LAS u32x2*)(L + O_ARB + t * PB + s0 * 2) = o;
          o.x = cvtpk(rk[0], rk[1]); o.y = cvtpk(rk[2], rk[3]); *(RW_LAS u32x2*)(L + O_ARK + t * PB + s0 * 2) = o; } }
    RW_SYNC();
    if (STOP == 2) continue;
    { const bf16x8 a0 = frag(L + O_AAK, t4, 0, lane), a1 = frag(L + O_AAK, t4, 1, lane);
#pragma unroll
      for (int u = 0; u < 2; ++u) { const int nt = p2 + u; f32x4 acc = {0.f, 0.f, 0.f, 0.f};
          acc = RW_MFMA(a0, frag(L + O_VT, nt, 0, lane), acc); acc = RW_MFMA(a1, frag(L + O_VT, nt, 1, lane), acc);
          *(RW_LAS f32x4*)(L + O_GT + (16 * nt + l15) * PF + (16 * t4 + 4 * g) * 4) = acc; } }
    if (w < 4 && lane < 16) {
        float x[16]; const RW_LAS unsigned char* ab = L + O_AAB + 16 * w * PF + 16 * w * 4;
#pragma unroll
        for (int r = 0; r < 16; ++r) { float a0 = (r == lane) ? 1.f : 0.f, a1 = 0.f;
#pragma unroll
            for (int q4 = 0; q4 < (r + 3) / 4; ++q4) { const f32x4 av = *(const RW_LAS f32x4*)(ab + r * PF + q4 * 16);
                if (4 * q4 + 0 < r) a0 += av[0] * x[4 * q4 + 0]; if (4 * q4 + 1 < r) a1 += av[1] * x[4 * q4 + 1]; if (4 * q4 + 2 < r) a0 += av[2] * x[4 * q4 + 2]; if (4 * q4 + 3 < r) a1 += av[3] * x[4 * q4 + 3]; }
            x[r] = a0 + a1; *(RW_LAS unsigned short*)(L + O_TB + w * 768 + r * 48 + lane * 2) = (unsigned short)(cvtpk(x[r], 0.f) & 0xffffu); } }
    RW_SYNC();
    if (STOP == 3) continue;
#if RW_SOLVE_OLD
    if (tid < 128) { const int c = tid;
        const RW_LAS unsigned char* rhs = c < 64 ? (L + O_A + c * 2) : (L + O_GT + (c - 64) * PF);
        RW_LAS unsigned char* dst = c < 64 ? (L + O_WT + c * PB) : (L + O_UT + (c - 64) * PB);
        for (int b = 0; b < 4; ++b) { float z[16];
#pragma unroll
            for (int r = 0; r < 16; ++r) z[r] = c < 64 ? blo((unsigned)*(const RW_LAS unsigned short*)(rhs + (16 * b + r) * PB)) : *(const RW_LAS float*)(rhs + (16 * b + r) * 4);
            const RW_LAS unsigned char* arow = L + O_AAB + 16 * b * PF;
            for (int s4 = 0; s4 < 4 * b; ++s4) { const u32x2 xw = *(const RW_LAS u32x2*)(dst + s4 * 8); const float x0 = blo(xw.x), x1 = bhi(xw.x), x2 = blo(xw.y), x3 = bhi(xw.y);
#pragma unroll
                for (int r = 0; r < 16; ++r) { const f32x4 av = *(const RW_LAS f32x4*)(arow + r * PF + s4 * 16); z[r] += (av[0] * x0 + av[1] * x1) + (av[2] * x2 + av[3] * x3); } }
#pragma unroll
            for (int r = 1; r < 16; ++r) {
#pragma unroll
                for (int q4 = 0; q4 < (r + 3) / 4; ++q4) { const f32x4 av = *(const RW_LAS f32x4*)(arow + r * PF + (4 * b + q4) * 16);
                    if (4 * q4 + 0 < r) z[r] += av[0] * z[4 * q4 + 0]; if (4 * q4 + 1 < r) z[r] += av[1] * z[4 * q4 + 1]; if (4 * q4 + 2 < r) z[r] += av[2] * z[4 * q4 + 2]; if (4 * q4 + 3 < r) z[r] += av[3] * z[4 * q4 + 3]; } }
            u32x4 o; o.x = cvtpk(z[0], z[1]); o.y = cvtpk(z[2], z[3]); o.z = cvtpk(z[4], z[5]); o.w = cvtpk(z[6], z[7]); *(RW_LAS u32x4*)(dst + 32 * b) = o;
            o.x = cvtpk(z[8], z[9]); o.y = cvtpk(z[10], z[11]); o.z = cvtpk(z[12], z[13]); o.w = cvtpk(z[14], z[15]); *(RW_LAS u32x4*)(dst + 32 * b + 16) = o;
            asm volatile("s_waitcnt lgkmcnt(0)" ::: "memory"); } }
    RW_SYNC();
#else
    { RW_LAS unsigned char* xt = (w < 4 ? L + O_WT : L + O_UT) + (w & 3) * 16 * PB;
      { const u32x4 z4 = {0u, 0u, 0u, 0u}; *(RW_LAS u32x4*)(xt + l15 * PB + g * 16) = z4; *(RW_LAS u32x4*)(xt + l15 * PB + 64 + g * 16) = z4; }
      asm volatile("s_waitcnt lgkmcnt(0)" ::: "memory");
#pragma unroll
      for (int b = 0; b < 4; ++b) { f32x4 z;
          if (w < 4) { const RW_LAS unsigned char* ap = L + O_A + (16 * b + 4 * g) * PB + (16 * w + l15) * 2;
              z = (f32x4){blo((unsigned)*(const RW_LAS unsigned short*)(ap)), blo((unsigned)*(const RW_LAS unsigned short*)(ap + PB)), blo((unsigned)*(const RW_LAS unsigned short*)(ap + 2 * PB)), blo((unsigned)*(const RW_LAS unsigned short*)(ap + 3 * PB))}; }
          else z = *(const RW_LAS f32x4*)(L + O_GT + (16 * (w - 4) + l15) * PF + (16 * b + 4 * g) * 4);
          if (b > 0) { z = RW_MFMA(frag(L + O_AABB, b, 0, lane), *(const RW_LAS bf16x8*)(xt + l15 * PB + (8 * g) * 2), z);
                       if (b > 2) z = RW_MFMA(frag(L + O_AABB, b, 1, lane), *(const RW_LAS bf16x8*)(xt + l15 * PB + (32 + 8 * g) * 2), z); }
          const u32x2 tw = *(const RW_LAS u32x2*)(L + O_TB + b * 768 + l15 * 48 + (4 * g) * 2);
          const u32x4 tf = {tw.x, tw.y, 0u, 0u}, zf = {cvtpk(z[0], z[1]), cvtpk(z[2], z[3]), 0u, 0u};
          f32x4 xb = {0.f, 0.f, 0.f, 0.f}; xb = RW_MFMA(__builtin_bit_cast(bf16x8, tf), __builtin_bit_cast(bf16x8, zf), xb);
          u32x2 o; o.x = cvtpk(xb[0], xb[1]); o.y = cvtpk(xb[2], xb[3]); *(RW_LAS u32x2*)(xt + l15 * PB + (16 * b + 4 * g) * 2) = o;
          asm volatile("s_waitcnt lgkmcnt(0)" ::: "memory"); } }
    RW_SYNC();
#endif
    if (STOP == 4) continue;
    {
      const bf16x8 rb0 = frag(L + O_ARB, t4, 0, lane), rb1 = frag(L + O_ARB, t4, 1, lane), bt0 = frag(L + O_BT, t4, 0, lane), bt1 = frag(L + O_BT, t4, 1, lane);
      const int col = 16 * t4 + l15; const float gam = ((const RW_LAS float*)(L + O_GAM))[col];
      unsigned qw[4], pw[4];
#pragma unroll
      for (int u = 0; u < 2; ++u) { const int mt = p2 + u, j0 = 16 * mt + 4 * g; const bf16x8 w0 = frag(L + O_WT, mt, 0, lane), w1 = frag(L + O_WT, mt, 1, lane);
          f32x4 q = {0.f, 0.f, 0.f, 0.f}, p = q; q = RW_MFMA(w0, rb0, q); q = RW_MFMA(w1, rb1, q); p = RW_MFMA(w0, bt0, p); p = RW_MFMA(w1, bt1, p);
          const u32x2 rr = *(const RW_LAS u32x2*)(L + O_R + col * PB + j0 * 2);
          q[0] += blo(rr.x); q[1] += bhi(rr.x); q[2] += blo(rr.y); q[3] += bhi(rr.y);
#pragma unroll
          for (int r = 0; r < 4; ++r) p[r] = (p[r] + ((j0 + r) == col ? 1.f : 0.f)) * gam;
          qw[2 * u] = cvtpk(q[0], q[1]); qw[2 * u + 1] = cvtpk(q[2], q[3]); pw[2 * u] = cvtpk(p[0], p[1]); pw[2 * u + 1] = cvtpk(p[2], p[3]); }
      const int fo = ((t4 * 2 + (p2 >> 1)) * 64 + lane) * 16;
      *(u32x4*)(rec + REC_Q + fo) = (u32x4){qw[0], qw[1], qw[2], qw[3]}; *(u32x4*)(rec + REC_P + fo) = (u32x4){pw[0], pw[1], pw[2], pw[3]}; }
    {
      const bf16x8 rb0 = frag(L + O_ARB, t4, 0, lane), rb1 = frag(L + O_ARB, t4, 1, lane), rk0 = frag(L + O_ARK, t4, 0, lane), rk1 = frag(L + O_ARK, t4, 1, lane);
      const bf16x8 ut0 = frag(L + O_UT, t4, 0, lane), ut1 = frag(L + O_UT, t4, 1, lane), vt0 = frag(L + O_VT, t4, 0, lane), vt1 = frag(L + O_VT, t4, 1, lane);
      const int col = 16 * t4 + l15;
#pragma unroll
      for (int u = 0; u < 2; ++u) { const int mt = p2 + u, m0 = 16 * mt + 4 * g;
          f32x4 y = {0.f, 0.f, 0.f, 0.f}, hm = y;
          y = RW_MFMA(frag(L + O_UT, mt, 0, lane), rb0, y); y = RW_MFMA(frag(L + O_UT, mt, 1, lane), rb1, y); y = RW_MFMA(frag(L + O_VT, mt, 0, lane), rk0, y); y = RW_MFMA(frag(L + O_VT, mt, 1, lane), rk1, y);
          hm = RW_MFMA(frag(L + O_BT, mt, 0, lane), ut0, hm); hm = RW_MFMA(frag(L + O_BT, mt, 1, lane), ut1, hm); hm = RW_MFMA(frag(L + O_KT, mt, 0, lane), vt0, hm); hm = RW_MFMA(frag(L + O_KT, mt, 1, lane), vt1, hm);
          const f32x4 gm = *(const RW_LAS f32x4*)(L + O_GAM + m0 * 4);
          u32x2 o; o.x = cvtpk(y[0], y[1]); o.y = cvtpk(y[2], y[3]); *(u32x2*)(rec + REC_Y + (col * 64 + m0) * 2) = o;
          o.x = cvtpk(hm[0] * gm[0], hm[1] * gm[1]); o.y = cvtpk(hm[2] * gm[2], hm[3] * gm[3]); *(u32x2*)(rec + REC_H + (col * 64 + m0) * 2) = o; } }
    RW_SYNC();
  }
}

__device__ __forceinline__ void phase_b_head(RW_LAS unsigned char* L, const unsigned char* recs, unsigned short* Yg, int tid) {
    constexpr int NCH = 256, NSLOT = 4;
    const int lane = tid & 63, w = __builtin_amdgcn_readfirstlane(tid >> 6), g = lane >> 4, l15 = lane & 15;
    if (w >= 4) {
        const int lw = w - 4; const unsigned char* src = recs + lw * 8192 + lane * 16;
#define RW_ISSUE(c_) do { _Pragma("unroll") for (int k_ = 0; k_ < 8; ++k_) __builtin_amdgcn_global_load_lds((const unsigned*)(src + (size_t)(c_) * REC + k_ * 1024), (RW_LAS unsigned*)(L + ((c_) & 3) * REC + lw * 8192 + k_ * 1024), 16, 0, 0); } while (0)
        RW_ISSUE(0); RW_ISSUE(1); RW_ISSUE(2);
        asm volatile("s_waitcnt vmcnt(16)" ::: "memory");
        RW_BAR();
        for (int c = 0; c < NCH; ++c) {
            if (c + 3 < NCH) { RW_ISSUE(c + 3); asm volatile("s_waitcnt vmcnt(16)" ::: "memory"); }
            else asm volatile("s_waitcnt vmcnt(0)" ::: "memory");
            RW_BAR();
        }
#undef RW_ISSUE
    } else {
        f32x4 sacc[4];
#pragma unroll
        for (int m = 0; m < 4; ++m) sacc[m] = (f32x4){0.f, 0.f, 0.f, 0.f};
        RW_BAR();
        for (int c = 0; c < NCH; ++c) { const RW_LAS unsigned char* sl = L + (c & 3) * REC;
            bf16x8 bf[2];
#pragma unroll
            for (int s = 0; s < 2; ++s) { u32x4 v; v.x = cvtpk(sacc[2 * s][0], sacc[2 * s][1]); v.y = cvtpk(sacc[2 * s][2], sacc[2 * s][3]); v.z = cvtpk(sacc[2 * s + 1][0], sacc[2 * s + 1][1]); v.w = cvtpk(sacc[2 * s + 1][2], sacc[2 * s + 1][3]); bf[s] = __builtin_bit_cast(bf16x8, v); }
            f32x4 sn[4];
#pragma unroll
            for (int m = 0; m < 4; ++m) { const u32x2 hw = *(const RW_LAS u32x2*)(sl + REC_H + ((16 * w + l15) * 64 + 16 * m + 4 * g) * 2);
                f32x4 acc = {blo(hw.x), bhi(hw.x), blo(hw.y), bhi(hw.y)};
                acc = RW_MFMA(*(const RW_LAS bf16x8*)(sl + REC_P + ((m * 2 + 0) * 64 + lane) * 16), bf[0], acc);
                acc = RW_MFMA(*(const RW_LAS bf16x8*)(sl + REC_P + ((m * 2 + 1) * 64 + lane) * 16), bf[1], acc); sn[m] = acc; }
#pragma unroll
            for (int n = 0; n < 4; ++n) { const u32x2 yw = *(const RW_LAS u32x2*)(sl + REC_Y + ((16 * n + l15) * 64 + 16 * w + 4 * g) * 2);
                f32x4 acc = {blo(yw.x), bhi(yw.x), blo(yw.y), bhi(yw.y)};
                acc = RW_MFMA(bf[0], *(const RW_LAS bf16x8*)(sl + REC_Q + ((n * 2 + 0) * 64 + lane) * 16), acc);
                acc = RW_MFMA(bf[1], *(const RW_LAS bf16x8*)(sl + REC_Q + ((n * 2 + 1) * 64 + lane) * 16), acc);
                u32x2 yo; yo.x = cvtpk(acc[0], acc[1]); yo.y = cvtpk(acc[2], acc[3]); *(u32x2*)(Yg + (size_t)(c * 64 + 16 * n + l15) * 1024 + 16 * w + 4 * g) = yo; }
#pragma unroll
            for (int m = 0; m < 4; ++m) sacc[m] = sn[m];
            asm volatile("s_waitcnt lgkmcnt(0)" ::: "memory");
            RW_BAR();
        }
    }
}
}
#define XB_TMO      128
#define XB_XCNT(j)  (256  + 64 * (j))
#define XB_XSUB(j)  (1280 + 64 * (j))
#define XB_XGEN(j)  (2304 + 64 * (j))
#define XB_TOP      3328
#define XB_TOPGEN   3392
#define XCD_BAR_WORDS 3456
#define XB_SPIN_CAP (1u << 18)

__device__ __forceinline__ unsigned xb_ld(unsigned* p)              { return __hip_atomic_load(p, __ATOMIC_RELAXED, __HIP_MEMORY_SCOPE_AGENT); }
__device__ __forceinline__ unsigned xb_add(unsigned* p, unsigned v) { return __hip_atomic_fetch_add(p, v, __ATOMIC_RELAXED, __HIP_MEMORY_SCOPE_AGENT); }
__device__ __forceinline__ unsigned xb_xcc_id() { return (unsigned)__builtin_amdgcn_s_getreg((3 << 11) | 20) & 0xFu; }
#define XB_SPIN(cond, bar) do { unsigned _sp = 0; while (cond) { __builtin_amdgcn_s_sleep(1); \
    if ((++_sp & 255u) == 0u) { if (xb_ld(&(bar)[XB_TMO])) break; if (_sp > XB_SPIN_CAP) { atomicAdd(&(bar)[XB_TMO], 1u); break; } } } } while (0)

struct XcdBarrier {
    unsigned* bar; unsigned x;
    volatile LAS unsigned* st;
};

__device__ __forceinline__ XcdBarrier xcd_barrier_post(unsigned* bar, volatile LAS unsigned* st, const int tid) {
    XcdBarrier b; b.bar = bar; b.x = xb_xcc_id(); b.st = st;
    if (tid == 0) (void)xb_add(&bar[XB_XCNT(b.x)], 1u);
    return b;
}
__device__ __forceinline__ void xcd_barrier_complete(unsigned* bar, unsigned x, unsigned& nloc, unsigned& nx) {
    const unsigned G = gridDim.x * gridDim.y * gridDim.z;
    unsigned sum, cnt, mine, sp = 0u;
    for (;;) {
        sum = 0u; cnt = 0u; mine = 0u;
#pragma unroll
        for (unsigned j = 0; j < 16; ++j) { const unsigned c = xb_ld(&bar[XB_XCNT(j)]); sum += c; cnt += (c > 0u) ? 1u : 0u; mine = (j == x) ? c : mine; }
        if (sum == G) break;
        __builtin_amdgcn_s_sleep(1);
        if ((++sp & 255u) == 0u) { if (xb_ld(&bar[XB_TMO])) break; if (sp > XB_SPIN_CAP) { atomicAdd(&bar[XB_TMO], 1u); break; } }
    }
    nloc = mine > 0u ? mine : 1u; nx = cnt > 0u ? cnt : 1u;
}

__device__ __forceinline__ void xcd_barrier(const XcdBarrier& b, const int tid) {
    asm volatile("s_waitcnt vmcnt(0)" ::: "memory");
    __syncthreads();
    if (tid == 0) {
        unsigned* bar = b.bar;
        __builtin_amdgcn_s_waitcnt(0);
        unsigned nloc = b.st[0], nx = b.st[1];
        if (nloc == 0u) { xcd_barrier_complete(bar, b.x, nloc, nx); b.st[0] = nloc; b.st[1] = nx; }
        const unsigned old = xb_add(&bar[XB_XSUB(b.x)], 1u);
        const unsigned gen = old / nloc;
        if (old + 1u == (gen + 1u) * nloc) {
            __builtin_amdgcn_fence(__ATOMIC_RELEASE, "agent");
            asm volatile("s_waitcnt vmcnt(0)" ::: "memory");
            const unsigned og = xb_add(&bar[XB_TOP], 1u);
            const unsigned tg = og / nx;
            if (og + 1u == (tg + 1u) * nx) xb_add(&bar[XB_TOPGEN], 1u);
            else XB_SPIN(xb_ld(&bar[XB_TOPGEN]) == tg, bar);
            __builtin_amdgcn_fence(__ATOMIC_ACQUIRE, "agent");
            xb_add(&bar[XB_XGEN(b.x)], 1u);
            asm volatile("s_waitcnt vmcnt(0)" ::: "memory");
        } else {
            XB_SPIN(xb_ld(&bar[XB_XGEN(b.x)]) == gen, bar);
            __builtin_amdgcn_fence(__ATOMIC_ACQUIRE, "agent");
            asm volatile("s_waitcnt vmcnt(0)" ::: "memory");
        }
    }
    __syncthreads();
}
enum InIdx { I_X = 0, I_C, I_WADA, I_BADA, I_N1G, I_WIN, I_MU, I_WDEC, I_W0, I_WICLR, I_A0, I_WGATE, I_KK, I_KA, I_RK, I_GNG, I_GNB, I_WOA, I_BF, I_QN, I_KN, I_WOB, I_WOUT, I_N2G, I_WR, I_BR, I_WGU, I_BGU, I_WDN, I_BDN, I_NFG, N_IN };
struct Args { const float* in[N_IN]; float* out; unsigned char* ws; int ph_lo, ph_hi; };
static_assert(sizeof(Args) == (N_IN + 2) * 8 + 8, "Args has no padding");
typedef const __attribute__((address_space(4))) Args* ArgsP;
struct Frame {
    LAS unsigned char* lds;
    volatile LAS unsigned* MISC;
    gu32* ctl;
    int tid, lane, wave, G, wg;
    unsigned char* ws;
    ArgsP ap;
};
#define WSP(T_, off) ((T_*)(F.ws + (off)))

__device__ __forceinline__ int win_orig_col(int c) {
    if (c < PC_GLO) return c;
    if (c < PC_DLO) return 3264 + (c - PC_GLO);
    if (c < PC_ALO) return 3072 + (c - PC_DLO);
    if (c < PC_F) return 3168 + (c - PC_ALO);
    if (c < PC_FEND) return 6592 + (c - PC_F);
    if (c < PC_SPLIT) return -1;
    if (c < PC_FQ) return 7624 + (c - PC_GA);
    if (c < PC_OG) return 3520 + (c - PC_FQ);
    if (c < PC_GB) return 6600 + (c - PC_OG);
    return 9672 + (c - PC_GB);
}
__device__ __forceinline__ void tr_item(const float* W, int ldw, int K, bf16* WT, int drow0, int scol0, int nvalid, int k0, LAS float* scr, int lane) {
    const int n = lane & 31;
#pragma unroll 8
    for (int i = 0; i < 32; ++i) { const int kk = 2 * i + (lane >> 5); scr[kk * 33 + n] = (n < nvalid) ? W[(size_t)(k0 + kk) * ldw + scol0 + n] : 0.f; }
    LDS_WAIT(); asm volatile("" ::: "memory");
    const int c = lane & 7;
#pragma unroll
    for (int j = 0; j < 4; ++j) { const int nn = (lane >> 3) + 8 * j; const LAS float* s = scr + (8 * c) * 33 + nn;
        v4u o; o.x = pk2(s[0 * 33], s[1 * 33]); o.y = pk2(s[2 * 33], s[3 * 33]); o.z = pk2(s[4 * 33], s[5 * 33]); o.w = pk2(s[6 * 33], s[7 * 33]);
        *(GAS v4u*)(WT + (size_t)(drow0 + nn) * K + k0 + 8 * c) = o; }
    LDS_WAIT(); asm volatile("" ::: "memory");
}
__device__ __forceinline__ unsigned pk4_fp8(float a, float b, float c, float d) { int w = __builtin_amdgcn_cvt_pk_fp8_f32(a, b, 0, false); w = __builtin_amdgcn_cvt_pk_fp8_f32(c, d, w, true); return (unsigned)w; }
__device__ __forceinline__ void tr_item8(const float* W, int ldw, int K, unsigned char* WT, int drow0, int scol0, int nvalid, int k0, float scale, LAS float* scr, int lane) {
    const int n = lane & 31;
#pragma unroll 8
    for (int i = 0; i < 32; ++i) { const int kk = 2 * i + (lane >> 5); scr[kk * 33 + n] = (n < nvalid) ? W[(size_t)(k0 + kk) * ldw + scol0 + n] * scale : 0.f; }
    LDS_WAIT(); asm volatile("" ::: "memory");
    const int c = lane & 7;
#pragma unroll
    for (int j = 0; j < 4; ++j) { const int nn = (lane >> 3) + 8 * j; const LAS float* s = scr + (8 * c) * 33 + nn;
        v2u o; o.x = pk4_fp8(s[0 * 33], s[1 * 33], s[2 * 33], s[3 * 33]); o.y = pk4_fp8(s[4 * 33], s[5 * 33], s[6 * 33], s[7 * 33]);
        *(GAS v2u*)(WT + (size_t)(drow0 + nn) * K + k0 + 8 * c) = o; }
    LDS_WAIT(); asm volatile("" ::: "memory");
}
struct ConvItem { const float* src; unsigned char* dst; int ldw, dn; };
__device__ __forceinline__ ConvItem conv_item(Frame& F, int it) {
    constexpr int I_GU = NE * 32 * 128; ConvItem c;
    if (it < I_GU) { const int e = it / (32 * 128), q = it % (32 * 128), kb = q / 128, gp = q % 128, d0 = gp * 32, pn = d0 >> 8, j = d0 & 255, sc = j < 128 ? 128 * pn + j : 2048 + 128 * pn + (j - 128);
        c.src = F.ap->in[I_WGU] + (size_t)e * 2048 * 4096 + (size_t)(kb * 64) * 4096 + sc; c.dst = WSP(unsigned char, WS_WGU) + (size_t)e * 4096 * 2048 + (size_t)d0 * 2048 + kb * 64; c.ldw = 4096; c.dn = 0; }
    else { const int r = it - I_GU, e = r / (32 * 64), q = r % (32 * 64), kb = q / 64, gp = q % 64;
        const int d0 = gp * 32, trow = (d0 & ~255) + 32 * ((d0 >> 6) & 3) + 16 * ((d0 >> 5) & 1);
        c.src = F.ap->in[I_WDN] + (size_t)e * 2048 * 2048 + (size_t)(kb * 64) * 2048 + d0; c.dst = WSP(unsigned char, WS_WDN) + (size_t)e * 2048 * 2048 + (size_t)trow * 2048 + kb * 64; c.ldw = 2048; c.dn = 1; }
    return c;
}
__device__ __forceinline__ void convert_experts(Frame& F, int rank, int nranks) {
    constexpr int NIT = NE * 32 * 128 + NE * 32 * 64;
    LAS float* scr = (LAS float*)(F.lds + RING_OFF + F.wave * 16384);
    const int lane = F.lane, gw = rank * NWAVES + F.wave, NGW = nranks * NWAVES, c4 = lane & 7, r8 = lane >> 3;
    f32x4 cur[8], n1[8], n2[8]; ConvItem ci, c1, c2;
#define CONV_LOAD(dst, cc, it_) do { cc = conv_item(F, it_); _Pragma("unroll") for (int j = 0; j < 8; ++j) dst[j] = __builtin_nontemporal_load((const f32x4*)(cc.src + (size_t)(r8 + 8 * j) * cc.ldw + 4 * c4)); } while (0)
    if (gw < NIT) CONV_LOAD(cur, ci, gw);
    if (gw + NGW < NIT) CONV_LOAD(n1, c1, gw + NGW);
    for (int it = gw; it < NIT; it += NGW) {
        if (it + 2 * NGW < NIT) CONV_LOAD(n2, c2, it + 2 * NGW);
#pragma unroll
        for (int j = 0; j < 8; ++j) { LAS float* s = scr + (r8 + 8 * j) * 33 + 4 * c4; s[0] = cur[j].x * FP8_SW; s[1] = cur[j].y * FP8_SW; s[2] = cur[j].z * FP8_SW; s[3] = cur[j].w * FP8_SW; }
        LDS_WAIT(); asm volatile("" ::: "memory");
#pragma unroll
        for (int j = 0; j < 4; ++j) { const int nn = r8 + 8 * j; const LAS float* s = scr + (8 * c4) * 33 + nn;
            v2u o; o.x = pk4_fp8(s[0 * 33], s[1 * 33], s[2 * 33], s[3 * 33]); o.y = pk4_fp8(s[4 * 33], s[5 * 33], s[6 * 33], s[7 * 33]);
            const int drow = ci.dn ? 128 * (j & 1) + 8 * (j >> 1) + r8 : nn;
            __builtin_nontemporal_store(o, (v2u*)(ci.dst + (size_t)drow * 2048 + 8 * c4)); }
        LDS_WAIT(); asm volatile("" ::: "memory");
        ci = c1; c1 = c2;
#pragma unroll
        for (int j = 0; j < 8; ++j) { cur[j] = n1[j]; n1[j] = n2[j]; }
    }
#undef CONV_LOAD
}
__device__ __forceinline__ void p0_prologue(Frame& F) {
    LAS float* scr = (LAS float*)(F.lds + RING_OFF + F.wave * 16384);
    const int gw = F.wg * NWAVES + F.wave, NGW = F.G * NWAVES, lane = F.lane;
    constexpr int I_IN = 32 * 368, I_OA = 16 * 64, I_OB = I_OA, I_OUT = 32 * 64;
    constexpr int NITEMS = I_IN + I_OA + I_OB + I_OUT;
    for (int it = gw; it < NITEMS; it += NGW) {
        int r = it;
        if (r < I_IN) { const int kb = r / 368, gp = r % 368, c0 = gp * 32, oc = win_orig_col(c0); const int nv = oc < 0 ? 0 : (c0 == PC_F ? PC_FEND - PC_F : 32);
            const bool as8 = INPROJ_FP8 == 1 || (INPROJ_FP8 == 2 && c0 >= PC_SPLIT);
            if (as8) tr_item8(F.ap->in[I_WIN], 11720, 2048, WSP(unsigned char, WS_WIN8), c0, oc < 0 ? 0 : oc, nv, kb * 64, FP8_SW, scr, lane);
            else tr_item(F.ap->in[I_WIN], 11720, 2048, WSP(bf16, WS_WIN), c0, oc < 0 ? 0 : oc, nv, kb * 64, scr, lane);
            continue; } r -= I_IN;
        if (r < I_OA) { tr_item(F.ap->in[I_WOA], 2048, 1024, WSP(bf16, WS_WOA), (r % 64) * 32, (r % 64) * 32, 32, (r / 64) * 64, scr, lane); continue; } r -= I_OA;
        if (r < I_OB) { tr_item(F.ap->in[I_WOB], 2048, 1024, WSP(bf16, WS_WOB), (r % 64) * 32, (r % 64) * 32, 32, (r / 64) * 64, scr, lane); continue; } r -= I_OB;
#if OUTPROJ_FP8
        { tr_item8(F.ap->in[I_WOUT], 2048, 2048, WSP(unsigned char, WS_WOUT), (r % 64) * 32, (r % 64) * 32, 32, (r / 64) * 64, FP8_SW, scr, lane); }
#else
        { tr_item(F.ap->in[I_WOUT], 2048, 2048, WSP(bf16, WS_WOUT), (r % 64) * 32, (r % 64) * 32, 32, (r / 64) * 64, scr, lane); }
#endif
    }
    const int gt = F.wg * (NWAVES * 64) + F.tid, NGT = F.G * NWAVES * 64;
    { bf16* b1 = WSP(bf16, WS_BT1); const float* wd = F.ap->in[I_WDEC]; const float* wi = F.ap->in[I_WICLR];
      for (int i = gt; i < 2048 * 256; i += NGT) { const int n = i >> 8, k = i & 255; float v = 0.f;
          if (n < 1024) { if (k < 96) v = wd[k * 1024 + n]; } else { if (k >= 128 && k < 224) v = wi[(k - 128) * 1024 + (n - 1024)]; }
          b1[i] = (bf16)f2bf(v); } }
    { bf16* b2 = WSP(bf16, WS_BT2); const float* wg = F.ap->in[I_WGATE];
      for (int i = gt; i < 1024 * 256; i += NGT) { const int n = i >> 8, k = i & 255; b2[i] = (bf16)f2bf(wg[k * 1024 + n]); } }
    { float* wrt = WSP(float, WS_WRT); const float* wr = F.ap->in[I_WR];
      for (int i = gt; i < 32 * 2048; i += NGT) { const int e = i >> 11, k = i & 2047; wrt[i] = wr[k * 32 + e]; } }
    { bf16* h = WSP(bf16, WS_H) + (size_t)T * DM; for (int i = gt; i < DM; i += NGT) h[i] = 0; }
    if (F.wg < 192) {
        const float* wa = F.ap->in[I_WADA]; const float* cc = F.ap->in[I_C]; const int n = F.wg * 64 + lane;
        LAS float* sl = (LAS float*)(F.lds + RING_OFF + 131072 - 4096 - 16384);
        __syncthreads();
#pragma unroll
        for (int j = 0; j < 8; ++j) { const int i = F.tid + 512 * j; const float c = cc[i]; sl[i] = c * sigmoidf_(c); }
        __syncthreads();
        float s0 = 0.f, s1 = 0.f; const float* wp = wa + (size_t)(F.wave * 256) * 12288 + n; const LAS float* s0p = sl + F.wave * 256; const LAS float* s1p = sl + 2048 + F.wave * 256;
        for (int k = 0; k < 256; k += 16) { float w[16];
#pragma unroll
            for (int u = 0; u < 16; ++u) w[u] = wp[(size_t)(k + u) * 12288];
#pragma unroll
            for (int u = 0; u < 16; u += 4) { const f32x4 a = *(const LAS f32x4*)(s0p + k + u), c = *(const LAS f32x4*)(s1p + k + u);
                s0 += (a[0] * w[u] + a[1] * w[u + 1]) + (a[2] * w[u + 2] + a[3] * w[u + 3]); s1 += (c[0] * w[u] + c[1] * w[u + 1]) + (c[2] * w[u + 2] + c[3] * w[u + 3]); } }
        LAS float* red = (LAS float*)(F.lds + RING_OFF + 131072 - 4096);
        __syncthreads();
        red[(F.wave * 2 + 0) * 64 + lane] = s0; red[(F.wave * 2 + 1) * 64 + lane] = s1;
        __syncthreads();
        if (F.wave < 2) { float s = 0.f;
#pragma unroll
            for (int w = 0; w < 8; ++w) s += red[(w * 2 + F.wave) * 64 + lane];
            WSP(float, WS_MOD)[F.wave * 12288 + n] = s + F.ap->in[I_BADA][n]; }
    }
}
template <int OUT8> __device__ __forceinline__ void norm_mod_rows(Frame& F, const float* x, const float* g, int shift_off, int scale_off, bf16* H, unsigned char* H8) {
    const int gw = F.wg * NWAVES + F.wave, NGW = F.G * NWAVES, lane = F.lane; const float* mod = WSP(float, WS_MOD);
    for (int m = gw; m < T; m += NGW) {
        const f32x4* xr = (const f32x4*)(x + (size_t)m * DM) + lane; f32x4 v[8]; float ss = 0.f;
#pragma unroll
        for (int j = 0; j < 8; ++j) { v[j] = xr[64 * j]; ss += (v[j].x * v[j].x + v[j].y * v[j].y) + (v[j].z * v[j].z + v[j].w * v[j].w); }
        const float rs = rsqrtf(wave_sum(ss) * (1.f / DM) + NORM_EPS); const float* mb = mod + (size_t)(m / SEQ) * 12288;
#pragma unroll
        for (int j = 0; j < 8; ++j) { const int c = 4 * lane + 256 * j; const f32x4 gg = *(const f32x4*)(g + c), sc = *(const f32x4*)(mb + scale_off + c), sh = *(const f32x4*)(mb + shift_off + c);
            const f32x4 y = v[j] * rs * gg * (sc + 1.f) + sh;
            if constexpr (OUT8 != 0) *(unsigned*)(H8 + (size_t)m * DM + c) = pk4_fp8(y.x * FP8_SA1, y.y * FP8_SA1, y.z * FP8_SA1, y.w * FP8_SA1);
            if constexpr (OUT8 != 1) { v2u o; o.x = pk2(y.x, y.y); o.y = pk2(y.z, y.w); *(v2u*)(H + (size_t)m * DM + c) = o; } }
    }
}
struct PrepTok { v4u rkv[6]; v4u lo; v4u fq[2], fk[2]; unsigned fp; };
__device__ __forceinline__ void prep_load(PrepTok& k, const bf16* pc, int lane, int cl) {
#pragma unroll
    for (int s = 0; s < 6; ++s) k.rkv[s] = *(const v4u*)(pc + PC_R + (s * 64 + lane) * 8);
    k.lo = *(const v4u*)(pc + cl);
#pragma unroll
    for (int s = 0; s < 2; ++s) { k.fq[s] = *(const v4u*)(pc + PC_FQ + (s * 64 + lane) * 8); k.fk[s] = *(const v4u*)(pc + PC_FK + (s * 64 + lane) * 8); }
    k.fp = (unsigned)pc[PC_F + (lane & 7)];
}
__device__ __forceinline__ void p3_prep(Frame& F) {
    const int gw = F.wg * NWAVES + F.wave, lane = F.lane, t0 = gw * 16;
    const bf16* P = WSP(bf16, WS_P); const float* mu = F.ap->in[I_MU];
    bf16* Rb = WSP(bf16, WS_R); bf16* LW = WSP(bf16, WS_LW); bf16* SG = WSP(bf16, WS_SG);
    int cl, mi; if (lane < 32) { cl = PC_GLO + 8 * lane; mi = 3264 + 8 * lane; } else if (lane < 44) { cl = PC_DLO + 8 * (lane - 32); mi = 3072 + 8 * (lane - 32); } else if (lane < 56) { cl = PC_ALO + 8 * (lane - 44); mi = 3168 + 8 * (lane - 44); } else { cl = PC_ALO; mi = 3168; }
    f32x4 m0[6], m1[6];
#pragma unroll
    for (int s = 0; s < 6; ++s) { const int c = (s * 64 + lane) * 8; m0[s] = *(const f32x4*)(mu + c); m1[s] = *(const f32x4*)(mu + c + 4); }
    const f32x4 ml0 = *(const f32x4*)(mu + mi), ml1 = *(const f32x4*)(mu + mi + 4);
    f32x4 gq[2][2], gk[2][2];
#pragma unroll
    for (int s = 0; s < 2; ++s) { const int d0 = ((s * 64 + lane) & 15) * 8; gq[s][0] = *(const f32x4*)(F.ap->in[I_QN] + d0); gq[s][1] = *(const f32x4*)(F.ap->in[I_QN] + d0 + 4); gk[s][0] = *(const f32x4*)(F.ap->in[I_KN] + d0); gk[s][1] = *(const f32x4*)(F.ap->in[I_KN] + d0 + 4); }
    const float bfl = F.ap->in[I_BF][lane & 7];
    v4u prv[6], prvl; const v4u zz = {0u, 0u, 0u, 0u};
    if ((t0 % SEQ) == 0) {
#pragma unroll
        for (int s = 0; s < 6; ++s) prv[s] = zz; prvl = zz; }
    else { const bf16* pp = P + (size_t)(t0 - 1) * NP;
#pragma unroll
        for (int s = 0; s < 6; ++s) prv[s] = *(const v4u*)(pp + PC_R + (s * 64 + lane) * 8); prvl = *(const v4u*)(pp + cl); }
    PrepTok cur, nxt; prep_load(cur, P + (size_t)t0 * NP, lane, cl);
    for (int i = 0; i < 16; ++i) { const int t = t0 + i;
        if (i + 1 < 16) prep_load(nxt, P + (size_t)(t + 1) * NP, lane, cl);
#pragma unroll
        for (int s = 0; s < 6; ++s) { const int c = (s * 64 + lane) * 8; float a[8], b[8], o[8]; unpack8(cur.rkv[s], a); unpack8(prv[s], b);
#pragma unroll
            for (int j = 0; j < 8; ++j) { const float mm = j < 4 ? m0[s][j] : m1[s][j - 4]; o[j] = a[j] + mm * (b[j] - a[j]); }
            *(v4u*)(Rb + (size_t)(c >> 10) * ((WS_K - WS_R) / 2) + (size_t)t * RW + (c & 1023)) = pack8f(o); prv[s] = cur.rkv[s]; }
        { float o[8] = {0.f, 0.f, 0.f, 0.f, 0.f, 0.f, 0.f, 0.f};
          if (lane < 56) { float a[8], b[8]; unpack8(cur.lo, a); unpack8(prvl, b);
#pragma unroll
              for (int j = 0; j < 8; ++j) { const float mm = j < 4 ? ml0[j] : ml1[j - 4]; const float v = a[j] + mm * (b[j] - a[j]); o[j] = lane < 32 ? sigmoidf_(v) : (lane < 44 ? tanhf(v) : v); } }
          prvl = cur.lo;
          bf16* dst; if (lane < 32) dst = SG + (size_t)t * 256 + 8 * lane; else if (lane < 44) dst = LW + (size_t)t * 256 + 8 * (lane - 32); else if (lane < 56) dst = LW + (size_t)t * 256 + 128 + 8 * (lane - 44);
          else if (lane < 60) dst = LW + (size_t)t * 256 + 96 + 8 * (lane - 56); else dst = LW + (size_t)t * 256 + 224 + 8 * (lane - 60);
          *(v4u*)dst = pack8f(o); }
#pragma unroll
        for (int s = 0; s < 2; ++s) { const int ch = s * 64 + lane;
#pragma unroll
            for (int qk = 0; qk < 2; ++qk) { float a[8]; unpack8(qk ? cur.fk[s] : cur.fq[s], a); float ss = 0.f;
#pragma unroll
                for (int j = 0; j < 8; ++j) ss += a[j] * a[j];
                ss += __shfl_xor(ss, 1); ss += __shfl_xor(ss, 2); ss += __shfl_xor(ss, 4); ss += __shfl_xor(ss, 8);
                const float rs = rsqrtf(ss * (1.f / 128.f) + NORM_EPS); const f32x4 g0 = qk ? gk[s][0] : gq[s][0], g1 = qk ? gk[s][1] : gq[s][1];
#pragma unroll
                for (int j = 0; j < 8; ++j) a[j] = a[j] * rs * (j < 4 ? g0[j] : g1[j - 4]);
                *(v4u*)(WSP(bf16, qk ? WS_FK : WS_FQ) + (size_t)t * FW + ch * 8) = pack8f(a); } }
        if (lane < 8) { const float xv = bflo(cur.fp) + bfl;
            WSP(float, WS_LF)[(size_t)t * 8 + lane] = fminf(xv, 0.f) - log1pf(__expf(-fabsf(xv))); }
        cur = nxt;
    }
}
__device__ __forceinline__ void p4_cumsum(Frame& F) {
    if (F.wg >= 16) return;
    const int b = F.wg >> 3, h = F.wg & 7; const float* lf = WSP(float, WS_LF) + (size_t)b * SEQ * 8 + h; float* cs = WSP(float, WS_CS) + (size_t)F.wg * SEQ;
    LAS float* part = (LAS float*)(F.lds + RING_OFF); LAS float* tend = part + 512; LAS float* tstart = part + 768;
    const int t0 = F.tid * 32; float s = 0.f;
    for (int i = 0; i < 32; ++i) s += lf[(size_t)(t0 + i) * 8];
    part[F.tid] = s; __syncthreads();
    if (F.tid == 0) { float run = 0.f; for (int i = 0; i < 512; ++i) { const float v = part[i]; part[i] = run; run += v; } }
    __syncthreads();
    float run = part[F.tid];
    for (int i = 0; i < 32; ++i) { run += lf[(size_t)(t0 + i) * 8]; const float c = -run * 11.313708498984761f; cs[t0 + i] = c;
        if (i == 0 && (F.tid & 7) == 0) tstart[F.tid >> 3] = c; if (i == 31 && (F.tid & 1)) tend[F.tid >> 1] = c; }
    __syncthreads();
    if (F.tid < 64) { const float* qn = F.ap->in[I_QN]; const float* kn = F.ap->in[I_KN]; float mq = fmaxf(fabsf(qn[F.tid]), fabsf(qn[F.tid + 64])), mk = fmaxf(fabsf(kn[F.tid]), fabsf(kn[F.tid + 64]));
#pragma unroll
        for (int o = 1; o < 64; o <<= 1) { mq = fmaxf(mq, __shfl_xor(mq, o)); mk = fmaxf(mk, __shfl_xor(mk, o)); }
        const float horizon = 2.f * 1.01f * 11.313708498984761f * mq * mk + 9.704060527839234f + FOX_SKIP_BITS * 0.6931471805599453f;
        const int qb = F.tid; const float target = tstart[qb] - horizon * 11.313708498984761f; int lo = 0, hi = 4 * qb;
        while (lo < hi) { const int mid = (lo + hi) >> 1; if (tend[mid] >= target) hi = mid; else lo = mid + 1; }
        WSP(int, WS_JLO)[F.wg * 64 + qb] = lo; }
    __syncthreads();
}
__device__ __forceinline__ void p5_scan_naive(Frame& F) {
    constexpr int CH = 64;
    LAS float* Wl = (LAS float*)(F.lds + RING_OFF); LAS float* Al = Wl + CH * 64; LAS float* Bl = Al + CH * 64; LAS float* Kl = Bl + CH * 64; LAS float* Rl = Kl + CH * 64; LAS float* Vl = Rl + CH * 64; LAS float* Yl = Vl + CH * 64;
    const int tid = F.tid, row = tid >> 3, q = tid & 7;
    for (int bh = F.wg; bh < 32; bh += F.G) {
        const int b = bh >> 4, h = bh & 15; const size_t base = (size_t)b * SEQ * RW + h * 64;
        const bf16* Rg = WSP(bf16, WS_R) + base; const bf16* Kg = WSP(bf16, WS_K) + base; const bf16* Vg = WSP(bf16, WS_V) + base; const bf16* Ag = WSP(bf16, WS_A) + base;
        const float* Lg = WSP(float, WS_LOGW) + base; float* Yg = WSP(float, WS_YRAW) + base;
        float kkw[8], kaw[8];
#pragma unroll
        for (int i = 0; i < 8; ++i) { kkw[i] = F.ap->in[I_KK][h * 64 + 8 * q + i]; kaw[i] = F.ap->in[I_KA][h * 64 + 8 * q + i]; }
        float S[8] = {0.f, 0.f, 0.f, 0.f, 0.f, 0.f, 0.f, 0.f};
        for (int t0 = 0; t0 < SEQ; t0 += CH) {
            { const size_t off = (size_t)(t0 + row) * RW + 8 * q; float r[8], k[8], v[8], a[8];
              unpack8(*(const v4u*)(Rg + off), r); unpack8(*(const v4u*)(Kg + off), k); unpack8(*(const v4u*)(Vg + off), v); unpack8(*(const v4u*)(Ag + off), a);
              const f32x4 l0 = *(const f32x4*)(Lg + off), l1 = *(const f32x4*)(Lg + off + 4);
              float kk[8], ss = 0.f;
#pragma unroll
              for (int i = 0; i < 8; ++i) { kk[i] = k[i] * kkw[i]; ss += kk[i] * kk[i]; }
              ss += __shfl_xor(ss, 1); ss += __shfl_xor(ss, 2); ss += __shfl_xor(ss, 4);
              const float inv = 1.f / fmaxf(sqrtf(ss), 1e-12f);
#pragma unroll
              for (int i = 0; i < 8; ++i) { const int o = row * 64 + 8 * q + i; kk[i] *= inv;
                  Wl[o] = __expf(i < 4 ? l0[i] : l1[i - 4]); Al[o] = -kk[i]; Bl[o] = kk[i] * a[i]; Kl[o] = k[i] * (1.f + (a[i] - 1.f) * kaw[i]); Rl[o] = r[i]; Vl[o] = v[i]; } }
            __syncthreads();
            for (int t = 0; t < CH; ++t) { const int o = t * 64 + 8 * q; float sa = 0.f;
                const f32x4 a0 = *(const LAS f32x4*)(Al + o), a1 = *(const LAS f32x4*)(Al + o + 4), w0 = *(const LAS f32x4*)(Wl + o), w1 = *(const LAS f32x4*)(Wl + o + 4);
                const f32x4 b0 = *(const LAS f32x4*)(Bl + o), b1 = *(const LAS f32x4*)(Bl + o + 4), k0 = *(const LAS f32x4*)(Kl + o), k1 = *(const LAS f32x4*)(Kl + o + 4);
                const f32x4 r0 = *(const LAS f32x4*)(Rl + o), r1 = *(const LAS f32x4*)(Rl + o + 4); const float vv = Vl[t * 64 + row];
#pragma unroll
                for (int i = 0; i < 8; ++i) sa += S[i] * (i < 4 ? a0[i] : a1[i - 4]);
                sa += __shfl_xor(sa, 1); sa += __shfl_xor(sa, 2); sa += __shfl_xor(sa, 4);
                float y = 0.f;
#pragma unroll
                for (int i = 0; i < 8; ++i) { S[i] = S[i] * (i < 4 ? w0[i] : w1[i - 4]) + sa * (i < 4 ? b0[i] : b1[i - 4]) + vv * (i < 4 ? k0[i] : k1[i - 4]); y += S[i] * (i < 4 ? r0[i] : r1[i - 4]); }
                y += __shfl_xor(y, 1); y += __shfl_xor(y, 2); y += __shfl_xor(y, 4);
                if (q == 0) Yl[t * 64 + row] = y; }
            __syncthreads();
            { const int tt = tid >> 3, c = (tid & 7) * 8; *(f32x4*)(Yg + (size_t)(t0 + tt) * RW + c) = *(const LAS f32x4*)(Yl + tt * 64 + c); *(f32x4*)(Yg + (size_t)(t0 + tt) * RW + c + 4) = *(const LAS f32x4*)(Yl + tt * 64 + c + 4); }
        }
        __syncthreads();
    }
}
struct PostTok { v4u y[2], r[2], k[2], v[2], a[2], g[2]; };
__device__ __forceinline__ void post_load(PostTok& p, const unsigned char* ws, size_t off) {
#pragma unroll
    for (int j = 0; j < 2; ++j) { p.y[j] = *(const v4u*)((const bf16*)(ws + WS_YRAW) + off + 512 * j); p.r[j] = *(const v4u*)((const bf16*)(ws + WS_R) + off + 512 * j); p.k[j] = *(const v4u*)((const bf16*)(ws + WS_K) + off + 512 * j);
        p.v[j] = *(const v4u*)((const bf16*)(ws + WS_V) + off + 512 * j); p.a[j] = *(const v4u*)((const bf16*)(ws + WS_A) + off + 512 * j); p.g[j] = *(const v4u*)((const bf16*)(ws + WS_G) + off + 512 * j); }
}
__device__ __forceinline__ void p7_post(Frame& F) {
    const int gw = F.wg * NWAVES + F.wave, NGW = F.G * NWAVES, lane = F.lane, c0 = 8 * lane;
    float ka[16], rk[16], gng[16], gnb[16];
#pragma unroll
    for (int i = 0; i < 16; ++i) { const int c = 512 * (i >> 3) + c0 + (i & 7); ka[i] = F.ap->in[I_KA][c]; rk[i] = F.ap->in[I_RK][c]; gng[i] = F.ap->in[I_GNG][c]; gnb[i] = F.ap->in[I_GNB][c]; }
    PostTok cur, nxt; if (gw < T) post_load(cur, F.ws, (size_t)gw * RW + c0);
    for (int t = gw; t < T; t += NGW) { const size_t off = (size_t)t * RW + c0;
        if (t + NGW < T) post_load(nxt, F.ws, (size_t)(t + NGW) * RW + c0);
        float y[16], r[16], k[16], v[16], a[16], g[16];
#pragma unroll
        for (int j = 0; j < 2; ++j) { float tmp[8];
            unpack8(cur.y[j], tmp); for (int i = 0; i < 8; ++i) y[8 * j + i] = tmp[i];
            unpack8(cur.r[j], tmp); for (int i = 0; i < 8; ++i) r[8 * j + i] = tmp[i];
            unpack8(cur.k[j], tmp); for (int i = 0; i < 8; ++i) k[8 * j + i] = tmp[i];
            unpack8(cur.v[j], tmp); for (int i = 0; i < 8; ++i) v[8 * j + i] = tmp[i];
            unpack8(cur.a[j], tmp); for (int i = 0; i < 8; ++i) a[8 * j + i] = tmp[i];
            unpack8(cur.g[j], tmp); for (int i = 0; i < 8; ++i) g[8 * j + i] = tmp[i]; }
        float o[16];
#pragma unroll
        for (int j = 0; j < 2; ++j) { float s = 0.f, bs = 0.f;
#pragma unroll
            for (int i = 8 * j; i < 8 * j + 8; ++i) { s += y[i]; const float kp = k[i] * (1.f + (a[i] - 1.f) * ka[i]); bs += r[i] * kp * rk[i]; }
            s += __shfl_xor(s, 1); s += __shfl_xor(s, 2); s += __shfl_xor(s, 4); bs += __shfl_xor(bs, 1); bs += __shfl_xor(bs, 2); bs += __shfl_xor(bs, 4);
            const float mean = s * (1.f / 64.f); float q = 0.f;
#pragma unroll
            for (int i = 8 * j; i < 8 * j + 8; ++i) { const float d = y[i] - mean; q += d * d; }
            q += __shfl_xor(q, 1); q += __shfl_xor(q, 2); q += __shfl_xor(q, 4);
            const float rstd = rsqrtf(q * (1.f / 64.f) + GN_EPS);
#pragma unroll
            for (int i = 8 * j; i < 8 * j + 8; ++i) o[i] = ((y[i] - mean) * rstd * gng[i] + gnb[i] + bs * v[i]) * g[i]; }
#if OUTA_FP8
#pragma unroll
        for (int j = 0; j < 2; ++j) { v2u w; w.x = pk4_fp8(o[8 * j] * FP8_SYA, o[8 * j + 1] * FP8_SYA, o[8 * j + 2] * FP8_SYA, o[8 * j + 3] * FP8_SYA); w.y = pk4_fp8(o[8 * j + 4] * FP8_SYA, o[8 * j + 5] * FP8_SYA, o[8 * j + 6] * FP8_SYA, o[8 * j + 7] * FP8_SYA);
            *(v2u*)(WSP(unsigned char, WS_YA) + off + 512 * j) = w; }
#else
#pragma unroll
        for (int j = 0; j < 2; ++j) { v4u w; w.x = pk2(o[8 * j], o[8 * j + 1]); w.y = pk2(o[8 * j + 2], o[8 * j + 3]); w.z = pk2(o[8 * j + 4], o[8 * j + 5]); w.w = pk2(o[8 * j + 6], o[8 * j + 7]); *(v4u*)(WSP(bf16, WS_YA) + off + 512 * j) = w; }
#endif
        cur = nxt;
    }
}
__device__ __forceinline__ fox::BlockRef<fox::bf16, fox::bf16> fox_ref(int L_, const unsigned char* ws) {
    const int it = ((const int*)(ws + WS_AORD))[L_], bh = it & 15, qb = it >> 4;
    fox::BlockRef<fox::bf16, fox::bf16> r; r.ws = ws; r.row0 = (bh / fox::H) * fox::SQ + qb * fox::QB; r.bh = bh; r.P0 = qb * fox::QB; r.jlo = ((const int*)(ws + WS_JLO))[bh * 64 + qb]; return r;
}
__device__ __forceinline__ void att_order(Frame& F) {
    LAS int* hist = (LAS int*)(F.lds + RING_OFF); LAS int* base = hist + 260;
    for (int i = F.tid; i < 260; i += NWAVES * 64) hist[i] = 0;
    __syncthreads();
    const int* jl = WSP(int, WS_JLO); int cost[2];
#pragma unroll
    for (int u = 0; u < 2; ++u) { const int it = F.tid + 512 * u, bh = it & 15, qb = it >> 4; cost[u] = 4 * (qb + 1) - jl[bh * 64 + qb]; __hip_atomic_fetch_add(hist + cost[u], 1, __ATOMIC_RELAXED, __HIP_MEMORY_SCOPE_WORKGROUP); }
    __syncthreads();
    if (F.tid == 0) { int run = 0; for (int c = 256; c >= 0; --c) { base[c] = run; run += hist[c]; } }
    __syncthreads();
#pragma unroll
    for (int u = 0; u < 2; ++u) { const int it = F.tid + 512 * u; const int pos = __hip_atomic_fetch_add(base + cost[u], 1, __ATOMIC_RELAXED, __HIP_MEMORY_SCOPE_WORKGROUP); WSP(int, WS_AORD)[pos] = it; }
    __syncthreads();
}
__device__ __forceinline__ int att_fetch(Frame& F, int qi = 0) {
    if (F.tid == 0) F.MISC[4] = __hip_atomic_fetch_add(F.ctl + CW_ATTQ + qi, 1u, RLX_AGENT);
    __syncthreads(); const int v = (int)F.MISC[4]; __syncthreads(); return v;
}
__device__ __forceinline__ void p6_attention(Frame& F, char* lds, int qi = 0) {
    constexpr int TOTAL = (fox::SQ / fox::QB) * fox::B * fox::H;
    int L = att_fetch(F, qi); if (L >= TOTAL) return;
    fox::BlockRef<fox::bf16, fox::bf16> cur = fox_ref(L, F.ws);
    fox::Seam<fox::bf16> S;
    fox::causal_swa_prime<fox::bf16, fox::bf16>(cur, fox::WINDOW, lds, S, F.tid);
    for (;;) {
        const int Ln = att_fetch(F, qi); const bool last = Ln >= TOTAL;
        const fox::BlockRef<fox::bf16, fox::bf16> nxt = last ? cur : fox_ref(Ln, F.ws);
        fox::causal_swa_block<fox::bf16, fox::bf16>(cur, nxt, fox::SKV, fox::WINDOW, lds, S, F.tid);
        if (last) break;
        cur = nxt;
    }
}
typedef float f32x4m __attribute__((ext_vector_type(4)));
__device__ __forceinline__ void p11_router(Frame& F) {
    constexpr int TPW = T / 256 / NWAVES, XP = 136;
    const int lane = F.lane, t0 = (F.wg * NWAVES + F.wave) * TPW;
    const float* x1 = WSP(float, WS_X1); const float* mod = WSP(float, WS_MOD) + (size_t)(t0 / SEQ) * 12288; const float* g2 = F.ap->in[I_N2G]; const float* wrt = WSP(float, WS_WRT);
    LAS float* xs = (LAS float*)(F.lds + RING_OFF + F.wave * (16 * XP * 4));
    LAS float* av = (LAS float*)(F.lds + RING_OFF + 69632); LAS float* sv = av + DM;
    LAS float* lg = (LAS float*)(F.lds + RING_OFF + 86016 + F.wave * 2304);
    LAS int* cnt = (LAS int*)(F.lds + RING_OFF + 104448);
    LAS float* cpart = (LAS float*)(F.lds + RING_OFF + 104704);
    if (F.tid < 32) cnt[F.tid] = 0;
    { const int c = 4 * F.tid; const f32x4 gg = *(const f32x4*)(g2 + c), sc = *(const f32x4*)(mod + 4 * 2048 + c), sh = *(const f32x4*)(mod + 3 * 2048 + c);
      *(LAS f32x4*)(av + c) = gg * (sc + 1.f); *(LAS f32x4*)(sv + c) = sh; }
    __syncthreads();
    { const int e = F.tid & 31, part = F.tid >> 5; float s = 0.f;
      for (int k = 128 * part; k < 128 * part + 128; k += 4) { const f32x4 w = *(const f32x4*)(wrt + (size_t)e * DM + k), h = *(const LAS f32x4*)(sv + k); s += (w[0] * h[0] + w[1] * h[1]) + (w[2] * h[2] + w[3] * h[3]); }
      cpart[part * 32 + e] = s; }
    __syncthreads();
    if (F.tid < 32) { float s = F.ap->in[I_BR][F.tid];
#pragma unroll
        for (int p = 0; p < 16; ++p) s += cpart[p * 32 + F.tid];
        cpart[512 + F.tid] = s; }
    __syncthreads();
    const int i = lane & 15, q = lane >> 4, hf = lane >> 5, l32 = lane & 31;
    { const float* sp = WSP(float, WS_SSP) + (size_t)(8 * q) * T + t0 + i; float s = 0.f;
#pragma unroll
      for (int p = 0; p < 8; ++p) s += sp[(size_t)p * T];
      s += __shfl_xor(s, 16); s += __shfl_xor(s, 32); if (q == 0) lg[512 + i] = rsqrtf(s * (1.f / DM) + NORM_EPS); }
    LDS_WAIT(); asm volatile("" ::: "memory");
    float rsj[8];
#pragma unroll
    for (int j = 0; j < 8; ++j) rsj[j] = lg[512 + 2 * j + hf];
    unsigned char* H2 = WSP(unsigned char, WS_HS) + (size_t)(t0 + hf) * DM + 4 * l32;
    f32x4m acc0 = {0.f, 0.f, 0.f, 0.f}, acc1 = {0.f, 0.f, 0.f, 0.f};
    const float* xrow = x1 + (size_t)(t0 + hf) * DM + 4 * l32; const float* wr = wrt + (size_t)i * DM + 4 * q;
    for (int k0 = 0; k0 < DM; k0 += 128) { f32x4 xv[8], w0[8], w1[8];
#pragma unroll
        for (int j = 0; j < 8; ++j) xv[j] = *(const f32x4*)(xrow + (size_t)(2 * j) * DM + k0);
#pragma unroll
        for (int u = 0; u < 8; ++u) { w0[u] = *(const f32x4*)(wr + k0 + 16 * u); w1[u] = *(const f32x4*)(wr + 16 * DM + k0 + 16 * u); }
        const f32x4 a4 = *(const LAS f32x4*)(av + k0 + 4 * l32), s4 = *(const LAS f32x4*)(sv + k0 + 4 * l32) * FP8_SA1;
#pragma unroll
        for (int j = 0; j < 8; ++j) { const f32x4 xa = xv[j] * a4, hh = xa * (rsj[j] * FP8_SA1) + s4; *(LAS f32x4*)(xs + (2 * j + hf) * XP + 4 * l32) = xa;
            *(unsigned*)(H2 + (size_t)(2 * j) * DM + k0) = pk4_fp8(hh[0], hh[1], hh[2], hh[3]); }
        LDS_WAIT(); asm volatile("" ::: "memory");
#pragma unroll
        for (int u = 0; u < 8; ++u) { const f32x4 hv = *(const LAS f32x4*)(xs + i * XP + 16 * u + 4 * q);
#pragma unroll
            for (int jj = 0; jj < 4; ++jj) { acc0 = __builtin_amdgcn_mfma_f32_16x16x4f32(hv[jj], w0[u][jj], acc0, 0, 0, 0); acc1 = __builtin_amdgcn_mfma_f32_16x16x4f32(hv[jj], w1[u][jj], acc1, 0, 0, 0); } }
        LDS_WAIT(); asm volatile("" ::: "memory"); }
    { const float c0 = cpart[512 + i], c1 = cpart[512 + 16 + i];
#pragma unroll
      for (int r = 0; r < 4; ++r) { const float rs = lg[512 + 4 * q + r]; lg[(4 * q + r) * 32 + i] = acc0[r] * rs + c0; lg[(4 * q + r) * 32 + 16 + i] = acc1[r] * rs + c1; } }
    LDS_WAIT(); asm volatile("" ::: "memory");
    if (lane < 16) { const int m = t0 + lane; float v[4]; int e[4]; unsigned used = 0u;
#pragma unroll
        for (int k = 0; k < 4; ++k) { float best = -3.0e38f; int bi = 0;
            for (int j = 0; j < 32; ++j) { const float x = lg[lane * 32 + j]; if (!((used >> j) & 1u) && x > best) { best = x; bi = j; } }
            used |= 1u << bi; v[k] = best; e[k] = bi; }
        const float e1 = __expf(v[1] - v[0]), e2 = __expf(v[2] - v[0]), e3 = __expf(v[3] - v[0]), inv = 1.f / (1.f + e1 + e2 + e3);
        *(f32x4*)(WSP(float, WS_TOKW) + (size_t)m * 4) = (f32x4){inv, e1 * inv, e2 * inv, e3 * inv};
        int* te = WSP(int, WS_TOKE) + (size_t)m * 4; te[0] = e[0]; te[1] = e[1]; te[2] = e[2]; te[3] = e[3];
#pragma unroll
        for (int k = 0; k < 4; ++k) __hip_atomic_fetch_add(cnt + e[k], 1, __ATOMIC_RELAXED, __HIP_MEMORY_SCOPE_WORKGROUP); }
    __syncthreads();
    if (F.tid < 32) WSP(int, WS_WGCNT)[F.wg * 32 + F.tid] = cnt[F.tid];
    __syncthreads();
}
__device__ __forceinline__ void p12_slots(Frame& F) {
    constexpr int TPG = T / 256;
    LAS int* cur = (LAS int*)(F.lds + RING_OFF); LAS int* tot = cur + 32; LAS int* pre = cur + 64; LAS int* off = cur + 96; LAS int* slotl = cur + 160;
    const int* wgcnt = WSP(int, WS_WGCNT);
    if (F.tid < 32) { int tt = 0, pp = 0; for (int w = 0; w < 256; ++w) { const int c = wgcnt[w * 32 + F.tid]; if (w < F.wg) pp += c; tt += c; } tot[F.tid] = tt; pre[F.tid] = pp; }
    __syncthreads();
    if (F.tid == 0) { int o = 0; for (int e = 0; e < 32; ++e) { off[e] = o; o += (tot[e] + 255) & ~255; } off[32] = o; }
    __syncthreads();
    if (F.tid < 32) cur[F.tid] = off[F.tid] + pre[F.tid];
    if (F.wg == 0) { int* te = WSP(int, WS_TILEE); const int nt = off[32] >> 8;
        for (int p = F.tid; p < nt; p += NWAVES * 64) { int e = 0; for (int j = 1; j < 32; ++j) if ((p << 8) >= off[j]) e = j; te[p] = e; }
        if (F.tid == 0) te[1024] = nt; }
    __syncthreads();
    { const int t = F.wg * TPG + (F.tid >> 2), k = F.tid & 3; const int e = WSP(int, WS_TOKE)[(size_t)t * 4 + k];
      const int s = __hip_atomic_fetch_add(cur + e, 1, __ATOMIC_RELAXED, __HIP_MEMORY_SCOPE_WORKGROUP);
      WSP(int, WS_TOKS)[(size_t)t * 4 + k] = s; WSP(int, WS_STOK)[s] = t; WSP(float, WS_SLOTW)[s] = WSP(float, WS_TOKW)[(size_t)t * 4 + k]; }
    if (F.wg < 32) { const int s = off[F.wg] + tot[F.wg] + F.tid; if (s < off[F.wg + 1]) WSP(int, WS_STOK)[s] = 0; }
    __syncthreads();
}
__device__ __forceinline__ void p15_final(Frame& F) {
    const int gw = F.wg * NWAVES + F.wave, NGW = F.G * NWAVES, lane = F.lane;
    const float* x1 = WSP(float, WS_X1); const unsigned char* YS = WSP(unsigned char, WS_YS); const float* gf = F.ap->in[I_NFG];
    typedef float f32x2f __attribute__((ext_vector_type(2)));
#ifdef PROBE_P17X
    for (int mm = gw; mm < 2 * T; mm += NGW) { const int m = mm & (T - 1); const float* gt = WSP(float, WS_MOD) + (size_t)(m / SEQ) * 12288 + 5 * 2048;
#else
    for (int m = gw; m < T; m += NGW) { const float* gt = WSP(float, WS_MOD) + (size_t)(m / SEQ) * 12288 + 5 * 2048;
#endif
        const int4 sl = *(const int4*)(WSP(int, WS_TOKS) + (size_t)m * 4); f32x4 v[8]; float ss = 0.f;
        const unsigned char* y0 = YS + (size_t)sl.x * DM + 4 * lane; const unsigned char* y1 = YS + (size_t)sl.y * DM + 4 * lane; const unsigned char* y2 = YS + (size_t)sl.z * DM + 4 * lane; const unsigned char* y3 = YS + (size_t)sl.w * DM + 4 * lane;
#pragma unroll
        for (int u = 0; u < 8; ++u) { const int c = 256 * u + 4 * lane;
            const int q0 = *(const int*)(y0 + 256 * u), q1 = *(const int*)(y1 + 256 * u), q2 = *(const int*)(y2 + 256 * u), q3 = *(const int*)(y3 + 256 * u);
            const f32x4 xa = *(const f32x4*)(x1 + (size_t)m * DM + c), ga = *(const f32x4*)(gt + c);
            const f32x2f s0 = (__builtin_amdgcn_cvt_pk_f32_fp8(q0, false) + __builtin_amdgcn_cvt_pk_f32_fp8(q1, false)) + (__builtin_amdgcn_cvt_pk_f32_fp8(q2, false) + __builtin_amdgcn_cvt_pk_f32_fp8(q3, false));
            const f32x2f s1 = (__builtin_amdgcn_cvt_pk_f32_fp8(q0, true) + __builtin_amdgcn_cvt_pk_f32_fp8(q1, true)) + (__builtin_amdgcn_cvt_pk_f32_fp8(q2, true) + __builtin_amdgcn_cvt_pk_f32_fp8(q3, true));
            const f32x4 y = (f32x4){s0.x, s0.y, s1.x, s1.y} * (1.f / FP8_SY), xv = xa + ga * y; v[u] = xv; ss += (xv[0] * xv[0] + xv[1] * xv[1]) + (xv[2] * xv[2] + xv[3] * xv[3]); }
        const float rs = rsqrtf(wave_sum(ss) * (1.f / DM) + NORM_EPS);
#pragma unroll
        for (int u = 0; u < 8; ++u) { const int c = 256 * u + 4 * lane; const f32x4 ga = *(const f32x4*)(gf + c); *(f32x4*)(F.ap->out + (size_t)m * DM + c) = v[u] * rs * ga; }
    }
}

__device__ __forceinline__ void stagger(Frame& F, int ticks_step) {
    const unsigned long long t0 = __builtin_amdgcn_s_memrealtime(), d = (unsigned long long)(((F.wg * 5) & 7) * ticks_step);
    while (__builtin_amdgcn_s_memrealtime() - t0 < d) __builtin_amdgcn_s_sleep(8);
}
__device__ __forceinline__ bool fresh(Frame& F) {
    asm volatile("" : "+s"(F.ap)); int w = F.wave; asm volatile("" : "+s"(w)); const int l = __builtin_amdgcn_mbcnt_hi(~0u, __builtin_amdgcn_mbcnt_lo(~0u, 0u)); F.lane = l; F.tid = w * 64 + l; return true; }
constexpr int N_PHASES = 18;
#ifndef STAGGER_TICKS
#define STAGGER_TICKS 400
#endif
#ifndef N_CONV_WG
#define N_CONV_WG 96
#endif
__global__ void __launch_bounds__(NWAVES * 64, 2) mk_fwd(Args args) {
    extern __shared__ __attribute__((aligned(16))) unsigned char lds[];
    Frame F;
    F.lds = (LAS unsigned char*)lds; F.MISC = (volatile LAS unsigned*)(F.lds + MISC_OFF);
    F.tid = threadIdx.x; F.lane = F.tid & 63; F.wave = __builtin_amdgcn_readfirstlane(F.tid >> 6); F.G = gridDim.x; F.wg = blockIdx.x;
    F.ap = (ArgsP)__builtin_amdgcn_kernarg_segment_ptr(); F.ws = F.ap->ws; F.ctl = (gu32*)(F.ws + WS_CTL);
    for (int u = F.tid; u < (LDS_BYTES - LDSCTL_OFF) / 4; u += NWAVES * 64) ((LAS unsigned*)(F.lds + LDSCTL_OFF))[u] = 0u;
    __syncthreads();
    const int lo = F.ap->ph_lo, hi = F.ap->ph_hi;
    XcdBarrier bar; bar.bar = (unsigned*)(F.ctl + CW_BAR); bar.x = 0; bar.st = nullptr;
    if (hi - lo > 1) bar = xcd_barrier_post((unsigned*)(F.ctl + CW_BAR), F.MISC + 8, F.tid);
#ifndef PH_MASK
#define PH_MASK 0x3ffff
#endif
#define IN(k) (((PH_MASK >> (k)) & 1) && lo <= (k) && (k) < hi && fresh(F))
#ifndef PROBE_DUP
#define PROBE_DUP 0
#endif
#ifndef PROBE_PHASEA
#define PROBE_PHASEA -1
#endif
#ifndef PROBE_TILE_EPI
#define PROBE_TILE_EPI 0
#endif
#ifndef PROBE_NULL_EPI
#define PROBE_NULL_EPI 0
#endif
#define REP(k) for (int rep_ = 0; rep_ < 1 + ((PROBE_DUP >> (k)) & 1); ++rep_)
#define SEAM_NB(k) do { } while (0)
#define SEAM(k) do { if (IN(k) && IN((k) + 1)) xcd_barrier(bar, F.tid); } while (0)
    if (IN(0)) REP(0) { p0_prologue(F); } SEAM(0);
    if (IN(1)) REP(1) { norm_mod_rows<INPROJ_FP8>(F, F.ap->in[I_X], F.ap->in[I_N1G], 0, 2048, WSP(bf16, WS_H), WSP(unsigned char, WS_H8)); } SEAM(1);
    if (IN(2)) REP(2) {
#if INPROJ_FP8 == 1
        pg8::Gemm g{WSP(bf16, WS_H8), WSP(bf16, WS_WIN8), T, NP, DM / 2}; pg8::StaticOrder S; S.init(T, NP, F.G, F.wg);
        pg8::EpiBf16S E{WSP(bf16, WS_P), NP, 1.f / (FP8_SA1 * FP8_SW)}; pg8::gemm_phase<pg8::EpiBf16S, pg8::StaticOrder, true, true, true>(F.lds + RING_OFF, g, S, E, F.tid);
#elif INPROJ_FP8 == 2
        pg8::Gemm g{WSP(bf16, WS_H8), (const pg8::bf16_t*)(F.ws + WS_WIN8 + (size_t)PC_SPLIT * DM), T, NP - PC_SPLIT, DM / 2}; pg8::StaticOrder S; S.init(T, NP - PC_SPLIT, F.G, F.wg);
#ifdef PROBE_EXTRA_ST
        pg8::EpiBf16S E{WSP(bf16, WS_P) + PC_SPLIT, NP, 1.f / (FP8_SA1 * FP8_SW), (pg8::bf16_t*)(F.ws + WS_END + (size_t)F.wg * 131072)};
#else
        pg8::EpiBf16S E{WSP(bf16, WS_P) + PC_SPLIT, NP, 1.f / (FP8_SA1 * FP8_SW)};
#endif
        pg8::gemm_phase<pg8::EpiBf16S, pg8::StaticOrder, true, true, true>(F.lds + RING_OFF, g, S, E, F.tid);
#else
        pg8::Gemm g{WSP(bf16, WS_H), WSP(bf16, WS_WIN), T, NP, DM}; pg8::StaticOrder S; S.init(T, NP, F.G, F.wg);
        pg8::EpiBf16<0> E{WSP(bf16, WS_P), NP, nullptr, 0, 0, 1.f}; pg8::gemm_phase<pg8::EpiBf16<0>, pg8::StaticOrder, true, true>(F.lds + RING_OFF, g, S, E, F.tid);
#endif
        } SEAM_NB(2);
#if INPROJ_FP8 == 2
    if (IN(2)) { (void)fresh(F); pg8::Gemm g{WSP(bf16, WS_H), WSP(bf16, WS_WIN), T, PC_SPLIT, DM}; pg8::StaticOrder S; S.init(T, PC_SPLIT, F.G, F.wg);
        pg8::EpiBf16<0> E{WSP(bf16, WS_P), NP, nullptr, 0, 0, 1.f}; pg8::gemm_phase<pg8::EpiBf16<0>, pg8::StaticOrder, true, true>(F.lds + RING_OFF, g, S, E, F.tid); }
#endif
    SEAM(2);
    if (IN(3)) REP(3) { p3_prep(F); } SEAM(3);
    if (IN(4)) REP(4) { p4_cumsum(F);
        { pg8::Gemm g{WSP(bf16, WS_LW), WSP(bf16, WS_BT1), T, 2048, 256}; pg8::StaticOrder S; S.init(T, 2048, F.G, F.wg);
          pg8::EpiLora1 E{WSP(float, WS_LOGW), WSP(bf16, WS_A), F.ap->in[I_W0], F.ap->in[I_A0]}; pg8::gemm_phase<pg8::EpiLora1, pg8::StaticOrder, true, true>(F.lds + RING_OFF, g, S, E, F.tid); }
        } SEAM(4);
    if (IN(5)) REP(5) { if (F.wg == 0) att_order(F);
        { pg8::Gemm g{WSP(bf16, WS_SG), WSP(bf16, WS_BT2), T, 1024, 256}; pg8::StaticOrder S; S.init(T, 1024, F.G, F.wg);
          pg8::EpiBf16<0> E{WSP(bf16, WS_G), 1024, nullptr, 0, 0, 1.f}; pg8::gemm_phase<pg8::EpiBf16<0>, pg8::StaticOrder, true, true>(F.lds + RING_OFF, g, S, E, F.tid); }
        } SEAM(5);
    if (IN(6)) REP(6) {
#if RWKV_NAIVE
        p5_scan_naive(F);
#else
        rw::phase_a<0>(F.lds + RING_OFF, F.ws, WS_REC, F.ap->in[I_KK], F.ap->in[I_KA], F.wg, F.G, F.tid);
#if PROBE_PHASEA >= 0
        __syncthreads(); rw::phase_a<PROBE_PHASEA>(F.lds + RING_OFF, F.ws, WS_END, F.ap->in[I_KK], F.ap->in[I_KA], F.wg, F.G, F.tid);
#endif
#endif
        } SEAM(6);
    if (IN(7)) REP(7) {
#if !RWKV_NAIVE
        for (int bh = F.wg; bh < 32; bh += F.G) { const int b = bh >> 4, h = bh & 15;
            rw::phase_b_head(F.lds + RING_OFF, F.ws + WS_REC + (size_t)bh * 256 * rw::REC, WSP(unsigned short, WS_YRAW) + (size_t)b * SEQ * RW + h * 64, F.tid); __syncthreads(); }
#endif
        if (F.wg >= 32 && F.wg < 32 + N_CONV_WG) { convert_experts(F, F.wg - 32, N_CONV_WG); __syncthreads(); }
        p6_attention(F, (char*)lds + RING_OFF, 0); } SEAM(7);
#ifdef PROBE_P7
    if (IN(8)) {
        for (int bh = F.wg; bh < 32; bh += F.G) { const int b = bh >> 4, h = bh & 15;
            rw::phase_b_head(F.lds + RING_OFF, F.ws + WS_REC + (size_t)bh * 256 * rw::REC, WSP(unsigned short, WS_YRAW) + (size_t)b * SEQ * RW + h * 64, F.tid); __syncthreads(); }
        if (F.wg >= 32 && F.wg < 32 + N_CONV_WG) { convert_experts(F, F.wg - 32, N_CONV_WG); __syncthreads(); }
        p6_attention(F, (char*)lds + RING_OFF, 1); } SEAM(8);
#endif
    if (IN(9)) REP(9) { p7_post(F); } SEAM(9);
    if (IN(10)) REP(10) { pg8::Gemm g{WSP(bf16, WS_YA), WSP(bf16, WS_WOA), T, DM, 1024}; pg8::StaticOrder S; S.init(T, DM, F.G, F.wg);
        pg8::EpiGateMerge<0> E{WSP(bf16, WS_MRG), WSP(bf16, WS_P), PC_GA, nullptr}; pg8::gemm_phase<pg8::EpiGateMerge<0>, pg8::StaticOrder, true, true>(F.lds + RING_OFF, g, S, E, F.tid); } SEAM(10);
    if (IN(11)) REP(11) { pg8::Gemm g{WSP(bf16, WS_YB), WSP(bf16, WS_WOB), T, DM, 1024}; pg8::StaticOrder S; S.init(T, DM, F.G, F.wg);
        pg8::EpiGateMerge<1> E{WSP(bf16, WS_MRG), WSP(bf16, WS_P), PC_GB, WSP(unsigned char, WS_MRG8)}; pg8::gemm_phase<pg8::EpiGateMerge<1>, pg8::StaticOrder, true, true>(F.lds + RING_OFF, g, S, E, F.tid); } SEAM(11);
#if OUTPROJ_FP8
    if (IN(12)) REP(12) { pg8::Gemm g{WSP(bf16, WS_MRG8), WSP(bf16, WS_WOUT), T, DM, DM / 2}; pg8::StaticOrder S; S.init(T, DM, F.G, F.wg);
        pg8::EpiResid E{F.ap->in[I_X], WSP(float, WS_X1), WSP(float, WS_MOD), WSP(float, WS_SSP), 1.f / (FP8_SM * FP8_SW)}; pg8::gemm_phase<pg8::EpiResid, pg8::StaticOrder, true, true, true>(F.lds + RING_OFF, g, S, E, F.tid); } SEAM(12);
#else
    if (IN(12)) REP(12) { pg8::Gemm g{WSP(bf16, WS_MRG), WSP(bf16, WS_WOUT), T, DM, DM}; pg8::StaticOrder S; S.init(T, DM, F.G, F.wg);
        pg8::EpiResid E{F.ap->in[I_X], WSP(float, WS_X1), WSP(float, WS_MOD), WSP(float, WS_SSP), 1.f}; pg8::gemm_phase<pg8::EpiResid, pg8::StaticOrder, true, true>(F.lds + RING_OFF, g, S, E, F.tid); } SEAM(12);
#endif
    if (IN(13)) REP(13) { p11_router(F); } SEAM(13);
    if (IN(14)) REP(14) { p12_slots(F); } SEAM(14);
    if (IN(15)) REP(15) { const int nt = WSP(int, WS_TILEE)[1024]; pg8::Gemm g{WSP(bf16, WS_HS), WSP(bf16, WS_WGU), nt * 256, 4096, DM / 2, WSP(int, WS_STOK)}; pg8::MoeOrder S; S.init(nt * 256, 4096, F.G, F.wg); S.tile_e = WSP(int, WS_TILEE);
        pg8::EpiSwiglu E{WSP(unsigned char, WS_ACT), F.ap->in[I_BGU]}; pg8::gemm_phase<pg8::EpiSwiglu, pg8::MoeOrder, true, true, true, true>(F.lds + RING_OFF, g, S, E, F.tid); } SEAM(15);
    if (IN(16)) REP(16) { const int nt = WSP(int, WS_TILEE)[1024]; pg8::Gemm g{WSP(bf16, WS_ACT), WSP(bf16, WS_WDN), nt * 256, 2048, DFF / 2}; pg8::MoeOrder S; S.init(nt * 256, 2048, F.G, F.wg); S.tile_e = WSP(int, WS_TILEE);
        pg8::EpiDown E{WSP(unsigned char, WS_YS), F.ap->in[I_BDN], WSP(float, WS_SLOTW)}; pg8::gemm_phase<pg8::EpiDown, pg8::MoeOrder, true, true, true>(F.lds + RING_OFF, g, S, E, F.tid); } SEAM(16);
    if (IN(17)) REP(17) { p15_final(F); }
#undef IN
#undef SEAM
}

extern "C" void kernel_launch(void* const* d_in, const int* in_sizes, int n_in, void* d_out, int out_size, void* d_ws, size_t ws_size, hipStream_t stream) {
    static int grid = 0;
    if (grid == 0) {
        if (n_in != N_IN || in_sizes[0] != T * DM || out_size != T * DM || ws_size < WS_END) { fprintf(stderr, "kernel_launch: shape/workspace mismatch (n_in %d, in0 %d, out %d, ws %zu < %zu)\n", n_in, n_in > 0 ? in_sizes[0] : -1, out_size, ws_size, (size_t)WS_END); grid = -1; return; }
        if (hipFuncSetAttribute((const void*)mk_fwd, hipFuncAttributeMaxDynamicSharedMemorySize, LDS_BYTES) != hipSuccess) { fprintf(stderr, "kernel_launch: hipFuncSetAttribute failed\n"); grid = -1; return; }
        int per_cu = 0;
        if (hipOccupancyMaxActiveBlocksPerMultiprocessor(&per_cu, (const void*)mk_fwd, NWAVES * 64, LDS_BYTES) != hipSuccess || per_cu < 1) fprintf(stderr, "kernel_launch: note: occupancy query reports %d workgroups per CU\n", per_cu);
        (void)hipGetLastError();
        grid = 256;
    }
    if (grid < 0) return;
    (void)hipMemsetAsync((char*)d_ws + WS_CTL, 0, CTL_ZERO_BYTES, stream);
    Args a{};
    for (int i = 0; i < N_IN; ++i) a.in[i] = (const float*)d_in[i];
    a.out = (float*)d_out; a.ws = (unsigned char*)d_ws;
#if MK_N_LAUNCHES == 1
    a.ph_lo = 0; a.ph_hi = N_PHASES;
    hipLaunchKernelGGL(mk_fwd, dim3(grid), dim3(NWAVES * 64), LDS_BYTES, stream, a);
#else
    for (int p = 0; p < N_PHASES; ++p) { a.ph_lo = p; a.ph_hi = p + 1; hipLaunchKernelGGL(mk_fwd, dim3(grid), dim3(NWAVES * 64), LDS_BYTES, stream, a); }
#endif
}
```
